# Optimizing an MI355X kernel written in HIP

```python
import math
import jax, jax.numpy as jnp
from jax import lax
import numpy as np

D_MODEL = 1024
BATCH = 4
SEQ = 8192
DEPTH = 2

RWKV_HEADS = 8
RWKV_HEAD_DIM = 64
RWKV_WIDTH = RWKV_HEADS * RWKV_HEAD_DIM
DECAY_LORA = 64
AAA_LORA = 64
MV_LORA = 32
GATE_LORA = 128
LN_X_EPS = 64e-5
MOBA_HEADS = 8
MOBA_HEAD_DIM = 64
MOBA_WIDTH = MOBA_HEADS * MOBA_HEAD_DIM
MOBA_BLOCK = 256
MOBA_TOPK = 3
Q_CHUNK = 128
REL_BUCKETS = 32
REL_MAX_DIST = 128
N_GROUPS = 4
EXPERTS_PER_GROUP = 8
N_EXPERTS = N_GROUPS * EXPERTS_PER_GROUP
FINE_TOPK = 2
D_EXPERT = 512
MOE_CHUNK = 1024
NORM_EPS = 1e-6
QK_EPS = 1e-6
IN_WIDTH = 3 * RWKV_WIDTH + 3 * MOBA_WIDTH + 2 * D_MODEL
SPLITS = [RWKV_WIDTH, 2 * RWKV_WIDTH, 3 * RWKV_WIDTH,
          3 * RWKV_WIDTH + MOBA_WIDTH, 3 * RWKV_WIDTH + 2 * MOBA_WIDTH,
          3 * RWKV_WIDTH + 3 * MOBA_WIDTH, 3 * RWKV_WIDTH + 3 * MOBA_WIDTH + D_MODEL]

kernel_name = 'hybrid_rwkv7_moba_hmoe'


def rms_norm(x, g, eps=NORM_EPS):
    xf = x.astype(jnp.float32)
    y = xf * lax.rsqrt(jnp.mean(xf * xf, axis=-1, keepdims=True) + eps)
    return (y * g.astype(jnp.float32)).astype(x.dtype)


def token_shift(x):
    return jnp.pad(x, ((0, 0), (1, 0), (0, 0)))[:, :-1]


def t5_bucket(rel):
    n = jnp.maximum(-rel, 0)
    max_exact = REL_BUCKETS // 2
    nf = jnp.maximum(n, 1).astype(jnp.float32)
    large = max_exact + (jnp.log(nf / max_exact) / math.log(REL_MAX_DIST / max_exact)
                         * (REL_BUCKETS - max_exact)).astype(jnp.int32)
    large = jnp.minimum(large, REL_BUCKETS - 1)
    return jnp.where(n < max_exact, n, large)


def rwkv7_scan(r, w, k, v, a, b):
    B_, S_, H, N = r.shape

    def step(state, inp):
        r_t, w_t, k_t, v_t, a_t, b_t = inp
        sa = jnp.einsum('bhvk,bhk->bhv', state, a_t)
        state = (state * w_t[:, :, None, :] + sa[..., None] * b_t[:, :, None, :]
                 + v_t[..., None] * k_t[:, :, None, :])
        return state, jnp.einsum('bhvk,bhk->bhv', state, r_t)

    xs = tuple(jnp.moveaxis(t, 1, 0) for t in (r, w, k, v, a, b))
    s0 = jnp.zeros((B_, H, N, N), jnp.float32)
    _, y = lax.scan(step, s0, xs)
    return jnp.moveaxis(y, 0, 1)


def rwkv7_branch(xn, r_p, k_p, v_p, mu_rkv, mu_x, w0, w1, w2, a0, a1, a2, g1, g2,
                 k_k, k_a, r_k, lnx_g, lnx_b, v_first, vres):
    B_, S_, _ = xn.shape
    H, N = RWKV_HEADS, RWKV_HEAD_DIM
    f32 = jnp.float32
    r = r_p + (token_shift(r_p) - r_p) * mu_rkv[0]
    k = k_p + (token_shift(k_p) - k_p) * mu_rkv[1]
    v = v_p + (token_shift(v_p) - v_p) * mu_rkv[2]
    xx = token_shift(xn) - xn
    xw = xn + xx * mu_x[0]
    xa = xn + xx * mu_x[1]
    xg = xn + xx * mu_x[2]
    w = -jax.nn.softplus(-(w0 + jnp.tanh(xw @ w1) @ w2).astype(f32)) - 0.5
    decay = jnp.exp(-jnp.exp(w))
    a = jax.nn.sigmoid(a0 + (xa @ a1) @ a2)
    g = jax.nn.sigmoid(xg @ g1) @ g2
    if vres is None:
        v_first = v
    else:
        v_mu, v0, v1, v2 = vres
        xv = xn + xx * v_mu
        v = v + (v_first - v) * jax.nn.sigmoid(v0 + (xv @ v1) @ v2)
    heads = lambda t: t.reshape(B_, S_, H, N).astype(f32)
    kk = heads(k * k_k)
    kk = kk / jnp.maximum(jnp.sqrt(jnp.sum(kk * kk, axis=-1, keepdims=True)), 1e-12)
    k = k * (1.0 + (a - 1.0) * k_a)
    rh, kh, vh, ah = heads(r), heads(k), heads(v), heads(a)
    y = rwkv7_scan(rh, heads(decay), kh, vh, -kk, kk * ah)
    mean = jnp.mean(y, axis=-1, keepdims=True)
    var = jnp.mean(jnp.square(y - mean), axis=-1, keepdims=True)
    y = ((y - mean) * lax.rsqrt(var + LN_X_EPS)).reshape(B_, S_, H * N)
    y = y * lnx_g.astype(f32) + lnx_b.astype(f32)
    bonus = jnp.sum(rh * kh * r_k.astype(f32), axis=-1, keepdims=True) * vh
    y = (y + bonus.reshape(B_, S_, H * N)) * g.astype(f32)
    return y.astype(xn.dtype), v_first


def moba_branch(q, k, v, q_gain, k_gain, rel_table):
    B_, S_, _ = q.shape
    H, Dh = MOBA_HEADS, MOBA_HEAD_DIM
    f32 = jnp.float32
    q = rms_norm(q.reshape(B_, S_, H, Dh), q_gain, QK_EPS).transpose(0, 2, 1, 3) * (Dh ** -0.5)
    k = rms_norm(k.reshape(B_, S_, H, Dh), k_gain, QK_EPS).transpose(0, 2, 1, 3)
    v = v.reshape(B_, S_, H, Dh).transpose(0, 2, 1, 3)
    S_pad = -(-S_ // MOBA_BLOCK) * MOBA_BLOCK
    pad = ((0, 0), (0, 0), (0, S_pad - S_), (0, 0))
    k_pad, v_pad = jnp.pad(k, pad), jnp.pad(v, pad)
    nb = S_pad // MOBA_BLOCK
    topk = min(MOBA_TOPK, nb)
    k_blocks = k_pad.reshape(B_, H, nb, MOBA_BLOCK, Dh)
    v_blocks = v_pad.reshape(B_, H, nb, MOBA_BLOCK, Dh)
    k_mean = jnp.mean(k_blocks.astype(f32), axis=3)
    table_t = rel_table.T.astype(f32)
    b_ix = jnp.arange(B_)[:, None, None, None]
    h_ix = jnp.arange(H)[None, :, None, None]
    h_ix5 = jnp.arange(H)[None, :, None, None, None]
    offs = jnp.arange(MOBA_BLOCK)

    def chunk_fn(c):
        q0 = c * Q_CHUNK
        qc = lax.dynamic_slice_in_dim(q, q0, Q_CHUNK, axis=2)
        blk = q0 // MOBA_BLOCK
        qpos = q0 + jnp.arange(Q_CHUNK)
        sc = jnp.einsum('bhqd,bhnd->bhqn', qc.astype(f32), k_mean)
        sc = jnp.where(jnp.arange(nb) < blk, sc, -jnp.inf)
        _, idx = lax.top_k(sc, topk)
        valid = jnp.arange(topk) < blk
        kg = k_blocks[b_ix, h_ix, idx]
        vg = v_blocks[b_ix, h_ix, idx]
        kpos = idx[..., None] * MOBA_BLOCK + offs
        rb = table_t[h_ix5, t5_bucket(kpos - qpos[:, None, None])]
        ls = jnp.einsum('bhqd,bhqstd->bhqst', qc, kg).astype(f32) + rb
        ls = jnp.where(valid[:, None], ls, -jnp.inf).reshape(B_, H, Q_CHUNK, topk * MOBA_BLOCK)
        k_own = lax.dynamic_slice_in_dim(k_pad, blk * MOBA_BLOCK, MOBA_BLOCK, axis=2)
        v_own = lax.dynamic_slice_in_dim(v_pad, blk * MOBA_BLOCK, MOBA_BLOCK, axis=2)
        rel = (blk * MOBA_BLOCK + offs)[None, :] - qpos[:, None]
        lo = jnp.einsum('bhqd,bhtd->bhqt', qc, k_own).astype(f32) + table_t[:, t5_bucket(rel)]
        lo = jnp.where(rel <= 0, lo, -jnp.inf)
        p = jax.nn.softmax(jnp.concatenate([ls, lo], axis=-1), axis=-1)
        ps = p[..., :topk * MOBA_BLOCK].reshape(B_, H, Q_CHUNK, topk, MOBA_BLOCK).astype(v.dtype)
        po = p[..., topk * MOBA_BLOCK:].astype(v.dtype)
        return (jnp.einsum('bhqst,bhqstd->bhqd', ps, vg)
                + jnp.einsum('bhqt,bhtd->bhqd', po, v_own))

    outs = lax.map(chunk_fn, jnp.arange(S_ // Q_CHUNK))
    return outs.transpose(1, 0, 3, 2, 4).reshape(B_, S_, H * Dh)


def hier_moe(xn, w_grp, b_grp, w_exp, b_exp, w_gate, w_up, w_down):
    B_, S_, D = xn.shape
    t = xn.reshape(-1, D)
    T = t.shape[0]
    f32 = jnp.float32
    lg = (t @ w_grp + b_grp).astype(f32)
    pg = jax.nn.softmax(lg, axis=-1)
    g_sel = jnp.argmax(lg, axis=-1)
    p_top = jnp.take_along_axis(pg, g_sel[:, None], axis=-1)
    le = (t @ w_exp + b_exp).astype(f32).reshape(T, N_GROUPS, EXPERTS_PER_GROUP)
    le_sel = jnp.take_along_axis(le, g_sel[:, None, None], axis=1)[:, 0]
    pe = jax.nn.softmax(le_sel, axis=-1)
    v2, i2 = lax.top_k(pe, FINE_TOPK)
    gates = p_top * (v2 / jnp.sum(v2, axis=-1, keepdims=True))
    eid = g_sel[:, None] * EXPERTS_PER_GROUP + i2
    comb = jnp.sum(jax.nn.one_hot(eid, N_EXPERTS, dtype=f32) * gates[..., None], axis=1)
    chunk = math.gcd(T, MOE_CHUNK)

    def chunk_fn(args):
        tc, cc = args
        h = jax.nn.silu(jnp.einsum('td,edh->teh', tc, w_gate)) * jnp.einsum('td,edh->teh', tc, w_up)
        h = h * cc[..., None].astype(h.dtype)
        return jnp.einsum('teh,ehd->td', h, w_down)

    y = lax.map(chunk_fn, (t.reshape(-1, chunk, D), comb.reshape(-1, chunk, N_EXPERTS)))
    return y.reshape(B_, S_, D)


def setup_inputs(seed: int = 0) -> dict:
    key = jax.random.key(seed)
    ks = iter(jax.random.split(key, 48))
    f32 = jnp.float32

    def nrm(shape, scale):
        return scale * jax.random.normal(next(ks), shape, f32)

    def uni(shape, lo, hi):
        return jax.random.uniform(next(ks), shape, f32, lo, hi)

    L, D, CR, CM = DEPTH, D_MODEL, RWKV_WIDTH, MOBA_WIDTH
    LV = DEPTH - 1
    return {
        'x': nrm((BATCH, SEQ, D), 1.0),
        'norm_mix_g': 1.0 + nrm((L, D), 0.02),
        'norm_ffn_g': 1.0 + nrm((L, D), 0.02),
        'w_in': nrm((L, D, IN_WIDTH), D ** -0.5),
        'mu_rkv': uni((L, 3, CR), 0.0, 1.0),
        'mu_x': uni((L, 3, D), 0.0, 1.0),
        'w0': uni((L, CR), -6.5, -1.5),
        'w1': nrm((L, D, DECAY_LORA), D ** -0.5),
        'w2': nrm((L, DECAY_LORA, CR), 0.1 * DECAY_LORA ** -0.5),
        'a0': nrm((L, CR), 0.1),
        'a1': nrm((L, D, AAA_LORA), D ** -0.5),
        'a2': nrm((L, AAA_LORA, CR), 0.5 * AAA_LORA ** -0.5),
        'g1': nrm((L, D, GATE_LORA), D ** -0.5),
        'g2': nrm((L, GATE_LORA, CR), GATE_LORA ** -0.5),
        'k_k': 0.85 + nrm((L, CR), 0.05),
        'k_a': 1.0 + nrm((L, CR), 0.05),
        'r_k': nrm((L, RWKV_HEADS, RWKV_HEAD_DIM), 0.1),
        'lnx_g': 1.0 + nrm((L, CR), 0.02),
        'lnx_b': nrm((L, CR), 0.02),
        'vres_mu': uni((LV, D), 0.0, 1.0),
        'vres_v0': nrm((LV, CR), 0.1),
        'vres_v1': nrm((LV, D, MV_LORA), D ** -0.5),
        'vres_v2': nrm((LV, MV_LORA, CR), 0.5 * MV_LORA ** -0.5),
        'q_gain': 1.0 + nrm((L, MOBA_HEAD_DIM), 0.02),
        'k_gain': 1.0 + nrm((L, MOBA_HEAD_DIM), 0.02),
        'rel_bias': nrm((REL_BUCKETS, MOBA_HEADS), 0.5),
        'w_br_rwkv': nrm((L, CR, D), CR ** -0.5),
        'w_br_moba': nrm((L, CM, D), CM ** -0.5),
        'w_out': nrm((L, D, D), D ** -0.5),
        'w_grp': nrm((L, D, N_GROUPS), D ** -0.5),
        'b_grp': nrm((L, N_GROUPS), 0.01),
        'w_exp': nrm((L, D, N_EXPERTS), D ** -0.5),
        'b_exp': nrm((L, N_EXPERTS), 0.01),
        'w_gate': nrm((L, N_EXPERTS, D, D_EXPERT), D ** -0.5),
        'w_up': nrm((L, N_EXPERTS, D, D_EXPERT), D ** -0.5),
        'w_down': nrm((L, N_EXPERTS, D_EXPERT, D), D_EXPERT ** -0.5),
    }


def reference(x, norm_mix_g, norm_ffn_g, w_in, mu_rkv, mu_x, w0, w1, w2, a0, a1, a2, g1, g2,
              k_k, k_a, r_k, lnx_g, lnx_b, vres_mu, vres_v0, vres_v1, vres_v2,
              q_gain, k_gain, rel_bias, w_br_rwkv, w_br_moba, w_out,
              w_grp, b_grp, w_exp, b_exp, w_gate, w_up, w_down):
    v_first = None
    for l in range(DEPTH):
        xn = rms_norm(x, norm_mix_g[l])
        proj = xn @ w_in[l]
        r_p, k_p, v_p, q_m, k_m, v_m, gate_r, gate_m = jnp.split(proj, SPLITS, axis=-1)
        vres = None if l == 0 else (vres_mu[l - 1], vres_v0[l - 1], vres_v1[l - 1], vres_v2[l - 1])
        y_r, v_first = rwkv7_branch(xn, r_p, k_p, v_p, mu_rkv[l], mu_x[l], w0[l], w1[l], w2[l],
                                    a0[l], a1[l], a2[l], g1[l], g2[l], k_k[l], k_a[l], r_k[l],
                                    lnx_g[l], lnx_b[l], v_first, vres)
        y_m = moba_branch(q_m, k_m, v_m, q_gain[l], k_gain[l], rel_bias)
        h = (jax.nn.sigmoid(gate_r) * (y_r @ w_br_rwkv[l])
             + jax.nn.sigmoid(gate_m) * (y_m @ w_br_moba[l]))
        x = x + h @ w_out[l]
        xn = rms_norm(x, norm_ffn_g[l])
        x = x + hier_moe(xn, w_grp[l], b_grp[l], w_exp[l], b_exp[l], w_gate[l], w_up[l], w_down[l])
    return x
```

```cpp
#include <hip/hip_runtime.h>
#include <cstdio>
#include <cstdint>
#define LAS __attribute__((address_space(3)))
#define GAS __attribute__((address_space(1)))
#define DI __device__ __forceinline__
typedef unsigned short bf16_t;
typedef short bf16x8 __attribute__((ext_vector_type(8)));
typedef short s16x4 __attribute__((ext_vector_type(4)));
typedef float f32x4 __attribute__((ext_vector_type(4)));
typedef float f32x2 __attribute__((ext_vector_type(2)));
typedef float f32x16 __attribute__((ext_vector_type(16)));
typedef unsigned u32x4 __attribute__((ext_vector_type(4)));
typedef unsigned u32x2 __attribute__((ext_vector_type(2)));
typedef __bf16 bf16v2 __attribute__((ext_vector_type(2)));

DI unsigned pk2(float lo, float hi) { f32x2 v = {lo, hi}; return __builtin_bit_cast(unsigned, __builtin_convertvector(v, bf16v2)); }
DI bf16_t f2bf(float f) { return (bf16_t)(pk2(f, 0.f) & 0xffffu); }
DI float bf2f(bf16_t b) { return __uint_as_float(((unsigned)b) << 16); }
DI float bflo(unsigned w) { return __uint_as_float(w << 16); }
DI float bfhi(unsigned w) { return __uint_as_float(w & 0xffff0000u); }
DI float sigmoidf_(float x) { return 1.0f / (1.0f + __expf(-x)); }

template <int CTRL> DI float dpp_mov(float v) { return __builtin_bit_cast(float, __builtin_amdgcn_update_dpp(0, __builtin_bit_cast(int, v), CTRL, 0xf, 0xf, true)); }
DI float rdlane(float v, int l) { return __builtin_bit_cast(float, __builtin_amdgcn_readlane(__builtin_bit_cast(int, v), l)); }
DI float wave_sum(float v) {
    v += dpp_mov<0xB1>(v);
    v += dpp_mov<0x4E>(v);
    v += dpp_mov<0x141>(v);
    v += dpp_mov<0x140>(v);
    return (rdlane(v, 0) + rdlane(v, 16)) + (rdlane(v, 32) + rdlane(v, 48));
}
namespace pg8 {
constexpr int BM = 256, BK = 64, HALF = 128, HTB = HALF * BK * 2  , STAGE_BYTES = 8 * HTB, NXCD = 8, WGM = 8;

__host__ __device__ __forceinline__ int lds_byte(int r, int c) { const int st = (r >> 4) * 2 + (c >> 5), rr = r & 15, cc = c & 31, ob = rr * 64 + cc * 2; return st * 1024 + (ob ^ (((ob >> 9) & 1) << 5)); }
__host__ __device__ __forceinline__ void stage_rc(int b, int& R, int& C) { const int st = b / 1024, sb = b % 1024, swz = sb ^ (((sb >> 9) & 1) << 5); R = (st >> 1) * 16 + swz / 64; C = (st & 1) * 32 + (swz % 64) / 2; }
__host__ __device__ __forceinline__ int perm32(int rho) { const int n = rho >> 4, i = rho & 15; return 8 * (i >> 2) + 4 * n + (i & 3); }

struct Unit { int pm, pn, pb; };
struct Gemm { const bf16_t* A; const bf16_t* Bt; int M, N, K; };

struct StaticOrder {
    int nM, nN, nwg, G, c;
    __device__ __forceinline__ void init(int M, int N, int G_, int c_) { nM = M / BM; nN = N / BM; nwg = nM * nN; G = G_; c = c_; }
    __device__ __forceinline__ bool next(int i, Unit& u) const {
        const long L = (long)i * G + c; if (L >= nwg) return false;
        int wgid = (int)L; { const int q = nwg / NXCD, r = nwg % NXCD, xcd = wgid % NXCD, off = wgid / NXCD; wgid = (xcd < r ? xcd * (q + 1) : r * (q + 1) + (xcd - r) * q) + off; }
        const int nig = WGM * nN, gid = wgid / nig, fm = gid * WGM, gsz = (nM - fm) < WGM ? (nM - fm) : WGM;
        u.pm = fm + ((wgid % nig) % gsz); u.pn = (wgid % nig) / gsz; u.pb = u.pn; return true;
    }
};
struct GroupOrder : StaticOrder {
    const int* pexp;
    __device__ __forceinline__ bool next(int i, Unit& u) const {
        if (!StaticOrder::next(i, u)) return false;
        u.pb = __builtin_amdgcn_readfirstlane(pexp[u.pm]) * nN + u.pn; return true;
    }
};

template <class Epi, class Sched, bool ALIGN_EPI = true, bool SP2 = true>
__device__ __forceinline__ void gemm_phase(LAS unsigned char* lds, const Gemm g, const Sched& S, const Epi& E, int tid_in) {
    const int tid = tid_in, wid = __builtin_amdgcn_readfirstlane(tid >> 6), lane = tid & 63, wr = wid >> 2, wc = wid & 3, fr = lane & 15, fq = lane >> 4;
    const int K = g.K, nt = K / BK;
    unsigned voffA[2], voffB[2];
#pragma unroll
    for (int i = 0; i < 2; ++i) { int R, C; stage_rc(tid * 16 + i * 8192, R, C); const int Rb = Epi::PERM ? ((R & ~31) + perm32(R & 31)) : R;
        voffA[i] = (unsigned)(R * K + C) * 2u; voffB[i] = (unsigned)(Rb * K + C) * 2u; }
    const size_t kstep = (size_t)(BK * 2);
    const size_t hstep = (size_t)HALF * K * 2;
    const size_t tstep = 2 * hstep;
    const unsigned ldsw = (unsigned)wid * 1024u;
    const int aoff = lds_byte(wr * 64 + fr, fq * 8), boff = lds_byte(wc * 32 + fr, fq * 8);
#define PG8_SA(b, h) (((b) * 2 + (h)) * HTB)
#define PG8_SB(b, h) ((4 + (b) * 2 + (h)) * HTB)
#define PG8_STAGE(bufoff, gbase, voff) do { _Pragma("unroll") for (int _i = 0; _i < 2; ++_i) \
        __builtin_amdgcn_global_load_lds((const unsigned*)((const char*)(gbase) + (voff)[_i]), (LAS unsigned*)(lds + (bufoff) + ldsw + _i * 8192), 16, 0, 0); } while (0)
#define PG8_LDA(dst, b, h) do { _Pragma("unroll") for (int m = 0; m < 4; ++m) _Pragma("unroll") for (int k = 0; k < 2; ++k) dst[m][k] = *(const LAS bf16x8*)(lds + PG8_SA(b, h) + aoff + m * 2048 + k * 1024); } while (0)
#define PG8_LDB(dst, b, h) do { _Pragma("unroll") for (int n = 0; n < 2; ++n) _Pragma("unroll") for (int k = 0; k < 2; ++k) dst[n][k] = *(const LAS bf16x8*)(lds + PG8_SB(b, h) + boff + n * 2048 + k * 1024); } while (0)
#define PG8_MMA(ai, bj, At, Bt) do { __builtin_amdgcn_s_setprio(1); _Pragma("unroll") for (int m = 0; m < 4; ++m) _Pragma("unroll") for (int n = 0; n < 2; ++n) _Pragma("unroll") for (int k = 0; k < 2; ++k) \
        acc[ai][bj][m][n] = __builtin_amdgcn_mfma_f32_16x16x32_bf16(Bt[n][k], At[m][k], acc[ai][bj][m][n], 0, 0, 0); __builtin_amdgcn_s_setprio(0); } while (0)
#define PG8_WAIT_V(n) asm volatile("s_waitcnt vmcnt(" #n ")" ::: "memory")
#define PG8_WAIT_L(n) asm volatile("s_waitcnt lgkmcnt(" #n ")" ::: "memory")
#define PG8_BAR __builtin_amdgcn_s_barrier()
#define PG8_SCHED __builtin_amdgcn_sched_barrier(0)
    Unit cur, nxt; int ui = 0;
    if (!S.next(0, cur)) return;
    f32x4 acc[2][2][4][2];
#pragma unroll
    for (int a = 0; a < 2; ++a)
#pragma unroll
        for (int b = 0; b < 2; ++b)
#pragma unroll
            for (int m = 0; m < 4; ++m)
#pragma unroll
                for (int n = 0; n < 2; ++n) acc[a][b][m][n] = (f32x4){0.f, 0.f, 0.f, 0.f};
    bf16x8 At[4][2], B0[2][2], B1[2][2];
    const char* cA = (const char*)g.A + (size_t)cur.pm * tstep; const char* cB = (const char*)g.Bt + (size_t)cur.pb * tstep;
    if constexpr (SP2) {
        PG8_STAGE(PG8_SB(0, 0), cB, voffB); PG8_STAGE(PG8_SB(0, 1), cB + hstep, voffB); PG8_STAGE(PG8_SA(0, 0), cA, voffA); PG8_STAGE(PG8_SA(0, 1), cA + hstep, voffA);
        if (wr == 1) PG8_BAR;
        PG8_WAIT_V(2); PG8_BAR;
        PG8_STAGE(PG8_SB(1, 0), cB + kstep, voffB); PG8_STAGE(PG8_SA(1, 0), cA + kstep, voffA); PG8_STAGE(PG8_SB(1, 1), cB + hstep + kstep, voffB);
        PG8_WAIT_V(6); PG8_BAR;
    } else {
        PG8_STAGE(PG8_SB(0, 0), cB, voffB); PG8_STAGE(PG8_SA(0, 0), cA, voffA); PG8_STAGE(PG8_SB(0, 1), cB + hstep, voffB); PG8_STAGE(PG8_SA(0, 1), cA + hstep, voffA);
        if (wr == 1) PG8_BAR;
        PG8_WAIT_V(4); PG8_BAR;
        PG8_STAGE(PG8_SB(1, 0), cB + kstep, voffB); PG8_STAGE(PG8_SA(1, 0), cA + kstep, voffA); PG8_STAGE(PG8_SB(1, 1), cB + hstep + kstep, voffB);
        PG8_WAIT_V(6); PG8_BAR;
    }
    for (;;) {
        const bool has_next = S.next(ui + 1, nxt);
        const char* nA = has_next ? (const char*)g.A + (size_t)nxt.pm * tstep : cA; const char* nB = has_next ? (const char*)g.Bt + (size_t)nxt.pb * tstep : cB;
        for (int t = 0; t < nt; t += 2) {
            const bool last = (t == nt - 2);
            const char* a1 = cA + (size_t)(t + 1) * kstep;
            const char* a2 = last ? nA : cA + (size_t)(t + 2) * kstep; const char* b2 = last ? nB : cB + (size_t)(t + 2) * kstep;
            const char* a3 = a2 + kstep; const char* b3 = b2 + kstep;
            if constexpr (SP2) {
            PG8_LDB(B0, 0, 0); PG8_LDB(B1, 0, 1); PG8_SCHED; PG8_LDA(At, 0, 0); PG8_STAGE(PG8_SA(1, 1), a1 + hstep, voffA);
            PG8_WAIT_V(8); PG8_WAIT_L(0); PG8_BAR; PG8_MMA(0, 0, At, B0); PG8_MMA(0, 1, At, B1); PG8_BAR; PG8_SCHED;
            PG8_LDA(At, 0, 1); PG8_STAGE(PG8_SB(0, 0), b2, voffB); PG8_STAGE(PG8_SB(0, 1), b2 + hstep, voffB); PG8_STAGE(PG8_SA(0, 0), a2, voffA);
            PG8_WAIT_V(8); PG8_WAIT_L(0); PG8_BAR; PG8_MMA(1, 0, At, B0); PG8_MMA(1, 1, At, B1); PG8_BAR; PG8_SCHED;
            PG8_LDB(B0, 1, 0); PG8_LDB(B1, 1, 1); PG8_SCHED; PG8_LDA(At, 1, 0); PG8_STAGE(PG8_SA(0, 1), a2 + hstep, voffA);
            PG8_WAIT_V(8); PG8_WAIT_L(0); PG8_BAR; PG8_MMA(0, 0, At, B0); PG8_MMA(0, 1, At, B1); PG8_BAR; PG8_SCHED;
            PG8_LDA(At, 1, 1); PG8_STAGE(PG8_SB(1, 0), b3, voffB); PG8_STAGE(PG8_SB(1, 1), b3 + hstep, voffB); PG8_STAGE(PG8_SA(1, 0), a3, voffA);
            PG8_WAIT_V(8); PG8_WAIT_L(0); PG8_BAR; PG8_MMA(1, 0, At, B0); PG8_MMA(1, 1, At, B1); PG8_BAR; PG8_SCHED;
            } else {
            PG8_LDB(B0, 0, 0); PG8_SCHED; PG8_LDA(At, 0, 0); PG8_STAGE(PG8_SA(1, 1), a1 + hstep, voffA);
            PG8_WAIT_L(8); PG8_BAR; PG8_WAIT_L(0); PG8_MMA(0, 0, At, B0); PG8_BAR; PG8_SCHED;
            PG8_LDB(B1, 0, 1); PG8_STAGE(PG8_SB(0, 0), b2, voffB);
            PG8_BAR; PG8_WAIT_L(0); PG8_MMA(0, 1, At, B1); PG8_BAR;
            PG8_LDA(At, 0, 1); PG8_STAGE(PG8_SA(0, 0), a2, voffA);
            PG8_BAR; PG8_WAIT_L(0); PG8_MMA(1, 0, At, B0); PG8_BAR; PG8_SCHED;
            PG8_STAGE(PG8_SB(0, 1), b2 + hstep, voffB);
            PG8_WAIT_V(6); PG8_BAR; PG8_MMA(1, 1, At, B1); PG8_BAR;
            PG8_LDB(B0, 1, 0); PG8_SCHED; PG8_LDA(At, 1, 0); PG8_STAGE(PG8_SA(0, 1), a2 + hstep, voffA);
            PG8_WAIT_L(8); PG8_BAR; PG8_WAIT_L(0); PG8_MMA(0, 0, At, B0); PG8_BAR; PG8_SCHED;
            PG8_LDB(B1, 1, 1); PG8_STAGE(PG8_SB(1, 0), b3, voffB);
            PG8_BAR; PG8_WAIT_L(0); PG8_MMA(0, 1, At, B1); PG8_BAR;
            PG8_LDA(At, 1, 1); PG8_STAGE(PG8_SA(1, 0), a3, voffA);
            PG8_BAR; PG8_WAIT_L(0); PG8_MMA(1, 0, At, B0); PG8_BAR; PG8_SCHED;
            PG8_STAGE(PG8_SB(1, 1), b3 + hstep, voffB);
            PG8_WAIT_V(6); PG8_BAR; PG8_MMA(1, 1, At, B1); PG8_BAR;
            }
        }
        if constexpr (ALIGN_EPI) { if (wr == 0) PG8_BAR; }
        E(acc, cur, wr, wc, fr, fq);
        if (!has_next) break;
#pragma unroll
        for (int a = 0; a < 2; ++a)
#pragma unroll
            for (int b = 0; b < 2; ++b)
#pragma unroll
                for (int m = 0; m < 4; ++m)
#pragma unroll
                    for (int n = 0; n < 2; ++n) acc[a][b][m][n] = (f32x4){0.f, 0.f, 0.f, 0.f};
        cur = nxt; cA = nA; cB = nB; ++ui;
        if constexpr (ALIGN_EPI) { if (wr == 1) PG8_BAR; }
    }
    PG8_WAIT_V(0);
    if constexpr (!ALIGN_EPI) { if (wr == 0) PG8_BAR; }
    PG8_BAR;
#undef PG8_SA
#undef PG8_SB
#undef PG8_STAGE
#undef PG8_LDA
#undef PG8_LDB
#undef PG8_MMA
#undef PG8_WAIT_V
#undef PG8_WAIT_L
#undef PG8_BAR
#undef PG8_SCHED
}
}
#define XB_TMO      128
#define XB_XCNT(j)  (256  + 64 * (j))
#define XB_XSUB(j)  (1280 + 64 * (j))
#define XB_XGEN(j)  (2304 + 64 * (j))
#define XB_TOP      3328
#define XB_TOPGEN   3392
#define XCD_BAR_WORDS 3456
#define XB_SPIN_CAP (1u << 18)

__device__ __forceinline__ unsigned xb_ld(unsigned* p)              { return __hip_atomic_load(p, __ATOMIC_RELAXED, __HIP_MEMORY_SCOPE_AGENT); }
__device__ __forceinline__ unsigned xb_add(unsigned* p, unsigned v) { return __hip_atomic_fetch_add(p, v, __ATOMIC_RELAXED, __HIP_MEMORY_SCOPE_AGENT); }
__device__ __forceinline__ unsigned xb_xcc_id() { return (unsigned)__builtin_amdgcn_s_getreg((3 << 11) | 20) & 0xFu; }
#define XB_SPIN(cond, bar) do { unsigned _sp = 0; while (cond) { __builtin_amdgcn_s_sleep(1); \
    if ((++_sp & 255u) == 0u) { if (xb_ld(&(bar)[XB_TMO])) break; if (_sp > XB_SPIN_CAP) { atomicAdd(&(bar)[XB_TMO], 1u); break; } } } } while (0)

struct XcdBarrier {
    unsigned* bar; unsigned x;
    volatile LAS unsigned* st;
};

__device__ __forceinline__ XcdBarrier xcd_barrier_post(unsigned* bar, volatile LAS unsigned* st) {
    XcdBarrier b; b.bar = bar; b.x = xb_xcc_id(); b.st = st;
    if (threadIdx.x == 0) (void)xb_add(&bar[XB_XCNT(b.x)], 1u);
    return b;
}
__device__ __forceinline__ void xcd_barrier_complete(unsigned* bar, unsigned x, unsigned& nloc, unsigned& nx) {
    const unsigned G = gridDim.x * gridDim.y * gridDim.z;
    unsigned sum, cnt, mine, sp = 0u;
    for (;;) {
        sum = 0u; cnt = 0u; mine = 0u;
#pragma unroll
        for (unsigned j = 0; j < 16; ++j) { const unsigned c = xb_ld(&bar[XB_XCNT(j)]); sum += c; cnt += (c > 0u) ? 1u : 0u; mine = (j == x) ? c : mine; }
        if (sum == G) break;
        __builtin_amdgcn_s_sleep(1);
        if ((++sp & 255u) == 0u) { if (xb_ld(&bar[XB_TMO])) break; if (sp > XB_SPIN_CAP) { atomicAdd(&bar[XB_TMO], 1u); break; } }
    }
    nloc = mine > 0u ? mine : 1u; nx = cnt > 0u ? cnt : 1u;
}

__device__ __forceinline__ void xcd_barrier(const XcdBarrier& b) {
    asm volatile("s_waitcnt vmcnt(0)" ::: "memory");
    __syncthreads();
    if (threadIdx.x == 0) {
        unsigned* bar = b.bar;
        __builtin_amdgcn_s_waitcnt(0);
        unsigned nloc = b.st[0], nx = b.st[1];
        if (nloc == 0u) { xcd_barrier_complete(bar, b.x, nloc, nx); b.st[0] = nloc; b.st[1] = nx; }
        const unsigned old = xb_add(&bar[XB_XSUB(b.x)], 1u);
        const unsigned gen = old / nloc;
        if (old + 1u == (gen + 1u) * nloc) {
            __builtin_amdgcn_fence(__ATOMIC_RELEASE, "agent");
            asm volatile("s_waitcnt vmcnt(0)" ::: "memory");
            const unsigned og = xb_add(&bar[XB_TOP], 1u);
            const unsigned tg = og / nx;
            if (og + 1u == (tg + 1u) * nx) xb_add(&bar[XB_TOPGEN], 1u);
            else XB_SPIN(xb_ld(&bar[XB_TOPGEN]) == tg, bar);
            __builtin_amdgcn_fence(__ATOMIC_ACQUIRE, "agent");
            xb_add(&bar[XB_XGEN(b.x)], 1u);
            asm volatile("s_waitcnt vmcnt(0)" ::: "memory");
        } else {
            XB_SPIN(xb_ld(&bar[XB_XGEN(b.x)]) == gen, bar);
            __builtin_amdgcn_fence(__ATOMIC_ACQUIRE, "agent");
            asm volatile("s_waitcnt vmcnt(0)" ::: "memory");
        }
    }
    __syncthreads();
}
constexpr int NB = 4, SEQ = 8192, DM = 1024, T = NB * SEQ;
constexpr int NH = 8, HD = 64, CW = 512;
constexpr int N_IN = 5120;
constexpr int NLAYER = 2;
constexpr int NEXP = 32, DEXP = 512;
constexpr int MOE_ROWS = 73728, MOE_PANELS = MOE_ROWS / 256;
constexpr int WCAT_ROWS = 5888;
constexpr int LO_W = 768;

constexpr size_t MiB = 1u << 20;
constexpr size_t WS_CTL = 0, CTL_ZERO_BYTES = 1 * MiB;
constexpr size_t WS_VF   = 1 * MiB;
constexpr size_t WS_TAB  = 33 * MiB;
constexpr size_t WS_WM   = 34 * MiB;
constexpr size_t WS_XN   = 50 * MiB;
constexpr size_t WS_RW   = 114 * MiB;
constexpr size_t WS_MO   = 114 * MiB;
constexpr size_t WS_LO   = 210 * MiB;
constexpr size_t WS_YR   = 210 * MiB;
constexpr size_t WS_SI   = 258 * MiB;
constexpr size_t WS_V1   = 418 * MiB;
constexpr size_t WS_G    = 450 * MiB;
constexpr size_t WS_YS   = 482 * MiB;
constexpr size_t WS_PO   = 258 * MiB;
constexpr size_t WS_PST  = 386 * MiB;
constexpr size_t WS_YM   = 394 * MiB;
constexpr size_t WS_GA   = 426 * MiB;
constexpr size_t WS_H    = 258 * MiB;
constexpr size_t WS_WE   = 34 * MiB;
constexpr size_t WS_WD   = 98 * MiB;
constexpr size_t WS_AM   = 130 * MiB;
constexpr size_t WS_HM   = 274 * MiB;
constexpr size_t WS_YE   = 346 * MiB;
constexpr size_t WS_RT   = 490 * MiB;
constexpr size_t WS_END  = 556 * MiB;
constexpr size_t TB_KMEAN = 0;
constexpr size_t TB_SEL   = 256 * 1024;
constexpr size_t RT_EID  = 0;
constexpr size_t RT_GATE = 256 * 1024;
constexpr size_t RT_ROW  = 512 * 1024;
constexpr size_t RT_GW   = 768 * 1024;
constexpr size_t RT_HIST = 1280 * 1024;
constexpr size_t RT_PEXP = 1408 * 1024;
constexpr size_t WS_SEL  = 556 * MiB;
constexpr size_t WS_NEED = 558 * MiB;
constexpr int CW_BAR = 4096;

constexpr int RING_BYTES = 131072;
constexpr int MISC_OFF = RING_BYTES + 320;
constexpr int LDS_BYTES = 147456;
struct Frame {
    LAS unsigned char* lds;
    int tid, lane, wave;
    int G, bid;
    const __attribute__((address_space(4))) unsigned char* ka;
    GAS float* out_g; GAS unsigned char* ws_g;
    DI float* outp() const { return (float*)out_g; }
    DI unsigned char* wsp() const { return (unsigned char*)ws_g; }
    DI const float* inp(int i) const { return (const float*)(*(const GAS float* const __attribute__((address_space(4)))*)(ka + 8 * i)); }
};
#define LDS_WAIT() asm volatile("s_waitcnt lgkmcnt(0)" ::: "memory")

DI void tr_item(const float* src, int ld, int k0, bf16_t* dst, int Kd, const float* sc, int mode, LAS float* scr, int lane) {
#pragma unroll 8
    for (int i = 0; i < 32; ++i) { const int kk = 2 * i + (lane >> 5);
        float v = src ? src[(size_t)(k0 + kk) * ld + (lane & 31)] : 0.f;
        if (mode == 1) v *= sc[k0 + kk]; else if (mode == 2) v *= (1.f - sc[k0 + kk]);
        scr[kk * 33 + (lane & 31)] = v; }
    LDS_WAIT(); asm volatile("" ::: "memory");
    const int c = lane & 7;
#pragma unroll
    for (int j = 0; j < 4; ++j) { const int n = (lane >> 3) + 8 * j; const LAS float* s = scr + (8 * c) * 33 + n;
        u32x4 o; o.x = pk2(s[0 * 33], s[1 * 33]); o.y = pk2(s[2 * 33], s[3 * 33]); o.z = pk2(s[4 * 33], s[5 * 33]); o.w = pk2(s[6 * 33], s[7 * 33]);
        *(u32x4*)(dst + (size_t)n * Kd + k0 + 8 * c) = o; }
    LDS_WAIT(); asm volatile("" ::: "memory");
}

constexpr size_t WM_WCAT = 0, WM_BRR = (size_t)WCAT_ROWS * 1024 * 2, WM_BRM = WM_BRR + 1024 * 512 * 2, WM_OUT = WM_BRM + 1024 * 512 * 2;
DI void phase_conv_mixer(Frame& F, int l) {
    LAS float* scr = (LAS float*)(F.lds + F.wave * 16384);
    const int gw = F.bid * 8 + F.wave, NGW = F.G * 8;
    bf16_t* wcat = (bf16_t*)(F.wsp() + WS_WM + WM_WCAT);
    const float* w_in = F.inp(3) + (size_t)l * DM * N_IN;
    const float* mu_x = F.inp(5) + (size_t)l * 3 * DM;
    constexpr int NBLK = WCAT_ROWS / 32;
    constexpr int I_CAT = NBLK * 16, I_BR = 8 * 32, I_OUT = 16 * 32;
    for (int it = gw; it < I_CAT + 2 * I_BR + I_OUT; it += NGW) {
        int r = it;
        if (r < I_CAT) {
            const int nb = r / 16, kb = r % 16, k0 = kb * 64;
            if (nb < 48) { tr_item(w_in + 32 * nb, N_IN, k0, wcat + (size_t)(32 * nb) * 1024, 1024, nullptr, 0, scr, F.lane); }
            else if (nb < 72) {
                const int q = nb - 48; const float* src = nullptr; int ld = 0; const float* sc = nullptr; int mode = 0;
                if (q < 4)       { src = F.inp(7)  + (size_t)l * DM * 64  + 32 * (q & 1); ld = 64;  sc = mu_x;          mode = (q < 2) ? 2 : 1; }
                else if (q < 8)  { src = F.inp(10) + (size_t)l * DM * 64  + 32 * (q & 1); ld = 64;  sc = mu_x + DM;     mode = (q < 6) ? 2 : 1; }
                else if (q < 16) { src = F.inp(12) + (size_t)l * DM * 128 + 32 * (q & 3); ld = 128; sc = mu_x + 2 * DM; mode = (q < 12) ? 2 : 1; }
                else if (q < 18 && l > 0) { src = F.inp(21) + (size_t)(l - 1) * DM * 32; ld = 32; sc = F.inp(19) + (size_t)(l - 1) * DM; mode = (q == 16) ? 2 : 1; }
                tr_item(src, ld, k0, wcat + (size_t)(1536 + 32 * q) * 1024, 1024, sc, mode, scr, F.lane);
            }
            else if (nb < 120) { tr_item(w_in + 1536 + 32 * (nb - 72), N_IN, k0, wcat + (size_t)(2304 + 32 * (nb - 72)) * 1024, 1024, nullptr, 0, scr, F.lane); }
            else { tr_item(w_in + 3072 + 32 * (nb - 120), N_IN, k0, wcat + (size_t)(3840 + 32 * (nb - 120)) * 1024, 1024, nullptr, 0, scr, F.lane); }
            continue;
        }
        r -= I_CAT;
        if (r < I_BR) { const int nb = r / 8, kb = r % 8; tr_item(F.inp(26) + (size_t)l * 512 * 1024 + 32 * nb, 1024, kb * 64, (bf16_t*)(F.wsp() + WS_WM + WM_BRR) + (size_t)(32 * nb) * 512, 512, nullptr, 0, scr, F.lane); continue; }
        r -= I_BR;
        if (r < I_BR) { const int nb = r / 8, kb = r % 8; tr_item(F.inp(27) + (size_t)l * 512 * 1024 + 32 * nb, 1024, kb * 64, (bf16_t*)(F.wsp() + WS_WM + WM_BRM) + (size_t)(32 * nb) * 512, 512, nullptr, 0, scr, F.lane); continue; }
        r -= I_BR;
        { const int nb = r / 16, kb = r % 16; tr_item(F.inp(28) + (size_t)l * 1024 * 1024 + 32 * nb, 1024, kb * 64, (bf16_t*)(F.wsp() + WS_WM + WM_OUT) + (size_t)(32 * nb) * 1024, 1024, nullptr, 0, scr, F.lane); }
    }
}
DI void phase_conv_experts(Frame& F, int l) {
    LAS float* scr = (LAS float*)(F.lds + F.wave * 16384);
    const int gw = F.bid * 8 + F.wave, NGW = F.G * 8;
    bf16_t* we = (bf16_t*)(F.wsp() + WS_WE); bf16_t* wd = (bf16_t*)(F.wsp() + WS_WD);
    const float* wg = F.inp(33) + (size_t)l * NEXP * DM * DEXP; const float* wu = F.inp(34) + (size_t)l * NEXP * DM * DEXP; const float* wdn = F.inp(35) + (size_t)l * NEXP * DEXP * DM;
    for (int it = gw; it < NEXP * 768; it += NGW) {
        const int e = it / 768; int r = it % 768;
        if (r < 512) {
            const int up = r >> 8; r &= 255; const int nb = r / 16, kb = r % 16, h0 = 32 * nb;
            const float* src = (up ? wu : wg) + (size_t)e * DM * DEXP + h0;
            tr_item(src, DEXP, kb * 64, we + ((size_t)e * 1024 + (h0 >> 7) * 256 + up * 128 + (h0 & 127)) * 1024, 1024, nullptr, 0, scr, F.lane);
        } else {
            r -= 512; const int nb = r / 8, kb = r % 8;
            tr_item(wdn + (size_t)e * DEXP * DM + 32 * nb, DM, kb * 64, wd + ((size_t)e * 1024 + 32 * nb) * 512, 512, nullptr, 0, scr, F.lane);
        }
    }
}
DI void rms_row_to_bf16(const float* xrow, const float* gain, bf16_t* o0, bf16_t* o1, int lane) {
    const f32x4* xr = (const f32x4*)xrow + lane; const f32x4* gr = (const f32x4*)gain + lane;
    f32x4 v[4]; float s = 0.f;
#pragma unroll
    for (int j = 0; j < 4; ++j) { v[j] = xr[64 * j]; s += (v[j].x * v[j].x + v[j].y * v[j].y) + (v[j].z * v[j].z + v[j].w * v[j].w); }
    const float rs = 1.0f / sqrtf(wave_sum(s) * (1.f / DM) + 1e-6f);
#pragma unroll
    for (int j = 0; j < 4; ++j) { const f32x4 g = gr[64 * j]; const f32x4 y = v[j] * rs * g;
        u32x2 w; w.x = pk2(y.x, y.y); w.y = pk2(y.z, y.w);
        *((u32x2*)o0 + lane + 64 * j) = w; if (o1) *((u32x2*)o1 + lane + 64 * j) = w; }
}
DI void phase_norm_x(Frame& F, const float* x, const float* gain) {
    const int gw = F.bid * 8 + F.wave, NGW = F.G * 8; bf16_t* xn = (bf16_t*)(F.wsp() + WS_XN);
    for (int m = gw; m < T; m += NGW) rms_row_to_bf16(x + (size_t)m * DM, gain, xn + (size_t)m * DM, nullptr, F.lane);
}

namespace pg8 {
struct EpiStore {
    static constexpr bool PERM = true;
    bf16_t* O; int ldc; int split; bf16_t* O2; int ldc2; int act;
    __device__ __forceinline__ void operator()(const f32x4 (&acc)[2][2][4][2], const Unit& u, int wr, int wc, int fr, int fq) const {
        const int row0 = u.pm * BM + wr * 64 + fr; int colt = u.pn * BM; bf16_t* base = O; int ld = ldc;
        if (split && colt >= split) { base = O2; ld = ldc2; colt -= split; }
        const int col0 = colt + wc * 32 + 8 * fq;
#pragma unroll
        for (int ai = 0; ai < 2; ++ai)
#pragma unroll
            for (int m = 0; m < 4; ++m) { bf16_t* rowp = base + (size_t)(row0 + ai * HALF + m * 16) * ld + col0;
#pragma unroll
                for (int bj = 0; bj < 2; ++bj) { f32x4 v0 = acc[ai][bj][m][0], v1 = acc[ai][bj][m][1];
                    if (act == 1) {
#pragma unroll
                        for (int j = 0; j < 4; ++j) { v0[j] = sigmoidf_(v0[j]); v1[j] = sigmoidf_(v1[j]); } }
                    u32x4 w; w.x = pk2(v0[0], v0[1]); w.y = pk2(v0[2], v0[3]); w.z = pk2(v1[0], v1[1]); w.w = pk2(v1[2], v1[3]);
                    *(u32x4*)(rowp + bj * HALF) = w; } }
    }
};
struct EpiBranch {
    static constexpr bool PERM = true;
    bf16_t* Hout; const bf16_t* gate; int gcol0; int first;
    __device__ __forceinline__ void operator()(const f32x4 (&acc)[2][2][4][2], const Unit& u, int wr, int wc, int fr, int fq) const {
        const int row0 = u.pm * BM + wr * 64 + fr; const int col0 = u.pn * BM + wc * 32 + 8 * fq;
#pragma unroll
        for (int ai = 0; ai < 2; ++ai)
#pragma unroll
            for (int m = 0; m < 4; ++m) { const size_t row = (size_t)(row0 + ai * HALF + m * 16);
#pragma unroll
                for (int bj = 0; bj < 2; ++bj) {
                    const u32x4 gv = *(const u32x4*)(gate + row * 2048 + gcol0 + col0 + bj * HALF);
                    bf16_t* hp = Hout + row * 1024 + col0 + bj * HALF;
                    f32x4 v0 = acc[ai][bj][m][0], v1 = acc[ai][bj][m][1];
                    v0[0] *= bflo(gv.x); v0[1] *= bfhi(gv.x); v0[2] *= bflo(gv.y); v0[3] *= bfhi(gv.y);
                    v1[0] *= bflo(gv.z); v1[1] *= bfhi(gv.z); v1[2] *= bflo(gv.w); v1[3] *= bfhi(gv.w);
                    if (!first) { const u32x4 hv = *(const u32x4*)hp;
                        v0[0] += bflo(hv.x); v0[1] += bfhi(hv.x); v0[2] += bflo(hv.y); v0[3] += bfhi(hv.y);
                        v1[0] += bflo(hv.z); v1[1] += bfhi(hv.z); v1[2] += bflo(hv.w); v1[3] += bfhi(hv.w); }
                    u32x4 w; w.x = pk2(v0[0], v0[1]); w.y = pk2(v0[2], v0[3]); w.z = pk2(v1[0], v1[1]); w.w = pk2(v1[2], v1[3]);
                    *(u32x4*)hp = w; } }
    }
};
struct EpiResid {
    static constexpr bool PERM = false;
    const float* xin; float* out;
    __device__ __forceinline__ void operator()(const f32x4 (&acc)[2][2][4][2], const Unit& u, int wr, int wc, int fr, int fq) const {
        const int row0 = u.pm * BM + wr * 64 + fr, col0 = u.pn * BM + wc * 32 + 4 * fq;
#pragma unroll
        for (int ai = 0; ai < 2; ++ai)
#pragma unroll
            for (int m = 0; m < 4; ++m) { const size_t off = (size_t)(row0 + ai * HALF + m * 16) * 1024 + col0;
#pragma unroll
                for (int bj = 0; bj < 2; ++bj)
#pragma unroll
                    for (int n = 0; n < 2; ++n) { const f32x4 xv = *(const f32x4*)(xin + off + bj * HALF + n * 16); *(f32x4*)(out + off + bj * HALF + n * 16) = xv + acc[ai][bj][m][n]; } }
    }
};
struct EpiExpertUp {
    static constexpr bool PERM = true;
    bf16_t* HM; const float* gw;
    __device__ __forceinline__ void operator()(const f32x4 (&acc)[2][2][4][2], const Unit& u, int wr, int wc, int fr, int fq) const {
        const int row0 = u.pm * BM + wr * 64 + fr; const int col0 = u.pn * 128 + wc * 32 + 8 * fq;
#pragma unroll
        for (int ai = 0; ai < 2; ++ai)
#pragma unroll
            for (int m = 0; m < 4; ++m) { const size_t row = (size_t)(row0 + ai * HALF + m * 16); const float gwt = gw[row];
                f32x4 v0, v1;
#pragma unroll
                for (int j = 0; j < 4; ++j) { const float g0 = acc[ai][0][m][0][j], g1 = acc[ai][0][m][1][j];
                    v0[j] = g0 * sigmoidf_(g0) * acc[ai][1][m][0][j] * gwt; v1[j] = g1 * sigmoidf_(g1) * acc[ai][1][m][1][j] * gwt; }
                u32x4 w; w.x = pk2(v0[0], v0[1]); w.y = pk2(v0[2], v0[3]); w.z = pk2(v1[0], v1[1]); w.w = pk2(v1[2], v1[3]);
                *(u32x4*)(HM + row * 512 + col0) = w; }
    }
};
}
constexpr size_t SI_PLANE = (size_t)T * CW * 2;
DI float softplusf_(float z) { return fmaxf(z, 0.f) + log1pf(__expf(-fabsf(z))); }

DI void phase_rwkv_prep(Frame& F, int l) {
    LAS float* act = (LAS float*)F.lds;
    const bf16_t* RW = (const bf16_t*)(F.wsp() + WS_RW); const bf16_t* LO = (const bf16_t*)(F.wsp() + WS_LO);
    bf16_t* SIr = (bf16_t*)(F.wsp() + WS_SI); bf16_t* SIw = SIr + (size_t)T * CW; bf16_t* SIk = SIw + (size_t)T * CW; bf16_t* SIa = SIk + (size_t)T * CW; bf16_t* SIb = SIa + (size_t)T * CW;
    bf16_t* VF = (bf16_t*)(F.wsp() + WS_VF); bf16_t* V1 = (bf16_t*)(F.wsp() + WS_V1); bf16_t* Gb = (bf16_t*)(F.wsp() + WS_G);
    int c = F.tid;
    const float* w2 = F.inp(8) + (size_t)l * 64 * CW; const float* a2 = F.inp(11) + (size_t)l * 64 * CW; const float* g2 = F.inp(13) + (size_t)l * 128 * CW;
    const float* v2 = F.inp(22);
    const float mu_r = F.inp(4)[(size_t)l * 3 * CW + c], mu_k = F.inp(4)[(size_t)l * 3 * CW + CW + c], mu_v = F.inp(4)[(size_t)l * 3 * CW + 2 * CW + c];
    const float w0c = F.inp(6)[l * CW + c], a0c = F.inp(9)[l * CW + c], kkc = F.inp(14)[l * CW + c], kac = F.inp(15)[l * CW + c];
    const float v0c = l > 0 ? F.inp(20)[c] : 0.f;
    for (int tile = F.bid; tile < T / 8; tile += F.G) {
        int t0 = tile * 8; asm volatile("" : "+s"(t0), "+v"(c));
        __syncthreads();
        for (int idx = F.tid; idx < 8 * 288; idx += 512) {
            const int tt = idx / 288, j = idx - tt * 288; const int t = t0 + tt; const bool has_prev = (t % SEQ) != 0;
            int pj, qj;
            if (j < 64) { pj = j; qj = 64 + j; } else if (j < 128) { pj = 128 + (j - 64); qj = 192 + (j - 64); } else if (j < 256) { pj = 256 + (j - 128); qj = 384 + (j - 128); } else { pj = 512 + (j - 256); qj = 544 + (j - 256); }
            float v = bf2f(LO[(size_t)t * LO_W + pj]); if (has_prev) v += bf2f(LO[(size_t)(t - 1) * LO_W + qj]);
            if (j < 64) v = tanhf(v); else if (j >= 128 && j < 256) v = sigmoidf_(v);
            act[j * 8 + tt] = v;
        }
        __syncthreads();
        float aw[8], aa[8], ag[8], av[8];
#pragma unroll
        for (int i = 0; i < 8; ++i) { aw[i] = 0.f; aa[i] = 0.f; ag[i] = 0.f; av[i] = 0.f; }
        for (int j = 0; j < 64; ++j) { const float w = w2[j * CW + c]; const LAS f32x4* ap = (const LAS f32x4*)(act + j * 8);
#pragma unroll
            for (int q = 0; q < 2; ++q) { const f32x4 x = ap[q]; aw[4 * q] += x.x * w; aw[4 * q + 1] += x.y * w; aw[4 * q + 2] += x.z * w; aw[4 * q + 3] += x.w * w; } }
        for (int j = 0; j < 64; ++j) { const float w = a2[j * CW + c]; const LAS f32x4* ap = (const LAS f32x4*)(act + (64 + j) * 8);
#pragma unroll
            for (int q = 0; q < 2; ++q) { const f32x4 x = ap[q]; aa[4 * q] += x.x * w; aa[4 * q + 1] += x.y * w; aa[4 * q + 2] += x.z * w; aa[4 * q + 3] += x.w * w; } }
        for (int j = 0; j < 128; ++j) { const float w = g2[j * CW + c]; const LAS f32x4* ap = (const LAS f32x4*)(act + (128 + j) * 8);
#pragma unroll
            for (int q = 0; q < 2; ++q) { const f32x4 x = ap[q]; ag[4 * q] += x.x * w; ag[4 * q + 1] += x.y * w; ag[4 * q + 2] += x.z * w; ag[4 * q + 3] += x.w * w; } }
        if (l > 0) for (int j = 0; j < 32; ++j) { const float w = v2[j * CW + c]; const LAS f32x4* ap = (const LAS f32x4*)(act + (256 + j) * 8);
#pragma unroll
            for (int q = 0; q < 2; ++q) { const f32x4 x = ap[q]; av[4 * q] += x.x * w; av[4 * q + 1] += x.y * w; av[4 * q + 2] += x.z * w; av[4 * q + 3] += x.w * w; } }
#pragma unroll
        for (int tt = 0; tt < 8; ++tt) {
            const int t = t0 + tt; const bool has_prev = (t % SEQ) != 0; const size_t ro = (size_t)t * 1536;
            const float rp = bf2f(RW[ro + c]), kp = bf2f(RW[ro + 512 + c]), vp = bf2f(RW[ro + 1024 + c]);
            float rq = 0.f, kq = 0.f, vq = 0.f;
            if (has_prev) { rq = bf2f(RW[ro - 1536 + c]); kq = bf2f(RW[ro - 1536 + 512 + c]); vq = bf2f(RW[ro - 1536 + 1024 + c]); }
            const float r = rp + (rq - rp) * mu_r, k = kp + (kq - kp) * mu_k; float v = vp + (vq - vp) * mu_v;
            const float wl = -softplusf_(-(w0c + aw[tt])) - 0.5f;
            const float lw = -__expf(wl);
            const float alr = sigmoidf_(a0c + aa[tt]);
            const size_t o = (size_t)t * CW + c;
            if (l > 0) { const float vf = bf2f(VF[o]); v = v + (vf - v) * sigmoidf_(v0c + av[tt]); V1[o] = f2bf(v); } else { VF[o] = f2bf(v); }
            float kk = k * kkc; const float nrm = sqrtf(wave_sum(kk * kk)); kk = kk / fmaxf(nrm, 1e-12f);
            const float k2 = k * (1.f + (alr - 1.f) * kac);
            SIr[o] = f2bf(r); SIw[o] = f2bf(lw); SIk[o] = f2bf(k2); SIa[o] = f2bf(kk); SIb[o] = f2bf(kk * alr); Gb[o] = f2bf(ag[tt]);
            asm volatile("" ::: "memory");
        }
    }
}

DI void phase_rwkv_scan_naive(Frame& F, int l) {
    LAS float* Lr = (LAS float*)F.lds; LAS float* Lw = Lr + 4096; LAS float* Lk = Lw + 4096; LAS float* La = Lk + 4096; LAS float* Lb = La + 4096;
    LAS float* Lv = Lb + 4096; LAS float* Ly = Lv + 512;
    const bf16_t* SIr = (const bf16_t*)(F.wsp() + WS_SI); const bf16_t* SIw = SIr + (size_t)T * CW; const bf16_t* SIk = SIw + (size_t)T * CW; const bf16_t* SIa = SIk + (size_t)T * CW; const bf16_t* SIb = SIa + (size_t)T * CW;
    const bf16_t* V = (const bf16_t*)(F.wsp() + (l > 0 ? WS_V1 : WS_VF)); float* YS = (float*)(F.wsp() + WS_YS);
    for (int u = F.bid; u < 256; u += F.G) {
        const int b = u >> 6, h = (u >> 3) & 7, rg = u & 7;
        float S = 0.f;
        for (int ch = 0; ch < SEQ / 64; ++ch) {
            const size_t tb = (size_t)b * SEQ + ch * 64;
            __syncthreads();
            for (int idx = F.tid; idx < 4096; idx += 512) { const int s = idx >> 6, kx = idx & 63; const size_t o = (tb + s) * CW + h * 64 + kx;
                Lr[idx] = bf2f(SIr[o]); Lw[idx] = __expf(bf2f(SIw[o])); Lk[idx] = bf2f(SIk[o]); La[idx] = -bf2f(SIa[o]); Lb[idx] = bf2f(SIb[o]); }
            { const int s = F.tid >> 3, rr = F.tid & 7; Lv[F.tid] = bf2f(V[(tb + s) * CW + h * 64 + rg * 8 + rr]); }
            __syncthreads();
#pragma unroll 4
            for (int s = 0; s < 64; ++s) {
                const float a = La[s * 64 + F.lane], w = Lw[s * 64 + F.lane], bb = Lb[s * 64 + F.lane], kk = Lk[s * 64 + F.lane], r = Lr[s * 64 + F.lane], v = Lv[s * 8 + F.wave];
                const float sa = wave_sum(S * a);
                S = S * w + sa * bb + v * kk;
                const float y = wave_sum(S * r);
                if (F.lane == 0) Ly[s * 8 + F.wave] = y;
            }
            __syncthreads();
            { const int s = F.tid >> 3, rr = F.tid & 7; YS[(tb + s) * CW + h * 64 + rg * 8 + rr] = Ly[F.tid]; }
        }
    }
}

DI void phase_rwkv_post(Frame& F, int l) {
    const float* YS = (const float*)(F.wsp() + WS_YS);
    const bf16_t* SIr = (const bf16_t*)(F.wsp() + WS_SI); const bf16_t* SIk = SIr + 2 * (size_t)T * CW;
    const bf16_t* V = (const bf16_t*)(F.wsp() + (l > 0 ? WS_V1 : WS_VF)); const bf16_t* Gb = (const bf16_t*)(F.wsp() + WS_G); bf16_t* YR = (bf16_t*)(F.wsp() + WS_YR);
    const int c = F.tid; const float lg = F.inp(17)[l * CW + c], lb = F.inp(18)[l * CW + c], rk = F.inp(16)[l * CW + c];
    for (int t = F.bid; t < T; t += F.G) {
        const size_t o = (size_t)t * CW + c;
        const float y = YS[o]; const float mean = wave_sum(y) * (1.f / 64.f); const float d = y - mean; const float var = wave_sum(d * d) * (1.f / 64.f);
        const float yn = d * (1.0f / sqrtf(var + 64e-5f)) * lg + lb;
        const float r = bf2f(SIr[o]), k = bf2f(SIk[o]), v = bf2f(V[o]);
        const float bonus = wave_sum(r * k * rk) * v;
        YR[o] = f2bf((yn + bonus) * bf2f(Gb[o]));
    }
}
DI void phase_moba_prep(Frame& F, int l) {
    bf16_t* MO = (bf16_t*)(F.wsp() + WS_MO); float* KM = (float*)(F.wsp() + WS_TAB + TB_KMEAN);
    const int c = F.tid; const float qg = F.inp(23)[l * 64 + (c & 63)] * 0.125f, kg = F.inp(24)[l * 64 + (c & 63)];
    for (int span = F.bid; span < T / 256; span += F.G) {
        float ksum = 0.f;
        for (int tt = 0; tt < 256; ++tt) {
            const size_t ro = (size_t)(span * 256 + tt) * 1536;
            const float q = bf2f(MO[ro + c]), k = bf2f(MO[ro + 512 + c]);
            const float qs = wave_sum(q * q) * (1.f / 64.f), ks = wave_sum(k * k) * (1.f / 64.f);
            const float qn = q * (1.0f / sqrtf(qs + 1e-6f)) * qg, kn = k * (1.0f / sqrtf(ks + 1e-6f)) * kg;
            MO[ro + c] = f2bf(qn); MO[ro + 512 + c] = f2bf(kn); ksum += kn;
        }
        KM[(size_t)span * CW + c] = ksum * (1.f / 256.f);
    }
}
DI void phase_moba_gate(Frame& F) {
    LAS float* KL = (LAS float*)F.lds;
    const bf16_t* MO = (const bf16_t*)(F.wsp() + WS_MO); const float* KM = (const float*)(F.wsp() + WS_TAB + TB_KMEAN); unsigned* SEL = (unsigned*)(F.wsp() + WS_SEL);
    for (int span = F.bid; span < T / 64; span += F.G) {
        const int t0 = span * 64, b = t0 / SEQ, blk = (t0 % SEQ) / 256;
        __syncthreads();
        for (int idx = F.tid; idx < blk * 512; idx += 512) { const int j = idx >> 9, cc = idx & 511, h = cc >> 6, d = cc & 63;
            KL[h * 2052 + j * 64 + d] = KM[((size_t)(b * 32 + j)) * CW + cc]; }
        __syncthreads();
        const int tok = F.tid >> 3, h = F.tid & 7; const int t = t0 + tok;
        float q[64];
        { const u32x4* qp = (const u32x4*)(MO + (size_t)t * 1536 + h * 64);
#pragma unroll
          for (int i = 0; i < 8; ++i) { const u32x4 w = qp[i]; q[8 * i] = bflo(w.x); q[8 * i + 1] = bfhi(w.x); q[8 * i + 2] = bflo(w.y); q[8 * i + 3] = bfhi(w.y); q[8 * i + 4] = bflo(w.z); q[8 * i + 5] = bfhi(w.z); q[8 * i + 6] = bflo(w.w); q[8 * i + 7] = bfhi(w.w); } }
        float v0 = -INFINITY, v1 = -INFINITY, v2 = -INFINITY; int i0 = 0, i1 = 1, i2 = 2;
        for (int j = 0; j < blk; ++j) {
            const LAS f32x4* kp = (const LAS f32x4*)(KL + h * 2052 + j * 64); float s = 0.f;
#pragma unroll
            for (int i = 0; i < 16; ++i) { const f32x4 kv = kp[i]; s += q[4 * i] * kv.x + q[4 * i + 1] * kv.y + q[4 * i + 2] * kv.z + q[4 * i + 3] * kv.w; }
            if (s > v0) { v2 = v1; i2 = i1; v1 = v0; i1 = i0; v0 = s; i0 = j; }
            else if (s > v1) { v2 = v1; i2 = i1; v1 = s; i1 = j; }
            else if (s > v2) { v2 = s; i2 = j; }
        }
        const int nv = blk < 3 ? blk : 3;
        SEL[(size_t)t * 8 + h] = (unsigned)i0 | ((unsigned)i1 << 8) | ((unsigned)i2 << 16) | ((unsigned)nv << 24);
    }
}

constexpr int KS_PITCH = 144, VT_PITCH = 520;
DI void phase_moba_attn(Frame& F) {
    LAS unsigned char* Ks = F.lds;
    LAS unsigned char* Vt = F.lds + 36864;
    LAS float* LUT = (LAS float*)(F.lds + 36864 + 33280);
    LAS unsigned* LIST = (LAS unsigned*)(F.lds + 36864 + 33280 + 528);
    LAS unsigned* CNT = LIST + 1024;
    const bf16_t* MO = (const bf16_t*)(F.wsp() + WS_MO); const unsigned* SEL = (const unsigned*)(F.wsp() + WS_SEL);
    bf16_t* PO = (bf16_t*)(F.wsp() + WS_PO); f32x2* PST = (f32x2*)(F.wsp() + WS_PST);
    const float* relb = F.inp(25);
    constexpr int UNITS_PER_BH = 144;
    for (int u = F.bid; u < NB * NH * UNITS_PER_BH; u += F.G) {
        const int bh = u & 31, b = bh >> 3, h = bh & 7; int sid = u >> 5;
        int j = 0; { int rem = sid; for (j = 0; j < 32; ++j) { const int ng = (32 - j + 3) >> 2; if (rem < ng) { sid = rem; break; } rem -= ng; } }
        const int g = sid; const int qb0 = j + 4 * g, qb1 = (qb0 + 3 < 31) ? qb0 + 3 : 31; const int nq = (qb1 - qb0 + 1) * 256;
        const size_t tokb = (size_t)b * SEQ;
        __syncthreads();
        for (int id = F.tid; id < 2048; id += 512) { const int row = id >> 3, c8 = id & 7; const size_t ro = (tokb + j * 256 + row) * 1536 + h * 64 + c8 * 8;
            const u32x4 kv = *(const u32x4*)(MO + ro + 512); *(LAS u32x4*)(Ks + row * KS_PITCH + c8 * 16) = kv;
            const u32x4 vv = *(const u32x4*)(MO + ro + 1024); LAS bf16_t* vp = (LAS bf16_t*)(Vt + (c8 * 8) * VT_PITCH + row * 2);
            vp[0 * (VT_PITCH / 2)] = (bf16_t)(vv.x & 0xffff); vp[1 * (VT_PITCH / 2)] = (bf16_t)(vv.x >> 16); vp[2 * (VT_PITCH / 2)] = (bf16_t)(vv.y & 0xffff); vp[3 * (VT_PITCH / 2)] = (bf16_t)(vv.y >> 16);
            vp[4 * (VT_PITCH / 2)] = (bf16_t)(vv.z & 0xffff); vp[5 * (VT_PITCH / 2)] = (bf16_t)(vv.z >> 16); vp[6 * (VT_PITCH / 2)] = (bf16_t)(vv.w & 0xffff); vp[7 * (VT_PITCH / 2)] = (bf16_t)(vv.w >> 16); }
        if (F.tid <= 128) { const int n = F.tid; int bucket;
            if (n < 16) bucket = n; else { int lg = 16 + (int)(logf((float)n / 16.0f) / 2.0794415416798357f * 16.0f); bucket = lg < 31 ? lg : 31; }
            LUT[n] = relb[bucket * 8 + h]; }
        unsigned ent[2]; bool mem[2];
#pragma unroll
        for (int r = 0; r < 2; ++r) { const int qi = r * 512 + F.tid; mem[r] = false; ent[r] = 0;
            if (qi < nq) { const int q = qb0 * 256 + qi; const int qb = q >> 8;
                if (qb == j) { mem[r] = true; ent[r] = (unsigned)q | (3u << 16); }
                else { const unsigned s = SEL[(tokb + q) * 8 + h]; const unsigned nv = s >> 24;
                    if (nv > 0 && (s & 0xff) == (unsigned)j) { mem[r] = true; ent[r] = (unsigned)q; }
                    else if (nv > 1 && ((s >> 8) & 0xff) == (unsigned)j) { mem[r] = true; ent[r] = (unsigned)q | (1u << 16); }
                    else if (nv > 2 && ((s >> 16) & 0xff) == (unsigned)j) { mem[r] = true; ent[r] = (unsigned)q | (2u << 16); } } }
            const unsigned long long bal = __ballot(mem[r]);
            if (F.lane == 0) CNT[r * 8 + F.wave] = (unsigned)__popcll(bal);
            ent[r] |= (unsigned)__popcll(bal & ((1ull << F.lane) - 1ull)) << 20;
        }
        __syncthreads();
        int total = 0;
        { int base0 = 0, base1 = 0;
#pragma unroll
          for (int i = 0; i < 16; ++i) { const int cnt = (int)CNT[i]; if (i < F.wave) base0 += cnt; if (i < 8 + F.wave) base1 += cnt; total += cnt; }
          if (mem[0]) LIST[base0 + (int)(ent[0] >> 20)] = ent[0] & 0xfffffu;
          if (mem[1]) LIST[base1 + (int)(ent[1] >> 20)] = ent[1] & 0xfffffu; }
        __syncthreads();
        const bool need_lut = (qb0 <= j + 1);
        const float bfar = LUT[128];
        const int ntile = (total + 31) >> 5;
        const int qi = F.lane & 31, half = F.lane >> 5;
        for (int tile = F.wave; tile < ntile; tile += 8) {
            const int e = tile * 32 + qi; const bool valid = e < total; const unsigned en = LIST[valid ? e : total - 1];
            const int q = (int)(en & 0xffffu), slot = (int)(en >> 16); const size_t tok = tokb + q;
            bf16x8 qf[4];
#pragma unroll
            for (int kk = 0; kk < 4; ++kk) qf[kk] = *(const bf16x8*)(MO + tok * 1536 + h * 64 + 16 * kk + 8 * half);
            float mrun = -1e30f, lsum = 0.f;
            f32x16 oacc[2];
#pragma unroll
            for (int i = 0; i < 16; ++i) { oacc[0][i] = 0.f; oacc[1][i] = 0.f; }
            const int qrel = q - j * 256;
#pragma unroll 1
            for (int ck = 0; ck < 4; ++ck) {
                f32x16 sacc[2];
#pragma unroll
                for (int k2 = 0; k2 < 2; ++k2) { const int kt = 2 * ck + k2;
#pragma unroll
                    for (int i = 0; i < 16; ++i) sacc[k2][i] = 0.f;
#pragma unroll
                    for (int kk = 0; kk < 4; ++kk) { const bf16x8 ka = *(const LAS bf16x8*)(Ks + (32 * kt + qi) * KS_PITCH + (16 * kk + 8 * half) * 2);
                        sacc[k2] = __builtin_amdgcn_mfma_f32_32x32x16_bf16(ka, qf[kk], sacc[k2], 0, 0, 0); } }
                float mx = -1e30f;
                if (need_lut) {
#pragma unroll
                    for (int k2 = 0; k2 < 2; ++k2)
#pragma unroll
                        for (int i = 0; i < 16; ++i) { const int key = 32 * (2 * ck + k2) + (i & 3) + 8 * (i >> 2) + 4 * half; const int n = qrel - key;
                            const float bias = LUT[n < 0 ? 0 : (n > 128 ? 128 : n)];
                            const float s = (n < 0) ? -1e30f : sacc[k2][i] + bias; sacc[k2][i] = s; mx = fmaxf(mx, s); }
                } else {
#pragma unroll
                    for (int k2 = 0; k2 < 2; ++k2)
#pragma unroll
                        for (int i = 0; i < 16; ++i) { const float s = sacc[k2][i] + bfar; sacc[k2][i] = s; mx = fmaxf(mx, s); }
                }
                mx = fmaxf(mx, __shfl_xor(mx, 32));
                const float mnew = fmaxf(mrun, mx); const float alpha = __expf(mrun - mnew); mrun = mnew;
                lsum *= alpha;
#pragma unroll
                for (int i = 0; i < 16; ++i) { oacc[0][i] *= alpha; oacc[1][i] *= alpha; }
#pragma unroll
                for (int k2 = 0; k2 < 2; ++k2) { const int kt = 2 * ck + k2;
#pragma unroll
                    for (int i = 0; i < 16; ++i) { const float p = __expf(sacc[k2][i] - mnew); sacc[k2][i] = p; lsum += p; }
#pragma unroll
                    for (int cc = 0; cc < 2; ++cc) {
                        u32x4 pw; pw.x = pk2(sacc[k2][8 * cc], sacc[k2][8 * cc + 1]); pw.y = pk2(sacc[k2][8 * cc + 2], sacc[k2][8 * cc + 3]); pw.z = pk2(sacc[k2][8 * cc + 4], sacc[k2][8 * cc + 5]); pw.w = pk2(sacc[k2][8 * cc + 6], sacc[k2][8 * cc + 7]);
                        const bf16x8 pf = __builtin_bit_cast(bf16x8, pw);
                        const int key0 = 32 * kt + 16 * cc + 4 * half;
#pragma unroll
                        for (int dt = 0; dt < 2; ++dt) { const LAS unsigned char* vb = Vt + (32 * dt + qi) * VT_PITCH + key0 * 2;
                            const u32x2 va = *(const LAS u32x2*)vb, vb2 = *(const LAS u32x2*)(vb + 16);
                            u32x4 vw; vw.x = va.x; vw.y = va.y; vw.z = vb2.x; vw.w = vb2.y;
                            oacc[dt] = __builtin_amdgcn_mfma_f32_32x32x16_bf16(__builtin_bit_cast(bf16x8, vw), pf, oacc[dt], 0, 0, 0); } } }
            }
            const float mx = mrun;
            lsum += __shfl_xor(lsum, 32);
            const float inv = 1.0f / lsum;
            if (valid) {
                bf16_t* op = PO + ((size_t)slot * T + tok) * CW + h * 64;
#pragma unroll
                for (int dt = 0; dt < 2; ++dt)
#pragma unroll
                    for (int ig = 0; ig < 4; ++ig) { u32x2 w; w.x = pk2(oacc[dt][4 * ig] * inv, oacc[dt][4 * ig + 1] * inv); w.y = pk2(oacc[dt][4 * ig + 2] * inv, oacc[dt][4 * ig + 3] * inv);
                        *(u32x2*)(op + 32 * dt + 8 * ig + 4 * half) = w; }
                if (half == 0) PST[((size_t)slot * T + tok) * 8 + h] = (f32x2){mx, lsum};
            }
        }
    }
}
DI void phase_moba_combine(Frame& F) {
    const bf16_t* PO = (const bf16_t*)(F.wsp() + WS_PO); const f32x2* PST = (const f32x2*)(F.wsp() + WS_PST); const unsigned* SEL = (const unsigned*)(F.wsp() + WS_SEL);
    bf16_t* YM = (bf16_t*)(F.wsp() + WS_YM);
    const int c = F.tid, h = c >> 6;
    for (int t = F.bid; t < T; t += F.G) {
        const int nv = (int)(SEL[(size_t)t * 8 + h] >> 24);
        float m[4], lw[4]; float M = -1e30f;
#pragma unroll
        for (int s = 0; s < 4; ++s) { const bool on = (s == 3) || (s < nv); if (on) { const f32x2 st = PST[((size_t)s * T + t) * 8 + h]; m[s] = st.x; lw[s] = st.y; M = fmaxf(M, st.x); } else { m[s] = -1e30f; lw[s] = 0.f; } }
        float den = 0.f, num = 0.f;
#pragma unroll
        for (int s = 0; s < 4; ++s) { const bool on = (s == 3) || (s < nv); if (on) { const float w = lw[s] * __expf(m[s] - M); den += w; num += w * bf2f(PO[((size_t)s * T + t) * CW + c]); } }
        YM[(size_t)t * CW + c] = f2bf(num / den);
    }
}
DI void phase_router(Frame& F, int l) {
    LAS float* xs = (LAS float*)F.lds;
    LAS float* wsm = xs + 64 * 129;
    LAS float* lgt = wsm + 128 * 36;
    LAS float* ssq = lgt + 64 * 37;
    LAS int* hist = (LAS int*)(ssq + 64);
    const float* x = F.outp(); const float* gain = F.inp(2) + (size_t)l * DM;
    const float* wgrp = F.inp(29) + (size_t)l * DM * 4; const float* wexp = F.inp(31) + (size_t)l * DM * 32;
    const float* bgrp = F.inp(30) + l * 4; const float* bexp = F.inp(32) + l * 32;
    int* EID = (int*)(F.wsp() + WS_RT + RT_EID); float* GATE = (float*)(F.wsp() + WS_RT + RT_GATE); int* HIST = (int*)(F.wsp() + WS_RT + RT_HIST);
    const int tok = F.tid & 63, jg = F.tid >> 6;
    for (int tile = F.bid; tile < T / 64; tile += F.G) {
        const int t0 = tile * 64;
        float acc[5] = {0.f, 0.f, 0.f, 0.f, 0.f}; float ss = 0.f;
        if (F.tid < 32) hist[F.tid] = 0;
        for (int kc = 0; kc < DM; kc += 128) {
            __syncthreads();
            for (int idx = F.tid; idx < 64 * 128; idx += 512) { const int r = idx >> 7, k = idx & 127; xs[r * 129 + k] = x[(size_t)(t0 + r) * DM + kc + k]; }
            for (int idx = F.tid; idx < 128 * 36; idx += 512) { const int k = idx / 36, j = idx - k * 36; const float g = gain[kc + k];
                wsm[idx] = g * (j < 4 ? wgrp[(size_t)(kc + k) * 4 + j] : wexp[(size_t)(kc + k) * 32 + (j - 4)]); }
            __syncthreads();
            for (int k = 0; k < 128; ++k) { const float xv = xs[tok * 129 + k]; ss += xv * xv;
#pragma unroll
                for (int i = 0; i < 5; ++i) { const int j = jg + 8 * i; if (j < 36) acc[i] += xv * wsm[k * 36 + j]; } }
        }
#pragma unroll
        for (int i = 0; i < 5; ++i) { const int j = jg + 8 * i; if (j < 36) lgt[tok * 37 + j] = acc[i]; }
        if (jg == 0) ssq[tok] = ss;
        __syncthreads();
        if (F.tid < 64) {
            const int t = t0 + F.tid; const float rs = 1.0f / sqrtf(ssq[F.tid] * (1.f / DM) + 1e-6f);
            float lg[4]; int gs = 0; float gm = -INFINITY;
#pragma unroll
            for (int g = 0; g < 4; ++g) { lg[g] = lgt[F.tid * 37 + g] * rs + bgrp[g]; if (lg[g] > gm) { gm = lg[g]; gs = g; } }
            float gden = 0.f;
#pragma unroll
            for (int g = 0; g < 4; ++g) gden += expf(lg[g] - gm);
            const float ptop = 1.0f / gden;
            float le[8]; float e0 = -INFINITY, e1 = -INFINITY; int j0 = 0, j1 = 1;
#pragma unroll
            for (int e = 0; e < 8; ++e) { le[e] = lgt[F.tid * 37 + 4 + gs * 8 + e] * rs + bexp[gs * 8 + e];
                if (le[e] > e0) { e1 = e0; j1 = j0; e0 = le[e]; j0 = e; } else if (le[e] > e1) { e1 = le[e]; j1 = e; } }
            const float p1 = expf(e1 - e0);
            const float g0 = ptop / (1.f + p1), g1 = ptop * p1 / (1.f + p1);
            const int ex0 = gs * 8 + j0, ex1 = gs * 8 + j1;
            EID[t * 2] = ex0; EID[t * 2 + 1] = ex1; GATE[t * 2] = g0; GATE[t * 2 + 1] = g1;
            __hip_atomic_fetch_add(&hist[ex0], 1, __ATOMIC_RELAXED, __HIP_MEMORY_SCOPE_WORKGROUP); __hip_atomic_fetch_add(&hist[ex1], 1, __ATOMIC_RELAXED, __HIP_MEMORY_SCOPE_WORKGROUP);
        }
        __syncthreads();
        if (F.tid < 32) HIST[tile * 32 + F.tid] = hist[F.tid];
        __syncthreads();
    }
}
DI void phase_moe_gather(Frame& F, int l) {
    LAS int* tot = (LAS int*)F.lds; LAS int* off = tot + 32; LAS int* base = off + 32; LAS int* eidl = base + 32; LAS int* rowl = eidl + 128; LAS int* ps = rowl + 128; LAS int* po = ps + 512;
    const float* x = F.outp(); const float* gain = F.inp(2) + (size_t)l * DM;
    const int* EID = (const int*)(F.wsp() + WS_RT + RT_EID); const float* GATE = (const float*)(F.wsp() + WS_RT + RT_GATE); const int* HIST = (const int*)(F.wsp() + WS_RT + RT_HIST);
    int* ROW = (int*)(F.wsp() + WS_RT + RT_ROW); float* GW = (float*)(F.wsp() + WS_RT + RT_GW); int* PEXP = (int*)(F.wsp() + WS_RT + RT_PEXP);
    bf16_t* AM = (bf16_t*)(F.wsp() + WS_AM);
    for (int tile = F.bid; tile < T / 64; tile += F.G) {
        const int t0 = tile * 64;
        __syncthreads();
        { const int e = F.tid & 31, part = F.tid >> 5; int s = 0, o = 0;
          for (int i = part * 32; i < part * 32 + 32; ++i) { const int v = HIST[i * 32 + e]; s += v; if (i < tile) o += v; }
          ps[F.tid] = s; po[F.tid] = o; }
        if (F.tid < 128) eidl[F.tid] = EID[t0 * 2 + F.tid];
        __syncthreads();
        if (F.tid < 32) { int s = 0, o = 0;
#pragma unroll
            for (int p = 0; p < 16; ++p) { s += ps[p * 32 + F.tid]; o += po[p * 32 + F.tid]; } tot[F.tid] = s; off[F.tid] = o; }
        __syncthreads();
        if (F.tid == 0) {
            int bs = 0; for (int e = 0; e < 32; ++e) { base[e] = bs; bs += (tot[e] + 255) & ~255; }
            if (tile == 0) { int p = 0; for (int e = 0; e < 32; ++e) { const int np = (tot[e] + 255) >> 8; for (int i = 0; i < np; ++i) PEXP[p++] = e; } PEXP[MOE_PANELS] = p; }
        }
        __syncthreads();
        if (F.tid < 128) { const int my = eidl[F.tid]; int rank = 0; for (int i = 0; i < F.tid; ++i) rank += (eidl[i] == my) ? 1 : 0;
            const int r = base[my] + off[my] + rank; rowl[F.tid] = r; ROW[t0 * 2 + F.tid] = r; GW[r] = GATE[t0 * 2 + F.tid]; }
        __syncthreads();
        for (int tk = F.wave; tk < 64; tk += 8) { const int t = t0 + tk;
            rms_row_to_bf16(x + (size_t)t * DM, gain, AM + (size_t)rowl[tk * 2] * DM, AM + (size_t)rowl[tk * 2 + 1] * DM, F.lane); }
    }
}
DI void phase_moe_combine(Frame& F, int l) {
    const bf16_t* YE = (const bf16_t*)(F.wsp() + WS_YE); const int* ROW = (const int*)(F.wsp() + WS_RT + RT_ROW); bf16_t* XN = (bf16_t*)(F.wsp() + WS_XN);
    const float* gain = F.inp(1) + (size_t)(l + 1 < NLAYER ? l + 1 : l) * DM;
    const int gw = F.bid * 8 + F.wave, NGW = F.G * 8;
    for (int t = gw; t < T; t += NGW) {
        const int r0 = ROW[t * 2], r1 = ROW[t * 2 + 1];
        f32x4* xr = (f32x4*)(F.outp() + (size_t)t * DM) + F.lane; const u32x2* y0 = (const u32x2*)(YE + (size_t)r0 * DM) + F.lane; const u32x2* y1 = (const u32x2*)(YE + (size_t)r1 * DM) + F.lane;
        f32x4 v[4]; float s = 0.f;
#pragma unroll
        for (int j = 0; j < 4; ++j) { const u32x2 a = y0[64 * j], b = y1[64 * j]; f32x4 xv = xr[64 * j];
            xv.x += bflo(a.x) + bflo(b.x); xv.y += bfhi(a.x) + bfhi(b.x); xv.z += bflo(a.y) + bflo(b.y); xv.w += bfhi(a.y) + bfhi(b.y);
            v[j] = xv; xr[64 * j] = xv; s += (xv.x * xv.x + xv.y * xv.y) + (xv.z * xv.z + xv.w * xv.w); }
        if (l + 1 < NLAYER) {
            const float rs = 1.0f / sqrtf(wave_sum(s) * (1.f / DM) + 1e-6f);
#pragma unroll
            for (int j = 0; j < 4; ++j) { const f32x4 g = ((const f32x4*)gain)[F.lane + 64 * j]; const f32x4 y = v[j] * rs * g; u32x2 w; w.x = pk2(y.x, y.y); w.y = pk2(y.z, y.w); *((u32x2*)(XN + (size_t)t * DM) + F.lane + 64 * j) = w; }
        }
    }
}
#ifndef MK_PER_PHASE_LAUNCH
#define MK_PER_PHASE_LAUNCH 0
#endif
constexpr int PH_PER_LAYER = 17, NPHASE = PH_PER_LAYER * NLAYER;
struct Args { const float* in[36]; float* out; unsigned char* ws; int ph_lo, ph_hi; };

#ifndef PHMASK
#define PHMASK 0x1ffff
#endif
#define IN(k) (((PHMASK >> ((k) % PH_PER_LAYER)) & 1) && lo <= (k) && (k) < hi)
#define SEAM(k) do { asm volatile("" : "+s"(barp), "+s"(bar.x)); bar.bar = (unsigned*)barp; if (IN(k) && IN((k) + 1)) xcd_barrier(bar); asm volatile("" : "+s"(F.ws_g), "+s"(F.out_g), "+s"(F.ka), "+s"(F.bid), "+s"(F.G), "+s"(F.lds)); } while (0)
#define FRESH() do { asm volatile("" : "+s"(F.wave)); int l_ = (int)__builtin_amdgcn_mbcnt_hi(~0u, __builtin_amdgcn_mbcnt_lo(~0u, 0u)); asm volatile("" : "+v"(l_)); F.lane = l_; F.tid = F.wave * 64 + l_; } while (0)
__global__ void __launch_bounds__(512, 2) fwd_kernel(Args args) {
    extern __shared__ __attribute__((aligned(16))) unsigned char lds_raw[];
    Frame F;
    F.lds = (LAS unsigned char*)lds_raw;
    F.tid = threadIdx.x; F.lane = F.tid & 63; F.wave = __builtin_amdgcn_readfirstlane(F.tid >> 6);
    F.G = gridDim.x; F.bid = blockIdx.x;
    F.ka = (const __attribute__((address_space(4))) unsigned char*)__builtin_amdgcn_kernarg_segment_ptr();
    F.out_g = (GAS float*)args.out; F.ws_g = (GAS unsigned char*)args.ws;
    volatile LAS unsigned* MISC = (volatile LAS unsigned*)(F.lds + MISC_OFF);
    if (F.tid < 32) MISC[F.tid] = 0u;
    __syncthreads();
    const int lo = args.ph_lo, hi = args.ph_hi;
    GAS unsigned* barp = (GAS unsigned*)(F.ws_g + WS_CTL) + CW_BAR;
    XcdBarrier bar; bar.bar = (unsigned*)barp; bar.x = 0; bar.st = nullptr;
    if (hi - lo > 1) bar = xcd_barrier_post((unsigned*)barp, MISC + 8);

    bf16_t* const XN = (bf16_t*)(F.wsp() + WS_XN);
    bf16_t* const WCAT = (bf16_t*)(F.wsp() + WS_WM + WM_WCAT);
    for (int l = 0; l < NLAYER; ++l) {
        const int P = l * PH_PER_LAYER;
        if (IN(P + 0)) { FRESH(); if (l == 0) { phase_conv_mixer(F, 0); phase_norm_x(F, F.inp(0), F.inp(1)); } }
        SEAM(P + 0);
        if (IN(P + 1)) { FRESH(); pg8::Gemm g{XN, WCAT, T, 2304, DM}; pg8::StaticOrder S; S.init(T, 2304, F.G, F.bid);
            pg8::EpiStore E{(bf16_t*)(F.wsp() + WS_RW), 1536, 1536, (bf16_t*)(F.wsp() + WS_LO), LO_W, 0};
            pg8::gemm_phase<pg8::EpiStore, pg8::StaticOrder>(F.lds, g, S, E, F.tid); }
        SEAM(P + 1);
        if (IN(P + 2)) { FRESH(); phase_rwkv_prep(F, l); }
        SEAM(P + 2);
        if (IN(P + 3)) { FRESH(); pg8::Gemm g{XN, WCAT + (size_t)2304 * DM, T, 1536, DM}; pg8::StaticOrder S; S.init(T, 1536, F.G, F.bid);
            pg8::EpiStore E{(bf16_t*)(F.wsp() + WS_MO), 1536, 0, nullptr, 0, 0};
            pg8::gemm_phase<pg8::EpiStore, pg8::StaticOrder>(F.lds, g, S, E, F.tid); }
        SEAM(P + 3);
        if (IN(P + 4)) { FRESH(); phase_moba_prep(F, l); }
        SEAM(P + 4);
        if (IN(P + 5)) { FRESH(); phase_moba_gate(F); phase_rwkv_scan_naive(F, l); }
        SEAM(P + 5);
        if (IN(P + 6)) { FRESH(); phase_rwkv_post(F, l); }
        SEAM(P + 6);
        if (IN(P + 7)) { FRESH(); phase_moba_attn(F); }
        SEAM(P + 7);
        if (IN(P + 8)) { FRESH(); phase_moba_combine(F); }
        SEAM(P + 8);
        if (IN(P + 9)) { FRESH(); pg8::Gemm g{XN, WCAT + (size_t)3840 * DM, T, 2048, DM}; pg8::StaticOrder S; S.init(T, 2048, F.G, F.bid);
            pg8::EpiStore E{(bf16_t*)(F.wsp() + WS_GA), 2048, 0, nullptr, 0, 1};
            pg8::gemm_phase<pg8::EpiStore, pg8::StaticOrder>(F.lds, g, S, E, F.tid); }
        SEAM(P + 9);
        if (IN(P + 10)) { FRESH();
            { pg8::Gemm g{(const bf16_t*)(F.wsp() + WS_YR), (const bf16_t*)(F.wsp() + WS_WM + WM_BRR), T, DM, CW}; pg8::StaticOrder S; S.init(T, DM, F.G, F.bid);
              pg8::EpiBranch E{(bf16_t*)(F.wsp() + WS_H), (const bf16_t*)(F.wsp() + WS_GA), 0, 1};
              pg8::gemm_phase<pg8::EpiBranch, pg8::StaticOrder>(F.lds, g, S, E, F.tid); }
            asm volatile("s_waitcnt vmcnt(0)" ::: "memory"); __syncthreads();
            { pg8::Gemm g{(const bf16_t*)(F.wsp() + WS_YM), (const bf16_t*)(F.wsp() + WS_WM + WM_BRM), T, DM, CW}; pg8::StaticOrder S; S.init(T, DM, F.G, F.bid);
              pg8::EpiBranch E{(bf16_t*)(F.wsp() + WS_H), (const bf16_t*)(F.wsp() + WS_GA), 1024, 0};
              pg8::gemm_phase<pg8::EpiBranch, pg8::StaticOrder>(F.lds, g, S, E, F.tid); }
        }
        SEAM(P + 10);
        if (IN(P + 11)) { FRESH(); pg8::Gemm g{(const bf16_t*)(F.wsp() + WS_H), (const bf16_t*)(F.wsp() + WS_WM + WM_OUT), T, DM, DM}; pg8::StaticOrder S; S.init(T, DM, F.G, F.bid);
            pg8::EpiResid E{l == 0 ? F.inp(0) : F.outp(), F.outp()};
            pg8::gemm_phase<pg8::EpiResid, pg8::StaticOrder>(F.lds, g, S, E, F.tid); }
        SEAM(P + 11);
        if (IN(P + 12)) { FRESH(); phase_router(F, l); phase_conv_experts(F, l); }
        SEAM(P + 12);
        if (IN(P + 13)) { FRESH(); phase_moe_gather(F, l); }
        SEAM(P + 13);
        if (IN(P + 14)) { FRESH(); const int* PEXP = (const int*)(F.wsp() + WS_RT + RT_PEXP); const int np = __builtin_amdgcn_readfirstlane(PEXP[MOE_PANELS]);
            pg8::Gemm g{(const bf16_t*)(F.wsp() + WS_AM), (const bf16_t*)(F.wsp() + WS_WE), np * 256, 1024, DM}; pg8::GroupOrder S; S.init(np * 256, 1024, F.G, F.bid); S.pexp = PEXP;
            pg8::EpiExpertUp E{(bf16_t*)(F.wsp() + WS_HM), (const float*)(F.wsp() + WS_RT + RT_GW)};
            pg8::gemm_phase<pg8::EpiExpertUp, pg8::GroupOrder>(F.lds, g, S, E, F.tid); }
        SEAM(P + 14);
        if (IN(P + 15)) { FRESH(); const int* PEXP = (const int*)(F.wsp() + WS_RT + RT_PEXP); const int np = __builtin_amdgcn_readfirstlane(PEXP[MOE_PANELS]);
            pg8::Gemm g{(const bf16_t*)(F.wsp() + WS_HM), (const bf16_t*)(F.wsp() + WS_WD), np * 256, 1024, DEXP}; pg8::GroupOrder S; S.init(np * 256, 1024, F.G, F.bid); S.pexp = PEXP;
            pg8::EpiStore E{(bf16_t*)(F.wsp() + WS_YE), 1024, 0, nullptr, 0, 0};
            pg8::gemm_phase<pg8::EpiStore, pg8::GroupOrder>(F.lds, g, S, E, F.tid); }
        SEAM(P + 15);
        if (IN(P + 16)) { FRESH(); phase_moe_combine(F, l); if (l + 1 < NLAYER) phase_conv_mixer(F, l + 1); }
        SEAM(P + 16);
        }
}

extern "C" void kernel_launch(void* const* d_in, const int* in_sizes, int n_in, void* d_out, int out_size, void* d_ws, size_t ws_size, hipStream_t stream) {
    static int grid = 0;
    if (grid == 0) {
        if (n_in != 36 || out_size != T * DM || ws_size < WS_NEED) { fprintf(stderr, "kernel_launch: unexpected problem (n_in %d, out %d, ws %zu); nothing launched\n", n_in, out_size, ws_size); grid = -1; return; }
        int dev = 0, cus = 0;
        if (hipGetDevice(&dev) != hipSuccess || hipDeviceGetAttribute(&cus, hipDeviceAttributeMultiprocessorCount, dev) != hipSuccess) { grid = -1; return; }
        if (hipFuncSetAttribute((const void*)fwd_kernel, hipFuncAttributeMaxDynamicSharedMemorySize, LDS_BYTES) != hipSuccess) { fprintf(stderr, "kernel_launch: hipFuncSetAttribute failed\n"); grid = -1; return; }
        int per_cu = 0;
        if (hipOccupancyMaxActiveBlocksPerMultiprocessor(&per_cu, (const void*)fwd_kernel, 512, LDS_BYTES) != hipSuccess || per_cu < 1) { fprintf(stderr, "kernel_launch: occupancy query says %d\n", per_cu); }
        (void)hipGetLastError();
        grid = cus;
    }
    if (grid < 0) return;
    (void)hipMemsetAsync((char*)d_ws + WS_CTL, 0, CTL_ZERO_BYTES, stream);
    Args a{};
    for (int i = 0; i < 36; ++i) a.in[i] = (const float*)d_in[i];
    a.out = (float*)d_out; a.ws = (unsigned char*)d_ws;
#if MK_PER_PHASE_LAUNCH
    for (int ph = 0; ph < NPHASE; ++ph) { if (ph == PH_PER_LAYER) continue; a.ph_lo = ph; a.ph_hi = ph + 1; hipLaunchKernelGGL(fwd_kernel, dim3(grid), dim3(512), LDS_BYTES, stream, a); }
#else
    a.ph_lo = 0; a.ph_hi = NPHASE;
    hipLaunchKernelGGL(fwd_kernel, dim3(grid), dim3(512), LDS_BYTES, stream, a);
#endif
}
```

```cpp
#include <hip/hip_runtime.h>
#include <cstdio>
#include <cstdint>
#define LAS __attribute__((address_space(3)))
#define GAS __attribute__((address_space(1)))
#define DI __device__ __forceinline__
typedef unsigned short bf16_t;
typedef short bf16x8 __attribute__((ext_vector_type(8)));
typedef short s16x4 __attribute__((ext_vector_type(4)));
typedef float f32x4 __attribute__((ext_vector_type(4)));
typedef float f32x2 __attribute__((ext_vector_type(2)));
typedef float f32x16 __attribute__((ext_vector_type(16)));
typedef unsigned u32x4 __attribute__((ext_vector_type(4)));
typedef unsigned u32x2 __attribute__((ext_vector_type(2)));
typedef __bf16 bf16v2 __attribute__((ext_vector_type(2)));

DI unsigned pk2(float lo, float hi) { f32x2 v = {lo, hi}; return __builtin_bit_cast(unsigned, __builtin_convertvector(v, bf16v2)); }
DI bf16_t f2bf(float f) { return (bf16_t)(pk2(f, 0.f) & 0xffffu); }
DI float bf2f(bf16_t b) { return __uint_as_float(((unsigned)b) << 16); }
DI float bflo(unsigned w) { return __uint_as_float(w << 16); }
DI float bfhi(unsigned w) { return __uint_as_float(w & 0xffff0000u); }
DI float sigmoidf_(float x) { return 1.0f / (1.0f + __expf(-x)); }

template <int CTRL> DI float dpp_mov(float v) { return __builtin_bit_cast(float, __builtin_amdgcn_update_dpp(0, __builtin_bit_cast(int, v), CTRL, 0xf, 0xf, true)); }
DI float rdlane(float v, int l) { return __builtin_bit_cast(float, __builtin_amdgcn_readlane(__builtin_bit_cast(int, v), l)); }
DI float wave_sum(float v) {
    v += dpp_mov<0xB1>(v);
    v += dpp_mov<0x4E>(v);
    v += dpp_mov<0x141>(v);
    v += dpp_mov<0x140>(v);
    return (rdlane(v, 0) + rdlane(v, 16)) + (rdlane(v, 32) + rdlane(v, 48));
}
namespace pg8 {
constexpr int BM = 256, BK = 64, HALF = 128, HTB = HALF * BK * 2  , STAGE_BYTES = 8 * HTB, NXCD = 8, WGM = 8;

__host__ __device__ __forceinline__ int lds_byte(int r, int c) { const int st = (r >> 4) * 2 + (c >> 5), rr = r & 15, cc = c & 31, ob = rr * 64 + cc * 2; return st * 1024 + (ob ^ (((ob >> 9) & 1) << 5)); }
__host__ __device__ __forceinline__ void stage_rc(int b, int& R, int& C) { const int st = b / 1024, sb = b % 1024, swz = sb ^ (((sb >> 9) & 1) << 5); R = (st >> 1) * 16 + swz / 64; C = (st & 1) * 32 + (swz % 64) / 2; }
__host__ __device__ __forceinline__ int perm32(int rho) { const int n = rho >> 4, i = rho & 15; return 8 * (i >> 2) + 4 * n + (i & 3); }

struct Unit { int pm, pn, pb; };
struct Gemm { const bf16_t* A; const bf16_t* Bt; int M, N, K; };

struct StaticOrder {
    int nM, nN, nwg, G, c;
    __device__ __forceinline__ void init(int M, int N, int G_, int c_) { nM = M / BM; nN = N / BM; nwg = nM * nN; G = G_; c = c_; }
    __device__ __forceinline__ bool next(int i, Unit& u) const {
        const long L = (long)i * G + c; if (L >= nwg) return false;
        int wgid = (int)L; { const int q = nwg / NXCD, r = nwg % NXCD, xcd = wgid % NXCD, off = wgid / NXCD; wgid = (xcd < r ? xcd * (q + 1) : r * (q + 1) + (xcd - r) * q) + off; }
        const int nig = WGM * nN, gid = wgid / nig, fm = gid * WGM, gsz = (nM - fm) < WGM ? (nM - fm) : WGM;
        u.pm = fm + ((wgid % nig) % gsz); u.pn = (wgid % nig) / gsz; u.pb = u.pn; return true;
    }
};
struct GroupOrder : StaticOrder {
    const int* pexp;
    __device__ __forceinline__ bool next(int i, Unit& u) const {
        if (!StaticOrder::next(i, u)) return false;
        u.pb = __builtin_amdgcn_readfirstlane(pexp[u.pm]) * nN + u.pn; return true;
    }
};

template <class Epi, class Sched, bool ALIGN_EPI = true, bool SP2 = true>
__device__ __forceinline__ void gemm_phase(LAS unsigned char* lds, const Gemm g, const Sched& S, const Epi& E, int tid_in) {
    const int tid = tid_in, wid = __builtin_amdgcn_readfirstlane(tid >> 6), lane = tid & 63, wr = wid >> 2, wc = wid & 3, fr = lane & 15, fq = lane >> 4;
    const int K = g.K, nt = K / BK;
    unsigned voffA[2], voffB[2];
#pragma unroll
    for (int i = 0; i < 2; ++i) { int R, C; stage_rc(tid * 16 + i * 8192, R, C); const int Rb = Epi::PERM ? ((R & ~31) + perm32(R & 31)) : R;
        voffA[i] = (unsigned)(R * K + C) * 2u; voffB[i] = (unsigned)(Rb * K + C) * 2u; }
    const size_t kstep = (size_t)(BK * 2);
    const size_t hstep = (size_t)HALF * K * 2;
    const size_t tstep = 2 * hstep;
    const unsigned ldsw = (unsigned)wid * 1024u;
    const int aoff = lds_byte(wr * 64 + fr, fq * 8), boff = lds_byte(wc * 32 + fr, fq * 8);
#define PG8_SA(b, h) (((b) * 2 + (h)) * HTB)
#define PG8_SB(b, h) ((4 + (b) * 2 + (h)) * HTB)
#define PG8_STAGE(bufoff, gbase, voff) do { _Pragma("unroll") for (int _i = 0; _i < 2; ++_i) \
        __builtin_amdgcn_global_load_lds((const unsigned*)((const char*)(gbase) + (voff)[_i]), (LAS unsigned*)(lds + (bufoff) + ldsw + _i * 8192), 16, 0, 0); } while (0)
#define PG8_LDA(dst, b, h) do { _Pragma("unroll") for (int m = 0; m < 4; ++m) _Pragma("unroll") for (int k = 0; k < 2; ++k) dst[m][k] = *(const LAS bf16x8*)(lds + PG8_SA(b, h) + aoff + m * 2048 + k * 1024); } while (0)
#define PG8_LDB(dst, b, h) do { _Pragma("unroll") for (int n = 0; n < 2; ++n) _Pragma("unroll") for (int k = 0; k < 2; ++k) dst[n][k] = *(const LAS bf16x8*)(lds + PG8_SB(b, h) + boff + n * 2048 + k * 1024); } while (0)
#define PG8_MMA(ai, bj, At, Bt) do { __builtin_amdgcn_s_setprio(1); _Pragma("unroll") for (int m = 0; m < 4; ++m) _Pragma("unroll") for (int n = 0; n < 2; ++n) _Pragma("unroll") for (int k = 0; k < 2; ++k) \
        acc[ai][bj][m][n] = __builtin_amdgcn_mfma_f32_16x16x32_bf16(Bt[n][k], At[m][k], acc[ai][bj][m][n], 0, 0, 0); __builtin_amdgcn_s_setprio(0); } while (0)
#define PG8_WAIT_V(n) asm volatile("s_waitcnt vmcnt(" #n ")" ::: "memory")
#define PG8_WAIT_L(n) asm volatile("s_waitcnt lgkmcnt(" #n ")" ::: "memory")
#define PG8_BAR __builtin_amdgcn_s_barrier()
#define PG8_SCHED __builtin_amdgcn_sched_barrier(0)
    Unit cur, nxt; int ui = 0;
    if (!S.next(0, cur)) return;
    f32x4 acc[2][2][4][2];
#pragma unroll
    for (int a = 0; a < 2; ++a)
#pragma unroll
        for (int b = 0; b < 2; ++b)
#pragma unroll
            for (int m = 0; m < 4; ++m)
#pragma unroll
                for (int n = 0; n < 2; ++n) acc[a][b][m][n] = (f32x4){0.f, 0.f, 0.f, 0.f};
    bf16x8 At[4][2], B0[2][2], B1[2][2];
    const char* cA = (const char*)g.A + (size_t)cur.pm * tstep; const char* cB = (const char*)g.Bt + (size_t)cur.pb * tstep;
    if constexpr (SP2) {
        PG8_STAGE(PG8_SB(0, 0), cB, voffB); PG8_STAGE(PG8_SB(0, 1), cB + hstep, voffB); PG8_STAGE(PG8_SA(0, 0), cA, voffA); PG8_STAGE(PG8_SA(0, 1), cA + hstep, voffA);
        if (wr == 1) PG8_BAR;
        PG8_WAIT_V(2); PG8_BAR;
        PG8_STAGE(PG8_SB(1, 0), cB + kstep, voffB); PG8_STAGE(PG8_SA(1, 0), cA + kstep, voffA); PG8_STAGE(PG8_SB(1, 1), cB + hstep + kstep, voffB);
        PG8_WAIT_V(6); PG8_BAR;
    } else {
        PG8_STAGE(PG8_SB(0, 0), cB, voffB); PG8_STAGE(PG8_SA(0, 0), cA, voffA); PG8_STAGE(PG8_SB(0, 1), cB + hstep, voffB); PG8_STAGE(PG8_SA(0, 1), cA + hstep, voffA);
        if (wr == 1) PG8_BAR;
        PG8_WAIT_V(4); PG8_BAR;
        PG8_STAGE(PG8_SB(1, 0), cB + kstep, voffB); PG8_STAGE(PG8_SA(1, 0), cA + kstep, voffA); PG8_STAGE(PG8_SB(1, 1), cB + hstep + kstep, voffB);
        PG8_WAIT_V(6); PG8_BAR;
    }
    for (;;) {
        const bool has_next = S.next(ui + 1, nxt);
        const char* nA = has_next ? (const char*)g.A + (size_t)nxt.pm * tstep : cA; const char* nB = has_next ? (const char*)g.Bt + (size_t)nxt.pb * tstep : cB;
        for (int t = 0; t < nt; t += 2) {
            const bool last = (t == nt - 2);
            const char* a1 = cA + (size_t)(t + 1) * kstep;
            const char* a2 = last ? nA : cA + (size_t)(t + 2) * kstep; const char* b2 = last ? nB : cB + (size_t)(t + 2) * kstep;
            const char* a3 = a2 + kstep; const char* b3 = b2 + kstep;
            if constexpr (SP2) {
            PG8_LDB(B0, 0, 0); PG8_LDB(B1, 0, 1); PG8_SCHED; PG8_LDA(At, 0, 0); PG8_STAGE(PG8_SA(1, 1), a1 + hstep, voffA);
            PG8_WAIT_V(8); PG8_WAIT_L(0); PG8_BAR; PG8_MMA(0, 0, At, B0); PG8_MMA(0, 1, At, B1); PG8_BAR; PG8_SCHED;
            PG8_LDA(At, 0, 1); PG8_STAGE(PG8_SB(0, 0), b2, voffB); PG8_STAGE(PG8_SB(0, 1), b2 + hstep, voffB); PG8_STAGE(PG8_SA(0, 0), a2, voffA);
            PG8_WAIT_V(8); PG8_WAIT_L(0); PG8_BAR; PG8_MMA(1, 0, At, B0); PG8_MMA(1, 1, At, B1); PG8_BAR; PG8_SCHED;
            PG8_LDB(B0, 1, 0); PG8_LDB(B1, 1, 1); PG8_SCHED; PG8_LDA(At, 1, 0); PG8_STAGE(PG8_SA(0, 1), a2 + hstep, voffA);
            PG8_WAIT_V(8); PG8_WAIT_L(0); PG8_BAR; PG8_MMA(0, 0, At, B0); PG8_MMA(0, 1, At, B1); PG8_BAR; PG8_SCHED;
            PG8_LDA(At, 1, 1); PG8_STAGE(PG8_SB(1, 0), b3, voffB); PG8_STAGE(PG8_SB(1, 1), b3 + hstep, voffB); PG8_STAGE(PG8_SA(1, 0), a3, voffA);
            PG8_WAIT_V(8); PG8_WAIT_L(0); PG8_BAR; PG8_MMA(1, 0, At, B0); PG8_MMA(1, 1, At, B1); PG8_BAR; PG8_SCHED;
            } else {
            PG8_LDB(B0, 0, 0); PG8_SCHED; PG8_LDA(At, 0, 0); PG8_STAGE(PG8_SA(1, 1), a1 + hstep, voffA);
            PG8_WAIT_L(8); PG8_BAR; PG8_WAIT_L(0); PG8_MMA(0, 0, At, B0); PG8_BAR; PG8_SCHED;
            PG8_LDB(B1, 0, 1); PG8_STAGE(PG8_SB(0, 0), b2, voffB);
            PG8_BAR; PG8_WAIT_L(0); PG8_MMA(0, 1, At, B1); PG8_BAR;
            PG8_LDA(At, 0, 1); PG8_STAGE(PG8_SA(0, 0), a2, voffA);
            PG8_BAR; PG8_WAIT_L(0); PG8_MMA(1, 0, At, B0); PG8_BAR; PG8_SCHED;
            PG8_STAGE(PG8_SB(0, 1), b2 + hstep, voffB);
            PG8_WAIT_V(6); PG8_BAR; PG8_MMA(1, 1, At, B1); PG8_BAR;
            PG8_LDB(B0, 1, 0); PG8_SCHED; PG8_LDA(At, 1, 0); PG8_STAGE(PG8_SA(0, 1), a2 + hstep, voffA);
            PG8_WAIT_L(8); PG8_BAR; PG8_WAIT_L(0); PG8_MMA(0, 0, At, B0); PG8_BAR; PG8_SCHED;
            PG8_LDB(B1, 1, 1); PG8_STAGE(PG8_SB(1, 0), b3, voffB);
            PG8_BAR; PG8_WAIT_L(0); PG8_MMA(0, 1, At, B1); PG8_BAR;
            PG8_LDA(At, 1, 1); PG8_STAGE(PG8_SA(1, 0), a3, voffA);
            PG8_BAR; PG8_WAIT_L(0); PG8_MMA(1, 0, At, B0); PG8_BAR; PG8_SCHED;
            PG8_STAGE(PG8_SB(1, 1), b3 + hstep, voffB);
            PG8_WAIT_V(6); PG8_BAR; PG8_MMA(1, 1, At, B1); PG8_BAR;
            }
        }
        if constexpr (ALIGN_EPI) { if (wr == 0) PG8_BAR; }
        E(acc, cur, wr, wc, fr, fq);
        if (!has_next) break;
#pragma unroll
        for (int a = 0; a < 2; ++a)
#pragma unroll
            for (int b = 0; b < 2; ++b)
#pragma unroll
                for (int m = 0; m < 4; ++m)
#pragma unroll
                    for (int n = 0; n < 2; ++n) acc[a][b][m][n] = (f32x4){0.f, 0.f, 0.f, 0.f};
        cur = nxt; cA = nA; cB = nB; ++ui;
        if constexpr (ALIGN_EPI) { if (wr == 1) PG8_BAR; }
    }
    PG8_WAIT_V(0);
    if constexpr (!ALIGN_EPI) { if (wr == 0) PG8_BAR; }
    PG8_BAR;
#undef PG8_SA
#undef PG8_SB
#undef PG8_STAGE
#undef PG8_LDA
#undef PG8_LDB
#undef PG8_MMA
#undef PG8_WAIT_V
#undef PG8_WAIT_L
#undef PG8_BAR
#undef PG8_SCHED
}
}
#define XB_TMO      128
#define XB_XCNT(j)  (256  + 64 * (j))
#define XB_XSUB(j)  (1280 + 64 * (j))
#define XB_XGEN(j)  (2304 + 64 * (j))
#define XB_TOP      3328
#define XB_TOPGEN   3392
#define XCD_BAR_WORDS 3456
#define XB_SPIN_CAP (1u << 18)

__device__ __forceinline__ unsigned xb_ld(unsigned* p)              { return __hip_atomic_load(p, __ATOMIC_RELAXED, __HIP_MEMORY_SCOPE_AGENT); }
__device__ __forceinline__ unsigned xb_add(unsigned* p, unsigned v) { return __hip_atomic_fetch_add(p, v, __ATOMIC_RELAXED, __HIP_MEMORY_SCOPE_AGENT); }
__device__ __forceinline__ unsigned xb_xcc_id() { return (unsigned)__builtin_amdgcn_s_getreg((3 << 11) | 20) & 0xFu; }
#define XB_SPIN(cond, bar) do { unsigned _sp = 0; while (cond) { __builtin_amdgcn_s_sleep(1); \
    if ((++_sp & 255u) == 0u) { if (xb_ld(&(bar)[XB_TMO])) break; if (_sp > XB_SPIN_CAP) { atomicAdd(&(bar)[XB_TMO], 1u); break; } } } } while (0)

struct XcdBarrier {
    unsigned* bar; unsigned x;
    volatile LAS unsigned* st;
};

__device__ __forceinline__ XcdBarrier xcd_barrier_post(unsigned* bar, volatile LAS unsigned* st) {
    XcdBarrier b; b.bar = bar; b.x = xb_xcc_id(); b.st = st;
    if (threadIdx.x == 0) (void)xb_add(&bar[XB_XCNT(b.x)], 1u);
    return b;
}
__device__ __forceinline__ void xcd_barrier_complete(unsigned* bar, unsigned x, unsigned& nloc, unsigned& nx) {
    const unsigned G = gridDim.x * gridDim.y * gridDim.z;
    unsigned sum, cnt, mine, sp = 0u;
    for (;;) {
        sum = 0u; cnt = 0u; mine = 0u;
#pragma unroll
        for (unsigned j = 0; j < 16; ++j) { const unsigned c = xb_ld(&bar[XB_XCNT(j)]); sum += c; cnt += (c > 0u) ? 1u : 0u; mine = (j == x) ? c : mine; }
        if (sum == G) break;
        __builtin_amdgcn_s_sleep(1);
        if ((++sp & 255u) == 0u) { if (xb_ld(&bar[XB_TMO])) break; if (sp > XB_SPIN_CAP) { atomicAdd(&bar[XB_TMO], 1u); break; } }
    }
    nloc = mine > 0u ? mine : 1u; nx = cnt > 0u ? cnt : 1u;
}

__device__ __forceinline__ void xcd_barrier(const XcdBarrier& b) {
    asm volatile("s_waitcnt vmcnt(0)" ::: "memory");
    __syncthreads();
    if (threadIdx.x == 0) {
        unsigned* bar = b.bar;
        __builtin_amdgcn_s_waitcnt(0);
        unsigned nloc = b.st[0], nx = b.st[1];
        if (nloc == 0u) { xcd_barrier_complete(bar, b.x, nloc, nx); b.st[0] = nloc; b.st[1] = nx; }
        const unsigned old = xb_add(&bar[XB_XSUB(b.x)], 1u);
        const unsigned gen = old / nloc;
        if (old + 1u == (gen + 1u) * nloc) {
            __builtin_amdgcn_fence(__ATOMIC_RELEASE, "agent");
            asm volatile("s_waitcnt vmcnt(0)" ::: "memory");
            const unsigned og = xb_add(&bar[XB_TOP], 1u);
            const unsigned tg = og / nx;
            if (og + 1u == (tg + 1u) * nx) xb_add(&bar[XB_TOPGEN], 1u);
            else XB_SPIN(xb_ld(&bar[XB_TOPGEN]) == tg, bar);
            __builtin_amdgcn_fence(__ATOMIC_ACQUIRE, "agent");
            xb_add(&bar[XB_XGEN(b.x)], 1u);
            asm volatile("s_waitcnt vmcnt(0)" ::: "memory");
        } else {
            XB_SPIN(xb_ld(&bar[XB_XGEN(b.x)]) == gen, bar);
            __builtin_amdgcn_fence(__ATOMIC_ACQUIRE, "agent");
            asm volatile("s_waitcnt vmcnt(0)" ::: "memory");
        }
    }
    __syncthreads();
}
constexpr int NB = 4, SEQ = 8192, DM = 1024, T = NB * SEQ;
constexpr int NH = 8, HD = 64, CW = 512;
constexpr int N_IN = 5120;
constexpr int NLAYER = 2;
constexpr int NEXP = 32, DEXP = 512;
constexpr int MOE_ROWS = 73728, MOE_PANELS = MOE_ROWS / 256;
constexpr int WCAT_ROWS = 5888;
constexpr int LO_W = 768;

constexpr size_t MiB = 1u << 20;
constexpr size_t WS_CTL = 0, CTL_ZERO_BYTES = 1 * MiB;
constexpr size_t WS_VF   = 1 * MiB;
constexpr size_t WS_TAB  = 33 * MiB;
constexpr size_t WS_WM   = 34 * MiB;
constexpr size_t WS_XN   = 50 * MiB;
constexpr size_t WS_RW   = 114 * MiB;
constexpr size_t WS_MO   = 114 * MiB;
constexpr size_t WS_LO   = 210 * MiB;
constexpr size_t WS_YR   = 354 * MiB;
constexpr size_t WS_SI   = 258 * MiB;
constexpr size_t WS_V1   = 418 * MiB;
constexpr size_t WS_G    = 450 * MiB;
constexpr size_t WS_YS   = 482 * MiB;
constexpr size_t WS_PO   = 418 * MiB;
constexpr size_t WS_PST  = 386 * MiB;
constexpr size_t WS_YM   = 258 * MiB;
constexpr size_t WS_GA   = 418 * MiB;
constexpr size_t WS_H    = 290 * MiB;
constexpr size_t WS_SC1  = 482 * MiB;
constexpr size_t WS_SC2  = 114 * MiB;
constexpr size_t WS_SCT  = 290 * MiB;
constexpr size_t WS_WE   = 34 * MiB;
constexpr size_t WS_WD   = 98 * MiB;
constexpr size_t WS_AM   = 130 * MiB;
constexpr size_t WS_HM   = 274 * MiB;
constexpr size_t WS_YE   = 346 * MiB;
constexpr size_t WS_RT   = 490 * MiB;
constexpr size_t WS_END  = 556 * MiB;
constexpr size_t TB_KMEAN = 0;
constexpr size_t TB_SEL   = 256 * 1024;
constexpr size_t RT_EID  = 0;
constexpr size_t RT_GATE = 256 * 1024;
constexpr size_t RT_ROW  = 512 * 1024;
constexpr size_t RT_GW   = 768 * 1024;
constexpr size_t RT_HIST = 1280 * 1024;
constexpr size_t RT_PEXP = 1408 * 1024;
constexpr size_t WS_SEL  = 556 * MiB;
constexpr size_t WS_NEED = 558 * MiB;
constexpr int CW_BAR = 4096;

constexpr int RING_BYTES = 131072;
constexpr int LDS_BYTES = 163840;
constexpr int MISC_OFF = LDS_BYTES - 256;
struct Frame {
    LAS unsigned char* lds;
    int tid, lane, wave;
    int G, bid;
    const __attribute__((address_space(4))) unsigned char* ka;
    GAS float* out_g; GAS unsigned char* ws_g;
    DI float* outp() const { return (float*)out_g; }
    DI unsigned char* wsp() const { return (unsigned char*)ws_g; }
    DI const float* inp(int i) const { return (const float*)(*(const GAS float* const __attribute__((address_space(4)))*)(ka + 8 * i)); }
};
#define LDS_WAIT() asm volatile("s_waitcnt lgkmcnt(0)" ::: "memory")

DI void tr_item(const float* src, int ld, int k0, bf16_t* dst, int Kd, const float* sc, int mode, LAS float* scr, int lane) {
#pragma unroll 8
    for (int i = 0; i < 32; ++i) { const int kk = 2 * i + (lane >> 5);
        float v = src ? src[(size_t)(k0 + kk) * ld + (lane & 31)] : 0.f;
        if (mode == 1) v *= sc[k0 + kk]; else if (mode == 2) v *= (1.f - sc[k0 + kk]);
        scr[kk * 33 + (lane & 31)] = v; }
    LDS_WAIT(); asm volatile("" ::: "memory");
    const int c = lane & 7;
#pragma unroll
    for (int j = 0; j < 4; ++j) { const int n = (lane >> 3) + 8 * j; const LAS float* s = scr + (8 * c) * 33 + n;
        u32x4 o; o.x = pk2(s[0 * 33], s[1 * 33]); o.y = pk2(s[2 * 33], s[3 * 33]); o.z = pk2(s[4 * 33], s[5 * 33]); o.w = pk2(s[6 * 33], s[7 * 33]);
        *(u32x4*)(dst + (size_t)n * Kd + k0 + 8 * c) = o; }
    LDS_WAIT(); asm volatile("" ::: "memory");
}

constexpr size_t WM_WCAT = 0, WM_BRR = (size_t)WCAT_ROWS * 1024 * 2, WM_BRM = WM_BRR + 1024 * 512 * 2, WM_OUT = WM_BRM + 1024 * 512 * 2;
DI void phase_conv_mixer(Frame& F, int l) {
    LAS float* scr = (LAS float*)(F.lds + F.wave * 16384);
    const int gw = F.bid * 8 + F.wave, NGW = F.G * 8;
    bf16_t* wcat = (bf16_t*)(F.wsp() + WS_WM + WM_WCAT);
    const float* w_in = F.inp(3) + (size_t)l * DM * N_IN;
    const float* mu_x = F.inp(5) + (size_t)l * 3 * DM;
    constexpr int NBLK = WCAT_ROWS / 32;
    constexpr int I_CAT = NBLK * 16, I_BR = 8 * 32, I_OUT = 16 * 32;
    for (int it = gw; it < I_CAT + 2 * I_BR + I_OUT; it += NGW) {
        int r = it;
        if (r < I_CAT) {
            const int nb = r / 16, kb = r % 16, k0 = kb * 64;
            if (nb < 48) { tr_item(w_in + 32 * nb, N_IN, k0, wcat + (size_t)(32 * nb) * 1024, 1024, nullptr, 0, scr, F.lane); }
            else if (nb < 72) {
                const int q = nb - 48; const float* src = nullptr; int ld = 0; const float* sc = nullptr; int mode = 0;
                if (q < 4)       { src = F.inp(7)  + (size_t)l * DM * 64  + 32 * (q & 1); ld = 64;  sc = mu_x;          mode = (q < 2) ? 2 : 1; }
                else if (q < 8)  { src = F.inp(10) + (size_t)l * DM * 64  + 32 * (q & 1); ld = 64;  sc = mu_x + DM;     mode = (q < 6) ? 2 : 1; }
                else if (q < 16) { src = F.inp(12) + (size_t)l * DM * 128 + 32 * (q & 3); ld = 128; sc = mu_x + 2 * DM; mode = (q < 12) ? 2 : 1; }
                else if (q < 18 && l > 0) { src = F.inp(21) + (size_t)(l - 1) * DM * 32; ld = 32; sc = F.inp(19) + (size_t)(l - 1) * DM; mode = (q == 16) ? 2 : 1; }
                tr_item(src, ld, k0, wcat + (size_t)(1536 + 32 * q) * 1024, 1024, sc, mode, scr, F.lane);
            }
            else if (nb < 120) { tr_item(w_in + 1536 + 32 * (nb - 72), N_IN, k0, wcat + (size_t)(2304 + 32 * (nb - 72)) * 1024, 1024, nullptr, 0, scr, F.lane); }
            else { tr_item(w_in + 3072 + 32 * (nb - 120), N_IN, k0, wcat + (size_t)(3840 + 32 * (nb - 120)) * 1024, 1024, nullptr, 0, scr, F.lane); }
            continue;
        }
        r -= I_CAT;
        if (r < I_BR) { const int nb = r / 8, kb = r % 8; tr_item(F.inp(26) + (size_t)l * 512 * 1024 + 32 * nb, 1024, kb * 64, (bf16_t*)(F.wsp() + WS_WM + WM_BRR) + (size_t)(32 * nb) * 512, 512, nullptr, 0, scr, F.lane); continue; }
        r -= I_BR;
        if (r < I_BR) { const int nb = r / 8, kb = r % 8; tr_item(F.inp(27) + (size_t)l * 512 * 1024 + 32 * nb, 1024, kb * 64, (bf16_t*)(F.wsp() + WS_WM + WM_BRM) + (size_t)(32 * nb) * 512, 512, nullptr, 0, scr, F.lane); continue; }
        r -= I_BR;
        { const int nb = r / 16, kb = r % 16; tr_item(F.inp(28) + (size_t)l * 1024 * 1024 + 32 * nb, 1024, kb * 64, (bf16_t*)(F.wsp() + WS_WM + WM_OUT) + (size_t)(32 * nb) * 1024, 1024, nullptr, 0, scr, F.lane); }
    }
}
DI void phase_conv_experts(Frame& F, int l) {
    LAS float* scr = (LAS float*)(F.lds + F.wave * 16384);
    const int gw = F.bid * 8 + F.wave, NGW = F.G * 8;
    bf16_t* we = (bf16_t*)(F.wsp() + WS_WE); bf16_t* wd = (bf16_t*)(F.wsp() + WS_WD);
    const float* wg = F.inp(33) + (size_t)l * NEXP * DM * DEXP; const float* wu = F.inp(34) + (size_t)l * NEXP * DM * DEXP; const float* wdn = F.inp(35) + (size_t)l * NEXP * DEXP * DM;
    for (int it = gw; it < NEXP * 768; it += NGW) {
        const int e = it / 768; int r = it % 768;
        if (r < 512) {
            const int up = r >> 8; r &= 255; const int nb = r / 16, kb = r % 16, h0 = 32 * nb;
            const float* src = (up ? wu : wg) + (size_t)e * DM * DEXP + h0;
            tr_item(src, DEXP, kb * 64, we + ((size_t)e * 1024 + (h0 >> 7) * 256 + up * 128 + (h0 & 127)) * 1024, 1024, nullptr, 0, scr, F.lane);
        } else {
            r -= 512; const int nb = r / 8, kb = r % 8;
            tr_item(wdn + (size_t)e * DEXP * DM + 32 * nb, DM, kb * 64, wd + ((size_t)e * 1024 + 32 * nb) * 512, 512, nullptr, 0, scr, F.lane);
        }
    }
}
DI void rms_row_to_bf16(const float* xrow, const float* gain, bf16_t* o0, bf16_t* o1, int lane) {
    const f32x4* xr = (const f32x4*)xrow + lane; const f32x4* gr = (const f32x4*)gain + lane;
    f32x4 v[4]; float s = 0.f;
#pragma unroll
    for (int j = 0; j < 4; ++j) { v[j] = xr[64 * j]; s += (v[j].x * v[j].x + v[j].y * v[j].y) + (v[j].z * v[j].z + v[j].w * v[j].w); }
    const float rs = 1.0f / sqrtf(wave_sum(s) * (1.f / DM) + 1e-6f);
#pragma unroll
    for (int j = 0; j < 4; ++j) { const f32x4 g = gr[64 * j]; const f32x4 y = v[j] * rs * g;
        u32x2 w; w.x = pk2(y.x, y.y); w.y = pk2(y.z, y.w);
        *((u32x2*)o0 + lane + 64 * j) = w; if (o1) *((u32x2*)o1 + lane + 64 * j) = w; }
}
DI void phase_norm_x(Frame& F, const float* x, const float* gain) {
    const int gw = F.bid * 8 + F.wave, NGW = F.G * 8; bf16_t* xn = (bf16_t*)(F.wsp() + WS_XN);
    for (int m = gw; m < T; m += NGW) rms_row_to_bf16(x + (size_t)m * DM, gain, xn + (size_t)m * DM, nullptr, F.lane);
}

namespace pg8 {
struct EpiStore {
    static constexpr bool PERM = true;
    bf16_t* O; int ldc; int split; bf16_t* O2; int ldc2; int act;
    __device__ __forceinline__ void operator()(const f32x4 (&acc)[2][2][4][2], const Unit& u, int wr, int wc, int fr, int fq) const {
        const int row0 = u.pm * BM + wr * 64 + fr; int colt = u.pn * BM; bf16_t* base = O; int ld = ldc;
        if (split && colt >= split) { base = O2; ld = ldc2; colt -= split; }
        const int col0 = colt + wc * 32 + 8 * fq;
#pragma unroll
        for (int ai = 0; ai < 2; ++ai)
#pragma unroll
            for (int m = 0; m < 4; ++m) { bf16_t* rowp = base + (size_t)(row0 + ai * HALF + m * 16) * ld + col0;
#pragma unroll
                for (int bj = 0; bj < 2; ++bj) { f32x4 v0 = acc[ai][bj][m][0], v1 = acc[ai][bj][m][1];
                    if (act == 1) {
#pragma unroll
                        for (int j = 0; j < 4; ++j) { v0[j] = sigmoidf_(v0[j]); v1[j] = sigmoidf_(v1[j]); } }
                    u32x4 w; w.x = pk2(v0[0], v0[1]); w.y = pk2(v0[2], v0[3]); w.z = pk2(v1[0], v1[1]); w.w = pk2(v1[2], v1[3]);
                    *(u32x4*)(rowp + bj * HALF) = w; } }
    }
};
struct EpiBranch {
    static constexpr bool PERM = true;
    bf16_t* Hout; const bf16_t* gate; int gcol0; int first;
    __device__ __forceinline__ void operator()(const f32x4 (&acc)[2][2][4][2], const Unit& u, int wr, int wc, int fr, int fq) const {
        const int row0 = u.pm * BM + wr * 64 + fr; const int col0 = u.pn * BM + wc * 32 + 8 * fq;
#pragma unroll
        for (int ai = 0; ai < 2; ++ai)
#pragma unroll
            for (int m = 0; m < 4; ++m) { const size_t row = (size_t)(row0 + ai * HALF + m * 16);
#pragma unroll
                for (int bj = 0; bj < 2; ++bj) {
                    const u32x4 gv = *(const u32x4*)(gate + row * 2048 + gcol0 + col0 + bj * HALF);
                    bf16_t* hp = Hout + row * 1024 + col0 + bj * HALF;
                    f32x4 v0 = acc[ai][bj][m][0], v1 = acc[ai][bj][m][1];
                    v0[0] *= bflo(gv.x); v0[1] *= bfhi(gv.x); v0[2] *= bflo(gv.y); v0[3] *= bfhi(gv.y);
                    v1[0] *= bflo(gv.z); v1[1] *= bfhi(gv.z); v1[2] *= bflo(gv.w); v1[3] *= bfhi(gv.w);
                    if (!first) { const u32x4 hv = *(const u32x4*)hp;
                        v0[0] += bflo(hv.x); v0[1] += bfhi(hv.x); v0[2] += bflo(hv.y); v0[3] += bfhi(hv.y);
                        v1[0] += bflo(hv.z); v1[1] += bfhi(hv.z); v1[2] += bflo(hv.w); v1[3] += bfhi(hv.w); }
                    u32x4 w; w.x = pk2(v0[0], v0[1]); w.y = pk2(v0[2], v0[3]); w.z = pk2(v1[0], v1[1]); w.w = pk2(v1[2], v1[3]);
                    *(u32x4*)hp = w; } }
    }
};
struct EpiResid {
    static constexpr bool PERM = false;
    const float* xin; float* out;
    __device__ __forceinline__ void operator()(const f32x4 (&acc)[2][2][4][2], const Unit& u, int wr, int wc, int fr, int fq) const {
        const int row0 = u.pm * BM + wr * 64 + fr, col0 = u.pn * BM + wc * 32 + 4 * fq;
#pragma unroll
        for (int ai = 0; ai < 2; ++ai)
#pragma unroll
            for (int m = 0; m < 4; ++m) { const size_t off = (size_t)(row0 + ai * HALF + m * 16) * 1024 + col0;
#pragma unroll
                for (int bj = 0; bj < 2; ++bj)
#pragma unroll
                    for (int n = 0; n < 2; ++n) { const f32x4 xv = *(const f32x4*)(xin + off + bj * HALF + n * 16); *(f32x4*)(out + off + bj * HALF + n * 16) = xv + acc[ai][bj][m][n]; } }
    }
};
struct EpiExpertUp {
    static constexpr bool PERM = true;
    bf16_t* HM; const float* gw;
    __device__ __forceinline__ void operator()(const f32x4 (&acc)[2][2][4][2], const Unit& u, int wr, int wc, int fr, int fq) const {
        const int row0 = u.pm * BM + wr * 64 + fr; const int col0 = u.pn * 128 + wc * 32 + 8 * fq;
#pragma unroll
        for (int ai = 0; ai < 2; ++ai)
#pragma unroll
            for (int m = 0; m < 4; ++m) { const size_t row = (size_t)(row0 + ai * HALF + m * 16); const float gwt = gw[row];
                f32x4 v0, v1;
#pragma unroll
                for (int j = 0; j < 4; ++j) { const float g0 = acc[ai][0][m][0][j], g1 = acc[ai][0][m][1][j];
                    v0[j] = g0 * sigmoidf_(g0) * acc[ai][1][m][0][j] * gwt; v1[j] = g1 * sigmoidf_(g1) * acc[ai][1][m][1][j] * gwt; }
                u32x4 w; w.x = pk2(v0[0], v0[1]); w.y = pk2(v0[2], v0[3]); w.z = pk2(v1[0], v1[1]); w.w = pk2(v1[2], v1[3]);
                *(u32x4*)(HM + row * 512 + col0) = w; }
    }
};
}
constexpr size_t SI_PLANE = (size_t)T * CW * 2;
DI float softplusf_(float z) { return fmaxf(z, 0.f) + log1pf(__expf(-fabsf(z))); }

DI void phase_rwkv_prep(Frame& F, int l) {
    LAS float* act = (LAS float*)F.lds;
    const bf16_t* RW = (const bf16_t*)(F.wsp() + WS_RW); const bf16_t* LO = (const bf16_t*)(F.wsp() + WS_LO);
    bf16_t* SIr = (bf16_t*)(F.wsp() + WS_SI); bf16_t* SIw = SIr + (size_t)T * CW; bf16_t* SIk = SIw + (size_t)T * CW; bf16_t* SIa = SIk + (size_t)T * CW; bf16_t* SIb = SIa + (size_t)T * CW;
    bf16_t* VF = (bf16_t*)(F.wsp() + WS_VF); bf16_t* V1 = (bf16_t*)(F.wsp() + WS_V1); bf16_t* Gb = (bf16_t*)(F.wsp() + WS_G);
    int c = F.tid;
    const float* w2 = F.inp(8) + (size_t)l * 64 * CW; const float* a2 = F.inp(11) + (size_t)l * 64 * CW; const float* g2 = F.inp(13) + (size_t)l * 128 * CW;
    const float* v2 = F.inp(22);
    const float mu_r = F.inp(4)[(size_t)l * 3 * CW + c], mu_k = F.inp(4)[(size_t)l * 3 * CW + CW + c], mu_v = F.inp(4)[(size_t)l * 3 * CW + 2 * CW + c];
    const float w0c = F.inp(6)[l * CW + c], a0c = F.inp(9)[l * CW + c], kkc = F.inp(14)[l * CW + c], kac = F.inp(15)[l * CW + c];
    const float v0c = l > 0 ? F.inp(20)[c] : 0.f;
    for (int tile = F.bid; tile < T / 8; tile += F.G) {
        int t0 = tile * 8; asm volatile("" : "+s"(t0), "+v"(c));
        __syncthreads();
        for (int idx = F.tid; idx < 8 * 288; idx += 512) {
            const int tt = idx / 288, j = idx - tt * 288; const int t = t0 + tt; const bool has_prev = (t % SEQ) != 0;
            int pj, qj;
            if (j < 64) { pj = j; qj = 64 + j; } else if (j < 128) { pj = 128 + (j - 64); qj = 192 + (j - 64); } else if (j < 256) { pj = 256 + (j - 128); qj = 384 + (j - 128); } else { pj = 512 + (j - 256); qj = 544 + (j - 256); }
            float v = bf2f(LO[(size_t)t * LO_W + pj]); if (has_prev) v += bf2f(LO[(size_t)(t - 1) * LO_W + qj]);
            if (j < 64) v = tanhf(v); else if (j >= 128 && j < 256) v = sigmoidf_(v);
            act[j * 8 + tt] = v;
        }
        __syncthreads();
        float aw[8], aa[8], ag[8], av[8];
#pragma unroll
        for (int i = 0; i < 8; ++i) { aw[i] = 0.f; aa[i] = 0.f; ag[i] = 0.f; av[i] = 0.f; }
        for (int j = 0; j < 64; ++j) { const float w = w2[j * CW + c]; const LAS f32x4* ap = (const LAS f32x4*)(act + j * 8);
#pragma unroll
            for (int q = 0; q < 2; ++q) { const f32x4 x = ap[q]; aw[4 * q] += x.x * w; aw[4 * q + 1] += x.y * w; aw[4 * q + 2] += x.z * w; aw[4 * q + 3] += x.w * w; } }
        for (int j = 0; j < 64; ++j) { const float w = a2[j * CW + c]; const LAS f32x4* ap = (const LAS f32x4*)(act + (64 + j) * 8);
#pragma unroll
            for (int q = 0; q < 2; ++q) { const f32x4 x = ap[q]; aa[4 * q] += x.x * w; aa[4 * q + 1] += x.y * w; aa[4 * q + 2] += x.z * w; aa[4 * q + 3] += x.w * w; } }
        for (int j = 0; j < 128; ++j) { const float w = g2[j * CW + c]; const LAS f32x4* ap = (const LAS f32x4*)(act + (128 + j) * 8);
#pragma unroll
            for (int q = 0; q < 2; ++q) { const f32x4 x = ap[q]; ag[4 * q] += x.x * w; ag[4 * q + 1] += x.y * w; ag[4 * q + 2] += x.z * w; ag[4 * q + 3] += x.w * w; } }
        if (l > 0) for (int j = 0; j < 32; ++j) { const float w = v2[j * CW + c]; const LAS f32x4* ap = (const LAS f32x4*)(act + (256 + j) * 8);
#pragma unroll
            for (int q = 0; q < 2; ++q) { const f32x4 x = ap[q]; av[4 * q] += x.x * w; av[4 * q + 1] += x.y * w; av[4 * q + 2] += x.z * w; av[4 * q + 3] += x.w * w; } }
#pragma unroll
        for (int tt = 0; tt < 8; ++tt) {
            const int t = t0 + tt; const bool has_prev = (t % SEQ) != 0; const size_t ro = (size_t)t * 1536;
            const float rp = bf2f(RW[ro + c]), kp = bf2f(RW[ro + 512 + c]), vp = bf2f(RW[ro + 1024 + c]);
            float rq = 0.f, kq = 0.f, vq = 0.f;
            if (has_prev) { rq = bf2f(RW[ro - 1536 + c]); kq = bf2f(RW[ro - 1536 + 512 + c]); vq = bf2f(RW[ro - 1536 + 1024 + c]); }
            const float r = rp + (rq - rp) * mu_r, k = kp + (kq - kp) * mu_k; float v = vp + (vq - vp) * mu_v;
            const float wl = -softplusf_(-(w0c + aw[tt])) - 0.5f;
            const float lw = -__expf(wl);
            const float alr = sigmoidf_(a0c + aa[tt]);
            const size_t o = (size_t)t * CW + c;
            if (l > 0) { const float vf = bf2f(VF[o]); v = v + (vf - v) * sigmoidf_(v0c + av[tt]); V1[o] = f2bf(v); } else { VF[o] = f2bf(v); }
            float kk = k * kkc; const float nrm = sqrtf(wave_sum(kk * kk)); kk = kk / fmaxf(nrm, 1e-12f);
            const float k2 = k * (1.f + (alr - 1.f) * kac);
            SIr[o] = f2bf(r); SIw[o] = f2bf(lw); SIk[o] = f2bf(k2); SIa[o] = f2bf(kk); SIb[o] = f2bf(kk * alr); Gb[o] = f2bf(ag[tt]);
            asm volatile("" ::: "memory");
        }
    }
}

DI void phase_rwkv_scan_naive(Frame& F, int l) {
    LAS float* Lr = (LAS float*)F.lds; LAS float* Lw = Lr + 4096; LAS float* Lk = Lw + 4096; LAS float* La = Lk + 4096; LAS float* Lb = La + 4096;
    LAS float* Lv = Lb + 4096; LAS float* Ly = Lv + 512;
    const bf16_t* SIr = (const bf16_t*)(F.wsp() + WS_SI); const bf16_t* SIw = SIr + (size_t)T * CW; const bf16_t* SIk = SIw + (size_t)T * CW; const bf16_t* SIa = SIk + (size_t)T * CW; const bf16_t* SIb = SIa + (size_t)T * CW;
    const bf16_t* V = (const bf16_t*)(F.wsp() + (l > 0 ? WS_V1 : WS_VF)); float* YS = (float*)(F.wsp() + WS_YS);
    for (int u = F.bid; u < 256; u += F.G) {
        const int b = u >> 6, h = (u >> 3) & 7, rg = u & 7;
        float S = 0.f;
        for (int ch = 0; ch < SEQ / 64; ++ch) {
            const size_t tb = (size_t)b * SEQ + ch * 64;
            __syncthreads();
            for (int idx = F.tid; idx < 4096; idx += 512) { const int s = idx >> 6, kx = idx & 63; const size_t o = (tb + s) * CW + h * 64 + kx;
                Lr[idx] = bf2f(SIr[o]); Lw[idx] = __expf(bf2f(SIw[o])); Lk[idx] = bf2f(SIk[o]); La[idx] = -bf2f(SIa[o]); Lb[idx] = bf2f(SIb[o]); }
            { const int s = F.tid >> 3, rr = F.tid & 7; Lv[F.tid] = bf2f(V[(tb + s) * CW + h * 64 + rg * 8 + rr]); }
            __syncthreads();
#pragma unroll 4
            for (int s = 0; s < 64; ++s) {
                const float a = La[s * 64 + F.lane], w = Lw[s * 64 + F.lane], bb = Lb[s * 64 + F.lane], kk = Lk[s * 64 + F.lane], r = Lr[s * 64 + F.lane], v = Lv[s * 8 + F.wave];
                const float sa = wave_sum(S * a);
                S = S * w + sa * bb + v * kk;
                const float y = wave_sum(S * r);
                if (F.lane == 0) Ly[s * 8 + F.wave] = y;
            }
            __syncthreads();
            { const int s = F.tid >> 3, rr = F.tid & 7; YS[(tb + s) * CW + h * 64 + rg * 8 + rr] = Ly[F.tid]; }
        }
    }
}

DI void phase_rwkv_post(Frame& F, int l) {
    const float* YS = (const float*)(F.wsp() + WS_YS);
    const bf16_t* SIr = (const bf16_t*)(F.wsp() + WS_SI); const bf16_t* SIk = SIr + 2 * (size_t)T * CW;
    const bf16_t* V = (const bf16_t*)(F.wsp() + (l > 0 ? WS_V1 : WS_VF)); const bf16_t* Gb = (const bf16_t*)(F.wsp() + WS_G); bf16_t* YR = (bf16_t*)(F.wsp() + WS_YR);
    const int c = F.tid; const float lg = F.inp(17)[l * CW + c], lb = F.inp(18)[l * CW + c], rk = F.inp(16)[l * CW + c];
    for (int t = F.bid; t < T; t += F.G) {
        const size_t o = (size_t)t * CW + c;
        const float y = YS[o]; const float mean = wave_sum(y) * (1.f / 64.f); const float d = y - mean; const float var = wave_sum(d * d) * (1.f / 64.f);
        const float yn = d * (1.0f / sqrtf(var + 64e-5f)) * lg + lb;
        const float r = bf2f(SIr[o]), k = bf2f(SIk[o]), v = bf2f(V[o]);
        const float bonus = wave_sum(r * k * rk) * v;
        YR[o] = f2bf((yn + bonus) * bf2f(Gb[o]));
    }
}
constexpr int NUNIT = NB * NH * (SEQ / 64);
constexpr size_t U_PMP = 0, U_RPP = 8192, U1_BYTES = 16384;
constexpr size_t U_QMT = 0, U_YLT = 16384, U2_BYTES = 32768;
DI int permk(int k) { return (k & 32) | (((k >> 2) & 3) << 3) | (((k >> 4) & 1) << 2) | (k & 3); }
constexpr int MP = 144;
constexpr int SP = 80;
DI f32x4 mfma16(bf16x8 a, bf16x8 b, f32x4 c) { return __builtin_amdgcn_mfma_f32_16x16x32_bf16(a, b, c, 0, 0, 0); }
DI f32x4 mm_tile(const LAS unsigned char* xb, int px, int m0, const LAS unsigned char* yb, int py, int n0, int ks, f32x4 acc, int lane) {
    const int r16 = lane & 15, g = lane >> 4;
    for (int s = 0; s < ks; ++s) {
        const bf16x8 a = *(const LAS bf16x8*)(xb + (m0 + r16) * px + (32 * s + 8 * g) * 2);
        const bf16x8 b = *(const LAS bf16x8*)(yb + (n0 + r16) * py + (32 * s + 8 * g) * 2);
        acc = mfma16(a, b, acc);
    }
    return acc;
}
DI u32x2 pk4(f32x4 v) { u32x2 w; w.x = pk2(v[0], v[1]); w.y = pk2(v[2], v[3]); return w; }

DI void phase_scan_a(Frame& F, int l) {
    LAS unsigned char* const L = F.lds;
#define MB(n) (L + (n) * 9216)
    LAS float* const Gf = (LAS float*)(L + 110592);
    LAS float* const SEG = (LAS float*)(L + 110592 + 16384);
    LAS float* const GL = SEG + 512;
    LAS unsigned char* const A21 = L + 110592 + 16384 + 2048 + 256;
    LAS unsigned char* const T11T = A21 + 2560;
    LAS unsigned char* const ZT = T11T + 2560;
    const bf16_t* SIr = (const bf16_t*)(F.wsp() + WS_SI); const bf16_t* SIw = SIr + (size_t)T * CW; const bf16_t* SIk = SIw + (size_t)T * CW; const bf16_t* SIa = SIk + (size_t)T * CW; const bf16_t* SIb = SIa + (size_t)T * CW;
    const bf16_t* V = (const bf16_t*)(F.wsp() + (l > 0 ? WS_V1 : WS_VF));
    const int lane = F.lane, wave = F.wave, r16 = lane & 15, g = lane >> 4;
    for (int u = F.bid; u < NUNIT; u += F.G) {
        const int bh = u & 31, c = u >> 5, b = bh >> 3, h = bh & 7;
        const size_t t0 = (size_t)b * SEQ + c * 64;
        unsigned char* const rec1 = F.wsp() + WS_SC1 + (size_t)((bh * 128) + c) * U1_BYTES; unsigned char* const rec2 = F.wsp() + WS_SC2 + (size_t)((bh * 128) + c) * U2_BYTES;
        __syncthreads();
        { const int k = F.tid & 63, seg = F.tid >> 6; float p[8]; float run = 0.f;
#pragma unroll
          for (int e = 0; e < 8; ++e) { run += bf2f(SIw[(t0 + 8 * seg + e) * CW + h * 64 + k]); p[e] = run; }
          SEG[seg * 64 + k] = run;
          __syncthreads();
          float off = 0.f;
#pragma unroll
          for (int s = 0; s < 8; ++s) off += (s < seg) ? SEG[s * 64 + k] : 0.f;
#pragma unroll
          for (int e = 0; e < 8; ++e) Gf[(8 * seg + e) * 64 + k] = off + p[e];
        }
        __syncthreads();
        { const int i = F.tid >> 3, k0 = (F.tid & 7) * 8; const size_t go = (t0 + i) * CW + h * 64 + k0;
          const u32x4 rv = *(const u32x4*)(SIr + go), kv = *(const u32x4*)(SIk + go), av = *(const u32x4*)(SIa + go), bv = *(const u32x4*)(SIb + go), vv = *(const u32x4*)(V + go);
          float fr[8], fk[8], fa[8], fb[8], fv[8];
          const unsigned rw[4] = {rv.x, rv.y, rv.z, rv.w}, kw[4] = {kv.x, kv.y, kv.z, kv.w}, aw[4] = {av.x, av.y, av.z, av.w}, bw[4] = {bv.x, bv.y, bv.z, bv.w}, vw[4] = {vv.x, vv.y, vv.z, vv.w};
#pragma unroll
          for (int q = 0; q < 4; ++q) { fr[2 * q] = bflo(rw[q]); fr[2 * q + 1] = bfhi(rw[q]); fk[2 * q] = bflo(kw[q]); fk[2 * q + 1] = bfhi(kw[q]); fa[2 * q] = bflo(aw[q]); fa[2 * q + 1] = bfhi(aw[q]);
              fb[2 * q] = bflo(bw[q]); fb[2 * q + 1] = bfhi(bw[q]); fv[2 * q] = bflo(vw[q]); fv[2 * q + 1] = bfhi(vw[q]); }
          float at[8], rt[8], bt[8], kt[8], bh8[8], kh8[8];
#pragma unroll
          for (int e = 0; e < 8; ++e) { const float gi = Gf[i * 64 + k0 + e], gp = (i > 0) ? Gf[(i - 1) * 64 + k0 + e] : 0.f, gl = Gf[63 * 64 + k0 + e];
              const float e1 = __expf(gp), e2 = __expf(gi), e3 = __expf(-gi), e4 = __expf(gl - gi);
              at[e] = -fa[e] * e1; rt[e] = fr[e] * e2; bt[e] = fb[e] * e3; kt[e] = fk[e] * e3; bh8[e] = fb[e] * e4; kh8[e] = fk[e] * e4;
              if (i == 63) GL[k0 + e] = e2; }
          u32x4 w;
          w.x = pk2(at[0], at[1]); w.y = pk2(at[2], at[3]); w.z = pk2(at[4], at[5]); w.w = pk2(at[6], at[7]); *(LAS u32x4*)(MB(0) + i * MP + k0 * 2) = w;
          w.x = pk2(rt[0], rt[1]); w.y = pk2(rt[2], rt[3]); w.z = pk2(rt[4], rt[5]); w.w = pk2(rt[6], rt[7]); *(LAS u32x4*)(MB(1) + i * MP + k0 * 2) = w;
          w.x = pk2(bt[0], bt[1]); w.y = pk2(bt[2], bt[3]); w.z = pk2(bt[4], bt[5]); w.w = pk2(bt[6], bt[7]); *(LAS u32x4*)(MB(2) + i * MP + k0 * 2) = w;
          w.x = pk2(kt[0], kt[1]); w.y = pk2(kt[2], kt[3]); w.z = pk2(kt[4], kt[5]); w.w = pk2(kt[6], kt[7]); *(LAS u32x4*)(MB(3) + i * MP + k0 * 2) = w;
#pragma unroll
          for (int e = 0; e < 8; ++e) { const int ro = (k0 + e) * MP + i * 2;
              *(LAS bf16_t*)(MB(4) + ro) = f2bf(at[e]); *(LAS bf16_t*)(MB(5) + ro) = f2bf(fv[e]); *(LAS bf16_t*)(MB(6) + ro) = f2bf(bh8[e]); *(LAS bf16_t*)(MB(7) + ro) = f2bf(kh8[e]); }
        }
        __syncthreads();
        { const int prod = wave >> 1;
          const LAS unsigned char* xb = (prod & 1) ? MB(3) : MB(2); const LAS unsigned char* yb = (prod < 2) ? MB(0) : MB(1);
          LAS unsigned char* ob = (prod == 1) ? MB(8) : (prod == 2) ? MB(9) : MB(10);
          for (int q = 0; q < 8; ++q) { const int tt = (wave & 1) * 8 + q, tm = tt >> 2, tn = tt & 3;
              f32x4 acc = {0.f, 0.f, 0.f, 0.f};
              if (tm <= tn) acc = mm_tile(xb, MP, 16 * tm, yb, MP, 16 * tn, 2, acc, lane);
              const int i = 16 * tn + r16, j0 = 16 * tm + 4 * g;
#pragma unroll
              for (int r = 0; r < 4; ++r) { const int j = j0 + r; const bool keep = (prod < 2) ? (j < i) : (j <= i); if (!keep) acc[r] = 0.f; }
              if (prod == 0) {
                  if ((i >> 5) == (j0 >> 5)) *(LAS f32x4*)(Gf + ((i >> 5) * 32 + (i & 31)) * 32 + (j0 & 31)) = acc;
                  if (i >= 32 && j0 < 32) *(LAS u32x2*)(A21 + (i - 32) * SP + j0 * 2) = pk4(acc);
              } else *(LAS u32x2*)(ob + i * MP + j0 * 2) = pk4(acc);
          } }
        __syncthreads();
        if (wave == 0) {
            const int blk = lane >> 5, cc = lane & 31; const LAS float* AD = Gf + blk * 1024;
            float Tc[32];
#pragma unroll
            for (int i = 0; i < 32; ++i) { float acc = (i == cc) ? 1.f : 0.f;
#pragma unroll
                for (int j = 0; j < i; ++j) acc += AD[i * 32 + j] * Tc[j];
                Tc[i] = acc; }
#pragma unroll
            for (int i = 0; i < 32; ++i) *(LAS bf16_t*)(MB(11) + (32 * blk + i) * MP + (32 * blk + cc) * 2) = f2bf(Tc[i]);
            if (blk == 0) {
#pragma unroll
                for (int q = 0; q < 4; ++q) { u32x4 w; w.x = pk2(Tc[8 * q], Tc[8 * q + 1]); w.y = pk2(Tc[8 * q + 2], Tc[8 * q + 3]); w.z = pk2(Tc[8 * q + 4], Tc[8 * q + 5]); w.w = pk2(Tc[8 * q + 6], Tc[8 * q + 7]);
                    *(LAS u32x4*)(T11T + cc * SP + q * 16) = w; }
            } else {
#pragma unroll
                for (int q = 0; q < 4; ++q) *(LAS u32x4*)(MB(11) + cc * MP + 64 + q * 16) = (u32x4){0u, 0u, 0u, 0u};
            }
        } else {
            for (int tt = wave - 1; tt < 16; tt += 7) { const int tm = tt >> 2, tn = tt & 3;
                f32x4 acc = {0.f, 0.f, 0.f, 0.f};
                acc = mm_tile(MB(8), MP, 16 * tm, MB(5), MP, 16 * tn, 2, acc, lane);
                *(LAS u32x2*)(MB(2) + (16 * tn + r16) * MP + (16 * tm + 4 * g) * 2) = pk4(acc); }
        }
        __syncthreads();
        if (wave < 4) { const int tm = wave >> 1, tn = wave & 1; f32x4 acc = {0.f, 0.f, 0.f, 0.f};
            acc = mm_tile(A21, SP, 16 * tm, T11T, SP, 16 * tn, 1, acc, lane);
            *(LAS u32x2*)(ZT + (16 * tn + r16) * SP + (16 * tm + 4 * g) * 2) = pk4(acc); }
        __syncthreads();
        if (wave < 4) { const int tm = wave >> 1, tn = wave & 1; f32x4 acc = {0.f, 0.f, 0.f, 0.f};
            acc = mm_tile(ZT, SP, 16 * tm, MB(11) + 32 * MP + 64, MP, 16 * tn, 1, acc, lane);
            *(LAS u32x2*)(MB(11) + (32 + 16 * tn + r16) * MP + (16 * tm + 4 * g) * 2) = pk4(acc); }
        __syncthreads();
        { const LAS unsigned char* yb = (wave < 4) ? MB(4) : MB(2); LAS unsigned char* ob = (wave < 4) ? MB(3) : MB(0);
          for (int q = 0; q < 4; ++q) { const int tt = (wave & 3) * 4 + q, tm = tt >> 2, tn = tt & 3;
              f32x4 acc = {0.f, 0.f, 0.f, 0.f};
              acc = mm_tile(MB(11), MP, 16 * tm, yb, MP, 16 * tn, 2, acc, lane);
              *(LAS u32x2*)(ob + (16 * tn + r16) * MP + (16 * tm + 4 * g) * 2) = pk4(acc); } }
        __syncthreads();
        for (int q = 0; q < 2; ++q) { const int tt = wave * 2 + q, tm = tt >> 2, tn = tt & 3;
            { f32x4 acc = {0.f, 0.f, 0.f, 0.f}; acc = mm_tile(MB(3), MP, 16 * tm, MB(9), MP, 16 * tn, 2, acc, lane);
              const int i = 16 * tn + r16, k0 = 16 * tm + 4 * g; const u32x2 rr = *(const LAS u32x2*)(MB(1) + i * MP + k0 * 2);
              acc[0] += bflo(rr.x); acc[1] += bfhi(rr.x); acc[2] += bflo(rr.y); acc[3] += bfhi(rr.y);
              *(u32x2*)(rec1 + U_RPP + (size_t)(i * 64 + permk(k0)) * 2) = pk4(acc); }
            { f32x4 acc = {0.f, 0.f, 0.f, 0.f}; acc = mm_tile(MB(3), MP, 16 * tm, MB(6), MP, 16 * tn, 2, acc, lane);
              const int kp = 16 * tn + r16, k0 = 16 * tm + 4 * g;
#pragma unroll
              for (int r = 0; r < 4; ++r) if (k0 + r == kp) acc[r] += GL[kp];
              *(u32x2*)(rec1 + U_PMP + (size_t)(kp * 64 + permk(k0)) * 2) = pk4(acc); }
            { f32x4 acc = {0.f, 0.f, 0.f, 0.f}; acc = mm_tile(MB(9), MP, 16 * tm, MB(0), MP, 16 * tn, 2, acc, lane); acc = mm_tile(MB(10), MP, 16 * tm, MB(5), MP, 16 * tn, 2, acc, lane);
              *(f32x4*)(rec2 + U_YLT + (size_t)((16 * tn + r16) * 64 + 16 * tm + 4 * g) * 4) = acc; }
            { f32x4 acc = {0.f, 0.f, 0.f, 0.f}; acc = mm_tile(MB(6), MP, 16 * tm, MB(0), MP, 16 * tn, 2, acc, lane); acc = mm_tile(MB(7), MP, 16 * tm, MB(5), MP, 16 * tn, 2, acc, lane);
              *(f32x4*)(rec2 + U_QMT + (size_t)((16 * tn + r16) * 64 + 16 * tm + 4 * g) * 4) = acc; }
        }
    }
#undef MB
}

struct ScanOps { bf16x8 pm[4][2]; f32x4 q[4]; };
DI void scanb_load(ScanOps& o, const unsigned char* r1b, const unsigned char* r2b, int cidx, int v, int r16, int g) {
    asm volatile("" : "+s"(cidx));
    const unsigned char* rec1 = r1b + (size_t)cidx * U1_BYTES; const unsigned char* rec2 = r2b + (size_t)cidx * U2_BYTES;
#pragma unroll
    for (int mt = 0; mt < 4; ++mt)
#pragma unroll
        for (int s = 0; s < 2; ++s) o.pm[mt][s] = *(const bf16x8*)(rec1 + U_PMP + (size_t)((16 * mt + r16) * 64 + 32 * s + 8 * g) * 2);
#pragma unroll
    for (int mt = 0; mt < 4; ++mt) o.q[mt] = *(const f32x4*)(rec2 + U_QMT + (size_t)(v * 64 + 16 * mt + 4 * g) * 4);
}
DI void scanb_step(const ScanOps& o, f32x4 (&sT)[4], bf16_t* sct, int v, int g) {
    bf16x8 hi[2], lo[2];
#pragma unroll
    for (int s = 0; s < 2; ++s) { u32x4 hw, lw;
#pragma unroll
        for (int q = 0; q < 2; ++q) { const f32x4 x = sT[2 * s + q]; const unsigned h0 = pk2(x[0], x[1]), h1 = pk2(x[2], x[3]);
            const unsigned l0 = pk2(x[0] - bflo(h0), x[1] - bfhi(h0)), l1 = pk2(x[2] - bflo(h1), x[3] - bfhi(h1));
            if (q == 0) { hw.x = h0; hw.y = h1; lw.x = l0; lw.y = l1; } else { hw.z = h0; hw.w = h1; lw.z = l0; lw.w = l1; } }
        hi[s] = __builtin_bit_cast(bf16x8, hw); lo[s] = __builtin_bit_cast(bf16x8, lw);
        *(u32x4*)(sct + (size_t)v * 64 + 32 * s + 8 * g) = hw; }
#pragma unroll
    for (int mt = 0; mt < 4; ++mt) { f32x4 n = o.q[mt];
#pragma unroll
        for (int s = 0; s < 2; ++s) { n = mfma16(o.pm[mt][s], hi[s], n); n = mfma16(o.pm[mt][s], lo[s], n); }
        sT[mt] = n; }
}
DI void phase_scan_b(Frame& F) {
    if (F.wave >= 4) return;
    const int lane = F.lane, r16 = lane & 15, g = lane >> 4, v = 16 * F.wave + r16;
    for (int bh = F.bid; bh < NB * NH; bh += F.G) {
        const unsigned char* r1 = F.wsp() + WS_SC1 + (size_t)bh * 128 * U1_BYTES; const unsigned char* r2 = F.wsp() + WS_SC2 + (size_t)bh * 128 * U2_BYTES; bf16_t* sct = (bf16_t*)(F.wsp() + WS_SCT) + (size_t)bh * 128 * 4096;
        f32x4 sT[4];
#pragma unroll
        for (int i = 0; i < 4; ++i) sT[i] = (f32x4){0.f, 0.f, 0.f, 0.f};
        ScanOps o0, o1, o2;
        scanb_load(o0, r1, r2, 0, v, r16, g); scanb_load(o1, r1, r2, 1, v, r16, g); scanb_load(o2, r1, r2, 2, v, r16, g);
        for (int c = 0; c < 126; c += 3) {
            const int c5 = (c + 5 < 128) ? c + 5 : 127;
            scanb_step(o0, sT, sct + (size_t)c * 4096, v, g);       scanb_load(o0, r1, r2, c + 3, v, r16, g);
            scanb_step(o1, sT, sct + (size_t)(c + 1) * 4096, v, g); scanb_load(o1, r1, r2, c + 4, v, r16, g);
            scanb_step(o2, sT, sct + (size_t)(c + 2) * 4096, v, g); scanb_load(o2, r1, r2, c5, v, r16, g);
        }
        scanb_step(o0, sT, sct + (size_t)126 * 4096, v, g);
        scanb_step(o1, sT, sct + (size_t)127 * 4096, v, g);
    }
}

DI void phase_scan_c(Frame& F, int l) {
    const bf16_t* SIr = (const bf16_t*)(F.wsp() + WS_SI); const bf16_t* SIk = SIr + 2 * (size_t)T * CW;
    const bf16_t* V = (const bf16_t*)(F.wsp() + (l > 0 ? WS_V1 : WS_VF)); const bf16_t* Gb = (const bf16_t*)(F.wsp() + WS_G); bf16_t* YR = (bf16_t*)(F.wsp() + WS_YR);
    const float* lng = F.inp(17) + l * CW; const float* lnb = F.inp(18) + l * CW; const float* rkp = F.inp(16) + l * CW;
    const int lane = F.lane, r16 = lane & 15, g = lane >> 4;
    for (int item = F.bid * 8 + F.wave; item < NUNIT * 4; item += F.G * 8) {
        const int u = item >> 2, it = item & 3; const int bh = u & 31, c = u >> 5, b = bh >> 3, h = bh & 7;
        const unsigned char* rec1 = F.wsp() + WS_SC1 + (size_t)((bh * 128) + c) * U1_BYTES; const unsigned char* rec2 = F.wsp() + WS_SC2 + (size_t)((bh * 128) + c) * U2_BYTES; const bf16_t* sct = (const bf16_t*)(F.wsp() + WS_SCT) + (size_t)((bh * 128) + c) * 4096;
        const size_t t0 = (size_t)b * SEQ + c * 64 + 16 * it;
        bf16x8 ra[2];
#pragma unroll
        for (int s = 0; s < 2; ++s) ra[s] = *(const bf16x8*)(rec1 + U_RPP + (size_t)((16 * it + r16) * 64 + 32 * s + 8 * g) * 2);
        f32x4 y[4];
#pragma unroll
        for (int vt = 0; vt < 4; ++vt) { y[vt] = *(const f32x4*)(rec2 + U_YLT + (size_t)((16 * vt + r16) * 64 + 16 * it + 4 * g) * 4);
#pragma unroll
            for (int s = 0; s < 2; ++s) { const bf16x8 sb = *(const bf16x8*)(sct + (size_t)(16 * vt + r16) * 64 + 32 * s + 8 * g); y[vt] = mfma16(ra[s], sb, y[vt]); } }
#pragma unroll
        for (int r = 0; r < 4; ++r) {
            const size_t tok = t0 + 4 * g + r; const size_t o = tok * CW + h * 64 + r16;
            float s1 = (y[0][r] + y[1][r]) + (y[2][r] + y[3][r]);
            s1 += dpp_mov<0xB1>(s1); s1 += dpp_mov<0x4E>(s1); s1 += dpp_mov<0x141>(s1); s1 += dpp_mov<0x140>(s1);
            const float mean = s1 * (1.f / 64.f);
            float d[4], s2 = 0.f;
#pragma unroll
            for (int vt = 0; vt < 4; ++vt) { d[vt] = y[vt][r] - mean; s2 += d[vt] * d[vt]; }
            s2 += dpp_mov<0xB1>(s2); s2 += dpp_mov<0x4E>(s2); s2 += dpp_mov<0x141>(s2); s2 += dpp_mov<0x140>(s2);
            const float rstd = 1.0f / sqrtf(s2 * (1.f / 64.f) + 64e-5f);
            float rr[4], kk[4], vv[4], s3 = 0.f;
#pragma unroll
            for (int vt = 0; vt < 4; ++vt) { rr[vt] = bf2f(SIr[o + 16 * vt]); kk[vt] = bf2f(SIk[o + 16 * vt]); vv[vt] = bf2f(V[o + 16 * vt]); s3 += rr[vt] * kk[vt] * rkp[h * 64 + 16 * vt + r16]; }
            s3 += dpp_mov<0xB1>(s3); s3 += dpp_mov<0x4E>(s3); s3 += dpp_mov<0x141>(s3); s3 += dpp_mov<0x140>(s3);
#pragma unroll
            for (int vt = 0; vt < 4; ++vt) { const int cidx = h * 64 + 16 * vt + r16;
                const float yn = d[vt] * rstd * lng[cidx] + lnb[cidx];
                YR[o + 16 * vt] = f2bf((yn + s3 * vv[vt]) * bf2f(Gb[o + 16 * vt])); }
        }
    }
}
DI void phase_moba_prep(Frame& F, int l) {
    bf16_t* MO = (bf16_t*)(F.wsp() + WS_MO); float* KM = (float*)(F.wsp() + WS_TAB + TB_KMEAN);
    const int c = F.tid; const float qg = F.inp(23)[l * 64 + (c & 63)] * 0.125f, kg = F.inp(24)[l * 64 + (c & 63)];
    for (int span = F.bid; span < T / 256; span += F.G) {
        float ksum = 0.f;
        for (int tt = 0; tt < 256; ++tt) {
            const size_t ro = (size_t)(span * 256 + tt) * 1536;
            const float q = bf2f(MO[ro + c]), k = bf2f(MO[ro + 512 + c]);
            const float qs = wave_sum(q * q) * (1.f / 64.f), ks = wave_sum(k * k) * (1.f / 64.f);
            const float qn = q * (1.0f / sqrtf(qs + 1e-6f)) * qg, kn = k * (1.0f / sqrtf(ks + 1e-6f)) * kg;
            MO[ro + c] = f2bf(qn); MO[ro + 512 + c] = f2bf(kn); ksum += kn;
        }
        KM[(size_t)span * CW + c] = ksum * (1.f / 256.f);
    }
}
DI void phase_moba_gate(Frame& F) {
    LAS float* KL = (LAS float*)F.lds;
    const bf16_t* MO = (const bf16_t*)(F.wsp() + WS_MO); const float* KM = (const float*)(F.wsp() + WS_TAB + TB_KMEAN); unsigned* SEL = (unsigned*)(F.wsp() + WS_SEL);
    for (int span = F.bid; span < T / 64; span += F.G) {
        const int t0 = span * 64, b = t0 / SEQ, blk = (t0 % SEQ) / 256;
        __syncthreads();
        for (int idx = F.tid; idx < blk * 512; idx += 512) { const int j = idx >> 9, cc = idx & 511, h = cc >> 6, d = cc & 63;
            KL[h * 2052 + j * 64 + d] = KM[((size_t)(b * 32 + j)) * CW + cc]; }
        __syncthreads();
        const int tok = F.tid >> 3, h = F.tid & 7; const int t = t0 + tok;
        float q[64];
        { const u32x4* qp = (const u32x4*)(MO + (size_t)t * 1536 + h * 64);
#pragma unroll
          for (int i = 0; i < 8; ++i) { const u32x4 w = qp[i]; q[8 * i] = bflo(w.x); q[8 * i + 1] = bfhi(w.x); q[8 * i + 2] = bflo(w.y); q[8 * i + 3] = bfhi(w.y); q[8 * i + 4] = bflo(w.z); q[8 * i + 5] = bfhi(w.z); q[8 * i + 6] = bflo(w.w); q[8 * i + 7] = bfhi(w.w); } }
        float v0 = -INFINITY, v1 = -INFINITY, v2 = -INFINITY; int i0 = 0, i1 = 1, i2 = 2;
        for (int j = 0; j < blk; ++j) {
            const LAS f32x4* kp = (const LAS f32x4*)(KL + h * 2052 + j * 64); float s = 0.f;
#pragma unroll
            for (int i = 0; i < 16; ++i) { const f32x4 kv = kp[i]; s += q[4 * i] * kv.x + q[4 * i + 1] * kv.y + q[4 * i + 2] * kv.z + q[4 * i + 3] * kv.w; }
            if (s > v0) { v2 = v1; i2 = i1; v1 = v0; i1 = i0; v0 = s; i0 = j; }
            else if (s > v1) { v2 = v1; i2 = i1; v1 = s; i1 = j; }
            else if (s > v2) { v2 = s; i2 = j; }
        }
        const int nv = blk < 3 ? blk : 3;
        SEL[(size_t)t * 8 + h] = (unsigned)i0 | ((unsigned)i1 << 8) | ((unsigned)i2 << 16) | ((unsigned)nv << 24);
    }
}

constexpr int KS_PITCH = 144, VT_PITCH = 520;
DI void phase_moba_attn(Frame& F) {
    LAS unsigned char* Ks = F.lds;
    LAS unsigned char* Vt = F.lds + 36864;
    LAS float* LUT = (LAS float*)(F.lds + 36864 + 33280);
    LAS unsigned* LIST = (LAS unsigned*)(F.lds + 36864 + 33280 + 528);
    LAS unsigned* CNT = LIST + 1024;
    const bf16_t* MO = (const bf16_t*)(F.wsp() + WS_MO); const unsigned* SEL = (const unsigned*)(F.wsp() + WS_SEL);
    bf16_t* PO = (bf16_t*)(F.wsp() + WS_PO); f32x2* PST = (f32x2*)(F.wsp() + WS_PST);
    const float* relb = F.inp(25);
    constexpr int UNITS_PER_BH = 144;
    for (int u = F.bid; u < NB * NH * UNITS_PER_BH; u += F.G) {
        const int bh = u & 31, b = bh >> 3, h = bh & 7; int sid = u >> 5;
        int j = 0; { int rem = sid; for (j = 0; j < 32; ++j) { const int ng = (32 - j + 3) >> 2; if (rem < ng) { sid = rem; break; } rem -= ng; } }
        const int g = sid; const int qb0 = j + 4 * g, qb1 = (qb0 + 3 < 31) ? qb0 + 3 : 31; const int nq = (qb1 - qb0 + 1) * 256;
        const size_t tokb = (size_t)b * SEQ;
        __syncthreads();
        for (int id = F.tid; id < 2048; id += 512) { const int row = id >> 3, c8 = id & 7; const size_t ro = (tokb + j * 256 + row) * 1536 + h * 64 + c8 * 8;
            const u32x4 kv = *(const u32x4*)(MO + ro + 512); *(LAS u32x4*)(Ks + row * KS_PITCH + c8 * 16) = kv;
            const u32x4 vv = *(const u32x4*)(MO + ro + 1024); LAS bf16_t* vp = (LAS bf16_t*)(Vt + (c8 * 8) * VT_PITCH + row * 2);
            vp[0 * (VT_PITCH / 2)] = (bf16_t)(vv.x & 0xffff); vp[1 * (VT_PITCH / 2)] = (bf16_t)(vv.x >> 16); vp[2 * (VT_PITCH / 2)] = (bf16_t)(vv.y & 0xffff); vp[3 * (VT_PITCH / 2)] = (bf16_t)(vv.y >> 16);
            vp[4 * (VT_PITCH / 2)] = (bf16_t)(vv.z & 0xffff); vp[5 * (VT_PITCH / 2)] = (bf16_t)(vv.z >> 16); vp[6 * (VT_PITCH / 2)] = (bf16_t)(vv.w & 0xffff); vp[7 * (VT_PITCH / 2)] = (bf16_t)(vv.w >> 16); }
        if (F.tid <= 128) { const int n = F.tid; int bucket;
            if (n < 16) bucket = n; else { int lg = 16 + (int)(logf((float)n / 16.0f) / 2.0794415416798357f * 16.0f); bucket = lg < 31 ? lg : 31; }
            LUT[n] = relb[bucket * 8 + h]; }
        unsigned ent[2]; bool mem[2];
#pragma unroll
        for (int r = 0; r < 2; ++r) { const int qi = r * 512 + F.tid; mem[r] = false; ent[r] = 0;
            if (qi < nq) { const int q = qb0 * 256 + qi; const int qb = q >> 8;
                if (qb == j) { mem[r] = true; ent[r] = (unsigned)q | (3u << 16); }
                else { const unsigned s = SEL[(tokb + q) * 8 + h]; const unsigned nv = s >> 24;
                    if (nv > 0 && (s & 0xff) == (unsigned)j) { mem[r] = true; ent[r] = (unsigned)q; }
                    else if (nv > 1 && ((s >> 8) & 0xff) == (unsigned)j) { mem[r] = true; ent[r] = (unsigned)q | (1u << 16); }
                    else if (nv > 2 && ((s >> 16) & 0xff) == (unsigned)j) { mem[r] = true; ent[r] = (unsigned)q | (2u << 16); } } }
            const unsigned long long bal = __ballot(mem[r]);
            if (F.lane == 0) CNT[r * 8 + F.wave] = (unsigned)__popcll(bal);
            ent[r] |= (unsigned)__popcll(bal & ((1ull << F.lane) - 1ull)) << 20;
        }
        __syncthreads();
        int total = 0;
        { int base0 = 0, base1 = 0;
#pragma unroll
          for (int i = 0; i < 16; ++i) { const int cnt = (int)CNT[i]; if (i < F.wave) base0 += cnt; if (i < 8 + F.wave) base1 += cnt; total += cnt; }
          if (mem[0]) LIST[base0 + (int)(ent[0] >> 20)] = ent[0] & 0xfffffu;
          if (mem[1]) LIST[base1 + (int)(ent[1] >> 20)] = ent[1] & 0xfffffu; }
        __syncthreads();
        const bool need_lut = (qb0 <= j + 1);
        const float bfar = LUT[128];
        const int ntile = (total + 31) >> 5;
        const int qi = F.lane & 31, half = F.lane >> 5;
        for (int tile = F.wave; tile < ntile; tile += 8) {
            const int e = tile * 32 + qi; const bool valid = e < total; const unsigned en = LIST[valid ? e : total - 1];
            const int q = (int)(en & 0xffffu), slot = (int)(en >> 16); const size_t tok = tokb + q;
            bf16x8 qf[4];
#pragma unroll
            for (int kk = 0; kk < 4; ++kk) qf[kk] = *(const bf16x8*)(MO + tok * 1536 + h * 64 + 16 * kk + 8 * half);
            float mrun = -1e30f, lsum = 0.f;
            f32x16 oacc[2];
#pragma unroll
            for (int i = 0; i < 16; ++i) { oacc[0][i] = 0.f; oacc[1][i] = 0.f; }
            const int qrel = q - j * 256;
#pragma unroll 1
            for (int ck = 0; ck < 4; ++ck) {
                f32x16 sacc[2];
#pragma unroll
                for (int k2 = 0; k2 < 2; ++k2) { const int kt = 2 * ck + k2;
#pragma unroll
                    for (int i = 0; i < 16; ++i) sacc[k2][i] = 0.f;
#pragma unroll
                    for (int kk = 0; kk < 4; ++kk) { const bf16x8 ka = *(const LAS bf16x8*)(Ks + (32 * kt + qi) * KS_PITCH + (16 * kk + 8 * half) * 2);
                        sacc[k2] = __builtin_amdgcn_mfma_f32_32x32x16_bf16(ka, qf[kk], sacc[k2], 0, 0, 0); } }
                float mx = -1e30f;
                if (need_lut) {
#pragma unroll
                    for (int k2 = 0; k2 < 2; ++k2)
#pragma unroll
                        for (int i = 0; i < 16; ++i) { const int key = 32 * (2 * ck + k2) + (i & 3) + 8 * (i >> 2) + 4 * half; const int n = qrel - key;
                            const float bias = LUT[n < 0 ? 0 : (n > 128 ? 128 : n)];
                            const float s = (n < 0) ? -1e30f : sacc[k2][i] + bias; sacc[k2][i] = s; mx = fmaxf(mx, s); }
                } else {
#pragma unroll
                    for (int k2 = 0; k2 < 2; ++k2)
#pragma unroll
                        for (int i = 0; i < 16; ++i) { const float s = sacc[k2][i] + bfar; sacc[k2][i] = s; mx = fmaxf(mx, s); }
                }
                mx = fmaxf(mx, __shfl_xor(mx, 32));
                const float mnew = fmaxf(mrun, mx); const float alpha = __expf(mrun - mnew); mrun = mnew;
                lsum *= alpha;
#pragma unroll
                for (int i = 0; i < 16; ++i) { oacc[0][i] *= alpha; oacc[1][i] *= alpha; }
#pragma unroll
                for (int k2 = 0; k2 < 2; ++k2) { const int kt = 2 * ck + k2;
#pragma unroll
                    for (int i = 0; i < 16; ++i) { const float p = __expf(sacc[k2][i] - mnew); sacc[k2][i] = p; lsum += p; }
#pragma unroll
                    for (int cc = 0; cc < 2; ++cc) {
                        u32x4 pw; pw.x = pk2(sacc[k2][8 * cc], sacc[k2][8 * cc + 1]); pw.y = pk2(sacc[k2][8 * cc + 2], sacc[k2][8 * cc + 3]); pw.z = pk2(sacc[k2][8 * cc + 4], sacc[k2][8 * cc + 5]); pw.w = pk2(sacc[k2][8 * cc + 6], sacc[k2][8 * cc + 7]);
                        const bf16x8 pf = __builtin_bit_cast(bf16x8, pw);
                        const int key0 = 32 * kt + 16 * cc + 4 * half;
#pragma unroll
                        for (int dt = 0; dt < 2; ++dt) { const LAS unsigned char* vb = Vt + (32 * dt + qi) * VT_PITCH + key0 * 2;
                            const u32x2 va = *(const LAS u32x2*)vb, vb2 = *(const LAS u32x2*)(vb + 16);
                            u32x4 vw; vw.x = va.x; vw.y = va.y; vw.z = vb2.x; vw.w = vb2.y;
                            oacc[dt] = __builtin_amdgcn_mfma_f32_32x32x16_bf16(__builtin_bit_cast(bf16x8, vw), pf, oacc[dt], 0, 0, 0); } } }
            }
            const float mx = mrun;
            lsum += __shfl_xor(lsum, 32);
            const float inv = 1.0f / lsum;
            if (valid) {
                bf16_t* op = PO + ((size_t)slot * T + tok) * CW + h * 64;
#pragma unroll
                for (int dt = 0; dt < 2; ++dt)
#pragma unroll
                    for (int ig = 0; ig < 4; ++ig) { u32x2 w; w.x = pk2(oacc[dt][4 * ig] * inv, oacc[dt][4 * ig + 1] * inv); w.y = pk2(oacc[dt][4 * ig + 2] * inv, oacc[dt][4 * ig + 3] * inv);
                        *(u32x2*)(op + 32 * dt + 8 * ig + 4 * half) = w; }
                if (half == 0) PST[((size_t)slot * T + tok) * 8 + h] = (f32x2){mx, lsum};
            }
        }
    }
}
DI void phase_moba_combine(Frame& F) {
    const bf16_t* PO = (const bf16_t*)(F.wsp() + WS_PO); const f32x2* PST = (const f32x2*)(F.wsp() + WS_PST); const unsigned* SEL = (const unsigned*)(F.wsp() + WS_SEL);
    bf16_t* YM = (bf16_t*)(F.wsp() + WS_YM);
    const int c = F.tid, h = c >> 6;
    for (int t = F.bid; t < T; t += F.G) {
        const int nv = (int)(SEL[(size_t)t * 8 + h] >> 24);
        float m[4], lw[4]; float M = -1e30f;
#pragma unroll
        for (int s = 0; s < 4; ++s) { const bool on = (s == 3) || (s < nv); if (on) { const f32x2 st = PST[((size_t)s * T + t) * 8 + h]; m[s] = st.x; lw[s] = st.y; M = fmaxf(M, st.x); } else { m[s] = -1e30f; lw[s] = 0.f; } }
        float den = 0.f, num = 0.f;
#pragma unroll
        for (int s = 0; s < 4; ++s) { const bool on = (s == 3) || (s < nv); if (on) { const float w = lw[s] * __expf(m[s] - M); den += w; num += w * bf2f(PO[((size_t)s * T + t) * CW + c]); } }
        YM[(size_t)t * CW + c] = f2bf(num / den);
    }
}
DI void phase_router(Frame& F, int l) {
    LAS float* xs = (LAS float*)F.lds;
    LAS float* wsm = xs + 64 * 129;
    LAS float* lgt = wsm + 128 * 36;
    LAS float* ssq = lgt + 64 * 37;
    LAS int* hist = (LAS int*)(ssq + 64);
    const float* x = F.outp(); const float* gain = F.inp(2) + (size_t)l * DM;
    const float* wgrp = F.inp(29) + (size_t)l * DM * 4; const float* wexp = F.inp(31) + (size_t)l * DM * 32;
    const float* bgrp = F.inp(30) + l * 4; const float* bexp = F.inp(32) + l * 32;
    int* EID = (int*)(F.wsp() + WS_RT + RT_EID); float* GATE = (float*)(F.wsp() + WS_RT + RT_GATE); int* HIST = (int*)(F.wsp() + WS_RT + RT_HIST);
    const int tok = F.tid & 63, jg = F.tid >> 6;
    for (int tile = F.bid; tile < T / 64; tile += F.G) {
        const int t0 = tile * 64;
        float acc[5] = {0.f, 0.f, 0.f, 0.f, 0.f}; float ss = 0.f;
        if (F.tid < 32) hist[F.tid] = 0;
        for (int kc = 0; kc < DM; kc += 128) {
            __syncthreads();
            for (int idx = F.tid; idx < 64 * 128; idx += 512) { const int r = idx >> 7, k = idx & 127; xs[r * 129 + k] = x[(size_t)(t0 + r) * DM + kc + k]; }
            for (int idx = F.tid; idx < 128 * 36; idx += 512) { const int k = idx / 36, j = idx - k * 36; const float g = gain[kc + k];
                wsm[idx] = g * (j < 4 ? wgrp[(size_t)(kc + k) * 4 + j] : wexp[(size_t)(kc + k) * 32 + (j - 4)]); }
            __syncthreads();
            for (int k = 0; k < 128; ++k) { const float xv = xs[tok * 129 + k]; ss += xv * xv;
#pragma unroll
                for (int i = 0; i < 5; ++i) { const int j = jg + 8 * i; if (j < 36) acc[i] += xv * wsm[k * 36 + j]; } }
        }
#pragma unroll
        for (int i = 0; i < 5; ++i) { const int j = jg + 8 * i; if (j < 36) lgt[tok * 37 + j] = acc[i]; }
        if (jg == 0) ssq[tok] = ss;
        __syncthreads();
        if (F.tid < 64) {
            const int t = t0 + F.tid; const float rs = 1.0f / sqrtf(ssq[F.tid] * (1.f / DM) + 1e-6f);
            float lg[4]; int gs = 0; float gm = -INFINITY;
#pragma unroll
            for (int g = 0; g < 4; ++g) { lg[g] = lgt[F.tid * 37 + g] * rs + bgrp[g]; if (lg[g] > gm) { gm = lg[g]; gs = g; } }
            float gden = 0.f;
#pragma unroll
            for (int g = 0; g < 4; ++g) gden += expf(lg[g] - gm);
            const float ptop = 1.0f / gden;
            float le[8]; float e0 = -INFINITY, e1 = -INFINITY; int j0 = 0, j1 = 1;
#pragma unroll
            for (int e = 0; e < 8; ++e) { le[e] = lgt[F.tid * 37 + 4 + gs * 8 + e] * rs + bexp[gs * 8 + e];
                if (le[e] > e0) { e1 = e0; j1 = j0; e0 = le[e]; j0 = e; } else if (le[e] > e1) { e1 = le[e]; j1 = e; } }
            const float p1 = expf(e1 - e0);
            const float g0 = ptop / (1.f + p1), g1 = ptop * p1 / (1.f + p1);
            const int ex0 = gs * 8 + j0, ex1 = gs * 8 + j1;
            EID[t * 2] = ex0; EID[t * 2 + 1] = ex1; GATE[t * 2] = g0; GATE[t * 2 + 1] = g1;
            __hip_atomic_fetch_add(&hist[ex0], 1, __ATOMIC_RELAXED, __HIP_MEMORY_SCOPE_WORKGROUP); __hip_atomic_fetch_add(&hist[ex1], 1, __ATOMIC_RELAXED, __HIP_MEMORY_SCOPE_WORKGROUP);
        }
        __syncthreads();
        if (F.tid < 32) HIST[tile * 32 + F.tid] = hist[F.tid];
        __syncthreads();
    }
}
DI void phase_moe_gather(Frame& F, int l) {
    LAS int* tot = (LAS int*)F.lds; LAS int* off = tot + 32; LAS int* base = off + 32; LAS int* eidl = base + 32; LAS int* rowl = eidl + 128; LAS int* ps = rowl + 128; LAS int* po = ps + 512;
    const float* x = F.outp(); const float* gain = F.inp(2) + (size_t)l * DM;
    const int* EID = (const int*)(F.wsp() + WS_RT + RT_EID); const float* GATE = (const float*)(F.wsp() + WS_RT + RT_GATE); const int* HIST = (const int*)(F.wsp() + WS_RT + RT_HIST);
    int* ROW = (int*)(F.wsp() + WS_RT + RT_ROW); float* GW = (float*)(F.wsp() + WS_RT + RT_GW); int* PEXP = (int*)(F.wsp() + WS_RT + RT_PEXP);
    bf16_t* AM = (bf16_t*)(F.wsp() + WS_AM);
    for (int tile = F.bid; tile < T / 64; tile += F.G) {
        const int t0 = tile * 64;
        __syncthreads();
        { const int e = F.tid & 31, part = F.tid >> 5; int s = 0, o = 0;
          for (int i = part * 32; i < part * 32 + 32; ++i) { const int v = HIST[i * 32 + e]; s += v; if (i < tile) o += v; }
          ps[F.tid] = s; po[F.tid] = o; }
        if (F.tid < 128) eidl[F.tid] = EID[t0 * 2 + F.tid];
        __syncthreads();
        if (F.tid < 32) { int s = 0, o = 0;
#pragma unroll
            for (int p = 0; p < 16; ++p) { s += ps[p * 32 + F.tid]; o += po[p * 32 + F.tid]; } tot[F.tid] = s; off[F.tid] = o; }
        __syncthreads();
        if (F.tid == 0) {
            int bs = 0; for (int e = 0; e < 32; ++e) { base[e] = bs; bs += (tot[e] + 255) & ~255; }
            if (tile == 0) { int p = 0; for (int e = 0; e < 32; ++e) { const int np = (tot[e] + 255) >> 8; for (int i = 0; i < np; ++i) PEXP[p++] = e; } PEXP[MOE_PANELS] = p; }
        }
        __syncthreads();
        if (F.tid < 128) { const int my = eidl[F.tid]; int rank = 0; for (int i = 0; i < F.tid; ++i) rank += (eidl[i] == my) ? 1 : 0;
            const int r = base[my] + off[my] + rank; rowl[F.tid] = r; ROW[t0 * 2 + F.tid] = r; GW[r] = GATE[t0 * 2 + F.tid]; }
        __syncthreads();
        for (int tk = F.wave; tk < 64; tk += 8) { const int t = t0 + tk;
            rms_row_to_bf16(x + (size_t)t * DM, gain, AM + (size_t)rowl[tk * 2] * DM, AM + (size_t)rowl[tk * 2 + 1] * DM, F.lane); }
    }
}
DI void phase_moe_combine(Frame& F, int l) {
    const bf16_t* YE = (const bf16_t*)(F.wsp() + WS_YE); const int* ROW = (const int*)(F.wsp() + WS_RT + RT_ROW); bf16_t* XN = (bf16_t*)(F.wsp() + WS_XN);
    const float* gain = F.inp(1) + (size_t)(l + 1 < NLAYER ? l + 1 : l) * DM;
    const int gw = F.bid * 8 + F.wave, NGW = F.G * 8;
    for (int t = gw; t < T; t += NGW) {
        const int r0 = ROW[t * 2], r1 = ROW[t * 2 + 1];
        f32x4* xr = (f32x4*)(F.outp() + (size_t)t * DM) + F.lane; const u32x2* y0 = (const u32x2*)(YE + (size_t)r0 * DM) + F.lane; const u32x2* y1 = (const u32x2*)(YE + (size_t)r1 * DM) + F.lane;
        f32x4 v[4]; float s = 0.f;
#pragma unroll
        for (int j = 0; j < 4; ++j) { const u32x2 a = y0[64 * j], b = y1[64 * j]; f32x4 xv = xr[64 * j];
            xv.x += bflo(a.x) + bflo(b.x); xv.y += bfhi(a.x) + bfhi(b.x); xv.z += bflo(a.y) + bflo(b.y); xv.w += bfhi(a.y) + bfhi(b.y);
            v[j] = xv; xr[64 * j] = xv; s += (xv.x * xv.x + xv.y * xv.y) + (xv.z * xv.z + xv.w * xv.w); }
        if (l + 1 < NLAYER) {
            const float rs = 1.0f / sqrtf(wave_sum(s) * (1.f / DM) + 1e-6f);
#pragma unroll
            for (int j = 0; j < 4; ++j) { const f32x4 g = ((const f32x4*)gain)[F.lane + 64 * j]; const f32x4 y = v[j] * rs * g; u32x2 w; w.x = pk2(y.x, y.y); w.y = pk2(y.z, y.w); *((u32x2*)(XN + (size_t)t * DM) + F.lane + 64 * j) = w; }
        }
    }
}
#ifndef MK_PER_PHASE_LAUNCH
#define MK_PER_PHASE_LAUNCH 0
#endif
constexpr int PH_PER_LAYER = 19, NPHASE = PH_PER_LAYER * NLAYER;
struct Args { const float* in[36]; float* out; unsigned char* ws; int ph_lo, ph_hi; };

#ifndef SCAN_NAIVE
#define SCAN_NAIVE 0
#endif
#ifndef PHMASK
#define PHMASK 0x7ffff
#endif
#ifndef DUPMASK
#define DUPMASK 0
#endif
#define NREP(k) ((((DUPMASK) >> (k)) & 1) ? 2 : 1)
#define IN(k) (((PHMASK >> ((k) % PH_PER_LAYER)) & 1) && lo <= (k) && (k) < hi)
#define SEAM(k) do { asm volatile("" : "+s"(barp), "+s"(bar.x)); bar.bar = (unsigned*)barp; if (IN(k) && IN((k) + 1)) xcd_barrier(bar); asm volatile("" : "+s"(F.ws_g), "+s"(F.out_g), "+s"(F.ka), "+s"(F.bid), "+s"(F.G), "+s"(F.lds)); } while (0)
#define FRESH() do { asm volatile("" : "+s"(F.wave)); int l_ = (int)__builtin_amdgcn_mbcnt_hi(~0u, __builtin_amdgcn_mbcnt_lo(~0u, 0u)); asm volatile("" : "+v"(l_)); F.lane = l_; F.tid = F.wave * 64 + l_; } while (0)
__global__ void __launch_bounds__(512, 2) fwd_kernel(Args args) {
    extern __shared__ __attribute__((aligned(16))) unsigned char lds_raw[];
    Frame F;
    F.lds = (LAS unsigned char*)lds_raw;
    F.tid = threadIdx.x; F.lane = F.tid & 63; F.wave = __builtin_amdgcn_readfirstlane(F.tid >> 6);
    F.G = gridDim.x; F.bid = blockIdx.x;
    F.ka = (const __attribute__((address_space(4))) unsigned char*)__builtin_amdgcn_kernarg_segment_ptr();
    F.out_g = (GAS float*)args.out; F.ws_g = (GAS unsigned char*)args.ws;
    volatile LAS unsigned* MISC = (volatile LAS unsigned*)(F.lds + MISC_OFF);
    if (F.tid < 32) MISC[F.tid] = 0u;
    __syncthreads();
    const int lo = args.ph_lo, hi = args.ph_hi;
    GAS unsigned* barp = (GAS unsigned*)(F.ws_g + WS_CTL) + CW_BAR;
    XcdBarrier bar; bar.bar = (unsigned*)barp; bar.x = 0; bar.st = nullptr;
    if (hi - lo > 1) bar = xcd_barrier_post((unsigned*)barp, MISC + 8);

    bf16_t* const XN = (bf16_t*)(F.wsp() + WS_XN);
    bf16_t* const WCAT = (bf16_t*)(F.wsp() + WS_WM + WM_WCAT);
    for (int l = 0; l < NLAYER; ++l) {
        const int P = l * PH_PER_LAYER;
#define PHASE(k) if (IN(P + (k))) for (int rep_ = 0; rep_ < NREP(k); ++rep_)
        PHASE(0) { FRESH(); if (l == 0) { phase_conv_mixer(F, 0); phase_norm_x(F, F.inp(0), F.inp(1)); } }
        SEAM(P + 0);
        PHASE(1) { FRESH(); pg8::Gemm g{XN, WCAT, T, 2304, DM}; pg8::StaticOrder S; S.init(T, 2304, F.G, F.bid);
            pg8::EpiStore E{(bf16_t*)(F.wsp() + WS_RW), 1536, 1536, (bf16_t*)(F.wsp() + WS_LO), LO_W, 0};
            pg8::gemm_phase<pg8::EpiStore, pg8::StaticOrder>(F.lds, g, S, E, F.tid); }
        SEAM(P + 1);
        PHASE(2) { FRESH(); phase_rwkv_prep(F, l); }
        SEAM(P + 2);
#if SCAN_NAIVE
        PHASE(3) { FRESH(); phase_rwkv_scan_naive(F, l); }
        SEAM(P + 3);
        SEAM(P + 4);
        PHASE(5) { FRESH(); phase_rwkv_post(F, l); }
        SEAM(P + 5);
#else
        PHASE(3) { FRESH(); phase_scan_a(F, l); }
        SEAM(P + 3);
        PHASE(4) { FRESH(); phase_scan_b(F); }
        SEAM(P + 4);
        PHASE(5) { FRESH(); phase_scan_c(F, l); }
        SEAM(P + 5);
#endif
        PHASE(6) { FRESH(); pg8::Gemm g{XN, WCAT + (size_t)2304 * DM, T, 1536, DM}; pg8::StaticOrder S; S.init(T, 1536, F.G, F.bid);
            pg8::EpiStore E{(bf16_t*)(F.wsp() + WS_MO), 1536, 0, nullptr, 0, 0};
            pg8::gemm_phase<pg8::EpiStore, pg8::StaticOrder>(F.lds, g, S, E, F.tid); }
        SEAM(P + 6);
        PHASE(7) { FRESH(); phase_moba_prep(F, l); }
        SEAM(P + 7);
        PHASE(8) { FRESH(); phase_moba_gate(F); }
        SEAM(P + 8);
        PHASE(9) { FRESH(); phase_moba_attn(F); }
        SEAM(P + 9);
        PHASE(10) { FRESH(); phase_moba_combine(F); }
        SEAM(P + 10);
        PHASE(11) { FRESH(); pg8::Gemm g{XN, WCAT + (size_t)3840 * DM, T, 2048, DM}; pg8::StaticOrder S; S.init(T, 2048, F.G, F.bid);
            pg8::EpiStore E{(bf16_t*)(F.wsp() + WS_GA), 2048, 0, nullptr, 0, 1};
            pg8::gemm_phase<pg8::EpiStore, pg8::StaticOrder>(F.lds, g, S, E, F.tid); }
        SEAM(P + 11);
        PHASE(12) { FRESH();
            { pg8::Gemm g{(const bf16_t*)(F.wsp() + WS_YR), (const bf16_t*)(F.wsp() + WS_WM + WM_BRR), T, DM, CW}; pg8::StaticOrder S; S.init(T, DM, F.G, F.bid);
              pg8::EpiBranch E{(bf16_t*)(F.wsp() + WS_H), (const bf16_t*)(F.wsp() + WS_GA), 0, 1};
              pg8::gemm_phase<pg8::EpiBranch, pg8::StaticOrder>(F.lds, g, S, E, F.tid); }
            asm volatile("s_waitcnt vmcnt(0)" ::: "memory"); __syncthreads();
            { pg8::Gemm g{(const bf16_t*)(F.wsp() + WS_YM), (const bf16_t*)(F.wsp() + WS_WM + WM_BRM), T, DM, CW}; pg8::StaticOrder S; S.init(T, DM, F.G, F.bid);
              pg8::EpiBranch E{(bf16_t*)(F.wsp() + WS_H), (const bf16_t*)(F.wsp() + WS_GA), 1024, 0};
              pg8::gemm_phase<pg8::EpiBranch, pg8::StaticOrder>(F.lds, g, S, E, F.tid); }
        }
        SEAM(P + 12);
        PHASE(13) { FRESH(); pg8::Gemm g{(const bf16_t*)(F.wsp() + WS_H), (const bf16_t*)(F.wsp() + WS_WM + WM_OUT), T, DM, DM}; pg8::StaticOrder S; S.init(T, DM, F.G, F.bid);
            pg8::EpiResid E{l == 0 ? F.inp(0) : F.outp(), F.outp()};
            pg8::gemm_phase<pg8::EpiResid, pg8::StaticOrder>(F.lds, g, S, E, F.tid); }
        SEAM(P + 13);
        PHASE(14) { FRESH(); phase_router(F, l); phase_conv_experts(F, l); }
        SEAM(P + 14);
        PHASE(15) { FRESH(); phase_moe_gather(F, l); }
        SEAM(P + 15);
        PHASE(16) { FRESH(); const int* PEXP = (const int*)(F.wsp() + WS_RT + RT_PEXP); const int np = __builtin_amdgcn_readfirstlane(PEXP[MOE_PANELS]);
            pg8::Gemm g{(const bf16_t*)(F.wsp() + WS_AM), (const bf16_t*)(F.wsp() + WS_WE), np * 256, 1024, DM}; pg8::GroupOrder S; S.init(np * 256, 1024, F.G, F.bid); S.pexp = PEXP;
            pg8::EpiExpertUp E{(bf16_t*)(F.wsp() + WS_HM), (const float*)(F.wsp() + WS_RT + RT_GW)};
            pg8::gemm_phase<pg8::EpiExpertUp, pg8::GroupOrder>(F.lds, g, S, E, F.tid); }
        SEAM(P + 16);
        PHASE(17) { FRESH(); const int* PEXP = (const int*)(F.wsp() + WS_RT + RT_PEXP); const int np = __builtin_amdgcn_readfirstlane(PEXP[MOE_PANELS]);
            pg8::Gemm g{(const bf16_t*)(F.wsp() + WS_HM), (const bf16_t*)(F.wsp() + WS_WD), np * 256, 1024, DEXP}; pg8::GroupOrder S; S.init(np * 256, 1024, F.G, F.bid); S.pexp = PEXP;
            pg8::EpiStore E{(bf16_t*)(F.wsp() + WS_YE), 1024, 0, nullptr, 0, 0};
            pg8::gemm_phase<pg8::EpiStore, pg8::GroupOrder>(F.lds, g, S, E, F.tid); }
        SEAM(P + 17);
        PHASE(18) { FRESH(); phase_moe_combine(F, l); if (l + 1 < NLAYER) phase_conv_mixer(F, l + 1); }
        SEAM(P + 18);
#undef PHASE
    }
}

extern "C" void kernel_launch(void* const* d_in, const int* in_sizes, int n_in, void* d_out, int out_size, void* d_ws, size_t ws_size, hipStream_t stream) {
    static int grid = 0;
    if (grid == 0) {
        if (n_in != 36 || out_size != T * DM || ws_size < WS_NEED) { fprintf(stderr, "kernel_launch: unexpected problem (n_in %d, out %d, ws %zu); nothing launched\n", n_in, out_size, ws_size); grid = -1; return; }
        int dev = 0, cus = 0;
        if (hipGetDevice(&dev) != hipSuccess || hipDeviceGetAttribute(&cus, hipDeviceAttributeMultiprocessorCount, dev) != hipSuccess) { grid = -1; return; }
        if (hipFuncSetAttribute((const void*)fwd_kernel, hipFuncAttributeMaxDynamicSharedMemorySize, LDS_BYTES) != hipSuccess) { fprintf(stderr, "kernel_launch: hipFuncSetAttribute failed\n"); grid = -1; return; }
        int per_cu = 0;
        if (hipOccupancyMaxActiveBlocksPerMultiprocessor(&per_cu, (const void*)fwd_kernel, 512, LDS_BYTES) != hipSuccess || per_cu < 1) { fprintf(stderr, "kernel_launch: occupancy query says %d\n", per_cu); }
        (void)hipGetLastError();
        grid = cus;
    }
    if (grid < 0) return;
    (void)hipMemsetAsync((char*)d_ws + WS_CTL, 0, CTL_ZERO_BYTES, stream);
    Args a{};
    for (int i = 0; i < 36; ++i) a.in[i] = (const float*)d_in[i];
    a.out = (float*)d_out; a.ws = (unsigned char*)d_ws;
#if MK_PER_PHASE_LAUNCH
    for (int ph = 0; ph < NPHASE; ++ph) { if (ph == PH_PER_LAYER) continue; a.ph_lo = ph; a.ph_hi = ph + 1; hipLaunchKernelGGL(fwd_kernel, dim3(grid), dim3(512), LDS_BYTES, stream, a); }
#else
    a.ph_lo = 0; a.ph_hi = NPHASE;
    hipLaunchKernelGGL(fwd_kernel, dim3(grid), dim3(512), LDS_BYTES, stream, a);
#endif
}
```

```cpp
#include <hip/hip_runtime.h>
#include <cstdio>
#include <cstdint>
#define LAS __attribute__((address_space(3)))
#define GAS __attribute__((address_space(1)))
#define DI __device__ __forceinline__
typedef unsigned short bf16_t;
typedef short bf16x8 __attribute__((ext_vector_type(8)));
typedef short s16x4 __attribute__((ext_vector_type(4)));
typedef float f32x4 __attribute__((ext_vector_type(4)));
typedef float f32x2 __attribute__((ext_vector_type(2)));
typedef float f32x16 __attribute__((ext_vector_type(16)));
typedef unsigned u32x4 __attribute__((ext_vector_type(4)));
typedef unsigned u32x2 __attribute__((ext_vector_type(2)));
typedef __bf16 bf16v2 __attribute__((ext_vector_type(2)));

DI unsigned pk2(float lo, float hi) { f32x2 v = {lo, hi}; return __builtin_bit_cast(unsigned, __builtin_convertvector(v, bf16v2)); }
DI bf16_t f2bf(float f) { return (bf16_t)(pk2(f, 0.f) & 0xffffu); }
DI float bf2f(bf16_t b) { return __uint_as_float(((unsigned)b) << 16); }
DI float bflo(unsigned w) { return __uint_as_float(w << 16); }
DI float bfhi(unsigned w) { return __uint_as_float(w & 0xffff0000u); }
DI float sigmoidf_(float x) { return 1.0f / (1.0f + __expf(-x)); }

template <int CTRL> DI float dpp_mov(float v) { return __builtin_bit_cast(float, __builtin_amdgcn_update_dpp(0, __builtin_bit_cast(int, v), CTRL, 0xf, 0xf, true)); }
DI float rdlane(float v, int l) { return __builtin_bit_cast(float, __builtin_amdgcn_readlane(__builtin_bit_cast(int, v), l)); }
DI float wave_sum(float v) {
    v += dpp_mov<0xB1>(v);
    v += dpp_mov<0x4E>(v);
    v += dpp_mov<0x141>(v);
    v += dpp_mov<0x140>(v);
    return (rdlane(v, 0) + rdlane(v, 16)) + (rdlane(v, 32) + rdlane(v, 48));
}
DI f32x4 mfma16(bf16x8 a, bf16x8 b, f32x4 c) { return __builtin_amdgcn_mfma_f32_16x16x32_bf16(a, b, c, 0, 0, 0); }
namespace pg8 {
constexpr int BM = 256, BK = 64, HALF = 128, HTB = HALF * BK * 2  , STAGE_BYTES = 8 * HTB, NXCD = 8, WGM = 8;

__host__ __device__ __forceinline__ int lds_byte(int r, int c) { const int st = (r >> 4) * 2 + (c >> 5), rr = r & 15, cc = c & 31, ob = rr * 64 + cc * 2; return st * 1024 + (ob ^ (((ob >> 9) & 1) << 5)); }
__host__ __device__ __forceinline__ void stage_rc(int b, int& R, int& C) { const int st = b / 1024, sb = b % 1024, swz = sb ^ (((sb >> 9) & 1) << 5); R = (st >> 1) * 16 + swz / 64; C = (st & 1) * 32 + (swz % 64) / 2; }
__host__ __device__ __forceinline__ int perm32(int rho) { const int n = rho >> 4, i = rho & 15; return 8 * (i >> 2) + 4 * n + (i & 3); }

struct Unit { int pm, pn, pb; };
struct Gemm { const bf16_t* A; const bf16_t* Bt; int M, N, K; };

struct StaticOrder {
    int nM, nN, nwg, G, c;
    __device__ __forceinline__ void init(int M, int N, int G_, int c_) { nM = M / BM; nN = N / BM; nwg = nM * nN; G = G_; c = c_; }
    __device__ __forceinline__ bool next(int i, Unit& u) const {
        const long L = (long)i * G + c; if (L >= nwg) return false;
        int wgid = (int)L; { const int q = nwg / NXCD, r = nwg % NXCD, xcd = wgid % NXCD, off = wgid / NXCD; wgid = (xcd < r ? xcd * (q + 1) : r * (q + 1) + (xcd - r) * q) + off; }
        const int nig = WGM * nN, gid = wgid / nig, fm = gid * WGM, gsz = (nM - fm) < WGM ? (nM - fm) : WGM;
        u.pm = fm + ((wgid % nig) % gsz); u.pn = (wgid % nig) / gsz; u.pb = u.pn; return true;
    }
};
struct GroupOrder : StaticOrder {
    const int* pexp;
    __device__ __forceinline__ bool next(int i, Unit& u) const {
        if (!StaticOrder::next(i, u)) return false;
        u.pb = __builtin_amdgcn_readfirstlane(pexp[u.pm]) * nN + u.pn; return true;
    }
};

template <class Epi, class Sched, bool ALIGN_EPI = true, bool SP2 = true>
__device__ __forceinline__ void gemm_phase(LAS unsigned char* lds, const Gemm g, const Sched& S, const Epi& E, int tid_in) {
    const int tid = tid_in, wid = __builtin_amdgcn_readfirstlane(tid >> 6), lane = tid & 63, wr = wid >> 2, wc = wid & 3, fr = lane & 15, fq = lane >> 4;
    const int K = g.K, nt = K / BK;
    unsigned voffA[2], voffB[2];
#pragma unroll
    for (int i = 0; i < 2; ++i) { int R, C; stage_rc(tid * 16 + i * 8192, R, C); const int Rb = Epi::PERM ? ((R & ~31) + perm32(R & 31)) : R;
        voffA[i] = (unsigned)(R * K + C) * 2u; voffB[i] = (unsigned)(Rb * K + C) * 2u; }
    const size_t kstep = (size_t)(BK * 2);
    const size_t hstep = (size_t)HALF * K * 2;
    const size_t tstep = 2 * hstep;
    const unsigned ldsw = (unsigned)wid * 1024u;
    const int aoff = lds_byte(wr * 64 + fr, fq * 8), boff = lds_byte(wc * 32 + fr, fq * 8);
#define PG8_SA(b, h) (((b) * 2 + (h)) * HTB)
#define PG8_SB(b, h) ((4 + (b) * 2 + (h)) * HTB)
#define PG8_STAGE(bufoff, gbase, voff) do { _Pragma("unroll") for (int _i = 0; _i < 2; ++_i) \
        __builtin_amdgcn_global_load_lds((const unsigned*)((const char*)(gbase) + (voff)[_i]), (LAS unsigned*)(lds + (bufoff) + ldsw + _i * 8192), 16, 0, 0); } while (0)
#define PG8_LDA(dst, b, h) do { _Pragma("unroll") for (int m = 0; m < 4; ++m) _Pragma("unroll") for (int k = 0; k < 2; ++k) dst[m][k] = *(const LAS bf16x8*)(lds + PG8_SA(b, h) + aoff + m * 2048 + k * 1024); } while (0)
#define PG8_LDB(dst, b, h) do { _Pragma("unroll") for (int n = 0; n < 2; ++n) _Pragma("unroll") for (int k = 0; k < 2; ++k) dst[n][k] = *(const LAS bf16x8*)(lds + PG8_SB(b, h) + boff + n * 2048 + k * 1024); } while (0)
#define PG8_MMA(ai, bj, At, Bt) do { __builtin_amdgcn_s_setprio(1); _Pragma("unroll") for (int m = 0; m < 4; ++m) _Pragma("unroll") for (int n = 0; n < 2; ++n) _Pragma("unroll") for (int k = 0; k < 2; ++k) \
        acc[ai][bj][m][n] = __builtin_amdgcn_mfma_f32_16x16x32_bf16(Bt[n][k], At[m][k], acc[ai][bj][m][n], 0, 0, 0); __builtin_amdgcn_s_setprio(0); } while (0)
#define PG8_WAIT_V(n) asm volatile("s_waitcnt vmcnt(" #n ")" ::: "memory")
#define PG8_WAIT_L(n) asm volatile("s_waitcnt lgkmcnt(" #n ")" ::: "memory")
#define PG8_BAR __builtin_amdgcn_s_barrier()
#define PG8_SCHED __builtin_amdgcn_sched_barrier(0)
    Unit cur, nxt; int ui = 0;
    if (!S.next(0, cur)) return;
    f32x4 acc[2][2][4][2];
#pragma unroll
    for (int a = 0; a < 2; ++a)
#pragma unroll
        for (int b = 0; b < 2; ++b)
#pragma unroll
            for (int m = 0; m < 4; ++m)
#pragma unroll
                for (int n = 0; n < 2; ++n) acc[a][b][m][n] = (f32x4){0.f, 0.f, 0.f, 0.f};
    bf16x8 At[4][2], B0[2][2], B1[2][2];
    const char* cA = (const char*)g.A + (size_t)cur.pm * tstep; const char* cB = (const char*)g.Bt + (size_t)cur.pb * tstep;
    if constexpr (SP2) {
        PG8_STAGE(PG8_SB(0, 0), cB, voffB); PG8_STAGE(PG8_SB(0, 1), cB + hstep, voffB); PG8_STAGE(PG8_SA(0, 0), cA, voffA); PG8_STAGE(PG8_SA(0, 1), cA + hstep, voffA);
        if (wr == 1) PG8_BAR;
        PG8_WAIT_V(2); PG8_BAR;
        PG8_STAGE(PG8_SB(1, 0), cB + kstep, voffB); PG8_STAGE(PG8_SA(1, 0), cA + kstep, voffA); PG8_STAGE(PG8_SB(1, 1), cB + hstep + kstep, voffB);
        PG8_WAIT_V(6); PG8_BAR;
    } else {
        PG8_STAGE(PG8_SB(0, 0), cB, voffB); PG8_STAGE(PG8_SA(0, 0), cA, voffA); PG8_STAGE(PG8_SB(0, 1), cB + hstep, voffB); PG8_STAGE(PG8_SA(0, 1), cA + hstep, voffA);
        if (wr == 1) PG8_BAR;
        PG8_WAIT_V(4); PG8_BAR;
        PG8_STAGE(PG8_SB(1, 0), cB + kstep, voffB); PG8_STAGE(PG8_SA(1, 0), cA + kstep, voffA); PG8_STAGE(PG8_SB(1, 1), cB + hstep + kstep, voffB);
        PG8_WAIT_V(6); PG8_BAR;
    }
    for (;;) {
        const bool has_next = S.next(ui + 1, nxt);
        const char* nA = has_next ? (const char*)g.A + (size_t)nxt.pm * tstep : cA; const char* nB = has_next ? (const char*)g.Bt + (size_t)nxt.pb * tstep : cB;
        for (int t = 0; t < nt; t += 2) {
            const bool last = (t == nt - 2);
            const char* a1 = cA + (size_t)(t + 1) * kstep;
            const char* a2 = last ? nA : cA + (size_t)(t + 2) * kstep; const char* b2 = last ? nB : cB + (size_t)(t + 2) * kstep;
            const char* a3 = a2 + kstep; const char* b3 = b2 + kstep;
            if constexpr (SP2) {
            PG8_LDB(B0, 0, 0); PG8_LDB(B1, 0, 1); PG8_SCHED; PG8_LDA(At, 0, 0); PG8_STAGE(PG8_SA(1, 1), a1 + hstep, voffA);
            PG8_WAIT_V(8); PG8_WAIT_L(0); PG8_BAR; PG8_MMA(0, 0, At, B0); PG8_MMA(0, 1, At, B1); PG8_BAR; PG8_SCHED;
            PG8_LDA(At, 0, 1); PG8_STAGE(PG8_SB(0, 0), b2, voffB); PG8_STAGE(PG8_SB(0, 1), b2 + hstep, voffB); PG8_STAGE(PG8_SA(0, 0), a2, voffA);
            PG8_WAIT_V(8); PG8_WAIT_L(0); PG8_BAR; PG8_MMA(1, 0, At, B0); PG8_MMA(1, 1, At, B1); PG8_BAR; PG8_SCHED;
            PG8_LDB(B0, 1, 0); PG8_LDB(B1, 1, 1); PG8_SCHED; PG8_LDA(At, 1, 0); PG8_STAGE(PG8_SA(0, 1), a2 + hstep, voffA);
            PG8_WAIT_V(8); PG8_WAIT_L(0); PG8_BAR; PG8_MMA(0, 0, At, B0); PG8_MMA(0, 1, At, B1); PG8_BAR; PG8_SCHED;
            PG8_LDA(At, 1, 1); PG8_STAGE(PG8_SB(1, 0), b3, voffB); PG8_STAGE(PG8_SB(1, 1), b3 + hstep, voffB); PG8_STAGE(PG8_SA(1, 0), a3, voffA);
            PG8_WAIT_V(8); PG8_WAIT_L(0); PG8_BAR; PG8_MMA(1, 0, At, B0); PG8_MMA(1, 1, At, B1); PG8_BAR; PG8_SCHED;
            } else {
            PG8_LDB(B0, 0, 0); PG8_SCHED; PG8_LDA(At, 0, 0); PG8_STAGE(PG8_SA(1, 1), a1 + hstep, voffA);
            PG8_WAIT_L(8); PG8_BAR; PG8_WAIT_L(0); PG8_MMA(0, 0, At, B0); PG8_BAR; PG8_SCHED;
            PG8_LDB(B1, 0, 1); PG8_STAGE(PG8_SB(0, 0), b2, voffB);
            PG8_BAR; PG8_WAIT_L(0); PG8_MMA(0, 1, At, B1); PG8_BAR;
            PG8_LDA(At, 0, 1); PG8_STAGE(PG8_SA(0, 0), a2, voffA);
            PG8_BAR; PG8_WAIT_L(0); PG8_MMA(1, 0, At, B0); PG8_BAR; PG8_SCHED;
            PG8_STAGE(PG8_SB(0, 1), b2 + hstep, voffB);
            PG8_WAIT_V(6); PG8_BAR; PG8_MMA(1, 1, At, B1); PG8_BAR;
            PG8_LDB(B0, 1, 0); PG8_SCHED; PG8_LDA(At, 1, 0); PG8_STAGE(PG8_SA(0, 1), a2 + hstep, voffA);
            PG8_WAIT_L(8); PG8_BAR; PG8_WAIT_L(0); PG8_MMA(0, 0, At, B0); PG8_BAR; PG8_SCHED;
            PG8_LDB(B1, 1, 1); PG8_STAGE(PG8_SB(1, 0), b3, voffB);
            PG8_BAR; PG8_WAIT_L(0); PG8_MMA(0, 1, At, B1); PG8_BAR;
            PG8_LDA(At, 1, 1); PG8_STAGE(PG8_SA(1, 0), a3, voffA);
            PG8_BAR; PG8_WAIT_L(0); PG8_MMA(1, 0, At, B0); PG8_BAR; PG8_SCHED;
            PG8_STAGE(PG8_SB(1, 1), b3 + hstep, voffB);
            PG8_WAIT_V(6); PG8_BAR; PG8_MMA(1, 1, At, B1); PG8_BAR;
            }
        }
        if constexpr (ALIGN_EPI) { if (wr == 0) PG8_BAR; }
        E(acc, cur, wr, wc, fr, fq);
        if (!has_next) break;
#pragma unroll
        for (int a = 0; a < 2; ++a)
#pragma unroll
            for (int b = 0; b < 2; ++b)
#pragma unroll
                for (int m = 0; m < 4; ++m)
#pragma unroll
                    for (int n = 0; n < 2; ++n) acc[a][b][m][n] = (f32x4){0.f, 0.f, 0.f, 0.f};
        cur = nxt; cA = nA; cB = nB; ++ui;
        if constexpr (ALIGN_EPI) { if (wr == 1) PG8_BAR; }
    }
    PG8_WAIT_V(0);
    if constexpr (!ALIGN_EPI) { if (wr == 0) PG8_BAR; }
    PG8_BAR;
#undef PG8_SA
#undef PG8_SB
#undef PG8_STAGE
#undef PG8_LDA
#undef PG8_LDB
#undef PG8_MMA
#undef PG8_WAIT_V
#undef PG8_WAIT_L
#undef PG8_BAR
#undef PG8_SCHED
}
}
#define XB_TMO      128
#define XB_XCNT(j)  (256  + 64 * (j))
#define XB_XSUB(j)  (1280 + 64 * (j))
#define XB_XGEN(j)  (2304 + 64 * (j))
#define XB_TOP      3328
#define XB_TOPGEN   3392
#define XCD_BAR_WORDS 3456
#define XB_SPIN_CAP (1u << 18)

__device__ __forceinline__ unsigned xb_ld(unsigned* p)              { return __hip_atomic_load(p, __ATOMIC_RELAXED, __HIP_MEMORY_SCOPE_AGENT); }
__device__ __forceinline__ unsigned xb_add(unsigned* p, unsigned v) { return __hip_atomic_fetch_add(p, v, __ATOMIC_RELAXED, __HIP_MEMORY_SCOPE_AGENT); }
__device__ __forceinline__ unsigned xb_xcc_id() { return (unsigned)__builtin_amdgcn_s_getreg((3 << 11) | 20) & 0xFu; }
#define XB_SPIN(cond, bar) do { unsigned _sp = 0; while (cond) { __builtin_amdgcn_s_sleep(1); \
    if ((++_sp & 255u) == 0u) { if (xb_ld(&(bar)[XB_TMO])) break; if (_sp > XB_SPIN_CAP) { atomicAdd(&(bar)[XB_TMO], 1u); break; } } } } while (0)

struct XcdBarrier {
    unsigned* bar; unsigned x;
    volatile LAS unsigned* st;
};

__device__ __forceinline__ XcdBarrier xcd_barrier_post(unsigned* bar, volatile LAS unsigned* st) {
    XcdBarrier b; b.bar = bar; b.x = xb_xcc_id(); b.st = st;
    if (threadIdx.x == 0) (void)xb_add(&bar[XB_XCNT(b.x)], 1u);
    return b;
}
__device__ __forceinline__ void xcd_barrier_complete(unsigned* bar, unsigned x, unsigned& nloc, unsigned& nx) {
    const unsigned G = gridDim.x * gridDim.y * gridDim.z;
    unsigned sum, cnt, mine, sp = 0u;
    for (;;) {
        sum = 0u; cnt = 0u; mine = 0u;
#pragma unroll
        for (unsigned j = 0; j < 16; ++j) { const unsigned c = xb_ld(&bar[XB_XCNT(j)]); sum += c; cnt += (c > 0u) ? 1u : 0u; mine = (j == x) ? c : mine; }
        if (sum == G) break;
        __builtin_amdgcn_s_sleep(1);
        if ((++sp & 255u) == 0u) { if (xb_ld(&bar[XB_TMO])) break; if (sp > XB_SPIN_CAP) { atomicAdd(&bar[XB_TMO], 1u); break; } }
    }
    nloc = mine > 0u ? mine : 1u; nx = cnt > 0u ? cnt : 1u;
}

__device__ __forceinline__ void xcd_barrier(const XcdBarrier& b) {
    asm volatile("s_waitcnt vmcnt(0)" ::: "memory");
    __syncthreads();
    if (threadIdx.x == 0) {
        unsigned* bar = b.bar;
        __builtin_amdgcn_s_waitcnt(0);
        unsigned nloc = b.st[0], nx = b.st[1];
        if (nloc == 0u) { xcd_barrier_complete(bar, b.x, nloc, nx); b.st[0] = nloc; b.st[1] = nx; }
        const unsigned old = xb_add(&bar[XB_XSUB(b.x)], 1u);
        const unsigned gen = old / nloc;
        if (old + 1u == (gen + 1u) * nloc) {
            __builtin_amdgcn_fence(__ATOMIC_RELEASE, "agent");
            asm volatile("s_waitcnt vmcnt(0)" ::: "memory");
            const unsigned og = xb_add(&bar[XB_TOP], 1u);
            const unsigned tg = og / nx;
            if (og + 1u == (tg + 1u) * nx) xb_add(&bar[XB_TOPGEN], 1u);
            else XB_SPIN(xb_ld(&bar[XB_TOPGEN]) == tg, bar);
            __builtin_amdgcn_fence(__ATOMIC_ACQUIRE, "agent");
            xb_add(&bar[XB_XGEN(b.x)], 1u);
            asm volatile("s_waitcnt vmcnt(0)" ::: "memory");
        } else {
            XB_SPIN(xb_ld(&bar[XB_XGEN(b.x)]) == gen, bar);
            __builtin_amdgcn_fence(__ATOMIC_ACQUIRE, "agent");
            asm volatile("s_waitcnt vmcnt(0)" ::: "memory");
        }
    }
    __syncthreads();
}
constexpr int NB = 4, SEQ = 8192, DM = 1024, T = NB * SEQ;
constexpr int NH = 8, HD = 64, CW = 512;
constexpr int N_IN = 5120;
constexpr int NLAYER = 2;
constexpr int NEXP = 32, DEXP = 512;
constexpr int MOE_ROWS = 73728, MOE_PANELS = MOE_ROWS / 256;
constexpr int WCAT_ROWS = 5888;
constexpr int LO_W = 768;

constexpr size_t MiB = 1u << 20;
constexpr size_t WS_CTL = 0, CTL_ZERO_BYTES = 1 * MiB;
constexpr size_t WS_VF   = 1 * MiB;
constexpr size_t WS_TAB  = 33 * MiB;
constexpr size_t WS_WM   = 34 * MiB;
constexpr size_t WS_XN   = 50 * MiB;
constexpr size_t WS_RW   = 114 * MiB;
constexpr size_t WS_MO   = 114 * MiB;
constexpr size_t WS_LO   = 210 * MiB;
constexpr size_t WS_YR   = 354 * MiB;
constexpr size_t WS_SI   = 258 * MiB;
constexpr size_t WS_V1   = 418 * MiB;
constexpr size_t WS_G    = 450 * MiB;
constexpr size_t WS_YS   = 482 * MiB;
constexpr size_t WS_PO   = 418 * MiB;
constexpr size_t WS_PST  = 386 * MiB;
constexpr size_t WS_YM   = 258 * MiB;
constexpr size_t WS_GA   = 418 * MiB;
constexpr size_t WS_H    = 290 * MiB;
constexpr size_t WS_SC1  = 482 * MiB;
constexpr size_t WS_SC2  = 114 * MiB;
constexpr size_t WS_SCT  = 290 * MiB;
constexpr size_t WS_WE   = 34 * MiB;
constexpr size_t WS_WD   = 98 * MiB;
constexpr size_t WS_AM   = 130 * MiB;
constexpr size_t WS_HM   = 274 * MiB;
constexpr size_t WS_YE   = 346 * MiB;
constexpr size_t WS_RT   = 490 * MiB;
constexpr size_t WS_END  = 556 * MiB;
constexpr size_t TB_KMEAN = 0;
constexpr size_t TB_SEL   = 256 * 1024;
constexpr size_t RT_EID  = 0;
constexpr size_t RT_GATE = 256 * 1024;
constexpr size_t RT_ROW  = 512 * 1024;
constexpr size_t RT_GW   = 768 * 1024;
constexpr size_t RT_HIST = 1280 * 1024;
constexpr size_t RT_PEXP = 1408 * 1024;
constexpr size_t WS_SEL  = 556 * MiB;
constexpr size_t WS_NEED = 558 * MiB;
constexpr int CW_BAR = 4096;

constexpr int RING_BYTES = 131072;
constexpr int LDS_BYTES = 163840;
constexpr int MISC_OFF = LDS_BYTES - 256;
struct Frame {
    LAS unsigned char* lds;
    int tid, lane, wave;
    int G, bid;
    const __attribute__((address_space(4))) unsigned char* ka;
    GAS float* out_g; GAS unsigned char* ws_g;
    DI float* outp() const { return (float*)out_g; }
    DI unsigned char* wsp() const { return (unsigned char*)ws_g; }
    DI const float* inp(int i) const { return (const float*)(*(const GAS float* const __attribute__((address_space(4)))*)(ka + 8 * i)); }
};
#define LDS_WAIT() asm volatile("s_waitcnt lgkmcnt(0)" ::: "memory")

DI void tr_item(const float* src, int ld, int k0, bf16_t* dst, int Kd, const float* sc, int mode, LAS float* scr, int lane) {
#pragma unroll 8
    for (int i = 0; i < 32; ++i) { const int kk = 2 * i + (lane >> 5);
        float v = src ? src[(size_t)(k0 + kk) * ld + (lane & 31)] : 0.f;
        if (mode == 1) v *= sc[k0 + kk]; else if (mode == 2) v *= (1.f - sc[k0 + kk]);
        scr[kk * 33 + (lane & 31)] = v; }
    LDS_WAIT(); asm volatile("" ::: "memory");
    const int c = lane & 7;
#pragma unroll
    for (int j = 0; j < 4; ++j) { const int n = (lane >> 3) + 8 * j; const LAS float* s = scr + (8 * c) * 33 + n;
        u32x4 o; o.x = pk2(s[0 * 33], s[1 * 33]); o.y = pk2(s[2 * 33], s[3 * 33]); o.z = pk2(s[4 * 33], s[5 * 33]); o.w = pk2(s[6 * 33], s[7 * 33]);
        *(u32x4*)(dst + (size_t)n * Kd + k0 + 8 * c) = o; }
    LDS_WAIT(); asm volatile("" ::: "memory");
}

constexpr size_t WM_WCAT = 0, WM_BRR = (size_t)WCAT_ROWS * 1024 * 2, WM_BRM = WM_BRR + 1024 * 512 * 2, WM_OUT = WM_BRM + 1024 * 512 * 2;
DI void phase_conv_mixer(Frame& F, int l) {
    LAS float* scr = (LAS float*)(F.lds + F.wave * 16384);
    const int gw = F.bid * 8 + F.wave, NGW = F.G * 8;
    bf16_t* wcat = (bf16_t*)(F.wsp() + WS_WM + WM_WCAT);
    const float* w_in = F.inp(3) + (size_t)l * DM * N_IN;
    const float* mu_x = F.inp(5) + (size_t)l * 3 * DM;
    constexpr int NBLK = WCAT_ROWS / 32;
    constexpr int I_CAT = NBLK * 16, I_BR = 8 * 32, I_OUT = 16 * 32;
    for (int it = gw; it < I_CAT + 2 * I_BR + I_OUT; it += NGW) {
        int r = it;
        if (r < I_CAT) {
            const int nb = r / 16, kb = r % 16, k0 = kb * 64;
            if (nb < 48) { tr_item(w_in + 32 * nb, N_IN, k0, wcat + (size_t)(32 * nb) * 1024, 1024, nullptr, 0, scr, F.lane); }
            else if (nb < 72) {
                const int q = nb - 48; const float* src = nullptr; int ld = 0; const float* sc = nullptr; int mode = 0;
                if (q < 4)       { src = F.inp(7)  + (size_t)l * DM * 64  + 32 * (q & 1); ld = 64;  sc = mu_x;          mode = (q < 2) ? 2 : 1; }
                else if (q < 8)  { src = F.inp(10) + (size_t)l * DM * 64  + 32 * (q & 1); ld = 64;  sc = mu_x + DM;     mode = (q < 6) ? 2 : 1; }
                else if (q < 16) { src = F.inp(12) + (size_t)l * DM * 128 + 32 * (q & 3); ld = 128; sc = mu_x + 2 * DM; mode = (q < 12) ? 2 : 1; }
                else if (q < 18 && l > 0) { src = F.inp(21) + (size_t)(l - 1) * DM * 32; ld = 32; sc = F.inp(19) + (size_t)(l - 1) * DM; mode = (q == 16) ? 2 : 1; }
                tr_item(src, ld, k0, wcat + (size_t)(1536 + 32 * q) * 1024, 1024, sc, mode, scr, F.lane);
            }
            else if (nb < 120) { tr_item(w_in + 1536 + 32 * (nb - 72), N_IN, k0, wcat + (size_t)(2304 + 32 * (nb - 72)) * 1024, 1024, nullptr, 0, scr, F.lane); }
            else { tr_item(w_in + 3072 + 32 * (nb - 120), N_IN, k0, wcat + (size_t)(3840 + 32 * (nb - 120)) * 1024, 1024, nullptr, 0, scr, F.lane); }
            continue;
        }
        r -= I_CAT;
        if (r < I_BR) { const int nb = r / 8, kb = r % 8; tr_item(F.inp(26) + (size_t)l * 512 * 1024 + 32 * nb, 1024, kb * 64, (bf16_t*)(F.wsp() + WS_WM + WM_BRR) + (size_t)(32 * nb) * 512, 512, nullptr, 0, scr, F.lane); continue; }
        r -= I_BR;
        if (r < I_BR) { const int nb = r / 8, kb = r % 8; tr_item(F.inp(27) + (size_t)l * 512 * 1024 + 32 * nb, 1024, kb * 64, (bf16_t*)(F.wsp() + WS_WM + WM_BRM) + (size_t)(32 * nb) * 512, 512, nullptr, 0, scr, F.lane); continue; }
        r -= I_BR;
        { const int nb = r / 16, kb = r % 16; tr_item(F.inp(28) + (size_t)l * 1024 * 1024 + 32 * nb, 1024, kb * 64, (bf16_t*)(F.wsp() + WS_WM + WM_OUT) + (size_t)(32 * nb) * 1024, 1024, nullptr, 0, scr, F.lane); }
    }
}
DI void phase_conv_experts(Frame& F, int l) {
    LAS float* scr = (LAS float*)(F.lds + F.wave * 16384);
    const int gw = F.bid * 8 + F.wave, NGW = F.G * 8;
    bf16_t* we = (bf16_t*)(F.wsp() + WS_WE); bf16_t* wd = (bf16_t*)(F.wsp() + WS_WD);
    const float* wg = F.inp(33) + (size_t)l * NEXP * DM * DEXP; const float* wu = F.inp(34) + (size_t)l * NEXP * DM * DEXP; const float* wdn = F.inp(35) + (size_t)l * NEXP * DEXP * DM;
    for (int it = gw; it < NEXP * 768; it += NGW) {
        const int e = it / 768; int r = it % 768;
        if (r < 512) {
            const int up = r >> 8; r &= 255; const int nb = r / 16, kb = r % 16, h0 = 32 * nb;
            const float* src = (up ? wu : wg) + (size_t)e * DM * DEXP + h0;
            tr_item(src, DEXP, kb * 64, we + ((size_t)e * 1024 + (h0 >> 7) * 256 + up * 128 + (h0 & 127)) * 1024, 1024, nullptr, 0, scr, F.lane);
        } else {
            r -= 512; const int nb = r / 8, kb = r % 8;
            tr_item(wdn + (size_t)e * DEXP * DM + 32 * nb, DM, kb * 64, wd + ((size_t)e * 1024 + 32 * nb) * 512, 512, nullptr, 0, scr, F.lane);
        }
    }
}
DI void rms_row_to_bf16(const float* xrow, const float* gain, bf16_t* o0, bf16_t* o1, int lane) {
    const f32x4* xr = (const f32x4*)xrow + lane; const f32x4* gr = (const f32x4*)gain + lane;
    f32x4 v[4]; float s = 0.f;
#pragma unroll
    for (int j = 0; j < 4; ++j) { v[j] = xr[64 * j]; s += (v[j].x * v[j].x + v[j].y * v[j].y) + (v[j].z * v[j].z + v[j].w * v[j].w); }
    const float rs = 1.0f / sqrtf(wave_sum(s) * (1.f / DM) + 1e-6f);
#pragma unroll
    for (int j = 0; j < 4; ++j) { const f32x4 g = gr[64 * j]; const f32x4 y = v[j] * rs * g;
        u32x2 w; w.x = pk2(y.x, y.y); w.y = pk2(y.z, y.w);
        *((u32x2*)o0 + lane + 64 * j) = w; if (o1) *((u32x2*)o1 + lane + 64 * j) = w; }
}
DI void phase_norm_x(Frame& F, const float* x, const float* gain) {
    const int gw = F.bid * 8 + F.wave, NGW = F.G * 8; bf16_t* xn = (bf16_t*)(F.wsp() + WS_XN);
    for (int m = gw; m < T; m += NGW) rms_row_to_bf16(x + (size_t)m * DM, gain, xn + (size_t)m * DM, nullptr, F.lane);
}

namespace pg8 {
struct EpiStore {
    static constexpr bool PERM = true;
    bf16_t* O; int ldc; int split; bf16_t* O2; int ldc2; int act;
    __device__ __forceinline__ void operator()(const f32x4 (&acc)[2][2][4][2], const Unit& u, int wr, int wc, int fr, int fq) const {
        const int row0 = u.pm * BM + wr * 64 + fr; int colt = u.pn * BM; bf16_t* base = O; int ld = ldc;
        if (split && colt >= split) { base = O2; ld = ldc2; colt -= split; }
        const int col0 = colt + wc * 32 + 8 * fq;
#pragma unroll
        for (int ai = 0; ai < 2; ++ai)
#pragma unroll
            for (int m = 0; m < 4; ++m) { bf16_t* rowp = base + (size_t)(row0 + ai * HALF + m * 16) * ld + col0;
#pragma unroll
                for (int bj = 0; bj < 2; ++bj) { f32x4 v0 = acc[ai][bj][m][0], v1 = acc[ai][bj][m][1];
                    if (act == 1) {
#pragma unroll
                        for (int j = 0; j < 4; ++j) { v0[j] = sigmoidf_(v0[j]); v1[j] = sigmoidf_(v1[j]); } }
                    u32x4 w; w.x = pk2(v0[0], v0[1]); w.y = pk2(v0[2], v0[3]); w.z = pk2(v1[0], v1[1]); w.w = pk2(v1[2], v1[3]);
                    *(u32x4*)(rowp + bj * HALF) = w; } }
    }
};
struct EpiBranch {
    static constexpr bool PERM = true;
    bf16_t* Hout; const bf16_t* gate; int gcol0; int first;
    __device__ __forceinline__ void operator()(const f32x4 (&acc)[2][2][4][2], const Unit& u, int wr, int wc, int fr, int fq) const {
        const int row0 = u.pm * BM + wr * 64 + fr; const int col0 = u.pn * BM + wc * 32 + 8 * fq;
#pragma unroll
        for (int ai = 0; ai < 2; ++ai)
#pragma unroll
            for (int m = 0; m < 4; ++m) { const size_t row = (size_t)(row0 + ai * HALF + m * 16);
#pragma unroll
                for (int bj = 0; bj < 2; ++bj) {
                    const u32x4 gv = *(const u32x4*)(gate + row * 2048 + gcol0 + col0 + bj * HALF);
                    bf16_t* hp = Hout + row * 1024 + col0 + bj * HALF;
                    f32x4 v0 = acc[ai][bj][m][0], v1 = acc[ai][bj][m][1];
                    v0[0] *= bflo(gv.x); v0[1] *= bfhi(gv.x); v0[2] *= bflo(gv.y); v0[3] *= bfhi(gv.y);
                    v1[0] *= bflo(gv.z); v1[1] *= bfhi(gv.z); v1[2] *= bflo(gv.w); v1[3] *= bfhi(gv.w);
                    if (!first) { const u32x4 hv = *(const u32x4*)hp;
                        v0[0] += bflo(hv.x); v0[1] += bfhi(hv.x); v0[2] += bflo(hv.y); v0[3] += bfhi(hv.y);
                        v1[0] += bflo(hv.z); v1[1] += bfhi(hv.z); v1[2] += bflo(hv.w); v1[3] += bfhi(hv.w); }
                    u32x4 w; w.x = pk2(v0[0], v0[1]); w.y = pk2(v0[2], v0[3]); w.z = pk2(v1[0], v1[1]); w.w = pk2(v1[2], v1[3]);
                    *(u32x4*)hp = w; } }
    }
};
struct EpiResid {
    static constexpr bool PERM = false;
    const float* xin; float* out;
    __device__ __forceinline__ void operator()(const f32x4 (&acc)[2][2][4][2], const Unit& u, int wr, int wc, int fr, int fq) const {
        const int row0 = u.pm * BM + wr * 64 + fr, col0 = u.pn * BM + wc * 32 + 4 * fq;
#pragma unroll
        for (int ai = 0; ai < 2; ++ai)
#pragma unroll
            for (int m = 0; m < 4; ++m) { const size_t off = (size_t)(row0 + ai * HALF + m * 16) * 1024 + col0;
#pragma unroll
                for (int bj = 0; bj < 2; ++bj)
#pragma unroll
                    for (int n = 0; n < 2; ++n) { const f32x4 xv = *(const f32x4*)(xin + off + bj * HALF + n * 16); *(f32x4*)(out + off + bj * HALF + n * 16) = xv + acc[ai][bj][m][n]; } }
    }
};
struct EpiExpertUp {
    static constexpr bool PERM = true;
    bf16_t* HM; const float* gw;
    __device__ __forceinline__ void operator()(const f32x4 (&acc)[2][2][4][2], const Unit& u, int wr, int wc, int fr, int fq) const {
        const int row0 = u.pm * BM + wr * 64 + fr; const int col0 = u.pn * 128 + wc * 32 + 8 * fq;
#pragma unroll
        for (int ai = 0; ai < 2; ++ai)
#pragma unroll
            for (int m = 0; m < 4; ++m) { const size_t row = (size_t)(row0 + ai * HALF + m * 16); const float gwt = gw[row];
                f32x4 v0, v1;
#pragma unroll
                for (int j = 0; j < 4; ++j) { const float g0 = acc[ai][0][m][0][j], g1 = acc[ai][0][m][1][j];
                    v0[j] = g0 * sigmoidf_(g0) * acc[ai][1][m][0][j] * gwt; v1[j] = g1 * sigmoidf_(g1) * acc[ai][1][m][1][j] * gwt; }
                u32x4 w; w.x = pk2(v0[0], v0[1]); w.y = pk2(v0[2], v0[3]); w.z = pk2(v1[0], v1[1]); w.w = pk2(v1[2], v1[3]);
                *(u32x4*)(HM + row * 512 + col0) = w; }
    }
};
}
constexpr size_t SI_PLANE = (size_t)T * CW * 2;
DI float softplusf_(float z) { return fmaxf(z, 0.f) + log1pf(__expf(-fabsf(z))); }

DI void phase_rwkv_prep(Frame& F, int l) {
    LAS float* act = (LAS float*)F.lds;
    const bf16_t* RW = (const bf16_t*)(F.wsp() + WS_RW); const bf16_t* LO = (const bf16_t*)(F.wsp() + WS_LO);
    bf16_t* SIr = (bf16_t*)(F.wsp() + WS_SI); bf16_t* SIw = SIr + (size_t)T * CW; bf16_t* SIk = SIw + (size_t)T * CW; bf16_t* SIa = SIk + (size_t)T * CW; bf16_t* SIb = SIa + (size_t)T * CW;
    bf16_t* VF = (bf16_t*)(F.wsp() + WS_VF); bf16_t* V1 = (bf16_t*)(F.wsp() + WS_V1); bf16_t* Gb = (bf16_t*)(F.wsp() + WS_G);
    int c = F.tid;
    const float* w2 = F.inp(8) + (size_t)l * 64 * CW; const float* a2 = F.inp(11) + (size_t)l * 64 * CW; const float* g2 = F.inp(13) + (size_t)l * 128 * CW;
    const float* v2 = F.inp(22);
    const float mu_r = F.inp(4)[(size_t)l * 3 * CW + c], mu_k = F.inp(4)[(size_t)l * 3 * CW + CW + c], mu_v = F.inp(4)[(size_t)l * 3 * CW + 2 * CW + c];
    const float w0c = F.inp(6)[l * CW + c], a0c = F.inp(9)[l * CW + c], kkc = F.inp(14)[l * CW + c], kac = F.inp(15)[l * CW + c];
    const float v0c = l > 0 ? F.inp(20)[c] : 0.f;
    for (int tile = F.bid; tile < T / 8; tile += F.G) {
        int t0 = tile * 8; asm volatile("" : "+s"(t0), "+v"(c));
        __syncthreads();
        for (int idx = F.tid; idx < 8 * 288; idx += 512) {
            const int tt = idx / 288, j = idx - tt * 288; const int t = t0 + tt; const bool has_prev = (t % SEQ) != 0;
            int pj, qj;
            if (j < 64) { pj = j; qj = 64 + j; } else if (j < 128) { pj = 128 + (j - 64); qj = 192 + (j - 64); } else if (j < 256) { pj = 256 + (j - 128); qj = 384 + (j - 128); } else { pj = 512 + (j - 256); qj = 544 + (j - 256); }
            float v = bf2f(LO[(size_t)t * LO_W + pj]); if (has_prev) v += bf2f(LO[(size_t)(t - 1) * LO_W + qj]);
            if (j < 64) v = tanhf(v); else if (j >= 128 && j < 256) v = sigmoidf_(v);
            act[j * 8 + tt] = v;
        }
        __syncthreads();
        float aw[8], aa[8], ag[8], av[8];
#pragma unroll
        for (int i = 0; i < 8; ++i) { aw[i] = 0.f; aa[i] = 0.f; ag[i] = 0.f; av[i] = 0.f; }
        for (int j = 0; j < 64; ++j) { const float w = w2[j * CW + c]; const LAS f32x4* ap = (const LAS f32x4*)(act + j * 8);
#pragma unroll
            for (int q = 0; q < 2; ++q) { const f32x4 x = ap[q]; aw[4 * q] += x.x * w; aw[4 * q + 1] += x.y * w; aw[4 * q + 2] += x.z * w; aw[4 * q + 3] += x.w * w; } }
        for (int j = 0; j < 64; ++j) { const float w = a2[j * CW + c]; const LAS f32x4* ap = (const LAS f32x4*)(act + (64 + j) * 8);
#pragma unroll
            for (int q = 0; q < 2; ++q) { const f32x4 x = ap[q]; aa[4 * q] += x.x * w; aa[4 * q + 1] += x.y * w; aa[4 * q + 2] += x.z * w; aa[4 * q + 3] += x.w * w; } }
        for (int j = 0; j < 128; ++j) { const float w = g2[j * CW + c]; const LAS f32x4* ap = (const LAS f32x4*)(act + (128 + j) * 8);
#pragma unroll
            for (int q = 0; q < 2; ++q) { const f32x4 x = ap[q]; ag[4 * q] += x.x * w; ag[4 * q + 1] += x.y * w; ag[4 * q + 2] += x.z * w; ag[4 * q + 3] += x.w * w; } }
        if (l > 0) for (int j = 0; j < 32; ++j) { const float w = v2[j * CW + c]; const LAS f32x4* ap = (const LAS f32x4*)(act + (256 + j) * 8);
#pragma unroll
            for (int q = 0; q < 2; ++q) { const f32x4 x = ap[q]; av[4 * q] += x.x * w; av[4 * q + 1] += x.y * w; av[4 * q + 2] += x.z * w; av[4 * q + 3] += x.w * w; } }
#pragma unroll
        for (int tt = 0; tt < 8; ++tt) {
            const int t = t0 + tt; const bool has_prev = (t % SEQ) != 0; const size_t ro = (size_t)t * 1536;
            const float rp = bf2f(RW[ro + c]), kp = bf2f(RW[ro + 512 + c]), vp = bf2f(RW[ro + 1024 + c]);
            float rq = 0.f, kq = 0.f, vq = 0.f;
            if (has_prev) { rq = bf2f(RW[ro - 1536 + c]); kq = bf2f(RW[ro - 1536 + 512 + c]); vq = bf2f(RW[ro - 1536 + 1024 + c]); }
            const float r = rp + (rq - rp) * mu_r, k = kp + (kq - kp) * mu_k; float v = vp + (vq - vp) * mu_v;
            const float wl = -softplusf_(-(w0c + aw[tt])) - 0.5f;
            const float lw = -__expf(wl);
            const float alr = sigmoidf_(a0c + aa[tt]);
            const size_t o = (size_t)t * CW + c;
            if (l > 0) { const float vf = bf2f(VF[o]); v = v + (vf - v) * sigmoidf_(v0c + av[tt]); V1[o] = f2bf(v); } else { VF[o] = f2bf(v); }
            float kk = k * kkc; const float nrm = sqrtf(wave_sum(kk * kk)); kk = kk / fmaxf(nrm, 1e-12f);
            const float k2 = k * (1.f + (alr - 1.f) * kac);
            SIr[o] = f2bf(r); SIw[o] = f2bf(lw); SIk[o] = f2bf(k2); SIa[o] = f2bf(kk); SIb[o] = f2bf(kk * alr); Gb[o] = f2bf(ag[tt]);
            asm volatile("" ::: "memory");
        }
    }
}

DI void phase_rwkv_scan_naive(Frame& F, int l) {
    LAS float* Lr = (LAS float*)F.lds; LAS float* Lw = Lr + 4096; LAS float* Lk = Lw + 4096; LAS float* La = Lk + 4096; LAS float* Lb = La + 4096;
    LAS float* Lv = Lb + 4096; LAS float* Ly = Lv + 512;
    const bf16_t* SIr = (const bf16_t*)(F.wsp() + WS_SI); const bf16_t* SIw = SIr + (size_t)T * CW; const bf16_t* SIk = SIw + (size_t)T * CW; const bf16_t* SIa = SIk + (size_t)T * CW; const bf16_t* SIb = SIa + (size_t)T * CW;
    const bf16_t* V = (const bf16_t*)(F.wsp() + (l > 0 ? WS_V1 : WS_VF)); float* YS = (float*)(F.wsp() + WS_YS);
    for (int u = F.bid; u < 256; u += F.G) {
        const int b = u >> 6, h = (u >> 3) & 7, rg = u & 7;
        float S = 0.f;
        for (int ch = 0; ch < SEQ / 64; ++ch) {
            const size_t tb = (size_t)b * SEQ + ch * 64;
            __syncthreads();
            for (int idx = F.tid; idx < 4096; idx += 512) { const int s = idx >> 6, kx = idx & 63; const size_t o = (tb + s) * CW + h * 64 + kx;
                Lr[idx] = bf2f(SIr[o]); Lw[idx] = __expf(bf2f(SIw[o])); Lk[idx] = bf2f(SIk[o]); La[idx] = -bf2f(SIa[o]); Lb[idx] = bf2f(SIb[o]); }
            { const int s = F.tid >> 3, rr = F.tid & 7; Lv[F.tid] = bf2f(V[(tb + s) * CW + h * 64 + rg * 8 + rr]); }
            __syncthreads();
#pragma unroll 4
            for (int s = 0; s < 64; ++s) {
                const float a = La[s * 64 + F.lane], w = Lw[s * 64 + F.lane], bb = Lb[s * 64 + F.lane], kk = Lk[s * 64 + F.lane], r = Lr[s * 64 + F.lane], v = Lv[s * 8 + F.wave];
                const float sa = wave_sum(S * a);
                S = S * w + sa * bb + v * kk;
                const float y = wave_sum(S * r);
                if (F.lane == 0) Ly[s * 8 + F.wave] = y;
            }
            __syncthreads();
            { const int s = F.tid >> 3, rr = F.tid & 7; YS[(tb + s) * CW + h * 64 + rg * 8 + rr] = Ly[F.tid]; }
        }
    }
}

DI void phase_rwkv_post(Frame& F, int l) {
    const float* YS = (const float*)(F.wsp() + WS_YS);
    const bf16_t* SIr = (const bf16_t*)(F.wsp() + WS_SI); const bf16_t* SIk = SIr + 2 * (size_t)T * CW;
    const bf16_t* V = (const bf16_t*)(F.wsp() + (l > 0 ? WS_V1 : WS_VF)); const bf16_t* Gb = (const bf16_t*)(F.wsp() + WS_G); bf16_t* YR = (bf16_t*)(F.wsp() + WS_YR);
    const int c = F.tid; const float lg = F.inp(17)[l * CW + c], lb = F.inp(18)[l * CW + c], rk = F.inp(16)[l * CW + c];
    for (int t = F.bid; t < T; t += F.G) {
        const size_t o = (size_t)t * CW + c;
        const float y = YS[o]; const float mean = wave_sum(y) * (1.f / 64.f); const float d = y - mean; const float var = wave_sum(d * d) * (1.f / 64.f);
        const float yn = d * (1.0f / sqrtf(var + 64e-5f)) * lg + lb;
        const float r = bf2f(SIr[o]), k = bf2f(SIk[o]), v = bf2f(V[o]);
        const float bonus = wave_sum(r * k * rk) * v;
        YR[o] = f2bf((yn + bonus) * bf2f(Gb[o]));
    }
}

constexpr int ACT_P = 592;
constexpr size_t WM_L2T = (size_t)WCAT_ROWS * 1024 * 2 + 2 * 1024 * 512 * 2 + 1024 * 1024 * 2;
DI void phase_conv_lora2(Frame& F, int l) {
    bf16_t* L2T = (bf16_t*)(F.wsp() + WS_WM + WM_L2T);
    const float* w2 = F.inp(8) + (size_t)l * 64 * CW; const float* a2 = F.inp(11) + (size_t)l * 64 * CW; const float* g2 = F.inp(13) + (size_t)l * 128 * CW; const float* v2 = F.inp(22);
    for (int idx = F.bid * 512 + F.tid; idx < 288 * CW; idx += F.G * 512) { const int j = idx >> 9, c = idx & 511;
        float v;
        if (j < 64) v = w2[j * CW + c]; else if (j < 128) v = a2[(j - 64) * CW + c]; else if (j < 256) v = g2[(j - 128) * CW + c]; else v = (l > 0) ? v2[(j - 256) * CW + c] : 0.f;
        L2T[c * 288 + j] = f2bf(v); }
}
DI float row16_sum(float v) { v += dpp_mov<0xB1>(v); v += dpp_mov<0x4E>(v); v += dpp_mov<0x141>(v); v += dpp_mov<0x140>(v); return v; }
DI void phase_rwkv_prep2(Frame& F, int l) {
    LAS unsigned char* act = F.lds;
    const bf16_t* RW = (const bf16_t*)(F.wsp() + WS_RW); const bf16_t* LO = (const bf16_t*)(F.wsp() + WS_LO); const unsigned char* L2T = F.wsp() + WS_WM + WM_L2T;
    bf16_t* SIr = (bf16_t*)(F.wsp() + WS_SI); bf16_t* SIw = SIr + (size_t)T * CW; bf16_t* SIk = SIw + (size_t)T * CW; bf16_t* SIa = SIk + (size_t)T * CW; bf16_t* SIb = SIa + (size_t)T * CW;
    bf16_t* VF = (bf16_t*)(F.wsp() + WS_VF); bf16_t* V1 = (bf16_t*)(F.wsp() + WS_V1); bf16_t* Gb = (bf16_t*)(F.wsp() + WS_G);
    const int lane = F.lane, r16 = lane & 15, g = lane >> 4, cb = 64 * F.wave + r16;
    float mu_r[4], mu_k[4], mu_v[4], w0c[4], a0c[4], kkc[4], kac[4], v0c[4];
#pragma unroll
    for (int ct = 0; ct < 4; ++ct) { const int c = cb + 16 * ct;
        mu_r[ct] = F.inp(4)[(size_t)l * 3 * CW + c]; mu_k[ct] = F.inp(4)[(size_t)l * 3 * CW + CW + c]; mu_v[ct] = F.inp(4)[(size_t)l * 3 * CW + 2 * CW + c];
        w0c[ct] = F.inp(6)[l * CW + c]; a0c[ct] = F.inp(9)[l * CW + c]; kkc[ct] = F.inp(14)[l * CW + c]; kac[ct] = F.inp(15)[l * CW + c]; v0c[ct] = l > 0 ? F.inp(20)[c] : 0.f; }
    for (int tile = F.bid; tile < T / 64; tile += F.G) {
        int t0 = tile * 64; asm volatile("" : "+s"(t0));
        __syncthreads();
        for (int grp = F.tid; grp < 64 * 36; grp += 512) { const int tt = grp / 36, jg = grp - tt * 36, j0 = 8 * jg; const int t = t0 + tt; const bool has_prev = (t % SEQ) != 0;
            int pj, qj; if (j0 < 64) { pj = j0; qj = 64 + j0; } else if (j0 < 128) { pj = 128 + (j0 - 64); qj = 192 + (j0 - 64); } else if (j0 < 256) { pj = 256 + (j0 - 128); qj = 384 + (j0 - 128); } else { pj = 512 + (j0 - 256); qj = 544 + (j0 - 256); }
            const u32x4 pv = *(const u32x4*)(LO + (size_t)t * LO_W + pj); u32x4 qv = {0u, 0u, 0u, 0u}; if (has_prev) qv = *(const u32x4*)(LO + (size_t)(t - 1) * LO_W + qj);
            const unsigned pw[4] = {pv.x, pv.y, pv.z, pv.w}, qw[4] = {qv.x, qv.y, qv.z, qv.w}; float v[8];
#pragma unroll
            for (int q = 0; q < 4; ++q) { v[2 * q] = bflo(pw[q]) + bflo(qw[q]); v[2 * q + 1] = bfhi(pw[q]) + bfhi(qw[q]); }
            if (j0 < 64) {
#pragma unroll
                for (int e = 0; e < 8; ++e) v[e] = tanhf(v[e]);
            } else if (j0 >= 128 && j0 < 256) {
#pragma unroll
                for (int e = 0; e < 8; ++e) v[e] = sigmoidf_(v[e]);
            }
            u32x4 w; w.x = pk2(v[0], v[1]); w.y = pk2(v[2], v[3]); w.z = pk2(v[4], v[5]); w.w = pk2(v[6], v[7]);
            *(LAS u32x4*)(act + tt * ACT_P + j0 * 2) = w; }
        __syncthreads();
#pragma unroll 1
        for (int tt = 0; tt < 4; ++tt) {
            bf16x8 a[9];
#pragma unroll
            for (int s = 0; s < 9; ++s) a[s] = *(const LAS bf16x8*)(act + (16 * tt + r16) * ACT_P + (32 * s + 8 * g) * 2);
            f32x4 aw[4], aa[4], ag[4], av[4];
#pragma unroll
            for (int ct = 0; ct < 4; ++ct) { const unsigned char* wrow = L2T + (size_t)(cb + 16 * ct) * 576 + 16 * g;
                f32x4 x = {0.f, 0.f, 0.f, 0.f};
                x = mfma16(a[0], *(const bf16x8*)(wrow), x); x = mfma16(a[1], *(const bf16x8*)(wrow + 64), x); aw[ct] = x;
                x = (f32x4){0.f, 0.f, 0.f, 0.f};
                x = mfma16(a[2], *(const bf16x8*)(wrow + 128), x); x = mfma16(a[3], *(const bf16x8*)(wrow + 192), x); aa[ct] = x;
                x = (f32x4){0.f, 0.f, 0.f, 0.f};
                x = mfma16(a[4], *(const bf16x8*)(wrow + 256), x); x = mfma16(a[5], *(const bf16x8*)(wrow + 320), x); x = mfma16(a[6], *(const bf16x8*)(wrow + 384), x); x = mfma16(a[7], *(const bf16x8*)(wrow + 448), x); ag[ct] = x;
                x = (f32x4){0.f, 0.f, 0.f, 0.f};
                if (l > 0) x = mfma16(a[8], *(const bf16x8*)(wrow + 512), x);
                av[ct] = x; }
#pragma unroll
            for (int r = 0; r < 4; ++r) {
                const int t = t0 + 16 * tt + 4 * g + r; const bool has_prev = (t % SEQ) != 0; const size_t ro = (size_t)t * 1536;
                float kq[4], kkv[4], alr[4]; float ss = 0.f;
#pragma unroll
                for (int ct = 0; ct < 4; ++ct) { const int c = cb + 16 * ct; const size_t o = (size_t)t * CW + c;
                    const float rp = bf2f(RW[ro + c]), kp = bf2f(RW[ro + 512 + c]), vp = bf2f(RW[ro + 1024 + c]);
                    float rq = 0.f, kq_ = 0.f, vq = 0.f;
                    if (has_prev) { rq = bf2f(RW[ro - 1536 + c]); kq_ = bf2f(RW[ro - 1536 + 512 + c]); vq = bf2f(RW[ro - 1536 + 1024 + c]); }
                    const float rr = rp + (rq - rp) * mu_r[ct], k = kp + (kq_ - kp) * mu_k[ct]; float v = vp + (vq - vp) * mu_v[ct];
                    const float wl = -softplusf_(-(w0c[ct] + aw[ct][r])) - 0.5f; const float lw = -__expf(wl);
                    alr[ct] = sigmoidf_(a0c[ct] + aa[ct][r]);
                    if (l > 0) { const float vf = bf2f(VF[o]); v = v + (vf - v) * sigmoidf_(v0c[ct] + av[ct][r]); V1[o] = f2bf(v); } else { VF[o] = f2bf(v); }
                    kq[ct] = k; kkv[ct] = k * kkc[ct]; ss += kkv[ct] * kkv[ct];
                    SIr[o] = f2bf(rr); SIw[o] = f2bf(lw); Gb[o] = f2bf(ag[ct][r]); }
                const float inv = 1.0f / fmaxf(sqrtf(row16_sum(ss)), 1e-12f);
#pragma unroll
                for (int ct = 0; ct < 4; ++ct) { const size_t o = (size_t)t * CW + cb + 16 * ct; const float kk = kkv[ct] * inv;
                    SIk[o] = f2bf(kq[ct] * (1.f + (alr[ct] - 1.f) * kac[ct])); SIa[o] = f2bf(kk); SIb[o] = f2bf(kk * alr[ct]); }
                asm volatile("" ::: "memory");
            }
        }
    }
}
constexpr int NUNIT = NB * NH * (SEQ / 64);
constexpr size_t U_PMP = 0, U_RPP = 8192, U1_BYTES = 16384;
constexpr size_t U_QMT = 0, U_YLT = 16384, U2_BYTES = 32768;
DI int permk(int k) { return (k & 32) | (((k >> 2) & 3) << 3) | (((k >> 4) & 1) << 2) | (k & 3); }
constexpr int MP = 144;
constexpr int SP = 80;
DI f32x4 mm_tile(const LAS unsigned char* xb, int px, int m0, const LAS unsigned char* yb, int py, int n0, int ks, f32x4 acc, int lane) {
    const int r16 = lane & 15, g = lane >> 4;
    for (int s = 0; s < ks; ++s) {
        const bf16x8 a = *(const LAS bf16x8*)(xb + (m0 + r16) * px + (32 * s + 8 * g) * 2);
        const bf16x8 b = *(const LAS bf16x8*)(yb + (n0 + r16) * py + (32 * s + 8 * g) * 2);
        acc = mfma16(a, b, acc);
    }
    return acc;
}
DI u32x2 pk4(f32x4 v) { u32x2 w; w.x = pk2(v[0], v[1]); w.y = pk2(v[2], v[3]); return w; }

DI void phase_scan_a(Frame& F, int l) {
    LAS unsigned char* const L = F.lds;
#define MB(n) (L + (n) * 9216)
    LAS float* const Gf = (LAS float*)(L + 110592);
    LAS float* const SEG = (LAS float*)(L + 110592 + 16384);
    LAS float* const GL = SEG + 512;
    LAS unsigned char* const A21 = L + 110592 + 16384 + 2048 + 256;
    LAS unsigned char* const T11T = A21 + 2560;
    LAS unsigned char* const ZT = T11T + 2560;
    const bf16_t* SIr = (const bf16_t*)(F.wsp() + WS_SI); const bf16_t* SIw = SIr + (size_t)T * CW; const bf16_t* SIk = SIw + (size_t)T * CW; const bf16_t* SIa = SIk + (size_t)T * CW; const bf16_t* SIb = SIa + (size_t)T * CW;
    const bf16_t* V = (const bf16_t*)(F.wsp() + (l > 0 ? WS_V1 : WS_VF));
    const int lane = F.lane, wave = F.wave, r16 = lane & 15, g = lane >> 4;
    for (int u = F.bid; u < NUNIT; u += F.G) {
        const int bh = u & 31, c = u >> 5, b = bh >> 3, h = bh & 7;
        const size_t t0 = (size_t)b * SEQ + c * 64;
        unsigned char* const rec1 = F.wsp() + WS_SC1 + (size_t)((bh * 128) + c) * U1_BYTES; unsigned char* const rec2 = F.wsp() + WS_SC2 + (size_t)((bh * 128) + c) * U2_BYTES;
        __syncthreads();
        { const int k = F.tid & 63, seg = F.tid >> 6; float p[8]; float run = 0.f;
#pragma unroll
          for (int e = 0; e < 8; ++e) { run += bf2f(SIw[(t0 + 8 * seg + e) * CW + h * 64 + k]); p[e] = run; }
          SEG[seg * 64 + k] = run;
          __syncthreads();
          float off = 0.f;
#pragma unroll
          for (int s = 0; s < 8; ++s) off += (s < seg) ? SEG[s * 64 + k] : 0.f;
#pragma unroll
          for (int e = 0; e < 8; ++e) Gf[(8 * seg + e) * 64 + k] = off + p[e];
        }
        __syncthreads();
        { const int i = F.tid >> 3, k0 = (F.tid & 7) * 8; const size_t go = (t0 + i) * CW + h * 64 + k0;
          const u32x4 rv = *(const u32x4*)(SIr + go), kv = *(const u32x4*)(SIk + go), av = *(const u32x4*)(SIa + go), bv = *(const u32x4*)(SIb + go), vv = *(const u32x4*)(V + go);
          float fr[8], fk[8], fa[8], fb[8], fv[8];
          const unsigned rw[4] = {rv.x, rv.y, rv.z, rv.w}, kw[4] = {kv.x, kv.y, kv.z, kv.w}, aw[4] = {av.x, av.y, av.z, av.w}, bw[4] = {bv.x, bv.y, bv.z, bv.w}, vw[4] = {vv.x, vv.y, vv.z, vv.w};
#pragma unroll
          for (int q = 0; q < 4; ++q) { fr[2 * q] = bflo(rw[q]); fr[2 * q + 1] = bfhi(rw[q]); fk[2 * q] = bflo(kw[q]); fk[2 * q + 1] = bfhi(kw[q]); fa[2 * q] = bflo(aw[q]); fa[2 * q + 1] = bfhi(aw[q]);
              fb[2 * q] = bflo(bw[q]); fb[2 * q + 1] = bfhi(bw[q]); fv[2 * q] = bflo(vw[q]); fv[2 * q + 1] = bfhi(vw[q]); }
          float at[8], rt[8], bt[8], kt[8], bh8[8], kh8[8];
#pragma unroll
          for (int e = 0; e < 8; ++e) { const float gi = Gf[i * 64 + k0 + e], gp = (i > 0) ? Gf[(i - 1) * 64 + k0 + e] : 0.f, gl = Gf[63 * 64 + k0 + e];
              const float e1 = __expf(gp), e2 = __expf(gi), e3 = __expf(-gi), e4 = __expf(gl - gi);
              at[e] = -fa[e] * e1; rt[e] = fr[e] * e2; bt[e] = fb[e] * e3; kt[e] = fk[e] * e3; bh8[e] = fb[e] * e4; kh8[e] = fk[e] * e4;
              if (i == 63) GL[k0 + e] = e2; }
          u32x4 w;
          w.x = pk2(at[0], at[1]); w.y = pk2(at[2], at[3]); w.z = pk2(at[4], at[5]); w.w = pk2(at[6], at[7]); *(LAS u32x4*)(MB(0) + i * MP + k0 * 2) = w;
          w.x = pk2(rt[0], rt[1]); w.y = pk2(rt[2], rt[3]); w.z = pk2(rt[4], rt[5]); w.w = pk2(rt[6], rt[7]); *(LAS u32x4*)(MB(1) + i * MP + k0 * 2) = w;
          w.x = pk2(bt[0], bt[1]); w.y = pk2(bt[2], bt[3]); w.z = pk2(bt[4], bt[5]); w.w = pk2(bt[6], bt[7]); *(LAS u32x4*)(MB(2) + i * MP + k0 * 2) = w;
          w.x = pk2(kt[0], kt[1]); w.y = pk2(kt[2], kt[3]); w.z = pk2(kt[4], kt[5]); w.w = pk2(kt[6], kt[7]); *(LAS u32x4*)(MB(3) + i * MP + k0 * 2) = w;
#pragma unroll
          for (int e = 0; e < 8; ++e) { const int ro = (k0 + e) * MP + i * 2;
              *(LAS bf16_t*)(MB(4) + ro) = f2bf(at[e]); *(LAS bf16_t*)(MB(5) + ro) = f2bf(fv[e]); *(LAS bf16_t*)(MB(6) + ro) = f2bf(bh8[e]); *(LAS bf16_t*)(MB(7) + ro) = f2bf(kh8[e]); }
        }
        __syncthreads();
        { const int prod = wave >> 1;
          const LAS unsigned char* xb = (prod & 1) ? MB(3) : MB(2); const LAS unsigned char* yb = (prod < 2) ? MB(0) : MB(1);
          LAS unsigned char* ob = (prod == 1) ? MB(8) : (prod == 2) ? MB(9) : MB(10);
          for (int q = 0; q < 8; ++q) { const int tt = (wave & 1) * 8 + q, tm = tt >> 2, tn = tt & 3;
              f32x4 acc = {0.f, 0.f, 0.f, 0.f};
              if (tm <= tn) acc = mm_tile(xb, MP, 16 * tm, yb, MP, 16 * tn, 2, acc, lane);
              const int i = 16 * tn + r16, j0 = 16 * tm + 4 * g;
#pragma unroll
              for (int r = 0; r < 4; ++r) { const int j = j0 + r; const bool keep = (prod < 2) ? (j < i) : (j <= i); if (!keep) acc[r] = 0.f; }
              if (prod == 0) {
                  if ((i >> 5) == (j0 >> 5)) *(LAS f32x4*)(Gf + ((i >> 5) * 32 + (i & 31)) * 32 + (j0 & 31)) = acc;
                  if (i >= 32 && j0 < 32) *(LAS u32x2*)(A21 + (i - 32) * SP + j0 * 2) = pk4(acc);
              } else *(LAS u32x2*)(ob + i * MP + j0 * 2) = pk4(acc);
          } }
        __syncthreads();
        if (wave == 0) {
            const int blk = lane >> 5, cc = lane & 31; const LAS float* AD = Gf + blk * 1024;
            float Tc[32];
#pragma unroll
            for (int i = 0; i < 32; ++i) { float acc = (i == cc) ? 1.f : 0.f;
#pragma unroll
                for (int j = 0; j < i; ++j) acc += AD[i * 32 + j] * Tc[j];
                Tc[i] = acc; }
#pragma unroll
            for (int i = 0; i < 32; ++i) *(LAS bf16_t*)(MB(11) + (32 * blk + i) * MP + (32 * blk + cc) * 2) = f2bf(Tc[i]);
            if (blk == 0) {
#pragma unroll
                for (int q = 0; q < 4; ++q) { u32x4 w; w.x = pk2(Tc[8 * q], Tc[8 * q + 1]); w.y = pk2(Tc[8 * q + 2], Tc[8 * q + 3]); w.z = pk2(Tc[8 * q + 4], Tc[8 * q + 5]); w.w = pk2(Tc[8 * q + 6], Tc[8 * q + 7]);
                    *(LAS u32x4*)(T11T + cc * SP + q * 16) = w; }
            } else {
#pragma unroll
                for (int q = 0; q < 4; ++q) *(LAS u32x4*)(MB(11) + cc * MP + 64 + q * 16) = (u32x4){0u, 0u, 0u, 0u};
            }
        } else {
            for (int tt = wave - 1; tt < 16; tt += 7) { const int tm = tt >> 2, tn = tt & 3;
                f32x4 acc = {0.f, 0.f, 0.f, 0.f};
                acc = mm_tile(MB(8), MP, 16 * tm, MB(5), MP, 16 * tn, 2, acc, lane);
                *(LAS u32x2*)(MB(2) + (16 * tn + r16) * MP + (16 * tm + 4 * g) * 2) = pk4(acc); }
        }
        __syncthreads();
        if (wave < 4) { const int tm = wave >> 1, tn = wave & 1; f32x4 acc = {0.f, 0.f, 0.f, 0.f};
            acc = mm_tile(A21, SP, 16 * tm, T11T, SP, 16 * tn, 1, acc, lane);
            *(LAS u32x2*)(ZT + (16 * tn + r16) * SP + (16 * tm + 4 * g) * 2) = pk4(acc); }
        __syncthreads();
        if (wave < 4) { const int tm = wave >> 1, tn = wave & 1; f32x4 acc = {0.f, 0.f, 0.f, 0.f};
            acc = mm_tile(ZT, SP, 16 * tm, MB(11) + 32 * MP + 64, MP, 16 * tn, 1, acc, lane);
            *(LAS u32x2*)(MB(11) + (32 + 16 * tn + r16) * MP + (16 * tm + 4 * g) * 2) = pk4(acc); }
        __syncthreads();
        { const LAS unsigned char* yb = (wave < 4) ? MB(4) : MB(2); LAS unsigned char* ob = (wave < 4) ? MB(3) : MB(0);
          for (int q = 0; q < 4; ++q) { const int tt = (wave & 3) * 4 + q, tm = tt >> 2, tn = tt & 3;
              f32x4 acc = {0.f, 0.f, 0.f, 0.f};
              acc = mm_tile(MB(11), MP, 16 * tm, yb, MP, 16 * tn, 2, acc, lane);
              *(LAS u32x2*)(ob + (16 * tn + r16) * MP + (16 * tm + 4 * g) * 2) = pk4(acc); } }
        __syncthreads();
        for (int q = 0; q < 2; ++q) { const int tt = wave * 2 + q, tm = tt >> 2, tn = tt & 3;
            { f32x4 acc = {0.f, 0.f, 0.f, 0.f}; acc = mm_tile(MB(3), MP, 16 * tm, MB(9), MP, 16 * tn, 2, acc, lane);
              const int i = 16 * tn + r16, k0 = 16 * tm + 4 * g; const u32x2 rr = *(const LAS u32x2*)(MB(1) + i * MP + k0 * 2);
              acc[0] += bflo(rr.x); acc[1] += bfhi(rr.x); acc[2] += bflo(rr.y); acc[3] += bfhi(rr.y);
              *(u32x2*)(rec1 + U_RPP + (size_t)(i * 64 + permk(k0)) * 2) = pk4(acc); }
            { f32x4 acc = {0.f, 0.f, 0.f, 0.f}; acc = mm_tile(MB(3), MP, 16 * tm, MB(6), MP, 16 * tn, 2, acc, lane);
              const int kp = 16 * tn + r16, k0 = 16 * tm + 4 * g;
#pragma unroll
              for (int r = 0; r < 4; ++r) if (k0 + r == kp) acc[r] += GL[kp];
              *(u32x2*)(rec1 + U_PMP + (size_t)(kp * 64 + permk(k0)) * 2) = pk4(acc); }
            { f32x4 acc = {0.f, 0.f, 0.f, 0.f}; acc = mm_tile(MB(9), MP, 16 * tm, MB(0), MP, 16 * tn, 2, acc, lane); acc = mm_tile(MB(10), MP, 16 * tm, MB(5), MP, 16 * tn, 2, acc, lane);
              *(f32x4*)(rec2 + U_YLT + (size_t)((16 * tn + r16) * 64 + 16 * tm + 4 * g) * 4) = acc; }
            { f32x4 acc = {0.f, 0.f, 0.f, 0.f}; acc = mm_tile(MB(6), MP, 16 * tm, MB(0), MP, 16 * tn, 2, acc, lane); acc = mm_tile(MB(7), MP, 16 * tm, MB(5), MP, 16 * tn, 2, acc, lane);
              *(f32x4*)(rec2 + U_QMT + (size_t)((16 * tn + r16) * 64 + 16 * tm + 4 * g) * 4) = acc; }
        }
    }
#undef MB
}

struct ScanOps { bf16x8 pm[4][2]; f32x4 q[4]; };
DI void scanb_load(ScanOps& o, const unsigned char* r1b, const unsigned char* r2b, int cidx, int v, int r16, int g) {
    asm volatile("" : "+s"(cidx));
    const unsigned char* rec1 = r1b + (size_t)cidx * U1_BYTES; const unsigned char* rec2 = r2b + (size_t)cidx * U2_BYTES;
#pragma unroll
    for (int mt = 0; mt < 4; ++mt)
#pragma unroll
        for (int s = 0; s < 2; ++s) o.pm[mt][s] = *(const bf16x8*)(rec1 + U_PMP + (size_t)((16 * mt + r16) * 64 + 32 * s + 8 * g) * 2);
#pragma unroll
    for (int mt = 0; mt < 4; ++mt) o.q[mt] = *(const f32x4*)(rec2 + U_QMT + (size_t)(v * 64 + 16 * mt + 4 * g) * 4);
}
DI void scanb_step(const ScanOps& o, f32x4 (&sT)[4], bf16_t* sct, int v, int g) {
    bf16x8 hi[2], lo[2];
#pragma unroll
    for (int s = 0; s < 2; ++s) { u32x4 hw, lw;
#pragma unroll
        for (int q = 0; q < 2; ++q) { const f32x4 x = sT[2 * s + q]; const unsigned h0 = pk2(x[0], x[1]), h1 = pk2(x[2], x[3]);
            const unsigned l0 = pk2(x[0] - bflo(h0), x[1] - bfhi(h0)), l1 = pk2(x[2] - bflo(h1), x[3] - bfhi(h1));
            if (q == 0) { hw.x = h0; hw.y = h1; lw.x = l0; lw.y = l1; } else { hw.z = h0; hw.w = h1; lw.z = l0; lw.w = l1; } }
        hi[s] = __builtin_bit_cast(bf16x8, hw); lo[s] = __builtin_bit_cast(bf16x8, lw);
        *(u32x4*)(sct + (size_t)v * 64 + 32 * s + 8 * g) = hw; }
#pragma unroll
    for (int mt = 0; mt < 4; ++mt) { f32x4 n = o.q[mt];
#pragma unroll
        for (int s = 0; s < 2; ++s) { n = mfma16(o.pm[mt][s], hi[s], n); n = mfma16(o.pm[mt][s], lo[s], n); }
        sT[mt] = n; }
}
DI void phase_scan_b(Frame& F) {
    if (F.wave >= 4) return;
    const int lane = F.lane, r16 = lane & 15, g = lane >> 4, v = 16 * F.wave + r16;
    for (int bh = F.bid; bh < NB * NH; bh += F.G) {
        const unsigned char* r1 = F.wsp() + WS_SC1 + (size_t)bh * 128 * U1_BYTES; const unsigned char* r2 = F.wsp() + WS_SC2 + (size_t)bh * 128 * U2_BYTES; bf16_t* sct = (bf16_t*)(F.wsp() + WS_SCT) + (size_t)bh * 128 * 4096;
        f32x4 sT[4];
#pragma unroll
        for (int i = 0; i < 4; ++i) sT[i] = (f32x4){0.f, 0.f, 0.f, 0.f};
        ScanOps o0, o1, o2;
        scanb_load(o0, r1, r2, 0, v, r16, g); scanb_load(o1, r1, r2, 1, v, r16, g); scanb_load(o2, r1, r2, 2, v, r16, g);
        for (int c = 0; c < 126; c += 3) {
            const int c5 = (c + 5 < 128) ? c + 5 : 127;
            scanb_step(o0, sT, sct + (size_t)c * 4096, v, g);       scanb_load(o0, r1, r2, c + 3, v, r16, g);
            scanb_step(o1, sT, sct + (size_t)(c + 1) * 4096, v, g); scanb_load(o1, r1, r2, c + 4, v, r16, g);
            scanb_step(o2, sT, sct + (size_t)(c + 2) * 4096, v, g); scanb_load(o2, r1, r2, c5, v, r16, g);
        }
        scanb_step(o0, sT, sct + (size_t)126 * 4096, v, g);
        scanb_step(o1, sT, sct + (size_t)127 * 4096, v, g);
    }
}

DI void phase_scan_c(Frame& F, int l) {
    const bf16_t* SIr = (const bf16_t*)(F.wsp() + WS_SI); const bf16_t* SIk = SIr + 2 * (size_t)T * CW;
    const bf16_t* V = (const bf16_t*)(F.wsp() + (l > 0 ? WS_V1 : WS_VF)); const bf16_t* Gb = (const bf16_t*)(F.wsp() + WS_G); bf16_t* YR = (bf16_t*)(F.wsp() + WS_YR);
    const float* lng = F.inp(17) + l * CW; const float* lnb = F.inp(18) + l * CW; const float* rkp = F.inp(16) + l * CW;
    const int lane = F.lane, r16 = lane & 15, g = lane >> 4;
    for (int item = F.bid * 8 + F.wave; item < NUNIT * 4; item += F.G * 8) {
        const int u = item >> 2, it = item & 3; const int bh = u & 31, c = u >> 5, b = bh >> 3, h = bh & 7;
        const unsigned char* rec1 = F.wsp() + WS_SC1 + (size_t)((bh * 128) + c) * U1_BYTES; const unsigned char* rec2 = F.wsp() + WS_SC2 + (size_t)((bh * 128) + c) * U2_BYTES; const bf16_t* sct = (const bf16_t*)(F.wsp() + WS_SCT) + (size_t)((bh * 128) + c) * 4096;
        const size_t t0 = (size_t)b * SEQ + c * 64 + 16 * it;
        bf16x8 ra[2];
#pragma unroll
        for (int s = 0; s < 2; ++s) ra[s] = *(const bf16x8*)(rec1 + U_RPP + (size_t)((16 * it + r16) * 64 + 32 * s + 8 * g) * 2);
        f32x4 y[4];
#pragma unroll
        for (int vt = 0; vt < 4; ++vt) { y[vt] = *(const f32x4*)(rec2 + U_YLT + (size_t)((16 * vt + r16) * 64 + 16 * it + 4 * g) * 4);
#pragma unroll
            for (int s = 0; s < 2; ++s) { const bf16x8 sb = *(const bf16x8*)(sct + (size_t)(16 * vt + r16) * 64 + 32 * s + 8 * g); y[vt] = mfma16(ra[s], sb, y[vt]); } }
#pragma unroll
        for (int r = 0; r < 4; ++r) {
            const size_t tok = t0 + 4 * g + r; const size_t o = tok * CW + h * 64 + r16;
            float s1 = (y[0][r] + y[1][r]) + (y[2][r] + y[3][r]);
            s1 += dpp_mov<0xB1>(s1); s1 += dpp_mov<0x4E>(s1); s1 += dpp_mov<0x141>(s1); s1 += dpp_mov<0x140>(s1);
            const float mean = s1 * (1.f / 64.f);
            float d[4], s2 = 0.f;
#pragma unroll
            for (int vt = 0; vt < 4; ++vt) { d[vt] = y[vt][r] - mean; s2 += d[vt] * d[vt]; }
            s2 += dpp_mov<0xB1>(s2); s2 += dpp_mov<0x4E>(s2); s2 += dpp_mov<0x141>(s2); s2 += dpp_mov<0x140>(s2);
            const float rstd = 1.0f / sqrtf(s2 * (1.f / 64.f) + 64e-5f);
            float rr[4], kk[4], vv[4], s3 = 0.f;
#pragma unroll
            for (int vt = 0; vt < 4; ++vt) { rr[vt] = bf2f(SIr[o + 16 * vt]); kk[vt] = bf2f(SIk[o + 16 * vt]); vv[vt] = bf2f(V[o + 16 * vt]); s3 += rr[vt] * kk[vt] * rkp[h * 64 + 16 * vt + r16]; }
            s3 += dpp_mov<0xB1>(s3); s3 += dpp_mov<0x4E>(s3); s3 += dpp_mov<0x141>(s3); s3 += dpp_mov<0x140>(s3);
#pragma unroll
            for (int vt = 0; vt < 4; ++vt) { const int cidx = h * 64 + 16 * vt + r16;
                const float yn = d[vt] * rstd * lng[cidx] + lnb[cidx];
                YR[o + 16 * vt] = f2bf((yn + s3 * vv[vt]) * bf2f(Gb[o + 16 * vt])); }
        }
    }
}
DI void phase_moba_prep(Frame& F, int l) {
    bf16_t* MO = (bf16_t*)(F.wsp() + WS_MO); float* KM = (float*)(F.wsp() + WS_TAB + TB_KMEAN);
    const int c = F.tid; const float qg = F.inp(23)[l * 64 + (c & 63)] * 0.125f, kg = F.inp(24)[l * 64 + (c & 63)];
    for (int span = F.bid; span < T / 256; span += F.G) {
        float ksum = 0.f;
        for (int tt = 0; tt < 256; ++tt) {
            const size_t ro = (size_t)(span * 256 + tt) * 1536;
            const float q = bf2f(MO[ro + c]), k = bf2f(MO[ro + 512 + c]);
            const float qs = wave_sum(q * q) * (1.f / 64.f), ks = wave_sum(k * k) * (1.f / 64.f);
            const float qn = q * (1.0f / sqrtf(qs + 1e-6f)) * qg, kn = k * (1.0f / sqrtf(ks + 1e-6f)) * kg;
            MO[ro + c] = f2bf(qn); MO[ro + 512 + c] = f2bf(kn); ksum += kn;
        }
        KM[(size_t)span * CW + c] = ksum * (1.f / 256.f);
    }
}
DI void phase_moba_gate(Frame& F) {
    LAS float* KL = (LAS float*)F.lds;
    const bf16_t* MO = (const bf16_t*)(F.wsp() + WS_MO); const float* KM = (const float*)(F.wsp() + WS_TAB + TB_KMEAN); unsigned* SEL = (unsigned*)(F.wsp() + WS_SEL);
    for (int span = F.bid; span < T / 64; span += F.G) {
        const int t0 = span * 64, b = t0 / SEQ, blk = (t0 % SEQ) / 256;
        __syncthreads();
        for (int idx = F.tid; idx < blk * 512; idx += 512) { const int j = idx >> 9, cc = idx & 511, h = cc >> 6, d = cc & 63;
            KL[h * 2052 + j * 64 + d] = KM[((size_t)(b * 32 + j)) * CW + cc]; }
        __syncthreads();
        const int tok = F.tid >> 3, h = F.tid & 7; const int t = t0 + tok;
        float q[64];
        { const u32x4* qp = (const u32x4*)(MO + (size_t)t * 1536 + h * 64);
#pragma unroll
          for (int i = 0; i < 8; ++i) { const u32x4 w = qp[i]; q[8 * i] = bflo(w.x); q[8 * i + 1] = bfhi(w.x); q[8 * i + 2] = bflo(w.y); q[8 * i + 3] = bfhi(w.y); q[8 * i + 4] = bflo(w.z); q[8 * i + 5] = bfhi(w.z); q[8 * i + 6] = bflo(w.w); q[8 * i + 7] = bfhi(w.w); } }
        float v0 = -INFINITY, v1 = -INFINITY, v2 = -INFINITY; int i0 = 0, i1 = 1, i2 = 2;
        for (int j = 0; j < blk; ++j) {
            const LAS f32x4* kp = (const LAS f32x4*)(KL + h * 2052 + j * 64); float s = 0.f;
#pragma unroll
            for (int i = 0; i < 16; ++i) { const f32x4 kv = kp[i]; s += q[4 * i] * kv.x + q[4 * i + 1] * kv.y + q[4 * i + 2] * kv.z + q[4 * i + 3] * kv.w; }
            if (s > v0) { v2 = v1; i2 = i1; v1 = v0; i1 = i0; v0 = s; i0 = j; }
            else if (s > v1) { v2 = v1; i2 = i1; v1 = s; i1 = j; }
            else if (s > v2) { v2 = s; i2 = j; }
        }
        const int nv = blk < 3 ? blk : 3;
        SEL[(size_t)t * 8 + h] = (unsigned)i0 | ((unsigned)i1 << 8) | ((unsigned)i2 << 16) | ((unsigned)nv << 24);
    }
}

constexpr int KS_PITCH = 144, VT_PITCH = 520;
DI void phase_moba_attn(Frame& F) {
    LAS unsigned char* Ks = F.lds;
    LAS unsigned char* Vt = F.lds + 36864;
    LAS float* LUT = (LAS float*)(F.lds + 36864 + 33280);
    LAS unsigned* LIST = (LAS unsigned*)(F.lds + 36864 + 33280 + 528);
    LAS unsigned* CNT = LIST + 1024;
    const bf16_t* MO = (const bf16_t*)(F.wsp() + WS_MO); const unsigned* SEL = (const unsigned*)(F.wsp() + WS_SEL);
    bf16_t* PO = (bf16_t*)(F.wsp() + WS_PO); f32x2* PST = (f32x2*)(F.wsp() + WS_PST);
    const float* relb = F.inp(25);
    constexpr int UNITS_PER_BH = 144;
    for (int u = F.bid; u < NB * NH * UNITS_PER_BH; u += F.G) {
        const int bh = u & 31, b = bh >> 3, h = bh & 7; int sid = u >> 5;
        int j = 0; { int rem = sid; for (j = 0; j < 32; ++j) { const int ng = (32 - j + 3) >> 2; if (rem < ng) { sid = rem; break; } rem -= ng; } }
        const int g = sid; const int qb0 = j + 4 * g, qb1 = (qb0 + 3 < 31) ? qb0 + 3 : 31; const int nq = (qb1 - qb0 + 1) * 256;
        const size_t tokb = (size_t)b * SEQ;
        __syncthreads();
        for (int id = F.tid; id < 2048; id += 512) { const int row = id >> 3, c8 = id & 7; const size_t ro = (tokb + j * 256 + row) * 1536 + h * 64 + c8 * 8;
            const u32x4 kv = *(const u32x4*)(MO + ro + 512); *(LAS u32x4*)(Ks + row * KS_PITCH + c8 * 16) = kv;
            const u32x4 vv = *(const u32x4*)(MO + ro + 1024); LAS bf16_t* vp = (LAS bf16_t*)(Vt + (c8 * 8) * VT_PITCH + row * 2);
            vp[0 * (VT_PITCH / 2)] = (bf16_t)(vv.x & 0xffff); vp[1 * (VT_PITCH / 2)] = (bf16_t)(vv.x >> 16); vp[2 * (VT_PITCH / 2)] = (bf16_t)(vv.y & 0xffff); vp[3 * (VT_PITCH / 2)] = (bf16_t)(vv.y >> 16);
            vp[4 * (VT_PITCH / 2)] = (bf16_t)(vv.z & 0xffff); vp[5 * (VT_PITCH / 2)] = (bf16_t)(vv.z >> 16); vp[6 * (VT_PITCH / 2)] = (bf16_t)(vv.w & 0xffff); vp[7 * (VT_PITCH / 2)] = (bf16_t)(vv.w >> 16); }
        if (F.tid <= 128) { const int n = F.tid; int bucket;
            if (n < 16) bucket = n; else { int lg = 16 + (int)(logf((float)n / 16.0f) / 2.0794415416798357f * 16.0f); bucket = lg < 31 ? lg : 31; }
            LUT[n] = relb[bucket * 8 + h]; }
        unsigned ent[2]; bool mem[2];
#pragma unroll
        for (int r = 0; r < 2; ++r) { const int qi = r * 512 + F.tid; mem[r] = false; ent[r] = 0;
            if (qi < nq) { const int q = qb0 * 256 + qi; const int qb = q >> 8;
                if (qb == j) { mem[r] = true; ent[r] = (unsigned)q | (3u << 16); }
                else { const unsigned s = SEL[(tokb + q) * 8 + h]; const unsigned nv = s >> 24;
                    if (nv > 0 && (s & 0xff) == (unsigned)j) { mem[r] = true; ent[r] = (unsigned)q; }
                    else if (nv > 1 && ((s >> 8) & 0xff) == (unsigned)j) { mem[r] = true; ent[r] = (unsigned)q | (1u << 16); }
                    else if (nv > 2 && ((s >> 16) & 0xff) == (unsigned)j) { mem[r] = true; ent[r] = (unsigned)q | (2u << 16); } } }
            const unsigned long long bal = __ballot(mem[r]);
            if (F.lane == 0) CNT[r * 8 + F.wave] = (unsigned)__popcll(bal);
            ent[r] |= (unsigned)__popcll(bal & ((1ull << F.lane) - 1ull)) << 20;
        }
        __syncthreads();
        int total = 0;
        { int base0 = 0, base1 = 0;
#pragma unroll
          for (int i = 0; i < 16; ++i) { const int cnt = (int)CNT[i]; if (i < F.wave) base0 += cnt; if (i < 8 + F.wave) base1 += cnt; total += cnt; }
          if (mem[0]) LIST[base0 + (int)(ent[0] >> 20)] = ent[0] & 0xfffffu;
          if (mem[1]) LIST[base1 + (int)(ent[1] >> 20)] = ent[1] & 0xfffffu; }
        __syncthreads();
        const bool need_lut = (qb0 <= j + 1);
        const float bfar = LUT[128];
        const int ntile = (total + 31) >> 5;
        const int qi = F.lane & 31, half = F.lane >> 5;
        for (int tile = F.wave; tile < ntile; tile += 8) {
            const int e = tile * 32 + qi; const bool valid = e < total; const unsigned en = LIST[valid ? e : total - 1];
            const int q = (int)(en & 0xffffu), slot = (int)(en >> 16); const size_t tok = tokb + q;
            bf16x8 qf[4];
#pragma unroll
            for (int kk = 0; kk < 4; ++kk) qf[kk] = *(const bf16x8*)(MO + tok * 1536 + h * 64 + 16 * kk + 8 * half);
            float mrun = -1e30f, lsum = 0.f;
            f32x16 oacc[2];
#pragma unroll
            for (int i = 0; i < 16; ++i) { oacc[0][i] = 0.f; oacc[1][i] = 0.f; }
            const int qrel = q - j * 256;
#pragma unroll 1
            for (int ck = 0; ck < 4; ++ck) {
                f32x16 sacc[2];
#pragma unroll
                for (int k2 = 0; k2 < 2; ++k2) { const int kt = 2 * ck + k2;
#pragma unroll
                    for (int i = 0; i < 16; ++i) sacc[k2][i] = 0.f;
#pragma unroll
                    for (int kk = 0; kk < 4; ++kk) { const bf16x8 ka = *(const LAS bf16x8*)(Ks + (32 * kt + qi) * KS_PITCH + (16 * kk + 8 * half) * 2);
                        sacc[k2] = __builtin_amdgcn_mfma_f32_32x32x16_bf16(ka, qf[kk], sacc[k2], 0, 0, 0); } }
                float mx = -1e30f;
                if (need_lut) {
#pragma unroll
                    for (int k2 = 0; k2 < 2; ++k2)
#pragma unroll
                        for (int i = 0; i < 16; ++i) { const int key = 32 * (2 * ck + k2) + (i & 3) + 8 * (i >> 2) + 4 * half; const int n = qrel - key;
                            const float bias = LUT[n < 0 ? 0 : (n > 128 ? 128 : n)];
                            const float s = (n < 0) ? -1e30f : sacc[k2][i] + bias; sacc[k2][i] = s; mx = fmaxf(mx, s); }
                } else {
#pragma unroll
                    for (int k2 = 0; k2 < 2; ++k2)
#pragma unroll
                        for (int i = 0; i < 16; ++i) { const float s = sacc[k2][i] + bfar; sacc[k2][i] = s; mx = fmaxf(mx, s); }
                }
                mx = fmaxf(mx, __shfl_xor(mx, 32));
                const float mnew = fmaxf(mrun, mx); const float alpha = __expf(mrun - mnew); mrun = mnew;
                lsum *= alpha;
#pragma unroll
                for (int i = 0; i < 16; ++i) { oacc[0][i] *= alpha; oacc[1][i] *= alpha; }
#pragma unroll
                for (int k2 = 0; k2 < 2; ++k2) { const int kt = 2 * ck + k2;
#pragma unroll
                    for (int i = 0; i < 16; ++i) { const float p = __expf(sacc[k2][i] - mnew); sacc[k2][i] = p; lsum += p; }
#pragma unroll
                    for (int cc = 0; cc < 2; ++cc) {
                        u32x4 pw; pw.x = pk2(sacc[k2][8 * cc], sacc[k2][8 * cc + 1]); pw.y = pk2(sacc[k2][8 * cc + 2], sacc[k2][8 * cc + 3]); pw.z = pk2(sacc[k2][8 * cc + 4], sacc[k2][8 * cc + 5]); pw.w = pk2(sacc[k2][8 * cc + 6], sacc[k2][8 * cc + 7]);
                        const bf16x8 pf = __builtin_bit_cast(bf16x8, pw);
                        const int key0 = 32 * kt + 16 * cc + 4 * half;
#pragma unroll
                        for (int dt = 0; dt < 2; ++dt) { const LAS unsigned char* vb = Vt + (32 * dt + qi) * VT_PITCH + key0 * 2;
                            const u32x2 va = *(const LAS u32x2*)vb, vb2 = *(const LAS u32x2*)(vb + 16);
                            u32x4 vw; vw.x = va.x; vw.y = va.y; vw.z = vb2.x; vw.w = vb2.y;
                            oacc[dt] = __builtin_amdgcn_mfma_f32_32x32x16_bf16(__builtin_bit_cast(bf16x8, vw), pf, oacc[dt], 0, 0, 0); } } }
            }
            const float mx = mrun;
            lsum += __shfl_xor(lsum, 32);
            const float inv = 1.0f / lsum;
            if (valid) {
                bf16_t* op = PO + ((size_t)slot * T + tok) * CW + h * 64;
#pragma unroll
                for (int dt = 0; dt < 2; ++dt)
#pragma unroll
                    for (int ig = 0; ig < 4; ++ig) { u32x2 w; w.x = pk2(oacc[dt][4 * ig] * inv, oacc[dt][4 * ig + 1] * inv); w.y = pk2(oacc[dt][4 * ig + 2] * inv, oacc[dt][4 * ig + 3] * inv);
                        *(u32x2*)(op + 32 * dt + 8 * ig + 4 * half) = w; }
                if (half == 0) PST[((size_t)slot * T + tok) * 8 + h] = (f32x2){mx, lsum};
            }
        }
    }
}
DI void phase_moba_combine(Frame& F) {
    const bf16_t* PO = (const bf16_t*)(F.wsp() + WS_PO); const f32x2* PST = (const f32x2*)(F.wsp() + WS_PST); const unsigned* SEL = (const unsigned*)(F.wsp() + WS_SEL);
    bf16_t* YM = (bf16_t*)(F.wsp() + WS_YM);
    const int c = F.tid, h = c >> 6;
    for (int t = F.bid; t < T; t += F.G) {
        const int nv = (int)(SEL[(size_t)t * 8 + h] >> 24);
        float m[4], lw[4]; float M = -1e30f;
#pragma unroll
        for (int s = 0; s < 4; ++s) { const bool on = (s == 3) || (s < nv); if (on) { const f32x2 st = PST[((size_t)s * T + t) * 8 + h]; m[s] = st.x; lw[s] = st.y; M = fmaxf(M, st.x); } else { m[s] = -1e30f; lw[s] = 0.f; } }
        float den = 0.f, num = 0.f;
#pragma unroll
        for (int s = 0; s < 4; ++s) { const bool on = (s == 3) || (s < nv); if (on) { const float w = lw[s] * __expf(m[s] - M); den += w; num += w * bf2f(PO[((size_t)s * T + t) * CW + c]); } }
        YM[(size_t)t * CW + c] = f2bf(num / den);
    }
}
DI void phase_router(Frame& F, int l) {
    LAS float* xs = (LAS float*)F.lds;
    LAS float* wsm = xs + 64 * 129;
    LAS float* lgt = wsm + 128 * 36;
    LAS float* ssq = lgt + 64 * 37;
    LAS int* hist = (LAS int*)(ssq + 64);
    const float* x = F.outp(); const float* gain = F.inp(2) + (size_t)l * DM;
    const float* wgrp = F.inp(29) + (size_t)l * DM * 4; const float* wexp = F.inp(31) + (size_t)l * DM * 32;
    const float* bgrp = F.inp(30) + l * 4; const float* bexp = F.inp(32) + l * 32;
    int* EID = (int*)(F.wsp() + WS_RT + RT_EID); float* GATE = (float*)(F.wsp() + WS_RT + RT_GATE); int* HIST = (int*)(F.wsp() + WS_RT + RT_HIST);
    const int tok = F.tid & 63, jg = F.tid >> 6;
    for (int tile = F.bid; tile < T / 64; tile += F.G) {
        const int t0 = tile * 64;
        float acc[5] = {0.f, 0.f, 0.f, 0.f, 0.f}; float ss = 0.f;
        if (F.tid < 32) hist[F.tid] = 0;
        for (int kc = 0; kc < DM; kc += 128) {
            __syncthreads();
            for (int idx = F.tid; idx < 64 * 128; idx += 512) { const int r = idx >> 7, k = idx & 127; xs[r * 129 + k] = x[(size_t)(t0 + r) * DM + kc + k]; }
            for (int idx = F.tid; idx < 128 * 36; idx += 512) { const int k = idx / 36, j = idx - k * 36; const float g = gain[kc + k];
                wsm[idx] = g * (j < 4 ? wgrp[(size_t)(kc + k) * 4 + j] : wexp[(size_t)(kc + k) * 32 + (j - 4)]); }
            __syncthreads();
            for (int k = 0; k < 128; ++k) { const float xv = xs[tok * 129 + k]; ss += xv * xv;
#pragma unroll
                for (int i = 0; i < 5; ++i) { const int j = jg + 8 * i; if (j < 36) acc[i] += xv * wsm[k * 36 + j]; } }
        }
#pragma unroll
        for (int i = 0; i < 5; ++i) { const int j = jg + 8 * i; if (j < 36) lgt[tok * 37 + j] = acc[i]; }
        if (jg == 0) ssq[tok] = ss;
        __syncthreads();
        if (F.tid < 64) {
            const int t = t0 + F.tid; const float rs = 1.0f / sqrtf(ssq[F.tid] * (1.f / DM) + 1e-6f);
            float lg[4]; int gs = 0; float gm = -INFINITY;
#pragma unroll
            for (int g = 0; g < 4; ++g) { lg[g] = lgt[F.tid * 37 + g] * rs + bgrp[g]; if (lg[g] > gm) { gm = lg[g]; gs = g; } }
            float gden = 0.f;
#pragma unroll
            for (int g = 0; g < 4; ++g) gden += expf(lg[g] - gm);
            const float ptop = 1.0f / gden;
            float le[8]; float e0 = -INFINITY, e1 = -INFINITY; int j0 = 0, j1 = 1;
#pragma unroll
            for (int e = 0; e < 8; ++e) { le[e] = lgt[F.tid * 37 + 4 + gs * 8 + e] * rs + bexp[gs * 8 + e];
                if (le[e] > e0) { e1 = e0; j1 = j0; e0 = le[e]; j0 = e; } else if (le[e] > e1) { e1 = le[e]; j1 = e; } }
            const float p1 = expf(e1 - e0);
            const float g0 = ptop / (1.f + p1), g1 = ptop * p1 / (1.f + p1);
            const int ex0 = gs * 8 + j0, ex1 = gs * 8 + j1;
            EID[t * 2] = ex0; EID[t * 2 + 1] = ex1; GATE[t * 2] = g0; GATE[t * 2 + 1] = g1;
            __hip_atomic_fetch_add(&hist[ex0], 1, __ATOMIC_RELAXED, __HIP_MEMORY_SCOPE_WORKGROUP); __hip_atomic_fetch_add(&hist[ex1], 1, __ATOMIC_RELAXED, __HIP_MEMORY_SCOPE_WORKGROUP);
        }
        __syncthreads();
        if (F.tid < 32) HIST[tile * 32 + F.tid] = hist[F.tid];
        __syncthreads();
    }
}
DI void phase_moe_gather(Frame& F, int l) {
    LAS int* tot = (LAS int*)F.lds; LAS int* off = tot + 32; LAS int* base = off + 32; LAS int* eidl = base + 32; LAS int* rowl = eidl + 128; LAS int* ps = rowl + 128; LAS int* po = ps + 512;
    const float* x = F.outp(); const float* gain = F.inp(2) + (size_t)l * DM;
    const int* EID = (const int*)(F.wsp() + WS_RT + RT_EID); const float* GATE = (const float*)(F.wsp() + WS_RT + RT_GATE); const int* HIST = (const int*)(F.wsp() + WS_RT + RT_HIST);
    int* ROW = (int*)(F.wsp() + WS_RT + RT_ROW); float* GW = (float*)(F.wsp() + WS_RT + RT_GW); int* PEXP = (int*)(F.wsp() + WS_RT + RT_PEXP);
    bf16_t* AM = (bf16_t*)(F.wsp() + WS_AM);
    for (int tile = F.bid; tile < T / 64; tile += F.G) {
        const int t0 = tile * 64;
        __syncthreads();
        { const int e = F.tid & 31, part = F.tid >> 5; int s = 0, o = 0;
          for (int i = part * 32; i < part * 32 + 32; ++i) { const int v = HIST[i * 32 + e]; s += v; if (i < tile) o += v; }
          ps[F.tid] = s; po[F.tid] = o; }
        if (F.tid < 128) eidl[F.tid] = EID[t0 * 2 + F.tid];
        __syncthreads();
        if (F.tid < 32) { int s = 0, o = 0;
#pragma unroll
            for (int p = 0; p < 16; ++p) { s += ps[p * 32 + F.tid]; o += po[p * 32 + F.tid]; } tot[F.tid] = s; off[F.tid] = o; }
        __syncthreads();
        if (F.tid == 0) {
            int bs = 0; for (int e = 0; e < 32; ++e) { base[e] = bs; bs += (tot[e] + 255) & ~255; }
            if (tile == 0) { int p = 0; for (int e = 0; e < 32; ++e) { const int np = (tot[e] + 255) >> 8; for (int i = 0; i < np; ++i) PEXP[p++] = e; } PEXP[MOE_PANELS] = p; }
        }
        __syncthreads();
        if (F.tid < 128) { const int my = eidl[F.tid]; int rank = 0; for (int i = 0; i < F.tid; ++i) rank += (eidl[i] == my) ? 1 : 0;
            const int r = base[my] + off[my] + rank; rowl[F.tid] = r; ROW[t0 * 2 + F.tid] = r; GW[r] = GATE[t0 * 2 + F.tid]; }
        __syncthreads();
        for (int tk = F.wave; tk < 64; tk += 8) { const int t = t0 + tk;
            rms_row_to_bf16(x + (size_t)t * DM, gain, AM + (size_t)rowl[tk * 2] * DM, AM + (size_t)rowl[tk * 2 + 1] * DM, F.lane); }
    }
}
DI void phase_moe_combine(Frame& F, int l) {
    const bf16_t* YE = (const bf16_t*)(F.wsp() + WS_YE); const int* ROW = (const int*)(F.wsp() + WS_RT + RT_ROW); bf16_t* XN = (bf16_t*)(F.wsp() + WS_XN);
    const float* gain = F.inp(1) + (size_t)(l + 1 < NLAYER ? l + 1 : l) * DM;
    const int gw = F.bid * 8 + F.wave, NGW = F.G * 8;
    for (int t = gw; t < T; t += NGW) {
        const int r0 = ROW[t * 2], r1 = ROW[t * 2 + 1];
        f32x4* xr = (f32x4*)(F.outp() + (size_t)t * DM) + F.lane; const u32x2* y0 = (const u32x2*)(YE + (size_t)r0 * DM) + F.lane; const u32x2* y1 = (const u32x2*)(YE + (size_t)r1 * DM) + F.lane;
        f32x4 v[4]; float s = 0.f;
#pragma unroll
        for (int j = 0; j < 4; ++j) { const u32x2 a = y0[64 * j], b = y1[64 * j]; f32x4 xv = xr[64 * j];
            xv.x += bflo(a.x) + bflo(b.x); xv.y += bfhi(a.x) + bfhi(b.x); xv.z += bflo(a.y) + bflo(b.y); xv.w += bfhi(a.y) + bfhi(b.y);
            v[j] = xv; xr[64 * j] = xv; s += (xv.x * xv.x + xv.y * xv.y) + (xv.z * xv.z + xv.w * xv.w); }
        if (l + 1 < NLAYER) {
            const float rs = 1.0f / sqrtf(wave_sum(s) * (1.f / DM) + 1e-6f);
#pragma unroll
            for (int j = 0; j < 4; ++j) { const f32x4 g = ((const f32x4*)gain)[F.lane + 64 * j]; const f32x4 y = v[j] * rs * g; u32x2 w; w.x = pk2(y.x, y.y); w.y = pk2(y.z, y.w); *((u32x2*)(XN + (size_t)t * DM) + F.lane + 64 * j) = w; }
        }
    }
}

constexpr size_t TB_WRH = 512 * 1024, TB_WRL = TB_WRH + 48 * 1024 * 2;
DI void phase_conv_router(Frame& F, int l) {
    bf16_t* WRH = (bf16_t*)(F.wsp() + WS_TAB + TB_WRH); bf16_t* WRL = (bf16_t*)(F.wsp() + WS_TAB + TB_WRL);
    const float* gain = F.inp(2) + (size_t)l * DM; const float* wgrp = F.inp(29) + (size_t)l * DM * 4; const float* wexp = F.inp(31) + (size_t)l * DM * 32;
    for (int idx = F.bid * 512 + F.tid; idx < 48 * DM; idx += F.G * 512) { const int n = idx >> 10, k = idx & 1023;
        float v = (n < 4) ? wgrp[k * 4 + n] : (n < 36) ? wexp[k * 32 + (n - 4)] : 0.f; v *= gain[k];
        const bf16_t h = f2bf(v); WRH[idx] = h; WRL[idx] = f2bf(v - bf2f(h)); }
}
DI void phase_router2(Frame& F, int l) {
    LAS float* lgt = (LAS float*)F.lds + F.wave * 1024;
    LAS int* hist = (LAS int*)(F.lds + 8 * 4096);
    const float* x = F.outp(); const bf16_t* WRH = (const bf16_t*)(F.wsp() + WS_TAB + TB_WRH); const bf16_t* WRL = (const bf16_t*)(F.wsp() + WS_TAB + TB_WRL);
    const float* bgrp = F.inp(30) + l * 4; const float* bexp = F.inp(32) + l * 32;
    int* EID = (int*)(F.wsp() + WS_RT + RT_EID); float* GATE = (float*)(F.wsp() + WS_RT + RT_GATE); int* HIST = (int*)(F.wsp() + WS_RT + RT_HIST);
    const int lane = F.lane, r16 = lane & 15, g = lane >> 4;
    for (int task = F.bid; task < T / 128; task += F.G) {
        const int t0 = task * 128 + F.wave * 16;
        __syncthreads();
        if (F.tid < 64) hist[F.tid] = 0;
        __syncthreads();
        f32x4 acc[3];
#pragma unroll
        for (int nt = 0; nt < 3; ++nt) acc[nt] = (f32x4){0.f, 0.f, 0.f, 0.f};
        float ss = 0.f;
        const float* xr = x + (size_t)(t0 + r16) * DM + 8 * g;
#pragma unroll 2
        for (int s = 0; s < 32; ++s) {
            const f32x4 x0 = *(const f32x4*)(xr + 32 * s), x1 = *(const f32x4*)(xr + 32 * s + 4);
            ss += (x0.x * x0.x + x0.y * x0.y) + (x0.z * x0.z + x0.w * x0.w) + (x1.x * x1.x + x1.y * x1.y) + (x1.z * x1.z + x1.w * x1.w);
            u32x4 hw, lw; hw.x = pk2(x0.x, x0.y); hw.y = pk2(x0.z, x0.w); hw.z = pk2(x1.x, x1.y); hw.w = pk2(x1.z, x1.w);
            lw.x = pk2(x0.x - bflo(hw.x), x0.y - bfhi(hw.x)); lw.y = pk2(x0.z - bflo(hw.y), x0.w - bfhi(hw.y)); lw.z = pk2(x1.x - bflo(hw.z), x1.y - bfhi(hw.z)); lw.w = pk2(x1.z - bflo(hw.w), x1.w - bfhi(hw.w));
            const bf16x8 ah = __builtin_bit_cast(bf16x8, hw), al = __builtin_bit_cast(bf16x8, lw);
#pragma unroll
            for (int nt = 0; nt < 3; ++nt) { const size_t wo = (size_t)(16 * nt + r16) * DM + 32 * s + 8 * g;
                const bf16x8 bh = *(const bf16x8*)(WRH + wo), bl = *(const bf16x8*)(WRL + wo);
                acc[nt] = mfma16(ah, bh, acc[nt]); acc[nt] = mfma16(ah, bl, acc[nt]); acc[nt] = mfma16(al, bh, acc[nt]); }
        }
        ss += __shfl_xor(ss, 16); ss += __shfl_xor(ss, 32);
#pragma unroll
        for (int nt = 0; nt < 3; ++nt)
#pragma unroll
            for (int r = 0; r < 4; ++r) lgt[(4 * g + r) * 48 + 16 * nt + r16] = acc[nt][r];
        if (g == 0) lgt[768 + r16] = ss;
        LDS_WAIT(); asm volatile("" ::: "memory");
        if (lane < 16) {
            const int t = t0 + lane; const float rs = 1.0f / sqrtf(lgt[768 + lane] * (1.f / DM) + 1e-6f); const LAS float* lr = lgt + lane * 48;
            float lg[4]; int gs = 0; float gm = -INFINITY;
#pragma unroll
            for (int q = 0; q < 4; ++q) { lg[q] = lr[q] * rs + bgrp[q]; if (lg[q] > gm) { gm = lg[q]; gs = q; } }
            float gden = 0.f;
#pragma unroll
            for (int q = 0; q < 4; ++q) gden += expf(lg[q] - gm);
            const float ptop = 1.0f / gden;
            float e0 = -INFINITY, e1 = -INFINITY; int j0 = 0, j1 = 1;
#pragma unroll
            for (int e = 0; e < 8; ++e) { const float le = lr[4 + gs * 8 + e] * rs + bexp[gs * 8 + e];
                if (le > e0) { e1 = e0; j1 = j0; e0 = le; j0 = e; } else if (le > e1) { e1 = le; j1 = e; } }
            const float p1 = expf(e1 - e0);
            const float g0 = ptop / (1.f + p1), g1 = ptop * p1 / (1.f + p1);
            const int ex0 = gs * 8 + j0, ex1 = gs * 8 + j1;
            EID[t * 2] = ex0; EID[t * 2 + 1] = ex1; GATE[t * 2] = g0; GATE[t * 2 + 1] = g1;
            LAS int* hh = hist + (F.wave >> 2) * 32;
            __hip_atomic_fetch_add(&hh[ex0], 1, __ATOMIC_RELAXED, __HIP_MEMORY_SCOPE_WORKGROUP); __hip_atomic_fetch_add(&hh[ex1], 1, __ATOMIC_RELAXED, __HIP_MEMORY_SCOPE_WORKGROUP);
        }
        __syncthreads();
        if (F.tid < 64) HIST[(task * 2 + (F.tid >> 5)) * 32 + (F.tid & 31)] = hist[F.tid];
    }
}
#ifndef MK_PER_PHASE_LAUNCH
#define MK_PER_PHASE_LAUNCH 0
#endif
constexpr int PH_PER_LAYER = 19, NPHASE = PH_PER_LAYER * NLAYER;
struct Args { const float* in[36]; float* out; unsigned char* ws; int ph_lo, ph_hi; };

#ifndef SCAN_NAIVE
#define SCAN_NAIVE 0
#endif
#ifndef PHMASK
#define PHMASK 0x7ffff
#endif
#ifndef DUPMASK
#define DUPMASK 0
#endif
#define NREP(k) ((((DUPMASK) >> (k)) & 1) ? 2 : 1)
#define IN(k) (((PHMASK >> ((k) % PH_PER_LAYER)) & 1) && lo <= (k) && (k) < hi)
#define SEAM(k) do { asm volatile("" : "+s"(barp), "+s"(bar.x)); bar.bar = (unsigned*)barp; if (IN(k) && IN((k) + 1)) xcd_barrier(bar); asm volatile("" : "+s"(F.ws_g), "+s"(F.out_g), "+s"(F.ka), "+s"(F.bid), "+s"(F.G), "+s"(F.lds)); } while (0)
#define FRESH() do { asm volatile("" : "+s"(F.wave)); int l_ = (int)__builtin_amdgcn_mbcnt_hi(~0u, __builtin_amdgcn_mbcnt_lo(~0u, 0u)); asm volatile("" : "+v"(l_)); F.lane = l_; F.tid = F.wave * 64 + l_; } while (0)
__global__ void __launch_bounds__(512, 2) fwd_kernel(Args args) {
    extern __shared__ __attribute__((aligned(16))) unsigned char lds_raw[];
    Frame F;
    F.lds = (LAS unsigned char*)lds_raw;
    F.tid = threadIdx.x; F.lane = F.tid & 63; F.wave = __builtin_amdgcn_readfirstlane(F.tid >> 6);
    F.G = gridDim.x; F.bid = blockIdx.x;
    F.ka = (const __attribute__((address_space(4))) unsigned char*)__builtin_amdgcn_kernarg_segment_ptr();
    F.out_g = (GAS float*)args.out; F.ws_g = (GAS unsigned char*)args.ws;
    volatile LAS unsigned* MISC = (volatile LAS unsigned*)(F.lds + MISC_OFF);
    if (F.tid < 32) MISC[F.tid] = 0u;
    __syncthreads();
    const int lo = args.ph_lo, hi = args.ph_hi;
    GAS unsigned* barp = (GAS unsigned*)(F.ws_g + WS_CTL) + CW_BAR;
    XcdBarrier bar; bar.bar = (unsigned*)barp; bar.x = 0; bar.st = nullptr;
    if (hi - lo > 1) bar = xcd_barrier_post((unsigned*)barp, MISC + 8);

    bf16_t* const XN = (bf16_t*)(F.wsp() + WS_XN);
    bf16_t* const WCAT = (bf16_t*)(F.wsp() + WS_WM + WM_WCAT);
    for (int l = 0; l < NLAYER; ++l) {
        const int P = l * PH_PER_LAYER;
#define PHASE(k) if (IN(P + (k))) for (int rep_ = 0; rep_ < NREP(k); ++rep_)
        PHASE(0) { FRESH(); if (l == 0) { phase_conv_mixer(F, 0); phase_conv_lora2(F, 0); phase_conv_router(F, 0); phase_norm_x(F, F.inp(0), F.inp(1)); } }
        SEAM(P + 0);
        PHASE(1) { FRESH(); pg8::Gemm g{XN, WCAT, T, 2304, DM}; pg8::StaticOrder S; S.init(T, 2304, F.G, F.bid);
            pg8::EpiStore E{(bf16_t*)(F.wsp() + WS_RW), 1536, 1536, (bf16_t*)(F.wsp() + WS_LO), LO_W, 0};
            pg8::gemm_phase<pg8::EpiStore, pg8::StaticOrder>(F.lds, g, S, E, F.tid); }
        SEAM(P + 1);
        PHASE(2) { FRESH(); phase_rwkv_prep2(F, l); }
        SEAM(P + 2);
#if SCAN_NAIVE
        PHASE(3) { FRESH(); phase_rwkv_scan_naive(F, l); }
        SEAM(P + 3);
        SEAM(P + 4);
        PHASE(5) { FRESH(); phase_rwkv_post(F, l); }
        SEAM(P + 5);
#else
        PHASE(3) { FRESH(); phase_scan_a(F, l); }
        SEAM(P + 3);
        PHASE(4) { FRESH(); phase_scan_b(F); }
        SEAM(P + 4);
        PHASE(5) { FRESH(); phase_scan_c(F, l); }
        SEAM(P + 5);
#endif
        PHASE(6) { FRESH(); pg8::Gemm g{XN, WCAT + (size_t)2304 * DM, T, 1536, DM}; pg8::StaticOrder S; S.init(T, 1536, F.G, F.bid);
            pg8::EpiStore E{(bf16_t*)(F.wsp() + WS_MO), 1536, 0, nullptr, 0, 0};
            pg8::gemm_phase<pg8::EpiStore, pg8::StaticOrder>(F.lds, g, S, E, F.tid); }
        SEAM(P + 6);
        PHASE(7) { FRESH(); phase_moba_prep(F, l); }
        SEAM(P + 7);
        PHASE(8) { FRESH(); phase_moba_gate(F); }
        SEAM(P + 8);
        PHASE(9) { FRESH(); phase_moba_attn(F); }
        SEAM(P + 9);
        PHASE(10) { FRESH(); phase_moba_combine(F); }
        SEAM(P + 10);
        PHASE(11) { FRESH(); pg8::Gemm g{XN, WCAT + (size_t)3840 * DM, T, 2048, DM}; pg8::StaticOrder S; S.init(T, 2048, F.G, F.bid);
            pg8::EpiStore E{(bf16_t*)(F.wsp() + WS_GA), 2048, 0, nullptr, 0, 1};
            pg8::gemm_phase<pg8::EpiStore, pg8::StaticOrder>(F.lds, g, S, E, F.tid); }
        SEAM(P + 11);
        PHASE(12) { FRESH();
            { pg8::Gemm g{(const bf16_t*)(F.wsp() + WS_YR), (const bf16_t*)(F.wsp() + WS_WM + WM_BRR), T, DM, CW}; pg8::StaticOrder S; S.init(T, DM, F.G, F.bid);
              pg8::EpiBranch E{(bf16_t*)(F.wsp() + WS_H), (const bf16_t*)(F.wsp() + WS_GA), 0, 1};
              pg8::gemm_phase<pg8::EpiBranch, pg8::StaticOrder>(F.lds, g, S, E, F.tid); }
            asm volatile("s_waitcnt vmcnt(0)" ::: "memory"); __syncthreads();
            { pg8::Gemm g{(const bf16_t*)(F.wsp() + WS_YM), (const bf16_t*)(F.wsp() + WS_WM + WM_BRM), T, DM, CW}; pg8::StaticOrder S; S.init(T, DM, F.G, F.bid);
              pg8::EpiBranch E{(bf16_t*)(F.wsp() + WS_H), (const bf16_t*)(F.wsp() + WS_GA), 1024, 0};
              pg8::gemm_phase<pg8::EpiBranch, pg8::StaticOrder>(F.lds, g, S, E, F.tid); }
        }
        SEAM(P + 12);
        PHASE(13) { FRESH(); pg8::Gemm g{(const bf16_t*)(F.wsp() + WS_H), (const bf16_t*)(F.wsp() + WS_WM + WM_OUT), T, DM, DM}; pg8::StaticOrder S; S.init(T, DM, F.G, F.bid);
            pg8::EpiResid E{l == 0 ? F.inp(0) : F.outp(), F.outp()};
            pg8::gemm_phase<pg8::EpiResid, pg8::StaticOrder>(F.lds, g, S, E, F.tid); }
        SEAM(P + 13);
        PHASE(14) { FRESH(); phase_router2(F, l); phase_conv_experts(F, l); }
        SEAM(P + 14);
        PHASE(15) { FRESH(); phase_moe_gather(F, l); }
        SEAM(P + 15);
        PHASE(16) { FRESH(); const int* PEXP = (const int*)(F.wsp() + WS_RT + RT_PEXP); const int np = __builtin_amdgcn_readfirstlane(PEXP[MOE_PANELS]);
            pg8::Gemm g{(const bf16_t*)(F.wsp() + WS_AM), (const bf16_t*)(F.wsp() + WS_WE), np * 256, 1024, DM}; pg8::GroupOrder S; S.init(np * 256, 1024, F.G, F.bid); S.pexp = PEXP;
            pg8::EpiExpertUp E{(bf16_t*)(F.wsp() + WS_HM), (const float*)(F.wsp() + WS_RT + RT_GW)};
            pg8::gemm_phase<pg8::EpiExpertUp, pg8::GroupOrder>(F.lds, g, S, E, F.tid); }
        SEAM(P + 16);
        PHASE(17) { FRESH(); const int* PEXP = (const int*)(F.wsp() + WS_RT + RT_PEXP); const int np = __builtin_amdgcn_readfirstlane(PEXP[MOE_PANELS]);
            pg8::Gemm g{(const bf16_t*)(F.wsp() + WS_HM), (const bf16_t*)(F.wsp() + WS_WD), np * 256, 1024, DEXP}; pg8::GroupOrder S; S.init(np * 256, 1024, F.G, F.bid); S.pexp = PEXP;
            pg8::EpiStore E{(bf16_t*)(F.wsp() + WS_YE), 1024, 0, nullptr, 0, 0};
            pg8::gemm_phase<pg8::EpiStore, pg8::GroupOrder>(F.lds, g, S, E, F.tid); }
        SEAM(P + 17);
        PHASE(18) { FRESH(); phase_moe_combine(F, l); if (l + 1 < NLAYER) { phase_conv_mixer(F, l + 1); phase_conv_lora2(F, l + 1); phase_conv_router(F, l + 1); } }
        SEAM(P + 18);
#undef PHASE
    }
}

extern "C" void kernel_launch(void* const* d_in, const int* in_sizes, int n_in, void* d_out, int out_size, void* d_ws, size_t ws_size, hipStream_t stream) {
    static int grid = 0;
    if (grid == 0) {
        if (n_in != 36 || out_size != T * DM || ws_size < WS_NEED) { fprintf(stderr, "kernel_launch: unexpected problem (n_in %d, out %d, ws %zu); nothing launched\n", n_in, out_size, ws_size); grid = -1; return; }
        int dev = 0, cus = 0;
        if (hipGetDevice(&dev) != hipSuccess || hipDeviceGetAttribute(&cus, hipDeviceAttributeMultiprocessorCount, dev) != hipSuccess) { grid = -1; return; }
        if (hipFuncSetAttribute((const void*)fwd_kernel, hipFuncAttributeMaxDynamicSharedMemorySize, LDS_BYTES) != hipSuccess) { fprintf(stderr, "kernel_launch: hipFuncSetAttribute failed\n"); grid = -1; return; }
        int per_cu = 0;
        if (hipOccupancyMaxActiveBlocksPerMultiprocessor(&per_cu, (const void*)fwd_kernel, 512, LDS_BYTES) != hipSuccess || per_cu < 1) { fprintf(stderr, "kernel_launch: occupancy query says %d\n", per_cu); }
        (void)hipGetLastError();
        grid = cus;
    }
    if (grid < 0) return;
    (void)hipMemsetAsync((char*)d_ws + WS_CTL, 0, CTL_ZERO_BYTES, stream);
    Args a{};
    for (int i = 0; i < 36; ++i) a.in[i] = (const float*)d_in[i];
    a.out = (float*)d_out; a.ws = (unsigned char*)d_ws;
#if MK_PER_PHASE_LAUNCH
    for (int ph = 0; ph < NPHASE; ++ph) { if (ph == PH_PER_LAYER) continue; a.ph_lo = ph; a.ph_hi = ph + 1; hipLaunchKernelGGL(fwd_kernel, dim3(grid), dim3(512), LDS_BYTES, stream, a); }
#else
    a.ph_lo = 0; a.ph_hi = NPHASE;
    hipLaunchKernelGGL(fwd_kernel, dim3(grid), dim3(512), LDS_BYTES, stream, a);
#endif
}
```

```cpp
#include <hip/hip_runtime.h>
#include <cstdio>
#include <cstdint>
#define LAS __attribute__((address_space(3)))
#define GAS __attribute__((address_space(1)))
#define DI __device__ __forceinline__
typedef unsigned short bf16_t;
typedef short bf16x8 __attribute__((ext_vector_type(8)));
typedef short s16x4 __attribute__((ext_vector_type(4)));
typedef float f32x4 __attribute__((ext_vector_type(4)));
typedef float f32x2 __attribute__((ext_vector_type(2)));
typedef float f32x16 __attribute__((ext_vector_type(16)));
typedef unsigned u32x4 __attribute__((ext_vector_type(4)));
typedef unsigned u32x2 __attribute__((ext_vector_type(2)));
typedef __bf16 bf16v2 __attribute__((ext_vector_type(2)));

DI unsigned pk2(float lo, float hi) { f32x2 v = {lo, hi}; return __builtin_bit_cast(unsigned, __builtin_convertvector(v, bf16v2)); }
DI bf16_t f2bf(float f) { return (bf16_t)(pk2(f, 0.f) & 0xffffu); }
DI float bf2f(bf16_t b) { return __uint_as_float(((unsigned)b) << 16); }
DI float bflo(unsigned w) { return __uint_as_float(w << 16); }
DI float bfhi(unsigned w) { return __uint_as_float(w & 0xffff0000u); }
DI float sigmoidf_(float x) { return 1.0f / (1.0f + __expf(-x)); }

template <int CTRL> DI float dpp_mov(float v) { return __builtin_bit_cast(float, __builtin_amdgcn_update_dpp(0, __builtin_bit_cast(int, v), CTRL, 0xf, 0xf, true)); }
DI float rdlane(float v, int l) { return __builtin_bit_cast(float, __builtin_amdgcn_readlane(__builtin_bit_cast(int, v), l)); }
DI float wave_sum(float v) {
    v += dpp_mov<0xB1>(v);
    v += dpp_mov<0x4E>(v);
    v += dpp_mov<0x141>(v);
    v += dpp_mov<0x140>(v);
    return (rdlane(v, 0) + rdlane(v, 16)) + (rdlane(v, 32) + rdlane(v, 48));
}
DI f32x4 mfma16(bf16x8 a, bf16x8 b, f32x4 c) { return __builtin_amdgcn_mfma_f32_16x16x32_bf16(a, b, c, 0, 0, 0); }
namespace pg8 {
constexpr int BM = 256, BK = 64, HALF = 128, HTB = HALF * BK * 2  , STAGE_BYTES = 8 * HTB, NXCD = 8, WGM = 8;

__host__ __device__ __forceinline__ int lds_byte(int r, int c) { const int st = (r >> 4) * 2 + (c >> 5), rr = r & 15, cc = c & 31, ob = rr * 64 + cc * 2; return st * 1024 + (ob ^ (((ob >> 9) & 1) << 5)); }
__host__ __device__ __forceinline__ void stage_rc(int b, int& R, int& C) { const int st = b / 1024, sb = b % 1024, swz = sb ^ (((sb >> 9) & 1) << 5); R = (st >> 1) * 16 + swz / 64; C = (st & 1) * 32 + (swz % 64) / 2; }
__host__ __device__ __forceinline__ int perm32(int rho) { const int n = rho >> 4, i = rho & 15; return 8 * (i >> 2) + 4 * n + (i & 3); }

struct Unit { int pm, pn, pb; };
struct Gemm { const bf16_t* A; const bf16_t* Bt; int M, N, K; };

struct StaticOrder {
    int nM, nN, nwg, G, c;
    __device__ __forceinline__ void init(int M, int N, int G_, int c_) { nM = M / BM; nN = N / BM; nwg = nM * nN; G = G_; c = c_; }
    __device__ __forceinline__ bool next(int i, Unit& u) const {
        const long L = (long)i * G + c; if (L >= nwg) return false;
        int wgid = (int)L; { const int q = nwg / NXCD, r = nwg % NXCD, xcd = wgid % NXCD, off = wgid / NXCD; wgid = (xcd < r ? xcd * (q + 1) : r * (q + 1) + (xcd - r) * q) + off; }
        const int nig = WGM * nN, gid = wgid / nig, fm = gid * WGM, gsz = (nM - fm) < WGM ? (nM - fm) : WGM;
        u.pm = fm + ((wgid % nig) % gsz); u.pn = (wgid % nig) / gsz; u.pb = u.pn; return true;
    }
};
struct GroupOrder : StaticOrder {
    const int* pexp;
    __device__ __forceinline__ bool next(int i, Unit& u) const {
        if (!StaticOrder::next(i, u)) return false;
        u.pb = __builtin_amdgcn_readfirstlane(pexp[u.pm]) * nN + u.pn; return true;
    }
};

template <class Epi, class Sched, bool ALIGN_EPI = true, bool SP2 = true>
__device__ __forceinline__ void gemm_phase(LAS unsigned char* lds, const Gemm g, const Sched& S, const Epi& E, int tid_in) {
    const int tid = tid_in, wid = __builtin_amdgcn_readfirstlane(tid >> 6), lane = tid & 63, wr = wid >> 2, wc = wid & 3, fr = lane & 15, fq = lane >> 4;
    const int K = g.K, nt = K / BK;
    unsigned voffA[2], voffB[2];
#pragma unroll
    for (int i = 0; i < 2; ++i) { int R, C; stage_rc(tid * 16 + i * 8192, R, C); const int Rb = Epi::PERM ? ((R & ~31) + perm32(R & 31)) : R;
        voffA[i] = (unsigned)(R * K + C) * 2u; voffB[i] = (unsigned)(Rb * K + C) * 2u; }
    const size_t kstep = (size_t)(BK * 2);
    const size_t hstep = (size_t)HALF * K * 2;
    const size_t tstep = 2 * hstep;
    const unsigned ldsw = (unsigned)wid * 1024u;
    const int aoff = lds_byte(wr * 64 + fr, fq * 8), boff = lds_byte(wc * 32 + fr, fq * 8);
#define PG8_SA(b, h) (((b) * 2 + (h)) * HTB)
#define PG8_SB(b, h) ((4 + (b) * 2 + (h)) * HTB)
#define PG8_STAGE(bufoff, gbase, voff) do { _Pragma("unroll") for (int _i = 0; _i < 2; ++_i) \
        __builtin_amdgcn_global_load_lds((const unsigned*)((const char*)(gbase) + (voff)[_i]), (LAS unsigned*)(lds + (bufoff) + ldsw + _i * 8192), 16, 0, 0); } while (0)
#define PG8_LDA(dst, b, h) do { _Pragma("unroll") for (int m = 0; m < 4; ++m) _Pragma("unroll") for (int k = 0; k < 2; ++k) dst[m][k] = *(const LAS bf16x8*)(lds + PG8_SA(b, h) + aoff + m * 2048 + k * 1024); } while (0)
#define PG8_LDB(dst, b, h) do { _Pragma("unroll") for (int n = 0; n < 2; ++n) _Pragma("unroll") for (int k = 0; k < 2; ++k) dst[n][k] = *(const LAS bf16x8*)(lds + PG8_SB(b, h) + boff + n * 2048 + k * 1024); } while (0)
#define PG8_MMA(ai, bj, At, Bt) do { __builtin_amdgcn_s_setprio(1); _Pragma("unroll") for (int m = 0; m < 4; ++m) _Pragma("unroll") for (int n = 0; n < 2; ++n) _Pragma("unroll") for (int k = 0; k < 2; ++k) \
        acc[ai][bj][m][n] = __builtin_amdgcn_mfma_f32_16x16x32_bf16(Bt[n][k], At[m][k], acc[ai][bj][m][n], 0, 0, 0); __builtin_amdgcn_s_setprio(0); } while (0)
#define PG8_WAIT_V(n) asm volatile("s_waitcnt vmcnt(" #n ")" ::: "memory")
#define PG8_WAIT_L(n) asm volatile("s_waitcnt lgkmcnt(" #n ")" ::: "memory")
#define PG8_BAR __builtin_amdgcn_s_barrier()
#define PG8_SCHED __builtin_amdgcn_sched_barrier(0)
    Unit cur, nxt; int ui = 0;
    if (!S.next(0, cur)) return;
    f32x4 acc[2][2][4][2];
#pragma unroll
    for (int a = 0; a < 2; ++a)
#pragma unroll
        for (int b = 0; b < 2; ++b)
#pragma unroll
            for (int m = 0; m < 4; ++m)
#pragma unroll
                for (int n = 0; n < 2; ++n) acc[a][b][m][n] = (f32x4){0.f, 0.f, 0.f, 0.f};
    bf16x8 At[4][2], B0[2][2], B1[2][2];
    const char* cA = (const char*)g.A + (size_t)cur.pm * tstep; const char* cB = (const char*)g.Bt + (size_t)cur.pb * tstep;
    if constexpr (SP2) {
        PG8_STAGE(PG8_SB(0, 0), cB, voffB); PG8_STAGE(PG8_SB(0, 1), cB + hstep, voffB); PG8_STAGE(PG8_SA(0, 0), cA, voffA); PG8_STAGE(PG8_SA(0, 1), cA + hstep, voffA);
        if (wr == 1) PG8_BAR;
        PG8_WAIT_V(2); PG8_BAR;
        PG8_STAGE(PG8_SB(1, 0), cB + kstep, voffB); PG8_STAGE(PG8_SA(1, 0), cA + kstep, voffA); PG8_STAGE(PG8_SB(1, 1), cB + hstep + kstep, voffB);
        PG8_WAIT_V(6); PG8_BAR;
    } else {
        PG8_STAGE(PG8_SB(0, 0), cB, voffB); PG8_STAGE(PG8_SA(0, 0), cA, voffA); PG8_STAGE(PG8_SB(0, 1), cB + hstep, voffB); PG8_STAGE(PG8_SA(0, 1), cA + hstep, voffA);
        if (wr == 1) PG8_BAR;
        PG8_WAIT_V(4); PG8_BAR;
        PG8_STAGE(PG8_SB(1, 0), cB + kstep, voffB); PG8_STAGE(PG8_SA(1, 0), cA + kstep, voffA); PG8_STAGE(PG8_SB(1, 1), cB + hstep + kstep, voffB);
        PG8_WAIT_V(6); PG8_BAR;
    }
    for (;;) {
        const bool has_next = S.next(ui + 1, nxt);
        const char* nA = has_next ? (const char*)g.A + (size_t)nxt.pm * tstep : cA; const char* nB = has_next ? (const char*)g.Bt + (size_t)nxt.pb * tstep : cB;
        for (int t = 0; t < nt; t += 2) {
            const bool last = (t == nt - 2);
            const char* a1 = cA + (size_t)(t + 1) * kstep;
            const char* a2 = last ? nA : cA + (size_t)(t + 2) * kstep; const char* b2 = last ? nB : cB + (size_t)(t + 2) * kstep;
            const char* a3 = a2 + kstep; const char* b3 = b2 + kstep;
            if constexpr (SP2) {
            PG8_LDB(B0, 0, 0); PG8_LDB(B1, 0, 1); PG8_SCHED; PG8_LDA(At, 0, 0); PG8_STAGE(PG8_SA(1, 1), a1 + hstep, voffA);
            PG8_WAIT_V(8); PG8_WAIT_L(0); PG8_BAR; PG8_MMA(0, 0, At, B0); PG8_MMA(0, 1, At, B1); PG8_BAR; PG8_SCHED;
            PG8_LDA(At, 0, 1); PG8_STAGE(PG8_SB(0, 0), b2, voffB); PG8_STAGE(PG8_SB(0, 1), b2 + hstep, voffB); PG8_STAGE(PG8_SA(0, 0), a2, voffA);
            PG8_WAIT_V(8); PG8_WAIT_L(0); PG8_BAR; PG8_MMA(1, 0, At, B0); PG8_MMA(1, 1, At, B1); PG8_BAR; PG8_SCHED;
            PG8_LDB(B0, 1, 0); PG8_LDB(B1, 1, 1); PG8_SCHED; PG8_LDA(At, 1, 0); PG8_STAGE(PG8_SA(0, 1), a2 + hstep, voffA);
            PG8_WAIT_V(8); PG8_WAIT_L(0); PG8_BAR; PG8_MMA(0, 0, At, B0); PG8_MMA(0, 1, At, B1); PG8_BAR; PG8_SCHED;
            PG8_LDA(At, 1, 1); PG8_STAGE(PG8_SB(1, 0), b3, voffB); PG8_STAGE(PG8_SB(1, 1), b3 + hstep, voffB); PG8_STAGE(PG8_SA(1, 0), a3, voffA);
            PG8_WAIT_V(8); PG8_WAIT_L(0); PG8_BAR; PG8_MMA(1, 0, At, B0); PG8_MMA(1, 1, At, B1); PG8_BAR; PG8_SCHED;
            } else {
            PG8_LDB(B0, 0, 0); PG8_SCHED; PG8_LDA(At, 0, 0); PG8_STAGE(PG8_SA(1, 1), a1 + hstep, voffA);
            PG8_WAIT_L(8); PG8_BAR; PG8_WAIT_L(0); PG8_MMA(0, 0, At, B0); PG8_BAR; PG8_SCHED;
            PG8_LDB(B1, 0, 1); PG8_STAGE(PG8_SB(0, 0), b2, voffB);
            PG8_BAR; PG8_WAIT_L(0); PG8_MMA(0, 1, At, B1); PG8_BAR;
            PG8_LDA(At, 0, 1); PG8_STAGE(PG8_SA(0, 0), a2, voffA);
            PG8_BAR; PG8_WAIT_L(0); PG8_MMA(1, 0, At, B0); PG8_BAR; PG8_SCHED;
            PG8_STAGE(PG8_SB(0, 1), b2 + hstep, voffB);
            PG8_WAIT_V(6); PG8_BAR; PG8_MMA(1, 1, At, B1); PG8_BAR;
            PG8_LDB(B0, 1, 0); PG8_SCHED; PG8_LDA(At, 1, 0); PG8_STAGE(PG8_SA(0, 1), a2 + hstep, voffA);
            PG8_WAIT_L(8); PG8_BAR; PG8_WAIT_L(0); PG8_MMA(0, 0, At, B0); PG8_BAR; PG8_SCHED;
            PG8_LDB(B1, 1, 1); PG8_STAGE(PG8_SB(1, 0), b3, voffB);
            PG8_BAR; PG8_WAIT_L(0); PG8_MMA(0, 1, At, B1); PG8_BAR;
            PG8_LDA(At, 1, 1); PG8_STAGE(PG8_SA(1, 0), a3, voffA);
            PG8_BAR; PG8_WAIT_L(0); PG8_MMA(1, 0, At, B0); PG8_BAR; PG8_SCHED;
            PG8_STAGE(PG8_SB(1, 1), b3 + hstep, voffB);
            PG8_WAIT_V(6); PG8_BAR; PG8_MMA(1, 1, At, B1); PG8_BAR;
            }
        }
        if constexpr (ALIGN_EPI) { if (wr == 0) PG8_BAR; }
        E(acc, cur, wr, wc, fr, fq);
        if (!has_next) break;
#pragma unroll
        for (int a = 0; a < 2; ++a)
#pragma unroll
            for (int b = 0; b < 2; ++b)
#pragma unroll
                for (int m = 0; m < 4; ++m)
#pragma unroll
                    for (int n = 0; n < 2; ++n) acc[a][b][m][n] = (f32x4){0.f, 0.f, 0.f, 0.f};
        cur = nxt; cA = nA; cB = nB; ++ui;
        if constexpr (ALIGN_EPI) { if (wr == 1) PG8_BAR; }
    }
    PG8_WAIT_V(0);
    if constexpr (!ALIGN_EPI) { if (wr == 0) PG8_BAR; }
    PG8_BAR;
#undef PG8_SA
#undef PG8_SB
#undef PG8_STAGE
#undef PG8_LDA
#undef PG8_LDB
#undef PG8_MMA
#undef PG8_WAIT_V
#undef PG8_WAIT_L
#undef PG8_BAR
#undef PG8_SCHED
}
}
#define XB_TMO      128
#define XB_XCNT(j)  (256  + 64 * (j))
#define XB_XSUB(j)  (1280 + 64 * (j))
#define XB_XGEN(j)  (2304 + 64 * (j))
#define XB_TOP      3328
#define XB_TOPGEN   3392
#define XCD_BAR_WORDS 3456
#define XB_SPIN_CAP (1u << 18)

__device__ __forceinline__ unsigned xb_ld(unsigned* p)              { return __hip_atomic_load(p, __ATOMIC_RELAXED, __HIP_MEMORY_SCOPE_AGENT); }
__device__ __forceinline__ unsigned xb_add(unsigned* p, unsigned v) { return __hip_atomic_fetch_add(p, v, __ATOMIC_RELAXED, __HIP_MEMORY_SCOPE_AGENT); }
__device__ __forceinline__ unsigned xb_xcc_id() { return (unsigned)__builtin_amdgcn_s_getreg((3 << 11) | 20) & 0xFu; }
#define XB_SPIN(cond, bar) do { unsigned _sp = 0; while (cond) { __builtin_amdgcn_s_sleep(1); \
    if ((++_sp & 255u) == 0u) { if (xb_ld(&(bar)[XB_TMO])) break; if (_sp > XB_SPIN_CAP) { atomicAdd(&(bar)[XB_TMO], 1u); break; } } } } while (0)

struct XcdBarrier {
    unsigned* bar; unsigned x;
    volatile LAS unsigned* st;
};

__device__ __forceinline__ XcdBarrier xcd_barrier_post(unsigned* bar, volatile LAS unsigned* st) {
    XcdBarrier b; b.bar = bar; b.x = xb_xcc_id(); b.st = st;
    if (threadIdx.x == 0) (void)xb_add(&bar[XB_XCNT(b.x)], 1u);
    return b;
}
__device__ __forceinline__ void xcd_barrier_complete(unsigned* bar, unsigned x, unsigned& nloc, unsigned& nx) {
    const unsigned G = gridDim.x * gridDim.y * gridDim.z;
    unsigned sum, cnt, mine, sp = 0u;
    for (;;) {
        sum = 0u; cnt = 0u; mine = 0u;
#pragma unroll
        for (unsigned j = 0; j < 16; ++j) { const unsigned c = xb_ld(&bar[XB_XCNT(j)]); sum += c; cnt += (c > 0u) ? 1u : 0u; mine = (j == x) ? c : mine; }
        if (sum == G) break;
        __builtin_amdgcn_s_sleep(1);
        if ((++sp & 255u) == 0u) { if (xb_ld(&bar[XB_TMO])) break; if (sp > XB_SPIN_CAP) { atomicAdd(&bar[XB_TMO], 1u); break; } }
    }
    nloc = mine > 0u ? mine : 1u; nx = cnt > 0u ? cnt : 1u;
}

__device__ __forceinline__ void xcd_barrier(const XcdBarrier& b) {
    asm volatile("s_waitcnt vmcnt(0)" ::: "memory");
    __syncthreads();
    if (threadIdx.x == 0) {
        unsigned* bar = b.bar;
        __builtin_amdgcn_s_waitcnt(0);
        unsigned nloc = b.st[0], nx = b.st[1];
        if (nloc == 0u) { xcd_barrier_complete(bar, b.x, nloc, nx); b.st[0] = nloc; b.st[1] = nx; }
        const unsigned old = xb_add(&bar[XB_XSUB(b.x)], 1u);
        const unsigned gen = old / nloc;
        if (old + 1u == (gen + 1u) * nloc) {
            __builtin_amdgcn_fence(__ATOMIC_RELEASE, "agent");
            asm volatile("s_waitcnt vmcnt(0)" ::: "memory");
            const unsigned og = xb_add(&bar[XB_TOP], 1u);
            const unsigned tg = og / nx;
            if (og + 1u == (tg + 1u) * nx) xb_add(&bar[XB_TOPGEN], 1u);
            else XB_SPIN(xb_ld(&bar[XB_TOPGEN]) == tg, bar);
            __builtin_amdgcn_fence(__ATOMIC_ACQUIRE, "agent");
            xb_add(&bar[XB_XGEN(b.x)], 1u);
            asm volatile("s_waitcnt vmcnt(0)" ::: "memory");
        } else {
            XB_SPIN(xb_ld(&bar[XB_XGEN(b.x)]) == gen, bar);
            __builtin_amdgcn_fence(__ATOMIC_ACQUIRE, "agent");
            asm volatile("s_waitcnt vmcnt(0)" ::: "memory");
        }
    }
    __syncthreads();
}
constexpr int NB = 4, SEQ = 8192, DM = 1024, T = NB * SEQ;
constexpr int NH = 8, HD = 64, CW = 512;
constexpr int N_IN = 5120;
constexpr int NLAYER = 2;
constexpr int NEXP = 32, DEXP = 512;
constexpr int MOE_ROWS = 73728, MOE_PANELS = MOE_ROWS / 256;
constexpr int WCAT_ROWS = 5888;
constexpr int LO_W = 768;

constexpr size_t MiB = 1u << 20;
constexpr size_t WS_CTL = 0, CTL_ZERO_BYTES = 1 * MiB;
constexpr size_t WS_VF   = 1 * MiB;
constexpr size_t WS_TAB  = 33 * MiB;
constexpr size_t WS_WM   = 34 * MiB;
constexpr size_t WS_XN   = 50 * MiB;
constexpr size_t WS_RW   = 114 * MiB;
constexpr size_t WS_MO   = 114 * MiB;
constexpr size_t WS_LO   = 210 * MiB;
constexpr size_t WS_YR   = 354 * MiB;
constexpr size_t WS_SI   = 258 * MiB;
constexpr size_t WS_V1   = 418 * MiB;
constexpr size_t WS_G    = 450 * MiB;
constexpr size_t WS_YS   = 482 * MiB;
constexpr size_t WS_PO   = 418 * MiB;
constexpr size_t WS_PST  = 386 * MiB;
constexpr size_t WS_YM   = 258 * MiB;
constexpr size_t WS_GA   = 418 * MiB;
constexpr size_t WS_H    = 290 * MiB;
constexpr size_t WS_SC1  = 482 * MiB;
constexpr size_t WS_SC2  = 114 * MiB;
constexpr size_t WS_SCT  = 290 * MiB;
constexpr size_t WS_WE   = 34 * MiB;
constexpr size_t WS_WD   = 98 * MiB;
constexpr size_t WS_AM   = 130 * MiB;
constexpr size_t WS_HM   = 274 * MiB;
constexpr size_t WS_YE   = 346 * MiB;
constexpr size_t WS_RT   = 490 * MiB;
constexpr size_t WS_END  = 556 * MiB;
constexpr size_t TB_KMEAN = 0;
constexpr size_t TB_SEL   = 256 * 1024;
constexpr size_t RT_EID  = 0;
constexpr size_t RT_GATE = 256 * 1024;
constexpr size_t RT_ROW  = 512 * 1024;
constexpr size_t RT_GW   = 768 * 1024;
constexpr size_t RT_HIST = 1280 * 1024;
constexpr size_t RT_PEXP = 1408 * 1024;
constexpr size_t WS_SEL  = 556 * MiB;
constexpr size_t WS_NEED = 558 * MiB;
constexpr int CW_BAR = 4096;

constexpr int RING_BYTES = 131072;
constexpr int LDS_BYTES = 163840;
constexpr int MISC_OFF = LDS_BYTES - 256;
struct Frame {
    LAS unsigned char* lds;
    int tid, lane, wave;
    int G, bid;
    const __attribute__((address_space(4))) unsigned char* ka;
    GAS float* out_g; GAS unsigned char* ws_g;
    DI float* outp() const { return (float*)out_g; }
    DI unsigned char* wsp() const { return (unsigned char*)ws_g; }
    DI const float* inp(int i) const { return (const float*)(*(const GAS float* const __attribute__((address_space(4)))*)(ka + 8 * i)); }
};
#define LDS_WAIT() asm volatile("s_waitcnt lgkmcnt(0)" ::: "memory")

DI void tr_item(const float* src, int ld, int k0, bf16_t* dst, int Kd, const float* sc, int mode, LAS float* scr, int lane) {
#pragma unroll 8
    for (int i = 0; i < 32; ++i) { const int kk = 2 * i + (lane >> 5);
        float v = src ? src[(size_t)(k0 + kk) * ld + (lane & 31)] : 0.f;
        if (mode == 1) v *= sc[k0 + kk]; else if (mode == 2) v *= (1.f - sc[k0 + kk]);
        scr[kk * 33 + (lane & 31)] = v; }
    LDS_WAIT(); asm volatile("" ::: "memory");
    const int c = lane & 7;
#pragma unroll
    for (int j = 0; j < 4; ++j) { const int n = (lane >> 3) + 8 * j; const LAS float* s = scr + (8 * c) * 33 + n;
        u32x4 o; o.x = pk2(s[0 * 33], s[1 * 33]); o.y = pk2(s[2 * 33], s[3 * 33]); o.z = pk2(s[4 * 33], s[5 * 33]); o.w = pk2(s[6 * 33], s[7 * 33]);
        *(u32x4*)(dst + (size_t)n * Kd + k0 + 8 * c) = o; }
    LDS_WAIT(); asm volatile("" ::: "memory");
}

constexpr size_t WM_WCAT = 0, WM_BRR = (size_t)WCAT_ROWS * 1024 * 2, WM_BRM = WM_BRR + 1024 * 512 * 2, WM_OUT = WM_BRM + 1024 * 512 * 2;
DI void phase_conv_mixer(Frame& F, int l) {
    LAS float* scr = (LAS float*)(F.lds + F.wave * 16384);
    const int gw = F.bid * 8 + F.wave, NGW = F.G * 8;
    bf16_t* wcat = (bf16_t*)(F.wsp() + WS_WM + WM_WCAT);
    const float* w_in = F.inp(3) + (size_t)l * DM * N_IN;
    const float* mu_x = F.inp(5) + (size_t)l * 3 * DM;
    constexpr int NBLK = WCAT_ROWS / 32;
    constexpr int I_CAT = NBLK * 16, I_BR = 8 * 32, I_OUT = 16 * 32;
    for (int it = gw; it < I_CAT + 2 * I_BR + I_OUT; it += NGW) {
        int r = it;
        if (r < I_CAT) {
            const int nb = r / 16, kb = r % 16, k0 = kb * 64;
            if (nb < 48) { tr_item(w_in + 32 * nb, N_IN, k0, wcat + (size_t)(32 * nb) * 1024, 1024, nullptr, 0, scr, F.lane); }
            else if (nb < 72) {
                const int q = nb - 48; const float* src = nullptr; int ld = 0; const float* sc = nullptr; int mode = 0;
                if (q < 4)       { src = F.inp(7)  + (size_t)l * DM * 64  + 32 * (q & 1); ld = 64;  sc = mu_x;          mode = (q < 2) ? 2 : 1; }
                else if (q < 8)  { src = F.inp(10) + (size_t)l * DM * 64  + 32 * (q & 1); ld = 64;  sc = mu_x + DM;     mode = (q < 6) ? 2 : 1; }
                else if (q < 16) { src = F.inp(12) + (size_t)l * DM * 128 + 32 * (q & 3); ld = 128; sc = mu_x + 2 * DM; mode = (q < 12) ? 2 : 1; }
                else if (q < 18 && l > 0) { src = F.inp(21) + (size_t)(l - 1) * DM * 32; ld = 32; sc = F.inp(19) + (size_t)(l - 1) * DM; mode = (q == 16) ? 2 : 1; }
                tr_item(src, ld, k0, wcat + (size_t)(1536 + 32 * q) * 1024, 1024, sc, mode, scr, F.lane);
            }
            else if (nb < 120) { tr_item(w_in + 1536 + 32 * (nb - 72), N_IN, k0, wcat + (size_t)(2304 + 32 * (nb - 72)) * 1024, 1024, nullptr, 0, scr, F.lane); }
            else { tr_item(w_in + 3072 + 32 * (nb - 120), N_IN, k0, wcat + (size_t)(3840 + 32 * (nb - 120)) * 1024, 1024, nullptr, 0, scr, F.lane); }
            continue;
        }
        r -= I_CAT;
        if (r < I_BR) { const int nb = r / 8, kb = r % 8; tr_item(F.inp(26) + (size_t)l * 512 * 1024 + 32 * nb, 1024, kb * 64, (bf16_t*)(F.wsp() + WS_WM + WM_BRR) + (size_t)(32 * nb) * 512, 512, nullptr, 0, scr, F.lane); continue; }
        r -= I_BR;
        if (r < I_BR) { const int nb = r / 8, kb = r % 8; tr_item(F.inp(27) + (size_t)l * 512 * 1024 + 32 * nb, 1024, kb * 64, (bf16_t*)(F.wsp() + WS_WM + WM_BRM) + (size_t)(32 * nb) * 512, 512, nullptr, 0, scr, F.lane); continue; }
        r -= I_BR;
        { const int nb = r / 16, kb = r % 16; tr_item(F.inp(28) + (size_t)l * 1024 * 1024 + 32 * nb, 1024, kb * 64, (bf16_t*)(F.wsp() + WS_WM + WM_OUT) + (size_t)(32 * nb) * 1024, 1024, nullptr, 0, scr, F.lane); }
    }
}
DI void tr_block(const float* src, int ld, int k0, int n0, bf16_t* dstbase, int Kd, int mode, LAS float* scr, int tid) {
#pragma unroll
    for (int i = 0; i < 8; ++i) { const int idx = tid + 512 * i, row = idx >> 6, c4 = idx & 63;
        const f32x4 v = *(const f32x4*)(src + (size_t)(k0 + row) * ld + n0 + 4 * c4);
        LAS float* d = scr + row * 257 + 4 * c4; d[0] = v.x; d[1] = v.y; d[2] = v.z; d[3] = v.w; }
    __syncthreads();
#pragma unroll
    for (int i = 0; i < 4; ++i) { const int idx = tid + 512 * i, n = idx >> 3, c = idx & 7; const LAS float* sp = scr + (8 * c) * 257 + n;
        u32x4 o; o.x = pk2(sp[0], sp[257]); o.y = pk2(sp[2 * 257], sp[3 * 257]); o.z = pk2(sp[4 * 257], sp[5 * 257]); o.w = pk2(sp[6 * 257], sp[7 * 257]);
        const int h = n0 + n; const int drow = (mode == 2) ? h : ((h >> 7) * 256 + mode * 128 + (h & 127));
        *(u32x4*)(dstbase + (size_t)drow * Kd + k0 + 8 * c) = o; }
    __syncthreads();
}
DI void phase_conv_experts(Frame& F, int l) {
    LAS float* scr = (LAS float*)F.lds;
    bf16_t* we = (bf16_t*)(F.wsp() + WS_WE); bf16_t* wd = (bf16_t*)(F.wsp() + WS_WD);
    const float* wg = F.inp(33) + (size_t)l * NEXP * DM * DEXP; const float* wu = F.inp(34) + (size_t)l * NEXP * DM * DEXP; const float* wdn = F.inp(35) + (size_t)l * NEXP * DEXP * DM;
    __syncthreads();
    for (int it = F.bid; it < NEXP * 96; it += F.G) {
        const int e = it / 96; int r = it % 96;
        if (r < 64) { const int up = r >> 5; r &= 31; const int kb = r >> 1, nb = r & 1;
            tr_block((up ? wu : wg) + (size_t)e * DM * DEXP, DEXP, kb * 64, nb * 256, we + (size_t)e * 1024 * 1024, 1024, up, scr, F.tid); }
        else { r -= 64; const int kb = r >> 2, nb = r & 3;
            tr_block(wdn + (size_t)e * DEXP * DM, DM, kb * 64, nb * 256, wd + (size_t)e * 1024 * 512, 512, 2, scr, F.tid); }
    }
}
DI void rms_row_to_bf16(const float* xrow, const float* gain, bf16_t* o0, bf16_t* o1, int lane) {
    const f32x4* xr = (const f32x4*)xrow + lane; const f32x4* gr = (const f32x4*)gain + lane;
    f32x4 v[4]; float s = 0.f;
#pragma unroll
    for (int j = 0; j < 4; ++j) { v[j] = xr[64 * j]; s += (v[j].x * v[j].x + v[j].y * v[j].y) + (v[j].z * v[j].z + v[j].w * v[j].w); }
    const float rs = 1.0f / sqrtf(wave_sum(s) * (1.f / DM) + 1e-6f);
#pragma unroll
    for (int j = 0; j < 4; ++j) { const f32x4 g = gr[64 * j]; const f32x4 y = v[j] * rs * g;
        u32x2 w; w.x = pk2(y.x, y.y); w.y = pk2(y.z, y.w);
        *((u32x2*)o0 + lane + 64 * j) = w; if (o1) *((u32x2*)o1 + lane + 64 * j) = w; }
}
DI void phase_norm_x(Frame& F, const float* x, const float* gain) {
    const int gw = F.bid * 8 + F.wave, NGW = F.G * 8; bf16_t* xn = (bf16_t*)(F.wsp() + WS_XN);
    for (int m = gw; m < T; m += NGW) rms_row_to_bf16(x + (size_t)m * DM, gain, xn + (size_t)m * DM, nullptr, F.lane);
}

namespace pg8 {
struct EpiStore {
    static constexpr bool PERM = true;
    bf16_t* O; int ldc; int split; bf16_t* O2; int ldc2; int act;
    __device__ __forceinline__ void operator()(const f32x4 (&acc)[2][2][4][2], const Unit& u, int wr, int wc, int fr, int fq) const {
        const int row0 = u.pm * BM + wr * 64 + fr; int colt = u.pn * BM; bf16_t* base = O; int ld = ldc;
        if (split && colt >= split) { base = O2; ld = ldc2; colt -= split; }
        const int col0 = colt + wc * 32 + 8 * fq;
#pragma unroll
        for (int ai = 0; ai < 2; ++ai)
#pragma unroll
            for (int m = 0; m < 4; ++m) { bf16_t* rowp = base + (size_t)(row0 + ai * HALF + m * 16) * ld + col0;
#pragma unroll
                for (int bj = 0; bj < 2; ++bj) { f32x4 v0 = acc[ai][bj][m][0], v1 = acc[ai][bj][m][1];
                    if (act == 1) {
#pragma unroll
                        for (int j = 0; j < 4; ++j) { v0[j] = sigmoidf_(v0[j]); v1[j] = sigmoidf_(v1[j]); } }
                    u32x4 w; w.x = pk2(v0[0], v0[1]); w.y = pk2(v0[2], v0[3]); w.z = pk2(v1[0], v1[1]); w.w = pk2(v1[2], v1[3]);
                    *(u32x4*)(rowp + bj * HALF) = w; } }
    }
};
struct EpiBranch {
    static constexpr bool PERM = true;
    bf16_t* Hout; const bf16_t* gate; int gcol0; int first;
    __device__ __forceinline__ void operator()(const f32x4 (&acc)[2][2][4][2], const Unit& u, int wr, int wc, int fr, int fq) const {
        const int row0 = u.pm * BM + wr * 64 + fr; const int col0 = u.pn * BM + wc * 32 + 8 * fq;
#pragma unroll
        for (int ai = 0; ai < 2; ++ai)
#pragma unroll
            for (int m = 0; m < 4; ++m) { const size_t row = (size_t)(row0 + ai * HALF + m * 16);
#pragma unroll
                for (int bj = 0; bj < 2; ++bj) {
                    const u32x4 gv = *(const u32x4*)(gate + row * 2048 + gcol0 + col0 + bj * HALF);
                    bf16_t* hp = Hout + row * 1024 + col0 + bj * HALF;
                    f32x4 v0 = acc[ai][bj][m][0], v1 = acc[ai][bj][m][1];
                    v0[0] *= bflo(gv.x); v0[1] *= bfhi(gv.x); v0[2] *= bflo(gv.y); v0[3] *= bfhi(gv.y);
                    v1[0] *= bflo(gv.z); v1[1] *= bfhi(gv.z); v1[2] *= bflo(gv.w); v1[3] *= bfhi(gv.w);
                    if (!first) { const u32x4 hv = *(const u32x4*)hp;
                        v0[0] += bflo(hv.x); v0[1] += bfhi(hv.x); v0[2] += bflo(hv.y); v0[3] += bfhi(hv.y);
                        v1[0] += bflo(hv.z); v1[1] += bfhi(hv.z); v1[2] += bflo(hv.w); v1[3] += bfhi(hv.w); }
                    u32x4 w; w.x = pk2(v0[0], v0[1]); w.y = pk2(v0[2], v0[3]); w.z = pk2(v1[0], v1[1]); w.w = pk2(v1[2], v1[3]);
                    *(u32x4*)hp = w; } }
    }
};
struct EpiResid {
    static constexpr bool PERM = false;
    const float* xin; float* out;
    __device__ __forceinline__ void operator()(const f32x4 (&acc)[2][2][4][2], const Unit& u, int wr, int wc, int fr, int fq) const {
        const int row0 = u.pm * BM + wr * 64 + fr, col0 = u.pn * BM + wc * 32 + 4 * fq;
#pragma unroll
        for (int ai = 0; ai < 2; ++ai)
#pragma unroll
            for (int m = 0; m < 4; ++m) { const size_t off = (size_t)(row0 + ai * HALF + m * 16) * 1024 + col0;
#pragma unroll
                for (int bj = 0; bj < 2; ++bj)
#pragma unroll
                    for (int n = 0; n < 2; ++n) { const f32x4 xv = *(const f32x4*)(xin + off + bj * HALF + n * 16); *(f32x4*)(out + off + bj * HALF + n * 16) = xv + acc[ai][bj][m][n]; } }
    }
};
struct EpiExpertUp {
    static constexpr bool PERM = true;
    bf16_t* HM; const float* gw;
    __device__ __forceinline__ void operator()(const f32x4 (&acc)[2][2][4][2], const Unit& u, int wr, int wc, int fr, int fq) const {
        const int row0 = u.pm * BM + wr * 64 + fr; const int col0 = u.pn * 128 + wc * 32 + 8 * fq;
#pragma unroll
        for (int ai = 0; ai < 2; ++ai)
#pragma unroll
            for (int m = 0; m < 4; ++m) { const size_t row = (size_t)(row0 + ai * HALF + m * 16); const float gwt = gw[row];
                f32x4 v0, v1;
#pragma unroll
                for (int j = 0; j < 4; ++j) { const float g0 = acc[ai][0][m][0][j], g1 = acc[ai][0][m][1][j];
                    v0[j] = g0 * sigmoidf_(g0) * acc[ai][1][m][0][j] * gwt; v1[j] = g1 * sigmoidf_(g1) * acc[ai][1][m][1][j] * gwt; }
                u32x4 w; w.x = pk2(v0[0], v0[1]); w.y = pk2(v0[2], v0[3]); w.z = pk2(v1[0], v1[1]); w.w = pk2(v1[2], v1[3]);
                *(u32x4*)(HM + row * 512 + col0) = w; }
    }
};
}
constexpr size_t SI_PLANE = (size_t)T * CW * 2;
DI float softplusf_(float z) { return fmaxf(z, 0.f) + log1pf(__expf(-fabsf(z))); }

DI void phase_rwkv_prep(Frame& F, int l) {
    LAS float* act = (LAS float*)F.lds;
    const bf16_t* RW = (const bf16_t*)(F.wsp() + WS_RW); const bf16_t* LO = (const bf16_t*)(F.wsp() + WS_LO);
    bf16_t* SIr = (bf16_t*)(F.wsp() + WS_SI); bf16_t* SIw = SIr + (size_t)T * CW; bf16_t* SIk = SIw + (size_t)T * CW; bf16_t* SIa = SIk + (size_t)T * CW; bf16_t* SIb = SIa + (size_t)T * CW;
    bf16_t* VF = (bf16_t*)(F.wsp() + WS_VF); bf16_t* V1 = (bf16_t*)(F.wsp() + WS_V1); bf16_t* Gb = (bf16_t*)(F.wsp() + WS_G);
    int c = F.tid;
    const float* w2 = F.inp(8) + (size_t)l * 64 * CW; const float* a2 = F.inp(11) + (size_t)l * 64 * CW; const float* g2 = F.inp(13) + (size_t)l * 128 * CW;
    const float* v2 = F.inp(22);
    const float mu_r = F.inp(4)[(size_t)l * 3 * CW + c], mu_k = F.inp(4)[(size_t)l * 3 * CW + CW + c], mu_v = F.inp(4)[(size_t)l * 3 * CW + 2 * CW + c];
    const float w0c = F.inp(6)[l * CW + c], a0c = F.inp(9)[l * CW + c], kkc = F.inp(14)[l * CW + c], kac = F.inp(15)[l * CW + c];
    const float v0c = l > 0 ? F.inp(20)[c] : 0.f;
    for (int tile = F.bid; tile < T / 8; tile += F.G) {
        int t0 = tile * 8; asm volatile("" : "+s"(t0), "+v"(c));
        __syncthreads();
        for (int idx = F.tid; idx < 8 * 288; idx += 512) {
            const int tt = idx / 288, j = idx - tt * 288; const int t = t0 + tt; const bool has_prev = (t % SEQ) != 0;
            int pj, qj;
            if (j < 64) { pj = j; qj = 64 + j; } else if (j < 128) { pj = 128 + (j - 64); qj = 192 + (j - 64); } else if (j < 256) { pj = 256 + (j - 128); qj = 384 + (j - 128); } else { pj = 512 + (j - 256); qj = 544 + (j - 256); }
            float v = bf2f(LO[(size_t)t * LO_W + pj]); if (has_prev) v += bf2f(LO[(size_t)(t - 1) * LO_W + qj]);
            if (j < 64) v = tanhf(v); else if (j >= 128 && j < 256) v = sigmoidf_(v);
            act[j * 8 + tt] = v;
        }
        __syncthreads();
        float aw[8], aa[8], ag[8], av[8];
#pragma unroll
        for (int i = 0; i < 8; ++i) { aw[i] = 0.f; aa[i] = 0.f; ag[i] = 0.f; av[i] = 0.f; }
        for (int j = 0; j < 64; ++j) { const float w = w2[j * CW + c]; const LAS f32x4* ap = (const LAS f32x4*)(act + j * 8);
#pragma unroll
            for (int q = 0; q < 2; ++q) { const f32x4 x = ap[q]; aw[4 * q] += x.x * w; aw[4 * q + 1] += x.y * w; aw[4 * q + 2] += x.z * w; aw[4 * q + 3] += x.w * w; } }
        for (int j = 0; j < 64; ++j) { const float w = a2[j * CW + c]; const LAS f32x4* ap = (const LAS f32x4*)(act + (64 + j) * 8);
#pragma unroll
            for (int q = 0; q < 2; ++q) { const f32x4 x = ap[q]; aa[4 * q] += x.x * w; aa[4 * q + 1] += x.y * w; aa[4 * q + 2] += x.z * w; aa[4 * q + 3] += x.w * w; } }
        for (int j = 0; j < 128; ++j) { const float w = g2[j * CW + c]; const LAS f32x4* ap = (const LAS f32x4*)(act + (128 + j) * 8);
#pragma unroll
            for (int q = 0; q < 2; ++q) { const f32x4 x = ap[q]; ag[4 * q] += x.x * w; ag[4 * q + 1] += x.y * w; ag[4 * q + 2] += x.z * w; ag[4 * q + 3] += x.w * w; } }
        if (l > 0) for (int j = 0; j < 32; ++j) { const float w = v2[j * CW + c]; const LAS f32x4* ap = (const LAS f32x4*)(act + (256 + j) * 8);
#pragma unroll
            for (int q = 0; q < 2; ++q) { const f32x4 x = ap[q]; av[4 * q] += x.x * w; av[4 * q + 1] += x.y * w; av[4 * q + 2] += x.z * w; av[4 * q + 3] += x.w * w; } }
#pragma unroll
        for (int tt = 0; tt < 8; ++tt) {
            const int t = t0 + tt; const bool has_prev = (t % SEQ) != 0; const size_t ro = (size_t)t * 1536;
            const float rp = bf2f(RW[ro + c]), kp = bf2f(RW[ro + 512 + c]), vp = bf2f(RW[ro + 1024 + c]);
            float rq = 0.f, kq = 0.f, vq = 0.f;
            if (has_prev) { rq = bf2f(RW[ro - 1536 + c]); kq = bf2f(RW[ro - 1536 + 512 + c]); vq = bf2f(RW[ro - 1536 + 1024 + c]); }
            const float r = rp + (rq - rp) * mu_r, k = kp + (kq - kp) * mu_k; float v = vp + (vq - vp) * mu_v;
            const float wl = -softplusf_(-(w0c + aw[tt])) - 0.5f;
            const float lw = -__expf(wl);
            const float alr = sigmoidf_(a0c + aa[tt]);
            const size_t o = (size_t)t * CW + c;
            if (l > 0) { const float vf = bf2f(VF[o]); v = v + (vf - v) * sigmoidf_(v0c + av[tt]); V1[o] = f2bf(v); } else { VF[o] = f2bf(v); }
            float kk = k * kkc; const float nrm = sqrtf(wave_sum(kk * kk)); kk = kk / fmaxf(nrm, 1e-12f);
            const float k2 = k * (1.f + (alr - 1.f) * kac);
            SIr[o] = f2bf(r); SIw[o] = f2bf(lw); SIk[o] = f2bf(k2); SIa[o] = f2bf(kk); SIb[o] = f2bf(kk * alr); Gb[o] = f2bf(ag[tt]);
            asm volatile("" ::: "memory");
        }
    }
}

DI void phase_rwkv_scan_naive(Frame& F, int l) {
    LAS float* Lr = (LAS float*)F.lds; LAS float* Lw = Lr + 4096; LAS float* Lk = Lw + 4096; LAS float* La = Lk + 4096; LAS float* Lb = La + 4096;
    LAS float* Lv = Lb + 4096; LAS float* Ly = Lv + 512;
    const bf16_t* SIr = (const bf16_t*)(F.wsp() + WS_SI); const bf16_t* SIw = SIr + (size_t)T * CW; const bf16_t* SIk = SIw + (size_t)T * CW; const bf16_t* SIa = SIk + (size_t)T * CW; const bf16_t* SIb = SIa + (size_t)T * CW;
    const bf16_t* V = (const bf16_t*)(F.wsp() + (l > 0 ? WS_V1 : WS_VF)); float* YS = (float*)(F.wsp() + WS_YS);
    for (int u = F.bid; u < 256; u += F.G) {
        const int b = u >> 6, h = (u >> 3) & 7, rg = u & 7;
        float S = 0.f;
        for (int ch = 0; ch < SEQ / 64; ++ch) {
            const size_t tb = (size_t)b * SEQ + ch * 64;
            __syncthreads();
            for (int idx = F.tid; idx < 4096; idx += 512) { const int s = idx >> 6, kx = idx & 63; const size_t o = (tb + s) * CW + h * 64 + kx;
                Lr[idx] = bf2f(SIr[o]); Lw[idx] = __expf(bf2f(SIw[o])); Lk[idx] = bf2f(SIk[o]); La[idx] = -bf2f(SIa[o]); Lb[idx] = bf2f(SIb[o]); }
            { const int s = F.tid >> 3, rr = F.tid & 7; Lv[F.tid] = bf2f(V[(tb + s) * CW + h * 64 + rg * 8 + rr]); }
            __syncthreads();
#pragma unroll 4
            for (int s = 0; s < 64; ++s) {
                const float a = La[s * 64 + F.lane], w = Lw[s * 64 + F.lane], bb = Lb[s * 64 + F.lane], kk = Lk[s * 64 + F.lane], r = Lr[s * 64 + F.lane], v = Lv[s * 8 + F.wave];
                const float sa = wave_sum(S * a);
                S = S * w + sa * bb + v * kk;
                const float y = wave_sum(S * r);
                if (F.lane == 0) Ly[s * 8 + F.wave] = y;
            }
            __syncthreads();
            { const int s = F.tid >> 3, rr = F.tid & 7; YS[(tb + s) * CW + h * 64 + rg * 8 + rr] = Ly[F.tid]; }
        }
    }
}

DI void phase_rwkv_post(Frame& F, int l) {
    const float* YS = (const float*)(F.wsp() + WS_YS);
    const bf16_t* SIr = (const bf16_t*)(F.wsp() + WS_SI); const bf16_t* SIk = SIr + 2 * (size_t)T * CW;
    const bf16_t* V = (const bf16_t*)(F.wsp() + (l > 0 ? WS_V1 : WS_VF)); const bf16_t* Gb = (const bf16_t*)(F.wsp() + WS_G); bf16_t* YR = (bf16_t*)(F.wsp() + WS_YR);
    const int c = F.tid; const float lg = F.inp(17)[l * CW + c], lb = F.inp(18)[l * CW + c], rk = F.inp(16)[l * CW + c];
    for (int t = F.bid; t < T; t += F.G) {
        const size_t o = (size_t)t * CW + c;
        const float y = YS[o]; const float mean = wave_sum(y) * (1.f / 64.f); const float d = y - mean; const float var = wave_sum(d * d) * (1.f / 64.f);
        const float yn = d * (1.0f / sqrtf(var + 64e-5f)) * lg + lb;
        const float r = bf2f(SIr[o]), k = bf2f(SIk[o]), v = bf2f(V[o]);
        const float bonus = wave_sum(r * k * rk) * v;
        YR[o] = f2bf((yn + bonus) * bf2f(Gb[o]));
    }
}

constexpr int ACT_P = 592;
constexpr size_t WM_L2T = (size_t)WCAT_ROWS * 1024 * 2 + 2 * 1024 * 512 * 2 + 1024 * 1024 * 2;
DI void phase_conv_lora2(Frame& F, int l) {
    bf16_t* L2T = (bf16_t*)(F.wsp() + WS_WM + WM_L2T);
    const float* w2 = F.inp(8) + (size_t)l * 64 * CW; const float* a2 = F.inp(11) + (size_t)l * 64 * CW; const float* g2 = F.inp(13) + (size_t)l * 128 * CW; const float* v2 = F.inp(22);
    for (int idx = F.bid * 512 + F.tid; idx < 288 * CW; idx += F.G * 512) { const int j = idx >> 9, c = idx & 511;
        float v;
        if (j < 64) v = w2[j * CW + c]; else if (j < 128) v = a2[(j - 64) * CW + c]; else if (j < 256) v = g2[(j - 128) * CW + c]; else v = (l > 0) ? v2[(j - 256) * CW + c] : 0.f;
        L2T[c * 288 + j] = f2bf(v); }
}
DI float row16_sum(float v) { v += dpp_mov<0xB1>(v); v += dpp_mov<0x4E>(v); v += dpp_mov<0x141>(v); v += dpp_mov<0x140>(v); return v; }
DI void phase_rwkv_prep2(Frame& F, int l) {
    LAS unsigned char* act = F.lds;
    const bf16_t* RW = (const bf16_t*)(F.wsp() + WS_RW); const bf16_t* LO = (const bf16_t*)(F.wsp() + WS_LO); const unsigned char* L2T = F.wsp() + WS_WM + WM_L2T;
    bf16_t* SIr = (bf16_t*)(F.wsp() + WS_SI); bf16_t* SIw = SIr + (size_t)T * CW; bf16_t* SIk = SIw + (size_t)T * CW; bf16_t* SIa = SIk + (size_t)T * CW; bf16_t* SIb = SIa + (size_t)T * CW;
    bf16_t* VF = (bf16_t*)(F.wsp() + WS_VF); bf16_t* V1 = (bf16_t*)(F.wsp() + WS_V1); bf16_t* Gb = (bf16_t*)(F.wsp() + WS_G);
    const int lane = F.lane, r16 = lane & 15, g = lane >> 4, cb = 64 * F.wave + r16;
    float mu_r[4], mu_k[4], mu_v[4], w0c[4], a0c[4], kkc[4], kac[4], v0c[4];
#pragma unroll
    for (int ct = 0; ct < 4; ++ct) { const int c = cb + 16 * ct;
        mu_r[ct] = F.inp(4)[(size_t)l * 3 * CW + c]; mu_k[ct] = F.inp(4)[(size_t)l * 3 * CW + CW + c]; mu_v[ct] = F.inp(4)[(size_t)l * 3 * CW + 2 * CW + c];
        w0c[ct] = F.inp(6)[l * CW + c]; a0c[ct] = F.inp(9)[l * CW + c]; kkc[ct] = F.inp(14)[l * CW + c]; kac[ct] = F.inp(15)[l * CW + c]; v0c[ct] = l > 0 ? F.inp(20)[c] : 0.f; }
    for (int tile = F.bid; tile < T / 64; tile += F.G) {
        int t0 = tile * 64; asm volatile("" : "+s"(t0));
        __syncthreads();
        for (int grp = F.tid; grp < 64 * 36; grp += 512) { const int tt = grp / 36, jg = grp - tt * 36, j0 = 8 * jg; const int t = t0 + tt; const bool has_prev = (t % SEQ) != 0;
            int pj, qj; if (j0 < 64) { pj = j0; qj = 64 + j0; } else if (j0 < 128) { pj = 128 + (j0 - 64); qj = 192 + (j0 - 64); } else if (j0 < 256) { pj = 256 + (j0 - 128); qj = 384 + (j0 - 128); } else { pj = 512 + (j0 - 256); qj = 544 + (j0 - 256); }
            const u32x4 pv = *(const u32x4*)(LO + (size_t)t * LO_W + pj); u32x4 qv = {0u, 0u, 0u, 0u}; if (has_prev) qv = *(const u32x4*)(LO + (size_t)(t - 1) * LO_W + qj);
            const unsigned pw[4] = {pv.x, pv.y, pv.z, pv.w}, qw[4] = {qv.x, qv.y, qv.z, qv.w}; float v[8];
#pragma unroll
            for (int q = 0; q < 4; ++q) { v[2 * q] = bflo(pw[q]) + bflo(qw[q]); v[2 * q + 1] = bfhi(pw[q]) + bfhi(qw[q]); }
            if (j0 < 64) {
#pragma unroll
                for (int e = 0; e < 8; ++e) v[e] = tanhf(v[e]);
            } else if (j0 >= 128 && j0 < 256) {
#pragma unroll
                for (int e = 0; e < 8; ++e) v[e] = sigmoidf_(v[e]);
            }
            u32x4 w; w.x = pk2(v[0], v[1]); w.y = pk2(v[2], v[3]); w.z = pk2(v[4], v[5]); w.w = pk2(v[6], v[7]);
            *(LAS u32x4*)(act + tt * ACT_P + j0 * 2) = w; }
        __syncthreads();
#pragma unroll 1
        for (int tt = 0; tt < 4; ++tt) {
            bf16x8 a[9];
#pragma unroll
            for (int s = 0; s < 9; ++s) a[s] = *(const LAS bf16x8*)(act + (16 * tt + r16) * ACT_P + (32 * s + 8 * g) * 2);
            f32x4 aw[4], aa[4], ag[4], av[4];
#pragma unroll
            for (int ct = 0; ct < 4; ++ct) { const unsigned char* wrow = L2T + (size_t)(cb + 16 * ct) * 576 + 16 * g;
                f32x4 x = {0.f, 0.f, 0.f, 0.f};
                x = mfma16(a[0], *(const bf16x8*)(wrow), x); x = mfma16(a[1], *(const bf16x8*)(wrow + 64), x); aw[ct] = x;
                x = (f32x4){0.f, 0.f, 0.f, 0.f};
                x = mfma16(a[2], *(const bf16x8*)(wrow + 128), x); x = mfma16(a[3], *(const bf16x8*)(wrow + 192), x); aa[ct] = x;
                x = (f32x4){0.f, 0.f, 0.f, 0.f};
                x = mfma16(a[4], *(const bf16x8*)(wrow + 256), x); x = mfma16(a[5], *(const bf16x8*)(wrow + 320), x); x = mfma16(a[6], *(const bf16x8*)(wrow + 384), x); x = mfma16(a[7], *(const bf16x8*)(wrow + 448), x); ag[ct] = x;
                x = (f32x4){0.f, 0.f, 0.f, 0.f};
                if (l > 0) x = mfma16(a[8], *(const bf16x8*)(wrow + 512), x);
                av[ct] = x; }
#pragma unroll
            for (int r = 0; r < 4; ++r) {
                const int t = t0 + 16 * tt + 4 * g + r; const bool has_prev = (t % SEQ) != 0; const size_t ro = (size_t)t * 1536;
                float kq[4], kkv[4], alr[4]; float ss = 0.f;
#pragma unroll
                for (int ct = 0; ct < 4; ++ct) { const int c = cb + 16 * ct; const size_t o = (size_t)t * CW + c;
                    const float rp = bf2f(RW[ro + c]), kp = bf2f(RW[ro + 512 + c]), vp = bf2f(RW[ro + 1024 + c]);
                    float rq = 0.f, kq_ = 0.f, vq = 0.f;
                    if (has_prev) { rq = bf2f(RW[ro - 1536 + c]); kq_ = bf2f(RW[ro - 1536 + 512 + c]); vq = bf2f(RW[ro - 1536 + 1024 + c]); }
                    const float rr = rp + (rq - rp) * mu_r[ct], k = kp + (kq_ - kp) * mu_k[ct]; float v = vp + (vq - vp) * mu_v[ct];
                    const float wl = -softplusf_(-(w0c[ct] + aw[ct][r])) - 0.5f; const float lw = -__expf(wl);
                    alr[ct] = sigmoidf_(a0c[ct] + aa[ct][r]);
                    if (l > 0) { const float vf = bf2f(VF[o]); v = v + (vf - v) * sigmoidf_(v0c[ct] + av[ct][r]); V1[o] = f2bf(v); } else { VF[o] = f2bf(v); }
                    kq[ct] = k; kkv[ct] = k * kkc[ct]; ss += kkv[ct] * kkv[ct];
                    SIr[o] = f2bf(rr); SIw[o] = f2bf(lw); Gb[o] = f2bf(ag[ct][r]); }
                const float inv = 1.0f / fmaxf(sqrtf(row16_sum(ss)), 1e-12f);
#pragma unroll
                for (int ct = 0; ct < 4; ++ct) { const size_t o = (size_t)t * CW + cb + 16 * ct; const float kk = kkv[ct] * inv;
                    SIk[o] = f2bf(kq[ct] * (1.f + (alr[ct] - 1.f) * kac[ct])); SIa[o] = f2bf(kk); SIb[o] = f2bf(kk * alr[ct]); }
                asm volatile("" ::: "memory");
            }
        }
    }
}
constexpr int NUNIT = NB * NH * (SEQ / 64);
constexpr size_t U_PMP = 0, U_RPP = 8192, U1_BYTES = 16384;
constexpr size_t U_QMT = 0, U_YLT = 16384, U2_BYTES = 32768;
DI int permk(int k) { return (k & 32) | (((k >> 2) & 3) << 3) | (((k >> 4) & 1) << 2) | (k & 3); }
constexpr int MP = 144;
constexpr int SP = 80;
DI f32x4 mm_tile(const LAS unsigned char* xb, int px, int m0, const LAS unsigned char* yb, int py, int n0, int ks, f32x4 acc, int lane) {
    const int r16 = lane & 15, g = lane >> 4;
    for (int s = 0; s < ks; ++s) {
        const bf16x8 a = *(const LAS bf16x8*)(xb + (m0 + r16) * px + (32 * s + 8 * g) * 2);
        const bf16x8 b = *(const LAS bf16x8*)(yb + (n0 + r16) * py + (32 * s + 8 * g) * 2);
        acc = mfma16(a, b, acc);
    }
    return acc;
}
DI u32x2 pk4(f32x4 v) { u32x2 w; w.x = pk2(v[0], v[1]); w.y = pk2(v[2], v[3]); return w; }

DI void phase_scan_a(Frame& F, int l) {
    LAS unsigned char* const L = F.lds;
#define MB(n) (L + (n) * 9216)
    LAS float* const Gf = (LAS float*)(L + 110592);
    LAS float* const SEG = (LAS float*)(L + 110592 + 16384);
    LAS float* const GL = SEG + 512;
    LAS unsigned char* const A21 = L + 110592 + 16384 + 2048 + 256;
    LAS unsigned char* const T11T = A21 + 2560;
    LAS unsigned char* const ZT = T11T + 2560;
    const bf16_t* SIr = (const bf16_t*)(F.wsp() + WS_SI); const bf16_t* SIw = SIr + (size_t)T * CW; const bf16_t* SIk = SIw + (size_t)T * CW; const bf16_t* SIa = SIk + (size_t)T * CW; const bf16_t* SIb = SIa + (size_t)T * CW;
    const bf16_t* V = (const bf16_t*)(F.wsp() + (l > 0 ? WS_V1 : WS_VF));
    const int lane = F.lane, wave = F.wave, r16 = lane & 15, g = lane >> 4;
    for (int u = F.bid; u < NUNIT; u += F.G) {
        const int bh = u & 31, c = u >> 5, b = bh >> 3, h = bh & 7;
        const size_t t0 = (size_t)b * SEQ + c * 64;
        unsigned char* const rec1 = F.wsp() + WS_SC1 + (size_t)((bh * 128) + c) * U1_BYTES; unsigned char* const rec2 = F.wsp() + WS_SC2 + (size_t)((bh * 128) + c) * U2_BYTES;
        __syncthreads();
        { const int k = F.tid & 63, seg = F.tid >> 6; float p[8]; float run = 0.f;
#pragma unroll
          for (int e = 0; e < 8; ++e) { run += bf2f(SIw[(t0 + 8 * seg + e) * CW + h * 64 + k]); p[e] = run; }
          SEG[seg * 64 + k] = run;
          __syncthreads();
          float off = 0.f;
#pragma unroll
          for (int s = 0; s < 8; ++s) off += (s < seg) ? SEG[s * 64 + k] : 0.f;
#pragma unroll
          for (int e = 0; e < 8; ++e) Gf[(8 * seg + e) * 64 + k] = off + p[e];
        }
        __syncthreads();
        { const int i = F.tid >> 3, k0 = (F.tid & 7) * 8; const size_t go = (t0 + i) * CW + h * 64 + k0;
          const u32x4 rv = *(const u32x4*)(SIr + go), kv = *(const u32x4*)(SIk + go), av = *(const u32x4*)(SIa + go), bv = *(const u32x4*)(SIb + go), vv = *(const u32x4*)(V + go);
          float fr[8], fk[8], fa[8], fb[8], fv[8];
          const unsigned rw[4] = {rv.x, rv.y, rv.z, rv.w}, kw[4] = {kv.x, kv.y, kv.z, kv.w}, aw[4] = {av.x, av.y, av.z, av.w}, bw[4] = {bv.x, bv.y, bv.z, bv.w}, vw[4] = {vv.x, vv.y, vv.z, vv.w};
#pragma unroll
          for (int q = 0; q < 4; ++q) { fr[2 * q] = bflo(rw[q]); fr[2 * q + 1] = bfhi(rw[q]); fk[2 * q] = bflo(kw[q]); fk[2 * q + 1] = bfhi(kw[q]); fa[2 * q] = bflo(aw[q]); fa[2 * q + 1] = bfhi(aw[q]);
              fb[2 * q] = bflo(bw[q]); fb[2 * q + 1] = bfhi(bw[q]); fv[2 * q] = bflo(vw[q]); fv[2 * q + 1] = bfhi(vw[q]); }
          float at[8], rt[8], bt[8], kt[8], bh8[8], kh8[8];
#pragma unroll
          for (int e = 0; e < 8; ++e) { const float gi = Gf[i * 64 + k0 + e], gp = (i > 0) ? Gf[(i - 1) * 64 + k0 + e] : 0.f, gl = Gf[63 * 64 + k0 + e];
              const float e1 = __expf(gp), e2 = __expf(gi), e3 = __expf(-gi), e4 = __expf(gl - gi);
              at[e] = -fa[e] * e1; rt[e] = fr[e] * e2; bt[e] = fb[e] * e3; kt[e] = fk[e] * e3; bh8[e] = fb[e] * e4; kh8[e] = fk[e] * e4;
              if (i == 63) GL[k0 + e] = e2; }
          u32x4 w;
          w.x = pk2(at[0], at[1]); w.y = pk2(at[2], at[3]); w.z = pk2(at[4], at[5]); w.w = pk2(at[6], at[7]); *(LAS u32x4*)(MB(0) + i * MP + k0 * 2) = w;
          w.x = pk2(rt[0], rt[1]); w.y = pk2(rt[2], rt[3]); w.z = pk2(rt[4], rt[5]); w.w = pk2(rt[6], rt[7]); *(LAS u32x4*)(MB(1) + i * MP + k0 * 2) = w;
          w.x = pk2(bt[0], bt[1]); w.y = pk2(bt[2], bt[3]); w.z = pk2(bt[4], bt[5]); w.w = pk2(bt[6], bt[7]); *(LAS u32x4*)(MB(2) + i * MP + k0 * 2) = w;
          w.x = pk2(kt[0], kt[1]); w.y = pk2(kt[2], kt[3]); w.z = pk2(kt[4], kt[5]); w.w = pk2(kt[6], kt[7]); *(LAS u32x4*)(MB(3) + i * MP + k0 * 2) = w;
#pragma unroll
          for (int e = 0; e < 8; ++e) { const int ro = (k0 + e) * MP + i * 2;
              *(LAS bf16_t*)(MB(4) + ro) = f2bf(at[e]); *(LAS bf16_t*)(MB(5) + ro) = f2bf(fv[e]); *(LAS bf16_t*)(MB(6) + ro) = f2bf(bh8[e]); *(LAS bf16_t*)(MB(7) + ro) = f2bf(kh8[e]); }
        }
        __syncthreads();
        { const int prod = wave >> 1;
          const LAS unsigned char* xb = (prod & 1) ? MB(3) : MB(2); const LAS unsigned char* yb = (prod < 2) ? MB(0) : MB(1);
          LAS unsigned char* ob = (prod == 1) ? MB(8) : (prod == 2) ? MB(9) : MB(10);
          float zf = 0.f; asm volatile("" : "+v"(zf));
          for (int q = 0; q < 8; ++q) { const int tt = (wave & 1) * 8 + q, tm = tt >> 2, tn = tt & 3;
              f32x4 acc = {zf, zf, zf, zf};
              if (tm <= tn) acc = mm_tile(xb, MP, 16 * tm, yb, MP, 16 * tn, 2, acc, lane);
              const int i = 16 * tn + r16, j0 = 16 * tm + 4 * g;
#pragma unroll
              for (int r = 0; r < 4; ++r) { const int j = j0 + r; const bool keep = (prod < 2) ? (j < i) : (j <= i); if (!keep) acc[r] = 0.f; }
              if (prod == 0) {
                  if ((i >> 5) == (j0 >> 5)) *(LAS f32x4*)(Gf + ((i >> 5) * 32 + (i & 31)) * 32 + (j0 & 31)) = acc;
                  if (i >= 32 && j0 < 32) *(LAS u32x2*)(A21 + (i - 32) * SP + j0 * 2) = pk4(acc);
              } else *(LAS u32x2*)(ob + i * MP + j0 * 2) = pk4(acc);
          } }
        __syncthreads();
        if (wave == 0) {
            const int blk = lane >> 5, cc = lane & 31; const LAS float* AD = Gf + blk * 1024;
            float Tc[32];
#pragma unroll
            for (int i = 0; i < 32; ++i) { float acc = (i == cc) ? 1.f : 0.f;
#pragma unroll
                for (int j = 0; j < i; ++j) acc += AD[i * 32 + j] * Tc[j];
                Tc[i] = acc; }
#pragma unroll
            for (int i = 0; i < 32; ++i) *(LAS bf16_t*)(MB(11) + (32 * blk + i) * MP + (32 * blk + cc) * 2) = f2bf(Tc[i]);
            if (blk == 0) {
#pragma unroll
                for (int q = 0; q < 4; ++q) { u32x4 w; w.x = pk2(Tc[8 * q], Tc[8 * q + 1]); w.y = pk2(Tc[8 * q + 2], Tc[8 * q + 3]); w.z = pk2(Tc[8 * q + 4], Tc[8 * q + 5]); w.w = pk2(Tc[8 * q + 6], Tc[8 * q + 7]);
                    *(LAS u32x4*)(T11T + cc * SP + q * 16) = w; }
            } else {
                unsigned z = 0u; asm volatile("" : "+v"(z));
#pragma unroll
                for (int q = 0; q < 4; ++q) *(LAS u32x4*)(MB(11) + cc * MP + 64 + q * 16) = (u32x4){z, z, z, z};
            }
        } else {
            for (int tt = wave - 1; tt < 16; tt += 7) { const int tm = tt >> 2, tn = tt & 3;
                f32x4 acc = {0.f, 0.f, 0.f, 0.f};
                acc = mm_tile(MB(8), MP, 16 * tm, MB(5), MP, 16 * tn, 2, acc, lane);
                *(LAS u32x2*)(MB(2) + (16 * tn + r16) * MP + (16 * tm + 4 * g) * 2) = pk4(acc); }
        }
        __syncthreads();
        if (wave < 4) { const int tm = wave >> 1, tn = wave & 1; f32x4 acc = {0.f, 0.f, 0.f, 0.f};
            acc = mm_tile(A21, SP, 16 * tm, T11T, SP, 16 * tn, 1, acc, lane);
            *(LAS u32x2*)(ZT + (16 * tn + r16) * SP + (16 * tm + 4 * g) * 2) = pk4(acc); }
        __syncthreads();
        if (wave < 4) { const int tm = wave >> 1, tn = wave & 1; f32x4 acc = {0.f, 0.f, 0.f, 0.f};
            acc = mm_tile(ZT, SP, 16 * tm, MB(11) + 32 * MP + 64, MP, 16 * tn, 1, acc, lane);
            *(LAS u32x2*)(MB(11) + (32 + 16 * tn + r16) * MP + (16 * tm + 4 * g) * 2) = pk4(acc); }
        __syncthreads();
        { const LAS unsigned char* yb = (wave < 4) ? MB(4) : MB(2); LAS unsigned char* ob = (wave < 4) ? MB(3) : MB(0);
          for (int q = 0; q < 4; ++q) { const int tt = (wave & 3) * 4 + q, tm = tt >> 2, tn = tt & 3;
              f32x4 acc = {0.f, 0.f, 0.f, 0.f};
              acc = mm_tile(MB(11), MP, 16 * tm, yb, MP, 16 * tn, 2, acc, lane);
              *(LAS u32x2*)(ob + (16 * tn + r16) * MP + (16 * tm + 4 * g) * 2) = pk4(acc); } }
        __syncthreads();
        for (int q = 0; q < 2; ++q) { const int tt = wave * 2 + q, tm = tt >> 2, tn = tt & 3;
            { f32x4 acc = {0.f, 0.f, 0.f, 0.f}; acc = mm_tile(MB(3), MP, 16 * tm, MB(9), MP, 16 * tn, 2, acc, lane);
              const int i = 16 * tn + r16, k0 = 16 * tm + 4 * g; const u32x2 rr = *(const LAS u32x2*)(MB(1) + i * MP + k0 * 2);
              acc[0] += bflo(rr.x); acc[1] += bfhi(rr.x); acc[2] += bflo(rr.y); acc[3] += bfhi(rr.y);
              *(u32x2*)(rec1 + U_RPP + (size_t)(i * 64 + permk(k0)) * 2) = pk4(acc); }
            { f32x4 acc = {0.f, 0.f, 0.f, 0.f}; acc = mm_tile(MB(3), MP, 16 * tm, MB(6), MP, 16 * tn, 2, acc, lane);
              const int kp = 16 * tn + r16, k0 = 16 * tm + 4 * g;
#pragma unroll
              for (int r = 0; r < 4; ++r) if (k0 + r == kp) acc[r] += GL[kp];
              *(u32x2*)(rec1 + U_PMP + (size_t)(kp * 64 + permk(k0)) * 2) = pk4(acc); }
            { f32x4 acc = {0.f, 0.f, 0.f, 0.f}; acc = mm_tile(MB(9), MP, 16 * tm, MB(0), MP, 16 * tn, 2, acc, lane); acc = mm_tile(MB(10), MP, 16 * tm, MB(5), MP, 16 * tn, 2, acc, lane);
              *(f32x4*)(rec2 + U_YLT + (size_t)((16 * tn + r16) * 64 + 16 * tm + 4 * g) * 4) = acc; }
            { f32x4 acc = {0.f, 0.f, 0.f, 0.f}; acc = mm_tile(MB(6), MP, 16 * tm, MB(0), MP, 16 * tn, 2, acc, lane); acc = mm_tile(MB(7), MP, 16 * tm, MB(5), MP, 16 * tn, 2, acc, lane);
              *(f32x4*)(rec2 + U_QMT + (size_t)((16 * tn + r16) * 64 + 16 * tm + 4 * g) * 4) = acc; }
        }
    }
#undef MB
}

struct ScanOps { bf16x8 pm[4][2]; f32x4 q[4]; };
DI void scanb_load(ScanOps& o, const unsigned char* r1b, const unsigned char* r2b, int cidx, int v, int r16, int g) {
    asm volatile("" : "+s"(cidx));
    const unsigned char* rec1 = r1b + (size_t)cidx * U1_BYTES; const unsigned char* rec2 = r2b + (size_t)cidx * U2_BYTES;
#pragma unroll
    for (int mt = 0; mt < 4; ++mt)
#pragma unroll
        for (int s = 0; s < 2; ++s) o.pm[mt][s] = *(const bf16x8*)(rec1 + U_PMP + (size_t)((16 * mt + r16) * 64 + 32 * s + 8 * g) * 2);
#pragma unroll
    for (int mt = 0; mt < 4; ++mt) o.q[mt] = *(const f32x4*)(rec2 + U_QMT + (size_t)(v * 64 + 16 * mt + 4 * g) * 4);
}
DI void scanb_step(const ScanOps& o, f32x4 (&sT)[4], bf16_t* sct, int v, int g) {
    bf16x8 hi[2], lo[2];
#pragma unroll
    for (int s = 0; s < 2; ++s) { u32x4 hw, lw;
#pragma unroll
        for (int q = 0; q < 2; ++q) { const f32x4 x = sT[2 * s + q]; const unsigned h0 = pk2(x[0], x[1]), h1 = pk2(x[2], x[3]);
            const unsigned l0 = pk2(x[0] - bflo(h0), x[1] - bfhi(h0)), l1 = pk2(x[2] - bflo(h1), x[3] - bfhi(h1));
            if (q == 0) { hw.x = h0; hw.y = h1; lw.x = l0; lw.y = l1; } else { hw.z = h0; hw.w = h1; lw.z = l0; lw.w = l1; } }
        hi[s] = __builtin_bit_cast(bf16x8, hw); lo[s] = __builtin_bit_cast(bf16x8, lw);
        *(u32x4*)(sct + (size_t)v * 64 + 32 * s + 8 * g) = hw; }
#pragma unroll
    for (int mt = 0; mt < 4; ++mt) { f32x4 n = o.q[mt];
#pragma unroll
        for (int s = 0; s < 2; ++s) { n = mfma16(o.pm[mt][s], hi[s], n); n = mfma16(o.pm[mt][s], lo[s], n); }
        sT[mt] = n; }
}
DI void phase_scan_b(Frame& F) {
    if (F.wave >= 4) return;
    const int lane = F.lane, r16 = lane & 15, g = lane >> 4, v = 16 * F.wave + r16;
    for (int bh = F.bid; bh < NB * NH; bh += F.G) {
        const unsigned char* r1 = F.wsp() + WS_SC1 + (size_t)bh * 128 * U1_BYTES; const unsigned char* r2 = F.wsp() + WS_SC2 + (size_t)bh * 128 * U2_BYTES; bf16_t* sct = (bf16_t*)(F.wsp() + WS_SCT) + (size_t)bh * 128 * 4096;
        f32x4 sT[4];
#pragma unroll
        for (int i = 0; i < 4; ++i) sT[i] = (f32x4){0.f, 0.f, 0.f, 0.f};
        ScanOps o0, o1, o2;
        scanb_load(o0, r1, r2, 0, v, r16, g); scanb_load(o1, r1, r2, 1, v, r16, g); scanb_load(o2, r1, r2, 2, v, r16, g);
        for (int c = 0; c < 126; c += 3) {
            const int c5 = (c + 5 < 128) ? c + 5 : 127;
            scanb_step(o0, sT, sct + (size_t)c * 4096, v, g);       scanb_load(o0, r1, r2, c + 3, v, r16, g);
            scanb_step(o1, sT, sct + (size_t)(c + 1) * 4096, v, g); scanb_load(o1, r1, r2, c + 4, v, r16, g);
            scanb_step(o2, sT, sct + (size_t)(c + 2) * 4096, v, g); scanb_load(o2, r1, r2, c5, v, r16, g);
        }
        scanb_step(o0, sT, sct + (size_t)126 * 4096, v, g);
        scanb_step(o1, sT, sct + (size_t)127 * 4096, v, g);
    }
}

DI void phase_scan_c(Frame& F, int l) {
    const bf16_t* SIr = (const bf16_t*)(F.wsp() + WS_SI); const bf16_t* SIk = SIr + 2 * (size_t)T * CW;
    const bf16_t* V = (const bf16_t*)(F.wsp() + (l > 0 ? WS_V1 : WS_VF)); const bf16_t* Gb = (const bf16_t*)(F.wsp() + WS_G); bf16_t* YR = (bf16_t*)(F.wsp() + WS_YR);
    const float* lng = F.inp(17) + l * CW; const float* lnb = F.inp(18) + l * CW; const float* rkp = F.inp(16) + l * CW;
    const int lane = F.lane, r16 = lane & 15, g = lane >> 4;
    for (int item = F.bid * 8 + F.wave; item < NUNIT * 4; item += F.G * 8) {
        const int u = item >> 2, it = item & 3; const int bh = u & 31, c = u >> 5, b = bh >> 3, h = bh & 7;
        const unsigned char* rec1 = F.wsp() + WS_SC1 + (size_t)((bh * 128) + c) * U1_BYTES; const unsigned char* rec2 = F.wsp() + WS_SC2 + (size_t)((bh * 128) + c) * U2_BYTES; const bf16_t* sct = (const bf16_t*)(F.wsp() + WS_SCT) + (size_t)((bh * 128) + c) * 4096;
        const size_t t0 = (size_t)b * SEQ + c * 64 + 16 * it;
        bf16x8 ra[2];
#pragma unroll
        for (int s = 0; s < 2; ++s) ra[s] = *(const bf16x8*)(rec1 + U_RPP + (size_t)((16 * it + r16) * 64 + 32 * s + 8 * g) * 2);
        f32x4 y[4];
#pragma unroll
        for (int vt = 0; vt < 4; ++vt) { y[vt] = *(const f32x4*)(rec2 + U_YLT + (size_t)((16 * vt + r16) * 64 + 16 * it + 4 * g) * 4);
#pragma unroll
            for (int s = 0; s < 2; ++s) { const bf16x8 sb = *(const bf16x8*)(sct + (size_t)(16 * vt + r16) * 64 + 32 * s + 8 * g); y[vt] = mfma16(ra[s], sb, y[vt]); } }
#pragma unroll
        for (int r = 0; r < 4; ++r) {
            const size_t tok = t0 + 4 * g + r; const size_t o = tok * CW + h * 64 + r16;
            float s1 = (y[0][r] + y[1][r]) + (y[2][r] + y[3][r]);
            s1 += dpp_mov<0xB1>(s1); s1 += dpp_mov<0x4E>(s1); s1 += dpp_mov<0x141>(s1); s1 += dpp_mov<0x140>(s1);
            const float mean = s1 * (1.f / 64.f);
            float d[4], s2 = 0.f;
#pragma unroll
            for (int vt = 0; vt < 4; ++vt) { d[vt] = y[vt][r] - mean; s2 += d[vt] * d[vt]; }
            s2 += dpp_mov<0xB1>(s2); s2 += dpp_mov<0x4E>(s2); s2 += dpp_mov<0x141>(s2); s2 += dpp_mov<0x140>(s2);
            const float rstd = 1.0f / sqrtf(s2 * (1.f / 64.f) + 64e-5f);
            float rr[4], kk[4], vv[4], s3 = 0.f;
#pragma unroll
            for (int vt = 0; vt < 4; ++vt) { rr[vt] = bf2f(SIr[o + 16 * vt]); kk[vt] = bf2f(SIk[o + 16 * vt]); vv[vt] = bf2f(V[o + 16 * vt]); s3 += rr[vt] * kk[vt] * rkp[h * 64 + 16 * vt + r16]; }
            s3 += dpp_mov<0xB1>(s3); s3 += dpp_mov<0x4E>(s3); s3 += dpp_mov<0x141>(s3); s3 += dpp_mov<0x140>(s3);
#pragma unroll
            for (int vt = 0; vt < 4; ++vt) { const int cidx = h * 64 + 16 * vt + r16;
                const float yn = d[vt] * rstd * lng[cidx] + lnb[cidx];
                YR[o + 16 * vt] = f2bf((yn + s3 * vv[vt]) * bf2f(Gb[o + 16 * vt])); }
        }
    }
}
constexpr size_t TB_KMEAN2 = 256 * 1024;
DI void phase_moba_prep(Frame& F, int l) {
    bf16_t* MO = (bf16_t*)(F.wsp() + WS_MO); float* KM = (float*)(F.wsp() + WS_TAB + TB_KMEAN);
    int c = F.tid; const float qg = F.inp(23)[l * 64 + (c & 63)] * 0.125f, kg = F.inp(24)[l * 64 + (c & 63)];
    for (int hs = F.bid; hs < T / 128; hs += F.G) {
        float ksum = 0.f;
        for (int tb = 0; tb < 128; tb += 8) {
            int tbase = hs * 128 + tb; asm volatile("" : "+s"(tbase), "+v"(c));
            float q[8], k[8];
#pragma unroll
            for (int e = 0; e < 8; ++e) { const size_t ro = (size_t)(tbase + e) * 1536; q[e] = bf2f(MO[ro + c]); k[e] = bf2f(MO[ro + 512 + c]); }
#pragma unroll
            for (int e = 0; e < 8; ++e) { const size_t ro = (size_t)(tbase + e) * 1536;
                const float qs = wave_sum(q[e] * q[e]) * (1.f / 64.f), ks = wave_sum(k[e] * k[e]) * (1.f / 64.f);
                const float qn = q[e] * (1.0f / sqrtf(qs + 1e-6f)) * qg, kn = k[e] * (1.0f / sqrtf(ks + 1e-6f)) * kg;
                MO[ro + c] = f2bf(qn); MO[ro + 512 + c] = f2bf(kn); ksum += kn; }
        }
        KM[(size_t)(hs & 1) * (TB_KMEAN2 / 4) + (size_t)(hs >> 1) * CW + c] = ksum * (1.f / 256.f);
    }
}
DI void phase_moba_gate(Frame& F) {
    LAS float* KL = (LAS float*)F.lds;
    const bf16_t* MO = (const bf16_t*)(F.wsp() + WS_MO); const float* KM = (const float*)(F.wsp() + WS_TAB + TB_KMEAN); unsigned* SEL = (unsigned*)(F.wsp() + WS_SEL);
    for (int span = F.bid; span < T / 64; span += F.G) {
        const int t0 = span * 64, b = t0 / SEQ, blk = (t0 % SEQ) / 256;
        __syncthreads();
        for (int idx = F.tid; idx < blk * 512; idx += 512) { const int j = idx >> 9, cc = idx & 511, h = cc >> 6, d = cc & 63;
            const size_t ko = ((size_t)(b * 32 + j)) * CW + cc; KL[h * 2052 + j * 64 + d] = KM[ko] + KM[ko + TB_KMEAN2 / 4]; }
        __syncthreads();
        const int tok = F.tid >> 3, h = F.tid & 7; const int t = t0 + tok;
        float q[64];
        { const u32x4* qp = (const u32x4*)(MO + (size_t)t * 1536 + h * 64);
#pragma unroll
          for (int i = 0; i < 8; ++i) { const u32x4 w = qp[i]; q[8 * i] = bflo(w.x); q[8 * i + 1] = bfhi(w.x); q[8 * i + 2] = bflo(w.y); q[8 * i + 3] = bfhi(w.y); q[8 * i + 4] = bflo(w.z); q[8 * i + 5] = bfhi(w.z); q[8 * i + 6] = bflo(w.w); q[8 * i + 7] = bfhi(w.w); } }
        float v0 = -INFINITY, v1 = -INFINITY, v2 = -INFINITY; int i0 = 0, i1 = 1, i2 = 2;
        for (int j = 0; j < blk; ++j) {
            const LAS f32x4* kp = (const LAS f32x4*)(KL + h * 2052 + j * 64); float s = 0.f;
#pragma unroll
            for (int i = 0; i < 16; ++i) { const f32x4 kv = kp[i]; s += q[4 * i] * kv.x + q[4 * i + 1] * kv.y + q[4 * i + 2] * kv.z + q[4 * i + 3] * kv.w; }
            if (s > v0) { v2 = v1; i2 = i1; v1 = v0; i1 = i0; v0 = s; i0 = j; }
            else if (s > v1) { v2 = v1; i2 = i1; v1 = s; i1 = j; }
            else if (s > v2) { v2 = s; i2 = j; }
        }
        const int nv = blk < 3 ? blk : 3;
        SEL[(size_t)t * 8 + h] = (unsigned)i0 | ((unsigned)i1 << 8) | ((unsigned)i2 << 16) | ((unsigned)nv << 24);
    }
}

constexpr int KS_PITCH = 144, VT_PITCH = 520;
constexpr int NPIECE = 47;
constexpr int CW_QATT = 8192;
DI void phase_moba_attn(Frame& F, int l) {
    static constexpr unsigned PIECES[NPIECE] = {196608,1837578,590595,1574658,1115654,1640713,1968907,1443848,918789,1049857,1246983,393730,787456,721924,2034700,262401,2034179,2034957,2035214,2035471,2034692,2035728,2034944,2035985,2036242,2036499,2035461,2036756,2037013,2037270,2035969,2037527,2036230,2037784,2038041,2038298,2036743,2038555,2038812,2039069,2039326,2037512,2039583,2038018,2038281,2039050,2039563};
    LAS unsigned char* Ks = F.lds;
    LAS unsigned char* Vt = F.lds + 36864;
    LAS float* LUT = (LAS float*)(F.lds + 36864 + 33280);
    LAS unsigned* CTL = (LAS unsigned*)(F.lds + 36864 + 33280 + 528);
    LAS unsigned* LIST = CTL + 4;
    const bf16_t* MO = (const bf16_t*)(F.wsp() + WS_MO); const unsigned* SEL = (const unsigned*)(F.wsp() + WS_SEL);
    bf16_t* PO = (bf16_t*)(F.wsp() + WS_PO); f32x2* PST = (f32x2*)(F.wsp() + WS_PST);
    unsigned* qctr = (unsigned*)(F.wsp() + WS_CTL) + CW_QATT + 64 * l;
    const float* relb = F.inp(25);
    const int lane = F.lane;
    for (;;) {
        __syncthreads();
        if (F.tid == 0) { CTL[0] = __hip_atomic_fetch_add(qctr, 1u, __ATOMIC_RELAXED, __HIP_MEMORY_SCOPE_AGENT); CTL[1] = 0u; }
        __syncthreads();
        const int u = (int)CTL[0];
        if (u >= NPIECE * NB * NH) break;
        const unsigned pc = PIECES[u >> 5]; const int bh = u & 31, b = bh >> 3, h = bh & 7;
        const int j = (int)(pc & 0xff), qlo = (int)((pc >> 8) & 0xff), qhi = (int)(pc >> 16); const int ncand = (qhi - qlo + 1) * 256;
        const size_t tokb = (size_t)b * SEQ;
        for (int id = F.tid; id < 2048; id += 512) { const int row = id >> 3, c8 = id & 7; const size_t ro = (tokb + j * 256 + row) * 1536 + h * 64 + c8 * 8;
            *(LAS u32x4*)(Ks + row * KS_PITCH + c8 * 16) = *(const u32x4*)(MO + ro + 512); }
        for (int id = F.tid; id < 1024; id += 512) { const int rp = id >> 3, c8 = id & 7; const size_t ro = (tokb + j * 256 + 2 * rp) * 1536 + h * 64 + c8 * 8 + 1024;
            const u32x4 v0 = *(const u32x4*)(MO + ro), v1 = *(const u32x4*)(MO + ro + 1536);
            const unsigned a[4] = {v0.x, v0.y, v0.z, v0.w}, bq[4] = {v1.x, v1.y, v1.z, v1.w};
            LAS unsigned char* vp = Vt + (c8 * 8) * VT_PITCH + rp * 4;
#pragma unroll
            for (int q = 0; q < 4; ++q) { *(LAS unsigned*)(vp + (2 * q) * VT_PITCH) = (a[q] & 0xffffu) | (bq[q] << 16); *(LAS unsigned*)(vp + (2 * q + 1) * VT_PITCH) = (a[q] >> 16) | (bq[q] & 0xffff0000u); } }
        if (F.tid <= 128) { const int n = F.tid; int bucket;
            if (n < 16) bucket = n; else { int lg = 16 + (int)(logf((float)n / 16.0f) / 2.0794415416798357f * 16.0f); bucket = lg < 31 ? lg : 31; }
            LUT[n] = relb[bucket * 8 + h]; }
        for (int base = 0; base < ncand; base += 512) {
            const int q = qlo * 256 + base + F.tid; const int qb = q >> 8; bool mem = false; unsigned ent = 0;
            if (base + F.tid >= ncand) { }
            else if (qb == j) { mem = true; ent = (unsigned)q | (3u << 16); }
            else { const unsigned s = SEL[(tokb + q) * 8 + h]; const unsigned nv = s >> 24;
                if (nv > 0 && (s & 0xff) == (unsigned)j) { mem = true; ent = (unsigned)q; }
                else if (nv > 1 && ((s >> 8) & 0xff) == (unsigned)j) { mem = true; ent = (unsigned)q | (1u << 16); }
                else if (nv > 2 && ((s >> 16) & 0xff) == (unsigned)j) { mem = true; ent = (unsigned)q | (2u << 16); } }
            const unsigned long long bal = __ballot(mem); const int cnt = __popcll(bal);
            unsigned wbase = 0; if (lane == 0 && cnt > 0) wbase = __hip_atomic_fetch_add(&CTL[1], (unsigned)cnt, __ATOMIC_RELAXED, __HIP_MEMORY_SCOPE_WORKGROUP);
            wbase = (unsigned)__builtin_amdgcn_readfirstlane((int)wbase);
            if (mem) LIST[wbase + __popcll(bal & ((1ull << lane) - 1ull))] = ent;
        }
        __syncthreads();
        const int total = (int)CTL[1];
        const float bfar = LUT[128];
        const int ntile = (total + 31) >> 5;
        const int qi = lane & 31, half = lane >> 5;
        for (int tile = F.wave; tile < ntile; tile += 8) {
            const int e = tile * 32 + qi; const bool valid = e < total; const unsigned en = LIST[valid ? e : total - 1];
            const int q = (int)(en & 0xffffu), slot = (int)(en >> 16); const size_t tok = tokb + q;
            const bool need_lut = __any((q >> 8) <= j + 1);
            bf16x8 qf[4];
#pragma unroll
            for (int kk = 0; kk < 4; ++kk) qf[kk] = *(const bf16x8*)(MO + tok * 1536 + h * 64 + 16 * kk + 8 * half);
            float mrun = -1e30f, lsum = 0.f;
            f32x16 oacc[2];
#pragma unroll
            for (int i = 0; i < 16; ++i) { oacc[0][i] = 0.f; oacc[1][i] = 0.f; }
            const int qrel = q - j * 256;
#pragma unroll 1
            for (int ck = 0; ck < 4; ++ck) {
                f32x16 sacc[2];
#pragma unroll
                for (int k2 = 0; k2 < 2; ++k2) { const int kt = 2 * ck + k2;
#pragma unroll
                    for (int i = 0; i < 16; ++i) sacc[k2][i] = 0.f;
#pragma unroll
                    for (int kk = 0; kk < 4; ++kk) { const bf16x8 ka = *(const LAS bf16x8*)(Ks + (32 * kt + qi) * KS_PITCH + (16 * kk + 8 * half) * 2);
                        sacc[k2] = __builtin_amdgcn_mfma_f32_32x32x16_bf16(ka, qf[kk], sacc[k2], 0, 0, 0); } }
                float mx = -1e30f;
                if (need_lut) {
#pragma unroll
                    for (int k2 = 0; k2 < 2; ++k2)
#pragma unroll
                        for (int i = 0; i < 16; ++i) { const int key = 32 * (2 * ck + k2) + (i & 3) + 8 * (i >> 2) + 4 * half; const int n = qrel - key;
                            const float bias = LUT[n < 0 ? 0 : (n > 128 ? 128 : n)];
                            const float s = (n < 0) ? -1e30f : sacc[k2][i] + bias; sacc[k2][i] = s; mx = fmaxf(mx, s); }
                } else {
#pragma unroll
                    for (int k2 = 0; k2 < 2; ++k2)
#pragma unroll
                        for (int i = 0; i < 16; ++i) { const float s = sacc[k2][i] + bfar; sacc[k2][i] = s; mx = fmaxf(mx, s); }
                }
                mx = fmaxf(mx, __shfl_xor(mx, 32));
                const float mnew = fmaxf(mrun, mx); const float alpha = __expf(mrun - mnew); mrun = mnew;
                lsum *= alpha;
#pragma unroll
                for (int i = 0; i < 16; ++i) { oacc[0][i] *= alpha; oacc[1][i] *= alpha; }
#pragma unroll
                for (int k2 = 0; k2 < 2; ++k2) { const int kt = 2 * ck + k2;
#pragma unroll
                    for (int i = 0; i < 16; ++i) { const float p = __expf(sacc[k2][i] - mnew); sacc[k2][i] = p; lsum += p; }
#pragma unroll
                    for (int cc = 0; cc < 2; ++cc) {
                        u32x4 pw; pw.x = pk2(sacc[k2][8 * cc], sacc[k2][8 * cc + 1]); pw.y = pk2(sacc[k2][8 * cc + 2], sacc[k2][8 * cc + 3]); pw.z = pk2(sacc[k2][8 * cc + 4], sacc[k2][8 * cc + 5]); pw.w = pk2(sacc[k2][8 * cc + 6], sacc[k2][8 * cc + 7]);
                        const bf16x8 pf = __builtin_bit_cast(bf16x8, pw);
                        const int key0 = 32 * kt + 16 * cc + 4 * half;
#pragma unroll
                        for (int dt = 0; dt < 2; ++dt) { const LAS unsigned char* vb = Vt + (32 * dt + qi) * VT_PITCH + key0 * 2;
                            const u32x2 va = *(const LAS u32x2*)vb, vb2 = *(const LAS u32x2*)(vb + 16);
                            u32x4 vw; vw.x = va.x; vw.y = va.y; vw.z = vb2.x; vw.w = vb2.y;
                            oacc[dt] = __builtin_amdgcn_mfma_f32_32x32x16_bf16(__builtin_bit_cast(bf16x8, vw), pf, oacc[dt], 0, 0, 0); } } }
            }
            const float mx = mrun;
            lsum += __shfl_xor(lsum, 32);
            const float inv = 1.0f / lsum;
            if (valid) {
                bf16_t* op = PO + ((size_t)slot * T + tok) * CW + h * 64;
#pragma unroll
                for (int dt = 0; dt < 2; ++dt)
#pragma unroll
                    for (int ig = 0; ig < 4; ++ig) { u32x2 w; w.x = pk2(oacc[dt][4 * ig] * inv, oacc[dt][4 * ig + 1] * inv); w.y = pk2(oacc[dt][4 * ig + 2] * inv, oacc[dt][4 * ig + 3] * inv);
                        *(u32x2*)(op + 32 * dt + 8 * ig + 4 * half) = w; }
                if (half == 0) PST[((size_t)slot * T + tok) * 8 + h] = (f32x2){mx, lsum};
            }
        }
    }
}
DI void phase_moba_combine(Frame& F) {
    const bf16_t* PO = (const bf16_t*)(F.wsp() + WS_PO); const f32x2* PST = (const f32x2*)(F.wsp() + WS_PST); const unsigned* SEL = (const unsigned*)(F.wsp() + WS_SEL);
    bf16_t* YM = (bf16_t*)(F.wsp() + WS_YM);
    int c = F.tid; const int h = c >> 6;
    for (int tb = F.bid * 8; tb < T; tb += F.G * 8) {
        int tbase = tb; asm volatile("" : "+s"(tbase), "+v"(c));
        int nv[8]; f32x2 st[8][4]; float po[8][4];
#pragma unroll
        for (int e = 0; e < 8; ++e) { const int t = tbase + e; nv[e] = (int)(SEL[(size_t)t * 8 + h] >> 24);
#pragma unroll
            for (int s = 0; s < 4; ++s) { st[e][s] = PST[((size_t)s * T + t) * 8 + h]; po[e][s] = bf2f(PO[((size_t)s * T + t) * CW + c]); } }
#pragma unroll
        for (int e = 0; e < 8; ++e) { const int t = tbase + e; float M = -1e30f;
#pragma unroll
            for (int s = 0; s < 4; ++s) { const bool on = (s == 3) || (s < nv[e]); if (on) M = fmaxf(M, st[e][s].x); }
            float den = 0.f, num = 0.f;
#pragma unroll
            for (int s = 0; s < 4; ++s) { const bool on = (s == 3) || (s < nv[e]); if (on) { const float w = st[e][s].y * __expf(st[e][s].x - M); den += w; num += w * po[e][s]; } }
            YM[(size_t)t * CW + c] = f2bf(num / den); }
    }
}
DI void phase_router(Frame& F, int l) {
    LAS float* xs = (LAS float*)F.lds;
    LAS float* wsm = xs + 64 * 129;
    LAS float* lgt = wsm + 128 * 36;
    LAS float* ssq = lgt + 64 * 37;
    LAS int* hist = (LAS int*)(ssq + 64);
    const float* x = F.outp(); const float* gain = F.inp(2) + (size_t)l * DM;
    const float* wgrp = F.inp(29) + (size_t)l * DM * 4; const float* wexp = F.inp(31) + (size_t)l * DM * 32;
    const float* bgrp = F.inp(30) + l * 4; const float* bexp = F.inp(32) + l * 32;
    int* EID = (int*)(F.wsp() + WS_RT + RT_EID); float* GATE = (float*)(F.wsp() + WS_RT + RT_GATE); int* HIST = (int*)(F.wsp() + WS_RT + RT_HIST);
    const int tok = F.tid & 63, jg = F.tid >> 6;
    for (int tile = F.bid; tile < T / 64; tile += F.G) {
        const int t0 = tile * 64;
        float acc[5] = {0.f, 0.f, 0.f, 0.f, 0.f}; float ss = 0.f;
        if (F.tid < 32) hist[F.tid] = 0;
        for (int kc = 0; kc < DM; kc += 128) {
            __syncthreads();
            for (int idx = F.tid; idx < 64 * 128; idx += 512) { const int r = idx >> 7, k = idx & 127; xs[r * 129 + k] = x[(size_t)(t0 + r) * DM + kc + k]; }
            for (int idx = F.tid; idx < 128 * 36; idx += 512) { const int k = idx / 36, j = idx - k * 36; const float g = gain[kc + k];
                wsm[idx] = g * (j < 4 ? wgrp[(size_t)(kc + k) * 4 + j] : wexp[(size_t)(kc + k) * 32 + (j - 4)]); }
            __syncthreads();
            for (int k = 0; k < 128; ++k) { const float xv = xs[tok * 129 + k]; ss += xv * xv;
#pragma unroll
                for (int i = 0; i < 5; ++i) { const int j = jg + 8 * i; if (j < 36) acc[i] += xv * wsm[k * 36 + j]; } }
        }
#pragma unroll
        for (int i = 0; i < 5; ++i) { const int j = jg + 8 * i; if (j < 36) lgt[tok * 37 + j] = acc[i]; }
        if (jg == 0) ssq[tok] = ss;
        __syncthreads();
        if (F.tid < 64) {
            const int t = t0 + F.tid; const float rs = 1.0f / sqrtf(ssq[F.tid] * (1.f / DM) + 1e-6f);
            float lg[4]; int gs = 0; float gm = -INFINITY;
#pragma unroll
            for (int g = 0; g < 4; ++g) { lg[g] = lgt[F.tid * 37 + g] * rs + bgrp[g]; if (lg[g] > gm) { gm = lg[g]; gs = g; } }
            float gden = 0.f;
#pragma unroll
            for (int g = 0; g < 4; ++g) gden += expf(lg[g] - gm);
            const float ptop = 1.0f / gden;
            float le[8]; float e0 = -INFINITY, e1 = -INFINITY; int j0 = 0, j1 = 1;
#pragma unroll
            for (int e = 0; e < 8; ++e) { le[e] = lgt[F.tid * 37 + 4 + gs * 8 + e] * rs + bexp[gs * 8 + e];
                if (le[e] > e0) { e1 = e0; j1 = j0; e0 = le[e]; j0 = e; } else if (le[e] > e1) { e1 = le[e]; j1 = e; } }
            const float p1 = expf(e1 - e0);
            const float g0 = ptop / (1.f + p1), g1 = ptop * p1 / (1.f + p1);
            const int ex0 = gs * 8 + j0, ex1 = gs * 8 + j1;
            EID[t * 2] = ex0; EID[t * 2 + 1] = ex1; GATE[t * 2] = g0; GATE[t * 2 + 1] = g1;
            __hip_atomic_fetch_add(&hist[ex0], 1, __ATOMIC_RELAXED, __HIP_MEMORY_SCOPE_WORKGROUP); __hip_atomic_fetch_add(&hist[ex1], 1, __ATOMIC_RELAXED, __HIP_MEMORY_SCOPE_WORKGROUP);
        }
        __syncthreads();
        if (F.tid < 32) HIST[tile * 32 + F.tid] = hist[F.tid];
        __syncthreads();
    }
}
DI void phase_moe_gather(Frame& F, int l) {
    LAS int* tot = (LAS int*)F.lds; LAS int* off = tot + 32; LAS int* base = off + 32; LAS int* eidl = base + 32; LAS int* rowl = eidl + 128; LAS int* ps = rowl + 128; LAS int* po = ps + 512;
    const float* x = F.outp(); const float* gain = F.inp(2) + (size_t)l * DM;
    const int* EID = (const int*)(F.wsp() + WS_RT + RT_EID); const float* GATE = (const float*)(F.wsp() + WS_RT + RT_GATE); const int* HIST = (const int*)(F.wsp() + WS_RT + RT_HIST);
    int* ROW = (int*)(F.wsp() + WS_RT + RT_ROW); float* GW = (float*)(F.wsp() + WS_RT + RT_GW); int* PEXP = (int*)(F.wsp() + WS_RT + RT_PEXP);
    bf16_t* AM = (bf16_t*)(F.wsp() + WS_AM);
    for (int tile = F.bid; tile < T / 64; tile += F.G) {
        const int t0 = tile * 64;
        __syncthreads();
        { const int e = F.tid & 31, part = F.tid >> 5; int s = 0, o = 0;
          for (int i = part * 32; i < part * 32 + 32; ++i) { const int v = HIST[i * 32 + e]; s += v; if (i < tile) o += v; }
          ps[F.tid] = s; po[F.tid] = o; }
        if (F.tid < 128) eidl[F.tid] = EID[t0 * 2 + F.tid];
        __syncthreads();
        if (F.tid < 32) { int s = 0, o = 0;
#pragma unroll
            for (int p = 0; p < 16; ++p) { s += ps[p * 32 + F.tid]; o += po[p * 32 + F.tid]; } tot[F.tid] = s; off[F.tid] = o; }
        __syncthreads();
        if (F.tid == 0) {
            int bs = 0; for (int e = 0; e < 32; ++e) { base[e] = bs; bs += (tot[e] + 255) & ~255; }
            if (tile == 0) { int p = 0; for (int e = 0; e < 32; ++e) { const int np = (tot[e] + 255) >> 8; for (int i = 0; i < np; ++i) PEXP[p++] = e; } PEXP[MOE_PANELS] = p; }
        }
        __syncthreads();
        if (F.tid < 128) { const int my = eidl[F.tid]; int rank = 0; for (int i = 0; i < F.tid; ++i) rank += (eidl[i] == my) ? 1 : 0;
            const int r = base[my] + off[my] + rank; rowl[F.tid] = r; ROW[t0 * 2 + F.tid] = r; GW[r] = GATE[t0 * 2 + F.tid]; }
        __syncthreads();
        for (int tk = F.wave; tk < 64; tk += 8) { const int t = t0 + tk;
            rms_row_to_bf16(x + (size_t)t * DM, gain, AM + (size_t)rowl[tk * 2] * DM, AM + (size_t)rowl[tk * 2 + 1] * DM, F.lane); }
    }
}
DI void phase_moe_combine(Frame& F, int l) {
    const bf16_t* YE = (const bf16_t*)(F.wsp() + WS_YE); const int* ROW = (const int*)(F.wsp() + WS_RT + RT_ROW); bf16_t* XN = (bf16_t*)(F.wsp() + WS_XN);
    const float* gain = F.inp(1) + (size_t)(l + 1 < NLAYER ? l + 1 : l) * DM;
    const int gw = F.bid * 8 + F.wave, NGW = F.G * 8;
    for (int t = gw; t < T; t += NGW) {
        const int r0 = ROW[t * 2], r1 = ROW[t * 2 + 1];
        f32x4* xr = (f32x4*)(F.outp() + (size_t)t * DM) + F.lane; const u32x2* y0 = (const u32x2*)(YE + (size_t)r0 * DM) + F.lane; const u32x2* y1 = (const u32x2*)(YE + (size_t)r1 * DM) + F.lane;
        f32x4 v[4]; float s = 0.f;
#pragma unroll
        for (int j = 0; j < 4; ++j) { const u32x2 a = y0[64 * j], b = y1[64 * j]; f32x4 xv = xr[64 * j];
            xv.x += bflo(a.x) + bflo(b.x); xv.y += bfhi(a.x) + bfhi(b.x); xv.z += bflo(a.y) + bflo(b.y); xv.w += bfhi(a.y) + bfhi(b.y);
            v[j] = xv; xr[64 * j] = xv; s += (xv.x * xv.x + xv.y * xv.y) + (xv.z * xv.z + xv.w * xv.w); }
        if (l + 1 < NLAYER) {
            const float rs = 1.0f / sqrtf(wave_sum(s) * (1.f / DM) + 1e-6f);
#pragma unroll
            for (int j = 0; j < 4; ++j) { const f32x4 g = ((const f32x4*)gain)[F.lane + 64 * j]; const f32x4 y = v[j] * rs * g; u32x2 w; w.x = pk2(y.x, y.y); w.y = pk2(y.z, y.w); *((u32x2*)(XN + (size_t)t * DM) + F.lane + 64 * j) = w; }
        }
    }
}

constexpr size_t TB_WRH = 512 * 1024, TB_WRL = TB_WRH + 48 * 1024 * 2;
DI void phase_conv_router(Frame& F, int l) {
    bf16_t* WRH = (bf16_t*)(F.wsp() + WS_TAB + TB_WRH); bf16_t* WRL = (bf16_t*)(F.wsp() + WS_TAB + TB_WRL);
    const float* gain = F.inp(2) + (size_t)l * DM; const float* wgrp = F.inp(29) + (size_t)l * DM * 4; const float* wexp = F.inp(31) + (size_t)l * DM * 32;
    for (int idx = F.bid * 512 + F.tid; idx < 48 * DM; idx += F.G * 512) { const int n = idx >> 10, k = idx & 1023;
        float v = (n < 4) ? wgrp[k * 4 + n] : (n < 36) ? wexp[k * 32 + (n - 4)] : 0.f; v *= gain[k];
        const bf16_t h = f2bf(v); WRH[idx] = h; WRL[idx] = f2bf(v - bf2f(h)); }
}
DI void phase_router2(Frame& F, int l) {
    LAS float* lgt = (LAS float*)F.lds + F.wave * 1024;
    LAS int* hist = (LAS int*)(F.lds + 8 * 4096);
    const float* x = F.outp(); const bf16_t* WRH = (const bf16_t*)(F.wsp() + WS_TAB + TB_WRH); const bf16_t* WRL = (const bf16_t*)(F.wsp() + WS_TAB + TB_WRL);
    const float* bgrp = F.inp(30) + l * 4; const float* bexp = F.inp(32) + l * 32;
    int* EID = (int*)(F.wsp() + WS_RT + RT_EID); float* GATE = (float*)(F.wsp() + WS_RT + RT_GATE); int* HIST = (int*)(F.wsp() + WS_RT + RT_HIST);
    const int lane = F.lane, r16 = lane & 15, g = lane >> 4;
    for (int task = F.bid; task < T / 128; task += F.G) {
        const int t0 = task * 128 + F.wave * 16;
        __syncthreads();
        if (F.tid < 64) hist[F.tid] = 0;
        __syncthreads();
        f32x4 acc[3];
#pragma unroll
        for (int nt = 0; nt < 3; ++nt) acc[nt] = (f32x4){0.f, 0.f, 0.f, 0.f};
        float ss = 0.f;
        const float* xr = x + (size_t)(t0 + r16) * DM + 8 * g;
#pragma unroll 2
        for (int s = 0; s < 32; ++s) {
            const f32x4 x0 = *(const f32x4*)(xr + 32 * s), x1 = *(const f32x4*)(xr + 32 * s + 4);
            ss += (x0.x * x0.x + x0.y * x0.y) + (x0.z * x0.z + x0.w * x0.w) + (x1.x * x1.x + x1.y * x1.y) + (x1.z * x1.z + x1.w * x1.w);
            u32x4 hw, lw; hw.x = pk2(x0.x, x0.y); hw.y = pk2(x0.z, x0.w); hw.z = pk2(x1.x, x1.y); hw.w = pk2(x1.z, x1.w);
            lw.x = pk2(x0.x - bflo(hw.x), x0.y - bfhi(hw.x)); lw.y = pk2(x0.z - bflo(hw.y), x0.w - bfhi(hw.y)); lw.z = pk2(x1.x - bflo(hw.z), x1.y - bfhi(hw.z)); lw.w = pk2(x1.z - bflo(hw.w), x1.w - bfhi(hw.w));
            const bf16x8 ah = __builtin_bit_cast(bf16x8, hw), al = __builtin_bit_cast(bf16x8, lw);
#pragma unroll
            for (int nt = 0; nt < 3; ++nt) { const size_t wo = (size_t)(16 * nt + r16) * DM + 32 * s + 8 * g;
                const bf16x8 bh = *(const bf16x8*)(WRH + wo), bl = *(const bf16x8*)(WRL + wo);
                acc[nt] = mfma16(ah, bh, acc[nt]); acc[nt] = mfma16(ah, bl, acc[nt]); acc[nt] = mfma16(al, bh, acc[nt]); }
        }
        ss += __shfl_xor(ss, 16); ss += __shfl_xor(ss, 32);
#pragma unroll
        for (int nt = 0; nt < 3; ++nt)
#pragma unroll
            for (int r = 0; r < 4; ++r) lgt[(4 * g + r) * 48 + 16 * nt + r16] = acc[nt][r];
        if (g == 0) lgt[768 + r16] = ss;
        LDS_WAIT(); asm volatile("" ::: "memory");
        if (lane < 16) {
            const int t = t0 + lane; const float rs = 1.0f / sqrtf(lgt[768 + lane] * (1.f / DM) + 1e-6f); const LAS float* lr = lgt + lane * 48;
            float lg[4]; int gs = 0; float gm = -INFINITY;
#pragma unroll
            for (int q = 0; q < 4; ++q) { lg[q] = lr[q] * rs + bgrp[q]; if (lg[q] > gm) { gm = lg[q]; gs = q; } }
            float gden = 0.f;
#pragma unroll
            for (int q = 0; q < 4; ++q) gden += expf(lg[q] - gm);
            const float ptop = 1.0f / gden;
            float e0 = -INFINITY, e1 = -INFINITY; int j0 = 0, j1 = 1;
#pragma unroll
            for (int e = 0; e < 8; ++e) { const float le = lr[4 + gs * 8 + e] * rs + bexp[gs * 8 + e];
                if (le > e0) { e1 = e0; j1 = j0; e0 = le; j0 = e; } else if (le > e1) { e1 = le; j1 = e; } }
            const float p1 = expf(e1 - e0);
            const float g0 = ptop / (1.f + p1), g1 = ptop * p1 / (1.f + p1);
            const int ex0 = gs * 8 + j0, ex1 = gs * 8 + j1;
            EID[t * 2] = ex0; EID[t * 2 + 1] = ex1; GATE[t * 2] = g0; GATE[t * 2 + 1] = g1;
            LAS int* hh = hist + (F.wave >> 2) * 32;
            __hip_atomic_fetch_add(&hh[ex0], 1, __ATOMIC_RELAXED, __HIP_MEMORY_SCOPE_WORKGROUP); __hip_atomic_fetch_add(&hh[ex1], 1, __ATOMIC_RELAXED, __HIP_MEMORY_SCOPE_WORKGROUP);
        }
        __syncthreads();
        if (F.tid < 64) HIST[(task * 2 + (F.tid >> 5)) * 32 + (F.tid & 31)] = hist[F.tid];
    }
}
#ifndef MK_PER_PHASE_LAUNCH
#define MK_PER_PHASE_LAUNCH 0
#endif
constexpr int PH_PER_LAYER = 19, NPHASE = PH_PER_LAYER * NLAYER;
struct Args { const float* in[36]; float* out; unsigned char* ws; int ph_lo, ph_hi; };

#ifndef SCAN_NAIVE
#define SCAN_NAIVE 0
#endif
#ifndef PHMASK
#define PHMASK 0x7ffff
#endif
#ifndef DUPMASK
#define DUPMASK 0
#endif
#define NREP(k) ((((DUPMASK) >> (k)) & 1) ? 2 : 1)
#define IN(k) (((PHMASK >> ((k) % PH_PER_LAYER)) & 1) && lo <= (k) && (k) < hi)
#define SEAM(k) do { asm volatile("" : "+s"(barp), "+s"(bar.x)); bar.bar = (unsigned*)barp; if (IN(k) && IN((k) + 1)) xcd_barrier(bar); asm volatile("" : "+s"(F.ws_g), "+s"(F.out_g), "+s"(F.ka), "+s"(F.bid), "+s"(F.G), "+s"(F.lds)); } while (0)
#define FRESH() do { asm volatile("" : "+s"(F.wave)); int l_ = (int)__builtin_amdgcn_mbcnt_hi(~0u, __builtin_amdgcn_mbcnt_lo(~0u, 0u)); asm volatile("" : "+v"(l_)); F.lane = l_; F.tid = F.wave * 64 + l_; } while (0)
__global__ void __launch_bounds__(512, 2) fwd_kernel(Args args) {
    extern __shared__ __attribute__((aligned(16))) unsigned char lds_raw[];
    Frame F;
    F.lds = (LAS unsigned char*)lds_raw;
    F.tid = threadIdx.x; F.lane = F.tid & 63; F.wave = __builtin_amdgcn_readfirstlane(F.tid >> 6);
    F.G = gridDim.x; F.bid = blockIdx.x;
    F.ka = (const __attribute__((address_space(4))) unsigned char*)__builtin_amdgcn_kernarg_segment_ptr();
    F.out_g = (GAS float*)args.out; F.ws_g = (GAS unsigned char*)args.ws;
    volatile LAS unsigned* MISC = (volatile LAS unsigned*)(F.lds + MISC_OFF);
    if (F.tid < 32) MISC[F.tid] = 0u;
    __syncthreads();
    const int lo = args.ph_lo, hi = args.ph_hi;
    GAS unsigned* barp = (GAS unsigned*)(F.ws_g + WS_CTL) + CW_BAR;
    XcdBarrier bar; bar.bar = (unsigned*)barp; bar.x = 0; bar.st = nullptr;
    if (hi - lo > 1) bar = xcd_barrier_post((unsigned*)barp, MISC + 8);

    bf16_t* const XN = (bf16_t*)(F.wsp() + WS_XN);
    bf16_t* const WCAT = (bf16_t*)(F.wsp() + WS_WM + WM_WCAT);
    for (int l = 0; l < NLAYER; ++l) {
        const int P = l * PH_PER_LAYER;
#define PHASE(k) if (IN(P + (k))) for (int rep_ = 0; rep_ < NREP(k); ++rep_)
        PHASE(0) { FRESH(); if (l == 0) { phase_conv_mixer(F, 0); phase_conv_lora2(F, 0); phase_conv_router(F, 0); phase_norm_x(F, F.inp(0), F.inp(1)); } }
        SEAM(P + 0);
        PHASE(1) { FRESH(); pg8::Gemm g{XN, WCAT, T, 2304, DM}; pg8::StaticOrder S; S.init(T, 2304, F.G, F.bid);
            pg8::EpiStore E{(bf16_t*)(F.wsp() + WS_RW), 1536, 1536, (bf16_t*)(F.wsp() + WS_LO), LO_W, 0};
            pg8::gemm_phase<pg8::EpiStore, pg8::StaticOrder>(F.lds, g, S, E, F.tid); }
        SEAM(P + 1);
        PHASE(2) { FRESH(); phase_rwkv_prep2(F, l); }
        SEAM(P + 2);
#if SCAN_NAIVE
        PHASE(3) { FRESH(); phase_rwkv_scan_naive(F, l); }
        SEAM(P + 3);
        SEAM(P + 4);
        PHASE(5) { FRESH(); phase_rwkv_post(F, l); }
        SEAM(P + 5);
#else
        PHASE(3) { FRESH(); phase_scan_a(F, l); }
        SEAM(P + 3);
        PHASE(4) { FRESH(); phase_scan_b(F); }
        SEAM(P + 4);
        PHASE(5) { FRESH(); phase_scan_c(F, l); }
        SEAM(P + 5);
#endif
        PHASE(6) { FRESH(); pg8::Gemm g{XN, WCAT + (size_t)2304 * DM, T, 1536, DM}; pg8::StaticOrder S; S.init(T, 1536, F.G, F.bid);
            pg8::EpiStore E{(bf16_t*)(F.wsp() + WS_MO), 1536, 0, nullptr, 0, 0};
            pg8::gemm_phase<pg8::EpiStore, pg8::StaticOrder>(F.lds, g, S, E, F.tid); }
        SEAM(P + 6);
        PHASE(7) { FRESH(); phase_moba_prep(F, l); }
        SEAM(P + 7);
        PHASE(8) { FRESH(); phase_moba_gate(F); }
        SEAM(P + 8);
        PHASE(9) { FRESH(); phase_moba_attn(F, l); }
        SEAM(P + 9);
        PHASE(10) { FRESH(); phase_moba_combine(F); }
        SEAM(P + 10);
        PHASE(11) { FRESH(); pg8::Gemm g{XN, WCAT + (size_t)3840 * DM, T, 2048, DM}; pg8::StaticOrder S; S.init(T, 2048, F.G, F.bid);
            pg8::EpiStore E{(bf16_t*)(F.wsp() + WS_GA), 2048, 0, nullptr, 0, 1};
            pg8::gemm_phase<pg8::EpiStore, pg8::StaticOrder>(F.lds, g, S, E, F.tid); }
        SEAM(P + 11);
        PHASE(12) { FRESH();
            { pg8::Gemm g{(const bf16_t*)(F.wsp() + WS_YR), (const bf16_t*)(F.wsp() + WS_WM + WM_BRR), T, DM, CW}; pg8::StaticOrder S; S.init(T, DM, F.G, F.bid);
              pg8::EpiBranch E{(bf16_t*)(F.wsp() + WS_H), (const bf16_t*)(F.wsp() + WS_GA), 0, 1};
              pg8::gemm_phase<pg8::EpiBranch, pg8::StaticOrder>(F.lds, g, S, E, F.tid); }
            asm volatile("s_waitcnt vmcnt(0)" ::: "memory"); __syncthreads();
            { pg8::Gemm g{(const bf16_t*)(F.wsp() + WS_YM), (const bf16_t*)(F.wsp() + WS_WM + WM_BRM), T, DM, CW}; pg8::StaticOrder S; S.init(T, DM, F.G, F.bid);
              pg8::EpiBranch E{(bf16_t*)(F.wsp() + WS_H), (const bf16_t*)(F.wsp() + WS_GA), 1024, 0};
              pg8::gemm_phase<pg8::EpiBranch, pg8::StaticOrder>(F.lds, g, S, E, F.tid); }
        }
        SEAM(P + 12);
        PHASE(13) { FRESH(); pg8::Gemm g{(const bf16_t*)(F.wsp() + WS_H), (const bf16_t*)(F.wsp() + WS_WM + WM_OUT), T, DM, DM}; pg8::StaticOrder S; S.init(T, DM, F.G, F.bid);
            pg8::EpiResid E{l == 0 ? F.inp(0) : F.outp(), F.outp()};
            pg8::gemm_phase<pg8::EpiResid, pg8::StaticOrder>(F.lds, g, S, E, F.tid); }
        SEAM(P + 13);
        PHASE(14) { FRESH(); phase_router2(F, l); phase_conv_experts(F, l); }
        SEAM(P + 14);
        PHASE(15) { FRESH(); phase_moe_gather(F, l); }
        SEAM(P + 15);
        PHASE(16) { FRESH(); const int* PEXP = (const int*)(F.wsp() + WS_RT + RT_PEXP); const int np = __builtin_amdgcn_readfirstlane(PEXP[MOE_PANELS]);
            pg8::Gemm g{(const bf16_t*)(F.wsp() + WS_AM), (const bf16_t*)(F.wsp() + WS_WE), np * 256, 1024, DM}; pg8::GroupOrder S; S.init(np * 256, 1024, F.G, F.bid); S.pexp = PEXP;
            pg8::EpiExpertUp E{(bf16_t*)(F.wsp() + WS_HM), (const float*)(F.wsp() + WS_RT + RT_GW)};
            pg8::gemm_phase<pg8::EpiExpertUp, pg8::GroupOrder>(F.lds, g, S, E, F.tid); }
        SEAM(P + 16);
        PHASE(17) { FRESH(); const int* PEXP = (const int*)(F.wsp() + WS_RT + RT_PEXP); const int np = __builtin_amdgcn_readfirstlane(PEXP[MOE_PANELS]);
            pg8::Gemm g{(const bf16_t*)(F.wsp() + WS_HM), (const bf16_t*)(F.wsp() + WS_WD), np * 256, 1024, DEXP}; pg8::GroupOrder S; S.init(np * 256, 1024, F.G, F.bid); S.pexp = PEXP;
            pg8::EpiStore E{(bf16_t*)(F.wsp() + WS_YE), 1024, 0, nullptr, 0, 0};
            pg8::gemm_phase<pg8::EpiStore, pg8::GroupOrder>(F.lds, g, S, E, F.tid); }
        SEAM(P + 17);
        PHASE(18) { FRESH(); phase_moe_combine(F, l); if (l + 1 < NLAYER) { phase_conv_mixer(F, l + 1); phase_conv_lora2(F, l + 1); phase_conv_router(F, l + 1); } }
        SEAM(P + 18);
#undef PHASE
    }
}

extern "C" void kernel_launch(void* const* d_in, const int* in_sizes, int n_in, void* d_out, int out_size, void* d_ws, size_t ws_size, hipStream_t stream) {
    static int grid = 0;
    if (grid == 0) {
        if (n_in != 36 || out_size != T * DM || ws_size < WS_NEED) { fprintf(stderr, "kernel_launch: unexpected problem (n_in %d, out %d, ws %zu); nothing launched\n", n_in, out_size, ws_size); grid = -1; return; }
        int dev = 0, cus = 0;
        if (hipGetDevice(&dev) != hipSuccess || hipDeviceGetAttribute(&cus, hipDeviceAttributeMultiprocessorCount, dev) != hipSuccess) { grid = -1; return; }
        if (hipFuncSetAttribute((const void*)fwd_kernel, hipFuncAttributeMaxDynamicSharedMemorySize, LDS_BYTES) != hipSuccess) { fprintf(stderr, "kernel_launch: hipFuncSetAttribute failed\n"); grid = -1; return; }
        int per_cu = 0;
        if (hipOccupancyMaxActiveBlocksPerMultiprocessor(&per_cu, (const void*)fwd_kernel, 512, LDS_BYTES) != hipSuccess || per_cu < 1) { fprintf(stderr, "kernel_launch: occupancy query says %d\n", per_cu); }
        (void)hipGetLastError();
        grid = cus;
    }
    if (grid < 0) return;
    (void)hipMemsetAsync((char*)d_ws + WS_CTL, 0, CTL_ZERO_BYTES, stream);
    Args a{};
    for (int i = 0; i < 36; ++i) a.in[i] = (const float*)d_in[i];
    a.out = (float*)d_out; a.ws = (unsigned char*)d_ws;
#if MK_PER_PHASE_LAUNCH
    for (int ph = 0; ph < NPHASE; ++ph) { if (ph == PH_PER_LAYER) continue; a.ph_lo = ph; a.ph_hi = ph + 1; hipLaunchKernelGGL(fwd_kernel, dim3(grid), dim3(512), LDS_BYTES, stream, a); }
#else
    a.ph_lo = 0; a.ph_hi = NPHASE;
    hipLaunchKernelGGL(fwd_kernel, dim3(grid), dim3(512), LDS_BYTES, stream, a);
#endif
}
```

```cpp
#include <hip/hip_runtime.h>
#include <cstdio>
#include <cstdint>
#define LAS __attribute__((address_space(3)))
#define GAS __attribute__((address_space(1)))
#define DI __device__ __forceinline__
typedef unsigned short bf16_t;
typedef short bf16x8 __attribute__((ext_vector_type(8)));
typedef short s16x4 __attribute__((ext_vector_type(4)));
typedef float f32x4 __attribute__((ext_vector_type(4)));
typedef float f32x2 __attribute__((ext_vector_type(2)));
typedef float f32x16 __attribute__((ext_vector_type(16)));
typedef unsigned u32x4 __attribute__((ext_vector_type(4)));
typedef unsigned u32x2 __attribute__((ext_vector_type(2)));
typedef __bf16 bf16v2 __attribute__((ext_vector_type(2)));

DI unsigned pk2(float lo, float hi) { f32x2 v = {lo, hi}; return __builtin_bit_cast(unsigned, __builtin_convertvector(v, bf16v2)); }
DI bf16_t f2bf(float f) { return (bf16_t)(pk2(f, 0.f) & 0xffffu); }
DI float bf2f(bf16_t b) { return __uint_as_float(((unsigned)b) << 16); }
DI float bflo(unsigned w) { return __uint_as_float(w << 16); }
DI float bfhi(unsigned w) { return __uint_as_float(w & 0xffff0000u); }
DI float rcpf_(float x) { return __builtin_amdgcn_rcpf(x); }
DI float sigmoidf_(float x) { return __builtin_amdgcn_rcpf(1.0f + __expf(-x)); }

template <int CTRL> DI float dpp_mov(float v) { return __builtin_bit_cast(float, __builtin_amdgcn_update_dpp(0, __builtin_bit_cast(int, v), CTRL, 0xf, 0xf, true)); }
DI float rdlane(float v, int l) { return __builtin_bit_cast(float, __builtin_amdgcn_readlane(__builtin_bit_cast(int, v), l)); }
DI float wave_sum(float v) {
    v += dpp_mov<0xB1>(v);
    v += dpp_mov<0x4E>(v);
    v += dpp_mov<0x141>(v);
    v += dpp_mov<0x140>(v);
    return (rdlane(v, 0) + rdlane(v, 16)) + (rdlane(v, 32) + rdlane(v, 48));
}
DI f32x4 mfma16(bf16x8 a, bf16x8 b, f32x4 c) { return __builtin_amdgcn_mfma_f32_16x16x32_bf16(a, b, c, 0, 0, 0); }
namespace pg8 {
constexpr int BM = 256, BK = 64, HALF = 128, HTB = HALF * BK * 2  , STAGE_BYTES = 8 * HTB, NXCD = 8, WGM = 8;

__host__ __device__ __forceinline__ int lds_byte(int r, int c) { const int st = (r >> 4) * 2 + (c >> 5), rr = r & 15, cc = c & 31, ob = rr * 64 + cc * 2; return st * 1024 + (ob ^ (((ob >> 9) & 1) << 5)); }
__host__ __device__ __forceinline__ void stage_rc(int b, int& R, int& C) { const int st = b / 1024, sb = b % 1024, swz = sb ^ (((sb >> 9) & 1) << 5); R = (st >> 1) * 16 + swz / 64; C = (st & 1) * 32 + (swz % 64) / 2; }
__host__ __device__ __forceinline__ int perm32(int rho) { const int n = rho >> 4, i = rho & 15; return 8 * (i >> 2) + 4 * n + (i & 3); }

struct Unit { int pm, pn, pb; };
struct Gemm { const bf16_t* A; const bf16_t* Bt; int M, N, K; };

struct StaticOrder {
    int nM, nN, nwg, G, c;
    __device__ __forceinline__ void init(int M, int N, int G_, int c_) { nM = M / BM; nN = N / BM; nwg = nM * nN; G = G_; c = c_; }
    __device__ __forceinline__ bool next(int i, Unit& u) const {
        const long L = (long)i * G + c; if (L >= nwg) return false;
        int wgid = (int)L; { const int q = nwg / NXCD, r = nwg % NXCD, xcd = wgid % NXCD, off = wgid / NXCD; wgid = (xcd < r ? xcd * (q + 1) : r * (q + 1) + (xcd - r) * q) + off; }
        const int nig = WGM * nN, gid = wgid / nig, fm = gid * WGM, gsz = (nM - fm) < WGM ? (nM - fm) : WGM;
        u.pm = fm + ((wgid % nig) % gsz); u.pn = (wgid % nig) / gsz; u.pb = u.pn; return true;
    }
};
struct GroupOrder : StaticOrder {
    const int* pexp;
    __device__ __forceinline__ bool next(int i, Unit& u) const {
        if (!StaticOrder::next(i, u)) return false;
        u.pb = __builtin_amdgcn_readfirstlane(pexp[u.pm]) * nN + u.pn; return true;
    }
};

template <class Epi, class Sched, bool ALIGN_EPI = true, bool SP2 = true>
__device__ __forceinline__ void gemm_phase(LAS unsigned char* lds, const Gemm g, const Sched& S, const Epi& E, int tid_in) {
    const int tid = tid_in, wid = __builtin_amdgcn_readfirstlane(tid >> 6), lane = tid & 63, wr = wid >> 2, wc = wid & 3, fr = lane & 15, fq = lane >> 4;
    const int K = g.K, nt = K / BK;
    unsigned voffA[2], voffB[2];
#pragma unroll
    for (int i = 0; i < 2; ++i) { int R, C; stage_rc(tid * 16 + i * 8192, R, C); const int Rb = Epi::PERM ? ((R & ~31) + perm32(R & 31)) : R;
        voffA[i] = (unsigned)(R * K + C) * 2u; voffB[i] = (unsigned)(Rb * K + C) * 2u; }
    const size_t kstep = (size_t)(BK * 2);
    const size_t hstep = (size_t)HALF * K * 2;
    const size_t tstep = 2 * hstep;
    const unsigned ldsw = (unsigned)wid * 1024u;
    const int aoff = lds_byte(wr * 64 + fr, fq * 8), boff = lds_byte(wc * 32 + fr, fq * 8);
#define PG8_SA(b, h) (((b) * 2 + (h)) * HTB)
#define PG8_SB(b, h) ((4 + (b) * 2 + (h)) * HTB)
#define PG8_STAGE(bufoff, gbase, voff) do { _Pragma("unroll") for (int _i = 0; _i < 2; ++_i) \
        __builtin_amdgcn_global_load_lds((const unsigned*)((const char*)(gbase) + (voff)[_i]), (LAS unsigned*)(lds + (bufoff) + ldsw + _i * 8192), 16, 0, 0); } while (0)
#define PG8_LDA(dst, b, h) do { _Pragma("unroll") for (int m = 0; m < 4; ++m) _Pragma("unroll") for (int k = 0; k < 2; ++k) dst[m][k] = *(const LAS bf16x8*)(lds + PG8_SA(b, h) + aoff + m * 2048 + k * 1024); } while (0)
#define PG8_LDB(dst, b, h) do { _Pragma("unroll") for (int n = 0; n < 2; ++n) _Pragma("unroll") for (int k = 0; k < 2; ++k) dst[n][k] = *(const LAS bf16x8*)(lds + PG8_SB(b, h) + boff + n * 2048 + k * 1024); } while (0)
#define PG8_MMA(ai, bj, At, Bt) do { __builtin_amdgcn_s_setprio(1); _Pragma("unroll") for (int m = 0; m < 4; ++m) _Pragma("unroll") for (int n = 0; n < 2; ++n) _Pragma("unroll") for (int k = 0; k < 2; ++k) \
        acc[ai][bj][m][n] = __builtin_amdgcn_mfma_f32_16x16x32_bf16(Bt[n][k], At[m][k], acc[ai][bj][m][n], 0, 0, 0); __builtin_amdgcn_s_setprio(0); } while (0)
#define PG8_WAIT_V(n) asm volatile("s_waitcnt vmcnt(" #n ")" ::: "memory")
#define PG8_WAIT_L(n) asm volatile("s_waitcnt lgkmcnt(" #n ")" ::: "memory")
#define PG8_BAR __builtin_amdgcn_s_barrier()
#define PG8_SCHED __builtin_amdgcn_sched_barrier(0)
    Unit cur, nxt; int ui = 0;
    if (!S.next(0, cur)) return;
    f32x4 acc[2][2][4][2];
#pragma unroll
    for (int a = 0; a < 2; ++a)
#pragma unroll
        for (int b = 0; b < 2; ++b)
#pragma unroll
            for (int m = 0; m < 4; ++m)
#pragma unroll
                for (int n = 0; n < 2; ++n) acc[a][b][m][n] = (f32x4){0.f, 0.f, 0.f, 0.f};
    bf16x8 At[4][2], B0[2][2], B1[2][2];
    const char* cA = (const char*)g.A + (size_t)cur.pm * tstep; const char* cB = (const char*)g.Bt + (size_t)cur.pb * tstep;
    if constexpr (SP2) {
        PG8_STAGE(PG8_SB(0, 0), cB, voffB); PG8_STAGE(PG8_SB(0, 1), cB + hstep, voffB); PG8_STAGE(PG8_SA(0, 0), cA, voffA); PG8_STAGE(PG8_SA(0, 1), cA + hstep, voffA);
        if (wr == 1) PG8_BAR;
        PG8_WAIT_V(2); PG8_BAR;
        PG8_STAGE(PG8_SB(1, 0), cB + kstep, voffB); PG8_STAGE(PG8_SA(1, 0), cA + kstep, voffA); PG8_STAGE(PG8_SB(1, 1), cB + hstep + kstep, voffB);
        PG8_WAIT_V(6); PG8_BAR;
    } else {
        PG8_STAGE(PG8_SB(0, 0), cB, voffB); PG8_STAGE(PG8_SA(0, 0), cA, voffA); PG8_STAGE(PG8_SB(0, 1), cB + hstep, voffB); PG8_STAGE(PG8_SA(0, 1), cA + hstep, voffA);
        if (wr == 1) PG8_BAR;
        PG8_WAIT_V(4); PG8_BAR;
        PG8_STAGE(PG8_SB(1, 0), cB + kstep, voffB); PG8_STAGE(PG8_SA(1, 0), cA + kstep, voffA); PG8_STAGE(PG8_SB(1, 1), cB + hstep + kstep, voffB);
        PG8_WAIT_V(6); PG8_BAR;
    }
    for (;;) {
        const bool has_next = S.next(ui + 1, nxt);
        const char* nA = has_next ? (const char*)g.A + (size_t)nxt.pm * tstep : cA; const char* nB = has_next ? (const char*)g.Bt + (size_t)nxt.pb * tstep : cB;
        for (int t = 0; t < nt; t += 2) {
            if constexpr (Epi::HAS_MID) { if (t == nt / 2) E.mid(acc, cur, wr, wc, fr, fq); }
            const bool last = (t == nt - 2);
            const char* a1 = cA + (size_t)(t + 1) * kstep;
            const char* a2 = last ? nA : cA + (size_t)(t + 2) * kstep; const char* b2 = last ? nB : cB + (size_t)(t + 2) * kstep;
            const char* a3 = a2 + kstep; const char* b3 = b2 + kstep;
            if constexpr (SP2) {
            PG8_LDB(B0, 0, 0); PG8_LDB(B1, 0, 1); PG8_SCHED; PG8_LDA(At, 0, 0); PG8_STAGE(PG8_SA(1, 1), a1 + hstep, voffA);
            PG8_WAIT_V(8); PG8_WAIT_L(0); PG8_BAR; PG8_MMA(0, 0, At, B0); PG8_MMA(0, 1, At, B1); PG8_BAR; PG8_SCHED;
            PG8_LDA(At, 0, 1); PG8_STAGE(PG8_SB(0, 0), b2, voffB); PG8_STAGE(PG8_SB(0, 1), b2 + hstep, voffB); PG8_STAGE(PG8_SA(0, 0), a2, voffA);
            PG8_WAIT_V(8); PG8_WAIT_L(0); PG8_BAR; PG8_MMA(1, 0, At, B0); PG8_MMA(1, 1, At, B1); PG8_BAR; PG8_SCHED;
            PG8_LDB(B0, 1, 0); PG8_LDB(B1, 1, 1); PG8_SCHED; PG8_LDA(At, 1, 0); PG8_STAGE(PG8_SA(0, 1), a2 + hstep, voffA);
            PG8_WAIT_V(8); PG8_WAIT_L(0); PG8_BAR; PG8_MMA(0, 0, At, B0); PG8_MMA(0, 1, At, B1); PG8_BAR; PG8_SCHED;
            PG8_LDA(At, 1, 1); PG8_STAGE(PG8_SB(1, 0), b3, voffB); PG8_STAGE(PG8_SB(1, 1), b3 + hstep, voffB); PG8_STAGE(PG8_SA(1, 0), a3, voffA);
            PG8_WAIT_V(8); PG8_WAIT_L(0); PG8_BAR; PG8_MMA(1, 0, At, B0); PG8_MMA(1, 1, At, B1); PG8_BAR; PG8_SCHED;
            } else {
            PG8_LDB(B0, 0, 0); PG8_SCHED; PG8_LDA(At, 0, 0); PG8_STAGE(PG8_SA(1, 1), a1 + hstep, voffA);
            PG8_WAIT_L(8); PG8_BAR; PG8_WAIT_L(0); PG8_MMA(0, 0, At, B0); PG8_BAR; PG8_SCHED;
            PG8_LDB(B1, 0, 1); PG8_STAGE(PG8_SB(0, 0), b2, voffB);
            PG8_BAR; PG8_WAIT_L(0); PG8_MMA(0, 1, At, B1); PG8_BAR;
            PG8_LDA(At, 0, 1); PG8_STAGE(PG8_SA(0, 0), a2, voffA);
            PG8_BAR; PG8_WAIT_L(0); PG8_MMA(1, 0, At, B0); PG8_BAR; PG8_SCHED;
            PG8_STAGE(PG8_SB(0, 1), b2 + hstep, voffB);
            PG8_WAIT_V(6); PG8_BAR; PG8_MMA(1, 1, At, B1); PG8_BAR;
            PG8_LDB(B0, 1, 0); PG8_SCHED; PG8_LDA(At, 1, 0); PG8_STAGE(PG8_SA(0, 1), a2 + hstep, voffA);
            PG8_WAIT_L(8); PG8_BAR; PG8_WAIT_L(0); PG8_MMA(0, 0, At, B0); PG8_BAR; PG8_SCHED;
            PG8_LDB(B1, 1, 1); PG8_STAGE(PG8_SB(1, 0), b3, voffB);
            PG8_BAR; PG8_WAIT_L(0); PG8_MMA(0, 1, At, B1); PG8_BAR;
            PG8_LDA(At, 1, 1); PG8_STAGE(PG8_SA(1, 0), a3, voffA);
            PG8_BAR; PG8_WAIT_L(0); PG8_MMA(1, 0, At, B0); PG8_BAR; PG8_SCHED;
            PG8_STAGE(PG8_SB(1, 1), b3 + hstep, voffB);
            PG8_WAIT_V(6); PG8_BAR; PG8_MMA(1, 1, At, B1); PG8_BAR;
            }
        }
        if constexpr (ALIGN_EPI) { if (wr == 0) PG8_BAR; }
        E(acc, cur, wr, wc, fr, fq);
        if (!has_next) break;
#pragma unroll
        for (int a = 0; a < 2; ++a)
#pragma unroll
            for (int b = 0; b < 2; ++b)
#pragma unroll
                for (int m = 0; m < 4; ++m)
#pragma unroll
                    for (int n = 0; n < 2; ++n) acc[a][b][m][n] = (f32x4){0.f, 0.f, 0.f, 0.f};
        cur = nxt; cA = nA; cB = nB; ++ui;
        if constexpr (ALIGN_EPI) { if (wr == 1) PG8_BAR; }
    }
    PG8_WAIT_V(0);
    if constexpr (!ALIGN_EPI) { if (wr == 0) PG8_BAR; }
    PG8_BAR;
#undef PG8_SA
#undef PG8_SB
#undef PG8_STAGE
#undef PG8_LDA
#undef PG8_LDB
#undef PG8_MMA
#undef PG8_WAIT_V
#undef PG8_WAIT_L
#undef PG8_BAR
#undef PG8_SCHED
}
}
#define XB_TMO      128
#define XB_XCNT(j)  (256  + 64 * (j))
#define XB_XSUB(j)  (1280 + 64 * (j))
#define XB_XGEN(j)  (2304 + 64 * (j))
#define XB_TOP      3328
#define XB_TOPGEN   3392
#define XCD_BAR_WORDS 3456
#define XB_SPIN_CAP (1u << 18)

__device__ __forceinline__ unsigned xb_ld(unsigned* p)              { return __hip_atomic_load(p, __ATOMIC_RELAXED, __HIP_MEMORY_SCOPE_AGENT); }
__device__ __forceinline__ unsigned xb_add(unsigned* p, unsigned v) { return __hip_atomic_fetch_add(p, v, __ATOMIC_RELAXED, __HIP_MEMORY_SCOPE_AGENT); }
__device__ __forceinline__ unsigned xb_xcc_id() { return (unsigned)__builtin_amdgcn_s_getreg((3 << 11) | 20) & 0xFu; }
#define XB_SPIN(cond, bar) do { unsigned _sp = 0; while (cond) { __builtin_amdgcn_s_sleep(1); \
    if ((++_sp & 255u) == 0u) { if (xb_ld(&(bar)[XB_TMO])) break; if (_sp > XB_SPIN_CAP) { atomicAdd(&(bar)[XB_TMO], 1u); break; } } } } while (0)

struct XcdBarrier {
    unsigned* bar; unsigned x;
    volatile LAS unsigned* st;
};

__device__ __forceinline__ XcdBarrier xcd_barrier_post(unsigned* bar, volatile LAS unsigned* st) {
    XcdBarrier b; b.bar = bar; b.x = xb_xcc_id(); b.st = st;
    if (threadIdx.x == 0) (void)xb_add(&bar[XB_XCNT(b.x)], 1u);
    return b;
}
__device__ __forceinline__ void xcd_barrier_complete(unsigned* bar, unsigned x, unsigned& nloc, unsigned& nx) {
    const unsigned G = gridDim.x * gridDim.y * gridDim.z;
    unsigned sum, cnt, mine, sp = 0u;
    for (;;) {
        sum = 0u; cnt = 0u; mine = 0u;
#pragma unroll
        for (unsigned j = 0; j < 16; ++j) { const unsigned c = xb_ld(&bar[XB_XCNT(j)]); sum += c; cnt += (c > 0u) ? 1u : 0u; mine = (j == x) ? c : mine; }
        if (sum == G) break;
        __builtin_amdgcn_s_sleep(1);
        if ((++sp & 255u) == 0u) { if (xb_ld(&bar[XB_TMO])) break; if (sp > XB_SPIN_CAP) { atomicAdd(&bar[XB_TMO], 1u); break; } }
    }
    nloc = mine > 0u ? mine : 1u; nx = cnt > 0u ? cnt : 1u;
}

__device__ __forceinline__ void xcd_barrier(const XcdBarrier& b) {
    asm volatile("s_waitcnt vmcnt(0)" ::: "memory");
    __syncthreads();
    if (threadIdx.x == 0) {
        unsigned* bar = b.bar;
        __builtin_amdgcn_s_waitcnt(0);
        unsigned nloc = b.st[0], nx = b.st[1];
        if (nloc == 0u) { xcd_barrier_complete(bar, b.x, nloc, nx); b.st[0] = nloc; b.st[1] = nx; }
        const unsigned old = xb_add(&bar[XB_XSUB(b.x)], 1u);
        const unsigned gen = old / nloc;
        if (old + 1u == (gen + 1u) * nloc) {
            __builtin_amdgcn_fence(__ATOMIC_RELEASE, "agent");
            asm volatile("s_waitcnt vmcnt(0)" ::: "memory");
            const unsigned og = xb_add(&bar[XB_TOP], 1u);
            const unsigned tg = og / nx;
            if (og + 1u == (tg + 1u) * nx) xb_add(&bar[XB_TOPGEN], 1u);
            else XB_SPIN(xb_ld(&bar[XB_TOPGEN]) == tg, bar);
            __builtin_amdgcn_fence(__ATOMIC_ACQUIRE, "agent");
            xb_add(&bar[XB_XGEN(b.x)], 1u);
            asm volatile("s_waitcnt vmcnt(0)" ::: "memory");
        } else {
            XB_SPIN(xb_ld(&bar[XB_XGEN(b.x)]) == gen, bar);
            __builtin_amdgcn_fence(__ATOMIC_ACQUIRE, "agent");
            asm volatile("s_waitcnt vmcnt(0)" ::: "memory");
        }
    }
    __syncthreads();
}
constexpr int NB = 4, SEQ = 8192, DM = 1024, T = NB * SEQ;
constexpr int NH = 8, HD = 64, CW = 512;
constexpr int N_IN = 5120;
constexpr int NLAYER = 2;
constexpr int NEXP = 32, DEXP = 512;
constexpr int MOE_ROWS = 73728, MOE_PANELS = MOE_ROWS / 256;
constexpr int WCAT_ROWS = 5888;
constexpr int LO_W = 768;

constexpr size_t MiB = 1u << 20;
constexpr size_t WS_CTL = 0, CTL_ZERO_BYTES = 1 * MiB;
constexpr size_t WS_VF   = 1 * MiB;
constexpr size_t WS_TAB  = 33 * MiB;
constexpr size_t WS_WM   = 34 * MiB;
constexpr size_t WS_XN   = 50 * MiB;
constexpr size_t WS_RW   = 114 * MiB;
constexpr size_t WS_MO   = 114 * MiB;
constexpr size_t WS_LO   = 210 * MiB;
constexpr size_t WS_YRM  = 354 * MiB;
constexpr int YRM_LD = 1024;
constexpr size_t WS_SI   = 258 * MiB;
constexpr size_t WS_V1   = 418 * MiB;
constexpr size_t WS_G    = 450 * MiB;
constexpr size_t WS_YS   = 482 * MiB;
constexpr size_t WS_PO   = 418 * MiB;
constexpr size_t WS_PST  = 258 * MiB;
constexpr size_t WS_GA   = 418 * MiB;
constexpr size_t WS_H    = 290 * MiB;
constexpr size_t WS_SC1  = 482 * MiB;
constexpr size_t WS_SC2  = 114 * MiB;
constexpr size_t WS_SCT  = 290 * MiB;
constexpr size_t WS_WE   = 34 * MiB;
constexpr size_t WS_WD   = 98 * MiB;
constexpr size_t WS_AM   = 130 * MiB;
constexpr size_t WS_HM   = 274 * MiB;
constexpr size_t WS_YE   = 346 * MiB;
constexpr size_t WS_RT   = 490 * MiB;
constexpr size_t WS_END  = 556 * MiB;
constexpr size_t TB_KMEAN = 0;
constexpr size_t TB_SEL   = 256 * 1024;
constexpr size_t RT_EID  = 0;
constexpr size_t RT_GATE = 256 * 1024;
constexpr size_t RT_ROW  = 512 * 1024;
constexpr size_t RT_GW   = 768 * 1024;
constexpr size_t RT_HIST = 1280 * 1024;
constexpr size_t RT_PEXP = 1408 * 1024;
constexpr size_t WS_SEL  = 556 * MiB;
constexpr size_t WS_NEED = 558 * MiB;
constexpr int CW_BAR = 4096;

constexpr int RING_BYTES = 131072;
constexpr int LDS_BYTES = 163840;
constexpr int MISC_OFF = LDS_BYTES - 256;
struct Frame {
    LAS unsigned char* lds;
    int tid, lane, wave;
    int G, bid;
    const __attribute__((address_space(4))) unsigned char* ka;
    GAS float* out_g; GAS unsigned char* ws_g;
    DI float* outp() const { return (float*)out_g; }
    DI unsigned char* wsp() const { return (unsigned char*)ws_g; }
    DI const float* inp(int i) const { return (const float*)(*(const GAS float* const __attribute__((address_space(4)))*)(ka + 8 * i)); }
};
#define LDS_WAIT() asm volatile("s_waitcnt lgkmcnt(0)" ::: "memory")

DI void tr_item(const float* src, int ld, int k0, bf16_t* dst, int Kd, const float* sc, int mode, LAS float* scr, int lane) {
#pragma unroll 8
    for (int i = 0; i < 32; ++i) { const int kk = 2 * i + (lane >> 5);
        float v = src ? src[(size_t)(k0 + kk) * ld + (lane & 31)] : 0.f;
        if (mode == 1) v *= sc[k0 + kk]; else if (mode == 2) v *= (1.f - sc[k0 + kk]);
        scr[kk * 33 + (lane & 31)] = v; }
    LDS_WAIT(); asm volatile("" ::: "memory");
    const int c = lane & 7;
#pragma unroll
    for (int j = 0; j < 4; ++j) { const int n = (lane >> 3) + 8 * j; const LAS float* s = scr + (8 * c) * 33 + n;
        u32x4 o; o.x = pk2(s[0 * 33], s[1 * 33]); o.y = pk2(s[2 * 33], s[3 * 33]); o.z = pk2(s[4 * 33], s[5 * 33]); o.w = pk2(s[6 * 33], s[7 * 33]);
        *(u32x4*)(dst + (size_t)n * Kd + k0 + 8 * c) = o; }
    LDS_WAIT(); asm volatile("" ::: "memory");
}

constexpr size_t WM_WCAT = 0, WM_BRR = (size_t)WCAT_ROWS * 1024 * 2, WM_BRM = WM_BRR + 1024 * 512 * 2, WM_OUT = WM_BRM + 1024 * 512 * 2;
DI void phase_conv_mixer(Frame& F, int l) {
    LAS float* scr = (LAS float*)(F.lds + F.wave * 16384);
    const int gw = F.bid * 8 + F.wave, NGW = F.G * 8;
    bf16_t* wcat = (bf16_t*)(F.wsp() + WS_WM + WM_WCAT);
    const float* w_in = F.inp(3) + (size_t)l * DM * N_IN;
    const float* mu_x = F.inp(5) + (size_t)l * 3 * DM;
    constexpr int NBLK = WCAT_ROWS / 32;
    constexpr int I_CAT = NBLK * 16, I_BR = 8 * 32, I_OUT = 16 * 32;
    for (int it = gw; it < I_CAT + 2 * I_BR + I_OUT; it += NGW) {
        int r = it;
        if (r < I_CAT) {
            const int nb = r / 16, kb = r % 16, k0 = kb * 64;
            if (nb < 48) { tr_item(w_in + 32 * nb, N_IN, k0, wcat + (size_t)(32 * nb) * 1024, 1024, nullptr, 0, scr, F.lane); }
            else if (nb < 72) {
                const int q = nb - 48; const float* src = nullptr; int ld = 0; const float* sc = nullptr; int mode = 0;
                if (q < 4)       { src = F.inp(7)  + (size_t)l * DM * 64  + 32 * (q & 1); ld = 64;  sc = mu_x;          mode = (q < 2) ? 2 : 1; }
                else if (q < 8)  { src = F.inp(10) + (size_t)l * DM * 64  + 32 * (q & 1); ld = 64;  sc = mu_x + DM;     mode = (q < 6) ? 2 : 1; }
                else if (q < 16) { src = F.inp(12) + (size_t)l * DM * 128 + 32 * (q & 3); ld = 128; sc = mu_x + 2 * DM; mode = (q < 12) ? 2 : 1; }
                else if (q < 18 && l > 0) { src = F.inp(21) + (size_t)(l - 1) * DM * 32; ld = 32; sc = F.inp(19) + (size_t)(l - 1) * DM; mode = (q == 16) ? 2 : 1; }
                tr_item(src, ld, k0, wcat + (size_t)(1536 + 32 * q) * 1024, 1024, sc, mode, scr, F.lane);
            }
            else if (nb < 120) { tr_item(w_in + 1536 + 32 * (nb - 72), N_IN, k0, wcat + (size_t)(2304 + 32 * (nb - 72)) * 1024, 1024, nullptr, 0, scr, F.lane); }
            else { tr_item(w_in + 3072 + 32 * (nb - 120), N_IN, k0, wcat + (size_t)(3840 + 32 * (nb - 120)) * 1024, 1024, nullptr, 0, scr, F.lane); }
            continue;
        }
        r -= I_CAT;
        if (r < I_BR) { const int nb = r / 8, kb = r % 8; tr_item(F.inp(26) + (size_t)l * 512 * 1024 + 32 * nb, 1024, kb * 64, (bf16_t*)(F.wsp() + WS_WM + WM_BRR) + (size_t)(32 * nb) * 1024, 1024, nullptr, 0, scr, F.lane); continue; }
        r -= I_BR;
        if (r < I_BR) { const int nb = r / 8, kb = r % 8; tr_item(F.inp(27) + (size_t)l * 512 * 1024 + 32 * nb, 1024, kb * 64, (bf16_t*)(F.wsp() + WS_WM + WM_BRR) + (size_t)(32 * nb) * 1024 + 512, 1024, nullptr, 0, scr, F.lane); continue; }
        r -= I_BR;
        { const int nb = r / 16, kb = r % 16; tr_item(F.inp(28) + (size_t)l * 1024 * 1024 + 32 * nb, 1024, kb * 64, (bf16_t*)(F.wsp() + WS_WM + WM_OUT) + (size_t)(32 * nb) * 1024, 1024, nullptr, 0, scr, F.lane); }
    }
}
DI void tr_block(const float* src, int ld, int k0, int n0, bf16_t* dstbase, int Kd, int mode, LAS float* scr, int tid) {
#pragma unroll
    for (int i = 0; i < 8; ++i) { const int idx = tid + 512 * i, row = idx >> 6, c4 = idx & 63;
        const f32x4 v = *(const f32x4*)(src + (size_t)(k0 + row) * ld + n0 + 4 * c4);
        LAS float* d = scr + row * 257 + 4 * c4; d[0] = v.x; d[1] = v.y; d[2] = v.z; d[3] = v.w; }
    __syncthreads();
#pragma unroll
    for (int i = 0; i < 4; ++i) { const int idx = tid + 512 * i, n = idx >> 3, c = idx & 7; const LAS float* sp = scr + (8 * c) * 257 + n;
        u32x4 o; o.x = pk2(sp[0], sp[257]); o.y = pk2(sp[2 * 257], sp[3 * 257]); o.z = pk2(sp[4 * 257], sp[5 * 257]); o.w = pk2(sp[6 * 257], sp[7 * 257]);
        const int h = n0 + n; const int drow = (mode == 2) ? h : ((h >> 7) * 256 + mode * 128 + (h & 127));
        *(u32x4*)(dstbase + (size_t)drow * Kd + k0 + 8 * c) = o; }
    __syncthreads();
}
DI void phase_conv_experts(Frame& F, int l) {
    LAS float* scr = (LAS float*)F.lds;
    bf16_t* we = (bf16_t*)(F.wsp() + WS_WE); bf16_t* wd = (bf16_t*)(F.wsp() + WS_WD);
    const float* wg = F.inp(33) + (size_t)l * NEXP * DM * DEXP; const float* wu = F.inp(34) + (size_t)l * NEXP * DM * DEXP; const float* wdn = F.inp(35) + (size_t)l * NEXP * DEXP * DM;
    __syncthreads();
    for (int it = F.bid; it < NEXP * 96; it += F.G) {
        const int e = it / 96; int r = it % 96;
        if (r < 64) { const int up = r >> 5; r &= 31; const int kb = r >> 1, nb = r & 1;
            tr_block((up ? wu : wg) + (size_t)e * DM * DEXP, DEXP, kb * 64, nb * 256, we + (size_t)e * 1024 * 1024, 1024, up, scr, F.tid); }
        else { r -= 64; const int kb = r >> 2, nb = r & 3;
            tr_block(wdn + (size_t)e * DEXP * DM, DM, kb * 64, nb * 256, wd + (size_t)e * 1024 * 512, 512, 2, scr, F.tid); }
    }
}
DI void rms_row_to_bf16(const float* xrow, const float* gain, bf16_t* o0, bf16_t* o1, int lane) {
    const f32x4* xr = (const f32x4*)xrow + lane; const f32x4* gr = (const f32x4*)gain + lane;
    f32x4 v[4]; float s = 0.f;
#pragma unroll
    for (int j = 0; j < 4; ++j) { v[j] = xr[64 * j]; s += (v[j].x * v[j].x + v[j].y * v[j].y) + (v[j].z * v[j].z + v[j].w * v[j].w); }
    const float rs = 1.0f / sqrtf(wave_sum(s) * (1.f / DM) + 1e-6f);
#pragma unroll
    for (int j = 0; j < 4; ++j) { const f32x4 g = gr[64 * j]; const f32x4 y = v[j] * rs * g;
        u32x2 w; w.x = pk2(y.x, y.y); w.y = pk2(y.z, y.w);
        *((u32x2*)o0 + lane + 64 * j) = w; if (o1) *((u32x2*)o1 + lane + 64 * j) = w; }
}
DI void phase_norm_x(Frame& F, const float* x, const float* gain) {
    const int gw = F.bid * 8 + F.wave, NGW = F.G * 8; bf16_t* xn = (bf16_t*)(F.wsp() + WS_XN);
    for (int m = gw; m < T; m += NGW) rms_row_to_bf16(x + (size_t)m * DM, gain, xn + (size_t)m * DM, nullptr, F.lane);
}

namespace pg8 {
struct EpiStore {
    static constexpr bool PERM = true, HAS_MID = false;
    bf16_t* O; int ldc; int split; bf16_t* O2; int ldc2; int act;
    __device__ __forceinline__ void operator()(const f32x4 (&acc)[2][2][4][2], const Unit& u, int wr, int wc, int fr, int fq) const {
        const int row0 = u.pm * BM + wr * 64 + fr; int colt = u.pn * BM; bf16_t* base = O; int ld = ldc;
        if (split && colt >= split) { base = O2; ld = ldc2; colt -= split; }
        const int col0 = colt + wc * 32 + 8 * fq;
#pragma unroll
        for (int ai = 0; ai < 2; ++ai)
#pragma unroll
            for (int m = 0; m < 4; ++m) { bf16_t* rowp = base + (size_t)(row0 + ai * HALF + m * 16) * ld + col0;
#pragma unroll
                for (int bj = 0; bj < 2; ++bj) { f32x4 v0 = acc[ai][bj][m][0], v1 = acc[ai][bj][m][1];
                    if (act == 1) {
#pragma unroll
                        for (int j = 0; j < 4; ++j) { v0[j] = sigmoidf_(v0[j]); v1[j] = sigmoidf_(v1[j]); } }
                    u32x4 w; w.x = pk2(v0[0], v0[1]); w.y = pk2(v0[2], v0[3]); w.z = pk2(v1[0], v1[1]); w.w = pk2(v1[2], v1[3]);
                    *(u32x4*)(rowp + bj * HALF) = w; } }
    }
};
struct EpiBranch {
    static constexpr bool PERM = true, HAS_MID = false;
    bf16_t* Hout; const bf16_t* gate; int gcol0; int first;
    __device__ __forceinline__ void operator()(const f32x4 (&acc)[2][2][4][2], const Unit& u, int wr, int wc, int fr, int fq) const {
        const int row0 = u.pm * BM + wr * 64 + fr; const int col0 = u.pn * BM + wc * 32 + 8 * fq;
#pragma unroll
        for (int ai = 0; ai < 2; ++ai)
#pragma unroll
            for (int m = 0; m < 4; ++m) { const size_t row = (size_t)(row0 + ai * HALF + m * 16);
#pragma unroll
                for (int bj = 0; bj < 2; ++bj) {
                    const u32x4 gv = *(const u32x4*)(gate + row * 2048 + gcol0 + col0 + bj * HALF);
                    bf16_t* hp = Hout + row * 1024 + col0 + bj * HALF;
                    f32x4 v0 = acc[ai][bj][m][0], v1 = acc[ai][bj][m][1];
                    v0[0] *= bflo(gv.x); v0[1] *= bfhi(gv.x); v0[2] *= bflo(gv.y); v0[3] *= bfhi(gv.y);
                    v1[0] *= bflo(gv.z); v1[1] *= bfhi(gv.z); v1[2] *= bflo(gv.w); v1[3] *= bfhi(gv.w);
                    if (!first) { const u32x4 hv = *(const u32x4*)hp;
                        v0[0] += bflo(hv.x); v0[1] += bfhi(hv.x); v0[2] += bflo(hv.y); v0[3] += bfhi(hv.y);
                        v1[0] += bflo(hv.z); v1[1] += bfhi(hv.z); v1[2] += bflo(hv.w); v1[3] += bfhi(hv.w); }
                    u32x4 w; w.x = pk2(v0[0], v0[1]); w.y = pk2(v0[2], v0[3]); w.z = pk2(v1[0], v1[1]); w.w = pk2(v1[2], v1[3]);
                    *(u32x4*)hp = w; } }
    }
};
struct EpiBranch2 {
    static constexpr bool PERM = true, HAS_MID = true;
    bf16_t* Hout; const bf16_t* gate;
    __device__ __forceinline__ void mid(f32x4 (&acc)[2][2][4][2], const Unit& u, int wr, int wc, int fr_, int fq_) const {
        int fr = fr_, fq = fq_; asm volatile("" : "+v"(fr), "+v"(fq));
        const int row0 = u.pm * BM + wr * 64 + fr; const int col0 = u.pn * BM + wc * 32 + 8 * fq;
#pragma unroll
        for (int ai = 0; ai < 2; ++ai)
#pragma unroll
            for (int m = 0; m < 4; ++m) { const size_t row = (size_t)(row0 + ai * HALF + m * 16);
#pragma unroll
                for (int bj = 0; bj < 2; ++bj) {
                    const u32x4 gr = *(const u32x4*)(gate + row * 2048 + col0 + bj * HALF), gm = *(const u32x4*)(gate + row * 2048 + 1024 + col0 + bj * HALF);
                    const unsigned grw[4] = {gr.x, gr.y, gr.z, gr.w}, gmw[4] = {gm.x, gm.y, gm.z, gm.w};
#pragma unroll
                    for (int q = 0; q < 4; ++q) { const float r0 = bflo(grw[q]) * __builtin_amdgcn_rcpf(fmaxf(bflo(gmw[q]), 1e-30f)), r1 = bfhi(grw[q]) * __builtin_amdgcn_rcpf(fmaxf(bfhi(gmw[q]), 1e-30f));
                        acc[ai][bj][m][q >> 1][2 * (q & 1)] *= r0; acc[ai][bj][m][q >> 1][2 * (q & 1) + 1] *= r1; } }
                asm volatile("" ::: "memory"); }
    }
    __device__ __forceinline__ void operator()(const f32x4 (&acc)[2][2][4][2], const Unit& u, int wr, int wc, int fr, int fq) const {
        const int row0 = u.pm * BM + wr * 64 + fr; const int col0 = u.pn * BM + wc * 32 + 8 * fq;
#pragma unroll
        for (int ai = 0; ai < 2; ++ai)
#pragma unroll
            for (int m = 0; m < 4; ++m) { const size_t row = (size_t)(row0 + ai * HALF + m * 16);
#pragma unroll
                for (int bj = 0; bj < 2; ++bj) {
                    const u32x4 gm = *(const u32x4*)(gate + row * 2048 + 1024 + col0 + bj * HALF);
                    f32x4 v0 = acc[ai][bj][m][0], v1 = acc[ai][bj][m][1];
                    v0[0] *= fmaxf(bflo(gm.x), 1e-30f); v0[1] *= fmaxf(bfhi(gm.x), 1e-30f); v0[2] *= fmaxf(bflo(gm.y), 1e-30f); v0[3] *= fmaxf(bfhi(gm.y), 1e-30f);
                    v1[0] *= fmaxf(bflo(gm.z), 1e-30f); v1[1] *= fmaxf(bfhi(gm.z), 1e-30f); v1[2] *= fmaxf(bflo(gm.w), 1e-30f); v1[3] *= fmaxf(bfhi(gm.w), 1e-30f);
                    u32x4 w; w.x = pk2(v0[0], v0[1]); w.y = pk2(v0[2], v0[3]); w.z = pk2(v1[0], v1[1]); w.w = pk2(v1[2], v1[3]);
                    *(u32x4*)(Hout + row * 1024 + col0 + bj * HALF) = w; } }
    }
};
struct EpiResid {
    static constexpr bool PERM = false, HAS_MID = false;
    const float* xin; float* out;
    __device__ __forceinline__ void operator()(const f32x4 (&acc)[2][2][4][2], const Unit& u, int wr, int wc, int fr, int fq) const {
        const int row0 = u.pm * BM + wr * 64 + fr, col0 = u.pn * BM + wc * 32 + 4 * fq;
#pragma unroll
        for (int ai = 0; ai < 2; ++ai)
#pragma unroll
            for (int m = 0; m < 4; ++m) { const size_t off = (size_t)(row0 + ai * HALF + m * 16) * 1024 + col0;
#pragma unroll
                for (int bj = 0; bj < 2; ++bj)
#pragma unroll
                    for (int n = 0; n < 2; ++n) { const f32x4 xv = *(const f32x4*)(xin + off + bj * HALF + n * 16); *(f32x4*)(out + off + bj * HALF + n * 16) = xv + acc[ai][bj][m][n]; } }
    }
};
struct EpiExpertUp {
    static constexpr bool PERM = true, HAS_MID = false;
    bf16_t* HM; const float* gw;
    __device__ __forceinline__ void operator()(const f32x4 (&acc)[2][2][4][2], const Unit& u, int wr, int wc, int fr, int fq) const {
        const int row0 = u.pm * BM + wr * 64 + fr; const int col0 = u.pn * 128 + wc * 32 + 8 * fq;
#pragma unroll
        for (int ai = 0; ai < 2; ++ai)
#pragma unroll
            for (int m = 0; m < 4; ++m) { const size_t row = (size_t)(row0 + ai * HALF + m * 16); const float gwt = gw[row];
                f32x4 v0, v1;
#pragma unroll
                for (int j = 0; j < 4; ++j) { const float g0 = acc[ai][0][m][0][j], g1 = acc[ai][0][m][1][j];
                    v0[j] = g0 * sigmoidf_(g0) * acc[ai][1][m][0][j] * gwt; v1[j] = g1 * sigmoidf_(g1) * acc[ai][1][m][1][j] * gwt; }
                u32x4 w; w.x = pk2(v0[0], v0[1]); w.y = pk2(v0[2], v0[3]); w.z = pk2(v1[0], v1[1]); w.w = pk2(v1[2], v1[3]);
                *(u32x4*)(HM + row * 512 + col0) = w; }
    }
};
}
constexpr size_t SI_PLANE = (size_t)T * CW * 2;
DI float softplusf_(float z) { return fmaxf(z, 0.f) + __logf(1.0f + __expf(-fabsf(z))); }

DI void phase_rwkv_prep(Frame& F, int l) {
    LAS float* act = (LAS float*)F.lds;
    const bf16_t* RW = (const bf16_t*)(F.wsp() + WS_RW); const bf16_t* LO = (const bf16_t*)(F.wsp() + WS_LO);
    bf16_t* SIr = (bf16_t*)(F.wsp() + WS_SI); bf16_t* SIw = SIr + (size_t)T * CW; bf16_t* SIk = SIw + (size_t)T * CW; bf16_t* SIa = SIk + (size_t)T * CW; bf16_t* SIb = SIa + (size_t)T * CW;
    bf16_t* VF = (bf16_t*)(F.wsp() + WS_VF); bf16_t* V1 = (bf16_t*)(F.wsp() + WS_V1); bf16_t* Gb = (bf16_t*)(F.wsp() + WS_G);
    int c = F.tid;
    const float* w2 = F.inp(8) + (size_t)l * 64 * CW; const float* a2 = F.inp(11) + (size_t)l * 64 * CW; const float* g2 = F.inp(13) + (size_t)l * 128 * CW;
    const float* v2 = F.inp(22);
    const float mu_r = F.inp(4)[(size_t)l * 3 * CW + c], mu_k = F.inp(4)[(size_t)l * 3 * CW + CW + c], mu_v = F.inp(4)[(size_t)l * 3 * CW + 2 * CW + c];
    const float w0c = F.inp(6)[l * CW + c], a0c = F.inp(9)[l * CW + c], kkc = F.inp(14)[l * CW + c], kac = F.inp(15)[l * CW + c];
    const float v0c = l > 0 ? F.inp(20)[c] : 0.f;
    for (int tile = F.bid; tile < T / 8; tile += F.G) {
        int t0 = tile * 8; asm volatile("" : "+s"(t0), "+v"(c));
        __syncthreads();
        for (int idx = F.tid; idx < 8 * 288; idx += 512) {
            const int tt = idx / 288, j = idx - tt * 288; const int t = t0 + tt; const bool has_prev = (t % SEQ) != 0;
            int pj, qj;
            if (j < 64) { pj = j; qj = 64 + j; } else if (j < 128) { pj = 128 + (j - 64); qj = 192 + (j - 64); } else if (j < 256) { pj = 256 + (j - 128); qj = 384 + (j - 128); } else { pj = 512 + (j - 256); qj = 544 + (j - 256); }
            float v = bf2f(LO[(size_t)t * LO_W + pj]); if (has_prev) v += bf2f(LO[(size_t)(t - 1) * LO_W + qj]);
            if (j < 64) v = tanhf(v); else if (j >= 128 && j < 256) v = sigmoidf_(v);
            act[j * 8 + tt] = v;
        }
        __syncthreads();
        float aw[8], aa[8], ag[8], av[8];
#pragma unroll
        for (int i = 0; i < 8; ++i) { aw[i] = 0.f; aa[i] = 0.f; ag[i] = 0.f; av[i] = 0.f; }
        for (int j = 0; j < 64; ++j) { const float w = w2[j * CW + c]; const LAS f32x4* ap = (const LAS f32x4*)(act + j * 8);
#pragma unroll
            for (int q = 0; q < 2; ++q) { const f32x4 x = ap[q]; aw[4 * q] += x.x * w; aw[4 * q + 1] += x.y * w; aw[4 * q + 2] += x.z * w; aw[4 * q + 3] += x.w * w; } }
        for (int j = 0; j < 64; ++j) { const float w = a2[j * CW + c]; const LAS f32x4* ap = (const LAS f32x4*)(act + (64 + j) * 8);
#pragma unroll
            for (int q = 0; q < 2; ++q) { const f32x4 x = ap[q]; aa[4 * q] += x.x * w; aa[4 * q + 1] += x.y * w; aa[4 * q + 2] += x.z * w; aa[4 * q + 3] += x.w * w; } }
        for (int j = 0; j < 128; ++j) { const float w = g2[j * CW + c]; const LAS f32x4* ap = (const LAS f32x4*)(act + (128 + j) * 8);
#pragma unroll
            for (int q = 0; q < 2; ++q) { const f32x4 x = ap[q]; ag[4 * q] += x.x * w; ag[4 * q + 1] += x.y * w; ag[4 * q + 2] += x.z * w; ag[4 * q + 3] += x.w * w; } }
        if (l > 0) for (int j = 0; j < 32; ++j) { const float w = v2[j * CW + c]; const LAS f32x4* ap = (const LAS f32x4*)(act + (256 + j) * 8);
#pragma unroll
            for (int q = 0; q < 2; ++q) { const f32x4 x = ap[q]; av[4 * q] += x.x * w; av[4 * q + 1] += x.y * w; av[4 * q + 2] += x.z * w; av[4 * q + 3] += x.w * w; } }
#pragma unroll
        for (int tt = 0; tt < 8; ++tt) {
            const int t = t0 + tt; const bool has_prev = (t % SEQ) != 0; const size_t ro = (size_t)t * 1536;
            const float rp = bf2f(RW[ro + c]), kp = bf2f(RW[ro + 512 + c]), vp = bf2f(RW[ro + 1024 + c]);
            float rq = 0.f, kq = 0.f, vq = 0.f;
            if (has_prev) { rq = bf2f(RW[ro - 1536 + c]); kq = bf2f(RW[ro - 1536 + 512 + c]); vq = bf2f(RW[ro - 1536 + 1024 + c]); }
            const float r = rp + (rq - rp) * mu_r, k = kp + (kq - kp) * mu_k; float v = vp + (vq - vp) * mu_v;
            const float wl = -softplusf_(-(w0c + aw[tt])) - 0.5f;
            const float lw = -__expf(wl);
            const float alr = sigmoidf_(a0c + aa[tt]);
            const size_t o = (size_t)t * CW + c;
            if (l > 0) { const float vf = bf2f(VF[o]); v = v + (vf - v) * sigmoidf_(v0c + av[tt]); V1[o] = f2bf(v); } else { VF[o] = f2bf(v); }
            float kk = k * kkc; const float nrm = sqrtf(wave_sum(kk * kk)); kk = kk / fmaxf(nrm, 1e-12f);
            const float k2 = k * (1.f + (alr - 1.f) * kac);
            SIr[o] = f2bf(r); SIw[o] = f2bf(lw); SIk[o] = f2bf(k2); SIa[o] = f2bf(kk); SIb[o] = f2bf(kk * alr); Gb[o] = f2bf(ag[tt]);
            asm volatile("" ::: "memory");
        }
    }
}

DI void phase_rwkv_scan_naive(Frame& F, int l) {
    LAS float* Lr = (LAS float*)F.lds; LAS float* Lw = Lr + 4096; LAS float* Lk = Lw + 4096; LAS float* La = Lk + 4096; LAS float* Lb = La + 4096;
    LAS float* Lv = Lb + 4096; LAS float* Ly = Lv + 512;
    const bf16_t* SIr = (const bf16_t*)(F.wsp() + WS_SI); const bf16_t* SIw = SIr + (size_t)T * CW; const bf16_t* SIk = SIw + (size_t)T * CW; const bf16_t* SIa = SIk + (size_t)T * CW; const bf16_t* SIb = SIa + (size_t)T * CW;
    const bf16_t* V = (const bf16_t*)(F.wsp() + (l > 0 ? WS_V1 : WS_VF)); float* YS = (float*)(F.wsp() + WS_YS);
    for (int u = F.bid; u < 256; u += F.G) {
        const int b = u >> 6, h = (u >> 3) & 7, rg = u & 7;
        float S = 0.f;
        for (int ch = 0; ch < SEQ / 64; ++ch) {
            const size_t tb = (size_t)b * SEQ + ch * 64;
            __syncthreads();
            for (int idx = F.tid; idx < 4096; idx += 512) { const int s = idx >> 6, kx = idx & 63; const size_t o = (tb + s) * CW + h * 64 + kx;
                Lr[idx] = bf2f(SIr[o]); Lw[idx] = __expf(bf2f(SIw[o])); Lk[idx] = bf2f(SIk[o]); La[idx] = -bf2f(SIa[o]); Lb[idx] = bf2f(SIb[o]); }
            { const int s = F.tid >> 3, rr = F.tid & 7; Lv[F.tid] = bf2f(V[(tb + s) * CW + h * 64 + rg * 8 + rr]); }
            __syncthreads();
#pragma unroll 4
            for (int s = 0; s < 64; ++s) {
                const float a = La[s * 64 + F.lane], w = Lw[s * 64 + F.lane], bb = Lb[s * 64 + F.lane], kk = Lk[s * 64 + F.lane], r = Lr[s * 64 + F.lane], v = Lv[s * 8 + F.wave];
                const float sa = wave_sum(S * a);
                S = S * w + sa * bb + v * kk;
                const float y = wave_sum(S * r);
                if (F.lane == 0) Ly[s * 8 + F.wave] = y;
            }
            __syncthreads();
            { const int s = F.tid >> 3, rr = F.tid & 7; YS[(tb + s) * CW + h * 64 + rg * 8 + rr] = Ly[F.tid]; }
        }
    }
}

DI void phase_rwkv_post(Frame& F, int l) {
    const float* YS = (const float*)(F.wsp() + WS_YS);
    const bf16_t* SIr = (const bf16_t*)(F.wsp() + WS_SI); const bf16_t* SIk = SIr + 2 * (size_t)T * CW;
    const bf16_t* V = (const bf16_t*)(F.wsp() + (l > 0 ? WS_V1 : WS_VF)); const bf16_t* Gb = (const bf16_t*)(F.wsp() + WS_G); bf16_t* YR = (bf16_t*)(F.wsp() + WS_YRM);
    const int c = F.tid; const float lg = F.inp(17)[l * CW + c], lb = F.inp(18)[l * CW + c], rk = F.inp(16)[l * CW + c];
    for (int t = F.bid; t < T; t += F.G) {
        const size_t o = (size_t)t * CW + c;
        const float y = YS[o]; const float mean = wave_sum(y) * (1.f / 64.f); const float d = y - mean; const float var = wave_sum(d * d) * (1.f / 64.f);
        const float yn = d * (1.0f / sqrtf(var + 64e-5f)) * lg + lb;
        const float r = bf2f(SIr[o]), k = bf2f(SIk[o]), v = bf2f(V[o]);
        const float bonus = wave_sum(r * k * rk) * v;
        YR[o] = f2bf((yn + bonus) * bf2f(Gb[o]));
    }
}

#ifndef PREP_DUP
#define PREP_DUP 0
#endif
constexpr int ACT_P = 592;
constexpr size_t WM_L2T = (size_t)WCAT_ROWS * 1024 * 2 + 2 * 1024 * 512 * 2 + 1024 * 1024 * 2;
DI void phase_conv_lora2(Frame& F, int l) {
    bf16_t* L2T = (bf16_t*)(F.wsp() + WS_WM + WM_L2T);
    const float* w2 = F.inp(8) + (size_t)l * 64 * CW; const float* a2 = F.inp(11) + (size_t)l * 64 * CW; const float* g2 = F.inp(13) + (size_t)l * 128 * CW; const float* v2 = F.inp(22);
    for (int idx = F.bid * 512 + F.tid; idx < 288 * CW; idx += F.G * 512) { const int j = idx >> 9, c = idx & 511;
        float v;
        if (j < 64) v = w2[j * CW + c]; else if (j < 128) v = a2[(j - 64) * CW + c]; else if (j < 256) v = g2[(j - 128) * CW + c]; else v = (l > 0) ? v2[(j - 256) * CW + c] : 0.f;
        L2T[c * 288 + j] = f2bf(v); }
}
DI float row16_sum(float v) { v += dpp_mov<0xB1>(v); v += dpp_mov<0x4E>(v); v += dpp_mov<0x141>(v); v += dpp_mov<0x140>(v); return v; }
DI void phase_rwkv_prep2(Frame& F, int l, int tile_lo, int tile_hi, int tile_step, bool init) {
    LAS unsigned char* act = F.lds;
    LAS float* PRM = (LAS float*)(F.lds + 139264);
    const bf16_t* RW = (const bf16_t*)(F.wsp() + WS_RW); const bf16_t* LO = (const bf16_t*)(F.wsp() + WS_LO); const unsigned char* L2T = F.wsp() + WS_WM + WM_L2T;
    bf16_t* SIr = (bf16_t*)(F.wsp() + WS_SI); bf16_t* SIw = SIr + (size_t)T * CW; bf16_t* SIk = SIw + (size_t)T * CW; bf16_t* SIa = SIk + (size_t)T * CW; bf16_t* SIb = SIa + (size_t)T * CW;
    bf16_t* VF = (bf16_t*)(F.wsp() + WS_VF); bf16_t* V1 = (bf16_t*)(F.wsp() + WS_V1); bf16_t* Gb = (bf16_t*)(F.wsp() + WS_G);
    const int lane = F.lane, r16 = lane & 15, g = lane >> 4;
    if (init) { __syncthreads();
      const int c = F.tid;
      PRM[c] = F.inp(4)[(size_t)l * 3 * CW + c]; PRM[512 + c] = F.inp(4)[(size_t)l * 3 * CW + CW + c]; PRM[1024 + c] = F.inp(4)[(size_t)l * 3 * CW + 2 * CW + c];
      PRM[1536 + c] = F.inp(6)[l * CW + c]; PRM[2048 + c] = F.inp(9)[l * CW + c]; PRM[2560 + c] = F.inp(14)[l * CW + c]; PRM[3072 + c] = F.inp(15)[l * CW + c]; PRM[3584 + c] = l > 0 ? F.inp(20)[c] : 0.f; }
    for (int tile = tile_lo; tile < tile_hi; tile += tile_step) {
        int t0 = tile * 64; asm volatile("" : "+s"(t0));
        __syncthreads();
        for (int dup1_ = 0; dup1_ < ((PREP_DUP & 1) ? 2 : 1); ++dup1_)
        for (int grp = F.tid; grp < 64 * 36; grp += 512) { const int tt = grp / 36, jg = grp - tt * 36, j0 = 8 * jg; const int t = t0 + tt; const bool has_prev = (t % SEQ) != 0;
            int pj, qj; if (j0 < 64) { pj = j0; qj = 64 + j0; } else if (j0 < 128) { pj = 128 + (j0 - 64); qj = 192 + (j0 - 64); } else if (j0 < 256) { pj = 256 + (j0 - 128); qj = 384 + (j0 - 128); } else { pj = 512 + (j0 - 256); qj = 544 + (j0 - 256); }
            const u32x4 pv = *(const u32x4*)(LO + (size_t)t * LO_W + pj); u32x4 qv = {0u, 0u, 0u, 0u}; if (has_prev) qv = *(const u32x4*)(LO + (size_t)(t - 1) * LO_W + qj);
            const unsigned pw[4] = {pv.x, pv.y, pv.z, pv.w}, qw[4] = {qv.x, qv.y, qv.z, qv.w}; float v[8];
#pragma unroll
            for (int q = 0; q < 4; ++q) { v[2 * q] = bflo(pw[q]) + bflo(qw[q]); v[2 * q + 1] = bfhi(pw[q]) + bfhi(qw[q]); }
            if (j0 < 64) {
#pragma unroll
                for (int e = 0; e < 8; ++e) v[e] = 1.0f - 2.0f * __builtin_amdgcn_rcpf(1.0f + __expf(2.0f * v[e]));
            } else if (j0 >= 128 && j0 < 256) {
#pragma unroll
                for (int e = 0; e < 8; ++e) v[e] = sigmoidf_(v[e]);
            }
            u32x4 w; w.x = pk2(v[0], v[1]); w.y = pk2(v[2], v[3]); w.z = pk2(v[4], v[5]); w.w = pk2(v[6], v[7]);
            *(LAS u32x4*)(act + tt * ACT_P + j0 * 2) = w; }
        __syncthreads();
        float inv[4];
        { int cw = 64 * F.wave + 4 * g; asm volatile("" : "+v"(cw));
          u32x2 kc[4][4], kp_[4][4];
#pragma unroll
          for (int tt = 0; tt < 4; ++tt) { const int t = t0 + 16 * tt + r16; const bool has_prev = (t % SEQ) != 0; const size_t ro = (size_t)t * 1536;
#pragma unroll
              for (int ct = 0; ct < 4; ++ct) { kc[tt][ct] = *(const u32x2*)(RW + ro + 512 + cw + 16 * ct); kp_[tt][ct] = (u32x2){0u, 0u}; if (has_prev) kp_[tt][ct] = *(const u32x2*)(RW + ro - 1536 + 512 + cw + 16 * ct); } }
#pragma unroll
          for (int tt = 0; tt < 4; ++tt) { float ss = 0.f;
#pragma unroll
              for (int ct = 0; ct < 4; ++ct) { const f32x4 muk = *(const LAS f32x4*)(PRM + 512 + cw + 16 * ct), kkc = *(const LAS f32x4*)(PRM + 2560 + cw + 16 * ct);
                  const float k0 = bflo(kc[tt][ct].x), k1 = bfhi(kc[tt][ct].x), k2 = bflo(kc[tt][ct].y), k3 = bfhi(kc[tt][ct].y), q0 = bflo(kp_[tt][ct].x), q1 = bfhi(kp_[tt][ct].x), q2 = bflo(kp_[tt][ct].y), q3 = bfhi(kp_[tt][ct].y);
                  const float a0 = (k0 + (q0 - k0) * muk[0]) * kkc[0], a1 = (k1 + (q1 - k1) * muk[1]) * kkc[1], a2 = (k2 + (q2 - k2) * muk[2]) * kkc[2], a3 = (k3 + (q3 - k3) * muk[3]) * kkc[3];
                  ss += (a0 * a0 + a1 * a1) + (a2 * a2 + a3 * a3); }
              ss += __shfl_xor(ss, 16); ss += __shfl_xor(ss, 32);
              inv[tt] = __builtin_amdgcn_rsqf(fmaxf(ss, 1e-24f)); } }
#pragma unroll 1
        for (int ct = 0; ct < 4; ++ct) {
            int cw = 64 * F.wave + 4 * g; asm volatile("" : "+v"(cw));
            const int c0 = cw + 16 * ct;
            bf16x8 wf[9];
            { const unsigned char* wrow = L2T + (size_t)(64 * F.wave + 16 * ct + r16) * 576 + 16 * g;
#pragma unroll
              for (int s = 0; s < 9; ++s) wf[s] = *(const bf16x8*)(wrow + 64 * s); }
            u32x2 cur[4][3], prv[4][3], vfl[4];
#pragma unroll
            for (int tt = 0; tt < 4; ++tt) { const int t = t0 + 16 * tt + r16; const bool has_prev = (t % SEQ) != 0; const size_t ro = (size_t)t * 1536;
#pragma unroll
                for (int p = 0; p < 3; ++p) { cur[tt][p] = *(const u32x2*)(RW + ro + 512 * p + c0); prv[tt][p] = (u32x2){0u, 0u}; if (has_prev) prv[tt][p] = *(const u32x2*)(RW + ro - 1536 + 512 * p + c0); }
                vfl[tt] = (u32x2){0u, 0u}; if (l > 0) vfl[tt] = *(const u32x2*)(VF + (size_t)t * CW + c0); }
            const f32x4 mur = *(const LAS f32x4*)(PRM + c0), muk = *(const LAS f32x4*)(PRM + 512 + c0), muv = *(const LAS f32x4*)(PRM + 1024 + c0), w0v = *(const LAS f32x4*)(PRM + 1536 + c0),
                        a0v = *(const LAS f32x4*)(PRM + 2048 + c0), kkc = *(const LAS f32x4*)(PRM + 2560 + c0), kac = *(const LAS f32x4*)(PRM + 3072 + c0), v0v = *(const LAS f32x4*)(PRM + 3584 + c0);
#pragma unroll
            for (int tt = 0; tt < 4; ++tt) {
                const int t = t0 + 16 * tt + r16; const size_t oo = (size_t)t * CW;
                bf16x8 a[9];
#pragma unroll
                for (int s = 0; s < 9; ++s) a[s] = *(const LAS bf16x8*)(act + (16 * tt + r16) * ACT_P + (32 * s + 8 * g) * 2);
                f32x4 aw = {0.f, 0.f, 0.f, 0.f}, aa = {0.f, 0.f, 0.f, 0.f}, ag = {0.f, 0.f, 0.f, 0.f}, av = {0.f, 0.f, 0.f, 0.f};
                aw = mfma16(wf[0], a[0], aw); aw = mfma16(wf[1], a[1], aw);
                aa = mfma16(wf[2], a[2], aa); aa = mfma16(wf[3], a[3], aa);
                ag = mfma16(wf[4], a[4], ag); ag = mfma16(wf[5], a[5], ag); ag = mfma16(wf[6], a[6], ag); ag = mfma16(wf[7], a[7], ag);
                if (l > 0) av = mfma16(wf[8], a[8], av);
                float ro4[4], lw4[4], vo4[4], k2[4], ka[4], kb[4];
#pragma unroll
                for (int r = 0; r < 4; ++r) {
                    const unsigned cwd_r = (r < 2) ? cur[tt][0].x : cur[tt][0].y, cwd_k = (r < 2) ? cur[tt][1].x : cur[tt][1].y, cwd_v = (r < 2) ? cur[tt][2].x : cur[tt][2].y;
                    const unsigned pwd_r = (r < 2) ? prv[tt][0].x : prv[tt][0].y, pwd_k = (r < 2) ? prv[tt][1].x : prv[tt][1].y, pwd_v = (r < 2) ? prv[tt][2].x : prv[tt][2].y;
                    const unsigned vwd = (r < 2) ? vfl[tt].x : vfl[tt].y;
                    const float rp = (r & 1) ? bfhi(cwd_r) : bflo(cwd_r), kp = (r & 1) ? bfhi(cwd_k) : bflo(cwd_k), vp = (r & 1) ? bfhi(cwd_v) : bflo(cwd_v);
                    const float rq = (r & 1) ? bfhi(pwd_r) : bflo(pwd_r), kq_ = (r & 1) ? bfhi(pwd_k) : bflo(pwd_k), vq = (r & 1) ? bfhi(pwd_v) : bflo(pwd_v);
                    const float rr = rp + (rq - rp) * mur[r], k = kp + (kq_ - kp) * muk[r]; float v = vp + (vq - vp) * muv[r];
                    const float wl = -softplusf_(-(w0v[r] + aw[r])) - 0.5f; lw4[r] = -__expf(wl);
                    const float alr = sigmoidf_(a0v[r] + aa[r]);
                    if (l > 0) { const float vf = (r & 1) ? bfhi(vwd) : bflo(vwd); v = v + (vf - v) * sigmoidf_(v0v[r] + av[r]); }
                    const float kk = k * kkc[r] * inv[tt];
                    ro4[r] = rr; vo4[r] = v; k2[r] = k * (1.f + (alr - 1.f) * kac[r]); ka[r] = kk; kb[r] = kk * alr; }
                u32x2 w;
                w.x = pk2(ro4[0], ro4[1]); w.y = pk2(ro4[2], ro4[3]); *(u32x2*)(SIr + oo + c0) = w;
                w.x = pk2(lw4[0], lw4[1]); w.y = pk2(lw4[2], lw4[3]); *(u32x2*)(SIw + oo + c0) = w;
                w.x = pk2(ag[0], ag[1]); w.y = pk2(ag[2], ag[3]); *(u32x2*)(Gb + oo + c0) = w;
                w.x = pk2(vo4[0], vo4[1]); w.y = pk2(vo4[2], vo4[3]); *(u32x2*)((l > 0 ? V1 : VF) + oo + c0) = w;
                w.x = pk2(k2[0], k2[1]); w.y = pk2(k2[2], k2[3]); *(u32x2*)(SIk + oo + c0) = w;
                w.x = pk2(ka[0], ka[1]); w.y = pk2(ka[2], ka[3]); *(u32x2*)(SIa + oo + c0) = w;
                w.x = pk2(kb[0], kb[1]); w.y = pk2(kb[2], kb[3]); *(u32x2*)(SIb + oo + c0) = w;
            }
        }
    }
}
constexpr int NUNIT = NB * NH * (SEQ / 64);
constexpr size_t U_PMP = 0, U_RPP = 8192, U1_BYTES = 16384;
constexpr size_t U_QMT = 0, U_YLT = 16384, U2_BYTES = 32768;
DI int permk(int k) { return (k & 32) | (((k >> 2) & 3) << 3) | (((k >> 4) & 1) << 2) | (k & 3); }
constexpr int MP = 144;
constexpr int SP = 80;
DI f32x4 mm_tile(const LAS unsigned char* xb, int px, int m0, const LAS unsigned char* yb, int py, int n0, int ks, f32x4 acc, int lane) {
    const int r16 = lane & 15, g = lane >> 4;
    for (int s = 0; s < ks; ++s) {
        const bf16x8 a = *(const LAS bf16x8*)(xb + (m0 + r16) * px + (32 * s + 8 * g) * 2);
        const bf16x8 b = *(const LAS bf16x8*)(yb + (n0 + r16) * py + (32 * s + 8 * g) * 2);
        acc = mfma16(a, b, acc);
    }
    return acc;
}
DI u32x2 pk4(f32x4 v) { u32x2 w; w.x = pk2(v[0], v[1]); w.y = pk2(v[2], v[3]); return w; }

#ifndef SA_DUP
#define SA_DUP 0
#endif
#define SA_REP(bit) for (int sd_ = 0; sd_ < ((SA_DUP & (bit)) ? 2 : 1); ++sd_)
DI void phase_scan_a(Frame& F, int l, int u_lo, int u_hi, int u_step) {
    LAS unsigned char* const L = F.lds;
#define MB(n) (L + (n) * 9216)
    LAS float* const Gf = (LAS float*)(L + 110592);
    LAS float* const SEG = (LAS float*)(L + 110592 + 16384);
    LAS float* const GL = SEG + 512;
    LAS unsigned char* const A21 = L + 110592 + 16384 + 2048 + 256;
    LAS unsigned char* const T11T = A21 + 2560;
    LAS unsigned char* const ZT = T11T + 2560;
    const bf16_t* SIr = (const bf16_t*)(F.wsp() + WS_SI); const bf16_t* SIw = SIr + (size_t)T * CW; const bf16_t* SIk = SIw + (size_t)T * CW; const bf16_t* SIa = SIk + (size_t)T * CW; const bf16_t* SIb = SIa + (size_t)T * CW;
    const bf16_t* V = (const bf16_t*)(F.wsp() + (l > 0 ? WS_V1 : WS_VF));
    const int lane = F.lane, wave = F.wave, r16 = lane & 15, g = lane >> 4;
    float plw[8]; u32x4 prv, pkv, pav, pbv, pvv;
#define SCANA_LOAD(uu) do { const int bh_ = (uu) & 31, c_ = (uu) >> 5, b_ = bh_ >> 3, h_ = bh_ & 7; const size_t t0_ = (size_t)b_ * SEQ + c_ * 64; \
        { const int k_ = F.tid & 63, seg_ = F.tid >> 6; _Pragma("unroll") for (int e = 0; e < 8; ++e) plw[e] = bf2f(SIw[(t0_ + 8 * seg_ + e) * CW + h_ * 64 + k_]); } \
        { const int i_ = F.tid >> 3, k0_ = (F.tid & 7) * 8; const size_t go_ = (t0_ + i_) * CW + h_ * 64 + k0_; \
          prv = *(const u32x4*)(SIr + go_); pkv = *(const u32x4*)(SIk + go_); pav = *(const u32x4*)(SIa + go_); pbv = *(const u32x4*)(SIb + go_); pvv = *(const u32x4*)(V + go_); } } while (0)
    if (u_lo < u_hi) SCANA_LOAD(u_lo);
    for (int u = u_lo; u < u_hi; u += u_step) {
        const int bh = u & 31, c = u >> 5, b = bh >> 3, h = bh & 7;
        const size_t t0 = (size_t)b * SEQ + c * 64; (void)t0; (void)b; (void)h;
        unsigned char* const rec1 = F.wsp() + WS_SC1 + (size_t)((bh * 128) + c) * U1_BYTES; unsigned char* const rec2 = F.wsp() + WS_SC2 + (size_t)((bh * 128) + c) * U2_BYTES;
        __syncthreads();
        SA_REP(1) {
        { const int k = F.tid & 63, seg = F.tid >> 6; float p[8]; float run = 0.f;
#pragma unroll
          for (int e = 0; e < 8; ++e) { run += plw[e]; p[e] = run; }
          SEG[seg * 64 + k] = run;
          __syncthreads();
          float off = 0.f;
#pragma unroll
          for (int s = 0; s < 8; ++s) off += (s < seg) ? SEG[s * 64 + k] : 0.f;
#pragma unroll
          for (int e = 0; e < 8; ++e) Gf[(8 * seg + e) * 64 + k] = off + p[e];
        }
        __syncthreads();
        { const int i = F.tid >> 3, k0 = (F.tid & 7) * 8;
          const u32x4 rv = prv, kv = pkv, av = pav, bv = pbv, vv = pvv;
          float fr[8], fk[8], fa[8], fb[8], fv[8];
          const unsigned rw[4] = {rv.x, rv.y, rv.z, rv.w}, kw[4] = {kv.x, kv.y, kv.z, kv.w}, aw[4] = {av.x, av.y, av.z, av.w}, bw[4] = {bv.x, bv.y, bv.z, bv.w}, vw[4] = {vv.x, vv.y, vv.z, vv.w};
#pragma unroll
          for (int q = 0; q < 4; ++q) { fr[2 * q] = bflo(rw[q]); fr[2 * q + 1] = bfhi(rw[q]); fk[2 * q] = bflo(kw[q]); fk[2 * q + 1] = bfhi(kw[q]); fa[2 * q] = bflo(aw[q]); fa[2 * q + 1] = bfhi(aw[q]);
              fb[2 * q] = bflo(bw[q]); fb[2 * q + 1] = bfhi(bw[q]); fv[2 * q] = bflo(vw[q]); fv[2 * q + 1] = bfhi(vw[q]); }
          float at[8], rt[8], bt[8], kt[8], bh8[8], kh8[8];
#pragma unroll
          for (int e = 0; e < 8; ++e) { const float gi = Gf[i * 64 + k0 + e], gp = (i > 0) ? Gf[(i - 1) * 64 + k0 + e] : 0.f, gl = Gf[63 * 64 + k0 + e];
              const float e1 = __expf(gp), e2 = __expf(gi), e3 = __expf(-gi), e4 = __expf(gl - gi);
              at[e] = -fa[e] * e1; rt[e] = fr[e] * e2; bt[e] = fb[e] * e3; kt[e] = fk[e] * e3; bh8[e] = fb[e] * e4; kh8[e] = fk[e] * e4;
              if (i == 63) GL[k0 + e] = e2; }
          u32x4 w;
          w.x = pk2(at[0], at[1]); w.y = pk2(at[2], at[3]); w.z = pk2(at[4], at[5]); w.w = pk2(at[6], at[7]); *(LAS u32x4*)(MB(0) + i * MP + k0 * 2) = w;
          w.x = pk2(rt[0], rt[1]); w.y = pk2(rt[2], rt[3]); w.z = pk2(rt[4], rt[5]); w.w = pk2(rt[6], rt[7]); *(LAS u32x4*)(MB(1) + i * MP + k0 * 2) = w;
          w.x = pk2(bt[0], bt[1]); w.y = pk2(bt[2], bt[3]); w.z = pk2(bt[4], bt[5]); w.w = pk2(bt[6], bt[7]); *(LAS u32x4*)(MB(2) + i * MP + k0 * 2) = w;
          w.x = pk2(kt[0], kt[1]); w.y = pk2(kt[2], kt[3]); w.z = pk2(kt[4], kt[5]); w.w = pk2(kt[6], kt[7]); *(LAS u32x4*)(MB(3) + i * MP + k0 * 2) = w;
#pragma unroll
          for (int e = 0; e < 8; ++e) { const int ro = (k0 + e) * MP + i * 2;
              *(LAS bf16_t*)(MB(4) + ro) = f2bf(at[e]); *(LAS bf16_t*)(MB(5) + ro) = f2bf(fv[e]); *(LAS bf16_t*)(MB(6) + ro) = f2bf(bh8[e]); *(LAS bf16_t*)(MB(7) + ro) = f2bf(kh8[e]); }
        }
        __syncthreads(); }
        if (u + u_step < u_hi) SCANA_LOAD(u + u_step);
        __syncthreads();
        SA_REP(2) {
        { const int prod = wave >> 1;
          const LAS unsigned char* xb = (prod & 1) ? MB(3) : MB(2); const LAS unsigned char* yb = (prod < 2) ? MB(0) : MB(1);
          LAS unsigned char* ob = (prod == 1) ? MB(8) : (prod == 2) ? MB(9) : MB(10);
          float zf = 0.f; asm volatile("" : "+v"(zf));
          for (int q = 0; q < 8; ++q) { const int tt = (wave & 1) * 8 + q, tm = tt >> 2, tn = tt & 3;
              f32x4 acc = {zf, zf, zf, zf};
              if (tm <= tn) acc = mm_tile(xb, MP, 16 * tm, yb, MP, 16 * tn, 2, acc, lane);
              const int i = 16 * tn + r16, j0 = 16 * tm + 4 * g;
#pragma unroll
              for (int r = 0; r < 4; ++r) { const int j = j0 + r; const bool keep = (prod < 2) ? (j < i) : (j <= i); if (!keep) acc[r] = 0.f; }
              if (prod == 0) {
                  if ((i >> 5) == (j0 >> 5)) *(LAS f32x4*)(Gf + ((i >> 5) * 32 + (i & 31)) * 32 + (j0 & 31)) = acc;
                  if (i >= 32 && j0 < 32) *(LAS u32x2*)(A21 + (i - 32) * SP + j0 * 2) = pk4(acc);
              } else *(LAS u32x2*)(ob + i * MP + j0 * 2) = pk4(acc);
          } }
        __syncthreads();
        }
        f32x4 pyl[2] = {{0.f, 0.f, 0.f, 0.f}, {0.f, 0.f, 0.f, 0.f}}, pqm[2] = {{0.f, 0.f, 0.f, 0.f}, {0.f, 0.f, 0.f, 0.f}};
        SA_REP(4) {
        if (wave == 0) {
            const int blk = lane >> 5, cc = lane & 31; const LAS float* AD = Gf + blk * 1024;
            float Tc[32];
#pragma unroll
            for (int i = 0; i < 32; ++i) { float a0 = (i == cc) ? 1.f : 0.f, a1 = 0.f, a2 = 0.f, a3 = 0.f;
#pragma unroll
                for (int q = 0; q < (i + 3) / 4; ++q) { const f32x4 a = *(const LAS f32x4*)(AD + i * 32 + 4 * q);
                    if (4 * q + 0 < i) a0 += a[0] * Tc[4 * q + 0]; if (4 * q + 1 < i) a1 += a[1] * Tc[4 * q + 1]; if (4 * q + 2 < i) a2 += a[2] * Tc[4 * q + 2]; if (4 * q + 3 < i) a3 += a[3] * Tc[4 * q + 3]; }
                Tc[i] = (a0 + a1) + (a2 + a3); }
#pragma unroll
            for (int i = 0; i < 32; ++i) *(LAS bf16_t*)(MB(11) + (32 * blk + i) * MP + (32 * blk + cc) * 2) = f2bf(Tc[i]);
            if (blk == 0) {
#pragma unroll
                for (int q = 0; q < 4; ++q) { u32x4 w; w.x = pk2(Tc[8 * q], Tc[8 * q + 1]); w.y = pk2(Tc[8 * q + 2], Tc[8 * q + 3]); w.z = pk2(Tc[8 * q + 4], Tc[8 * q + 5]); w.w = pk2(Tc[8 * q + 6], Tc[8 * q + 7]);
                    *(LAS u32x4*)(T11T + cc * SP + q * 16) = w; }
            } else {
                unsigned z = 0u; asm volatile("" : "+v"(z));
#pragma unroll
                for (int q = 0; q < 4; ++q) *(LAS u32x4*)(MB(11) + cc * MP + 64 + q * 16) = (u32x4){z, z, z, z};
            }
        } else {
            for (int tt = wave - 1; tt < 16; tt += 7) { const int tm = tt >> 2, tn = tt & 3;
                f32x4 acc = {0.f, 0.f, 0.f, 0.f};
                acc = mm_tile(MB(8), MP, 16 * tm, MB(5), MP, 16 * tn, 2, acc, lane);
                *(LAS u32x2*)(MB(2) + (16 * tn + r16) * MP + (16 * tm + 4 * g) * 2) = pk4(acc); }
            if (sd_ == 0) {
#pragma unroll
                for (int q = 0; q < 2; ++q) { const int tt = wave * 2 + q, tm = tt >> 2, tn = tt & 3; const f32x4 z = {0.f, 0.f, 0.f, 0.f};
                    pyl[q] = mm_tile(MB(5), MP, 16 * tm, MB(10), MP, 16 * tn, 2, z, lane);
                    pqm[q] = mm_tile(MB(7), MP, 16 * tm, MB(5), MP, 16 * tn, 2, z, lane); } }
        }
        __syncthreads();
        if (wave < 4) { const int tm = wave >> 1, tn = wave & 1; f32x4 acc = {0.f, 0.f, 0.f, 0.f};
            acc = mm_tile(A21, SP, 16 * tm, T11T, SP, 16 * tn, 1, acc, lane);
            *(LAS u32x2*)(ZT + (16 * tn + r16) * SP + (16 * tm + 4 * g) * 2) = pk4(acc); }
        __syncthreads();
        if (wave < 4) { const int tm = wave >> 1, tn = wave & 1; f32x4 acc = {0.f, 0.f, 0.f, 0.f};
            acc = mm_tile(ZT, SP, 16 * tm, MB(11) + 32 * MP + 64, MP, 16 * tn, 1, acc, lane);
            *(LAS u32x2*)(MB(11) + (32 + 16 * tn + r16) * MP + (16 * tm + 4 * g) * 2) = pk4(acc); }
        __syncthreads();
        }
        SA_REP(8) {
        { const LAS unsigned char* yb = (wave < 4) ? MB(4) : MB(2); LAS unsigned char* ob = (wave < 4) ? MB(3) : MB(0);
          for (int q = 0; q < 4; ++q) { const int tt = (wave & 3) * 4 + q, tm = tt >> 2, tn = tt & 3;
              f32x4 acc = {0.f, 0.f, 0.f, 0.f};
              acc = mm_tile(MB(11), MP, 16 * tm, yb, MP, 16 * tn, 2, acc, lane);
              *(LAS u32x2*)(ob + (16 * tn + r16) * MP + (16 * tm + 4 * g) * 2) = pk4(acc); } }
        __syncthreads();
        }
        SA_REP(16) {
#pragma unroll
        for (int q = 0; q < 2; ++q) { const int tt = wave * 2 + q, tm = tt >> 2, tn = tt & 3;
            { f32x4 acc = {0.f, 0.f, 0.f, 0.f}; acc = mm_tile(MB(3), MP, 16 * tm, MB(9), MP, 16 * tn, 2, acc, lane);
              const int i = 16 * tn + r16, k0 = 16 * tm + 4 * g; const u32x2 rr = *(const LAS u32x2*)(MB(1) + i * MP + k0 * 2);
              acc[0] += bflo(rr.x); acc[1] += bfhi(rr.x); acc[2] += bflo(rr.y); acc[3] += bfhi(rr.y);
              *(u32x2*)(rec1 + U_RPP + (size_t)(i * 64 + permk(k0)) * 2) = pk4(acc); }
            { f32x4 acc = {0.f, 0.f, 0.f, 0.f}; acc = mm_tile(MB(3), MP, 16 * tm, MB(6), MP, 16 * tn, 2, acc, lane);
              const int kp = 16 * tn + r16, k0 = 16 * tm + 4 * g;
#pragma unroll
              for (int r = 0; r < 4; ++r) if (k0 + r == kp) acc[r] += GL[kp];
              *(u32x2*)(rec1 + U_PMP + (size_t)(kp * 64 + permk(k0)) * 2) = pk4(acc); }
            { f32x4 acc = pyl[q]; acc = mm_tile(MB(0), MP, 16 * tm, MB(9), MP, 16 * tn, 2, acc, lane); if (wave == 0) acc = mm_tile(MB(5), MP, 16 * tm, MB(10), MP, 16 * tn, 2, acc, lane);
              *(f32x4*)(rec2 + U_YLT + (size_t)((16 * tn + r16) * 64 + 16 * tm + 4 * g) * 4) = acc; }
            { f32x4 acc = pqm[q]; acc = mm_tile(MB(6), MP, 16 * tm, MB(0), MP, 16 * tn, 2, acc, lane); if (wave == 0) acc = mm_tile(MB(7), MP, 16 * tm, MB(5), MP, 16 * tn, 2, acc, lane);
              *(f32x4*)(rec2 + U_QMT + (size_t)((16 * tn + r16) * 64 + 16 * tm + 4 * g) * 4) = acc; }
        }
        __syncthreads(); }
    }
#undef MB
#undef SCANA_LOAD
}

constexpr int SB_D = 5, SB_SLOT = 24576;
DI void scanb_issue(LAS unsigned char* lds, const unsigned char* r1b, const unsigned char* r2b, int cidx, int lw, int lane) {
    const unsigned char* rec1 = r1b + (size_t)cidx * U1_BYTES; const unsigned char* rec2 = r2b + (size_t)cidx * U2_BYTES;
    LAS unsigned char* slot = lds + (cidx % SB_D) * SB_SLOT;
#pragma unroll
    for (int i = 0; i < 2; ++i) { const int ci = 2 * lw + i;
        const int row = 8 * ci + (lane >> 3), sl = lane & 7;
        __builtin_amdgcn_global_load_lds((const unsigned*)(rec1 + U_PMP + row * 128 + ((sl ^ (row & 7)) << 4)), (LAS unsigned*)(slot + ci * 1024), 16, 0, 0); }
#pragma unroll
    for (int i = 0; i < 4; ++i) { const int ci = 4 * lw + i;
        const int v = 4 * ci + (lane >> 4), sl = lane & 15;
        __builtin_amdgcn_global_load_lds((const unsigned*)(rec2 + U_QMT + v * 256 + ((sl ^ (v & 15)) << 4)), (LAS unsigned*)(slot + 8192 + ci * 1024), 16, 0, 0); }
}
DI void phase_scan_b(Frame& F) {
    const int lane = F.lane, r16 = lane & 15, g = lane >> 4, w = F.wave, v = 16 * (w & 3) + r16;
    for (int bh = F.bid; bh < NB * NH; bh += F.G) {
        const unsigned char* r1 = F.wsp() + WS_SC1 + (size_t)bh * 128 * U1_BYTES; const unsigned char* r2 = F.wsp() + WS_SC2 + (size_t)bh * 128 * U2_BYTES;
        bf16_t* sct = (bf16_t*)(F.wsp() + WS_SCT) + (size_t)bh * 128 * 4096;
        f32x4 sT[4];
#pragma unroll
        for (int i = 0; i < 4; ++i) sT[i] = (f32x4){0.f, 0.f, 0.f, 0.f};
        __syncthreads();
        if (w >= 4) {
#pragma unroll
            for (int d = 0; d < SB_D; ++d) scanb_issue(F.lds, r1, r2, d, w - 4, lane);
        }
        for (int c = 0; c < 128; ++c) {
            if (w >= 4) asm volatile("s_waitcnt vmcnt(18)" ::: "memory");
            __builtin_amdgcn_s_barrier();
            asm volatile("" ::: "memory");
            if (w >= 4) {
                if (c >= 1) { const int cn = c - 1 + SB_D; scanb_issue(F.lds, r1, r2, cn < 128 ? cn : c, w - 4, lane); }
            } else {
                const LAS unsigned char* slot = F.lds + (c % SB_D) * SB_SLOT;
                bf16x8 pm[4][2]; f32x4 q[4];
#pragma unroll
                for (int mt = 0; mt < 4; ++mt) { const int row = 16 * mt + r16;
#pragma unroll
                    for (int s2 = 0; s2 < 2; ++s2) pm[mt][s2] = *(const LAS bf16x8*)(slot + row * 128 + (((4 * s2 + g) ^ (row & 7)) << 4));
                    q[mt] = *(const LAS f32x4*)(slot + 8192 + v * 256 + (((4 * mt + g) ^ (v & 15)) << 4)); }
                bf16x8 hi[2], lo[2];
#pragma unroll
                for (int s2 = 0; s2 < 2; ++s2) { u32x4 hw, lw;
#pragma unroll
                    for (int qq = 0; qq < 2; ++qq) { const f32x4 x = sT[2 * s2 + qq]; const unsigned h0 = pk2(x[0], x[1]), h1 = pk2(x[2], x[3]);
                        const unsigned l0 = pk2(x[0] - bflo(h0), x[1] - bfhi(h0)), l1 = pk2(x[2] - bflo(h1), x[3] - bfhi(h1));
                        if (qq == 0) { hw.x = h0; hw.y = h1; lw.x = l0; lw.y = l1; } else { hw.z = h0; hw.w = h1; lw.z = l0; lw.w = l1; } }
                    hi[s2] = __builtin_bit_cast(bf16x8, hw); lo[s2] = __builtin_bit_cast(bf16x8, lw);
                    *(u32x4*)(sct + (size_t)c * 4096 + (size_t)v * 64 + 32 * s2 + 8 * g) = hw; }
#pragma unroll
                for (int mt = 0; mt < 4; ++mt) { f32x4 n = q[mt];
#pragma unroll
                    for (int s2 = 0; s2 < 2; ++s2) { n = mfma16(pm[mt][s2], hi[s2], n); n = mfma16(pm[mt][s2], lo[s2], n); }
                    sT[mt] = n; }
                asm volatile("s_waitcnt lgkmcnt(0)" ::: "memory");
            }
        }
        asm volatile("s_waitcnt vmcnt(0)" ::: "memory");
    }
}

struct ScanCIn { bf16x8 ra[2]; f32x4 yl[4]; bf16x8 sb[4][2]; };
DI void scanc_load(ScanCIn& o, const unsigned char* ws, int item, int r16, int g) {
    asm volatile("" : "+s"(item));
    const int u = item >> 2, it = item & 3; const int bh = u & 31, c = u >> 5; const size_t ui = (size_t)(bh * 128 + c);
    const unsigned char* rec1 = ws + WS_SC1 + ui * U1_BYTES; const unsigned char* rec2 = ws + WS_SC2 + ui * U2_BYTES; const bf16_t* sct = (const bf16_t*)(ws + WS_SCT) + ui * 4096;
#pragma unroll
    for (int s = 0; s < 2; ++s) o.ra[s] = *(const bf16x8*)(rec1 + U_RPP + (size_t)((16 * it + r16) * 64 + 32 * s + 8 * g) * 2);
#pragma unroll
    for (int vt = 0; vt < 4; ++vt) { o.yl[vt] = *(const f32x4*)(rec2 + U_YLT + (size_t)((16 * it + r16) * 64 + 16 * vt + 4 * g) * 4);
#pragma unroll
        for (int s = 0; s < 2; ++s) o.sb[vt][s] = *(const bf16x8*)(sct + (size_t)(16 * vt + r16) * 64 + 32 * s + 8 * g); }
}
DI void scanc_item(const ScanCIn& o, Frame& F, int l, int item, int r16, int g) {
    const bf16_t* SIr = (const bf16_t*)(F.wsp() + WS_SI); const bf16_t* SIk = SIr + 2 * (size_t)T * CW;
    const bf16_t* V = (const bf16_t*)(F.wsp() + (l > 0 ? WS_V1 : WS_VF)); const bf16_t* Gb = (const bf16_t*)(F.wsp() + WS_G); bf16_t* YR = (bf16_t*)(F.wsp() + WS_YRM);
    const int u = item >> 2, it = item & 3; const int bh = u & 31, c = u >> 5, b = bh >> 3, h = bh & 7;
    const size_t tok = (size_t)b * SEQ + c * 64 + 16 * it + r16; const size_t o0 = tok * CW + h * 64 + 4 * g, oy = tok * YRM_LD + h * 64 + 4 * g;
    u32x2 pr[4], pk[4], pv[4], pg[4];
#pragma unroll
    for (int vt = 0; vt < 4; ++vt) { pr[vt] = *(const u32x2*)(SIr + o0 + 16 * vt); pk[vt] = *(const u32x2*)(SIk + o0 + 16 * vt); pv[vt] = *(const u32x2*)(V + o0 + 16 * vt); pg[vt] = *(const u32x2*)(Gb + o0 + 16 * vt); }
    f32x4 y[4];
#pragma unroll
    for (int vt = 0; vt < 4; ++vt) { y[vt] = o.yl[vt];
#pragma unroll
        for (int s = 0; s < 2; ++s) y[vt] = mfma16(o.sb[vt][s], o.ra[s], y[vt]); }
    float s1 = 0.f;
#pragma unroll
    for (int vt = 0; vt < 4; ++vt) s1 += (y[vt][0] + y[vt][1]) + (y[vt][2] + y[vt][3]);
    s1 += __shfl_xor(s1, 16); s1 += __shfl_xor(s1, 32);
    const float mean = s1 * (1.f / 64.f); float s2 = 0.f;
#pragma unroll
    for (int vt = 0; vt < 4; ++vt) { y[vt] = y[vt] - mean; s2 += (y[vt][0] * y[vt][0] + y[vt][1] * y[vt][1]) + (y[vt][2] * y[vt][2] + y[vt][3] * y[vt][3]); }
    s2 += __shfl_xor(s2, 16); s2 += __shfl_xor(s2, 32);
    const float rstd = __builtin_amdgcn_rsqf(s2 * (1.f / 64.f) + 64e-5f);
    const float* lng = F.inp(17) + l * CW + h * 64 + 4 * g; const float* lnb = F.inp(18) + l * CW + h * 64 + 4 * g; const float* rkp = F.inp(16) + l * CW + h * 64 + 4 * g;
    float s3 = 0.f;
#pragma unroll
    for (int vt = 0; vt < 4; ++vt) { const f32x4 rk = *(const f32x4*)(rkp + 16 * vt);
        s3 += bflo(pr[vt].x) * bflo(pk[vt].x) * rk[0] + bfhi(pr[vt].x) * bfhi(pk[vt].x) * rk[1] + bflo(pr[vt].y) * bflo(pk[vt].y) * rk[2] + bfhi(pr[vt].y) * bfhi(pk[vt].y) * rk[3]; }
    s3 += __shfl_xor(s3, 16); s3 += __shfl_xor(s3, 32);
#pragma unroll
    for (int vt = 0; vt < 4; ++vt) { const f32x4 lg4 = *(const f32x4*)(lng + 16 * vt), lb4 = *(const f32x4*)(lnb + 16 * vt);
        const float o_0 = (y[vt][0] * rstd * lg4[0] + lb4[0] + s3 * bflo(pv[vt].x)) * bflo(pg[vt].x), o_1 = (y[vt][1] * rstd * lg4[1] + lb4[1] + s3 * bfhi(pv[vt].x)) * bfhi(pg[vt].x);
        const float o_2 = (y[vt][2] * rstd * lg4[2] + lb4[2] + s3 * bflo(pv[vt].y)) * bflo(pg[vt].y), o_3 = (y[vt][3] * rstd * lg4[3] + lb4[3] + s3 * bfhi(pv[vt].y)) * bfhi(pg[vt].y);
        u32x2 w; w.x = pk2(o_0, o_1); w.y = pk2(o_2, o_3); *(u32x2*)(YR + oy + 16 * vt) = w; }
}
DI void phase_scan_c(Frame& F, int l) {
    const int lane = F.lane, r16 = lane & 15, g = lane >> 4;
    const int first = F.bid * 8 + F.wave, stride = F.G * 8;
    if (first >= NUNIT * 4) return;
    ScanCIn o0, o1;
    scanc_load(o0, F.wsp(), first, r16, g);
    for (int item = first; item < NUNIT * 4; item += 2 * stride) {
        const int i1 = item + stride, i2 = item + 2 * stride;
        if (i1 < NUNIT * 4) scanc_load(o1, F.wsp(), i1, r16, g);
        scanc_item(o0, F, l, item, r16, g);
        if (i1 < NUNIT * 4) { if (i2 < NUNIT * 4) scanc_load(o0, F.wsp(), i2, r16, g); scanc_item(o1, F, l, i1, r16, g); }
    }
}

DI void phase_prep_scana(Frame& F, int l) {
    phase_rwkv_prep2(F, l, 0, 0, 1, true);
#define RELANE() do { int l_ = F.lane; asm volatile("" : "+v"(l_)); F.lane = l_; F.tid = F.wave * 64 + l_; } while (0)
    for (int tile = F.bid; tile < T / 64; tile += F.G) {
        RELANE();
        phase_rwkv_prep2(F, l, tile, tile + 1, 1, false);
        asm volatile("s_waitcnt vmcnt(0)" ::: "memory");
        __syncthreads();
        __builtin_amdgcn_fence(__ATOMIC_ACQUIRE, "agent");
        asm volatile("s_waitcnt vmcnt(0)" ::: "memory");
        const int b = tile >> 7, c = tile & 127; const int u0 = c * 32 + b * 8;
        RELANE();
        phase_scan_a(F, l, u0, u0 + 8, 1);
    }
#undef RELANE
}
constexpr size_t TB_KMEAN2 = 256 * 1024;
DI void phase_moba_prep(Frame& F, int l) {
    bf16_t* MO = (bf16_t*)(F.wsp() + WS_MO); float* KM = (float*)(F.wsp() + WS_TAB + TB_KMEAN);
    int c = F.tid; const float qg = F.inp(23)[l * 64 + (c & 63)] * 0.125f, kg = F.inp(24)[l * 64 + (c & 63)];
    for (int hs = F.bid; hs < T / 128; hs += F.G) {
        float ksum = 0.f;
        for (int tb = 0; tb < 128; tb += 8) {
            int tbase = hs * 128 + tb; asm volatile("" : "+s"(tbase), "+v"(c));
            float q[8], k[8];
#pragma unroll
            for (int e = 0; e < 8; ++e) { const size_t ro = (size_t)(tbase + e) * 1536; q[e] = bf2f(MO[ro + c]); k[e] = bf2f(MO[ro + 512 + c]); }
#pragma unroll
            for (int e = 0; e < 8; ++e) { const size_t ro = (size_t)(tbase + e) * 1536;
                const float qs = wave_sum(q[e] * q[e]) * (1.f / 64.f), ks = wave_sum(k[e] * k[e]) * (1.f / 64.f);
                const float qn = q[e] * (1.0f / sqrtf(qs + 1e-6f)) * qg, kn = k[e] * (1.0f / sqrtf(ks + 1e-6f)) * kg;
                MO[ro + c] = f2bf(qn); MO[ro + 512 + c] = f2bf(kn); ksum += kn; }
        }
        KM[(size_t)(hs & 1) * (TB_KMEAN2 / 4) + (size_t)(hs >> 1) * CW + c] = ksum * (1.f / 256.f);
    }
}
DI void phase_moba_gate(Frame& F) {
    LAS float* KL = (LAS float*)F.lds;
    const bf16_t* MO = (const bf16_t*)(F.wsp() + WS_MO); const float* KM = (const float*)(F.wsp() + WS_TAB + TB_KMEAN); unsigned* SEL = (unsigned*)(F.wsp() + WS_SEL);
    for (int span = F.bid; span < T / 64; span += F.G) {
        const int t0 = span * 64, b = t0 / SEQ, blk = (t0 % SEQ) / 256;
        __syncthreads();
        for (int idx = F.tid; idx < blk * 512; idx += 512) { const int j = idx >> 9, cc = idx & 511, h = cc >> 6, d = cc & 63;
            const size_t ko = ((size_t)(b * 32 + j)) * CW + cc; KL[h * 2052 + j * 64 + d] = KM[ko] + KM[ko + TB_KMEAN2 / 4]; }
        __syncthreads();
        const int tok = F.tid >> 3, h = F.tid & 7; const int t = t0 + tok;
        float q[64];
        { const u32x4* qp = (const u32x4*)(MO + (size_t)t * 1536 + h * 64);
#pragma unroll
          for (int i = 0; i < 8; ++i) { const u32x4 w = qp[i]; q[8 * i] = bflo(w.x); q[8 * i + 1] = bfhi(w.x); q[8 * i + 2] = bflo(w.y); q[8 * i + 3] = bfhi(w.y); q[8 * i + 4] = bflo(w.z); q[8 * i + 5] = bfhi(w.z); q[8 * i + 6] = bflo(w.w); q[8 * i + 7] = bfhi(w.w); } }
        float v0 = -INFINITY, v1 = -INFINITY, v2 = -INFINITY; int i0 = 0, i1 = 1, i2 = 2;
        for (int j = 0; j < blk; ++j) {
            const LAS f32x4* kp = (const LAS f32x4*)(KL + h * 2052 + j * 64); float s = 0.f;
#pragma unroll
            for (int i = 0; i < 16; ++i) { const f32x4 kv = kp[i]; s += q[4 * i] * kv.x + q[4 * i + 1] * kv.y + q[4 * i + 2] * kv.z + q[4 * i + 3] * kv.w; }
            if (s > v0) { v2 = v1; i2 = i1; v1 = v0; i1 = i0; v0 = s; i0 = j; }
            else if (s > v1) { v2 = v1; i2 = i1; v1 = s; i1 = j; }
            else if (s > v2) { v2 = s; i2 = j; }
        }
        const int nv = blk < 3 ? blk : 3;
        SEL[(size_t)t * 8 + h] = (unsigned)i0 | ((unsigned)i1 << 8) | ((unsigned)i2 << 16) | ((unsigned)nv << 24);
    }
}

constexpr int KS_PITCH = 144, VT_PITCH = 520;
constexpr int NPIECE = 47;
constexpr int CW_QATT = 8192;
DI void phase_moba_attn(Frame& F, int l) {
    static constexpr unsigned PIECES[NPIECE] = {196608,1837578,590595,1574658,1115654,1640713,1968907,1443848,918789,1049857,1246983,393730,787456,721924,2034700,262401,2034179,2034957,2035214,2035471,2034692,2035728,2034944,2035985,2036242,2036499,2035461,2036756,2037013,2037270,2035969,2037527,2036230,2037784,2038041,2038298,2036743,2038555,2038812,2039069,2039326,2037512,2039583,2038018,2038281,2039050,2039563};
    LAS unsigned char* Ks = F.lds;
    LAS unsigned char* Vt = F.lds + 36864;
    LAS float* LUT = (LAS float*)(F.lds + 36864 + 33280);
    LAS unsigned* CTL = (LAS unsigned*)(F.lds + 36864 + 33280 + 528);
    LAS unsigned* LIST = CTL + 4;
    const bf16_t* MO = (const bf16_t*)(F.wsp() + WS_MO); const unsigned* SEL = (const unsigned*)(F.wsp() + WS_SEL);
    bf16_t* PO = (bf16_t*)(F.wsp() + WS_PO); f32x2* PST = (f32x2*)(F.wsp() + WS_PST);
    unsigned* qctr = (unsigned*)(F.wsp() + WS_CTL) + CW_QATT + 64 * l;
    const float* relb = F.inp(25);
    const int lane = F.lane;
    for (;;) {
        __syncthreads();
        if (F.tid == 0) { CTL[0] = __hip_atomic_fetch_add(qctr, 1u, __ATOMIC_RELAXED, __HIP_MEMORY_SCOPE_AGENT); CTL[1] = 0u; }
        __syncthreads();
        const int u = (int)CTL[0];
        if (u >= NPIECE * NB * NH) break;
        const unsigned pc = PIECES[u >> 5]; const int bh = u & 31, b = bh >> 3, h = bh & 7;
        const int j = (int)(pc & 0xff), qlo = (int)((pc >> 8) & 0xff), qhi = (int)(pc >> 16); const int ncand = (qhi - qlo + 1) * 256;
        const size_t tokb = (size_t)b * SEQ;
        for (int id = F.tid; id < 2048; id += 512) { const int row = id >> 3, c8 = id & 7; const size_t ro = (tokb + j * 256 + row) * 1536 + h * 64 + c8 * 8;
            *(LAS u32x4*)(Ks + row * KS_PITCH + c8 * 16) = *(const u32x4*)(MO + ro + 512); }
        for (int id = F.tid; id < 1024; id += 512) { const int rp = id >> 3, c8 = id & 7; const size_t ro = (tokb + j * 256 + 2 * rp) * 1536 + h * 64 + c8 * 8 + 1024;
            const u32x4 v0 = *(const u32x4*)(MO + ro), v1 = *(const u32x4*)(MO + ro + 1536);
            const unsigned a[4] = {v0.x, v0.y, v0.z, v0.w}, bq[4] = {v1.x, v1.y, v1.z, v1.w};
            LAS unsigned char* vp = Vt + (c8 * 8) * VT_PITCH + rp * 4;
#pragma unroll
            for (int q = 0; q < 4; ++q) { *(LAS unsigned*)(vp + (2 * q) * VT_PITCH) = (a[q] & 0xffffu) | (bq[q] << 16); *(LAS unsigned*)(vp + (2 * q + 1) * VT_PITCH) = (a[q] >> 16) | (bq[q] & 0xffff0000u); } }
        if (F.tid <= 128) { const int n = F.tid; int bucket;
            if (n < 16) bucket = n; else { int lg = 16 + (int)(logf((float)n / 16.0f) / 2.0794415416798357f * 16.0f); bucket = lg < 31 ? lg : 31; }
            LUT[n] = relb[bucket * 8 + h]; }
        for (int base = 0; base < ncand; base += 512) {
            const int q = qlo * 256 + base + F.tid; const int qb = q >> 8; bool mem = false; unsigned ent = 0;
            if (base + F.tid >= ncand) { }
            else if (qb == j) { mem = true; ent = (unsigned)q | (3u << 16); }
            else { const unsigned s = SEL[(tokb + q) * 8 + h]; const unsigned nv = s >> 24;
                if (nv > 0 && (s & 0xff) == (unsigned)j) { mem = true; ent = (unsigned)q; }
                else if (nv > 1 && ((s >> 8) & 0xff) == (unsigned)j) { mem = true; ent = (unsigned)q | (1u << 16); }
                else if (nv > 2 && ((s >> 16) & 0xff) == (unsigned)j) { mem = true; ent = (unsigned)q | (2u << 16); } }
            const unsigned long long bal = __ballot(mem); const int cnt = __popcll(bal);
            unsigned wbase = 0; if (lane == 0 && cnt > 0) wbase = __hip_atomic_fetch_add(&CTL[1], (unsigned)cnt, __ATOMIC_RELAXED, __HIP_MEMORY_SCOPE_WORKGROUP);
            wbase = (unsigned)__builtin_amdgcn_readfirstlane((int)wbase);
            if (mem) LIST[wbase + __popcll(bal & ((1ull << lane) - 1ull))] = ent;
        }
        __syncthreads();
        const int total = (int)CTL[1];
        const float bfar = LUT[128];
        const int ntile = (total + 31) >> 5;
        const int qi = lane & 31, half = lane >> 5;
        for (int tile = F.wave; tile < ntile; tile += 8) {
            const int e = tile * 32 + qi; const bool valid = e < total; const unsigned en = LIST[valid ? e : total - 1];
            const int q = (int)(en & 0xffffu), slot = (int)(en >> 16); const size_t tok = tokb + q;
            const bool need_lut = __any((q >> 8) <= j + 1);
            bf16x8 qf[4];
#pragma unroll
            for (int kk = 0; kk < 4; ++kk) qf[kk] = *(const bf16x8*)(MO + tok * 1536 + h * 64 + 16 * kk + 8 * half);
            float mrun = -1e30f, lsum = 0.f;
            f32x16 oacc[2];
#pragma unroll
            for (int i = 0; i < 16; ++i) { oacc[0][i] = 0.f; oacc[1][i] = 0.f; }
            const int qrel = q - j * 256;
#pragma unroll 1
            for (int ck = 0; ck < 4; ++ck) {
                f32x16 sacc[2];
#pragma unroll
                for (int k2 = 0; k2 < 2; ++k2) { const int kt = 2 * ck + k2;
#pragma unroll
                    for (int i = 0; i < 16; ++i) sacc[k2][i] = 0.f;
#pragma unroll
                    for (int kk = 0; kk < 4; ++kk) { const bf16x8 ka = *(const LAS bf16x8*)(Ks + (32 * kt + qi) * KS_PITCH + (16 * kk + 8 * half) * 2);
                        sacc[k2] = __builtin_amdgcn_mfma_f32_32x32x16_bf16(ka, qf[kk], sacc[k2], 0, 0, 0); } }
                float mx = -1e30f;
                if (need_lut) {
#pragma unroll
                    for (int k2 = 0; k2 < 2; ++k2)
#pragma unroll
                        for (int i = 0; i < 16; ++i) { const int key = 32 * (2 * ck + k2) + (i & 3) + 8 * (i >> 2) + 4 * half; const int n = qrel - key;
                            const float bias = LUT[n < 0 ? 0 : (n > 128 ? 128 : n)];
                            const float s = (n < 0) ? -1e30f : sacc[k2][i] + bias; sacc[k2][i] = s; mx = fmaxf(mx, s); }
                } else {
#pragma unroll
                    for (int k2 = 0; k2 < 2; ++k2)
#pragma unroll
                        for (int i = 0; i < 16; ++i) { const float s = sacc[k2][i] + bfar; sacc[k2][i] = s; mx = fmaxf(mx, s); }
                }
                mx = fmaxf(mx, __shfl_xor(mx, 32));
                const float mnew = fmaxf(mrun, mx); const float alpha = __expf(mrun - mnew); mrun = mnew;
                lsum *= alpha;
#pragma unroll
                for (int i = 0; i < 16; ++i) { oacc[0][i] *= alpha; oacc[1][i] *= alpha; }
#pragma unroll
                for (int k2 = 0; k2 < 2; ++k2) { const int kt = 2 * ck + k2;
#pragma unroll
                    for (int i = 0; i < 16; ++i) { const float p = __expf(sacc[k2][i] - mnew); sacc[k2][i] = p; lsum += p; }
#pragma unroll
                    for (int cc = 0; cc < 2; ++cc) {
                        u32x4 pw; pw.x = pk2(sacc[k2][8 * cc], sacc[k2][8 * cc + 1]); pw.y = pk2(sacc[k2][8 * cc + 2], sacc[k2][8 * cc + 3]); pw.z = pk2(sacc[k2][8 * cc + 4], sacc[k2][8 * cc + 5]); pw.w = pk2(sacc[k2][8 * cc + 6], sacc[k2][8 * cc + 7]);
                        const bf16x8 pf = __builtin_bit_cast(bf16x8, pw);
                        const int key0 = 32 * kt + 16 * cc + 4 * half;
#pragma unroll
                        for (int dt = 0; dt < 2; ++dt) { const LAS unsigned char* vb = Vt + (32 * dt + qi) * VT_PITCH + key0 * 2;
                            const u32x2 va = *(const LAS u32x2*)vb, vb2 = *(const LAS u32x2*)(vb + 16);
                            u32x4 vw; vw.x = va.x; vw.y = va.y; vw.z = vb2.x; vw.w = vb2.y;
                            oacc[dt] = __builtin_amdgcn_mfma_f32_32x32x16_bf16(__builtin_bit_cast(bf16x8, vw), pf, oacc[dt], 0, 0, 0); } } }
            }
            const float mx = mrun;
            lsum += __shfl_xor(lsum, 32);
            const float inv = 1.0f / lsum;
            if (valid) {
                bf16_t* op = PO + ((size_t)slot * T + tok) * CW + h * 64;
#pragma unroll
                for (int dt = 0; dt < 2; ++dt)
#pragma unroll
                    for (int ig = 0; ig < 4; ++ig) { u32x2 w; w.x = pk2(oacc[dt][4 * ig] * inv, oacc[dt][4 * ig + 1] * inv); w.y = pk2(oacc[dt][4 * ig + 2] * inv, oacc[dt][4 * ig + 3] * inv);
                        *(u32x2*)(op + 32 * dt + 8 * ig + 4 * half) = w; }
                if (half == 0) PST[((size_t)slot * T + tok) * 8 + h] = (f32x2){mx, lsum};
            }
        }
    }
}
DI void phase_moba_combine(Frame& F) {
    const bf16_t* PO = (const bf16_t*)(F.wsp() + WS_PO); const f32x2* PST = (const f32x2*)(F.wsp() + WS_PST); const unsigned* SEL = (const unsigned*)(F.wsp() + WS_SEL);
    bf16_t* YM = (bf16_t*)(F.wsp() + WS_YRM) + 512;
    int c = F.tid; const int h = c >> 6;
    for (int tb = F.bid * 8; tb < T; tb += F.G * 8) {
        int tbase = tb; asm volatile("" : "+s"(tbase), "+v"(c));
        int nv[8]; f32x2 st[8][4]; float po[8][4];
#pragma unroll
        for (int e = 0; e < 8; ++e) { const int t = tbase + e; nv[e] = (int)(SEL[(size_t)t * 8 + h] >> 24);
#pragma unroll
            for (int s = 0; s < 4; ++s) { st[e][s] = PST[((size_t)s * T + t) * 8 + h]; po[e][s] = bf2f(PO[((size_t)s * T + t) * CW + c]); } }
#pragma unroll
        for (int e = 0; e < 8; ++e) { const int t = tbase + e; float M = -1e30f;
#pragma unroll
            for (int s = 0; s < 4; ++s) { const bool on = (s == 3) || (s < nv[e]); if (on) M = fmaxf(M, st[e][s].x); }
            float den = 0.f, num = 0.f;
#pragma unroll
            for (int s = 0; s < 4; ++s) { const bool on = (s == 3) || (s < nv[e]); if (on) { const float w = st[e][s].y * __expf(st[e][s].x - M); den += w; num += w * po[e][s]; } }
            YM[(size_t)t * YRM_LD + c] = f2bf(num / den); }
    }
}
DI void phase_router(Frame& F, int l) {
    LAS float* xs = (LAS float*)F.lds;
    LAS float* wsm = xs + 64 * 129;
    LAS float* lgt = wsm + 128 * 36;
    LAS float* ssq = lgt + 64 * 37;
    LAS int* hist = (LAS int*)(ssq + 64);
    const float* x = F.outp(); const float* gain = F.inp(2) + (size_t)l * DM;
    const float* wgrp = F.inp(29) + (size_t)l * DM * 4; const float* wexp = F.inp(31) + (size_t)l * DM * 32;
    const float* bgrp = F.inp(30) + l * 4; const float* bexp = F.inp(32) + l * 32;
    int* EID = (int*)(F.wsp() + WS_RT + RT_EID); float* GATE = (float*)(F.wsp() + WS_RT + RT_GATE); int* HIST = (int*)(F.wsp() + WS_RT + RT_HIST);
    const int tok = F.tid & 63, jg = F.tid >> 6;
    for (int tile = F.bid; tile < T / 64; tile += F.G) {
        const int t0 = tile * 64;
        float acc[5] = {0.f, 0.f, 0.f, 0.f, 0.f}; float ss = 0.f;
        if (F.tid < 32) hist[F.tid] = 0;
        for (int kc = 0; kc < DM; kc += 128) {
            __syncthreads();
            for (int idx = F.tid; idx < 64 * 128; idx += 512) { const int r = idx >> 7, k = idx & 127; xs[r * 129 + k] = x[(size_t)(t0 + r) * DM + kc + k]; }
            for (int idx = F.tid; idx < 128 * 36; idx += 512) { const int k = idx / 36, j = idx - k * 36; const float g = gain[kc + k];
                wsm[idx] = g * (j < 4 ? wgrp[(size_t)(kc + k) * 4 + j] : wexp[(size_t)(kc + k) * 32 + (j - 4)]); }
            __syncthreads();
            for (int k = 0; k < 128; ++k) { const float xv = xs[tok * 129 + k]; ss += xv * xv;
#pragma unroll
                for (int i = 0; i < 5; ++i) { const int j = jg + 8 * i; if (j < 36) acc[i] += xv * wsm[k * 36 + j]; } }
        }
#pragma unroll
        for (int i = 0; i < 5; ++i) { const int j = jg + 8 * i; if (j < 36) lgt[tok * 37 + j] = acc[i]; }
        if (jg == 0) ssq[tok] = ss;
        __syncthreads();
        if (F.tid < 64) {
            const int t = t0 + F.tid; const float rs = 1.0f / sqrtf(ssq[F.tid] * (1.f / DM) + 1e-6f);
            float lg[4]; int gs = 0; float gm = -INFINITY;
#pragma unroll
            for (int g = 0; g < 4; ++g) { lg[g] = lgt[F.tid * 37 + g] * rs + bgrp[g]; if (lg[g] > gm) { gm = lg[g]; gs = g; } }
            float gden = 0.f;
#pragma unroll
            for (int g = 0; g < 4; ++g) gden += expf(lg[g] - gm);
            const float ptop = 1.0f / gden;
            float le[8]; float e0 = -INFINITY, e1 = -INFINITY; int j0 = 0, j1 = 1;
#pragma unroll
            for (int e = 0; e < 8; ++e) { le[e] = lgt[F.tid * 37 + 4 + gs * 8 + e] * rs + bexp[gs * 8 + e];
                if (le[e] > e0) { e1 = e0; j1 = j0; e0 = le[e]; j0 = e; } else if (le[e] > e1) { e1 = le[e]; j1 = e; } }
            const float p1 = expf(e1 - e0);
            const float g0 = ptop / (1.f + p1), g1 = ptop * p1 / (1.f + p1);
            const int ex0 = gs * 8 + j0, ex1 = gs * 8 + j1;
            EID[t * 2] = ex0; EID[t * 2 + 1] = ex1; GATE[t * 2] = g0; GATE[t * 2 + 1] = g1;
            __hip_atomic_fetch_add(&hist[ex0], 1, __ATOMIC_RELAXED, __HIP_MEMORY_SCOPE_WORKGROUP); __hip_atomic_fetch_add(&hist[ex1], 1, __ATOMIC_RELAXED, __HIP_MEMORY_SCOPE_WORKGROUP);
        }
        __syncthreads();
        if (F.tid < 32) HIST[tile * 32 + F.tid] = hist[F.tid];
        __syncthreads();
    }
}
DI void phase_moe_gather(Frame& F, int l) {
    LAS int* tot = (LAS int*)F.lds; LAS int* off = tot + 32; LAS int* base = off + 32; LAS int* eidl = base + 32; LAS int* rowl = eidl + 128; LAS int* ps = rowl + 128; LAS int* po = ps + 512;
    const float* x = F.outp(); const float* gain = F.inp(2) + (size_t)l * DM;
    const int* EID = (const int*)(F.wsp() + WS_RT + RT_EID); const float* GATE = (const float*)(F.wsp() + WS_RT + RT_GATE); const int* HIST = (const int*)(F.wsp() + WS_RT + RT_HIST);
    int* ROW = (int*)(F.wsp() + WS_RT + RT_ROW); float* GW = (float*)(F.wsp() + WS_RT + RT_GW); int* PEXP = (int*)(F.wsp() + WS_RT + RT_PEXP);
    bf16_t* AM = (bf16_t*)(F.wsp() + WS_AM);
    for (int tile = F.bid; tile < T / 64; tile += F.G) {
        const int t0 = tile * 64;
        __syncthreads();
        { const int e = F.tid & 31, part = F.tid >> 5; int s = 0, o = 0;
          for (int i = part * 32; i < part * 32 + 32; ++i) { const int v = HIST[i * 32 + e]; s += v; if (i < tile) o += v; }
          ps[F.tid] = s; po[F.tid] = o; }
        if (F.tid < 128) eidl[F.tid] = EID[t0 * 2 + F.tid];
        __syncthreads();
        if (F.tid < 32) { int s = 0, o = 0;
#pragma unroll
            for (int p = 0; p < 16; ++p) { s += ps[p * 32 + F.tid]; o += po[p * 32 + F.tid]; } tot[F.tid] = s; off[F.tid] = o; }
        __syncthreads();
        if (F.tid == 0) {
            int bs = 0; for (int e = 0; e < 32; ++e) { base[e] = bs; bs += (tot[e] + 255) & ~255; }
            if (tile == 0) { int p = 0; for (int e = 0; e < 32; ++e) { const int np = (tot[e] + 255) >> 8; for (int i = 0; i < np; ++i) PEXP[p++] = e; } PEXP[MOE_PANELS] = p; }
        }
        __syncthreads();
        if (F.tid < 128) { const int my = eidl[F.tid]; int rank = 0; for (int i = 0; i < F.tid; ++i) rank += (eidl[i] == my) ? 1 : 0;
            const int r = base[my] + off[my] + rank; rowl[F.tid] = r; ROW[t0 * 2 + F.tid] = r; GW[r] = GATE[t0 * 2 + F.tid]; }
        __syncthreads();
        for (int tk = F.wave; tk < 64; tk += 8) { const int t = t0 + tk;
            rms_row_to_bf16(x + (size_t)t * DM, gain, AM + (size_t)rowl[tk * 2] * DM, AM + (size_t)rowl[tk * 2 + 1] * DM, F.lane); }
    }
}
DI void phase_moe_combine(Frame& F, int l) {
    const bf16_t* YE = (const bf16_t*)(F.wsp() + WS_YE); const int* ROW = (const int*)(F.wsp() + WS_RT + RT_ROW); bf16_t* XN = (bf16_t*)(F.wsp() + WS_XN);
    const float* gain = F.inp(1) + (size_t)(l + 1 < NLAYER ? l + 1 : l) * DM;
    const int gw = F.bid * 8 + F.wave, NGW = F.G * 8;
    for (int t = gw; t < T; t += NGW) {
        const int r0 = ROW[t * 2], r1 = ROW[t * 2 + 1];
        f32x4* xr = (f32x4*)(F.outp() + (size_t)t * DM) + F.lane; const u32x2* y0 = (const u32x2*)(YE + (size_t)r0 * DM) + F.lane; const u32x2* y1 = (const u32x2*)(YE + (size_t)r1 * DM) + F.lane;
        f32x4 v[4]; float s = 0.f;
#pragma unroll
        for (int j = 0; j < 4; ++j) { const u32x2 a = y0[64 * j], b = y1[64 * j]; f32x4 xv = xr[64 * j];
            xv.x += bflo(a.x) + bflo(b.x); xv.y += bfhi(a.x) + bfhi(b.x); xv.z += bflo(a.y) + bflo(b.y); xv.w += bfhi(a.y) + bfhi(b.y);
            v[j] = xv; xr[64 * j] = xv; s += (xv.x * xv.x + xv.y * xv.y) + (xv.z * xv.z + xv.w * xv.w); }
        if (l + 1 < NLAYER) {
            const float rs = 1.0f / sqrtf(wave_sum(s) * (1.f / DM) + 1e-6f);
#pragma unroll
            for (int j = 0; j < 4; ++j) { const f32x4 g = ((const f32x4*)gain)[F.lane + 64 * j]; const f32x4 y = v[j] * rs * g; u32x2 w; w.x = pk2(y.x, y.y); w.y = pk2(y.z, y.w); *((u32x2*)(XN + (size_t)t * DM) + F.lane + 64 * j) = w; }
        }
    }
}

constexpr size_t TB_WRH = 512 * 1024, TB_WRL = TB_WRH + 48 * 1024 * 2;
DI void phase_conv_router(Frame& F, int l) {
    bf16_t* WRH = (bf16_t*)(F.wsp() + WS_TAB + TB_WRH); bf16_t* WRL = (bf16_t*)(F.wsp() + WS_TAB + TB_WRL);
    const float* gain = F.inp(2) + (size_t)l * DM; const float* wgrp = F.inp(29) + (size_t)l * DM * 4; const float* wexp = F.inp(31) + (size_t)l * DM * 32;
    for (int idx = F.bid * 512 + F.tid; idx < 48 * DM; idx += F.G * 512) { const int n = idx >> 10, k = idx & 1023;
        float v = (n < 4) ? wgrp[k * 4 + n] : (n < 36) ? wexp[k * 32 + (n - 4)] : 0.f; v *= gain[k];
        const bf16_t h = f2bf(v); WRH[idx] = h; WRL[idx] = f2bf(v - bf2f(h)); }
}
DI void phase_router2(Frame& F, int l) {
    LAS float* lgt = (LAS float*)F.lds + F.wave * 1024;
    LAS int* hist = (LAS int*)(F.lds + 8 * 4096);
    const float* x = F.outp(); const bf16_t* WRH = (const bf16_t*)(F.wsp() + WS_TAB + TB_WRH); const bf16_t* WRL = (const bf16_t*)(F.wsp() + WS_TAB + TB_WRL);
    const float* bgrp = F.inp(30) + l * 4; const float* bexp = F.inp(32) + l * 32;
    int* EID = (int*)(F.wsp() + WS_RT + RT_EID); float* GATE = (float*)(F.wsp() + WS_RT + RT_GATE); int* HIST = (int*)(F.wsp() + WS_RT + RT_HIST);
    const int lane = F.lane, r16 = lane & 15, g = lane >> 4;
    for (int task = F.bid; task < T / 128; task += F.G) {
        const int t0 = task * 128 + F.wave * 16;
        __syncthreads();
        if (F.tid < 64) hist[F.tid] = 0;
        __syncthreads();
        f32x4 acc[3];
#pragma unroll
        for (int nt = 0; nt < 3; ++nt) acc[nt] = (f32x4){0.f, 0.f, 0.f, 0.f};
        float ss = 0.f;
        const float* xr = x + (size_t)(t0 + r16) * DM + 8 * g;
#pragma unroll 2
        for (int s = 0; s < 32; ++s) {
            const f32x4 x0 = *(const f32x4*)(xr + 32 * s), x1 = *(const f32x4*)(xr + 32 * s + 4);
            ss += (x0.x * x0.x + x0.y * x0.y) + (x0.z * x0.z + x0.w * x0.w) + (x1.x * x1.x + x1.y * x1.y) + (x1.z * x1.z + x1.w * x1.w);
            u32x4 hw, lw; hw.x = pk2(x0.x, x0.y); hw.y = pk2(x0.z, x0.w); hw.z = pk2(x1.x, x1.y); hw.w = pk2(x1.z, x1.w);
            lw.x = pk2(x0.x - bflo(hw.x), x0.y - bfhi(hw.x)); lw.y = pk2(x0.z - bflo(hw.y), x0.w - bfhi(hw.y)); lw.z = pk2(x1.x - bflo(hw.z), x1.y - bfhi(hw.z)); lw.w = pk2(x1.z - bflo(hw.w), x1.w - bfhi(hw.w));
            const bf16x8 ah = __builtin_bit_cast(bf16x8, hw), al = __builtin_bit_cast(bf16x8, lw);
#pragma unroll
            for (int nt = 0; nt < 3; ++nt) { const size_t wo = (size_t)(16 * nt + r16) * DM + 32 * s + 8 * g;
                const bf16x8 bh = *(const bf16x8*)(WRH + wo), bl = *(const bf16x8*)(WRL + wo);
                acc[nt] = mfma16(ah, bh, acc[nt]); acc[nt] = mfma16(ah, bl, acc[nt]); acc[nt] = mfma16(al, bh, acc[nt]); }
        }
        ss += __shfl_xor(ss, 16); ss += __shfl_xor(ss, 32);
#pragma unroll
        for (int nt = 0; nt < 3; ++nt)
#pragma unroll
            for (int r = 0; r < 4; ++r) lgt[(4 * g + r) * 48 + 16 * nt + r16] = acc[nt][r];
        if (g == 0) lgt[768 + r16] = ss;
        LDS_WAIT(); asm volatile("" ::: "memory");
        if (lane < 16) {
            const int t = t0 + lane; const float rs = 1.0f / sqrtf(lgt[768 + lane] * (1.f / DM) + 1e-6f); const LAS float* lr = lgt + lane * 48;
            float lg[4]; int gs = 0; float gm = -INFINITY;
#pragma unroll
            for (int q = 0; q < 4; ++q) { lg[q] = lr[q] * rs + bgrp[q]; if (lg[q] > gm) { gm = lg[q]; gs = q; } }
            float gden = 0.f;
#pragma unroll
            for (int q = 0; q < 4; ++q) gden += expf(lg[q] - gm);
            const float ptop = 1.0f / gden;
            float e0 = -INFINITY, e1 = -INFINITY; int j0 = 0, j1 = 1;
#pragma unroll
            for (int e = 0; e < 8; ++e) { const float le = lr[4 + gs * 8 + e] * rs + bexp[gs * 8 + e];
                if (le > e0) { e1 = e0; j1 = j0; e0 = le; j0 = e; } else if (le > e1) { e1 = le; j1 = e; } }
            const float p1 = expf(e1 - e0);
            const float g0 = ptop / (1.f + p1), g1 = ptop * p1 / (1.f + p1);
            const int ex0 = gs * 8 + j0, ex1 = gs * 8 + j1;
            EID[t * 2] = ex0; EID[t * 2 + 1] = ex1; GATE[t * 2] = g0; GATE[t * 2 + 1] = g1;
            LAS int* hh = hist + (F.wave >> 2) * 32;
            __hip_atomic_fetch_add(&hh[ex0], 1, __ATOMIC_RELAXED, __HIP_MEMORY_SCOPE_WORKGROUP); __hip_atomic_fetch_add(&hh[ex1], 1, __ATOMIC_RELAXED, __HIP_MEMORY_SCOPE_WORKGROUP);
        }
        __syncthreads();
        if (F.tid < 64) HIST[(task * 2 + (F.tid >> 5)) * 32 + (F.tid & 31)] = hist[F.tid];
    }
}
#ifndef MK_PER_PHASE_LAUNCH
#define MK_PER_PHASE_LAUNCH 0
#endif
constexpr int PH_PER_LAYER = 19, NPHASE = PH_PER_LAYER * NLAYER;
struct Args { const float* in[36]; float* out; unsigned char* ws; int ph_lo, ph_hi; };

#ifndef SCAN_NAIVE
#define SCAN_NAIVE 0
#endif
#ifndef PHMASK
#define PHMASK 0x7ffff
#endif
#ifndef DUPMASK
#define DUPMASK 0
#endif
#define NREP(k) ((((DUPMASK) >> (k)) & 1) ? 2 : 1)
#define IN(k) (((PHMASK >> ((k) % PH_PER_LAYER)) & 1) && lo <= (k) && (k) < hi)
#define SEAM(k) do { asm volatile("" : "+s"(barp), "+s"(bar.x)); bar.bar = (unsigned*)barp; if (IN(k) && IN((k) + 1)) xcd_barrier(bar); asm volatile("" : "+s"(F.ws_g), "+s"(F.out_g), "+s"(F.ka), "+s"(F.bid), "+s"(F.G), "+s"(F.lds)); } while (0)
#define FRESH() do { asm volatile("" : "+s"(F.wave)); int l_ = (int)__builtin_amdgcn_mbcnt_hi(~0u, __builtin_amdgcn_mbcnt_lo(~0u, 0u)); asm volatile("" : "+v"(l_)); F.lane = l_; F.tid = F.wave * 64 + l_; } while (0)
__global__ void __launch_bounds__(512, 2) fwd_kernel(Args args) {
    extern __shared__ __attribute__((aligned(16))) unsigned char lds_raw[];
    Frame F;
    F.lds = (LAS unsigned char*)lds_raw;
    F.tid = threadIdx.x; F.lane = F.tid & 63; F.wave = __builtin_amdgcn_readfirstlane(F.tid >> 6);
    F.G = gridDim.x; F.bid = blockIdx.x;
    F.ka = (const __attribute__((address_space(4))) unsigned char*)__builtin_amdgcn_kernarg_segment_ptr();
    F.out_g = (GAS float*)args.out; F.ws_g = (GAS unsigned char*)args.ws;
    volatile LAS unsigned* MISC = (volatile LAS unsigned*)(F.lds + MISC_OFF);
    if (F.tid < 32) MISC[F.tid] = 0u;
    __syncthreads();
    const int lo = args.ph_lo, hi = args.ph_hi;
    GAS unsigned* barp = (GAS unsigned*)(F.ws_g + WS_CTL) + CW_BAR;
    XcdBarrier bar; bar.bar = (unsigned*)barp; bar.x = 0; bar.st = nullptr;
    if (hi - lo > 1) bar = xcd_barrier_post((unsigned*)barp, MISC + 8);

    bf16_t* const XN = (bf16_t*)(F.wsp() + WS_XN);
    bf16_t* const WCAT = (bf16_t*)(F.wsp() + WS_WM + WM_WCAT);
    for (int l = 0; l < NLAYER; ++l) {
        const int P = l * PH_PER_LAYER;
#define PHASE(k) if (IN(P + (k))) for (int rep_ = 0; rep_ < NREP(k); ++rep_)
        PHASE(0) { FRESH(); if (l == 0) { phase_conv_mixer(F, 0); phase_conv_lora2(F, 0); phase_conv_router(F, 0); phase_norm_x(F, F.inp(0), F.inp(1)); } }
        SEAM(P + 0);
#if defined(XTRA_BARS)
        if (hi - lo > 1) for (int xb_ = 0; xb_ < XTRA_BARS; ++xb_) { asm volatile("" : "+s"(barp), "+s"(bar.x)); bar.bar = (unsigned*)barp; xcd_barrier(bar); }
#endif
        PHASE(1) { FRESH(); pg8::Gemm g{XN, WCAT, T, 2304, DM}; pg8::StaticOrder S; S.init(T, 2304, F.G, F.bid);
            pg8::EpiStore E{(bf16_t*)(F.wsp() + WS_RW), 1536, 1536, (bf16_t*)(F.wsp() + WS_LO), LO_W, 0};
            pg8::gemm_phase<pg8::EpiStore, pg8::StaticOrder>(F.lds, g, S, E, F.tid); }
        SEAM(P + 1);
        PHASE(2) { FRESH(); phase_rwkv_prep2(F, l, F.bid, T / 64, F.G, true); }
        SEAM(P + 2);
#if SCAN_NAIVE
        PHASE(3) { FRESH(); phase_rwkv_scan_naive(F, l); }
        SEAM(P + 3);
        SEAM(P + 4);
        PHASE(5) { FRESH(); phase_rwkv_post(F, l); }
        SEAM(P + 5);
#else
        PHASE(3) { FRESH(); phase_scan_a(F, l, F.bid, NUNIT, F.G); }
        SEAM(P + 3);
        PHASE(4) { FRESH(); phase_scan_b(F); }
        SEAM(P + 4);
        PHASE(5) { FRESH(); phase_scan_c(F, l); }
        SEAM(P + 5);
#endif
        PHASE(6) { FRESH(); pg8::Gemm g{XN, WCAT + (size_t)2304 * DM, T, 1536, DM}; pg8::StaticOrder S; S.init(T, 1536, F.G, F.bid);
            pg8::EpiStore E{(bf16_t*)(F.wsp() + WS_MO), 1536, 0, nullptr, 0, 0};
            pg8::gemm_phase<pg8::EpiStore, pg8::StaticOrder>(F.lds, g, S, E, F.tid); }
        SEAM(P + 6);
        PHASE(7) { FRESH(); phase_moba_prep(F, l); }
        SEAM(P + 7);
        PHASE(8) { FRESH(); phase_moba_gate(F); }
        SEAM(P + 8);
        PHASE(9) { FRESH(); phase_moba_attn(F, l); }
        SEAM(P + 9);
        PHASE(10) { FRESH(); phase_moba_combine(F); }
        SEAM(P + 10);
        PHASE(11) { FRESH(); pg8::Gemm g{XN, WCAT + (size_t)3840 * DM, T, 2048, DM}; pg8::StaticOrder S; S.init(T, 2048, F.G, F.bid);
            pg8::EpiStore E{(bf16_t*)(F.wsp() + WS_GA), 2048, 0, nullptr, 0, 1};
            pg8::gemm_phase<pg8::EpiStore, pg8::StaticOrder>(F.lds, g, S, E, F.tid); }
        SEAM(P + 11);
        PHASE(12) { FRESH(); pg8::Gemm g{(const bf16_t*)(F.wsp() + WS_YRM), (const bf16_t*)(F.wsp() + WS_WM + WM_BRR), T, DM, DM}; pg8::StaticOrder S; S.init(T, DM, F.G, F.bid);
            pg8::EpiBranch2 E{(bf16_t*)(F.wsp() + WS_H), (const bf16_t*)(F.wsp() + WS_GA)};
            pg8::gemm_phase<pg8::EpiBranch2, pg8::StaticOrder>(F.lds, g, S, E, F.tid); }
        SEAM(P + 12);
        PHASE(13) { FRESH(); pg8::Gemm g{(const bf16_t*)(F.wsp() + WS_H), (const bf16_t*)(F.wsp() + WS_WM + WM_OUT), T, DM, DM}; pg8::StaticOrder S; S.init(T, DM, F.G, F.bid);
            pg8::EpiResid E{l == 0 ? F.inp(0) : F.outp(), F.outp()};
            pg8::gemm_phase<pg8::EpiResid, pg8::StaticOrder>(F.lds, g, S, E, F.tid); }
        SEAM(P + 13);
        PHASE(14) { FRESH(); phase_router2(F, l); phase_conv_experts(F, l); }
        SEAM(P + 14);
        PHASE(15) { FRESH(); phase_moe_gather(F, l); }
        SEAM(P + 15);
        PHASE(16) { FRESH(); const int* PEXP = (const int*)(F.wsp() + WS_RT + RT_PEXP); const int np = __builtin_amdgcn_readfirstlane(PEXP[MOE_PANELS]);
            pg8::Gemm g{(const bf16_t*)(F.wsp() + WS_AM), (const bf16_t*)(F.wsp() + WS_WE), np * 256, 1024, DM}; pg8::GroupOrder S; S.init(np * 256, 1024, F.G, F.bid); S.pexp = PEXP;
            pg8::EpiExpertUp E{(bf16_t*)(F.wsp() + WS_HM), (const float*)(F.wsp() + WS_RT + RT_GW)};
            pg8::gemm_phase<pg8::EpiExpertUp, pg8::GroupOrder>(F.lds, g, S, E, F.tid); }
        SEAM(P + 16);
        PHASE(17) { FRESH(); const int* PEXP = (const int*)(F.wsp() + WS_RT + RT_PEXP); const int np = __builtin_amdgcn_readfirstlane(PEXP[MOE_PANELS]);
            pg8::Gemm g{(const bf16_t*)(F.wsp() + WS_HM), (const bf16_t*)(F.wsp() + WS_WD), np * 256, 1024, DEXP}; pg8::GroupOrder S; S.init(np * 256, 1024, F.G, F.bid); S.pexp = PEXP;
            pg8::EpiStore E{(bf16_t*)(F.wsp() + WS_YE), 1024, 0, nullptr, 0, 0};
            pg8::gemm_phase<pg8::EpiStore, pg8::GroupOrder>(F.lds, g, S, E, F.tid); }
        SEAM(P + 17);
        PHASE(18) { FRESH(); phase_moe_combine(F, l); if (l + 1 < NLAYER) { phase_conv_mixer(F, l + 1); phase_conv_lora2(F, l + 1); phase_conv_router(F, l + 1); } }
        SEAM(P + 18);
#undef PHASE
    }
}

extern "C" void kernel_launch(void* const* d_in, const int* in_sizes, int n_in, void* d_out, int out_size, void* d_ws, size_t ws_size, hipStream_t stream) {
    static int grid = 0;
    if (grid == 0) {
        if (n_in != 36 || out_size != T * DM || ws_size < WS_NEED) { fprintf(stderr, "kernel_launch: unexpected problem (n_in %d, out %d, ws %zu); nothing launched\n", n_in, out_size, ws_size); grid = -1; return; }
        int dev = 0, cus = 0;
        if (hipGetDevice(&dev) != hipSuccess || hipDeviceGetAttribute(&cus, hipDeviceAttributeMultiprocessorCount, dev) != hipSuccess) { grid = -1; return; }
        if (hipFuncSetAttribute((const void*)fwd_kernel, hipFuncAttributeMaxDynamicSharedMemorySize, LDS_BYTES) != hipSuccess) { fprintf(stderr, "kernel_launch: hipFuncSetAttribute failed\n"); grid = -1; return; }
        int per_cu = 0;
        if (hipOccupancyMaxActiveBlocksPerMultiprocessor(&per_cu, (const void*)fwd_kernel, 512, LDS_BYTES) != hipSuccess || per_cu < 1) { fprintf(stderr, "kernel_launch: occupancy query says %d\n", per_cu); }
        (void)hipGetLastError();
        grid = cus;
    }
    if (grid < 0) return;
    (void)hipMemsetAsync((char*)d_ws + WS_CTL, 0, CTL_ZERO_BYTES, stream);
    Args a{};
    for (int i = 0; i < 36; ++i) a.in[i] = (const float*)d_in[i];
    a.out = (float*)d_out; a.ws = (unsigned char*)d_ws;
#if MK_PER_PHASE_LAUNCH
    for (int ph = 0; ph < NPHASE; ++ph) { if (ph == PH_PER_LAYER) continue; a.ph_lo = ph; a.ph_hi = ph + 1; hipLaunchKernelGGL(fwd_kernel, dim3(grid), dim3(512), LDS_BYTES, stream, a); }
#else
    a.ph_lo = 0; a.ph_hi = NPHASE;
    hipLaunchKernelGGL(fwd_kernel, dim3(grid), dim3(512), LDS_BYTES, stream, a);
#endif
}
```

```cpp
#include <hip/hip_runtime.h>
#include <cstdio>
#include <cstdint>
#define LAS __attribute__((address_space(3)))
#define GAS __attribute__((address_space(1)))
#define DI __device__ __forceinline__
typedef unsigned short bf16_t;
typedef short bf16x8 __attribute__((ext_vector_type(8)));
typedef short s16x4 __attribute__((ext_vector_type(4)));
typedef float f32x4 __attribute__((ext_vector_type(4)));
typedef float f32x2 __attribute__((ext_vector_type(2)));
typedef float f32x16 __attribute__((ext_vector_type(16)));
typedef unsigned u32x4 __attribute__((ext_vector_type(4)));
typedef unsigned u32x2 __attribute__((ext_vector_type(2)));
typedef __bf16 bf16v2 __attribute__((ext_vector_type(2)));

DI unsigned pk2(float lo, float hi) { f32x2 v = {lo, hi}; return __builtin_bit_cast(unsigned, __builtin_convertvector(v, bf16v2)); }
DI bf16_t f2bf(float f) { return (bf16_t)(pk2(f, 0.f) & 0xffffu); }
DI float bf2f(bf16_t b) { return __uint_as_float(((unsigned)b) << 16); }
DI float bflo(unsigned w) { return __uint_as_float(w << 16); }
DI float bfhi(unsigned w) { return __uint_as_float(w & 0xffff0000u); }
DI float rcpf_(float x) { return __builtin_amdgcn_rcpf(x); }
DI float sigmoidf_(float x) { return __builtin_amdgcn_rcpf(1.0f + __expf(-x)); }

template <int CTRL> DI float dpp_mov(float v) { return __builtin_bit_cast(float, __builtin_amdgcn_update_dpp(0, __builtin_bit_cast(int, v), CTRL, 0xf, 0xf, true)); }
DI float rdlane(float v, int l) { return __builtin_bit_cast(float, __builtin_amdgcn_readlane(__builtin_bit_cast(int, v), l)); }
DI float wave_sum(float v) {
    v += dpp_mov<0xB1>(v);
    v += dpp_mov<0x4E>(v);
    v += dpp_mov<0x141>(v);
    v += dpp_mov<0x140>(v);
    return (rdlane(v, 0) + rdlane(v, 16)) + (rdlane(v, 32) + rdlane(v, 48));
}
DI f32x4 mfma16(bf16x8 a, bf16x8 b, f32x4 c) { return __builtin_amdgcn_mfma_f32_16x16x32_bf16(a, b, c, 0, 0, 0); }
namespace pg8 {
constexpr int BM = 256, BK = 64, HALF = 128, HTB = HALF * BK * 2  , STAGE_BYTES = 8 * HTB, NXCD = 8, WGM = 8;

__host__ __device__ __forceinline__ int lds_byte(int r, int c) { const int st = (r >> 4) * 2 + (c >> 5), rr = r & 15, cc = c & 31, ob = rr * 64 + cc * 2; return st * 1024 + (ob ^ (((ob >> 9) & 1) << 5)); }
__host__ __device__ __forceinline__ void stage_rc(int b, int& R, int& C) { const int st = b / 1024, sb = b % 1024, swz = sb ^ (((sb >> 9) & 1) << 5); R = (st >> 1) * 16 + swz / 64; C = (st & 1) * 32 + (swz % 64) / 2; }
__host__ __device__ __forceinline__ int perm32(int rho) { const int n = rho >> 4, i = rho & 15; return 8 * (i >> 2) + 4 * n + (i & 3); }

struct Unit { int pm, pn, pb; };
struct Gemm { const bf16_t* A; const bf16_t* Bt; int M, N, K; };

struct StaticOrder {
    static constexpr bool GATHER = false;
    int nM, nN, nwg, G, c;
    __device__ __forceinline__ void init(int M, int N, int G_, int c_) { nM = M / BM; nN = N / BM; nwg = nM * nN; G = G_; c = c_; }
    __device__ __forceinline__ bool next(int i, Unit& u) const {
        const long L = (long)i * G + c; if (L >= nwg) return false;
        int wgid = (int)L; { const int q = nwg / NXCD, r = nwg % NXCD, xcd = wgid % NXCD, off = wgid / NXCD; wgid = (xcd < r ? xcd * (q + 1) : r * (q + 1) + (xcd - r) * q) + off; }
        const int nig = WGM * nN, gid = wgid / nig, fm = gid * WGM, gsz = (nM - fm) < WGM ? (nM - fm) : WGM;
        u.pm = fm + ((wgid % nig) % gsz); u.pn = (wgid % nig) / gsz; u.pb = u.pn; return true;
    }
};
struct GroupOrder : StaticOrder {
    const int* pexp;
    __device__ __forceinline__ bool next(int i, Unit& u) const {
        if (!StaticOrder::next(i, u)) return false;
        u.pb = __builtin_amdgcn_readfirstlane(pexp[u.pm]) * nN + u.pn; return true;
    }
};
struct GatherOrder : GroupOrder {
    static constexpr bool GATHER = true;
    const LAS int* tokL;
};

template <class Epi, class Sched, bool ALIGN_EPI = true, bool SP2 = true>
__device__ __forceinline__ void gemm_phase(LAS unsigned char* lds, const Gemm g, const Sched& S, const Epi& E, int tid_in) {
    const int tid = tid_in, wid = __builtin_amdgcn_readfirstlane(tid >> 6), lane = tid & 63, wr = wid >> 2, wc = wid & 3, fr = lane & 15, fq = lane >> 4;
    const int K = g.K, nt = K / BK;
    unsigned voffA[2], voffB[2];
#pragma unroll
    for (int i = 0; i < 2; ++i) { int R, C; stage_rc(tid * 16 + i * 8192, R, C); const int Rb = Epi::HEADS ? (64 * (R >> 5) + perm32(R & 31)) : Epi::PERM ? ((R & ~31) + perm32(R & 31)) : R;
        voffA[i] = (unsigned)(R * K + C) * 2u; voffB[i] = (unsigned)(Rb * K + C) * 2u; }
    unsigned goff[2][2] = {{0u, 0u}, {0u, 0u}}, goffN[2][2] = {{0u, 0u}, {0u, 0u}};
#define PG8_GOFF(dst, ui_) do { if constexpr (Sched::GATHER) { _Pragma("unroll") for (int h_ = 0; h_ < 2; ++h_) _Pragma("unroll") for (int i_ = 0; i_ < 2; ++i_) { int R_, C_; stage_rc(tid * 16 + i_ * 8192, R_, C_); \
        const int tk_ = S.tokL[(ui_) * 256 + 128 * h_ + R_]; dst[h_][i_] = (unsigned)(tk_ * K + C_) * 2u; } } } while (0)
#define PG8_STAGE_A(bufoff, kt, h, usenext) do { if constexpr (Sched::GATHER) { unsigned vo_[2] = { (usenext) ? goffN[h][0] : goff[h][0], (usenext) ? goffN[h][1] : goff[h][1] }; PG8_STAGE(bufoff, kt, vo_); } \
        else { PG8_STAGE(bufoff, (kt) + ((h) ? hstep : 0), voffA); } } while (0)
    const size_t kstep = (size_t)(BK * 2);
    const size_t hstep = (size_t)HALF * K * 2;
    const size_t hstepB = Epi::HEADS ? (size_t)32 * K * 2 : hstep;
    const size_t tstep = 2 * hstep;
    const unsigned ldsw = (unsigned)wid * 1024u;
    const int aoff = lds_byte(wr * 64 + fr, fq * 8), boff = lds_byte(wc * 32 + fr, fq * 8);
#define PG8_SA(b, h) (((b) * 2 + (h)) * HTB)
#define PG8_SB(b, h) ((4 + (b) * 2 + (h)) * HTB)
#define PG8_STAGE(bufoff, gbase, voff) do { _Pragma("unroll") for (int _i = 0; _i < 2; ++_i) \
        __builtin_amdgcn_global_load_lds((const unsigned*)((const char*)(gbase) + (voff)[_i]), (LAS unsigned*)(lds + (bufoff) + ldsw + _i * 8192), 16, 0, 0); } while (0)
#define PG8_LDA(dst, b, h) do { _Pragma("unroll") for (int m = 0; m < 4; ++m) _Pragma("unroll") for (int k = 0; k < 2; ++k) dst[m][k] = *(const LAS bf16x8*)(lds + PG8_SA(b, h) + aoff + m * 2048 + k * 1024); } while (0)
#define PG8_LDB(dst, b, h) do { _Pragma("unroll") for (int n = 0; n < 2; ++n) _Pragma("unroll") for (int k = 0; k < 2; ++k) dst[n][k] = *(const LAS bf16x8*)(lds + PG8_SB(b, h) + boff + n * 2048 + k * 1024); } while (0)
#define PG8_MMA(ai, bj, At, Bt) do { __builtin_amdgcn_s_setprio(1); _Pragma("unroll") for (int m = 0; m < 4; ++m) _Pragma("unroll") for (int n = 0; n < 2; ++n) _Pragma("unroll") for (int k = 0; k < 2; ++k) \
        acc[ai][bj][m][n] = __builtin_amdgcn_mfma_f32_16x16x32_bf16(Bt[n][k], At[m][k], acc[ai][bj][m][n], 0, 0, 0); __builtin_amdgcn_s_setprio(0); } while (0)
#define PG8_WAIT_V(n) asm volatile("s_waitcnt vmcnt(" #n ")" ::: "memory")
#define PG8_WAIT_L(n) asm volatile("s_waitcnt lgkmcnt(" #n ")" ::: "memory")
#define PG8_BAR __builtin_amdgcn_s_barrier()
#define PG8_SCHED __builtin_amdgcn_sched_barrier(0)
    Unit cur, nxt; int ui = 0;
    if (!S.next(0, cur)) return;
    f32x4 acc[2][2][4][2];
#pragma unroll
    for (int a = 0; a < 2; ++a)
#pragma unroll
        for (int b = 0; b < 2; ++b)
#pragma unroll
            for (int m = 0; m < 4; ++m)
#pragma unroll
                for (int n = 0; n < 2; ++n) acc[a][b][m][n] = (f32x4){0.f, 0.f, 0.f, 0.f};
    bf16x8 At[4][2], B0[2][2], B1[2][2];
    const char* cA = (const char*)g.A + (Sched::GATHER ? (size_t)0 : (size_t)cur.pm * tstep); const char* cB = (const char*)g.Bt + (size_t)cur.pb * tstep;
    PG8_GOFF(goff, 0);
    if constexpr (SP2) {
        PG8_STAGE(PG8_SB(0, 0), cB, voffB); PG8_STAGE(PG8_SB(0, 1), cB + hstepB, voffB); PG8_STAGE_A(PG8_SA(0, 0), cA, 0, false); PG8_STAGE_A(PG8_SA(0, 1), cA, 1, false);
        if (wr == 1) PG8_BAR;
        PG8_WAIT_V(2); PG8_BAR;
        PG8_STAGE(PG8_SB(1, 0), cB + kstep, voffB); PG8_STAGE_A(PG8_SA(1, 0), cA + kstep, 0, false); PG8_STAGE(PG8_SB(1, 1), cB + hstepB + kstep, voffB);
        PG8_WAIT_V(6); PG8_BAR;
    } else {
        PG8_STAGE(PG8_SB(0, 0), cB, voffB); PG8_STAGE_A(PG8_SA(0, 0), cA, 0, false); PG8_STAGE(PG8_SB(0, 1), cB + hstepB, voffB); PG8_STAGE_A(PG8_SA(0, 1), cA, 1, false);
        if (wr == 1) PG8_BAR;
        PG8_WAIT_V(4); PG8_BAR;
        PG8_STAGE(PG8_SB(1, 0), cB + kstep, voffB); PG8_STAGE_A(PG8_SA(1, 0), cA + kstep, 0, false); PG8_STAGE(PG8_SB(1, 1), cB + hstepB + kstep, voffB);
        PG8_WAIT_V(6); PG8_BAR;
    }
    for (;;) {
        const bool has_next = S.next(ui + 1, nxt);
        const char* nA = (has_next && !Sched::GATHER) ? (const char*)g.A + (size_t)nxt.pm * tstep : cA; const char* nB = has_next ? (const char*)g.Bt + (size_t)nxt.pb * tstep : cB;
        if constexpr (Sched::GATHER) { if (has_next) PG8_GOFF(goffN, ui + 1); else { goffN[0][0] = goff[0][0]; goffN[0][1] = goff[0][1]; goffN[1][0] = goff[1][0]; goffN[1][1] = goff[1][1]; } }
        for (int t = 0; t < nt; t += 2) {
            if constexpr (Epi::HAS_MID) { if (t == nt / 2) E.mid(acc, cur, wr, wc, fr, fq); }
            const bool last = (t == nt - 2);
            const char* a1 = cA + (size_t)(t + 1) * kstep;
            const char* a2 = last ? nA : cA + (size_t)(t + 2) * kstep; const char* b2 = last ? nB : cB + (size_t)(t + 2) * kstep;
            const char* a3 = a2 + kstep; const char* b3 = b2 + kstep;
            if constexpr (SP2) {
            PG8_LDB(B0, 0, 0); PG8_LDB(B1, 0, 1); PG8_SCHED; PG8_LDA(At, 0, 0); PG8_STAGE_A(PG8_SA(1, 1), a1, 1, false);
            PG8_WAIT_V(8); PG8_WAIT_L(0); PG8_BAR; PG8_MMA(0, 0, At, B0); PG8_MMA(0, 1, At, B1); PG8_BAR; PG8_SCHED;
            PG8_LDA(At, 0, 1); PG8_STAGE(PG8_SB(0, 0), b2, voffB); PG8_STAGE(PG8_SB(0, 1), b2 + hstepB, voffB); PG8_STAGE_A(PG8_SA(0, 0), a2, 0, last);
            PG8_WAIT_V(8); PG8_WAIT_L(0); PG8_BAR; PG8_MMA(1, 0, At, B0); PG8_MMA(1, 1, At, B1); PG8_BAR; PG8_SCHED;
            PG8_LDB(B0, 1, 0); PG8_LDB(B1, 1, 1); PG8_SCHED; PG8_LDA(At, 1, 0); PG8_STAGE_A(PG8_SA(0, 1), a2, 1, last);
            PG8_WAIT_V(8); PG8_WAIT_L(0); PG8_BAR; PG8_MMA(0, 0, At, B0); PG8_MMA(0, 1, At, B1); PG8_BAR; PG8_SCHED;
            PG8_LDA(At, 1, 1); PG8_STAGE(PG8_SB(1, 0), b3, voffB); PG8_STAGE(PG8_SB(1, 1), b3 + hstepB, voffB); PG8_STAGE_A(PG8_SA(1, 0), a3, 0, last);
            PG8_WAIT_V(8); PG8_WAIT_L(0); PG8_BAR; PG8_MMA(1, 0, At, B0); PG8_MMA(1, 1, At, B1); PG8_BAR; PG8_SCHED;
            } else {
            PG8_LDB(B0, 0, 0); PG8_SCHED; PG8_LDA(At, 0, 0); PG8_STAGE_A(PG8_SA(1, 1), a1, 1, false);
            PG8_WAIT_L(8); PG8_BAR; PG8_WAIT_L(0); PG8_MMA(0, 0, At, B0); PG8_BAR; PG8_SCHED;
            PG8_LDB(B1, 0, 1); PG8_STAGE(PG8_SB(0, 0), b2, voffB);
            PG8_BAR; PG8_WAIT_L(0); PG8_MMA(0, 1, At, B1); PG8_BAR;
            PG8_LDA(At, 0, 1); PG8_STAGE_A(PG8_SA(0, 0), a2, 0, last);
            PG8_BAR; PG8_WAIT_L(0); PG8_MMA(1, 0, At, B0); PG8_BAR; PG8_SCHED;
            PG8_STAGE(PG8_SB(0, 1), b2 + hstepB, voffB);
            PG8_WAIT_V(6); PG8_BAR; PG8_MMA(1, 1, At, B1); PG8_BAR;
            PG8_LDB(B0, 1, 0); PG8_SCHED; PG8_LDA(At, 1, 0); PG8_STAGE_A(PG8_SA(0, 1), a2, 1, last);
            PG8_WAIT_L(8); PG8_BAR; PG8_WAIT_L(0); PG8_MMA(0, 0, At, B0); PG8_BAR; PG8_SCHED;
            PG8_LDB(B1, 1, 1); PG8_STAGE(PG8_SB(1, 0), b3, voffB);
            PG8_BAR; PG8_WAIT_L(0); PG8_MMA(0, 1, At, B1); PG8_BAR;
            PG8_LDA(At, 1, 1); PG8_STAGE_A(PG8_SA(1, 0), a3, 0, last);
            PG8_BAR; PG8_WAIT_L(0); PG8_MMA(1, 0, At, B0); PG8_BAR; PG8_SCHED;
            PG8_STAGE(PG8_SB(1, 1), b3 + hstepB, voffB);
            PG8_WAIT_V(6); PG8_BAR; PG8_MMA(1, 1, At, B1); PG8_BAR;
            }
        }
        if constexpr (ALIGN_EPI) { if (wr == 0) PG8_BAR; }
        E(acc, cur, wr, wc, fr, fq);
        if (!has_next) break;
#pragma unroll
        for (int a = 0; a < 2; ++a)
#pragma unroll
            for (int b = 0; b < 2; ++b)
#pragma unroll
                for (int m = 0; m < 4; ++m)
#pragma unroll
                    for (int n = 0; n < 2; ++n) acc[a][b][m][n] = (f32x4){0.f, 0.f, 0.f, 0.f};
        cur = nxt; cA = nA; cB = nB; ++ui;
        if constexpr (Sched::GATHER) { goff[0][0] = goffN[0][0]; goff[0][1] = goffN[0][1]; goff[1][0] = goffN[1][0]; goff[1][1] = goffN[1][1]; }
        if constexpr (ALIGN_EPI) { if (wr == 1) PG8_BAR; }
    }
    PG8_WAIT_V(0);
    if constexpr (!ALIGN_EPI) { if (wr == 0) PG8_BAR; }
    PG8_BAR;
#undef PG8_SA
#undef PG8_GOFF
#undef PG8_STAGE_A
#undef PG8_SB
#undef PG8_STAGE
#undef PG8_LDA
#undef PG8_LDB
#undef PG8_MMA
#undef PG8_WAIT_V
#undef PG8_WAIT_L
#undef PG8_BAR
#undef PG8_SCHED
}
}
#define XB_TMO      128
#define XB_XCNT(j)  (256  + 64 * (j))
#define XB_XSUB(j)  (1280 + 64 * (j))
#define XB_XGEN(j)  (2304 + 64 * (j))
#define XB_TOP      3328
#define XB_TOPGEN   3392
#define XCD_BAR_WORDS 3456
#define XB_SPIN_CAP (1u << 18)

__device__ __forceinline__ unsigned xb_ld(unsigned* p)              { return __hip_atomic_load(p, __ATOMIC_RELAXED, __HIP_MEMORY_SCOPE_AGENT); }
__device__ __forceinline__ unsigned xb_add(unsigned* p, unsigned v) { return __hip_atomic_fetch_add(p, v, __ATOMIC_RELAXED, __HIP_MEMORY_SCOPE_AGENT); }
__device__ __forceinline__ unsigned xb_xcc_id() { return (unsigned)__builtin_amdgcn_s_getreg((3 << 11) | 20) & 0xFu; }
#define XB_SPIN(cond, bar) do { unsigned _sp = 0; while (cond) { __builtin_amdgcn_s_sleep(1); \
    if ((++_sp & 255u) == 0u) { if (xb_ld(&(bar)[XB_TMO])) break; if (_sp > XB_SPIN_CAP) { atomicAdd(&(bar)[XB_TMO], 1u); break; } } } } while (0)

struct XcdBarrier {
    unsigned* bar; unsigned x;
    volatile LAS unsigned* st;
};

__device__ __forceinline__ XcdBarrier xcd_barrier_post(unsigned* bar, volatile LAS unsigned* st) {
    XcdBarrier b; b.bar = bar; b.x = xb_xcc_id(); b.st = st;
    if (threadIdx.x == 0) (void)xb_add(&bar[XB_XCNT(b.x)], 1u);
    return b;
}
__device__ __forceinline__ void xcd_barrier_complete(unsigned* bar, unsigned x, unsigned& nloc, unsigned& nx) {
    const unsigned G = gridDim.x * gridDim.y * gridDim.z;
    unsigned sum, cnt, mine, sp = 0u;
    for (;;) {
        sum = 0u; cnt = 0u; mine = 0u;
#pragma unroll
        for (unsigned j = 0; j < 16; ++j) { const unsigned c = xb_ld(&bar[XB_XCNT(j)]); sum += c; cnt += (c > 0u) ? 1u : 0u; mine = (j == x) ? c : mine; }
        if (sum == G) break;
        __builtin_amdgcn_s_sleep(1);
        if ((++sp & 255u) == 0u) { if (xb_ld(&bar[XB_TMO])) break; if (sp > XB_SPIN_CAP) { atomicAdd(&bar[XB_TMO], 1u); break; } }
    }
    nloc = mine > 0u ? mine : 1u; nx = cnt > 0u ? cnt : 1u;
}

__device__ __forceinline__ void xcd_barrier(const XcdBarrier& b) {
    asm volatile("s_waitcnt vmcnt(0)" ::: "memory");
    __syncthreads();
    if (threadIdx.x == 0) {
        unsigned* bar = b.bar;
        __builtin_amdgcn_s_waitcnt(0);
        unsigned nloc = b.st[0], nx = b.st[1];
        if (nloc == 0u) { xcd_barrier_complete(bar, b.x, nloc, nx); b.st[0] = nloc; b.st[1] = nx; }
        const unsigned old = xb_add(&bar[XB_XSUB(b.x)], 1u);
        const unsigned gen = old / nloc;
        if (old + 1u == (gen + 1u) * nloc) {
            __builtin_amdgcn_fence(__ATOMIC_RELEASE, "agent");
            asm volatile("s_waitcnt vmcnt(0)" ::: "memory");
            const unsigned og = xb_add(&bar[XB_TOP], 1u);
            const unsigned tg = og / nx;
            if (og + 1u == (tg + 1u) * nx) xb_add(&bar[XB_TOPGEN], 1u);
            else XB_SPIN(xb_ld(&bar[XB_TOPGEN]) == tg, bar);
            __builtin_amdgcn_fence(__ATOMIC_ACQUIRE, "agent");
            xb_add(&bar[XB_XGEN(b.x)], 1u);
            asm volatile("s_waitcnt vmcnt(0)" ::: "memory");
        } else {
            XB_SPIN(xb_ld(&bar[XB_XGEN(b.x)]) == gen, bar);
            __builtin_amdgcn_fence(__ATOMIC_ACQUIRE, "agent");
            asm volatile("s_waitcnt vmcnt(0)" ::: "memory");
        }
    }
    __syncthreads();
}
constexpr int NB = 4, SEQ = 8192, DM = 1024, T = NB * SEQ;
constexpr int NH = 8, HD = 64, CW = 512;
constexpr int N_IN = 5120;
constexpr int NLAYER = 2;
constexpr int NEXP = 32, DEXP = 512;
constexpr int MOE_ROWS = 73728, MOE_PANELS = MOE_ROWS / 256;
constexpr int WCAT_ROWS = 5888;
constexpr int LO_W = 768;

constexpr size_t MiB = 1u << 20;
constexpr size_t WS_CTL = 0, CTL_ZERO_BYTES = 1 * MiB;
constexpr size_t WS_VF   = 1 * MiB;
constexpr size_t WS_TAB  = 33 * MiB;
constexpr size_t WS_WM   = 34 * MiB;
constexpr size_t WS_XN   = 50 * MiB;
constexpr size_t WS_RW   = 114 * MiB;
constexpr size_t WS_MO   = 114 * MiB;
constexpr size_t WS_LO   = 210 * MiB;
constexpr size_t WS_YRM  = 354 * MiB;
constexpr int YRM_LD = 1024;
constexpr size_t WS_SI   = 258 * MiB;
constexpr size_t WS_V1   = 418 * MiB;
constexpr size_t WS_G    = 450 * MiB;
constexpr size_t WS_YS   = 482 * MiB;
constexpr size_t WS_PO   = 418 * MiB;
constexpr size_t WS_PST  = 258 * MiB;
constexpr size_t WS_GA   = 418 * MiB;
constexpr size_t WS_H    = 290 * MiB;
constexpr size_t WS_SC1  = 482 * MiB;
constexpr size_t WS_SC2  = 114 * MiB;
constexpr size_t WS_SCT  = 290 * MiB;
constexpr size_t WS_WE   = 34 * MiB;
constexpr size_t WS_WD   = 98 * MiB;
constexpr size_t WS_AM   = 130 * MiB;
constexpr size_t WS_HM   = 274 * MiB;
constexpr size_t WS_YE   = 346 * MiB;
constexpr size_t WS_RT   = 490 * MiB;
constexpr size_t WS_END  = 556 * MiB;
constexpr size_t TB_KMEAN = 0;
constexpr size_t TB_KMEAN2 = 256 * 1024;
constexpr size_t TB_SEL   = 256 * 1024;
constexpr size_t RT_EID  = 0;
constexpr size_t RT_GATE = 256 * 1024;
constexpr size_t RT_ROW  = 512 * 1024;
constexpr size_t RT_GW   = 768 * 1024;
constexpr size_t RT_HIST = 1280 * 1024;
constexpr size_t RT_PEXP = 1408 * 1024;
constexpr size_t RT_TOK  = 1536 * 1024;
constexpr size_t WS_SEL  = 556 * MiB;
constexpr size_t WS_NEED = 558 * MiB;
constexpr int CW_BAR = 4096;

constexpr int RING_BYTES = 131072;
constexpr int LDS_BYTES = 163840;
constexpr int MISC_OFF = LDS_BYTES - 256;
struct Frame {
    LAS unsigned char* lds;
    int tid, lane, wave;
    int G, bid;
    const __attribute__((address_space(4))) unsigned char* ka;
    GAS float* out_g; GAS unsigned char* ws_g;
    DI float* outp() const { return (float*)out_g; }
    DI unsigned char* wsp() const { return (unsigned char*)ws_g; }
    DI const float* inp(int i) const { return (const float*)(*(const GAS float* const __attribute__((address_space(4)))*)(ka + 8 * i)); }
};
#define LDS_WAIT() asm volatile("s_waitcnt lgkmcnt(0)" ::: "memory")

DI void tr_item(const float* src, int ld, int k0, bf16_t* dst, int Kd, const float* sc, int mode, LAS float* scr, int lane) {
#pragma unroll 8
    for (int i = 0; i < 32; ++i) { const int kk = 2 * i + (lane >> 5);
        float v = src ? src[(size_t)(k0 + kk) * ld + (lane & 31)] : 0.f;
        if (mode == 1) v *= sc[k0 + kk]; else if (mode == 2) v *= (1.f - sc[k0 + kk]);
        scr[kk * 33 + (lane & 31)] = v; }
    LDS_WAIT(); asm volatile("" ::: "memory");
    const int c = lane & 7;
#pragma unroll
    for (int j = 0; j < 4; ++j) { const int n = (lane >> 3) + 8 * j; const LAS float* s = scr + (8 * c) * 33 + n;
        u32x4 o; o.x = pk2(s[0 * 33], s[1 * 33]); o.y = pk2(s[2 * 33], s[3 * 33]); o.z = pk2(s[4 * 33], s[5 * 33]); o.w = pk2(s[6 * 33], s[7 * 33]);
        *(u32x4*)(dst + (size_t)n * Kd + k0 + 8 * c) = o; }
    LDS_WAIT(); asm volatile("" ::: "memory");
}

constexpr size_t WM_WCAT = 0, WM_BRR = (size_t)WCAT_ROWS * 1024 * 2, WM_BRM = WM_BRR + 1024 * 512 * 2, WM_OUT = WM_BRM + 1024 * 512 * 2;
DI void phase_conv_mixer(Frame& F, int l) {
    LAS float* scr = (LAS float*)(F.lds + F.wave * 16384);
    const int gw = F.bid * 8 + F.wave, NGW = F.G * 8;
    bf16_t* wcat = (bf16_t*)(F.wsp() + WS_WM + WM_WCAT);
    const float* w_in = F.inp(3) + (size_t)l * DM * N_IN;
    const float* mu_x = F.inp(5) + (size_t)l * 3 * DM;
    constexpr int NBLK = WCAT_ROWS / 32;
    constexpr int I_CAT = NBLK * 16, I_BR = 8 * 32, I_OUT = 16 * 32;
    for (int it = gw; it < I_CAT + 2 * I_BR + I_OUT; it += NGW) {
        int r = it;
        if (r < I_CAT) {
            const int nb = r / 16, kb = r % 16, k0 = kb * 64;
            if (nb < 48) { tr_item(w_in + 32 * nb, N_IN, k0, wcat + (size_t)(32 * nb) * 1024, 1024, nullptr, 0, scr, F.lane); }
            else if (nb < 72) {
                const int q = nb - 48; const float* src = nullptr; int ld = 0; const float* sc = nullptr; int mode = 0;
                if (q < 4)       { src = F.inp(7)  + (size_t)l * DM * 64  + 32 * (q & 1); ld = 64;  sc = mu_x;          mode = (q < 2) ? 2 : 1; }
                else if (q < 8)  { src = F.inp(10) + (size_t)l * DM * 64  + 32 * (q & 1); ld = 64;  sc = mu_x + DM;     mode = (q < 6) ? 2 : 1; }
                else if (q < 16) { src = F.inp(12) + (size_t)l * DM * 128 + 32 * (q & 3); ld = 128; sc = mu_x + 2 * DM; mode = (q < 12) ? 2 : 1; }
                else if (q < 18 && l > 0) { src = F.inp(21) + (size_t)(l - 1) * DM * 32; ld = 32; sc = F.inp(19) + (size_t)(l - 1) * DM; mode = (q == 16) ? 2 : 1; }
                tr_item(src, ld, k0, wcat + (size_t)(1536 + 32 * q) * 1024, 1024, sc, mode, scr, F.lane);
            }
            else if (nb < 120) { tr_item(w_in + 1536 + 32 * (nb - 72), N_IN, k0, wcat + (size_t)(2304 + 32 * (nb - 72)) * 1024, 1024, nullptr, 0, scr, F.lane); }
            else { tr_item(w_in + 3072 + 32 * (nb - 120), N_IN, k0, wcat + (size_t)(3840 + 32 * (nb - 120)) * 1024, 1024, nullptr, 0, scr, F.lane); }
            continue;
        }
        r -= I_CAT;
        if (r < I_BR) { const int nb = r / 8, kb = r % 8; tr_item(F.inp(26) + (size_t)l * 512 * 1024 + 32 * nb, 1024, kb * 64, (bf16_t*)(F.wsp() + WS_WM + WM_BRR) + (size_t)(32 * nb) * 1024, 1024, nullptr, 0, scr, F.lane); continue; }
        r -= I_BR;
        if (r < I_BR) { const int nb = r / 8, kb = r % 8; tr_item(F.inp(27) + (size_t)l * 512 * 1024 + 32 * nb, 1024, kb * 64, (bf16_t*)(F.wsp() + WS_WM + WM_BRR) + (size_t)(32 * nb) * 1024 + 512, 1024, nullptr, 0, scr, F.lane); continue; }
        r -= I_BR;
        { const int nb = r / 16, kb = r % 16; tr_item(F.inp(28) + (size_t)l * 1024 * 1024 + 32 * nb, 1024, kb * 64, (bf16_t*)(F.wsp() + WS_WM + WM_OUT) + (size_t)(32 * nb) * 1024, 1024, nullptr, 0, scr, F.lane); }
    }
}
DI void tr_block(const float* src, int ld, int k0, int n0, bf16_t* dstbase, int Kd, int mode, LAS float* scr, int tid) {
#pragma unroll
    for (int i = 0; i < 8; ++i) { const int idx = tid + 512 * i, row = idx >> 6, c4 = idx & 63;
        const f32x4 v = *(const f32x4*)(src + (size_t)(k0 + row) * ld + n0 + 4 * c4);
        LAS float* d = scr + row * 257 + 4 * c4; d[0] = v.x; d[1] = v.y; d[2] = v.z; d[3] = v.w; }
    __syncthreads();
#pragma unroll
    for (int i = 0; i < 4; ++i) { const int idx = tid + 512 * i, n = idx >> 3, c = idx & 7; const LAS float* sp = scr + (8 * c) * 257 + n;
        u32x4 o; o.x = pk2(sp[0], sp[257]); o.y = pk2(sp[2 * 257], sp[3 * 257]); o.z = pk2(sp[4 * 257], sp[5 * 257]); o.w = pk2(sp[6 * 257], sp[7 * 257]);
        const int h = n0 + n; const int drow = (mode == 2) ? h : ((h >> 7) * 256 + mode * 128 + (h & 127));
        *(u32x4*)(dstbase + (size_t)drow * Kd + k0 + 8 * c) = o; }
    __syncthreads();
}
DI void phase_conv_experts(Frame& F, int l) {
    LAS float* scr = (LAS float*)F.lds;
    bf16_t* we = (bf16_t*)(F.wsp() + WS_WE); bf16_t* wd = (bf16_t*)(F.wsp() + WS_WD);
    const float* wg = F.inp(33) + (size_t)l * NEXP * DM * DEXP; const float* wu = F.inp(34) + (size_t)l * NEXP * DM * DEXP; const float* wdn = F.inp(35) + (size_t)l * NEXP * DEXP * DM;
    __syncthreads();
    for (int it = F.bid; it < NEXP * 96; it += F.G) {
        const int e = it / 96; int r = it % 96;
        if (r < 64) { const int up = r >> 5; r &= 31; const int kb = r >> 1, nb = r & 1;
            tr_block((up ? wu : wg) + (size_t)e * DM * DEXP, DEXP, kb * 64, nb * 256, we + (size_t)e * 1024 * 1024, 1024, up, scr, F.tid); }
        else { r -= 64; const int kb = r >> 2, nb = r & 3;
            tr_block(wdn + (size_t)e * DEXP * DM, DM, kb * 64, nb * 256, wd + (size_t)e * 1024 * 512, 512, 2, scr, F.tid); }
    }
}
DI void rms_row_to_bf16(const float* xrow, const float* gain, bf16_t* o0, bf16_t* o1, int lane) {
    const f32x4* xr = (const f32x4*)xrow + lane; const f32x4* gr = (const f32x4*)gain + lane;
    f32x4 v[4]; float s = 0.f;
#pragma unroll
    for (int j = 0; j < 4; ++j) { v[j] = xr[64 * j]; s += (v[j].x * v[j].x + v[j].y * v[j].y) + (v[j].z * v[j].z + v[j].w * v[j].w); }
    const float rs = 1.0f / sqrtf(wave_sum(s) * (1.f / DM) + 1e-6f);
#pragma unroll
    for (int j = 0; j < 4; ++j) { const f32x4 g = gr[64 * j]; const f32x4 y = v[j] * rs * g;
        u32x2 w; w.x = pk2(y.x, y.y); w.y = pk2(y.z, y.w);
        *((u32x2*)o0 + lane + 64 * j) = w; if (o1) *((u32x2*)o1 + lane + 64 * j) = w; }
}
DI void phase_norm_x(Frame& F, const float* x, const float* gain) {
    const int gw = F.bid * 8 + F.wave, NGW = F.G * 8; bf16_t* xn = (bf16_t*)(F.wsp() + WS_XN);
    for (int m = gw; m < T; m += NGW) rms_row_to_bf16(x + (size_t)m * DM, gain, xn + (size_t)m * DM, nullptr, F.lane);
}

namespace pg8 {
struct EpiStore {
    static constexpr bool PERM = true, HAS_MID = false, HEADS = false;
    bf16_t* O; int ldc; int split; bf16_t* O2; int ldc2; int act;
    __device__ __forceinline__ void operator()(const f32x4 (&acc)[2][2][4][2], const Unit& u, int wr, int wc, int fr, int fq) const {
        const int row0 = u.pm * BM + wr * 64 + fr; int colt = u.pn * BM; bf16_t* base = O; int ld = ldc;
        if (split && colt >= split) { base = O2; ld = ldc2; colt -= split; }
        const int col0 = colt + wc * 32 + 8 * fq;
#pragma unroll
        for (int ai = 0; ai < 2; ++ai)
#pragma unroll
            for (int m = 0; m < 4; ++m) { bf16_t* rowp = base + (size_t)(row0 + ai * HALF + m * 16) * ld + col0;
#pragma unroll
                for (int bj = 0; bj < 2; ++bj) { f32x4 v0 = acc[ai][bj][m][0], v1 = acc[ai][bj][m][1];
                    if (act == 1) {
#pragma unroll
                        for (int j = 0; j < 4; ++j) { v0[j] = sigmoidf_(v0[j]); v1[j] = sigmoidf_(v1[j]); } }
                    u32x4 w; w.x = pk2(v0[0], v0[1]); w.y = pk2(v0[2], v0[3]); w.z = pk2(v1[0], v1[1]); w.w = pk2(v1[2], v1[3]);
                    *(u32x4*)(rowp + bj * HALF) = w; } }
    }
};
struct EpiBranch {
    static constexpr bool PERM = true, HAS_MID = false, HEADS = false;
    bf16_t* Hout; const bf16_t* gate; int gcol0; int first;
    __device__ __forceinline__ void operator()(const f32x4 (&acc)[2][2][4][2], const Unit& u, int wr, int wc, int fr, int fq) const {
        const int row0 = u.pm * BM + wr * 64 + fr; const int col0 = u.pn * BM + wc * 32 + 8 * fq;
#pragma unroll
        for (int ai = 0; ai < 2; ++ai)
#pragma unroll
            for (int m = 0; m < 4; ++m) { const size_t row = (size_t)(row0 + ai * HALF + m * 16);
#pragma unroll
                for (int bj = 0; bj < 2; ++bj) {
                    const u32x4 gv = *(const u32x4*)(gate + row * 2048 + gcol0 + col0 + bj * HALF);
                    bf16_t* hp = Hout + row * 1024 + col0 + bj * HALF;
                    f32x4 v0 = acc[ai][bj][m][0], v1 = acc[ai][bj][m][1];
                    v0[0] *= bflo(gv.x); v0[1] *= bfhi(gv.x); v0[2] *= bflo(gv.y); v0[3] *= bfhi(gv.y);
                    v1[0] *= bflo(gv.z); v1[1] *= bfhi(gv.z); v1[2] *= bflo(gv.w); v1[3] *= bfhi(gv.w);
                    if (!first) { const u32x4 hv = *(const u32x4*)hp;
                        v0[0] += bflo(hv.x); v0[1] += bfhi(hv.x); v0[2] += bflo(hv.y); v0[3] += bfhi(hv.y);
                        v1[0] += bflo(hv.z); v1[1] += bfhi(hv.z); v1[2] += bflo(hv.w); v1[3] += bfhi(hv.w); }
                    u32x4 w; w.x = pk2(v0[0], v0[1]); w.y = pk2(v0[2], v0[3]); w.z = pk2(v1[0], v1[1]); w.w = pk2(v1[2], v1[3]);
                    *(u32x4*)hp = w; } }
    }
};
struct EpiBranch2 {
    static constexpr bool PERM = true, HAS_MID = true, HEADS = false;
    bf16_t* Hout; const bf16_t* gate;
    __device__ __forceinline__ void mid(f32x4 (&acc)[2][2][4][2], const Unit& u, int wr, int wc, int fr_, int fq_) const {
        int fr = fr_, fq = fq_; asm volatile("" : "+v"(fr), "+v"(fq));
        const int row0 = u.pm * BM + wr * 64 + fr; const int col0 = u.pn * BM + wc * 32 + 8 * fq;
#pragma unroll
        for (int ai = 0; ai < 2; ++ai)
#pragma unroll
            for (int m = 0; m < 4; ++m) { const size_t row = (size_t)(row0 + ai * HALF + m * 16);
#pragma unroll
                for (int bj = 0; bj < 2; ++bj) {
                    const u32x4 gr = *(const u32x4*)(gate + row * 2048 + col0 + bj * HALF), gm = *(const u32x4*)(gate + row * 2048 + 1024 + col0 + bj * HALF);
                    const unsigned grw[4] = {gr.x, gr.y, gr.z, gr.w}, gmw[4] = {gm.x, gm.y, gm.z, gm.w};
#pragma unroll
                    for (int q = 0; q < 4; ++q) { const float r0 = bflo(grw[q]) * __builtin_amdgcn_rcpf(fmaxf(bflo(gmw[q]), 1e-30f)), r1 = bfhi(grw[q]) * __builtin_amdgcn_rcpf(fmaxf(bfhi(gmw[q]), 1e-30f));
                        acc[ai][bj][m][q >> 1][2 * (q & 1)] *= r0; acc[ai][bj][m][q >> 1][2 * (q & 1) + 1] *= r1; } }
                asm volatile("" ::: "memory"); }
    }
    __device__ __forceinline__ void operator()(const f32x4 (&acc)[2][2][4][2], const Unit& u, int wr, int wc, int fr, int fq) const {
        const int row0 = u.pm * BM + wr * 64 + fr; const int col0 = u.pn * BM + wc * 32 + 8 * fq;
#pragma unroll
        for (int ai = 0; ai < 2; ++ai)
#pragma unroll
            for (int m = 0; m < 4; ++m) { const size_t row = (size_t)(row0 + ai * HALF + m * 16);
#pragma unroll
                for (int bj = 0; bj < 2; ++bj) {
                    const u32x4 gm = *(const u32x4*)(gate + row * 2048 + 1024 + col0 + bj * HALF);
                    f32x4 v0 = acc[ai][bj][m][0], v1 = acc[ai][bj][m][1];
                    v0[0] *= fmaxf(bflo(gm.x), 1e-30f); v0[1] *= fmaxf(bfhi(gm.x), 1e-30f); v0[2] *= fmaxf(bflo(gm.y), 1e-30f); v0[3] *= fmaxf(bfhi(gm.y), 1e-30f);
                    v1[0] *= fmaxf(bflo(gm.z), 1e-30f); v1[1] *= fmaxf(bfhi(gm.z), 1e-30f); v1[2] *= fmaxf(bflo(gm.w), 1e-30f); v1[3] *= fmaxf(bfhi(gm.w), 1e-30f);
                    u32x4 w; w.x = pk2(v0[0], v0[1]); w.y = pk2(v0[2], v0[3]); w.z = pk2(v1[0], v1[1]); w.w = pk2(v1[2], v1[3]);
                    *(u32x4*)(Hout + row * 1024 + col0 + bj * HALF) = w; } }
    }
};
struct EpiMoba {
    static constexpr bool PERM = true, HAS_MID = false, HEADS = true;
    bf16_t* MO; const float* qgain; const float* kgain; float* KM; int km_half;
    __device__ __forceinline__ void operator()(const f32x4 (&acc)[2][2][4][2], const Unit& u, int wr, int wc, int fr, int fq) const {
        const int row0 = u.pm * BM + wr * 64 + fr; const int kind = u.pn >> 1; const int colb = u.pn * BM + 64 * wc + 8 * fq;
        if (kind == 2) {
#pragma unroll
            for (int ai = 0; ai < 2; ++ai)
#pragma unroll
                for (int m = 0; m < 4; ++m) { bf16_t* rowp = MO + (size_t)(row0 + ai * HALF + m * 16) * 1536 + colb;
#pragma unroll
                    for (int bj = 0; bj < 2; ++bj) { const f32x4 v0 = acc[ai][bj][m][0], v1 = acc[ai][bj][m][1];
                        u32x4 w; w.x = pk2(v0[0], v0[1]); w.y = pk2(v0[2], v0[3]); w.z = pk2(v1[0], v1[1]); w.w = pk2(v1[2], v1[3]); *(u32x4*)(rowp + 32 * bj) = w; } }
            return;
        }
        const float* gp = (kind == 0 ? qgain : kgain) + 8 * fq; const float gs = (kind == 0) ? 0.125f : 1.0f;
        f32x4 gn[2][2];
#pragma unroll
        for (int bj = 0; bj < 2; ++bj)
#pragma unroll
            for (int n = 0; n < 2; ++n) gn[bj][n] = *(const f32x4*)(gp + 32 * bj + 4 * n) * gs;
        f32x4 cs[2][2];
#pragma unroll
        for (int bj = 0; bj < 2; ++bj)
#pragma unroll
            for (int n = 0; n < 2; ++n) cs[bj][n] = (f32x4){0.f, 0.f, 0.f, 0.f};
#pragma unroll
        for (int ai = 0; ai < 2; ++ai)
#pragma unroll
            for (int m = 0; m < 4; ++m) { float ss = 0.f;
#pragma unroll
                for (int bj = 0; bj < 2; ++bj)
#pragma unroll
                    for (int n = 0; n < 2; ++n) { const f32x4 x = acc[ai][bj][m][n]; ss += (x[0] * x[0] + x[1] * x[1]) + (x[2] * x[2] + x[3] * x[3]); }
                ss += __shfl_xor(ss, 16); ss += __shfl_xor(ss, 32);
                const float rs = __builtin_amdgcn_rsqf(ss * (1.f / 64.f) + 1e-6f);
                bf16_t* rowp = MO + (size_t)(row0 + ai * HALF + m * 16) * 1536 + colb;
#pragma unroll
                for (int bj = 0; bj < 2; ++bj) { const f32x4 v0 = acc[ai][bj][m][0] * rs * gn[bj][0], v1 = acc[ai][bj][m][1] * rs * gn[bj][1];
                    cs[bj][0] += v0; cs[bj][1] += v1;
                    u32x4 w; w.x = pk2(v0[0], v0[1]); w.y = pk2(v0[2], v0[3]); w.z = pk2(v1[0], v1[1]); w.w = pk2(v1[2], v1[3]); *(u32x4*)(rowp + 32 * bj) = w; }
                asm volatile("" : "+v"(cs[0][0]), "+v"(cs[0][1]), "+v"(cs[1][0]), "+v"(cs[1][1]));
            }
        if (kind == 1) {
#pragma unroll
            for (int bj = 0; bj < 2; ++bj)
#pragma unroll
                for (int n = 0; n < 2; ++n) { f32x4 t = cs[bj][n];
#pragma unroll
                    for (int j = 0; j < 4; ++j) { float v = t[j]; v += dpp_mov<0xB1>(v); v += dpp_mov<0x4E>(v); v += dpp_mov<0x141>(v); v += dpp_mov<0x140>(v); t[j] = v * (1.f / 256.f); }
                    if (fr == 0) *(f32x4*)(KM + (size_t)wr * km_half + (size_t)u.pm * 512 + (u.pn * BM - 512) + 64 * wc + 32 * bj + 8 * fq + 4 * n) = t; }
        }
    }
};
struct EpiResid {
    static constexpr bool PERM = false, HAS_MID = false, HEADS = false;
    const float* xin; float* out;
    __device__ __forceinline__ void operator()(const f32x4 (&acc)[2][2][4][2], const Unit& u, int wr, int wc, int fr, int fq) const {
        const int row0 = u.pm * BM + wr * 64 + fr, col0 = u.pn * BM + wc * 32 + 4 * fq;
#pragma unroll
        for (int ai = 0; ai < 2; ++ai)
#pragma unroll
            for (int m = 0; m < 4; ++m) { const size_t off = (size_t)(row0 + ai * HALF + m * 16) * 1024 + col0;
#pragma unroll
                for (int bj = 0; bj < 2; ++bj)
#pragma unroll
                    for (int n = 0; n < 2; ++n) { const f32x4 xv = *(const f32x4*)(xin + off + bj * HALF + n * 16); *(f32x4*)(out + off + bj * HALF + n * 16) = xv + acc[ai][bj][m][n]; } }
    }
};
struct EpiExpertUp {
    static constexpr bool PERM = true, HAS_MID = false, HEADS = false;
    bf16_t* HM; const float* gw;
    __device__ __forceinline__ void operator()(const f32x4 (&acc)[2][2][4][2], const Unit& u, int wr, int wc, int fr, int fq) const {
        const int row0 = u.pm * BM + wr * 64 + fr; const int col0 = u.pn * 128 + wc * 32 + 8 * fq;
#pragma unroll
        for (int ai = 0; ai < 2; ++ai)
#pragma unroll
            for (int m = 0; m < 4; ++m) { const size_t row = (size_t)(row0 + ai * HALF + m * 16); const float gwt = gw[row];
                f32x4 v0, v1;
#pragma unroll
                for (int j = 0; j < 4; ++j) { const float g0 = acc[ai][0][m][0][j], g1 = acc[ai][0][m][1][j];
                    v0[j] = g0 * sigmoidf_(g0) * acc[ai][1][m][0][j] * gwt; v1[j] = g1 * sigmoidf_(g1) * acc[ai][1][m][1][j] * gwt; }
                u32x4 w; w.x = pk2(v0[0], v0[1]); w.y = pk2(v0[2], v0[3]); w.z = pk2(v1[0], v1[1]); w.w = pk2(v1[2], v1[3]);
                *(u32x4*)(HM + row * 512 + col0) = w; }
    }
};
}
constexpr size_t SI_PLANE = (size_t)T * CW * 2;
DI float softplusf_(float z) { return fmaxf(z, 0.f) + __logf(1.0f + __expf(-fabsf(z))); }

DI void phase_rwkv_prep(Frame& F, int l) {
    LAS float* act = (LAS float*)F.lds;
    const bf16_t* RW = (const bf16_t*)(F.wsp() + WS_RW); const bf16_t* LO = (const bf16_t*)(F.wsp() + WS_LO);
    bf16_t* SIr = (bf16_t*)(F.wsp() + WS_SI); bf16_t* SIw = SIr + (size_t)T * CW; bf16_t* SIk = SIw + (size_t)T * CW; bf16_t* SIa = SIk + (size_t)T * CW; bf16_t* SIb = SIa + (size_t)T * CW;
    bf16_t* VF = (bf16_t*)(F.wsp() + WS_VF); bf16_t* V1 = (bf16_t*)(F.wsp() + WS_V1); bf16_t* Gb = (bf16_t*)(F.wsp() + WS_G);
    int c = F.tid;
    const float* w2 = F.inp(8) + (size_t)l * 64 * CW; const float* a2 = F.inp(11) + (size_t)l * 64 * CW; const float* g2 = F.inp(13) + (size_t)l * 128 * CW;
    const float* v2 = F.inp(22);
    const float mu_r = F.inp(4)[(size_t)l * 3 * CW + c], mu_k = F.inp(4)[(size_t)l * 3 * CW + CW + c], mu_v = F.inp(4)[(size_t)l * 3 * CW + 2 * CW + c];
    const float w0c = F.inp(6)[l * CW + c], a0c = F.inp(9)[l * CW + c], kkc = F.inp(14)[l * CW + c], kac = F.inp(15)[l * CW + c];
    const float v0c = l > 0 ? F.inp(20)[c] : 0.f;
    for (int tile = F.bid; tile < T / 8; tile += F.G) {
        int t0 = tile * 8; asm volatile("" : "+s"(t0), "+v"(c));
        __syncthreads();
        for (int idx = F.tid; idx < 8 * 288; idx += 512) {
            const int tt = idx / 288, j = idx - tt * 288; const int t = t0 + tt; const bool has_prev = (t % SEQ) != 0;
            int pj, qj;
            if (j < 64) { pj = j; qj = 64 + j; } else if (j < 128) { pj = 128 + (j - 64); qj = 192 + (j - 64); } else if (j < 256) { pj = 256 + (j - 128); qj = 384 + (j - 128); } else { pj = 512 + (j - 256); qj = 544 + (j - 256); }
            float v = bf2f(LO[(size_t)t * LO_W + pj]); if (has_prev) v += bf2f(LO[(size_t)(t - 1) * LO_W + qj]);
            if (j < 64) v = tanhf(v); else if (j >= 128 && j < 256) v = sigmoidf_(v);
            act[j * 8 + tt] = v;
        }
        __syncthreads();
        float aw[8], aa[8], ag[8], av[8];
#pragma unroll
        for (int i = 0; i < 8; ++i) { aw[i] = 0.f; aa[i] = 0.f; ag[i] = 0.f; av[i] = 0.f; }
        for (int j = 0; j < 64; ++j) { const float w = w2[j * CW + c]; const LAS f32x4* ap = (const LAS f32x4*)(act + j * 8);
#pragma unroll
            for (int q = 0; q < 2; ++q) { const f32x4 x = ap[q]; aw[4 * q] += x.x * w; aw[4 * q + 1] += x.y * w; aw[4 * q + 2] += x.z * w; aw[4 * q + 3] += x.w * w; } }
        for (int j = 0; j < 64; ++j) { const float w = a2[j * CW + c]; const LAS f32x4* ap = (const LAS f32x4*)(act + (64 + j) * 8);
#pragma unroll
            for (int q = 0; q < 2; ++q) { const f32x4 x = ap[q]; aa[4 * q] += x.x * w; aa[4 * q + 1] += x.y * w; aa[4 * q + 2] += x.z * w; aa[4 * q + 3] += x.w * w; } }
        for (int j = 0; j < 128; ++j) { const float w = g2[j * CW + c]; const LAS f32x4* ap = (const LAS f32x4*)(act + (128 + j) * 8);
#pragma unroll
            for (int q = 0; q < 2; ++q) { const f32x4 x = ap[q]; ag[4 * q] += x.x * w; ag[4 * q + 1] += x.y * w; ag[4 * q + 2] += x.z * w; ag[4 * q + 3] += x.w * w; } }
        if (l > 0) for (int j = 0; j < 32; ++j) { const float w = v2[j * CW + c]; const LAS f32x4* ap = (const LAS f32x4*)(act + (256 + j) * 8);
#pragma unroll
            for (int q = 0; q < 2; ++q) { const f32x4 x = ap[q]; av[4 * q] += x.x * w; av[4 * q + 1] += x.y * w; av[4 * q + 2] += x.z * w; av[4 * q + 3] += x.w * w; } }
#pragma unroll
        for (int tt = 0; tt < 8; ++tt) {
            const int t = t0 + tt; const bool has_prev = (t % SEQ) != 0; const size_t ro = (size_t)t * 1536;
            const float rp = bf2f(RW[ro + c]), kp = bf2f(RW[ro + 512 + c]), vp = bf2f(RW[ro + 1024 + c]);
            float rq = 0.f, kq = 0.f, vq = 0.f;
            if (has_prev) { rq = bf2f(RW[ro - 1536 + c]); kq = bf2f(RW[ro - 1536 + 512 + c]); vq = bf2f(RW[ro - 1536 + 1024 + c]); }
            const float r = rp + (rq - rp) * mu_r, k = kp + (kq - kp) * mu_k; float v = vp + (vq - vp) * mu_v;
            const float wl = -softplusf_(-(w0c + aw[tt])) - 0.5f;
            const float lw = -__expf(wl);
            const float alr = sigmoidf_(a0c + aa[tt]);
            const size_t o = (size_t)t * CW + c;
            if (l > 0) { const float vf = bf2f(VF[o]); v = v + (vf - v) * sigmoidf_(v0c + av[tt]); V1[o] = f2bf(v); } else { VF[o] = f2bf(v); }
            float kk = k * kkc; const float nrm = sqrtf(wave_sum(kk * kk)); kk = kk / fmaxf(nrm, 1e-12f);
            const float k2 = k * (1.f + (alr - 1.f) * kac);
            SIr[o] = f2bf(r); SIw[o] = f2bf(lw); SIk[o] = f2bf(k2); SIa[o] = f2bf(kk); SIb[o] = f2bf(kk * alr); Gb[o] = f2bf(ag[tt]);
            asm volatile("" ::: "memory");
        }
    }
}

DI void phase_rwkv_scan_naive(Frame& F, int l) {
    LAS float* Lr = (LAS float*)F.lds; LAS float* Lw = Lr + 4096; LAS float* Lk = Lw + 4096; LAS float* La = Lk + 4096; LAS float* Lb = La + 4096;
    LAS float* Lv = Lb + 4096; LAS float* Ly = Lv + 512;
    const bf16_t* SIr = (const bf16_t*)(F.wsp() + WS_SI); const bf16_t* SIw = SIr + (size_t)T * CW; const bf16_t* SIk = SIw + (size_t)T * CW; const bf16_t* SIa = SIk + (size_t)T * CW; const bf16_t* SIb = SIa + (size_t)T * CW;
    const bf16_t* V = (const bf16_t*)(F.wsp() + (l > 0 ? WS_V1 : WS_VF)); float* YS = (float*)(F.wsp() + WS_YS);
    for (int u = F.bid; u < 256; u += F.G) {
        const int b = u >> 6, h = (u >> 3) & 7, rg = u & 7;
        float S = 0.f;
        for (int ch = 0; ch < SEQ / 64; ++ch) {
            const size_t tb = (size_t)b * SEQ + ch * 64;
            __syncthreads();
            for (int idx = F.tid; idx < 4096; idx += 512) { const int s = idx >> 6, kx = idx & 63; const size_t o = (tb + s) * CW + h * 64 + kx;
                Lr[idx] = bf2f(SIr[o]); Lw[idx] = __expf(bf2f(SIw[o])); Lk[idx] = bf2f(SIk[o]); La[idx] = -bf2f(SIa[o]); Lb[idx] = bf2f(SIb[o]); }
            { const int s = F.tid >> 3, rr = F.tid & 7; Lv[F.tid] = bf2f(V[(tb + s) * CW + h * 64 + rg * 8 + rr]); }
            __syncthreads();
#pragma unroll 4
            for (int s = 0; s < 64; ++s) {
                const float a = La[s * 64 + F.lane], w = Lw[s * 64 + F.lane], bb = Lb[s * 64 + F.lane], kk = Lk[s * 64 + F.lane], r = Lr[s * 64 + F.lane], v = Lv[s * 8 + F.wave];
                const float sa = wave_sum(S * a);
                S = S * w + sa * bb + v * kk;
                const float y = wave_sum(S * r);
                if (F.lane == 0) Ly[s * 8 + F.wave] = y;
            }
            __syncthreads();
            { const int s = F.tid >> 3, rr = F.tid & 7; YS[(tb + s) * CW + h * 64 + rg * 8 + rr] = Ly[F.tid]; }
        }
    }
}

DI void phase_rwkv_post(Frame& F, int l) {
    const float* YS = (const float*)(F.wsp() + WS_YS);
    const bf16_t* SIr = (const bf16_t*)(F.wsp() + WS_SI); const bf16_t* SIk = SIr + 2 * (size_t)T * CW;
    const bf16_t* V = (const bf16_t*)(F.wsp() + (l > 0 ? WS_V1 : WS_VF)); const bf16_t* Gb = (const bf16_t*)(F.wsp() + WS_G); bf16_t* YR = (bf16_t*)(F.wsp() + WS_YRM);
    const int c = F.tid; const float lg = F.inp(17)[l * CW + c], lb = F.inp(18)[l * CW + c], rk = F.inp(16)[l * CW + c];
    for (int t = F.bid; t < T; t += F.G) {
        const size_t o = (size_t)t * CW + c;
        const float y = YS[o]; const float mean = wave_sum(y) * (1.f / 64.f); const float d = y - mean; const float var = wave_sum(d * d) * (1.f / 64.f);
        const float yn = d * (1.0f / sqrtf(var + 64e-5f)) * lg + lb;
        const float r = bf2f(SIr[o]), k = bf2f(SIk[o]), v = bf2f(V[o]);
        const float bonus = wave_sum(r * k * rk) * v;
        YR[o] = f2bf((yn + bonus) * bf2f(Gb[o]));
    }
}

#ifndef PREP_DUP
#define PREP_DUP 0
#endif
constexpr int ACT_P = 592;
constexpr size_t WM_L2T = (size_t)WCAT_ROWS * 1024 * 2 + 2 * 1024 * 512 * 2 + 1024 * 1024 * 2;
DI void phase_conv_lora2(Frame& F, int l) {
    bf16_t* L2T = (bf16_t*)(F.wsp() + WS_WM + WM_L2T);
    const float* w2 = F.inp(8) + (size_t)l * 64 * CW; const float* a2 = F.inp(11) + (size_t)l * 64 * CW; const float* g2 = F.inp(13) + (size_t)l * 128 * CW; const float* v2 = F.inp(22);
    for (int idx = F.bid * 512 + F.tid; idx < 288 * CW; idx += F.G * 512) { const int j = idx >> 9, c = idx & 511;
        float v;
        if (j < 64) v = w2[j * CW + c]; else if (j < 128) v = a2[(j - 64) * CW + c]; else if (j < 256) v = g2[(j - 128) * CW + c]; else v = (l > 0) ? v2[(j - 256) * CW + c] : 0.f;
        L2T[c * 288 + j] = f2bf(v); }
}
DI float row16_sum(float v) { v += dpp_mov<0xB1>(v); v += dpp_mov<0x4E>(v); v += dpp_mov<0x141>(v); v += dpp_mov<0x140>(v); return v; }
DI void phase_rwkv_prep2(Frame& F, int l, int tile_lo, int tile_hi, int tile_step, bool init) {
    LAS unsigned char* act = F.lds;
    LAS float* PRM = (LAS float*)(F.lds + 139264);
    const bf16_t* RW = (const bf16_t*)(F.wsp() + WS_RW); const bf16_t* LO = (const bf16_t*)(F.wsp() + WS_LO); const unsigned char* L2T = F.wsp() + WS_WM + WM_L2T;
    bf16_t* SIr = (bf16_t*)(F.wsp() + WS_SI); bf16_t* SIw = SIr + (size_t)T * CW; bf16_t* SIk = SIw + (size_t)T * CW; bf16_t* SIa = SIk + (size_t)T * CW; bf16_t* SIb = SIa + (size_t)T * CW;
    bf16_t* VF = (bf16_t*)(F.wsp() + WS_VF); bf16_t* V1 = (bf16_t*)(F.wsp() + WS_V1); bf16_t* Gb = (bf16_t*)(F.wsp() + WS_G);
    const int lane = F.lane, r16 = lane & 15, g = lane >> 4;
    if (init) { __syncthreads();
      const int c = F.tid;
      PRM[c] = F.inp(4)[(size_t)l * 3 * CW + c]; PRM[512 + c] = F.inp(4)[(size_t)l * 3 * CW + CW + c]; PRM[1024 + c] = F.inp(4)[(size_t)l * 3 * CW + 2 * CW + c];
      PRM[1536 + c] = F.inp(6)[l * CW + c]; PRM[2048 + c] = F.inp(9)[l * CW + c]; PRM[2560 + c] = F.inp(14)[l * CW + c]; PRM[3072 + c] = F.inp(15)[l * CW + c]; PRM[3584 + c] = l > 0 ? F.inp(20)[c] : 0.f; }
    for (int tile = tile_lo; tile < tile_hi; tile += tile_step) {
        int t0 = tile * 64; asm volatile("" : "+s"(t0));
        __syncthreads();
        for (int dup1_ = 0; dup1_ < ((PREP_DUP & 1) ? 2 : 1); ++dup1_)
        for (int grp = F.tid; grp < 64 * 36; grp += 512) { const int tt = grp / 36, jg = grp - tt * 36, j0 = 8 * jg; const int t = t0 + tt; const bool has_prev = (t % SEQ) != 0;
            int pj, qj; if (j0 < 64) { pj = j0; qj = 64 + j0; } else if (j0 < 128) { pj = 128 + (j0 - 64); qj = 192 + (j0 - 64); } else if (j0 < 256) { pj = 256 + (j0 - 128); qj = 384 + (j0 - 128); } else { pj = 512 + (j0 - 256); qj = 544 + (j0 - 256); }
            const u32x4 pv = *(const u32x4*)(LO + (size_t)t * LO_W + pj); u32x4 qv = {0u, 0u, 0u, 0u}; if (has_prev) qv = *(const u32x4*)(LO + (size_t)(t - 1) * LO_W + qj);
            const unsigned pw[4] = {pv.x, pv.y, pv.z, pv.w}, qw[4] = {qv.x, qv.y, qv.z, qv.w}; float v[8];
#pragma unroll
            for (int q = 0; q < 4; ++q) { v[2 * q] = bflo(pw[q]) + bflo(qw[q]); v[2 * q + 1] = bfhi(pw[q]) + bfhi(qw[q]); }
            if (j0 < 64) {
#pragma unroll
                for (int e = 0; e < 8; ++e) v[e] = 1.0f - 2.0f * __builtin_amdgcn_rcpf(1.0f + __expf(2.0f * v[e]));
            } else if (j0 >= 128 && j0 < 256) {
#pragma unroll
                for (int e = 0; e < 8; ++e) v[e] = sigmoidf_(v[e]);
            }
            u32x4 w; w.x = pk2(v[0], v[1]); w.y = pk2(v[2], v[3]); w.z = pk2(v[4], v[5]); w.w = pk2(v[6], v[7]);
            *(LAS u32x4*)(act + tt * ACT_P + j0 * 2) = w; }
        __syncthreads();
        float inv[4];
        { int cw = 64 * F.wave + 4 * g; asm volatile("" : "+v"(cw));
          u32x2 kc[4][4], kp_[4][4];
#pragma unroll
          for (int tt = 0; tt < 4; ++tt) { const int t = t0 + 16 * tt + r16; const bool has_prev = (t % SEQ) != 0; const size_t ro = (size_t)t * 1536;
#pragma unroll
              for (int ct = 0; ct < 4; ++ct) { kc[tt][ct] = *(const u32x2*)(RW + ro + 512 + cw + 16 * ct); kp_[tt][ct] = (u32x2){0u, 0u}; if (has_prev) kp_[tt][ct] = *(const u32x2*)(RW + ro - 1536 + 512 + cw + 16 * ct); } }
#pragma unroll
          for (int tt = 0; tt < 4; ++tt) { float ss = 0.f;
#pragma unroll
              for (int ct = 0; ct < 4; ++ct) { const f32x4 muk = *(const LAS f32x4*)(PRM + 512 + cw + 16 * ct), kkc = *(const LAS f32x4*)(PRM + 2560 + cw + 16 * ct);
                  const float k0 = bflo(kc[tt][ct].x), k1 = bfhi(kc[tt][ct].x), k2 = bflo(kc[tt][ct].y), k3 = bfhi(kc[tt][ct].y), q0 = bflo(kp_[tt][ct].x), q1 = bfhi(kp_[tt][ct].x), q2 = bflo(kp_[tt][ct].y), q3 = bfhi(kp_[tt][ct].y);
                  const float a0 = (k0 + (q0 - k0) * muk[0]) * kkc[0], a1 = (k1 + (q1 - k1) * muk[1]) * kkc[1], a2 = (k2 + (q2 - k2) * muk[2]) * kkc[2], a3 = (k3 + (q3 - k3) * muk[3]) * kkc[3];
                  ss += (a0 * a0 + a1 * a1) + (a2 * a2 + a3 * a3); }
              ss += __shfl_xor(ss, 16); ss += __shfl_xor(ss, 32);
              inv[tt] = __builtin_amdgcn_rsqf(fmaxf(ss, 1e-24f)); } }
#pragma unroll 1
        for (int ct = 0; ct < 4; ++ct) {
            int cw = 64 * F.wave + 4 * g; asm volatile("" : "+v"(cw));
            const int c0 = cw + 16 * ct;
            bf16x8 wf[9];
            { const unsigned char* wrow = L2T + (size_t)(64 * F.wave + 16 * ct + r16) * 576 + 16 * g;
#pragma unroll
              for (int s = 0; s < 9; ++s) wf[s] = *(const bf16x8*)(wrow + 64 * s); }
            u32x2 cur[4][3], prv[4][3], vfl[4];
#pragma unroll
            for (int tt = 0; tt < 4; ++tt) { const int t = t0 + 16 * tt + r16; const bool has_prev = (t % SEQ) != 0; const size_t ro = (size_t)t * 1536;
#pragma unroll
                for (int p = 0; p < 3; ++p) { cur[tt][p] = *(const u32x2*)(RW + ro + 512 * p + c0); prv[tt][p] = (u32x2){0u, 0u}; if (has_prev) prv[tt][p] = *(const u32x2*)(RW + ro - 1536 + 512 * p + c0); }
                vfl[tt] = (u32x2){0u, 0u}; if (l > 0) vfl[tt] = *(const u32x2*)(VF + (size_t)t * CW + c0); }
            const f32x4 mur = *(const LAS f32x4*)(PRM + c0), muk = *(const LAS f32x4*)(PRM + 512 + c0), muv = *(const LAS f32x4*)(PRM + 1024 + c0), w0v = *(const LAS f32x4*)(PRM + 1536 + c0),
                        a0v = *(const LAS f32x4*)(PRM + 2048 + c0), kkc = *(const LAS f32x4*)(PRM + 2560 + c0), kac = *(const LAS f32x4*)(PRM + 3072 + c0), v0v = *(const LAS f32x4*)(PRM + 3584 + c0);
#pragma unroll
            for (int tt = 0; tt < 4; ++tt) {
                const int t = t0 + 16 * tt + r16; const size_t oo = (size_t)t * CW;
                bf16x8 a[9];
#pragma unroll
                for (int s = 0; s < 9; ++s) a[s] = *(const LAS bf16x8*)(act + (16 * tt + r16) * ACT_P + (32 * s + 8 * g) * 2);
                f32x4 aw = {0.f, 0.f, 0.f, 0.f}, aa = {0.f, 0.f, 0.f, 0.f}, ag = {0.f, 0.f, 0.f, 0.f}, av = {0.f, 0.f, 0.f, 0.f};
                aw = mfma16(wf[0], a[0], aw); aw = mfma16(wf[1], a[1], aw);
                aa = mfma16(wf[2], a[2], aa); aa = mfma16(wf[3], a[3], aa);
                ag = mfma16(wf[4], a[4], ag); ag = mfma16(wf[5], a[5], ag); ag = mfma16(wf[6], a[6], ag); ag = mfma16(wf[7], a[7], ag);
                if (l > 0) av = mfma16(wf[8], a[8], av);
                float ro4[4], lw4[4], vo4[4], k2[4], ka[4], kb[4];
#pragma unroll
                for (int r = 0; r < 4; ++r) {
                    const unsigned cwd_r = (r < 2) ? cur[tt][0].x : cur[tt][0].y, cwd_k = (r < 2) ? cur[tt][1].x : cur[tt][1].y, cwd_v = (r < 2) ? cur[tt][2].x : cur[tt][2].y;
                    const unsigned pwd_r = (r < 2) ? prv[tt][0].x : prv[tt][0].y, pwd_k = (r < 2) ? prv[tt][1].x : prv[tt][1].y, pwd_v = (r < 2) ? prv[tt][2].x : prv[tt][2].y;
                    const unsigned vwd = (r < 2) ? vfl[tt].x : vfl[tt].y;
                    const float rp = (r & 1) ? bfhi(cwd_r) : bflo(cwd_r), kp = (r & 1) ? bfhi(cwd_k) : bflo(cwd_k), vp = (r & 1) ? bfhi(cwd_v) : bflo(cwd_v);
                    const float rq = (r & 1) ? bfhi(pwd_r) : bflo(pwd_r), kq_ = (r & 1) ? bfhi(pwd_k) : bflo(pwd_k), vq = (r & 1) ? bfhi(pwd_v) : bflo(pwd_v);
                    const float rr = rp + (rq - rp) * mur[r], k = kp + (kq_ - kp) * muk[r]; float v = vp + (vq - vp) * muv[r];
                    const float wl = -softplusf_(-(w0v[r] + aw[r])) - 0.5f; lw4[r] = -__expf(wl);
                    const float alr = sigmoidf_(a0v[r] + aa[r]);
                    if (l > 0) { const float vf = (r & 1) ? bfhi(vwd) : bflo(vwd); v = v + (vf - v) * sigmoidf_(v0v[r] + av[r]); }
                    const float kk = k * kkc[r] * inv[tt];
                    ro4[r] = rr; vo4[r] = v; k2[r] = k * (1.f + (alr - 1.f) * kac[r]); ka[r] = kk; kb[r] = kk * alr; }
                u32x2 w;
                w.x = pk2(ro4[0], ro4[1]); w.y = pk2(ro4[2], ro4[3]); *(u32x2*)(SIr + oo + c0) = w;
                w.x = pk2(lw4[0], lw4[1]); w.y = pk2(lw4[2], lw4[3]); *(u32x2*)(SIw + oo + c0) = w;
                w.x = pk2(ag[0], ag[1]); w.y = pk2(ag[2], ag[3]); *(u32x2*)(Gb + oo + c0) = w;
                w.x = pk2(vo4[0], vo4[1]); w.y = pk2(vo4[2], vo4[3]); *(u32x2*)((l > 0 ? V1 : VF) + oo + c0) = w;
                w.x = pk2(k2[0], k2[1]); w.y = pk2(k2[2], k2[3]); *(u32x2*)(SIk + oo + c0) = w;
                w.x = pk2(ka[0], ka[1]); w.y = pk2(ka[2], ka[3]); *(u32x2*)(SIa + oo + c0) = w;
                w.x = pk2(kb[0], kb[1]); w.y = pk2(kb[2], kb[3]); *(u32x2*)(SIb + oo + c0) = w;
            }
        }
    }
}
constexpr int NUNIT = NB * NH * (SEQ / 64);
constexpr size_t U_PMP = 0, U_RPP = 8192, U1_BYTES = 16384;
constexpr size_t U_QMT = 0, U_YLT = 16384, U2_BYTES = 32768;
DI int permk(int k) { return (k & 32) | (((k >> 2) & 3) << 3) | (((k >> 4) & 1) << 2) | (k & 3); }
constexpr int MP = 144;
constexpr int SP = 80;
DI f32x4 mm_tile(const LAS unsigned char* xb, int px, int m0, const LAS unsigned char* yb, int py, int n0, int ks, f32x4 acc, int lane) {
    const int r16 = lane & 15, g = lane >> 4;
    for (int s = 0; s < ks; ++s) {
        const bf16x8 a = *(const LAS bf16x8*)(xb + (m0 + r16) * px + (32 * s + 8 * g) * 2);
        const bf16x8 b = *(const LAS bf16x8*)(yb + (n0 + r16) * py + (32 * s + 8 * g) * 2);
        acc = mfma16(a, b, acc);
    }
    return acc;
}
DI u32x2 pk4(f32x4 v) { u32x2 w; w.x = pk2(v[0], v[1]); w.y = pk2(v[2], v[3]); return w; }

#ifndef SA_DUP
#define SA_DUP 0
#endif
#define SA_REP(bit) for (int sd_ = 0; sd_ < ((SA_DUP & (bit)) ? 2 : 1); ++sd_)
DI void phase_scan_a(Frame& F, int l, int u_lo, int u_hi, int u_step) {
    LAS unsigned char* const L = F.lds;
#define MB(n) (L + (n) * 9216)
    LAS float* const Gf = (LAS float*)(L + 110592);
    LAS float* const SEG = (LAS float*)(L + 110592 + 16384);
    LAS float* const GL = SEG + 512;
    LAS unsigned char* const A21 = L + 110592 + 16384 + 2048 + 256;
    LAS unsigned char* const T11T = A21 + 2560;
    LAS unsigned char* const ZT = T11T + 2560;
    const bf16_t* SIr = (const bf16_t*)(F.wsp() + WS_SI); const bf16_t* SIw = SIr + (size_t)T * CW; const bf16_t* SIk = SIw + (size_t)T * CW; const bf16_t* SIa = SIk + (size_t)T * CW; const bf16_t* SIb = SIa + (size_t)T * CW;
    const bf16_t* V = (const bf16_t*)(F.wsp() + (l > 0 ? WS_V1 : WS_VF));
    const int lane = F.lane, wave = F.wave, r16 = lane & 15, g = lane >> 4;
    float plw[8]; u32x4 prv, pkv, pav, pbv, pvv;
#define SCANA_LOAD(uu) do { const int bh_ = (uu) & 31, c_ = (uu) >> 5, b_ = bh_ >> 3, h_ = bh_ & 7; const size_t t0_ = (size_t)b_ * SEQ + c_ * 64; \
        { const int k_ = F.tid & 63, seg_ = F.tid >> 6; _Pragma("unroll") for (int e = 0; e < 8; ++e) plw[e] = bf2f(SIw[(t0_ + 8 * seg_ + e) * CW + h_ * 64 + k_]); } \
        { const int i_ = F.tid >> 3, k0_ = (F.tid & 7) * 8; const size_t go_ = (t0_ + i_) * CW + h_ * 64 + k0_; \
          prv = *(const u32x4*)(SIr + go_); pkv = *(const u32x4*)(SIk + go_); pav = *(const u32x4*)(SIa + go_); pbv = *(const u32x4*)(SIb + go_); pvv = *(const u32x4*)(V + go_); } } while (0)
    if (u_lo < u_hi) SCANA_LOAD(u_lo);
    for (int u = u_lo; u < u_hi; u += u_step) {
        const int bh = u & 31, c = u >> 5, b = bh >> 3, h = bh & 7;
        const size_t t0 = (size_t)b * SEQ + c * 64; (void)t0; (void)b; (void)h;
        unsigned char* const rec1 = F.wsp() + WS_SC1 + (size_t)((bh * 128) + c) * U1_BYTES; unsigned char* const rec2 = F.wsp() + WS_SC2 + (size_t)((bh * 128) + c) * U2_BYTES;
        __syncthreads();
        SA_REP(1) {
        { const int k = F.tid & 63, seg = F.tid >> 6; float p[8]; float run = 0.f;
#pragma unroll
          for (int e = 0; e < 8; ++e) { run += plw[e]; p[e] = run; }
          SEG[seg * 64 + k] = run;
          __syncthreads();
          float off = 0.f;
#pragma unroll
          for (int s = 0; s < 8; ++s) off += (s < seg) ? SEG[s * 64 + k] : 0.f;
#pragma unroll
          for (int e = 0; e < 8; ++e) Gf[(8 * seg + e) * 64 + k] = off + p[e];
        }
        __syncthreads();
        { const int i = F.tid >> 3, k0 = (F.tid & 7) * 8;
          const u32x4 rv = prv, kv = pkv, av = pav, bv = pbv, vv = pvv;
          float fr[8], fk[8], fa[8], fb[8], fv[8];
          const unsigned rw[4] = {rv.x, rv.y, rv.z, rv.w}, kw[4] = {kv.x, kv.y, kv.z, kv.w}, aw[4] = {av.x, av.y, av.z, av.w}, bw[4] = {bv.x, bv.y, bv.z, bv.w}, vw[4] = {vv.x, vv.y, vv.z, vv.w};
#pragma unroll
          for (int q = 0; q < 4; ++q) { fr[2 * q] = bflo(rw[q]); fr[2 * q + 1] = bfhi(rw[q]); fk[2 * q] = bflo(kw[q]); fk[2 * q + 1] = bfhi(kw[q]); fa[2 * q] = bflo(aw[q]); fa[2 * q + 1] = bfhi(aw[q]);
              fb[2 * q] = bflo(bw[q]); fb[2 * q + 1] = bfhi(bw[q]); fv[2 * q] = bflo(vw[q]); fv[2 * q + 1] = bfhi(vw[q]); }
          float at[8], rt[8], bt[8], kt[8], bh8[8], kh8[8];
#pragma unroll
          for (int e = 0; e < 8; ++e) { const float gi = Gf[i * 64 + k0 + e], gp = (i > 0) ? Gf[(i - 1) * 64 + k0 + e] : 0.f, gl = Gf[63 * 64 + k0 + e];
              const float e1 = __expf(gp), e2 = __expf(gi), e3 = __expf(-gi), e4 = __expf(gl - gi);
              at[e] = -fa[e] * e1; rt[e] = fr[e] * e2; bt[e] = fb[e] * e3; kt[e] = fk[e] * e3; bh8[e] = fb[e] * e4; kh8[e] = fk[e] * e4;
              if (i == 63) GL[k0 + e] = e2; }
          u32x4 w;
          w.x = pk2(at[0], at[1]); w.y = pk2(at[2], at[3]); w.z = pk2(at[4], at[5]); w.w = pk2(at[6], at[7]); *(LAS u32x4*)(MB(0) + i * MP + k0 * 2) = w;
          w.x = pk2(rt[0], rt[1]); w.y = pk2(rt[2], rt[3]); w.z = pk2(rt[4], rt[5]); w.w = pk2(rt[6], rt[7]); *(LAS u32x4*)(MB(1) + i * MP + k0 * 2) = w;
          w.x = pk2(bt[0], bt[1]); w.y = pk2(bt[2], bt[3]); w.z = pk2(bt[4], bt[5]); w.w = pk2(bt[6], bt[7]); *(LAS u32x4*)(MB(2) + i * MP + k0 * 2) = w;
          w.x = pk2(kt[0], kt[1]); w.y = pk2(kt[2], kt[3]); w.z = pk2(kt[4], kt[5]); w.w = pk2(kt[6], kt[7]); *(LAS u32x4*)(MB(3) + i * MP + k0 * 2) = w;
#pragma unroll
          for (int e = 0; e < 8; ++e) { const int ro = (k0 + e) * MP + i * 2;
              *(LAS bf16_t*)(MB(4) + ro) = f2bf(at[e]); *(LAS bf16_t*)(MB(5) + ro) = f2bf(fv[e]); *(LAS bf16_t*)(MB(6) + ro) = f2bf(bh8[e]); *(LAS bf16_t*)(MB(7) + ro) = f2bf(kh8[e]); }
        }
        __syncthreads(); }
        if (u + u_step < u_hi) SCANA_LOAD(u + u_step);
        __syncthreads();
        SA_REP(2) {
        { const int prod = wave >> 1;
          const LAS unsigned char* xb = (prod & 1) ? MB(3) : MB(2); const LAS unsigned char* yb = (prod < 2) ? MB(0) : MB(1);
          LAS unsigned char* ob = (prod == 1) ? MB(8) : (prod == 2) ? MB(9) : MB(10);
          float zf = 0.f; asm volatile("" : "+v"(zf));
          for (int q = 0; q < 8; ++q) { const int tt = (wave & 1) * 8 + q, tm = tt >> 2, tn = tt & 3;
              f32x4 acc = {zf, zf, zf, zf};
              if (tm <= tn) acc = mm_tile(xb, MP, 16 * tm, yb, MP, 16 * tn, 2, acc, lane);
              const int i = 16 * tn + r16, j0 = 16 * tm + 4 * g;
#pragma unroll
              for (int r = 0; r < 4; ++r) { const int j = j0 + r; const bool keep = (prod < 2) ? (j < i) : (j <= i); if (!keep) acc[r] = 0.f; }
              if (prod == 0) {
                  if ((i >> 5) == (j0 >> 5)) *(LAS f32x4*)(Gf + ((i >> 5) * 32 + (i & 31)) * 32 + (j0 & 31)) = acc;
                  if (i >= 32 && j0 < 32) *(LAS u32x2*)(A21 + (i - 32) * SP + j0 * 2) = pk4(acc);
              } else *(LAS u32x2*)(ob + i * MP + j0 * 2) = pk4(acc);
          } }
        __syncthreads();
        }
        f32x4 pyl[2] = {{0.f, 0.f, 0.f, 0.f}, {0.f, 0.f, 0.f, 0.f}}, pqm[2] = {{0.f, 0.f, 0.f, 0.f}, {0.f, 0.f, 0.f, 0.f}};
        SA_REP(4) {
        if (wave == 0) {
            const int blk = lane >> 5, cc = lane & 31; const LAS float* AD = Gf + blk * 1024;
            float Tc[32];
#pragma unroll
            for (int i = 0; i < 32; ++i) { float a0 = (i == cc) ? 1.f : 0.f, a1 = 0.f, a2 = 0.f, a3 = 0.f;
#pragma unroll
                for (int q = 0; q < (i + 3) / 4; ++q) { const f32x4 a = *(const LAS f32x4*)(AD + i * 32 + 4 * q);
                    if (4 * q + 0 < i) a0 += a[0] * Tc[4 * q + 0]; if (4 * q + 1 < i) a1 += a[1] * Tc[4 * q + 1]; if (4 * q + 2 < i) a2 += a[2] * Tc[4 * q + 2]; if (4 * q + 3 < i) a3 += a[3] * Tc[4 * q + 3]; }
                Tc[i] = (a0 + a1) + (a2 + a3); }
#pragma unroll
            for (int i = 0; i < 32; ++i) *(LAS bf16_t*)(MB(11) + (32 * blk + i) * MP + (32 * blk + cc) * 2) = f2bf(Tc[i]);
            if (blk == 0) {
#pragma unroll
                for (int q = 0; q < 4; ++q) { u32x4 w; w.x = pk2(Tc[8 * q], Tc[8 * q + 1]); w.y = pk2(Tc[8 * q + 2], Tc[8 * q + 3]); w.z = pk2(Tc[8 * q + 4], Tc[8 * q + 5]); w.w = pk2(Tc[8 * q + 6], Tc[8 * q + 7]);
                    *(LAS u32x4*)(T11T + cc * SP + q * 16) = w; }
            } else {
                unsigned z = 0u; asm volatile("" : "+v"(z));
#pragma unroll
                for (int q = 0; q < 4; ++q) *(LAS u32x4*)(MB(11) + cc * MP + 64 + q * 16) = (u32x4){z, z, z, z};
            }
        } else {
            for (int tt = wave - 1; tt < 16; tt += 7) { const int tm = tt >> 2, tn = tt & 3;
                f32x4 acc = {0.f, 0.f, 0.f, 0.f};
                acc = mm_tile(MB(8), MP, 16 * tm, MB(5), MP, 16 * tn, 2, acc, lane);
                *(LAS u32x2*)(MB(2) + (16 * tn + r16) * MP + (16 * tm + 4 * g) * 2) = pk4(acc); }
            if (sd_ == 0) {
#pragma unroll
                for (int q = 0; q < 2; ++q) { const int tt = wave * 2 + q, tm = tt >> 2, tn = tt & 3; const f32x4 z = {0.f, 0.f, 0.f, 0.f};
                    pyl[q] = mm_tile(MB(5), MP, 16 * tm, MB(10), MP, 16 * tn, 2, z, lane);
                    pqm[q] = mm_tile(MB(7), MP, 16 * tm, MB(5), MP, 16 * tn, 2, z, lane); } }
        }
        __syncthreads();
        if (wave < 4) { const int tm = wave >> 1, tn = wave & 1; f32x4 acc = {0.f, 0.f, 0.f, 0.f};
            acc = mm_tile(A21, SP, 16 * tm, T11T, SP, 16 * tn, 1, acc, lane);
            *(LAS u32x2*)(ZT + (16 * tn + r16) * SP + (16 * tm + 4 * g) * 2) = pk4(acc); }
        __syncthreads();
        if (wave < 4) { const int tm = wave >> 1, tn = wave & 1; f32x4 acc = {0.f, 0.f, 0.f, 0.f};
            acc = mm_tile(ZT, SP, 16 * tm, MB(11) + 32 * MP + 64, MP, 16 * tn, 1, acc, lane);
            *(LAS u32x2*)(MB(11) + (32 + 16 * tn + r16) * MP + (16 * tm + 4 * g) * 2) = pk4(acc); }
        __syncthreads();
        }
        SA_REP(8) {
        { const LAS unsigned char* yb = (wave < 4) ? MB(4) : MB(2); LAS unsigned char* ob = (wave < 4) ? MB(3) : MB(0);
          for (int q = 0; q < 4; ++q) { const int tt = (wave & 3) * 4 + q, tm = tt >> 2, tn = tt & 3;
              f32x4 acc = {0.f, 0.f, 0.f, 0.f};
              acc = mm_tile(MB(11), MP, 16 * tm, yb, MP, 16 * tn, 2, acc, lane);
              *(LAS u32x2*)(ob + (16 * tn + r16) * MP + (16 * tm + 4 * g) * 2) = pk4(acc); } }
        __syncthreads();
        }
        SA_REP(16) {
#pragma unroll
        for (int q = 0; q < 2; ++q) { const int tt = wave * 2 + q, tm = tt >> 2, tn = tt & 3;
            { f32x4 acc = {0.f, 0.f, 0.f, 0.f}; acc = mm_tile(MB(3), MP, 16 * tm, MB(9), MP, 16 * tn, 2, acc, lane);
              const int i = 16 * tn + r16, k0 = 16 * tm + 4 * g; const u32x2 rr = *(const LAS u32x2*)(MB(1) + i * MP + k0 * 2);
              acc[0] += bflo(rr.x); acc[1] += bfhi(rr.x); acc[2] += bflo(rr.y); acc[3] += bfhi(rr.y);
              *(u32x2*)(rec1 + U_RPP + (size_t)(i * 64 + permk(k0)) * 2) = pk4(acc); }
            { f32x4 acc = {0.f, 0.f, 0.f, 0.f}; acc = mm_tile(MB(3), MP, 16 * tm, MB(6), MP, 16 * tn, 2, acc, lane);
              const int kp = 16 * tn + r16, k0 = 16 * tm + 4 * g;
#pragma unroll
              for (int r = 0; r < 4; ++r) if (k0 + r == kp) acc[r] += GL[kp];
              *(u32x2*)(rec1 + U_PMP + (size_t)(kp * 64 + permk(k0)) * 2) = pk4(acc); }
            { f32x4 acc = pyl[q]; acc = mm_tile(MB(0), MP, 16 * tm, MB(9), MP, 16 * tn, 2, acc, lane); if (wave == 0) acc = mm_tile(MB(5), MP, 16 * tm, MB(10), MP, 16 * tn, 2, acc, lane);
              *(f32x4*)(rec2 + U_YLT + (size_t)((16 * tn + r16) * 64 + 16 * tm + 4 * g) * 4) = acc; }
            { f32x4 acc = pqm[q]; acc = mm_tile(MB(6), MP, 16 * tm, MB(0), MP, 16 * tn, 2, acc, lane); if (wave == 0) acc = mm_tile(MB(7), MP, 16 * tm, MB(5), MP, 16 * tn, 2, acc, lane);
              *(f32x4*)(rec2 + U_QMT + (size_t)((16 * tn + r16) * 64 + 16 * tm + 4 * g) * 4) = acc; }
        }
        __syncthreads(); }
    }
#undef MB
#undef SCANA_LOAD
}

constexpr int SB_D = 5, SB_SLOT = 24576;
DI void scanb_issue(LAS unsigned char* lds, const unsigned char* r1b, const unsigned char* r2b, int cidx, int lw, int lane) {
    const unsigned char* rec1 = r1b + (size_t)cidx * U1_BYTES; const unsigned char* rec2 = r2b + (size_t)cidx * U2_BYTES;
    LAS unsigned char* slot = lds + (cidx % SB_D) * SB_SLOT;
#pragma unroll
    for (int i = 0; i < 2; ++i) { const int ci = 2 * lw + i;
        const int row = 8 * ci + (lane >> 3), sl = lane & 7;
        __builtin_amdgcn_global_load_lds((const unsigned*)(rec1 + U_PMP + row * 128 + ((sl ^ (row & 7)) << 4)), (LAS unsigned*)(slot + ci * 1024), 16, 0, 0); }
#pragma unroll
    for (int i = 0; i < 4; ++i) { const int ci = 4 * lw + i;
        const int v = 4 * ci + (lane >> 4), sl = lane & 15;
        __builtin_amdgcn_global_load_lds((const unsigned*)(rec2 + U_QMT + v * 256 + ((sl ^ (v & 15)) << 4)), (LAS unsigned*)(slot + 8192 + ci * 1024), 16, 0, 0); }
}
DI void phase_scan_b(Frame& F) {
    const int lane = F.lane, r16 = lane & 15, g = lane >> 4, w = F.wave, v = 16 * (w & 3) + r16;
    for (int bh = F.bid; bh < NB * NH; bh += F.G) {
        const unsigned char* r1 = F.wsp() + WS_SC1 + (size_t)bh * 128 * U1_BYTES; const unsigned char* r2 = F.wsp() + WS_SC2 + (size_t)bh * 128 * U2_BYTES;
        bf16_t* sct = (bf16_t*)(F.wsp() + WS_SCT) + (size_t)bh * 128 * 4096;
        f32x4 sT[4];
#pragma unroll
        for (int i = 0; i < 4; ++i) sT[i] = (f32x4){0.f, 0.f, 0.f, 0.f};
        __syncthreads();
        if (w >= 4) {
#pragma unroll
            for (int d = 0; d < SB_D; ++d) scanb_issue(F.lds, r1, r2, d, w - 4, lane);
        }
        for (int c = 0; c < 128; ++c) {
            if (w >= 4) asm volatile("s_waitcnt vmcnt(18)" ::: "memory");
            __builtin_amdgcn_s_barrier();
            asm volatile("" ::: "memory");
            if (w >= 4) {
                if (c >= 1) { const int cn = c - 1 + SB_D; scanb_issue(F.lds, r1, r2, cn < 128 ? cn : c, w - 4, lane); }
            } else {
                const LAS unsigned char* slot = F.lds + (c % SB_D) * SB_SLOT;
                bf16x8 pm[4][2]; f32x4 q[4];
#pragma unroll
                for (int mt = 0; mt < 4; ++mt) { const int row = 16 * mt + r16;
#pragma unroll
                    for (int s2 = 0; s2 < 2; ++s2) pm[mt][s2] = *(const LAS bf16x8*)(slot + row * 128 + (((4 * s2 + g) ^ (row & 7)) << 4));
                    q[mt] = *(const LAS f32x4*)(slot + 8192 + v * 256 + (((4 * mt + g) ^ (v & 15)) << 4)); }
                bf16x8 hi[2], lo[2];
#pragma unroll
                for (int s2 = 0; s2 < 2; ++s2) { u32x4 hw, lw;
#pragma unroll
                    for (int qq = 0; qq < 2; ++qq) { const f32x4 x = sT[2 * s2 + qq]; const unsigned h0 = pk2(x[0], x[1]), h1 = pk2(x[2], x[3]);
                        const unsigned l0 = pk2(x[0] - bflo(h0), x[1] - bfhi(h0)), l1 = pk2(x[2] - bflo(h1), x[3] - bfhi(h1));
                        if (qq == 0) { hw.x = h0; hw.y = h1; lw.x = l0; lw.y = l1; } else { hw.z = h0; hw.w = h1; lw.z = l0; lw.w = l1; } }
                    hi[s2] = __builtin_bit_cast(bf16x8, hw); lo[s2] = __builtin_bit_cast(bf16x8, lw);
                    *(u32x4*)(sct + (size_t)c * 4096 + (size_t)v * 64 + 32 * s2 + 8 * g) = hw; }
#pragma unroll
                for (int mt = 0; mt < 4; ++mt) { f32x4 n = q[mt];
#pragma unroll
                    for (int s2 = 0; s2 < 2; ++s2) { n = mfma16(pm[mt][s2], hi[s2], n); n = mfma16(pm[mt][s2], lo[s2], n); }
                    sT[mt] = n; }
                asm volatile("s_waitcnt lgkmcnt(0)" ::: "memory");
            }
        }
        asm volatile("s_waitcnt vmcnt(0)" ::: "memory");
    }
}

struct ScanCIn { bf16x8 ra[2]; f32x4 yl[4]; bf16x8 sb[4][2]; };
DI void scanc_load(ScanCIn& o, const unsigned char* ws, int item, int r16, int g) {
    asm volatile("" : "+s"(item));
    const int u = item >> 2, it = item & 3; const int bh = u & 31, c = u >> 5; const size_t ui = (size_t)(bh * 128 + c);
    const unsigned char* rec1 = ws + WS_SC1 + ui * U1_BYTES; const unsigned char* rec2 = ws + WS_SC2 + ui * U2_BYTES; const bf16_t* sct = (const bf16_t*)(ws + WS_SCT) + ui * 4096;
#pragma unroll
    for (int s = 0; s < 2; ++s) o.ra[s] = *(const bf16x8*)(rec1 + U_RPP + (size_t)((16 * it + r16) * 64 + 32 * s + 8 * g) * 2);
#pragma unroll
    for (int vt = 0; vt < 4; ++vt) { o.yl[vt] = *(const f32x4*)(rec2 + U_YLT + (size_t)((16 * it + r16) * 64 + 16 * vt + 4 * g) * 4);
#pragma unroll
        for (int s = 0; s < 2; ++s) o.sb[vt][s] = *(const bf16x8*)(sct + (size_t)(16 * vt + r16) * 64 + 32 * s + 8 * g); }
}
DI void scanc_item(const ScanCIn& o, Frame& F, int l, int item, int r16, int g) {
    const bf16_t* SIr = (const bf16_t*)(F.wsp() + WS_SI); const bf16_t* SIk = SIr + 2 * (size_t)T * CW;
    const bf16_t* V = (const bf16_t*)(F.wsp() + (l > 0 ? WS_V1 : WS_VF)); const bf16_t* Gb = (const bf16_t*)(F.wsp() + WS_G); bf16_t* YR = (bf16_t*)(F.wsp() + WS_YRM);
    const int u = item >> 2, it = item & 3; const int bh = u & 31, c = u >> 5, b = bh >> 3, h = bh & 7;
    const size_t tok = (size_t)b * SEQ + c * 64 + 16 * it + r16; const size_t o0 = tok * CW + h * 64 + 4 * g, oy = tok * YRM_LD + h * 64 + 4 * g;
    u32x2 pr[4], pk[4], pv[4], pg[4];
#pragma unroll
    for (int vt = 0; vt < 4; ++vt) { pr[vt] = *(const u32x2*)(SIr + o0 + 16 * vt); pk[vt] = *(const u32x2*)(SIk + o0 + 16 * vt); pv[vt] = *(const u32x2*)(V + o0 + 16 * vt); pg[vt] = *(const u32x2*)(Gb + o0 + 16 * vt); }
    f32x4 y[4];
#pragma unroll
    for (int vt = 0; vt < 4; ++vt) { y[vt] = o.yl[vt];
#pragma unroll
        for (int s = 0; s < 2; ++s) y[vt] = mfma16(o.sb[vt][s], o.ra[s], y[vt]); }
    float s1 = 0.f;
#pragma unroll
    for (int vt = 0; vt < 4; ++vt) s1 += (y[vt][0] + y[vt][1]) + (y[vt][2] + y[vt][3]);
    s1 += __shfl_xor(s1, 16); s1 += __shfl_xor(s1, 32);
    const float mean = s1 * (1.f / 64.f); float s2 = 0.f;
#pragma unroll
    for (int vt = 0; vt < 4; ++vt) { y[vt] = y[vt] - mean; s2 += (y[vt][0] * y[vt][0] + y[vt][1] * y[vt][1]) + (y[vt][2] * y[vt][2] + y[vt][3] * y[vt][3]); }
    s2 += __shfl_xor(s2, 16); s2 += __shfl_xor(s2, 32);
    const float rstd = __builtin_amdgcn_rsqf(s2 * (1.f / 64.f) + 64e-5f);
    const float* lng = F.inp(17) + l * CW + h * 64 + 4 * g; const float* lnb = F.inp(18) + l * CW + h * 64 + 4 * g; const float* rkp = F.inp(16) + l * CW + h * 64 + 4 * g;
    float s3 = 0.f;
#pragma unroll
    for (int vt = 0; vt < 4; ++vt) { const f32x4 rk = *(const f32x4*)(rkp + 16 * vt);
        s3 += bflo(pr[vt].x) * bflo(pk[vt].x) * rk[0] + bfhi(pr[vt].x) * bfhi(pk[vt].x) * rk[1] + bflo(pr[vt].y) * bflo(pk[vt].y) * rk[2] + bfhi(pr[vt].y) * bfhi(pk[vt].y) * rk[3]; }
    s3 += __shfl_xor(s3, 16); s3 += __shfl_xor(s3, 32);
#pragma unroll
    for (int vt = 0; vt < 4; ++vt) { const f32x4 lg4 = *(const f32x4*)(lng + 16 * vt), lb4 = *(const f32x4*)(lnb + 16 * vt);
        const float o_0 = (y[vt][0] * rstd * lg4[0] + lb4[0] + s3 * bflo(pv[vt].x)) * bflo(pg[vt].x), o_1 = (y[vt][1] * rstd * lg4[1] + lb4[1] + s3 * bfhi(pv[vt].x)) * bfhi(pg[vt].x);
        const float o_2 = (y[vt][2] * rstd * lg4[2] + lb4[2] + s3 * bflo(pv[vt].y)) * bflo(pg[vt].y), o_3 = (y[vt][3] * rstd * lg4[3] + lb4[3] + s3 * bfhi(pv[vt].y)) * bfhi(pg[vt].y);
        u32x2 w; w.x = pk2(o_0, o_1); w.y = pk2(o_2, o_3); *(u32x2*)(YR + oy + 16 * vt) = w; }
}
DI void phase_scan_c(Frame& F, int l) {
    const int lane = F.lane, r16 = lane & 15, g = lane >> 4;
    const int first = F.bid * 8 + F.wave, stride = F.G * 8;
    if (first >= NUNIT * 4) return;
    ScanCIn o0, o1;
    scanc_load(o0, F.wsp(), first, r16, g);
    for (int item = first; item < NUNIT * 4; item += 2 * stride) {
        const int i1 = item + stride, i2 = item + 2 * stride;
        if (i1 < NUNIT * 4) scanc_load(o1, F.wsp(), i1, r16, g);
        scanc_item(o0, F, l, item, r16, g);
        if (i1 < NUNIT * 4) { if (i2 < NUNIT * 4) scanc_load(o0, F.wsp(), i2, r16, g); scanc_item(o1, F, l, i1, r16, g); }
    }
}

DI void phase_prep_scana(Frame& F, int l) {
    phase_rwkv_prep2(F, l, 0, 0, 1, true);
#define RELANE() do { int l_ = F.lane; asm volatile("" : "+v"(l_)); F.lane = l_; F.tid = F.wave * 64 + l_; } while (0)
    for (int tile = F.bid; tile < T / 64; tile += F.G) {
        RELANE();
        phase_rwkv_prep2(F, l, tile, tile + 1, 1, false);
        asm volatile("s_waitcnt vmcnt(0)" ::: "memory");
        __syncthreads();
        __builtin_amdgcn_fence(__ATOMIC_ACQUIRE, "agent");
        asm volatile("s_waitcnt vmcnt(0)" ::: "memory");
        const int b = tile >> 7, c = tile & 127; const int u0 = c * 32 + b * 8;
        RELANE();
        phase_scan_a(F, l, u0, u0 + 8, 1);
    }
#undef RELANE
}
DI void phase_moba_prep(Frame& F, int l) {
    bf16_t* MO = (bf16_t*)(F.wsp() + WS_MO); float* KM = (float*)(F.wsp() + WS_TAB + TB_KMEAN);
    int c = F.tid; const float qg = F.inp(23)[l * 64 + (c & 63)] * 0.125f, kg = F.inp(24)[l * 64 + (c & 63)];
    for (int hs = F.bid; hs < T / 128; hs += F.G) {
        float ksum = 0.f;
        for (int tb = 0; tb < 128; tb += 8) {
            int tbase = hs * 128 + tb; asm volatile("" : "+s"(tbase), "+v"(c));
            float q[8], k[8];
#pragma unroll
            for (int e = 0; e < 8; ++e) { const size_t ro = (size_t)(tbase + e) * 1536; q[e] = bf2f(MO[ro + c]); k[e] = bf2f(MO[ro + 512 + c]); }
#pragma unroll
            for (int e = 0; e < 8; ++e) { const size_t ro = (size_t)(tbase + e) * 1536;
                const float qs = wave_sum(q[e] * q[e]) * (1.f / 64.f), ks = wave_sum(k[e] * k[e]) * (1.f / 64.f);
                const float qn = q[e] * (1.0f / sqrtf(qs + 1e-6f)) * qg, kn = k[e] * (1.0f / sqrtf(ks + 1e-6f)) * kg;
                MO[ro + c] = f2bf(qn); MO[ro + 512 + c] = f2bf(kn); ksum += kn; }
        }
        KM[(size_t)(hs & 1) * (TB_KMEAN2 / 4) + (size_t)(hs >> 1) * CW + c] = ksum * (1.f / 256.f);
    }
}
DI void phase_moba_gate(Frame& F) {
    LAS float* KL = (LAS float*)F.lds;
    const bf16_t* MO = (const bf16_t*)(F.wsp() + WS_MO); const float* KM = (const float*)(F.wsp() + WS_TAB + TB_KMEAN); unsigned* SEL = (unsigned*)(F.wsp() + WS_SEL);
    for (int span = F.bid; span < T / 64; span += F.G) {
        const int t0 = span * 64, b = t0 / SEQ, blk = (t0 % SEQ) / 256;
        __syncthreads();
        { const int cc = F.tid, h = cc >> 6, d = cc & 63;
          for (int j0 = 0; j0 < blk; j0 += 8) { float v0[8], v1[8];
#pragma unroll
              for (int e = 0; e < 8; ++e) { const int j = (j0 + e < blk) ? j0 + e : blk - 1; const size_t ko = ((size_t)(b * 32 + j)) * CW + cc; v0[e] = KM[ko]; v1[e] = KM[ko + TB_KMEAN2 / 4]; }
#pragma unroll
              for (int e = 0; e < 8; ++e) if (j0 + e < blk) KL[h * 2052 + (j0 + e) * 64 + d] = v0[e] + v1[e]; } }
        __syncthreads();
        const int tok = F.tid >> 3, h = F.tid & 7; const int t = t0 + tok;
        float q[64];
        { const u32x4* qp = (const u32x4*)(MO + (size_t)t * 1536 + h * 64);
#pragma unroll
          for (int i = 0; i < 8; ++i) { const u32x4 w = qp[i]; q[8 * i] = bflo(w.x); q[8 * i + 1] = bfhi(w.x); q[8 * i + 2] = bflo(w.y); q[8 * i + 3] = bfhi(w.y); q[8 * i + 4] = bflo(w.z); q[8 * i + 5] = bfhi(w.z); q[8 * i + 6] = bflo(w.w); q[8 * i + 7] = bfhi(w.w); } }
        float v0 = -INFINITY, v1 = -INFINITY, v2 = -INFINITY; int i0 = 0, i1 = 1, i2 = 2;
        for (int j = 0; j < blk; ++j) {
            const LAS f32x4* kp = (const LAS f32x4*)(KL + h * 2052 + j * 64); float s = 0.f;
#pragma unroll
            for (int i = 0; i < 16; ++i) { const f32x4 kv = kp[i]; s += q[4 * i] * kv.x + q[4 * i + 1] * kv.y + q[4 * i + 2] * kv.z + q[4 * i + 3] * kv.w; }
            if (s > v0) { v2 = v1; i2 = i1; v1 = v0; i1 = i0; v0 = s; i0 = j; }
            else if (s > v1) { v2 = v1; i2 = i1; v1 = s; i1 = j; }
            else if (s > v2) { v2 = s; i2 = j; }
        }
        const int nv = blk < 3 ? blk : 3;
        SEL[(size_t)t * 8 + h] = (unsigned)i0 | ((unsigned)i1 << 8) | ((unsigned)i2 << 16) | ((unsigned)nv << 24);
    }
}

constexpr int KS_PITCH = 144, VT_PITCH = 520;
constexpr int NPIECE = 47;
constexpr int CW_QATT = 8192;
DI void phase_moba_attn(Frame& F, int l) {
    static constexpr unsigned PIECES[NPIECE] = {196608,1837578,590595,1574658,1115654,1640713,1968907,1443848,918789,1049857,1246983,393730,787456,721924,2034700,262401,2034179,2034957,2035214,2035471,2034692,2035728,2034944,2035985,2036242,2036499,2035461,2036756,2037013,2037270,2035969,2037527,2036230,2037784,2038041,2038298,2036743,2038555,2038812,2039069,2039326,2037512,2039583,2038018,2038281,2039050,2039563};
    LAS unsigned char* Ks = F.lds;
    LAS unsigned char* Vt = F.lds + 36864;
    LAS float* LUT = (LAS float*)(F.lds + 36864 + 33280);
    LAS unsigned* CTL = (LAS unsigned*)(F.lds + 36864 + 33280 + 528);
    LAS unsigned* LIST = CTL + 4;
    const bf16_t* MO = (const bf16_t*)(F.wsp() + WS_MO); const unsigned* SEL = (const unsigned*)(F.wsp() + WS_SEL);
    bf16_t* PO = (bf16_t*)(F.wsp() + WS_PO); f32x2* PST = (f32x2*)(F.wsp() + WS_PST);
    unsigned* qctr = (unsigned*)(F.wsp() + WS_CTL) + CW_QATT + 64 * l;
    const float* relb = F.inp(25);
    const int lane = F.lane;
    for (;;) {
        __syncthreads();
        if (F.tid == 0) { CTL[0] = __hip_atomic_fetch_add(qctr, 1u, __ATOMIC_RELAXED, __HIP_MEMORY_SCOPE_AGENT); CTL[1] = 0u; }
        __syncthreads();
        const int u = (int)CTL[0];
        if (u >= NPIECE * NB * NH) break;
        const unsigned pc = PIECES[u >> 5]; const int bh = u & 31, b = bh >> 3, h = bh & 7;
        const int j = (int)(pc & 0xff), qlo = (int)((pc >> 8) & 0xff), qhi = (int)(pc >> 16); const int ncand = (qhi - qlo + 1) * 256;
        const size_t tokb = (size_t)b * SEQ;
        for (int id = F.tid; id < 2048; id += 512) { const int row = id >> 3, c8 = id & 7; const size_t ro = (tokb + j * 256 + row) * 1536 + h * 64 + c8 * 8;
            *(LAS u32x4*)(Ks + row * KS_PITCH + c8 * 16) = *(const u32x4*)(MO + ro + 512); }
        for (int id = F.tid; id < 1024; id += 512) { const int rp = id >> 3, c8 = id & 7; const size_t ro = (tokb + j * 256 + 2 * rp) * 1536 + h * 64 + c8 * 8 + 1024;
            const u32x4 v0 = *(const u32x4*)(MO + ro), v1 = *(const u32x4*)(MO + ro + 1536);
            const unsigned a[4] = {v0.x, v0.y, v0.z, v0.w}, bq[4] = {v1.x, v1.y, v1.z, v1.w};
            LAS unsigned char* vp = Vt + (c8 * 8) * VT_PITCH + rp * 4;
#pragma unroll
            for (int q = 0; q < 4; ++q) { *(LAS unsigned*)(vp + (2 * q) * VT_PITCH) = (a[q] & 0xffffu) | (bq[q] << 16); *(LAS unsigned*)(vp + (2 * q + 1) * VT_PITCH) = (a[q] >> 16) | (bq[q] & 0xffff0000u); } }
        if (F.tid <= 128) { const int n = F.tid; int bucket;
            if (n < 16) bucket = n; else { int lg = 16 + (int)(logf((float)n / 16.0f) / 2.0794415416798357f * 16.0f); bucket = lg < 31 ? lg : 31; }
            LUT[n] = relb[bucket * 8 + h]; }
        unsigned selw[11];
#pragma unroll
        for (int r = 0; r < 11; ++r) { const int qq = qlo * 256 + r * 512 + F.tid; selw[r] = (r * 512 + F.tid < ncand) ? SEL[(tokb + qq) * 8 + h] : 0u; }
#pragma unroll
        for (int r = 0; r < 11; ++r) { const int base = r * 512; if (base >= ncand) break;
            const int q = qlo * 256 + base + F.tid; const int qb = q >> 8; bool mem = false; unsigned ent = 0;
            if (base + F.tid >= ncand) { }
            else if (qb == j) { mem = true; ent = (unsigned)q | (3u << 16); }
            else { const unsigned s = selw[r]; const unsigned nv = s >> 24;
                if (nv > 0 && (s & 0xff) == (unsigned)j) { mem = true; ent = (unsigned)q; }
                else if (nv > 1 && ((s >> 8) & 0xff) == (unsigned)j) { mem = true; ent = (unsigned)q | (1u << 16); }
                else if (nv > 2 && ((s >> 16) & 0xff) == (unsigned)j) { mem = true; ent = (unsigned)q | (2u << 16); } }
            const unsigned long long bal = __ballot(mem); const int cnt = __popcll(bal);
            unsigned wbase = 0; if (lane == 0 && cnt > 0) wbase = __hip_atomic_fetch_add(&CTL[1], (unsigned)cnt, __ATOMIC_RELAXED, __HIP_MEMORY_SCOPE_WORKGROUP);
            wbase = (unsigned)__builtin_amdgcn_readfirstlane((int)wbase);
            if (mem) LIST[wbase + __popcll(bal & ((1ull << lane) - 1ull))] = ent;
        }
        __syncthreads();
        const int total = (int)CTL[1];
        const float bfar = LUT[128];
        const int ntile = (total + 31) >> 5;
        const int qi = lane & 31, half = lane >> 5;
        for (int tile = F.wave; tile < ntile; tile += 8) {
            const int e = tile * 32 + qi; const bool valid = e < total; const unsigned en = LIST[valid ? e : total - 1];
            const int q = (int)(en & 0xffffu), slot = (int)(en >> 16); const size_t tok = tokb + q;
            const bool need_lut = __any((q >> 8) <= j + 1);
            bf16x8 qf[4];
#pragma unroll
            for (int kk = 0; kk < 4; ++kk) qf[kk] = *(const bf16x8*)(MO + tok * 1536 + h * 64 + 16 * kk + 8 * half);
            float mrun = -1e30f, lsum = 0.f;
            f32x16 oacc[2];
#pragma unroll
            for (int i = 0; i < 16; ++i) { oacc[0][i] = 0.f; oacc[1][i] = 0.f; }
            const int qrel = q - j * 256;
#pragma unroll 1
            for (int ck = 0; ck < 4; ++ck) {
                f32x16 sacc[2];
#pragma unroll
                for (int k2 = 0; k2 < 2; ++k2) { const int kt = 2 * ck + k2;
#pragma unroll
                    for (int i = 0; i < 16; ++i) sacc[k2][i] = 0.f;
#pragma unroll
                    for (int kk = 0; kk < 4; ++kk) { const bf16x8 ka = *(const LAS bf16x8*)(Ks + (32 * kt + qi) * KS_PITCH + (16 * kk + 8 * half) * 2);
                        sacc[k2] = __builtin_amdgcn_mfma_f32_32x32x16_bf16(ka, qf[kk], sacc[k2], 0, 0, 0); } }
                float mx = -1e30f;
                if (need_lut) {
#pragma unroll
                    for (int k2 = 0; k2 < 2; ++k2)
#pragma unroll
                        for (int i = 0; i < 16; ++i) { const int key = 32 * (2 * ck + k2) + (i & 3) + 8 * (i >> 2) + 4 * half; const int n = qrel - key;
                            const float bias = LUT[n < 0 ? 0 : (n > 128 ? 128 : n)];
                            const float s = (n < 0) ? -1e30f : sacc[k2][i] + bias; sacc[k2][i] = s; mx = fmaxf(mx, s); }
                } else {
#pragma unroll
                    for (int k2 = 0; k2 < 2; ++k2)
#pragma unroll
                        for (int i = 0; i < 16; ++i) { const float s = sacc[k2][i] + bfar; sacc[k2][i] = s; mx = fmaxf(mx, s); }
                }
                mx = fmaxf(mx, __shfl_xor(mx, 32));
                const float mnew = fmaxf(mrun, mx); const float alpha = __expf(mrun - mnew); mrun = mnew;
                lsum *= alpha;
#pragma unroll
                for (int i = 0; i < 16; ++i) { oacc[0][i] *= alpha; oacc[1][i] *= alpha; }
#pragma unroll
                for (int k2 = 0; k2 < 2; ++k2) { const int kt = 2 * ck + k2;
#pragma unroll
                    for (int i = 0; i < 16; ++i) { const float p = __expf(sacc[k2][i] - mnew); sacc[k2][i] = p; lsum += p; }
#pragma unroll
                    for (int cc = 0; cc < 2; ++cc) {
                        u32x4 pw; pw.x = pk2(sacc[k2][8 * cc], sacc[k2][8 * cc + 1]); pw.y = pk2(sacc[k2][8 * cc + 2], sacc[k2][8 * cc + 3]); pw.z = pk2(sacc[k2][8 * cc + 4], sacc[k2][8 * cc + 5]); pw.w = pk2(sacc[k2][8 * cc + 6], sacc[k2][8 * cc + 7]);
                        const bf16x8 pf = __builtin_bit_cast(bf16x8, pw);
                        const int key0 = 32 * kt + 16 * cc + 4 * half;
#pragma unroll
                        for (int dt = 0; dt < 2; ++dt) { const LAS unsigned char* vb = Vt + (32 * dt + qi) * VT_PITCH + key0 * 2;
                            const u32x2 va = *(const LAS u32x2*)vb, vb2 = *(const LAS u32x2*)(vb + 16);
                            u32x4 vw; vw.x = va.x; vw.y = va.y; vw.z = vb2.x; vw.w = vb2.y;
                            oacc[dt] = __builtin_amdgcn_mfma_f32_32x32x16_bf16(__builtin_bit_cast(bf16x8, vw), pf, oacc[dt], 0, 0, 0); } } }
            }
            const float mx = mrun;
            lsum += __shfl_xor(lsum, 32);
            const float inv = 1.0f / lsum;
            if (valid) {
                bf16_t* op = PO + ((size_t)slot * T + tok) * CW + h * 64;
#pragma unroll
                for (int dt = 0; dt < 2; ++dt)
#pragma unroll
                    for (int ig = 0; ig < 4; ++ig) { u32x2 w; w.x = pk2(oacc[dt][4 * ig] * inv, oacc[dt][4 * ig + 1] * inv); w.y = pk2(oacc[dt][4 * ig + 2] * inv, oacc[dt][4 * ig + 3] * inv);
                        *(u32x2*)(op + 32 * dt + 8 * ig + 4 * half) = w; }
                if (half == 0) PST[((size_t)slot * T + tok) * 8 + h] = (f32x2){mx, lsum};
            }
        }
    }
}
DI void phase_moba_combine(Frame& F) {
    const bf16_t* PO = (const bf16_t*)(F.wsp() + WS_PO); const f32x2* PST = (const f32x2*)(F.wsp() + WS_PST); const unsigned* SEL = (const unsigned*)(F.wsp() + WS_SEL);
    bf16_t* YM = (bf16_t*)(F.wsp() + WS_YRM) + 512;
    int c = F.tid; const int h = c >> 6;
    for (int tb = F.bid * 8; tb < T; tb += F.G * 8) {
        int tbase = tb; asm volatile("" : "+s"(tbase), "+v"(c));
        int nv[8]; f32x2 st[8][4]; float po[8][4];
#pragma unroll
        for (int e = 0; e < 8; ++e) { const int t = tbase + e; nv[e] = (int)(SEL[(size_t)t * 8 + h] >> 24);
#pragma unroll
            for (int s = 0; s < 4; ++s) { st[e][s] = PST[((size_t)s * T + t) * 8 + h]; po[e][s] = bf2f(PO[((size_t)s * T + t) * CW + c]); } }
#pragma unroll
        for (int e = 0; e < 8; ++e) { const int t = tbase + e; float M = -1e30f;
#pragma unroll
            for (int s = 0; s < 4; ++s) { const bool on = (s == 3) || (s < nv[e]); if (on) M = fmaxf(M, st[e][s].x); }
            float den = 0.f, num = 0.f;
#pragma unroll
            for (int s = 0; s < 4; ++s) { const bool on = (s == 3) || (s < nv[e]); if (on) { const float w = st[e][s].y * __expf(st[e][s].x - M); den += w; num += w * po[e][s]; } }
            YM[(size_t)t * YRM_LD + c] = f2bf(num / den); }
    }
}
DI void phase_router(Frame& F, int l) {
    LAS float* xs = (LAS float*)F.lds;
    LAS float* wsm = xs + 64 * 129;
    LAS float* lgt = wsm + 128 * 36;
    LAS float* ssq = lgt + 64 * 37;
    LAS int* hist = (LAS int*)(ssq + 64);
    const float* x = F.outp(); const float* gain = F.inp(2) + (size_t)l * DM;
    const float* wgrp = F.inp(29) + (size_t)l * DM * 4; const float* wexp = F.inp(31) + (size_t)l * DM * 32;
    const float* bgrp = F.inp(30) + l * 4; const float* bexp = F.inp(32) + l * 32;
    int* EID = (int*)(F.wsp() + WS_RT + RT_EID); float* GATE = (float*)(F.wsp() + WS_RT + RT_GATE); int* HIST = (int*)(F.wsp() + WS_RT + RT_HIST);
    const int tok = F.tid & 63, jg = F.tid >> 6;
    for (int tile = F.bid; tile < T / 64; tile += F.G) {
        const int t0 = tile * 64;
        float acc[5] = {0.f, 0.f, 0.f, 0.f, 0.f}; float ss = 0.f;
        if (F.tid < 32) hist[F.tid] = 0;
        for (int kc = 0; kc < DM; kc += 128) {
            __syncthreads();
            for (int idx = F.tid; idx < 64 * 128; idx += 512) { const int r = idx >> 7, k = idx & 127; xs[r * 129 + k] = x[(size_t)(t0 + r) * DM + kc + k]; }
            for (int idx = F.tid; idx < 128 * 36; idx += 512) { const int k = idx / 36, j = idx - k * 36; const float g = gain[kc + k];
                wsm[idx] = g * (j < 4 ? wgrp[(size_t)(kc + k) * 4 + j] : wexp[(size_t)(kc + k) * 32 + (j - 4)]); }
            __syncthreads();
            for (int k = 0; k < 128; ++k) { const float xv = xs[tok * 129 + k]; ss += xv * xv;
#pragma unroll
                for (int i = 0; i < 5; ++i) { const int j = jg + 8 * i; if (j < 36) acc[i] += xv * wsm[k * 36 + j]; } }
        }
#pragma unroll
        for (int i = 0; i < 5; ++i) { const int j = jg + 8 * i; if (j < 36) lgt[tok * 37 + j] = acc[i]; }
        if (jg == 0) ssq[tok] = ss;
        __syncthreads();
        if (F.tid < 64) {
            const int t = t0 + F.tid; const float rs = 1.0f / sqrtf(ssq[F.tid] * (1.f / DM) + 1e-6f);
            float lg[4]; int gs = 0; float gm = -INFINITY;
#pragma unroll
            for (int g = 0; g < 4; ++g) { lg[g] = lgt[F.tid * 37 + g] * rs + bgrp[g]; if (lg[g] > gm) { gm = lg[g]; gs = g; } }
            float gden = 0.f;
#pragma unroll
            for (int g = 0; g < 4; ++g) gden += expf(lg[g] - gm);
            const float ptop = 1.0f / gden;
            float le[8]; float e0 = -INFINITY, e1 = -INFINITY; int j0 = 0, j1 = 1;
#pragma unroll
            for (int e = 0; e < 8; ++e) { le[e] = lgt[F.tid * 37 + 4 + gs * 8 + e] * rs + bexp[gs * 8 + e];
                if (le[e] > e0) { e1 = e0; j1 = j0; e0 = le[e]; j0 = e; } else if (le[e] > e1) { e1 = le[e]; j1 = e; } }
            const float p1 = expf(e1 - e0);
            const float g0 = ptop / (1.f + p1), g1 = ptop * p1 / (1.f + p1);
            const int ex0 = gs * 8 + j0, ex1 = gs * 8 + j1;
            EID[t * 2] = ex0; EID[t * 2 + 1] = ex1; GATE[t * 2] = g0; GATE[t * 2 + 1] = g1;
            __hip_atomic_fetch_add(&hist[ex0], 1, __ATOMIC_RELAXED, __HIP_MEMORY_SCOPE_WORKGROUP); __hip_atomic_fetch_add(&hist[ex1], 1, __ATOMIC_RELAXED, __HIP_MEMORY_SCOPE_WORKGROUP);
        }
        __syncthreads();
        if (F.tid < 32) HIST[tile * 32 + F.tid] = hist[F.tid];
        __syncthreads();
    }
}
DI void phase_moe_gather(Frame& F, int l) {
    LAS int* tot = (LAS int*)F.lds; LAS int* off = tot + 32; LAS int* base = off + 32; LAS int* eidl = base + 32; LAS int* rowl = eidl + 128; LAS int* ps = rowl + 128; LAS int* po = ps + 512;
    const int* EID = (const int*)(F.wsp() + WS_RT + RT_EID); const float* GATE = (const float*)(F.wsp() + WS_RT + RT_GATE); const int* HIST = (const int*)(F.wsp() + WS_RT + RT_HIST);
    int* ROW = (int*)(F.wsp() + WS_RT + RT_ROW); float* GW = (float*)(F.wsp() + WS_RT + RT_GW); int* PEXP = (int*)(F.wsp() + WS_RT + RT_PEXP);
    int* TOK = (int*)(F.wsp() + WS_RT + RT_TOK);
    for (int tile = F.bid; tile < T / 64; tile += F.G) {
        const int t0 = tile * 64;
        __syncthreads();
        { const int e = F.tid & 31, part = F.tid >> 5; int s = 0, o = 0;
#pragma unroll 8
          for (int i = part * 32; i < part * 32 + 32; ++i) { const int v = HIST[i * 32 + e]; s += v; if (i < tile) o += v; }
          ps[F.tid] = s; po[F.tid] = o; }
        if (F.tid < 128) eidl[F.tid] = EID[t0 * 2 + F.tid];
        __syncthreads();
        if (F.tid < 32) { int s = 0, o = 0;
#pragma unroll
            for (int p = 0; p < 16; ++p) { s += ps[p * 32 + F.tid]; o += po[p * 32 + F.tid]; } tot[F.tid] = s; off[F.tid] = o; }
        __syncthreads();
        if (F.tid == 0) {
            int bs = 0; for (int e = 0; e < 32; ++e) { base[e] = bs; bs += (tot[e] + 255) & ~255; }
            if (tile == 0) { int p = 0; for (int e = 0; e < 32; ++e) { const int np = (tot[e] + 255) >> 8; for (int i = 0; i < np; ++i) PEXP[p++] = e; } PEXP[MOE_PANELS] = p; }
        }
        __syncthreads();
        if (F.tid < 128) { const int my = eidl[F.tid]; int rank = 0; for (int i = 0; i < F.tid; ++i) rank += (eidl[i] == my) ? 1 : 0;
            const int r = base[my] + off[my] + rank; rowl[F.tid] = r; ROW[t0 * 2 + F.tid] = r; GW[r] = GATE[t0 * 2 + F.tid]; TOK[r] = t0 + (F.tid >> 1); }
    }
}
DI void phase_moe_combine(Frame& F, int l) {
    const bf16_t* YE = (const bf16_t*)(F.wsp() + WS_YE); const int* ROW = (const int*)(F.wsp() + WS_RT + RT_ROW); bf16_t* XN = (bf16_t*)(F.wsp() + WS_XN);
    const float* gain = F.inp(1) + (size_t)(l + 1 < NLAYER ? l + 1 : l) * DM;
    const int gw = F.bid * 8 + F.wave, NGW = F.G * 8; int lane = F.lane;
    for (int tb = gw * 4; tb < T; tb += NGW * 4) {
        int tbase = tb; asm volatile("" : "+s"(tbase), "+v"(lane));
        int r0[4], r1[4];
#pragma unroll
        for (int e = 0; e < 4; ++e) { r0[e] = ROW[(tbase + e) * 2]; r1[e] = ROW[(tbase + e) * 2 + 1]; }
        u32x2 ya[4][4], yb[4][4]; f32x4 xv[4][4];
#pragma unroll
        for (int e = 0; e < 4; ++e) { const u32x2* y0 = (const u32x2*)(YE + (size_t)r0[e] * DM) + lane; const u32x2* y1 = (const u32x2*)(YE + (size_t)r1[e] * DM) + lane; const f32x4* xr = (const f32x4*)(F.outp() + (size_t)(tbase + e) * DM) + lane;
#pragma unroll
            for (int j = 0; j < 4; ++j) { ya[e][j] = y0[64 * j]; yb[e][j] = y1[64 * j]; xv[e][j] = xr[64 * j]; } }
#pragma unroll
        for (int e = 0; e < 4; ++e) { const int t = tbase + e; f32x4* xr = (f32x4*)(F.outp() + (size_t)t * DM) + lane; float s = 0.f;
#pragma unroll
            for (int j = 0; j < 4; ++j) { f32x4 v = xv[e][j]; const u32x2 a = ya[e][j], b = yb[e][j];
                v.x += bflo(a.x) + bflo(b.x); v.y += bfhi(a.x) + bfhi(b.x); v.z += bflo(a.y) + bflo(b.y); v.w += bfhi(a.y) + bfhi(b.y);
                xv[e][j] = v; xr[64 * j] = v; s += (v.x * v.x + v.y * v.y) + (v.z * v.z + v.w * v.w); }
            if (l + 1 < NLAYER) {
                const float rs = __builtin_amdgcn_rsqf(wave_sum(s) * (1.f / DM) + 1e-6f);
#pragma unroll
                for (int j = 0; j < 4; ++j) { const f32x4 g = ((const f32x4*)gain)[lane + 64 * j]; const f32x4 y = xv[e][j] * rs * g; u32x2 w; w.x = pk2(y.x, y.y); w.y = pk2(y.z, y.w); *((u32x2*)(XN + (size_t)t * DM) + lane + 64 * j) = w; }
            } }
    }
}
constexpr size_t TB_WRH = 512 * 1024, TB_WRL = TB_WRH + 48 * 1024 * 2;
DI void phase_conv_router(Frame& F, int l) {
    bf16_t* WRH = (bf16_t*)(F.wsp() + WS_TAB + TB_WRH); bf16_t* WRL = (bf16_t*)(F.wsp() + WS_TAB + TB_WRL);
    const float* gain = F.inp(2) + (size_t)l * DM; const float* wgrp = F.inp(29) + (size_t)l * DM * 4; const float* wexp = F.inp(31) + (size_t)l * DM * 32;
    for (int idx = F.bid * 512 + F.tid; idx < 48 * DM; idx += F.G * 512) { const int n = idx >> 10, k = idx & 1023;
        float v = (n < 4) ? wgrp[k * 4 + n] : (n < 36) ? wexp[k * 32 + (n - 4)] : 0.f; v *= gain[k];
        const bf16_t h = f2bf(v); WRH[idx] = h; WRL[idx] = f2bf(v - bf2f(h)); }
}
DI void phase_router2(Frame& F, int l) {
    LAS float* lgt = (LAS float*)F.lds + F.wave * 1024;
    LAS int* hist = (LAS int*)(F.lds + 8 * 4096);
    const float* x = F.outp(); const bf16_t* WRH = (const bf16_t*)(F.wsp() + WS_TAB + TB_WRH); const bf16_t* WRL = (const bf16_t*)(F.wsp() + WS_TAB + TB_WRL);
    const float* bgrp = F.inp(30) + l * 4; const float* bexp = F.inp(32) + l * 32;
    int* EID = (int*)(F.wsp() + WS_RT + RT_EID); float* GATE = (float*)(F.wsp() + WS_RT + RT_GATE); int* HIST = (int*)(F.wsp() + WS_RT + RT_HIST);
    const int lane = F.lane, r16 = lane & 15, g = lane >> 4;
    bf16_t* XN2 = (bf16_t*)(F.wsp() + WS_AM); const float* gain = F.inp(2) + (size_t)l * DM;
    { int* TOK = (int*)(F.wsp() + WS_RT + RT_TOK); for (int i = F.bid * 512 + F.tid; i < MOE_ROWS; i += F.G * 512) TOK[i] = 0; }
    for (int task = F.bid; task < T / 128; task += F.G) {
        const int t0 = task * 128 + F.wave * 16;
        __syncthreads();
        if (F.tid < 64) hist[F.tid] = 0;
        __syncthreads();
        f32x4 acc[3];
#pragma unroll
        for (int nt = 0; nt < 3; ++nt) acc[nt] = (f32x4){0.f, 0.f, 0.f, 0.f};
        float ss = 0.f;
        const float* xr = x + (size_t)(t0 + r16) * DM + 8 * g;
#pragma unroll 2
        for (int s = 0; s < 32; ++s) {
            const f32x4 x0 = *(const f32x4*)(xr + 32 * s), x1 = *(const f32x4*)(xr + 32 * s + 4);
            ss += (x0.x * x0.x + x0.y * x0.y) + (x0.z * x0.z + x0.w * x0.w) + (x1.x * x1.x + x1.y * x1.y) + (x1.z * x1.z + x1.w * x1.w);
            u32x4 hw, lw; hw.x = pk2(x0.x, x0.y); hw.y = pk2(x0.z, x0.w); hw.z = pk2(x1.x, x1.y); hw.w = pk2(x1.z, x1.w);
            lw.x = pk2(x0.x - bflo(hw.x), x0.y - bfhi(hw.x)); lw.y = pk2(x0.z - bflo(hw.y), x0.w - bfhi(hw.y)); lw.z = pk2(x1.x - bflo(hw.z), x1.y - bfhi(hw.z)); lw.w = pk2(x1.z - bflo(hw.w), x1.w - bfhi(hw.w));
            const bf16x8 ah = __builtin_bit_cast(bf16x8, hw), al = __builtin_bit_cast(bf16x8, lw);
#pragma unroll
            for (int nt = 0; nt < 3; ++nt) { const size_t wo = (size_t)(16 * nt + r16) * DM + 32 * s + 8 * g;
                const bf16x8 bh = *(const bf16x8*)(WRH + wo), bl = *(const bf16x8*)(WRL + wo);
                acc[nt] = mfma16(ah, bh, acc[nt]); acc[nt] = mfma16(ah, bl, acc[nt]); acc[nt] = mfma16(al, bh, acc[nt]); }
        }
        ss += __shfl_xor(ss, 16); ss += __shfl_xor(ss, 32);
        {
          const float rs = __builtin_amdgcn_rsqf(ss * (1.f / DM) + 1e-6f); bf16_t* xo = XN2 + (size_t)(t0 + r16) * DM + 8 * g; const float* gp = gain + 8 * g;
#pragma unroll 4
          for (int s = 0; s < 32; ++s) { const f32x4 x0 = *(const f32x4*)(xr + 32 * s), x1 = *(const f32x4*)(xr + 32 * s + 4); const f32x4 g0 = *(const f32x4*)(gp + 32 * s), g1 = *(const f32x4*)(gp + 32 * s + 4);
              u32x4 w; w.x = pk2(x0.x * rs * g0.x, x0.y * rs * g0.y); w.y = pk2(x0.z * rs * g0.z, x0.w * rs * g0.w); w.z = pk2(x1.x * rs * g1.x, x1.y * rs * g1.y); w.w = pk2(x1.z * rs * g1.z, x1.w * rs * g1.w);
              *(u32x4*)(xo + 32 * s) = w; } }
#pragma unroll
        for (int nt = 0; nt < 3; ++nt)
#pragma unroll
            for (int r = 0; r < 4; ++r) lgt[(4 * g + r) * 48 + 16 * nt + r16] = acc[nt][r];
        if (g == 0) lgt[768 + r16] = ss;
        LDS_WAIT(); asm volatile("" ::: "memory");
        if (lane < 16) {
            const int t = t0 + lane; const float rs = 1.0f / sqrtf(lgt[768 + lane] * (1.f / DM) + 1e-6f); const LAS float* lr = lgt + lane * 48;
            float lg[4]; int gs = 0; float gm = -INFINITY;
#pragma unroll
            for (int q = 0; q < 4; ++q) { lg[q] = lr[q] * rs + bgrp[q]; if (lg[q] > gm) { gm = lg[q]; gs = q; } }
            float gden = 0.f;
#pragma unroll
            for (int q = 0; q < 4; ++q) gden += expf(lg[q] - gm);
            const float ptop = 1.0f / gden;
            float e0 = -INFINITY, e1 = -INFINITY; int j0 = 0, j1 = 1;
#pragma unroll
            for (int e = 0; e < 8; ++e) { const float le = lr[4 + gs * 8 + e] * rs + bexp[gs * 8 + e];
                if (le > e0) { e1 = e0; j1 = j0; e0 = le; j0 = e; } else if (le > e1) { e1 = le; j1 = e; } }
            const float p1 = expf(e1 - e0);
            const float g0 = ptop / (1.f + p1), g1 = ptop * p1 / (1.f + p1);
            const int ex0 = gs * 8 + j0, ex1 = gs * 8 + j1;
            EID[t * 2] = ex0; EID[t * 2 + 1] = ex1; GATE[t * 2] = g0; GATE[t * 2 + 1] = g1;
            LAS int* hh = hist + (F.wave >> 2) * 32;
            __hip_atomic_fetch_add(&hh[ex0], 1, __ATOMIC_RELAXED, __HIP_MEMORY_SCOPE_WORKGROUP); __hip_atomic_fetch_add(&hh[ex1], 1, __ATOMIC_RELAXED, __HIP_MEMORY_SCOPE_WORKGROUP);
        }
        __syncthreads();
        if (F.tid < 64) HIST[(task * 2 + (F.tid >> 5)) * 32 + (F.tid & 31)] = hist[F.tid];
    }
}
#ifndef MK_PER_PHASE_LAUNCH
#define MK_PER_PHASE_LAUNCH 0
#endif
constexpr int PH_PER_LAYER = 19, NPHASE = PH_PER_LAYER * NLAYER;
struct Args { const float* in[36]; float* out; unsigned char* ws; int ph_lo, ph_hi; };

#ifndef SCAN_NAIVE
#define SCAN_NAIVE 0
#endif
#ifndef PHMASK
#define PHMASK 0x7ffff
#endif
#ifndef DUPMASK
#define DUPMASK 0
#endif
#define NREP(k) ((((DUPMASK) >> (k)) & 1) ? 2 : 1)
#define IN(k) (((PHMASK >> ((k) % PH_PER_LAYER)) & 1) && lo <= (k) && (k) < hi)
#define SEAM(k) do { asm volatile("" : "+s"(barp), "+s"(bar.x)); bar.bar = (unsigned*)barp; if (IN(k) && IN((k) + 1)) xcd_barrier(bar); asm volatile("" : "+s"(F.ws_g), "+s"(F.out_g), "+s"(F.ka), "+s"(F.bid), "+s"(F.G), "+s"(F.lds)); } while (0)
#define FRESH() do { asm volatile("" : "+s"(F.wave)); int l_ = (int)__builtin_amdgcn_mbcnt_hi(~0u, __builtin_amdgcn_mbcnt_lo(~0u, 0u)); asm volatile("" : "+v"(l_)); F.lane = l_; F.tid = F.wave * 64 + l_; } while (0)
__global__ void __launch_bounds__(512, 2) fwd_kernel(Args args) {
    extern __shared__ __attribute__((aligned(16))) unsigned char lds_raw[];
    Frame F;
    F.lds = (LAS unsigned char*)lds_raw;
    F.tid = threadIdx.x; F.lane = F.tid & 63; F.wave = __builtin_amdgcn_readfirstlane(F.tid >> 6);
    F.G = gridDim.x; F.bid = blockIdx.x;
    F.ka = (const __attribute__((address_space(4))) unsigned char*)__builtin_amdgcn_kernarg_segment_ptr();
    F.out_g = (GAS float*)args.out; F.ws_g = (GAS unsigned char*)args.ws;
    volatile LAS unsigned* MISC = (volatile LAS unsigned*)(F.lds + MISC_OFF);
    if (F.tid < 32) MISC[F.tid] = 0u;
    __syncthreads();
    const int lo = args.ph_lo, hi = args.ph_hi;
    GAS unsigned* barp = (GAS unsigned*)(F.ws_g + WS_CTL) + CW_BAR;
    XcdBarrier bar; bar.bar = (unsigned*)barp; bar.x = 0; bar.st = nullptr;
    if (hi - lo > 1) bar = xcd_barrier_post((unsigned*)barp, MISC + 8);

    bf16_t* const XN = (bf16_t*)(F.wsp() + WS_XN);
    bf16_t* const WCAT = (bf16_t*)(F.wsp() + WS_WM + WM_WCAT);
    for (int l = 0; l < NLAYER; ++l) {
        const int P = l * PH_PER_LAYER;
#define PHASE(k) if (IN(P + (k))) for (int rep_ = 0; rep_ < NREP(k); ++rep_)
        PHASE(0) { FRESH(); if (l == 0) { phase_conv_mixer(F, 0); phase_conv_lora2(F, 0); phase_conv_router(F, 0); phase_norm_x(F, F.inp(0), F.inp(1)); } }
        if (l == 0) SEAM(P + 0);
#if defined(XTRA_BARS)
        if (hi - lo > 1) for (int xb_ = 0; xb_ < XTRA_BARS; ++xb_) { asm volatile("" : "+s"(barp), "+s"(bar.x)); bar.bar = (unsigned*)barp; xcd_barrier(bar); }
#endif
        PHASE(1) { FRESH(); const int n1 = (l == 0) ? 2048 : 2304;
            pg8::Gemm g{XN, WCAT, T, n1, DM}; pg8::StaticOrder S; S.init(T, n1, F.G, F.bid);
            pg8::EpiStore E{(bf16_t*)(F.wsp() + WS_RW), 1536, 1536, (bf16_t*)(F.wsp() + WS_LO), LO_W, 0};
            pg8::gemm_phase<pg8::EpiStore, pg8::StaticOrder>(F.lds, g, S, E, F.tid); }
        SEAM(P + 1);
        PHASE(2) { FRESH(); phase_rwkv_prep2(F, l, F.bid, T / 64, F.G, true); }
        SEAM(P + 2);
#if SCAN_NAIVE
        PHASE(3) { FRESH(); phase_rwkv_scan_naive(F, l); }
        SEAM(P + 3);
        SEAM(P + 4);
        PHASE(5) { FRESH(); phase_rwkv_post(F, l); }
        SEAM(P + 5);
#else
        PHASE(3) { FRESH(); phase_scan_a(F, l, F.bid, NUNIT, F.G); }
        SEAM(P + 3);
        PHASE(4) { FRESH(); phase_scan_b(F); }
        SEAM(P + 4);
        PHASE(5) { FRESH(); phase_scan_c(F, l); }
        SEAM(P + 5);
#endif
        PHASE(6) { FRESH(); pg8::Gemm g{XN, WCAT + (size_t)2304 * DM, T, 1536, DM}; pg8::StaticOrder S; S.init(T, 1536, F.G, F.bid);
            pg8::EpiMoba E{(bf16_t*)(F.wsp() + WS_MO), F.inp(23) + l * 64, F.inp(24) + l * 64, (float*)(F.wsp() + WS_TAB + TB_KMEAN), (int)(TB_KMEAN2 / 4)};
            pg8::gemm_phase<pg8::EpiMoba, pg8::StaticOrder>(F.lds, g, S, E, F.tid); }
        SEAM(P + 6);
        PHASE(8) { FRESH(); phase_moba_gate(F); }
        SEAM(P + 8);
        PHASE(9) { FRESH(); phase_moba_attn(F, l); }
        SEAM(P + 9);
        PHASE(10) { FRESH(); phase_moba_combine(F); }
        SEAM(P + 10);
        PHASE(11) { FRESH(); pg8::Gemm g{XN, WCAT + (size_t)3840 * DM, T, 2048, DM}; pg8::StaticOrder S; S.init(T, 2048, F.G, F.bid);
            pg8::EpiStore E{(bf16_t*)(F.wsp() + WS_GA), 2048, 0, nullptr, 0, 1};
            pg8::gemm_phase<pg8::EpiStore, pg8::StaticOrder>(F.lds, g, S, E, F.tid); }
        SEAM(P + 11);
        PHASE(12) { FRESH(); pg8::Gemm g{(const bf16_t*)(F.wsp() + WS_YRM), (const bf16_t*)(F.wsp() + WS_WM + WM_BRR), T, DM, DM}; pg8::StaticOrder S; S.init(T, DM, F.G, F.bid);
            pg8::EpiBranch2 E{(bf16_t*)(F.wsp() + WS_H), (const bf16_t*)(F.wsp() + WS_GA)};
            pg8::gemm_phase<pg8::EpiBranch2, pg8::StaticOrder>(F.lds, g, S, E, F.tid); }
        SEAM(P + 12);
        PHASE(13) { FRESH(); pg8::Gemm g{(const bf16_t*)(F.wsp() + WS_H), (const bf16_t*)(F.wsp() + WS_WM + WM_OUT), T, DM, DM}; pg8::StaticOrder S; S.init(T, DM, F.G, F.bid);
            pg8::EpiResid E{l == 0 ? F.inp(0) : F.outp(), F.outp()};
            pg8::gemm_phase<pg8::EpiResid, pg8::StaticOrder>(F.lds, g, S, E, F.tid); }
        SEAM(P + 13);
        PHASE(14) { FRESH(); phase_router2(F, l); phase_conv_experts(F, l); }
        SEAM(P + 14);
        PHASE(15) { FRESH(); phase_moe_gather(F, l); }
        SEAM(P + 15);
        PHASE(16) { FRESH(); const int* PEXP = (const int*)(F.wsp() + WS_RT + RT_PEXP); const int np = __builtin_amdgcn_readfirstlane(PEXP[MOE_PANELS]);
            pg8::Gemm g{(const bf16_t*)(F.wsp() + WS_AM), (const bf16_t*)(F.wsp() + WS_WE), np * 256, 1024, DM}; pg8::GatherOrder S; S.init(np * 256, 1024, F.G, F.bid); S.pexp = PEXP;
            LAS int* tokL = (LAS int*)(F.lds + RING_BYTES); S.tokL = tokL;
            { const int* TOK = (const int*)(F.wsp() + WS_RT + RT_TOK); __syncthreads();
              for (int i = 0; i < 16; ++i) { pg8::Unit uu; if (!S.next(i, uu)) break; if (F.tid < 256) tokL[i * 256 + F.tid] = TOK[uu.pm * 256 + F.tid]; }
              __syncthreads(); }
            pg8::EpiExpertUp E{(bf16_t*)(F.wsp() + WS_HM), (const float*)(F.wsp() + WS_RT + RT_GW)};
            pg8::gemm_phase<pg8::EpiExpertUp, pg8::GatherOrder>(F.lds, g, S, E, F.tid); }
        SEAM(P + 16);
        PHASE(17) { FRESH(); const int* PEXP = (const int*)(F.wsp() + WS_RT + RT_PEXP); const int np = __builtin_amdgcn_readfirstlane(PEXP[MOE_PANELS]);
            pg8::Gemm g{(const bf16_t*)(F.wsp() + WS_HM), (const bf16_t*)(F.wsp() + WS_WD), np * 256, 1024, DEXP}; pg8::GroupOrder S; S.init(np * 256, 1024, F.G, F.bid); S.pexp = PEXP;
            pg8::EpiStore E{(bf16_t*)(F.wsp() + WS_YE), 1024, 0, nullptr, 0, 0};
            pg8::gemm_phase<pg8::EpiStore, pg8::GroupOrder>(F.lds, g, S, E, F.tid); }
        SEAM(P + 17);
        PHASE(18) { FRESH(); phase_moe_combine(F, l); if (l + 1 < NLAYER) { phase_conv_mixer(F, l + 1); phase_conv_lora2(F, l + 1); phase_conv_router(F, l + 1); } }
        SEAM(P + 18);
#undef PHASE
    }
}

extern "C" void kernel_launch(void* const* d_in, const int* in_sizes, int n_in, void* d_out, int out_size, void* d_ws, size_t ws_size, hipStream_t stream) {
    static int grid = 0;
    if (grid == 0) {
        if (n_in != 36 || out_size != T * DM || ws_size < WS_NEED) { fprintf(stderr, "kernel_launch: unexpected problem (n_in %d, out %d, ws %zu); nothing launched\n", n_in, out_size, ws_size); grid = -1; return; }
        int dev = 0, cus = 0;
        if (hipGetDevice(&dev) != hipSuccess || hipDeviceGetAttribute(&cus, hipDeviceAttributeMultiprocessorCount, dev) != hipSuccess) { grid = -1; return; }
        if (hipFuncSetAttribute((const void*)fwd_kernel, hipFuncAttributeMaxDynamicSharedMemorySize, LDS_BYTES) != hipSuccess) { fprintf(stderr, "kernel_launch: hipFuncSetAttribute failed\n"); grid = -1; return; }
        int per_cu = 0;
        if (hipOccupancyMaxActiveBlocksPerMultiprocessor(&per_cu, (const void*)fwd_kernel, 512, LDS_BYTES) != hipSuccess || per_cu < 1) { fprintf(stderr, "kernel_launch: occupancy query says %d\n", per_cu); }
        (void)hipGetLastError();
        grid = cus;
    }
    if (grid < 0) return;
    (void)hipMemsetAsync((char*)d_ws + WS_CTL, 0, CTL_ZERO_BYTES, stream);
    Args a{};
    for (int i = 0; i < 36; ++i) a.in[i] = (const float*)d_in[i];
    a.out = (float*)d_out; a.ws = (unsigned char*)d_ws;
#if MK_PER_PHASE_LAUNCH
    for (int ph = 0; ph < NPHASE; ++ph) { if (ph == PH_PER_LAYER) continue; a.ph_lo = ph; a.ph_hi = ph + 1; hipLaunchKernelGGL(fwd_kernel, dim3(grid), dim3(512), LDS_BYTES, stream, a); }
#else
    a.ph_lo = 0; a.ph_hi = NPHASE;
    hipLaunchKernelGGL(fwd_kernel, dim3(grid), dim3(512), LDS_BYTES, stream, a);
#endif
}
```

```cpp
#include <hip/hip_runtime.h>
#include <cstdio>
#include <cstdint>
#define LAS __attribute__((address_space(3)))
#define GAS __attribute__((address_space(1)))
#define DI __device__ __forceinline__
typedef unsigned short bf16_t;
typedef short bf16x8 __attribute__((ext_vector_type(8)));
typedef short s16x4 __attribute__((ext_vector_type(4)));
typedef float f32x4 __attribute__((ext_vector_type(4)));
typedef float f32x2 __attribute__((ext_vector_type(2)));
typedef float f32x16 __attribute__((ext_vector_type(16)));
typedef unsigned u32x4 __attribute__((ext_vector_type(4)));
typedef unsigned u32x2 __attribute__((ext_vector_type(2)));
typedef __bf16 bf16v2 __attribute__((ext_vector_type(2)));

DI unsigned pk2(float lo, float hi) { f32x2 v = {lo, hi}; return __builtin_bit_cast(unsigned, __builtin_convertvector(v, bf16v2)); }
DI bf16_t f2bf(float f) { return (bf16_t)(pk2(f, 0.f) & 0xffffu); }
DI float bf2f(bf16_t b) { return __uint_as_float(((unsigned)b) << 16); }
DI float bflo(unsigned w) { return __uint_as_float(w << 16); }
DI float bfhi(unsigned w) { return __uint_as_float(w & 0xffff0000u); }
DI float rcpf_(float x) { return __builtin_amdgcn_rcpf(x); }
DI float sigmoidf_(float x) { return __builtin_amdgcn_rcpf(1.0f + __expf(-x)); }

template <int CTRL> DI float dpp_mov(float v) { return __builtin_bit_cast(float, __builtin_amdgcn_update_dpp(0, __builtin_bit_cast(int, v), CTRL, 0xf, 0xf, true)); }
DI float rdlane(float v, int l) { return __builtin_bit_cast(float, __builtin_amdgcn_readlane(__builtin_bit_cast(int, v), l)); }
DI float wave_sum(float v) {
    v += dpp_mov<0xB1>(v);
    v += dpp_mov<0x4E>(v);
    v += dpp_mov<0x141>(v);
    v += dpp_mov<0x140>(v);
    return (rdlane(v, 0) + rdlane(v, 16)) + (rdlane(v, 32) + rdlane(v, 48));
}
DI f32x4 mfma16(bf16x8 a, bf16x8 b, f32x4 c) { return __builtin_amdgcn_mfma_f32_16x16x32_bf16(a, b, c, 0, 0, 0); }
namespace pg8 {
constexpr int BM = 256, BK = 64, HALF = 128, HTB = HALF * BK * 2  , STAGE_BYTES = 8 * HTB, NXCD = 8, WGM = 8;

__host__ __device__ __forceinline__ int lds_byte(int r, int c) { const int st = (r >> 4) * 2 + (c >> 5), rr = r & 15, cc = c & 31, ob = rr * 64 + cc * 2; return st * 1024 + (ob ^ (((ob >> 9) & 1) << 5)); }
__host__ __device__ __forceinline__ void stage_rc(int b, int& R, int& C) { const int st = b / 1024, sb = b % 1024, swz = sb ^ (((sb >> 9) & 1) << 5); R = (st >> 1) * 16 + swz / 64; C = (st & 1) * 32 + (swz % 64) / 2; }
__host__ __device__ __forceinline__ int perm32(int rho) { const int n = rho >> 4, i = rho & 15; return 8 * (i >> 2) + 4 * n + (i & 3); }

struct Unit { int pm, pn, pb; };
struct Gemm { const bf16_t* A; const bf16_t* Bt; int M, N, K; };

struct StaticOrder {
    static constexpr bool GATHER = false;
    int nM, nN, nwg, G, c;
    __device__ __forceinline__ void init(int M, int N, int G_, int c_) { nM = M / BM; nN = N / BM; nwg = nM * nN; G = G_; c = c_; }
    __device__ __forceinline__ bool next(int i, Unit& u) const {
        const long L = (long)i * G + c; if (L >= nwg) return false;
        int wgid = (int)L; { const int q = nwg / NXCD, r = nwg % NXCD, xcd = wgid % NXCD, off = wgid / NXCD; wgid = (xcd < r ? xcd * (q + 1) : r * (q + 1) + (xcd - r) * q) + off; }
        const int nig = WGM * nN, gid = wgid / nig, fm = gid * WGM, gsz = (nM - fm) < WGM ? (nM - fm) : WGM;
        u.pm = fm + ((wgid % nig) % gsz); u.pn = (wgid % nig) / gsz; u.pb = u.pn; return true;
    }
};
struct GroupOrder : StaticOrder {
    const int* pexp;
    __device__ __forceinline__ bool next(int i, Unit& u) const {
        if (!StaticOrder::next(i, u)) return false;
        u.pb = __builtin_amdgcn_readfirstlane(pexp[u.pm]) * nN + u.pn; return true;
    }
};
struct GatherOrder : GroupOrder {
    static constexpr bool GATHER = true;
    const LAS int* tokL;
};

template <class Epi, class Sched, bool ALIGN_EPI = true, bool SP2 = true>
__device__ __forceinline__ void gemm_phase(LAS unsigned char* lds, const Gemm g, const Sched& S, const Epi& E, int tid_in) {
    const int tid = tid_in, wid = __builtin_amdgcn_readfirstlane(tid >> 6), lane = tid & 63, wr = wid >> 2, wc = wid & 3, fr = lane & 15, fq = lane >> 4;
    const int K = g.K, nt = K / BK;
    unsigned voffA[2], voffB[2];
#pragma unroll
    for (int i = 0; i < 2; ++i) { int R, C; stage_rc(tid * 16 + i * 8192, R, C); const int Rb = Epi::HEADS ? (64 * (R >> 5) + perm32(R & 31)) : Epi::PERM ? ((R & ~31) + perm32(R & 31)) : R;
        voffA[i] = (unsigned)(R * K + C) * 2u; voffB[i] = (unsigned)(Rb * K + C) * 2u; }
    unsigned goff[2][2] = {{0u, 0u}, {0u, 0u}}, goffN[2][2] = {{0u, 0u}, {0u, 0u}};
#define PG8_GOFF(dst, ui_) do { if constexpr (Sched::GATHER) { _Pragma("unroll") for (int h_ = 0; h_ < 2; ++h_) _Pragma("unroll") for (int i_ = 0; i_ < 2; ++i_) { int R_, C_; stage_rc(tid * 16 + i_ * 8192, R_, C_); \
        const int tk_ = S.tokL[(ui_) * 256 + 128 * h_ + R_]; dst[h_][i_] = (unsigned)(tk_ * K + C_) * 2u; } } } while (0)
#define PG8_STAGE_A(bufoff, kt, h, usenext) do { if constexpr (Sched::GATHER) { unsigned vo_[2] = { (usenext) ? goffN[h][0] : goff[h][0], (usenext) ? goffN[h][1] : goff[h][1] }; PG8_STAGE(bufoff, kt, vo_); } \
        else { PG8_STAGE(bufoff, (kt) + ((h) ? hstep : 0), voffA); } } while (0)
    const size_t kstep = (size_t)(BK * 2);
    const size_t hstep = (size_t)HALF * K * 2;
    const size_t hstepB = Epi::HEADS ? (size_t)32 * K * 2 : hstep;
    const size_t tstep = 2 * hstep;
    const unsigned ldsw = (unsigned)wid * 1024u;
    const int aoff = lds_byte(wr * 64 + fr, fq * 8), boff = lds_byte(wc * 32 + fr, fq * 8);
#define PG8_SA(b, h) (((b) * 2 + (h)) * HTB)
#define PG8_SB(b, h) ((4 + (b) * 2 + (h)) * HTB)
#define PG8_STAGE(bufoff, gbase, voff) do { _Pragma("unroll") for (int _i = 0; _i < 2; ++_i) \
        __builtin_amdgcn_global_load_lds((const unsigned*)((const char*)(gbase) + (voff)[_i]), (LAS unsigned*)(lds + (bufoff) + ldsw + _i * 8192), 16, 0, 0); } while (0)
#define PG8_LDA(dst, b, h) do { _Pragma("unroll") for (int m = 0; m < 4; ++m) _Pragma("unroll") for (int k = 0; k < 2; ++k) dst[m][k] = *(const LAS bf16x8*)(lds + PG8_SA(b, h) + aoff + m * 2048 + k * 1024); } while (0)
#define PG8_LDB(dst, b, h) do { _Pragma("unroll") for (int n = 0; n < 2; ++n) _Pragma("unroll") for (int k = 0; k < 2; ++k) dst[n][k] = *(const LAS bf16x8*)(lds + PG8_SB(b, h) + boff + n * 2048 + k * 1024); } while (0)
#define PG8_MMA(ai, bj, At, Bt) do { __builtin_amdgcn_s_setprio(1); _Pragma("unroll") for (int m = 0; m < 4; ++m) _Pragma("unroll") for (int n = 0; n < 2; ++n) _Pragma("unroll") for (int k = 0; k < 2; ++k) \
        acc[ai][bj][m][n] = __builtin_amdgcn_mfma_f32_16x16x32_bf16(Bt[n][k], At[m][k], acc[ai][bj][m][n], 0, 0, 0); __builtin_amdgcn_s_setprio(0); } while (0)
#define PG8_WAIT_V(n) asm volatile("s_waitcnt vmcnt(" #n ")" ::: "memory")
#define PG8_WAIT_L(n) asm volatile("s_waitcnt lgkmcnt(" #n ")" ::: "memory")
#define PG8_BAR __builtin_amdgcn_s_barrier()
#define PG8_SCHED __builtin_amdgcn_sched_barrier(0)
    Unit cur, nxt; int ui = 0;
    if (!S.next(0, cur)) return;
    f32x4 acc[2][2][4][2];
#pragma unroll
    for (int a = 0; a < 2; ++a)
#pragma unroll
        for (int b = 0; b < 2; ++b)
#pragma unroll
            for (int m = 0; m < 4; ++m)
#pragma unroll
                for (int n = 0; n < 2; ++n) acc[a][b][m][n] = (f32x4){0.f, 0.f, 0.f, 0.f};
    bf16x8 At[4][2], B0[2][2], B1[2][2];
    const char* cA = (const char*)g.A + (Sched::GATHER ? (size_t)0 : (size_t)cur.pm * tstep); const char* cB = (const char*)g.Bt + (size_t)cur.pb * tstep;
    PG8_GOFF(goff, 0);
    if constexpr (SP2) {
        PG8_STAGE(PG8_SB(0, 0), cB, voffB); PG8_STAGE(PG8_SB(0, 1), cB + hstepB, voffB); PG8_STAGE_A(PG8_SA(0, 0), cA, 0, false); PG8_STAGE_A(PG8_SA(0, 1), cA, 1, false);
        if (wr == 1) PG8_BAR;
        PG8_WAIT_V(2); PG8_BAR;
        PG8_STAGE(PG8_SB(1, 0), cB + kstep, voffB); PG8_STAGE_A(PG8_SA(1, 0), cA + kstep, 0, false); PG8_STAGE(PG8_SB(1, 1), cB + hstepB + kstep, voffB);
        PG8_WAIT_V(6); PG8_BAR;
    } else {
        PG8_STAGE(PG8_SB(0, 0), cB, voffB); PG8_STAGE_A(PG8_SA(0, 0), cA, 0, false); PG8_STAGE(PG8_SB(0, 1), cB + hstepB, voffB); PG8_STAGE_A(PG8_SA(0, 1), cA, 1, false);
        if (wr == 1) PG8_BAR;
        PG8_WAIT_V(4); PG8_BAR;
        PG8_STAGE(PG8_SB(1, 0), cB + kstep, voffB); PG8_STAGE_A(PG8_SA(1, 0), cA + kstep, 0, false); PG8_STAGE(PG8_SB(1, 1), cB + hstepB + kstep, voffB);
        PG8_WAIT_V(6); PG8_BAR;
    }
    for (;;) {
        const bool has_next = S.next(ui + 1, nxt);
        const char* nA = (has_next && !Sched::GATHER) ? (const char*)g.A + (size_t)nxt.pm * tstep : cA; const char* nB = has_next ? (const char*)g.Bt + (size_t)nxt.pb * tstep : cB;
        if constexpr (Sched::GATHER) { if (has_next) PG8_GOFF(goffN, ui + 1); else { goffN[0][0] = goff[0][0]; goffN[0][1] = goff[0][1]; goffN[1][0] = goff[1][0]; goffN[1][1] = goff[1][1]; } }
        for (int t = 0; t < nt; t += 2) {
            if constexpr (Epi::HAS_MID) { if (t == nt / 2) E.mid(acc, cur, wr, wc, fr, fq); }
            const bool last = (t == nt - 2);
            const char* a1 = cA + (size_t)(t + 1) * kstep;
            const char* a2 = last ? nA : cA + (size_t)(t + 2) * kstep; const char* b2 = last ? nB : cB + (size_t)(t + 2) * kstep;
            const char* a3 = a2 + kstep; const char* b3 = b2 + kstep;
            if constexpr (SP2) {
            PG8_LDB(B0, 0, 0); PG8_LDB(B1, 0, 1); PG8_SCHED; PG8_LDA(At, 0, 0); PG8_STAGE_A(PG8_SA(1, 1), a1, 1, false);
            PG8_WAIT_V(8); PG8_WAIT_L(0); PG8_BAR; PG8_MMA(0, 0, At, B0); PG8_MMA(0, 1, At, B1); PG8_BAR; PG8_SCHED;
            PG8_LDA(At, 0, 1); PG8_STAGE(PG8_SB(0, 0), b2, voffB); PG8_STAGE(PG8_SB(0, 1), b2 + hstepB, voffB); PG8_STAGE_A(PG8_SA(0, 0), a2, 0, last);
            PG8_WAIT_V(8); PG8_WAIT_L(0); PG8_BAR; PG8_MMA(1, 0, At, B0); PG8_MMA(1, 1, At, B1); PG8_BAR; PG8_SCHED;
            PG8_LDB(B0, 1, 0); PG8_LDB(B1, 1, 1); PG8_SCHED; PG8_LDA(At, 1, 0); PG8_STAGE_A(PG8_SA(0, 1), a2, 1, last);
            PG8_WAIT_V(8); PG8_WAIT_L(0); PG8_BAR; PG8_MMA(0, 0, At, B0); PG8_MMA(0, 1, At, B1); PG8_BAR; PG8_SCHED;
            PG8_LDA(At, 1, 1); PG8_STAGE(PG8_SB(1, 0), b3, voffB); PG8_STAGE(PG8_SB(1, 1), b3 + hstepB, voffB); PG8_STAGE_A(PG8_SA(1, 0), a3, 0, last);
            PG8_WAIT_V(8); PG8_WAIT_L(0); PG8_BAR; PG8_MMA(1, 0, At, B0); PG8_MMA(1, 1, At, B1); PG8_BAR; PG8_SCHED;
            } else {
            PG8_LDB(B0, 0, 0); PG8_SCHED; PG8_LDA(At, 0, 0); PG8_STAGE_A(PG8_SA(1, 1), a1, 1, false);
            PG8_WAIT_L(8); PG8_BAR; PG8_WAIT_L(0); PG8_MMA(0, 0, At, B0); PG8_BAR; PG8_SCHED;
            PG8_LDB(B1, 0, 1); PG8_STAGE(PG8_SB(0, 0), b2, voffB);
            PG8_BAR; PG8_WAIT_L(0); PG8_MMA(0, 1, At, B1); PG8_BAR;
            PG8_LDA(At, 0, 1); PG8_STAGE_A(PG8_SA(0, 0), a2, 0, last);
            PG8_BAR; PG8_WAIT_L(0); PG8_MMA(1, 0, At, B0); PG8_BAR; PG8_SCHED;
            PG8_STAGE(PG8_SB(0, 1), b2 + hstepB, voffB);
            PG8_WAIT_V(6); PG8_BAR; PG8_MMA(1, 1, At, B1); PG8_BAR;
            PG8_LDB(B0, 1, 0); PG8_SCHED; PG8_LDA(At, 1, 0); PG8_STAGE_A(PG8_SA(0, 1), a2, 1, last);
            PG8_WAIT_L(8); PG8_BAR; PG8_WAIT_L(0); PG8_MMA(0, 0, At, B0); PG8_BAR; PG8_SCHED;
            PG8_LDB(B1, 1, 1); PG8_STAGE(PG8_SB(1, 0), b3, voffB);
            PG8_BAR; PG8_WAIT_L(0); PG8_MMA(0, 1, At, B1); PG8_BAR;
            PG8_LDA(At, 1, 1); PG8_STAGE_A(PG8_SA(1, 0), a3, 0, last);
            PG8_BAR; PG8_WAIT_L(0); PG8_MMA(1, 0, At, B0); PG8_BAR; PG8_SCHED;
            PG8_STAGE(PG8_SB(1, 1), b3 + hstepB, voffB);
            PG8_WAIT_V(6); PG8_BAR; PG8_MMA(1, 1, At, B1); PG8_BAR;
            }
        }
        if constexpr (ALIGN_EPI) { if (wr == 0) PG8_BAR; }
        E(acc, cur, wr, wc, fr, fq);
        if (!has_next) break;
#pragma unroll
        for (int a = 0; a < 2; ++a)
#pragma unroll
            for (int b = 0; b < 2; ++b)
#pragma unroll
                for (int m = 0; m < 4; ++m)
#pragma unroll
                    for (int n = 0; n < 2; ++n) acc[a][b][m][n] = (f32x4){0.f, 0.f, 0.f, 0.f};
        cur = nxt; cA = nA; cB = nB; ++ui;
        if constexpr (Sched::GATHER) { goff[0][0] = goffN[0][0]; goff[0][1] = goffN[0][1]; goff[1][0] = goffN[1][0]; goff[1][1] = goffN[1][1]; }
        if constexpr (ALIGN_EPI) { if (wr == 1) PG8_BAR; }
    }
    PG8_WAIT_V(0);
    if constexpr (!ALIGN_EPI) { if (wr == 0) PG8_BAR; }
    PG8_BAR;
#undef PG8_SA
#undef PG8_GOFF
#undef PG8_STAGE_A
#undef PG8_SB
#undef PG8_STAGE
#undef PG8_LDA
#undef PG8_LDB
#undef PG8_MMA
#undef PG8_WAIT_V
#undef PG8_WAIT_L
#undef PG8_BAR
#undef PG8_SCHED
}
}
#define XB_TMO      128
#define XB_XCNT(j)  (256  + 64 * (j))
#define XB_XSUB(j)  (1280 + 64 * (j))
#define XB_XGEN(j)  (2304 + 64 * (j))
#define XB_TOP      3328
#define XB_TOPGEN   3392
#define XCD_BAR_WORDS 3456
#define XB_SPIN_CAP (1u << 18)

__device__ __forceinline__ unsigned xb_ld(unsigned* p)              { return __hip_atomic_load(p, __ATOMIC_RELAXED, __HIP_MEMORY_SCOPE_AGENT); }
__device__ __forceinline__ unsigned xb_add(unsigned* p, unsigned v) { return __hip_atomic_fetch_add(p, v, __ATOMIC_RELAXED, __HIP_MEMORY_SCOPE_AGENT); }
__device__ __forceinline__ unsigned xb_xcc_id() { return (unsigned)__builtin_amdgcn_s_getreg((3 << 11) | 20) & 0xFu; }
#define XB_SPIN(cond, bar) do { unsigned _sp = 0; while (cond) { __builtin_amdgcn_s_sleep(1); \
    if ((++_sp & 255u) == 0u) { if (xb_ld(&(bar)[XB_TMO])) break; if (_sp > XB_SPIN_CAP) { atomicAdd(&(bar)[XB_TMO], 1u); break; } } } } while (0)

struct XcdBarrier {
    unsigned* bar; unsigned x;
    volatile LAS unsigned* st;
};

__device__ __forceinline__ XcdBarrier xcd_barrier_post(unsigned* bar, volatile LAS unsigned* st) {
    XcdBarrier b; b.bar = bar; b.x = xb_xcc_id(); b.st = st;
    if (threadIdx.x == 0) (void)xb_add(&bar[XB_XCNT(b.x)], 1u);
    return b;
}
__device__ __forceinline__ void xcd_barrier_complete(unsigned* bar, unsigned x, unsigned& nloc, unsigned& nx) {
    const unsigned G = gridDim.x * gridDim.y * gridDim.z;
    unsigned sum, cnt, mine, sp = 0u;
    for (;;) {
        sum = 0u; cnt = 0u; mine = 0u;
#pragma unroll
        for (unsigned j = 0; j < 16; ++j) { const unsigned c = xb_ld(&bar[XB_XCNT(j)]); sum += c; cnt += (c > 0u) ? 1u : 0u; mine = (j == x) ? c : mine; }
        if (sum == G) break;
        __builtin_amdgcn_s_sleep(1);
        if ((++sp & 255u) == 0u) { if (xb_ld(&bar[XB_TMO])) break; if (sp > XB_SPIN_CAP) { atomicAdd(&bar[XB_TMO], 1u); break; } }
    }
    nloc = mine > 0u ? mine : 1u; nx = cnt > 0u ? cnt : 1u;
}

__device__ __forceinline__ void xcd_barrier(const XcdBarrier& b) {
    asm volatile("s_waitcnt vmcnt(0)" ::: "memory");
    __syncthreads();
    if (threadIdx.x == 0) {
        unsigned* bar = b.bar;
        __builtin_amdgcn_s_waitcnt(0);
        unsigned nloc = b.st[0], nx = b.st[1];
        if (nloc == 0u) { xcd_barrier_complete(bar, b.x, nloc, nx); b.st[0] = nloc; b.st[1] = nx; }
        const unsigned old = xb_add(&bar[XB_XSUB(b.x)], 1u);
        const unsigned gen = old / nloc;
        if (old + 1u == (gen + 1u) * nloc) {
            __builtin_amdgcn_fence(__ATOMIC_RELEASE, "agent");
            asm volatile("s_waitcnt vmcnt(0)" ::: "memory");
            const unsigned og = xb_add(&bar[XB_TOP], 1u);
            const unsigned tg = og / nx;
            if (og + 1u == (tg + 1u) * nx) xb_add(&bar[XB_TOPGEN], 1u);
            else XB_SPIN(xb_ld(&bar[XB_TOPGEN]) == tg, bar);
            __builtin_amdgcn_fence(__ATOMIC_ACQUIRE, "agent");
            xb_add(&bar[XB_XGEN(b.x)], 1u);
            asm volatile("s_waitcnt vmcnt(0)" ::: "memory");
        } else {
            XB_SPIN(xb_ld(&bar[XB_XGEN(b.x)]) == gen, bar);
            __builtin_amdgcn_fence(__ATOMIC_ACQUIRE, "agent");
            asm volatile("s_waitcnt vmcnt(0)" ::: "memory");
        }
    }
    __syncthreads();
}
constexpr int NB = 4, SEQ = 8192, DM = 1024, T = NB * SEQ;
constexpr int NH = 8, HD = 64, CW = 512;
constexpr int N_IN = 5120;
constexpr int NLAYER = 2;
constexpr int NEXP = 32, DEXP = 512;
constexpr int MOE_ROWS = 73728, MOE_PANELS = MOE_ROWS / 256;
constexpr int WCAT_ROWS = 5888;
constexpr int LO_W = 768;

constexpr size_t MiB = 1u << 20;
constexpr size_t WS_CTL = 0, CTL_ZERO_BYTES = 1 * MiB;
constexpr size_t WS_VF   = 1 * MiB;
constexpr size_t WS_TAB  = 33 * MiB;
constexpr size_t WS_WM   = 34 * MiB;
constexpr size_t WS_XN   = 50 * MiB;
constexpr size_t WS_RW   = 114 * MiB;
constexpr size_t WS_MO   = 178 * MiB;
constexpr size_t WS_LO   = 210 * MiB;
constexpr size_t WS_YRM  = 114 * MiB;
constexpr int YRM_LD = 1024;
constexpr size_t WS_SIR  = 258 * MiB;
constexpr size_t WS_SIK  = 322 * MiB;
constexpr size_t WS_SCRW = 290 * MiB, WS_SCRA = 306 * MiB, WS_SCRB = 546 * MiB;
constexpr size_t WS_V1   = 418 * MiB;
constexpr size_t WS_G    = 450 * MiB;
constexpr size_t WS_YS   = 482 * MiB;
constexpr size_t WS_PO   = 418 * MiB;
constexpr size_t WS_PST  = 274 * MiB;
constexpr size_t WS_GA   = 418 * MiB;
constexpr size_t WS_H    = 290 * MiB;
constexpr size_t WS_SC1  = 482 * MiB;
constexpr size_t WS_SC2  = 354 * MiB;
constexpr size_t WS_SCT  = 290 * MiB;
constexpr size_t WS_WE   = 34 * MiB;
constexpr size_t WS_WD   = 98 * MiB;
constexpr size_t WS_AM   = 130 * MiB;
constexpr size_t WS_HM   = 274 * MiB;
constexpr size_t WS_YE   = 346 * MiB;
constexpr size_t WS_RT   = 490 * MiB;
constexpr size_t WS_END  = 556 * MiB;
constexpr size_t TB_KMEAN = 0;
constexpr size_t TB_KMEAN2 = 256 * 1024;
constexpr size_t TB_SEL   = 256 * 1024;
constexpr size_t RT_EID  = 0;
constexpr size_t RT_GATE = 256 * 1024;
constexpr size_t RT_ROW  = 512 * 1024;
constexpr size_t RT_GW   = 768 * 1024;
constexpr size_t RT_HIST = 1280 * 1024;
constexpr size_t RT_PEXP = 1408 * 1024;
constexpr size_t RT_TOK  = 1536 * 1024;
constexpr size_t RT_RSQ  = 2048 * 1024;
constexpr size_t RT_RSR  = 2304 * 1024;
constexpr size_t WS_SEL  = 562 * MiB;
constexpr size_t WS_NEED = 564 * MiB;
constexpr int CW_BAR = 4096;

constexpr int RING_BYTES = 131072;
constexpr int LDS_BYTES = 163840;
constexpr int MISC_OFF = LDS_BYTES - 256;
struct Frame {
    LAS unsigned char* lds;
    int tid, lane, wave;
    int G, bid;
    const __attribute__((address_space(4))) unsigned char* ka;
    GAS float* out_g; GAS unsigned char* ws_g;
    DI float* outp() const { return (float*)out_g; }
    DI unsigned char* wsp() const { return (unsigned char*)ws_g; }
    DI const float* inp(int i) const { return (const float*)(*(const GAS float* const __attribute__((address_space(4)))*)(ka + 8 * i)); }
};
#define LDS_WAIT() asm volatile("s_waitcnt lgkmcnt(0)" ::: "memory")

DI void tr_item(const float* src, int ld, int k0, bf16_t* dst, int Kd, const float* sc, int mode, LAS float* scr, int lane) {
#pragma unroll 8
    for (int i = 0; i < 32; ++i) { const int kk = 2 * i + (lane >> 5);
        float v = src ? src[(size_t)(k0 + kk) * ld + (lane & 31)] : 0.f;
        if (mode == 1) v *= sc[k0 + kk]; else if (mode == 2) v *= (1.f - sc[k0 + kk]);
        scr[kk * 33 + (lane & 31)] = v; }
    LDS_WAIT(); asm volatile("" ::: "memory");
    const int c = lane & 7;
#pragma unroll
    for (int j = 0; j < 4; ++j) { const int n = (lane >> 3) + 8 * j; const LAS float* s = scr + (8 * c) * 33 + n;
        u32x4 o; o.x = pk2(s[0 * 33], s[1 * 33]); o.y = pk2(s[2 * 33], s[3 * 33]); o.z = pk2(s[4 * 33], s[5 * 33]); o.w = pk2(s[6 * 33], s[7 * 33]);
        *(u32x4*)(dst + (size_t)n * Kd + k0 + 8 * c) = o; }
    LDS_WAIT(); asm volatile("" ::: "memory");
}

constexpr size_t WM_WCAT = 0, WM_BRR = (size_t)WCAT_ROWS * 1024 * 2, WM_BRM = WM_BRR + 1024 * 512 * 2, WM_OUT = WM_BRM + 1024 * 512 * 2;
DI void phase_conv_mixer(Frame& F, int l) {
    LAS float* scr = (LAS float*)(F.lds + F.wave * 16384);
    const int gw = F.bid * 8 + F.wave, NGW = F.G * 8;
    bf16_t* wcat = (bf16_t*)(F.wsp() + WS_WM + WM_WCAT);
    const float* w_in = F.inp(3) + (size_t)l * DM * N_IN;
    const float* mu_x = F.inp(5) + (size_t)l * 3 * DM;
    constexpr int NBLK = WCAT_ROWS / 32;
    constexpr int I_CAT = NBLK * 16, I_BR = 8 * 32, I_OUT = 16 * 32;
    for (int it = gw; it < I_CAT + 2 * I_BR + I_OUT; it += NGW) {
        int r = it;
        if (r < I_CAT) {
            const int nb = r / 16, kb = r % 16, k0 = kb * 64;
            if (nb < 48) { tr_item(w_in + 32 * nb, N_IN, k0, wcat + (size_t)(32 * nb) * 1024, 1024, nullptr, 0, scr, F.lane); }
            else if (nb < 72) {
                const int q = nb - 48; const float* src = nullptr; int ld = 0; const float* sc = nullptr; int mode = 0;
                if (q < 4)       { src = F.inp(7)  + (size_t)l * DM * 64  + 32 * (q & 1); ld = 64;  sc = mu_x;          mode = (q < 2) ? 2 : 1; }
                else if (q < 8)  { src = F.inp(10) + (size_t)l * DM * 64  + 32 * (q & 1); ld = 64;  sc = mu_x + DM;     mode = (q < 6) ? 2 : 1; }
                else if (q < 16) { src = F.inp(12) + (size_t)l * DM * 128 + 32 * (q & 3); ld = 128; sc = mu_x + 2 * DM; mode = (q < 12) ? 2 : 1; }
                else if (q < 18 && l > 0) { src = F.inp(21) + (size_t)(l - 1) * DM * 32; ld = 32; sc = F.inp(19) + (size_t)(l - 1) * DM; mode = (q == 16) ? 2 : 1; }
                tr_item(src, ld, k0, wcat + (size_t)(1536 + 32 * q) * 1024, 1024, sc, mode, scr, F.lane);
            }
            else if (nb < 120) { tr_item(w_in + 1536 + 32 * (nb - 72), N_IN, k0, wcat + (size_t)(2304 + 32 * (nb - 72)) * 1024, 1024, nullptr, 0, scr, F.lane); }
            else { tr_item(w_in + 3072 + 32 * (nb - 120), N_IN, k0, wcat + (size_t)(3840 + 32 * (nb - 120)) * 1024, 1024, nullptr, 0, scr, F.lane); }
            continue;
        }
        r -= I_CAT;
        if (r < I_BR) { const int nb = r / 8, kb = r % 8; tr_item(F.inp(26) + (size_t)l * 512 * 1024 + 32 * nb, 1024, kb * 64, (bf16_t*)(F.wsp() + WS_WM + WM_BRR) + (size_t)(32 * nb) * 1024, 1024, nullptr, 0, scr, F.lane); continue; }
        r -= I_BR;
        if (r < I_BR) { const int nb = r / 8, kb = r % 8; tr_item(F.inp(27) + (size_t)l * 512 * 1024 + 32 * nb, 1024, kb * 64, (bf16_t*)(F.wsp() + WS_WM + WM_BRR) + (size_t)(32 * nb) * 1024 + 512, 1024, nullptr, 0, scr, F.lane); continue; }
        r -= I_BR;
        { const int nb = r / 16, kb = r % 16; tr_item(F.inp(28) + (size_t)l * 1024 * 1024 + 32 * nb, 1024, kb * 64, (bf16_t*)(F.wsp() + WS_WM + WM_OUT) + (size_t)(32 * nb) * 1024, 1024, nullptr, 0, scr, F.lane); }
    }
}
DI void tr_block(const float* src, int ld, int k0, int n0, bf16_t* dstbase, int Kd, int mode, LAS float* scr, int tid) {
#pragma unroll
    for (int i = 0; i < 8; ++i) { const int idx = tid + 512 * i, row = idx >> 6, c4 = idx & 63;
        const f32x4 v = *(const f32x4*)(src + (size_t)(k0 + row) * ld + n0 + 4 * c4);
        LAS float* d = scr + row * 257 + 4 * c4; d[0] = v.x; d[1] = v.y; d[2] = v.z; d[3] = v.w; }
    __syncthreads();
#pragma unroll
    for (int i = 0; i < 4; ++i) { const int idx = tid + 512 * i, n = idx >> 3, c = idx & 7; const LAS float* sp = scr + (8 * c) * 257 + n;
        u32x4 o; o.x = pk2(sp[0], sp[257]); o.y = pk2(sp[2 * 257], sp[3 * 257]); o.z = pk2(sp[4 * 257], sp[5 * 257]); o.w = pk2(sp[6 * 257], sp[7 * 257]);
        const int h = n0 + n; const int drow = (mode == 2) ? h : ((h >> 7) * 256 + mode * 128 + (h & 127));
        *(u32x4*)(dstbase + (size_t)drow * Kd + k0 + 8 * c) = o; }
    __syncthreads();
}
DI void phase_conv_experts(Frame& F, int l) {
    LAS float* scr = (LAS float*)F.lds;
    bf16_t* we = (bf16_t*)(F.wsp() + WS_WE); bf16_t* wd = (bf16_t*)(F.wsp() + WS_WD);
    const float* wg = F.inp(33) + (size_t)l * NEXP * DM * DEXP; const float* wu = F.inp(34) + (size_t)l * NEXP * DM * DEXP; const float* wdn = F.inp(35) + (size_t)l * NEXP * DEXP * DM;
    __syncthreads();
    for (int it = F.bid; it < NEXP * 96; it += F.G) {
        const int e = it / 96; int r = it % 96;
        if (r < 64) { const int up = r >> 5; r &= 31; const int kb = r >> 1, nb = r & 1;
            tr_block((up ? wu : wg) + (size_t)e * DM * DEXP, DEXP, kb * 64, nb * 256, we + (size_t)e * 1024 * 1024, 1024, up, scr, F.tid); }
        else { r -= 64; const int kb = r >> 2, nb = r & 3;
            tr_block(wdn + (size_t)e * DEXP * DM, DM, kb * 64, nb * 256, wd + (size_t)e * 1024 * 512, 512, 2, scr, F.tid); }
    }
}
DI void rms_row_to_bf16(const float* xrow, const float* gain, bf16_t* o0, bf16_t* o1, int lane) {
    const f32x4* xr = (const f32x4*)xrow + lane; const f32x4* gr = (const f32x4*)gain + lane;
    f32x4 v[4]; float s = 0.f;
#pragma unroll
    for (int j = 0; j < 4; ++j) { v[j] = xr[64 * j]; s += (v[j].x * v[j].x + v[j].y * v[j].y) + (v[j].z * v[j].z + v[j].w * v[j].w); }
    const float rs = 1.0f / sqrtf(wave_sum(s) * (1.f / DM) + 1e-6f);
#pragma unroll
    for (int j = 0; j < 4; ++j) { const f32x4 g = gr[64 * j]; const f32x4 y = v[j] * rs * g;
        u32x2 w; w.x = pk2(y.x, y.y); w.y = pk2(y.z, y.w);
        *((u32x2*)o0 + lane + 64 * j) = w; if (o1) *((u32x2*)o1 + lane + 64 * j) = w; }
}
DI void phase_norm_x(Frame& F, const float* x, const float* gain) {
    const int gw = F.bid * 8 + F.wave, NGW = F.G * 8; bf16_t* xn = (bf16_t*)(F.wsp() + WS_XN);
    for (int m = gw; m < T; m += NGW) rms_row_to_bf16(x + (size_t)m * DM, gain, xn + (size_t)m * DM, nullptr, F.lane);
}

namespace pg8 {
struct EpiStore {
    static constexpr bool PERM = true, HAS_MID = false, HEADS = false;
    bf16_t* O; int ldc; int split; bf16_t* O2; int ldc2; int act;
    __device__ __forceinline__ void operator()(const f32x4 (&acc)[2][2][4][2], const Unit& u, int wr, int wc, int fr, int fq) const {
        const int row0 = u.pm * BM + wr * 64 + fr; int colt = u.pn * BM; bf16_t* base = O; int ld = ldc;
        if (split && colt >= split) { base = O2; ld = ldc2; colt -= split; }
        const int col0 = colt + wc * 32 + 8 * fq;
#pragma unroll
        for (int ai = 0; ai < 2; ++ai)
#pragma unroll
            for (int m = 0; m < 4; ++m) { bf16_t* rowp = base + (size_t)(row0 + ai * HALF + m * 16) * ld + col0;
#pragma unroll
                for (int bj = 0; bj < 2; ++bj) { f32x4 v0 = acc[ai][bj][m][0], v1 = acc[ai][bj][m][1];
                    if (act == 1) {
#pragma unroll
                        for (int j = 0; j < 4; ++j) { v0[j] = sigmoidf_(v0[j]); v1[j] = sigmoidf_(v1[j]); } }
                    u32x4 w; w.x = pk2(v0[0], v0[1]); w.y = pk2(v0[2], v0[3]); w.z = pk2(v1[0], v1[1]); w.w = pk2(v1[2], v1[3]);
                    *(u32x4*)(rowp + bj * HALF) = w; } }
    }
};
struct EpiBranch {
    static constexpr bool PERM = true, HAS_MID = false, HEADS = false;
    bf16_t* Hout; const bf16_t* gate; int gcol0; int first;
    __device__ __forceinline__ void operator()(const f32x4 (&acc)[2][2][4][2], const Unit& u, int wr, int wc, int fr, int fq) const {
        const int row0 = u.pm * BM + wr * 64 + fr; const int col0 = u.pn * BM + wc * 32 + 8 * fq;
#pragma unroll
        for (int ai = 0; ai < 2; ++ai)
#pragma unroll
            for (int m = 0; m < 4; ++m) { const size_t row = (size_t)(row0 + ai * HALF + m * 16);
#pragma unroll
                for (int bj = 0; bj < 2; ++bj) {
                    const u32x4 gv = *(const u32x4*)(gate + row * 2048 + gcol0 + col0 + bj * HALF);
                    bf16_t* hp = Hout + row * 1024 + col0 + bj * HALF;
                    f32x4 v0 = acc[ai][bj][m][0], v1 = acc[ai][bj][m][1];
                    v0[0] *= bflo(gv.x); v0[1] *= bfhi(gv.x); v0[2] *= bflo(gv.y); v0[3] *= bfhi(gv.y);
                    v1[0] *= bflo(gv.z); v1[1] *= bfhi(gv.z); v1[2] *= bflo(gv.w); v1[3] *= bfhi(gv.w);
                    if (!first) { const u32x4 hv = *(const u32x4*)hp;
                        v0[0] += bflo(hv.x); v0[1] += bfhi(hv.x); v0[2] += bflo(hv.y); v0[3] += bfhi(hv.y);
                        v1[0] += bflo(hv.z); v1[1] += bfhi(hv.z); v1[2] += bflo(hv.w); v1[3] += bfhi(hv.w); }
                    u32x4 w; w.x = pk2(v0[0], v0[1]); w.y = pk2(v0[2], v0[3]); w.z = pk2(v1[0], v1[1]); w.w = pk2(v1[2], v1[3]);
                    *(u32x4*)hp = w; } }
    }
};
struct EpiBranch2 {
    static constexpr bool PERM = true, HAS_MID = true, HEADS = false;
    bf16_t* Hout; const bf16_t* gate;
    __device__ __forceinline__ void mid(f32x4 (&acc)[2][2][4][2], const Unit& u, int wr, int wc, int fr_, int fq_) const {
        int fr = fr_, fq = fq_; asm volatile("" : "+v"(fr), "+v"(fq));
        const int row0 = u.pm * BM + wr * 64 + fr; const int col0 = u.pn * BM + wc * 32 + 8 * fq;
#pragma unroll
        for (int ai = 0; ai < 2; ++ai)
#pragma unroll
            for (int m = 0; m < 4; ++m) { const size_t row = (size_t)(row0 + ai * HALF + m * 16);
#pragma unroll
                for (int bj = 0; bj < 2; ++bj) {
                    const u32x4 gr = *(const u32x4*)(gate + row * 2048 + col0 + bj * HALF), gm = *(const u32x4*)(gate + row * 2048 + 1024 + col0 + bj * HALF);
                    const unsigned grw[4] = {gr.x, gr.y, gr.z, gr.w}, gmw[4] = {gm.x, gm.y, gm.z, gm.w};
#pragma unroll
                    for (int q = 0; q < 4; ++q) { const float r0 = bflo(grw[q]) * __builtin_amdgcn_rcpf(fmaxf(bflo(gmw[q]), 1e-30f)), r1 = bfhi(grw[q]) * __builtin_amdgcn_rcpf(fmaxf(bfhi(gmw[q]), 1e-30f));
                        acc[ai][bj][m][q >> 1][2 * (q & 1)] *= r0; acc[ai][bj][m][q >> 1][2 * (q & 1) + 1] *= r1; } }
                asm volatile("" ::: "memory"); }
    }
    __device__ __forceinline__ void operator()(const f32x4 (&acc)[2][2][4][2], const Unit& u, int wr, int wc, int fr, int fq) const {
        const int row0 = u.pm * BM + wr * 64 + fr; const int col0 = u.pn * BM + wc * 32 + 8 * fq;
#pragma unroll
        for (int ai = 0; ai < 2; ++ai)
#pragma unroll
            for (int m = 0; m < 4; ++m) { const size_t row = (size_t)(row0 + ai * HALF + m * 16);
#pragma unroll
                for (int bj = 0; bj < 2; ++bj) {
                    const u32x4 gm = *(const u32x4*)(gate + row * 2048 + 1024 + col0 + bj * HALF);
                    f32x4 v0 = acc[ai][bj][m][0], v1 = acc[ai][bj][m][1];
                    v0[0] *= fmaxf(bflo(gm.x), 1e-30f); v0[1] *= fmaxf(bfhi(gm.x), 1e-30f); v0[2] *= fmaxf(bflo(gm.y), 1e-30f); v0[3] *= fmaxf(bfhi(gm.y), 1e-30f);
                    v1[0] *= fmaxf(bflo(gm.z), 1e-30f); v1[1] *= fmaxf(bfhi(gm.z), 1e-30f); v1[2] *= fmaxf(bflo(gm.w), 1e-30f); v1[3] *= fmaxf(bfhi(gm.w), 1e-30f);
                    u32x4 w; w.x = pk2(v0[0], v0[1]); w.y = pk2(v0[2], v0[3]); w.z = pk2(v1[0], v1[1]); w.w = pk2(v1[2], v1[3]);
                    *(u32x4*)(Hout + row * 1024 + col0 + bj * HALF) = w; } }
    }
};
struct EpiMoba {
    static constexpr bool PERM = true, HAS_MID = false, HEADS = true;
    bf16_t* MO; const float* qgain; const float* kgain; float* KM; int km_half;
    __device__ __forceinline__ void operator()(const f32x4 (&acc)[2][2][4][2], const Unit& u, int wr, int wc, int fr, int fq) const {
        const int row0 = u.pm * BM + wr * 64 + fr; const int kind = u.pn >> 1; const int colb = u.pn * BM + 64 * wc + 8 * fq;
        if (kind == 2) {
#pragma unroll
            for (int ai = 0; ai < 2; ++ai)
#pragma unroll
                for (int m = 0; m < 4; ++m) { bf16_t* rowp = MO + (size_t)(row0 + ai * HALF + m * 16) * 1536 + colb;
#pragma unroll
                    for (int bj = 0; bj < 2; ++bj) { const f32x4 v0 = acc[ai][bj][m][0], v1 = acc[ai][bj][m][1];
                        u32x4 w; w.x = pk2(v0[0], v0[1]); w.y = pk2(v0[2], v0[3]); w.z = pk2(v1[0], v1[1]); w.w = pk2(v1[2], v1[3]); *(u32x4*)(rowp + 32 * bj) = w; } }
            return;
        }
        const float* gp = (kind == 0 ? qgain : kgain) + 8 * fq; const float gs = (kind == 0) ? 0.125f : 1.0f;
        f32x4 gn[2][2];
#pragma unroll
        for (int bj = 0; bj < 2; ++bj)
#pragma unroll
            for (int n = 0; n < 2; ++n) gn[bj][n] = *(const f32x4*)(gp + 32 * bj + 4 * n) * gs;
        f32x4 cs[2][2];
#pragma unroll
        for (int bj = 0; bj < 2; ++bj)
#pragma unroll
            for (int n = 0; n < 2; ++n) cs[bj][n] = (f32x4){0.f, 0.f, 0.f, 0.f};
#pragma unroll
        for (int ai = 0; ai < 2; ++ai)
#pragma unroll
            for (int m = 0; m < 4; ++m) { float ss = 0.f;
#pragma unroll
                for (int bj = 0; bj < 2; ++bj)
#pragma unroll
                    for (int n = 0; n < 2; ++n) { const f32x4 x = acc[ai][bj][m][n]; ss += (x[0] * x[0] + x[1] * x[1]) + (x[2] * x[2] + x[3] * x[3]); }
                ss += __shfl_xor(ss, 16); ss += __shfl_xor(ss, 32);
                const float rs = __builtin_amdgcn_rsqf(ss * (1.f / 64.f) + 1e-6f);
                bf16_t* rowp = MO + (size_t)(row0 + ai * HALF + m * 16) * 1536 + colb;
#pragma unroll
                for (int bj = 0; bj < 2; ++bj) { const f32x4 v0 = acc[ai][bj][m][0] * rs * gn[bj][0], v1 = acc[ai][bj][m][1] * rs * gn[bj][1];
                    cs[bj][0] += v0; cs[bj][1] += v1;
                    u32x4 w; w.x = pk2(v0[0], v0[1]); w.y = pk2(v0[2], v0[3]); w.z = pk2(v1[0], v1[1]); w.w = pk2(v1[2], v1[3]); *(u32x4*)(rowp + 32 * bj) = w; }
                asm volatile("" : "+v"(cs[0][0]), "+v"(cs[0][1]), "+v"(cs[1][0]), "+v"(cs[1][1]));
            }
        if (kind == 1) {
#pragma unroll
            for (int bj = 0; bj < 2; ++bj)
#pragma unroll
                for (int n = 0; n < 2; ++n) { f32x4 t = cs[bj][n];
#pragma unroll
                    for (int j = 0; j < 4; ++j) { float v = t[j]; v += dpp_mov<0xB1>(v); v += dpp_mov<0x4E>(v); v += dpp_mov<0x141>(v); v += dpp_mov<0x140>(v); t[j] = v * (1.f / 256.f); }
                    if (fr == 0) *(f32x4*)(KM + (size_t)wr * km_half + (size_t)u.pm * 512 + (u.pn * BM - 512) + 64 * wc + 32 * bj + 8 * fq + 4 * n) = t; }
        }
    }
};
struct EpiResid {
    static constexpr bool PERM = false, HAS_MID = false, HEADS = false;
    const float* xin; float* out;
    __device__ __forceinline__ void operator()(const f32x4 (&acc)[2][2][4][2], const Unit& u, int wr, int wc, int fr, int fq) const {
        const int row0 = u.pm * BM + wr * 64 + fr, col0 = u.pn * BM + wc * 32 + 4 * fq;
#pragma unroll
        for (int ai = 0; ai < 2; ++ai)
#pragma unroll
            for (int m = 0; m < 4; ++m) { const size_t off = (size_t)(row0 + ai * HALF + m * 16) * 1024 + col0;
#pragma unroll
                for (int bj = 0; bj < 2; ++bj)
#pragma unroll
                    for (int n = 0; n < 2; ++n) { const f32x4 xv = *(const f32x4*)(xin + off + bj * HALF + n * 16); *(f32x4*)(out + off + bj * HALF + n * 16) = xv + acc[ai][bj][m][n]; } }
    }
};
struct EpiExpertUp {
    static constexpr bool PERM = true, HAS_MID = false, HEADS = false;
    bf16_t* HM; const float* gw; const float* rsr;
    __device__ __forceinline__ void operator()(const f32x4 (&acc)[2][2][4][2], const Unit& u, int wr, int wc, int fr, int fq) const {
        const int row0 = u.pm * BM + wr * 64 + fr; const int col0 = u.pn * 128 + wc * 32 + 8 * fq;
#pragma unroll
        for (int ai = 0; ai < 2; ++ai)
#pragma unroll
            for (int m = 0; m < 4; ++m) { const size_t row = (size_t)(row0 + ai * HALF + m * 16); const float rs = rsr[row]; const float gwt = gw[row] * rs;
                f32x4 v0, v1;
#pragma unroll
                for (int j = 0; j < 4; ++j) { const float g0 = acc[ai][0][m][0][j] * rs, g1 = acc[ai][0][m][1][j] * rs;
                    v0[j] = g0 * sigmoidf_(g0) * acc[ai][1][m][0][j] * gwt; v1[j] = g1 * sigmoidf_(g1) * acc[ai][1][m][1][j] * gwt; }
                u32x4 w; w.x = pk2(v0[0], v0[1]); w.y = pk2(v0[2], v0[3]); w.z = pk2(v1[0], v1[1]); w.w = pk2(v1[2], v1[3]);
                *(u32x4*)(HM + row * 512 + col0) = w; }
    }
};
}
constexpr size_t SI_PLANE = (size_t)T * CW * 2;
DI float softplusf_(float z) { return fmaxf(z, 0.f) + __logf(1.0f + __expf(-fabsf(z))); }

#ifndef PREP_DUP
#define PREP_DUP 0
#endif
constexpr int ACT_P = 592;
constexpr size_t WM_L2T = (size_t)WCAT_ROWS * 1024 * 2 + 2 * 1024 * 512 * 2 + 1024 * 1024 * 2;
DI void phase_conv_lora2(Frame& F, int l) {
    bf16_t* L2T = (bf16_t*)(F.wsp() + WS_WM + WM_L2T);
    const float* w2 = F.inp(8) + (size_t)l * 64 * CW; const float* a2 = F.inp(11) + (size_t)l * 64 * CW; const float* g2 = F.inp(13) + (size_t)l * 128 * CW; const float* v2 = F.inp(22);
    for (int idx = F.bid * 512 + F.tid; idx < 288 * CW; idx += F.G * 512) { const int j = idx >> 9, c = idx & 511;
        float v;
        if (j < 64) v = w2[j * CW + c]; else if (j < 128) v = a2[(j - 64) * CW + c]; else if (j < 256) v = g2[(j - 128) * CW + c]; else v = (l > 0) ? v2[(j - 256) * CW + c] : 0.f;
        L2T[c * 288 + j] = f2bf(v); }
}
DI float row16_sum(float v) { v += dpp_mov<0xB1>(v); v += dpp_mov<0x4E>(v); v += dpp_mov<0x141>(v); v += dpp_mov<0x140>(v); return v; }
DI void phase_rwkv_prep2(Frame& F, int l, int tile_lo, int tile_hi, int tile_step, bool init) {
    LAS unsigned char* act = F.lds;
    LAS float* PRM = (LAS float*)(F.lds + 139264);
    const bf16_t* RW = (const bf16_t*)(F.wsp() + WS_RW); const bf16_t* LO = (const bf16_t*)(F.wsp() + WS_LO); const unsigned char* L2T = F.wsp() + WS_WM + WM_L2T;
    bf16_t* SIr = (bf16_t*)(F.wsp() + WS_SIR); bf16_t* SIk = (bf16_t*)(F.wsp() + WS_SIK);
    bf16_t* SCw = (bf16_t*)(F.wsp() + WS_SCRW) + (size_t)F.bid * 64 * CW; bf16_t* SCa = (bf16_t*)(F.wsp() + WS_SCRA) + (size_t)F.bid * 64 * CW; bf16_t* SCb = (bf16_t*)(F.wsp() + WS_SCRB) + (size_t)F.bid * 64 * CW;
    bf16_t* VF = (bf16_t*)(F.wsp() + WS_VF); bf16_t* V1 = (bf16_t*)(F.wsp() + WS_V1); bf16_t* Gb = (bf16_t*)(F.wsp() + WS_G);
    const int lane = F.lane, r16 = lane & 15, g = lane >> 4;
    if (init) { __syncthreads();
      const int c = F.tid;
      PRM[c] = F.inp(4)[(size_t)l * 3 * CW + c]; PRM[512 + c] = F.inp(4)[(size_t)l * 3 * CW + CW + c]; PRM[1024 + c] = F.inp(4)[(size_t)l * 3 * CW + 2 * CW + c];
      PRM[1536 + c] = F.inp(6)[l * CW + c]; PRM[2048 + c] = F.inp(9)[l * CW + c]; PRM[2560 + c] = F.inp(14)[l * CW + c]; PRM[3072 + c] = F.inp(15)[l * CW + c]; PRM[3584 + c] = l > 0 ? F.inp(20)[c] : 0.f; }
    for (int tile = tile_lo; tile < tile_hi; tile += tile_step) {
        int t0 = tile * 64; asm volatile("" : "+s"(t0));
        __syncthreads();
        for (int dup1_ = 0; dup1_ < ((PREP_DUP & 1) ? 2 : 1); ++dup1_)
        for (int grp = F.tid; grp < 64 * 36; grp += 512) { const int tt = grp / 36, jg = grp - tt * 36, j0 = 8 * jg; const int t = t0 + tt; const bool has_prev = (t % SEQ) != 0;
            int pj, qj; if (j0 < 64) { pj = j0; qj = 64 + j0; } else if (j0 < 128) { pj = 128 + (j0 - 64); qj = 192 + (j0 - 64); } else if (j0 < 256) { pj = 256 + (j0 - 128); qj = 384 + (j0 - 128); } else { pj = 512 + (j0 - 256); qj = 544 + (j0 - 256); }
            const u32x4 pv = *(const u32x4*)(LO + (size_t)t * LO_W + pj); u32x4 qv = {0u, 0u, 0u, 0u}; if (has_prev) qv = *(const u32x4*)(LO + (size_t)(t - 1) * LO_W + qj);
            const unsigned pw[4] = {pv.x, pv.y, pv.z, pv.w}, qw[4] = {qv.x, qv.y, qv.z, qv.w}; float v[8];
#pragma unroll
            for (int q = 0; q < 4; ++q) { v[2 * q] = bflo(pw[q]) + bflo(qw[q]); v[2 * q + 1] = bfhi(pw[q]) + bfhi(qw[q]); }
            if (j0 < 64) {
#pragma unroll
                for (int e = 0; e < 8; ++e) v[e] = 1.0f - 2.0f * __builtin_amdgcn_rcpf(1.0f + __expf(2.0f * v[e]));
            } else if (j0 >= 128 && j0 < 256) {
#pragma unroll
                for (int e = 0; e < 8; ++e) v[e] = sigmoidf_(v[e]);
            }
            u32x4 w; w.x = pk2(v[0], v[1]); w.y = pk2(v[2], v[3]); w.z = pk2(v[4], v[5]); w.w = pk2(v[6], v[7]);
            *(LAS u32x4*)(act + tt * ACT_P + j0 * 2) = w; }
        __syncthreads();
        float inv[4];
        for (int pd_ = 0; pd_ < ((PREP_DUP & 4) ? 2 : 1); ++pd_)
        { int cw = 64 * F.wave + 4 * g; asm volatile("" : "+v"(cw));
          u32x2 kc[4][4], kp_[4][4];
#pragma unroll
          for (int tt = 0; tt < 4; ++tt) { const int t = t0 + 16 * tt + r16; const bool has_prev = (t % SEQ) != 0; const size_t ro = (size_t)t * 1536;
#pragma unroll
              for (int ct = 0; ct < 4; ++ct) { kc[tt][ct] = *(const u32x2*)(RW + ro + 512 + cw + 16 * ct); kp_[tt][ct] = (u32x2){0u, 0u}; if (has_prev) kp_[tt][ct] = *(const u32x2*)(RW + ro - 1536 + 512 + cw + 16 * ct); } }
#pragma unroll
          for (int tt = 0; tt < 4; ++tt) { float ss = 0.f;
#pragma unroll
              for (int ct = 0; ct < 4; ++ct) { const f32x4 muk = *(const LAS f32x4*)(PRM + 512 + cw + 16 * ct), kkc = *(const LAS f32x4*)(PRM + 2560 + cw + 16 * ct);
                  const float k0 = bflo(kc[tt][ct].x), k1 = bfhi(kc[tt][ct].x), k2 = bflo(kc[tt][ct].y), k3 = bfhi(kc[tt][ct].y), q0 = bflo(kp_[tt][ct].x), q1 = bfhi(kp_[tt][ct].x), q2 = bflo(kp_[tt][ct].y), q3 = bfhi(kp_[tt][ct].y);
                  const float a0 = (k0 + (q0 - k0) * muk[0]) * kkc[0], a1 = (k1 + (q1 - k1) * muk[1]) * kkc[1], a2 = (k2 + (q2 - k2) * muk[2]) * kkc[2], a3 = (k3 + (q3 - k3) * muk[3]) * kkc[3];
                  ss += (a0 * a0 + a1 * a1) + (a2 * a2 + a3 * a3); }
              ss += __shfl_xor(ss, 16); ss += __shfl_xor(ss, 32);
              inv[tt] = __builtin_amdgcn_rsqf(fmaxf(ss, 1e-24f)); } }
#pragma unroll 1
        for (int ct8 = 0; ct8 < ((PREP_DUP & 8) ? 8 : 4); ++ct8) { const int ct = ct8 & 3;
            int cw = 64 * F.wave + 4 * g; asm volatile("" : "+v"(cw));
            const int c0 = cw + 16 * ct;
            bf16x8 wf[9];
            { const unsigned char* wrow = L2T + (size_t)(64 * F.wave + 16 * ct + r16) * 576 + 16 * g;
#pragma unroll
              for (int s = 0; s < 9; ++s) wf[s] = *(const bf16x8*)(wrow + 64 * s); }
            u32x2 cur[4][3], prv[4][3], vfl[4];
#pragma unroll
            for (int tt = 0; tt < 4; ++tt) { const int t = t0 + 16 * tt + r16; const bool has_prev = (t % SEQ) != 0; const size_t ro = (size_t)t * 1536;
#pragma unroll
                for (int p = 0; p < 3; ++p) { cur[tt][p] = *(const u32x2*)(RW + ro + 512 * p + c0); prv[tt][p] = (u32x2){0u, 0u}; if (has_prev) prv[tt][p] = *(const u32x2*)(RW + ro - 1536 + 512 * p + c0); }
                vfl[tt] = (u32x2){0u, 0u}; if (l > 0) vfl[tt] = *(const u32x2*)(VF + (size_t)t * CW + c0); }
            const f32x4 mur = *(const LAS f32x4*)(PRM + c0), muk = *(const LAS f32x4*)(PRM + 512 + c0), muv = *(const LAS f32x4*)(PRM + 1024 + c0), w0v = *(const LAS f32x4*)(PRM + 1536 + c0),
                        a0v = *(const LAS f32x4*)(PRM + 2048 + c0), kkc = *(const LAS f32x4*)(PRM + 2560 + c0), kac = *(const LAS f32x4*)(PRM + 3072 + c0), v0v = *(const LAS f32x4*)(PRM + 3584 + c0);
#pragma unroll
            for (int tt = 0; tt < 4; ++tt) {
                const int t = t0 + 16 * tt + r16; const size_t oo = (size_t)t * CW, os = (size_t)(16 * tt + r16) * CW;
                bf16x8 a[9];
#pragma unroll
                for (int s = 0; s < 9; ++s) a[s] = *(const LAS bf16x8*)(act + (16 * tt + r16) * ACT_P + (32 * s + 8 * g) * 2);
                f32x4 aw = {0.f, 0.f, 0.f, 0.f}, aa = {0.f, 0.f, 0.f, 0.f}, ag = {0.f, 0.f, 0.f, 0.f}, av = {0.f, 0.f, 0.f, 0.f};
                aw = mfma16(wf[0], a[0], aw); aw = mfma16(wf[1], a[1], aw);
                aa = mfma16(wf[2], a[2], aa); aa = mfma16(wf[3], a[3], aa);
                ag = mfma16(wf[4], a[4], ag); ag = mfma16(wf[5], a[5], ag); ag = mfma16(wf[6], a[6], ag); ag = mfma16(wf[7], a[7], ag);
                if (l > 0) av = mfma16(wf[8], a[8], av);
                float ro4[4], lw4[4], vo4[4], k2[4], ka[4], kb[4];
#pragma unroll
                for (int r = 0; r < 4; ++r) {
                    const unsigned cwd_r = (r < 2) ? cur[tt][0].x : cur[tt][0].y, cwd_k = (r < 2) ? cur[tt][1].x : cur[tt][1].y, cwd_v = (r < 2) ? cur[tt][2].x : cur[tt][2].y;
                    const unsigned pwd_r = (r < 2) ? prv[tt][0].x : prv[tt][0].y, pwd_k = (r < 2) ? prv[tt][1].x : prv[tt][1].y, pwd_v = (r < 2) ? prv[tt][2].x : prv[tt][2].y;
                    const unsigned vwd = (r < 2) ? vfl[tt].x : vfl[tt].y;
                    const float rp = (r & 1) ? bfhi(cwd_r) : bflo(cwd_r), kp = (r & 1) ? bfhi(cwd_k) : bflo(cwd_k), vp = (r & 1) ? bfhi(cwd_v) : bflo(cwd_v);
                    const float rq = (r & 1) ? bfhi(pwd_r) : bflo(pwd_r), kq_ = (r & 1) ? bfhi(pwd_k) : bflo(pwd_k), vq = (r & 1) ? bfhi(pwd_v) : bflo(pwd_v);
                    const float rr = rp + (rq - rp) * mur[r], k = kp + (kq_ - kp) * muk[r]; float v = vp + (vq - vp) * muv[r];
                    lw4[r] = -0.60653066f * sigmoidf_(w0v[r] + aw[r]);
                    const float alr = sigmoidf_(a0v[r] + aa[r]);
                    if (l > 0) { const float vf = (r & 1) ? bfhi(vwd) : bflo(vwd); v = v + (vf - v) * sigmoidf_(v0v[r] + av[r]); }
                    const float kk = k * kkc[r] * inv[tt];
                    ro4[r] = rr; vo4[r] = v; k2[r] = k * (1.f + (alr - 1.f) * kac[r]); ka[r] = kk; kb[r] = kk * alr; }
                u32x2 w;
                w.x = pk2(ro4[0], ro4[1]); w.y = pk2(ro4[2], ro4[3]); *(u32x2*)(SIr + oo + c0) = w;
                w.x = pk2(lw4[0], lw4[1]); w.y = pk2(lw4[2], lw4[3]); *(u32x2*)(SCw + os + c0) = w;
                w.x = pk2(ag[0], ag[1]); w.y = pk2(ag[2], ag[3]); *(u32x2*)(Gb + oo + c0) = w;
                w.x = pk2(vo4[0], vo4[1]); w.y = pk2(vo4[2], vo4[3]); *(u32x2*)((l > 0 ? V1 : VF) + oo + c0) = w;
                w.x = pk2(k2[0], k2[1]); w.y = pk2(k2[2], k2[3]); *(u32x2*)(SIk + oo + c0) = w;
                w.x = pk2(ka[0], ka[1]); w.y = pk2(ka[2], ka[3]); *(u32x2*)(SCa + os + c0) = w;
                w.x = pk2(kb[0], kb[1]); w.y = pk2(kb[2], kb[3]); *(u32x2*)(SCb + os + c0) = w;
            }
        }
    }
}
constexpr int NUNIT = NB * NH * (SEQ / 64);
constexpr size_t U_PMP = 0, U_RPP = 8192, U1_BYTES = 16384;
constexpr size_t U_QMT = 0, U_YLT = 8192, U2_BYTES = 16384;
DI int permk(int k) { return (k & 32) | (((k >> 2) & 3) << 3) | (((k >> 4) & 1) << 2) | (k & 3); }
constexpr int MP = 144;
constexpr int SP = 80;
DI f32x4 mm_tile(const LAS unsigned char* xb, int px, int m0, const LAS unsigned char* yb, int py, int n0, int ks, f32x4 acc, int lane) {
    const int r16 = lane & 15, g = lane >> 4;
    for (int s = 0; s < ks; ++s) {
        const bf16x8 a = *(const LAS bf16x8*)(xb + (m0 + r16) * px + (32 * s + 8 * g) * 2);
        const bf16x8 b = *(const LAS bf16x8*)(yb + (n0 + r16) * py + (32 * s + 8 * g) * 2);
        acc = mfma16(a, b, acc);
    }
    return acc;
}
DI u32x2 pk4(f32x4 v) { u32x2 w; w.x = pk2(v[0], v[1]); w.y = pk2(v[2], v[3]); return w; }

#ifndef SA_DUP
#define SA_DUP 0
#endif
#define SA_REP(bit) for (int sd_ = 0; sd_ < ((SA_DUP & (bit)) ? 2 : 1); ++sd_)
DI void phase_scan_a(Frame& F, int l, int u_lo, int u_hi, int u_step) {
    LAS unsigned char* const L = F.lds;
#define MB(n) (L + (n) * 9216)
    LAS float* const Gf = (LAS float*)(L + 110592);
    LAS float* const SEG = (LAS float*)(L + 110592 + 16384);
    LAS float* const GL = SEG + 512;
    LAS unsigned char* const A21 = L + 110592 + 16384 + 2048 + 256;
    LAS unsigned char* const T11T = A21 + 2560;
    LAS unsigned char* const ZT = T11T + 2560;
    const bf16_t* SIr = (const bf16_t*)(F.wsp() + WS_SIR); const bf16_t* SIk = (const bf16_t*)(F.wsp() + WS_SIK);
    const bf16_t* SCw = (const bf16_t*)(F.wsp() + WS_SCRW) + (size_t)F.bid * 64 * CW; const bf16_t* SCa = (const bf16_t*)(F.wsp() + WS_SCRA) + (size_t)F.bid * 64 * CW; const bf16_t* SCb = (const bf16_t*)(F.wsp() + WS_SCRB) + (size_t)F.bid * 64 * CW;
    const bf16_t* V = (const bf16_t*)(F.wsp() + (l > 0 ? WS_V1 : WS_VF));
    const int lane = F.lane, wave = F.wave, r16 = lane & 15, g = lane >> 4;
    float plw[8]; u32x4 prv, pkv, pav, pbv, pvv;
#define SCANA_LOAD(uu) do { const int bh_ = (uu) & 31, c_ = (uu) >> 5, b_ = bh_ >> 3, h_ = bh_ & 7; const size_t t0_ = (size_t)b_ * SEQ + c_ * 64; \
        { const int k_ = F.tid & 63, seg_ = F.tid >> 6; _Pragma("unroll") for (int e = 0; e < 8; ++e) plw[e] = bf2f(SCw[(size_t)(8 * seg_ + e) * CW + h_ * 64 + k_]); } \
        { const int i_ = F.tid >> 3, k0_ = (F.tid & 7) * 8; const size_t go_ = (t0_ + i_) * CW + h_ * 64 + k0_, gs_ = (size_t)i_ * CW + h_ * 64 + k0_; \
          prv = *(const u32x4*)(SIr + go_); pkv = *(const u32x4*)(SIk + go_); pav = *(const u32x4*)(SCa + gs_); pbv = *(const u32x4*)(SCb + gs_); pvv = *(const u32x4*)(V + go_); } } while (0)
    if (u_lo < u_hi) SCANA_LOAD(u_lo);
    for (int u = u_lo; u < u_hi; u += u_step) {
        const int bh = u & 31, c = u >> 5, b = bh >> 3, h = bh & 7;
        const size_t t0 = (size_t)b * SEQ + c * 64; (void)t0; (void)b; (void)h;
        unsigned char* const rec1 = F.wsp() + WS_SC1 + (size_t)((bh * 128) + c) * U1_BYTES; unsigned char* const rec2 = F.wsp() + WS_SC2 + (size_t)((bh * 128) + c) * U2_BYTES;
        __syncthreads();
        SA_REP(1) {
        { const int k = F.tid & 63, seg = F.tid >> 6; float p[8]; float run = 0.f;
#pragma unroll
          for (int e = 0; e < 8; ++e) { run += plw[e]; p[e] = run; }
          SEG[seg * 64 + k] = run;
          __syncthreads();
          float off = 0.f;
#pragma unroll
          for (int s = 0; s < 8; ++s) off += (s < seg) ? SEG[s * 64 + k] : 0.f;
#pragma unroll
          for (int e = 0; e < 8; ++e) Gf[(8 * seg + e) * 64 + k] = off + p[e];
        }
        __syncthreads();
        { const int i = F.tid >> 3, k0 = (F.tid & 7) * 8;
          const u32x4 rv = prv, kv = pkv, av = pav, bv = pbv, vv = pvv;
          float fr[8], fk[8], fa[8], fb[8], fv[8];
          const unsigned rw[4] = {rv.x, rv.y, rv.z, rv.w}, kw[4] = {kv.x, kv.y, kv.z, kv.w}, aw[4] = {av.x, av.y, av.z, av.w}, bw[4] = {bv.x, bv.y, bv.z, bv.w}, vw[4] = {vv.x, vv.y, vv.z, vv.w};
#pragma unroll
          for (int q = 0; q < 4; ++q) { fr[2 * q] = bflo(rw[q]); fr[2 * q + 1] = bfhi(rw[q]); fk[2 * q] = bflo(kw[q]); fk[2 * q + 1] = bfhi(kw[q]); fa[2 * q] = bflo(aw[q]); fa[2 * q + 1] = bfhi(aw[q]);
              fb[2 * q] = bflo(bw[q]); fb[2 * q + 1] = bfhi(bw[q]); fv[2 * q] = bflo(vw[q]); fv[2 * q + 1] = bfhi(vw[q]); }
          float at[8], rt[8], bt[8], kt[8], bh8[8], kh8[8];
#pragma unroll
          for (int e = 0; e < 8; ++e) { const float gi = Gf[i * 64 + k0 + e], gp = (i > 0) ? Gf[(i - 1) * 64 + k0 + e] : 0.f, gl = Gf[63 * 64 + k0 + e];
              const float e1 = __expf(gp), e2 = __expf(gi), e3 = __expf(-gi), e4 = __expf(gl - gi);
              at[e] = -fa[e] * e1; rt[e] = fr[e] * e2; bt[e] = fb[e] * e3; kt[e] = fk[e] * e3; bh8[e] = fb[e] * e4; kh8[e] = fk[e] * e4;
              if (i == 63) GL[k0 + e] = e2; }
          u32x4 w;
          w.x = pk2(at[0], at[1]); w.y = pk2(at[2], at[3]); w.z = pk2(at[4], at[5]); w.w = pk2(at[6], at[7]); *(LAS u32x4*)(MB(0) + i * MP + k0 * 2) = w;
          w.x = pk2(rt[0], rt[1]); w.y = pk2(rt[2], rt[3]); w.z = pk2(rt[4], rt[5]); w.w = pk2(rt[6], rt[7]); *(LAS u32x4*)(MB(1) + i * MP + k0 * 2) = w;
          w.x = pk2(bt[0], bt[1]); w.y = pk2(bt[2], bt[3]); w.z = pk2(bt[4], bt[5]); w.w = pk2(bt[6], bt[7]); *(LAS u32x4*)(MB(2) + i * MP + k0 * 2) = w;
          w.x = pk2(kt[0], kt[1]); w.y = pk2(kt[2], kt[3]); w.z = pk2(kt[4], kt[5]); w.w = pk2(kt[6], kt[7]); *(LAS u32x4*)(MB(3) + i * MP + k0 * 2) = w;
#pragma unroll
          for (int e = 0; e < 8; ++e) { const int ro = (k0 + e) * MP + i * 2;
              *(LAS bf16_t*)(MB(4) + ro) = f2bf(at[e]); *(LAS bf16_t*)(MB(5) + ro) = f2bf(fv[e]); *(LAS bf16_t*)(MB(6) + ro) = f2bf(bh8[e]); *(LAS bf16_t*)(MB(7) + ro) = f2bf(kh8[e]); }
        }
        __syncthreads(); }
        if (u + u_step < u_hi) SCANA_LOAD(u + u_step);
        __syncthreads();
        SA_REP(2) {
        { const int prod = wave >> 1;
          const LAS unsigned char* xb = (prod & 1) ? MB(3) : MB(2); const LAS unsigned char* yb = (prod < 2) ? MB(0) : MB(1);
          LAS unsigned char* ob = (prod == 1) ? MB(8) : (prod == 2) ? MB(9) : MB(10);
          float zf = 0.f; asm volatile("" : "+v"(zf));
          for (int q = 0; q < 8; ++q) { const int tt = (wave & 1) * 8 + q, tm = tt >> 2, tn = tt & 3;
              f32x4 acc = {zf, zf, zf, zf};
              if (tm <= tn) acc = mm_tile(xb, MP, 16 * tm, yb, MP, 16 * tn, 2, acc, lane);
              const int i = 16 * tn + r16, j0 = 16 * tm + 4 * g;
#pragma unroll
              for (int r = 0; r < 4; ++r) { const int j = j0 + r; const bool keep = (prod < 2) ? (j < i) : (j <= i); if (!keep) acc[r] = 0.f; }
              if (prod == 0) {
                  if ((i >> 5) == (j0 >> 5)) *(LAS f32x4*)(Gf + ((i >> 5) * 32 + (i & 31)) * 32 + (j0 & 31)) = acc;
                  if (i >= 32 && j0 < 32) *(LAS u32x2*)(A21 + (i - 32) * SP + j0 * 2) = pk4(acc);
              } else *(LAS u32x2*)(ob + i * MP + j0 * 2) = pk4(acc);
          } }
        __syncthreads();
        }
        f32x4 pyl[2] = {{0.f, 0.f, 0.f, 0.f}, {0.f, 0.f, 0.f, 0.f}}, pqm[2] = {{0.f, 0.f, 0.f, 0.f}, {0.f, 0.f, 0.f, 0.f}};
        SA_REP(4) {
        if (wave == 0) {
            const int blk = lane >> 5, cc = lane & 31; const LAS float* AD = Gf + blk * 1024;
            float Tc[32];
#pragma unroll
            for (int i = 0; i < 32; ++i) { float a0 = (i == cc) ? 1.f : 0.f, a1 = 0.f, a2 = 0.f, a3 = 0.f;
#pragma unroll
                for (int q = 0; q < (i + 3) / 4; ++q) { const f32x4 a = *(const LAS f32x4*)(AD + i * 32 + 4 * q);
                    if (4 * q + 0 < i) a0 += a[0] * Tc[4 * q + 0]; if (4 * q + 1 < i) a1 += a[1] * Tc[4 * q + 1]; if (4 * q + 2 < i) a2 += a[2] * Tc[4 * q + 2]; if (4 * q + 3 < i) a3 += a[3] * Tc[4 * q + 3]; }
                Tc[i] = (a0 + a1) + (a2 + a3); }
#pragma unroll
            for (int i = 0; i < 32; ++i) *(LAS bf16_t*)(MB(11) + (32 * blk + i) * MP + (32 * blk + cc) * 2) = f2bf(Tc[i]);
            if (blk == 0) {
#pragma unroll
                for (int q = 0; q < 4; ++q) { u32x4 w; w.x = pk2(Tc[8 * q], Tc[8 * q + 1]); w.y = pk2(Tc[8 * q + 2], Tc[8 * q + 3]); w.z = pk2(Tc[8 * q + 4], Tc[8 * q + 5]); w.w = pk2(Tc[8 * q + 6], Tc[8 * q + 7]);
                    *(LAS u32x4*)(T11T + cc * SP + q * 16) = w; }
            } else {
                unsigned z = 0u; asm volatile("" : "+v"(z));
#pragma unroll
                for (int q = 0; q < 4; ++q) *(LAS u32x4*)(MB(11) + cc * MP + 64 + q * 16) = (u32x4){z, z, z, z};
            }
        } else {
            for (int tt = wave - 1; tt < 16; tt += 7) { const int tm = tt >> 2, tn = tt & 3;
                f32x4 acc = {0.f, 0.f, 0.f, 0.f};
                acc = mm_tile(MB(8), MP, 16 * tm, MB(5), MP, 16 * tn, 2, acc, lane);
                *(LAS u32x2*)(MB(2) + (16 * tn + r16) * MP + (16 * tm + 4 * g) * 2) = pk4(acc); }
            if (sd_ == 0) {
#pragma unroll
                for (int q = 0; q < 2; ++q) { const int tt = wave * 2 + q, tm = tt >> 2, tn = tt & 3; const f32x4 z = {0.f, 0.f, 0.f, 0.f};
                    pyl[q] = mm_tile(MB(5), MP, 16 * tm, MB(10), MP, 16 * tn, 2, z, lane);
                    pqm[q] = mm_tile(MB(7), MP, 16 * tm, MB(5), MP, 16 * tn, 2, z, lane); } }
        }
        __syncthreads();
        if (wave < 4) { const int tm = wave >> 1, tn = wave & 1; f32x4 acc = {0.f, 0.f, 0.f, 0.f};
            acc = mm_tile(A21, SP, 16 * tm, T11T, SP, 16 * tn, 1, acc, lane);
            *(LAS u32x2*)(ZT + (16 * tn + r16) * SP + (16 * tm + 4 * g) * 2) = pk4(acc); }
        __syncthreads();
        if (wave < 4) { const int tm = wave >> 1, tn = wave & 1; f32x4 acc = {0.f, 0.f, 0.f, 0.f};
            acc = mm_tile(ZT, SP, 16 * tm, MB(11) + 32 * MP + 64, MP, 16 * tn, 1, acc, lane);
            *(LAS u32x2*)(MB(11) + (32 + 16 * tn + r16) * MP + (16 * tm + 4 * g) * 2) = pk4(acc); }
        __syncthreads();
        }
        SA_REP(8) {
        { const LAS unsigned char* yb = (wave < 4) ? MB(4) : MB(2); LAS unsigned char* ob = (wave < 4) ? MB(3) : MB(0);
          for (int q = 0; q < 4; ++q) { const int tt = (wave & 3) * 4 + q, tm = tt >> 2, tn = tt & 3;
              f32x4 acc = {0.f, 0.f, 0.f, 0.f};
              acc = mm_tile(MB(11), MP, 16 * tm, yb, MP, 16 * tn, 2, acc, lane);
              *(LAS u32x2*)(ob + (16 * tn + r16) * MP + (16 * tm + 4 * g) * 2) = pk4(acc); } }
        __syncthreads();
        }
        SA_REP(16) {
#pragma unroll
        for (int q = 0; q < 2; ++q) { const int tt = wave * 2 + q, tm = tt >> 2, tn = tt & 3;
            { f32x4 acc = {0.f, 0.f, 0.f, 0.f}; acc = mm_tile(MB(3), MP, 16 * tm, MB(9), MP, 16 * tn, 2, acc, lane);
              const int i = 16 * tn + r16, k0 = 16 * tm + 4 * g; const u32x2 rr = *(const LAS u32x2*)(MB(1) + i * MP + k0 * 2);
              acc[0] += bflo(rr.x); acc[1] += bfhi(rr.x); acc[2] += bflo(rr.y); acc[3] += bfhi(rr.y);
              *(u32x2*)(rec1 + U_RPP + (size_t)(i * 64 + permk(k0)) * 2) = pk4(acc); }
            { f32x4 acc = {0.f, 0.f, 0.f, 0.f}; acc = mm_tile(MB(3), MP, 16 * tm, MB(6), MP, 16 * tn, 2, acc, lane);
              const int kp = 16 * tn + r16, k0 = 16 * tm + 4 * g;
#pragma unroll
              for (int r = 0; r < 4; ++r) if (k0 + r == kp) acc[r] += GL[kp];
              *(u32x2*)(rec1 + U_PMP + (size_t)(kp * 64 + permk(k0)) * 2) = pk4(acc); }
            { f32x4 acc = pyl[q]; acc = mm_tile(MB(0), MP, 16 * tm, MB(9), MP, 16 * tn, 2, acc, lane); if (wave == 0) acc = mm_tile(MB(5), MP, 16 * tm, MB(10), MP, 16 * tn, 2, acc, lane);
              *(u32x2*)(rec2 + U_YLT + (size_t)((16 * tn + r16) * 64 + 16 * tm + 4 * g) * 2) = pk4(acc); }
            { f32x4 acc = pqm[q]; acc = mm_tile(MB(6), MP, 16 * tm, MB(0), MP, 16 * tn, 2, acc, lane); if (wave == 0) acc = mm_tile(MB(7), MP, 16 * tm, MB(5), MP, 16 * tn, 2, acc, lane);
              *(u32x2*)(rec2 + U_QMT + (size_t)((16 * tn + r16) * 64 + 16 * tm + 4 * g) * 2) = pk4(acc); }
        }
        __syncthreads(); }
    }
#undef MB
#undef SCANA_LOAD
}

constexpr int SB_D = 7, SB_SLOT = 16384;
DI void scanb_issue(LAS unsigned char* lds, const unsigned char* r1b, const unsigned char* r2b, int cidx, int lw, int lane) {
    const unsigned char* rec1 = r1b + (size_t)cidx * U1_BYTES; const unsigned char* rec2 = r2b + (size_t)cidx * U2_BYTES;
    LAS unsigned char* slot = lds + (cidx % SB_D) * SB_SLOT;
#pragma unroll
    for (int i = 0; i < 2; ++i) { const int ci = 2 * lw + i;
        const int row = 8 * ci + (lane >> 3), sl = lane & 7;
        __builtin_amdgcn_global_load_lds((const unsigned*)(rec1 + U_PMP + row * 128 + ((sl ^ (row & 7)) << 4)), (LAS unsigned*)(slot + ci * 1024), 16, 0, 0); }
#pragma unroll
    for (int i = 0; i < 2; ++i) { const int ci = 2 * lw + i;
        const int v = 8 * ci + (lane >> 3), sl = lane & 7;
        __builtin_amdgcn_global_load_lds((const unsigned*)(rec2 + U_QMT + v * 128 + ((sl ^ (v & 7)) << 4)), (LAS unsigned*)(slot + 8192 + ci * 1024), 16, 0, 0); }
}
DI void phase_scan_b(Frame& F) {
    const int lane = F.lane, r16 = lane & 15, g = lane >> 4, w = F.wave, v = 16 * (w & 3) + r16;
    for (int bh = F.bid; bh < NB * NH; bh += F.G) {
        const unsigned char* r1 = F.wsp() + WS_SC1 + (size_t)bh * 128 * U1_BYTES; const unsigned char* r2 = F.wsp() + WS_SC2 + (size_t)bh * 128 * U2_BYTES;
        bf16_t* sct = (bf16_t*)(F.wsp() + WS_SCT) + (size_t)bh * 128 * 4096;
        f32x4 sT[4];
#pragma unroll
        for (int i = 0; i < 4; ++i) sT[i] = (f32x4){0.f, 0.f, 0.f, 0.f};
        __syncthreads();
        if (w >= 4) {
#pragma unroll
            for (int d = 0; d < SB_D; ++d) scanb_issue(F.lds, r1, r2, d, w - 4, lane);
        }
        for (int c = 0; c < 128; ++c) {
            if (w >= 4) asm volatile("s_waitcnt vmcnt(20)" ::: "memory");
            __builtin_amdgcn_s_barrier();
            asm volatile("" ::: "memory");
            if (w >= 4) {
                if (c >= 1) { const int cn = c - 1 + SB_D; scanb_issue(F.lds, r1, r2, cn < 128 ? cn : c, w - 4, lane); }
            } else {
                const LAS unsigned char* slot = F.lds + (c % SB_D) * SB_SLOT;
                bf16x8 pm[4][2]; f32x4 q[4];
#pragma unroll
                for (int mt = 0; mt < 4; ++mt) { const int row = 16 * mt + r16;
#pragma unroll
                    for (int s2 = 0; s2 < 2; ++s2) pm[mt][s2] = *(const LAS bf16x8*)(slot + row * 128 + (((4 * s2 + g) ^ (row & 7)) << 4));
                    { const u32x2 qw = *(const LAS u32x2*)(slot + 8192 + v * 128 + (((2 * mt + (g >> 1)) ^ (v & 7)) << 4) + (g & 1) * 8); q[mt] = (f32x4){bflo(qw.x), bfhi(qw.x), bflo(qw.y), bfhi(qw.y)}; } }
                bf16x8 hi[2], lo[2];
#pragma unroll
                for (int s2 = 0; s2 < 2; ++s2) { u32x4 hw, lw;
#pragma unroll
                    for (int qq = 0; qq < 2; ++qq) { const f32x4 x = sT[2 * s2 + qq]; const unsigned h0 = pk2(x[0], x[1]), h1 = pk2(x[2], x[3]);
                        const unsigned l0 = pk2(x[0] - bflo(h0), x[1] - bfhi(h0)), l1 = pk2(x[2] - bflo(h1), x[3] - bfhi(h1));
                        if (qq == 0) { hw.x = h0; hw.y = h1; lw.x = l0; lw.y = l1; } else { hw.z = h0; hw.w = h1; lw.z = l0; lw.w = l1; } }
                    hi[s2] = __builtin_bit_cast(bf16x8, hw); lo[s2] = __builtin_bit_cast(bf16x8, lw);
                    *(u32x4*)(sct + (size_t)c * 4096 + (size_t)v * 64 + 32 * s2 + 8 * g) = hw; }
#pragma unroll
                for (int mt = 0; mt < 4; ++mt) { f32x4 n = q[mt];
#pragma unroll
                    for (int s2 = 0; s2 < 2; ++s2) { n = mfma16(pm[mt][s2], hi[s2], n); n = mfma16(pm[mt][s2], lo[s2], n); }
                    sT[mt] = n; }
                asm volatile("s_waitcnt lgkmcnt(0)" ::: "memory");
            }
        }
        asm volatile("s_waitcnt vmcnt(0)" ::: "memory");
    }
}

struct ScanCIn { bf16x8 ra[2]; f32x4 yl[4]; bf16x8 sb[4][2]; };
DI void scanc_load(ScanCIn& o, const unsigned char* ws, int item, int r16, int g) {
    asm volatile("" : "+s"(item));
    const int u = item >> 2, it = item & 3; const int bh = u & 31, c = u >> 5; const size_t ui = (size_t)(bh * 128 + c);
    const unsigned char* rec1 = ws + WS_SC1 + ui * U1_BYTES; const unsigned char* rec2 = ws + WS_SC2 + ui * U2_BYTES; const bf16_t* sct = (const bf16_t*)(ws + WS_SCT) + ui * 4096;
#pragma unroll
    for (int s = 0; s < 2; ++s) o.ra[s] = *(const bf16x8*)(rec1 + U_RPP + (size_t)((16 * it + r16) * 64 + 32 * s + 8 * g) * 2);
#pragma unroll
    for (int vt = 0; vt < 4; ++vt) { { const u32x2 yw = *(const u32x2*)(rec2 + U_YLT + (size_t)((16 * it + r16) * 64 + 16 * vt + 4 * g) * 2); o.yl[vt] = (f32x4){bflo(yw.x), bfhi(yw.x), bflo(yw.y), bfhi(yw.y)}; }
#pragma unroll
        for (int s = 0; s < 2; ++s) o.sb[vt][s] = *(const bf16x8*)(sct + (size_t)(16 * vt + r16) * 64 + 32 * s + 8 * g); }
}
DI void scanc_item(const ScanCIn& o, Frame& F, int l, int item, int r16, int g) {
    const bf16_t* SIr = (const bf16_t*)(F.wsp() + WS_SIR); const bf16_t* SIk = (const bf16_t*)(F.wsp() + WS_SIK);
    const bf16_t* V = (const bf16_t*)(F.wsp() + (l > 0 ? WS_V1 : WS_VF)); const bf16_t* Gb = (const bf16_t*)(F.wsp() + WS_G); bf16_t* YR = (bf16_t*)(F.wsp() + WS_YRM);
    const int u = item >> 2, it = item & 3; const int bh = u & 31, c = u >> 5, b = bh >> 3, h = bh & 7;
    const size_t tok = (size_t)b * SEQ + c * 64 + 16 * it + r16; const size_t o0 = tok * CW + h * 64 + 4 * g, oy = tok * YRM_LD + h * 64 + 4 * g;
    u32x2 pr[4], pk[4], pv[4], pg[4];
#pragma unroll
    for (int vt = 0; vt < 4; ++vt) { pr[vt] = *(const u32x2*)(SIr + o0 + 16 * vt); pk[vt] = *(const u32x2*)(SIk + o0 + 16 * vt); pv[vt] = *(const u32x2*)(V + o0 + 16 * vt); pg[vt] = *(const u32x2*)(Gb + o0 + 16 * vt); }
    f32x4 y[4];
#pragma unroll
    for (int vt = 0; vt < 4; ++vt) { y[vt] = o.yl[vt];
#pragma unroll
        for (int s = 0; s < 2; ++s) y[vt] = mfma16(o.sb[vt][s], o.ra[s], y[vt]); }
    float s1 = 0.f;
#pragma unroll
    for (int vt = 0; vt < 4; ++vt) s1 += (y[vt][0] + y[vt][1]) + (y[vt][2] + y[vt][3]);
    s1 += __shfl_xor(s1, 16); s1 += __shfl_xor(s1, 32);
    const float mean = s1 * (1.f / 64.f); float s2 = 0.f;
#pragma unroll
    for (int vt = 0; vt < 4; ++vt) { y[vt] = y[vt] - mean; s2 += (y[vt][0] * y[vt][0] + y[vt][1] * y[vt][1]) + (y[vt][2] * y[vt][2] + y[vt][3] * y[vt][3]); }
    s2 += __shfl_xor(s2, 16); s2 += __shfl_xor(s2, 32);
    const float rstd = __builtin_amdgcn_rsqf(s2 * (1.f / 64.f) + 64e-5f);
    const float* lng = F.inp(17) + l * CW + h * 64 + 4 * g; const float* lnb = F.inp(18) + l * CW + h * 64 + 4 * g; const float* rkp = F.inp(16) + l * CW + h * 64 + 4 * g;
    float s3 = 0.f;
#pragma unroll
    for (int vt = 0; vt < 4; ++vt) { const f32x4 rk = *(const f32x4*)(rkp + 16 * vt);
        s3 += bflo(pr[vt].x) * bflo(pk[vt].x) * rk[0] + bfhi(pr[vt].x) * bfhi(pk[vt].x) * rk[1] + bflo(pr[vt].y) * bflo(pk[vt].y) * rk[2] + bfhi(pr[vt].y) * bfhi(pk[vt].y) * rk[3]; }
    s3 += __shfl_xor(s3, 16); s3 += __shfl_xor(s3, 32);
#pragma unroll
    for (int vt = 0; vt < 4; ++vt) { const f32x4 lg4 = *(const f32x4*)(lng + 16 * vt), lb4 = *(const f32x4*)(lnb + 16 * vt);
        const float o_0 = (y[vt][0] * rstd * lg4[0] + lb4[0] + s3 * bflo(pv[vt].x)) * bflo(pg[vt].x), o_1 = (y[vt][1] * rstd * lg4[1] + lb4[1] + s3 * bfhi(pv[vt].x)) * bfhi(pg[vt].x);
        const float o_2 = (y[vt][2] * rstd * lg4[2] + lb4[2] + s3 * bflo(pv[vt].y)) * bflo(pg[vt].y), o_3 = (y[vt][3] * rstd * lg4[3] + lb4[3] + s3 * bfhi(pv[vt].y)) * bfhi(pg[vt].y);
        u32x2 w; w.x = pk2(o_0, o_1); w.y = pk2(o_2, o_3); *(u32x2*)(YR + oy + 16 * vt) = w; }
}
DI void phase_scan_c(Frame& F, int l) {
    const int lane = F.lane, r16 = lane & 15, g = lane >> 4;
    const int first = F.bid * 8 + F.wave, stride = F.G * 8;
    if (first >= NUNIT * 4) return;
    ScanCIn o0, o1;
    scanc_load(o0, F.wsp(), first, r16, g);
    for (int item = first; item < NUNIT * 4; item += 2 * stride) {
        const int i1 = item + stride, i2 = item + 2 * stride;
        if (i1 < NUNIT * 4) scanc_load(o1, F.wsp(), i1, r16, g);
        scanc_item(o0, F, l, item, r16, g);
        if (i1 < NUNIT * 4) { if (i2 < NUNIT * 4) scanc_load(o0, F.wsp(), i2, r16, g); scanc_item(o1, F, l, i1, r16, g); }
    }
}

#ifndef FUSE_DUP
#define FUSE_DUP 0
#endif
DI void phase_prep_scana(Frame& F, int l) {
    phase_rwkv_prep2(F, l, 0, 0, 1, true);
#define RELANE() do { int l_ = F.lane; asm volatile("" : "+v"(l_)); F.lane = l_; F.tid = F.wave * 64 + l_; } while (0)
    for (int tile = F.bid; tile < T / 64; tile += F.G) {
        for (int fd_ = 0; fd_ < ((FUSE_DUP & 1) ? 2 : 1); ++fd_) {
        RELANE();
        phase_rwkv_prep2(F, l, tile, tile + 1, 1, false);
        }
        asm volatile("s_waitcnt vmcnt(0)" ::: "memory");
        __syncthreads();
        __builtin_amdgcn_fence(__ATOMIC_ACQUIRE, "agent");
        asm volatile("s_waitcnt vmcnt(0)" ::: "memory");
        const int b = tile >> 7, c = tile & 127; const int u0 = c * 32 + b * 8;
        for (int fd_ = 0; fd_ < ((FUSE_DUP & 2) ? 2 : 1); ++fd_) {
        RELANE();
        phase_scan_a(F, l, u0, u0 + 8, 1);
        }
    }
#undef RELANE
}
DI void phase_moba_prep(Frame& F, int l) {
    bf16_t* MO = (bf16_t*)(F.wsp() + WS_MO); float* KM = (float*)(F.wsp() + WS_TAB + TB_KMEAN);
    int c = F.tid; const float qg = F.inp(23)[l * 64 + (c & 63)] * 0.125f, kg = F.inp(24)[l * 64 + (c & 63)];
    for (int hs = F.bid; hs < T / 128; hs += F.G) {
        float ksum = 0.f;
        for (int tb = 0; tb < 128; tb += 8) {
            int tbase = hs * 128 + tb; asm volatile("" : "+s"(tbase), "+v"(c));
            float q[8], k[8];
#pragma unroll
            for (int e = 0; e < 8; ++e) { const size_t ro = (size_t)(tbase + e) * 1536; q[e] = bf2f(MO[ro + c]); k[e] = bf2f(MO[ro + 512 + c]); }
#pragma unroll
            for (int e = 0; e < 8; ++e) { const size_t ro = (size_t)(tbase + e) * 1536;
                const float qs = wave_sum(q[e] * q[e]) * (1.f / 64.f), ks = wave_sum(k[e] * k[e]) * (1.f / 64.f);
                const float qn = q[e] * (1.0f / sqrtf(qs + 1e-6f)) * qg, kn = k[e] * (1.0f / sqrtf(ks + 1e-6f)) * kg;
                MO[ro + c] = f2bf(qn); MO[ro + 512 + c] = f2bf(kn); ksum += kn; }
        }
        KM[(size_t)(hs & 1) * (TB_KMEAN2 / 4) + (size_t)(hs >> 1) * CW + c] = ksum * (1.f / 256.f);
    }
}
DI void phase_moba_gate(Frame& F) {
    LAS float* KL = (LAS float*)F.lds;
    const bf16_t* MO = (const bf16_t*)(F.wsp() + WS_MO); const float* KM = (const float*)(F.wsp() + WS_TAB + TB_KMEAN); unsigned* SEL = (unsigned*)(F.wsp() + WS_SEL);
    for (int sidx = F.bid; sidx < T / 64; sidx += F.G) {
        const int span = ((sidx / F.G) & 1) ? ((sidx & ~127) + (127 - (sidx & 127))) : sidx;
        const int t0 = span * 64, b = t0 / SEQ, blk = (t0 % SEQ) / 256;
        __syncthreads();
        { const int cc = F.tid, h = cc >> 6, d = cc & 63;
          for (int j0 = 0; j0 < blk; j0 += 8) { float v0[8], v1[8];
#pragma unroll
              for (int e = 0; e < 8; ++e) { const int j = (j0 + e < blk) ? j0 + e : blk - 1; const size_t ko = ((size_t)(b * 32 + j)) * CW + cc; v0[e] = KM[ko]; v1[e] = KM[ko + TB_KMEAN2 / 4]; }
#pragma unroll
              for (int e = 0; e < 8; ++e) if (j0 + e < blk) KL[h * 2052 + (j0 + e) * 64 + d] = v0[e] + v1[e]; } }
        __syncthreads();
        const int tok = F.tid >> 3, h = F.tid & 7; const int t = t0 + tok;
        float q[64];
        { const u32x4* qp = (const u32x4*)(MO + (size_t)t * 1536 + h * 64);
#pragma unroll
          for (int i = 0; i < 8; ++i) { const u32x4 w = qp[i]; q[8 * i] = bflo(w.x); q[8 * i + 1] = bfhi(w.x); q[8 * i + 2] = bflo(w.y); q[8 * i + 3] = bfhi(w.y); q[8 * i + 4] = bflo(w.z); q[8 * i + 5] = bfhi(w.z); q[8 * i + 6] = bflo(w.w); q[8 * i + 7] = bfhi(w.w); } }
        float v0 = -INFINITY, v1 = -INFINITY, v2 = -INFINITY; int i0 = 0, i1 = 1, i2 = 2;
        for (int j = 0; j < blk; ++j) {
            const LAS f32x4* kp = (const LAS f32x4*)(KL + h * 2052 + j * 64); float s = 0.f;
#pragma unroll
            for (int i = 0; i < 16; ++i) { const f32x4 kv = kp[i]; s += q[4 * i] * kv.x + q[4 * i + 1] * kv.y + q[4 * i + 2] * kv.z + q[4 * i + 3] * kv.w; }
            if (s > v0) { v2 = v1; i2 = i1; v1 = v0; i1 = i0; v0 = s; i0 = j; }
            else if (s > v1) { v2 = v1; i2 = i1; v1 = s; i1 = j; }
            else if (s > v2) { v2 = s; i2 = j; }
        }
        const int nv = blk < 3 ? blk : 3;
        SEL[(size_t)t * 8 + h] = (unsigned)i0 | ((unsigned)i1 << 8) | ((unsigned)i2 << 16) | ((unsigned)nv << 24);
    }
}

constexpr int KS_PITCH = 144, VT_PITCH = 520;
constexpr int NPIECE = 47;
constexpr int CW_QATT = 8192;
DI void phase_moba_attn(Frame& F, int l) {
    static constexpr unsigned PIECES[NPIECE] = {196608,1837578,590595,1574658,1115654,1640713,1968907,1443848,918789,1049857,1246983,393730,787456,721924,2034700,262401,2034179,2034957,2035214,2035471,2034692,2035728,2034944,2035985,2036242,2036499,2035461,2036756,2037013,2037270,2035969,2037527,2036230,2037784,2038041,2038298,2036743,2038555,2038812,2039069,2039326,2037512,2039583,2038018,2038281,2039050,2039563};
    LAS unsigned char* Ks = F.lds;
    LAS unsigned char* Vt = F.lds + 36864;
    LAS float* LUT = (LAS float*)(F.lds + 36864 + 33280);
    LAS unsigned* CTL = (LAS unsigned*)(F.lds + 36864 + 33280 + 528);
    LAS unsigned* LIST = CTL + 4;
    const bf16_t* MO = (const bf16_t*)(F.wsp() + WS_MO); const unsigned* SEL = (const unsigned*)(F.wsp() + WS_SEL);
    bf16_t* PO = (bf16_t*)(F.wsp() + WS_PO); f32x2* PST = (f32x2*)(F.wsp() + WS_PST);
    unsigned* qctr = (unsigned*)(F.wsp() + WS_CTL) + CW_QATT + 64 * l;
    const float* relb = F.inp(25);
    const int lane = F.lane;
    for (;;) {
        __syncthreads();
        if (F.tid == 0) { CTL[0] = __hip_atomic_fetch_add(qctr, 1u, __ATOMIC_RELAXED, __HIP_MEMORY_SCOPE_AGENT); CTL[1] = 0u; }
        __syncthreads();
        const int u = (int)CTL[0];
        if (u >= NPIECE * NB * NH) break;
        const unsigned pc = PIECES[u >> 5]; const int bh = u & 31, b = bh >> 3, h = bh & 7;
        const int j = (int)(pc & 0xff), qlo = (int)((pc >> 8) & 0xff), qhi = (int)(pc >> 16); const int ncand = (qhi - qlo + 1) * 256;
        const size_t tokb = (size_t)b * SEQ;
        for (int id = F.tid; id < 2048; id += 512) { const int row = id >> 3, c8 = id & 7; const size_t ro = (tokb + j * 256 + row) * 1536 + h * 64 + c8 * 8;
            *(LAS u32x4*)(Ks + row * KS_PITCH + c8 * 16) = *(const u32x4*)(MO + ro + 512); }
        for (int id = F.tid; id < 1024; id += 512) { const int rp = id >> 3, c8 = id & 7; const size_t ro = (tokb + j * 256 + 2 * rp) * 1536 + h * 64 + c8 * 8 + 1024;
            const u32x4 v0 = *(const u32x4*)(MO + ro), v1 = *(const u32x4*)(MO + ro + 1536);
            const unsigned a[4] = {v0.x, v0.y, v0.z, v0.w}, bq[4] = {v1.x, v1.y, v1.z, v1.w};
            LAS unsigned char* vp = Vt + (c8 * 8) * VT_PITCH + rp * 4;
#pragma unroll
            for (int q = 0; q < 4; ++q) { *(LAS unsigned*)(vp + (2 * q) * VT_PITCH) = (a[q] & 0xffffu) | (bq[q] << 16); *(LAS unsigned*)(vp + (2 * q + 1) * VT_PITCH) = (a[q] >> 16) | (bq[q] & 0xffff0000u); } }
        if (F.tid <= 128) { const int n = F.tid; int bucket;
            if (n < 16) bucket = n; else { int lg = 16 + (int)(logf((float)n / 16.0f) / 2.0794415416798357f * 16.0f); bucket = lg < 31 ? lg : 31; }
            LUT[n] = relb[bucket * 8 + h]; }
        unsigned selw[11];
#pragma unroll
        for (int r = 0; r < 11; ++r) { const int qq = qlo * 256 + r * 512 + F.tid; selw[r] = (r * 512 + F.tid < ncand) ? SEL[(tokb + qq) * 8 + h] : 0u; }
#pragma unroll
        for (int r = 0; r < 11; ++r) { const int base = r * 512; if (base >= ncand) break;
            const int q = qlo * 256 + base + F.tid; const int qb = q >> 8; bool mem = false; unsigned ent = 0;
            if (base + F.tid >= ncand) { }
            else if (qb == j) { mem = true; ent = (unsigned)q | (3u << 16); }
            else { const unsigned s = selw[r]; const unsigned nv = s >> 24;
                if (nv > 0 && (s & 0xff) == (unsigned)j) { mem = true; ent = (unsigned)q; }
                else if (nv > 1 && ((s >> 8) & 0xff) == (unsigned)j) { mem = true; ent = (unsigned)q | (1u << 16); }
                else if (nv > 2 && ((s >> 16) & 0xff) == (unsigned)j) { mem = true; ent = (unsigned)q | (2u << 16); } }
            const unsigned long long bal = __ballot(mem); const int cnt = __popcll(bal);
            unsigned wbase = 0; if (lane == 0 && cnt > 0) wbase = __hip_atomic_fetch_add(&CTL[1], (unsigned)cnt, __ATOMIC_RELAXED, __HIP_MEMORY_SCOPE_WORKGROUP);
            wbase = (unsigned)__builtin_amdgcn_readfirstlane((int)wbase);
            if (mem) LIST[wbase + __popcll(bal & ((1ull << lane) - 1ull))] = ent;
        }
        __syncthreads();
        const int total = (int)CTL[1];
        const float bfar = LUT[128];
        const int ntile = (total + 31) >> 5;
        const int qi = lane & 31, half = lane >> 5;
        for (int tile = F.wave; tile < ntile; tile += 8) {
            const int e = tile * 32 + qi; const bool valid = e < total; const unsigned en = LIST[valid ? e : total - 1];
            const int q = (int)(en & 0xffffu), slot = (int)(en >> 16); const size_t tok = tokb + q;
            const bool need_lut = __any((q >> 8) <= j + 1);
            bf16x8 qf[4];
#pragma unroll
            for (int kk = 0; kk < 4; ++kk) qf[kk] = *(const bf16x8*)(MO + tok * 1536 + h * 64 + 16 * kk + 8 * half);
            float mrun = -1e30f, lsum = 0.f;
            f32x16 oacc[2];
#pragma unroll
            for (int i = 0; i < 16; ++i) { oacc[0][i] = 0.f; oacc[1][i] = 0.f; }
            const int qrel = q - j * 256;
#pragma unroll 1
            for (int ck = 0; ck < 4; ++ck) {
                if (!__any(qrel >= 64 * ck)) break;
                f32x16 sacc[2];
#pragma unroll
                for (int k2 = 0; k2 < 2; ++k2) { const int kt = 2 * ck + k2;
#pragma unroll
                    for (int i = 0; i < 16; ++i) sacc[k2][i] = 0.f;
#pragma unroll
                    for (int kk = 0; kk < 4; ++kk) { const bf16x8 ka = *(const LAS bf16x8*)(Ks + (32 * kt + qi) * KS_PITCH + (16 * kk + 8 * half) * 2);
                        sacc[k2] = __builtin_amdgcn_mfma_f32_32x32x16_bf16(ka, qf[kk], sacc[k2], 0, 0, 0); } }
                float mx = -1e30f;
                if (need_lut) {
#pragma unroll
                    for (int k2 = 0; k2 < 2; ++k2)
#pragma unroll
                        for (int i = 0; i < 16; ++i) { const int key = 32 * (2 * ck + k2) + (i & 3) + 8 * (i >> 2) + 4 * half; const int n = qrel - key;
                            const float bias = LUT[n < 0 ? 0 : (n > 128 ? 128 : n)];
                            const float s = (n < 0) ? -1e30f : sacc[k2][i] + bias; sacc[k2][i] = s; mx = fmaxf(mx, s); }
                } else {
#pragma unroll
                    for (int k2 = 0; k2 < 2; ++k2)
#pragma unroll
                        for (int i = 0; i < 16; ++i) { const float s = sacc[k2][i] + bfar; sacc[k2][i] = s; mx = fmaxf(mx, s); }
                }
                mx = fmaxf(mx, __shfl_xor(mx, 32));
                const float mnew = fmaxf(mrun, mx); const float alpha = __expf(mrun - mnew); mrun = mnew;
                lsum *= alpha;
#pragma unroll
                for (int i = 0; i < 16; ++i) { oacc[0][i] *= alpha; oacc[1][i] *= alpha; }
#pragma unroll
                for (int k2 = 0; k2 < 2; ++k2) { const int kt = 2 * ck + k2;
#pragma unroll
                    for (int i = 0; i < 16; ++i) { const float p = __expf(sacc[k2][i] - mnew); sacc[k2][i] = p; lsum += p; }
#pragma unroll
                    for (int cc = 0; cc < 2; ++cc) {
                        u32x4 pw; pw.x = pk2(sacc[k2][8 * cc], sacc[k2][8 * cc + 1]); pw.y = pk2(sacc[k2][8 * cc + 2], sacc[k2][8 * cc + 3]); pw.z = pk2(sacc[k2][8 * cc + 4], sacc[k2][8 * cc + 5]); pw.w = pk2(sacc[k2][8 * cc + 6], sacc[k2][8 * cc + 7]);
                        const bf16x8 pf = __builtin_bit_cast(bf16x8, pw);
                        const int key0 = 32 * kt + 16 * cc + 4 * half;
#pragma unroll
                        for (int dt = 0; dt < 2; ++dt) { const LAS unsigned char* vb = Vt + (32 * dt + qi) * VT_PITCH + key0 * 2;
                            const u32x2 va = *(const LAS u32x2*)vb, vb2 = *(const LAS u32x2*)(vb + 16);
                            u32x4 vw; vw.x = va.x; vw.y = va.y; vw.z = vb2.x; vw.w = vb2.y;
                            oacc[dt] = __builtin_amdgcn_mfma_f32_32x32x16_bf16(__builtin_bit_cast(bf16x8, vw), pf, oacc[dt], 0, 0, 0); } } }
            }
            const float mx = mrun;
            lsum += __shfl_xor(lsum, 32);
            const float inv = 1.0f / lsum;
            if (valid) {
                bf16_t* op = PO + ((size_t)slot * T + tok) * CW + h * 64;
#pragma unroll
                for (int dt = 0; dt < 2; ++dt)
#pragma unroll
                    for (int ig = 0; ig < 4; ++ig) { u32x2 w; w.x = pk2(oacc[dt][4 * ig] * inv, oacc[dt][4 * ig + 1] * inv); w.y = pk2(oacc[dt][4 * ig + 2] * inv, oacc[dt][4 * ig + 3] * inv);
                        *(u32x2*)(op + 32 * dt + 8 * ig + 4 * half) = w; }
                if (half == 0) PST[((size_t)slot * T + tok) * 8 + h] = (f32x2){mx, lsum};
            }
        }
    }
}
DI void phase_moba_combine(Frame& F) {
    const bf16_t* PO = (const bf16_t*)(F.wsp() + WS_PO); const f32x2* PST = (const f32x2*)(F.wsp() + WS_PST); const unsigned* SEL = (const unsigned*)(F.wsp() + WS_SEL);
    bf16_t* YM = (bf16_t*)(F.wsp() + WS_YRM) + 512;
    int c = F.tid; const int h = c >> 6;
    for (int tb = F.bid * 8; tb < T; tb += F.G * 8) {
        int tbase = tb; asm volatile("" : "+s"(tbase), "+v"(c));
        int nv[8]; f32x2 st[8][4]; float po[8][4];
#pragma unroll
        for (int e = 0; e < 8; ++e) { const int t = tbase + e; nv[e] = (int)(SEL[(size_t)t * 8 + h] >> 24);
#pragma unroll
            for (int s = 0; s < 4; ++s) { st[e][s] = PST[((size_t)s * T + t) * 8 + h]; po[e][s] = bf2f(PO[((size_t)s * T + t) * CW + c]); } }
#pragma unroll
        for (int e = 0; e < 8; ++e) { const int t = tbase + e; float M = -1e30f;
#pragma unroll
            for (int s = 0; s < 4; ++s) { const bool on = (s == 3) || (s < nv[e]); if (on) M = fmaxf(M, st[e][s].x); }
            float den = 0.f, num = 0.f;
#pragma unroll
            for (int s = 0; s < 4; ++s) { const bool on = (s == 3) || (s < nv[e]); if (on) { const float w = st[e][s].y * __expf(st[e][s].x - M); den += w; num += w * po[e][s]; } }
            YM[(size_t)t * YRM_LD + c] = f2bf(num / den); }
    }
}
DI void phase_router(Frame& F, int l) {
    LAS float* xs = (LAS float*)F.lds;
    LAS float* wsm = xs + 64 * 129;
    LAS float* lgt = wsm + 128 * 36;
    LAS float* ssq = lgt + 64 * 37;
    LAS int* hist = (LAS int*)(ssq + 64);
    const float* x = F.outp(); const float* gain = F.inp(2) + (size_t)l * DM;
    const float* wgrp = F.inp(29) + (size_t)l * DM * 4; const float* wexp = F.inp(31) + (size_t)l * DM * 32;
    const float* bgrp = F.inp(30) + l * 4; const float* bexp = F.inp(32) + l * 32;
    int* EID = (int*)(F.wsp() + WS_RT + RT_EID); float* GATE = (float*)(F.wsp() + WS_RT + RT_GATE); int* HIST = (int*)(F.wsp() + WS_RT + RT_HIST);
    const int tok = F.tid & 63, jg = F.tid >> 6;
    for (int tile = F.bid; tile < T / 64; tile += F.G) {
        const int t0 = tile * 64;
        float acc[5] = {0.f, 0.f, 0.f, 0.f, 0.f}; float ss = 0.f;
        if (F.tid < 32) hist[F.tid] = 0;
        for (int kc = 0; kc < DM; kc += 128) {
            __syncthreads();
            for (int idx = F.tid; idx < 64 * 128; idx += 512) { const int r = idx >> 7, k = idx & 127; xs[r * 129 + k] = x[(size_t)(t0 + r) * DM + kc + k]; }
            for (int idx = F.tid; idx < 128 * 36; idx += 512) { const int k = idx / 36, j = idx - k * 36; const float g = gain[kc + k];
                wsm[idx] = g * (j < 4 ? wgrp[(size_t)(kc + k) * 4 + j] : wexp[(size_t)(kc + k) * 32 + (j - 4)]); }
            __syncthreads();
            for (int k = 0; k < 128; ++k) { const float xv = xs[tok * 129 + k]; ss += xv * xv;
#pragma unroll
                for (int i = 0; i < 5; ++i) { const int j = jg + 8 * i; if (j < 36) acc[i] += xv * wsm[k * 36 + j]; } }
        }
#pragma unroll
        for (int i = 0; i < 5; ++i) { const int j = jg + 8 * i; if (j < 36) lgt[tok * 37 + j] = acc[i]; }
        if (jg == 0) ssq[tok] = ss;
        __syncthreads();
        if (F.tid < 64) {
            const int t = t0 + F.tid; const float rs = 1.0f / sqrtf(ssq[F.tid] * (1.f / DM) + 1e-6f);
            float lg[4]; int gs = 0; float gm = -INFINITY;
#pragma unroll
            for (int g = 0; g < 4; ++g) { lg[g] = lgt[F.tid * 37 + g] * rs + bgrp[g]; if (lg[g] > gm) { gm = lg[g]; gs = g; } }
            float gden = 0.f;
#pragma unroll
            for (int g = 0; g < 4; ++g) gden += expf(lg[g] - gm);
            const float ptop = 1.0f / gden;
            float le[8]; float e0 = -INFINITY, e1 = -INFINITY; int j0 = 0, j1 = 1;
#pragma unroll
            for (int e = 0; e < 8; ++e) { le[e] = lgt[F.tid * 37 + 4 + gs * 8 + e] * rs + bexp[gs * 8 + e];
                if (le[e] > e0) { e1 = e0; j1 = j0; e0 = le[e]; j0 = e; } else if (le[e] > e1) { e1 = le[e]; j1 = e; } }
            const float p1 = expf(e1 - e0);
            const float g0 = ptop / (1.f + p1), g1 = ptop * p1 / (1.f + p1);
            const int ex0 = gs * 8 + j0, ex1 = gs * 8 + j1;
            EID[t * 2] = ex0; EID[t * 2 + 1] = ex1; GATE[t * 2] = g0; GATE[t * 2 + 1] = g1;
            __hip_atomic_fetch_add(&hist[ex0], 1, __ATOMIC_RELAXED, __HIP_MEMORY_SCOPE_WORKGROUP); __hip_atomic_fetch_add(&hist[ex1], 1, __ATOMIC_RELAXED, __HIP_MEMORY_SCOPE_WORKGROUP);
        }
        __syncthreads();
        if (F.tid < 32) HIST[tile * 32 + F.tid] = hist[F.tid];
        __syncthreads();
    }
}
DI void phase_moe_gather(Frame& F, int l) {
    LAS int* tot = (LAS int*)F.lds; LAS int* off = tot + 32; LAS int* base = off + 32; LAS int* eidl = base + 32; LAS int* rowl = eidl + 128; LAS int* ps = rowl + 128; LAS int* po = ps + 512;
    const int* EID = (const int*)(F.wsp() + WS_RT + RT_EID); const float* GATE = (const float*)(F.wsp() + WS_RT + RT_GATE); const int* HIST = (const int*)(F.wsp() + WS_RT + RT_HIST);
    int* ROW = (int*)(F.wsp() + WS_RT + RT_ROW); float* GW = (float*)(F.wsp() + WS_RT + RT_GW); int* PEXP = (int*)(F.wsp() + WS_RT + RT_PEXP);
    int* TOK = (int*)(F.wsp() + WS_RT + RT_TOK); const float* RSQ = (const float*)(F.wsp() + WS_RT + RT_RSQ); float* RSR = (float*)(F.wsp() + WS_RT + RT_RSR);
    for (int tile = F.bid; tile < T / 64; tile += F.G) {
        const int t0 = tile * 64;
        __syncthreads();
        { const int e = F.tid & 31, part = F.tid >> 5; int s = 0, o = 0;
#pragma unroll 8
          for (int i = part * 32; i < part * 32 + 32; ++i) { const int v = HIST[i * 32 + e]; s += v; if (i < tile) o += v; }
          ps[F.tid] = s; po[F.tid] = o; }
        if (F.tid < 128) eidl[F.tid] = EID[t0 * 2 + F.tid];
        __syncthreads();
        if (F.tid < 32) { int s = 0, o = 0;
#pragma unroll
            for (int p = 0; p < 16; ++p) { s += ps[p * 32 + F.tid]; o += po[p * 32 + F.tid]; } tot[F.tid] = s; off[F.tid] = o; }
        __syncthreads();
        if (F.tid == 0) {
            int bs = 0; for (int e = 0; e < 32; ++e) { base[e] = bs; bs += (tot[e] + 255) & ~255; }
            if (tile == 0) { int p = 0; for (int e = 0; e < 32; ++e) { const int np = (tot[e] + 255) >> 8; for (int i = 0; i < np; ++i) PEXP[p++] = e; } PEXP[MOE_PANELS] = p; }
        }
        __syncthreads();
        if (F.tid < 128) { const int my = eidl[F.tid]; int rank = 0; for (int i = 0; i < F.tid; ++i) rank += (eidl[i] == my) ? 1 : 0;
            const int r = base[my] + off[my] + rank; rowl[F.tid] = r; ROW[t0 * 2 + F.tid] = r; GW[r] = GATE[t0 * 2 + F.tid]; TOK[r] = t0 + (F.tid >> 1); RSR[r] = RSQ[t0 + (F.tid >> 1)]; }
    }
}
DI void phase_moe_combine(Frame& F, int l) {
    const bf16_t* YE = (const bf16_t*)(F.wsp() + WS_YE); const int* ROW = (const int*)(F.wsp() + WS_RT + RT_ROW); bf16_t* XN = (bf16_t*)(F.wsp() + WS_XN);
    const float* gain = F.inp(1) + (size_t)(l + 1 < NLAYER ? l + 1 : l) * DM;
    const int gw = F.bid * 8 + F.wave, NGW = F.G * 8; int lane = F.lane;
    for (int tb = gw * 4; tb < T; tb += NGW * 4) {
        int tbase = tb; asm volatile("" : "+s"(tbase), "+v"(lane));
        int r0[4], r1[4];
#pragma unroll
        for (int e = 0; e < 4; ++e) { r0[e] = ROW[(tbase + e) * 2]; r1[e] = ROW[(tbase + e) * 2 + 1]; }
        u32x2 ya[4][4], yb[4][4]; f32x4 xv[4][4];
#pragma unroll
        for (int e = 0; e < 4; ++e) { const u32x2* y0 = (const u32x2*)(YE + (size_t)r0[e] * DM) + lane; const u32x2* y1 = (const u32x2*)(YE + (size_t)r1[e] * DM) + lane; const f32x4* xr = (const f32x4*)(F.outp() + (size_t)(tbase + e) * DM) + lane;
#pragma unroll
            for (int j = 0; j < 4; ++j) { ya[e][j] = y0[64 * j]; yb[e][j] = y1[64 * j]; xv[e][j] = xr[64 * j]; } }
#pragma unroll
        for (int e = 0; e < 4; ++e) { const int t = tbase + e; f32x4* xr = (f32x4*)(F.outp() + (size_t)t * DM) + lane; float s = 0.f;
#pragma unroll
            for (int j = 0; j < 4; ++j) { f32x4 v = xv[e][j]; const u32x2 a = ya[e][j], b = yb[e][j];
                v.x += bflo(a.x) + bflo(b.x); v.y += bfhi(a.x) + bfhi(b.x); v.z += bflo(a.y) + bflo(b.y); v.w += bfhi(a.y) + bfhi(b.y);
                xv[e][j] = v; xr[64 * j] = v; s += (v.x * v.x + v.y * v.y) + (v.z * v.z + v.w * v.w); }
            if (l + 1 < NLAYER) {
                const float rs = __builtin_amdgcn_rsqf(wave_sum(s) * (1.f / DM) + 1e-6f);
#pragma unroll
                for (int j = 0; j < 4; ++j) { const f32x4 g = ((const f32x4*)gain)[lane + 64 * j]; const f32x4 y = xv[e][j] * rs * g; u32x2 w; w.x = pk2(y.x, y.y); w.y = pk2(y.z, y.w); *((u32x2*)(XN + (size_t)t * DM) + lane + 64 * j) = w; }
            } }
    }
}
constexpr size_t TB_WRH = 512 * 1024, TB_WRL = TB_WRH + 48 * 1024 * 2;
DI void phase_conv_router(Frame& F, int l) {
    bf16_t* WRH = (bf16_t*)(F.wsp() + WS_TAB + TB_WRH); bf16_t* WRL = (bf16_t*)(F.wsp() + WS_TAB + TB_WRL);
    const float* gain = F.inp(2) + (size_t)l * DM; const float* wgrp = F.inp(29) + (size_t)l * DM * 4; const float* wexp = F.inp(31) + (size_t)l * DM * 32;
    for (int idx = F.bid * 512 + F.tid; idx < 48 * DM; idx += F.G * 512) { const int n = idx >> 10, k = idx & 1023;
        float v = (n < 4) ? wgrp[k * 4 + n] : (n < 36) ? wexp[k * 32 + (n - 4)] : 0.f; v *= gain[k];
        const bf16_t h = f2bf(v); WRH[idx] = h; WRL[idx] = f2bf(v - bf2f(h)); }
}
DI void phase_router2(Frame& F, int l) {
    LAS float* lgt = (LAS float*)F.lds + F.wave * 1024;
    LAS int* hist = (LAS int*)(F.lds + 8 * 4096);
    const float* x = F.outp(); const bf16_t* WRH = (const bf16_t*)(F.wsp() + WS_TAB + TB_WRH); const bf16_t* WRL = (const bf16_t*)(F.wsp() + WS_TAB + TB_WRL);
    const float* bgrp = F.inp(30) + l * 4; const float* bexp = F.inp(32) + l * 32;
    int* EID = (int*)(F.wsp() + WS_RT + RT_EID); float* GATE = (float*)(F.wsp() + WS_RT + RT_GATE); int* HIST = (int*)(F.wsp() + WS_RT + RT_HIST);
    const int lane = F.lane, r16 = lane & 15, g = lane >> 4;
    bf16_t* XN2 = (bf16_t*)(F.wsp() + WS_AM); const float* gain = F.inp(2) + (size_t)l * DM; float* RSQ = (float*)(F.wsp() + WS_RT + RT_RSQ);
    { int* TOK = (int*)(F.wsp() + WS_RT + RT_TOK); for (int i = F.bid * 512 + F.tid; i < MOE_ROWS; i += F.G * 512) TOK[i] = 0; }
    for (int task = F.bid; task < T / 128; task += F.G) {
        const int t0 = task * 128 + F.wave * 16;
        __syncthreads();
        if (F.tid < 64) hist[F.tid] = 0;
        __syncthreads();
        f32x4 acc[3];
#pragma unroll
        for (int nt = 0; nt < 3; ++nt) acc[nt] = (f32x4){0.f, 0.f, 0.f, 0.f};
        float ss = 0.f;
        const float* xr = x + (size_t)(t0 + r16) * DM + 8 * g; bf16_t* xo = XN2 + (size_t)(t0 + r16) * DM + 8 * g; const float* gp = gain + 8 * g;
#pragma unroll 2
        for (int s = 0; s < 32; ++s) {
            const f32x4 x0 = *(const f32x4*)(xr + 32 * s), x1 = *(const f32x4*)(xr + 32 * s + 4);
            ss += (x0.x * x0.x + x0.y * x0.y) + (x0.z * x0.z + x0.w * x0.w) + (x1.x * x1.x + x1.y * x1.y) + (x1.z * x1.z + x1.w * x1.w);
            { const f32x4 g0 = *(const f32x4*)(gp + 32 * s), g1 = *(const f32x4*)(gp + 32 * s + 4);
              u32x4 w; w.x = pk2(x0.x * g0.x, x0.y * g0.y); w.y = pk2(x0.z * g0.z, x0.w * g0.w); w.z = pk2(x1.x * g1.x, x1.y * g1.y); w.w = pk2(x1.z * g1.z, x1.w * g1.w);
              *(u32x4*)(xo + 32 * s) = w; }
            u32x4 hw, lw; hw.x = pk2(x0.x, x0.y); hw.y = pk2(x0.z, x0.w); hw.z = pk2(x1.x, x1.y); hw.w = pk2(x1.z, x1.w);
            lw.x = pk2(x0.x - bflo(hw.x), x0.y - bfhi(hw.x)); lw.y = pk2(x0.z - bflo(hw.y), x0.w - bfhi(hw.y)); lw.z = pk2(x1.x - bflo(hw.z), x1.y - bfhi(hw.z)); lw.w = pk2(x1.z - bflo(hw.w), x1.w - bfhi(hw.w));
            const bf16x8 ah = __builtin_bit_cast(bf16x8, hw), al = __builtin_bit_cast(bf16x8, lw);
#pragma unroll
            for (int nt = 0; nt < 3; ++nt) { const size_t wo = (size_t)(16 * nt + r16) * DM + 32 * s + 8 * g;
                const bf16x8 bh = *(const bf16x8*)(WRH + wo), bl = *(const bf16x8*)(WRL + wo);
                acc[nt] = mfma16(ah, bh, acc[nt]); acc[nt] = mfma16(ah, bl, acc[nt]); acc[nt] = mfma16(al, bh, acc[nt]); }
        }
        ss += __shfl_xor(ss, 16); ss += __shfl_xor(ss, 32);
        if (g == 0) RSQ[t0 + r16] = __builtin_amdgcn_rsqf(ss * (1.f / DM) + 1e-6f);
#pragma unroll
        for (int nt = 0; nt < 3; ++nt)
#pragma unroll
            for (int r = 0; r < 4; ++r) lgt[(4 * g + r) * 48 + 16 * nt + r16] = acc[nt][r];
        if (g == 0) lgt[768 + r16] = ss;
        LDS_WAIT(); asm volatile("" ::: "memory");
        if (lane < 16) {
            const int t = t0 + lane; const float rs = 1.0f / sqrtf(lgt[768 + lane] * (1.f / DM) + 1e-6f); const LAS float* lr = lgt + lane * 48;
            float lg[4]; int gs = 0; float gm = -INFINITY;
#pragma unroll
            for (int q = 0; q < 4; ++q) { lg[q] = lr[q] * rs + bgrp[q]; if (lg[q] > gm) { gm = lg[q]; gs = q; } }
            float gden = 0.f;
#pragma unroll
            for (int q = 0; q < 4; ++q) gden += expf(lg[q] - gm);
            const float ptop = 1.0f / gden;
            float e0 = -INFINITY, e1 = -INFINITY; int j0 = 0, j1 = 1;
#pragma unroll
            for (int e = 0; e < 8; ++e) { const float le = lr[4 + gs * 8 + e] * rs + bexp[gs * 8 + e];
                if (le > e0) { e1 = e0; j1 = j0; e0 = le; j0 = e; } else if (le > e1) { e1 = le; j1 = e; } }
            const float p1 = expf(e1 - e0);
            const float g0 = ptop / (1.f + p1), g1 = ptop * p1 / (1.f + p1);
            const int ex0 = gs * 8 + j0, ex1 = gs * 8 + j1;
            EID[t * 2] = ex0; EID[t * 2 + 1] = ex1; GATE[t * 2] = g0; GATE[t * 2 + 1] = g1;
            LAS int* hh = hist + (F.wave >> 2) * 32;
            __hip_atomic_fetch_add(&hh[ex0], 1, __ATOMIC_RELAXED, __HIP_MEMORY_SCOPE_WORKGROUP); __hip_atomic_fetch_add(&hh[ex1], 1, __ATOMIC_RELAXED, __HIP_MEMORY_SCOPE_WORKGROUP);
        }
        __syncthreads();
        if (F.tid < 64) HIST[(task * 2 + (F.tid >> 5)) * 32 + (F.tid & 31)] = hist[F.tid];
    }
}
#ifndef MK_PER_PHASE_LAUNCH
#define MK_PER_PHASE_LAUNCH 0
#endif
constexpr int PH_PER_LAYER = 19, NPHASE = PH_PER_LAYER * NLAYER;
struct Args { const float* in[36]; float* out; unsigned char* ws; int ph_lo, ph_hi; };

#ifndef SCAN_NAIVE
#define SCAN_NAIVE 0
#endif
#ifndef PHMASK
#define PHMASK 0x7ffff
#endif
#ifndef DUPMASK
#define DUPMASK 0
#endif
#define NREP(k) ((((DUPMASK) >> (k)) & 1) ? 2 : 1)
#define IN(k) (((PHMASK >> ((k) % PH_PER_LAYER)) & 1) && lo <= (k) && (k) < hi)
#define SEAM(k) do { asm volatile("" : "+s"(barp), "+s"(bar.x)); bar.bar = (unsigned*)barp; if (IN(k) && IN((k) + 1)) xcd_barrier(bar); asm volatile("" : "+s"(F.ws_g), "+s"(F.out_g), "+s"(F.ka), "+s"(F.bid), "+s"(F.G), "+s"(F.lds)); } while (0)
#define FRESH() do { asm volatile("" : "+s"(F.wave)); int l_ = (int)__builtin_amdgcn_mbcnt_hi(~0u, __builtin_amdgcn_mbcnt_lo(~0u, 0u)); asm volatile("" : "+v"(l_)); F.lane = l_; F.tid = F.wave * 64 + l_; } while (0)
__global__ void __launch_bounds__(512, 2) fwd_kernel(Args args) {
    extern __shared__ __attribute__((aligned(16))) unsigned char lds_raw[];
    Frame F;
    F.lds = (LAS unsigned char*)lds_raw;
    F.tid = threadIdx.x; F.lane = F.tid & 63; F.wave = __builtin_amdgcn_readfirstlane(F.tid >> 6);
    F.G = gridDim.x; F.bid = blockIdx.x;
    F.ka = (const __attribute__((address_space(4))) unsigned char*)__builtin_amdgcn_kernarg_segment_ptr();
    F.out_g = (GAS float*)args.out; F.ws_g = (GAS unsigned char*)args.ws;
    volatile LAS unsigned* MISC = (volatile LAS unsigned*)(F.lds + MISC_OFF);
    if (F.tid < 32) MISC[F.tid] = 0u;
    __syncthreads();
    const int lo = args.ph_lo, hi = args.ph_hi;
    GAS unsigned* barp = (GAS unsigned*)(F.ws_g + WS_CTL) + CW_BAR;
    XcdBarrier bar; bar.bar = (unsigned*)barp; bar.x = 0; bar.st = nullptr;
    if (hi - lo > 1) bar = xcd_barrier_post((unsigned*)barp, MISC + 8);

    bf16_t* const XN = (bf16_t*)(F.wsp() + WS_XN);
    bf16_t* const WCAT = (bf16_t*)(F.wsp() + WS_WM + WM_WCAT);
    for (int l = 0; l < NLAYER; ++l) {
        const int P = l * PH_PER_LAYER;
#define PHASE(k) if (IN(P + (k))) for (int rep_ = 0; rep_ < NREP(k); ++rep_)
        PHASE(0) { FRESH(); if (l == 0) { phase_conv_mixer(F, 0); phase_conv_lora2(F, 0); phase_conv_router(F, 0); phase_norm_x(F, F.inp(0), F.inp(1)); } }
        if (l == 0) SEAM(P + 0);
#if defined(XTRA_BARS)
        if (hi - lo > 1) for (int xb_ = 0; xb_ < XTRA_BARS; ++xb_) { asm volatile("" : "+s"(barp), "+s"(bar.x)); bar.bar = (unsigned*)barp; xcd_barrier(bar); }
#endif
        PHASE(1) { FRESH(); const int n1 = (l == 0) ? 2048 : 2304;
            pg8::Gemm g{XN, WCAT, T, n1, DM}; pg8::StaticOrder S; S.init(T, n1, F.G, F.bid);
            pg8::EpiStore E{(bf16_t*)(F.wsp() + WS_RW), 1536, 1536, (bf16_t*)(F.wsp() + WS_LO), LO_W, 0};
            pg8::gemm_phase<pg8::EpiStore, pg8::StaticOrder>(F.lds, g, S, E, F.tid); }
        SEAM(P + 1);
        PHASE(2) { FRESH(); phase_prep_scana(F, l); }
        SEAM(P + 2);
        PHASE(4) { FRESH(); phase_scan_b(F); }
        SEAM(P + 4);
        PHASE(5) { FRESH(); phase_scan_c(F, l); }
        SEAM(P + 5);
        PHASE(6) { FRESH(); pg8::Gemm g{XN, WCAT + (size_t)2304 * DM, T, 1536, DM}; pg8::StaticOrder S; S.init(T, 1536, F.G, F.bid);
            pg8::EpiMoba E{(bf16_t*)(F.wsp() + WS_MO), F.inp(23) + l * 64, F.inp(24) + l * 64, (float*)(F.wsp() + WS_TAB + TB_KMEAN), (int)(TB_KMEAN2 / 4)};
            pg8::gemm_phase<pg8::EpiMoba, pg8::StaticOrder>(F.lds, g, S, E, F.tid); }
        SEAM(P + 6);
        PHASE(8) { FRESH(); phase_moba_gate(F); }
        SEAM(P + 8);
        PHASE(9) { FRESH(); phase_moba_attn(F, l); }
        SEAM(P + 9);
        PHASE(10) { FRESH(); phase_moba_combine(F); }
        SEAM(P + 10);
        PHASE(11) { FRESH(); pg8::Gemm g{XN, WCAT + (size_t)3840 * DM, T, 2048, DM}; pg8::StaticOrder S; S.init(T, 2048, F.G, F.bid);
            pg8::EpiStore E{(bf16_t*)(F.wsp() + WS_GA), 2048, 0, nullptr, 0, 1};
            pg8::gemm_phase<pg8::EpiStore, pg8::StaticOrder>(F.lds, g, S, E, F.tid); }
        SEAM(P + 11);
        PHASE(12) { FRESH(); pg8::Gemm g{(const bf16_t*)(F.wsp() + WS_YRM), (const bf16_t*)(F.wsp() + WS_WM + WM_BRR), T, DM, DM}; pg8::StaticOrder S; S.init(T, DM, F.G, F.bid);
            pg8::EpiBranch2 E{(bf16_t*)(F.wsp() + WS_H), (const bf16_t*)(F.wsp() + WS_GA)};
            pg8::gemm_phase<pg8::EpiBranch2, pg8::StaticOrder>(F.lds, g, S, E, F.tid); }
        SEAM(P + 12);
        PHASE(13) { FRESH(); pg8::Gemm g{(const bf16_t*)(F.wsp() + WS_H), (const bf16_t*)(F.wsp() + WS_WM + WM_OUT), T, DM, DM}; pg8::StaticOrder S; S.init(T, DM, F.G, F.bid);
            pg8::EpiResid E{l == 0 ? F.inp(0) : F.outp(), F.outp()};
            pg8::gemm_phase<pg8::EpiResid, pg8::StaticOrder>(F.lds, g, S, E, F.tid); }
        SEAM(P + 13);
        PHASE(14) { FRESH(); phase_router2(F, l); phase_conv_experts(F, l); }
        SEAM(P + 14);
        PHASE(15) { FRESH(); phase_moe_gather(F, l); }
        SEAM(P + 15);
        PHASE(16) { FRESH(); const int* PEXP = (const int*)(F.wsp() + WS_RT + RT_PEXP); const int np = __builtin_amdgcn_readfirstlane(PEXP[MOE_PANELS]);
            pg8::Gemm g{(const bf16_t*)(F.wsp() + WS_AM), (const bf16_t*)(F.wsp() + WS_WE), np * 256, 1024, DM}; pg8::GatherOrder S; S.init(np * 256, 1024, F.G, F.bid); S.pexp = PEXP;
            LAS int* tokL = (LAS int*)(F.lds + RING_BYTES); S.tokL = tokL;
            { const int* TOK = (const int*)(F.wsp() + WS_RT + RT_TOK); __syncthreads();
              for (int i = 0; i < 16; ++i) { pg8::Unit uu; if (!S.next(i, uu)) break; if (F.tid < 256) tokL[i * 256 + F.tid] = TOK[uu.pm * 256 + F.tid]; }
              __syncthreads(); }
            pg8::EpiExpertUp E{(bf16_t*)(F.wsp() + WS_HM), (const float*)(F.wsp() + WS_RT + RT_GW), (const float*)(F.wsp() + WS_RT + RT_RSR)};
            pg8::gemm_phase<pg8::EpiExpertUp, pg8::GatherOrder>(F.lds, g, S, E, F.tid); }
        SEAM(P + 16);
        PHASE(17) { FRESH(); const int* PEXP = (const int*)(F.wsp() + WS_RT + RT_PEXP); const int np = __builtin_amdgcn_readfirstlane(PEXP[MOE_PANELS]);
            pg8::Gemm g{(const bf16_t*)(F.wsp() + WS_HM), (const bf16_t*)(F.wsp() + WS_WD), np * 256, 1024, DEXP}; pg8::GroupOrder S; S.init(np * 256, 1024, F.G, F.bid); S.pexp = PEXP;
            pg8::EpiStore E{(bf16_t*)(F.wsp() + WS_YE), 1024, 0, nullptr, 0, 0};
            pg8::gemm_phase<pg8::EpiStore, pg8::GroupOrder>(F.lds, g, S, E, F.tid); }
        SEAM(P + 17);
        PHASE(18) { FRESH(); phase_moe_combine(F, l); if (l + 1 < NLAYER) { phase_conv_mixer(F, l + 1); phase_conv_lora2(F, l + 1); phase_conv_router(F, l + 1); } }
        SEAM(P + 18);
#undef PHASE
    }
}

extern "C" void kernel_launch(void* const* d_in, const int* in_sizes, int n_in, void* d_out, int out_size, void* d_ws, size_t ws_size, hipStream_t stream) {
    static int grid = 0;
    if (grid == 0) {
        if (n_in != 36 || out_size != T * DM || ws_size < WS_NEED) { fprintf(stderr, "kernel_launch: unexpected problem (n_in %d, out %d, ws %zu); nothing launched\n", n_in, out_size, ws_size); grid = -1; return; }
        int dev = 0, cus = 0;
        if (hipGetDevice(&dev) != hipSuccess || hipDeviceGetAttribute(&cus, hipDeviceAttributeMultiprocessorCount, dev) != hipSuccess) { grid = -1; return; }
        if (hipFuncSetAttribute((const void*)fwd_kernel, hipFuncAttributeMaxDynamicSharedMemorySize, LDS_BYTES) != hipSuccess) { fprintf(stderr, "kernel_launch: hipFuncSetAttribute failed\n"); grid = -1; return; }
        int per_cu = 0;
        if (hipOccupancyMaxActiveBlocksPerMultiprocessor(&per_cu, (const void*)fwd_kernel, 512, LDS_BYTES) != hipSuccess || per_cu < 1) { fprintf(stderr, "kernel_launch: occupancy query says %d\n", per_cu); }
        (void)hipGetLastError();
        grid = cus;
    }
    if (grid < 0) return;
    (void)hipMemsetAsync((char*)d_ws + WS_CTL, 0, CTL_ZERO_BYTES, stream);
    Args a{};
    for (int i = 0; i < 36; ++i) a.in[i] = (const float*)d_in[i];
    a.out = (float*)d_out; a.ws = (unsigned char*)d_ws;
#if MK_PER_PHASE_LAUNCH
    for (int ph = 0; ph < NPHASE; ++ph) { if (ph == PH_PER_LAYER) continue; a.ph_lo = ph; a.ph_hi = ph + 1; hipLaunchKernelGGL(fwd_kernel, dim3(grid), dim3(512), LDS_BYTES, stream, a); }
#else
    a.ph_lo = 0; a.ph_hi = NPHASE;
    hipLaunchKernelGGL(fwd_kernel, dim3(grid), dim3(512), LDS_BYTES, stream, a);
#endif
}
```

```cpp
#include <hip/hip_runtime.h>
#include <cstdio>
#include <cstdint>
#define LAS __attribute__((address_space(3)))
#define GAS __attribute__((address_space(1)))
#define DI __device__ __forceinline__
typedef unsigned short bf16_t;
typedef short bf16x8 __attribute__((ext_vector_type(8)));
typedef short s16x4 __attribute__((ext_vector_type(4)));
typedef float f32x4 __attribute__((ext_vector_type(4)));
typedef float f32x2 __attribute__((ext_vector_type(2)));
typedef float f32x16 __attribute__((ext_vector_type(16)));
typedef unsigned u32x4 __attribute__((ext_vector_type(4)));
typedef unsigned u32x2 __attribute__((ext_vector_type(2)));
typedef __bf16 bf16v2 __attribute__((ext_vector_type(2)));

DI unsigned pk2(float lo, float hi) { f32x2 v = {lo, hi}; return __builtin_bit_cast(unsigned, __builtin_convertvector(v, bf16v2)); }
DI bf16_t f2bf(float f) { return (bf16_t)(pk2(f, 0.f) & 0xffffu); }
DI float bf2f(bf16_t b) { return __uint_as_float(((unsigned)b) << 16); }
DI float bflo(unsigned w) { return __uint_as_float(w << 16); }
DI float bfhi(unsigned w) { return __uint_as_float(w & 0xffff0000u); }
DI float rcpf_(float x) { return __builtin_amdgcn_rcpf(x); }
DI float sigmoidf_(float x) { return __builtin_amdgcn_rcpf(1.0f + __expf(-x)); }

template <int CTRL> DI float dpp_mov(float v) { return __builtin_bit_cast(float, __builtin_amdgcn_update_dpp(0, __builtin_bit_cast(int, v), CTRL, 0xf, 0xf, true)); }
DI float rdlane(float v, int l) { return __builtin_bit_cast(float, __builtin_amdgcn_readlane(__builtin_bit_cast(int, v), l)); }
DI float wave_sum(float v) {
    v += dpp_mov<0xB1>(v);
    v += dpp_mov<0x4E>(v);
    v += dpp_mov<0x141>(v);
    v += dpp_mov<0x140>(v);
    return (rdlane(v, 0) + rdlane(v, 16)) + (rdlane(v, 32) + rdlane(v, 48));
}
DI f32x4 mfma16(bf16x8 a, bf16x8 b, f32x4 c) { return __builtin_amdgcn_mfma_f32_16x16x32_bf16(a, b, c, 0, 0, 0); }
namespace pg8 {
constexpr int BM = 256, BK = 64, HALF = 128, HTB = HALF * BK * 2  , STAGE_BYTES = 8 * HTB, NXCD = 8, WGM = 8;

__host__ __device__ __forceinline__ int lds_byte(int r, int c) { const int st = (r >> 4) * 2 + (c >> 5), rr = r & 15, cc = c & 31, ob = rr * 64 + cc * 2; return st * 1024 + (ob ^ (((ob >> 9) & 1) << 5)); }
__host__ __device__ __forceinline__ void stage_rc(int b, int& R, int& C) { const int st = b / 1024, sb = b % 1024, swz = sb ^ (((sb >> 9) & 1) << 5); R = (st >> 1) * 16 + swz / 64; C = (st & 1) * 32 + (swz % 64) / 2; }
__host__ __device__ __forceinline__ int perm32(int rho) { const int n = rho >> 4, i = rho & 15; return 8 * (i >> 2) + 4 * n + (i & 3); }

struct Unit { int pm, pn, pb; };
struct Gemm { const bf16_t* A; const bf16_t* Bt; int M, N, K; };

struct StaticOrder {
    static constexpr bool GATHER = false;
    int nM, nN, nwg, G, c;
    __device__ __forceinline__ void init(int M, int N, int G_, int c_) { nM = M / BM; nN = N / BM; nwg = nM * nN; G = G_; c = c_; }
    __device__ __forceinline__ bool next(int i, Unit& u) const {
        const long L = (long)i * G + c; if (L >= nwg) return false;
        int wgid = (int)L; { const int q = nwg / NXCD, r = nwg % NXCD, xcd = wgid % NXCD, off = wgid / NXCD; wgid = (xcd < r ? xcd * (q + 1) : r * (q + 1) + (xcd - r) * q) + off; }
        const int nig = WGM * nN, gid = wgid / nig, fm = gid * WGM, gsz = (nM - fm) < WGM ? (nM - fm) : WGM;
        u.pm = fm + ((wgid % nig) % gsz); u.pn = (wgid % nig) / gsz; u.pb = u.pn; return true;
    }
};
struct GroupOrder : StaticOrder {
    const int* pexp;
    __device__ __forceinline__ bool next(int i, Unit& u) const {
        if (!StaticOrder::next(i, u)) return false;
        u.pb = __builtin_amdgcn_readfirstlane(pexp[u.pm]) * nN + u.pn; return true;
    }
};
struct GatherOrder : GroupOrder {
    static constexpr bool GATHER = true;
    const LAS int* tokL;
};

template <class Epi, class Sched, bool ALIGN_EPI = true, bool SP2 = true>
__device__ __forceinline__ void gemm_phase(LAS unsigned char* lds, const Gemm g, const Sched& S, const Epi& E, int tid_in) {
    const int tid = tid_in, wid = __builtin_amdgcn_readfirstlane(tid >> 6), lane = tid & 63, wr = wid >> 2, wc = wid & 3, fr = lane & 15, fq = lane >> 4;
    const int K = g.K, nt = K / BK;
    unsigned voffA[2], voffB[2];
#pragma unroll
    for (int i = 0; i < 2; ++i) { int R, C; stage_rc(tid * 16 + i * 8192, R, C); const int Rb = Epi::HEADS ? (64 * (R >> 5) + perm32(R & 31)) : Epi::PERM ? ((R & ~31) + perm32(R & 31)) : R;
        voffA[i] = (unsigned)(R * K + C) * 2u; voffB[i] = (unsigned)(Rb * K + C) * 2u; }
    unsigned goff[2][2] = {{0u, 0u}, {0u, 0u}}, goffN[2][2] = {{0u, 0u}, {0u, 0u}};
#define PG8_GOFF(dst, ui_) do { if constexpr (Sched::GATHER) { _Pragma("unroll") for (int h_ = 0; h_ < 2; ++h_) _Pragma("unroll") for (int i_ = 0; i_ < 2; ++i_) { int R_, C_; stage_rc(tid * 16 + i_ * 8192, R_, C_); \
        const int tk_ = S.tokL[(ui_) * 256 + 128 * h_ + R_]; dst[h_][i_] = (unsigned)(tk_ * K + C_) * 2u; } } } while (0)
#define PG8_STAGE_A(bufoff, kt, h, usenext) do { if constexpr (Sched::GATHER) { unsigned vo_[2] = { (usenext) ? goffN[h][0] : goff[h][0], (usenext) ? goffN[h][1] : goff[h][1] }; PG8_STAGE(bufoff, kt, vo_); } \
        else { PG8_STAGE(bufoff, (kt) + ((h) ? hstep : 0), voffA); } } while (0)
    const size_t kstep = (size_t)(BK * 2);
    const size_t hstep = (size_t)HALF * K * 2;
    const size_t hstepB = Epi::HEADS ? (size_t)32 * K * 2 : hstep;
    const size_t tstep = 2 * hstep;
    const unsigned ldsw = (unsigned)wid * 1024u;
    const int aoff = lds_byte(wr * 64 + fr, fq * 8), boff = lds_byte(wc * 32 + fr, fq * 8);
#define PG8_SA(b, h) (((b) * 2 + (h)) * HTB)
#define PG8_SB(b, h) ((4 + (b) * 2 + (h)) * HTB)
#define PG8_STAGE(bufoff, gbase, voff) do { _Pragma("unroll") for (int _i = 0; _i < 2; ++_i) \
        __builtin_amdgcn_global_load_lds((const unsigned*)((const char*)(gbase) + (voff)[_i]), (LAS unsigned*)(lds + (bufoff) + ldsw + _i * 8192), 16, 0, 0); } while (0)
#define PG8_LDA(dst, b, h) do { _Pragma("unroll") for (int m = 0; m < 4; ++m) _Pragma("unroll") for (int k = 0; k < 2; ++k) dst[m][k] = *(const LAS bf16x8*)(lds + PG8_SA(b, h) + aoff + m * 2048 + k * 1024); } while (0)
#define PG8_LDB(dst, b, h) do { _Pragma("unroll") for (int n = 0; n < 2; ++n) _Pragma("unroll") for (int k = 0; k < 2; ++k) dst[n][k] = *(const LAS bf16x8*)(lds + PG8_SB(b, h) + boff + n * 2048 + k * 1024); } while (0)
#define PG8_MMA(ai, bj, At, Bt) do { __builtin_amdgcn_s_setprio(1); _Pragma("unroll") for (int m = 0; m < 4; ++m) _Pragma("unroll") for (int n = 0; n < 2; ++n) _Pragma("unroll") for (int k = 0; k < 2; ++k) \
        acc[ai][bj][m][n] = __builtin_amdgcn_mfma_f32_16x16x32_bf16(Bt[n][k], At[m][k], acc[ai][bj][m][n], 0, 0, 0); __builtin_amdgcn_s_setprio(0); } while (0)
#define PG8_WAIT_V(n) asm volatile("s_waitcnt vmcnt(" #n ")" ::: "memory")
#define PG8_WAIT_L(n) asm volatile("s_waitcnt lgkmcnt(" #n ")" ::: "memory")
#define PG8_BAR __builtin_amdgcn_s_barrier()
#define PG8_SCHED __builtin_amdgcn_sched_barrier(0)
    Unit cur, nxt; int ui = 0;
    if (!S.next(0, cur)) return;
    f32x4 acc[2][2][4][2];
#pragma unroll
    for (int a = 0; a < 2; ++a)
#pragma unroll
        for (int b = 0; b < 2; ++b)
#pragma unroll
            for (int m = 0; m < 4; ++m)
#pragma unroll
                for (int n = 0; n < 2; ++n) acc[a][b][m][n] = (f32x4){0.f, 0.f, 0.f, 0.f};
    bf16x8 At[4][2], B0[2][2], B1[2][2];
    const char* cA = (const char*)g.A + (Sched::GATHER ? (size_t)0 : (size_t)cur.pm * tstep); const char* cB = (const char*)g.Bt + (size_t)cur.pb * tstep;
    PG8_GOFF(goff, 0);
    if constexpr (SP2) {
        PG8_STAGE(PG8_SB(0, 0), cB, voffB); PG8_STAGE(PG8_SB(0, 1), cB + hstepB, voffB); PG8_STAGE_A(PG8_SA(0, 0), cA, 0, false); PG8_STAGE_A(PG8_SA(0, 1), cA, 1, false);
        if (wr == 1) PG8_BAR;
        PG8_WAIT_V(2); PG8_BAR;
        PG8_STAGE(PG8_SB(1, 0), cB + kstep, voffB); PG8_STAGE_A(PG8_SA(1, 0), cA + kstep, 0, false); PG8_STAGE(PG8_SB(1, 1), cB + hstepB + kstep, voffB);
        PG8_WAIT_V(6); PG8_BAR;
    } else {
        PG8_STAGE(PG8_SB(0, 0), cB, voffB); PG8_STAGE_A(PG8_SA(0, 0), cA, 0, false); PG8_STAGE(PG8_SB(0, 1), cB + hstepB, voffB); PG8_STAGE_A(PG8_SA(0, 1), cA, 1, false);
        if (wr == 1) PG8_BAR;
        PG8_WAIT_V(4); PG8_BAR;
        PG8_STAGE(PG8_SB(1, 0), cB + kstep, voffB); PG8_STAGE_A(PG8_SA(1, 0), cA + kstep, 0, false); PG8_STAGE(PG8_SB(1, 1), cB + hstepB + kstep, voffB);
        PG8_WAIT_V(6); PG8_BAR;
    }
    for (;;) {
        const bool has_next = S.next(ui + 1, nxt);
        const char* nA = (has_next && !Sched::GATHER) ? (const char*)g.A + (size_t)nxt.pm * tstep : cA; const char* nB = has_next ? (const char*)g.Bt + (size_t)nxt.pb * tstep : cB;
        if constexpr (Sched::GATHER) { if (has_next) PG8_GOFF(goffN, ui + 1); else { goffN[0][0] = goff[0][0]; goffN[0][1] = goff[0][1]; goffN[1][0] = goff[1][0]; goffN[1][1] = goff[1][1]; } }
        for (int t = 0; t < nt; t += 2) {
            if constexpr (Epi::HAS_MID) { if (t == nt / 2) E.mid(acc, cur, wr, wc, fr, fq); }
            const bool last = (t == nt - 2);
            const char* a1 = cA + (size_t)(t + 1) * kstep;
            const char* a2 = last ? nA : cA + (size_t)(t + 2) * kstep; const char* b2 = last ? nB : cB + (size_t)(t + 2) * kstep;
            const char* a3 = a2 + kstep; const char* b3 = b2 + kstep;
            if constexpr (SP2) {
            PG8_LDB(B0, 0, 0); PG8_LDB(B1, 0, 1); PG8_SCHED; PG8_LDA(At, 0, 0); PG8_STAGE_A(PG8_SA(1, 1), a1, 1, false);
            PG8_WAIT_V(8); PG8_WAIT_L(0); PG8_BAR; PG8_MMA(0, 0, At, B0); PG8_MMA(0, 1, At, B1); PG8_BAR; PG8_SCHED;
            PG8_LDA(At, 0, 1); PG8_STAGE(PG8_SB(0, 0), b2, voffB); PG8_STAGE(PG8_SB(0, 1), b2 + hstepB, voffB); PG8_STAGE_A(PG8_SA(0, 0), a2, 0, last);
            PG8_WAIT_V(8); PG8_WAIT_L(0); PG8_BAR; PG8_MMA(1, 0, At, B0); PG8_MMA(1, 1, At, B1); PG8_BAR; PG8_SCHED;
            PG8_LDB(B0, 1, 0); PG8_LDB(B1, 1, 1); PG8_SCHED; PG8_LDA(At, 1, 0); PG8_STAGE_A(PG8_SA(0, 1), a2, 1, last);
            PG8_WAIT_V(8); PG8_WAIT_L(0); PG8_BAR; PG8_MMA(0, 0, At, B0); PG8_MMA(0, 1, At, B1); PG8_BAR; PG8_SCHED;
            PG8_LDA(At, 1, 1); PG8_STAGE(PG8_SB(1, 0), b3, voffB); PG8_STAGE(PG8_SB(1, 1), b3 + hstepB, voffB); PG8_STAGE_A(PG8_SA(1, 0), a3, 0, last);
            PG8_WAIT_V(8); PG8_WAIT_L(0); PG8_BAR; PG8_MMA(1, 0, At, B0); PG8_MMA(1, 1, At, B1); PG8_BAR; PG8_SCHED;
            } else {
            PG8_LDB(B0, 0, 0); PG8_SCHED; PG8_LDA(At, 0, 0); PG8_STAGE_A(PG8_SA(1, 1), a1, 1, false);
            PG8_WAIT_L(8); PG8_BAR; PG8_WAIT_L(0); PG8_MMA(0, 0, At, B0); PG8_BAR; PG8_SCHED;
            PG8_LDB(B1, 0, 1); PG8_STAGE(PG8_SB(0, 0), b2, voffB);
            PG8_BAR; PG8_WAIT_L(0); PG8_MMA(0, 1, At, B1); PG8_BAR;
            PG8_LDA(At, 0, 1); PG8_STAGE_A(PG8_SA(0, 0), a2, 0, last);
            PG8_BAR; PG8_WAIT_L(0); PG8_MMA(1, 0, At, B0); PG8_BAR; PG8_SCHED;
            PG8_STAGE(PG8_SB(0, 1), b2 + hstepB, voffB);
            PG8_WAIT_V(6); PG8_BAR; PG8_MMA(1, 1, At, B1); PG8_BAR;
            PG8_LDB(B0, 1, 0); PG8_SCHED; PG8_LDA(At, 1, 0); PG8_STAGE_A(PG8_SA(0, 1), a2, 1, last);
            PG8_WAIT_L(8); PG8_BAR; PG8_WAIT_L(0); PG8_MMA(0, 0, At, B0); PG8_BAR; PG8_SCHED;
            PG8_LDB(B1, 1, 1); PG8_STAGE(PG8_SB(1, 0), b3, voffB);
            PG8_BAR; PG8_WAIT_L(0); PG8_MMA(0, 1, At, B1); PG8_BAR;
            PG8_LDA(At, 1, 1); PG8_STAGE_A(PG8_SA(1, 0), a3, 0, last);
            PG8_BAR; PG8_WAIT_L(0); PG8_MMA(1, 0, At, B0); PG8_BAR; PG8_SCHED;
            PG8_STAGE(PG8_SB(1, 1), b3 + hstepB, voffB);
            PG8_WAIT_V(6); PG8_BAR; PG8_MMA(1, 1, At, B1); PG8_BAR;
            }
        }
        if constexpr (ALIGN_EPI) { if (wr == 0) PG8_BAR; }
        E(acc, cur, wr, wc, fr, fq);
        if (!has_next) break;
#pragma unroll
        for (int a = 0; a < 2; ++a)
#pragma unroll
            for (int b = 0; b < 2; ++b)
#pragma unroll
                for (int m = 0; m < 4; ++m)
#pragma unroll
                    for (int n = 0; n < 2; ++n) acc[a][b][m][n] = (f32x4){0.f, 0.f, 0.f, 0.f};
        cur = nxt; cA = nA; cB = nB; ++ui;
        if constexpr (Sched::GATHER) { goff[0][0] = goffN[0][0]; goff[0][1] = goffN[0][1]; goff[1][0] = goffN[1][0]; goff[1][1] = goffN[1][1]; }
        if constexpr (ALIGN_EPI) { if (wr == 1) PG8_BAR; }
    }
    PG8_WAIT_V(0);
    if constexpr (!ALIGN_EPI) { if (wr == 0) PG8_BAR; }
    PG8_BAR;
#undef PG8_SA
#undef PG8_GOFF
#undef PG8_STAGE_A
#undef PG8_SB
#undef PG8_STAGE
#undef PG8_LDA
#undef PG8_LDB
#undef PG8_MMA
#undef PG8_WAIT_V
#undef PG8_WAIT_L
#undef PG8_BAR
#undef PG8_SCHED
}
}
#define XB_TMO      128
#define XB_XCNT(j)  (256  + 64 * (j))
#define XB_XSUB(j)  (1280 + 64 * (j))
#define XB_XGEN(j)  (2304 + 64 * (j))
#define XB_TOP      3328
#define XB_TOPGEN   3392
#define XCD_BAR_WORDS 3456
#define XB_SPIN_CAP (1u << 18)

__device__ __forceinline__ unsigned xb_ld(unsigned* p)              { return __hip_atomic_load(p, __ATOMIC_RELAXED, __HIP_MEMORY_SCOPE_AGENT); }
__device__ __forceinline__ unsigned xb_add(unsigned* p, unsigned v) { return __hip_atomic_fetch_add(p, v, __ATOMIC_RELAXED, __HIP_MEMORY_SCOPE_AGENT); }
__device__ __forceinline__ unsigned xb_xcc_id() { return (unsigned)__builtin_amdgcn_s_getreg((3 << 11) | 20) & 0xFu; }
#define XB_SPIN(cond, bar) do { unsigned _sp = 0; while (cond) { __builtin_amdgcn_s_sleep(1); \
    if ((++_sp & 255u) == 0u) { if (xb_ld(&(bar)[XB_TMO])) break; if (_sp > XB_SPIN_CAP) { atomicAdd(&(bar)[XB_TMO], 1u); break; } } } } while (0)

struct XcdBarrier {
    unsigned* bar; unsigned x;
    volatile LAS unsigned* st;
};

__device__ __forceinline__ XcdBarrier xcd_barrier_post(unsigned* bar, volatile LAS unsigned* st) {
    XcdBarrier b; b.bar = bar; b.x = xb_xcc_id(); b.st = st;
    if (threadIdx.x == 0) (void)xb_add(&bar[XB_XCNT(b.x)], 1u);
    return b;
}
__device__ __forceinline__ void xcd_barrier_complete(unsigned* bar, unsigned x, unsigned& nloc, unsigned& nx) {
    const unsigned G = gridDim.x * gridDim.y * gridDim.z;
    unsigned sum, cnt, mine, sp = 0u;
    for (;;) {
        sum = 0u; cnt = 0u; mine = 0u;
#pragma unroll
        for (unsigned j = 0; j < 16; ++j) { const unsigned c = xb_ld(&bar[XB_XCNT(j)]); sum += c; cnt += (c > 0u) ? 1u : 0u; mine = (j == x) ? c : mine; }
        if (sum == G) break;
        __builtin_amdgcn_s_sleep(1);
        if ((++sp & 255u) == 0u) { if (xb_ld(&bar[XB_TMO])) break; if (sp > XB_SPIN_CAP) { atomicAdd(&bar[XB_TMO], 1u); break; } }
    }
    nloc = mine > 0u ? mine : 1u; nx = cnt > 0u ? cnt : 1u;
}

__device__ __forceinline__ void xcd_barrier(const XcdBarrier& b) {
    asm volatile("s_waitcnt vmcnt(0)" ::: "memory");
    __syncthreads();
    if (threadIdx.x == 0) {
        unsigned* bar = b.bar;
        __builtin_amdgcn_s_waitcnt(0);
        unsigned nloc = b.st[0], nx = b.st[1];
        if (nloc == 0u) { xcd_barrier_complete(bar, b.x, nloc, nx); b.st[0] = nloc; b.st[1] = nx; }
        const unsigned old = xb_add(&bar[XB_XSUB(b.x)], 1u);
        const unsigned gen = old / nloc;
        if (old + 1u == (gen + 1u) * nloc) {
            __builtin_amdgcn_fence(__ATOMIC_RELEASE, "agent");
            asm volatile("s_waitcnt vmcnt(0)" ::: "memory");
            const unsigned og = xb_add(&bar[XB_TOP], 1u);
            const unsigned tg = og / nx;
            if (og + 1u == (tg + 1u) * nx) xb_add(&bar[XB_TOPGEN], 1u);
            else XB_SPIN(xb_ld(&bar[XB_TOPGEN]) == tg, bar);
            __builtin_amdgcn_fence(__ATOMIC_ACQUIRE, "agent");
            xb_add(&bar[XB_XGEN(b.x)], 1u);
            asm volatile("s_waitcnt vmcnt(0)" ::: "memory");
        } else {
            XB_SPIN(xb_ld(&bar[XB_XGEN(b.x)]) == gen, bar);
            __builtin_amdgcn_fence(__ATOMIC_ACQUIRE, "agent");
            asm volatile("s_waitcnt vmcnt(0)" ::: "memory");
        }
    }
    __syncthreads();
}
constexpr int NB = 4, SEQ = 8192, DM = 1024, T = NB * SEQ;
constexpr int NH = 8, HD = 64, CW = 512;
constexpr int N_IN = 5120;
constexpr int NLAYER = 2;
constexpr int NEXP = 32, DEXP = 512;
constexpr int MOE_ROWS = 73728, MOE_PANELS = MOE_ROWS / 256;
constexpr int WCAT_ROWS = 5888;
constexpr int LO_W = 768;

constexpr size_t MiB = 1u << 20;
constexpr size_t WS_CTL = 0, CTL_ZERO_BYTES = 1 * MiB;
constexpr size_t WS_VF   = 1 * MiB;
constexpr size_t WS_TAB  = 33 * MiB;
constexpr size_t WS_WM   = 34 * MiB;
constexpr size_t WS_XN   = 50 * MiB;
constexpr size_t WS_RW   = 114 * MiB;
constexpr size_t WS_MO   = 178 * MiB;
constexpr size_t WS_LO   = 210 * MiB;
constexpr size_t WS_YRM  = 114 * MiB;
constexpr int YRM_LD = 1024;
constexpr size_t WS_SIR  = 258 * MiB;
constexpr size_t WS_SIK  = 322 * MiB;
constexpr size_t WS_SCRW = 290 * MiB, WS_SCRA = 306 * MiB, WS_SCRB = 546 * MiB;
constexpr size_t WS_V1   = 418 * MiB;
constexpr size_t WS_G    = 450 * MiB;
constexpr size_t WS_YS   = 482 * MiB;
constexpr size_t WS_PO   = 418 * MiB;
constexpr size_t WS_PST  = 274 * MiB;
constexpr size_t WS_GA   = 418 * MiB;
constexpr size_t WS_H    = 290 * MiB;
constexpr size_t WS_SC1  = 482 * MiB;
constexpr size_t WS_SC2  = 354 * MiB;
constexpr size_t WS_SCT  = 290 * MiB;
constexpr size_t WS_WE   = 34 * MiB;
constexpr size_t WS_WD   = 98 * MiB;
constexpr size_t WS_AM   = 130 * MiB;
constexpr size_t WS_HM   = 274 * MiB;
constexpr size_t WS_YE   = 346 * MiB;
constexpr size_t WS_RT   = 490 * MiB;
constexpr size_t WS_END  = 556 * MiB;
constexpr size_t TB_KMEAN = 0;
constexpr size_t TB_KMEAN2 = 256 * 1024;
constexpr size_t TB_SEL   = 256 * 1024;
constexpr size_t RT_EID  = 0;
constexpr size_t RT_GATE = 256 * 1024;
constexpr size_t RT_ROW  = 512 * 1024;
constexpr size_t RT_GW   = 768 * 1024;
constexpr size_t RT_HIST = 1280 * 1024;
constexpr size_t RT_PEXP = 1408 * 1024;
constexpr size_t RT_TOK  = 1536 * 1024;
constexpr size_t RT_RSQ  = 2048 * 1024;
constexpr size_t RT_RSR  = 2304 * 1024;
constexpr size_t WS_SEL  = 562 * MiB;
constexpr size_t WS_NEED = 564 * MiB;
constexpr int CW_BAR = 4096;

constexpr int RING_BYTES = 131072;
constexpr int LDS_BYTES = 163840;
constexpr int MISC_OFF = LDS_BYTES - 256;
struct Frame {
    LAS unsigned char* lds;
    int tid, lane, wave;
    int G, bid;
    const __attribute__((address_space(4))) unsigned char* ka;
    GAS float* out_g; GAS unsigned char* ws_g;
    DI float* outp() const { return (float*)out_g; }
    DI unsigned char* wsp() const { return (unsigned char*)ws_g; }
    DI const float* inp(int i) const { return (const float*)(*(const GAS float* const __attribute__((address_space(4)))*)(ka + 8 * i)); }
};
#define LDS_WAIT() asm volatile("s_waitcnt lgkmcnt(0)" ::: "memory")

DI void tr_item(const float* src, int ld, int k0, bf16_t* dst, int Kd, const float* sc, int mode, LAS float* scr, int lane) {
#pragma unroll 8
    for (int i = 0; i < 32; ++i) { const int kk = 2 * i + (lane >> 5);
        float v = src ? src[(size_t)(k0 + kk) * ld + (lane & 31)] : 0.f;
        if (mode == 1) v *= sc[k0 + kk]; else if (mode == 2) v *= (1.f - sc[k0 + kk]);
        scr[kk * 33 + (lane & 31)] = v; }
    LDS_WAIT(); asm volatile("" ::: "memory");
    const int c = lane & 7;
#pragma unroll
    for (int j = 0; j < 4; ++j) { const int n = (lane >> 3) + 8 * j; const LAS float* s = scr + (8 * c) * 33 + n;
        u32x4 o; o.x = pk2(s[0 * 33], s[1 * 33]); o.y = pk2(s[2 * 33], s[3 * 33]); o.z = pk2(s[4 * 33], s[5 * 33]); o.w = pk2(s[6 * 33], s[7 * 33]);
        *(u32x4*)(dst + (size_t)n * Kd + k0 + 8 * c) = o; }
    LDS_WAIT(); asm volatile("" ::: "memory");
}

constexpr size_t WM_WCAT = 0, WM_BRR = (size_t)WCAT_ROWS * 1024 * 2, WM_BRM = WM_BRR + 1024 * 512 * 2, WM_OUT = WM_BRM + 1024 * 512 * 2;
DI void phase_conv_mixer(Frame& F, int l) {
    LAS float* scr = (LAS float*)(F.lds + F.wave * 16384);
    const int gw = F.bid * 8 + F.wave, NGW = F.G * 8;
    bf16_t* wcat = (bf16_t*)(F.wsp() + WS_WM + WM_WCAT);
    const float* w_in = F.inp(3) + (size_t)l * DM * N_IN;
    const float* mu_x = F.inp(5) + (size_t)l * 3 * DM;
    constexpr int NBLK = WCAT_ROWS / 32;
    constexpr int I_CAT = NBLK * 16, I_BR = 8 * 32, I_OUT = 16 * 32;
    for (int it = gw; it < I_CAT + 2 * I_BR + I_OUT; it += NGW) {
        int r = it;
        if (r < I_CAT) {
            const int nb = r / 16, kb = r % 16, k0 = kb * 64;
            if (nb < 48) { tr_item(w_in + 32 * nb, N_IN, k0, wcat + (size_t)(32 * nb) * 1024, 1024, nullptr, 0, scr, F.lane); }
            else if (nb < 72) {
                const int q = nb - 48; const float* src = nullptr; int ld = 0; const float* sc = nullptr; int mode = 0;
                if (q < 4)       { src = F.inp(7)  + (size_t)l * DM * 64  + 32 * (q & 1); ld = 64;  sc = mu_x;          mode = (q < 2) ? 2 : 1; }
                else if (q < 8)  { src = F.inp(10) + (size_t)l * DM * 64  + 32 * (q & 1); ld = 64;  sc = mu_x + DM;     mode = (q < 6) ? 2 : 1; }
                else if (q < 16) { src = F.inp(12) + (size_t)l * DM * 128 + 32 * (q & 3); ld = 128; sc = mu_x + 2 * DM; mode = (q < 12) ? 2 : 1; }
                else if (q < 18 && l > 0) { src = F.inp(21) + (size_t)(l - 1) * DM * 32; ld = 32; sc = F.inp(19) + (size_t)(l - 1) * DM; mode = (q == 16) ? 2 : 1; }
                tr_item(src, ld, k0, wcat + (size_t)(1536 + 32 * q) * 1024, 1024, sc, mode, scr, F.lane);
            }
            else if (nb < 120) { tr_item(w_in + 1536 + 32 * (nb - 72), N_IN, k0, wcat + (size_t)(2304 + 32 * (nb - 72)) * 1024, 1024, nullptr, 0, scr, F.lane); }
            else { tr_item(w_in + 3072 + 32 * (nb - 120), N_IN, k0, wcat + (size_t)(3840 + 32 * (nb - 120)) * 1024, 1024, nullptr, 0, scr, F.lane); }
            continue;
        }
        r -= I_CAT;
        if (r < I_BR) { const int nb = r / 8, kb = r % 8; tr_item(F.inp(26) + (size_t)l * 512 * 1024 + 32 * nb, 1024, kb * 64, (bf16_t*)(F.wsp() + WS_WM + WM_BRR) + (size_t)(32 * nb) * 1024, 1024, nullptr, 0, scr, F.lane); continue; }
        r -= I_BR;
        if (r < I_BR) { const int nb = r / 8, kb = r % 8; tr_item(F.inp(27) + (size_t)l * 512 * 1024 + 32 * nb, 1024, kb * 64, (bf16_t*)(F.wsp() + WS_WM + WM_BRR) + (size_t)(32 * nb) * 1024 + 512, 1024, nullptr, 0, scr, F.lane); continue; }
        r -= I_BR;
        { const int nb = r / 16, kb = r % 16; tr_item(F.inp(28) + (size_t)l * 1024 * 1024 + 32 * nb, 1024, kb * 64, (bf16_t*)(F.wsp() + WS_WM + WM_OUT) + (size_t)(32 * nb) * 1024, 1024, nullptr, 0, scr, F.lane); }
    }
}
DI void tr_block(const float* src, int ld, int k0, int n0, bf16_t* dstbase, int Kd, int mode, LAS float* scr, int tid) {
#pragma unroll
    for (int i = 0; i < 8; ++i) { const int idx = tid + 512 * i, row = idx >> 6, c4 = idx & 63;
        const f32x4 v = *(const f32x4*)(src + (size_t)(k0 + row) * ld + n0 + 4 * c4);
        LAS float* d = scr + row * 257 + 4 * c4; d[0] = v.x; d[1] = v.y; d[2] = v.z; d[3] = v.w; }
    __syncthreads();
#pragma unroll
    for (int i = 0; i < 4; ++i) { const int idx = tid + 512 * i, n = idx >> 3, c = idx & 7; const LAS float* sp = scr + (8 * c) * 257 + n;
        u32x4 o; o.x = pk2(sp[0], sp[257]); o.y = pk2(sp[2 * 257], sp[3 * 257]); o.z = pk2(sp[4 * 257], sp[5 * 257]); o.w = pk2(sp[6 * 257], sp[7 * 257]);
        const int h = n0 + n; const int drow = (mode == 2) ? h : ((h >> 7) * 256 + mode * 128 + (h & 127));
        *(u32x4*)(dstbase + (size_t)drow * Kd + k0 + 8 * c) = o; }
    __syncthreads();
}
DI void phase_conv_experts(Frame& F, int l) {
    LAS float* scr = (LAS float*)F.lds;
    bf16_t* we = (bf16_t*)(F.wsp() + WS_WE); bf16_t* wd = (bf16_t*)(F.wsp() + WS_WD);
    const float* wg = F.inp(33) + (size_t)l * NEXP * DM * DEXP; const float* wu = F.inp(34) + (size_t)l * NEXP * DM * DEXP; const float* wdn = F.inp(35) + (size_t)l * NEXP * DEXP * DM;
    __syncthreads();
    for (int it = F.bid; it < NEXP * 96; it += F.G) {
        const int e = it / 96; int r = it % 96;
        if (r < 64) { const int up = r >> 5; r &= 31; const int kb = r >> 1, nb = r & 1;
            tr_block((up ? wu : wg) + (size_t)e * DM * DEXP, DEXP, kb * 64, nb * 256, we + (size_t)e * 1024 * 1024, 1024, up, scr, F.tid); }
        else { r -= 64; const int kb = r >> 2, nb = r & 3;
            tr_block(wdn + (size_t)e * DEXP * DM, DM, kb * 64, nb * 256, wd + (size_t)e * 1024 * 512, 512, 2, scr, F.tid); }
    }
}
DI void rms_row_to_bf16(const float* xrow, const float* gain, bf16_t* o0, bf16_t* o1, int lane) {
    const f32x4* xr = (const f32x4*)xrow + lane; const f32x4* gr = (const f32x4*)gain + lane;
    f32x4 v[4]; float s = 0.f;
#pragma unroll
    for (int j = 0; j < 4; ++j) { v[j] = xr[64 * j]; s += (v[j].x * v[j].x + v[j].y * v[j].y) + (v[j].z * v[j].z + v[j].w * v[j].w); }
    const float rs = 1.0f / sqrtf(wave_sum(s) * (1.f / DM) + 1e-6f);
#pragma unroll
    for (int j = 0; j < 4; ++j) { const f32x4 g = gr[64 * j]; const f32x4 y = v[j] * rs * g;
        u32x2 w; w.x = pk2(y.x, y.y); w.y = pk2(y.z, y.w);
        *((u32x2*)o0 + lane + 64 * j) = w; if (o1) *((u32x2*)o1 + lane + 64 * j) = w; }
}
DI void phase_norm_x(Frame& F, const float* x, const float* gain) {
    const int gw = F.bid * 8 + F.wave, NGW = F.G * 8; bf16_t* xn = (bf16_t*)(F.wsp() + WS_XN);
    for (int m = gw; m < T; m += NGW) rms_row_to_bf16(x + (size_t)m * DM, gain, xn + (size_t)m * DM, nullptr, F.lane);
}

namespace pg8 {
struct EpiStore {
    static constexpr bool PERM = true, HAS_MID = false, HEADS = false;
    bf16_t* O; int ldc; int split; bf16_t* O2; int ldc2; int act;
    __device__ __forceinline__ void operator()(const f32x4 (&acc)[2][2][4][2], const Unit& u, int wr, int wc, int fr, int fq) const {
        const int row0 = u.pm * BM + wr * 64 + fr; int colt = u.pn * BM; bf16_t* base = O; int ld = ldc;
        if (split && colt >= split) { base = O2; ld = ldc2; colt -= split; }
        const int col0 = colt + wc * 32 + 8 * fq;
#pragma unroll
        for (int ai = 0; ai < 2; ++ai)
#pragma unroll
            for (int m = 0; m < 4; ++m) { bf16_t* rowp = base + (size_t)(row0 + ai * HALF + m * 16) * ld + col0;
#pragma unroll
                for (int bj = 0; bj < 2; ++bj) { f32x4 v0 = acc[ai][bj][m][0], v1 = acc[ai][bj][m][1];
                    if (act == 1) {
#pragma unroll
                        for (int j = 0; j < 4; ++j) { v0[j] = sigmoidf_(v0[j]); v1[j] = sigmoidf_(v1[j]); } }
                    u32x4 w; w.x = pk2(v0[0], v0[1]); w.y = pk2(v0[2], v0[3]); w.z = pk2(v1[0], v1[1]); w.w = pk2(v1[2], v1[3]);
                    *(u32x4*)(rowp + bj * HALF) = w; } }
    }
};
struct EpiBranch {
    static constexpr bool PERM = true, HAS_MID = false, HEADS = false;
    bf16_t* Hout; const bf16_t* gate; int gcol0; int first;
    __device__ __forceinline__ void operator()(const f32x4 (&acc)[2][2][4][2], const Unit& u, int wr, int wc, int fr, int fq) const {
        const int row0 = u.pm * BM + wr * 64 + fr; const int col0 = u.pn * BM + wc * 32 + 8 * fq;
#pragma unroll
        for (int ai = 0; ai < 2; ++ai)
#pragma unroll
            for (int m = 0; m < 4; ++m) { const size_t row = (size_t)(row0 + ai * HALF + m * 16);
#pragma unroll
                for (int bj = 0; bj < 2; ++bj) {
                    const u32x4 gv = *(const u32x4*)(gate + row * 2048 + gcol0 + col0 + bj * HALF);
                    bf16_t* hp = Hout + row * 1024 + col0 + bj * HALF;
                    f32x4 v0 = acc[ai][bj][m][0], v1 = acc[ai][bj][m][1];
                    v0[0] *= bflo(gv.x); v0[1] *= bfhi(gv.x); v0[2] *= bflo(gv.y); v0[3] *= bfhi(gv.y);
                    v1[0] *= bflo(gv.z); v1[1] *= bfhi(gv.z); v1[2] *= bflo(gv.w); v1[3] *= bfhi(gv.w);
                    if (!first) { const u32x4 hv = *(const u32x4*)hp;
                        v0[0] += bflo(hv.x); v0[1] += bfhi(hv.x); v0[2] += bflo(hv.y); v0[3] += bfhi(hv.y);
                        v1[0] += bflo(hv.z); v1[1] += bfhi(hv.z); v1[2] += bflo(hv.w); v1[3] += bfhi(hv.w); }
                    u32x4 w; w.x = pk2(v0[0], v0[1]); w.y = pk2(v0[2], v0[3]); w.z = pk2(v1[0], v1[1]); w.w = pk2(v1[2], v1[3]);
                    *(u32x4*)hp = w; } }
    }
};
struct EpiBranch2 {
    static constexpr bool PERM = true, HAS_MID = true, HEADS = false;
    bf16_t* Hout; const bf16_t* gate;
    __device__ __forceinline__ void mid(f32x4 (&acc)[2][2][4][2], const Unit& u, int wr, int wc, int fr_, int fq_) const {
        int fr = fr_, fq = fq_; asm volatile("" : "+v"(fr), "+v"(fq));
        const int row0 = u.pm * BM + wr * 64 + fr; const int col0 = u.pn * BM + wc * 32 + 8 * fq;
#pragma unroll
        for (int ai = 0; ai < 2; ++ai)
#pragma unroll
            for (int m = 0; m < 4; ++m) { const size_t row = (size_t)(row0 + ai * HALF + m * 16);
#pragma unroll
                for (int bj = 0; bj < 2; ++bj) {
                    const u32x4 gr = *(const u32x4*)(gate + row * 2048 + col0 + bj * HALF), gm = *(const u32x4*)(gate + row * 2048 + 1024 + col0 + bj * HALF);
                    const unsigned grw[4] = {gr.x, gr.y, gr.z, gr.w}, gmw[4] = {gm.x, gm.y, gm.z, gm.w};
#pragma unroll
                    for (int q = 0; q < 4; ++q) { const float r0 = bflo(grw[q]) * __builtin_amdgcn_rcpf(fmaxf(bflo(gmw[q]), 1e-30f)), r1 = bfhi(grw[q]) * __builtin_amdgcn_rcpf(fmaxf(bfhi(gmw[q]), 1e-30f));
                        acc[ai][bj][m][q >> 1][2 * (q & 1)] *= r0; acc[ai][bj][m][q >> 1][2 * (q & 1) + 1] *= r1; } }
                asm volatile("" ::: "memory"); }
    }
    __device__ __forceinline__ void operator()(const f32x4 (&acc)[2][2][4][2], const Unit& u, int wr, int wc, int fr, int fq) const {
        const int row0 = u.pm * BM + wr * 64 + fr; const int col0 = u.pn * BM + wc * 32 + 8 * fq;
#pragma unroll
        for (int ai = 0; ai < 2; ++ai)
#pragma unroll
            for (int m = 0; m < 4; ++m) { const size_t row = (size_t)(row0 + ai * HALF + m * 16);
#pragma unroll
                for (int bj = 0; bj < 2; ++bj) {
                    const u32x4 gm = *(const u32x4*)(gate + row * 2048 + 1024 + col0 + bj * HALF);
                    f32x4 v0 = acc[ai][bj][m][0], v1 = acc[ai][bj][m][1];
                    v0[0] *= fmaxf(bflo(gm.x), 1e-30f); v0[1] *= fmaxf(bfhi(gm.x), 1e-30f); v0[2] *= fmaxf(bflo(gm.y), 1e-30f); v0[3] *= fmaxf(bfhi(gm.y), 1e-30f);
                    v1[0] *= fmaxf(bflo(gm.z), 1e-30f); v1[1] *= fmaxf(bfhi(gm.z), 1e-30f); v1[2] *= fmaxf(bflo(gm.w), 1e-30f); v1[3] *= fmaxf(bfhi(gm.w), 1e-30f);
                    u32x4 w; w.x = pk2(v0[0], v0[1]); w.y = pk2(v0[2], v0[3]); w.z = pk2(v1[0], v1[1]); w.w = pk2(v1[2], v1[3]);
                    *(u32x4*)(Hout + row * 1024 + col0 + bj * HALF) = w; } }
    }
};
struct EpiMoba {
    static constexpr bool PERM = true, HAS_MID = false, HEADS = true;
    bf16_t* MO; const float* qgain; const float* kgain; float* KM; int km_half;
    __device__ __forceinline__ void operator()(const f32x4 (&acc)[2][2][4][2], const Unit& u, int wr, int wc, int fr, int fq) const {
        const int row0 = u.pm * BM + wr * 64 + fr; const int kind = u.pn >> 1; const int colb = u.pn * BM + 64 * wc + 8 * fq;
        if (kind == 2) {
#pragma unroll
            for (int ai = 0; ai < 2; ++ai)
#pragma unroll
                for (int m = 0; m < 4; ++m) { bf16_t* rowp = MO + (size_t)(row0 + ai * HALF + m * 16) * 1536 + colb;
#pragma unroll
                    for (int bj = 0; bj < 2; ++bj) { const f32x4 v0 = acc[ai][bj][m][0], v1 = acc[ai][bj][m][1];
                        u32x4 w; w.x = pk2(v0[0], v0[1]); w.y = pk2(v0[2], v0[3]); w.z = pk2(v1[0], v1[1]); w.w = pk2(v1[2], v1[3]); *(u32x4*)(rowp + 32 * bj) = w; } }
            return;
        }
        const float* gp = (kind == 0 ? qgain : kgain) + 8 * fq; const float gs = (kind == 0) ? 0.125f : 1.0f;
        f32x4 gn[2][2];
#pragma unroll
        for (int bj = 0; bj < 2; ++bj)
#pragma unroll
            for (int n = 0; n < 2; ++n) gn[bj][n] = *(const f32x4*)(gp + 32 * bj + 4 * n) * gs;
        f32x4 cs[2][2];
#pragma unroll
        for (int bj = 0; bj < 2; ++bj)
#pragma unroll
            for (int n = 0; n < 2; ++n) cs[bj][n] = (f32x4){0.f, 0.f, 0.f, 0.f};
#pragma unroll
        for (int ai = 0; ai < 2; ++ai)
#pragma unroll
            for (int m = 0; m < 4; ++m) { float ss = 0.f;
#pragma unroll
                for (int bj = 0; bj < 2; ++bj)
#pragma unroll
                    for (int n = 0; n < 2; ++n) { const f32x4 x = acc[ai][bj][m][n]; ss += (x[0] * x[0] + x[1] * x[1]) + (x[2] * x[2] + x[3] * x[3]); }
                ss += __shfl_xor(ss, 16); ss += __shfl_xor(ss, 32);
                const float rs = __builtin_amdgcn_rsqf(ss * (1.f / 64.f) + 1e-6f);
                bf16_t* rowp = MO + (size_t)(row0 + ai * HALF + m * 16) * 1536 + colb;
#pragma unroll
                for (int bj = 0; bj < 2; ++bj) { const f32x4 v0 = acc[ai][bj][m][0] * rs * gn[bj][0], v1 = acc[ai][bj][m][1] * rs * gn[bj][1];
                    cs[bj][0] += v0; cs[bj][1] += v1;
                    u32x4 w; w.x = pk2(v0[0], v0[1]); w.y = pk2(v0[2], v0[3]); w.z = pk2(v1[0], v1[1]); w.w = pk2(v1[2], v1[3]); *(u32x4*)(rowp + 32 * bj) = w; }
                asm volatile("" : "+v"(cs[0][0]), "+v"(cs[0][1]), "+v"(cs[1][0]), "+v"(cs[1][1]));
            }
        if (kind == 1) {
#pragma unroll
            for (int bj = 0; bj < 2; ++bj)
#pragma unroll
                for (int n = 0; n < 2; ++n) { f32x4 t = cs[bj][n];
#pragma unroll
                    for (int j = 0; j < 4; ++j) { float v = t[j]; v += dpp_mov<0xB1>(v); v += dpp_mov<0x4E>(v); v += dpp_mov<0x141>(v); v += dpp_mov<0x140>(v); t[j] = v * (1.f / 256.f); }
                    if (fr == 0) *(f32x4*)(KM + (size_t)wr * km_half + (size_t)u.pm * 512 + (u.pn * BM - 512) + 64 * wc + 32 * bj + 8 * fq + 4 * n) = t; }
        }
    }
};
struct EpiResid {
    static constexpr bool PERM = false, HAS_MID = false, HEADS = false;
    const float* xin; float* out;
    __device__ __forceinline__ void operator()(const f32x4 (&acc)[2][2][4][2], const Unit& u, int wr, int wc, int fr, int fq) const {
        const int row0 = u.pm * BM + wr * 64 + fr, col0 = u.pn * BM + wc * 32 + 4 * fq;
#pragma unroll
        for (int ai = 0; ai < 2; ++ai)
#pragma unroll
            for (int m = 0; m < 4; ++m) { const size_t off = (size_t)(row0 + ai * HALF + m * 16) * 1024 + col0;
#pragma unroll
                for (int bj = 0; bj < 2; ++bj)
#pragma unroll
                    for (int n = 0; n < 2; ++n) { const f32x4 xv = *(const f32x4*)(xin + off + bj * HALF + n * 16); *(f32x4*)(out + off + bj * HALF + n * 16) = xv + acc[ai][bj][m][n]; } }
    }
};
struct EpiExpertUp {
    static constexpr bool PERM = true, HAS_MID = false, HEADS = false;
    bf16_t* HM; const float* gw; const float* rsr;
    __device__ __forceinline__ void operator()(const f32x4 (&acc)[2][2][4][2], const Unit& u, int wr, int wc, int fr, int fq) const {
        const int row0 = u.pm * BM + wr * 64 + fr; const int col0 = u.pn * 128 + wc * 32 + 8 * fq;
#pragma unroll
        for (int ai = 0; ai < 2; ++ai)
#pragma unroll
            for (int m = 0; m < 4; ++m) { const size_t row = (size_t)(row0 + ai * HALF + m * 16); const float rs = rsr[row]; const float gwt = gw[row] * rs;
                f32x4 v0, v1;
#pragma unroll
                for (int j = 0; j < 4; ++j) { const float g0 = acc[ai][0][m][0][j] * rs, g1 = acc[ai][0][m][1][j] * rs;
                    v0[j] = g0 * sigmoidf_(g0) * acc[ai][1][m][0][j] * gwt; v1[j] = g1 * sigmoidf_(g1) * acc[ai][1][m][1][j] * gwt; }
                u32x4 w; w.x = pk2(v0[0], v0[1]); w.y = pk2(v0[2], v0[3]); w.z = pk2(v1[0], v1[1]); w.w = pk2(v1[2], v1[3]);
                *(u32x4*)(HM + row * 512 + col0) = w; }
    }
};
}
constexpr size_t SI_PLANE = (size_t)T * CW * 2;
DI float softplusf_(float z) { return fmaxf(z, 0.f) + __logf(1.0f + __expf(-fabsf(z))); }

#ifndef PREP_DUP
#define PREP_DUP 0
#endif
constexpr int ACT_P = 592;
constexpr size_t WM_L2T = (size_t)WCAT_ROWS * 1024 * 2 + 2 * 1024 * 512 * 2 + 1024 * 1024 * 2;
DI void phase_conv_lora2(Frame& F, int l) {
    bf16_t* L2T = (bf16_t*)(F.wsp() + WS_WM + WM_L2T);
    const float* w2 = F.inp(8) + (size_t)l * 64 * CW; const float* a2 = F.inp(11) + (size_t)l * 64 * CW; const float* g2 = F.inp(13) + (size_t)l * 128 * CW; const float* v2 = F.inp(22);
    for (int idx = F.bid * 512 + F.tid; idx < 288 * CW; idx += F.G * 512) { const int j = idx >> 9, c = idx & 511;
        float v;
        if (j < 64) v = w2[j * CW + c]; else if (j < 128) v = a2[(j - 64) * CW + c]; else if (j < 256) v = g2[(j - 128) * CW + c]; else v = (l > 0) ? v2[(j - 256) * CW + c] : 0.f;
        L2T[c * 288 + j] = f2bf(v); }
}
DI float row16_sum(float v) { v += dpp_mov<0xB1>(v); v += dpp_mov<0x4E>(v); v += dpp_mov<0x141>(v); v += dpp_mov<0x140>(v); return v; }
DI void phase_rwkv_prep2(Frame& F, int l, int tile_lo, int tile_hi, int tile_step, bool init) {
    LAS unsigned char* act = F.lds;
    LAS float* PRM = (LAS float*)(F.lds + 139264);
    const bf16_t* RW = (const bf16_t*)(F.wsp() + WS_RW); const bf16_t* LO = (const bf16_t*)(F.wsp() + WS_LO); const unsigned char* L2T = F.wsp() + WS_WM + WM_L2T;
    bf16_t* SIr = (bf16_t*)(F.wsp() + WS_SIR); bf16_t* SIk = (bf16_t*)(F.wsp() + WS_SIK);
    bf16_t* SCw = (bf16_t*)(F.wsp() + WS_SCRW) + (size_t)F.bid * 64 * CW; bf16_t* SCa = (bf16_t*)(F.wsp() + WS_SCRA) + (size_t)F.bid * 64 * CW; bf16_t* SCb = (bf16_t*)(F.wsp() + WS_SCRB) + (size_t)F.bid * 64 * CW;
    bf16_t* VF = (bf16_t*)(F.wsp() + WS_VF); bf16_t* V1 = (bf16_t*)(F.wsp() + WS_V1); bf16_t* Gb = (bf16_t*)(F.wsp() + WS_G);
    const int lane = F.lane, r16 = lane & 15, g = lane >> 4;
    if (init) { __syncthreads();
      const int c = F.tid;
      PRM[c] = F.inp(4)[(size_t)l * 3 * CW + c]; PRM[512 + c] = F.inp(4)[(size_t)l * 3 * CW + CW + c]; PRM[1024 + c] = F.inp(4)[(size_t)l * 3 * CW + 2 * CW + c];
      PRM[1536 + c] = F.inp(6)[l * CW + c]; PRM[2048 + c] = F.inp(9)[l * CW + c]; PRM[2560 + c] = F.inp(14)[l * CW + c]; PRM[3072 + c] = F.inp(15)[l * CW + c]; PRM[3584 + c] = l > 0 ? F.inp(20)[c] : 0.f; }
    for (int tile = tile_lo; tile < tile_hi; tile += tile_step) {
        int t0 = tile * 64; asm volatile("" : "+s"(t0));
        __syncthreads();
        for (int dup1_ = 0; dup1_ < ((PREP_DUP & 1) ? 2 : 1); ++dup1_)
        for (int grp = F.tid; grp < 64 * 36; grp += 512) { const int tt = grp / 36, jg = grp - tt * 36, j0 = 8 * jg; const int t = t0 + tt; const bool has_prev = (t % SEQ) != 0;
            int pj, qj; if (j0 < 64) { pj = j0; qj = 64 + j0; } else if (j0 < 128) { pj = 128 + (j0 - 64); qj = 192 + (j0 - 64); } else if (j0 < 256) { pj = 256 + (j0 - 128); qj = 384 + (j0 - 128); } else { pj = 512 + (j0 - 256); qj = 544 + (j0 - 256); }
            const u32x4 pv = *(const u32x4*)(LO + (size_t)t * LO_W + pj); u32x4 qv = {0u, 0u, 0u, 0u}; if (has_prev) qv = *(const u32x4*)(LO + (size_t)(t - 1) * LO_W + qj);
            const unsigned pw[4] = {pv.x, pv.y, pv.z, pv.w}, qw[4] = {qv.x, qv.y, qv.z, qv.w}; float v[8];
#pragma unroll
            for (int q = 0; q < 4; ++q) { v[2 * q] = bflo(pw[q]) + bflo(qw[q]); v[2 * q + 1] = bfhi(pw[q]) + bfhi(qw[q]); }
            if (j0 < 64) {
#pragma unroll
                for (int e = 0; e < 8; ++e) v[e] = 1.0f - 2.0f * __builtin_amdgcn_rcpf(1.0f + __expf(2.0f * v[e]));
            } else if (j0 >= 128 && j0 < 256) {
#pragma unroll
                for (int e = 0; e < 8; ++e) v[e] = sigmoidf_(v[e]);
            }
            u32x4 w; w.x = pk2(v[0], v[1]); w.y = pk2(v[2], v[3]); w.z = pk2(v[4], v[5]); w.w = pk2(v[6], v[7]);
            *(LAS u32x4*)(act + tt * ACT_P + j0 * 2) = w; }
        __syncthreads();
        float inv[4];
        for (int pd_ = 0; pd_ < ((PREP_DUP & 4) ? 2 : 1); ++pd_)
        { int cw = 64 * F.wave + 4 * g; asm volatile("" : "+v"(cw));
          u32x2 kc[4][4], kp_[4][4];
#pragma unroll
          for (int tt = 0; tt < 4; ++tt) { const int t = t0 + 16 * tt + r16; const bool has_prev = (t % SEQ) != 0; const size_t ro = (size_t)t * 1536;
#pragma unroll
              for (int ct = 0; ct < 4; ++ct) { kc[tt][ct] = *(const u32x2*)(RW + ro + 512 + cw + 16 * ct); kp_[tt][ct] = (u32x2){0u, 0u}; if (has_prev) kp_[tt][ct] = *(const u32x2*)(RW + ro - 1536 + 512 + cw + 16 * ct); } }
#pragma unroll
          for (int tt = 0; tt < 4; ++tt) { float ss = 0.f;
#pragma unroll
              for (int ct = 0; ct < 4; ++ct) { const f32x4 muk = *(const LAS f32x4*)(PRM + 512 + cw + 16 * ct), kkc = *(const LAS f32x4*)(PRM + 2560 + cw + 16 * ct);
                  const float k0 = bflo(kc[tt][ct].x), k1 = bfhi(kc[tt][ct].x), k2 = bflo(kc[tt][ct].y), k3 = bfhi(kc[tt][ct].y), q0 = bflo(kp_[tt][ct].x), q1 = bfhi(kp_[tt][ct].x), q2 = bflo(kp_[tt][ct].y), q3 = bfhi(kp_[tt][ct].y);
                  const float a0 = (k0 + (q0 - k0) * muk[0]) * kkc[0], a1 = (k1 + (q1 - k1) * muk[1]) * kkc[1], a2 = (k2 + (q2 - k2) * muk[2]) * kkc[2], a3 = (k3 + (q3 - k3) * muk[3]) * kkc[3];
                  ss += (a0 * a0 + a1 * a1) + (a2 * a2 + a3 * a3); }
              ss += __shfl_xor(ss, 16); ss += __shfl_xor(ss, 32);
              inv[tt] = __builtin_amdgcn_rsqf(fmaxf(ss, 1e-24f)); } }
#pragma unroll 1
        for (int ct8 = 0; ct8 < ((PREP_DUP & 8) ? 8 : 4); ++ct8) { const int ct = ct8 & 3;
            int cw = 64 * F.wave + 4 * g; asm volatile("" : "+v"(cw));
            const int c0 = cw + 16 * ct;
            bf16x8 wf[9];
            { const unsigned char* wrow = L2T + (size_t)(64 * F.wave + 16 * ct + r16) * 576 + 16 * g;
#pragma unroll
              for (int s = 0; s < 9; ++s) wf[s] = *(const bf16x8*)(wrow + 64 * s); }
            u32x2 cur[4][3], prv[4][3], vfl[4];
#pragma unroll
            for (int tt = 0; tt < 4; ++tt) { const int t = t0 + 16 * tt + r16; const bool has_prev = (t % SEQ) != 0; const size_t ro = (size_t)t * 1536;
#pragma unroll
                for (int p = 0; p < 3; ++p) { cur[tt][p] = *(const u32x2*)(RW + ro + 512 * p + c0); prv[tt][p] = (u32x2){0u, 0u}; if (has_prev) prv[tt][p] = *(const u32x2*)(RW + ro - 1536 + 512 * p + c0); }
                vfl[tt] = (u32x2){0u, 0u}; if (l > 0) vfl[tt] = *(const u32x2*)(VF + (size_t)t * CW + c0); }
            const f32x4 mur = *(const LAS f32x4*)(PRM + c0), muk = *(const LAS f32x4*)(PRM + 512 + c0), muv = *(const LAS f32x4*)(PRM + 1024 + c0), w0v = *(const LAS f32x4*)(PRM + 1536 + c0),
                        a0v = *(const LAS f32x4*)(PRM + 2048 + c0), kkc = *(const LAS f32x4*)(PRM + 2560 + c0), kac = *(const LAS f32x4*)(PRM + 3072 + c0), v0v = *(const LAS f32x4*)(PRM + 3584 + c0);
#pragma unroll
            for (int tt = 0; tt < 4; ++tt) {
                const int t = t0 + 16 * tt + r16; const size_t oo = (size_t)t * CW, os = (size_t)(16 * tt + r16) * CW;
                bf16x8 a[9];
#pragma unroll
                for (int s = 0; s < 9; ++s) a[s] = *(const LAS bf16x8*)(act + (16 * tt + r16) * ACT_P + (32 * s + 8 * g) * 2);
                f32x4 aw = {0.f, 0.f, 0.f, 0.f}, aa = {0.f, 0.f, 0.f, 0.f}, ag = {0.f, 0.f, 0.f, 0.f}, av = {0.f, 0.f, 0.f, 0.f};
                aw = mfma16(wf[0], a[0], aw); aw = mfma16(wf[1], a[1], aw);
                aa = mfma16(wf[2], a[2], aa); aa = mfma16(wf[3], a[3], aa);
                ag = mfma16(wf[4], a[4], ag); ag = mfma16(wf[5], a[5], ag); ag = mfma16(wf[6], a[6], ag); ag = mfma16(wf[7], a[7], ag);
                if (l > 0) av = mfma16(wf[8], a[8], av);
                float ro4[4], lw4[4], vo4[4], k2[4], ka[4], kb[4];
#pragma unroll
                for (int r = 0; r < 4; ++r) {
                    const unsigned cwd_r = (r < 2) ? cur[tt][0].x : cur[tt][0].y, cwd_k = (r < 2) ? cur[tt][1].x : cur[tt][1].y, cwd_v = (r < 2) ? cur[tt][2].x : cur[tt][2].y;
                    const unsigned pwd_r = (r < 2) ? prv[tt][0].x : prv[tt][0].y, pwd_k = (r < 2) ? prv[tt][1].x : prv[tt][1].y, pwd_v = (r < 2) ? prv[tt][2].x : prv[tt][2].y;
                    const unsigned vwd = (r < 2) ? vfl[tt].x : vfl[tt].y;
                    const float rp = (r & 1) ? bfhi(cwd_r) : bflo(cwd_r), kp = (r & 1) ? bfhi(cwd_k) : bflo(cwd_k), vp = (r & 1) ? bfhi(cwd_v) : bflo(cwd_v);
                    const float rq = (r & 1) ? bfhi(pwd_r) : bflo(pwd_r), kq_ = (r & 1) ? bfhi(pwd_k) : bflo(pwd_k), vq = (r & 1) ? bfhi(pwd_v) : bflo(pwd_v);
                    const float rr = rp + (rq - rp) * mur[r], k = kp + (kq_ - kp) * muk[r]; float v = vp + (vq - vp) * muv[r];
                    lw4[r] = -0.60653066f * sigmoidf_(w0v[r] + aw[r]);
                    const float alr = sigmoidf_(a0v[r] + aa[r]);
                    if (l > 0) { const float vf = (r & 1) ? bfhi(vwd) : bflo(vwd); v = v + (vf - v) * sigmoidf_(v0v[r] + av[r]); }
                    const float kk = k * kkc[r] * inv[tt];
                    ro4[r] = rr; vo4[r] = v; k2[r] = k * (1.f + (alr - 1.f) * kac[r]); ka[r] = kk; kb[r] = kk * alr; }
                u32x2 w;
                w.x = pk2(ro4[0], ro4[1]); w.y = pk2(ro4[2], ro4[3]); *(u32x2*)(SIr + oo + c0) = w;
                w.x = pk2(lw4[0], lw4[1]); w.y = pk2(lw4[2], lw4[3]); *(u32x2*)(SCw + os + c0) = w;
                w.x = pk2(ag[0], ag[1]); w.y = pk2(ag[2], ag[3]); *(u32x2*)(Gb + oo + c0) = w;
                w.x = pk2(vo4[0], vo4[1]); w.y = pk2(vo4[2], vo4[3]); *(u32x2*)((l > 0 ? V1 : VF) + oo + c0) = w;
                w.x = pk2(k2[0], k2[1]); w.y = pk2(k2[2], k2[3]); *(u32x2*)(SIk + oo + c0) = w;
                w.x = pk2(ka[0], ka[1]); w.y = pk2(ka[2], ka[3]); *(u32x2*)(SCa + os + c0) = w;
                w.x = pk2(kb[0], kb[1]); w.y = pk2(kb[2], kb[3]); *(u32x2*)(SCb + os + c0) = w;
            }
        }
    }
}
constexpr int NUNIT = NB * NH * (SEQ / 64);
constexpr size_t U_PMP = 0, U_RPP = 8192, U1_BYTES = 16384;
constexpr size_t U_QMT = 0, U_YLT = 8192, U2_BYTES = 16384;
DI int permk(int k) { return (k & 32) | (((k >> 2) & 3) << 3) | (((k >> 4) & 1) << 2) | (k & 3); }
constexpr int MP = 144;
constexpr int SP = 80;
DI f32x4 mm_tile(const LAS unsigned char* xb, int px, int m0, const LAS unsigned char* yb, int py, int n0, int ks, f32x4 acc, int lane) {
    const int r16 = lane & 15, g = lane >> 4;
    for (int s = 0; s < ks; ++s) {
        const bf16x8 a = *(const LAS bf16x8*)(xb + (m0 + r16) * px + (32 * s + 8 * g) * 2);
        const bf16x8 b = *(const LAS bf16x8*)(yb + (n0 + r16) * py + (32 * s + 8 * g) * 2);
        acc = mfma16(a, b, acc);
    }
    return acc;
}
DI u32x2 pk4(f32x4 v) { u32x2 w; w.x = pk2(v[0], v[1]); w.y = pk2(v[2], v[3]); return w; }

#ifndef SA_DUP
#define SA_DUP 0
#endif
#define SA_REP(bit) for (int sd_ = 0; sd_ < ((SA_DUP & (bit)) ? 2 : 1); ++sd_)
DI void phase_scan_a(Frame& F, int l, int u_lo, int u_hi, int u_step) {
    LAS unsigned char* const L = F.lds;
#define MB(n) (L + (n) * 9216)
    LAS float* const Gf = (LAS float*)(L + 110592);
    LAS float* const SEG = (LAS float*)(L + 110592 + 16384);
    LAS float* const GL = SEG + 512;
    LAS unsigned char* const A21 = L + 110592 + 16384 + 2048 + 256;
    LAS unsigned char* const T11T = A21 + 2560;
    LAS unsigned char* const ZT = T11T + 2560;
    const bf16_t* SIr = (const bf16_t*)(F.wsp() + WS_SIR); const bf16_t* SIk = (const bf16_t*)(F.wsp() + WS_SIK);
    const bf16_t* SCw = (const bf16_t*)(F.wsp() + WS_SCRW) + (size_t)F.bid * 64 * CW; const bf16_t* SCa = (const bf16_t*)(F.wsp() + WS_SCRA) + (size_t)F.bid * 64 * CW; const bf16_t* SCb = (const bf16_t*)(F.wsp() + WS_SCRB) + (size_t)F.bid * 64 * CW;
    const bf16_t* V = (const bf16_t*)(F.wsp() + (l > 0 ? WS_V1 : WS_VF));
    const int lane = F.lane, wave = F.wave, r16 = lane & 15, g = lane >> 4;
    float plw[8]; u32x4 prv, pkv, pav, pbv, pvv;
#define SCANA_LOAD(uu) do { const int bh_ = (uu) & 31, c_ = (uu) >> 5, b_ = bh_ >> 3, h_ = bh_ & 7; const size_t t0_ = (size_t)b_ * SEQ + c_ * 64; \
        { const int k_ = F.tid & 63, seg_ = F.tid >> 6; _Pragma("unroll") for (int e = 0; e < 8; ++e) plw[e] = bf2f(SCw[(size_t)(8 * seg_ + e) * CW + h_ * 64 + k_]); } \
        { const int i_ = F.tid >> 3, k0_ = (F.tid & 7) * 8; const size_t go_ = (t0_ + i_) * CW + h_ * 64 + k0_, gs_ = (size_t)i_ * CW + h_ * 64 + k0_; \
          prv = *(const u32x4*)(SIr + go_); pkv = *(const u32x4*)(SIk + go_); pav = *(const u32x4*)(SCa + gs_); pbv = *(const u32x4*)(SCb + gs_); pvv = *(const u32x4*)(V + go_); } } while (0)
    if (u_lo < u_hi) SCANA_LOAD(u_lo);
    for (int u = u_lo; u < u_hi; u += u_step) {
        const int bh = u & 31, c = u >> 5, b = bh >> 3, h = bh & 7;
        const size_t t0 = (size_t)b * SEQ + c * 64; (void)t0; (void)b; (void)h;
        unsigned char* const rec1 = F.wsp() + WS_SC1 + (size_t)((bh * 128) + c) * U1_BYTES; unsigned char* const rec2 = F.wsp() + WS_SC2 + (size_t)((bh * 128) + c) * U2_BYTES;
        __syncthreads();
        SA_REP(1) {
        { const int k = F.tid & 63, seg = F.tid >> 6; float p[8]; float run = 0.f;
#pragma unroll
          for (int e = 0; e < 8; ++e) { run += plw[e]; p[e] = run; }
          SEG[seg * 64 + k] = run;
          __syncthreads();
          float off = 0.f;
#pragma unroll
          for (int s = 0; s < 8; ++s) off += (s < seg) ? SEG[s * 64 + k] : 0.f;
#pragma unroll
          for (int e = 0; e < 8; ++e) Gf[(8 * seg + e) * 64 + k] = off + p[e];
        }
        __syncthreads();
        { const int i = F.tid >> 3, k0 = (F.tid & 7) * 8;
          const u32x4 rv = prv, kv = pkv, av = pav, bv = pbv, vv = pvv;
          float fr[8], fk[8], fa[8], fb[8], fv[8];
          const unsigned rw[4] = {rv.x, rv.y, rv.z, rv.w}, kw[4] = {kv.x, kv.y, kv.z, kv.w}, aw[4] = {av.x, av.y, av.z, av.w}, bw[4] = {bv.x, bv.y, bv.z, bv.w}, vw[4] = {vv.x, vv.y, vv.z, vv.w};
#pragma unroll
          for (int q = 0; q < 4; ++q) { fr[2 * q] = bflo(rw[q]); fr[2 * q + 1] = bfhi(rw[q]); fk[2 * q] = bflo(kw[q]); fk[2 * q + 1] = bfhi(kw[q]); fa[2 * q] = bflo(aw[q]); fa[2 * q + 1] = bfhi(aw[q]);
              fb[2 * q] = bflo(bw[q]); fb[2 * q + 1] = bfhi(bw[q]); fv[2 * q] = bflo(vw[q]); fv[2 * q + 1] = bfhi(vw[q]); }
          float at[8], rt[8], bt[8], kt[8], bh8[8], kh8[8];
#pragma unroll
          for (int e = 0; e < 8; ++e) { const float gi = Gf[i * 64 + k0 + e], gp = (i > 0) ? Gf[(i - 1) * 64 + k0 + e] : 0.f, gl = Gf[63 * 64 + k0 + e];
              const float e1 = __expf(gp), e2 = __expf(gi), e3 = __expf(-gi), e4 = __expf(gl - gi);
              at[e] = -fa[e] * e1; rt[e] = fr[e] * e2; bt[e] = fb[e] * e3; kt[e] = fk[e] * e3; bh8[e] = fb[e] * e4; kh8[e] = fk[e] * e4;
              if (i == 63) GL[k0 + e] = e2; }
          u32x4 w;
          w.x = pk2(at[0], at[1]); w.y = pk2(at[2], at[3]); w.z = pk2(at[4], at[5]); w.w = pk2(at[6], at[7]); *(LAS u32x4*)(MB(0) + i * MP + k0 * 2) = w;
          w.x = pk2(rt[0], rt[1]); w.y = pk2(rt[2], rt[3]); w.z = pk2(rt[4], rt[5]); w.w = pk2(rt[6], rt[7]); *(LAS u32x4*)(MB(1) + i * MP + k0 * 2) = w;
          w.x = pk2(bt[0], bt[1]); w.y = pk2(bt[2], bt[3]); w.z = pk2(bt[4], bt[5]); w.w = pk2(bt[6], bt[7]); *(LAS u32x4*)(MB(2) + i * MP + k0 * 2) = w;
          w.x = pk2(kt[0], kt[1]); w.y = pk2(kt[2], kt[3]); w.z = pk2(kt[4], kt[5]); w.w = pk2(kt[6], kt[7]); *(LAS u32x4*)(MB(3) + i * MP + k0 * 2) = w;
#pragma unroll
          for (int e = 0; e < 8; ++e) { const int ro = (k0 + e) * MP + i * 2;
              *(LAS bf16_t*)(MB(4) + ro) = f2bf(at[e]); *(LAS bf16_t*)(MB(5) + ro) = f2bf(fv[e]); *(LAS bf16_t*)(MB(6) + ro) = f2bf(bh8[e]); *(LAS bf16_t*)(MB(7) + ro) = f2bf(kh8[e]); }
        }
        __syncthreads(); }
        if (u + u_step < u_hi) SCANA_LOAD(u + u_step);
        __syncthreads();
        SA_REP(2) {
        { const int prod = wave >> 1;
          const LAS unsigned char* xb = (prod & 1) ? MB(3) : MB(2); const LAS unsigned char* yb = (prod < 2) ? MB(0) : MB(1);
          LAS unsigned char* ob = (prod == 1) ? MB(8) : (prod == 2) ? MB(9) : MB(10);
          float zf = 0.f; asm volatile("" : "+v"(zf));
          for (int q = 0; q < 8; ++q) { const int tt = (wave & 1) * 8 + q, tm = tt >> 2, tn = tt & 3;
              f32x4 acc = {zf, zf, zf, zf};
              if (tm <= tn) acc = mm_tile(xb, MP, 16 * tm, yb, MP, 16 * tn, 2, acc, lane);
              const int i = 16 * tn + r16, j0 = 16 * tm + 4 * g;
#pragma unroll
              for (int r = 0; r < 4; ++r) { const int j = j0 + r; const bool keep = (prod < 2) ? (j < i) : (j <= i); if (!keep) acc[r] = 0.f; }
              if (prod == 0) {
                  if ((i >> 5) == (j0 >> 5)) *(LAS f32x4*)(Gf + ((i >> 5) * 32 + (i & 31)) * 32 + (j0 & 31)) = acc;
                  if (i >= 32 && j0 < 32) *(LAS u32x2*)(A21 + (i - 32) * SP + j0 * 2) = pk4(acc);
              } else *(LAS u32x2*)(ob + i * MP + j0 * 2) = pk4(acc);
          } }
        __syncthreads();
        }
        f32x4 pyl[2] = {{0.f, 0.f, 0.f, 0.f}, {0.f, 0.f, 0.f, 0.f}}, pqm[2] = {{0.f, 0.f, 0.f, 0.f}, {0.f, 0.f, 0.f, 0.f}};
        SA_REP(4) {
        if (wave == 0) {
            const int blk = lane >> 5, cc = lane & 31; const LAS float* AD = Gf + blk * 1024;
            float Tc[32];
#pragma unroll
            for (int i = 0; i < 32; ++i) { float a0 = (i == cc) ? 1.f : 0.f, a1 = 0.f, a2 = 0.f, a3 = 0.f;
#pragma unroll
                for (int q = 0; q < (i + 3) / 4; ++q) { const f32x4 a = *(const LAS f32x4*)(AD + i * 32 + 4 * q);
                    if (4 * q + 0 < i) a0 += a[0] * Tc[4 * q + 0]; if (4 * q + 1 < i) a1 += a[1] * Tc[4 * q + 1]; if (4 * q + 2 < i) a2 += a[2] * Tc[4 * q + 2]; if (4 * q + 3 < i) a3 += a[3] * Tc[4 * q + 3]; }
                Tc[i] = (a0 + a1) + (a2 + a3); }
#pragma unroll
            for (int i = 0; i < 32; ++i) *(LAS bf16_t*)(MB(11) + (32 * blk + i) * MP + (32 * blk + cc) * 2) = f2bf(Tc[i]);
            if (blk == 0) {
#pragma unroll
                for (int q = 0; q < 4; ++q) { u32x4 w; w.x = pk2(Tc[8 * q], Tc[8 * q + 1]); w.y = pk2(Tc[8 * q + 2], Tc[8 * q + 3]); w.z = pk2(Tc[8 * q + 4], Tc[8 * q + 5]); w.w = pk2(Tc[8 * q + 6], Tc[8 * q + 7]);
                    *(LAS u32x4*)(T11T + cc * SP + q * 16) = w; }
            } else {
                unsigned z = 0u; asm volatile("" : "+v"(z));
#pragma unroll
                for (int q = 0; q < 4; ++q) *(LAS u32x4*)(MB(11) + cc * MP + 64 + q * 16) = (u32x4){z, z, z, z};
            }
        } else {
            for (int tt = wave - 1; tt < 16; tt += 7) { const int tm = tt >> 2, tn = tt & 3;
                f32x4 acc = {0.f, 0.f, 0.f, 0.f};
                acc = mm_tile(MB(8), MP, 16 * tm, MB(5), MP, 16 * tn, 2, acc, lane);
                *(LAS u32x2*)(MB(2) + (16 * tn + r16) * MP + (16 * tm + 4 * g) * 2) = pk4(acc); }
            if (sd_ == 0) {
#pragma unroll
                for (int q = 0; q < 2; ++q) { const int tt = wave * 2 + q, tm = tt >> 2, tn = tt & 3; const f32x4 z = {0.f, 0.f, 0.f, 0.f};
                    pyl[q] = mm_tile(MB(5), MP, 16 * tm, MB(10), MP, 16 * tn, 2, z, lane);
                    pqm[q] = mm_tile(MB(7), MP, 16 * tm, MB(5), MP, 16 * tn, 2, z, lane); } }
        }
        __syncthreads();
        if (wave < 4) { const int tm = wave >> 1, tn = wave & 1; f32x4 acc = {0.f, 0.f, 0.f, 0.f};
            acc = mm_tile(A21, SP, 16 * tm, T11T, SP, 16 * tn, 1, acc, lane);
            *(LAS u32x2*)(ZT + (16 * tn + r16) * SP + (16 * tm + 4 * g) * 2) = pk4(acc); }
        __syncthreads();
        if (wave < 4) { const int tm = wave >> 1, tn = wave & 1; f32x4 acc = {0.f, 0.f, 0.f, 0.f};
            acc = mm_tile(ZT, SP, 16 * tm, MB(11) + 32 * MP + 64, MP, 16 * tn, 1, acc, lane);
            *(LAS u32x2*)(MB(11) + (32 + 16 * tn + r16) * MP + (16 * tm + 4 * g) * 2) = pk4(acc); }
        __syncthreads();
        }
        SA_REP(8) {
        { const LAS unsigned char* yb = (wave < 4) ? MB(4) : MB(2); LAS unsigned char* ob = (wave < 4) ? MB(3) : MB(0);
          for (int q = 0; q < 4; ++q) { const int tt = (wave & 3) * 4 + q, tm = tt >> 2, tn = tt & 3;
              f32x4 acc = {0.f, 0.f, 0.f, 0.f};
              acc = mm_tile(MB(11), MP, 16 * tm, yb, MP, 16 * tn, 2, acc, lane);
              *(LAS u32x2*)(ob + (16 * tn + r16) * MP + (16 * tm + 4 * g) * 2) = pk4(acc); } }
        __syncthreads();
        }
        SA_REP(16) {
#pragma unroll
        for (int q = 0; q < 2; ++q) { const int tt = wave * 2 + q, tm = tt >> 2, tn = tt & 3;
            { f32x4 acc = {0.f, 0.f, 0.f, 0.f}; acc = mm_tile(MB(3), MP, 16 * tm, MB(9), MP, 16 * tn, 2, acc, lane);
              const int i = 16 * tn + r16, k0 = 16 * tm + 4 * g; const u32x2 rr = *(const LAS u32x2*)(MB(1) + i * MP + k0 * 2);
              acc[0] += bflo(rr.x); acc[1] += bfhi(rr.x); acc[2] += bflo(rr.y); acc[3] += bfhi(rr.y);
              *(u32x2*)(rec1 + U_RPP + (size_t)(i * 64 + permk(k0)) * 2) = pk4(acc); }
            { f32x4 acc = {0.f, 0.f, 0.f, 0.f}; acc = mm_tile(MB(3), MP, 16 * tm, MB(6), MP, 16 * tn, 2, acc, lane);
              const int kp = 16 * tn + r16, k0 = 16 * tm + 4 * g;
#pragma unroll
              for (int r = 0; r < 4; ++r) if (k0 + r == kp) acc[r] += GL[kp];
              *(u32x2*)(rec1 + U_PMP + (size_t)(kp * 64 + permk(k0)) * 2) = pk4(acc); }
            { f32x4 acc = pyl[q]; acc = mm_tile(MB(0), MP, 16 * tm, MB(9), MP, 16 * tn, 2, acc, lane); if (wave == 0) acc = mm_tile(MB(5), MP, 16 * tm, MB(10), MP, 16 * tn, 2, acc, lane);
              *(u32x2*)(rec2 + U_YLT + (size_t)((16 * tn + r16) * 64 + 16 * tm + 4 * g) * 2) = pk4(acc); }
            { f32x4 acc = pqm[q]; acc = mm_tile(MB(6), MP, 16 * tm, MB(0), MP, 16 * tn, 2, acc, lane); if (wave == 0) acc = mm_tile(MB(7), MP, 16 * tm, MB(5), MP, 16 * tn, 2, acc, lane);
              *(u32x2*)(rec2 + U_QMT + (size_t)((16 * tn + r16) * 64 + 16 * tm + 4 * g) * 2) = pk4(acc); }
        }
        __syncthreads(); }
    }
#undef MB
#undef SCANA_LOAD
}

constexpr int SB_D = 9, SB_SLOT = 16384;
DI void scanb_issue(LAS unsigned char* lds, const unsigned char* r1b, const unsigned char* r2b, int cidx, int lw, int lane) {
    const unsigned char* rec1 = r1b + (size_t)cidx * U1_BYTES; const unsigned char* rec2 = r2b + (size_t)cidx * U2_BYTES;
    LAS unsigned char* slot = lds + (cidx % SB_D) * SB_SLOT;
#pragma unroll
    for (int i = 0; i < 2; ++i) { const int ci = 2 * lw + i;
        const int row = 8 * ci + (lane >> 3), sl = lane & 7;
        __builtin_amdgcn_global_load_lds((const unsigned*)(rec1 + U_PMP + row * 128 + ((sl ^ (row & 7)) << 4)), (LAS unsigned*)(slot + ci * 1024), 16, 0, 0); }
#pragma unroll
    for (int i = 0; i < 2; ++i) { const int ci = 2 * lw + i;
        const int v = 8 * ci + (lane >> 3), sl = lane & 7;
        __builtin_amdgcn_global_load_lds((const unsigned*)(rec2 + U_QMT + v * 128 + ((sl ^ (v & 7)) << 4)), (LAS unsigned*)(slot + 8192 + ci * 1024), 16, 0, 0); }
}
constexpr int CW_SFLG = 12288;
DI void phase_scan_b(Frame& F, int l) {
    const int lane = F.lane, r16 = lane & 15, g = lane >> 4, w = F.wave, v = 16 * (w & 3) + r16;
    for (int bh = F.bid; bh < NB * NH; bh += F.G) {
        const unsigned char* r1 = F.wsp() + WS_SC1 + (size_t)bh * 128 * U1_BYTES; const unsigned char* r2 = F.wsp() + WS_SC2 + (size_t)bh * 128 * U2_BYTES;
        bf16_t* sct = (bf16_t*)(F.wsp() + WS_SCT) + (size_t)bh * 128 * 4096;
        const __amdgpu_buffer_rsrc_t srs = __builtin_amdgcn_make_buffer_rsrc((void*)sct, 0, 128 * 8192, 0x00020000);
        GAS unsigned* flg = (GAS unsigned*)(F.ws_g + WS_CTL) + CW_SFLG + 64 * (l * 32 + bh);
        f32x4 sT[4];
#pragma unroll
        for (int i = 0; i < 4; ++i) sT[i] = (f32x4){0.f, 0.f, 0.f, 0.f};
        __syncthreads();
        if (w >= 4) {
#pragma unroll
            for (int d = 0; d < SB_D; ++d) scanb_issue(F.lds, r1, r2, d, w - 4, lane);
        }
        for (int c = 0; c < 128; ++c) {
            if (w >= 4) asm volatile("s_waitcnt vmcnt(28)" ::: "memory");
            __builtin_amdgcn_s_barrier();
            asm volatile("" ::: "memory");
            if (w >= 4) {
                if (c >= 1) { const int cn = c - 1 + SB_D; scanb_issue(F.lds, r1, r2, cn < 128 ? cn : c, w - 4, lane); }
            } else {
                const LAS unsigned char* slot = F.lds + (c % SB_D) * SB_SLOT;
                bf16x8 pm[4][2]; f32x4 q[4];
#pragma unroll
                for (int mt = 0; mt < 4; ++mt) { const int row = 16 * mt + r16;
#pragma unroll
                    for (int s2 = 0; s2 < 2; ++s2) pm[mt][s2] = *(const LAS bf16x8*)(slot + row * 128 + (((4 * s2 + g) ^ (row & 7)) << 4));
                    { const u32x2 qw = *(const LAS u32x2*)(slot + 8192 + v * 128 + (((2 * mt + (g >> 1)) ^ (v & 7)) << 4) + (g & 1) * 8); q[mt] = (f32x4){bflo(qw.x), bfhi(qw.x), bflo(qw.y), bfhi(qw.y)}; } }
                bf16x8 hi[2], lo[2];
#pragma unroll
                for (int s2 = 0; s2 < 2; ++s2) { u32x4 hw, lw;
#pragma unroll
                    for (int qq = 0; qq < 2; ++qq) { const f32x4 x = sT[2 * s2 + qq]; const unsigned h0 = pk2(x[0], x[1]), h1 = pk2(x[2], x[3]);
                        const unsigned l0 = pk2(x[0] - bflo(h0), x[1] - bfhi(h0)), l1 = pk2(x[2] - bflo(h1), x[3] - bfhi(h1));
                        if (qq == 0) { hw.x = h0; hw.y = h1; lw.x = l0; lw.y = l1; } else { hw.z = h0; hw.w = h1; lw.z = l0; lw.w = l1; } }
                    hi[s2] = __builtin_bit_cast(bf16x8, hw); lo[s2] = __builtin_bit_cast(bf16x8, lw);
                    __builtin_amdgcn_raw_buffer_store_b128(hw, srs, (int)(((unsigned)c * 4096u + (unsigned)v * 64u + 32u * s2 + 8u * g) * 2u), 0, 16); }
#pragma unroll
                for (int mt = 0; mt < 4; ++mt) { f32x4 n = q[mt];
#pragma unroll
                    for (int s2 = 0; s2 < 2; ++s2) { n = mfma16(pm[mt][s2], hi[s2], n); n = mfma16(pm[mt][s2], lo[s2], n); }
                    sT[mt] = n; }
                asm volatile("s_waitcnt lgkmcnt(0)" ::: "memory");
                if ((c & 3) == 3 && c >= 7) { asm volatile("s_waitcnt vmcnt(8)" ::: "memory");
                    if (lane == 0) __hip_atomic_fetch_add(flg, 1u, __ATOMIC_RELAXED, __HIP_MEMORY_SCOPE_AGENT); }
            }
        }
        asm volatile("s_waitcnt vmcnt(0)" ::: "memory");
        if (w < 4 && lane == 0) __hip_atomic_fetch_add(flg, 1u, __ATOMIC_RELAXED, __HIP_MEMORY_SCOPE_AGENT);
    }
}

struct ScanCIn { bf16x8 ra[2]; f32x4 yl[4]; bf16x8 sb[4][2]; };
DI void scanc_load(ScanCIn& o, const unsigned char* ws, GAS unsigned* flags, int item, int r16, int g) {
    asm volatile("" : "+s"(item));
    const int u = item >> 2, it = item & 3; const int bh = u & 31, c = u >> 5; const size_t ui = (size_t)(bh * 128 + c);
    {
      GAS unsigned* fw = flags + 64 * bh; const unsigned need = 4u * ((unsigned)(c >> 2) + 1u); unsigned spins = 0;
      while ((unsigned)__builtin_amdgcn_readfirstlane((int)__hip_atomic_load(fw, __ATOMIC_RELAXED, __HIP_MEMORY_SCOPE_AGENT)) < need) { __builtin_amdgcn_s_sleep(2); if (++spins > (1u << 20)) break; }
      asm volatile("" ::: "memory"); }
    const unsigned char* rec1 = ws + WS_SC1 + ui * U1_BYTES; const unsigned char* rec2 = ws + WS_SC2 + ui * U2_BYTES;
    const __amdgpu_buffer_rsrc_t srs = __builtin_amdgcn_make_buffer_rsrc((void*)(ws + WS_SCT + ui * 8192), 0, 8192, 0x00020000);
#pragma unroll
    for (int s = 0; s < 2; ++s) o.ra[s] = *(const bf16x8*)(rec1 + U_RPP + (size_t)((16 * it + r16) * 64 + 32 * s + 8 * g) * 2);
#pragma unroll
    for (int vt = 0; vt < 4; ++vt) { { const u32x2 yw = *(const u32x2*)(rec2 + U_YLT + (size_t)((16 * it + r16) * 64 + 16 * vt + 4 * g) * 2); o.yl[vt] = (f32x4){bflo(yw.x), bfhi(yw.x), bflo(yw.y), bfhi(yw.y)}; }
#pragma unroll
        for (int s = 0; s < 2; ++s) o.sb[vt][s] = __builtin_bit_cast(bf16x8, __builtin_amdgcn_raw_buffer_load_b128(srs, (int)(((16 * vt + r16) * 64 + 32 * s + 8 * g) * 2), 0, 16)); }
}
DI void scanc_item(const ScanCIn& o, Frame& F, int l, int item, int r16, int g) {
    const bf16_t* SIr = (const bf16_t*)(F.wsp() + WS_SIR); const bf16_t* SIk = (const bf16_t*)(F.wsp() + WS_SIK);
    const bf16_t* V = (const bf16_t*)(F.wsp() + (l > 0 ? WS_V1 : WS_VF)); const bf16_t* Gb = (const bf16_t*)(F.wsp() + WS_G); bf16_t* YR = (bf16_t*)(F.wsp() + WS_YRM);
    const int u = item >> 2, it = item & 3; const int bh = u & 31, c = u >> 5, b = bh >> 3, h = bh & 7;
    const size_t tok = (size_t)b * SEQ + c * 64 + 16 * it + r16; const size_t o0 = tok * CW + h * 64 + 4 * g, oy = tok * YRM_LD + h * 64 + 4 * g;
    u32x2 pr[4], pk[4], pv[4], pg[4];
#pragma unroll
    for (int vt = 0; vt < 4; ++vt) { pr[vt] = *(const u32x2*)(SIr + o0 + 16 * vt); pk[vt] = *(const u32x2*)(SIk + o0 + 16 * vt); pv[vt] = *(const u32x2*)(V + o0 + 16 * vt); pg[vt] = *(const u32x2*)(Gb + o0 + 16 * vt); }
    f32x4 y[4];
#pragma unroll
    for (int vt = 0; vt < 4; ++vt) { y[vt] = o.yl[vt];
#pragma unroll
        for (int s = 0; s < 2; ++s) y[vt] = mfma16(o.sb[vt][s], o.ra[s], y[vt]); }
    float s1 = 0.f;
#pragma unroll
    for (int vt = 0; vt < 4; ++vt) s1 += (y[vt][0] + y[vt][1]) + (y[vt][2] + y[vt][3]);
    s1 += __shfl_xor(s1, 16); s1 += __shfl_xor(s1, 32);
    const float mean = s1 * (1.f / 64.f); float s2 = 0.f;
#pragma unroll
    for (int vt = 0; vt < 4; ++vt) { y[vt] = y[vt] - mean; s2 += (y[vt][0] * y[vt][0] + y[vt][1] * y[vt][1]) + (y[vt][2] * y[vt][2] + y[vt][3] * y[vt][3]); }
    s2 += __shfl_xor(s2, 16); s2 += __shfl_xor(s2, 32);
    const float rstd = __builtin_amdgcn_rsqf(s2 * (1.f / 64.f) + 64e-5f);
    const float* lng = F.inp(17) + l * CW + h * 64 + 4 * g; const float* lnb = F.inp(18) + l * CW + h * 64 + 4 * g; const float* rkp = F.inp(16) + l * CW + h * 64 + 4 * g;
    float s3 = 0.f;
#pragma unroll
    for (int vt = 0; vt < 4; ++vt) { const f32x4 rk = *(const f32x4*)(rkp + 16 * vt);
        s3 += bflo(pr[vt].x) * bflo(pk[vt].x) * rk[0] + bfhi(pr[vt].x) * bfhi(pk[vt].x) * rk[1] + bflo(pr[vt].y) * bflo(pk[vt].y) * rk[2] + bfhi(pr[vt].y) * bfhi(pk[vt].y) * rk[3]; }
    s3 += __shfl_xor(s3, 16); s3 += __shfl_xor(s3, 32);
#pragma unroll
    for (int vt = 0; vt < 4; ++vt) { const f32x4 lg4 = *(const f32x4*)(lng + 16 * vt), lb4 = *(const f32x4*)(lnb + 16 * vt);
        const float o_0 = (y[vt][0] * rstd * lg4[0] + lb4[0] + s3 * bflo(pv[vt].x)) * bflo(pg[vt].x), o_1 = (y[vt][1] * rstd * lg4[1] + lb4[1] + s3 * bfhi(pv[vt].x)) * bfhi(pg[vt].x);
        const float o_2 = (y[vt][2] * rstd * lg4[2] + lb4[2] + s3 * bflo(pv[vt].y)) * bflo(pg[vt].y), o_3 = (y[vt][3] * rstd * lg4[3] + lb4[3] + s3 * bfhi(pv[vt].y)) * bfhi(pg[vt].y);
        u32x2 w; w.x = pk2(o_0, o_1); w.y = pk2(o_2, o_3); *(u32x2*)(YR + oy + 16 * vt) = w; }
}
DI void phase_scan_c(Frame& F, int l, int nskip) {
    const int lane = F.lane, r16 = lane & 15, g = lane >> 4;
    const int first = (F.bid - nskip) * 8 + F.wave, stride = (F.G - nskip) * 8;
    if (first >= NUNIT * 4) return;
    GAS unsigned* flags = (GAS unsigned*)(F.ws_g + WS_CTL) + CW_SFLG + 64 * (l * 32);
    ScanCIn o0, o1;
    scanc_load(o0, F.wsp(), flags, first, r16, g);
    for (int item = first; item < NUNIT * 4; item += 2 * stride) {
        const int i1 = item + stride, i2 = item + 2 * stride;
        if (i1 < NUNIT * 4) scanc_load(o1, F.wsp(), flags, i1, r16, g);
        scanc_item(o0, F, l, item, r16, g);
        if (i1 < NUNIT * 4) { if (i2 < NUNIT * 4) scanc_load(o0, F.wsp(), flags, i2, r16, g); scanc_item(o1, F, l, i1, r16, g); }
    }
}

#ifndef FUSE_DUP
#define FUSE_DUP 0
#endif
DI void phase_prep_scana(Frame& F, int l) {
    phase_rwkv_prep2(F, l, 0, 0, 1, true);
#define RELANE() do { int l_ = F.lane; asm volatile("" : "+v"(l_)); F.lane = l_; F.tid = F.wave * 64 + l_; } while (0)
    for (int tile = F.bid; tile < T / 64; tile += F.G) {
        for (int fd_ = 0; fd_ < ((FUSE_DUP & 1) ? 2 : 1); ++fd_) {
        RELANE();
        phase_rwkv_prep2(F, l, tile, tile + 1, 1, false);
        }
        asm volatile("s_waitcnt vmcnt(0)" ::: "memory");
        __syncthreads();
        __builtin_amdgcn_fence(__ATOMIC_ACQUIRE, "agent");
        asm volatile("s_waitcnt vmcnt(0)" ::: "memory");
        const int b = tile >> 7, c = tile & 127; const int u0 = c * 32 + b * 8;
        for (int fd_ = 0; fd_ < ((FUSE_DUP & 2) ? 2 : 1); ++fd_) {
        RELANE();
        phase_scan_a(F, l, u0, u0 + 8, 1);
        }
    }
#undef RELANE
}
DI void phase_moba_prep(Frame& F, int l) {
    bf16_t* MO = (bf16_t*)(F.wsp() + WS_MO); float* KM = (float*)(F.wsp() + WS_TAB + TB_KMEAN);
    int c = F.tid; const float qg = F.inp(23)[l * 64 + (c & 63)] * 0.125f, kg = F.inp(24)[l * 64 + (c & 63)];
    for (int hs = F.bid; hs < T / 128; hs += F.G) {
        float ksum = 0.f;
        for (int tb = 0; tb < 128; tb += 8) {
            int tbase = hs * 128 + tb; asm volatile("" : "+s"(tbase), "+v"(c));
            float q[8], k[8];
#pragma unroll
            for (int e = 0; e < 8; ++e) { const size_t ro = (size_t)(tbase + e) * 1536; q[e] = bf2f(MO[ro + c]); k[e] = bf2f(MO[ro + 512 + c]); }
#pragma unroll
            for (int e = 0; e < 8; ++e) { const size_t ro = (size_t)(tbase + e) * 1536;
                const float qs = wave_sum(q[e] * q[e]) * (1.f / 64.f), ks = wave_sum(k[e] * k[e]) * (1.f / 64.f);
                const float qn = q[e] * (1.0f / sqrtf(qs + 1e-6f)) * qg, kn = k[e] * (1.0f / sqrtf(ks + 1e-6f)) * kg;
                MO[ro + c] = f2bf(qn); MO[ro + 512 + c] = f2bf(kn); ksum += kn; }
        }
        KM[(size_t)(hs & 1) * (TB_KMEAN2 / 4) + (size_t)(hs >> 1) * CW + c] = ksum * (1.f / 256.f);
    }
}
DI void phase_moba_gate(Frame& F) {
    LAS float* KL = (LAS float*)F.lds;
    const bf16_t* MO = (const bf16_t*)(F.wsp() + WS_MO); const float* KM = (const float*)(F.wsp() + WS_TAB + TB_KMEAN); unsigned* SEL = (unsigned*)(F.wsp() + WS_SEL);
    for (int sidx = F.bid; sidx < T / 64; sidx += F.G) {
        const int span = ((sidx / F.G) & 1) ? ((sidx & ~127) + (127 - (sidx & 127))) : sidx;
        const int t0 = span * 64, b = t0 / SEQ, blk = (t0 % SEQ) / 256;
        __syncthreads();
        { const int cc = F.tid, h = cc >> 6, d = cc & 63;
          for (int j0 = 0; j0 < blk; j0 += 8) { float v0[8], v1[8];
#pragma unroll
              for (int e = 0; e < 8; ++e) { const int j = (j0 + e < blk) ? j0 + e : blk - 1; const size_t ko = ((size_t)(b * 32 + j)) * CW + cc; v0[e] = KM[ko]; v1[e] = KM[ko + TB_KMEAN2 / 4]; }
#pragma unroll
              for (int e = 0; e < 8; ++e) if (j0 + e < blk) KL[h * 2052 + (j0 + e) * 64 + d] = v0[e] + v1[e]; } }
        __syncthreads();
        const int tok = F.tid >> 3, h = F.tid & 7; const int t = t0 + tok;
        float q[64];
        { const u32x4* qp = (const u32x4*)(MO + (size_t)t * 1536 + h * 64);
#pragma unroll
          for (int i = 0; i < 8; ++i) { const u32x4 w = qp[i]; q[8 * i] = bflo(w.x); q[8 * i + 1] = bfhi(w.x); q[8 * i + 2] = bflo(w.y); q[8 * i + 3] = bfhi(w.y); q[8 * i + 4] = bflo(w.z); q[8 * i + 5] = bfhi(w.z); q[8 * i + 6] = bflo(w.w); q[8 * i + 7] = bfhi(w.w); } }
        float v0 = -INFINITY, v1 = -INFINITY, v2 = -INFINITY; int i0 = 0, i1 = 1, i2 = 2;
        for (int j = 0; j < blk; ++j) {
            const LAS f32x4* kp = (const LAS f32x4*)(KL + h * 2052 + j * 64); float s = 0.f;
#pragma unroll
            for (int i = 0; i < 16; ++i) { const f32x4 kv = kp[i]; s += q[4 * i] * kv.x + q[4 * i + 1] * kv.y + q[4 * i + 2] * kv.z + q[4 * i + 3] * kv.w; }
            if (s > v0) { v2 = v1; i2 = i1; v1 = v0; i1 = i0; v0 = s; i0 = j; }
            else if (s > v1) { v2 = v1; i2 = i1; v1 = s; i1 = j; }
            else if (s > v2) { v2 = s; i2 = j; }
        }
        const int nv = blk < 3 ? blk : 3;
        SEL[(size_t)t * 8 + h] = (unsigned)i0 | ((unsigned)i1 << 8) | ((unsigned)i2 << 16) | ((unsigned)nv << 24);
    }
}

constexpr int KS_PITCH = 144, VT_PITCH = 520;
constexpr int NPIECE = 47;
constexpr int CW_QATT = 8192;
DI void phase_moba_attn(Frame& F, int l) {
    static constexpr unsigned PIECES[NPIECE] = {196608,1837578,590595,1574658,1115654,1640713,1968907,1443848,918789,1049857,1246983,393730,787456,721924,2034700,262401,2034179,2034957,2035214,2035471,2034692,2035728,2034944,2035985,2036242,2036499,2035461,2036756,2037013,2037270,2035969,2037527,2036230,2037784,2038041,2038298,2036743,2038555,2038812,2039069,2039326,2037512,2039583,2038018,2038281,2039050,2039563};
    LAS unsigned char* Ks = F.lds;
    LAS unsigned char* Vt = F.lds + 36864;
    LAS float* LUT = (LAS float*)(F.lds + 36864 + 33280);
    LAS unsigned* CTL = (LAS unsigned*)(F.lds + 36864 + 33280 + 528);
    LAS unsigned* LIST = CTL + 4;
    const bf16_t* MO = (const bf16_t*)(F.wsp() + WS_MO); const unsigned* SEL = (const unsigned*)(F.wsp() + WS_SEL);
    bf16_t* PO = (bf16_t*)(F.wsp() + WS_PO); f32x2* PST = (f32x2*)(F.wsp() + WS_PST);
    unsigned* qctr = (unsigned*)(F.wsp() + WS_CTL) + CW_QATT + 64 * l;
    const float* relb = F.inp(25);
    const int lane = F.lane;
    for (;;) {
        __syncthreads();
        if (F.tid == 0) { CTL[0] = __hip_atomic_fetch_add(qctr, 1u, __ATOMIC_RELAXED, __HIP_MEMORY_SCOPE_AGENT); CTL[1] = 0u; }
        __syncthreads();
        const int u = (int)CTL[0];
        if (u >= NPIECE * NB * NH) break;
        const unsigned pc = PIECES[u >> 5]; const int bh = u & 31, b = bh >> 3, h = bh & 7;
        const int j = (int)(pc & 0xff), qlo = (int)((pc >> 8) & 0xff), qhi = (int)(pc >> 16); const int ncand = (qhi - qlo + 1) * 256;
        const size_t tokb = (size_t)b * SEQ;
        for (int id = F.tid; id < 2048; id += 512) { const int row = id >> 3, c8 = id & 7; const size_t ro = (tokb + j * 256 + row) * 1536 + h * 64 + c8 * 8;
            *(LAS u32x4*)(Ks + row * KS_PITCH + c8 * 16) = *(const u32x4*)(MO + ro + 512); }
        for (int id = F.tid; id < 1024; id += 512) { const int rp = id >> 3, c8 = id & 7; const size_t ro = (tokb + j * 256 + 2 * rp) * 1536 + h * 64 + c8 * 8 + 1024;
            const u32x4 v0 = *(const u32x4*)(MO + ro), v1 = *(const u32x4*)(MO + ro + 1536);
            const unsigned a[4] = {v0.x, v0.y, v0.z, v0.w}, bq[4] = {v1.x, v1.y, v1.z, v1.w};
            LAS unsigned char* vp = Vt + (c8 * 8) * VT_PITCH + rp * 4;
#pragma unroll
            for (int q = 0; q < 4; ++q) { *(LAS unsigned*)(vp + (2 * q) * VT_PITCH) = (a[q] & 0xffffu) | (bq[q] << 16); *(LAS unsigned*)(vp + (2 * q + 1) * VT_PITCH) = (a[q] >> 16) | (bq[q] & 0xffff0000u); } }
        if (F.tid <= 128) { const int n = F.tid; int bucket;
            if (n < 16) bucket = n; else { int lg = 16 + (int)(logf((float)n / 16.0f) / 2.0794415416798357f * 16.0f); bucket = lg < 31 ? lg : 31; }
            LUT[n] = relb[bucket * 8 + h]; }
        unsigned selw[11];
#pragma unroll
        for (int r = 0; r < 11; ++r) { const int qq = qlo * 256 + r * 512 + F.tid; selw[r] = (r * 512 + F.tid < ncand) ? SEL[(tokb + qq) * 8 + h] : 0u; }
#pragma unroll
        for (int r = 0; r < 11; ++r) { const int base = r * 512; if (base >= ncand) break;
            const int q = qlo * 256 + base + F.tid; const int qb = q >> 8; bool mem = false; unsigned ent = 0;
            if (base + F.tid >= ncand) { }
            else if (qb == j) { mem = true; ent = (unsigned)q | (3u << 16); }
            else { const unsigned s = selw[r]; const unsigned nv = s >> 24;
                if (nv > 0 && (s & 0xff) == (unsigned)j) { mem = true; ent = (unsigned)q; }
                else if (nv > 1 && ((s >> 8) & 0xff) == (unsigned)j) { mem = true; ent = (unsigned)q | (1u << 16); }
                else if (nv > 2 && ((s >> 16) & 0xff) == (unsigned)j) { mem = true; ent = (unsigned)q | (2u << 16); } }
            const unsigned long long bal = __ballot(mem); const int cnt = __popcll(bal);
            unsigned wbase = 0; if (lane == 0 && cnt > 0) wbase = __hip_atomic_fetch_add(&CTL[1], (unsigned)cnt, __ATOMIC_RELAXED, __HIP_MEMORY_SCOPE_WORKGROUP);
            wbase = (unsigned)__builtin_amdgcn_readfirstlane((int)wbase);
            if (mem) LIST[wbase + __popcll(bal & ((1ull << lane) - 1ull))] = ent;
        }
        __syncthreads();
        const int total = (int)CTL[1];
        const float bfar = LUT[128];
        const int ntile = (total + 31) >> 5;
        const int qi = lane & 31, half = lane >> 5;
        for (int tile = F.wave; tile < ntile; tile += 8) {
            const int e = tile * 32 + qi; const bool valid = e < total; const unsigned en = LIST[valid ? e : total - 1];
            const int q = (int)(en & 0xffffu), slot = (int)(en >> 16); const size_t tok = tokb + q;
            const bool need_lut = __any((q >> 8) <= j + 1);
            bf16x8 qf[4];
#pragma unroll
            for (int kk = 0; kk < 4; ++kk) qf[kk] = *(const bf16x8*)(MO + tok * 1536 + h * 64 + 16 * kk + 8 * half);
            float mrun = -1e30f, lsum = 0.f;
            f32x16 oacc[2];
#pragma unroll
            for (int i = 0; i < 16; ++i) { oacc[0][i] = 0.f; oacc[1][i] = 0.f; }
            const int qrel = q - j * 256;
#pragma unroll 1
            for (int ck = 0; ck < 4; ++ck) {
                if (!__any(qrel >= 64 * ck)) break;
                f32x16 sacc[2];
#pragma unroll
                for (int k2 = 0; k2 < 2; ++k2) { const int kt = 2 * ck + k2;
#pragma unroll
                    for (int i = 0; i < 16; ++i) sacc[k2][i] = 0.f;
#pragma unroll
                    for (int kk = 0; kk < 4; ++kk) { const bf16x8 ka = *(const LAS bf16x8*)(Ks + (32 * kt + qi) * KS_PITCH + (16 * kk + 8 * half) * 2);
                        sacc[k2] = __builtin_amdgcn_mfma_f32_32x32x16_bf16(ka, qf[kk], sacc[k2], 0, 0, 0); } }
                float mx = -1e30f;
                if (need_lut) {
#pragma unroll
                    for (int k2 = 0; k2 < 2; ++k2)
#pragma unroll
                        for (int i = 0; i < 16; ++i) { const int key = 32 * (2 * ck + k2) + (i & 3) + 8 * (i >> 2) + 4 * half; const int n = qrel - key;
                            const float bias = LUT[n < 0 ? 0 : (n > 128 ? 128 : n)];
                            const float s = (n < 0) ? -1e30f : sacc[k2][i] + bias; sacc[k2][i] = s; mx = fmaxf(mx, s); }
                } else {
#pragma unroll
                    for (int k2 = 0; k2 < 2; ++k2)
#pragma unroll
                        for (int i = 0; i < 16; ++i) { const float s = sacc[k2][i] + bfar; sacc[k2][i] = s; mx = fmaxf(mx, s); }
                }
                mx = fmaxf(mx, __shfl_xor(mx, 32));
                const float mnew = fmaxf(mrun, mx); const float alpha = __expf(mrun - mnew); mrun = mnew;
                lsum *= alpha;
#pragma unroll
                for (int i = 0; i < 16; ++i) { oacc[0][i] *= alpha; oacc[1][i] *= alpha; }
#pragma unroll
                for (int k2 = 0; k2 < 2; ++k2) { const int kt = 2 * ck + k2;
#pragma unroll
                    for (int i = 0; i < 16; ++i) { const float p = __expf(sacc[k2][i] - mnew); sacc[k2][i] = p; lsum += p; }
#pragma unroll
                    for (int cc = 0; cc < 2; ++cc) {
                        u32x4 pw; pw.x = pk2(sacc[k2][8 * cc], sacc[k2][8 * cc + 1]); pw.y = pk2(sacc[k2][8 * cc + 2], sacc[k2][8 * cc + 3]); pw.z = pk2(sacc[k2][8 * cc + 4], sacc[k2][8 * cc + 5]); pw.w = pk2(sacc[k2][8 * cc + 6], sacc[k2][8 * cc + 7]);
                        const bf16x8 pf = __builtin_bit_cast(bf16x8, pw);
                        const int key0 = 32 * kt + 16 * cc + 4 * half;
#pragma unroll
                        for (int dt = 0; dt < 2; ++dt) { const LAS unsigned char* vb = Vt + (32 * dt + qi) * VT_PITCH + key0 * 2;
                            const u32x2 va = *(const LAS u32x2*)vb, vb2 = *(const LAS u32x2*)(vb + 16);
                            u32x4 vw; vw.x = va.x; vw.y = va.y; vw.z = vb2.x; vw.w = vb2.y;
                            oacc[dt] = __builtin_amdgcn_mfma_f32_32x32x16_bf16(__builtin_bit_cast(bf16x8, vw), pf, oacc[dt], 0, 0, 0); } } }
            }
            const float mx = mrun;
            lsum += __shfl_xor(lsum, 32);
            const float inv = 1.0f / lsum;
            if (valid) {
                bf16_t* op = PO + ((size_t)slot * T + tok) * CW + h * 64;
#pragma unroll
                for (int dt = 0; dt < 2; ++dt)
#pragma unroll
                    for (int ig = 0; ig < 4; ++ig) { u32x2 w; w.x = pk2(oacc[dt][4 * ig] * inv, oacc[dt][4 * ig + 1] * inv); w.y = pk2(oacc[dt][4 * ig + 2] * inv, oacc[dt][4 * ig + 3] * inv);
                        *(u32x2*)(op + 32 * dt + 8 * ig + 4 * half) = w; }
                if (half == 0) PST[((size_t)slot * T + tok) * 8 + h] = (f32x2){mx, lsum};
            }
        }
    }
}
DI void phase_moba_combine(Frame& F) {
    const bf16_t* PO = (const bf16_t*)(F.wsp() + WS_PO); const f32x2* PST = (const f32x2*)(F.wsp() + WS_PST); const unsigned* SEL = (const unsigned*)(F.wsp() + WS_SEL);
    bf16_t* YM = (bf16_t*)(F.wsp() + WS_YRM) + 512;
    int c = F.tid; const int h = c >> 6;
    for (int tb = F.bid * 8; tb < T; tb += F.G * 8) {
        int tbase = tb; asm volatile("" : "+s"(tbase), "+v"(c));
        int nv[8]; f32x2 st[8][4]; float po[8][4];
#pragma unroll
        for (int e = 0; e < 8; ++e) { const int t = tbase + e; nv[e] = (int)(SEL[(size_t)t * 8 + h] >> 24);
#pragma unroll
            for (int s = 0; s < 4; ++s) { st[e][s] = PST[((size_t)s * T + t) * 8 + h]; po[e][s] = bf2f(PO[((size_t)s * T + t) * CW + c]); } }
#pragma unroll
        for (int e = 0; e < 8; ++e) { const int t = tbase + e; float M = -1e30f;
#pragma unroll
            for (int s = 0; s < 4; ++s) { const bool on = (s == 3) || (s < nv[e]); if (on) M = fmaxf(M, st[e][s].x); }
            float den = 0.f, num = 0.f;
#pragma unroll
            for (int s = 0; s < 4; ++s) { const bool on = (s == 3) || (s < nv[e]); if (on) { const float w = st[e][s].y * __expf(st[e][s].x - M); den += w; num += w * po[e][s]; } }
            YM[(size_t)t * YRM_LD + c] = f2bf(num / den); }
    }
}
DI void phase_router(Frame& F, int l) {
    LAS float* xs = (LAS float*)F.lds;
    LAS float* wsm = xs + 64 * 129;
    LAS float* lgt = wsm + 128 * 36;
    LAS float* ssq = lgt + 64 * 37;
    LAS int* hist = (LAS int*)(ssq + 64);
    const float* x = F.outp(); const float* gain = F.inp(2) + (size_t)l * DM;
    const float* wgrp = F.inp(29) + (size_t)l * DM * 4; const float* wexp = F.inp(31) + (size_t)l * DM * 32;
    const float* bgrp = F.inp(30) + l * 4; const float* bexp = F.inp(32) + l * 32;
    int* EID = (int*)(F.wsp() + WS_RT + RT_EID); float* GATE = (float*)(F.wsp() + WS_RT + RT_GATE); int* HIST = (int*)(F.wsp() + WS_RT + RT_HIST);
    const int tok = F.tid & 63, jg = F.tid >> 6;
    for (int tile = F.bid; tile < T / 64; tile += F.G) {
        const int t0 = tile * 64;
        float acc[5] = {0.f, 0.f, 0.f, 0.f, 0.f}; float ss = 0.f;
        if (F.tid < 32) hist[F.tid] = 0;
        for (int kc = 0; kc < DM; kc += 128) {
            __syncthreads();
            for (int idx = F.tid; idx < 64 * 128; idx += 512) { const int r = idx >> 7, k = idx & 127; xs[r * 129 + k] = x[(size_t)(t0 + r) * DM + kc + k]; }
            for (int idx = F.tid; idx < 128 * 36; idx += 512) { const int k = idx / 36, j = idx - k * 36; const float g = gain[kc + k];
                wsm[idx] = g * (j < 4 ? wgrp[(size_t)(kc + k) * 4 + j] : wexp[(size_t)(kc + k) * 32 + (j - 4)]); }
            __syncthreads();
            for (int k = 0; k < 128; ++k) { const float xv = xs[tok * 129 + k]; ss += xv * xv;
#pragma unroll
                for (int i = 0; i < 5; ++i) { const int j = jg + 8 * i; if (j < 36) acc[i] += xv * wsm[k * 36 + j]; } }
        }
#pragma unroll
        for (int i = 0; i < 5; ++i) { const int j = jg + 8 * i; if (j < 36) lgt[tok * 37 + j] = acc[i]; }
        if (jg == 0) ssq[tok] = ss;
        __syncthreads();
        if (F.tid < 64) {
            const int t = t0 + F.tid; const float rs = 1.0f / sqrtf(ssq[F.tid] * (1.f / DM) + 1e-6f);
            float lg[4]; int gs = 0; float gm = -INFINITY;
#pragma unroll
            for (int g = 0; g < 4; ++g) { lg[g] = lgt[F.tid * 37 + g] * rs + bgrp[g]; if (lg[g] > gm) { gm = lg[g]; gs = g; } }
            float gden = 0.f;
#pragma unroll
            for (int g = 0; g < 4; ++g) gden += expf(lg[g] - gm);
            const float ptop = 1.0f / gden;
            float le[8]; float e0 = -INFINITY, e1 = -INFINITY; int j0 = 0, j1 = 1;
#pragma unroll
            for (int e = 0; e < 8; ++e) { le[e] = lgt[F.tid * 37 + 4 + gs * 8 + e] * rs + bexp[gs * 8 + e];
                if (le[e] > e0) { e1 = e0; j1 = j0; e0 = le[e]; j0 = e; } else if (le[e] > e1) { e1 = le[e]; j1 = e; } }
            const float p1 = expf(e1 - e0);
            const float g0 = ptop / (1.f + p1), g1 = ptop * p1 / (1.f + p1);
            const int ex0 = gs * 8 + j0, ex1 = gs * 8 + j1;
            EID[t * 2] = ex0; EID[t * 2 + 1] = ex1; GATE[t * 2] = g0; GATE[t * 2 + 1] = g1;
            __hip_atomic_fetch_add(&hist[ex0], 1, __ATOMIC_RELAXED, __HIP_MEMORY_SCOPE_WORKGROUP); __hip_atomic_fetch_add(&hist[ex1], 1, __ATOMIC_RELAXED, __HIP_MEMORY_SCOPE_WORKGROUP);
        }
        __syncthreads();
        if (F.tid < 32) HIST[tile * 32 + F.tid] = hist[F.tid];
        __syncthreads();
    }
}
DI void phase_moe_gather(Frame& F, int l) {
    LAS int* tot = (LAS int*)F.lds; LAS int* off = tot + 32; LAS int* base = off + 32; LAS int* eidl = base + 32; LAS int* rowl = eidl + 128; LAS int* ps = rowl + 128; LAS int* po = ps + 512;
    const int* EID = (const int*)(F.wsp() + WS_RT + RT_EID); const float* GATE = (const float*)(F.wsp() + WS_RT + RT_GATE); const int* HIST = (const int*)(F.wsp() + WS_RT + RT_HIST);
    int* ROW = (int*)(F.wsp() + WS_RT + RT_ROW); float* GW = (float*)(F.wsp() + WS_RT + RT_GW); int* PEXP = (int*)(F.wsp() + WS_RT + RT_PEXP);
    int* TOK = (int*)(F.wsp() + WS_RT + RT_TOK); const float* RSQ = (const float*)(F.wsp() + WS_RT + RT_RSQ); float* RSR = (float*)(F.wsp() + WS_RT + RT_RSR);
    for (int tile = F.bid; tile < T / 64; tile += F.G) {
        const int t0 = tile * 64;
        __syncthreads();
        { const int e = F.tid & 31, part = F.tid >> 5; int s = 0, o = 0;
#pragma unroll 8
          for (int i = part * 32; i < part * 32 + 32; ++i) { const int v = HIST[i * 32 + e]; s += v; if (i < tile) o += v; }
          ps[F.tid] = s; po[F.tid] = o; }
        if (F.tid < 128) eidl[F.tid] = EID[t0 * 2 + F.tid];
        __syncthreads();
        if (F.tid < 32) { int s = 0, o = 0;
#pragma unroll
            for (int p = 0; p < 16; ++p) { s += ps[p * 32 + F.tid]; o += po[p * 32 + F.tid]; } tot[F.tid] = s; off[F.tid] = o; }
        __syncthreads();
        if (F.tid == 0) {
            int bs = 0; for (int e = 0; e < 32; ++e) { base[e] = bs; bs += (tot[e] + 255) & ~255; }
            if (tile == 0) { int p = 0; for (int e = 0; e < 32; ++e) { const int np = (tot[e] + 255) >> 8; for (int i = 0; i < np; ++i) PEXP[p++] = e; } PEXP[MOE_PANELS] = p; }
        }
        __syncthreads();
        if (F.tid < 128) { const int my = eidl[F.tid]; int rank = 0; for (int i = 0; i < F.tid; ++i) rank += (eidl[i] == my) ? 1 : 0;
            const int r = base[my] + off[my] + rank; rowl[F.tid] = r; ROW[t0 * 2 + F.tid] = r; GW[r] = GATE[t0 * 2 + F.tid]; TOK[r] = t0 + (F.tid >> 1); RSR[r] = RSQ[t0 + (F.tid >> 1)]; }
    }
}
DI void phase_moe_combine(Frame& F, int l) {
    const bf16_t* YE = (const bf16_t*)(F.wsp() + WS_YE); const int* ROW = (const int*)(F.wsp() + WS_RT + RT_ROW); bf16_t* XN = (bf16_t*)(F.wsp() + WS_XN);
    const float* gain = F.inp(1) + (size_t)(l + 1 < NLAYER ? l + 1 : l) * DM;
    const int gw = F.bid * 8 + F.wave, NGW = F.G * 8; int lane = F.lane;
    for (int tb = gw * 4; tb < T; tb += NGW * 4) {
        int tbase = tb; asm volatile("" : "+s"(tbase), "+v"(lane));
        int r0[4], r1[4];
#pragma unroll
        for (int e = 0; e < 4; ++e) { r0[e] = ROW[(tbase + e) * 2]; r1[e] = ROW[(tbase + e) * 2 + 1]; }
        u32x2 ya[4][4], yb[4][4]; f32x4 xv[4][4];
#pragma unroll
        for (int e = 0; e < 4; ++e) { const u32x2* y0 = (const u32x2*)(YE + (size_t)r0[e] * DM) + lane; const u32x2* y1 = (const u32x2*)(YE + (size_t)r1[e] * DM) + lane; const f32x4* xr = (const f32x4*)(F.outp() + (size_t)(tbase + e) * DM) + lane;
#pragma unroll
            for (int j = 0; j < 4; ++j) { ya[e][j] = y0[64 * j]; yb[e][j] = y1[64 * j]; xv[e][j] = xr[64 * j]; } }
#pragma unroll
        for (int e = 0; e < 4; ++e) { const int t = tbase + e; f32x4* xr = (f32x4*)(F.outp() + (size_t)t * DM) + lane; float s = 0.f;
#pragma unroll
            for (int j = 0; j < 4; ++j) { f32x4 v = xv[e][j]; const u32x2 a = ya[e][j], b = yb[e][j];
                v.x += bflo(a.x) + bflo(b.x); v.y += bfhi(a.x) + bfhi(b.x); v.z += bflo(a.y) + bflo(b.y); v.w += bfhi(a.y) + bfhi(b.y);
                xv[e][j] = v; xr[64 * j] = v; s += (v.x * v.x + v.y * v.y) + (v.z * v.z + v.w * v.w); }
            if (l + 1 < NLAYER) {
                const float rs = __builtin_amdgcn_rsqf(wave_sum(s) * (1.f / DM) + 1e-6f);
#pragma unroll
                for (int j = 0; j < 4; ++j) { const f32x4 g = ((const f32x4*)gain)[lane + 64 * j]; const f32x4 y = xv[e][j] * rs * g; u32x2 w; w.x = pk2(y.x, y.y); w.y = pk2(y.z, y.w); *((u32x2*)(XN + (size_t)t * DM) + lane + 64 * j) = w; }
            } }
    }
}
constexpr size_t TB_WRH = 512 * 1024, TB_WRL = TB_WRH + 48 * 1024 * 2;
DI void phase_conv_router(Frame& F, int l) {
    bf16_t* WRH = (bf16_t*)(F.wsp() + WS_TAB + TB_WRH); bf16_t* WRL = (bf16_t*)(F.wsp() + WS_TAB + TB_WRL);
    const float* gain = F.inp(2) + (size_t)l * DM; const float* wgrp = F.inp(29) + (size_t)l * DM * 4; const float* wexp = F.inp(31) + (size_t)l * DM * 32;
    for (int idx = F.bid * 512 + F.tid; idx < 48 * DM; idx += F.G * 512) { const int n = idx >> 10, k = idx & 1023;
        float v = (n < 4) ? wgrp[k * 4 + n] : (n < 36) ? wexp[k * 32 + (n - 4)] : 0.f; v *= gain[k];
        const bf16_t h = f2bf(v); WRH[idx] = h; WRL[idx] = f2bf(v - bf2f(h)); }
}
DI void phase_router2(Frame& F, int l) {
    LAS float* lgt = (LAS float*)F.lds + F.wave * 1024;
    LAS int* hist = (LAS int*)(F.lds + 8 * 4096);
    const float* x = F.outp(); const bf16_t* WRH = (const bf16_t*)(F.wsp() + WS_TAB + TB_WRH); const bf16_t* WRL = (const bf16_t*)(F.wsp() + WS_TAB + TB_WRL);
    const float* bgrp = F.inp(30) + l * 4; const float* bexp = F.inp(32) + l * 32;
    int* EID = (int*)(F.wsp() + WS_RT + RT_EID); float* GATE = (float*)(F.wsp() + WS_RT + RT_GATE); int* HIST = (int*)(F.wsp() + WS_RT + RT_HIST);
    const int lane = F.lane, r16 = lane & 15, g = lane >> 4;
    bf16_t* XN2 = (bf16_t*)(F.wsp() + WS_AM); const float* gain = F.inp(2) + (size_t)l * DM; float* RSQ = (float*)(F.wsp() + WS_RT + RT_RSQ);
    { int* TOK = (int*)(F.wsp() + WS_RT + RT_TOK); for (int i = F.bid * 512 + F.tid; i < MOE_ROWS; i += F.G * 512) TOK[i] = 0; }
    for (int task = F.bid; task < T / 128; task += F.G) {
        const int t0 = task * 128 + F.wave * 16;
        __syncthreads();
        if (F.tid < 64) hist[F.tid] = 0;
        __syncthreads();
        f32x4 acc[3];
#pragma unroll
        for (int nt = 0; nt < 3; ++nt) acc[nt] = (f32x4){0.f, 0.f, 0.f, 0.f};
        float ss = 0.f;
        const float* xr = x + (size_t)(t0 + r16) * DM + 8 * g; bf16_t* xo = XN2 + (size_t)(t0 + r16) * DM + 8 * g; const float* gp = gain + 8 * g;
#pragma unroll 2
        for (int s = 0; s < 32; ++s) {
            const f32x4 x0 = *(const f32x4*)(xr + 32 * s), x1 = *(const f32x4*)(xr + 32 * s + 4);
            ss += (x0.x * x0.x + x0.y * x0.y) + (x0.z * x0.z + x0.w * x0.w) + (x1.x * x1.x + x1.y * x1.y) + (x1.z * x1.z + x1.w * x1.w);
            { const f32x4 g0 = *(const f32x4*)(gp + 32 * s), g1 = *(const f32x4*)(gp + 32 * s + 4);
              u32x4 w; w.x = pk2(x0.x * g0.x, x0.y * g0.y); w.y = pk2(x0.z * g0.z, x0.w * g0.w); w.z = pk2(x1.x * g1.x, x1.y * g1.y); w.w = pk2(x1.z * g1.z, x1.w * g1.w);
              *(u32x4*)(xo + 32 * s) = w; }
            u32x4 hw, lw; hw.x = pk2(x0.x, x0.y); hw.y = pk2(x0.z, x0.w); hw.z = pk2(x1.x, x1.y); hw.w = pk2(x1.z, x1.w);
            lw.x = pk2(x0.x - bflo(hw.x), x0.y - bfhi(hw.x)); lw.y = pk2(x0.z - bflo(hw.y), x0.w - bfhi(hw.y)); lw.z = pk2(x1.x - bflo(hw.z), x1.y - bfhi(hw.z)); lw.w = pk2(x1.z - bflo(hw.w), x1.w - bfhi(hw.w));
            const bf16x8 ah = __builtin_bit_cast(bf16x8, hw), al = __builtin_bit_cast(bf16x8, lw);
#pragma unroll
            for (int nt = 0; nt < 3; ++nt) { const size_t wo = (size_t)(16 * nt + r16) * DM + 32 * s + 8 * g;
                const bf16x8 bh = *(const bf16x8*)(WRH + wo), bl = *(const bf16x8*)(WRL + wo);
                acc[nt] = mfma16(ah, bh, acc[nt]); acc[nt] = mfma16(ah, bl, acc[nt]); acc[nt] = mfma16(al, bh, acc[nt]); }
        }
        ss += __shfl_xor(ss, 16); ss += __shfl_xor(ss, 32);
        if (g == 0) RSQ[t0 + r16] = __builtin_amdgcn_rsqf(ss * (1.f / DM) + 1e-6f);
#pragma unroll
        for (int nt = 0; nt < 3; ++nt)
#pragma unroll
            for (int r = 0; r < 4; ++r) lgt[(4 * g + r) * 48 + 16 * nt + r16] = acc[nt][r];
        if (g == 0) lgt[768 + r16] = ss;
        LDS_WAIT(); asm volatile("" ::: "memory");
        if (lane < 16) {
            const int t = t0 + lane; const float rs = 1.0f / sqrtf(lgt[768 + lane] * (1.f / DM) + 1e-6f); const LAS float* lr = lgt + lane * 48;
            float lg[4]; int gs = 0; float gm = -INFINITY;
#pragma unroll
            for (int q = 0; q < 4; ++q) { lg[q] = lr[q] * rs + bgrp[q]; if (lg[q] > gm) { gm = lg[q]; gs = q; } }
            float gden = 0.f;
#pragma unroll
            for (int q = 0; q < 4; ++q) gden += expf(lg[q] - gm);
            const float ptop = 1.0f / gden;
            float e0 = -INFINITY, e1 = -INFINITY; int j0 = 0, j1 = 1;
#pragma unroll
            for (int e = 0; e < 8; ++e) { const float le = lr[4 + gs * 8 + e] * rs + bexp[gs * 8 + e];
                if (le > e0) { e1 = e0; j1 = j0; e0 = le; j0 = e; } else if (le > e1) { e1 = le; j1 = e; } }
            const float p1 = expf(e1 - e0);
            const float g0 = ptop / (1.f + p1), g1 = ptop * p1 / (1.f + p1);
            const int ex0 = gs * 8 + j0, ex1 = gs * 8 + j1;
            EID[t * 2] = ex0; EID[t * 2 + 1] = ex1; GATE[t * 2] = g0; GATE[t * 2 + 1] = g1;
            LAS int* hh = hist + (F.wave >> 2) * 32;
            __hip_atomic_fetch_add(&hh[ex0], 1, __ATOMIC_RELAXED, __HIP_MEMORY_SCOPE_WORKGROUP); __hip_atomic_fetch_add(&hh[ex1], 1, __ATOMIC_RELAXED, __HIP_MEMORY_SCOPE_WORKGROUP);
        }
        __syncthreads();
        if (F.tid < 64) HIST[(task * 2 + (F.tid >> 5)) * 32 + (F.tid & 31)] = hist[F.tid];
    }
}
#ifndef MK_PER_PHASE_LAUNCH
#define MK_PER_PHASE_LAUNCH 0
#endif
constexpr int PH_PER_LAYER = 19, NPHASE = PH_PER_LAYER * NLAYER;
struct Args { const float* in[36]; float* out; unsigned char* ws; int ph_lo, ph_hi; };

#ifndef SCAN_NAIVE
#define SCAN_NAIVE 0
#endif
#ifndef PHMASK
#define PHMASK 0x7ffff
#endif
#ifndef DUPMASK
#define DUPMASK 0
#endif
#define NREP(k) ((((DUPMASK) >> (k)) & 1) ? 2 : 1)
#define IN(k) (((PHMASK >> ((k) % PH_PER_LAYER)) & 1) && lo <= (k) && (k) < hi)
#define SEAM(k) do { asm volatile("" : "+s"(barp), "+s"(bar.x)); bar.bar = (unsigned*)barp; if (IN(k) && IN((k) + 1)) xcd_barrier(bar); asm volatile("" : "+s"(F.ws_g), "+s"(F.out_g), "+s"(F.ka), "+s"(F.bid), "+s"(F.G), "+s"(F.lds)); } while (0)
#define FRESH() do { asm volatile("" : "+s"(F.wave)); int l_ = (int)__builtin_amdgcn_mbcnt_hi(~0u, __builtin_amdgcn_mbcnt_lo(~0u, 0u)); asm volatile("" : "+v"(l_)); F.lane = l_; F.tid = F.wave * 64 + l_; } while (0)
__global__ void __launch_bounds__(512, 2) fwd_kernel(Args args) {
    extern __shared__ __attribute__((aligned(16))) unsigned char lds_raw[];
    Frame F;
    F.lds = (LAS unsigned char*)lds_raw;
    F.tid = threadIdx.x; F.lane = F.tid & 63; F.wave = __builtin_amdgcn_readfirstlane(F.tid >> 6);
    F.G = gridDim.x; F.bid = blockIdx.x;
    F.ka = (const __attribute__((address_space(4))) unsigned char*)__builtin_amdgcn_kernarg_segment_ptr();
    F.out_g = (GAS float*)args.out; F.ws_g = (GAS unsigned char*)args.ws;
    volatile LAS unsigned* MISC = (volatile LAS unsigned*)(F.lds + MISC_OFF);
    if (F.tid < 32) MISC[F.tid] = 0u;
    __syncthreads();
    const int lo = args.ph_lo, hi = args.ph_hi;
    GAS unsigned* barp = (GAS unsigned*)(F.ws_g + WS_CTL) + CW_BAR;
    XcdBarrier bar; bar.bar = (unsigned*)barp; bar.x = 0; bar.st = nullptr;
    if (hi - lo > 1) bar = xcd_barrier_post((unsigned*)barp, MISC + 8);

    bf16_t* const XN = (bf16_t*)(F.wsp() + WS_XN);
    bf16_t* const WCAT = (bf16_t*)(F.wsp() + WS_WM + WM_WCAT);
    for (int l = 0; l < NLAYER; ++l) {
        const int P = l * PH_PER_LAYER;
#define PHASE(k) if (IN(P + (k))) for (int rep_ = 0; rep_ < NREP(k); ++rep_)
        PHASE(0) { FRESH(); if (l == 0) { phase_conv_mixer(F, 0); phase_conv_lora2(F, 0); phase_conv_router(F, 0); phase_norm_x(F, F.inp(0), F.inp(1)); } }
        if (l == 0) SEAM(P + 0);
#if defined(XTRA_BARS)
        if (hi - lo > 1) for (int xb_ = 0; xb_ < XTRA_BARS; ++xb_) { asm volatile("" : "+s"(barp), "+s"(bar.x)); bar.bar = (unsigned*)barp; xcd_barrier(bar); }
#endif
        PHASE(1) { FRESH(); const int n1 = (l == 0) ? 2048 : 2304;
            pg8::Gemm g{XN, WCAT, T, n1, DM}; pg8::StaticOrder S; S.init(T, n1, F.G, F.bid);
            pg8::EpiStore E{(bf16_t*)(F.wsp() + WS_RW), 1536, 1536, (bf16_t*)(F.wsp() + WS_LO), LO_W, 0};
            pg8::gemm_phase<pg8::EpiStore, pg8::StaticOrder>(F.lds, g, S, E, F.tid); }
        SEAM(P + 1);
        PHASE(2) { FRESH(); phase_prep_scana(F, l); }
        SEAM(P + 2);
        PHASE(4) { FRESH(); if (F.bid < NB * NH && F.G > 2 * NB * NH) phase_scan_b(F, l); else if (F.G > 2 * NB * NH) phase_scan_c(F, l, NB * NH); else {   } }
        SEAM(P + 5);
        PHASE(6) { FRESH(); pg8::Gemm g{XN, WCAT + (size_t)2304 * DM, T, 1536, DM}; pg8::StaticOrder S; S.init(T, 1536, F.G, F.bid);
            pg8::EpiMoba E{(bf16_t*)(F.wsp() + WS_MO), F.inp(23) + l * 64, F.inp(24) + l * 64, (float*)(F.wsp() + WS_TAB + TB_KMEAN), (int)(TB_KMEAN2 / 4)};
            pg8::gemm_phase<pg8::EpiMoba, pg8::StaticOrder>(F.lds, g, S, E, F.tid); }
        SEAM(P + 6);
        PHASE(8) { FRESH(); phase_moba_gate(F); }
        SEAM(P + 8);
        PHASE(9) { FRESH(); phase_moba_attn(F, l); }
        SEAM(P + 9);
        PHASE(10) { FRESH(); phase_moba_combine(F); }
        SEAM(P + 10);
        PHASE(11) { FRESH(); pg8::Gemm g{XN, WCAT + (size_t)3840 * DM, T, 2048, DM}; pg8::StaticOrder S; S.init(T, 2048, F.G, F.bid);
            pg8::EpiStore E{(bf16_t*)(F.wsp() + WS_GA), 2048, 0, nullptr, 0, 1};
            pg8::gemm_phase<pg8::EpiStore, pg8::StaticOrder>(F.lds, g, S, E, F.tid); }
        SEAM(P + 11);
        PHASE(12) { FRESH(); pg8::Gemm g{(const bf16_t*)(F.wsp() + WS_YRM), (const bf16_t*)(F.wsp() + WS_WM + WM_BRR), T, DM, DM}; pg8::StaticOrder S; S.init(T, DM, F.G, F.bid);
            pg8::EpiBranch2 E{(bf16_t*)(F.wsp() + WS_H), (const bf16_t*)(F.wsp() + WS_GA)};
            pg8::gemm_phase<pg8::EpiBranch2, pg8::StaticOrder>(F.lds, g, S, E, F.tid); }
        SEAM(P + 12);
        PHASE(13) { FRESH(); pg8::Gemm g{(const bf16_t*)(F.wsp() + WS_H), (const bf16_t*)(F.wsp() + WS_WM + WM_OUT), T, DM, DM}; pg8::StaticOrder S; S.init(T, DM, F.G, F.bid);
            pg8::EpiResid E{l == 0 ? F.inp(0) : F.outp(), F.outp()};
            pg8::gemm_phase<pg8::EpiResid, pg8::StaticOrder>(F.lds, g, S, E, F.tid); }
        SEAM(P + 13);
        PHASE(14) { FRESH(); phase_router2(F, l); phase_conv_experts(F, l); }
        SEAM(P + 14);
        PHASE(15) { FRESH(); phase_moe_gather(F, l); }
        SEAM(P + 15);
        PHASE(16) { FRESH(); const int* PEXP = (const int*)(F.wsp() + WS_RT + RT_PEXP); const int np = __builtin_amdgcn_readfirstlane(PEXP[MOE_PANELS]);
            pg8::Gemm g{(const bf16_t*)(F.wsp() + WS_AM), (const bf16_t*)(F.wsp() + WS_WE), np * 256, 1024, DM}; pg8::GatherOrder S; S.init(np * 256, 1024, F.G, F.bid); S.pexp = PEXP;
            LAS int* tokL = (LAS int*)(F.lds + RING_BYTES); S.tokL = tokL;
            { const int* TOK = (const int*)(F.wsp() + WS_RT + RT_TOK); __syncthreads();
              for (int i = 0; i < 16; ++i) { pg8::Unit uu; if (!S.next(i, uu)) break; if (F.tid < 256) tokL[i * 256 + F.tid] = TOK[uu.pm * 256 + F.tid]; }
              __syncthreads(); }
            pg8::EpiExpertUp E{(bf16_t*)(F.wsp() + WS_HM), (const float*)(F.wsp() + WS_RT + RT_GW), (const float*)(F.wsp() + WS_RT + RT_RSR)};
            pg8::gemm_phase<pg8::EpiExpertUp, pg8::GatherOrder>(F.lds, g, S, E, F.tid); }
        SEAM(P + 16);
        PHASE(17) { FRESH(); const int* PEXP = (const int*)(F.wsp() + WS_RT + RT_PEXP); const int np = __builtin_amdgcn_readfirstlane(PEXP[MOE_PANELS]);
            pg8::Gemm g{(const bf16_t*)(F.wsp() + WS_HM), (const bf16_t*)(F.wsp() + WS_WD), np * 256, 1024, DEXP}; pg8::GroupOrder S; S.init(np * 256, 1024, F.G, F.bid); S.pexp = PEXP;
            pg8::EpiStore E{(bf16_t*)(F.wsp() + WS_YE), 1024, 0, nullptr, 0, 0};
            pg8::gemm_phase<pg8::EpiStore, pg8::GroupOrder>(F.lds, g, S, E, F.tid); }
        SEAM(P + 17);
        PHASE(18) { FRESH(); phase_moe_combine(F, l); if (l + 1 < NLAYER) { phase_conv_mixer(F, l + 1); phase_conv_lora2(F, l + 1); phase_conv_router(F, l + 1); } }
        SEAM(P + 18);
#undef PHASE
    }
}

extern "C" void kernel_launch(void* const* d_in, const int* in_sizes, int n_in, void* d_out, int out_size, void* d_ws, size_t ws_size, hipStream_t stream) {
    static int grid = 0;
    if (grid == 0) {
        if (n_in != 36 || out_size != T * DM || ws_size < WS_NEED) { fprintf(stderr, "kernel_launch: unexpected problem (n_in %d, out %d, ws %zu); nothing launched\n", n_in, out_size, ws_size); grid = -1; return; }
        int dev = 0, cus = 0;
        if (hipGetDevice(&dev) != hipSuccess || hipDeviceGetAttribute(&cus, hipDeviceAttributeMultiprocessorCount, dev) != hipSuccess) { grid = -1; return; }
        if (hipFuncSetAttribute((const void*)fwd_kernel, hipFuncAttributeMaxDynamicSharedMemorySize, LDS_BYTES) != hipSuccess) { fprintf(stderr, "kernel_launch: hipFuncSetAttribute failed\n"); grid = -1; return; }
        int per_cu = 0;
        if (hipOccupancyMaxActiveBlocksPerMultiprocessor(&per_cu, (const void*)fwd_kernel, 512, LDS_BYTES) != hipSuccess || per_cu < 1) { fprintf(stderr, "kernel_launch: occupancy query says %d\n", per_cu); }
        (void)hipGetLastError();
        grid = cus;
    }
    if (grid < 0) return;
    (void)hipMemsetAsync((char*)d_ws + WS_CTL, 0, CTL_ZERO_BYTES, stream);
    Args a{};
    for (int i = 0; i < 36; ++i) a.in[i] = (const float*)d_in[i];
    a.out = (float*)d_out; a.ws = (unsigned char*)d_ws;
#if MK_PER_PHASE_LAUNCH
    for (int ph = 0; ph < NPHASE; ++ph) { if (ph == PH_PER_LAYER) continue; a.ph_lo = ph; a.ph_hi = ph + 1; hipLaunchKernelGGL(fwd_kernel, dim3(grid), dim3(512), LDS_BYTES, stream, a); }
#else
    a.ph_lo = 0; a.ph_hi = NPHASE;
    hipLaunchKernelGGL(fwd_kernel, dim3(grid), dim3(512), LDS_BYTES, stream, a);
#endif
}
```

```cpp
#include <hip/hip_runtime.h>
#include <cstdio>
#include <cstdint>
#define LAS __attribute__((address_space(3)))
#define GAS __attribute__((address_space(1)))
#define DI __device__ __forceinline__
typedef unsigned short bf16_t;
typedef short bf16x8 __attribute__((ext_vector_type(8)));
typedef short s16x4 __attribute__((ext_vector_type(4)));
typedef float f32x4 __attribute__((ext_vector_type(4)));
typedef float f32x2 __attribute__((ext_vector_type(2)));
typedef float f32x16 __attribute__((ext_vector_type(16)));
typedef unsigned u32x4 __attribute__((ext_vector_type(4)));
typedef unsigned u32x2 __attribute__((ext_vector_type(2)));
typedef __bf16 bf16v2 __attribute__((ext_vector_type(2)));

DI unsigned pk2(float lo, float hi) { f32x2 v = {lo, hi}; return __builtin_bit_cast(unsigned, __builtin_convertvector(v, bf16v2)); }
DI bf16_t f2bf(float f) { return (bf16_t)(pk2(f, 0.f) & 0xffffu); }
DI float bf2f(bf16_t b) { return __uint_as_float(((unsigned)b) << 16); }
DI float bflo(unsigned w) { return __uint_as_float(w << 16); }
DI float bfhi(unsigned w) { return __uint_as_float(w & 0xffff0000u); }
DI float rcpf_(float x) { return __builtin_amdgcn_rcpf(x); }
DI float sigmoidf_(float x) { return __builtin_amdgcn_rcpf(1.0f + __expf(-x)); }

template <int CTRL> DI float dpp_mov(float v) { return __builtin_bit_cast(float, __builtin_amdgcn_update_dpp(0, __builtin_bit_cast(int, v), CTRL, 0xf, 0xf, true)); }
DI float rdlane(float v, int l) { return __builtin_bit_cast(float, __builtin_amdgcn_readlane(__builtin_bit_cast(int, v), l)); }
DI float wave_sum(float v) {
    v += dpp_mov<0xB1>(v);
    v += dpp_mov<0x4E>(v);
    v += dpp_mov<0x141>(v);
    v += dpp_mov<0x140>(v);
    return (rdlane(v, 0) + rdlane(v, 16)) + (rdlane(v, 32) + rdlane(v, 48));
}
DI f32x4 mfma16(bf16x8 a, bf16x8 b, f32x4 c) { return __builtin_amdgcn_mfma_f32_16x16x32_bf16(a, b, c, 0, 0, 0); }
namespace pg8 {
constexpr int BM = 256, BK = 64, HALF = 128, HTB = HALF * BK * 2  , STAGE_BYTES = 8 * HTB, NXCD = 8, WGM = 8;

__host__ __device__ __forceinline__ int lds_byte(int r, int c) { const int st = (r >> 4) * 2 + (c >> 5), rr = r & 15, cc = c & 31, ob = rr * 64 + cc * 2; return st * 1024 + (ob ^ (((ob >> 9) & 1) << 5)); }
__host__ __device__ __forceinline__ void stage_rc(int b, int& R, int& C) { const int st = b / 1024, sb = b % 1024, swz = sb ^ (((sb >> 9) & 1) << 5); R = (st >> 1) * 16 + swz / 64; C = (st & 1) * 32 + (swz % 64) / 2; }
__host__ __device__ __forceinline__ int perm32(int rho) { const int n = rho >> 4, i = rho & 15; return 8 * (i >> 2) + 4 * n + (i & 3); }

struct Unit { int pm, pn, pb; };
struct Gemm { const bf16_t* A; const bf16_t* Bt; int M, N, K; };

struct StaticOrder {
    static constexpr bool GATHER = false;
    int nM, nN, nwg, G, c;
    __device__ __forceinline__ void init(int M, int N, int G_, int c_) { nM = M / BM; nN = N / BM; nwg = nM * nN; G = G_; c = c_; }
    __device__ __forceinline__ bool next(int i, Unit& u) const {
        const long L = (long)i * G + c; if (L >= nwg) return false;
        int wgid = (int)L; { const int q = nwg / NXCD, r = nwg % NXCD, xcd = wgid % NXCD, off = wgid / NXCD; wgid = (xcd < r ? xcd * (q + 1) : r * (q + 1) + (xcd - r) * q) + off; }
        const int nig = WGM * nN, gid = wgid / nig, fm = gid * WGM, gsz = (nM - fm) < WGM ? (nM - fm) : WGM;
        u.pm = fm + ((wgid % nig) % gsz); u.pn = (wgid % nig) / gsz; u.pb = u.pn; return true;
    }
};
struct GroupOrder : StaticOrder {
    const int* pexp;
    __device__ __forceinline__ bool next(int i, Unit& u) const {
        if (!StaticOrder::next(i, u)) return false;
        u.pb = __builtin_amdgcn_readfirstlane(pexp[u.pm]) * nN + u.pn; return true;
    }
};
struct GatherOrder : GroupOrder {
    static constexpr bool GATHER = true;
    const LAS int* tokL;
};

template <class Epi, class Sched, bool ALIGN_EPI = true, bool SP2 = true>
__device__ __forceinline__ void gemm_phase(LAS unsigned char* lds, const Gemm g, const Sched& S, const Epi& E, int tid_in) {
    const int tid = tid_in, wid = __builtin_amdgcn_readfirstlane(tid >> 6), lane = tid & 63, wr = wid >> 2, wc = wid & 3, fr = lane & 15, fq = lane >> 4;
    const int K = g.K, nt = K / BK;
    unsigned voffA[2], voffB[2];
#pragma unroll
    for (int i = 0; i < 2; ++i) { int R, C; stage_rc(tid * 16 + i * 8192, R, C); const int Rb = Epi::HEADS ? (64 * (R >> 5) + perm32(R & 31)) : Epi::PERM ? ((R & ~31) + perm32(R & 31)) : R;
        voffA[i] = (unsigned)(R * K + C) * 2u; voffB[i] = (unsigned)(Rb * K + C) * 2u; }
    unsigned goff[2][2] = {{0u, 0u}, {0u, 0u}}, goffN[2][2] = {{0u, 0u}, {0u, 0u}};
#define PG8_GOFF(dst, ui_) do { if constexpr (Sched::GATHER) { _Pragma("unroll") for (int h_ = 0; h_ < 2; ++h_) _Pragma("unroll") for (int i_ = 0; i_ < 2; ++i_) { int R_, C_; stage_rc(tid * 16 + i_ * 8192, R_, C_); \
        const int tk_ = S.tokL[(ui_) * 256 + 128 * h_ + R_]; dst[h_][i_] = (unsigned)(tk_ * K + C_) * 2u; } } } while (0)
#define PG8_STAGE_A(bufoff, kt, h, usenext) do { if constexpr (Sched::GATHER) { unsigned vo_[2] = { (usenext) ? goffN[h][0] : goff[h][0], (usenext) ? goffN[h][1] : goff[h][1] }; PG8_STAGE(bufoff, kt, vo_); } \
        else { PG8_STAGE(bufoff, (kt) + ((h) ? hstep : 0), voffA); } } while (0)
    const size_t kstep = (size_t)(BK * 2);
    const size_t hstep = (size_t)HALF * K * 2;
    const size_t hstepB = Epi::HEADS ? (size_t)32 * K * 2 : hstep;
    const size_t tstep = 2 * hstep;
    const unsigned ldsw = (unsigned)wid * 1024u;
    const int aoff = lds_byte(wr * 64 + fr, fq * 8), boff = lds_byte(wc * 32 + fr, fq * 8);
#define PG8_SA(b, h) (((b) * 2 + (h)) * HTB)
#define PG8_SB(b, h) ((4 + (b) * 2 + (h)) * HTB)
#define PG8_STAGE(bufoff, gbase, voff) do { _Pragma("unroll") for (int _i = 0; _i < 2; ++_i) \
        __builtin_amdgcn_global_load_lds((const unsigned*)((const char*)(gbase) + (voff)[_i]), (LAS unsigned*)(lds + (bufoff) + ldsw + _i * 8192), 16, 0, 0); } while (0)
#define PG8_LDA(dst, b, h) do { _Pragma("unroll") for (int m = 0; m < 4; ++m) _Pragma("unroll") for (int k = 0; k < 2; ++k) dst[m][k] = *(const LAS bf16x8*)(lds + PG8_SA(b, h) + aoff + m * 2048 + k * 1024); } while (0)
#define PG8_LDB(dst, b, h) do { _Pragma("unroll") for (int n = 0; n < 2; ++n) _Pragma("unroll") for (int k = 0; k < 2; ++k) dst[n][k] = *(const LAS bf16x8*)(lds + PG8_SB(b, h) + boff + n * 2048 + k * 1024); } while (0)
#define PG8_MMA(ai, bj, At, Bt) do { __builtin_amdgcn_s_setprio(1); _Pragma("unroll") for (int m = 0; m < 4; ++m) _Pragma("unroll") for (int n = 0; n < 2; ++n) _Pragma("unroll") for (int k = 0; k < 2; ++k) \
        acc[ai][bj][m][n] = __builtin_amdgcn_mfma_f32_16x16x32_bf16(Bt[n][k], At[m][k], acc[ai][bj][m][n], 0, 0, 0); __builtin_amdgcn_s_setprio(0); } while (0)
#define PG8_WAIT_V(n) asm volatile("s_waitcnt vmcnt(" #n ")" ::: "memory")
#define PG8_WAIT_L(n) asm volatile("s_waitcnt lgkmcnt(" #n ")" ::: "memory")
#define PG8_BAR __builtin_amdgcn_s_barrier()
#define PG8_SCHED __builtin_amdgcn_sched_barrier(0)
    Unit cur, nxt; int ui = 0;
    if (!S.next(0, cur)) return;
    f32x4 acc[2][2][4][2];
#pragma unroll
    for (int a = 0; a < 2; ++a)
#pragma unroll
        for (int b = 0; b < 2; ++b)
#pragma unroll
            for (int m = 0; m < 4; ++m)
#pragma unroll
                for (int n = 0; n < 2; ++n) acc[a][b][m][n] = (f32x4){0.f, 0.f, 0.f, 0.f};
    bf16x8 At[4][2], B0[2][2], B1[2][2];
    const char* cA = (const char*)g.A + (Sched::GATHER ? (size_t)0 : (size_t)cur.pm * tstep); const char* cB = (const char*)g.Bt + (size_t)cur.pb * tstep;
    PG8_GOFF(goff, 0);
    if constexpr (SP2) {
        PG8_STAGE(PG8_SB(0, 0), cB, voffB); PG8_STAGE(PG8_SB(0, 1), cB + hstepB, voffB); PG8_STAGE_A(PG8_SA(0, 0), cA, 0, false); PG8_STAGE_A(PG8_SA(0, 1), cA, 1, false);
        if (wr == 1) PG8_BAR;
        PG8_WAIT_V(2); PG8_BAR;
        PG8_STAGE(PG8_SB(1, 0), cB + kstep, voffB); PG8_STAGE_A(PG8_SA(1, 0), cA + kstep, 0, false); PG8_STAGE(PG8_SB(1, 1), cB + hstepB + kstep, voffB);
        PG8_WAIT_V(6); PG8_BAR;
    } else {
        PG8_STAGE(PG8_SB(0, 0), cB, voffB); PG8_STAGE_A(PG8_SA(0, 0), cA, 0, false); PG8_STAGE(PG8_SB(0, 1), cB + hstepB, voffB); PG8_STAGE_A(PG8_SA(0, 1), cA, 1, false);
        if (wr == 1) PG8_BAR;
        PG8_WAIT_V(4); PG8_BAR;
        PG8_STAGE(PG8_SB(1, 0), cB + kstep, voffB); PG8_STAGE_A(PG8_SA(1, 0), cA + kstep, 0, false); PG8_STAGE(PG8_SB(1, 1), cB + hstepB + kstep, voffB);
        PG8_WAIT_V(6); PG8_BAR;
    }
    for (;;) {
        const bool has_next = S.next(ui + 1, nxt);
        const char* nA = (has_next && !Sched::GATHER) ? (const char*)g.A + (size_t)nxt.pm * tstep : cA; const char* nB = has_next ? (const char*)g.Bt + (size_t)nxt.pb * tstep : cB;
        if constexpr (Sched::GATHER) { if (has_next) PG8_GOFF(goffN, ui + 1); else { goffN[0][0] = goff[0][0]; goffN[0][1] = goff[0][1]; goffN[1][0] = goff[1][0]; goffN[1][1] = goff[1][1]; } }
        for (int t = 0; t < nt; t += 2) {
            if constexpr (Epi::HAS_MID) { if (t == nt / 2) E.mid(acc, cur, wr, wc, fr, fq); }
            const bool last = (t == nt - 2);
            const char* a1 = cA + (size_t)(t + 1) * kstep;
            const char* a2 = last ? nA : cA + (size_t)(t + 2) * kstep; const char* b2 = last ? nB : cB + (size_t)(t + 2) * kstep;
            const char* a3 = a2 + kstep; const char* b3 = b2 + kstep;
            if constexpr (SP2) {
            PG8_LDB(B0, 0, 0); PG8_LDB(B1, 0, 1); PG8_SCHED; PG8_LDA(At, 0, 0); PG8_STAGE_A(PG8_SA(1, 1), a1, 1, false);
            PG8_WAIT_V(8); PG8_WAIT_L(0); PG8_BAR; PG8_MMA(0, 0, At, B0); PG8_MMA(0, 1, At, B1); PG8_BAR; PG8_SCHED;
            PG8_LDA(At, 0, 1); PG8_STAGE(PG8_SB(0, 0), b2, voffB); PG8_STAGE(PG8_SB(0, 1), b2 + hstepB, voffB); PG8_STAGE_A(PG8_SA(0, 0), a2, 0, last);
            PG8_WAIT_V(8); PG8_WAIT_L(0); PG8_BAR; PG8_MMA(1, 0, At, B0); PG8_MMA(1, 1, At, B1); PG8_BAR; PG8_SCHED;
            PG8_LDB(B0, 1, 0); PG8_LDB(B1, 1, 1); PG8_SCHED; PG8_LDA(At, 1, 0); PG8_STAGE_A(PG8_SA(0, 1), a2, 1, last);
            PG8_WAIT_V(8); PG8_WAIT_L(0); PG8_BAR; PG8_MMA(0, 0, At, B0); PG8_MMA(0, 1, At, B1); PG8_BAR; PG8_SCHED;
            PG8_LDA(At, 1, 1); PG8_STAGE(PG8_SB(1, 0), b3, voffB); PG8_STAGE(PG8_SB(1, 1), b3 + hstepB, voffB); PG8_STAGE_A(PG8_SA(1, 0), a3, 0, last);
            PG8_WAIT_V(8); PG8_WAIT_L(0); PG8_BAR; PG8_MMA(1, 0, At, B0); PG8_MMA(1, 1, At, B1); PG8_BAR; PG8_SCHED;
            } else {
            PG8_LDB(B0, 0, 0); PG8_SCHED; PG8_LDA(At, 0, 0); PG8_STAGE_A(PG8_SA(1, 1), a1, 1, false);
            PG8_WAIT_L(8); PG8_BAR; PG8_WAIT_L(0); PG8_MMA(0, 0, At, B0); PG8_BAR; PG8_SCHED;
            PG8_LDB(B1, 0, 1); PG8_STAGE(PG8_SB(0, 0), b2, voffB);
            PG8_BAR; PG8_WAIT_L(0); PG8_MMA(0, 1, At, B1); PG8_BAR;
            PG8_LDA(At, 0, 1); PG8_STAGE_A(PG8_SA(0, 0), a2, 0, last);
            PG8_BAR; PG8_WAIT_L(0); PG8_MMA(1, 0, At, B0); PG8_BAR; PG8_SCHED;
            PG8_STAGE(PG8_SB(0, 1), b2 + hstepB, voffB);
            PG8_WAIT_V(6); PG8_BAR; PG8_MMA(1, 1, At, B1); PG8_BAR;
            PG8_LDB(B0, 1, 0); PG8_SCHED; PG8_LDA(At, 1, 0); PG8_STAGE_A(PG8_SA(0, 1), a2, 1, last);
            PG8_WAIT_L(8); PG8_BAR; PG8_WAIT_L(0); PG8_MMA(0, 0, At, B0); PG8_BAR; PG8_SCHED;
            PG8_LDB(B1, 1, 1); PG8_STAGE(PG8_SB(1, 0), b3, voffB);
            PG8_BAR; PG8_WAIT_L(0); PG8_MMA(0, 1, At, B1); PG8_BAR;
            PG8_LDA(At, 1, 1); PG8_STAGE_A(PG8_SA(1, 0), a3, 0, last);
            PG8_BAR; PG8_WAIT_L(0); PG8_MMA(1, 0, At, B0); PG8_BAR; PG8_SCHED;
            PG8_STAGE(PG8_SB(1, 1), b3 + hstepB, voffB);
            PG8_WAIT_V(6); PG8_BAR; PG8_MMA(1, 1, At, B1); PG8_BAR;
            }
        }
        if constexpr (ALIGN_EPI) { if (wr == 0) PG8_BAR; }
        E(acc, cur, wr, wc, fr, fq);
        if (!has_next) break;
#pragma unroll
        for (int a = 0; a < 2; ++a)
#pragma unroll
            for (int b = 0; b < 2; ++b)
#pragma unroll
                for (int m = 0; m < 4; ++m)
#pragma unroll
                    for (int n = 0; n < 2; ++n) acc[a][b][m][n] = (f32x4){0.f, 0.f, 0.f, 0.f};
        cur = nxt; cA = nA; cB = nB; ++ui;
        if constexpr (Sched::GATHER) { goff[0][0] = goffN[0][0]; goff[0][1] = goffN[0][1]; goff[1][0] = goffN[1][0]; goff[1][1] = goffN[1][1]; }
        if constexpr (ALIGN_EPI) { if (wr == 1) PG8_BAR; }
    }
    PG8_WAIT_V(0);
    if constexpr (!ALIGN_EPI) { if (wr == 0) PG8_BAR; }
    PG8_BAR;
#undef PG8_SA
#undef PG8_GOFF
#undef PG8_STAGE_A
#undef PG8_SB
#undef PG8_STAGE
#undef PG8_LDA
#undef PG8_LDB
#undef PG8_MMA
#undef PG8_WAIT_V
#undef PG8_WAIT_L
#undef PG8_BAR
#undef PG8_SCHED
}
}
#define XB_TMO      128
#define XB_XCNT(j)  (256  + 64 * (j))
#define XB_XSUB(j)  (1280 + 64 * (j))
#define XB_XGEN(j)  (2304 + 64 * (j))
#define XB_TOP      3328
#define XB_TOPGEN   3392
#define XCD_BAR_WORDS 3456
#define XB_SPIN_CAP (1u << 18)

__device__ __forceinline__ unsigned xb_ld(unsigned* p)              { return __hip_atomic_load(p, __ATOMIC_RELAXED, __HIP_MEMORY_SCOPE_AGENT); }
__device__ __forceinline__ unsigned xb_add(unsigned* p, unsigned v) { return __hip_atomic_fetch_add(p, v, __ATOMIC_RELAXED, __HIP_MEMORY_SCOPE_AGENT); }
__device__ __forceinline__ unsigned xb_xcc_id() { return (unsigned)__builtin_amdgcn_s_getreg((3 << 11) | 20) & 0xFu; }
#define XB_SPIN(cond, bar) do { unsigned _sp = 0; while (cond) { __builtin_amdgcn_s_sleep(1); \
    if ((++_sp & 255u) == 0u) { if (xb_ld(&(bar)[XB_TMO])) break; if (_sp > XB_SPIN_CAP) { atomicAdd(&(bar)[XB_TMO], 1u); break; } } } } while (0)

struct XcdBarrier {
    unsigned* bar; unsigned x;
    volatile LAS unsigned* st;
};

__device__ __forceinline__ XcdBarrier xcd_barrier_post(unsigned* bar, volatile LAS unsigned* st) {
    XcdBarrier b; b.bar = bar; b.x = xb_xcc_id(); b.st = st;
    if (threadIdx.x == 0) (void)xb_add(&bar[XB_XCNT(b.x)], 1u);
    return b;
}
__device__ __forceinline__ void xcd_barrier_complete(unsigned* bar, unsigned x, unsigned& nloc, unsigned& nx) {
    const unsigned G = gridDim.x * gridDim.y * gridDim.z;
    unsigned sum, cnt, mine, sp = 0u;
    for (;;) {
        sum = 0u; cnt = 0u; mine = 0u;
#pragma unroll
        for (unsigned j = 0; j < 16; ++j) { const unsigned c = xb_ld(&bar[XB_XCNT(j)]); sum += c; cnt += (c > 0u) ? 1u : 0u; mine = (j == x) ? c : mine; }
        if (sum == G) break;
        __builtin_amdgcn_s_sleep(1);
        if ((++sp & 255u) == 0u) { if (xb_ld(&bar[XB_TMO])) break; if (sp > XB_SPIN_CAP) { atomicAdd(&bar[XB_TMO], 1u); break; } }
    }
    nloc = mine > 0u ? mine : 1u; nx = cnt > 0u ? cnt : 1u;
}

__device__ __forceinline__ void xcd_barrier(const XcdBarrier& b) {
    asm volatile("s_waitcnt vmcnt(0)" ::: "memory");
    __syncthreads();
    if (threadIdx.x == 0) {
        unsigned* bar = b.bar;
        __builtin_amdgcn_s_waitcnt(0);
        unsigned nloc = b.st[0], nx = b.st[1];
        if (nloc == 0u) { xcd_barrier_complete(bar, b.x, nloc, nx); b.st[0] = nloc; b.st[1] = nx; }
        const unsigned old = xb_add(&bar[XB_XSUB(b.x)], 1u);
        const unsigned gen = old / nloc;
        if (old + 1u == (gen + 1u) * nloc) {
            __builtin_amdgcn_fence(__ATOMIC_RELEASE, "agent");
            asm volatile("s_waitcnt vmcnt(0)" ::: "memory");
            const unsigned og = xb_add(&bar[XB_TOP], 1u);
            const unsigned tg = og / nx;
            if (og + 1u == (tg + 1u) * nx) xb_add(&bar[XB_TOPGEN], 1u);
            else XB_SPIN(xb_ld(&bar[XB_TOPGEN]) == tg, bar);
            __builtin_amdgcn_fence(__ATOMIC_ACQUIRE, "agent");
            xb_add(&bar[XB_XGEN(b.x)], 1u);
            asm volatile("s_waitcnt vmcnt(0)" ::: "memory");
        } else {
            XB_SPIN(xb_ld(&bar[XB_XGEN(b.x)]) == gen, bar);
            __builtin_amdgcn_fence(__ATOMIC_ACQUIRE, "agent");
            asm volatile("s_waitcnt vmcnt(0)" ::: "memory");
        }
    }
    __syncthreads();
}
constexpr int NB = 4, SEQ = 8192, DM = 1024, T = NB * SEQ;
constexpr int NH = 8, HD = 64, CW = 512;
constexpr int N_IN = 5120;
constexpr int NLAYER = 2;
constexpr int NEXP = 32, DEXP = 512;
constexpr int MOE_ROWS = 73728, MOE_PANELS = MOE_ROWS / 256;
constexpr int WCAT_ROWS = 5888;
constexpr int LO_W = 768;

constexpr size_t MiB = 1u << 20;
constexpr size_t WS_CTL = 0, CTL_ZERO_BYTES = 1 * MiB;
constexpr size_t WS_VF   = 1 * MiB;
constexpr size_t WS_TAB  = 33 * MiB;
constexpr size_t WS_WM   = 34 * MiB;
constexpr size_t WS_XN   = 50 * MiB;
constexpr size_t WS_RW   = 114 * MiB;
constexpr size_t WS_MO   = 178 * MiB;
constexpr size_t WS_LO   = 210 * MiB;
constexpr size_t WS_YRM  = 114 * MiB;
constexpr int YRM_LD = 1024;
constexpr size_t WS_SIR  = 258 * MiB;
constexpr size_t WS_SIK  = 322 * MiB;
constexpr size_t WS_SCRW = 290 * MiB, WS_SCRA = 306 * MiB, WS_SCRB = 546 * MiB;
constexpr size_t WS_V1   = 418 * MiB;
constexpr size_t WS_G    = 450 * MiB;
constexpr size_t WS_YS   = 482 * MiB;
constexpr size_t WS_PO   = 418 * MiB;
constexpr size_t WS_PST  = 274 * MiB;
constexpr size_t WS_GA   = 418 * MiB;
constexpr size_t WS_H    = 50 * MiB;
constexpr size_t WS_SC1  = 482 * MiB;
constexpr size_t WS_SC2  = 354 * MiB;
constexpr size_t WS_SCT  = 290 * MiB;
constexpr size_t WS_WE   = 290 * MiB;
constexpr size_t WS_WD   = 354 * MiB;
constexpr size_t WS_AM   = 130 * MiB;
constexpr size_t WS_HM   = 194 * MiB;
constexpr size_t WS_YE   = 386 * MiB;
constexpr size_t WS_RT   = 546 * MiB;
constexpr size_t WS_END  = 556 * MiB;
constexpr size_t TB_KMEAN = 0;
constexpr size_t TB_KMEAN2 = 256 * 1024;
constexpr size_t TB_SEL   = 256 * 1024;
constexpr size_t RT_EID  = 0;
constexpr size_t RT_GATE = 256 * 1024;
constexpr size_t RT_ROW  = 512 * 1024;
constexpr size_t RT_GW   = 768 * 1024;
constexpr size_t RT_HIST = 1280 * 1024;
constexpr size_t RT_PEXP = 1408 * 1024;
constexpr size_t RT_TOK  = 1536 * 1024;
constexpr size_t RT_RSQ  = 2048 * 1024;
constexpr size_t RT_RSR  = 2304 * 1024;
constexpr size_t WS_SEL  = 562 * MiB;
constexpr size_t WS_NEED = 564 * MiB;
constexpr int CW_BAR = 4096;

constexpr int RING_BYTES = 131072;
constexpr int LDS_BYTES = 163840;
constexpr int MISC_OFF = LDS_BYTES - 256;
struct Frame {
    LAS unsigned char* lds;
    int tid, lane, wave;
    int G, bid;
    const __attribute__((address_space(4))) unsigned char* ka;
    GAS float* out_g; GAS unsigned char* ws_g;
    DI float* outp() const { return (float*)out_g; }
    DI unsigned char* wsp() const { return (unsigned char*)ws_g; }
    DI const float* inp(int i) const { return (const float*)(*(const GAS float* const __attribute__((address_space(4)))*)(ka + 8 * i)); }
};
#define LDS_WAIT() asm volatile("s_waitcnt lgkmcnt(0)" ::: "memory")

DI void tr_item(const float* src, int ld, int k0, bf16_t* dst, int Kd, const float* sc, int mode, LAS float* scr, int lane) {
#pragma unroll 8
    for (int i = 0; i < 32; ++i) { const int kk = 2 * i + (lane >> 5);
        float v = src ? src[(size_t)(k0 + kk) * ld + (lane & 31)] : 0.f;
        if (mode == 1) v *= sc[k0 + kk]; else if (mode == 2) v *= (1.f - sc[k0 + kk]);
        scr[kk * 33 + (lane & 31)] = v; }
    LDS_WAIT(); asm volatile("" ::: "memory");
    const int c = lane & 7;
#pragma unroll
    for (int j = 0; j < 4; ++j) { const int n = (lane >> 3) + 8 * j; const LAS float* s = scr + (8 * c) * 33 + n;
        u32x4 o; o.x = pk2(s[0 * 33], s[1 * 33]); o.y = pk2(s[2 * 33], s[3 * 33]); o.z = pk2(s[4 * 33], s[5 * 33]); o.w = pk2(s[6 * 33], s[7 * 33]);
        *(u32x4*)(dst + (size_t)n * Kd + k0 + 8 * c) = o; }
    LDS_WAIT(); asm volatile("" ::: "memory");
}

constexpr size_t WM_WCAT = 0, WM_BRR = (size_t)WCAT_ROWS * 1024 * 2, WM_BRM = WM_BRR + 1024 * 512 * 2, WM_OUT = WM_BRM + 1024 * 512 * 2;
DI void phase_conv_mixer(Frame& F, int l) {
    LAS float* scr = (LAS float*)(F.lds + F.wave * 16384);
    const int gw = F.bid * 8 + F.wave, NGW = F.G * 8;
    bf16_t* wcat = (bf16_t*)(F.wsp() + WS_WM + WM_WCAT);
    const float* w_in = F.inp(3) + (size_t)l * DM * N_IN;
    const float* mu_x = F.inp(5) + (size_t)l * 3 * DM;
    constexpr int NBLK = WCAT_ROWS / 32;
    constexpr int I_CAT = NBLK * 16, I_BR = 8 * 32, I_OUT = 16 * 32;
    for (int it = gw; it < I_CAT + 2 * I_BR + I_OUT; it += NGW) {
        int r = it;
        if (r < I_CAT) {
            const int nb = r / 16, kb = r % 16, k0 = kb * 64;
            if (nb < 48) { tr_item(w_in + 32 * nb, N_IN, k0, wcat + (size_t)(32 * nb) * 1024, 1024, nullptr, 0, scr, F.lane); }
            else if (nb < 72) {
                const int q = nb - 48; const float* src = nullptr; int ld = 0; const float* sc = nullptr; int mode = 0;
                if (q < 4)       { src = F.inp(7)  + (size_t)l * DM * 64  + 32 * (q & 1); ld = 64;  sc = mu_x;          mode = (q < 2) ? 2 : 1; }
                else if (q < 8)  { src = F.inp(10) + (size_t)l * DM * 64  + 32 * (q & 1); ld = 64;  sc = mu_x + DM;     mode = (q < 6) ? 2 : 1; }
                else if (q < 16) { src = F.inp(12) + (size_t)l * DM * 128 + 32 * (q & 3); ld = 128; sc = mu_x + 2 * DM; mode = (q < 12) ? 2 : 1; }
                else if (q < 18 && l > 0) { src = F.inp(21) + (size_t)(l - 1) * DM * 32; ld = 32; sc = F.inp(19) + (size_t)(l - 1) * DM; mode = (q == 16) ? 2 : 1; }
                tr_item(src, ld, k0, wcat + (size_t)(1536 + 32 * q) * 1024, 1024, sc, mode, scr, F.lane);
            }
            else if (nb < 120) { tr_item(w_in + 1536 + 32 * (nb - 72), N_IN, k0, wcat + (size_t)(2304 + 32 * (nb - 72)) * 1024, 1024, nullptr, 0, scr, F.lane); }
            else { tr_item(w_in + 3072 + 32 * (nb - 120), N_IN, k0, wcat + (size_t)(3840 + 32 * (nb - 120)) * 1024, 1024, nullptr, 0, scr, F.lane); }
            continue;
        }
        r -= I_CAT;
        if (r < I_BR) { const int nb = r / 8, kb = r % 8; tr_item(F.inp(26) + (size_t)l * 512 * 1024 + 32 * nb, 1024, kb * 64, (bf16_t*)(F.wsp() + WS_WM + WM_BRR) + (size_t)(32 * nb) * 1024, 1024, nullptr, 0, scr, F.lane); continue; }
        r -= I_BR;
        if (r < I_BR) { const int nb = r / 8, kb = r % 8; tr_item(F.inp(27) + (size_t)l * 512 * 1024 + 32 * nb, 1024, kb * 64, (bf16_t*)(F.wsp() + WS_WM + WM_BRR) + (size_t)(32 * nb) * 1024 + 512, 1024, nullptr, 0, scr, F.lane); continue; }
        r -= I_BR;
        { const int nb = r / 16, kb = r % 16; tr_item(F.inp(28) + (size_t)l * 1024 * 1024 + 32 * nb, 1024, kb * 64, (bf16_t*)(F.wsp() + WS_WM + WM_OUT) + (size_t)(32 * nb) * 1024, 1024, nullptr, 0, scr, F.lane); }
    }
}
struct ConvItem { const float* src; int ld, k0, n0, Kd, mode; bf16_t* dst; };
DI ConvItem conv_item(int it, const float* wg, const float* wu, const float* wdn, bf16_t* we, bf16_t* wd) {
    ConvItem c; const int e = it / 96; int r = it % 96;
    if (r < 64) { const int up = r >> 5; r &= 31; c.src = (up ? wu : wg) + (size_t)e * DM * DEXP; c.ld = DEXP; c.k0 = (r >> 1) * 64; c.n0 = (r & 1) * 256; c.dst = we + (size_t)e * 1024 * 1024; c.Kd = 1024; c.mode = up; }
    else { r -= 64; c.src = wdn + (size_t)e * DEXP * DM; c.ld = DM; c.k0 = (r >> 2) * 64; c.n0 = (r & 3) * 256; c.dst = wd + (size_t)e * 1024 * 512; c.Kd = 512; c.mode = 2; }
    return c;
}
DI void conv_load(const ConvItem& c, f32x4 (&v)[8], int tid) {
#pragma unroll
    for (int i = 0; i < 8; ++i) { const int idx = tid + 512 * i, row = idx >> 6, c4 = idx & 63; v[i] = *(const f32x4*)(c.src + (size_t)(c.k0 + row) * c.ld + c.n0 + 4 * c4); }
}
DI void conv_store(const ConvItem& c, const f32x4 (&v)[8], LAS float* scr, int tid) {
#pragma unroll
    for (int i = 0; i < 8; ++i) { const int idx = tid + 512 * i, row = idx >> 6, c4 = idx & 63; LAS float* d = scr + row * 257 + 4 * c4; d[0] = v[i].x; d[1] = v[i].y; d[2] = v[i].z; d[3] = v[i].w; }
    __syncthreads();
#pragma unroll
    for (int i = 0; i < 4; ++i) { const int idx = tid + 512 * i, n = idx >> 3, cc = idx & 7; const LAS float* sp = scr + (8 * cc) * 257 + n;
        u32x4 o; o.x = pk2(sp[0], sp[257]); o.y = pk2(sp[2 * 257], sp[3 * 257]); o.z = pk2(sp[4 * 257], sp[5 * 257]); o.w = pk2(sp[6 * 257], sp[7 * 257]);
        const int h = c.n0 + n; const int drow = (c.mode == 2) ? h : ((h >> 7) * 256 + c.mode * 128 + (h & 127));
        *(u32x4*)(c.dst + (size_t)drow * c.Kd + c.k0 + 8 * cc) = o; }
    __syncthreads();
}
constexpr int CONV_ITEMS = NEXP * 96, CONV_GROUP = 8, CONV_UNITS = CONV_ITEMS / CONV_GROUP;
DI void conv_experts_items(Frame& F, int l, int it_lo, int it_hi, int it_step) {
    LAS float* scr = (LAS float*)F.lds;
    bf16_t* we = (bf16_t*)(F.wsp() + WS_WE); bf16_t* wd = (bf16_t*)(F.wsp() + WS_WD);
    const float* wg = F.inp(33) + (size_t)l * NEXP * DM * DEXP; const float* wu = F.inp(34) + (size_t)l * NEXP * DM * DEXP; const float* wdn = F.inp(35) + (size_t)l * NEXP * DEXP * DM;
    __syncthreads();
    if (it_lo >= it_hi) return;
    f32x4 cur[8], nxt[8];
    ConvItem ci = conv_item(it_lo, wg, wu, wdn, we, wd); conv_load(ci, cur, F.tid);
    for (int it = it_lo; it < it_hi; it += it_step) {
        const bool more = it + it_step < it_hi; ConvItem cn = ci;
        if (more) { cn = conv_item(it + it_step, wg, wu, wdn, we, wd); conv_load(cn, nxt, F.tid); }
        conv_store(ci, cur, scr, F.tid);
        if (more) {
#pragma unroll
            for (int i = 0; i < 8; ++i) cur[i] = nxt[i];
            ci = cn; }
    }
}
DI void rms_row_to_bf16(const float* xrow, const float* gain, bf16_t* o0, bf16_t* o1, int lane) {
    const f32x4* xr = (const f32x4*)xrow + lane; const f32x4* gr = (const f32x4*)gain + lane;
    f32x4 v[4]; float s = 0.f;
#pragma unroll
    for (int j = 0; j < 4; ++j) { v[j] = xr[64 * j]; s += (v[j].x * v[j].x + v[j].y * v[j].y) + (v[j].z * v[j].z + v[j].w * v[j].w); }
    const float rs = 1.0f / sqrtf(wave_sum(s) * (1.f / DM) + 1e-6f);
#pragma unroll
    for (int j = 0; j < 4; ++j) { const f32x4 g = gr[64 * j]; const f32x4 y = v[j] * rs * g;
        u32x2 w; w.x = pk2(y.x, y.y); w.y = pk2(y.z, y.w);
        *((u32x2*)o0 + lane + 64 * j) = w; if (o1) *((u32x2*)o1 + lane + 64 * j) = w; }
}
DI void phase_norm_x(Frame& F, const float* x, const float* gain) {
    const int gw = F.bid * 8 + F.wave, NGW = F.G * 8; bf16_t* xn = (bf16_t*)(F.wsp() + WS_XN);
    for (int m = gw; m < T; m += NGW) rms_row_to_bf16(x + (size_t)m * DM, gain, xn + (size_t)m * DM, nullptr, F.lane);
}

namespace pg8 {
struct EpiStore {
    static constexpr bool PERM = true, HAS_MID = false, HEADS = false;
    bf16_t* O; int ldc; int split; bf16_t* O2; int ldc2; int act;
    __device__ __forceinline__ void operator()(const f32x4 (&acc)[2][2][4][2], const Unit& u, int wr, int wc, int fr, int fq) const {
        const int row0 = u.pm * BM + wr * 64 + fr; int colt = u.pn * BM; bf16_t* base = O; int ld = ldc;
        if (split && colt >= split) { base = O2; ld = ldc2; colt -= split; }
        const int col0 = colt + wc * 32 + 8 * fq;
#pragma unroll
        for (int ai = 0; ai < 2; ++ai)
#pragma unroll
            for (int m = 0; m < 4; ++m) { bf16_t* rowp = base + (size_t)(row0 + ai * HALF + m * 16) * ld + col0;
#pragma unroll
                for (int bj = 0; bj < 2; ++bj) { f32x4 v0 = acc[ai][bj][m][0], v1 = acc[ai][bj][m][1];
                    if (act == 1) {
#pragma unroll
                        for (int j = 0; j < 4; ++j) { v0[j] = sigmoidf_(v0[j]); v1[j] = sigmoidf_(v1[j]); } }
                    u32x4 w; w.x = pk2(v0[0], v0[1]); w.y = pk2(v0[2], v0[3]); w.z = pk2(v1[0], v1[1]); w.w = pk2(v1[2], v1[3]);
                    *(u32x4*)(rowp + bj * HALF) = w; } }
    }
};
struct EpiBranch {
    static constexpr bool PERM = true, HAS_MID = false, HEADS = false;
    bf16_t* Hout; const bf16_t* gate; int gcol0; int first;
    __device__ __forceinline__ void operator()(const f32x4 (&acc)[2][2][4][2], const Unit& u, int wr, int wc, int fr, int fq) const {
        const int row0 = u.pm * BM + wr * 64 + fr; const int col0 = u.pn * BM + wc * 32 + 8 * fq;
#pragma unroll
        for (int ai = 0; ai < 2; ++ai)
#pragma unroll
            for (int m = 0; m < 4; ++m) { const size_t row = (size_t)(row0 + ai * HALF + m * 16);
#pragma unroll
                for (int bj = 0; bj < 2; ++bj) {
                    const u32x4 gv = *(const u32x4*)(gate + row * 2048 + gcol0 + col0 + bj * HALF);
                    bf16_t* hp = Hout + row * 1024 + col0 + bj * HALF;
                    f32x4 v0 = acc[ai][bj][m][0], v1 = acc[ai][bj][m][1];
                    v0[0] *= bflo(gv.x); v0[1] *= bfhi(gv.x); v0[2] *= bflo(gv.y); v0[3] *= bfhi(gv.y);
                    v1[0] *= bflo(gv.z); v1[1] *= bfhi(gv.z); v1[2] *= bflo(gv.w); v1[3] *= bfhi(gv.w);
                    if (!first) { const u32x4 hv = *(const u32x4*)hp;
                        v0[0] += bflo(hv.x); v0[1] += bfhi(hv.x); v0[2] += bflo(hv.y); v0[3] += bfhi(hv.y);
                        v1[0] += bflo(hv.z); v1[1] += bfhi(hv.z); v1[2] += bflo(hv.w); v1[3] += bfhi(hv.w); }
                    u32x4 w; w.x = pk2(v0[0], v0[1]); w.y = pk2(v0[2], v0[3]); w.z = pk2(v1[0], v1[1]); w.w = pk2(v1[2], v1[3]);
                    *(u32x4*)hp = w; } }
    }
};
struct EpiBranch2 {
    static constexpr bool PERM = true, HAS_MID = true, HEADS = false;
    bf16_t* Hout; const bf16_t* gate;
    __device__ __forceinline__ void mid(f32x4 (&acc)[2][2][4][2], const Unit& u, int wr, int wc, int fr_, int fq_) const {
        int fr = fr_, fq = fq_; asm volatile("" : "+v"(fr), "+v"(fq));
        const int row0 = u.pm * BM + wr * 64 + fr; const int col0 = u.pn * BM + wc * 32 + 8 * fq;
#pragma unroll
        for (int ai = 0; ai < 2; ++ai)
#pragma unroll
            for (int m = 0; m < 4; ++m) { const size_t row = (size_t)(row0 + ai * HALF + m * 16);
#pragma unroll
                for (int bj = 0; bj < 2; ++bj) {
                    const u32x4 gr = *(const u32x4*)(gate + row * 2048 + col0 + bj * HALF), gm = *(const u32x4*)(gate + row * 2048 + 1024 + col0 + bj * HALF);
                    const unsigned grw[4] = {gr.x, gr.y, gr.z, gr.w}, gmw[4] = {gm.x, gm.y, gm.z, gm.w};
#pragma unroll
                    for (int q = 0; q < 4; ++q) { const float r0 = bflo(grw[q]) * __builtin_amdgcn_rcpf(fmaxf(bflo(gmw[q]), 1e-30f)), r1 = bfhi(grw[q]) * __builtin_amdgcn_rcpf(fmaxf(bfhi(gmw[q]), 1e-30f));
                        acc[ai][bj][m][q >> 1][2 * (q & 1)] *= r0; acc[ai][bj][m][q >> 1][2 * (q & 1) + 1] *= r1; } }
                asm volatile("" ::: "memory"); }
    }
    __device__ __forceinline__ void operator()(const f32x4 (&acc)[2][2][4][2], const Unit& u, int wr, int wc, int fr, int fq) const {
        const int row0 = u.pm * BM + wr * 64 + fr; const int col0 = u.pn * BM + wc * 32 + 8 * fq;
#pragma unroll
        for (int ai = 0; ai < 2; ++ai)
#pragma unroll
            for (int m = 0; m < 4; ++m) { const size_t row = (size_t)(row0 + ai * HALF + m * 16);
#pragma unroll
                for (int bj = 0; bj < 2; ++bj) {
                    const u32x4 gm = *(const u32x4*)(gate + row * 2048 + 1024 + col0 + bj * HALF);
                    f32x4 v0 = acc[ai][bj][m][0], v1 = acc[ai][bj][m][1];
                    v0[0] *= fmaxf(bflo(gm.x), 1e-30f); v0[1] *= fmaxf(bfhi(gm.x), 1e-30f); v0[2] *= fmaxf(bflo(gm.y), 1e-30f); v0[3] *= fmaxf(bfhi(gm.y), 1e-30f);
                    v1[0] *= fmaxf(bflo(gm.z), 1e-30f); v1[1] *= fmaxf(bfhi(gm.z), 1e-30f); v1[2] *= fmaxf(bflo(gm.w), 1e-30f); v1[3] *= fmaxf(bfhi(gm.w), 1e-30f);
                    u32x4 w; w.x = pk2(v0[0], v0[1]); w.y = pk2(v0[2], v0[3]); w.z = pk2(v1[0], v1[1]); w.w = pk2(v1[2], v1[3]);
                    *(u32x4*)(Hout + row * 1024 + col0 + bj * HALF) = w; } }
    }
};
struct EpiMoba {
    static constexpr bool PERM = true, HAS_MID = false, HEADS = true;
    bf16_t* MO; const float* qgain; const float* kgain; float* KM; int km_half;
    __device__ __forceinline__ void operator()(const f32x4 (&acc)[2][2][4][2], const Unit& u, int wr, int wc, int fr, int fq) const {
        const int row0 = u.pm * BM + wr * 64 + fr; const int kind = u.pn >> 1; const int colb = u.pn * BM + 64 * wc + 8 * fq;
        if (kind == 2) {
#pragma unroll
            for (int ai = 0; ai < 2; ++ai)
#pragma unroll
                for (int m = 0; m < 4; ++m) { bf16_t* rowp = MO + (size_t)(row0 + ai * HALF + m * 16) * 1536 + colb;
#pragma unroll
                    for (int bj = 0; bj < 2; ++bj) { const f32x4 v0 = acc[ai][bj][m][0], v1 = acc[ai][bj][m][1];
                        u32x4 w; w.x = pk2(v0[0], v0[1]); w.y = pk2(v0[2], v0[3]); w.z = pk2(v1[0], v1[1]); w.w = pk2(v1[2], v1[3]); *(u32x4*)(rowp + 32 * bj) = w; } }
            return;
        }
        const float* gp = (kind == 0 ? qgain : kgain) + 8 * fq; const float gs = (kind == 0) ? 0.125f : 1.0f;
        f32x4 gn[2][2];
#pragma unroll
        for (int bj = 0; bj < 2; ++bj)
#pragma unroll
            for (int n = 0; n < 2; ++n) gn[bj][n] = *(const f32x4*)(gp + 32 * bj + 4 * n) * gs;
        f32x4 cs[2][2];
#pragma unroll
        for (int bj = 0; bj < 2; ++bj)
#pragma unroll
            for (int n = 0; n < 2; ++n) cs[bj][n] = (f32x4){0.f, 0.f, 0.f, 0.f};
#pragma unroll
        for (int ai = 0; ai < 2; ++ai)
#pragma unroll
            for (int m = 0; m < 4; ++m) { float ss = 0.f;
#pragma unroll
                for (int bj = 0; bj < 2; ++bj)
#pragma unroll
                    for (int n = 0; n < 2; ++n) { const f32x4 x = acc[ai][bj][m][n]; ss += (x[0] * x[0] + x[1] * x[1]) + (x[2] * x[2] + x[3] * x[3]); }
                ss += __shfl_xor(ss, 16); ss += __shfl_xor(ss, 32);
                const float rs = __builtin_amdgcn_rsqf(ss * (1.f / 64.f) + 1e-6f);
                bf16_t* rowp = MO + (size_t)(row0 + ai * HALF + m * 16) * 1536 + colb;
#pragma unroll
                for (int bj = 0; bj < 2; ++bj) { const f32x4 v0 = acc[ai][bj][m][0] * rs * gn[bj][0], v1 = acc[ai][bj][m][1] * rs * gn[bj][1];
                    cs[bj][0] += v0; cs[bj][1] += v1;
                    u32x4 w; w.x = pk2(v0[0], v0[1]); w.y = pk2(v0[2], v0[3]); w.z = pk2(v1[0], v1[1]); w.w = pk2(v1[2], v1[3]); *(u32x4*)(rowp + 32 * bj) = w; }
                asm volatile("" : "+v"(cs[0][0]), "+v"(cs[0][1]), "+v"(cs[1][0]), "+v"(cs[1][1]));
            }
        if (kind == 1) {
#pragma unroll
            for (int bj = 0; bj < 2; ++bj)
#pragma unroll
                for (int n = 0; n < 2; ++n) { f32x4 t = cs[bj][n];
#pragma unroll
                    for (int j = 0; j < 4; ++j) { float v = t[j]; v += dpp_mov<0xB1>(v); v += dpp_mov<0x4E>(v); v += dpp_mov<0x141>(v); v += dpp_mov<0x140>(v); t[j] = v * (1.f / 256.f); }
                    if (fr == 0) *(f32x4*)(KM + (size_t)wr * km_half + (size_t)u.pm * 512 + (u.pn * BM - 512) + 64 * wc + 32 * bj + 8 * fq + 4 * n) = t; }
        }
    }
};
struct EpiResid {
    static constexpr bool PERM = false, HAS_MID = false, HEADS = false;
    const float* xin; float* out;
    __device__ __forceinline__ void operator()(const f32x4 (&acc)[2][2][4][2], const Unit& u, int wr, int wc, int fr, int fq) const {
        const int row0 = u.pm * BM + wr * 64 + fr, col0 = u.pn * BM + wc * 32 + 4 * fq;
#pragma unroll
        for (int ai = 0; ai < 2; ++ai)
#pragma unroll
            for (int m = 0; m < 4; ++m) { const size_t off = (size_t)(row0 + ai * HALF + m * 16) * 1024 + col0;
#pragma unroll
                for (int bj = 0; bj < 2; ++bj)
#pragma unroll
                    for (int n = 0; n < 2; ++n) { const f32x4 xv = *(const f32x4*)(xin + off + bj * HALF + n * 16); *(f32x4*)(out + off + bj * HALF + n * 16) = xv + acc[ai][bj][m][n]; } }
    }
};
struct EpiExpertUp {
    static constexpr bool PERM = true, HAS_MID = false, HEADS = false;
    bf16_t* HM; const float* gw; const float* rsr;
    __device__ __forceinline__ void operator()(const f32x4 (&acc)[2][2][4][2], const Unit& u, int wr, int wc, int fr, int fq) const {
        const int row0 = u.pm * BM + wr * 64 + fr; const int col0 = u.pn * 128 + wc * 32 + 8 * fq;
#pragma unroll
        for (int ai = 0; ai < 2; ++ai)
#pragma unroll
            for (int m = 0; m < 4; ++m) { const size_t row = (size_t)(row0 + ai * HALF + m * 16); const float rs = rsr[row]; const float gwt = gw[row] * rs;
                f32x4 v0, v1;
#pragma unroll
                for (int j = 0; j < 4; ++j) { const float g0 = acc[ai][0][m][0][j] * rs, g1 = acc[ai][0][m][1][j] * rs;
                    v0[j] = g0 * sigmoidf_(g0) * acc[ai][1][m][0][j] * gwt; v1[j] = g1 * sigmoidf_(g1) * acc[ai][1][m][1][j] * gwt; }
                u32x4 w; w.x = pk2(v0[0], v0[1]); w.y = pk2(v0[2], v0[3]); w.z = pk2(v1[0], v1[1]); w.w = pk2(v1[2], v1[3]);
                *(u32x4*)(HM + row * 512 + col0) = w; }
    }
};
}
constexpr size_t SI_PLANE = (size_t)T * CW * 2;
DI float softplusf_(float z) { return fmaxf(z, 0.f) + __logf(1.0f + __expf(-fabsf(z))); }

#ifndef PREP_DUP
#define PREP_DUP 0
#endif
constexpr int ACT_P = 592;
constexpr size_t WM_L2T = (size_t)WCAT_ROWS * 1024 * 2 + 2 * 1024 * 512 * 2 + 1024 * 1024 * 2;
DI void phase_conv_lora2(Frame& F, int l) {
    bf16_t* L2T = (bf16_t*)(F.wsp() + WS_WM + WM_L2T);
    const float* w2 = F.inp(8) + (size_t)l * 64 * CW; const float* a2 = F.inp(11) + (size_t)l * 64 * CW; const float* g2 = F.inp(13) + (size_t)l * 128 * CW; const float* v2 = F.inp(22);
    for (int idx = F.bid * 512 + F.tid; idx < 288 * CW; idx += F.G * 512) { const int j = idx >> 9, c = idx & 511;
        float v;
        if (j < 64) v = w2[j * CW + c]; else if (j < 128) v = a2[(j - 64) * CW + c]; else if (j < 256) v = g2[(j - 128) * CW + c]; else v = (l > 0) ? v2[(j - 256) * CW + c] : 0.f;
        L2T[c * 288 + j] = f2bf(v); }
}
DI float row16_sum(float v) { v += dpp_mov<0xB1>(v); v += dpp_mov<0x4E>(v); v += dpp_mov<0x141>(v); v += dpp_mov<0x140>(v); return v; }
DI void phase_rwkv_prep2(Frame& F, int l, int tile_lo, int tile_hi, int tile_step, bool init) {
    LAS unsigned char* act = F.lds;
    LAS float* PRM = (LAS float*)(F.lds + 139264);
    const bf16_t* RW = (const bf16_t*)(F.wsp() + WS_RW); const bf16_t* LO = (const bf16_t*)(F.wsp() + WS_LO); const unsigned char* L2T = F.wsp() + WS_WM + WM_L2T;
    bf16_t* SIr = (bf16_t*)(F.wsp() + WS_SIR); bf16_t* SIk = (bf16_t*)(F.wsp() + WS_SIK);
    bf16_t* SCw = (bf16_t*)(F.wsp() + WS_SCRW) + (size_t)F.bid * 64 * CW; bf16_t* SCa = (bf16_t*)(F.wsp() + WS_SCRA) + (size_t)F.bid * 64 * CW; bf16_t* SCb = (bf16_t*)(F.wsp() + WS_SCRB) + (size_t)F.bid * 64 * CW;
    bf16_t* VF = (bf16_t*)(F.wsp() + WS_VF); bf16_t* V1 = (bf16_t*)(F.wsp() + WS_V1); bf16_t* Gb = (bf16_t*)(F.wsp() + WS_G);
    const int lane = F.lane, r16 = lane & 15, g = lane >> 4;
    if (init) { __syncthreads();
      const int c = F.tid;
      PRM[c] = F.inp(4)[(size_t)l * 3 * CW + c]; PRM[512 + c] = F.inp(4)[(size_t)l * 3 * CW + CW + c]; PRM[1024 + c] = F.inp(4)[(size_t)l * 3 * CW + 2 * CW + c];
      PRM[1536 + c] = F.inp(6)[l * CW + c]; PRM[2048 + c] = F.inp(9)[l * CW + c]; PRM[2560 + c] = F.inp(14)[l * CW + c]; PRM[3072 + c] = F.inp(15)[l * CW + c]; PRM[3584 + c] = l > 0 ? F.inp(20)[c] : 0.f; }
    for (int tile = tile_lo; tile < tile_hi; tile += tile_step) {
        int t0 = tile * 64; asm volatile("" : "+s"(t0));
        __syncthreads();
        for (int dup1_ = 0; dup1_ < ((PREP_DUP & 1) ? 2 : 1); ++dup1_)
        for (int grp = F.tid; grp < 64 * 36; grp += 512) { const int tt = grp / 36, jg = grp - tt * 36, j0 = 8 * jg; const int t = t0 + tt; const bool has_prev = (t % SEQ) != 0;
            int pj, qj; if (j0 < 64) { pj = j0; qj = 64 + j0; } else if (j0 < 128) { pj = 128 + (j0 - 64); qj = 192 + (j0 - 64); } else if (j0 < 256) { pj = 256 + (j0 - 128); qj = 384 + (j0 - 128); } else { pj = 512 + (j0 - 256); qj = 544 + (j0 - 256); }
            const u32x4 pv = *(const u32x4*)(LO + (size_t)t * LO_W + pj); u32x4 qv = {0u, 0u, 0u, 0u}; if (has_prev) qv = *(const u32x4*)(LO + (size_t)(t - 1) * LO_W + qj);
            const unsigned pw[4] = {pv.x, pv.y, pv.z, pv.w}, qw[4] = {qv.x, qv.y, qv.z, qv.w}; float v[8];
#pragma unroll
            for (int q = 0; q < 4; ++q) { v[2 * q] = bflo(pw[q]) + bflo(qw[q]); v[2 * q + 1] = bfhi(pw[q]) + bfhi(qw[q]); }
            if (j0 < 64) {
#pragma unroll
                for (int e = 0; e < 8; ++e) v[e] = 1.0f - 2.0f * __builtin_amdgcn_rcpf(1.0f + __expf(2.0f * v[e]));
            } else if (j0 >= 128 && j0 < 256) {
#pragma unroll
                for (int e = 0; e < 8; ++e) v[e] = sigmoidf_(v[e]);
            }
            u32x4 w; w.x = pk2(v[0], v[1]); w.y = pk2(v[2], v[3]); w.z = pk2(v[4], v[5]); w.w = pk2(v[6], v[7]);
            *(LAS u32x4*)(act + tt * ACT_P + j0 * 2) = w; }
        __syncthreads();
        float inv[4];
        for (int pd_ = 0; pd_ < ((PREP_DUP & 4) ? 2 : 1); ++pd_)
        { int cw = 64 * F.wave + 4 * g; asm volatile("" : "+v"(cw));
          u32x2 kc[4][4], kp_[4][4];
#pragma unroll
          for (int tt = 0; tt < 4; ++tt) { const int t = t0 + 16 * tt + r16; const bool has_prev = (t % SEQ) != 0; const size_t ro = (size_t)t * 1536;
#pragma unroll
              for (int ct = 0; ct < 4; ++ct) { kc[tt][ct] = *(const u32x2*)(RW + ro + 512 + cw + 16 * ct); kp_[tt][ct] = (u32x2){0u, 0u}; if (has_prev) kp_[tt][ct] = *(const u32x2*)(RW + ro - 1536 + 512 + cw + 16 * ct); } }
#pragma unroll
          for (int tt = 0; tt < 4; ++tt) { float ss = 0.f;
#pragma unroll
              for (int ct = 0; ct < 4; ++ct) { const f32x4 muk = *(const LAS f32x4*)(PRM + 512 + cw + 16 * ct), kkc = *(const LAS f32x4*)(PRM + 2560 + cw + 16 * ct);
                  const float k0 = bflo(kc[tt][ct].x), k1 = bfhi(kc[tt][ct].x), k2 = bflo(kc[tt][ct].y), k3 = bfhi(kc[tt][ct].y), q0 = bflo(kp_[tt][ct].x), q1 = bfhi(kp_[tt][ct].x), q2 = bflo(kp_[tt][ct].y), q3 = bfhi(kp_[tt][ct].y);
                  const float a0 = (k0 + (q0 - k0) * muk[0]) * kkc[0], a1 = (k1 + (q1 - k1) * muk[1]) * kkc[1], a2 = (k2 + (q2 - k2) * muk[2]) * kkc[2], a3 = (k3 + (q3 - k3) * muk[3]) * kkc[3];
                  ss += (a0 * a0 + a1 * a1) + (a2 * a2 + a3 * a3); }
              ss += __shfl_xor(ss, 16); ss += __shfl_xor(ss, 32);
              inv[tt] = __builtin_amdgcn_rsqf(fmaxf(ss, 1e-24f)); } }
#pragma unroll 1
        for (int ct8 = 0; ct8 < ((PREP_DUP & 8) ? 8 : 4); ++ct8) { const int ct = ct8 & 3;
            int cw = 64 * F.wave + 4 * g; asm volatile("" : "+v"(cw));
            const int c0 = cw + 16 * ct;
            bf16x8 wf[9];
            { const unsigned char* wrow = L2T + (size_t)(64 * F.wave + 16 * ct + r16) * 576 + 16 * g;
#pragma unroll
              for (int s = 0; s < 9; ++s) wf[s] = *(const bf16x8*)(wrow + 64 * s); }
            u32x2 cur[4][3], prv[4][3], vfl[4];
#pragma unroll
            for (int tt = 0; tt < 4; ++tt) { const int t = t0 + 16 * tt + r16; const bool has_prev = (t % SEQ) != 0; const size_t ro = (size_t)t * 1536;
#pragma unroll
                for (int p = 0; p < 3; ++p) { cur[tt][p] = *(const u32x2*)(RW + ro + 512 * p + c0); prv[tt][p] = (u32x2){0u, 0u}; if (has_prev) prv[tt][p] = *(const u32x2*)(RW + ro - 1536 + 512 * p + c0); }
                vfl[tt] = (u32x2){0u, 0u}; if (l > 0) vfl[tt] = *(const u32x2*)(VF + (size_t)t * CW + c0); }
            const f32x4 mur = *(const LAS f32x4*)(PRM + c0), muk = *(const LAS f32x4*)(PRM + 512 + c0), muv = *(const LAS f32x4*)(PRM + 1024 + c0), w0v = *(const LAS f32x4*)(PRM + 1536 + c0),
                        a0v = *(const LAS f32x4*)(PRM + 2048 + c0), kkc = *(const LAS f32x4*)(PRM + 2560 + c0), kac = *(const LAS f32x4*)(PRM + 3072 + c0), v0v = *(const LAS f32x4*)(PRM + 3584 + c0);
#pragma unroll
            for (int tt = 0; tt < 4; ++tt) {
                const int t = t0 + 16 * tt + r16; const size_t oo = (size_t)t * CW, os = (size_t)(16 * tt + r16) * CW;
                bf16x8 a[9];
#pragma unroll
                for (int s = 0; s < 9; ++s) a[s] = *(const LAS bf16x8*)(act + (16 * tt + r16) * ACT_P + (32 * s + 8 * g) * 2);
                f32x4 aw = {0.f, 0.f, 0.f, 0.f}, aa = {0.f, 0.f, 0.f, 0.f}, ag = {0.f, 0.f, 0.f, 0.f}, av = {0.f, 0.f, 0.f, 0.f};
                aw = mfma16(wf[0], a[0], aw); aw = mfma16(wf[1], a[1], aw);
                aa = mfma16(wf[2], a[2], aa); aa = mfma16(wf[3], a[3], aa);
                ag = mfma16(wf[4], a[4], ag); ag = mfma16(wf[5], a[5], ag); ag = mfma16(wf[6], a[6], ag); ag = mfma16(wf[7], a[7], ag);
                if (l > 0) av = mfma16(wf[8], a[8], av);
                float ro4[4], lw4[4], vo4[4], k2[4], ka[4], kb[4];
#pragma unroll
                for (int r = 0; r < 4; ++r) {
                    const unsigned cwd_r = (r < 2) ? cur[tt][0].x : cur[tt][0].y, cwd_k = (r < 2) ? cur[tt][1].x : cur[tt][1].y, cwd_v = (r < 2) ? cur[tt][2].x : cur[tt][2].y;
                    const unsigned pwd_r = (r < 2) ? prv[tt][0].x : prv[tt][0].y, pwd_k = (r < 2) ? prv[tt][1].x : prv[tt][1].y, pwd_v = (r < 2) ? prv[tt][2].x : prv[tt][2].y;
                    const unsigned vwd = (r < 2) ? vfl[tt].x : vfl[tt].y;
                    const float rp = (r & 1) ? bfhi(cwd_r) : bflo(cwd_r), kp = (r & 1) ? bfhi(cwd_k) : bflo(cwd_k), vp = (r & 1) ? bfhi(cwd_v) : bflo(cwd_v);
                    const float rq = (r & 1) ? bfhi(pwd_r) : bflo(pwd_r), kq_ = (r & 1) ? bfhi(pwd_k) : bflo(pwd_k), vq = (r & 1) ? bfhi(pwd_v) : bflo(pwd_v);
                    const float rr = rp + (rq - rp) * mur[r], k = kp + (kq_ - kp) * muk[r]; float v = vp + (vq - vp) * muv[r];
                    lw4[r] = -0.60653066f * sigmoidf_(w0v[r] + aw[r]);
                    const float alr = sigmoidf_(a0v[r] + aa[r]);
                    if (l > 0) { const float vf = (r & 1) ? bfhi(vwd) : bflo(vwd); v = v + (vf - v) * sigmoidf_(v0v[r] + av[r]); }
                    const float kk = k * kkc[r] * inv[tt];
                    ro4[r] = rr; vo4[r] = v; k2[r] = k * (1.f + (alr - 1.f) * kac[r]); ka[r] = kk; kb[r] = kk * alr; }
                u32x2 w;
                w.x = pk2(ro4[0], ro4[1]); w.y = pk2(ro4[2], ro4[3]); *(u32x2*)(SIr + oo + c0) = w;
                w.x = pk2(lw4[0], lw4[1]); w.y = pk2(lw4[2], lw4[3]); *(u32x2*)(SCw + os + c0) = w;
                w.x = pk2(ag[0], ag[1]); w.y = pk2(ag[2], ag[3]); *(u32x2*)(Gb + oo + c0) = w;
                w.x = pk2(vo4[0], vo4[1]); w.y = pk2(vo4[2], vo4[3]); *(u32x2*)((l > 0 ? V1 : VF) + oo + c0) = w;
                w.x = pk2(k2[0], k2[1]); w.y = pk2(k2[2], k2[3]); *(u32x2*)(SIk + oo + c0) = w;
                w.x = pk2(ka[0], ka[1]); w.y = pk2(ka[2], ka[3]); *(u32x2*)(SCa + os + c0) = w;
                w.x = pk2(kb[0], kb[1]); w.y = pk2(kb[2], kb[3]); *(u32x2*)(SCb + os + c0) = w;
            }
        }
    }
}
constexpr int NUNIT = NB * NH * (SEQ / 64);
constexpr size_t U_PMP = 0, U_RPP = 8192, U1_BYTES = 16384;
constexpr size_t U_QMT = 0, U_YLT = 8192, U2_BYTES = 16384;
DI int permk(int k) { return (k & 32) | (((k >> 2) & 3) << 3) | (((k >> 4) & 1) << 2) | (k & 3); }
constexpr int MP = 144;
constexpr int SP = 80;
DI f32x4 mm_tile(const LAS unsigned char* xb, int px, int m0, const LAS unsigned char* yb, int py, int n0, int ks, f32x4 acc, int lane) {
    const int r16 = lane & 15, g = lane >> 4;
    for (int s = 0; s < ks; ++s) {
        const bf16x8 a = *(const LAS bf16x8*)(xb + (m0 + r16) * px + (32 * s + 8 * g) * 2);
        const bf16x8 b = *(const LAS bf16x8*)(yb + (n0 + r16) * py + (32 * s + 8 * g) * 2);
        acc = mfma16(a, b, acc);
    }
    return acc;
}
DI u32x2 pk4(f32x4 v) { u32x2 w; w.x = pk2(v[0], v[1]); w.y = pk2(v[2], v[3]); return w; }

#ifndef SA_DUP
#define SA_DUP 0
#endif
#define SA_REP(bit) for (int sd_ = 0; sd_ < ((SA_DUP & (bit)) ? 2 : 1); ++sd_)
DI void phase_scan_a(Frame& F, int l, int u_lo, int u_hi, int u_step) {
    LAS unsigned char* const L = F.lds;
#define MB(n) (L + (n) * 9216)
    LAS float* const Gf = (LAS float*)(L + 110592);
    LAS float* const SEG = (LAS float*)(L + 110592 + 16384);
    LAS float* const GL = SEG + 512;
    LAS unsigned char* const A21 = L + 110592 + 16384 + 2048 + 256;
    LAS unsigned char* const T11T = A21 + 2560;
    LAS unsigned char* const ZT = T11T + 2560;
    const bf16_t* SIr = (const bf16_t*)(F.wsp() + WS_SIR); const bf16_t* SIk = (const bf16_t*)(F.wsp() + WS_SIK);
    const bf16_t* SCw = (const bf16_t*)(F.wsp() + WS_SCRW) + (size_t)F.bid * 64 * CW; const bf16_t* SCa = (const bf16_t*)(F.wsp() + WS_SCRA) + (size_t)F.bid * 64 * CW; const bf16_t* SCb = (const bf16_t*)(F.wsp() + WS_SCRB) + (size_t)F.bid * 64 * CW;
    const bf16_t* V = (const bf16_t*)(F.wsp() + (l > 0 ? WS_V1 : WS_VF));
    const int lane = F.lane, wave = F.wave, r16 = lane & 15, g = lane >> 4;
    float plw[8]; u32x4 prv, pkv, pav, pbv, pvv;
#define SCANA_LOAD(uu) do { const int bh_ = (uu) & 31, c_ = (uu) >> 5, b_ = bh_ >> 3, h_ = bh_ & 7; const size_t t0_ = (size_t)b_ * SEQ + c_ * 64; \
        { const int k_ = F.tid & 63, seg_ = F.tid >> 6; _Pragma("unroll") for (int e = 0; e < 8; ++e) plw[e] = bf2f(SCw[(size_t)(8 * seg_ + e) * CW + h_ * 64 + k_]); } \
        { const int i_ = F.tid >> 3, k0_ = (F.tid & 7) * 8; const size_t go_ = (t0_ + i_) * CW + h_ * 64 + k0_, gs_ = (size_t)i_ * CW + h_ * 64 + k0_; \
          prv = *(const u32x4*)(SIr + go_); pkv = *(const u32x4*)(SIk + go_); pav = *(const u32x4*)(SCa + gs_); pbv = *(const u32x4*)(SCb + gs_); pvv = *(const u32x4*)(V + go_); } } while (0)
    if (u_lo < u_hi) SCANA_LOAD(u_lo);
    for (int u = u_lo; u < u_hi; u += u_step) {
        const int bh = u & 31, c = u >> 5, b = bh >> 3, h = bh & 7;
        const size_t t0 = (size_t)b * SEQ + c * 64; (void)t0; (void)b; (void)h;
        unsigned char* const rec1 = F.wsp() + WS_SC1 + (size_t)((bh * 128) + c) * U1_BYTES; unsigned char* const rec2 = F.wsp() + WS_SC2 + (size_t)((bh * 128) + c) * U2_BYTES;
        __syncthreads();
        SA_REP(1) {
        { const int k = F.tid & 63, seg = F.tid >> 6; float p[8]; float run = 0.f;
#pragma unroll
          for (int e = 0; e < 8; ++e) { run += plw[e]; p[e] = run; }
          SEG[seg * 64 + k] = run;
          __syncthreads();
          float off = 0.f;
#pragma unroll
          for (int s = 0; s < 8; ++s) off += (s < seg) ? SEG[s * 64 + k] : 0.f;
#pragma unroll
          for (int e = 0; e < 8; ++e) Gf[(8 * seg + e) * 64 + k] = off + p[e];
        }
        __syncthreads();
        { const int i = F.tid >> 3, k0 = (F.tid & 7) * 8;
          const u32x4 rv = prv, kv = pkv, av = pav, bv = pbv, vv = pvv;
          float fr[8], fk[8], fa[8], fb[8], fv[8];
          const unsigned rw[4] = {rv.x, rv.y, rv.z, rv.w}, kw[4] = {kv.x, kv.y, kv.z, kv.w}, aw[4] = {av.x, av.y, av.z, av.w}, bw[4] = {bv.x, bv.y, bv.z, bv.w}, vw[4] = {vv.x, vv.y, vv.z, vv.w};
#pragma unroll
          for (int q = 0; q < 4; ++q) { fr[2 * q] = bflo(rw[q]); fr[2 * q + 1] = bfhi(rw[q]); fk[2 * q] = bflo(kw[q]); fk[2 * q + 1] = bfhi(kw[q]); fa[2 * q] = bflo(aw[q]); fa[2 * q + 1] = bfhi(aw[q]);
              fb[2 * q] = bflo(bw[q]); fb[2 * q + 1] = bfhi(bw[q]); fv[2 * q] = bflo(vw[q]); fv[2 * q + 1] = bfhi(vw[q]); }
          float at[8], rt[8], bt[8], kt[8], bh8[8], kh8[8];
#pragma unroll
          for (int e = 0; e < 8; ++e) { const float gi = Gf[i * 64 + k0 + e], gp = (i > 0) ? Gf[(i - 1) * 64 + k0 + e] : 0.f, gl = Gf[63 * 64 + k0 + e];
              const float e1 = __expf(gp), e2 = __expf(gi), e3 = __expf(-gi), e4 = __expf(gl - gi);
              at[e] = -fa[e] * e1; rt[e] = fr[e] * e2; bt[e] = fb[e] * e3; kt[e] = fk[e] * e3; bh8[e] = fb[e] * e4; kh8[e] = fk[e] * e4;
              if (i == 63) GL[k0 + e] = e2; }
          u32x4 w;
          w.x = pk2(at[0], at[1]); w.y = pk2(at[2], at[3]); w.z = pk2(at[4], at[5]); w.w = pk2(at[6], at[7]); *(LAS u32x4*)(MB(0) + i * MP + k0 * 2) = w;
          w.x = pk2(rt[0], rt[1]); w.y = pk2(rt[2], rt[3]); w.z = pk2(rt[4], rt[5]); w.w = pk2(rt[6], rt[7]); *(LAS u32x4*)(MB(1) + i * MP + k0 * 2) = w;
          w.x = pk2(bt[0], bt[1]); w.y = pk2(bt[2], bt[3]); w.z = pk2(bt[4], bt[5]); w.w = pk2(bt[6], bt[7]); *(LAS u32x4*)(MB(2) + i * MP + k0 * 2) = w;
          w.x = pk2(kt[0], kt[1]); w.y = pk2(kt[2], kt[3]); w.z = pk2(kt[4], kt[5]); w.w = pk2(kt[6], kt[7]); *(LAS u32x4*)(MB(3) + i * MP + k0 * 2) = w;
#pragma unroll
          for (int e = 0; e < 8; ++e) { const int ro = (k0 + e) * MP + i * 2;
              *(LAS bf16_t*)(MB(4) + ro) = f2bf(at[e]); *(LAS bf16_t*)(MB(5) + ro) = f2bf(fv[e]); *(LAS bf16_t*)(MB(6) + ro) = f2bf(bh8[e]); *(LAS bf16_t*)(MB(7) + ro) = f2bf(kh8[e]); }
        }
        __syncthreads(); }
        if (u + u_step < u_hi) SCANA_LOAD(u + u_step);
        __syncthreads();
        SA_REP(2) {
        { const int prod = wave >> 1;
          const LAS unsigned char* xb = (prod & 1) ? MB(3) : MB(2); const LAS unsigned char* yb = (prod < 2) ? MB(0) : MB(1);
          LAS unsigned char* ob = (prod == 1) ? MB(8) : (prod == 2) ? MB(9) : MB(10);
          float zf = 0.f; asm volatile("" : "+v"(zf));
          for (int q = 0; q < 8; ++q) { const int tt = (wave & 1) * 8 + q, tm = tt >> 2, tn = tt & 3;
              f32x4 acc = {zf, zf, zf, zf};
              if (tm <= tn) acc = mm_tile(xb, MP, 16 * tm, yb, MP, 16 * tn, 2, acc, lane);
              const int i = 16 * tn + r16, j0 = 16 * tm + 4 * g;
#pragma unroll
              for (int r = 0; r < 4; ++r) { const int j = j0 + r; const bool keep = (prod < 2) ? (j < i) : (j <= i); if (!keep) acc[r] = 0.f; }
              if (prod == 0) {
                  if ((i >> 5) == (j0 >> 5)) *(LAS f32x4*)(Gf + ((i >> 5) * 32 + (i & 31)) * 32 + (j0 & 31)) = acc;
                  if (i >= 32 && j0 < 32) *(LAS u32x2*)(A21 + (i - 32) * SP + j0 * 2) = pk4(acc);
              } else *(LAS u32x2*)(ob + i * MP + j0 * 2) = pk4(acc);
          } }
        __syncthreads();
        }
        f32x4 pyl[2] = {{0.f, 0.f, 0.f, 0.f}, {0.f, 0.f, 0.f, 0.f}}, pqm[2] = {{0.f, 0.f, 0.f, 0.f}, {0.f, 0.f, 0.f, 0.f}};
        SA_REP(4) {
        if (wave == 0) {
            const int blk = lane >> 5, cc = lane & 31; const LAS float* AD = Gf + blk * 1024;
            float Tc[32];
#pragma unroll
            for (int i = 0; i < 32; ++i) { float a0 = (i == cc) ? 1.f : 0.f, a1 = 0.f, a2 = 0.f, a3 = 0.f;
#pragma unroll
                for (int q = 0; q < (i + 3) / 4; ++q) { const f32x4 a = *(const LAS f32x4*)(AD + i * 32 + 4 * q);
                    if (4 * q + 0 < i) a0 += a[0] * Tc[4 * q + 0]; if (4 * q + 1 < i) a1 += a[1] * Tc[4 * q + 1]; if (4 * q + 2 < i) a2 += a[2] * Tc[4 * q + 2]; if (4 * q + 3 < i) a3 += a[3] * Tc[4 * q + 3]; }
                Tc[i] = (a0 + a1) + (a2 + a3); }
#pragma unroll
            for (int i = 0; i < 32; ++i) *(LAS bf16_t*)(MB(11) + (32 * blk + i) * MP + (32 * blk + cc) * 2) = f2bf(Tc[i]);
            if (blk == 0) {
#pragma unroll
                for (int q = 0; q < 4; ++q) { u32x4 w; w.x = pk2(Tc[8 * q], Tc[8 * q + 1]); w.y = pk2(Tc[8 * q + 2], Tc[8 * q + 3]); w.z = pk2(Tc[8 * q + 4], Tc[8 * q + 5]); w.w = pk2(Tc[8 * q + 6], Tc[8 * q + 7]);
                    *(LAS u32x4*)(T11T + cc * SP + q * 16) = w; }
            } else {
                unsigned z = 0u; asm volatile("" : "+v"(z));
#pragma unroll
                for (int q = 0; q < 4; ++q) *(LAS u32x4*)(MB(11) + cc * MP + 64 + q * 16) = (u32x4){z, z, z, z};
            }
        } else {
            for (int tt = wave - 1; tt < 16; tt += 7) { const int tm = tt >> 2, tn = tt & 3;
                f32x4 acc = {0.f, 0.f, 0.f, 0.f};
                acc = mm_tile(MB(8), MP, 16 * tm, MB(5), MP, 16 * tn, 2, acc, lane);
                *(LAS u32x2*)(MB(2) + (16 * tn + r16) * MP + (16 * tm + 4 * g) * 2) = pk4(acc); }
            if (sd_ == 0) {
#pragma unroll
                for (int q = 0; q < 2; ++q) { const int tt = wave * 2 + q, tm = tt >> 2, tn = tt & 3; const f32x4 z = {0.f, 0.f, 0.f, 0.f};
                    pyl[q] = mm_tile(MB(5), MP, 16 * tm, MB(10), MP, 16 * tn, 2, z, lane);
                    pqm[q] = mm_tile(MB(7), MP, 16 * tm, MB(5), MP, 16 * tn, 2, z, lane); } }
        }
        __syncthreads();
        if (wave < 4) { const int tm = wave >> 1, tn = wave & 1; f32x4 acc = {0.f, 0.f, 0.f, 0.f};
            acc = mm_tile(A21, SP, 16 * tm, T11T, SP, 16 * tn, 1, acc, lane);
            *(LAS u32x2*)(ZT + (16 * tn + r16) * SP + (16 * tm + 4 * g) * 2) = pk4(acc); }
        __syncthreads();
        if (wave < 4) { const int tm = wave >> 1, tn = wave & 1; f32x4 acc = {0.f, 0.f, 0.f, 0.f};
            acc = mm_tile(ZT, SP, 16 * tm, MB(11) + 32 * MP + 64, MP, 16 * tn, 1, acc, lane);
            *(LAS u32x2*)(MB(11) + (32 + 16 * tn + r16) * MP + (16 * tm + 4 * g) * 2) = pk4(acc); }
        __syncthreads();
        }
        SA_REP(8) {
        { const LAS unsigned char* yb = (wave < 4) ? MB(4) : MB(2); LAS unsigned char* ob = (wave < 4) ? MB(3) : MB(0);
          for (int q = 0; q < 4; ++q) { const int tt = (wave & 3) * 4 + q, tm = tt >> 2, tn = tt & 3;
              f32x4 acc = {0.f, 0.f, 0.f, 0.f};
              acc = mm_tile(MB(11), MP, 16 * tm, yb, MP, 16 * tn, 2, acc, lane);
              *(LAS u32x2*)(ob + (16 * tn + r16) * MP + (16 * tm + 4 * g) * 2) = pk4(acc); } }
        __syncthreads();
        }
        SA_REP(16) {
#pragma unroll
        for (int q = 0; q < 2; ++q) { const int tt = wave * 2 + q, tm = tt >> 2, tn = tt & 3;
            { f32x4 acc = {0.f, 0.f, 0.f, 0.f}; acc = mm_tile(MB(3), MP, 16 * tm, MB(9), MP, 16 * tn, 2, acc, lane);
              const int i = 16 * tn + r16, k0 = 16 * tm + 4 * g; const u32x2 rr = *(const LAS u32x2*)(MB(1) + i * MP + k0 * 2);
              acc[0] += bflo(rr.x); acc[1] += bfhi(rr.x); acc[2] += bflo(rr.y); acc[3] += bfhi(rr.y);
              *(u32x2*)(rec1 + U_RPP + (size_t)(i * 64 + permk(k0)) * 2) = pk4(acc); }
            { f32x4 acc = {0.f, 0.f, 0.f, 0.f}; acc = mm_tile(MB(3), MP, 16 * tm, MB(6), MP, 16 * tn, 2, acc, lane);
              const int kp = 16 * tn + r16, k0 = 16 * tm + 4 * g;
#pragma unroll
              for (int r = 0; r < 4; ++r) if (k0 + r == kp) acc[r] += GL[kp];
              *(u32x2*)(rec1 + U_PMP + (size_t)(kp * 64 + permk(k0)) * 2) = pk4(acc); }
            { f32x4 acc = pyl[q]; acc = mm_tile(MB(0), MP, 16 * tm, MB(9), MP, 16 * tn, 2, acc, lane); if (wave == 0) acc = mm_tile(MB(5), MP, 16 * tm, MB(10), MP, 16 * tn, 2, acc, lane);
              *(u32x2*)(rec2 + U_YLT + (size_t)((16 * tn + r16) * 64 + 16 * tm + 4 * g) * 2) = pk4(acc); }
            { f32x4 acc = pqm[q]; acc = mm_tile(MB(6), MP, 16 * tm, MB(0), MP, 16 * tn, 2, acc, lane); if (wave == 0) acc = mm_tile(MB(7), MP, 16 * tm, MB(5), MP, 16 * tn, 2, acc, lane);
              *(u32x2*)(rec2 + U_QMT + (size_t)((16 * tn + r16) * 64 + 16 * tm + 4 * g) * 2) = pk4(acc); }
        }
        __syncthreads(); }
    }
#undef MB
#undef SCANA_LOAD
}

constexpr int SB_D = 9, SB_SLOT = 16384;
DI void scanb_issue(LAS unsigned char* lds, const unsigned char* r1b, const unsigned char* r2b, int cidx, int lw, int lane) {
    const unsigned char* rec1 = r1b + (size_t)cidx * U1_BYTES; const unsigned char* rec2 = r2b + (size_t)cidx * U2_BYTES;
    LAS unsigned char* slot = lds + (cidx % SB_D) * SB_SLOT;
#pragma unroll
    for (int i = 0; i < 2; ++i) { const int ci = 2 * lw + i;
        const int row = 8 * ci + (lane >> 3), sl = lane & 7;
        __builtin_amdgcn_global_load_lds((const unsigned*)(rec1 + U_PMP + row * 128 + ((sl ^ (row & 7)) << 4)), (LAS unsigned*)(slot + ci * 1024), 16, 0, 0); }
#pragma unroll
    for (int i = 0; i < 2; ++i) { const int ci = 2 * lw + i;
        const int v = 8 * ci + (lane >> 3), sl = lane & 7;
        __builtin_amdgcn_global_load_lds((const unsigned*)(rec2 + U_QMT + v * 128 + ((sl ^ (v & 7)) << 4)), (LAS unsigned*)(slot + 8192 + ci * 1024), 16, 0, 0); }
}
constexpr int CW_SFLG = 12288;
DI void phase_scan_b(Frame& F, int l) {
    const int lane = F.lane, r16 = lane & 15, g = lane >> 4, w = F.wave, v = 16 * (w & 3) + r16;
    for (int bh = F.bid; bh < NB * NH; bh += F.G) {
        const unsigned char* r1 = F.wsp() + WS_SC1 + (size_t)bh * 128 * U1_BYTES; const unsigned char* r2 = F.wsp() + WS_SC2 + (size_t)bh * 128 * U2_BYTES;
        bf16_t* sct = (bf16_t*)(F.wsp() + WS_SCT) + (size_t)bh * 128 * 4096;
        const __amdgpu_buffer_rsrc_t srs = __builtin_amdgcn_make_buffer_rsrc((void*)sct, 0, 128 * 8192, 0x00020000);
        GAS unsigned* flg = (GAS unsigned*)(F.ws_g + WS_CTL) + CW_SFLG + 64 * (l * 32 + bh);
        f32x4 sT[4];
#pragma unroll
        for (int i = 0; i < 4; ++i) sT[i] = (f32x4){0.f, 0.f, 0.f, 0.f};
        __syncthreads();
        if (w >= 4) {
#pragma unroll
            for (int d = 0; d < SB_D; ++d) scanb_issue(F.lds, r1, r2, d, w - 4, lane);
        }
        for (int c = 0; c < 128; ++c) {
            if (w >= 4) asm volatile("s_waitcnt vmcnt(28)" ::: "memory");
            __builtin_amdgcn_s_barrier();
            asm volatile("" ::: "memory");
            if (w >= 4) {
                if (c >= 1) { const int cn = c - 1 + SB_D; scanb_issue(F.lds, r1, r2, cn < 128 ? cn : c, w - 4, lane); }
            } else {
                const LAS unsigned char* slot = F.lds + (c % SB_D) * SB_SLOT;
                bf16x8 pm[4][2]; f32x4 q[4];
#pragma unroll
                for (int mt = 0; mt < 4; ++mt) { const int row = 16 * mt + r16;
#pragma unroll
                    for (int s2 = 0; s2 < 2; ++s2) pm[mt][s2] = *(const LAS bf16x8*)(slot + row * 128 + (((4 * s2 + g) ^ (row & 7)) << 4));
                    { const u32x2 qw = *(const LAS u32x2*)(slot + 8192 + v * 128 + (((2 * mt + (g >> 1)) ^ (v & 7)) << 4) + (g & 1) * 8); q[mt] = (f32x4){bflo(qw.x), bfhi(qw.x), bflo(qw.y), bfhi(qw.y)}; } }
                bf16x8 hi[2], lo[2];
#pragma unroll
                for (int s2 = 0; s2 < 2; ++s2) { u32x4 hw, lw;
#pragma unroll
                    for (int qq = 0; qq < 2; ++qq) { const f32x4 x = sT[2 * s2 + qq]; const unsigned h0 = pk2(x[0], x[1]), h1 = pk2(x[2], x[3]);
                        const unsigned l0 = pk2(x[0] - bflo(h0), x[1] - bfhi(h0)), l1 = pk2(x[2] - bflo(h1), x[3] - bfhi(h1));
                        if (qq == 0) { hw.x = h0; hw.y = h1; lw.x = l0; lw.y = l1; } else { hw.z = h0; hw.w = h1; lw.z = l0; lw.w = l1; } }
                    hi[s2] = __builtin_bit_cast(bf16x8, hw); lo[s2] = __builtin_bit_cast(bf16x8, lw);
                    __builtin_amdgcn_raw_buffer_store_b128(hw, srs, (int)(((unsigned)c * 4096u + (unsigned)v * 64u + 32u * s2 + 8u * g) * 2u), 0, 16); }
#pragma unroll
                for (int mt = 0; mt < 4; ++mt) { f32x4 n = q[mt];
#pragma unroll
                    for (int s2 = 0; s2 < 2; ++s2) { n = mfma16(pm[mt][s2], hi[s2], n); n = mfma16(pm[mt][s2], lo[s2], n); }
                    sT[mt] = n; }
                asm volatile("s_waitcnt lgkmcnt(0)" ::: "memory");
                if ((c & 3) == 3 && c >= 7) { asm volatile("s_waitcnt vmcnt(8)" ::: "memory");
                    if (lane == 0) __hip_atomic_fetch_add(flg, 1u, __ATOMIC_RELAXED, __HIP_MEMORY_SCOPE_AGENT); }
            }
        }
        asm volatile("s_waitcnt vmcnt(0)" ::: "memory");
        if (w < 4 && lane == 0) __hip_atomic_fetch_add(flg, 1u, __ATOMIC_RELAXED, __HIP_MEMORY_SCOPE_AGENT);
    }
}

struct ScanCIn { bf16x8 ra[2]; f32x4 yl[4]; bf16x8 sb[4][2]; };
DI void scanc_load(ScanCIn& o, const unsigned char* ws, GAS unsigned* flags, int item, int r16, int g) {
    asm volatile("" : "+s"(item));
    const int u = item >> 2, it = item & 3; const int bh = u & 31, c = u >> 5; const size_t ui = (size_t)(bh * 128 + c);
    {
      GAS unsigned* fw = flags + 64 * bh; const unsigned need = 4u * ((unsigned)(c >> 2) + 1u); unsigned spins = 0;
      while ((unsigned)__builtin_amdgcn_readfirstlane((int)__hip_atomic_load(fw, __ATOMIC_RELAXED, __HIP_MEMORY_SCOPE_AGENT)) < need) { __builtin_amdgcn_s_sleep(2); if (++spins > (1u << 20)) break; }
      asm volatile("" ::: "memory"); }
    const unsigned char* rec1 = ws + WS_SC1 + ui * U1_BYTES; const unsigned char* rec2 = ws + WS_SC2 + ui * U2_BYTES;
    const __amdgpu_buffer_rsrc_t srs = __builtin_amdgcn_make_buffer_rsrc((void*)(ws + WS_SCT + ui * 8192), 0, 8192, 0x00020000);
#pragma unroll
    for (int s = 0; s < 2; ++s) o.ra[s] = *(const bf16x8*)(rec1 + U_RPP + (size_t)((16 * it + r16) * 64 + 32 * s + 8 * g) * 2);
#pragma unroll
    for (int vt = 0; vt < 4; ++vt) { { const u32x2 yw = *(const u32x2*)(rec2 + U_YLT + (size_t)((16 * it + r16) * 64 + 16 * vt + 4 * g) * 2); o.yl[vt] = (f32x4){bflo(yw.x), bfhi(yw.x), bflo(yw.y), bfhi(yw.y)}; }
#pragma unroll
        for (int s = 0; s < 2; ++s) o.sb[vt][s] = __builtin_bit_cast(bf16x8, __builtin_amdgcn_raw_buffer_load_b128(srs, (int)(((16 * vt + r16) * 64 + 32 * s + 8 * g) * 2), 0, 16)); }
}
DI void scanc_item(const ScanCIn& o, Frame& F, int l, int item, int r16, int g) {
    const bf16_t* SIr = (const bf16_t*)(F.wsp() + WS_SIR); const bf16_t* SIk = (const bf16_t*)(F.wsp() + WS_SIK);
    const bf16_t* V = (const bf16_t*)(F.wsp() + (l > 0 ? WS_V1 : WS_VF)); const bf16_t* Gb = (const bf16_t*)(F.wsp() + WS_G); bf16_t* YR = (bf16_t*)(F.wsp() + WS_YRM);
    const int u = item >> 2, it = item & 3; const int bh = u & 31, c = u >> 5, b = bh >> 3, h = bh & 7;
    const size_t tok = (size_t)b * SEQ + c * 64 + 16 * it + r16; const size_t o0 = tok * CW + h * 64 + 4 * g, oy = tok * YRM_LD + h * 64 + 4 * g;
    u32x2 pr[4], pk[4], pv[4], pg[4];
#pragma unroll
    for (int vt = 0; vt < 4; ++vt) { pr[vt] = *(const u32x2*)(SIr + o0 + 16 * vt); pk[vt] = *(const u32x2*)(SIk + o0 + 16 * vt); pv[vt] = *(const u32x2*)(V + o0 + 16 * vt); pg[vt] = *(const u32x2*)(Gb + o0 + 16 * vt); }
    f32x4 y[4];
#pragma unroll
    for (int vt = 0; vt < 4; ++vt) { y[vt] = o.yl[vt];
#pragma unroll
        for (int s = 0; s < 2; ++s) y[vt] = mfma16(o.sb[vt][s], o.ra[s], y[vt]); }
    float s1 = 0.f;
#pragma unroll
    for (int vt = 0; vt < 4; ++vt) s1 += (y[vt][0] + y[vt][1]) + (y[vt][2] + y[vt][3]);
    s1 += __shfl_xor(s1, 16); s1 += __shfl_xor(s1, 32);
    const float mean = s1 * (1.f / 64.f); float s2 = 0.f;
#pragma unroll
    for (int vt = 0; vt < 4; ++vt) { y[vt] = y[vt] - mean; s2 += (y[vt][0] * y[vt][0] + y[vt][1] * y[vt][1]) + (y[vt][2] * y[vt][2] + y[vt][3] * y[vt][3]); }
    s2 += __shfl_xor(s2, 16); s2 += __shfl_xor(s2, 32);
    const float rstd = __builtin_amdgcn_rsqf(s2 * (1.f / 64.f) + 64e-5f);
    const float* lng = F.inp(17) + l * CW + h * 64 + 4 * g; const float* lnb = F.inp(18) + l * CW + h * 64 + 4 * g; const float* rkp = F.inp(16) + l * CW + h * 64 + 4 * g;
    float s3 = 0.f;
#pragma unroll
    for (int vt = 0; vt < 4; ++vt) { const f32x4 rk = *(const f32x4*)(rkp + 16 * vt);
        s3 += bflo(pr[vt].x) * bflo(pk[vt].x) * rk[0] + bfhi(pr[vt].x) * bfhi(pk[vt].x) * rk[1] + bflo(pr[vt].y) * bflo(pk[vt].y) * rk[2] + bfhi(pr[vt].y) * bfhi(pk[vt].y) * rk[3]; }
    s3 += __shfl_xor(s3, 16); s3 += __shfl_xor(s3, 32);
#pragma unroll
    for (int vt = 0; vt < 4; ++vt) { const f32x4 lg4 = *(const f32x4*)(lng + 16 * vt), lb4 = *(const f32x4*)(lnb + 16 * vt);
        const float o_0 = (y[vt][0] * rstd * lg4[0] + lb4[0] + s3 * bflo(pv[vt].x)) * bflo(pg[vt].x), o_1 = (y[vt][1] * rstd * lg4[1] + lb4[1] + s3 * bfhi(pv[vt].x)) * bfhi(pg[vt].x);
        const float o_2 = (y[vt][2] * rstd * lg4[2] + lb4[2] + s3 * bflo(pv[vt].y)) * bflo(pg[vt].y), o_3 = (y[vt][3] * rstd * lg4[3] + lb4[3] + s3 * bfhi(pv[vt].y)) * bfhi(pg[vt].y);
        u32x2 w; w.x = pk2(o_0, o_1); w.y = pk2(o_2, o_3); *(u32x2*)(YR + oy + 16 * vt) = w; }
}
DI void phase_scan_c(Frame& F, int l, int nskip) {
    const int lane = F.lane, r16 = lane & 15, g = lane >> 4;
    const int first = (F.bid - nskip) * 8 + F.wave, stride = (F.G - nskip) * 8;
    if (first >= NUNIT * 4) return;
    GAS unsigned* flags = (GAS unsigned*)(F.ws_g + WS_CTL) + CW_SFLG + 64 * (l * 32);
    ScanCIn o0, o1;
    scanc_load(o0, F.wsp(), flags, first, r16, g);
    for (int item = first; item < NUNIT * 4; item += 2 * stride) {
        const int i1 = item + stride, i2 = item + 2 * stride;
        if (i1 < NUNIT * 4) scanc_load(o1, F.wsp(), flags, i1, r16, g);
        scanc_item(o0, F, l, item, r16, g);
        if (i1 < NUNIT * 4) { if (i2 < NUNIT * 4) scanc_load(o0, F.wsp(), flags, i2, r16, g); scanc_item(o1, F, l, i1, r16, g); }
    }
}

#ifndef FUSE_DUP
#define FUSE_DUP 0
#endif
DI void phase_prep_scana(Frame& F, int l) {
    phase_rwkv_prep2(F, l, 0, 0, 1, true);
#define RELANE() do { int l_ = F.lane; asm volatile("" : "+v"(l_)); F.lane = l_; F.tid = F.wave * 64 + l_; } while (0)
    for (int tile = F.bid; tile < T / 64; tile += F.G) {
        for (int fd_ = 0; fd_ < ((FUSE_DUP & 1) ? 2 : 1); ++fd_) {
        RELANE();
        phase_rwkv_prep2(F, l, tile, tile + 1, 1, false);
        }
        asm volatile("s_waitcnt vmcnt(0)" ::: "memory");
        __syncthreads();
        __builtin_amdgcn_fence(__ATOMIC_ACQUIRE, "agent");
        asm volatile("s_waitcnt vmcnt(0)" ::: "memory");
        const int b = tile >> 7, c = tile & 127; const int u0 = c * 32 + b * 8;
        for (int fd_ = 0; fd_ < ((FUSE_DUP & 2) ? 2 : 1); ++fd_) {
        RELANE();
        phase_scan_a(F, l, u0, u0 + 8, 1);
        }
    }
#undef RELANE
}
DI void phase_moba_prep(Frame& F, int l) {
    bf16_t* MO = (bf16_t*)(F.wsp() + WS_MO); float* KM = (float*)(F.wsp() + WS_TAB + TB_KMEAN);
    int c = F.tid; const float qg = F.inp(23)[l * 64 + (c & 63)] * 0.125f, kg = F.inp(24)[l * 64 + (c & 63)];
    for (int hs = F.bid; hs < T / 128; hs += F.G) {
        float ksum = 0.f;
        for (int tb = 0; tb < 128; tb += 8) {
            int tbase = hs * 128 + tb; asm volatile("" : "+s"(tbase), "+v"(c));
            float q[8], k[8];
#pragma unroll
            for (int e = 0; e < 8; ++e) { const size_t ro = (size_t)(tbase + e) * 1536; q[e] = bf2f(MO[ro + c]); k[e] = bf2f(MO[ro + 512 + c]); }
#pragma unroll
            for (int e = 0; e < 8; ++e) { const size_t ro = (size_t)(tbase + e) * 1536;
                const float qs = wave_sum(q[e] * q[e]) * (1.f / 64.f), ks = wave_sum(k[e] * k[e]) * (1.f / 64.f);
                const float qn = q[e] * (1.0f / sqrtf(qs + 1e-6f)) * qg, kn = k[e] * (1.0f / sqrtf(ks + 1e-6f)) * kg;
                MO[ro + c] = f2bf(qn); MO[ro + 512 + c] = f2bf(kn); ksum += kn; }
        }
        KM[(size_t)(hs & 1) * (TB_KMEAN2 / 4) + (size_t)(hs >> 1) * CW + c] = ksum * (1.f / 256.f);
    }
}
DI void phase_moba_gate(Frame& F) {
    LAS float* KL = (LAS float*)F.lds;
    const bf16_t* MO = (const bf16_t*)(F.wsp() + WS_MO); const float* KM = (const float*)(F.wsp() + WS_TAB + TB_KMEAN); unsigned* SEL = (unsigned*)(F.wsp() + WS_SEL);
    for (int sidx = F.bid; sidx < T / 64; sidx += F.G) {
        const int span = ((sidx / F.G) & 1) ? ((sidx & ~127) + (127 - (sidx & 127))) : sidx;
        const int t0 = span * 64, b = t0 / SEQ, blk = (t0 % SEQ) / 256;
        __syncthreads();
        { const int cc = F.tid, h = cc >> 6, d = cc & 63;
          for (int j0 = 0; j0 < blk; j0 += 8) { float v0[8], v1[8];
#pragma unroll
              for (int e = 0; e < 8; ++e) { const int j = (j0 + e < blk) ? j0 + e : blk - 1; const size_t ko = ((size_t)(b * 32 + j)) * CW + cc; v0[e] = KM[ko]; v1[e] = KM[ko + TB_KMEAN2 / 4]; }
#pragma unroll
              for (int e = 0; e < 8; ++e) if (j0 + e < blk) KL[h * 2052 + (j0 + e) * 64 + d] = v0[e] + v1[e]; } }
        __syncthreads();
        const int tok = F.tid >> 3, h = F.tid & 7; const int t = t0 + tok;
        float q[64];
        { const u32x4* qp = (const u32x4*)(MO + (size_t)t * 1536 + h * 64);
#pragma unroll
          for (int i = 0; i < 8; ++i) { const u32x4 w = qp[i]; q[8 * i] = bflo(w.x); q[8 * i + 1] = bfhi(w.x); q[8 * i + 2] = bflo(w.y); q[8 * i + 3] = bfhi(w.y); q[8 * i + 4] = bflo(w.z); q[8 * i + 5] = bfhi(w.z); q[8 * i + 6] = bflo(w.w); q[8 * i + 7] = bfhi(w.w); } }
        float v0 = -INFINITY, v1 = -INFINITY, v2 = -INFINITY; int i0 = 0, i1 = 1, i2 = 2;
        for (int j = 0; j < blk; ++j) {
            const LAS f32x4* kp = (const LAS f32x4*)(KL + h * 2052 + j * 64); float s = 0.f;
#pragma unroll
            for (int i = 0; i < 16; ++i) { const f32x4 kv = kp[i]; s += q[4 * i] * kv.x + q[4 * i + 1] * kv.y + q[4 * i + 2] * kv.z + q[4 * i + 3] * kv.w; }
            if (s > v0) { v2 = v1; i2 = i1; v1 = v0; i1 = i0; v0 = s; i0 = j; }
            else if (s > v1) { v2 = v1; i2 = i1; v1 = s; i1 = j; }
            else if (s > v2) { v2 = s; i2 = j; }
        }
        const int nv = blk < 3 ? blk : 3;
        SEL[(size_t)t * 8 + h] = (unsigned)i0 | ((unsigned)i1 << 8) | ((unsigned)i2 << 16) | ((unsigned)nv << 24);
    }
}

constexpr int KS_PITCH = 144, VT_PITCH = 520;
constexpr int NPIECE = 47;
constexpr int CW_QATT = 8192;
DI void phase_moba_attn(Frame& F, int l) {
    static constexpr unsigned PIECES[NPIECE] = {196608,1837578,590595,1574658,1115654,1640713,1968907,1443848,918789,1049857,1246983,393730,787456,721924,2034700,262401,2034179,2034957,2035214,2035471,2034692,2035728,2034944,2035985,2036242,2036499,2035461,2036756,2037013,2037270,2035969,2037527,2036230,2037784,2038041,2038298,2036743,2038555,2038812,2039069,2039326,2037512,2039583,2038018,2038281,2039050,2039563};
    LAS unsigned char* Ks = F.lds;
    LAS unsigned char* Vt = F.lds + 36864;
    LAS float* LUT = (LAS float*)(F.lds + 36864 + 33280);
    LAS unsigned* CTL = (LAS unsigned*)(F.lds + 36864 + 33280 + 528);
    LAS unsigned* LIST = CTL + 4;
    const bf16_t* MO = (const bf16_t*)(F.wsp() + WS_MO); const unsigned* SEL = (const unsigned*)(F.wsp() + WS_SEL);
    bf16_t* PO = (bf16_t*)(F.wsp() + WS_PO); f32x2* PST = (f32x2*)(F.wsp() + WS_PST);
    unsigned* qctr = (unsigned*)(F.wsp() + WS_CTL) + CW_QATT + 64 * l;
    const float* relb = F.inp(25);
    const int lane = F.lane;
    bool att_done = false, conv_done = false;
    for (int trip = 0;; ++trip) {
        if (!conv_done && (att_done || (trip % 3) == 2)) {
            __syncthreads();
            if (F.tid == 0) CTL[2] = __hip_atomic_fetch_add(qctr + 16, 1u, __ATOMIC_RELAXED, __HIP_MEMORY_SCOPE_AGENT);
            __syncthreads();
            const int cu = (int)CTL[2];
            if (cu >= CONV_UNITS) conv_done = true; else conv_experts_items(F, l, cu * CONV_GROUP, (cu + 1) * CONV_GROUP, 1);
        }
        if (att_done) { if (conv_done) break; continue; }
        __syncthreads();
        if (F.tid == 0) { CTL[0] = __hip_atomic_fetch_add(qctr, 1u, __ATOMIC_RELAXED, __HIP_MEMORY_SCOPE_AGENT); CTL[1] = 0u; }
        __syncthreads();
        const int u = (int)CTL[0];
        if (u >= NPIECE * NB * NH) { att_done = true; if (conv_done) break; continue; }
        const unsigned pc = PIECES[u >> 5]; const int bh = u & 31, b = bh >> 3, h = bh & 7;
        const int j = (int)(pc & 0xff), qlo = (int)((pc >> 8) & 0xff), qhi = (int)(pc >> 16); const int ncand = (qhi - qlo + 1) * 256;
        const size_t tokb = (size_t)b * SEQ;
        for (int id = F.tid; id < 2048; id += 512) { const int row = id >> 3, c8 = id & 7; const size_t ro = (tokb + j * 256 + row) * 1536 + h * 64 + c8 * 8;
            *(LAS u32x4*)(Ks + row * KS_PITCH + c8 * 16) = *(const u32x4*)(MO + ro + 512); }
        for (int id = F.tid; id < 1024; id += 512) { const int rp = id >> 3, c8 = id & 7; const size_t ro = (tokb + j * 256 + 2 * rp) * 1536 + h * 64 + c8 * 8 + 1024;
            const u32x4 v0 = *(const u32x4*)(MO + ro), v1 = *(const u32x4*)(MO + ro + 1536);
            const unsigned a[4] = {v0.x, v0.y, v0.z, v0.w}, bq[4] = {v1.x, v1.y, v1.z, v1.w};
            LAS unsigned char* vp = Vt + (c8 * 8) * VT_PITCH + rp * 4;
#pragma unroll
            for (int q = 0; q < 4; ++q) { *(LAS unsigned*)(vp + (2 * q) * VT_PITCH) = (a[q] & 0xffffu) | (bq[q] << 16); *(LAS unsigned*)(vp + (2 * q + 1) * VT_PITCH) = (a[q] >> 16) | (bq[q] & 0xffff0000u); } }
        if (F.tid <= 128) { const int n = F.tid; int bucket;
            if (n < 16) bucket = n; else { int lg = 16 + (int)(logf((float)n / 16.0f) / 2.0794415416798357f * 16.0f); bucket = lg < 31 ? lg : 31; }
            LUT[n] = relb[bucket * 8 + h]; }
        unsigned selw[11];
#pragma unroll
        for (int r = 0; r < 11; ++r) { const int qq = qlo * 256 + r * 512 + F.tid; selw[r] = (r * 512 + F.tid < ncand) ? SEL[(tokb + qq) * 8 + h] : 0u; }
#pragma unroll
        for (int r = 0; r < 11; ++r) { const int base = r * 512; if (base >= ncand) break;
            const int q = qlo * 256 + base + F.tid; const int qb = q >> 8; bool mem = false; unsigned ent = 0;
            if (base + F.tid >= ncand) { }
            else if (qb == j) { mem = true; ent = (unsigned)q | (3u << 16); }
            else { const unsigned s = selw[r]; const unsigned nv = s >> 24;
                if (nv > 0 && (s & 0xff) == (unsigned)j) { mem = true; ent = (unsigned)q; }
                else if (nv > 1 && ((s >> 8) & 0xff) == (unsigned)j) { mem = true; ent = (unsigned)q | (1u << 16); }
                else if (nv > 2 && ((s >> 16) & 0xff) == (unsigned)j) { mem = true; ent = (unsigned)q | (2u << 16); } }
            const unsigned long long bal = __ballot(mem); const int cnt = __popcll(bal);
            unsigned wbase = 0; if (lane == 0 && cnt > 0) wbase = __hip_atomic_fetch_add(&CTL[1], (unsigned)cnt, __ATOMIC_RELAXED, __HIP_MEMORY_SCOPE_WORKGROUP);
            wbase = (unsigned)__builtin_amdgcn_readfirstlane((int)wbase);
            if (mem) LIST[wbase + __popcll(bal & ((1ull << lane) - 1ull))] = ent;
        }
        __syncthreads();
        const int total = (int)CTL[1];
        const float bfar = LUT[128];
        const int ntile = (total + 31) >> 5;
        const int qi = lane & 31, half = lane >> 5;
        for (int tile = F.wave; tile < ntile; tile += 8) {
            const int e = tile * 32 + qi; const bool valid = e < total; const unsigned en = LIST[valid ? e : total - 1];
            const int q = (int)(en & 0xffffu), slot = (int)(en >> 16); const size_t tok = tokb + q;
            const bool need_lut = __any((q >> 8) <= j + 1);
            bf16x8 qf[4];
#pragma unroll
            for (int kk = 0; kk < 4; ++kk) qf[kk] = *(const bf16x8*)(MO + tok * 1536 + h * 64 + 16 * kk + 8 * half);
            float mrun = -1e30f, lsum = 0.f;
            f32x16 oacc[2];
#pragma unroll
            for (int i = 0; i < 16; ++i) { oacc[0][i] = 0.f; oacc[1][i] = 0.f; }
            const int qrel = q - j * 256;
#pragma unroll 1
            for (int ck = 0; ck < 4; ++ck) {
                if (!__any(qrel >= 64 * ck)) break;
                f32x16 sacc[2];
#pragma unroll
                for (int k2 = 0; k2 < 2; ++k2) { const int kt = 2 * ck + k2;
#pragma unroll
                    for (int i = 0; i < 16; ++i) sacc[k2][i] = 0.f;
#pragma unroll
                    for (int kk = 0; kk < 4; ++kk) { const bf16x8 ka = *(const LAS bf16x8*)(Ks + (32 * kt + qi) * KS_PITCH + (16 * kk + 8 * half) * 2);
                        sacc[k2] = __builtin_amdgcn_mfma_f32_32x32x16_bf16(ka, qf[kk], sacc[k2], 0, 0, 0); } }
                float mx = -1e30f;
                if (need_lut) {
#pragma unroll
                    for (int k2 = 0; k2 < 2; ++k2)
#pragma unroll
                        for (int i = 0; i < 16; ++i) { const int key = 32 * (2 * ck + k2) + (i & 3) + 8 * (i >> 2) + 4 * half; const int n = qrel - key;
                            const float bias = LUT[n < 0 ? 0 : (n > 128 ? 128 : n)];
                            const float s = (n < 0) ? -1e30f : sacc[k2][i] + bias; sacc[k2][i] = s; mx = fmaxf(mx, s); }
                } else {
#pragma unroll
                    for (int k2 = 0; k2 < 2; ++k2)
#pragma unroll
                        for (int i = 0; i < 16; ++i) { const float s = sacc[k2][i] + bfar; sacc[k2][i] = s; mx = fmaxf(mx, s); }
                }
                mx = fmaxf(mx, __shfl_xor(mx, 32));
                const float mnew = fmaxf(mrun, mx); const float alpha = __expf(mrun - mnew); mrun = mnew;
                lsum *= alpha;
#pragma unroll
                for (int i = 0; i < 16; ++i) { oacc[0][i] *= alpha; oacc[1][i] *= alpha; }
#pragma unroll
                for (int k2 = 0; k2 < 2; ++k2) { const int kt = 2 * ck + k2;
#pragma unroll
                    for (int i = 0; i < 16; ++i) { const float p = __expf(sacc[k2][i] - mnew); sacc[k2][i] = p; lsum += p; }
#pragma unroll
                    for (int cc = 0; cc < 2; ++cc) {
                        u32x4 pw; pw.x = pk2(sacc[k2][8 * cc], sacc[k2][8 * cc + 1]); pw.y = pk2(sacc[k2][8 * cc + 2], sacc[k2][8 * cc + 3]); pw.z = pk2(sacc[k2][8 * cc + 4], sacc[k2][8 * cc + 5]); pw.w = pk2(sacc[k2][8 * cc + 6], sacc[k2][8 * cc + 7]);
                        const bf16x8 pf = __builtin_bit_cast(bf16x8, pw);
                        const int key0 = 32 * kt + 16 * cc + 4 * half;
#pragma unroll
                        for (int dt = 0; dt < 2; ++dt) { const LAS unsigned char* vb = Vt + (32 * dt + qi) * VT_PITCH + key0 * 2;
                            const u32x2 va = *(const LAS u32x2*)vb, vb2 = *(const LAS u32x2*)(vb + 16);
                            u32x4 vw; vw.x = va.x; vw.y = va.y; vw.z = vb2.x; vw.w = vb2.y;
                            oacc[dt] = __builtin_amdgcn_mfma_f32_32x32x16_bf16(__builtin_bit_cast(bf16x8, vw), pf, oacc[dt], 0, 0, 0); } } }
            }
            const float mx = mrun;
            lsum += __shfl_xor(lsum, 32);
            const float inv = 1.0f / lsum;
            if (valid) {
                bf16_t* op = PO + ((size_t)slot * T + tok) * CW + h * 64;
#pragma unroll
                for (int dt = 0; dt < 2; ++dt)
#pragma unroll
                    for (int ig = 0; ig < 4; ++ig) { u32x2 w; w.x = pk2(oacc[dt][4 * ig] * inv, oacc[dt][4 * ig + 1] * inv); w.y = pk2(oacc[dt][4 * ig + 2] * inv, oacc[dt][4 * ig + 3] * inv);
                        *(u32x2*)(op + 32 * dt + 8 * ig + 4 * half) = w; }
                if (half == 0) PST[((size_t)slot * T + tok) * 8 + h] = (f32x2){mx, lsum};
            }
        }
    }
}
DI void phase_moba_combine(Frame& F) {
    const bf16_t* PO = (const bf16_t*)(F.wsp() + WS_PO); const f32x2* PST = (const f32x2*)(F.wsp() + WS_PST); const unsigned* SEL = (const unsigned*)(F.wsp() + WS_SEL);
    bf16_t* YM = (bf16_t*)(F.wsp() + WS_YRM) + 512;
    int c = F.tid; const int h = c >> 6;
    for (int tb = F.bid * 8; tb < T; tb += F.G * 8) {
        int tbase = tb; asm volatile("" : "+s"(tbase), "+v"(c));
        int nv[8]; f32x2 st[8][4]; float po[8][4];
#pragma unroll
        for (int e = 0; e < 8; ++e) { const int t = tbase + e; nv[e] = (int)(SEL[(size_t)t * 8 + h] >> 24);
#pragma unroll
            for (int s = 0; s < 4; ++s) { st[e][s] = PST[((size_t)s * T + t) * 8 + h]; po[e][s] = bf2f(PO[((size_t)s * T + t) * CW + c]); } }
#pragma unroll
        for (int e = 0; e < 8; ++e) { const int t = tbase + e; float M = -1e30f;
#pragma unroll
            for (int s = 0; s < 4; ++s) { const bool on = (s == 3) || (s < nv[e]); if (on) M = fmaxf(M, st[e][s].x); }
            float den = 0.f, num = 0.f;
#pragma unroll
            for (int s = 0; s < 4; ++s) { const bool on = (s == 3) || (s < nv[e]); if (on) { const float w = st[e][s].y * __expf(st[e][s].x - M); den += w; num += w * po[e][s]; } }
            YM[(size_t)t * YRM_LD + c] = f2bf(num / den); }
    }
}
DI void phase_router(Frame& F, int l) {
    LAS float* xs = (LAS float*)F.lds;
    LAS float* wsm = xs + 64 * 129;
    LAS float* lgt = wsm + 128 * 36;
    LAS float* ssq = lgt + 64 * 37;
    LAS int* hist = (LAS int*)(ssq + 64);
    const float* x = F.outp(); const float* gain = F.inp(2) + (size_t)l * DM;
    const float* wgrp = F.inp(29) + (size_t)l * DM * 4; const float* wexp = F.inp(31) + (size_t)l * DM * 32;
    const float* bgrp = F.inp(30) + l * 4; const float* bexp = F.inp(32) + l * 32;
    int* EID = (int*)(F.wsp() + WS_RT + RT_EID); float* GATE = (float*)(F.wsp() + WS_RT + RT_GATE); int* HIST = (int*)(F.wsp() + WS_RT + RT_HIST);
    const int tok = F.tid & 63, jg = F.tid >> 6;
    for (int tile = F.bid; tile < T / 64; tile += F.G) {
        const int t0 = tile * 64;
        float acc[5] = {0.f, 0.f, 0.f, 0.f, 0.f}; float ss = 0.f;
        if (F.tid < 32) hist[F.tid] = 0;
        for (int kc = 0; kc < DM; kc += 128) {
            __syncthreads();
            for (int idx = F.tid; idx < 64 * 128; idx += 512) { const int r = idx >> 7, k = idx & 127; xs[r * 129 + k] = x[(size_t)(t0 + r) * DM + kc + k]; }
            for (int idx = F.tid; idx < 128 * 36; idx += 512) { const int k = idx / 36, j = idx - k * 36; const float g = gain[kc + k];
                wsm[idx] = g * (j < 4 ? wgrp[(size_t)(kc + k) * 4 + j] : wexp[(size_t)(kc + k) * 32 + (j - 4)]); }
            __syncthreads();
            for (int k = 0; k < 128; ++k) { const float xv = xs[tok * 129 + k]; ss += xv * xv;
#pragma unroll
                for (int i = 0; i < 5; ++i) { const int j = jg + 8 * i; if (j < 36) acc[i] += xv * wsm[k * 36 + j]; } }
        }
#pragma unroll
        for (int i = 0; i < 5; ++i) { const int j = jg + 8 * i; if (j < 36) lgt[tok * 37 + j] = acc[i]; }
        if (jg == 0) ssq[tok] = ss;
        __syncthreads();
        if (F.tid < 64) {
            const int t = t0 + F.tid; const float rs = 1.0f / sqrtf(ssq[F.tid] * (1.f / DM) + 1e-6f);
            float lg[4]; int gs = 0; float gm = -INFINITY;
#pragma unroll
            for (int g = 0; g < 4; ++g) { lg[g] = lgt[F.tid * 37 + g] * rs + bgrp[g]; if (lg[g] > gm) { gm = lg[g]; gs = g; } }
            float gden = 0.f;
#pragma unroll
            for (int g = 0; g < 4; ++g) gden += expf(lg[g] - gm);
            const float ptop = 1.0f / gden;
            float le[8]; float e0 = -INFINITY, e1 = -INFINITY; int j0 = 0, j1 = 1;
#pragma unroll
            for (int e = 0; e < 8; ++e) { le[e] = lgt[F.tid * 37 + 4 + gs * 8 + e] * rs + bexp[gs * 8 + e];
                if (le[e] > e0) { e1 = e0; j1 = j0; e0 = le[e]; j0 = e; } else if (le[e] > e1) { e1 = le[e]; j1 = e; } }
            const float p1 = expf(e1 - e0);
            const float g0 = ptop / (1.f + p1), g1 = ptop * p1 / (1.f + p1);
            const int ex0 = gs * 8 + j0, ex1 = gs * 8 + j1;
            EID[t * 2] = ex0; EID[t * 2 + 1] = ex1; GATE[t * 2] = g0; GATE[t * 2 + 1] = g1;
            __hip_atomic_fetch_add(&hist[ex0], 1, __ATOMIC_RELAXED, __HIP_MEMORY_SCOPE_WORKGROUP); __hip_atomic_fetch_add(&hist[ex1], 1, __ATOMIC_RELAXED, __HIP_MEMORY_SCOPE_WORKGROUP);
        }
        __syncthreads();
        if (F.tid < 32) HIST[tile * 32 + F.tid] = hist[F.tid];
        __syncthreads();
    }
}
DI void phase_moe_gather(Frame& F, int l) {
    LAS int* tot = (LAS int*)F.lds; LAS int* off = tot + 32; LAS int* base = off + 32; LAS int* eidl = base + 32; LAS int* rowl = eidl + 128; LAS int* ps = rowl + 128; LAS int* po = ps + 512;
    const int* EID = (const int*)(F.wsp() + WS_RT + RT_EID); const float* GATE = (const float*)(F.wsp() + WS_RT + RT_GATE); const int* HIST = (const int*)(F.wsp() + WS_RT + RT_HIST);
    int* ROW = (int*)(F.wsp() + WS_RT + RT_ROW); float* GW = (float*)(F.wsp() + WS_RT + RT_GW); int* PEXP = (int*)(F.wsp() + WS_RT + RT_PEXP);
    int* TOK = (int*)(F.wsp() + WS_RT + RT_TOK); const float* RSQ = (const float*)(F.wsp() + WS_RT + RT_RSQ); float* RSR = (float*)(F.wsp() + WS_RT + RT_RSR);
    for (int tile = F.bid; tile < T / 64; tile += F.G) {
        const int t0 = tile * 64;
        __syncthreads();
        { const int e = F.tid & 31, part = F.tid >> 5; int s = 0, o = 0;
#pragma unroll 8
          for (int i = part * 32; i < part * 32 + 32; ++i) { const int v = HIST[i * 32 + e]; s += v; if (i < tile) o += v; }
          ps[F.tid] = s; po[F.tid] = o; }
        if (F.tid < 128) eidl[F.tid] = EID[t0 * 2 + F.tid];
        __syncthreads();
        if (F.tid < 32) { int s = 0, o = 0;
#pragma unroll
            for (int p = 0; p < 16; ++p) { s += ps[p * 32 + F.tid]; o += po[p * 32 + F.tid]; } tot[F.tid] = s; off[F.tid] = o; }
        __syncthreads();
        if (F.tid == 0) {
            int bs = 0; for (int e = 0; e < 32; ++e) { base[e] = bs; bs += (tot[e] + 255) & ~255; }
            if (tile == 0) { int p = 0; for (int e = 0; e < 32; ++e) { const int np = (tot[e] + 255) >> 8; for (int i = 0; i < np; ++i) PEXP[p++] = e; } PEXP[MOE_PANELS] = p; }
        }
        __syncthreads();
        if (F.tid < 128) { const int my = eidl[F.tid]; int rank = 0; for (int i = 0; i < F.tid; ++i) rank += (eidl[i] == my) ? 1 : 0;
            const int r = base[my] + off[my] + rank; rowl[F.tid] = r; ROW[t0 * 2 + F.tid] = r; GW[r] = GATE[t0 * 2 + F.tid]; TOK[r] = t0 + (F.tid >> 1); RSR[r] = RSQ[t0 + (F.tid >> 1)]; }
    }
}
DI void phase_moe_combine(Frame& F, int l) {
    const bf16_t* YE = (const bf16_t*)(F.wsp() + WS_YE); const int* ROW = (const int*)(F.wsp() + WS_RT + RT_ROW); bf16_t* XN = (bf16_t*)(F.wsp() + WS_XN);
    const float* gain = F.inp(1) + (size_t)(l + 1 < NLAYER ? l + 1 : l) * DM;
    const int gw = F.bid * 8 + F.wave, NGW = F.G * 8; int lane = F.lane;
    for (int tb = gw * 4; tb < T; tb += NGW * 4) {
        int tbase = tb; asm volatile("" : "+s"(tbase), "+v"(lane));
        int r0[4], r1[4];
#pragma unroll
        for (int e = 0; e < 4; ++e) { r0[e] = ROW[(tbase + e) * 2]; r1[e] = ROW[(tbase + e) * 2 + 1]; }
        u32x2 ya[4][4], yb[4][4]; f32x4 xv[4][4];
#pragma unroll
        for (int e = 0; e < 4; ++e) { const u32x2* y0 = (const u32x2*)(YE + (size_t)r0[e] * DM) + lane; const u32x2* y1 = (const u32x2*)(YE + (size_t)r1[e] * DM) + lane; const f32x4* xr = (const f32x4*)(F.outp() + (size_t)(tbase + e) * DM) + lane;
#pragma unroll
            for (int j = 0; j < 4; ++j) { ya[e][j] = y0[64 * j]; yb[e][j] = y1[64 * j]; xv[e][j] = xr[64 * j]; } }
#pragma unroll
        for (int e = 0; e < 4; ++e) { const int t = tbase + e; f32x4* xr = (f32x4*)(F.outp() + (size_t)t * DM) + lane; float s = 0.f;
#pragma unroll
            for (int j = 0; j < 4; ++j) { f32x4 v = xv[e][j]; const u32x2 a = ya[e][j], b = yb[e][j];
                v.x += bflo(a.x) + bflo(b.x); v.y += bfhi(a.x) + bfhi(b.x); v.z += bflo(a.y) + bflo(b.y); v.w += bfhi(a.y) + bfhi(b.y);
                xv[e][j] = v; xr[64 * j] = v; s += (v.x * v.x + v.y * v.y) + (v.z * v.z + v.w * v.w); }
            if (l + 1 < NLAYER) {
                const float rs = __builtin_amdgcn_rsqf(wave_sum(s) * (1.f / DM) + 1e-6f);
#pragma unroll
                for (int j = 0; j < 4; ++j) { const f32x4 g = ((const f32x4*)gain)[lane + 64 * j]; const f32x4 y = xv[e][j] * rs * g; u32x2 w; w.x = pk2(y.x, y.y); w.y = pk2(y.z, y.w); *((u32x2*)(XN + (size_t)t * DM) + lane + 64 * j) = w; }
            } }
    }
}
constexpr size_t TB_WRH = 512 * 1024, TB_WRL = TB_WRH + 48 * 1024 * 2;
DI void phase_conv_router(Frame& F, int l) {
    bf16_t* WRH = (bf16_t*)(F.wsp() + WS_TAB + TB_WRH); bf16_t* WRL = (bf16_t*)(F.wsp() + WS_TAB + TB_WRL);
    const float* gain = F.inp(2) + (size_t)l * DM; const float* wgrp = F.inp(29) + (size_t)l * DM * 4; const float* wexp = F.inp(31) + (size_t)l * DM * 32;
    for (int idx = F.bid * 512 + F.tid; idx < 48 * DM; idx += F.G * 512) { const int n = idx >> 10, k = idx & 1023;
        float v = (n < 4) ? wgrp[k * 4 + n] : (n < 36) ? wexp[k * 32 + (n - 4)] : 0.f; v *= gain[k];
        const bf16_t h = f2bf(v); WRH[idx] = h; WRL[idx] = f2bf(v - bf2f(h)); }
}
DI void phase_router2(Frame& F, int l) {
    LAS float* lgt = (LAS float*)F.lds + F.wave * 1024;
    LAS int* hist = (LAS int*)(F.lds + 8 * 4096);
    const float* x = F.outp(); const bf16_t* WRH = (const bf16_t*)(F.wsp() + WS_TAB + TB_WRH); const bf16_t* WRL = (const bf16_t*)(F.wsp() + WS_TAB + TB_WRL);
    const float* bgrp = F.inp(30) + l * 4; const float* bexp = F.inp(32) + l * 32;
    int* EID = (int*)(F.wsp() + WS_RT + RT_EID); float* GATE = (float*)(F.wsp() + WS_RT + RT_GATE); int* HIST = (int*)(F.wsp() + WS_RT + RT_HIST);
    const int lane = F.lane, r16 = lane & 15, g = lane >> 4;
    bf16_t* XN2 = (bf16_t*)(F.wsp() + WS_AM); const float* gain = F.inp(2) + (size_t)l * DM; float* RSQ = (float*)(F.wsp() + WS_RT + RT_RSQ);
    { int* TOK = (int*)(F.wsp() + WS_RT + RT_TOK); for (int i = F.bid * 512 + F.tid; i < MOE_ROWS; i += F.G * 512) TOK[i] = 0; }
    for (int task = F.bid; task < T / 128; task += F.G) {
        const int t0 = task * 128 + F.wave * 16;
        __syncthreads();
        if (F.tid < 64) hist[F.tid] = 0;
        __syncthreads();
        f32x4 acc[3];
#pragma unroll
        for (int nt = 0; nt < 3; ++nt) acc[nt] = (f32x4){0.f, 0.f, 0.f, 0.f};
        float ss = 0.f;
        const float* xr = x + (size_t)(t0 + r16) * DM + 8 * g; bf16_t* xo = XN2 + (size_t)(t0 + r16) * DM + 8 * g; const float* gp = gain + 8 * g;
#pragma unroll 2
        for (int s = 0; s < 32; ++s) {
            const f32x4 x0 = *(const f32x4*)(xr + 32 * s), x1 = *(const f32x4*)(xr + 32 * s + 4);
            ss += (x0.x * x0.x + x0.y * x0.y) + (x0.z * x0.z + x0.w * x0.w) + (x1.x * x1.x + x1.y * x1.y) + (x1.z * x1.z + x1.w * x1.w);
            { const f32x4 g0 = *(const f32x4*)(gp + 32 * s), g1 = *(const f32x4*)(gp + 32 * s + 4);
              u32x4 w; w.x = pk2(x0.x * g0.x, x0.y * g0.y); w.y = pk2(x0.z * g0.z, x0.w * g0.w); w.z = pk2(x1.x * g1.x, x1.y * g1.y); w.w = pk2(x1.z * g1.z, x1.w * g1.w);
              *(u32x4*)(xo + 32 * s) = w; }
            u32x4 hw, lw; hw.x = pk2(x0.x, x0.y); hw.y = pk2(x0.z, x0.w); hw.z = pk2(x1.x, x1.y); hw.w = pk2(x1.z, x1.w);
            lw.x = pk2(x0.x - bflo(hw.x), x0.y - bfhi(hw.x)); lw.y = pk2(x0.z - bflo(hw.y), x0.w - bfhi(hw.y)); lw.z = pk2(x1.x - bflo(hw.z), x1.y - bfhi(hw.z)); lw.w = pk2(x1.z - bflo(hw.w), x1.w - bfhi(hw.w));
            const bf16x8 ah = __builtin_bit_cast(bf16x8, hw), al = __builtin_bit_cast(bf16x8, lw);
#pragma unroll
            for (int nt = 0; nt < 3; ++nt) { const size_t wo = (size_t)(16 * nt + r16) * DM + 32 * s + 8 * g;
                const bf16x8 bh = *(const bf16x8*)(WRH + wo), bl = *(const bf16x8*)(WRL + wo);
                acc[nt] = mfma16(ah, bh, acc[nt]); acc[nt] = mfma16(ah, bl, acc[nt]); acc[nt] = mfma16(al, bh, acc[nt]); }
        }
        ss += __shfl_xor(ss, 16); ss += __shfl_xor(ss, 32);
        if (g == 0) RSQ[t0 + r16] = __builtin_amdgcn_rsqf(ss * (1.f / DM) + 1e-6f);
#pragma unroll
        for (int nt = 0; nt < 3; ++nt)
#pragma unroll
            for (int r = 0; r < 4; ++r) lgt[(4 * g + r) * 48 + 16 * nt + r16] = acc[nt][r];
        if (g == 0) lgt[768 + r16] = ss;
        LDS_WAIT(); asm volatile("" ::: "memory");
        if (lane < 16) {
            const int t = t0 + lane; const float rs = 1.0f / sqrtf(lgt[768 + lane] * (1.f / DM) + 1e-6f); const LAS float* lr = lgt + lane * 48;
            float lg[4]; int gs = 0; float gm = -INFINITY;
#pragma unroll
            for (int q = 0; q < 4; ++q) { lg[q] = lr[q] * rs + bgrp[q]; if (lg[q] > gm) { gm = lg[q]; gs = q; } }
            float gden = 0.f;
#pragma unroll
            for (int q = 0; q < 4; ++q) gden += expf(lg[q] - gm);
            const float ptop = 1.0f / gden;
            float e0 = -INFINITY, e1 = -INFINITY; int j0 = 0, j1 = 1;
#pragma unroll
            for (int e = 0; e < 8; ++e) { const float le = lr[4 + gs * 8 + e] * rs + bexp[gs * 8 + e];
                if (le > e0) { e1 = e0; j1 = j0; e0 = le; j0 = e; } else if (le > e1) { e1 = le; j1 = e; } }
            const float p1 = expf(e1 - e0);
            const float g0 = ptop / (1.f + p1), g1 = ptop * p1 / (1.f + p1);
            const int ex0 = gs * 8 + j0, ex1 = gs * 8 + j1;
            EID[t * 2] = ex0; EID[t * 2 + 1] = ex1; GATE[t * 2] = g0; GATE[t * 2 + 1] = g1;
            LAS int* hh = hist + (F.wave >> 2) * 32;
            __hip_atomic_fetch_add(&hh[ex0], 1, __ATOMIC_RELAXED, __HIP_MEMORY_SCOPE_WORKGROUP); __hip_atomic_fetch_add(&hh[ex1], 1, __ATOMIC_RELAXED, __HIP_MEMORY_SCOPE_WORKGROUP);
        }
        __syncthreads();
        if (F.tid < 64) HIST[(task * 2 + (F.tid >> 5)) * 32 + (F.tid & 31)] = hist[F.tid];
    }
}
#ifndef MK_PER_PHASE_LAUNCH
#define MK_PER_PHASE_LAUNCH 0
#endif
constexpr int PH_PER_LAYER = 19, NPHASE = PH_PER_LAYER * NLAYER;
struct Args { const float* in[36]; float* out; unsigned char* ws; int ph_lo, ph_hi; };

#ifndef SCAN_NAIVE
#define SCAN_NAIVE 0
#endif
#ifndef PHMASK
#define PHMASK 0x7ffff
#endif
#ifndef DUPMASK
#define DUPMASK 0
#endif
#define NREP(k) ((((DUPMASK) >> (k)) & 1) ? 2 : 1)
#define IN(k) (((PHMASK >> ((k) % PH_PER_LAYER)) & 1) && lo <= (k) && (k) < hi)
#define SEAM(k) do { asm volatile("" : "+s"(barp), "+s"(bar.x)); bar.bar = (unsigned*)barp; if (IN(k) && IN((k) + 1)) xcd_barrier(bar); asm volatile("" : "+s"(F.ws_g), "+s"(F.out_g), "+s"(F.ka), "+s"(F.bid), "+s"(F.G), "+s"(F.lds)); } while (0)
#define FRESH() do { asm volatile("" : "+s"(F.wave)); int l_ = (int)__builtin_amdgcn_mbcnt_hi(~0u, __builtin_amdgcn_mbcnt_lo(~0u, 0u)); asm volatile("" : "+v"(l_)); F.lane = l_; F.tid = F.wave * 64 + l_; } while (0)
__global__ void __launch_bounds__(512, 2) fwd_kernel(Args args) {
    extern __shared__ __attribute__((aligned(16))) unsigned char lds_raw[];
    Frame F;
    F.lds = (LAS unsigned char*)lds_raw;
    F.tid = threadIdx.x; F.lane = F.tid & 63; F.wave = __builtin_amdgcn_readfirstlane(F.tid >> 6);
    F.G = gridDim.x; F.bid = blockIdx.x;
    F.ka = (const __attribute__((address_space(4))) unsigned char*)__builtin_amdgcn_kernarg_segment_ptr();
    F.out_g = (GAS float*)args.out; F.ws_g = (GAS unsigned char*)args.ws;
    volatile LAS unsigned* MISC = (volatile LAS unsigned*)(F.lds + MISC_OFF);
    if (F.tid < 32) MISC[F.tid] = 0u;
    __syncthreads();
    const int lo = args.ph_lo, hi = args.ph_hi;
    GAS unsigned* barp = (GAS unsigned*)(F.ws_g + WS_CTL) + CW_BAR;
    XcdBarrier bar; bar.bar = (unsigned*)barp; bar.x = 0; bar.st = nullptr;
    if (hi - lo > 1) bar = xcd_barrier_post((unsigned*)barp, MISC + 8);

    bf16_t* const XN = (bf16_t*)(F.wsp() + WS_XN);
    bf16_t* const WCAT = (bf16_t*)(F.wsp() + WS_WM + WM_WCAT);
    for (int l = 0; l < NLAYER; ++l) {
        const int P = l * PH_PER_LAYER;
#define PHASE(k) if (IN(P + (k))) for (int rep_ = 0; rep_ < NREP(k); ++rep_)
        PHASE(0) { FRESH(); if (l == 0) { phase_conv_mixer(F, 0); phase_conv_lora2(F, 0); phase_conv_router(F, 0); phase_norm_x(F, F.inp(0), F.inp(1)); } }
        if (l == 0) SEAM(P + 0);
#if defined(XTRA_BARS)
        if (hi - lo > 1) for (int xb_ = 0; xb_ < XTRA_BARS; ++xb_) { asm volatile("" : "+s"(barp), "+s"(bar.x)); bar.bar = (unsigned*)barp; xcd_barrier(bar); }
#endif
        PHASE(1) { FRESH(); const int n1 = (l == 0) ? 2048 : 2304;
            pg8::Gemm g{XN, WCAT, T, n1, DM}; pg8::StaticOrder S; S.init(T, n1, F.G, F.bid);
            pg8::EpiStore E{(bf16_t*)(F.wsp() + WS_RW), 1536, 1536, (bf16_t*)(F.wsp() + WS_LO), LO_W, 0};
            pg8::gemm_phase<pg8::EpiStore, pg8::StaticOrder>(F.lds, g, S, E, F.tid); }
        SEAM(P + 1);
        PHASE(2) { FRESH(); phase_prep_scana(F, l); }
        SEAM(P + 2);
        PHASE(4) { FRESH(); if (F.bid < NB * NH && F.G > 2 * NB * NH) phase_scan_b(F, l); else if (F.G > 2 * NB * NH) phase_scan_c(F, l, NB * NH); else {   } }
        SEAM(P + 5);
        PHASE(6) { FRESH(); pg8::Gemm g{XN, WCAT + (size_t)2304 * DM, T, 1536, DM}; pg8::StaticOrder S; S.init(T, 1536, F.G, F.bid);
            pg8::EpiMoba E{(bf16_t*)(F.wsp() + WS_MO), F.inp(23) + l * 64, F.inp(24) + l * 64, (float*)(F.wsp() + WS_TAB + TB_KMEAN), (int)(TB_KMEAN2 / 4)};
            pg8::gemm_phase<pg8::EpiMoba, pg8::StaticOrder>(F.lds, g, S, E, F.tid); }
        SEAM(P + 6);
        PHASE(8) { FRESH(); phase_moba_gate(F); }
        SEAM(P + 8);
        PHASE(9) { FRESH(); phase_moba_attn(F, l); }
        SEAM(P + 9);
        PHASE(10) { FRESH(); phase_moba_combine(F); }
        SEAM(P + 10);
        PHASE(11) { FRESH(); pg8::Gemm g{XN, WCAT + (size_t)3840 * DM, T, 2048, DM}; pg8::StaticOrder S; S.init(T, 2048, F.G, F.bid);
            pg8::EpiStore E{(bf16_t*)(F.wsp() + WS_GA), 2048, 0, nullptr, 0, 1};
            pg8::gemm_phase<pg8::EpiStore, pg8::StaticOrder>(F.lds, g, S, E, F.tid); }
        SEAM(P + 11);
        PHASE(12) { FRESH(); pg8::Gemm g{(const bf16_t*)(F.wsp() + WS_YRM), (const bf16_t*)(F.wsp() + WS_WM + WM_BRR), T, DM, DM}; pg8::StaticOrder S; S.init(T, DM, F.G, F.bid);
            pg8::EpiBranch2 E{(bf16_t*)(F.wsp() + WS_H), (const bf16_t*)(F.wsp() + WS_GA)};
            pg8::gemm_phase<pg8::EpiBranch2, pg8::StaticOrder>(F.lds, g, S, E, F.tid); }
        SEAM(P + 12);
        PHASE(13) { FRESH(); pg8::Gemm g{(const bf16_t*)(F.wsp() + WS_H), (const bf16_t*)(F.wsp() + WS_WM + WM_OUT), T, DM, DM}; pg8::StaticOrder S; S.init(T, DM, F.G, F.bid);
            pg8::EpiResid E{l == 0 ? F.inp(0) : F.outp(), F.outp()};
            pg8::gemm_phase<pg8::EpiResid, pg8::StaticOrder>(F.lds, g, S, E, F.tid); }
        SEAM(P + 13);
        PHASE(14) { FRESH(); phase_router2(F, l); }
        SEAM(P + 14);
        PHASE(15) { FRESH(); phase_moe_gather(F, l); }
        SEAM(P + 15);
        PHASE(16) { FRESH(); const int* PEXP = (const int*)(F.wsp() + WS_RT + RT_PEXP); const int np = __builtin_amdgcn_readfirstlane(PEXP[MOE_PANELS]);
            pg8::Gemm g{(const bf16_t*)(F.wsp() + WS_AM), (const bf16_t*)(F.wsp() + WS_WE), np * 256, 1024, DM}; pg8::GatherOrder S; S.init(np * 256, 1024, F.G, F.bid); S.pexp = PEXP;
            LAS int* tokL = (LAS int*)(F.lds + RING_BYTES); S.tokL = tokL;
            { const int* TOK = (const int*)(F.wsp() + WS_RT + RT_TOK); __syncthreads();
              for (int i = 0; i < 16; ++i) { pg8::Unit uu; if (!S.next(i, uu)) break; if (F.tid < 256) tokL[i * 256 + F.tid] = TOK[uu.pm * 256 + F.tid]; }
              __syncthreads(); }
            pg8::EpiExpertUp E{(bf16_t*)(F.wsp() + WS_HM), (const float*)(F.wsp() + WS_RT + RT_GW), (const float*)(F.wsp() + WS_RT + RT_RSR)};
            pg8::gemm_phase<pg8::EpiExpertUp, pg8::GatherOrder>(F.lds, g, S, E, F.tid); }
        SEAM(P + 16);
        PHASE(17) { FRESH(); const int* PEXP = (const int*)(F.wsp() + WS_RT + RT_PEXP); const int np = __builtin_amdgcn_readfirstlane(PEXP[MOE_PANELS]);
            pg8::Gemm g{(const bf16_t*)(F.wsp() + WS_HM), (const bf16_t*)(F.wsp() + WS_WD), np * 256, 1024, DEXP}; pg8::GroupOrder S; S.init(np * 256, 1024, F.G, F.bid); S.pexp = PEXP;
            pg8::EpiStore E{(bf16_t*)(F.wsp() + WS_YE), 1024, 0, nullptr, 0, 0};
            pg8::gemm_phase<pg8::EpiStore, pg8::GroupOrder>(F.lds, g, S, E, F.tid); }
        SEAM(P + 17);
        PHASE(18) { FRESH(); phase_moe_combine(F, l); if (l + 1 < NLAYER) { phase_conv_mixer(F, l + 1); phase_conv_lora2(F, l + 1); phase_conv_router(F, l + 1); } }
        SEAM(P + 18);
#undef PHASE
    }
}

extern "C" void kernel_launch(void* const* d_in, const int* in_sizes, int n_in, void* d_out, int out_size, void* d_ws, size_t ws_size, hipStream_t stream) {
    static int grid = 0;
    if (grid == 0) {
        if (n_in != 36 || out_size != T * DM || ws_size < WS_NEED) { fprintf(stderr, "kernel_launch: unexpected problem (n_in %d, out %d, ws %zu); nothing launched\n", n_in, out_size, ws_size); grid = -1; return; }
        int dev = 0, cus = 0;
        if (hipGetDevice(&dev) != hipSuccess || hipDeviceGetAttribute(&cus, hipDeviceAttributeMultiprocessorCount, dev) != hipSuccess) { grid = -1; return; }
        if (hipFuncSetAttribute((const void*)fwd_kernel, hipFuncAttributeMaxDynamicSharedMemorySize, LDS_BYTES) != hipSuccess) { fprintf(stderr, "kernel_launch: hipFuncSetAttribute failed\n"); grid = -1; return; }
        int per_cu = 0;
        if (hipOccupancyMaxActiveBlocksPerMultiprocessor(&per_cu, (const void*)fwd_kernel, 512, LDS_BYTES) != hipSuccess || per_cu < 1) { fprintf(stderr, "kernel_launch: occupancy query says %d\n", per_cu); }
        (void)hipGetLastError();
        grid = cus;
    }
    if (grid < 0) return;
    (void)hipMemsetAsync((char*)d_ws + WS_CTL, 0, CTL_ZERO_BYTES, stream);
    Args a{};
    for (int i = 0; i < 36; ++i) a.in[i] = (const float*)d_in[i];
    a.out = (float*)d_out; a.ws = (unsigned char*)d_ws;
#if MK_PER_PHASE_LAUNCH
    for (int ph = 0; ph < NPHASE; ++ph) { if (ph == PH_PER_LAYER) continue; a.ph_lo = ph; a.ph_hi = ph + 1; hipLaunchKernelGGL(fwd_kernel, dim3(grid), dim3(512), LDS_BYTES, stream, a); }
#else
    a.ph_lo = 0; a.ph_hi = NPHASE;
    hipLaunchKernelGGL(fwd_kernel, dim3(grid), dim3(512), LDS_BYTES, stream, a);
#endif
}
```

```cpp
#include <hip/hip_runtime.h>
#include <cstdio>
#include <cstdint>
#define LAS __attribute__((address_space(3)))
#define GAS __attribute__((address_space(1)))
#define DI __device__ __forceinline__
typedef unsigned short bf16_t;
typedef short bf16x8 __attribute__((ext_vector_type(8)));
typedef short s16x4 __attribute__((ext_vector_type(4)));
typedef float f32x4 __attribute__((ext_vector_type(4)));
typedef float f32x2 __attribute__((ext_vector_type(2)));
typedef float f32x16 __attribute__((ext_vector_type(16)));
typedef unsigned u32x4 __attribute__((ext_vector_type(4)));
typedef unsigned u32x2 __attribute__((ext_vector_type(2)));
typedef __bf16 bf16v2 __attribute__((ext_vector_type(2)));

DI unsigned pk2(float lo, float hi) { f32x2 v = {lo, hi}; return __builtin_bit_cast(unsigned, __builtin_convertvector(v, bf16v2)); }
DI bf16_t f2bf(float f) { return (bf16_t)(pk2(f, 0.f) & 0xffffu); }
DI float bf2f(bf16_t b) { return __uint_as_float(((unsigned)b) << 16); }
DI float bflo(unsigned w) { return __uint_as_float(w << 16); }
DI float bfhi(unsigned w) { return __uint_as_float(w & 0xffff0000u); }
DI float rcpf_(float x) { return __builtin_amdgcn_rcpf(x); }
DI float sigmoidf_(float x) { return __builtin_amdgcn_rcpf(1.0f + __expf(-x)); }

template <int CTRL> DI float dpp_mov(float v) { return __builtin_bit_cast(float, __builtin_amdgcn_update_dpp(0, __builtin_bit_cast(int, v), CTRL, 0xf, 0xf, true)); }
DI float rdlane(float v, int l) { return __builtin_bit_cast(float, __builtin_amdgcn_readlane(__builtin_bit_cast(int, v), l)); }
DI float wave_sum(float v) {
    v += dpp_mov<0xB1>(v);
    v += dpp_mov<0x4E>(v);
    v += dpp_mov<0x141>(v);
    v += dpp_mov<0x140>(v);
    return (rdlane(v, 0) + rdlane(v, 16)) + (rdlane(v, 32) + rdlane(v, 48));
}
DI f32x4 mfma16(bf16x8 a, bf16x8 b, f32x4 c) { return __builtin_amdgcn_mfma_f32_16x16x32_bf16(a, b, c, 0, 0, 0); }
namespace pg8 {
constexpr int BM = 256, BK = 64, HALF = 128, HTB = HALF * BK * 2  , STAGE_BYTES = 8 * HTB, NXCD = 8, WGM = 8;

__host__ __device__ __forceinline__ int lds_byte(int r, int c) { const int st = (r >> 4) * 2 + (c >> 5), rr = r & 15, cc = c & 31, ob = rr * 64 + cc * 2; return st * 1024 + (ob ^ (((ob >> 9) & 1) << 5)); }
__host__ __device__ __forceinline__ void stage_rc(int b, int& R, int& C) { const int st = b / 1024, sb = b % 1024, swz = sb ^ (((sb >> 9) & 1) << 5); R = (st >> 1) * 16 + swz / 64; C = (st & 1) * 32 + (swz % 64) / 2; }
__host__ __device__ __forceinline__ int perm32(int rho) { const int n = rho >> 4, i = rho & 15; return 8 * (i >> 2) + 4 * n + (i & 3); }

struct Unit { int pm, pn, pb; };
struct Gemm { const bf16_t* A; const bf16_t* Bt; int M, N, K; };

struct StaticOrder {
    static constexpr bool GATHER = false;
    int nM, nN, nwg, G, c;
    __device__ __forceinline__ void init(int M, int N, int G_, int c_) { nM = M / BM; nN = N / BM; nwg = nM * nN; G = G_; c = c_; }
    __device__ __forceinline__ bool next(int i, Unit& u) const {
        const long L = (long)i * G + c; if (L >= nwg) return false;
        int wgid = (int)L; { const int q = nwg / NXCD, r = nwg % NXCD, xcd = wgid % NXCD, off = wgid / NXCD; wgid = (xcd < r ? xcd * (q + 1) : r * (q + 1) + (xcd - r) * q) + off; }
        const int nig = WGM * nN, gid = wgid / nig, fm = gid * WGM, gsz = (nM - fm) < WGM ? (nM - fm) : WGM;
        u.pm = fm + ((wgid % nig) % gsz); u.pn = (wgid % nig) / gsz; u.pb = u.pn; return true;
    }
};
struct GroupOrder : StaticOrder {
    const int* pexp;
    __device__ __forceinline__ bool next(int i, Unit& u) const {
        if (!StaticOrder::next(i, u)) return false;
        u.pb = __builtin_amdgcn_readfirstlane(pexp[u.pm]) * nN + u.pn; return true;
    }
};
struct GatherOrder : GroupOrder {
    static constexpr bool GATHER = true;
    const LAS int* tokL;
};

template <class Epi, class Sched, bool ALIGN_EPI = true, bool SP2 = true>
__device__ __forceinline__ void gemm_phase(LAS unsigned char* lds, const Gemm g, const Sched& S, const Epi& E, int tid_in) {
    const int tid = tid_in, wid = __builtin_amdgcn_readfirstlane(tid >> 6), lane = tid & 63, wr = wid >> 2, wc = wid & 3, fr = lane & 15, fq = lane >> 4;
    const int K = g.K, nt = K / BK;
    unsigned voffA[2], voffB[2];
#pragma unroll
    for (int i = 0; i < 2; ++i) { int R, C; stage_rc(tid * 16 + i * 8192, R, C); const int Rb = Epi::HEADS ? (64 * (R >> 5) + perm32(R & 31)) : Epi::PERM ? ((R & ~31) + perm32(R & 31)) : R;
        voffA[i] = (unsigned)(R * K + C) * 2u; voffB[i] = (unsigned)(Rb * K + C) * 2u; }
    unsigned goff[2][2] = {{0u, 0u}, {0u, 0u}}, goffN[2][2] = {{0u, 0u}, {0u, 0u}};
#define PG8_GOFF(dst, ui_) do { if constexpr (Sched::GATHER) { _Pragma("unroll") for (int h_ = 0; h_ < 2; ++h_) _Pragma("unroll") for (int i_ = 0; i_ < 2; ++i_) { int R_, C_; stage_rc(tid * 16 + i_ * 8192, R_, C_); \
        const int tk_ = S.tokL[(ui_) * 256 + 128 * h_ + R_]; dst[h_][i_] = (unsigned)(tk_ * K + C_) * 2u; } } } while (0)
#define PG8_STAGE_A(bufoff, kt, h, usenext) do { if constexpr (Sched::GATHER) { unsigned vo_[2] = { (usenext) ? goffN[h][0] : goff[h][0], (usenext) ? goffN[h][1] : goff[h][1] }; PG8_STAGE(bufoff, kt, vo_); } \
        else { PG8_STAGE(bufoff, (kt) + ((h) ? hstep : 0), voffA); } } while (0)
    const size_t kstep = (size_t)(BK * 2);
    const size_t hstep = (size_t)HALF * K * 2;
    const size_t hstepB = Epi::HEADS ? (size_t)32 * K * 2 : hstep;
    const size_t tstep = 2 * hstep;
    const unsigned ldsw = (unsigned)wid * 1024u;
    const int aoff = lds_byte(wr * 64 + fr, fq * 8), boff = lds_byte(wc * 32 + fr, fq * 8);
#define PG8_SA(b, h) (((b) * 2 + (h)) * HTB)
#define PG8_SB(b, h) ((4 + (b) * 2 + (h)) * HTB)
#define PG8_STAGE(bufoff, gbase, voff) do { _Pragma("unroll") for (int _i = 0; _i < 2; ++_i) \
        __builtin_amdgcn_global_load_lds((const unsigned*)((const char*)(gbase) + (voff)[_i]), (LAS unsigned*)(lds + (bufoff) + ldsw + _i * 8192), 16, 0, 0); } while (0)
#define PG8_LDA(dst, b, h) do { _Pragma("unroll") for (int m = 0; m < 4; ++m) _Pragma("unroll") for (int k = 0; k < 2; ++k) dst[m][k] = *(const LAS bf16x8*)(lds + PG8_SA(b, h) + aoff + m * 2048 + k * 1024); } while (0)
#define PG8_LDB(dst, b, h) do { _Pragma("unroll") for (int n = 0; n < 2; ++n) _Pragma("unroll") for (int k = 0; k < 2; ++k) dst[n][k] = *(const LAS bf16x8*)(lds + PG8_SB(b, h) + boff + n * 2048 + k * 1024); } while (0)
#define PG8_MMA(ai, bj, At, Bt) do { __builtin_amdgcn_s_setprio(1); _Pragma("unroll") for (int m = 0; m < 4; ++m) _Pragma("unroll") for (int n = 0; n < 2; ++n) _Pragma("unroll") for (int k = 0; k < 2; ++k) \
        acc[ai][bj][m][n] = __builtin_amdgcn_mfma_f32_16x16x32_bf16(Bt[n][k], At[m][k], acc[ai][bj][m][n], 0, 0, 0); __builtin_amdgcn_s_setprio(0); } while (0)
#define PG8_WAIT_V(n) asm volatile("s_waitcnt vmcnt(" #n ")" ::: "memory")
#define PG8_WAIT_L(n) asm volatile("s_waitcnt lgkmcnt(" #n ")" ::: "memory")
#define PG8_BAR __builtin_amdgcn_s_barrier()
#define PG8_SCHED __builtin_amdgcn_sched_barrier(0)
    Unit cur, nxt; int ui = 0;
    if (!S.next(0, cur)) return;
    f32x4 acc[2][2][4][2];
#pragma unroll
    for (int a = 0; a < 2; ++a)
#pragma unroll
        for (int b = 0; b < 2; ++b)
#pragma unroll
            for (int m = 0; m < 4; ++m)
#pragma unroll
                for (int n = 0; n < 2; ++n) acc[a][b][m][n] = (f32x4){0.f, 0.f, 0.f, 0.f};
    bf16x8 At[4][2], B0[2][2], B1[2][2];
    const char* cA = (const char*)g.A + (Sched::GATHER ? (size_t)0 : (size_t)cur.pm * tstep); const char* cB = (const char*)g.Bt + (size_t)cur.pb * tstep;
    PG8_GOFF(goff, 0);
    if constexpr (SP2) {
        PG8_STAGE(PG8_SB(0, 0), cB, voffB); PG8_STAGE(PG8_SB(0, 1), cB + hstepB, voffB); PG8_STAGE_A(PG8_SA(0, 0), cA, 0, false); PG8_STAGE_A(PG8_SA(0, 1), cA, 1, false);
        if (wr == 1) PG8_BAR;
        PG8_WAIT_V(2); PG8_BAR;
        PG8_STAGE(PG8_SB(1, 0), cB + kstep, voffB); PG8_STAGE_A(PG8_SA(1, 0), cA + kstep, 0, false); PG8_STAGE(PG8_SB(1, 1), cB + hstepB + kstep, voffB);
        PG8_WAIT_V(6); PG8_BAR;
    } else {
        PG8_STAGE(PG8_SB(0, 0), cB, voffB); PG8_STAGE_A(PG8_SA(0, 0), cA, 0, false); PG8_STAGE(PG8_SB(0, 1), cB + hstepB, voffB); PG8_STAGE_A(PG8_SA(0, 1), cA, 1, false);
        if (wr == 1) PG8_BAR;
        PG8_WAIT_V(4); PG8_BAR;
        PG8_STAGE(PG8_SB(1, 0), cB + kstep, voffB); PG8_STAGE_A(PG8_SA(1, 0), cA + kstep, 0, false); PG8_STAGE(PG8_SB(1, 1), cB + hstepB + kstep, voffB);
        PG8_WAIT_V(6); PG8_BAR;
    }
    for (;;) {
        const bool has_next = S.next(ui + 1, nxt);
        const char* nA = (has_next && !Sched::GATHER) ? (const char*)g.A + (size_t)nxt.pm * tstep : cA; const char* nB = has_next ? (const char*)g.Bt + (size_t)nxt.pb * tstep : cB;
        if constexpr (Sched::GATHER) { if (has_next) PG8_GOFF(goffN, ui + 1); else { goffN[0][0] = goff[0][0]; goffN[0][1] = goff[0][1]; goffN[1][0] = goff[1][0]; goffN[1][1] = goff[1][1]; } }
        for (int t = 0; t < nt; t += 2) {
            if constexpr (Epi::HAS_MID) { if (t == nt / 2) E.mid(acc, cur, wr, wc, fr, fq); }
            const bool last = (t == nt - 2);
            const char* a1 = cA + (size_t)(t + 1) * kstep;
            const char* a2 = last ? nA : cA + (size_t)(t + 2) * kstep; const char* b2 = last ? nB : cB + (size_t)(t + 2) * kstep;
            const char* a3 = a2 + kstep; const char* b3 = b2 + kstep;
            if constexpr (SP2) {
            PG8_LDB(B0, 0, 0); PG8_LDB(B1, 0, 1); PG8_SCHED; PG8_LDA(At, 0, 0); PG8_STAGE_A(PG8_SA(1, 1), a1, 1, false);
            PG8_WAIT_V(8); PG8_WAIT_L(0); PG8_BAR; PG8_MMA(0, 0, At, B0); PG8_MMA(0, 1, At, B1); PG8_BAR; PG8_SCHED;
            PG8_LDA(At, 0, 1); PG8_STAGE(PG8_SB(0, 0), b2, voffB); PG8_STAGE(PG8_SB(0, 1), b2 + hstepB, voffB); PG8_STAGE_A(PG8_SA(0, 0), a2, 0, last);
            PG8_WAIT_V(8); PG8_WAIT_L(0); PG8_BAR; PG8_MMA(1, 0, At, B0); PG8_MMA(1, 1, At, B1); PG8_BAR; PG8_SCHED;
            PG8_LDB(B0, 1, 0); PG8_LDB(B1, 1, 1); PG8_SCHED; PG8_LDA(At, 1, 0); PG8_STAGE_A(PG8_SA(0, 1), a2, 1, last);
            PG8_WAIT_V(8); PG8_WAIT_L(0); PG8_BAR; PG8_MMA(0, 0, At, B0); PG8_MMA(0, 1, At, B1); PG8_BAR; PG8_SCHED;
            PG8_LDA(At, 1, 1); PG8_STAGE(PG8_SB(1, 0), b3, voffB); PG8_STAGE(PG8_SB(1, 1), b3 + hstepB, voffB); PG8_STAGE_A(PG8_SA(1, 0), a3, 0, last);
            PG8_WAIT_V(8); PG8_WAIT_L(0); PG8_BAR; PG8_MMA(1, 0, At, B0); PG8_MMA(1, 1, At, B1); PG8_BAR; PG8_SCHED;
            } else {
            PG8_LDB(B0, 0, 0); PG8_SCHED; PG8_LDA(At, 0, 0); PG8_STAGE_A(PG8_SA(1, 1), a1, 1, false);
            PG8_WAIT_L(8); PG8_BAR; PG8_WAIT_L(0); PG8_MMA(0, 0, At, B0); PG8_BAR; PG8_SCHED;
            PG8_LDB(B1, 0, 1); PG8_STAGE(PG8_SB(0, 0), b2, voffB);
            PG8_BAR; PG8_WAIT_L(0); PG8_MMA(0, 1, At, B1); PG8_BAR;
            PG8_LDA(At, 0, 1); PG8_STAGE_A(PG8_SA(0, 0), a2, 0, last);
            PG8_BAR; PG8_WAIT_L(0); PG8_MMA(1, 0, At, B0); PG8_BAR; PG8_SCHED;
            PG8_STAGE(PG8_SB(0, 1), b2 + hstepB, voffB);
            PG8_WAIT_V(6); PG8_BAR; PG8_MMA(1, 1, At, B1); PG8_BAR;
            PG8_LDB(B0, 1, 0); PG8_SCHED; PG8_LDA(At, 1, 0); PG8_STAGE_A(PG8_SA(0, 1), a2, 1, last);
            PG8_WAIT_L(8); PG8_BAR; PG8_WAIT_L(0); PG8_MMA(0, 0, At, B0); PG8_BAR; PG8_SCHED;
            PG8_LDB(B1, 1, 1); PG8_STAGE(PG8_SB(1, 0), b3, voffB);
            PG8_BAR; PG8_WAIT_L(0); PG8_MMA(0, 1, At, B1); PG8_BAR;
            PG8_LDA(At, 1, 1); PG8_STAGE_A(PG8_SA(1, 0), a3, 0, last);
            PG8_BAR; PG8_WAIT_L(0); PG8_MMA(1, 0, At, B0); PG8_BAR; PG8_SCHED;
            PG8_STAGE(PG8_SB(1, 1), b3 + hstepB, voffB);
            PG8_WAIT_V(6); PG8_BAR; PG8_MMA(1, 1, At, B1); PG8_BAR;
            }
        }
        if constexpr (ALIGN_EPI) { if (wr == 0) PG8_BAR; }
        E(acc, cur, wr, wc, fr, fq);
        if (!has_next) break;
#pragma unroll
        for (int a = 0; a < 2; ++a)
#pragma unroll
            for (int b = 0; b < 2; ++b)
#pragma unroll
                for (int m = 0; m < 4; ++m)
#pragma unroll
                    for (int n = 0; n < 2; ++n) acc[a][b][m][n] = (f32x4){0.f, 0.f, 0.f, 0.f};
        cur = nxt; cA = nA; cB = nB; ++ui;
        if constexpr (Sched::GATHER) { goff[0][0] = goffN[0][0]; goff[0][1] = goffN[0][1]; goff[1][0] = goffN[1][0]; goff[1][1] = goffN[1][1]; }
        if constexpr (ALIGN_EPI) { if (wr == 1) PG8_BAR; }
    }
    PG8_WAIT_V(0);
    if constexpr (!ALIGN_EPI) { if (wr == 0) PG8_BAR; }
    PG8_BAR;
#undef PG8_SA
#undef PG8_GOFF
#undef PG8_STAGE_A
#undef PG8_SB
#undef PG8_STAGE
#undef PG8_LDA
#undef PG8_LDB
#undef PG8_MMA
#undef PG8_WAIT_V
#undef PG8_WAIT_L
#undef PG8_BAR
#undef PG8_SCHED
}
}
#define XB_TMO      128
#define XB_XCNT(j)  (256  + 64 * (j))
#define XB_XSUB(j)  (1280 + 64 * (j))
#define XB_XGEN(j)  (2304 + 64 * (j))
#define XB_TOP      3328
#define XB_TOPGEN   3392
#define XCD_BAR_WORDS 3456
#define XB_SPIN_CAP (1u << 18)

__device__ __forceinline__ unsigned xb_ld(unsigned* p)              { return __hip_atomic_load(p, __ATOMIC_RELAXED, __HIP_MEMORY_SCOPE_AGENT); }
__device__ __forceinline__ unsigned xb_add(unsigned* p, unsigned v) { return __hip_atomic_fetch_add(p, v, __ATOMIC_RELAXED, __HIP_MEMORY_SCOPE_AGENT); }
__device__ __forceinline__ unsigned xb_xcc_id() { return (unsigned)__builtin_amdgcn_s_getreg((3 << 11) | 20) & 0xFu; }
#define XB_SPIN(cond, bar) do { unsigned _sp = 0; while (cond) { __builtin_amdgcn_s_sleep(1); \
    if ((++_sp & 255u) == 0u) { if (xb_ld(&(bar)[XB_TMO])) break; if (_sp > XB_SPIN_CAP) { atomicAdd(&(bar)[XB_TMO], 1u); break; } } } } while (0)

struct XcdBarrier {
    unsigned* bar; unsigned x;
    volatile LAS unsigned* st;
};

__device__ __forceinline__ XcdBarrier xcd_barrier_post(unsigned* bar, volatile LAS unsigned* st) {
    XcdBarrier b; b.bar = bar; b.x = xb_xcc_id(); b.st = st;
    if (threadIdx.x == 0) (void)xb_add(&bar[XB_XCNT(b.x)], 1u);
    return b;
}
__device__ __forceinline__ void xcd_barrier_complete(unsigned* bar, unsigned x, unsigned& nloc, unsigned& nx) {
    const unsigned G = gridDim.x * gridDim.y * gridDim.z;
    unsigned sum, cnt, mine, sp = 0u;
    for (;;) {
        sum = 0u; cnt = 0u; mine = 0u;
#pragma unroll
        for (unsigned j = 0; j < 16; ++j) { const unsigned c = xb_ld(&bar[XB_XCNT(j)]); sum += c; cnt += (c > 0u) ? 1u : 0u; mine = (j == x) ? c : mine; }
        if (sum == G) break;
        __builtin_amdgcn_s_sleep(1);
        if ((++sp & 255u) == 0u) { if (xb_ld(&bar[XB_TMO])) break; if (sp > XB_SPIN_CAP) { atomicAdd(&bar[XB_TMO], 1u); break; } }
    }
    nloc = mine > 0u ? mine : 1u; nx = cnt > 0u ? cnt : 1u;
}

__device__ __forceinline__ void xcd_barrier(const XcdBarrier& b) {
    asm volatile("s_waitcnt vmcnt(0)" ::: "memory");
    __syncthreads();
    if (threadIdx.x == 0) {
        unsigned* bar = b.bar;
        __builtin_amdgcn_s_waitcnt(0);
        unsigned nloc = b.st[0], nx = b.st[1];
        if (nloc == 0u) { xcd_barrier_complete(bar, b.x, nloc, nx); b.st[0] = nloc; b.st[1] = nx; }
        const unsigned old = xb_add(&bar[XB_XSUB(b.x)], 1u);
        const unsigned gen = old / nloc;
        if (old + 1u == (gen + 1u) * nloc) {
            __builtin_amdgcn_fence(__ATOMIC_RELEASE, "agent");
            asm volatile("s_waitcnt vmcnt(0)" ::: "memory");
            const unsigned og = xb_add(&bar[XB_TOP], 1u);
            const unsigned tg = og / nx;
            if (og + 1u == (tg + 1u) * nx) xb_add(&bar[XB_TOPGEN], 1u);
            else XB_SPIN(xb_ld(&bar[XB_TOPGEN]) == tg, bar);
            __builtin_amdgcn_fence(__ATOMIC_ACQUIRE, "agent");
            xb_add(&bar[XB_XGEN(b.x)], 1u);
            asm volatile("s_waitcnt vmcnt(0)" ::: "memory");
        } else {
            XB_SPIN(xb_ld(&bar[XB_XGEN(b.x)]) == gen, bar);
            __builtin_amdgcn_fence(__ATOMIC_ACQUIRE, "agent");
            asm volatile("s_waitcnt vmcnt(0)" ::: "memory");
        }
    }
    __syncthreads();
}
constexpr int NB = 4, SEQ = 8192, DM = 1024, T = NB * SEQ;
constexpr int NH = 8, HD = 64, CW = 512;
constexpr int N_IN = 5120;
constexpr int NLAYER = 2;
constexpr int NEXP = 32, DEXP = 512;
constexpr int MOE_ROWS = 73728, MOE_PANELS = MOE_ROWS / 256;
constexpr int WCAT_ROWS = 5888;
constexpr int LO_W = 768;

constexpr size_t MiB = 1u << 20;
constexpr size_t WS_CTL = 0, CTL_ZERO_BYTES = 1 * MiB;
constexpr size_t WS_VF   = 1 * MiB;
constexpr size_t WS_TAB  = 33 * MiB;
constexpr size_t WS_WM   = 34 * MiB;
constexpr size_t WS_XN   = 50 * MiB;
constexpr size_t WS_RW   = 114 * MiB;
constexpr size_t WS_MO   = 178 * MiB;
constexpr size_t WS_LO   = 210 * MiB;
constexpr size_t WS_YRM  = 114 * MiB;
constexpr int YRM_LD = 1024;
constexpr size_t WS_SIR  = 258 * MiB;
constexpr size_t WS_SIK  = 322 * MiB;
constexpr size_t WS_SCRW = 290 * MiB, WS_SCRA = 306 * MiB, WS_SCRB = 546 * MiB;
constexpr size_t WS_V1   = 418 * MiB;
constexpr size_t WS_G    = 450 * MiB;
constexpr size_t WS_YS   = 482 * MiB;
constexpr size_t WS_PO   = 418 * MiB;
constexpr size_t WS_PST  = 274 * MiB;
constexpr size_t WS_GA   = 418 * MiB;
constexpr size_t WS_H    = 50 * MiB;
constexpr size_t WS_SC1  = 482 * MiB;
constexpr size_t WS_SC2  = 354 * MiB;
constexpr size_t WS_SCT  = 290 * MiB;
constexpr size_t WS_WE   = 290 * MiB;
constexpr size_t WS_WD   = 354 * MiB;
constexpr size_t WS_AM   = 130 * MiB;
constexpr size_t WS_HM   = 194 * MiB;
constexpr size_t WS_YE   = 386 * MiB;
constexpr size_t WS_RT   = 546 * MiB;
constexpr size_t WS_END  = 556 * MiB;
constexpr size_t TB_KMEAN = 0;
constexpr size_t TB_KMEAN2 = 256 * 1024;
constexpr size_t TB_SEL   = 256 * 1024;
constexpr size_t RT_EID  = 0;
constexpr size_t RT_GATE = 256 * 1024;
constexpr size_t RT_ROW  = 512 * 1024;
constexpr size_t RT_GW   = 768 * 1024;
constexpr size_t RT_HIST = 1280 * 1024;
constexpr size_t RT_PEXP = 1408 * 1024;
constexpr size_t RT_TOK  = 1536 * 1024;
constexpr size_t RT_RSQ  = 2048 * 1024;
constexpr size_t RT_RSR  = 2304 * 1024;
constexpr size_t WS_SEL  = 562 * MiB;
constexpr size_t WS_NEED = 564 * MiB;
constexpr int CW_BAR = 4096;

constexpr int RING_BYTES = 131072;
constexpr int LDS_BYTES = 163840;
constexpr int MISC_OFF = LDS_BYTES - 256;
struct Frame {
    LAS unsigned char* lds;
    int tid, lane, wave;
    int G, bid;
    const __attribute__((address_space(4))) unsigned char* ka;
    GAS float* out_g; GAS unsigned char* ws_g;
    DI float* outp() const { return (float*)out_g; }
    DI unsigned char* wsp() const { return (unsigned char*)ws_g; }
    DI const float* inp(int i) const { return (const float*)(*(const GAS float* const __attribute__((address_space(4)))*)(ka + 8 * i)); }
};
#define LDS_WAIT() asm volatile("s_waitcnt lgkmcnt(0)" ::: "memory")

DI void tr_item(const float* src, int ld, int k0, bf16_t* dst, int Kd, const float* sc, int mode, LAS float* scr, int lane) {
#pragma unroll 8
    for (int i = 0; i < 32; ++i) { const int kk = 2 * i + (lane >> 5);
        float v = src ? src[(size_t)(k0 + kk) * ld + (lane & 31)] : 0.f;
        if (mode == 1) v *= sc[k0 + kk]; else if (mode == 2) v *= (1.f - sc[k0 + kk]);
        scr[kk * 33 + (lane & 31)] = v; }
    LDS_WAIT(); asm volatile("" ::: "memory");
    const int c = lane & 7;
#pragma unroll
    for (int j = 0; j < 4; ++j) { const int n = (lane >> 3) + 8 * j; const LAS float* s = scr + (8 * c) * 33 + n;
        u32x4 o; o.x = pk2(s[0 * 33], s[1 * 33]); o.y = pk2(s[2 * 33], s[3 * 33]); o.z = pk2(s[4 * 33], s[5 * 33]); o.w = pk2(s[6 * 33], s[7 * 33]);
        *(u32x4*)(dst + (size_t)n * Kd + k0 + 8 * c) = o; }
    LDS_WAIT(); asm volatile("" ::: "memory");
}

constexpr size_t WM_WCAT = 0, WM_BRR = (size_t)WCAT_ROWS * 1024 * 2, WM_BRM = WM_BRR + 1024 * 512 * 2, WM_OUT = WM_BRM + 1024 * 512 * 2;
DI void phase_conv_mixer(Frame& F, int l) {
    LAS float* scr = (LAS float*)(F.lds + F.wave * 16384);
    const int gw = F.bid * 8 + F.wave, NGW = F.G * 8;
    bf16_t* wcat = (bf16_t*)(F.wsp() + WS_WM + WM_WCAT);
    const float* w_in = F.inp(3) + (size_t)l * DM * N_IN;
    const float* mu_x = F.inp(5) + (size_t)l * 3 * DM;
    constexpr int NBLK = WCAT_ROWS / 32;
    constexpr int I_CAT = NBLK * 16, I_BR = 8 * 32, I_OUT = 16 * 32;
    for (int it = gw; it < I_CAT + 2 * I_BR + I_OUT; it += NGW) {
        int r = it;
        if (r < I_CAT) {
            const int nb = r / 16, kb = r % 16, k0 = kb * 64;
            if (nb < 48) { tr_item(w_in + 32 * nb, N_IN, k0, wcat + (size_t)(32 * nb) * 1024, 1024, nullptr, 0, scr, F.lane); }
            else if (nb < 72) {
                const int q = nb - 48; const float* src = nullptr; int ld = 0; const float* sc = nullptr; int mode = 0;
                if (q < 4)       { src = F.inp(7)  + (size_t)l * DM * 64  + 32 * (q & 1); ld = 64;  sc = mu_x;          mode = (q < 2) ? 2 : 1; }
                else if (q < 8)  { src = F.inp(10) + (size_t)l * DM * 64  + 32 * (q & 1); ld = 64;  sc = mu_x + DM;     mode = (q < 6) ? 2 : 1; }
                else if (q < 16) { src = F.inp(12) + (size_t)l * DM * 128 + 32 * (q & 3); ld = 128; sc = mu_x + 2 * DM; mode = (q < 12) ? 2 : 1; }
                else if (q < 18 && l > 0) { src = F.inp(21) + (size_t)(l - 1) * DM * 32; ld = 32; sc = F.inp(19) + (size_t)(l - 1) * DM; mode = (q == 16) ? 2 : 1; }
                tr_item(src, ld, k0, wcat + (size_t)(1536 + 32 * q) * 1024, 1024, sc, mode, scr, F.lane);
            }
            else if (nb < 120) { tr_item(w_in + 1536 + 32 * (nb - 72), N_IN, k0, wcat + (size_t)(2304 + 32 * (nb - 72)) * 1024, 1024, nullptr, 0, scr, F.lane); }
            else { tr_item(w_in + 3072 + 32 * (nb - 120), N_IN, k0, wcat + (size_t)(3840 + 32 * (nb - 120)) * 1024, 1024, nullptr, 0, scr, F.lane); }
            continue;
        }
        r -= I_CAT;
        if (r < I_BR) { const int nb = r / 8, kb = r % 8; tr_item(F.inp(26) + (size_t)l * 512 * 1024 + 32 * nb, 1024, kb * 64, (bf16_t*)(F.wsp() + WS_WM + WM_BRR) + (size_t)(32 * nb) * 1024, 1024, nullptr, 0, scr, F.lane); continue; }
        r -= I_BR;
        if (r < I_BR) { const int nb = r / 8, kb = r % 8; tr_item(F.inp(27) + (size_t)l * 512 * 1024 + 32 * nb, 1024, kb * 64, (bf16_t*)(F.wsp() + WS_WM + WM_BRR) + (size_t)(32 * nb) * 1024 + 512, 1024, nullptr, 0, scr, F.lane); continue; }
        r -= I_BR;
        { const int nb = r / 16, kb = r % 16; tr_item(F.inp(28) + (size_t)l * 1024 * 1024 + 32 * nb, 1024, kb * 64, (bf16_t*)(F.wsp() + WS_WM + WM_OUT) + (size_t)(32 * nb) * 1024, 1024, nullptr, 0, scr, F.lane); }
    }
}
struct ConvItem { const float* src; int ld, k0, n0, Kd, mode; bf16_t* dst; };
DI ConvItem conv_item(int it, const float* wg, const float* wu, const float* wdn, bf16_t* we, bf16_t* wd) {
    ConvItem c; const int e = it / 96; int r = it % 96;
    if (r < 64) { const int up = r >> 5; r &= 31; c.src = (up ? wu : wg) + (size_t)e * DM * DEXP; c.ld = DEXP; c.k0 = (r >> 1) * 64; c.n0 = (r & 1) * 256; c.dst = we + (size_t)e * 1024 * 1024; c.Kd = 1024; c.mode = up; }
    else { r -= 64; c.src = wdn + (size_t)e * DEXP * DM; c.ld = DM; c.k0 = (r >> 2) * 64; c.n0 = (r & 3) * 256; c.dst = wd + (size_t)e * 1024 * 512; c.Kd = 512; c.mode = 2; }
    return c;
}
DI void conv_load(const ConvItem& c, f32x4 (&v)[8], int tid) {
#pragma unroll
    for (int i = 0; i < 8; ++i) { const int idx = tid + 512 * i, row = idx >> 6, c4 = idx & 63; v[i] = *(const f32x4*)(c.src + (size_t)(c.k0 + row) * c.ld + c.n0 + 4 * c4); }
}
DI void conv_store(const ConvItem& c, const f32x4 (&v)[8], LAS float* scr, int tid) {
#pragma unroll
    for (int i = 0; i < 8; ++i) { const int idx = tid + 512 * i, row = idx >> 6, c4 = idx & 63; LAS float* d = scr + row * 257 + 4 * c4; d[0] = v[i].x; d[1] = v[i].y; d[2] = v[i].z; d[3] = v[i].w; }
    __syncthreads();
#pragma unroll
    for (int i = 0; i < 4; ++i) { const int idx = tid + 512 * i, n = idx >> 3, cc = idx & 7; const LAS float* sp = scr + (8 * cc) * 257 + n;
        u32x4 o; o.x = pk2(sp[0], sp[257]); o.y = pk2(sp[2 * 257], sp[3 * 257]); o.z = pk2(sp[4 * 257], sp[5 * 257]); o.w = pk2(sp[6 * 257], sp[7 * 257]);
        const int h = c.n0 + n; const int drow = (c.mode == 2) ? h : ((h >> 7) * 256 + c.mode * 128 + (h & 127));
        *(u32x4*)(c.dst + (size_t)drow * c.Kd + c.k0 + 8 * cc) = o; }
    __syncthreads();
}
constexpr int CONV_ITEMS = NEXP * 96, CONV_GROUP = 8, CONV_UNITS = CONV_ITEMS / CONV_GROUP;
DI void conv_experts_items(Frame& F, int l, int it_lo, int it_hi, int it_step) {
    LAS float* scr = (LAS float*)F.lds;
    bf16_t* we = (bf16_t*)(F.wsp() + WS_WE); bf16_t* wd = (bf16_t*)(F.wsp() + WS_WD);
    const float* wg = F.inp(33) + (size_t)l * NEXP * DM * DEXP; const float* wu = F.inp(34) + (size_t)l * NEXP * DM * DEXP; const float* wdn = F.inp(35) + (size_t)l * NEXP * DEXP * DM;
    __syncthreads();
    if (it_lo >= it_hi) return;
    f32x4 cur[8], nxt[8];
    ConvItem ci = conv_item(it_lo, wg, wu, wdn, we, wd); conv_load(ci, cur, F.tid);
    for (int it = it_lo; it < it_hi; it += it_step) {
        const bool more = it + it_step < it_hi; ConvItem cn = ci;
        if (more) { cn = conv_item(it + it_step, wg, wu, wdn, we, wd); conv_load(cn, nxt, F.tid); }
        conv_store(ci, cur, scr, F.tid);
        if (more) {
#pragma unroll
            for (int i = 0; i < 8; ++i) cur[i] = nxt[i];
            ci = cn; }
    }
}
DI void rms_row_to_bf16(const float* xrow, const float* gain, bf16_t* o0, bf16_t* o1, int lane) {
    const f32x4* xr = (const f32x4*)xrow + lane; const f32x4* gr = (const f32x4*)gain + lane;
    f32x4 v[4]; float s = 0.f;
#pragma unroll
    for (int j = 0; j < 4; ++j) { v[j] = xr[64 * j]; s += (v[j].x * v[j].x + v[j].y * v[j].y) + (v[j].z * v[j].z + v[j].w * v[j].w); }
    const float rs = 1.0f / sqrtf(wave_sum(s) * (1.f / DM) + 1e-6f);
#pragma unroll
    for (int j = 0; j < 4; ++j) { const f32x4 g = gr[64 * j]; const f32x4 y = v[j] * rs * g;
        u32x2 w; w.x = pk2(y.x, y.y); w.y = pk2(y.z, y.w);
        *((u32x2*)o0 + lane + 64 * j) = w; if (o1) *((u32x2*)o1 + lane + 64 * j) = w; }
}
DI void phase_norm_x(Frame& F, const float* x, const float* gain) {
    const int gw = F.bid * 8 + F.wave, NGW = F.G * 8; bf16_t* xn = (bf16_t*)(F.wsp() + WS_XN);
    for (int m = gw; m < T; m += NGW) rms_row_to_bf16(x + (size_t)m * DM, gain, xn + (size_t)m * DM, nullptr, F.lane);
}

namespace pg8 {
struct EpiStore {
    static constexpr bool PERM = true, HAS_MID = false, HEADS = false;
    bf16_t* O; int ldc; int split; bf16_t* O2; int ldc2; int act;
    __device__ __forceinline__ void operator()(const f32x4 (&acc)[2][2][4][2], const Unit& u, int wr, int wc, int fr, int fq) const {
        const int row0 = u.pm * BM + wr * 64 + fr; int colt = u.pn * BM; bf16_t* base = O; int ld = ldc;
        if (split && colt >= split) { base = O2; ld = ldc2; colt -= split; }
        const int col0 = colt + wc * 32 + 8 * fq;
#pragma unroll
        for (int ai = 0; ai < 2; ++ai)
#pragma unroll
            for (int m = 0; m < 4; ++m) { bf16_t* rowp = base + (size_t)(row0 + ai * HALF + m * 16) * ld + col0;
#pragma unroll
                for (int bj = 0; bj < 2; ++bj) { f32x4 v0 = acc[ai][bj][m][0], v1 = acc[ai][bj][m][1];
                    if (act == 1) {
#pragma unroll
                        for (int j = 0; j < 4; ++j) { v0[j] = sigmoidf_(v0[j]); v1[j] = sigmoidf_(v1[j]); } }
                    u32x4 w; w.x = pk2(v0[0], v0[1]); w.y = pk2(v0[2], v0[3]); w.z = pk2(v1[0], v1[1]); w.w = pk2(v1[2], v1[3]);
                    *(u32x4*)(rowp + bj * HALF) = w; } }
    }
};
struct EpiBranch {
    static constexpr bool PERM = true, HAS_MID = false, HEADS = false;
    bf16_t* Hout; const bf16_t* gate; int gcol0; int first;
    __device__ __forceinline__ void operator()(const f32x4 (&acc)[2][2][4][2], const Unit& u, int wr, int wc, int fr, int fq) const {
        const int row0 = u.pm * BM + wr * 64 + fr; const int col0 = u.pn * BM + wc * 32 + 8 * fq;
#pragma unroll
        for (int ai = 0; ai < 2; ++ai)
#pragma unroll
            for (int m = 0; m < 4; ++m) { const size_t row = (size_t)(row0 + ai * HALF + m * 16);
#pragma unroll
                for (int bj = 0; bj < 2; ++bj) {
                    const u32x4 gv = *(const u32x4*)(gate + row * 2048 + gcol0 + col0 + bj * HALF);
                    bf16_t* hp = Hout + row * 1024 + col0 + bj * HALF;
                    f32x4 v0 = acc[ai][bj][m][0], v1 = acc[ai][bj][m][1];
                    v0[0] *= bflo(gv.x); v0[1] *= bfhi(gv.x); v0[2] *= bflo(gv.y); v0[3] *= bfhi(gv.y);
                    v1[0] *= bflo(gv.z); v1[1] *= bfhi(gv.z); v1[2] *= bflo(gv.w); v1[3] *= bfhi(gv.w);
                    if (!first) { const u32x4 hv = *(const u32x4*)hp;
                        v0[0] += bflo(hv.x); v0[1] += bfhi(hv.x); v0[2] += bflo(hv.y); v0[3] += bfhi(hv.y);
                        v1[0] += bflo(hv.z); v1[1] += bfhi(hv.z); v1[2] += bflo(hv.w); v1[3] += bfhi(hv.w); }
                    u32x4 w; w.x = pk2(v0[0], v0[1]); w.y = pk2(v0[2], v0[3]); w.z = pk2(v1[0], v1[1]); w.w = pk2(v1[2], v1[3]);
                    *(u32x4*)hp = w; } }
    }
};
struct EpiBranch2 {
    static constexpr bool PERM = true, HAS_MID = true, HEADS = false;
    bf16_t* Hout; const bf16_t* gate;
    __device__ __forceinline__ void mid(f32x4 (&acc)[2][2][4][2], const Unit& u, int wr, int wc, int fr_, int fq_) const {
        int fr = fr_, fq = fq_; asm volatile("" : "+v"(fr), "+v"(fq));
        const int row0 = u.pm * BM + wr * 64 + fr; const int col0 = u.pn * BM + wc * 32 + 8 * fq;
#pragma unroll
        for (int ai = 0; ai < 2; ++ai)
#pragma unroll
            for (int m = 0; m < 4; ++m) { const size_t row = (size_t)(row0 + ai * HALF + m * 16);
#pragma unroll
                for (int bj = 0; bj < 2; ++bj) {
                    const u32x4 gr = *(const u32x4*)(gate + row * 2048 + col0 + bj * HALF), gm = *(const u32x4*)(gate + row * 2048 + 1024 + col0 + bj * HALF);
                    const unsigned grw[4] = {gr.x, gr.y, gr.z, gr.w}, gmw[4] = {gm.x, gm.y, gm.z, gm.w};
#pragma unroll
                    for (int q = 0; q < 4; ++q) { const float r0 = bflo(grw[q]) * __builtin_amdgcn_rcpf(fmaxf(bflo(gmw[q]), 1e-30f)), r1 = bfhi(grw[q]) * __builtin_amdgcn_rcpf(fmaxf(bfhi(gmw[q]), 1e-30f));
                        acc[ai][bj][m][q >> 1][2 * (q & 1)] *= r0; acc[ai][bj][m][q >> 1][2 * (q & 1) + 1] *= r1; } }
                asm volatile("" ::: "memory"); }
    }
    __device__ __forceinline__ void operator()(const f32x4 (&acc)[2][2][4][2], const Unit& u, int wr, int wc, int fr, int fq) const {
        const int row0 = u.pm * BM + wr * 64 + fr; const int col0 = u.pn * BM + wc * 32 + 8 * fq;
#pragma unroll
        for (int ai = 0; ai < 2; ++ai)
#pragma unroll
            for (int m = 0; m < 4; ++m) { const size_t row = (size_t)(row0 + ai * HALF + m * 16);
#pragma unroll
                for (int bj = 0; bj < 2; ++bj) {
                    const u32x4 gm = *(const u32x4*)(gate + row * 2048 + 1024 + col0 + bj * HALF);
                    f32x4 v0 = acc[ai][bj][m][0], v1 = acc[ai][bj][m][1];
                    v0[0] *= fmaxf(bflo(gm.x), 1e-30f); v0[1] *= fmaxf(bfhi(gm.x), 1e-30f); v0[2] *= fmaxf(bflo(gm.y), 1e-30f); v0[3] *= fmaxf(bfhi(gm.y), 1e-30f);
                    v1[0] *= fmaxf(bflo(gm.z), 1e-30f); v1[1] *= fmaxf(bfhi(gm.z), 1e-30f); v1[2] *= fmaxf(bflo(gm.w), 1e-30f); v1[3] *= fmaxf(bfhi(gm.w), 1e-30f);
                    u32x4 w; w.x = pk2(v0[0], v0[1]); w.y = pk2(v0[2], v0[3]); w.z = pk2(v1[0], v1[1]); w.w = pk2(v1[2], v1[3]);
                    *(u32x4*)(Hout + row * 1024 + col0 + bj * HALF) = w; } }
    }
};
struct EpiMoba {
    static constexpr bool PERM = true, HAS_MID = false, HEADS = true;
    bf16_t* MO; const float* qgain; const float* kgain; float* KM; int km_half;
    __device__ __forceinline__ void operator()(const f32x4 (&acc)[2][2][4][2], const Unit& u, int wr, int wc, int fr, int fq) const {
        const int row0 = u.pm * BM + wr * 64 + fr; const int kind = u.pn >> 1; const int colb = u.pn * BM + 64 * wc + 8 * fq;
        if (kind == 2) {
#pragma unroll
            for (int ai = 0; ai < 2; ++ai)
#pragma unroll
                for (int m = 0; m < 4; ++m) { bf16_t* rowp = MO + (size_t)(row0 + ai * HALF + m * 16) * 1536 + colb;
#pragma unroll
                    for (int bj = 0; bj < 2; ++bj) { const f32x4 v0 = acc[ai][bj][m][0], v1 = acc[ai][bj][m][1];
                        u32x4 w; w.x = pk2(v0[0], v0[1]); w.y = pk2(v0[2], v0[3]); w.z = pk2(v1[0], v1[1]); w.w = pk2(v1[2], v1[3]); *(u32x4*)(rowp + 32 * bj) = w; } }
            return;
        }
        const float* gp = (kind == 0 ? qgain : kgain) + 8 * fq; const float gs = (kind == 0) ? 0.125f : 1.0f;
        f32x4 gn[2][2];
#pragma unroll
        for (int bj = 0; bj < 2; ++bj)
#pragma unroll
            for (int n = 0; n < 2; ++n) gn[bj][n] = *(const f32x4*)(gp + 32 * bj + 4 * n) * gs;
        f32x4 cs[2][2];
#pragma unroll
        for (int bj = 0; bj < 2; ++bj)
#pragma unroll
            for (int n = 0; n < 2; ++n) cs[bj][n] = (f32x4){0.f, 0.f, 0.f, 0.f};
        float rsv[2][4];
#pragma unroll
        for (int ai = 0; ai < 2; ++ai)
#pragma unroll
            for (int m = 0; m < 4; ++m) { float ss = 0.f;
#pragma unroll
                for (int bj = 0; bj < 2; ++bj)
#pragma unroll
                    for (int n = 0; n < 2; ++n) { const f32x4 x = acc[ai][bj][m][n]; ss += (x[0] * x[0] + x[1] * x[1]) + (x[2] * x[2] + x[3] * x[3]); }
                rsv[ai][m] = ss; }
#pragma unroll
        for (int ai = 0; ai < 2; ++ai)
#pragma unroll
            for (int m = 0; m < 4; ++m) rsv[ai][m] += __shfl_xor(rsv[ai][m], 16);
#pragma unroll
        for (int ai = 0; ai < 2; ++ai)
#pragma unroll
            for (int m = 0; m < 4; ++m) { rsv[ai][m] += __shfl_xor(rsv[ai][m], 32); rsv[ai][m] = __builtin_amdgcn_rsqf(rsv[ai][m] * (1.f / 64.f) + 1e-6f); }
#pragma unroll
        for (int ai = 0; ai < 2; ++ai)
#pragma unroll
            for (int m = 0; m < 4; ++m) { const float rs = rsv[ai][m];
                bf16_t* rowp = MO + (size_t)(row0 + ai * HALF + m * 16) * 1536 + colb;
#pragma unroll
                for (int bj = 0; bj < 2; ++bj) { const f32x4 v0 = acc[ai][bj][m][0] * rs * gn[bj][0], v1 = acc[ai][bj][m][1] * rs * gn[bj][1];
                    cs[bj][0] += v0; cs[bj][1] += v1;
                    u32x4 w; w.x = pk2(v0[0], v0[1]); w.y = pk2(v0[2], v0[3]); w.z = pk2(v1[0], v1[1]); w.w = pk2(v1[2], v1[3]); *(u32x4*)(rowp + 32 * bj) = w; }
                asm volatile("" : "+v"(cs[0][0]), "+v"(cs[0][1]), "+v"(cs[1][0]), "+v"(cs[1][1]));
            }
        if (kind == 1) {
#pragma unroll
            for (int bj = 0; bj < 2; ++bj)
#pragma unroll
                for (int n = 0; n < 2; ++n) { f32x4 t = cs[bj][n];
#pragma unroll
                    for (int j = 0; j < 4; ++j) { float v = t[j]; v += dpp_mov<0xB1>(v); v += dpp_mov<0x4E>(v); v += dpp_mov<0x141>(v); v += dpp_mov<0x140>(v); t[j] = v * (1.f / 256.f); }
                    if (fr == 0) *(f32x4*)(KM + (size_t)wr * km_half + (size_t)u.pm * 512 + (u.pn * BM - 512) + 64 * wc + 32 * bj + 8 * fq + 4 * n) = t; }
        }
    }
};
struct EpiResid {
    static constexpr bool PERM = false, HAS_MID = false, HEADS = false;
    const float* xin; float* out;
    __device__ __forceinline__ void operator()(const f32x4 (&acc)[2][2][4][2], const Unit& u, int wr, int wc, int fr, int fq) const {
        const int row0 = u.pm * BM + wr * 64 + fr, col0 = u.pn * BM + wc * 32 + 4 * fq;
#pragma unroll
        for (int ai = 0; ai < 2; ++ai)
#pragma unroll
            for (int m = 0; m < 4; ++m) { const size_t off = (size_t)(row0 + ai * HALF + m * 16) * 1024 + col0;
#pragma unroll
                for (int bj = 0; bj < 2; ++bj)
#pragma unroll
                    for (int n = 0; n < 2; ++n) { const f32x4 xv = *(const f32x4*)(xin + off + bj * HALF + n * 16); *(f32x4*)(out + off + bj * HALF + n * 16) = xv + acc[ai][bj][m][n]; } }
    }
};
struct EpiExpertUp {
    static constexpr bool PERM = true, HAS_MID = false, HEADS = false;
    bf16_t* HM; const float* gw; const float* rsr;
    __device__ __forceinline__ void operator()(const f32x4 (&acc)[2][2][4][2], const Unit& u, int wr, int wc, int fr, int fq) const {
        const int row0 = u.pm * BM + wr * 64 + fr; const int col0 = u.pn * 128 + wc * 32 + 8 * fq;
#pragma unroll
        for (int ai = 0; ai < 2; ++ai)
#pragma unroll
            for (int m = 0; m < 4; ++m) { const size_t row = (size_t)(row0 + ai * HALF + m * 16); const float rs = rsr[row]; const float gwt = gw[row] * rs;
                f32x4 v0, v1;
#pragma unroll
                for (int j = 0; j < 4; ++j) { const float g0 = acc[ai][0][m][0][j] * rs, g1 = acc[ai][0][m][1][j] * rs;
                    v0[j] = g0 * sigmoidf_(g0) * acc[ai][1][m][0][j] * gwt; v1[j] = g1 * sigmoidf_(g1) * acc[ai][1][m][1][j] * gwt; }
                u32x4 w; w.x = pk2(v0[0], v0[1]); w.y = pk2(v0[2], v0[3]); w.z = pk2(v1[0], v1[1]); w.w = pk2(v1[2], v1[3]);
                *(u32x4*)(HM + row * 512 + col0) = w; }
    }
};
}
constexpr size_t SI_PLANE = (size_t)T * CW * 2;
DI float softplusf_(float z) { return fmaxf(z, 0.f) + __logf(1.0f + __expf(-fabsf(z))); }

#ifndef PREP_DUP
#define PREP_DUP 0
#endif
constexpr int ACT_P = 592;
constexpr size_t WM_L2T = (size_t)WCAT_ROWS * 1024 * 2 + 2 * 1024 * 512 * 2 + 1024 * 1024 * 2;
DI void phase_conv_lora2(Frame& F, int l) {
    bf16_t* L2T = (bf16_t*)(F.wsp() + WS_WM + WM_L2T);
    const float* w2 = F.inp(8) + (size_t)l * 64 * CW; const float* a2 = F.inp(11) + (size_t)l * 64 * CW; const float* g2 = F.inp(13) + (size_t)l * 128 * CW; const float* v2 = F.inp(22);
    for (int idx = F.bid * 512 + F.tid; idx < 288 * CW; idx += F.G * 512) { const int j = idx >> 9, c = idx & 511;
        float v;
        if (j < 64) v = w2[j * CW + c]; else if (j < 128) v = a2[(j - 64) * CW + c]; else if (j < 256) v = g2[(j - 128) * CW + c]; else v = (l > 0) ? v2[(j - 256) * CW + c] : 0.f;
        L2T[c * 288 + j] = f2bf(v); }
}
DI float row16_sum(float v) { v += dpp_mov<0xB1>(v); v += dpp_mov<0x4E>(v); v += dpp_mov<0x141>(v); v += dpp_mov<0x140>(v); return v; }
DI void phase_rwkv_prep2(Frame& F, int l, int tile_lo, int tile_hi, int tile_step, bool init) {
    LAS unsigned char* act = F.lds;
    LAS float* PRM = (LAS float*)(F.lds + 139264);
    const bf16_t* RW = (const bf16_t*)(F.wsp() + WS_RW); const bf16_t* LO = (const bf16_t*)(F.wsp() + WS_LO); const unsigned char* L2T = F.wsp() + WS_WM + WM_L2T;
    bf16_t* SIr = (bf16_t*)(F.wsp() + WS_SIR); bf16_t* SIk = (bf16_t*)(F.wsp() + WS_SIK);
    bf16_t* SCw = (bf16_t*)(F.wsp() + WS_SCRW) + (size_t)F.bid * 64 * CW; bf16_t* SCa = (bf16_t*)(F.wsp() + WS_SCRA) + (size_t)F.bid * 64 * CW; bf16_t* SCb = (bf16_t*)(F.wsp() + WS_SCRB) + (size_t)F.bid * 64 * CW;
    bf16_t* VF = (bf16_t*)(F.wsp() + WS_VF); bf16_t* V1 = (bf16_t*)(F.wsp() + WS_V1); bf16_t* Gb = (bf16_t*)(F.wsp() + WS_G);
    const int lane = F.lane, r16 = lane & 15, g = lane >> 4;
    if (init) { __syncthreads();
      const int c = F.tid;
      PRM[c] = F.inp(4)[(size_t)l * 3 * CW + c]; PRM[512 + c] = F.inp(4)[(size_t)l * 3 * CW + CW + c]; PRM[1024 + c] = F.inp(4)[(size_t)l * 3 * CW + 2 * CW + c];
      PRM[1536 + c] = F.inp(6)[l * CW + c]; PRM[2048 + c] = F.inp(9)[l * CW + c]; PRM[2560 + c] = F.inp(14)[l * CW + c]; PRM[3072 + c] = F.inp(15)[l * CW + c]; PRM[3584 + c] = l > 0 ? F.inp(20)[c] : 0.f; }
    for (int tile = tile_lo; tile < tile_hi; tile += tile_step) {
        int t0 = tile * 64; asm volatile("" : "+s"(t0));
        __syncthreads();
        for (int dup1_ = 0; dup1_ < ((PREP_DUP & 1) ? 2 : 1); ++dup1_)
        for (int grp = F.tid; grp < 64 * 36; grp += 512) { const int tt = grp / 36, jg = grp - tt * 36, j0 = 8 * jg; const int t = t0 + tt; const bool has_prev = (t % SEQ) != 0;
            int pj, qj; if (j0 < 64) { pj = j0; qj = 64 + j0; } else if (j0 < 128) { pj = 128 + (j0 - 64); qj = 192 + (j0 - 64); } else if (j0 < 256) { pj = 256 + (j0 - 128); qj = 384 + (j0 - 128); } else { pj = 512 + (j0 - 256); qj = 544 + (j0 - 256); }
            const u32x4 pv = *(const u32x4*)(LO + (size_t)t * LO_W + pj); u32x4 qv = {0u, 0u, 0u, 0u}; if (has_prev) qv = *(const u32x4*)(LO + (size_t)(t - 1) * LO_W + qj);
            const unsigned pw[4] = {pv.x, pv.y, pv.z, pv.w}, qw[4] = {qv.x, qv.y, qv.z, qv.w}; float v[8];
#pragma unroll
            for (int q = 0; q < 4; ++q) { v[2 * q] = bflo(pw[q]) + bflo(qw[q]); v[2 * q + 1] = bfhi(pw[q]) + bfhi(qw[q]); }
            if (j0 < 64) {
#pragma unroll
                for (int e = 0; e < 8; ++e) v[e] = 1.0f - 2.0f * __builtin_amdgcn_rcpf(1.0f + __expf(2.0f * v[e]));
            } else if (j0 >= 128 && j0 < 256) {
#pragma unroll
                for (int e = 0; e < 8; ++e) v[e] = sigmoidf_(v[e]);
            }
            u32x4 w; w.x = pk2(v[0], v[1]); w.y = pk2(v[2], v[3]); w.z = pk2(v[4], v[5]); w.w = pk2(v[6], v[7]);
            *(LAS u32x4*)(act + tt * ACT_P + j0 * 2) = w; }
        __syncthreads();
        float inv[4];
        for (int pd_ = 0; pd_ < ((PREP_DUP & 4) ? 2 : 1); ++pd_)
        { int cw = 64 * F.wave + 4 * g; asm volatile("" : "+v"(cw));
          u32x2 kc[4][4], kp_[4][4];
#pragma unroll
          for (int tt = 0; tt < 4; ++tt) { const int t = t0 + 16 * tt + r16; const bool has_prev = (t % SEQ) != 0; const size_t ro = (size_t)t * 1536;
#pragma unroll
              for (int ct = 0; ct < 4; ++ct) { kc[tt][ct] = *(const u32x2*)(RW + ro + 512 + cw + 16 * ct); kp_[tt][ct] = (u32x2){0u, 0u}; if (has_prev) kp_[tt][ct] = *(const u32x2*)(RW + ro - 1536 + 512 + cw + 16 * ct); } }
#pragma unroll
          for (int tt = 0; tt < 4; ++tt) { float ss = 0.f;
#pragma unroll
              for (int ct = 0; ct < 4; ++ct) { const f32x4 muk = *(const LAS f32x4*)(PRM + 512 + cw + 16 * ct), kkc = *(const LAS f32x4*)(PRM + 2560 + cw + 16 * ct);
                  const float k0 = bflo(kc[tt][ct].x), k1 = bfhi(kc[tt][ct].x), k2 = bflo(kc[tt][ct].y), k3 = bfhi(kc[tt][ct].y), q0 = bflo(kp_[tt][ct].x), q1 = bfhi(kp_[tt][ct].x), q2 = bflo(kp_[tt][ct].y), q3 = bfhi(kp_[tt][ct].y);
                  const float a0 = (k0 + (q0 - k0) * muk[0]) * kkc[0], a1 = (k1 + (q1 - k1) * muk[1]) * kkc[1], a2 = (k2 + (q2 - k2) * muk[2]) * kkc[2], a3 = (k3 + (q3 - k3) * muk[3]) * kkc[3];
                  ss += (a0 * a0 + a1 * a1) + (a2 * a2 + a3 * a3); }
              ss += __shfl_xor(ss, 16); ss += __shfl_xor(ss, 32);
              inv[tt] = __builtin_amdgcn_rsqf(fmaxf(ss, 1e-24f)); } }
#pragma unroll 1
        for (int ct8 = 0; ct8 < ((PREP_DUP & 8) ? 8 : 4); ++ct8) { const int ct = ct8 & 3;
            int cw = 64 * F.wave + 4 * g; asm volatile("" : "+v"(cw));
            const int c0 = cw + 16 * ct;
            bf16x8 wf[9];
            { const unsigned char* wrow = L2T + (size_t)(64 * F.wave + 16 * ct + r16) * 576 + 16 * g;
#pragma unroll
              for (int s = 0; s < 9; ++s) wf[s] = *(const bf16x8*)(wrow + 64 * s); }
            u32x2 cur[4][3], prv[4][3], vfl[4];
#pragma unroll
            for (int tt = 0; tt < 4; ++tt) { const int t = t0 + 16 * tt + r16; const bool has_prev = (t % SEQ) != 0; const size_t ro = (size_t)t * 1536;
#pragma unroll
                for (int p = 0; p < 3; ++p) { cur[tt][p] = *(const u32x2*)(RW + ro + 512 * p + c0); prv[tt][p] = (u32x2){0u, 0u}; if (has_prev) prv[tt][p] = *(const u32x2*)(RW + ro - 1536 + 512 * p + c0); }
                vfl[tt] = (u32x2){0u, 0u}; if (l > 0) vfl[tt] = *(const u32x2*)(VF + (size_t)t * CW + c0); }
            const f32x4 mur = *(const LAS f32x4*)(PRM + c0), muk = *(const LAS f32x4*)(PRM + 512 + c0), muv = *(const LAS f32x4*)(PRM + 1024 + c0), w0v = *(const LAS f32x4*)(PRM + 1536 + c0),
                        a0v = *(const LAS f32x4*)(PRM + 2048 + c0), kkc = *(const LAS f32x4*)(PRM + 2560 + c0), kac = *(const LAS f32x4*)(PRM + 3072 + c0), v0v = *(const LAS f32x4*)(PRM + 3584 + c0);
#pragma unroll
            for (int tt = 0; tt < 4; ++tt) {
                const int t = t0 + 16 * tt + r16; const size_t oo = (size_t)t * CW, os = (size_t)(16 * tt + r16) * CW;
                bf16x8 a[9];
#pragma unroll
                for (int s = 0; s < 9; ++s) a[s] = *(const LAS bf16x8*)(act + (16 * tt + r16) * ACT_P + (32 * s + 8 * g) * 2);
                f32x4 aw = {0.f, 0.f, 0.f, 0.f}, aa = {0.f, 0.f, 0.f, 0.f}, ag = {0.f, 0.f, 0.f, 0.f}, av = {0.f, 0.f, 0.f, 0.f};
                aw = mfma16(wf[0], a[0], aw); aw = mfma16(wf[1], a[1], aw);
                aa = mfma16(wf[2], a[2], aa); aa = mfma16(wf[3], a[3], aa);
                ag = mfma16(wf[4], a[4], ag); ag = mfma16(wf[5], a[5], ag); ag = mfma16(wf[6], a[6], ag); ag = mfma16(wf[7], a[7], ag);
                if (l > 0) av = mfma16(wf[8], a[8], av);
                float ro4[4], lw4[4], vo4[4], k2[4], ka[4], kb[4];
#pragma unroll
                for (int r = 0; r < 4; ++r) {
                    const unsigned cwd_r = (r < 2) ? cur[tt][0].x : cur[tt][0].y, cwd_k = (r < 2) ? cur[tt][1].x : cur[tt][1].y, cwd_v = (r < 2) ? cur[tt][2].x : cur[tt][2].y;
                    const unsigned pwd_r = (r < 2) ? prv[tt][0].x : prv[tt][0].y, pwd_k = (r < 2) ? prv[tt][1].x : prv[tt][1].y, pwd_v = (r < 2) ? prv[tt][2].x : prv[tt][2].y;
                    const unsigned vwd = (r < 2) ? vfl[tt].x : vfl[tt].y;
                    const float rp = (r & 1) ? bfhi(cwd_r) : bflo(cwd_r), kp = (r & 1) ? bfhi(cwd_k) : bflo(cwd_k), vp = (r & 1) ? bfhi(cwd_v) : bflo(cwd_v);
                    const float rq = (r & 1) ? bfhi(pwd_r) : bflo(pwd_r), kq_ = (r & 1) ? bfhi(pwd_k) : bflo(pwd_k), vq = (r & 1) ? bfhi(pwd_v) : bflo(pwd_v);
                    const float rr = rp + (rq - rp) * mur[r], k = kp + (kq_ - kp) * muk[r]; float v = vp + (vq - vp) * muv[r];
                    lw4[r] = -0.60653066f * sigmoidf_(w0v[r] + aw[r]);
                    const float alr = sigmoidf_(a0v[r] + aa[r]);
                    if (l > 0) { const float vf = (r & 1) ? bfhi(vwd) : bflo(vwd); v = v + (vf - v) * sigmoidf_(v0v[r] + av[r]); }
                    const float kk = k * kkc[r] * inv[tt];
                    ro4[r] = rr; vo4[r] = v; k2[r] = k * (1.f + (alr - 1.f) * kac[r]); ka[r] = kk; kb[r] = kk * alr; }
                u32x2 w;
                w.x = pk2(ro4[0], ro4[1]); w.y = pk2(ro4[2], ro4[3]); *(u32x2*)(SIr + oo + c0) = w;
                w.x = pk2(lw4[0], lw4[1]); w.y = pk2(lw4[2], lw4[3]); *(u32x2*)(SCw + os + c0) = w;
                w.x = pk2(ag[0], ag[1]); w.y = pk2(ag[2], ag[3]); *(u32x2*)(Gb + oo + c0) = w;
                w.x = pk2(vo4[0], vo4[1]); w.y = pk2(vo4[2], vo4[3]); *(u32x2*)((l > 0 ? V1 : VF) + oo + c0) = w;
                w.x = pk2(k2[0], k2[1]); w.y = pk2(k2[2], k2[3]); *(u32x2*)(SIk + oo + c0) = w;
                w.x = pk2(ka[0], ka[1]); w.y = pk2(ka[2], ka[3]); *(u32x2*)(SCa + os + c0) = w;
                w.x = pk2(kb[0], kb[1]); w.y = pk2(kb[2], kb[3]); *(u32x2*)(SCb + os + c0) = w;
            }
        }
    }
}
constexpr int NUNIT = NB * NH * (SEQ / 64);
constexpr size_t U_PMP = 0, U_RPP = 8192, U1_BYTES = 16384;
constexpr size_t U_QMT = 0, U_YLT = 8192, U2_BYTES = 16384;
DI int permk(int k) { return (k & 32) | (((k >> 2) & 3) << 3) | (((k >> 4) & 1) << 2) | (k & 3); }
constexpr int MP = 144;
constexpr int SP = 80;
DI f32x4 mm_tile(const LAS unsigned char* xb, int px, int m0, const LAS unsigned char* yb, int py, int n0, int ks, f32x4 acc, int lane) {
    const int r16 = lane & 15, g = lane >> 4;
    for (int s = 0; s < ks; ++s) {
        const bf16x8 a = *(const LAS bf16x8*)(xb + (m0 + r16) * px + (32 * s + 8 * g) * 2);
        const bf16x8 b = *(const LAS bf16x8*)(yb + (n0 + r16) * py + (32 * s + 8 * g) * 2);
        acc = mfma16(a, b, acc);
    }
    return acc;
}
DI u32x2 pk4(f32x4 v) { u32x2 w; w.x = pk2(v[0], v[1]); w.y = pk2(v[2], v[3]); return w; }

#ifndef SA_DUP
#define SA_DUP 0
#endif
#define SA_REP(bit) for (int sd_ = 0; sd_ < ((SA_DUP & (bit)) ? 2 : 1); ++sd_)
DI void phase_scan_a(Frame& F, int l, int u_lo, int u_hi, int u_step) {
    LAS unsigned char* const L = F.lds;
#define MB(n) (L + (n) * 9216)
    LAS float* const Gf = (LAS float*)(L + 110592);
    LAS float* const SEG = (LAS float*)(L + 110592 + 16384);
    LAS float* const GL = SEG + 512;
    LAS unsigned char* const A21 = L + 110592 + 16384 + 2048 + 256;
    LAS unsigned char* const T11T = A21 + 2560;
    LAS unsigned char* const ZT = T11T + 2560;
    const bf16_t* SIr = (const bf16_t*)(F.wsp() + WS_SIR); const bf16_t* SIk = (const bf16_t*)(F.wsp() + WS_SIK);
    const bf16_t* SCw = (const bf16_t*)(F.wsp() + WS_SCRW) + (size_t)F.bid * 64 * CW; const bf16_t* SCa = (const bf16_t*)(F.wsp() + WS_SCRA) + (size_t)F.bid * 64 * CW; const bf16_t* SCb = (const bf16_t*)(F.wsp() + WS_SCRB) + (size_t)F.bid * 64 * CW;
    const bf16_t* V = (const bf16_t*)(F.wsp() + (l > 0 ? WS_V1 : WS_VF));
    const int lane = F.lane, wave = F.wave, r16 = lane & 15, g = lane >> 4;
    float plw[8]; u32x4 prv, pkv, pav, pbv, pvv;
#define SCANA_LOAD(uu) do { const int bh_ = (uu) & 31, c_ = (uu) >> 5, b_ = bh_ >> 3, h_ = bh_ & 7; const size_t t0_ = (size_t)b_ * SEQ + c_ * 64; \
        { const int k_ = F.tid & 63, seg_ = F.tid >> 6; _Pragma("unroll") for (int e = 0; e < 8; ++e) plw[e] = bf2f(SCw[(size_t)(8 * seg_ + e) * CW + h_ * 64 + k_]); } \
        { const int i_ = F.tid >> 3, k0_ = (F.tid & 7) * 8; const size_t go_ = (t0_ + i_) * CW + h_ * 64 + k0_, gs_ = (size_t)i_ * CW + h_ * 64 + k0_; \
          prv = *(const u32x4*)(SIr + go_); pkv = *(const u32x4*)(SIk + go_); pav = *(const u32x4*)(SCa + gs_); pbv = *(const u32x4*)(SCb + gs_); pvv = *(const u32x4*)(V + go_); } } while (0)
    if (u_lo < u_hi) SCANA_LOAD(u_lo);
    for (int u = u_lo; u < u_hi; u += u_step) {
        const int bh = u & 31, c = u >> 5, b = bh >> 3, h = bh & 7;
        const size_t t0 = (size_t)b * SEQ + c * 64; (void)t0; (void)b; (void)h;
        unsigned char* const rec1 = F.wsp() + WS_SC1 + (size_t)((bh * 128) + c) * U1_BYTES; unsigned char* const rec2 = F.wsp() + WS_SC2 + (size_t)((bh * 128) + c) * U2_BYTES;
        __syncthreads();
        SA_REP(1) {
        { const int k = F.tid & 63, seg = F.tid >> 6; float p[8]; float run = 0.f;
#pragma unroll
          for (int e = 0; e < 8; ++e) { run += plw[e]; p[e] = run; }
          SEG[seg * 64 + k] = run;
          __syncthreads();
          float off = 0.f;
#pragma unroll
          for (int s = 0; s < 8; ++s) off += (s < seg) ? SEG[s * 64 + k] : 0.f;
#pragma unroll
          for (int e = 0; e < 8; ++e) Gf[(8 * seg + e) * 64 + k] = off + p[e];
        }
        __syncthreads();
        { const int i = F.tid >> 3, k0 = (F.tid & 7) * 8;
          const u32x4 rv = prv, kv = pkv, av = pav, bv = pbv, vv = pvv;
          float fr[8], fk[8], fa[8], fb[8], fv[8];
          const unsigned rw[4] = {rv.x, rv.y, rv.z, rv.w}, kw[4] = {kv.x, kv.y, kv.z, kv.w}, aw[4] = {av.x, av.y, av.z, av.w}, bw[4] = {bv.x, bv.y, bv.z, bv.w}, vw[4] = {vv.x, vv.y, vv.z, vv.w};
#pragma unroll
          for (int q = 0; q < 4; ++q) { fr[2 * q] = bflo(rw[q]); fr[2 * q + 1] = bfhi(rw[q]); fk[2 * q] = bflo(kw[q]); fk[2 * q + 1] = bfhi(kw[q]); fa[2 * q] = bflo(aw[q]); fa[2 * q + 1] = bfhi(aw[q]);
              fb[2 * q] = bflo(bw[q]); fb[2 * q + 1] = bfhi(bw[q]); fv[2 * q] = bflo(vw[q]); fv[2 * q + 1] = bfhi(vw[q]); }
          float at[8], rt[8], bt[8], kt[8], bh8[8], kh8[8];
#pragma unroll
          for (int e = 0; e < 8; ++e) { const float gi = Gf[i * 64 + k0 + e], gp = (i > 0) ? Gf[(i - 1) * 64 + k0 + e] : 0.f, gl = Gf[63 * 64 + k0 + e];
              const float e1 = __expf(gp), e2 = __expf(gi), e3 = __expf(-gi), e4 = __expf(gl - gi);
              at[e] = -fa[e] * e1; rt[e] = fr[e] * e2; bt[e] = fb[e] * e3; kt[e] = fk[e] * e3; bh8[e] = fb[e] * e4; kh8[e] = fk[e] * e4;
              if (i == 63) GL[k0 + e] = e2; }
          u32x4 w;
          w.x = pk2(at[0], at[1]); w.y = pk2(at[2], at[3]); w.z = pk2(at[4], at[5]); w.w = pk2(at[6], at[7]); *(LAS u32x4*)(MB(0) + i * MP + k0 * 2) = w;
          w.x = pk2(rt[0], rt[1]); w.y = pk2(rt[2], rt[3]); w.z = pk2(rt[4], rt[5]); w.w = pk2(rt[6], rt[7]); *(LAS u32x4*)(MB(1) + i * MP + k0 * 2) = w;
          w.x = pk2(bt[0], bt[1]); w.y = pk2(bt[2], bt[3]); w.z = pk2(bt[4], bt[5]); w.w = pk2(bt[6], bt[7]); *(LAS u32x4*)(MB(2) + i * MP + k0 * 2) = w;
          w.x = pk2(kt[0], kt[1]); w.y = pk2(kt[2], kt[3]); w.z = pk2(kt[4], kt[5]); w.w = pk2(kt[6], kt[7]); *(LAS u32x4*)(MB(3) + i * MP + k0 * 2) = w;
#pragma unroll
          for (int e = 0; e < 8; ++e) { const int ro = (k0 + e) * MP + i * 2;
              *(LAS bf16_t*)(MB(4) + ro) = f2bf(at[e]); *(LAS bf16_t*)(MB(5) + ro) = f2bf(fv[e]); *(LAS bf16_t*)(MB(6) + ro) = f2bf(bh8[e]); *(LAS bf16_t*)(MB(7) + ro) = f2bf(kh8[e]); }
        }
        __syncthreads(); }
        if (u + u_step < u_hi) SCANA_LOAD(u + u_step);
        __syncthreads();
        SA_REP(2) {
        { const int prod = wave >> 1;
          const LAS unsigned char* xb = (prod & 1) ? MB(3) : MB(2); const LAS unsigned char* yb = (prod < 2) ? MB(0) : MB(1);
          LAS unsigned char* ob = (prod == 1) ? MB(8) : (prod == 2) ? MB(9) : MB(10);
          float zf = 0.f; asm volatile("" : "+v"(zf));
          for (int q = 0; q < 8; ++q) { const int tt = (wave & 1) * 8 + q, tm = tt >> 2, tn = tt & 3;
              f32x4 acc = {zf, zf, zf, zf};
              if (tm <= tn) acc = mm_tile(xb, MP, 16 * tm, yb, MP, 16 * tn, 2, acc, lane);
              const int i = 16 * tn + r16, j0 = 16 * tm + 4 * g;
#pragma unroll
              for (int r = 0; r < 4; ++r) { const int j = j0 + r; const bool keep = (prod < 2) ? (j < i) : (j <= i); if (!keep) acc[r] = 0.f; }
              if (prod == 0) {
                  if ((i >> 5) == (j0 >> 5)) *(LAS f32x4*)(Gf + ((i >> 5) * 32 + (i & 31)) * 32 + (j0 & 31)) = acc;
                  if (i >= 32 && j0 < 32) *(LAS u32x2*)(A21 + (i - 32) * SP + j0 * 2) = pk4(acc);
              } else *(LAS u32x2*)(ob + i * MP + j0 * 2) = pk4(acc);
          } }
        __syncthreads();
        }
        f32x4 pyl[2] = {{0.f, 0.f, 0.f, 0.f}, {0.f, 0.f, 0.f, 0.f}}, pqm[2] = {{0.f, 0.f, 0.f, 0.f}, {0.f, 0.f, 0.f, 0.f}};
        SA_REP(4) {
        if (wave == 0) {
            const int blk = lane >> 5, cc = lane & 31; const LAS float* AD = Gf + blk * 1024;
            float Tc[32];
#pragma unroll
            for (int i = 0; i < 32; ++i) { float a0 = (i == cc) ? 1.f : 0.f, a1 = 0.f, a2 = 0.f, a3 = 0.f;
#pragma unroll
                for (int q = 0; q < (i + 3) / 4; ++q) { const f32x4 a = *(const LAS f32x4*)(AD + i * 32 + 4 * q);
                    if (4 * q + 0 < i) a0 += a[0] * Tc[4 * q + 0]; if (4 * q + 1 < i) a1 += a[1] * Tc[4 * q + 1]; if (4 * q + 2 < i) a2 += a[2] * Tc[4 * q + 2]; if (4 * q + 3 < i) a3 += a[3] * Tc[4 * q + 3]; }
                Tc[i] = (a0 + a1) + (a2 + a3); }
#pragma unroll
            for (int i = 0; i < 32; ++i) *(LAS bf16_t*)(MB(11) + (32 * blk + i) * MP + (32 * blk + cc) * 2) = f2bf(Tc[i]);
            if (blk == 0) {
#pragma unroll
                for (int q = 0; q < 4; ++q) { u32x4 w; w.x = pk2(Tc[8 * q], Tc[8 * q + 1]); w.y = pk2(Tc[8 * q + 2], Tc[8 * q + 3]); w.z = pk2(Tc[8 * q + 4], Tc[8 * q + 5]); w.w = pk2(Tc[8 * q + 6], Tc[8 * q + 7]);
                    *(LAS u32x4*)(T11T + cc * SP + q * 16) = w; }
            } else {
                unsigned z = 0u; asm volatile("" : "+v"(z));
#pragma unroll
                for (int q = 0; q < 4; ++q) *(LAS u32x4*)(MB(11) + cc * MP + 64 + q * 16) = (u32x4){z, z, z, z};
            }
        } else {
            for (int tt = wave - 1; tt < 16; tt += 7) { const int tm = tt >> 2, tn = tt & 3;
                f32x4 acc = {0.f, 0.f, 0.f, 0.f};
                acc = mm_tile(MB(8), MP, 16 * tm, MB(5), MP, 16 * tn, 2, acc, lane);
                *(LAS u32x2*)(MB(2) + (16 * tn + r16) * MP + (16 * tm + 4 * g) * 2) = pk4(acc); }
            if (sd_ == 0) {
#pragma unroll
                for (int q = 0; q < 2; ++q) { const int tt = wave * 2 + q, tm = tt >> 2, tn = tt & 3; const f32x4 z = {0.f, 0.f, 0.f, 0.f};
                    pyl[q] = mm_tile(MB(5), MP, 16 * tm, MB(10), MP, 16 * tn, 2, z, lane);
                    pqm[q] = mm_tile(MB(7), MP, 16 * tm, MB(5), MP, 16 * tn, 2, z, lane); } }
        }
        __syncthreads();
        if (wave < 4) { const int tm = wave >> 1, tn = wave & 1; f32x4 acc = {0.f, 0.f, 0.f, 0.f};
            acc = mm_tile(A21, SP, 16 * tm, T11T, SP, 16 * tn, 1, acc, lane);
            *(LAS u32x2*)(ZT + (16 * tn + r16) * SP + (16 * tm + 4 * g) * 2) = pk4(acc); }
        __syncthreads();
        if (wave < 4) { const int tm = wave >> 1, tn = wave & 1; f32x4 acc = {0.f, 0.f, 0.f, 0.f};
            acc = mm_tile(ZT, SP, 16 * tm, MB(11) + 32 * MP + 64, MP, 16 * tn, 1, acc, lane);
            *(LAS u32x2*)(MB(11) + (32 + 16 * tn + r16) * MP + (16 * tm + 4 * g) * 2) = pk4(acc); }
        __syncthreads();
        }
        SA_REP(8) {
        { const LAS unsigned char* yb = (wave < 4) ? MB(4) : MB(2); LAS unsigned char* ob = (wave < 4) ? MB(3) : MB(0);
          for (int q = 0; q < 4; ++q) { const int tt = (wave & 3) * 4 + q, tm = tt >> 2, tn = tt & 3;
              f32x4 acc = {0.f, 0.f, 0.f, 0.f};
              acc = mm_tile(MB(11), MP, 16 * tm, yb, MP, 16 * tn, 2, acc, lane);
              *(LAS u32x2*)(ob + (16 * tn + r16) * MP + (16 * tm + 4 * g) * 2) = pk4(acc); } }
        __syncthreads();
        }
        SA_REP(16) {
#pragma unroll
        for (int q = 0; q < 2; ++q) { const int tt = wave * 2 + q, tm = tt >> 2, tn = tt & 3;
            { f32x4 acc = {0.f, 0.f, 0.f, 0.f}; acc = mm_tile(MB(3), MP, 16 * tm, MB(9), MP, 16 * tn, 2, acc, lane);
              const int i = 16 * tn + r16, k0 = 16 * tm + 4 * g; const u32x2 rr = *(const LAS u32x2*)(MB(1) + i * MP + k0 * 2);
              acc[0] += bflo(rr.x); acc[1] += bfhi(rr.x); acc[2] += bflo(rr.y); acc[3] += bfhi(rr.y);
              *(u32x2*)(rec1 + U_RPP + (size_t)(i * 64 + permk(k0)) * 2) = pk4(acc); }
            { f32x4 acc = {0.f, 0.f, 0.f, 0.f}; acc = mm_tile(MB(3), MP, 16 * tm, MB(6), MP, 16 * tn, 2, acc, lane);
              const int kp = 16 * tn + r16, k0 = 16 * tm + 4 * g;
#pragma unroll
              for (int r = 0; r < 4; ++r) if (k0 + r == kp) acc[r] += GL[kp];
              *(u32x2*)(rec1 + U_PMP + (size_t)(kp * 64 + permk(k0)) * 2) = pk4(acc); }
            { f32x4 acc = pyl[q]; acc = mm_tile(MB(0), MP, 16 * tm, MB(9), MP, 16 * tn, 2, acc, lane); if (wave == 0) acc = mm_tile(MB(5), MP, 16 * tm, MB(10), MP, 16 * tn, 2, acc, lane);
              *(u32x2*)(rec2 + U_YLT + (size_t)((16 * tn + r16) * 64 + 16 * tm + 4 * g) * 2) = pk4(acc); }
            { f32x4 acc = pqm[q]; acc = mm_tile(MB(6), MP, 16 * tm, MB(0), MP, 16 * tn, 2, acc, lane); if (wave == 0) acc = mm_tile(MB(7), MP, 16 * tm, MB(5), MP, 16 * tn, 2, acc, lane);
              *(u32x2*)(rec2 + U_QMT + (size_t)((16 * tn + r16) * 64 + 16 * tm + 4 * g) * 2) = pk4(acc); }
        }
        __syncthreads(); }
    }
#undef MB
#undef SCANA_LOAD
}

constexpr int SB_D = 9, SB_SLOT = 16384;
DI void scanb_issue(LAS unsigned char* lds, const unsigned char* r1b, const unsigned char* r2b, int cidx, int lw, int lane) {
    const unsigned char* rec1 = r1b + (size_t)cidx * U1_BYTES; const unsigned char* rec2 = r2b + (size_t)cidx * U2_BYTES;
    LAS unsigned char* slot = lds + (cidx % SB_D) * SB_SLOT;
#pragma unroll
    for (int i = 0; i < 2; ++i) { const int ci = 2 * lw + i;
        const int row = 8 * ci + (lane >> 3), sl = lane & 7;
        __builtin_amdgcn_global_load_lds((const unsigned*)(rec1 + U_PMP + row * 128 + ((sl ^ (row & 7)) << 4)), (LAS unsigned*)(slot + ci * 1024), 16, 0, 0); }
#pragma unroll
    for (int i = 0; i < 2; ++i) { const int ci = 2 * lw + i;
        const int v = 8 * ci + (lane >> 3), sl = lane & 7;
        __builtin_amdgcn_global_load_lds((const unsigned*)(rec2 + U_QMT + v * 128 + ((sl ^ (v & 7)) << 4)), (LAS unsigned*)(slot + 8192 + ci * 1024), 16, 0, 0); }
}
constexpr int CW_SFLG = 12288;
DI void phase_scan_b(Frame& F, int l) {
    const int lane = F.lane, r16 = lane & 15, g = lane >> 4, w = F.wave, v = 16 * (w & 3) + r16;
    for (int bh = F.bid; bh < NB * NH; bh += F.G) {
        const unsigned char* r1 = F.wsp() + WS_SC1 + (size_t)bh * 128 * U1_BYTES; const unsigned char* r2 = F.wsp() + WS_SC2 + (size_t)bh * 128 * U2_BYTES;
        bf16_t* sct = (bf16_t*)(F.wsp() + WS_SCT) + (size_t)bh * 128 * 4096;
        const __amdgpu_buffer_rsrc_t srs = __builtin_amdgcn_make_buffer_rsrc((void*)sct, 0, 128 * 8192, 0x00020000);
        GAS unsigned* flg = (GAS unsigned*)(F.ws_g + WS_CTL) + CW_SFLG + 64 * (l * 32 + bh);
        f32x4 sT[4];
#pragma unroll
        for (int i = 0; i < 4; ++i) sT[i] = (f32x4){0.f, 0.f, 0.f, 0.f};
        __syncthreads();
        if (w >= 4) {
#pragma unroll
            for (int d = 0; d < SB_D; ++d) scanb_issue(F.lds, r1, r2, d, w - 4, lane);
        }
        for (int c = 0; c < 128; ++c) {
            if (w >= 4) asm volatile("s_waitcnt vmcnt(28)" ::: "memory");
            __builtin_amdgcn_s_barrier();
            asm volatile("" ::: "memory");
            if (w >= 4) {
                if (c >= 1) { const int cn = c - 1 + SB_D; scanb_issue(F.lds, r1, r2, cn < 128 ? cn : c, w - 4, lane); }
            } else {
                const LAS unsigned char* slot = F.lds + (c % SB_D) * SB_SLOT;
                bf16x8 pm[4][2]; f32x4 q[4];
#pragma unroll
                for (int mt = 0; mt < 4; ++mt) { const int row = 16 * mt + r16;
#pragma unroll
                    for (int s2 = 0; s2 < 2; ++s2) pm[mt][s2] = *(const LAS bf16x8*)(slot + row * 128 + (((4 * s2 + g) ^ (row & 7)) << 4));
                    { const u32x2 qw = *(const LAS u32x2*)(slot + 8192 + v * 128 + (((2 * mt + (g >> 1)) ^ (v & 7)) << 4) + (g & 1) * 8); q[mt] = (f32x4){bflo(qw.x), bfhi(qw.x), bflo(qw.y), bfhi(qw.y)}; } }
                bf16x8 hi[2], lo[2];
#pragma unroll
                for (int s2 = 0; s2 < 2; ++s2) { u32x4 hw, lw;
#pragma unroll
                    for (int qq = 0; qq < 2; ++qq) { const f32x4 x = sT[2 * s2 + qq]; const unsigned h0 = pk2(x[0], x[1]), h1 = pk2(x[2], x[3]);
                        const unsigned l0 = pk2(x[0] - bflo(h0), x[1] - bfhi(h0)), l1 = pk2(x[2] - bflo(h1), x[3] - bfhi(h1));
                        if (qq == 0) { hw.x = h0; hw.y = h1; lw.x = l0; lw.y = l1; } else { hw.z = h0; hw.w = h1; lw.z = l0; lw.w = l1; } }
                    hi[s2] = __builtin_bit_cast(bf16x8, hw); lo[s2] = __builtin_bit_cast(bf16x8, lw);
                    __builtin_amdgcn_raw_buffer_store_b128(hw, srs, (int)(((unsigned)c * 4096u + (unsigned)v * 64u + 32u * s2 + 8u * g) * 2u), 0, 16); }
#pragma unroll
                for (int mt = 0; mt < 4; ++mt) { f32x4 n = q[mt];
#pragma unroll
                    for (int s2 = 0; s2 < 2; ++s2) { n = mfma16(pm[mt][s2], hi[s2], n); n = mfma16(pm[mt][s2], lo[s2], n); }
                    sT[mt] = n; }
                asm volatile("s_waitcnt lgkmcnt(0)" ::: "memory");
                if ((c & 3) == 3 && c >= 7) { asm volatile("s_waitcnt vmcnt(8)" ::: "memory");
                    if (lane == 0) __hip_atomic_fetch_add(flg, 1u, __ATOMIC_RELAXED, __HIP_MEMORY_SCOPE_AGENT); }
            }
        }
        asm volatile("s_waitcnt vmcnt(0)" ::: "memory");
        if (w < 4 && lane == 0) __hip_atomic_fetch_add(flg, 1u, __ATOMIC_RELAXED, __HIP_MEMORY_SCOPE_AGENT);
    }
}

struct ScanCIn { bf16x8 ra[2]; f32x4 yl[4]; bf16x8 sb[4][2]; };
DI void scanc_load(ScanCIn& o, const unsigned char* ws, GAS unsigned* flags, int item, int r16, int g) {
    asm volatile("" : "+s"(item));
    const int u = item >> 2, it = item & 3; const int bh = u & 31, c = u >> 5; const size_t ui = (size_t)(bh * 128 + c);
    {
      GAS unsigned* fw = flags + 64 * bh; const unsigned need = 4u * ((unsigned)(c >> 2) + 1u); unsigned spins = 0;
      while ((unsigned)__builtin_amdgcn_readfirstlane((int)__hip_atomic_load(fw, __ATOMIC_RELAXED, __HIP_MEMORY_SCOPE_AGENT)) < need) { __builtin_amdgcn_s_sleep(2); if (++spins > (1u << 20)) break; }
      asm volatile("" ::: "memory"); }
    const unsigned char* rec1 = ws + WS_SC1 + ui * U1_BYTES; const unsigned char* rec2 = ws + WS_SC2 + ui * U2_BYTES;
    const __amdgpu_buffer_rsrc_t srs = __builtin_amdgcn_make_buffer_rsrc((void*)(ws + WS_SCT + ui * 8192), 0, 8192, 0x00020000);
#pragma unroll
    for (int s = 0; s < 2; ++s) o.ra[s] = *(const bf16x8*)(rec1 + U_RPP + (size_t)((16 * it + r16) * 64 + 32 * s + 8 * g) * 2);
#pragma unroll
    for (int vt = 0; vt < 4; ++vt) { { const u32x2 yw = *(const u32x2*)(rec2 + U_YLT + (size_t)((16 * it + r16) * 64 + 32 * (vt >> 1) + 8 * g + 4 * (vt & 1)) * 2); o.yl[vt] = (f32x4){bflo(yw.x), bfhi(yw.x), bflo(yw.y), bfhi(yw.y)}; }
        const int vrow = 32 * (vt >> 1) + 8 * (r16 >> 2) + 4 * (vt & 1) + (r16 & 3);
#pragma unroll
        for (int s = 0; s < 2; ++s) o.sb[vt][s] = __builtin_bit_cast(bf16x8, __builtin_amdgcn_raw_buffer_load_b128(srs, (int)((vrow * 64 + 32 * s + 8 * g) * 2), 0, 16)); }
}
DI void scanc_item(const ScanCIn& o, Frame& F, int l, int item, int r16, int g) {
    const bf16_t* SIr = (const bf16_t*)(F.wsp() + WS_SIR); const bf16_t* SIk = (const bf16_t*)(F.wsp() + WS_SIK);
    const bf16_t* V = (const bf16_t*)(F.wsp() + (l > 0 ? WS_V1 : WS_VF)); const bf16_t* Gb = (const bf16_t*)(F.wsp() + WS_G); bf16_t* YR = (bf16_t*)(F.wsp() + WS_YRM);
    const int u = item >> 2, it = item & 3; const int bh = u & 31, c = u >> 5, b = bh >> 3, h = bh & 7;
    const size_t tok = (size_t)b * SEQ + c * 64 + 16 * it + r16; const size_t o0 = tok * CW + h * 64 + 8 * g, oy = tok * YRM_LD + h * 64 + 8 * g;
    u32x4 pr[2], pk[2], pv[2], pg[2];
#pragma unroll
    for (int p = 0; p < 2; ++p) { pr[p] = *(const u32x4*)(SIr + o0 + 32 * p); pk[p] = *(const u32x4*)(SIk + o0 + 32 * p); pv[p] = *(const u32x4*)(V + o0 + 32 * p); pg[p] = *(const u32x4*)(Gb + o0 + 32 * p); }
    f32x4 y[4];
#pragma unroll
    for (int vt = 0; vt < 4; ++vt) { y[vt] = o.yl[vt];
#pragma unroll
        for (int s = 0; s < 2; ++s) y[vt] = mfma16(o.sb[vt][s], o.ra[s], y[vt]); }
    float s1 = 0.f;
#pragma unroll
    for (int vt = 0; vt < 4; ++vt) s1 += (y[vt][0] + y[vt][1]) + (y[vt][2] + y[vt][3]);
    s1 += __shfl_xor(s1, 16); s1 += __shfl_xor(s1, 32);
    const float mean = s1 * (1.f / 64.f); float s2 = 0.f;
#pragma unroll
    for (int vt = 0; vt < 4; ++vt) { y[vt] = y[vt] - mean; s2 += (y[vt][0] * y[vt][0] + y[vt][1] * y[vt][1]) + (y[vt][2] * y[vt][2] + y[vt][3] * y[vt][3]); }
    s2 += __shfl_xor(s2, 16); s2 += __shfl_xor(s2, 32);
    const float rstd = __builtin_amdgcn_rsqf(s2 * (1.f / 64.f) + 64e-5f);
    const float* lng = F.inp(17) + l * CW + h * 64 + 8 * g; const float* lnb = F.inp(18) + l * CW + h * 64 + 8 * g; const float* rkp = F.inp(16) + l * CW + h * 64 + 8 * g;
    float s3 = 0.f;
#pragma unroll
    for (int p = 0; p < 2; ++p) { const f32x4 rk0 = *(const f32x4*)(rkp + 32 * p), rk1 = *(const f32x4*)(rkp + 32 * p + 4);
        s3 += bflo(pr[p].x) * bflo(pk[p].x) * rk0[0] + bfhi(pr[p].x) * bfhi(pk[p].x) * rk0[1] + bflo(pr[p].y) * bflo(pk[p].y) * rk0[2] + bfhi(pr[p].y) * bfhi(pk[p].y) * rk0[3]
            + bflo(pr[p].z) * bflo(pk[p].z) * rk1[0] + bfhi(pr[p].z) * bfhi(pk[p].z) * rk1[1] + bflo(pr[p].w) * bflo(pk[p].w) * rk1[2] + bfhi(pr[p].w) * bfhi(pk[p].w) * rk1[3]; }
    s3 += __shfl_xor(s3, 16); s3 += __shfl_xor(s3, 32);
#pragma unroll
    for (int p = 0; p < 2; ++p) { const f32x4 lg0 = *(const f32x4*)(lng + 32 * p), lg1 = *(const f32x4*)(lng + 32 * p + 4), lb0 = *(const f32x4*)(lnb + 32 * p), lb1 = *(const f32x4*)(lnb + 32 * p + 4);
        const f32x4 ya = y[2 * p], yb = y[2 * p + 1];
        const float o_0 = (ya[0] * rstd * lg0[0] + lb0[0] + s3 * bflo(pv[p].x)) * bflo(pg[p].x), o_1 = (ya[1] * rstd * lg0[1] + lb0[1] + s3 * bfhi(pv[p].x)) * bfhi(pg[p].x);
        const float o_2 = (ya[2] * rstd * lg0[2] + lb0[2] + s3 * bflo(pv[p].y)) * bflo(pg[p].y), o_3 = (ya[3] * rstd * lg0[3] + lb0[3] + s3 * bfhi(pv[p].y)) * bfhi(pg[p].y);
        const float o_4 = (yb[0] * rstd * lg1[0] + lb1[0] + s3 * bflo(pv[p].z)) * bflo(pg[p].z), o_5 = (yb[1] * rstd * lg1[1] + lb1[1] + s3 * bfhi(pv[p].z)) * bfhi(pg[p].z);
        const float o_6 = (yb[2] * rstd * lg1[2] + lb1[2] + s3 * bflo(pv[p].w)) * bflo(pg[p].w), o_7 = (yb[3] * rstd * lg1[3] + lb1[3] + s3 * bfhi(pv[p].w)) * bfhi(pg[p].w);
        u32x4 w; w.x = pk2(o_0, o_1); w.y = pk2(o_2, o_3); w.z = pk2(o_4, o_5); w.w = pk2(o_6, o_7); *(u32x4*)(YR + oy + 32 * p) = w; }
}
DI void phase_scan_c(Frame& F, int l, int nskip) {
    const int lane = F.lane, r16 = lane & 15, g = lane >> 4;
    const int first = (F.bid - nskip) * 8 + F.wave, stride = (F.G - nskip) * 8;
    if (first >= NUNIT * 4) return;
    GAS unsigned* flags = (GAS unsigned*)(F.ws_g + WS_CTL) + CW_SFLG + 64 * (l * 32);
    ScanCIn o0, o1;
    scanc_load(o0, F.wsp(), flags, first, r16, g);
    for (int item = first; item < NUNIT * 4; item += 2 * stride) {
        const int i1 = item + stride, i2 = item + 2 * stride;
        if (i1 < NUNIT * 4) scanc_load(o1, F.wsp(), flags, i1, r16, g);
        scanc_item(o0, F, l, item, r16, g);
        if (i1 < NUNIT * 4) { if (i2 < NUNIT * 4) scanc_load(o0, F.wsp(), flags, i2, r16, g); scanc_item(o1, F, l, i1, r16, g); }
    }
}

#ifndef FUSE_DUP
#define FUSE_DUP 0
#endif
DI void phase_prep_scana(Frame& F, int l) {
    phase_rwkv_prep2(F, l, 0, 0, 1, true);
#define RELANE() do { int l_ = F.lane; asm volatile("" : "+v"(l_)); F.lane = l_; F.tid = F.wave * 64 + l_; } while (0)
    for (int tile = F.bid; tile < T / 64; tile += F.G) {
        for (int fd_ = 0; fd_ < ((FUSE_DUP & 1) ? 2 : 1); ++fd_) {
        RELANE();
        phase_rwkv_prep2(F, l, tile, tile + 1, 1, false);
        }
        asm volatile("s_waitcnt vmcnt(0)" ::: "memory");
        __syncthreads();
        __builtin_amdgcn_fence(__ATOMIC_ACQUIRE, "agent");
        asm volatile("s_waitcnt vmcnt(0)" ::: "memory");
        const int b = tile >> 7, c = tile & 127; const int u0 = c * 32 + b * 8;
        for (int fd_ = 0; fd_ < ((FUSE_DUP & 2) ? 2 : 1); ++fd_) {
        RELANE();
        phase_scan_a(F, l, u0, u0 + 8, 1);
        }
    }
#undef RELANE
}
DI void phase_moba_prep(Frame& F, int l) {
    bf16_t* MO = (bf16_t*)(F.wsp() + WS_MO); float* KM = (float*)(F.wsp() + WS_TAB + TB_KMEAN);
    int c = F.tid; const float qg = F.inp(23)[l * 64 + (c & 63)] * 0.125f, kg = F.inp(24)[l * 64 + (c & 63)];
    for (int hs = F.bid; hs < T / 128; hs += F.G) {
        float ksum = 0.f;
        for (int tb = 0; tb < 128; tb += 8) {
            int tbase = hs * 128 + tb; asm volatile("" : "+s"(tbase), "+v"(c));
            float q[8], k[8];
#pragma unroll
            for (int e = 0; e < 8; ++e) { const size_t ro = (size_t)(tbase + e) * 1536; q[e] = bf2f(MO[ro + c]); k[e] = bf2f(MO[ro + 512 + c]); }
#pragma unroll
            for (int e = 0; e < 8; ++e) { const size_t ro = (size_t)(tbase + e) * 1536;
                const float qs = wave_sum(q[e] * q[e]) * (1.f / 64.f), ks = wave_sum(k[e] * k[e]) * (1.f / 64.f);
                const float qn = q[e] * (1.0f / sqrtf(qs + 1e-6f)) * qg, kn = k[e] * (1.0f / sqrtf(ks + 1e-6f)) * kg;
                MO[ro + c] = f2bf(qn); MO[ro + 512 + c] = f2bf(kn); ksum += kn; }
        }
        KM[(size_t)(hs & 1) * (TB_KMEAN2 / 4) + (size_t)(hs >> 1) * CW + c] = ksum * (1.f / 256.f);
    }
}
DI void phase_moba_gate(Frame& F) {
    LAS float* KL = (LAS float*)F.lds;
    const bf16_t* MO = (const bf16_t*)(F.wsp() + WS_MO); const float* KM = (const float*)(F.wsp() + WS_TAB + TB_KMEAN); unsigned* SEL = (unsigned*)(F.wsp() + WS_SEL);
    for (int sidx = F.bid; sidx < T / 64; sidx += F.G) {
        const int span = ((sidx / F.G) & 1) ? ((sidx & ~127) + (127 - (sidx & 127))) : sidx;
        const int t0 = span * 64, b = t0 / SEQ, blk = (t0 % SEQ) / 256;
        __syncthreads();
        { const int cc = F.tid, h = cc >> 6, d = cc & 63;
          for (int j0 = 0; j0 < blk; j0 += 8) { float v0[8], v1[8];
#pragma unroll
              for (int e = 0; e < 8; ++e) { const int j = (j0 + e < blk) ? j0 + e : blk - 1; const size_t ko = ((size_t)(b * 32 + j)) * CW + cc; v0[e] = KM[ko]; v1[e] = KM[ko + TB_KMEAN2 / 4]; }
#pragma unroll
              for (int e = 0; e < 8; ++e) if (j0 + e < blk) KL[h * 2052 + (j0 + e) * 64 + d] = v0[e] + v1[e]; } }
        __syncthreads();
        const int tok = F.tid >> 3, h = F.tid & 7; const int t = t0 + tok;
        float q[64];
        { const u32x4* qp = (const u32x4*)(MO + (size_t)t * 1536 + h * 64);
#pragma unroll
          for (int i = 0; i < 8; ++i) { const u32x4 w = qp[i]; q[8 * i] = bflo(w.x); q[8 * i + 1] = bfhi(w.x); q[8 * i + 2] = bflo(w.y); q[8 * i + 3] = bfhi(w.y); q[8 * i + 4] = bflo(w.z); q[8 * i + 5] = bfhi(w.z); q[8 * i + 6] = bflo(w.w); q[8 * i + 7] = bfhi(w.w); } }
        float v0 = -INFINITY, v1 = -INFINITY, v2 = -INFINITY; int i0 = 0, i1 = 1, i2 = 2;
        for (int j = 0; j < blk; ++j) {
            const LAS f32x4* kp = (const LAS f32x4*)(KL + h * 2052 + j * 64); float s = 0.f;
#pragma unroll
            for (int i = 0; i < 16; ++i) { const f32x4 kv = kp[i]; s += q[4 * i] * kv.x + q[4 * i + 1] * kv.y + q[4 * i + 2] * kv.z + q[4 * i + 3] * kv.w; }
            if (s > v0) { v2 = v1; i2 = i1; v1 = v0; i1 = i0; v0 = s; i0 = j; }
            else if (s > v1) { v2 = v1; i2 = i1; v1 = s; i1 = j; }
            else if (s > v2) { v2 = s; i2 = j; }
        }
        const int nv = blk < 3 ? blk : 3;
        SEL[(size_t)t * 8 + h] = (unsigned)i0 | ((unsigned)i1 << 8) | ((unsigned)i2 << 16) | ((unsigned)nv << 24);
    }
}

constexpr int KS_PITCH = 144, VT_PITCH = 520;
constexpr int NPIECE = 47;
constexpr int CW_QATT = 8192;
DI void phase_moba_attn(Frame& F, int l) {
    static constexpr unsigned PIECES[NPIECE] = {196608,1837578,590595,1574658,1115654,1640713,1968907,1443848,918789,1049857,1246983,393730,787456,721924,2034700,262401,2034179,2034957,2035214,2035471,2034692,2035728,2034944,2035985,2036242,2036499,2035461,2036756,2037013,2037270,2035969,2037527,2036230,2037784,2038041,2038298,2036743,2038555,2038812,2039069,2039326,2037512,2039583,2038018,2038281,2039050,2039563};
    LAS unsigned char* Ks = F.lds;
    LAS unsigned char* Vt = F.lds + 36864;
    LAS float* LUT = (LAS float*)(F.lds + 36864 + 33280);
    LAS unsigned* CTL = (LAS unsigned*)(F.lds + 36864 + 33280 + 528);
    LAS unsigned* LIST = CTL + 4;
    const bf16_t* MO = (const bf16_t*)(F.wsp() + WS_MO); const unsigned* SEL = (const unsigned*)(F.wsp() + WS_SEL);
    bf16_t* PO = (bf16_t*)(F.wsp() + WS_PO); f32x2* PST = (f32x2*)(F.wsp() + WS_PST);
    unsigned* qctr = (unsigned*)(F.wsp() + WS_CTL) + CW_QATT + 64 * l;
    const float* relb = F.inp(25);
    const int lane = F.lane;
    bool att_done = false, conv_done = false;
    for (int trip = 0;; ++trip) {
        if (!conv_done && (att_done || (trip % 3) == 2)) {
            __syncthreads();
            if (F.tid == 0) CTL[2] = __hip_atomic_fetch_add(qctr + 16, 1u, __ATOMIC_RELAXED, __HIP_MEMORY_SCOPE_AGENT);
            __syncthreads();
            const int cu = (int)CTL[2];
            if (cu >= CONV_UNITS) conv_done = true; else conv_experts_items(F, l, cu * CONV_GROUP, (cu + 1) * CONV_GROUP, 1);
        }
        if (att_done) { if (conv_done) break; continue; }
        __syncthreads();
        if (F.tid == 0) { CTL[0] = __hip_atomic_fetch_add(qctr, 1u, __ATOMIC_RELAXED, __HIP_MEMORY_SCOPE_AGENT); CTL[1] = 0u; }
        __syncthreads();
        const int u = (int)CTL[0];
        if (u >= NPIECE * NB * NH) { att_done = true; if (conv_done) break; continue; }
        const unsigned pc = PIECES[u >> 5]; const int bh = u & 31, b = bh >> 3, h = bh & 7;
        const int j = (int)(pc & 0xff), qlo = (int)((pc >> 8) & 0xff), qhi = (int)(pc >> 16); const int ncand = (qhi - qlo + 1) * 256;
        const size_t tokb = (size_t)b * SEQ;
        for (int id = F.tid; id < 2048; id += 512) { const int row = id >> 3, c8 = id & 7; const size_t ro = (tokb + j * 256 + row) * 1536 + h * 64 + c8 * 8;
            *(LAS u32x4*)(Ks + row * KS_PITCH + c8 * 16) = *(const u32x4*)(MO + ro + 512); }
        for (int id = F.tid; id < 1024; id += 512) { const int rp = id >> 3, c8 = id & 7; const size_t ro = (tokb + j * 256 + 2 * rp) * 1536 + h * 64 + c8 * 8 + 1024;
            const u32x4 v0 = *(const u32x4*)(MO + ro), v1 = *(const u32x4*)(MO + ro + 1536);
            const unsigned a[4] = {v0.x, v0.y, v0.z, v0.w}, bq[4] = {v1.x, v1.y, v1.z, v1.w};
            LAS unsigned char* vp = Vt + (c8 * 8) * VT_PITCH + rp * 4;
#pragma unroll
            for (int q = 0; q < 4; ++q) { *(LAS unsigned*)(vp + (2 * q) * VT_PITCH) = (a[q] & 0xffffu) | (bq[q] << 16); *(LAS unsigned*)(vp + (2 * q + 1) * VT_PITCH) = (a[q] >> 16) | (bq[q] & 0xffff0000u); } }
        if (F.tid <= 128) { const int n = F.tid; int bucket;
            if (n < 16) bucket = n; else { int lg = 16 + (int)(logf((float)n / 16.0f) / 2.0794415416798357f * 16.0f); bucket = lg < 31 ? lg : 31; }
            LUT[n] = relb[bucket * 8 + h]; }
        unsigned selw[11];
#pragma unroll
        for (int r = 0; r < 11; ++r) { const int qq = qlo * 256 + r * 512 + F.tid; selw[r] = (r * 512 + F.tid < ncand) ? SEL[(tokb + qq) * 8 + h] : 0u; }
#pragma unroll
        for (int r = 0; r < 11; ++r) { const int base = r * 512; if (base >= ncand) break;
            const int q = qlo * 256 + base + F.tid; const int qb = q >> 8; bool mem = false; unsigned ent = 0;
            if (base + F.tid >= ncand) { }
            else if (qb == j) { mem = true; ent = (unsigned)q | (3u << 16); }
            else { const unsigned s = selw[r]; const unsigned nv = s >> 24;
                if (nv > 0 && (s & 0xff) == (unsigned)j) { mem = true; ent = (unsigned)q; }
                else if (nv > 1 && ((s >> 8) & 0xff) == (unsigned)j) { mem = true; ent = (unsigned)q | (1u << 16); }
                else if (nv > 2 && ((s >> 16) & 0xff) == (unsigned)j) { mem = true; ent = (unsigned)q | (2u << 16); } }
            const unsigned long long bal = __ballot(mem); const int cnt = __popcll(bal);
            unsigned wbase = 0; if (lane == 0 && cnt > 0) wbase = __hip_atomic_fetch_add(&CTL[1], (unsigned)cnt, __ATOMIC_RELAXED, __HIP_MEMORY_SCOPE_WORKGROUP);
            wbase = (unsigned)__builtin_amdgcn_readfirstlane((int)wbase);
            if (mem) LIST[wbase + __popcll(bal & ((1ull << lane) - 1ull))] = ent;
        }
        __syncthreads();
        const int total = (int)CTL[1];
        const float bfar = LUT[128];
        const int ntile = (total + 31) >> 5;
        const int qi = lane & 31, half = lane >> 5;
        bf16x8 qfn[4]; unsigned enn = 0u;
        if (F.wave < ntile) { const int e0 = F.wave * 32 + qi; enn = LIST[e0 < total ? e0 : total - 1]; const size_t tk0 = tokb + (enn & 0xffffu);
#pragma unroll
            for (int kk = 0; kk < 4; ++kk) qfn[kk] = *(const bf16x8*)(MO + tk0 * 1536 + h * 64 + 16 * kk + 8 * half); }
        for (int tile = F.wave; tile < ntile; tile += 8) {
            const int e = tile * 32 + qi; const bool valid = e < total; const unsigned en = enn;
            const int q = (int)(en & 0xffffu), slot = (int)(en >> 16); const size_t tok = tokb + q;
            const bool need_lut = __any((q >> 8) <= j + 1);
            bf16x8 qf[4];
#pragma unroll
            for (int kk = 0; kk < 4; ++kk) qf[kk] = qfn[kk];
            if (tile + 8 < ntile) { const int e1 = (tile + 8) * 32 + qi; enn = LIST[e1 < total ? e1 : total - 1]; const size_t tk1 = tokb + (enn & 0xffffu);
#pragma unroll
                for (int kk = 0; kk < 4; ++kk) qfn[kk] = *(const bf16x8*)(MO + tk1 * 1536 + h * 64 + 16 * kk + 8 * half); }
            float mrun = -1e30f, lsum = 0.f;
            f32x16 oacc[2];
#pragma unroll
            for (int i = 0; i < 16; ++i) { oacc[0][i] = 0.f; oacc[1][i] = 0.f; }
            const int qrel = q - j * 256;
#pragma unroll 1
            for (int ck = 0; ck < 4; ++ck) {
                if (!__any(qrel >= 64 * ck)) break;
                f32x16 sacc[2];
#pragma unroll
                for (int k2 = 0; k2 < 2; ++k2) { const int kt = 2 * ck + k2;
#pragma unroll
                    for (int i = 0; i < 16; ++i) sacc[k2][i] = 0.f;
#pragma unroll
                    for (int kk = 0; kk < 4; ++kk) { const bf16x8 ka = *(const LAS bf16x8*)(Ks + (32 * kt + qi) * KS_PITCH + (16 * kk + 8 * half) * 2);
                        sacc[k2] = __builtin_amdgcn_mfma_f32_32x32x16_bf16(ka, qf[kk], sacc[k2], 0, 0, 0); } }
                float mx = -1e30f;
                if (need_lut) {
#pragma unroll
                    for (int k2 = 0; k2 < 2; ++k2)
#pragma unroll
                        for (int i = 0; i < 16; ++i) { const int key = 32 * (2 * ck + k2) + (i & 3) + 8 * (i >> 2) + 4 * half; const int n = qrel - key;
                            const float bias = LUT[n < 0 ? 0 : (n > 128 ? 128 : n)];
                            const float s = (n < 0) ? -1e30f : sacc[k2][i] + bias; sacc[k2][i] = s; mx = fmaxf(mx, s); }
                } else {
#pragma unroll
                    for (int k2 = 0; k2 < 2; ++k2)
#pragma unroll
                        for (int i = 0; i < 16; ++i) { const float s = sacc[k2][i] + bfar; sacc[k2][i] = s; mx = fmaxf(mx, s); }
                }
                mx = fmaxf(mx, __shfl_xor(mx, 32));
                const float mnew = fmaxf(mrun, mx); const float alpha = __expf(mrun - mnew); mrun = mnew;
                lsum *= alpha;
#pragma unroll
                for (int i = 0; i < 16; ++i) { oacc[0][i] *= alpha; oacc[1][i] *= alpha; }
#pragma unroll
                for (int k2 = 0; k2 < 2; ++k2) { const int kt = 2 * ck + k2;
#pragma unroll
                    for (int i = 0; i < 16; ++i) { const float p = __expf(sacc[k2][i] - mnew); sacc[k2][i] = p; lsum += p; }
#pragma unroll
                    for (int cc = 0; cc < 2; ++cc) {
                        u32x4 pw; pw.x = pk2(sacc[k2][8 * cc], sacc[k2][8 * cc + 1]); pw.y = pk2(sacc[k2][8 * cc + 2], sacc[k2][8 * cc + 3]); pw.z = pk2(sacc[k2][8 * cc + 4], sacc[k2][8 * cc + 5]); pw.w = pk2(sacc[k2][8 * cc + 6], sacc[k2][8 * cc + 7]);
                        const bf16x8 pf = __builtin_bit_cast(bf16x8, pw);
                        const int key0 = 32 * kt + 16 * cc + 4 * half;
#pragma unroll
                        for (int dt = 0; dt < 2; ++dt) { const LAS unsigned char* vb = Vt + (32 * dt + qi) * VT_PITCH + key0 * 2;
                            const u32x2 va = *(const LAS u32x2*)vb, vb2 = *(const LAS u32x2*)(vb + 16);
                            u32x4 vw; vw.x = va.x; vw.y = va.y; vw.z = vb2.x; vw.w = vb2.y;
                            oacc[dt] = __builtin_amdgcn_mfma_f32_32x32x16_bf16(__builtin_bit_cast(bf16x8, vw), pf, oacc[dt], 0, 0, 0); } } }
            }
            const float mx = mrun;
            lsum += __shfl_xor(lsum, 32);
            const float inv = 1.0f / lsum;
            if (valid) {
                bf16_t* op = PO + ((size_t)slot * T + tok) * CW + h * 64;
#pragma unroll
                for (int dt = 0; dt < 2; ++dt)
#pragma unroll
                    for (int ig = 0; ig < 4; ++ig) { u32x2 w; w.x = pk2(oacc[dt][4 * ig] * inv, oacc[dt][4 * ig + 1] * inv); w.y = pk2(oacc[dt][4 * ig + 2] * inv, oacc[dt][4 * ig + 3] * inv);
                        *(u32x2*)(op + 32 * dt + 8 * ig + 4 * half) = w; }
                if (half == 0) PST[((size_t)slot * T + tok) * 8 + h] = (f32x2){mx, lsum};
            }
        }
    }
}
DI void phase_moba_combine(Frame& F) {
    const bf16_t* PO = (const bf16_t*)(F.wsp() + WS_PO); const f32x2* PST = (const f32x2*)(F.wsp() + WS_PST); const unsigned* SEL = (const unsigned*)(F.wsp() + WS_SEL);
    bf16_t* YM = (bf16_t*)(F.wsp() + WS_YRM) + 512;
    int tid = F.tid;
    for (int tb = F.bid * 16; tb < T; tb += F.G * 16) {
        int tbase = tb; asm volatile("" : "+s"(tbase), "+v"(tid));
        const int c0 = (tid & 63) * 8, h = c0 >> 6;
        int nv[2]; f32x2 st[2][4]; u32x4 po[2][4];
#pragma unroll
        for (int e = 0; e < 2; ++e) { const int t = tbase + 8 * e + (tid >> 6); nv[e] = (int)(SEL[(size_t)t * 8 + h] >> 24);
#pragma unroll
            for (int s = 0; s < 4; ++s) { st[e][s] = PST[((size_t)s * T + t) * 8 + h]; po[e][s] = *(const u32x4*)(PO + ((size_t)s * T + t) * CW + c0); } }
#pragma unroll
        for (int e = 0; e < 2; ++e) { const int t = tbase + 8 * e + (tid >> 6); float M = -1e30f;
#pragma unroll
            for (int s = 0; s < 4; ++s) { const bool on = (s == 3) || (s < nv[e]); if (on) M = fmaxf(M, st[e][s].x); }
            float den = 0.f, num[8];
#pragma unroll
            for (int j = 0; j < 8; ++j) num[j] = 0.f;
#pragma unroll
            for (int s = 0; s < 4; ++s) { const bool on = (s == 3) || (s < nv[e]); if (on) { const float w = st[e][s].y * __expf(st[e][s].x - M); den += w;
                    num[0] += w * bflo(po[e][s].x); num[1] += w * bfhi(po[e][s].x); num[2] += w * bflo(po[e][s].y); num[3] += w * bfhi(po[e][s].y);
                    num[4] += w * bflo(po[e][s].z); num[5] += w * bfhi(po[e][s].z); num[6] += w * bflo(po[e][s].w); num[7] += w * bfhi(po[e][s].w); } }
            const float inv = __builtin_amdgcn_rcpf(den);
            u32x4 o; o.x = pk2(num[0] * inv, num[1] * inv); o.y = pk2(num[2] * inv, num[3] * inv); o.z = pk2(num[4] * inv, num[5] * inv); o.w = pk2(num[6] * inv, num[7] * inv);
            *(u32x4*)(YM + (size_t)t * YRM_LD + c0) = o; }
    }
}
DI void phase_router(Frame& F, int l) {
    LAS float* xs = (LAS float*)F.lds;
    LAS float* wsm = xs + 64 * 129;
    LAS float* lgt = wsm + 128 * 36;
    LAS float* ssq = lgt + 64 * 37;
    LAS int* hist = (LAS int*)(ssq + 64);
    const float* x = F.outp(); const float* gain = F.inp(2) + (size_t)l * DM;
    const float* wgrp = F.inp(29) + (size_t)l * DM * 4; const float* wexp = F.inp(31) + (size_t)l * DM * 32;
    const float* bgrp = F.inp(30) + l * 4; const float* bexp = F.inp(32) + l * 32;
    int* EID = (int*)(F.wsp() + WS_RT + RT_EID); float* GATE = (float*)(F.wsp() + WS_RT + RT_GATE); int* HIST = (int*)(F.wsp() + WS_RT + RT_HIST);
    const int tok = F.tid & 63, jg = F.tid >> 6;
    for (int tile = F.bid; tile < T / 64; tile += F.G) {
        const int t0 = tile * 64;
        float acc[5] = {0.f, 0.f, 0.f, 0.f, 0.f}; float ss = 0.f;
        if (F.tid < 32) hist[F.tid] = 0;
        for (int kc = 0; kc < DM; kc += 128) {
            __syncthreads();
            for (int idx = F.tid; idx < 64 * 128; idx += 512) { const int r = idx >> 7, k = idx & 127; xs[r * 129 + k] = x[(size_t)(t0 + r) * DM + kc + k]; }
            for (int idx = F.tid; idx < 128 * 36; idx += 512) { const int k = idx / 36, j = idx - k * 36; const float g = gain[kc + k];
                wsm[idx] = g * (j < 4 ? wgrp[(size_t)(kc + k) * 4 + j] : wexp[(size_t)(kc + k) * 32 + (j - 4)]); }
            __syncthreads();
            for (int k = 0; k < 128; ++k) { const float xv = xs[tok * 129 + k]; ss += xv * xv;
#pragma unroll
                for (int i = 0; i < 5; ++i) { const int j = jg + 8 * i; if (j < 36) acc[i] += xv * wsm[k * 36 + j]; } }
        }
#pragma unroll
        for (int i = 0; i < 5; ++i) { const int j = jg + 8 * i; if (j < 36) lgt[tok * 37 + j] = acc[i]; }
        if (jg == 0) ssq[tok] = ss;
        __syncthreads();
        if (F.tid < 64) {
            const int t = t0 + F.tid; const float rs = 1.0f / sqrtf(ssq[F.tid] * (1.f / DM) + 1e-6f);
            float lg[4]; int gs = 0; float gm = -INFINITY;
#pragma unroll
            for (int g = 0; g < 4; ++g) { lg[g] = lgt[F.tid * 37 + g] * rs + bgrp[g]; if (lg[g] > gm) { gm = lg[g]; gs = g; } }
            float gden = 0.f;
#pragma unroll
            for (int g = 0; g < 4; ++g) gden += expf(lg[g] - gm);
            const float ptop = 1.0f / gden;
            float le[8]; float e0 = -INFINITY, e1 = -INFINITY; int j0 = 0, j1 = 1;
#pragma unroll
            for (int e = 0; e < 8; ++e) { le[e] = lgt[F.tid * 37 + 4 + gs * 8 + e] * rs + bexp[gs * 8 + e];
                if (le[e] > e0) { e1 = e0; j1 = j0; e0 = le[e]; j0 = e; } else if (le[e] > e1) { e1 = le[e]; j1 = e; } }
            const float p1 = expf(e1 - e0);
            const float g0 = ptop / (1.f + p1), g1 = ptop * p1 / (1.f + p1);
            const int ex0 = gs * 8 + j0, ex1 = gs * 8 + j1;
            EID[t * 2] = ex0; EID[t * 2 + 1] = ex1; GATE[t * 2] = g0; GATE[t * 2 + 1] = g1;
            __hip_atomic_fetch_add(&hist[ex0], 1, __ATOMIC_RELAXED, __HIP_MEMORY_SCOPE_WORKGROUP); __hip_atomic_fetch_add(&hist[ex1], 1, __ATOMIC_RELAXED, __HIP_MEMORY_SCOPE_WORKGROUP);
        }
        __syncthreads();
        if (F.tid < 32) HIST[tile * 32 + F.tid] = hist[F.tid];
        __syncthreads();
    }
}
DI void phase_moe_gather(Frame& F, int l) {
    LAS int* tot = (LAS int*)F.lds; LAS int* off = tot + 32; LAS int* base = off + 32; LAS int* eidl = base + 32; LAS int* rowl = eidl + 128; LAS int* ps = rowl + 128; LAS int* po = ps + 512;
    const int* EID = (const int*)(F.wsp() + WS_RT + RT_EID); const float* GATE = (const float*)(F.wsp() + WS_RT + RT_GATE); const int* HIST = (const int*)(F.wsp() + WS_RT + RT_HIST);
    int* ROW = (int*)(F.wsp() + WS_RT + RT_ROW); float* GW = (float*)(F.wsp() + WS_RT + RT_GW); int* PEXP = (int*)(F.wsp() + WS_RT + RT_PEXP);
    int* TOK = (int*)(F.wsp() + WS_RT + RT_TOK); const float* RSQ = (const float*)(F.wsp() + WS_RT + RT_RSQ); float* RSR = (float*)(F.wsp() + WS_RT + RT_RSR);
    for (int tile = F.bid; tile < T / 64; tile += F.G) {
        const int t0 = tile * 64;
        __syncthreads();
        { const int e = F.tid & 31, part = F.tid >> 5; int s = 0, o = 0;
#pragma unroll 8
          for (int i = part * 32; i < part * 32 + 32; ++i) { const int v = HIST[i * 32 + e]; s += v; if (i < tile) o += v; }
          ps[F.tid] = s; po[F.tid] = o; }
        if (F.tid < 128) eidl[F.tid] = EID[t0 * 2 + F.tid];
        __syncthreads();
        if (F.tid < 32) { int s = 0, o = 0;
#pragma unroll
            for (int p = 0; p < 16; ++p) { s += ps[p * 32 + F.tid]; o += po[p * 32 + F.tid]; } tot[F.tid] = s; off[F.tid] = o; }
        __syncthreads();
        if (F.tid == 0) {
            int bs = 0; for (int e = 0; e < 32; ++e) { base[e] = bs; bs += (tot[e] + 255) & ~255; }
            if (tile == 0) { int p = 0; for (int e = 0; e < 32; ++e) { const int np = (tot[e] + 255) >> 8; for (int i = 0; i < np; ++i) PEXP[p++] = e; } PEXP[MOE_PANELS] = p; }
        }
        __syncthreads();
        if (F.tid < 128) { const int my = eidl[F.tid]; int rank = 0; for (int i = 0; i < F.tid; ++i) rank += (eidl[i] == my) ? 1 : 0;
            const int r = base[my] + off[my] + rank; rowl[F.tid] = r; ROW[t0 * 2 + F.tid] = r; GW[r] = GATE[t0 * 2 + F.tid]; TOK[r] = t0 + (F.tid >> 1); RSR[r] = RSQ[t0 + (F.tid >> 1)]; }
    }
}
DI void phase_moe_combine(Frame& F, int l) {
    const bf16_t* YE = (const bf16_t*)(F.wsp() + WS_YE); const int* ROW = (const int*)(F.wsp() + WS_RT + RT_ROW); bf16_t* XN = (bf16_t*)(F.wsp() + WS_XN);
    const float* gain = F.inp(1) + (size_t)(l + 1 < NLAYER ? l + 1 : l) * DM;
    const int gw = F.bid * 8 + F.wave, NGW = F.G * 8; int lane = F.lane;
    for (int tb = gw * 4; tb < T; tb += NGW * 4) {
        int tbase = tb; asm volatile("" : "+s"(tbase), "+v"(lane));
        int r0[4], r1[4];
#pragma unroll
        for (int e = 0; e < 4; ++e) { r0[e] = ROW[(tbase + e) * 2]; r1[e] = ROW[(tbase + e) * 2 + 1]; }
        u32x2 ya[4][4], yb[4][4]; f32x4 xv[4][4];
#pragma unroll
        for (int e = 0; e < 4; ++e) { const u32x2* y0 = (const u32x2*)(YE + (size_t)r0[e] * DM) + lane; const u32x2* y1 = (const u32x2*)(YE + (size_t)r1[e] * DM) + lane; const f32x4* xr = (const f32x4*)(F.outp() + (size_t)(tbase + e) * DM) + lane;
#pragma unroll
            for (int j = 0; j < 4; ++j) { ya[e][j] = y0[64 * j]; yb[e][j] = y1[64 * j]; xv[e][j] = xr[64 * j]; } }
#pragma unroll
        for (int e = 0; e < 4; ++e) { const int t = tbase + e; f32x4* xr = (f32x4*)(F.outp() + (size_t)t * DM) + lane; float s = 0.f;
#pragma unroll
            for (int j = 0; j < 4; ++j) { f32x4 v = xv[e][j]; const u32x2 a = ya[e][j], b = yb[e][j];
                v.x += bflo(a.x) + bflo(b.x); v.y += bfhi(a.x) + bfhi(b.x); v.z += bflo(a.y) + bflo(b.y); v.w += bfhi(a.y) + bfhi(b.y);
                xv[e][j] = v; xr[64 * j] = v; s += (v.x * v.x + v.y * v.y) + (v.z * v.z + v.w * v.w); }
            if (l + 1 < NLAYER) {
                const float rs = __builtin_amdgcn_rsqf(wave_sum(s) * (1.f / DM) + 1e-6f);
#pragma unroll
                for (int j = 0; j < 4; ++j) { const f32x4 g = ((const f32x4*)gain)[lane + 64 * j]; const f32x4 y = xv[e][j] * rs * g; u32x2 w; w.x = pk2(y.x, y.y); w.y = pk2(y.z, y.w); *((u32x2*)(XN + (size_t)t * DM) + lane + 64 * j) = w; }
            } }
    }
}
constexpr size_t TB_WRH = 512 * 1024, TB_WRL = TB_WRH + 48 * 1024 * 2;
DI void phase_conv_router(Frame& F, int l) {
    bf16_t* WRH = (bf16_t*)(F.wsp() + WS_TAB + TB_WRH); bf16_t* WRL = (bf16_t*)(F.wsp() + WS_TAB + TB_WRL);
    const float* gain = F.inp(2) + (size_t)l * DM; const float* wgrp = F.inp(29) + (size_t)l * DM * 4; const float* wexp = F.inp(31) + (size_t)l * DM * 32;
    for (int idx = F.bid * 512 + F.tid; idx < 48 * DM; idx += F.G * 512) { const int n = idx >> 10, k = idx & 1023;
        float v = (n < 4) ? wgrp[k * 4 + n] : (n < 36) ? wexp[k * 32 + (n - 4)] : 0.f; v *= gain[k];
        const bf16_t h = f2bf(v); WRH[idx] = h; WRL[idx] = f2bf(v - bf2f(h)); }
}
DI void phase_router2(Frame& F, int l) {
    LAS float* lgt = (LAS float*)F.lds + F.wave * 1024;
    LAS int* hist = (LAS int*)(F.lds + 8 * 4096);
    const float* x = F.outp(); const bf16_t* WRH = (const bf16_t*)(F.wsp() + WS_TAB + TB_WRH); const bf16_t* WRL = (const bf16_t*)(F.wsp() + WS_TAB + TB_WRL);
    const float* bgrp = F.inp(30) + l * 4; const float* bexp = F.inp(32) + l * 32;
    int* EID = (int*)(F.wsp() + WS_RT + RT_EID); float* GATE = (float*)(F.wsp() + WS_RT + RT_GATE); int* HIST = (int*)(F.wsp() + WS_RT + RT_HIST);
    const int lane = F.lane, r16 = lane & 15, g = lane >> 4;
    bf16_t* XN2 = (bf16_t*)(F.wsp() + WS_AM); const float* gain = F.inp(2) + (size_t)l * DM; float* RSQ = (float*)(F.wsp() + WS_RT + RT_RSQ);
    { int* TOK = (int*)(F.wsp() + WS_RT + RT_TOK); for (int i = F.bid * 512 + F.tid; i < MOE_ROWS; i += F.G * 512) TOK[i] = 0; }
    for (int task = F.bid; task < T / 128; task += F.G) {
        const int t0 = task * 128 + F.wave * 16;
        __syncthreads();
        if (F.tid < 64) hist[F.tid] = 0;
        __syncthreads();
        f32x4 acc[3];
#pragma unroll
        for (int nt = 0; nt < 3; ++nt) acc[nt] = (f32x4){0.f, 0.f, 0.f, 0.f};
        float ss = 0.f;
        const float* xr = x + (size_t)(t0 + r16) * DM + 8 * g; bf16_t* xo = XN2 + (size_t)(t0 + r16) * DM + 8 * g; const float* gp = gain + 8 * g;
#pragma unroll 2
        for (int s = 0; s < 32; ++s) {
            const f32x4 x0 = *(const f32x4*)(xr + 32 * s), x1 = *(const f32x4*)(xr + 32 * s + 4);
            ss += (x0.x * x0.x + x0.y * x0.y) + (x0.z * x0.z + x0.w * x0.w) + (x1.x * x1.x + x1.y * x1.y) + (x1.z * x1.z + x1.w * x1.w);
            { const f32x4 g0 = *(const f32x4*)(gp + 32 * s), g1 = *(const f32x4*)(gp + 32 * s + 4);
              u32x4 w; w.x = pk2(x0.x * g0.x, x0.y * g0.y); w.y = pk2(x0.z * g0.z, x0.w * g0.w); w.z = pk2(x1.x * g1.x, x1.y * g1.y); w.w = pk2(x1.z * g1.z, x1.w * g1.w);
              *(u32x4*)(xo + 32 * s) = w; }
            u32x4 hw, lw; hw.x = pk2(x0.x, x0.y); hw.y = pk2(x0.z, x0.w); hw.z = pk2(x1.x, x1.y); hw.w = pk2(x1.z, x1.w);
            lw.x = pk2(x0.x - bflo(hw.x), x0.y - bfhi(hw.x)); lw.y = pk2(x0.z - bflo(hw.y), x0.w - bfhi(hw.y)); lw.z = pk2(x1.x - bflo(hw.z), x1.y - bfhi(hw.z)); lw.w = pk2(x1.z - bflo(hw.w), x1.w - bfhi(hw.w));
            const bf16x8 ah = __builtin_bit_cast(bf16x8, hw), al = __builtin_bit_cast(bf16x8, lw);
#pragma unroll
            for (int nt = 0; nt < 3; ++nt) { const size_t wo = (size_t)(16 * nt + r16) * DM + 32 * s + 8 * g;
                const bf16x8 bh = *(const bf16x8*)(WRH + wo), bl = *(const bf16x8*)(WRL + wo);
                acc[nt] = mfma16(ah, bh, acc[nt]); acc[nt] = mfma16(ah, bl, acc[nt]); acc[nt] = mfma16(al, bh, acc[nt]); }
        }
        ss += __shfl_xor(ss, 16); ss += __shfl_xor(ss, 32);
        if (g == 0) RSQ[t0 + r16] = __builtin_amdgcn_rsqf(ss * (1.f / DM) + 1e-6f);
#pragma unroll
        for (int nt = 0; nt < 3; ++nt)
#pragma unroll
            for (int r = 0; r < 4; ++r) lgt[(4 * g + r) * 48 + 16 * nt + r16] = acc[nt][r];
        if (g == 0) lgt[768 + r16] = ss;
        LDS_WAIT(); asm volatile("" ::: "memory");
        if (lane < 16) {
            const int t = t0 + lane; const float rs = 1.0f / sqrtf(lgt[768 + lane] * (1.f / DM) + 1e-6f); const LAS float* lr = lgt + lane * 48;
            float lg[4]; int gs = 0; float gm = -INFINITY;
#pragma unroll
            for (int q = 0; q < 4; ++q) { lg[q] = lr[q] * rs + bgrp[q]; if (lg[q] > gm) { gm = lg[q]; gs = q; } }
            float gden = 0.f;
#pragma unroll
            for (int q = 0; q < 4; ++q) gden += expf(lg[q] - gm);
            const float ptop = 1.0f / gden;
            float e0 = -INFINITY, e1 = -INFINITY; int j0 = 0, j1 = 1;
#pragma unroll
            for (int e = 0; e < 8; ++e) { const float le = lr[4 + gs * 8 + e] * rs + bexp[gs * 8 + e];
                if (le > e0) { e1 = e0; j1 = j0; e0 = le; j0 = e; } else if (le > e1) { e1 = le; j1 = e; } }
            const float p1 = expf(e1 - e0);
            const float g0 = ptop / (1.f + p1), g1 = ptop * p1 / (1.f + p1);
            const int ex0 = gs * 8 + j0, ex1 = gs * 8 + j1;
            EID[t * 2] = ex0; EID[t * 2 + 1] = ex1; GATE[t * 2] = g0; GATE[t * 2 + 1] = g1;
            LAS int* hh = hist + (F.wave >> 2) * 32;
            __hip_atomic_fetch_add(&hh[ex0], 1, __ATOMIC_RELAXED, __HIP_MEMORY_SCOPE_WORKGROUP); __hip_atomic_fetch_add(&hh[ex1], 1, __ATOMIC_RELAXED, __HIP_MEMORY_SCOPE_WORKGROUP);
        }
        __syncthreads();
        if (F.tid < 64) HIST[(task * 2 + (F.tid >> 5)) * 32 + (F.tid & 31)] = hist[F.tid];
    }
}
#ifndef MK_PER_PHASE_LAUNCH
#define MK_PER_PHASE_LAUNCH 0
#endif
constexpr int PH_PER_LAYER = 19, NPHASE = PH_PER_LAYER * NLAYER;
struct Args { const float* in[36]; float* out; unsigned char* ws; int ph_lo, ph_hi; };

#ifndef SCAN_NAIVE
#define SCAN_NAIVE 0
#endif
#ifndef PHMASK
#define PHMASK 0x7ffff
#endif
#ifndef DUPMASK
#define DUPMASK 0
#endif
#define NREP(k) ((((DUPMASK) >> (k)) & 1) ? 2 : 1)
#define IN(k) (((PHMASK >> ((k) % PH_PER_LAYER)) & 1) && lo <= (k) && (k) < hi)
#define SEAM(k) do { asm volatile("" : "+s"(barp), "+s"(bar.x)); bar.bar = (unsigned*)barp; if (IN(k) && IN((k) + 1)) xcd_barrier(bar); asm volatile("" : "+s"(F.ws_g), "+s"(F.out_g), "+s"(F.ka), "+s"(F.bid), "+s"(F.G), "+s"(F.lds)); } while (0)
#define FRESH() do { asm volatile("" : "+s"(F.wave)); int l_ = (int)__builtin_amdgcn_mbcnt_hi(~0u, __builtin_amdgcn_mbcnt_lo(~0u, 0u)); asm volatile("" : "+v"(l_)); F.lane = l_; F.tid = F.wave * 64 + l_; } while (0)
__global__ void __launch_bounds__(512, 2) fwd_kernel(Args args) {
    extern __shared__ __attribute__((aligned(16))) unsigned char lds_raw[];
    Frame F;
    F.lds = (LAS unsigned char*)lds_raw;
    F.tid = threadIdx.x; F.lane = F.tid & 63; F.wave = __builtin_amdgcn_readfirstlane(F.tid >> 6);
    F.G = gridDim.x; F.bid = blockIdx.x;
    F.ka = (const __attribute__((address_space(4))) unsigned char*)__builtin_amdgcn_kernarg_segment_ptr();
    F.out_g = (GAS float*)args.out; F.ws_g = (GAS unsigned char*)args.ws;
    volatile LAS unsigned* MISC = (volatile LAS unsigned*)(F.lds + MISC_OFF);
    if (F.tid < 32) MISC[F.tid] = 0u;
    __syncthreads();
    const int lo = args.ph_lo, hi = args.ph_hi;
    GAS unsigned* barp = (GAS unsigned*)(F.ws_g + WS_CTL) + CW_BAR;
    XcdBarrier bar; bar.bar = (unsigned*)barp; bar.x = 0; bar.st = nullptr;
    if (hi - lo > 1) bar = xcd_barrier_post((unsigned*)barp, MISC + 8);

    bf16_t* const XN = (bf16_t*)(F.wsp() + WS_XN);
    bf16_t* const WCAT = (bf16_t*)(F.wsp() + WS_WM + WM_WCAT);
    for (int l = 0; l < NLAYER; ++l) {
        const int P = l * PH_PER_LAYER;
#define PHASE(k) if (IN(P + (k))) for (int rep_ = 0; rep_ < NREP(k); ++rep_)
        PHASE(0) { FRESH(); if (l == 0) { phase_conv_mixer(F, 0); phase_conv_lora2(F, 0); phase_conv_router(F, 0); phase_norm_x(F, F.inp(0), F.inp(1)); } }
        if (l == 0) SEAM(P + 0);
#if defined(XTRA_BARS)
        if (hi - lo > 1) for (int xb_ = 0; xb_ < XTRA_BARS; ++xb_) { asm volatile("" : "+s"(barp), "+s"(bar.x)); bar.bar = (unsigned*)barp; xcd_barrier(bar); }
#endif
        PHASE(1) { FRESH(); const int n1 = (l == 0) ? 2048 : 2304;
            pg8::Gemm g{XN, WCAT, T, n1, DM}; pg8::StaticOrder S; S.init(T, n1, F.G, F.bid);
            pg8::EpiStore E{(bf16_t*)(F.wsp() + WS_RW), 1536, 1536, (bf16_t*)(F.wsp() + WS_LO), LO_W, 0};
            pg8::gemm_phase<pg8::EpiStore, pg8::StaticOrder>(F.lds, g, S, E, F.tid); }
        SEAM(P + 1);
        PHASE(2) { FRESH(); phase_prep_scana(F, l); }
        SEAM(P + 2);
        PHASE(4) { FRESH(); if (F.bid < NB * NH && F.G > 2 * NB * NH) phase_scan_b(F, l); else if (F.G > 2 * NB * NH) phase_scan_c(F, l, NB * NH); else {   } }
        SEAM(P + 5);
        PHASE(6) { FRESH(); pg8::Gemm g{XN, WCAT + (size_t)2304 * DM, T, 1536, DM}; pg8::StaticOrder S; S.init(T, 1536, F.G, F.bid);
            pg8::EpiMoba E{(bf16_t*)(F.wsp() + WS_MO), F.inp(23) + l * 64, F.inp(24) + l * 64, (float*)(F.wsp() + WS_TAB + TB_KMEAN), (int)(TB_KMEAN2 / 4)};
            pg8::gemm_phase<pg8::EpiMoba, pg8::StaticOrder>(F.lds, g, S, E, F.tid); }
        SEAM(P + 6);
        PHASE(8) { FRESH(); phase_moba_gate(F); }
        SEAM(P + 8);
        PHASE(9) { FRESH(); phase_moba_attn(F, l); }
        SEAM(P + 9);
        PHASE(10) { FRESH(); phase_moba_combine(F); }
        SEAM(P + 10);
        PHASE(11) { FRESH(); pg8::Gemm g{XN, WCAT + (size_t)3840 * DM, T, 2048, DM}; pg8::StaticOrder S; S.init(T, 2048, F.G, F.bid);
            pg8::EpiStore E{(bf16_t*)(F.wsp() + WS_GA), 2048, 0, nullptr, 0, 1};
            pg8::gemm_phase<pg8::EpiStore, pg8::StaticOrder>(F.lds, g, S, E, F.tid); }
        SEAM(P + 11);
        PHASE(12) { FRESH(); pg8::Gemm g{(const bf16_t*)(F.wsp() + WS_YRM), (const bf16_t*)(F.wsp() + WS_WM + WM_BRR), T, DM, DM}; pg8::StaticOrder S; S.init(T, DM, F.G, F.bid);
            pg8::EpiBranch2 E{(bf16_t*)(F.wsp() + WS_H), (const bf16_t*)(F.wsp() + WS_GA)};
            pg8::gemm_phase<pg8::EpiBranch2, pg8::StaticOrder>(F.lds, g, S, E, F.tid); }
        SEAM(P + 12);
        PHASE(13) { FRESH(); pg8::Gemm g{(const bf16_t*)(F.wsp() + WS_H), (const bf16_t*)(F.wsp() + WS_WM + WM_OUT), T, DM, DM}; pg8::StaticOrder S; S.init(T, DM, F.G, F.bid);
            pg8::EpiResid E{l == 0 ? F.inp(0) : F.outp(), F.outp()};
            pg8::gemm_phase<pg8::EpiResid, pg8::StaticOrder>(F.lds, g, S, E, F.tid); }
        SEAM(P + 13);
        PHASE(14) { FRESH(); phase_router2(F, l); }
        SEAM(P + 14);
        PHASE(15) { FRESH(); phase_moe_gather(F, l); }
        SEAM(P + 15);
        PHASE(16) { FRESH(); const int* PEXP = (const int*)(F.wsp() + WS_RT + RT_PEXP); const int np = __builtin_amdgcn_readfirstlane(PEXP[MOE_PANELS]);
            pg8::Gemm g{(const bf16_t*)(F.wsp() + WS_AM), (const bf16_t*)(F.wsp() + WS_WE), np * 256, 1024, DM}; pg8::GatherOrder S; S.init(np * 256, 1024, F.G, F.bid); S.pexp = PEXP;
            LAS int* tokL = (LAS int*)(F.lds + RING_BYTES); S.tokL = tokL;
            { const int* TOK = (const int*)(F.wsp() + WS_RT + RT_TOK); __syncthreads();
              for (int i = 0; i < 16; ++i) { pg8::Unit uu; if (!S.next(i, uu)) break; if (F.tid < 256) tokL[i * 256 + F.tid] = TOK[uu.pm * 256 + F.tid]; }
              __syncthreads(); }
            pg8::EpiExpertUp E{(bf16_t*)(F.wsp() + WS_HM), (const float*)(F.wsp() + WS_RT + RT_GW), (const float*)(F.wsp() + WS_RT + RT_RSR)};
            pg8::gemm_phase<pg8::EpiExpertUp, pg8::GatherOrder>(F.lds, g, S, E, F.tid); }
        SEAM(P + 16);
        PHASE(17) { FRESH(); const int* PEXP = (const int*)(F.wsp() + WS_RT + RT_PEXP); const int np = __builtin_amdgcn_readfirstlane(PEXP[MOE_PANELS]);
            pg8::Gemm g{(const bf16_t*)(F.wsp() + WS_HM), (const bf16_t*)(F.wsp() + WS_WD), np * 256, 1024, DEXP}; pg8::GroupOrder S; S.init(np * 256, 1024, F.G, F.bid); S.pexp = PEXP;
            pg8::EpiStore E{(bf16_t*)(F.wsp() + WS_YE), 1024, 0, nullptr, 0, 0};
            pg8::gemm_phase<pg8::EpiStore, pg8::GroupOrder>(F.lds, g, S, E, F.tid); }
        SEAM(P + 17);
        PHASE(18) { FRESH(); phase_moe_combine(F, l); if (l + 1 < NLAYER) { phase_conv_mixer(F, l + 1); phase_conv_lora2(F, l + 1); phase_conv_router(F, l + 1); } }
        SEAM(P + 18);
#undef PHASE
    }
}

extern "C" void kernel_launch(void* const* d_in, const int* in_sizes, int n_in, void* d_out, int out_size, void* d_ws, size_t ws_size, hipStream_t stream) {
    static int grid = 0;
    if (grid == 0) {
        if (n_in != 36 || out_size != T * DM || ws_size < WS_NEED) { fprintf(stderr, "kernel_launch: unexpected problem (n_in %d, out %d, ws %zu); nothing launched\n", n_in, out_size, ws_size); grid = -1; return; }
        int dev = 0, cus = 0;
        if (hipGetDevice(&dev) != hipSuccess || hipDeviceGetAttribute(&cus, hipDeviceAttributeMultiprocessorCount, dev) != hipSuccess) { grid = -1; return; }
        if (hipFuncSetAttribute((const void*)fwd_kernel, hipFuncAttributeMaxDynamicSharedMemorySize, LDS_BYTES) != hipSuccess) { fprintf(stderr, "kernel_launch: hipFuncSetAttribute failed\n"); grid = -1; return; }
        int per_cu = 0;
        if (hipOccupancyMaxActiveBlocksPerMultiprocessor(&per_cu, (const void*)fwd_kernel, 512, LDS_BYTES) != hipSuccess || per_cu < 1) { fprintf(stderr, "kernel_launch: occupancy query says %d\n", per_cu); }
        (void)hipGetLastError();
        grid = cus;
    }
    if (grid < 0) return;
    (void)hipMemsetAsync((char*)d_ws + WS_CTL, 0, CTL_ZERO_BYTES, stream);
    Args a{};
    for (int i = 0; i < 36; ++i) a.in[i] = (const float*)d_in[i];
    a.out = (float*)d_out; a.ws = (unsigned char*)d_ws;
#if MK_PER_PHASE_LAUNCH
    for (int ph = 0; ph < NPHASE; ++ph) { if (ph == PH_PER_LAYER) continue; a.ph_lo = ph; a.ph_hi = ph + 1; hipLaunchKernelGGL(fwd_kernel, dim3(grid), dim3(512), LDS_BYTES, stream, a); }
#else
    a.ph_lo = 0; a.ph_hi = NPHASE;
    hipLaunchKernelGGL(fwd_kernel, dim3(grid), dim3(512), LDS_BYTES, stream, a);
#endif
}
```

```cpp
#include <hip/hip_runtime.h>
#include <cstdio>
#include <cstdint>
#define LAS __attribute__((address_space(3)))
#define GAS __attribute__((address_space(1)))
#define DI __device__ __forceinline__
typedef unsigned short bf16_t;
typedef short bf16x8 __attribute__((ext_vector_type(8)));
typedef short s16x4 __attribute__((ext_vector_type(4)));
typedef float f32x4 __attribute__((ext_vector_type(4)));
typedef float f32x2 __attribute__((ext_vector_type(2)));
typedef float f32x16 __attribute__((ext_vector_type(16)));
typedef unsigned u32x4 __attribute__((ext_vector_type(4)));
typedef unsigned u32x2 __attribute__((ext_vector_type(2)));
typedef __bf16 bf16v2 __attribute__((ext_vector_type(2)));

DI unsigned pk2(float lo, float hi) { f32x2 v = {lo, hi}; return __builtin_bit_cast(unsigned, __builtin_convertvector(v, bf16v2)); }
DI bf16_t f2bf(float f) { return (bf16_t)(pk2(f, 0.f) & 0xffffu); }
DI float bf2f(bf16_t b) { return __uint_as_float(((unsigned)b) << 16); }
DI float bflo(unsigned w) { return __uint_as_float(w << 16); }
DI float bfhi(unsigned w) { return __uint_as_float(w & 0xffff0000u); }
DI float rcpf_(float x) { return __builtin_amdgcn_rcpf(x); }
DI float sigmoidf_(float x) { return __builtin_amdgcn_rcpf(1.0f + __expf(-x)); }

template <int CTRL> DI float dpp_mov(float v) { return __builtin_bit_cast(float, __builtin_amdgcn_update_dpp(0, __builtin_bit_cast(int, v), CTRL, 0xf, 0xf, true)); }
DI float rdlane(float v, int l) { return __builtin_bit_cast(float, __builtin_amdgcn_readlane(__builtin_bit_cast(int, v), l)); }
DI float wave_sum(float v) {
    v += dpp_mov<0xB1>(v);
    v += dpp_mov<0x4E>(v);
    v += dpp_mov<0x141>(v);
    v += dpp_mov<0x140>(v);
    return (rdlane(v, 0) + rdlane(v, 16)) + (rdlane(v, 32) + rdlane(v, 48));
}
DI f32x4 mfma16(bf16x8 a, bf16x8 b, f32x4 c) { return __builtin_amdgcn_mfma_f32_16x16x32_bf16(a, b, c, 0, 0, 0); }
namespace pg8 {
constexpr int BM = 256, BK = 64, HALF = 128, HTB = HALF * BK * 2  , STAGE_BYTES = 8 * HTB, NXCD = 8, WGM = 8;

__host__ __device__ __forceinline__ int lds_byte(int r, int c) { const int st = (r >> 4) * 2 + (c >> 5), rr = r & 15, cc = c & 31, ob = rr * 64 + cc * 2; return st * 1024 + (ob ^ (((ob >> 9) & 1) << 5)); }
__host__ __device__ __forceinline__ void stage_rc(int b, int& R, int& C) { const int st = b / 1024, sb = b % 1024, swz = sb ^ (((sb >> 9) & 1) << 5); R = (st >> 1) * 16 + swz / 64; C = (st & 1) * 32 + (swz % 64) / 2; }
__host__ __device__ __forceinline__ int perm32(int rho) { const int n = rho >> 4, i = rho & 15; return 8 * (i >> 2) + 4 * n + (i & 3); }

struct Unit { int pm, pn, pb; };
struct Gemm { const bf16_t* A; const bf16_t* Bt; int M, N, K; };

struct StaticOrder {
    static constexpr bool GATHER = false;
    int nM, nN, nwg, G, c;
    __device__ __forceinline__ void init(int M, int N, int G_, int c_) { nM = M / BM; nN = N / BM; nwg = nM * nN; G = G_; c = c_; }
    __device__ __forceinline__ bool next(int i, Unit& u) const {
        const long L = (long)i * G + c; if (L >= nwg) return false;
        int wgid = (int)L; { const int q = nwg / NXCD, r = nwg % NXCD, xcd = wgid % NXCD, off = wgid / NXCD; wgid = (xcd < r ? xcd * (q + 1) : r * (q + 1) + (xcd - r) * q) + off; }
        const int nig = WGM * nN, gid = wgid / nig, fm = gid * WGM, gsz = (nM - fm) < WGM ? (nM - fm) : WGM;
        u.pm = fm + ((wgid % nig) % gsz); u.pn = (wgid % nig) / gsz; u.pb = u.pn; return true;
    }
};
struct GroupOrder : StaticOrder {
    const int* pexp;
    __device__ __forceinline__ bool next(int i, Unit& u) const {
        if (!StaticOrder::next(i, u)) return false;
        u.pb = __builtin_amdgcn_readfirstlane(pexp[u.pm]) * nN + u.pn; return true;
    }
};
struct GatherOrder : GroupOrder {
    static constexpr bool GATHER = true;
    const LAS int* tokL;
};

template <class Epi, class Sched, bool ALIGN_EPI = true, bool SP2 = true>
__device__ __forceinline__ void gemm_phase(LAS unsigned char* lds, const Gemm g, const Sched& S, const Epi& E, int tid_in) {
    const int tid = tid_in, wid = __builtin_amdgcn_readfirstlane(tid >> 6), lane = tid & 63, wr = wid >> 2, wc = wid & 3, fr = lane & 15, fq = lane >> 4;
    const int K = g.K, nt = K / BK;
    unsigned voffA[2], voffB[2];
#pragma unroll
    for (int i = 0; i < 2; ++i) { int R, C; stage_rc(tid * 16 + i * 8192, R, C); const int Rb = Epi::HEADS ? (64 * (R >> 5) + perm32(R & 31)) : Epi::PERM ? ((R & ~31) + perm32(R & 31)) : R;
        voffA[i] = (unsigned)(R * K + C) * 2u; voffB[i] = (unsigned)(Rb * K + C) * 2u; }
    unsigned goff[2][2] = {{0u, 0u}, {0u, 0u}}, goffN[2][2] = {{0u, 0u}, {0u, 0u}};
#define PG8_GOFF(dst, ui_) do { if constexpr (Sched::GATHER) { _Pragma("unroll") for (int h_ = 0; h_ < 2; ++h_) _Pragma("unroll") for (int i_ = 0; i_ < 2; ++i_) { int R_, C_; stage_rc(tid * 16 + i_ * 8192, R_, C_); \
        const int tk_ = S.tokL[(ui_) * 256 + 128 * h_ + R_]; dst[h_][i_] = (unsigned)(tk_ * K + C_) * 2u; } } } while (0)
#define PG8_STAGE_A(bufoff, kt, h, usenext) do { if constexpr (Sched::GATHER) { unsigned vo_[2] = { (usenext) ? goffN[h][0] : goff[h][0], (usenext) ? goffN[h][1] : goff[h][1] }; PG8_STAGE(bufoff, kt, vo_); } \
        else { PG8_STAGE(bufoff, (kt) + ((h) ? hstep : 0), voffA); } } while (0)
    const size_t kstep = (size_t)(BK * 2);
    const size_t hstep = (size_t)HALF * K * 2;
    const size_t hstepB = Epi::HEADS ? (size_t)32 * K * 2 : hstep;
    const size_t tstep = 2 * hstep;
    const unsigned ldsw = (unsigned)wid * 1024u;
    const int aoff = lds_byte(wr * 64 + fr, fq * 8), boff = lds_byte(wc * 32 + fr, fq * 8);
#define PG8_SA(b, h) (((b) * 2 + (h)) * HTB)
#define PG8_SB(b, h) ((4 + (b) * 2 + (h)) * HTB)
#define PG8_STAGE(bufoff, gbase, voff) do { _Pragma("unroll") for (int _i = 0; _i < 2; ++_i) \
        __builtin_amdgcn_global_load_lds((const unsigned*)((const char*)(gbase) + (voff)[_i]), (LAS unsigned*)(lds + (bufoff) + ldsw + _i * 8192), 16, 0, 0); } while (0)
#define PG8_LDA(dst, b, h) do { _Pragma("unroll") for (int m = 0; m < 4; ++m) _Pragma("unroll") for (int k = 0; k < 2; ++k) dst[m][k] = *(const LAS bf16x8*)(lds + PG8_SA(b, h) + aoff + m * 2048 + k * 1024); } while (0)
#define PG8_LDB(dst, b, h) do { _Pragma("unroll") for (int n = 0; n < 2; ++n) _Pragma("unroll") for (int k = 0; k < 2; ++k) dst[n][k] = *(const LAS bf16x8*)(lds + PG8_SB(b, h) + boff + n * 2048 + k * 1024); } while (0)
#define PG8_MMA(ai, bj, At, Bt) do { __builtin_amdgcn_s_setprio(1); _Pragma("unroll") for (int m = 0; m < 4; ++m) _Pragma("unroll") for (int n = 0; n < 2; ++n) _Pragma("unroll") for (int k = 0; k < 2; ++k) \
        acc[ai][bj][m][n] = __builtin_amdgcn_mfma_f32_16x16x32_bf16(Bt[n][k], At[m][k], acc[ai][bj][m][n], 0, 0, 0); __builtin_amdgcn_s_setprio(0); } while (0)
#define PG8_WAIT_V(n) asm volatile("s_waitcnt vmcnt(" #n ")" ::: "memory")
#define PG8_WAIT_L(n) asm volatile("s_waitcnt lgkmcnt(" #n ")" ::: "memory")
#define PG8_BAR __builtin_amdgcn_s_barrier()
#define PG8_SCHED __builtin_amdgcn_sched_barrier(0)
    Unit cur, nxt; int ui = 0;
    if (!S.next(0, cur)) return;
    f32x4 acc[2][2][4][2];
#pragma unroll
    for (int a = 0; a < 2; ++a)
#pragma unroll
        for (int b = 0; b < 2; ++b)
#pragma unroll
            for (int m = 0; m < 4; ++m)
#pragma unroll
                for (int n = 0; n < 2; ++n) acc[a][b][m][n] = (f32x4){0.f, 0.f, 0.f, 0.f};
    bf16x8 At[4][2], B0[2][2], B1[2][2];
    const char* cA = (const char*)g.A + (Sched::GATHER ? (size_t)0 : (size_t)cur.pm * tstep); const char* cB = (const char*)g.Bt + (size_t)cur.pb * tstep;
    PG8_GOFF(goff, 0);
    if constexpr (SP2) {
        PG8_STAGE(PG8_SB(0, 0), cB, voffB); PG8_STAGE(PG8_SB(0, 1), cB + hstepB, voffB); PG8_STAGE_A(PG8_SA(0, 0), cA, 0, false); PG8_STAGE_A(PG8_SA(0, 1), cA, 1, false);
        if (wr == 1) PG8_BAR;
        PG8_WAIT_V(2); PG8_BAR;
        PG8_STAGE(PG8_SB(1, 0), cB + kstep, voffB); PG8_STAGE_A(PG8_SA(1, 0), cA + kstep, 0, false); PG8_STAGE(PG8_SB(1, 1), cB + hstepB + kstep, voffB);
        PG8_WAIT_V(6); PG8_BAR;
    } else {
        PG8_STAGE(PG8_SB(0, 0), cB, voffB); PG8_STAGE_A(PG8_SA(0, 0), cA, 0, false); PG8_STAGE(PG8_SB(0, 1), cB + hstepB, voffB); PG8_STAGE_A(PG8_SA(0, 1), cA, 1, false);
        if (wr == 1) PG8_BAR;
        PG8_WAIT_V(4); PG8_BAR;
        PG8_STAGE(PG8_SB(1, 0), cB + kstep, voffB); PG8_STAGE_A(PG8_SA(1, 0), cA + kstep, 0, false); PG8_STAGE(PG8_SB(1, 1), cB + hstepB + kstep, voffB);
        PG8_WAIT_V(6); PG8_BAR;
    }
    for (;;) {
        const bool has_next = S.next(ui + 1, nxt);
        const char* nA = (has_next && !Sched::GATHER) ? (const char*)g.A + (size_t)nxt.pm * tstep : cA; const char* nB = has_next ? (const char*)g.Bt + (size_t)nxt.pb * tstep : cB;
        if constexpr (Sched::GATHER) { if (has_next) PG8_GOFF(goffN, ui + 1); else { goffN[0][0] = goff[0][0]; goffN[0][1] = goff[0][1]; goffN[1][0] = goff[1][0]; goffN[1][1] = goff[1][1]; } }
        for (int t = 0; t < nt; t += 2) {
            if constexpr (Epi::HAS_MID) { if (t == nt / 2) E.mid(acc, cur, wr, wc, fr, fq); }
            const bool last = (t == nt - 2);
            const char* a1 = cA + (size_t)(t + 1) * kstep;
            const char* a2 = last ? nA : cA + (size_t)(t + 2) * kstep; const char* b2 = last ? nB : cB + (size_t)(t + 2) * kstep;
            const char* a3 = a2 + kstep; const char* b3 = b2 + kstep;
            if constexpr (SP2) {
            PG8_LDB(B0, 0, 0); PG8_LDB(B1, 0, 1); PG8_SCHED; PG8_LDA(At, 0, 0); PG8_STAGE_A(PG8_SA(1, 1), a1, 1, false);
            PG8_WAIT_V(8); PG8_WAIT_L(0); PG8_BAR; PG8_MMA(0, 0, At, B0); PG8_MMA(0, 1, At, B1); PG8_BAR; PG8_SCHED;
            PG8_LDA(At, 0, 1); PG8_STAGE(PG8_SB(0, 0), b2, voffB); PG8_STAGE(PG8_SB(0, 1), b2 + hstepB, voffB); PG8_STAGE_A(PG8_SA(0, 0), a2, 0, last);
            PG8_WAIT_V(8); PG8_WAIT_L(0); PG8_BAR; PG8_MMA(1, 0, At, B0); PG8_MMA(1, 1, At, B1); PG8_BAR; PG8_SCHED;
            PG8_LDB(B0, 1, 0); PG8_LDB(B1, 1, 1); PG8_SCHED; PG8_LDA(At, 1, 0); PG8_STAGE_A(PG8_SA(0, 1), a2, 1, last);
            PG8_WAIT_V(8); PG8_WAIT_L(0); PG8_BAR; PG8_MMA(0, 0, At, B0); PG8_MMA(0, 1, At, B1); PG8_BAR; PG8_SCHED;
            PG8_LDA(At, 1, 1); PG8_STAGE(PG8_SB(1, 0), b3, voffB); PG8_STAGE(PG8_SB(1, 1), b3 + hstepB, voffB); PG8_STAGE_A(PG8_SA(1, 0), a3, 0, last);
            PG8_WAIT_V(8); PG8_WAIT_L(0); PG8_BAR; PG8_MMA(1, 0, At, B0); PG8_MMA(1, 1, At, B1); PG8_BAR; PG8_SCHED;
            } else {
            PG8_LDB(B0, 0, 0); PG8_SCHED; PG8_LDA(At, 0, 0); PG8_STAGE_A(PG8_SA(1, 1), a1, 1, false);
            PG8_WAIT_L(8); PG8_BAR; PG8_WAIT_L(0); PG8_MMA(0, 0, At, B0); PG8_BAR; PG8_SCHED;
            PG8_LDB(B1, 0, 1); PG8_STAGE(PG8_SB(0, 0), b2, voffB);
            PG8_BAR; PG8_WAIT_L(0); PG8_MMA(0, 1, At, B1); PG8_BAR;
            PG8_LDA(At, 0, 1); PG8_STAGE_A(PG8_SA(0, 0), a2, 0, last);
            PG8_BAR; PG8_WAIT_L(0); PG8_MMA(1, 0, At, B0); PG8_BAR; PG8_SCHED;
            PG8_STAGE(PG8_SB(0, 1), b2 + hstepB, voffB);
            PG8_WAIT_V(6); PG8_BAR; PG8_MMA(1, 1, At, B1); PG8_BAR;
            PG8_LDB(B0, 1, 0); PG8_SCHED; PG8_LDA(At, 1, 0); PG8_STAGE_A(PG8_SA(0, 1), a2, 1, last);
            PG8_WAIT_L(8); PG8_BAR; PG8_WAIT_L(0); PG8_MMA(0, 0, At, B0); PG8_BAR; PG8_SCHED;
            PG8_LDB(B1, 1, 1); PG8_STAGE(PG8_SB(1, 0), b3, voffB);
            PG8_BAR; PG8_WAIT_L(0); PG8_MMA(0, 1, At, B1); PG8_BAR;
            PG8_LDA(At, 1, 1); PG8_STAGE_A(PG8_SA(1, 0), a3, 0, last);
            PG8_BAR; PG8_WAIT_L(0); PG8_MMA(1, 0, At, B0); PG8_BAR; PG8_SCHED;
            PG8_STAGE(PG8_SB(1, 1), b3 + hstepB, voffB);
            PG8_WAIT_V(6); PG8_BAR; PG8_MMA(1, 1, At, B1); PG8_BAR;
            }
        }
        if constexpr (ALIGN_EPI) { if (wr == 0) PG8_BAR; }
        E(acc, cur, wr, wc, fr, fq);
        if (!has_next) break;
#pragma unroll
        for (int a = 0; a < 2; ++a)
#pragma unroll
            for (int b = 0; b < 2; ++b)
#pragma unroll
                for (int m = 0; m < 4; ++m)
#pragma unroll
                    for (int n = 0; n < 2; ++n) acc[a][b][m][n] = (f32x4){0.f, 0.f, 0.f, 0.f};
        cur = nxt; cA = nA; cB = nB; ++ui;
        if constexpr (Sched::GATHER) { goff[0][0] = goffN[0][0]; goff[0][1] = goffN[0][1]; goff[1][0] = goffN[1][0]; goff[1][1] = goffN[1][1]; }
        if constexpr (ALIGN_EPI) { if (wr == 1) PG8_BAR; }
    }
    PG8_WAIT_V(0);
    if constexpr (!ALIGN_EPI) { if (wr == 0) PG8_BAR; }
    PG8_BAR;
#undef PG8_SA
#undef PG8_GOFF
#undef PG8_STAGE_A
#undef PG8_SB
#undef PG8_STAGE
#undef PG8_LDA
#undef PG8_LDB
#undef PG8_MMA
#undef PG8_WAIT_V
#undef PG8_WAIT_L
#undef PG8_BAR
#undef PG8_SCHED
}
}
#define XB_TMO      128
#define XB_XCNT(j)  (256  + 64 * (j))
#define XB_XSUB(j)  (1280 + 64 * (j))
#define XB_XGEN(j)  (2304 + 64 * (j))
#define XB_TOP      3328
#define XB_TOPGEN   3392
#define XCD_BAR_WORDS 3456
#define XB_SPIN_CAP (1u << 18)

__device__ __forceinline__ unsigned xb_ld(unsigned* p)              { return __hip_atomic_load(p, __ATOMIC_RELAXED, __HIP_MEMORY_SCOPE_AGENT); }
__device__ __forceinline__ unsigned xb_add(unsigned* p, unsigned v) { return __hip_atomic_fetch_add(p, v, __ATOMIC_RELAXED, __HIP_MEMORY_SCOPE_AGENT); }
__device__ __forceinline__ unsigned xb_xcc_id() { return (unsigned)__builtin_amdgcn_s_getreg((3 << 11) | 20) & 0xFu; }
#define XB_SPIN(cond, bar) do { unsigned _sp = 0; while (cond) { __builtin_amdgcn_s_sleep(1); \
    if ((++_sp & 255u) == 0u) { if (xb_ld(&(bar)[XB_TMO])) break; if (_sp > XB_SPIN_CAP) { atomicAdd(&(bar)[XB_TMO], 1u); break; } } } } while (0)

struct XcdBarrier {
    unsigned* bar; unsigned x;
    volatile LAS unsigned* st;
};

__device__ __forceinline__ XcdBarrier xcd_barrier_post(unsigned* bar, volatile LAS unsigned* st) {
    XcdBarrier b; b.bar = bar; b.x = xb_xcc_id(); b.st = st;
    if (threadIdx.x == 0) (void)xb_add(&bar[XB_XCNT(b.x)], 1u);
    return b;
}
__device__ __forceinline__ void xcd_barrier_complete(unsigned* bar, unsigned x, unsigned& nloc, unsigned& nx) {
    const unsigned G = gridDim.x * gridDim.y * gridDim.z;
    unsigned sum, cnt, mine, sp = 0u;
    for (;;) {
        sum = 0u; cnt = 0u; mine = 0u;
#pragma unroll
        for (unsigned j = 0; j < 16; ++j) { const unsigned c = xb_ld(&bar[XB_XCNT(j)]); sum += c; cnt += (c > 0u) ? 1u : 0u; mine = (j == x) ? c : mine; }
        if (sum == G) break;
        __builtin_amdgcn_s_sleep(1);
        if ((++sp & 255u) == 0u) { if (xb_ld(&bar[XB_TMO])) break; if (sp > XB_SPIN_CAP) { atomicAdd(&bar[XB_TMO], 1u); break; } }
    }
    nloc = mine > 0u ? mine : 1u; nx = cnt > 0u ? cnt : 1u;
}

__device__ __forceinline__ void xcd_barrier(const XcdBarrier& b) {
    asm volatile("s_waitcnt vmcnt(0)" ::: "memory");
    __syncthreads();
    if (threadIdx.x == 0) {
        unsigned* bar = b.bar;
        __builtin_amdgcn_s_waitcnt(0);
        unsigned nloc = b.st[0], nx = b.st[1];
        if (nloc == 0u) { xcd_barrier_complete(bar, b.x, nloc, nx); b.st[0] = nloc; b.st[1] = nx; }
        const unsigned old = xb_add(&bar[XB_XSUB(b.x)], 1u);
        const unsigned gen = old / nloc;
        if (old + 1u == (gen + 1u) * nloc) {
            __builtin_amdgcn_fence(__ATOMIC_RELEASE, "agent");
            asm volatile("s_waitcnt vmcnt(0)" ::: "memory");
            const unsigned og = xb_add(&bar[XB_TOP], 1u);
            const unsigned tg = og / nx;
            if (og + 1u == (tg + 1u) * nx) xb_add(&bar[XB_TOPGEN], 1u);
            else XB_SPIN(xb_ld(&bar[XB_TOPGEN]) == tg, bar);
            __builtin_amdgcn_fence(__ATOMIC_ACQUIRE, "agent");
            xb_add(&bar[XB_XGEN(b.x)], 1u);
            asm volatile("s_waitcnt vmcnt(0)" ::: "memory");
        } else {
            XB_SPIN(xb_ld(&bar[XB_XGEN(b.x)]) == gen, bar);
            __builtin_amdgcn_fence(__ATOMIC_ACQUIRE, "agent");
            asm volatile("s_waitcnt vmcnt(0)" ::: "memory");
        }
    }
    __syncthreads();
}
constexpr int NB = 4, SEQ = 8192, DM = 1024, T = NB * SEQ;
constexpr int NH = 8, HD = 64, CW = 512;
constexpr int N_IN = 5120;
constexpr int NLAYER = 2;
constexpr int NEXP = 32, DEXP = 512;
constexpr int MOE_ROWS = 73728, MOE_PANELS = MOE_ROWS / 256;
constexpr int WCAT_ROWS = 5888;
constexpr int LO_W = 768;

constexpr size_t MiB = 1u << 20;
constexpr size_t WS_CTL = 0, CTL_ZERO_BYTES = 1 * MiB;
constexpr size_t WS_VF   = 1 * MiB;
constexpr size_t WS_TAB  = 33 * MiB;
constexpr size_t WS_WM   = 34 * MiB;
constexpr size_t WS_XN   = 50 * MiB;
constexpr size_t WS_RW   = 114 * MiB;
constexpr size_t WS_MO   = 178 * MiB;
constexpr size_t WS_LO   = 210 * MiB;
constexpr size_t WS_YRM  = 114 * MiB;
constexpr int YRM_LD = 1024;
constexpr size_t WS_SIR  = 258 * MiB;
constexpr size_t WS_SIK  = 322 * MiB;
constexpr size_t WS_SCRW = 290 * MiB, WS_SCRA = 306 * MiB, WS_SCRB = 546 * MiB;
constexpr size_t WS_V1   = 418 * MiB;
constexpr size_t WS_G    = 450 * MiB;
constexpr size_t WS_YS   = 482 * MiB;
constexpr size_t WS_PO   = 418 * MiB;
constexpr size_t WS_PST  = 274 * MiB;
constexpr size_t WS_GA   = 418 * MiB;
constexpr size_t WS_H    = 50 * MiB;
constexpr size_t WS_SC1  = 482 * MiB;
constexpr size_t WS_SC2  = 354 * MiB;
constexpr size_t WS_SCT  = 290 * MiB;
constexpr size_t WS_WE   = 290 * MiB;
constexpr size_t WS_WD   = 354 * MiB;
constexpr size_t WS_AM   = 130 * MiB;
constexpr size_t WS_HM   = 194 * MiB;
constexpr size_t WS_YE   = 386 * MiB;
constexpr size_t WS_RT   = 546 * MiB;
constexpr size_t WS_END  = 556 * MiB;
constexpr size_t TB_KMEAN = 0;
constexpr size_t TB_KMEAN2 = 256 * 1024;
constexpr size_t TB_SEL   = 256 * 1024;
constexpr size_t RT_EID  = 0;
constexpr size_t RT_GATE = 256 * 1024;
constexpr size_t RT_ROW  = 512 * 1024;
constexpr size_t RT_GW   = 768 * 1024;
constexpr size_t RT_HIST = 1280 * 1024;
constexpr size_t RT_PEXP = 1408 * 1024;
constexpr size_t RT_TOK  = 1536 * 1024;
constexpr size_t RT_RSQ  = 2048 * 1024;
constexpr size_t RT_RSR  = 2304 * 1024;
constexpr size_t WS_SEL  = 562 * MiB;
constexpr size_t WS_NEED = 564 * MiB;
constexpr int CW_BAR = 4096;

constexpr int RING_BYTES = 131072;
constexpr int LDS_BYTES = 163840;
constexpr int MISC_OFF = LDS_BYTES - 256;
struct Frame {
    LAS unsigned char* lds;
    int tid, lane, wave;
    int G, bid;
    const __attribute__((address_space(4))) unsigned char* ka;
    GAS float* out_g; GAS unsigned char* ws_g;
    DI float* outp() const { return (float*)out_g; }
    DI unsigned char* wsp() const { return (unsigned char*)ws_g; }
    DI const float* inp(int i) const { return (const float*)(*(const GAS float* const __attribute__((address_space(4)))*)(ka + 8 * i)); }
};
#define LDS_WAIT() asm volatile("s_waitcnt lgkmcnt(0)" ::: "memory")

DI void tr_item(const float* src, int ld, int k0, bf16_t* dst, int Kd, const float* sc, int mode, LAS float* scr, int lane) {
#pragma unroll 8
    for (int i = 0; i < 32; ++i) { const int kk = 2 * i + (lane >> 5);
        float v = src ? src[(size_t)(k0 + kk) * ld + (lane & 31)] : 0.f;
        if (mode == 1) v *= sc[k0 + kk]; else if (mode == 2) v *= (1.f - sc[k0 + kk]);
        scr[kk * 33 + (lane & 31)] = v; }
    LDS_WAIT(); asm volatile("" ::: "memory");
    const int c = lane & 7;
#pragma unroll
    for (int j = 0; j < 4; ++j) { const int n = (lane >> 3) + 8 * j; const LAS float* s = scr + (8 * c) * 33 + n;
        u32x4 o; o.x = pk2(s[0 * 33], s[1 * 33]); o.y = pk2(s[2 * 33], s[3 * 33]); o.z = pk2(s[4 * 33], s[5 * 33]); o.w = pk2(s[6 * 33], s[7 * 33]);
        *(u32x4*)(dst + (size_t)n * Kd + k0 + 8 * c) = o; }
    LDS_WAIT(); asm volatile("" ::: "memory");
}

constexpr size_t WM_WCAT = 0, WM_BRR = (size_t)WCAT_ROWS * 1024 * 2, WM_BRM = WM_BRR + 1024 * 512 * 2, WM_OUT = WM_BRM + 1024 * 512 * 2;
DI void phase_conv_mixer(Frame& F, int l) {
    LAS float* scr = (LAS float*)(F.lds + F.wave * 16384);
    const int gw = F.bid * 8 + F.wave, NGW = F.G * 8;
    bf16_t* wcat = (bf16_t*)(F.wsp() + WS_WM + WM_WCAT);
    const float* w_in = F.inp(3) + (size_t)l * DM * N_IN;
    const float* mu_x = F.inp(5) + (size_t)l * 3 * DM;
    constexpr int NBLK = WCAT_ROWS / 32;
    constexpr int I_CAT = NBLK * 16, I_BR = 8 * 32, I_OUT = 16 * 32;
    for (int it = gw; it < I_CAT + 2 * I_BR + I_OUT; it += NGW) {
        int r = it;
        if (r < I_CAT) {
            const int nb = r / 16, kb = r % 16, k0 = kb * 64;
            if (nb < 48) { tr_item(w_in + 32 * nb, N_IN, k0, wcat + (size_t)(32 * nb) * 1024, 1024, nullptr, 0, scr, F.lane); }
            else if (nb < 72) {
                const int q = nb - 48; const float* src = nullptr; int ld = 0; const float* sc = nullptr; int mode = 0;
                if (q < 4)       { src = F.inp(7)  + (size_t)l * DM * 64  + 32 * (q & 1); ld = 64;  sc = mu_x;          mode = (q < 2) ? 2 : 1; }
                else if (q < 8)  { src = F.inp(10) + (size_t)l * DM * 64  + 32 * (q & 1); ld = 64;  sc = mu_x + DM;     mode = (q < 6) ? 2 : 1; }
                else if (q < 16) { src = F.inp(12) + (size_t)l * DM * 128 + 32 * (q & 3); ld = 128; sc = mu_x + 2 * DM; mode = (q < 12) ? 2 : 1; }
                else if (q < 18 && l > 0) { src = F.inp(21) + (size_t)(l - 1) * DM * 32; ld = 32; sc = F.inp(19) + (size_t)(l - 1) * DM; mode = (q == 16) ? 2 : 1; }
                tr_item(src, ld, k0, wcat + (size_t)(1536 + 32 * q) * 1024, 1024, sc, mode, scr, F.lane);
            }
            else if (nb < 120) { tr_item(w_in + 1536 + 32 * (nb - 72), N_IN, k0, wcat + (size_t)(2304 + 32 * (nb - 72)) * 1024, 1024, nullptr, 0, scr, F.lane); }
            else { tr_item(w_in + 3072 + 32 * (nb - 120), N_IN, k0, wcat + (size_t)(3840 + 32 * (nb - 120)) * 1024, 1024, nullptr, 0, scr, F.lane); }
            continue;
        }
        r -= I_CAT;
        if (r < I_BR) { const int nb = r / 8, kb = r % 8; tr_item(F.inp(26) + (size_t)l * 512 * 1024 + 32 * nb, 1024, kb * 64, (bf16_t*)(F.wsp() + WS_WM + WM_BRR) + (size_t)(32 * nb) * 1024, 1024, nullptr, 0, scr, F.lane); continue; }
        r -= I_BR;
        if (r < I_BR) { const int nb = r / 8, kb = r % 8; tr_item(F.inp(27) + (size_t)l * 512 * 1024 + 32 * nb, 1024, kb * 64, (bf16_t*)(F.wsp() + WS_WM + WM_BRR) + (size_t)(32 * nb) * 1024 + 512, 1024, nullptr, 0, scr, F.lane); continue; }
        r -= I_BR;
        { const int nb = r / 16, kb = r % 16; tr_item(F.inp(28) + (size_t)l * 1024 * 1024 + 32 * nb, 1024, kb * 64, (bf16_t*)(F.wsp() + WS_WM + WM_OUT) + (size_t)(32 * nb) * 1024, 1024, nullptr, 0, scr, F.lane); }
    }
}
struct ConvItem { const float* src; int ld, k0, n0, Kd, mode; bf16_t* dst; };
DI ConvItem conv_item(int it, const float* wg, const float* wu, const float* wdn, bf16_t* we, bf16_t* wd) {
    ConvItem c; const int e = it / 96; int r = it % 96;
    if (r < 64) { const int up = r >> 5; r &= 31; c.src = (up ? wu : wg) + (size_t)e * DM * DEXP; c.ld = DEXP; c.k0 = (r >> 1) * 64; c.n0 = (r & 1) * 256; c.dst = we + (size_t)e * 1024 * 1024; c.Kd = 1024; c.mode = up; }
    else { r -= 64; c.src = wdn + (size_t)e * DEXP * DM; c.ld = DM; c.k0 = (r >> 2) * 64; c.n0 = (r & 3) * 256; c.dst = wd + (size_t)e * 1024 * 512; c.Kd = 512; c.mode = 2; }
    return c;
}
DI void conv_load(const ConvItem& c, f32x4 (&v)[8], int tid) {
#pragma unroll
    for (int i = 0; i < 8; ++i) { const int idx = tid + 512 * i, row = idx >> 6, c4 = idx & 63; v[i] = *(const f32x4*)(c.src + (size_t)(c.k0 + row) * c.ld + c.n0 + 4 * c4); }
}
DI void conv_store(const ConvItem& c, const f32x4 (&v)[8], LAS float* scr, int tid) {
#pragma unroll
    for (int i = 0; i < 8; ++i) { const int idx = tid + 512 * i, row = idx >> 6, c4 = idx & 63; LAS float* d = scr + row * 257 + 4 * c4; d[0] = v[i].x; d[1] = v[i].y; d[2] = v[i].z; d[3] = v[i].w; }
    __syncthreads();
#pragma unroll
    for (int i = 0; i < 4; ++i) { const int idx = tid + 512 * i, n = idx >> 3, cc = idx & 7; const LAS float* sp = scr + (8 * cc) * 257 + n;
        u32x4 o; o.x = pk2(sp[0], sp[257]); o.y = pk2(sp[2 * 257], sp[3 * 257]); o.z = pk2(sp[4 * 257], sp[5 * 257]); o.w = pk2(sp[6 * 257], sp[7 * 257]);
        const int h = c.n0 + n; const int drow = (c.mode == 2) ? h : ((h >> 7) * 256 + c.mode * 128 + (h & 127));
        *(u32x4*)(c.dst + (size_t)drow * c.Kd + c.k0 + 8 * cc) = o; }
    __syncthreads();
}
constexpr int CONV_ITEMS = NEXP * 96, CONV_GROUP = 12, CONV_UNITS = CONV_ITEMS / CONV_GROUP;
DI void conv_experts_items(Frame& F, int l, int it_lo, int it_hi, int it_step) {
    LAS float* scr = (LAS float*)F.lds;
    bf16_t* we = (bf16_t*)(F.wsp() + WS_WE); bf16_t* wd = (bf16_t*)(F.wsp() + WS_WD);
    const float* wg = F.inp(33) + (size_t)l * NEXP * DM * DEXP; const float* wu = F.inp(34) + (size_t)l * NEXP * DM * DEXP; const float* wdn = F.inp(35) + (size_t)l * NEXP * DEXP * DM;
    __syncthreads();
    if (it_lo >= it_hi) return;
    f32x4 r0[8], r1[8], r2[8];
    ConvItem c0 = conv_item(it_lo, wg, wu, wdn, we, wd), c1 = c0, c2 = c0;
    conv_load(c0, r0, F.tid);
    const bool h1 = it_lo + it_step < it_hi; if (h1) { c1 = conv_item(it_lo + it_step, wg, wu, wdn, we, wd); conv_load(c1, r1, F.tid); }
    for (int it = it_lo; it < it_hi; it += 3 * it_step) {
        const int i2 = it + 2 * it_step, i3 = it + 3 * it_step, i4 = it + 4 * it_step;
        if (i2 < it_hi) { c2 = conv_item(i2, wg, wu, wdn, we, wd); conv_load(c2, r2, F.tid); }
        conv_store(c0, r0, scr, F.tid);
        if (it + it_step >= it_hi) break;
        if (i3 < it_hi) { c0 = conv_item(i3, wg, wu, wdn, we, wd); conv_load(c0, r0, F.tid); }
        conv_store(c1, r1, scr, F.tid);
        if (i2 >= it_hi) break;
        if (i4 < it_hi) { c1 = conv_item(i4, wg, wu, wdn, we, wd); conv_load(c1, r1, F.tid); }
        conv_store(c2, r2, scr, F.tid);
    }
}
DI void rms_row_to_bf16(const float* xrow, const float* gain, bf16_t* o0, bf16_t* o1, int lane) {
    const f32x4* xr = (const f32x4*)xrow + lane; const f32x4* gr = (const f32x4*)gain + lane;
    f32x4 v[4]; float s = 0.f;
#pragma unroll
    for (int j = 0; j < 4; ++j) { v[j] = xr[64 * j]; s += (v[j].x * v[j].x + v[j].y * v[j].y) + (v[j].z * v[j].z + v[j].w * v[j].w); }
    const float rs = 1.0f / sqrtf(wave_sum(s) * (1.f / DM) + 1e-6f);
#pragma unroll
    for (int j = 0; j < 4; ++j) { const f32x4 g = gr[64 * j]; const f32x4 y = v[j] * rs * g;
        u32x2 w; w.x = pk2(y.x, y.y); w.y = pk2(y.z, y.w);
        *((u32x2*)o0 + lane + 64 * j) = w; if (o1) *((u32x2*)o1 + lane + 64 * j) = w; }
}
DI void phase_norm_x(Frame& F, const float* x, const float* gain) {
    const int gw = F.bid * 8 + F.wave, NGW = F.G * 8; bf16_t* xn = (bf16_t*)(F.wsp() + WS_XN); int lane = F.lane;
    for (int mb = gw * 4; mb < T; mb += NGW * 4) {
        int m0 = mb; asm volatile("" : "+s"(m0), "+v"(lane));
        f32x4 v[4][4];
#pragma unroll
        for (int e = 0; e < 4; ++e) { const f32x4* xr = (const f32x4*)(x + (size_t)(m0 + e) * DM) + lane;
#pragma unroll
            for (int j = 0; j < 4; ++j) v[e][j] = xr[64 * j]; }
#pragma unroll
        for (int e = 0; e < 4; ++e) { float s = 0.f;
#pragma unroll
            for (int j = 0; j < 4; ++j) s += (v[e][j].x * v[e][j].x + v[e][j].y * v[e][j].y) + (v[e][j].z * v[e][j].z + v[e][j].w * v[e][j].w);
            const float rs = __builtin_amdgcn_rsqf(wave_sum(s) * (1.f / DM) + 1e-6f);
#pragma unroll
            for (int j = 0; j < 4; ++j) { const f32x4 g = ((const f32x4*)gain)[lane + 64 * j]; const f32x4 y = v[e][j] * rs * g; u32x2 w; w.x = pk2(y.x, y.y); w.y = pk2(y.z, y.w);
                *((u32x2*)(xn + (size_t)(m0 + e) * DM) + lane + 64 * j) = w; } }
    }
}

namespace pg8 {
struct EpiStore {
    static constexpr bool PERM = true, HAS_MID = false, HEADS = false;
    bf16_t* O; int ldc; int split; bf16_t* O2; int ldc2; int act;
    __device__ __forceinline__ void operator()(const f32x4 (&acc)[2][2][4][2], const Unit& u, int wr, int wc, int fr, int fq) const {
        const int row0 = u.pm * BM + wr * 64 + fr; int colt = u.pn * BM; bf16_t* base = O; int ld = ldc;
        if (split && colt >= split) { base = O2; ld = ldc2; colt -= split; }
        const int col0 = colt + wc * 32 + 8 * fq;
#pragma unroll
        for (int ai = 0; ai < 2; ++ai)
#pragma unroll
            for (int m = 0; m < 4; ++m) { bf16_t* rowp = base + (size_t)(row0 + ai * HALF + m * 16) * ld + col0;
#pragma unroll
                for (int bj = 0; bj < 2; ++bj) { f32x4 v0 = acc[ai][bj][m][0], v1 = acc[ai][bj][m][1];
                    if (act == 1) {
#pragma unroll
                        for (int j = 0; j < 4; ++j) { v0[j] = sigmoidf_(v0[j]); v1[j] = sigmoidf_(v1[j]); } }
                    u32x4 w; w.x = pk2(v0[0], v0[1]); w.y = pk2(v0[2], v0[3]); w.z = pk2(v1[0], v1[1]); w.w = pk2(v1[2], v1[3]);
                    *(u32x4*)(rowp + bj * HALF) = w; } }
    }
};
struct EpiBranch {
    static constexpr bool PERM = true, HAS_MID = false, HEADS = false;
    bf16_t* Hout; const bf16_t* gate; int gcol0; int first;
    __device__ __forceinline__ void operator()(const f32x4 (&acc)[2][2][4][2], const Unit& u, int wr, int wc, int fr, int fq) const {
        const int row0 = u.pm * BM + wr * 64 + fr; const int col0 = u.pn * BM + wc * 32 + 8 * fq;
#pragma unroll
        for (int ai = 0; ai < 2; ++ai)
#pragma unroll
            for (int m = 0; m < 4; ++m) { const size_t row = (size_t)(row0 + ai * HALF + m * 16);
#pragma unroll
                for (int bj = 0; bj < 2; ++bj) {
                    const u32x4 gv = *(const u32x4*)(gate + row * 2048 + gcol0 + col0 + bj * HALF);
                    bf16_t* hp = Hout + row * 1024 + col0 + bj * HALF;
                    f32x4 v0 = acc[ai][bj][m][0], v1 = acc[ai][bj][m][1];
                    v0[0] *= bflo(gv.x); v0[1] *= bfhi(gv.x); v0[2] *= bflo(gv.y); v0[3] *= bfhi(gv.y);
                    v1[0] *= bflo(gv.z); v1[1] *= bfhi(gv.z); v1[2] *= bflo(gv.w); v1[3] *= bfhi(gv.w);
                    if (!first) { const u32x4 hv = *(const u32x4*)hp;
                        v0[0] += bflo(hv.x); v0[1] += bfhi(hv.x); v0[2] += bflo(hv.y); v0[3] += bfhi(hv.y);
                        v1[0] += bflo(hv.z); v1[1] += bfhi(hv.z); v1[2] += bflo(hv.w); v1[3] += bfhi(hv.w); }
                    u32x4 w; w.x = pk2(v0[0], v0[1]); w.y = pk2(v0[2], v0[3]); w.z = pk2(v1[0], v1[1]); w.w = pk2(v1[2], v1[3]);
                    *(u32x4*)hp = w; } }
    }
};
struct EpiBranch2 {
    static constexpr bool PERM = true, HAS_MID = true, HEADS = false;
    bf16_t* Hout; const bf16_t* gate;
    __device__ __forceinline__ void mid(f32x4 (&acc)[2][2][4][2], const Unit& u, int wr, int wc, int fr_, int fq_) const {
        int fr = fr_, fq = fq_; asm volatile("" : "+v"(fr), "+v"(fq));
        const int row0 = u.pm * BM + wr * 64 + fr; const int col0 = u.pn * BM + wc * 32 + 8 * fq;
#pragma unroll
        for (int ai = 0; ai < 2; ++ai)
#pragma unroll
            for (int m = 0; m < 4; ++m) { const size_t row = (size_t)(row0 + ai * HALF + m * 16);
#pragma unroll
                for (int bj = 0; bj < 2; ++bj) {
                    const u32x4 gr = *(const u32x4*)(gate + row * 2048 + col0 + bj * HALF), gm = *(const u32x4*)(gate + row * 2048 + 1024 + col0 + bj * HALF);
                    const unsigned grw[4] = {gr.x, gr.y, gr.z, gr.w}, gmw[4] = {gm.x, gm.y, gm.z, gm.w};
#pragma unroll
                    for (int q = 0; q < 4; ++q) { const float r0 = bflo(grw[q]) * __builtin_amdgcn_rcpf(fmaxf(bflo(gmw[q]), 1e-30f)), r1 = bfhi(grw[q]) * __builtin_amdgcn_rcpf(fmaxf(bfhi(gmw[q]), 1e-30f));
                        acc[ai][bj][m][q >> 1][2 * (q & 1)] *= r0; acc[ai][bj][m][q >> 1][2 * (q & 1) + 1] *= r1; } }
                if (m == 3) asm volatile("" ::: "memory"); }
    }
    __device__ __forceinline__ void operator()(const f32x4 (&acc)[2][2][4][2], const Unit& u, int wr, int wc, int fr, int fq) const {
        const int row0 = u.pm * BM + wr * 64 + fr; const int col0 = u.pn * BM + wc * 32 + 8 * fq;
#pragma unroll
        for (int ai = 0; ai < 2; ++ai)
#pragma unroll
            for (int m = 0; m < 4; ++m) { const size_t row = (size_t)(row0 + ai * HALF + m * 16);
#pragma unroll
                for (int bj = 0; bj < 2; ++bj) {
                    const u32x4 gm = *(const u32x4*)(gate + row * 2048 + 1024 + col0 + bj * HALF);
                    f32x4 v0 = acc[ai][bj][m][0], v1 = acc[ai][bj][m][1];
                    v0[0] *= fmaxf(bflo(gm.x), 1e-30f); v0[1] *= fmaxf(bfhi(gm.x), 1e-30f); v0[2] *= fmaxf(bflo(gm.y), 1e-30f); v0[3] *= fmaxf(bfhi(gm.y), 1e-30f);
                    v1[0] *= fmaxf(bflo(gm.z), 1e-30f); v1[1] *= fmaxf(bfhi(gm.z), 1e-30f); v1[2] *= fmaxf(bflo(gm.w), 1e-30f); v1[3] *= fmaxf(bfhi(gm.w), 1e-30f);
                    u32x4 w; w.x = pk2(v0[0], v0[1]); w.y = pk2(v0[2], v0[3]); w.z = pk2(v1[0], v1[1]); w.w = pk2(v1[2], v1[3]);
                    *(u32x4*)(Hout + row * 1024 + col0 + bj * HALF) = w; } }
    }
};
struct EpiMoba {
    static constexpr bool PERM = true, HAS_MID = false, HEADS = true;
    bf16_t* MO; const float* qgain; const float* kgain; float* KM; int km_half;
    __device__ __forceinline__ void operator()(const f32x4 (&acc)[2][2][4][2], const Unit& u, int wr, int wc, int fr, int fq) const {
        const int row0 = u.pm * BM + wr * 64 + fr; const int kind = u.pn >> 1; const int colb = u.pn * BM + 64 * wc + 8 * fq;
        if (kind == 2) {
#pragma unroll
            for (int ai = 0; ai < 2; ++ai)
#pragma unroll
                for (int m = 0; m < 4; ++m) { bf16_t* rowp = MO + (size_t)(row0 + ai * HALF + m * 16) * 1536 + colb;
#pragma unroll
                    for (int bj = 0; bj < 2; ++bj) { const f32x4 v0 = acc[ai][bj][m][0], v1 = acc[ai][bj][m][1];
                        u32x4 w; w.x = pk2(v0[0], v0[1]); w.y = pk2(v0[2], v0[3]); w.z = pk2(v1[0], v1[1]); w.w = pk2(v1[2], v1[3]); *(u32x4*)(rowp + 32 * bj) = w; } }
            return;
        }
        const float* gp = (kind == 0 ? qgain : kgain) + 8 * fq; const float gs = (kind == 0) ? 0.125f : 1.0f;
        f32x4 gn[2][2];
#pragma unroll
        for (int bj = 0; bj < 2; ++bj)
#pragma unroll
            for (int n = 0; n < 2; ++n) gn[bj][n] = *(const f32x4*)(gp + 32 * bj + 4 * n) * gs;
        f32x4 cs[2][2];
#pragma unroll
        for (int bj = 0; bj < 2; ++bj)
#pragma unroll
            for (int n = 0; n < 2; ++n) cs[bj][n] = (f32x4){0.f, 0.f, 0.f, 0.f};
        float rsv[2][4];
#pragma unroll
        for (int ai = 0; ai < 2; ++ai)
#pragma unroll
            for (int m = 0; m < 4; ++m) { float ss = 0.f;
#pragma unroll
                for (int bj = 0; bj < 2; ++bj)
#pragma unroll
                    for (int n = 0; n < 2; ++n) { const f32x4 x = acc[ai][bj][m][n]; ss += (x[0] * x[0] + x[1] * x[1]) + (x[2] * x[2] + x[3] * x[3]); }
                rsv[ai][m] = ss; }
#pragma unroll
        for (int ai = 0; ai < 2; ++ai)
#pragma unroll
            for (int m = 0; m < 4; ++m) rsv[ai][m] += __shfl_xor(rsv[ai][m], 16);
#pragma unroll
        for (int ai = 0; ai < 2; ++ai)
#pragma unroll
            for (int m = 0; m < 4; ++m) { rsv[ai][m] += __shfl_xor(rsv[ai][m], 32); rsv[ai][m] = __builtin_amdgcn_rsqf(rsv[ai][m] * (1.f / 64.f) + 1e-6f); }
#pragma unroll
        for (int ai = 0; ai < 2; ++ai)
#pragma unroll
            for (int m = 0; m < 4; ++m) { const float rs = rsv[ai][m];
                bf16_t* rowp = MO + (size_t)(row0 + ai * HALF + m * 16) * 1536 + colb;
#pragma unroll
                for (int bj = 0; bj < 2; ++bj) { const f32x4 v0 = acc[ai][bj][m][0] * rs * gn[bj][0], v1 = acc[ai][bj][m][1] * rs * gn[bj][1];
                    cs[bj][0] += v0; cs[bj][1] += v1;
                    u32x4 w; w.x = pk2(v0[0], v0[1]); w.y = pk2(v0[2], v0[3]); w.z = pk2(v1[0], v1[1]); w.w = pk2(v1[2], v1[3]); *(u32x4*)(rowp + 32 * bj) = w; }
                asm volatile("" : "+v"(cs[0][0]), "+v"(cs[0][1]), "+v"(cs[1][0]), "+v"(cs[1][1]));
            }
        if (kind == 1) {
#pragma unroll
            for (int bj = 0; bj < 2; ++bj)
#pragma unroll
                for (int n = 0; n < 2; ++n) { f32x4 t = cs[bj][n];
#pragma unroll
                    for (int j = 0; j < 4; ++j) { float v = t[j]; v += dpp_mov<0xB1>(v); v += dpp_mov<0x4E>(v); v += dpp_mov<0x141>(v); v += dpp_mov<0x140>(v); t[j] = v * (1.f / 256.f); }
                    if (fr == 0) *(f32x4*)(KM + (size_t)wr * km_half + (size_t)u.pm * 512 + (u.pn * BM - 512) + 64 * wc + 32 * bj + 8 * fq + 4 * n) = t; }
        }
    }
};
struct EpiResid {
    static constexpr bool PERM = false, HAS_MID = false, HEADS = false;
    const float* xin; float* out;
    __device__ __forceinline__ void operator()(const f32x4 (&acc)[2][2][4][2], const Unit& u, int wr, int wc, int fr, int fq) const {
        const int row0 = u.pm * BM + wr * 64 + fr, col0 = u.pn * BM + wc * 32 + 4 * fq;
#pragma unroll
        for (int ai = 0; ai < 2; ++ai)
#pragma unroll
            for (int m = 0; m < 4; ++m) { const size_t off = (size_t)(row0 + ai * HALF + m * 16) * 1024 + col0;
#pragma unroll
                for (int bj = 0; bj < 2; ++bj)
#pragma unroll
                    for (int n = 0; n < 2; ++n) { const f32x4 xv = *(const f32x4*)(xin + off + bj * HALF + n * 16); *(f32x4*)(out + off + bj * HALF + n * 16) = xv + acc[ai][bj][m][n]; } }
    }
};
struct EpiExpertUp {
    static constexpr bool PERM = true, HAS_MID = false, HEADS = false;
    bf16_t* HM; const float* gw; const float* rsr;
    __device__ __forceinline__ void operator()(const f32x4 (&acc)[2][2][4][2], const Unit& u, int wr, int wc, int fr, int fq) const {
        const int row0 = u.pm * BM + wr * 64 + fr; const int col0 = u.pn * 128 + wc * 32 + 8 * fq;
#pragma unroll
        for (int ai = 0; ai < 2; ++ai)
#pragma unroll
            for (int m = 0; m < 4; ++m) { const size_t row = (size_t)(row0 + ai * HALF + m * 16); const float rs = rsr[row]; const float gwt = gw[row] * rs;
                f32x4 v0, v1;
#pragma unroll
                for (int j = 0; j < 4; ++j) { const float g0 = acc[ai][0][m][0][j] * rs, g1 = acc[ai][0][m][1][j] * rs;
                    v0[j] = g0 * sigmoidf_(g0) * acc[ai][1][m][0][j] * gwt; v1[j] = g1 * sigmoidf_(g1) * acc[ai][1][m][1][j] * gwt; }
                u32x4 w; w.x = pk2(v0[0], v0[1]); w.y = pk2(v0[2], v0[3]); w.z = pk2(v1[0], v1[1]); w.w = pk2(v1[2], v1[3]);
                *(u32x4*)(HM + row * 512 + col0) = w; }
    }
};
}
constexpr size_t SI_PLANE = (size_t)T * CW * 2;
DI float softplusf_(float z) { return fmaxf(z, 0.f) + __logf(1.0f + __expf(-fabsf(z))); }

#ifndef PREP_DUP
#define PREP_DUP 0
#endif
constexpr int ACT_P = 592;
constexpr size_t WM_L2T = (size_t)WCAT_ROWS * 1024 * 2 + 2 * 1024 * 512 * 2 + 1024 * 1024 * 2;
DI void phase_conv_lora2(Frame& F, int l) {
    bf16_t* L2T = (bf16_t*)(F.wsp() + WS_WM + WM_L2T);
    const float* w2 = F.inp(8) + (size_t)l * 64 * CW; const float* a2 = F.inp(11) + (size_t)l * 64 * CW; const float* g2 = F.inp(13) + (size_t)l * 128 * CW; const float* v2 = F.inp(22);
    for (int idx = F.bid * 512 + F.tid; idx < 288 * CW; idx += F.G * 512) { const int j = idx >> 9, c = idx & 511;
        float v;
        if (j < 64) v = w2[j * CW + c]; else if (j < 128) v = a2[(j - 64) * CW + c]; else if (j < 256) v = g2[(j - 128) * CW + c]; else v = (l > 0) ? v2[(j - 256) * CW + c] : 0.f;
        L2T[c * 288 + j] = f2bf(v); }
}
DI float row16_sum(float v) { v += dpp_mov<0xB1>(v); v += dpp_mov<0x4E>(v); v += dpp_mov<0x141>(v); v += dpp_mov<0x140>(v); return v; }
DI void phase_rwkv_prep2(Frame& F, int l, int tile_lo, int tile_hi, int tile_step, bool init) {
    LAS unsigned char* act = F.lds;
    LAS float* PRM = (LAS float*)(F.lds + 139264);
    const bf16_t* RW = (const bf16_t*)(F.wsp() + WS_RW); const bf16_t* LO = (const bf16_t*)(F.wsp() + WS_LO); const unsigned char* L2T = F.wsp() + WS_WM + WM_L2T;
    bf16_t* SIr = (bf16_t*)(F.wsp() + WS_SIR); bf16_t* SIk = (bf16_t*)(F.wsp() + WS_SIK);
    bf16_t* SCw = (bf16_t*)(F.wsp() + WS_SCRW) + (size_t)F.bid * 64 * CW; bf16_t* SCa = (bf16_t*)(F.wsp() + WS_SCRA) + (size_t)F.bid * 64 * CW; bf16_t* SCb = (bf16_t*)(F.wsp() + WS_SCRB) + (size_t)F.bid * 64 * CW;
    bf16_t* VF = (bf16_t*)(F.wsp() + WS_VF); bf16_t* V1 = (bf16_t*)(F.wsp() + WS_V1); bf16_t* Gb = (bf16_t*)(F.wsp() + WS_G);
    const int lane = F.lane, r16 = lane & 15, g = lane >> 4;
    if (init) { __syncthreads();
      const int c = F.tid;
      PRM[c] = F.inp(4)[(size_t)l * 3 * CW + c]; PRM[512 + c] = F.inp(4)[(size_t)l * 3 * CW + CW + c]; PRM[1024 + c] = F.inp(4)[(size_t)l * 3 * CW + 2 * CW + c];
      PRM[1536 + c] = F.inp(6)[l * CW + c]; PRM[2048 + c] = F.inp(9)[l * CW + c]; PRM[2560 + c] = F.inp(14)[l * CW + c]; PRM[3072 + c] = F.inp(15)[l * CW + c]; PRM[3584 + c] = l > 0 ? F.inp(20)[c] : 0.f; }
    for (int tile = tile_lo; tile < tile_hi; tile += tile_step) {
        int t0 = tile * 64; asm volatile("" : "+s"(t0));
        __syncthreads();
        for (int dup1_ = 0; dup1_ < ((PREP_DUP & 1) ? 2 : 1); ++dup1_)
        for (int grp = F.tid; grp < 64 * 36; grp += 512) { const int tt = grp / 36, jg = grp - tt * 36, j0 = 8 * jg; const int t = t0 + tt; const bool has_prev = (t % SEQ) != 0;
            int pj, qj; if (j0 < 64) { pj = j0; qj = 64 + j0; } else if (j0 < 128) { pj = 128 + (j0 - 64); qj = 192 + (j0 - 64); } else if (j0 < 256) { pj = 256 + (j0 - 128); qj = 384 + (j0 - 128); } else { pj = 512 + (j0 - 256); qj = 544 + (j0 - 256); }
            const u32x4 pv = *(const u32x4*)(LO + (size_t)t * LO_W + pj); u32x4 qv = {0u, 0u, 0u, 0u}; if (has_prev) qv = *(const u32x4*)(LO + (size_t)(t - 1) * LO_W + qj);
            const unsigned pw[4] = {pv.x, pv.y, pv.z, pv.w}, qw[4] = {qv.x, qv.y, qv.z, qv.w}; float v[8];
#pragma unroll
            for (int q = 0; q < 4; ++q) { v[2 * q] = bflo(pw[q]) + bflo(qw[q]); v[2 * q + 1] = bfhi(pw[q]) + bfhi(qw[q]); }
            if (j0 < 64) {
#pragma unroll
                for (int e = 0; e < 8; ++e) v[e] = 1.0f - 2.0f * __builtin_amdgcn_rcpf(1.0f + __expf(2.0f * v[e]));
            } else if (j0 >= 128 && j0 < 256) {
#pragma unroll
                for (int e = 0; e < 8; ++e) v[e] = sigmoidf_(v[e]);
            }
            u32x4 w; w.x = pk2(v[0], v[1]); w.y = pk2(v[2], v[3]); w.z = pk2(v[4], v[5]); w.w = pk2(v[6], v[7]);
            *(LAS u32x4*)(act + tt * ACT_P + j0 * 2) = w; }
        __syncthreads();
        float inv[4];
        for (int pd_ = 0; pd_ < ((PREP_DUP & 4) ? 2 : 1); ++pd_)
        { int cw = 64 * F.wave + 4 * g; asm volatile("" : "+v"(cw));
          u32x2 kc[4][4], kp_[4][4];
#pragma unroll
          for (int tt = 0; tt < 4; ++tt) { const int t = t0 + 16 * tt + r16; const bool has_prev = (t % SEQ) != 0; const size_t ro = (size_t)t * 1536;
#pragma unroll
              for (int ct = 0; ct < 4; ++ct) { kc[tt][ct] = *(const u32x2*)(RW + ro + 512 + cw + 16 * ct); kp_[tt][ct] = (u32x2){0u, 0u}; if (has_prev) kp_[tt][ct] = *(const u32x2*)(RW + ro - 1536 + 512 + cw + 16 * ct); } }
#pragma unroll
          for (int tt = 0; tt < 4; ++tt) { float ss = 0.f;
#pragma unroll
              for (int ct = 0; ct < 4; ++ct) { const f32x4 muk = *(const LAS f32x4*)(PRM + 512 + cw + 16 * ct), kkc = *(const LAS f32x4*)(PRM + 2560 + cw + 16 * ct);
                  const float k0 = bflo(kc[tt][ct].x), k1 = bfhi(kc[tt][ct].x), k2 = bflo(kc[tt][ct].y), k3 = bfhi(kc[tt][ct].y), q0 = bflo(kp_[tt][ct].x), q1 = bfhi(kp_[tt][ct].x), q2 = bflo(kp_[tt][ct].y), q3 = bfhi(kp_[tt][ct].y);
                  const float a0 = (k0 + (q0 - k0) * muk[0]) * kkc[0], a1 = (k1 + (q1 - k1) * muk[1]) * kkc[1], a2 = (k2 + (q2 - k2) * muk[2]) * kkc[2], a3 = (k3 + (q3 - k3) * muk[3]) * kkc[3];
                  ss += (a0 * a0 + a1 * a1) + (a2 * a2 + a3 * a3); }
              ss += __shfl_xor(ss, 16); ss += __shfl_xor(ss, 32);
              inv[tt] = __builtin_amdgcn_rsqf(fmaxf(ss, 1e-24f)); } }
#pragma unroll 1
        for (int ct8 = 0; ct8 < ((PREP_DUP & 8) ? 8 : 4); ++ct8) { const int ct = ct8 & 3;
            int cw = 64 * F.wave + 4 * g; asm volatile("" : "+v"(cw));
            const int c0 = cw + 16 * ct;
            bf16x8 wf[9];
            { const unsigned char* wrow = L2T + (size_t)(64 * F.wave + 16 * ct + r16) * 576 + 16 * g;
#pragma unroll
              for (int s = 0; s < 9; ++s) wf[s] = *(const bf16x8*)(wrow + 64 * s); }
            u32x2 cur[4][3], prv[4][3], vfl[4];
#pragma unroll
            for (int tt = 0; tt < 4; ++tt) { const int t = t0 + 16 * tt + r16; const bool has_prev = (t % SEQ) != 0; const size_t ro = (size_t)t * 1536;
#pragma unroll
                for (int p = 0; p < 3; ++p) { cur[tt][p] = *(const u32x2*)(RW + ro + 512 * p + c0); prv[tt][p] = (u32x2){0u, 0u}; if (has_prev) prv[tt][p] = *(const u32x2*)(RW + ro - 1536 + 512 * p + c0); }
                vfl[tt] = (u32x2){0u, 0u}; if (l > 0) vfl[tt] = *(const u32x2*)(VF + (size_t)t * CW + c0); }
            const f32x4 mur = *(const LAS f32x4*)(PRM + c0), muk = *(const LAS f32x4*)(PRM + 512 + c0), muv = *(const LAS f32x4*)(PRM + 1024 + c0), w0v = *(const LAS f32x4*)(PRM + 1536 + c0),
                        a0v = *(const LAS f32x4*)(PRM + 2048 + c0), kkc = *(const LAS f32x4*)(PRM + 2560 + c0), kac = *(const LAS f32x4*)(PRM + 3072 + c0), v0v = *(const LAS f32x4*)(PRM + 3584 + c0);
#pragma unroll
            for (int tt = 0; tt < 4; ++tt) {
                const int t = t0 + 16 * tt + r16; const size_t oo = (size_t)t * CW, os = (size_t)(16 * tt + r16) * CW;
                bf16x8 a[9];
#pragma unroll
                for (int s = 0; s < 9; ++s) a[s] = *(const LAS bf16x8*)(act + (16 * tt + r16) * ACT_P + (32 * s + 8 * g) * 2);
                f32x4 aw = {0.f, 0.f, 0.f, 0.f}, aa = {0.f, 0.f, 0.f, 0.f}, ag = {0.f, 0.f, 0.f, 0.f}, av = {0.f, 0.f, 0.f, 0.f};
                aw = mfma16(wf[0], a[0], aw); aw = mfma16(wf[1], a[1], aw);
                aa = mfma16(wf[2], a[2], aa); aa = mfma16(wf[3], a[3], aa);
                ag = mfma16(wf[4], a[4], ag); ag = mfma16(wf[5], a[5], ag); ag = mfma16(wf[6], a[6], ag); ag = mfma16(wf[7], a[7], ag);
                if (l > 0) av = mfma16(wf[8], a[8], av);
                float ro4[4], lw4[4], vo4[4], k2[4], ka[4], kb[4];
#pragma unroll
                for (int r = 0; r < 4; ++r) {
                    const unsigned cwd_r = (r < 2) ? cur[tt][0].x : cur[tt][0].y, cwd_k = (r < 2) ? cur[tt][1].x : cur[tt][1].y, cwd_v = (r < 2) ? cur[tt][2].x : cur[tt][2].y;
                    const unsigned pwd_r = (r < 2) ? prv[tt][0].x : prv[tt][0].y, pwd_k = (r < 2) ? prv[tt][1].x : prv[tt][1].y, pwd_v = (r < 2) ? prv[tt][2].x : prv[tt][2].y;
                    const unsigned vwd = (r < 2) ? vfl[tt].x : vfl[tt].y;
                    const float rp = (r & 1) ? bfhi(cwd_r) : bflo(cwd_r), kp = (r & 1) ? bfhi(cwd_k) : bflo(cwd_k), vp = (r & 1) ? bfhi(cwd_v) : bflo(cwd_v);
                    const float rq = (r & 1) ? bfhi(pwd_r) : bflo(pwd_r), kq_ = (r & 1) ? bfhi(pwd_k) : bflo(pwd_k), vq = (r & 1) ? bfhi(pwd_v) : bflo(pwd_v);
                    const float rr = rp + (rq - rp) * mur[r], k = kp + (kq_ - kp) * muk[r]; float v = vp + (vq - vp) * muv[r];
                    lw4[r] = -0.60653066f * sigmoidf_(w0v[r] + aw[r]);
                    const float alr = sigmoidf_(a0v[r] + aa[r]);
                    if (l > 0) { const float vf = (r & 1) ? bfhi(vwd) : bflo(vwd); v = v + (vf - v) * sigmoidf_(v0v[r] + av[r]); }
                    const float kk = k * kkc[r] * inv[tt];
                    ro4[r] = rr; vo4[r] = v; k2[r] = k * (1.f + (alr - 1.f) * kac[r]); ka[r] = kk; kb[r] = kk * alr; }
                u32x2 w;
                w.x = pk2(ro4[0], ro4[1]); w.y = pk2(ro4[2], ro4[3]); *(u32x2*)(SIr + oo + c0) = w;
                w.x = pk2(lw4[0], lw4[1]); w.y = pk2(lw4[2], lw4[3]); *(u32x2*)(SCw + os + c0) = w;
                w.x = pk2(ag[0], ag[1]); w.y = pk2(ag[2], ag[3]); *(u32x2*)(Gb + oo + c0) = w;
                w.x = pk2(vo4[0], vo4[1]); w.y = pk2(vo4[2], vo4[3]); *(u32x2*)((l > 0 ? V1 : VF) + oo + c0) = w;
                w.x = pk2(k2[0], k2[1]); w.y = pk2(k2[2], k2[3]); *(u32x2*)(SIk + oo + c0) = w;
                w.x = pk2(ka[0], ka[1]); w.y = pk2(ka[2], ka[3]); *(u32x2*)(SCa + os + c0) = w;
                w.x = pk2(kb[0], kb[1]); w.y = pk2(kb[2], kb[3]); *(u32x2*)(SCb + os + c0) = w;
            }
        }
    }
}
constexpr int NUNIT = NB * NH * (SEQ / 64);
constexpr size_t U_PMP = 0, U_RPP = 8192, U1_BYTES = 16384;
constexpr size_t U_QMT = 0, U_YLT = 8192, U2_BYTES = 16384;
DI int permk(int k) { return (k & 32) | (((k >> 2) & 3) << 3) | (((k >> 4) & 1) << 2) | (k & 3); }
constexpr int MP = 144;
constexpr int SP = 80;
DI f32x4 mm_tile(const LAS unsigned char* xb, int px, int m0, const LAS unsigned char* yb, int py, int n0, int ks, f32x4 acc, int lane) {
    const int r16 = lane & 15, g = lane >> 4;
    for (int s = 0; s < ks; ++s) {
        const bf16x8 a = *(const LAS bf16x8*)(xb + (m0 + r16) * px + (32 * s + 8 * g) * 2);
        const bf16x8 b = *(const LAS bf16x8*)(yb + (n0 + r16) * py + (32 * s + 8 * g) * 2);
        acc = mfma16(a, b, acc);
    }
    return acc;
}
DI u32x2 pk4(f32x4 v) { u32x2 w; w.x = pk2(v[0], v[1]); w.y = pk2(v[2], v[3]); return w; }

#ifndef SA_DUP
#define SA_DUP 0
#endif
#define SA_REP(bit) for (int sd_ = 0; sd_ < ((SA_DUP & (bit)) ? 2 : 1); ++sd_)
DI void phase_scan_a(Frame& F, int l, int u_lo, int u_hi, int u_step) {
    LAS unsigned char* const L = F.lds;
#define MB(n) (L + (n) * 9216)
    LAS float* const Gf = (LAS float*)(L + 110592);
    LAS float* const SEG = (LAS float*)(L + 110592 + 16384);
    LAS float* const GL = SEG + 512;
    LAS unsigned char* const A21 = L + 110592 + 16384 + 2048 + 256;
    LAS unsigned char* const T11T = A21 + 2560;
    LAS unsigned char* const ZT = T11T + 2560;
    const bf16_t* SIr = (const bf16_t*)(F.wsp() + WS_SIR); const bf16_t* SIk = (const bf16_t*)(F.wsp() + WS_SIK);
    const bf16_t* SCw = (const bf16_t*)(F.wsp() + WS_SCRW) + (size_t)F.bid * 64 * CW; const bf16_t* SCa = (const bf16_t*)(F.wsp() + WS_SCRA) + (size_t)F.bid * 64 * CW; const bf16_t* SCb = (const bf16_t*)(F.wsp() + WS_SCRB) + (size_t)F.bid * 64 * CW;
    const bf16_t* V = (const bf16_t*)(F.wsp() + (l > 0 ? WS_V1 : WS_VF));
    const int lane = F.lane, wave = F.wave, r16 = lane & 15, g = lane >> 4;
    float plw[8]; u32x4 prv, pkv, pav, pbv, pvv;
#define SCANA_LOAD(uu) do { const int bh_ = (uu) & 31, c_ = (uu) >> 5, b_ = bh_ >> 3, h_ = bh_ & 7; const size_t t0_ = (size_t)b_ * SEQ + c_ * 64; \
        { const int k_ = F.tid & 63, seg_ = F.tid >> 6; _Pragma("unroll") for (int e = 0; e < 8; ++e) plw[e] = bf2f(SCw[(size_t)(8 * seg_ + e) * CW + h_ * 64 + k_]); } \
        { const int i_ = F.tid >> 3, k0_ = (F.tid & 7) * 8; const size_t go_ = (t0_ + i_) * CW + h_ * 64 + k0_, gs_ = (size_t)i_ * CW + h_ * 64 + k0_; \
          prv = *(const u32x4*)(SIr + go_); pkv = *(const u32x4*)(SIk + go_); pav = *(const u32x4*)(SCa + gs_); pbv = *(const u32x4*)(SCb + gs_); pvv = *(const u32x4*)(V + go_); } } while (0)
    if (u_lo < u_hi) SCANA_LOAD(u_lo);
    for (int u = u_lo; u < u_hi; u += u_step) {
        const int bh = u & 31, c = u >> 5, b = bh >> 3, h = bh & 7;
        const size_t t0 = (size_t)b * SEQ + c * 64; (void)t0; (void)b; (void)h;
        unsigned char* const rec1 = F.wsp() + WS_SC1 + (size_t)((bh * 128) + c) * U1_BYTES; unsigned char* const rec2 = F.wsp() + WS_SC2 + (size_t)((bh * 128) + c) * U2_BYTES;
        __syncthreads();
        SA_REP(1) {
        { const int k = F.tid & 63, seg = F.tid >> 6; float p[8]; float run = 0.f;
#pragma unroll
          for (int e = 0; e < 8; ++e) { run += plw[e]; p[e] = run; }
          SEG[seg * 64 + k] = run;
          __syncthreads();
          float off = 0.f;
#pragma unroll
          for (int s = 0; s < 8; ++s) off += (s < seg) ? SEG[s * 64 + k] : 0.f;
#pragma unroll
          for (int e = 0; e < 8; ++e) Gf[(8 * seg + e) * 64 + k] = off + p[e];
        }
        __syncthreads();
        { const int i = F.tid >> 3, k0 = (F.tid & 7) * 8;
          const u32x4 rv = prv, kv = pkv, av = pav, bv = pbv, vv = pvv;
          float fr[8], fk[8], fa[8], fb[8], fv[8];
          const unsigned rw[4] = {rv.x, rv.y, rv.z, rv.w}, kw[4] = {kv.x, kv.y, kv.z, kv.w}, aw[4] = {av.x, av.y, av.z, av.w}, bw[4] = {bv.x, bv.y, bv.z, bv.w}, vw[4] = {vv.x, vv.y, vv.z, vv.w};
#pragma unroll
          for (int q = 0; q < 4; ++q) { fr[2 * q] = bflo(rw[q]); fr[2 * q + 1] = bfhi(rw[q]); fk[2 * q] = bflo(kw[q]); fk[2 * q + 1] = bfhi(kw[q]); fa[2 * q] = bflo(aw[q]); fa[2 * q + 1] = bfhi(aw[q]);
              fb[2 * q] = bflo(bw[q]); fb[2 * q + 1] = bfhi(bw[q]); fv[2 * q] = bflo(vw[q]); fv[2 * q + 1] = bfhi(vw[q]); }
          float at[8], rt[8], bt[8], kt[8], bh8[8], kh8[8];
#pragma unroll
          for (int e = 0; e < 8; ++e) { const float gi = Gf[i * 64 + k0 + e], gp = (i > 0) ? Gf[(i - 1) * 64 + k0 + e] : 0.f, gl = Gf[63 * 64 + k0 + e];
              const float e1 = __expf(gp), e2 = __expf(gi), e3 = __expf(-gi), e4 = __expf(gl - gi);
              at[e] = -fa[e] * e1; rt[e] = fr[e] * e2; bt[e] = fb[e] * e3; kt[e] = fk[e] * e3; bh8[e] = fb[e] * e4; kh8[e] = fk[e] * e4;
              if (i == 63) GL[k0 + e] = e2; }
          u32x4 w;
          w.x = pk2(at[0], at[1]); w.y = pk2(at[2], at[3]); w.z = pk2(at[4], at[5]); w.w = pk2(at[6], at[7]); *(LAS u32x4*)(MB(0) + i * MP + k0 * 2) = w;
          w.x = pk2(rt[0], rt[1]); w.y = pk2(rt[2], rt[3]); w.z = pk2(rt[4], rt[5]); w.w = pk2(rt[6], rt[7]); *(LAS u32x4*)(MB(1) + i * MP + k0 * 2) = w;
          w.x = pk2(bt[0], bt[1]); w.y = pk2(bt[2], bt[3]); w.z = pk2(bt[4], bt[5]); w.w = pk2(bt[6], bt[7]); *(LAS u32x4*)(MB(2) + i * MP + k0 * 2) = w;
          w.x = pk2(kt[0], kt[1]); w.y = pk2(kt[2], kt[3]); w.z = pk2(kt[4], kt[5]); w.w = pk2(kt[6], kt[7]); *(LAS u32x4*)(MB(3) + i * MP + k0 * 2) = w;
#pragma unroll
          for (int e = 0; e < 8; ++e) { const int ro = (k0 + e) * MP + i * 2;
              *(LAS bf16_t*)(MB(4) + ro) = f2bf(at[e]); *(LAS bf16_t*)(MB(5) + ro) = f2bf(fv[e]); *(LAS bf16_t*)(MB(6) + ro) = f2bf(bh8[e]); *(LAS bf16_t*)(MB(7) + ro) = f2bf(kh8[e]); }
        }
        __syncthreads(); }
        if (u + u_step < u_hi) SCANA_LOAD(u + u_step);
        __syncthreads();
        SA_REP(2) {
        { const int prod = wave >> 1;
          const LAS unsigned char* xb = (prod & 1) ? MB(3) : MB(2); const LAS unsigned char* yb = (prod < 2) ? MB(0) : MB(1);
          LAS unsigned char* ob = (prod == 1) ? MB(8) : (prod == 2) ? MB(9) : MB(10);
          float zf = 0.f; asm volatile("" : "+v"(zf));
          for (int q = 0; q < 8; ++q) { const int tt = (wave & 1) * 8 + q, tm = tt >> 2, tn = tt & 3;
              f32x4 acc = {zf, zf, zf, zf};
              if (tm <= tn) acc = mm_tile(xb, MP, 16 * tm, yb, MP, 16 * tn, 2, acc, lane);
              const int i = 16 * tn + r16, j0 = 16 * tm + 4 * g;
#pragma unroll
              for (int r = 0; r < 4; ++r) { const int j = j0 + r; const bool keep = (prod < 2) ? (j < i) : (j <= i); if (!keep) acc[r] = 0.f; }
              if (prod == 0) {
                  if ((i >> 5) == (j0 >> 5)) *(LAS f32x4*)(Gf + ((i >> 5) * 32 + (i & 31)) * 32 + (j0 & 31)) = acc;
                  if (i >= 32 && j0 < 32) *(LAS u32x2*)(A21 + (i - 32) * SP + j0 * 2) = pk4(acc);
              } else *(LAS u32x2*)(ob + i * MP + j0 * 2) = pk4(acc);
          } }
        __syncthreads();
        }
        f32x4 pyl[2] = {{0.f, 0.f, 0.f, 0.f}, {0.f, 0.f, 0.f, 0.f}}, pqm[2] = {{0.f, 0.f, 0.f, 0.f}, {0.f, 0.f, 0.f, 0.f}};
        SA_REP(4) {
        if (wave == 0) {
            const int blk = lane >> 5, cc = lane & 31; const LAS float* AD = Gf + blk * 1024;
            float Tc[32];
#pragma unroll
            for (int i = 0; i < 32; ++i) { float a0 = (i == cc) ? 1.f : 0.f, a1 = 0.f, a2 = 0.f, a3 = 0.f;
#pragma unroll
                for (int q = 0; q < (i + 3) / 4; ++q) { const f32x4 a = *(const LAS f32x4*)(AD + i * 32 + 4 * q);
                    if (4 * q + 0 < i) a0 += a[0] * Tc[4 * q + 0]; if (4 * q + 1 < i) a1 += a[1] * Tc[4 * q + 1]; if (4 * q + 2 < i) a2 += a[2] * Tc[4 * q + 2]; if (4 * q + 3 < i) a3 += a[3] * Tc[4 * q + 3]; }
                Tc[i] = (a0 + a1) + (a2 + a3); }
#pragma unroll
            for (int i = 0; i < 32; ++i) *(LAS bf16_t*)(MB(11) + (32 * blk + i) * MP + (32 * blk + cc) * 2) = f2bf(Tc[i]);
            if (blk == 0) {
#pragma unroll
                for (int q = 0; q < 4; ++q) { u32x4 w; w.x = pk2(Tc[8 * q], Tc[8 * q + 1]); w.y = pk2(Tc[8 * q + 2], Tc[8 * q + 3]); w.z = pk2(Tc[8 * q + 4], Tc[8 * q + 5]); w.w = pk2(Tc[8 * q + 6], Tc[8 * q + 7]);
                    *(LAS u32x4*)(T11T + cc * SP + q * 16) = w; }
            } else {
                unsigned z = 0u; asm volatile("" : "+v"(z));
#pragma unroll
                for (int q = 0; q < 4; ++q) *(LAS u32x4*)(MB(11) + cc * MP + 64 + q * 16) = (u32x4){z, z, z, z};
            }
        } else {
            for (int tt = wave - 1; tt < 16; tt += 7) { const int tm = tt >> 2, tn = tt & 3;
                f32x4 acc = {0.f, 0.f, 0.f, 0.f};
                acc = mm_tile(MB(8), MP, 16 * tm, MB(5), MP, 16 * tn, 2, acc, lane);
                *(LAS u32x2*)(MB(2) + (16 * tn + r16) * MP + (16 * tm + 4 * g) * 2) = pk4(acc); }
            if (sd_ == 0) {
#pragma unroll
                for (int q = 0; q < 2; ++q) { const int tt = wave * 2 + q, tm = tt >> 2, tn = tt & 3; const f32x4 z = {0.f, 0.f, 0.f, 0.f};
                    pyl[q] = mm_tile(MB(5), MP, 16 * tm, MB(10), MP, 16 * tn, 2, z, lane);
                    pqm[q] = mm_tile(MB(7), MP, 16 * tm, MB(5), MP, 16 * tn, 2, z, lane); } }
        }
        __syncthreads();
        if (wave < 4) { const int tm = wave >> 1, tn = wave & 1; f32x4 acc = {0.f, 0.f, 0.f, 0.f};
            acc = mm_tile(A21, SP, 16 * tm, T11T, SP, 16 * tn, 1, acc, lane);
            *(LAS u32x2*)(ZT + (16 * tn + r16) * SP + (16 * tm + 4 * g) * 2) = pk4(acc); }
        __syncthreads();
        if (wave < 4) { const int tm = wave >> 1, tn = wave & 1; f32x4 acc = {0.f, 0.f, 0.f, 0.f};
            acc = mm_tile(ZT, SP, 16 * tm, MB(11) + 32 * MP + 64, MP, 16 * tn, 1, acc, lane);
            *(LAS u32x2*)(MB(11) + (32 + 16 * tn + r16) * MP + (16 * tm + 4 * g) * 2) = pk4(acc); }
        __syncthreads();
        }
        SA_REP(8) {
        { const LAS unsigned char* yb = (wave < 4) ? MB(4) : MB(2); LAS unsigned char* ob = (wave < 4) ? MB(3) : MB(0);
          for (int q = 0; q < 4; ++q) { const int tt = (wave & 3) * 4 + q, tm = tt >> 2, tn = tt & 3;
              f32x4 acc = {0.f, 0.f, 0.f, 0.f};
              acc = mm_tile(MB(11), MP, 16 * tm, yb, MP, 16 * tn, 2, acc, lane);
              *(LAS u32x2*)(ob + (16 * tn + r16) * MP + (16 * tm + 4 * g) * 2) = pk4(acc); } }
        __syncthreads();
        }
        SA_REP(16) {
#pragma unroll
        for (int q = 0; q < 2; ++q) { const int tt = wave * 2 + q, tm = tt >> 2, tn = tt & 3;
            { f32x4 acc = {0.f, 0.f, 0.f, 0.f}; acc = mm_tile(MB(3), MP, 16 * tm, MB(9), MP, 16 * tn, 2, acc, lane);
              const int i = 16 * tn + r16, k0 = 16 * tm + 4 * g; const u32x2 rr = *(const LAS u32x2*)(MB(1) + i * MP + k0 * 2);
              acc[0] += bflo(rr.x); acc[1] += bfhi(rr.x); acc[2] += bflo(rr.y); acc[3] += bfhi(rr.y);
              *(u32x2*)(rec1 + U_RPP + (size_t)(i * 64 + permk(k0)) * 2) = pk4(acc); }
            { f32x4 acc = {0.f, 0.f, 0.f, 0.f}; acc = mm_tile(MB(3), MP, 16 * tm, MB(6), MP, 16 * tn, 2, acc, lane);
              const int kp = 16 * tn + r16, k0 = 16 * tm + 4 * g;
#pragma unroll
              for (int r = 0; r < 4; ++r) if (k0 + r == kp) acc[r] += GL[kp];
              *(u32x2*)(rec1 + U_PMP + (size_t)(kp * 64 + permk(k0)) * 2) = pk4(acc); }
            { f32x4 acc = pyl[q]; acc = mm_tile(MB(0), MP, 16 * tm, MB(9), MP, 16 * tn, 2, acc, lane); if (wave == 0) acc = mm_tile(MB(5), MP, 16 * tm, MB(10), MP, 16 * tn, 2, acc, lane);
              *(u32x2*)(rec2 + U_YLT + (size_t)((16 * tn + r16) * 64 + 16 * tm + 4 * g) * 2) = pk4(acc); }
            { f32x4 acc = pqm[q]; acc = mm_tile(MB(6), MP, 16 * tm, MB(0), MP, 16 * tn, 2, acc, lane); if (wave == 0) acc = mm_tile(MB(7), MP, 16 * tm, MB(5), MP, 16 * tn, 2, acc, lane);
              *(u32x2*)(rec2 + U_QMT + (size_t)((16 * tn + r16) * 64 + 16 * tm + 4 * g) * 2) = pk4(acc); }
        }
        __syncthreads(); }
    }
#undef MB
#undef SCANA_LOAD
}

constexpr int SB_D = 9, SB_SLOT = 16384;
DI void scanb_issue(LAS unsigned char* lds, const unsigned char* r1b, const unsigned char* r2b, int cidx, int lw, int lane) {
    const unsigned char* rec1 = r1b + (size_t)cidx * U1_BYTES; const unsigned char* rec2 = r2b + (size_t)cidx * U2_BYTES;
    LAS unsigned char* slot = lds + (cidx % SB_D) * SB_SLOT;
#pragma unroll
    for (int i = 0; i < 2; ++i) { const int ci = 2 * lw + i;
        const int row = 8 * ci + (lane >> 3), sl = lane & 7;
        __builtin_amdgcn_global_load_lds((const unsigned*)(rec1 + U_PMP + row * 128 + ((sl ^ (row & 7)) << 4)), (LAS unsigned*)(slot + ci * 1024), 16, 0, 0); }
#pragma unroll
    for (int i = 0; i < 2; ++i) { const int ci = 2 * lw + i;
        const int v = 8 * ci + (lane >> 3), sl = lane & 7;
        __builtin_amdgcn_global_load_lds((const unsigned*)(rec2 + U_QMT + v * 128 + ((sl ^ (v & 7)) << 4)), (LAS unsigned*)(slot + 8192 + ci * 1024), 16, 0, 0); }
}
constexpr int CW_SFLG = 12288;
DI void phase_scan_b(Frame& F, int l) {
    const int lane = F.lane, r16 = lane & 15, g = lane >> 4, w = F.wave, v = 16 * (w & 3) + r16;
    for (int bh = F.bid; bh < NB * NH; bh += F.G) {
        const unsigned char* r1 = F.wsp() + WS_SC1 + (size_t)bh * 128 * U1_BYTES; const unsigned char* r2 = F.wsp() + WS_SC2 + (size_t)bh * 128 * U2_BYTES;
        bf16_t* sct = (bf16_t*)(F.wsp() + WS_SCT) + (size_t)bh * 128 * 4096;
        const __amdgpu_buffer_rsrc_t srs = __builtin_amdgcn_make_buffer_rsrc((void*)sct, 0, 128 * 8192, 0x00020000);
        GAS unsigned* flg = (GAS unsigned*)(F.ws_g + WS_CTL) + CW_SFLG + 64 * (l * 32 + bh);
        f32x4 sT[4];
#pragma unroll
        for (int i = 0; i < 4; ++i) sT[i] = (f32x4){0.f, 0.f, 0.f, 0.f};
        __syncthreads();
        if (w >= 4) {
#pragma unroll
            for (int d = 0; d < SB_D; ++d) scanb_issue(F.lds, r1, r2, d, w - 4, lane);
        }
        for (int c = 0; c < 128; ++c) {
            if (w >= 4) asm volatile("s_waitcnt vmcnt(28)" ::: "memory");
            __builtin_amdgcn_s_barrier();
            asm volatile("" ::: "memory");
            if (w >= 4) {
                if (c >= 1) { const int cn = c - 1 + SB_D; scanb_issue(F.lds, r1, r2, cn < 128 ? cn : c, w - 4, lane); }
            } else {
                const LAS unsigned char* slot = F.lds + (c % SB_D) * SB_SLOT;
                bf16x8 pm[4][2]; f32x4 q[4];
#pragma unroll
                for (int mt = 0; mt < 4; ++mt) { const int row = 16 * mt + r16;
#pragma unroll
                    for (int s2 = 0; s2 < 2; ++s2) pm[mt][s2] = *(const LAS bf16x8*)(slot + row * 128 + (((4 * s2 + g) ^ (row & 7)) << 4));
                    { const u32x2 qw = *(const LAS u32x2*)(slot + 8192 + v * 128 + (((2 * mt + (g >> 1)) ^ (v & 7)) << 4) + (g & 1) * 8); q[mt] = (f32x4){bflo(qw.x), bfhi(qw.x), bflo(qw.y), bfhi(qw.y)}; } }
                bf16x8 hi[2], lo[2];
#pragma unroll
                for (int s2 = 0; s2 < 2; ++s2) { u32x4 hw, lw;
#pragma unroll
                    for (int qq = 0; qq < 2; ++qq) { const f32x4 x = sT[2 * s2 + qq]; const unsigned h0 = pk2(x[0], x[1]), h1 = pk2(x[2], x[3]);
                        const unsigned l0 = pk2(x[0] - bflo(h0), x[1] - bfhi(h0)), l1 = pk2(x[2] - bflo(h1), x[3] - bfhi(h1));
                        if (qq == 0) { hw.x = h0; hw.y = h1; lw.x = l0; lw.y = l1; } else { hw.z = h0; hw.w = h1; lw.z = l0; lw.w = l1; } }
                    hi[s2] = __builtin_bit_cast(bf16x8, hw); lo[s2] = __builtin_bit_cast(bf16x8, lw);
                    __builtin_amdgcn_raw_buffer_store_b128(hw, srs, (int)(((unsigned)c * 4096u + (unsigned)v * 64u + 32u * s2 + 8u * g) * 2u), 0, 16); }
#pragma unroll
                for (int mt = 0; mt < 4; ++mt) { f32x4 n = q[mt];
#pragma unroll
                    for (int s2 = 0; s2 < 2; ++s2) { n = mfma16(pm[mt][s2], hi[s2], n); n = mfma16(pm[mt][s2], lo[s2], n); }
                    sT[mt] = n; }
                asm volatile("s_waitcnt lgkmcnt(0)" ::: "memory");
                if ((c & 3) == 3 && c >= 7) { asm volatile("s_waitcnt vmcnt(8)" ::: "memory");
                    if (lane == 0) __hip_atomic_fetch_add(flg, 1u, __ATOMIC_RELAXED, __HIP_MEMORY_SCOPE_AGENT); }
            }
        }
        asm volatile("s_waitcnt vmcnt(0)" ::: "memory");
        if (w < 4 && lane == 0) __hip_atomic_fetch_add(flg, 1u, __ATOMIC_RELAXED, __HIP_MEMORY_SCOPE_AGENT);
    }
}

struct ScanCIn { bf16x8 ra[2]; f32x4 yl[4]; bf16x8 sb[4][2]; };
DI void scanc_load(ScanCIn& o, const unsigned char* ws, GAS unsigned* flags, int item, int r16, int g) {
    asm volatile("" : "+s"(item));
    const int u = item >> 2, it = item & 3; const int bh = u & 31, c = u >> 5; const size_t ui = (size_t)(bh * 128 + c);
    {
      GAS unsigned* fw = flags + 64 * bh; const unsigned need = 4u * ((unsigned)(c >> 2) + 1u); unsigned spins = 0;
      while ((unsigned)__builtin_amdgcn_readfirstlane((int)__hip_atomic_load(fw, __ATOMIC_RELAXED, __HIP_MEMORY_SCOPE_AGENT)) < need) { __builtin_amdgcn_s_sleep(2); if (++spins > (1u << 20)) break; }
      asm volatile("" ::: "memory"); }
    const unsigned char* rec1 = ws + WS_SC1 + ui * U1_BYTES; const unsigned char* rec2 = ws + WS_SC2 + ui * U2_BYTES;
    const __amdgpu_buffer_rsrc_t srs = __builtin_amdgcn_make_buffer_rsrc((void*)(ws + WS_SCT + ui * 8192), 0, 8192, 0x00020000);
#pragma unroll
    for (int s = 0; s < 2; ++s) o.ra[s] = *(const bf16x8*)(rec1 + U_RPP + (size_t)((16 * it + r16) * 64 + 32 * s + 8 * g) * 2);
#pragma unroll
    for (int vt = 0; vt < 4; ++vt) { { const u32x2 yw = *(const u32x2*)(rec2 + U_YLT + (size_t)((16 * it + r16) * 64 + 32 * (vt >> 1) + 8 * g + 4 * (vt & 1)) * 2); o.yl[vt] = (f32x4){bflo(yw.x), bfhi(yw.x), bflo(yw.y), bfhi(yw.y)}; }
        const int vrow = 32 * (vt >> 1) + 8 * (r16 >> 2) + 4 * (vt & 1) + (r16 & 3);
#pragma unroll
        for (int s = 0; s < 2; ++s) o.sb[vt][s] = __builtin_bit_cast(bf16x8, __builtin_amdgcn_raw_buffer_load_b128(srs, (int)((vrow * 64 + 32 * s + 8 * g) * 2), 0, 16)); }
}
DI void scanc_item(const ScanCIn& o, Frame& F, int l, int item, int r16, int g) {
    const bf16_t* SIr = (const bf16_t*)(F.wsp() + WS_SIR); const bf16_t* SIk = (const bf16_t*)(F.wsp() + WS_SIK);
    const bf16_t* V = (const bf16_t*)(F.wsp() + (l > 0 ? WS_V1 : WS_VF)); const bf16_t* Gb = (const bf16_t*)(F.wsp() + WS_G); bf16_t* YR = (bf16_t*)(F.wsp() + WS_YRM);
    const int u = item >> 2, it = item & 3; const int bh = u & 31, c = u >> 5, b = bh >> 3, h = bh & 7;
    const size_t tok = (size_t)b * SEQ + c * 64 + 16 * it + r16; const size_t o0 = tok * CW + h * 64 + 8 * g, oy = tok * YRM_LD + h * 64 + 8 * g;
    u32x4 pr[2], pk[2], pv[2], pg[2];
#pragma unroll
    for (int p = 0; p < 2; ++p) { pr[p] = *(const u32x4*)(SIr + o0 + 32 * p); pk[p] = *(const u32x4*)(SIk + o0 + 32 * p); pv[p] = *(const u32x4*)(V + o0 + 32 * p); pg[p] = *(const u32x4*)(Gb + o0 + 32 * p); }
    f32x4 y[4];
#pragma unroll
    for (int vt = 0; vt < 4; ++vt) { y[vt] = o.yl[vt];
#pragma unroll
        for (int s = 0; s < 2; ++s) y[vt] = mfma16(o.sb[vt][s], o.ra[s], y[vt]); }
    float s1 = 0.f;
#pragma unroll
    for (int vt = 0; vt < 4; ++vt) s1 += (y[vt][0] + y[vt][1]) + (y[vt][2] + y[vt][3]);
    s1 += __shfl_xor(s1, 16); s1 += __shfl_xor(s1, 32);
    const float mean = s1 * (1.f / 64.f); float s2 = 0.f;
#pragma unroll
    for (int vt = 0; vt < 4; ++vt) { y[vt] = y[vt] - mean; s2 += (y[vt][0] * y[vt][0] + y[vt][1] * y[vt][1]) + (y[vt][2] * y[vt][2] + y[vt][3] * y[vt][3]); }
    s2 += __shfl_xor(s2, 16); s2 += __shfl_xor(s2, 32);
    const float rstd = __builtin_amdgcn_rsqf(s2 * (1.f / 64.f) + 64e-5f);
    const float* lng = F.inp(17) + l * CW + h * 64 + 8 * g; const float* lnb = F.inp(18) + l * CW + h * 64 + 8 * g; const float* rkp = F.inp(16) + l * CW + h * 64 + 8 * g;
    float s3 = 0.f;
#pragma unroll
    for (int p = 0; p < 2; ++p) { const f32x4 rk0 = *(const f32x4*)(rkp + 32 * p), rk1 = *(const f32x4*)(rkp + 32 * p + 4);
        s3 += bflo(pr[p].x) * bflo(pk[p].x) * rk0[0] + bfhi(pr[p].x) * bfhi(pk[p].x) * rk0[1] + bflo(pr[p].y) * bflo(pk[p].y) * rk0[2] + bfhi(pr[p].y) * bfhi(pk[p].y) * rk0[3]
            + bflo(pr[p].z) * bflo(pk[p].z) * rk1[0] + bfhi(pr[p].z) * bfhi(pk[p].z) * rk1[1] + bflo(pr[p].w) * bflo(pk[p].w) * rk1[2] + bfhi(pr[p].w) * bfhi(pk[p].w) * rk1[3]; }
    s3 += __shfl_xor(s3, 16); s3 += __shfl_xor(s3, 32);
#pragma unroll
    for (int p = 0; p < 2; ++p) { const f32x4 lg0 = *(const f32x4*)(lng + 32 * p), lg1 = *(const f32x4*)(lng + 32 * p + 4), lb0 = *(const f32x4*)(lnb + 32 * p), lb1 = *(const f32x4*)(lnb + 32 * p + 4);
        const f32x4 ya = y[2 * p], yb = y[2 * p + 1];
        const float o_0 = (ya[0] * rstd * lg0[0] + lb0[0] + s3 * bflo(pv[p].x)) * bflo(pg[p].x), o_1 = (ya[1] * rstd * lg0[1] + lb0[1] + s3 * bfhi(pv[p].x)) * bfhi(pg[p].x);
        const float o_2 = (ya[2] * rstd * lg0[2] + lb0[2] + s3 * bflo(pv[p].y)) * bflo(pg[p].y), o_3 = (ya[3] * rstd * lg0[3] + lb0[3] + s3 * bfhi(pv[p].y)) * bfhi(pg[p].y);
        const float o_4 = (yb[0] * rstd * lg1[0] + lb1[0] + s3 * bflo(pv[p].z)) * bflo(pg[p].z), o_5 = (yb[1] * rstd * lg1[1] + lb1[1] + s3 * bfhi(pv[p].z)) * bfhi(pg[p].z);
        const float o_6 = (yb[2] * rstd * lg1[2] + lb1[2] + s3 * bflo(pv[p].w)) * bflo(pg[p].w), o_7 = (yb[3] * rstd * lg1[3] + lb1[3] + s3 * bfhi(pv[p].w)) * bfhi(pg[p].w);
        u32x4 w; w.x = pk2(o_0, o_1); w.y = pk2(o_2, o_3); w.z = pk2(o_4, o_5); w.w = pk2(o_6, o_7); *(u32x4*)(YR + oy + 32 * p) = w; }
}
DI void phase_scan_c(Frame& F, int l, int nskip) {
    const int lane = F.lane, r16 = lane & 15, g = lane >> 4;
    const int first = (F.bid - nskip) * 8 + F.wave, stride = (F.G - nskip) * 8;
    if (first >= NUNIT * 4) return;
    GAS unsigned* flags = (GAS unsigned*)(F.ws_g + WS_CTL) + CW_SFLG + 64 * (l * 32);
    ScanCIn o0, o1;
    scanc_load(o0, F.wsp(), flags, first, r16, g);
    for (int item = first; item < NUNIT * 4; item += 2 * stride) {
        const int i1 = item + stride, i2 = item + 2 * stride;
        if (i1 < NUNIT * 4) scanc_load(o1, F.wsp(), flags, i1, r16, g);
        scanc_item(o0, F, l, item, r16, g);
        if (i1 < NUNIT * 4) { if (i2 < NUNIT * 4) scanc_load(o0, F.wsp(), flags, i2, r16, g); scanc_item(o1, F, l, i1, r16, g); }
    }
}

#ifndef FUSE_DUP
#define FUSE_DUP 0
#endif
DI void phase_prep_scana(Frame& F, int l) {
    phase_rwkv_prep2(F, l, 0, 0, 1, true);
#define RELANE() do { int l_ = F.lane; asm volatile("" : "+v"(l_)); F.lane = l_; F.tid = F.wave * 64 + l_; } while (0)
    for (int tile = F.bid; tile < T / 64; tile += F.G) {
        for (int fd_ = 0; fd_ < ((FUSE_DUP & 1) ? 2 : 1); ++fd_) {
        RELANE();
        phase_rwkv_prep2(F, l, tile, tile + 1, 1, false);
        }
        asm volatile("s_waitcnt vmcnt(0)" ::: "memory");
        __syncthreads();
        __builtin_amdgcn_fence(__ATOMIC_ACQUIRE, "agent");
        asm volatile("s_waitcnt vmcnt(0)" ::: "memory");
        const int b = tile >> 7, c = tile & 127; const int u0 = c * 32 + b * 8;
        for (int fd_ = 0; fd_ < ((FUSE_DUP & 2) ? 2 : 1); ++fd_) {
        RELANE();
        phase_scan_a(F, l, u0, u0 + 8, 1);
        }
    }
#undef RELANE
}
DI void phase_moba_prep(Frame& F, int l) {
    bf16_t* MO = (bf16_t*)(F.wsp() + WS_MO); float* KM = (float*)(F.wsp() + WS_TAB + TB_KMEAN);
    int c = F.tid; const float qg = F.inp(23)[l * 64 + (c & 63)] * 0.125f, kg = F.inp(24)[l * 64 + (c & 63)];
    for (int hs = F.bid; hs < T / 128; hs += F.G) {
        float ksum = 0.f;
        for (int tb = 0; tb < 128; tb += 8) {
            int tbase = hs * 128 + tb; asm volatile("" : "+s"(tbase), "+v"(c));
            float q[8], k[8];
#pragma unroll
            for (int e = 0; e < 8; ++e) { const size_t ro = (size_t)(tbase + e) * 1536; q[e] = bf2f(MO[ro + c]); k[e] = bf2f(MO[ro + 512 + c]); }
#pragma unroll
            for (int e = 0; e < 8; ++e) { const size_t ro = (size_t)(tbase + e) * 1536;
                const float qs = wave_sum(q[e] * q[e]) * (1.f / 64.f), ks = wave_sum(k[e] * k[e]) * (1.f / 64.f);
                const float qn = q[e] * (1.0f / sqrtf(qs + 1e-6f)) * qg, kn = k[e] * (1.0f / sqrtf(ks + 1e-6f)) * kg;
                MO[ro + c] = f2bf(qn); MO[ro + 512 + c] = f2bf(kn); ksum += kn; }
        }
        KM[(size_t)(hs & 1) * (TB_KMEAN2 / 4) + (size_t)(hs >> 1) * CW + c] = ksum * (1.f / 256.f);
    }
}
DI void phase_moba_gate(Frame& F) {
    LAS float* KL = (LAS float*)F.lds;
    const bf16_t* MO = (const bf16_t*)(F.wsp() + WS_MO); const float* KM = (const float*)(F.wsp() + WS_TAB + TB_KMEAN); unsigned* SEL = (unsigned*)(F.wsp() + WS_SEL);
    for (int sidx = F.bid; sidx < T / 64; sidx += F.G) {
        const int span = ((sidx / F.G) & 1) ? ((sidx & ~127) + (127 - (sidx & 127))) : sidx;
        const int t0 = span * 64, b = t0 / SEQ, blk = (t0 % SEQ) / 256;
        __syncthreads();
        { const int cc = F.tid, h = cc >> 6, d = cc & 63;
          for (int j0 = 0; j0 < blk; j0 += 8) { float v0[8], v1[8];
#pragma unroll
              for (int e = 0; e < 8; ++e) { const int j = (j0 + e < blk) ? j0 + e : blk - 1; const size_t ko = ((size_t)(b * 32 + j)) * CW + cc; v0[e] = KM[ko]; v1[e] = KM[ko + TB_KMEAN2 / 4]; }
#pragma unroll
              for (int e = 0; e < 8; ++e) if (j0 + e < blk) KL[h * 2052 + (j0 + e) * 64 + d] = v0[e] + v1[e]; } }
        __syncthreads();
        const int tok = F.tid >> 3, h = F.tid & 7; const int t = t0 + tok;
        float q[64];
        { const u32x4* qp = (const u32x4*)(MO + (size_t)t * 1536 + h * 64);
#pragma unroll
          for (int i = 0; i < 8; ++i) { const u32x4 w = qp[i]; q[8 * i] = bflo(w.x); q[8 * i + 1] = bfhi(w.x); q[8 * i + 2] = bflo(w.y); q[8 * i + 3] = bfhi(w.y); q[8 * i + 4] = bflo(w.z); q[8 * i + 5] = bfhi(w.z); q[8 * i + 6] = bflo(w.w); q[8 * i + 7] = bfhi(w.w); } }
        float v0 = -INFINITY, v1 = -INFINITY, v2 = -INFINITY; int i0 = 0, i1 = 1, i2 = 2;
        for (int j = 0; j < blk; ++j) {
            const LAS f32x4* kp = (const LAS f32x4*)(KL + h * 2052 + j * 64); float s = 0.f;
#pragma unroll
            for (int i = 0; i < 16; ++i) { const f32x4 kv = kp[i]; s += q[4 * i] * kv.x + q[4 * i + 1] * kv.y + q[4 * i + 2] * kv.z + q[4 * i + 3] * kv.w; }
            if (s > v0) { v2 = v1; i2 = i1; v1 = v0; i1 = i0; v0 = s; i0 = j; }
            else if (s > v1) { v2 = v1; i2 = i1; v1 = s; i1 = j; }
            else if (s > v2) { v2 = s; i2 = j; }
        }
        const int nv = blk < 3 ? blk : 3;
        SEL[(size_t)t * 8 + h] = (unsigned)i0 | ((unsigned)i1 << 8) | ((unsigned)i2 << 16) | ((unsigned)nv << 24);
    }
}

constexpr int KS_PITCH = 144, VT_PITCH = 520;
constexpr int NPIECE = 47;
constexpr int CW_QATT = 8192;
DI void phase_moba_attn(Frame& F, int l) {
    static constexpr unsigned PIECES[NPIECE] = {196608,1837578,590595,1574658,1115654,1640713,1968907,1443848,918789,1049857,1246983,393730,787456,721924,2034700,262401,2034179,2034957,2035214,2035471,2034692,2035728,2034944,2035985,2036242,2036499,2035461,2036756,2037013,2037270,2035969,2037527,2036230,2037784,2038041,2038298,2036743,2038555,2038812,2039069,2039326,2037512,2039583,2038018,2038281,2039050,2039563};
    LAS unsigned char* Ks = F.lds;
    LAS unsigned char* Vt = F.lds + 36864;
    LAS float* LUT = (LAS float*)(F.lds + 36864 + 33280);
    LAS unsigned* CTL = (LAS unsigned*)(F.lds + 36864 + 33280 + 528);
    LAS unsigned* LIST = CTL + 4;
    const bf16_t* MO = (const bf16_t*)(F.wsp() + WS_MO); const unsigned* SEL = (const unsigned*)(F.wsp() + WS_SEL);
    bf16_t* PO = (bf16_t*)(F.wsp() + WS_PO); f32x2* PST = (f32x2*)(F.wsp() + WS_PST);
    unsigned* qctr = (unsigned*)(F.wsp() + WS_CTL) + CW_QATT + 64 * l;
    const float* relb = F.inp(25);
    const int lane = F.lane;
    bool att_done = false, conv_done = false;
    for (int trip = 0;; ++trip) {
        if (!conv_done && (att_done || (trip % 3) == 2)) {
            __syncthreads();
            if (F.tid == 0) CTL[2] = __hip_atomic_fetch_add(qctr + 16, 1u, __ATOMIC_RELAXED, __HIP_MEMORY_SCOPE_AGENT);
            __syncthreads();
            const int cu = (int)CTL[2];
            if (cu >= CONV_UNITS) conv_done = true; else conv_experts_items(F, l, cu * CONV_GROUP, (cu + 1) * CONV_GROUP, 1);
        }
        if (att_done) { if (conv_done) break; continue; }
        __syncthreads();
        if (F.tid == 0) { CTL[0] = __hip_atomic_fetch_add(qctr, 1u, __ATOMIC_RELAXED, __HIP_MEMORY_SCOPE_AGENT); CTL[1] = 0u; }
        __syncthreads();
        const int u = (int)CTL[0];
        if (u >= NPIECE * NB * NH) { att_done = true; if (conv_done) break; continue; }
        const unsigned pc = PIECES[u >> 5]; const int bh = u & 31, b = bh >> 3, h = bh & 7;
        const int j = (int)(pc & 0xff), qlo = (int)((pc >> 8) & 0xff), qhi = (int)(pc >> 16); const int ncand = (qhi - qlo + 1) * 256;
        const size_t tokb = (size_t)b * SEQ;
        for (int id = F.tid; id < 2048; id += 512) { const int row = id >> 3, c8 = id & 7; const size_t ro = (tokb + j * 256 + row) * 1536 + h * 64 + c8 * 8;
            *(LAS u32x4*)(Ks + row * KS_PITCH + c8 * 16) = *(const u32x4*)(MO + ro + 512); }
        for (int id = F.tid; id < 1024; id += 512) { const int rp = id >> 3, c8 = id & 7; const size_t ro = (tokb + j * 256 + 2 * rp) * 1536 + h * 64 + c8 * 8 + 1024;
            const u32x4 v0 = *(const u32x4*)(MO + ro), v1 = *(const u32x4*)(MO + ro + 1536);
            const unsigned a[4] = {v0.x, v0.y, v0.z, v0.w}, bq[4] = {v1.x, v1.y, v1.z, v1.w};
            LAS unsigned char* vp = Vt + (c8 * 8) * VT_PITCH + rp * 4;
#pragma unroll
            for (int q = 0; q < 4; ++q) { *(LAS unsigned*)(vp + (2 * q) * VT_PITCH) = (a[q] & 0xffffu) | (bq[q] << 16); *(LAS unsigned*)(vp + (2 * q + 1) * VT_PITCH) = (a[q] >> 16) | (bq[q] & 0xffff0000u); } }
        if (F.tid <= 128) { const int n = F.tid; int bucket;
            if (n < 16) bucket = n; else { int lg = 16 + (int)(logf((float)n / 16.0f) / 2.0794415416798357f * 16.0f); bucket = lg < 31 ? lg : 31; }
            LUT[n] = relb[bucket * 8 + h]; }
        unsigned selw[11];
#pragma unroll
        for (int r = 0; r < 11; ++r) { const int qq = qlo * 256 + r * 512 + F.tid; selw[r] = (r * 512 + F.tid < ncand) ? SEL[(tokb + qq) * 8 + h] : 0u; }
#pragma unroll
        for (int r = 0; r < 11; ++r) { const int base = r * 512; if (base >= ncand) break;
            const int q = qlo * 256 + base + F.tid; const int qb = q >> 8; bool mem = false; unsigned ent = 0;
            if (base + F.tid >= ncand) { }
            else if (qb == j) { mem = true; ent = (unsigned)q | (3u << 16); }
            else { const unsigned s = selw[r]; const unsigned nv = s >> 24;
                if (nv > 0 && (s & 0xff) == (unsigned)j) { mem = true; ent = (unsigned)q; }
                else if (nv > 1 && ((s >> 8) & 0xff) == (unsigned)j) { mem = true; ent = (unsigned)q | (1u << 16); }
                else if (nv > 2 && ((s >> 16) & 0xff) == (unsigned)j) { mem = true; ent = (unsigned)q | (2u << 16); } }
            const unsigned long long bal = __ballot(mem); const int cnt = __popcll(bal);
            unsigned wbase = 0; if (lane == 0 && cnt > 0) wbase = __hip_atomic_fetch_add(&CTL[1], (unsigned)cnt, __ATOMIC_RELAXED, __HIP_MEMORY_SCOPE_WORKGROUP);
            wbase = (unsigned)__builtin_amdgcn_readfirstlane((int)wbase);
            if (mem) LIST[wbase + __popcll(bal & ((1ull << lane) - 1ull))] = ent;
        }
        __syncthreads();
        const int total = (int)CTL[1];
        const float bfar = LUT[128];
        const int ntile = (total + 31) >> 5;
        const int qi = lane & 31, half = lane >> 5;
        bf16x8 qfn[4]; unsigned enn = 0u;
        if (F.wave < ntile) { const int e0 = F.wave * 32 + qi; enn = LIST[e0 < total ? e0 : total - 1]; const size_t tk0 = tokb + (enn & 0xffffu);
#pragma unroll
            for (int kk = 0; kk < 4; ++kk) qfn[kk] = *(const bf16x8*)(MO + tk0 * 1536 + h * 64 + 16 * kk + 8 * half); }
        for (int tile = F.wave; tile < ntile; tile += 8) {
            const int e = tile * 32 + qi; const bool valid = e < total; const unsigned en = enn;
            const int q = (int)(en & 0xffffu), slot = (int)(en >> 16); const size_t tok = tokb + q;
            const bool need_lut = __any((q >> 8) <= j + 1);
            bf16x8 qf[4];
#pragma unroll
            for (int kk = 0; kk < 4; ++kk) qf[kk] = qfn[kk];
            if (tile + 8 < ntile) { const int e1 = (tile + 8) * 32 + qi; enn = LIST[e1 < total ? e1 : total - 1]; const size_t tk1 = tokb + (enn & 0xffffu);
#pragma unroll
                for (int kk = 0; kk < 4; ++kk) qfn[kk] = *(const bf16x8*)(MO + tk1 * 1536 + h * 64 + 16 * kk + 8 * half); }
            float mrun = -1e30f, lsum = 0.f;
            f32x16 oacc[2];
#pragma unroll
            for (int i = 0; i < 16; ++i) { oacc[0][i] = 0.f; oacc[1][i] = 0.f; }
            const int qrel = q - j * 256;
#pragma unroll 1
            for (int ck = 0; ck < 4; ++ck) {
                if (!__any(qrel >= 64 * ck)) break;
                f32x16 sacc[2];
#pragma unroll
                for (int k2 = 0; k2 < 2; ++k2) { const int kt = 2 * ck + k2;
#pragma unroll
                    for (int i = 0; i < 16; ++i) sacc[k2][i] = 0.f;
#pragma unroll
                    for (int kk = 0; kk < 4; ++kk) { const bf16x8 ka = *(const LAS bf16x8*)(Ks + (32 * kt + qi) * KS_PITCH + (16 * kk + 8 * half) * 2);
                        sacc[k2] = __builtin_amdgcn_mfma_f32_32x32x16_bf16(ka, qf[kk], sacc[k2], 0, 0, 0); } }
                float mx = -1e30f;
                if (need_lut) {
#pragma unroll
                    for (int k2 = 0; k2 < 2; ++k2)
#pragma unroll
                        for (int i = 0; i < 16; ++i) { const int key = 32 * (2 * ck + k2) + (i & 3) + 8 * (i >> 2) + 4 * half; const int n = qrel - key;
                            const float bias = LUT[n < 0 ? 0 : (n > 128 ? 128 : n)];
                            const float s = (n < 0) ? -1e30f : sacc[k2][i] + bias; sacc[k2][i] = s; mx = fmaxf(mx, s); }
                } else {
#pragma unroll
                    for (int k2 = 0; k2 < 2; ++k2)
#pragma unroll
                        for (int i = 0; i < 16; ++i) { const float s = sacc[k2][i] + bfar; sacc[k2][i] = s; mx = fmaxf(mx, s); }
                }
                mx = fmaxf(mx, __shfl_xor(mx, 32));
                const float mnew = fmaxf(mrun, mx); const float alpha = __expf(mrun - mnew); mrun = mnew;
                lsum *= alpha;
#pragma unroll
                for (int i = 0; i < 16; ++i) { oacc[0][i] *= alpha; oacc[1][i] *= alpha; }
#pragma unroll
                for (int k2 = 0; k2 < 2; ++k2) { const int kt = 2 * ck + k2;
#pragma unroll
                    for (int i = 0; i < 16; ++i) { const float p = __expf(sacc[k2][i] - mnew); sacc[k2][i] = p; lsum += p; }
#pragma unroll
                    for (int cc = 0; cc < 2; ++cc) {
                        u32x4 pw; pw.x = pk2(sacc[k2][8 * cc], sacc[k2][8 * cc + 1]); pw.y = pk2(sacc[k2][8 * cc + 2], sacc[k2][8 * cc + 3]); pw.z = pk2(sacc[k2][8 * cc + 4], sacc[k2][8 * cc + 5]); pw.w = pk2(sacc[k2][8 * cc + 6], sacc[k2][8 * cc + 7]);
                        const bf16x8 pf = __builtin_bit_cast(bf16x8, pw);
                        const int key0 = 32 * kt + 16 * cc + 4 * half;
#pragma unroll
                        for (int dt = 0; dt < 2; ++dt) { const LAS unsigned char* vb = Vt + (32 * dt + qi) * VT_PITCH + key0 * 2;
                            const u32x2 va = *(const LAS u32x2*)vb, vb2 = *(const LAS u32x2*)(vb + 16);
                            u32x4 vw; vw.x = va.x; vw.y = va.y; vw.z = vb2.x; vw.w = vb2.y;
                            oacc[dt] = __builtin_amdgcn_mfma_f32_32x32x16_bf16(__builtin_bit_cast(bf16x8, vw), pf, oacc[dt], 0, 0, 0); } } }
            }
            const float mx = mrun;
            lsum += __shfl_xor(lsum, 32);
            const float inv = 1.0f / lsum;
            if (valid) {
                bf16_t* op = PO + ((size_t)slot * T + tok) * CW + h * 64;
#pragma unroll
                for (int dt = 0; dt < 2; ++dt)
#pragma unroll
                    for (int ig = 0; ig < 4; ++ig) { u32x2 w; w.x = pk2(oacc[dt][4 * ig] * inv, oacc[dt][4 * ig + 1] * inv); w.y = pk2(oacc[dt][4 * ig + 2] * inv, oacc[dt][4 * ig + 3] * inv);
                        *(u32x2*)(op + 32 * dt + 8 * ig + 4 * half) = w; }
                if (half == 0) PST[((size_t)slot * T + tok) * 8 + h] = (f32x2){mx, lsum};
            }
        }
    }
}
DI void phase_moba_combine(Frame& F) {
    const bf16_t* PO = (const bf16_t*)(F.wsp() + WS_PO); const f32x2* PST = (const f32x2*)(F.wsp() + WS_PST); const unsigned* SEL = (const unsigned*)(F.wsp() + WS_SEL);
    bf16_t* YM = (bf16_t*)(F.wsp() + WS_YRM) + 512;
    int tid = F.tid;
    for (int tb = F.bid * 16; tb < T; tb += F.G * 16) {
        int tbase = tb; asm volatile("" : "+s"(tbase), "+v"(tid));
        const int c0 = (tid & 63) * 8, h = c0 >> 6;
        int nv[2]; f32x2 st[2][4]; u32x4 po[2][4];
#pragma unroll
        for (int e = 0; e < 2; ++e) { const int t = tbase + 8 * e + (tid >> 6); nv[e] = (int)(SEL[(size_t)t * 8 + h] >> 24);
#pragma unroll
            for (int s = 0; s < 4; ++s) { st[e][s] = PST[((size_t)s * T + t) * 8 + h]; po[e][s] = *(const u32x4*)(PO + ((size_t)s * T + t) * CW + c0); } }
#pragma unroll
        for (int e = 0; e < 2; ++e) { const int t = tbase + 8 * e + (tid >> 6); float M = -1e30f;
#pragma unroll
            for (int s = 0; s < 4; ++s) { const bool on = (s == 3) || (s < nv[e]); if (on) M = fmaxf(M, st[e][s].x); }
            float den = 0.f, num[8];
#pragma unroll
            for (int j = 0; j < 8; ++j) num[j] = 0.f;
#pragma unroll
            for (int s = 0; s < 4; ++s) { const bool on = (s == 3) || (s < nv[e]); if (on) { const float w = st[e][s].y * __expf(st[e][s].x - M); den += w;
                    num[0] += w * bflo(po[e][s].x); num[1] += w * bfhi(po[e][s].x); num[2] += w * bflo(po[e][s].y); num[3] += w * bfhi(po[e][s].y);
                    num[4] += w * bflo(po[e][s].z); num[5] += w * bfhi(po[e][s].z); num[6] += w * bflo(po[e][s].w); num[7] += w * bfhi(po[e][s].w); } }
            const float inv = __builtin_amdgcn_rcpf(den);
            u32x4 o; o.x = pk2(num[0] * inv, num[1] * inv); o.y = pk2(num[2] * inv, num[3] * inv); o.z = pk2(num[4] * inv, num[5] * inv); o.w = pk2(num[6] * inv, num[7] * inv);
            *(u32x4*)(YM + (size_t)t * YRM_LD + c0) = o; }
    }
}
DI void phase_router(Frame& F, int l) {
    LAS float* xs = (LAS float*)F.lds;
    LAS float* wsm = xs + 64 * 129;
    LAS float* lgt = wsm + 128 * 36;
    LAS float* ssq = lgt + 64 * 37;
    LAS int* hist = (LAS int*)(ssq + 64);
    const float* x = F.outp(); const float* gain = F.inp(2) + (size_t)l * DM;
    const float* wgrp = F.inp(29) + (size_t)l * DM * 4; const float* wexp = F.inp(31) + (size_t)l * DM * 32;
    const float* bgrp = F.inp(30) + l * 4; const float* bexp = F.inp(32) + l * 32;
    int* EID = (int*)(F.wsp() + WS_RT + RT_EID); float* GATE = (float*)(F.wsp() + WS_RT + RT_GATE); int* HIST = (int*)(F.wsp() + WS_RT + RT_HIST);
    const int tok = F.tid & 63, jg = F.tid >> 6;
    for (int tile = F.bid; tile < T / 64; tile += F.G) {
        const int t0 = tile * 64;
        float acc[5] = {0.f, 0.f, 0.f, 0.f, 0.f}; float ss = 0.f;
        if (F.tid < 32) hist[F.tid] = 0;
        for (int kc = 0; kc < DM; kc += 128) {
            __syncthreads();
            for (int idx = F.tid; idx < 64 * 128; idx += 512) { const int r = idx >> 7, k = idx & 127; xs[r * 129 + k] = x[(size_t)(t0 + r) * DM + kc + k]; }
            for (int idx = F.tid; idx < 128 * 36; idx += 512) { const int k = idx / 36, j = idx - k * 36; const float g = gain[kc + k];
                wsm[idx] = g * (j < 4 ? wgrp[(size_t)(kc + k) * 4 + j] : wexp[(size_t)(kc + k) * 32 + (j - 4)]); }
            __syncthreads();
            for (int k = 0; k < 128; ++k) { const float xv = xs[tok * 129 + k]; ss += xv * xv;
#pragma unroll
                for (int i = 0; i < 5; ++i) { const int j = jg + 8 * i; if (j < 36) acc[i] += xv * wsm[k * 36 + j]; } }
        }
#pragma unroll
        for (int i = 0; i < 5; ++i) { const int j = jg + 8 * i; if (j < 36) lgt[tok * 37 + j] = acc[i]; }
        if (jg == 0) ssq[tok] = ss;
        __syncthreads();
        if (F.tid < 64) {
            const int t = t0 + F.tid; const float rs = 1.0f / sqrtf(ssq[F.tid] * (1.f / DM) + 1e-6f);
            float lg[4]; int gs = 0; float gm = -INFINITY;
#pragma unroll
            for (int g = 0; g < 4; ++g) { lg[g] = lgt[F.tid * 37 + g] * rs + bgrp[g]; if (lg[g] > gm) { gm = lg[g]; gs = g; } }
            float gden = 0.f;
#pragma unroll
            for (int g = 0; g < 4; ++g) gden += expf(lg[g] - gm);
            const float ptop = 1.0f / gden;
            float le[8]; float e0 = -INFINITY, e1 = -INFINITY; int j0 = 0, j1 = 1;
#pragma unroll
            for (int e = 0; e < 8; ++e) { le[e] = lgt[F.tid * 37 + 4 + gs * 8 + e] * rs + bexp[gs * 8 + e];
                if (le[e] > e0) { e1 = e0; j1 = j0; e0 = le[e]; j0 = e; } else if (le[e] > e1) { e1 = le[e]; j1 = e; } }
            const float p1 = expf(e1 - e0);
            const float g0 = ptop / (1.f + p1), g1 = ptop * p1 / (1.f + p1);
            const int ex0 = gs * 8 + j0, ex1 = gs * 8 + j1;
            EID[t * 2] = ex0; EID[t * 2 + 1] = ex1; GATE[t * 2] = g0; GATE[t * 2 + 1] = g1;
            __hip_atomic_fetch_add(&hist[ex0], 1, __ATOMIC_RELAXED, __HIP_MEMORY_SCOPE_WORKGROUP); __hip_atomic_fetch_add(&hist[ex1], 1, __ATOMIC_RELAXED, __HIP_MEMORY_SCOPE_WORKGROUP);
        }
        __syncthreads();
        if (F.tid < 32) HIST[tile * 32 + F.tid] = hist[F.tid];
        __syncthreads();
    }
}
DI void phase_moe_gather(Frame& F, int l) {
    LAS int* tot = (LAS int*)F.lds; LAS int* off = tot + 32; LAS int* base = off + 32; LAS int* eidl = base + 32; LAS int* rowl = eidl + 128; LAS int* ps = rowl + 128; LAS int* po = ps + 512;
    const int* EID = (const int*)(F.wsp() + WS_RT + RT_EID); const float* GATE = (const float*)(F.wsp() + WS_RT + RT_GATE); const int* HIST = (const int*)(F.wsp() + WS_RT + RT_HIST);
    int* ROW = (int*)(F.wsp() + WS_RT + RT_ROW); float* GW = (float*)(F.wsp() + WS_RT + RT_GW); int* PEXP = (int*)(F.wsp() + WS_RT + RT_PEXP);
    int* TOK = (int*)(F.wsp() + WS_RT + RT_TOK); const float* RSQ = (const float*)(F.wsp() + WS_RT + RT_RSQ); float* RSR = (float*)(F.wsp() + WS_RT + RT_RSR);
    for (int tile = F.bid; tile < T / 64; tile += F.G) {
        const int t0 = tile * 64;
        __syncthreads();
        { const int e = F.tid & 31, part = F.tid >> 5; int s = 0, o = 0;
#pragma unroll 8
          for (int i = part * 32; i < part * 32 + 32; ++i) { const int v = HIST[i * 32 + e]; s += v; if (i < tile) o += v; }
          ps[F.tid] = s; po[F.tid] = o; }
        if (F.tid < 128) eidl[F.tid] = EID[t0 * 2 + F.tid];
        __syncthreads();
        if (F.tid < 32) { int s = 0, o = 0;
#pragma unroll
            for (int p = 0; p < 16; ++p) { s += ps[p * 32 + F.tid]; o += po[p * 32 + F.tid]; } tot[F.tid] = s; off[F.tid] = o; }
        __syncthreads();
        if (F.tid == 0) {
            int bs = 0; for (int e = 0; e < 32; ++e) { base[e] = bs; bs += (tot[e] + 255) & ~255; }
            if (tile == 0) { int p = 0; for (int e = 0; e < 32; ++e) { const int np = (tot[e] + 255) >> 8; for (int i = 0; i < np; ++i) PEXP[p++] = e; } PEXP[MOE_PANELS] = p; }
        }
        __syncthreads();
        if (F.tid < 128) { const int my = eidl[F.tid]; int rank = 0; for (int i = 0; i < F.tid; ++i) rank += (eidl[i] == my) ? 1 : 0;
            const int r = base[my] + off[my] + rank; rowl[F.tid] = r; ROW[t0 * 2 + F.tid] = r; GW[r] = GATE[t0 * 2 + F.tid]; TOK[r] = t0 + (F.tid >> 1); RSR[r] = RSQ[t0 + (F.tid >> 1)]; }
    }
}
DI void phase_moe_combine(Frame& F, int l) {
    const bf16_t* YE = (const bf16_t*)(F.wsp() + WS_YE); const int* ROW = (const int*)(F.wsp() + WS_RT + RT_ROW); bf16_t* XN = (bf16_t*)(F.wsp() + WS_XN);
    const float* gain = F.inp(1) + (size_t)(l + 1 < NLAYER ? l + 1 : l) * DM;
    const int gw = F.bid * 8 + F.wave, NGW = F.G * 8; int lane = F.lane;
    for (int tb = gw * 4; tb < T; tb += NGW * 4) {
        int tbase = tb; asm volatile("" : "+s"(tbase), "+v"(lane));
        int r0[4], r1[4];
#pragma unroll
        for (int e = 0; e < 4; ++e) { r0[e] = ROW[(tbase + e) * 2]; r1[e] = ROW[(tbase + e) * 2 + 1]; }
        u32x2 ya[4][4], yb[4][4]; f32x4 xv[4][4];
#pragma unroll
        for (int e = 0; e < 4; ++e) { const u32x2* y0 = (const u32x2*)(YE + (size_t)r0[e] * DM) + lane; const u32x2* y1 = (const u32x2*)(YE + (size_t)r1[e] * DM) + lane; const f32x4* xr = (const f32x4*)(F.outp() + (size_t)(tbase + e) * DM) + lane;
#pragma unroll
            for (int j = 0; j < 4; ++j) { ya[e][j] = y0[64 * j]; yb[e][j] = y1[64 * j]; xv[e][j] = xr[64 * j]; } }
#pragma unroll
        for (int e = 0; e < 4; ++e) { const int t = tbase + e; f32x4* xr = (f32x4*)(F.outp() + (size_t)t * DM) + lane; float s = 0.f;
#pragma unroll
            for (int j = 0; j < 4; ++j) { f32x4 v = xv[e][j]; const u32x2 a = ya[e][j], b = yb[e][j];
                v.x += bflo(a.x) + bflo(b.x); v.y += bfhi(a.x) + bfhi(b.x); v.z += bflo(a.y) + bflo(b.y); v.w += bfhi(a.y) + bfhi(b.y);
                xv[e][j] = v; xr[64 * j] = v; s += (v.x * v.x + v.y * v.y) + (v.z * v.z + v.w * v.w); }
            if (l + 1 < NLAYER) {
                const float rs = __builtin_amdgcn_rsqf(wave_sum(s) * (1.f / DM) + 1e-6f);
#pragma unroll
                for (int j = 0; j < 4; ++j) { const f32x4 g = ((const f32x4*)gain)[lane + 64 * j]; const f32x4 y = xv[e][j] * rs * g; u32x2 w; w.x = pk2(y.x, y.y); w.y = pk2(y.z, y.w); *((u32x2*)(XN + (size_t)t * DM) + lane + 64 * j) = w; }
            } }
    }
}
constexpr size_t TB_WRH = 512 * 1024, TB_WRL = TB_WRH + 48 * 1024 * 2;
DI void phase_conv_router(Frame& F, int l) {
    bf16_t* WRH = (bf16_t*)(F.wsp() + WS_TAB + TB_WRH); bf16_t* WRL = (bf16_t*)(F.wsp() + WS_TAB + TB_WRL);
    const float* gain = F.inp(2) + (size_t)l * DM; const float* wgrp = F.inp(29) + (size_t)l * DM * 4; const float* wexp = F.inp(31) + (size_t)l * DM * 32;
    for (int idx = F.bid * 512 + F.tid; idx < 48 * DM; idx += F.G * 512) { const int n = idx >> 10, k = idx & 1023;
        float v = (n < 4) ? wgrp[k * 4 + n] : (n < 36) ? wexp[k * 32 + (n - 4)] : 0.f; v *= gain[k];
        const bf16_t h = f2bf(v); WRH[idx] = h; WRL[idx] = f2bf(v - bf2f(h)); }
}
DI void phase_router2(Frame& F, int l) {
    LAS float* lgt = (LAS float*)F.lds + F.wave * 1024;
    LAS int* hist = (LAS int*)(F.lds + 8 * 4096);
    const float* x = F.outp(); const bf16_t* WRH = (const bf16_t*)(F.wsp() + WS_TAB + TB_WRH); const bf16_t* WRL = (const bf16_t*)(F.wsp() + WS_TAB + TB_WRL);
    const float* bgrp = F.inp(30) + l * 4; const float* bexp = F.inp(32) + l * 32;
    int* EID = (int*)(F.wsp() + WS_RT + RT_EID); float* GATE = (float*)(F.wsp() + WS_RT + RT_GATE); int* HIST = (int*)(F.wsp() + WS_RT + RT_HIST);
    const int lane = F.lane, r16 = lane & 15, g = lane >> 4;
    bf16_t* XN2 = (bf16_t*)(F.wsp() + WS_AM); const float* gain = F.inp(2) + (size_t)l * DM; float* RSQ = (float*)(F.wsp() + WS_RT + RT_RSQ);
    { int* TOK = (int*)(F.wsp() + WS_RT + RT_TOK); for (int i = F.bid * 512 + F.tid; i < MOE_ROWS; i += F.G * 512) TOK[i] = 0; }
    for (int task = F.bid; task < T / 128; task += F.G) {
        const int t0 = task * 128 + F.wave * 16;
        __syncthreads();
        if (F.tid < 64) hist[F.tid] = 0;
        __syncthreads();
        f32x4 acc[3];
#pragma unroll
        for (int nt = 0; nt < 3; ++nt) acc[nt] = (f32x4){0.f, 0.f, 0.f, 0.f};
        float ss = 0.f;
        const float* xr = x + (size_t)(t0 + r16) * DM + 8 * g; bf16_t* xo = XN2 + (size_t)(t0 + r16) * DM + 8 * g; const float* gp = gain + 8 * g;
#pragma unroll 2
        for (int s = 0; s < 32; ++s) {
            const f32x4 x0 = *(const f32x4*)(xr + 32 * s), x1 = *(const f32x4*)(xr + 32 * s + 4);
            ss += (x0.x * x0.x + x0.y * x0.y) + (x0.z * x0.z + x0.w * x0.w) + (x1.x * x1.x + x1.y * x1.y) + (x1.z * x1.z + x1.w * x1.w);
            { const f32x4 g0 = *(const f32x4*)(gp + 32 * s), g1 = *(const f32x4*)(gp + 32 * s + 4);
              u32x4 w; w.x = pk2(x0.x * g0.x, x0.y * g0.y); w.y = pk2(x0.z * g0.z, x0.w * g0.w); w.z = pk2(x1.x * g1.x, x1.y * g1.y); w.w = pk2(x1.z * g1.z, x1.w * g1.w);
              *(u32x4*)(xo + 32 * s) = w; }
            u32x4 hw, lw; hw.x = pk2(x0.x, x0.y); hw.y = pk2(x0.z, x0.w); hw.z = pk2(x1.x, x1.y); hw.w = pk2(x1.z, x1.w);
            lw.x = pk2(x0.x - bflo(hw.x), x0.y - bfhi(hw.x)); lw.y = pk2(x0.z - bflo(hw.y), x0.w - bfhi(hw.y)); lw.z = pk2(x1.x - bflo(hw.z), x1.y - bfhi(hw.z)); lw.w = pk2(x1.z - bflo(hw.w), x1.w - bfhi(hw.w));
            const bf16x8 ah = __builtin_bit_cast(bf16x8, hw), al = __builtin_bit_cast(bf16x8, lw);
#pragma unroll
            for (int nt = 0; nt < 3; ++nt) { const size_t wo = (size_t)(16 * nt + r16) * DM + 32 * s + 8 * g;
                const bf16x8 bh = *(const bf16x8*)(WRH + wo), bl = *(const bf16x8*)(WRL + wo);
                acc[nt] = mfma16(ah, bh, acc[nt]); acc[nt] = mfma16(ah, bl, acc[nt]); acc[nt] = mfma16(al, bh, acc[nt]); }
        }
        ss += __shfl_xor(ss, 16); ss += __shfl_xor(ss, 32);
        if (g == 0) RSQ[t0 + r16] = __builtin_amdgcn_rsqf(ss * (1.f / DM) + 1e-6f);
#pragma unroll
        for (int nt = 0; nt < 3; ++nt)
#pragma unroll
            for (int r = 0; r < 4; ++r) lgt[(4 * g + r) * 48 + 16 * nt + r16] = acc[nt][r];
        if (g == 0) lgt[768 + r16] = ss;
        LDS_WAIT(); asm volatile("" ::: "memory");
        if (lane < 16) {
            const int t = t0 + lane; const float rs = 1.0f / sqrtf(lgt[768 + lane] * (1.f / DM) + 1e-6f); const LAS float* lr = lgt + lane * 48;
            float lg[4]; int gs = 0; float gm = -INFINITY;
#pragma unroll
            for (int q = 0; q < 4; ++q) { lg[q] = lr[q] * rs + bgrp[q]; if (lg[q] > gm) { gm = lg[q]; gs = q; } }
            float gden = 0.f;
#pragma unroll
            for (int q = 0; q < 4; ++q) gden += expf(lg[q] - gm);
            const float ptop = 1.0f / gden;
            float e0 = -INFINITY, e1 = -INFINITY; int j0 = 0, j1 = 1;
#pragma unroll
            for (int e = 0; e < 8; ++e) { const float le = lr[4 + gs * 8 + e] * rs + bexp[gs * 8 + e];
                if (le > e0) { e1 = e0; j1 = j0; e0 = le; j0 = e; } else if (le > e1) { e1 = le; j1 = e; } }
            const float p1 = expf(e1 - e0);
            const float g0 = ptop / (1.f + p1), g1 = ptop * p1 / (1.f + p1);
            const int ex0 = gs * 8 + j0, ex1 = gs * 8 + j1;
            EID[t * 2] = ex0; EID[t * 2 + 1] = ex1; GATE[t * 2] = g0; GATE[t * 2 + 1] = g1;
            LAS int* hh = hist + (F.wave >> 2) * 32;
            __hip_atomic_fetch_add(&hh[ex0], 1, __ATOMIC_RELAXED, __HIP_MEMORY_SCOPE_WORKGROUP); __hip_atomic_fetch_add(&hh[ex1], 1, __ATOMIC_RELAXED, __HIP_MEMORY_SCOPE_WORKGROUP);
        }
        __syncthreads();
        if (F.tid < 64) HIST[(task * 2 + (F.tid >> 5)) * 32 + (F.tid & 31)] = hist[F.tid];
    }
}
#ifndef MK_PER_PHASE_LAUNCH
#define MK_PER_PHASE_LAUNCH 0
#endif
constexpr int PH_PER_LAYER = 19, NPHASE = PH_PER_LAYER * NLAYER;
struct Args { const float* in[36]; float* out; unsigned char* ws; int ph_lo, ph_hi; };

#ifndef SCAN_NAIVE
#define SCAN_NAIVE 0
#endif
#ifndef PHMASK
#define PHMASK 0x7ffff
#endif
#ifndef DUPMASK
#define DUPMASK 0
#endif
#define NREP(k) ((((DUPMASK) >> (k)) & 1) ? 2 : 1)
#define IN(k) (((PHMASK >> ((k) % PH_PER_LAYER)) & 1) && lo <= (k) && (k) < hi)
#define SEAM(k) do { asm volatile("" : "+s"(barp), "+s"(bar.x)); bar.bar = (unsigned*)barp; if (IN(k) && IN((k) + 1)) xcd_barrier(bar); asm volatile("" : "+s"(F.ws_g), "+s"(F.out_g), "+s"(F.ka), "+s"(F.bid), "+s"(F.G), "+s"(F.lds)); } while (0)
#define FRESH() do { asm volatile("" : "+s"(F.wave)); int l_ = (int)__builtin_amdgcn_mbcnt_hi(~0u, __builtin_amdgcn_mbcnt_lo(~0u, 0u)); asm volatile("" : "+v"(l_)); F.lane = l_; F.tid = F.wave * 64 + l_; } while (0)
__global__ void __launch_bounds__(512, 2) fwd_kernel(Args args) {
    extern __shared__ __attribute__((aligned(16))) unsigned char lds_raw[];
    Frame F;
    F.lds = (LAS unsigned char*)lds_raw;
    F.tid = threadIdx.x; F.lane = F.tid & 63; F.wave = __builtin_amdgcn_readfirstlane(F.tid >> 6);
    F.G = gridDim.x; F.bid = blockIdx.x;
    F.ka = (const __attribute__((address_space(4))) unsigned char*)__builtin_amdgcn_kernarg_segment_ptr();
    F.out_g = (GAS float*)args.out; F.ws_g = (GAS unsigned char*)args.ws;
    volatile LAS unsigned* MISC = (volatile LAS unsigned*)(F.lds + MISC_OFF);
    if (F.tid < 32) MISC[F.tid] = 0u;
    __syncthreads();
    const int lo = args.ph_lo, hi = args.ph_hi;
    GAS unsigned* barp = (GAS unsigned*)(F.ws_g + WS_CTL) + CW_BAR;
    XcdBarrier bar; bar.bar = (unsigned*)barp; bar.x = 0; bar.st = nullptr;
    if (hi - lo > 1) bar = xcd_barrier_post((unsigned*)barp, MISC + 8);

    bf16_t* const XN = (bf16_t*)(F.wsp() + WS_XN);
    bf16_t* const WCAT = (bf16_t*)(F.wsp() + WS_WM + WM_WCAT);
    for (int l = 0; l < NLAYER; ++l) {
        const int P = l * PH_PER_LAYER;
#define PHASE(k) if (IN(P + (k))) for (int rep_ = 0; rep_ < NREP(k); ++rep_)
        PHASE(0) { FRESH(); if (l == 0) { phase_conv_mixer(F, 0); phase_conv_lora2(F, 0); phase_conv_router(F, 0); phase_norm_x(F, F.inp(0), F.inp(1)); } }
        if (l == 0) SEAM(P + 0);
#if defined(XTRA_BARS)
        if (hi - lo > 1) for (int xb_ = 0; xb_ < XTRA_BARS; ++xb_) { asm volatile("" : "+s"(barp), "+s"(bar.x)); bar.bar = (unsigned*)barp; xcd_barrier(bar); }
#endif
        PHASE(1) { FRESH(); const int n1 = (l == 0) ? 2048 : 2304;
            pg8::Gemm g{XN, WCAT, T, n1, DM}; pg8::StaticOrder S; S.init(T, n1, F.G, F.bid);
            pg8::EpiStore E{(bf16_t*)(F.wsp() + WS_RW), 1536, 1536, (bf16_t*)(F.wsp() + WS_LO), LO_W, 0};
            pg8::gemm_phase<pg8::EpiStore, pg8::StaticOrder>(F.lds, g, S, E, F.tid); }
        SEAM(P + 1);
        PHASE(2) { FRESH(); phase_prep_scana(F, l); }
        SEAM(P + 2);
        PHASE(4) { FRESH(); if (F.bid < NB * NH && F.G > 2 * NB * NH) phase_scan_b(F, l); else if (F.G > 2 * NB * NH) phase_scan_c(F, l, NB * NH); else {   } }
        SEAM(P + 5);
        PHASE(6) { FRESH(); pg8::Gemm g{XN, WCAT + (size_t)2304 * DM, T, 1536, DM}; pg8::StaticOrder S; S.init(T, 1536, F.G, F.bid);
            pg8::EpiMoba E{(bf16_t*)(F.wsp() + WS_MO), F.inp(23) + l * 64, F.inp(24) + l * 64, (float*)(F.wsp() + WS_TAB + TB_KMEAN), (int)(TB_KMEAN2 / 4)};
            pg8::gemm_phase<pg8::EpiMoba, pg8::StaticOrder>(F.lds, g, S, E, F.tid); }
        SEAM(P + 6);
        PHASE(8) { FRESH(); phase_moba_gate(F); }
        SEAM(P + 8);
        PHASE(9) { FRESH(); phase_moba_attn(F, l); }
        SEAM(P + 9);
        PHASE(10) { FRESH(); phase_moba_combine(F); }
        SEAM(P + 10);
        PHASE(11) { FRESH(); pg8::Gemm g{XN, WCAT + (size_t)3840 * DM, T, 2048, DM}; pg8::StaticOrder S; S.init(T, 2048, F.G, F.bid);
            pg8::EpiStore E{(bf16_t*)(F.wsp() + WS_GA), 2048, 0, nullptr, 0, 1};
            pg8::gemm_phase<pg8::EpiStore, pg8::StaticOrder>(F.lds, g, S, E, F.tid); }
        SEAM(P + 11);
        PHASE(12) { FRESH(); pg8::Gemm g{(const bf16_t*)(F.wsp() + WS_YRM), (const bf16_t*)(F.wsp() + WS_WM + WM_BRR), T, DM, DM}; pg8::StaticOrder S; S.init(T, DM, F.G, F.bid);
            pg8::EpiBranch2 E{(bf16_t*)(F.wsp() + WS_H), (const bf16_t*)(F.wsp() + WS_GA)};
            pg8::gemm_phase<pg8::EpiBranch2, pg8::StaticOrder>(F.lds, g, S, E, F.tid); }
        SEAM(P + 12);
        PHASE(13) { FRESH(); pg8::Gemm g{(const bf16_t*)(F.wsp() + WS_H), (const bf16_t*)(F.wsp() + WS_WM + WM_OUT), T, DM, DM}; pg8::StaticOrder S; S.init(T, DM, F.G, F.bid);
            pg8::EpiResid E{l == 0 ? F.inp(0) : F.outp(), F.outp()};
            pg8::gemm_phase<pg8::EpiResid, pg8::StaticOrder>(F.lds, g, S, E, F.tid); }
        SEAM(P + 13);
        PHASE(14) { FRESH(); phase_router2(F, l); }
        SEAM(P + 14);
        PHASE(15) { FRESH(); phase_moe_gather(F, l); }
        SEAM(P + 15);
        PHASE(16) { FRESH(); const int* PEXP = (const int*)(F.wsp() + WS_RT + RT_PEXP); const int np = __builtin_amdgcn_readfirstlane(PEXP[MOE_PANELS]);
            pg8::Gemm g{(const bf16_t*)(F.wsp() + WS_AM), (const bf16_t*)(F.wsp() + WS_WE), np * 256, 1024, DM}; pg8::GatherOrder S; S.init(np * 256, 1024, F.G, F.bid); S.pexp = PEXP;
            LAS int* tokL = (LAS int*)(F.lds + RING_BYTES); S.tokL = tokL;
            { const int* TOK = (const int*)(F.wsp() + WS_RT + RT_TOK); __syncthreads();
              for (int i = 0; i < 16; ++i) { pg8::Unit uu; if (!S.next(i, uu)) break; if (F.tid < 256) tokL[i * 256 + F.tid] = TOK[uu.pm * 256 + F.tid]; }
              __syncthreads(); }
            pg8::EpiExpertUp E{(bf16_t*)(F.wsp() + WS_HM), (const float*)(F.wsp() + WS_RT + RT_GW), (const float*)(F.wsp() + WS_RT + RT_RSR)};
            pg8::gemm_phase<pg8::EpiExpertUp, pg8::GatherOrder>(F.lds, g, S, E, F.tid); }
        SEAM(P + 16);
        PHASE(17) { FRESH(); const int* PEXP = (const int*)(F.wsp() + WS_RT + RT_PEXP); const int np = __builtin_amdgcn_readfirstlane(PEXP[MOE_PANELS]);
            pg8::Gemm g{(const bf16_t*)(F.wsp() + WS_HM), (const bf16_t*)(F.wsp() + WS_WD), np * 256, 1024, DEXP}; pg8::GroupOrder S; S.init(np * 256, 1024, F.G, F.bid); S.pexp = PEXP;
            pg8::EpiStore E{(bf16_t*)(F.wsp() + WS_YE), 1024, 0, nullptr, 0, 0};
            pg8::gemm_phase<pg8::EpiStore, pg8::GroupOrder>(F.lds, g, S, E, F.tid); }
        SEAM(P + 17);
        PHASE(18) { FRESH(); phase_moe_combine(F, l); if (l + 1 < NLAYER) { phase_conv_mixer(F, l + 1); phase_conv_lora2(F, l + 1); phase_conv_router(F, l + 1); } }
        SEAM(P + 18);
#undef PHASE
    }
}

extern "C" void kernel_launch(void* const* d_in, const int* in_sizes, int n_in, void* d_out, int out_size, void* d_ws, size_t ws_size, hipStream_t stream) {
    static int grid = 0;
    if (grid == 0) {
        if (n_in != 36 || out_size != T * DM || ws_size < WS_NEED) { fprintf(stderr, "kernel_launch: unexpected problem (n_in %d, out %d, ws %zu); nothing launched\n", n_in, out_size, ws_size); grid = -1; return; }
        int dev = 0, cus = 0;
        if (hipGetDevice(&dev) != hipSuccess || hipDeviceGetAttribute(&cus, hipDeviceAttributeMultiprocessorCount, dev) != hipSuccess) { grid = -1; return; }
        if (hipFuncSetAttribute((const void*)fwd_kernel, hipFuncAttributeMaxDynamicSharedMemorySize, LDS_BYTES) != hipSuccess) { fprintf(stderr, "kernel_launch: hipFuncSetAttribute failed\n"); grid = -1; return; }
        int per_cu = 0;
        if (hipOccupancyMaxActiveBlocksPerMultiprocessor(&per_cu, (const void*)fwd_kernel, 512, LDS_BYTES) != hipSuccess || per_cu < 1) { fprintf(stderr, "kernel_launch: occupancy query says %d\n", per_cu); }
        (void)hipGetLastError();
        grid = cus;
    }
    if (grid < 0) return;
    (void)hipMemsetAsync((char*)d_ws + WS_CTL, 0, CTL_ZERO_BYTES, stream);
    Args a{};
    for (int i = 0; i < 36; ++i) a.in[i] = (const float*)d_in[i];
    a.out = (float*)d_out; a.ws = (unsigned char*)d_ws;
#if MK_PER_PHASE_LAUNCH
    for (int ph = 0; ph < NPHASE; ++ph) { if (ph == PH_PER_LAYER) continue; a.ph_lo = ph; a.ph_hi = ph + 1; hipLaunchKernelGGL(fwd_kernel, dim3(grid), dim3(512), LDS_BYTES, stream, a); }
#else
    a.ph_lo = 0; a.ph_hi = NPHASE;
    hipLaunchKernelGGL(fwd_kernel, dim3(grid), dim3(512), LDS_BYTES, stream, a);
#endif
}
```

```cpp
#include <hip/hip_runtime.h>
#include <cstdio>
#include <cstdint>
#define LAS __attribute__((address_space(3)))
#define GAS __attribute__((address_space(1)))
#define DI __device__ __forceinline__
typedef unsigned short bf16_t;
typedef short bf16x8 __attribute__((ext_vector_type(8)));
typedef short s16x4 __attribute__((ext_vector_type(4)));
typedef float f32x4 __attribute__((ext_vector_type(4)));
typedef float f32x2 __attribute__((ext_vector_type(2)));
typedef float f32x16 __attribute__((ext_vector_type(16)));
typedef unsigned u32x4 __attribute__((ext_vector_type(4)));
typedef unsigned u32x2 __attribute__((ext_vector_type(2)));
typedef __bf16 bf16v2 __attribute__((ext_vector_type(2)));

DI unsigned pk2(float lo, float hi) { f32x2 v = {lo, hi}; return __builtin_bit_cast(unsigned, __builtin_convertvector(v, bf16v2)); }
DI bf16_t f2bf(float f) { return (bf16_t)(pk2(f, 0.f) & 0xffffu); }
DI float bf2f(bf16_t b) { return __uint_as_float(((unsigned)b) << 16); }
DI float bflo(unsigned w) { return __uint_as_float(w << 16); }
DI float bfhi(unsigned w) { return __uint_as_float(w & 0xffff0000u); }
DI float rcpf_(float x) { return __builtin_amdgcn_rcpf(x); }
DI float sigmoidf_(float x) { return __builtin_amdgcn_rcpf(1.0f + __expf(-x)); }

template <int CTRL> DI float dpp_mov(float v) { return __builtin_bit_cast(float, __builtin_amdgcn_update_dpp(0, __builtin_bit_cast(int, v), CTRL, 0xf, 0xf, true)); }
DI float rdlane(float v, int l) { return __builtin_bit_cast(float, __builtin_amdgcn_readlane(__builtin_bit_cast(int, v), l)); }
DI float wave_sum(float v) {
    v += dpp_mov<0xB1>(v);
    v += dpp_mov<0x4E>(v);
    v += dpp_mov<0x141>(v);
    v += dpp_mov<0x140>(v);
    return (rdlane(v, 0) + rdlane(v, 16)) + (rdlane(v, 32) + rdlane(v, 48));
}
DI f32x4 mfma16(bf16x8 a, bf16x8 b, f32x4 c) { return __builtin_amdgcn_mfma_f32_16x16x32_bf16(a, b, c, 0, 0, 0); }
namespace pg8 {
constexpr int BM = 256, BK = 64, HALF = 128, HTB = HALF * BK * 2  , STAGE_BYTES = 8 * HTB, NXCD = 8, WGM = 8;

__host__ __device__ __forceinline__ int lds_byte(int r, int c) { const int st = (r >> 4) * 2 + (c >> 5), rr = r & 15, cc = c & 31, ob = rr * 64 + cc * 2; return st * 1024 + (ob ^ (((ob >> 9) & 1) << 5)); }
__host__ __device__ __forceinline__ void stage_rc(int b, int& R, int& C) { const int st = b / 1024, sb = b % 1024, swz = sb ^ (((sb >> 9) & 1) << 5); R = (st >> 1) * 16 + swz / 64; C = (st & 1) * 32 + (swz % 64) / 2; }
__host__ __device__ __forceinline__ int perm32(int rho) { const int n = rho >> 4, i = rho & 15; return 8 * (i >> 2) + 4 * n + (i & 3); }

struct Unit { int pm, pn, pb; };
struct Gemm { const bf16_t* A; const bf16_t* Bt; int M, N, K; };

struct StaticOrder {
    static constexpr bool GATHER = false;
    int nM, nN, nwg, G, c;
    __device__ __forceinline__ void init(int M, int N, int G_, int c_) { nM = M / BM; nN = N / BM; nwg = nM * nN; G = G_; c = c_; }
    __device__ __forceinline__ bool next(int i, Unit& u) const {
        const long L = (long)i * G + c; if (L >= nwg) return false;
        int wgid = (int)L; { const int q = nwg / NXCD, r = nwg % NXCD, xcd = wgid % NXCD, off = wgid / NXCD; wgid = (xcd < r ? xcd * (q + 1) : r * (q + 1) + (xcd - r) * q) + off; }
        const int nig = WGM * nN, gid = wgid / nig, fm = gid * WGM, gsz = (nM - fm) < WGM ? (nM - fm) : WGM;
        u.pm = fm + ((wgid % nig) % gsz); u.pn = (wgid % nig) / gsz; u.pb = u.pn; return true;
    }
};
struct GroupOrder : StaticOrder {
    const int* pexp;
    __device__ __forceinline__ bool next(int i, Unit& u) const {
        if (!StaticOrder::next(i, u)) return false;
        u.pb = __builtin_amdgcn_readfirstlane(pexp[u.pm]) * nN + u.pn; return true;
    }
};
struct GatherOrder : GroupOrder {
    static constexpr bool GATHER = true;
    const LAS int* tokL;
};

template <class Epi, class Sched, bool ALIGN_EPI = true, bool SP2 = true>
__device__ __forceinline__ void gemm_phase(LAS unsigned char* lds, const Gemm g, const Sched& S, const Epi& E, int tid_in) {
    const int tid = tid_in, wid = __builtin_amdgcn_readfirstlane(tid >> 6), lane = tid & 63, wr = wid >> 2, wc = wid & 3, fr = lane & 15, fq = lane >> 4;
    const int K = g.K, nt = K / BK;
    unsigned voffA[2], voffB[2];
#pragma unroll
    for (int i = 0; i < 2; ++i) { int R, C; stage_rc(tid * 16 + i * 8192, R, C); const int Rb = Epi::HEADS ? (64 * (R >> 5) + perm32(R & 31)) : Epi::PERM ? ((R & ~31) + perm32(R & 31)) : R;
        voffA[i] = (unsigned)(R * K + C) * 2u; voffB[i] = (unsigned)(Rb * K + C) * 2u; }
    unsigned goff[2][2] = {{0u, 0u}, {0u, 0u}}, goffN[2][2] = {{0u, 0u}, {0u, 0u}};
#define PG8_GOFF(dst, ui_) do { if constexpr (Sched::GATHER) { _Pragma("unroll") for (int h_ = 0; h_ < 2; ++h_) _Pragma("unroll") for (int i_ = 0; i_ < 2; ++i_) { int R_, C_; stage_rc(tid * 16 + i_ * 8192, R_, C_); \
        const int tk_ = S.tokL[(ui_) * 256 + 128 * h_ + R_]; dst[h_][i_] = (unsigned)(tk_ * K + C_) * 2u; } } } while (0)
#define PG8_STAGE_A(bufoff, kt, h, usenext) do { if constexpr (Sched::GATHER) { unsigned vo_[2] = { (usenext) ? goffN[h][0] : goff[h][0], (usenext) ? goffN[h][1] : goff[h][1] }; PG8_STAGE(bufoff, kt, vo_); } \
        else { PG8_STAGE(bufoff, (kt) + ((h) ? hstep : 0), voffA); } } while (0)
    const size_t kstep = (size_t)(BK * 2);
    const size_t hstep = (size_t)HALF * K * 2;
    const size_t hstepB = Epi::HEADS ? (size_t)32 * K * 2 : hstep;
    const size_t tstep = 2 * hstep;
    const unsigned ldsw = (unsigned)wid * 1024u;
    const int aoff = lds_byte(wr * 64 + fr, fq * 8), boff = lds_byte(wc * 32 + fr, fq * 8);
#define PG8_SA(b, h) (((b) * 2 + (h)) * HTB)
#define PG8_SB(b, h) ((4 + (b) * 2 + (h)) * HTB)
#define PG8_STAGE(bufoff, gbase, voff) do { _Pragma("unroll") for (int _i = 0; _i < 2; ++_i) \
        __builtin_amdgcn_global_load_lds((const unsigned*)((const char*)(gbase) + (voff)[_i]), (LAS unsigned*)(lds + (bufoff) + ldsw + _i * 8192), 16, 0, 0); } while (0)
#define PG8_LDA(dst, b, h) do { _Pragma("unroll") for (int m = 0; m < 4; ++m) _Pragma("unroll") for (int k = 0; k < 2; ++k) dst[m][k] = *(const LAS bf16x8*)(lds + PG8_SA(b, h) + aoff + m * 2048 + k * 1024); } while (0)
#define PG8_LDB(dst, b, h) do { _Pragma("unroll") for (int n = 0; n < 2; ++n) _Pragma("unroll") for (int k = 0; k < 2; ++k) dst[n][k] = *(const LAS bf16x8*)(lds + PG8_SB(b, h) + boff + n * 2048 + k * 1024); } while (0)
#define PG8_MMA(ai, bj, At, Bt) do { __builtin_amdgcn_s_setprio(1); _Pragma("unroll") for (int m = 0; m < 4; ++m) _Pragma("unroll") for (int n = 0; n < 2; ++n) _Pragma("unroll") for (int k = 0; k < 2; ++k) \
        acc[ai][bj][m][n] = __builtin_amdgcn_mfma_f32_16x16x32_bf16(Bt[n][k], At[m][k], acc[ai][bj][m][n], 0, 0, 0); __builtin_amdgcn_s_setprio(0); } while (0)
#define PG8_WAIT_V(n) asm volatile("s_waitcnt vmcnt(" #n ")" ::: "memory")
#define PG8_WAIT_L(n) asm volatile("s_waitcnt lgkmcnt(" #n ")" ::: "memory")
#define PG8_BAR __builtin_amdgcn_s_barrier()
#define PG8_SCHED __builtin_amdgcn_sched_barrier(0)
    Unit cur, nxt; int ui = 0;
    if (!S.next(0, cur)) return;
    f32x4 acc[2][2][4][2];
#pragma unroll
    for (int a = 0; a < 2; ++a)
#pragma unroll
        for (int b = 0; b < 2; ++b)
#pragma unroll
            for (int m = 0; m < 4; ++m)
#pragma unroll
                for (int n = 0; n < 2; ++n) acc[a][b][m][n] = (f32x4){0.f, 0.f, 0.f, 0.f};
    bf16x8 At[4][2], B0[2][2], B1[2][2];
    const char* cA = (const char*)g.A + (Sched::GATHER ? (size_t)0 : (size_t)cur.pm * tstep); const char* cB = (const char*)g.Bt + (size_t)cur.pb * tstep;
    PG8_GOFF(goff, 0);
    if constexpr (SP2) {
        PG8_STAGE(PG8_SB(0, 0), cB, voffB); PG8_STAGE(PG8_SB(0, 1), cB + hstepB, voffB); PG8_STAGE_A(PG8_SA(0, 0), cA, 0, false); PG8_STAGE_A(PG8_SA(0, 1), cA, 1, false);
        if (wr == 1) PG8_BAR;
        PG8_WAIT_V(2); PG8_BAR;
        PG8_STAGE(PG8_SB(1, 0), cB + kstep, voffB); PG8_STAGE_A(PG8_SA(1, 0), cA + kstep, 0, false); PG8_STAGE(PG8_SB(1, 1), cB + hstepB + kstep, voffB);
        PG8_WAIT_V(6); PG8_BAR;
    } else {
        PG8_STAGE(PG8_SB(0, 0), cB, voffB); PG8_STAGE_A(PG8_SA(0, 0), cA, 0, false); PG8_STAGE(PG8_SB(0, 1), cB + hstepB, voffB); PG8_STAGE_A(PG8_SA(0, 1), cA, 1, false);
        if (wr == 1) PG8_BAR;
        PG8_WAIT_V(4); PG8_BAR;
        PG8_STAGE(PG8_SB(1, 0), cB + kstep, voffB); PG8_STAGE_A(PG8_SA(1, 0), cA + kstep, 0, false); PG8_STAGE(PG8_SB(1, 1), cB + hstepB + kstep, voffB);
        PG8_WAIT_V(6); PG8_BAR;
    }
    for (;;) {
        const bool has_next = S.next(ui + 1, nxt);
        const char* nA = (has_next && !Sched::GATHER) ? (const char*)g.A + (size_t)nxt.pm * tstep : cA; const char* nB = has_next ? (const char*)g.Bt + (size_t)nxt.pb * tstep : cB;
        if constexpr (Sched::GATHER) { if (has_next) PG8_GOFF(goffN, ui + 1); else { goffN[0][0] = goff[0][0]; goffN[0][1] = goff[0][1]; goffN[1][0] = goff[1][0]; goffN[1][1] = goff[1][1]; } }
        for (int t = 0; t < nt; t += 2) {
            if constexpr (Epi::HAS_MID) { if (t == nt / 2) E.mid(acc, cur, wr, wc, fr, fq); }
            const bool last = (t == nt - 2);
            const char* a1 = cA + (size_t)(t + 1) * kstep;
            const char* a2 = last ? nA : cA + (size_t)(t + 2) * kstep; const char* b2 = last ? nB : cB + (size_t)(t + 2) * kstep;
            const char* a3 = a2 + kstep; const char* b3 = b2 + kstep;
            if constexpr (SP2) {
            PG8_LDB(B0, 0, 0); PG8_LDB(B1, 0, 1); PG8_SCHED; PG8_LDA(At, 0, 0); PG8_STAGE_A(PG8_SA(1, 1), a1, 1, false);
            PG8_WAIT_V(8); PG8_WAIT_L(0); PG8_BAR; PG8_MMA(0, 0, At, B0); PG8_MMA(0, 1, At, B1); PG8_BAR; PG8_SCHED;
            PG8_LDA(At, 0, 1); PG8_STAGE(PG8_SB(0, 0), b2, voffB); PG8_STAGE(PG8_SB(0, 1), b2 + hstepB, voffB); PG8_STAGE_A(PG8_SA(0, 0), a2, 0, last);
            PG8_WAIT_V(8); PG8_WAIT_L(0); PG8_BAR; PG8_MMA(1, 0, At, B0); PG8_MMA(1, 1, At, B1); PG8_BAR; PG8_SCHED;
            PG8_LDB(B0, 1, 0); PG8_LDB(B1, 1, 1); PG8_SCHED; PG8_LDA(At, 1, 0); PG8_STAGE_A(PG8_SA(0, 1), a2, 1, last);
            PG8_WAIT_V(8); PG8_WAIT_L(0); PG8_BAR; PG8_MMA(0, 0, At, B0); PG8_MMA(0, 1, At, B1); PG8_BAR; PG8_SCHED;
            PG8_LDA(At, 1, 1); PG8_STAGE(PG8_SB(1, 0), b3, voffB); PG8_STAGE(PG8_SB(1, 1), b3 + hstepB, voffB); PG8_STAGE_A(PG8_SA(1, 0), a3, 0, last);
            PG8_WAIT_V(8); PG8_WAIT_L(0); PG8_BAR; PG8_MMA(1, 0, At, B0); PG8_MMA(1, 1, At, B1); PG8_BAR; PG8_SCHED;
            } else {
            PG8_LDB(B0, 0, 0); PG8_SCHED; PG8_LDA(At, 0, 0); PG8_STAGE_A(PG8_SA(1, 1), a1, 1, false);
            PG8_WAIT_L(8); PG8_BAR; PG8_WAIT_L(0); PG8_MMA(0, 0, At, B0); PG8_BAR; PG8_SCHED;
            PG8_LDB(B1, 0, 1); PG8_STAGE(PG8_SB(0, 0), b2, voffB);
            PG8_BAR; PG8_WAIT_L(0); PG8_MMA(0, 1, At, B1); PG8_BAR;
            PG8_LDA(At, 0, 1); PG8_STAGE_A(PG8_SA(0, 0), a2, 0, last);
            PG8_BAR; PG8_WAIT_L(0); PG8_MMA(1, 0, At, B0); PG8_BAR; PG8_SCHED;
            PG8_STAGE(PG8_SB(0, 1), b2 + hstepB, voffB);
            PG8_WAIT_V(6); PG8_BAR; PG8_MMA(1, 1, At, B1); PG8_BAR;
            PG8_LDB(B0, 1, 0); PG8_SCHED; PG8_LDA(At, 1, 0); PG8_STAGE_A(PG8_SA(0, 1), a2, 1, last);
            PG8_WAIT_L(8); PG8_BAR; PG8_WAIT_L(0); PG8_MMA(0, 0, At, B0); PG8_BAR; PG8_SCHED;
            PG8_LDB(B1, 1, 1); PG8_STAGE(PG8_SB(1, 0), b3, voffB);
            PG8_BAR; PG8_WAIT_L(0); PG8_MMA(0, 1, At, B1); PG8_BAR;
            PG8_LDA(At, 1, 1); PG8_STAGE_A(PG8_SA(1, 0), a3, 0, last);
            PG8_BAR; PG8_WAIT_L(0); PG8_MMA(1, 0, At, B0); PG8_BAR; PG8_SCHED;
            PG8_STAGE(PG8_SB(1, 1), b3 + hstepB, voffB);
            PG8_WAIT_V(6); PG8_BAR; PG8_MMA(1, 1, At, B1); PG8_BAR;
            }
        }
        if constexpr (ALIGN_EPI) { if (wr == 0) PG8_BAR; }
        E(acc, cur, wr, wc, fr, fq);
        if (!has_next) break;
#pragma unroll
        for (int a = 0; a < 2; ++a)
#pragma unroll
            for (int b = 0; b < 2; ++b)
#pragma unroll
                for (int m = 0; m < 4; ++m)
#pragma unroll
                    for (int n = 0; n < 2; ++n) acc[a][b][m][n] = (f32x4){0.f, 0.f, 0.f, 0.f};
        cur = nxt; cA = nA; cB = nB; ++ui;
        if constexpr (Sched::GATHER) { goff[0][0] = goffN[0][0]; goff[0][1] = goffN[0][1]; goff[1][0] = goffN[1][0]; goff[1][1] = goffN[1][1]; }
        if constexpr (ALIGN_EPI) { if (wr == 1) PG8_BAR; }
    }
    PG8_WAIT_V(0);
    if constexpr (!ALIGN_EPI) { if (wr == 0) PG8_BAR; }
    PG8_BAR;
#undef PG8_SA
#undef PG8_GOFF
#undef PG8_STAGE_A
#undef PG8_SB
#undef PG8_STAGE
#undef PG8_LDA
#undef PG8_LDB
#undef PG8_MMA
#undef PG8_WAIT_V
#undef PG8_WAIT_L
#undef PG8_BAR
#undef PG8_SCHED
}
}
#define XB_TMO      128
#define XB_XCNT(j)  (256  + 64 * (j))
#define XB_XSUB(j)  (1280 + 64 * (j))
#define XB_XGEN(j)  (2304 + 64 * (j))
#define XB_TOP      3328
#define XB_TOPGEN   3392
#define XCD_BAR_WORDS 3456
#define XB_SPIN_CAP (1u << 18)

__device__ __forceinline__ unsigned xb_ld(unsigned* p)              { return __hip_atomic_load(p, __ATOMIC_RELAXED, __HIP_MEMORY_SCOPE_AGENT); }
__device__ __forceinline__ unsigned xb_add(unsigned* p, unsigned v) { return __hip_atomic_fetch_add(p, v, __ATOMIC_RELAXED, __HIP_MEMORY_SCOPE_AGENT); }
__device__ __forceinline__ unsigned xb_xcc_id() { return (unsigned)__builtin_amdgcn_s_getreg((3 << 11) | 20) & 0xFu; }
#define XB_SPIN(cond, bar) do { unsigned _sp = 0; while (cond) { __builtin_amdgcn_s_sleep(1); \
    if ((++_sp & 255u) == 0u) { if (xb_ld(&(bar)[XB_TMO])) break; if (_sp > XB_SPIN_CAP) { atomicAdd(&(bar)[XB_TMO], 1u); break; } } } } while (0)

struct XcdBarrier {
    unsigned* bar; unsigned x;
    volatile LAS unsigned* st;
};

__device__ __forceinline__ XcdBarrier xcd_barrier_post(unsigned* bar, volatile LAS unsigned* st) {
    XcdBarrier b; b.bar = bar; b.x = xb_xcc_id(); b.st = st;
    if (threadIdx.x == 0) (void)xb_add(&bar[XB_XCNT(b.x)], 1u);
    return b;
}
__device__ __forceinline__ void xcd_barrier_complete(unsigned* bar, unsigned x, unsigned& nloc, unsigned& nx) {
    const unsigned G = gridDim.x * gridDim.y * gridDim.z;
    unsigned sum, cnt, mine, sp = 0u;
    for (;;) {
        sum = 0u; cnt = 0u; mine = 0u;
#pragma unroll
        for (unsigned j = 0; j < 16; ++j) { const unsigned c = xb_ld(&bar[XB_XCNT(j)]); sum += c; cnt += (c > 0u) ? 1u : 0u; mine = (j == x) ? c : mine; }
        if (sum == G) break;
        __builtin_amdgcn_s_sleep(1);
        if ((++sp & 255u) == 0u) { if (xb_ld(&bar[XB_TMO])) break; if (sp > XB_SPIN_CAP) { atomicAdd(&bar[XB_TMO], 1u); break; } }
    }
    nloc = mine > 0u ? mine : 1u; nx = cnt > 0u ? cnt : 1u;
}

__device__ __forceinline__ void xcd_barrier(const XcdBarrier& b) {
    asm volatile("s_waitcnt vmcnt(0)" ::: "memory");
    __syncthreads();
    if (threadIdx.x == 0) {
        unsigned* bar = b.bar;
        __builtin_amdgcn_s_waitcnt(0);
        unsigned nloc = b.st[0], nx = b.st[1];
        if (nloc == 0u) { xcd_barrier_complete(bar, b.x, nloc, nx); b.st[0] = nloc; b.st[1] = nx; }
        const unsigned old = xb_add(&bar[XB_XSUB(b.x)], 1u);
        const unsigned gen = old / nloc;
        if (old + 1u == (gen + 1u) * nloc) {
            __builtin_amdgcn_fence(__ATOMIC_RELEASE, "agent");
            asm volatile("s_waitcnt vmcnt(0)" ::: "memory");
            const unsigned og = xb_add(&bar[XB_TOP], 1u);
            const unsigned tg = og / nx;
            if (og + 1u == (tg + 1u) * nx) xb_add(&bar[XB_TOPGEN], 1u);
            else XB_SPIN(xb_ld(&bar[XB_TOPGEN]) == tg, bar);
            __builtin_amdgcn_fence(__ATOMIC_ACQUIRE, "agent");
            xb_add(&bar[XB_XGEN(b.x)], 1u);
            asm volatile("s_waitcnt vmcnt(0)" ::: "memory");
        } else {
            XB_SPIN(xb_ld(&bar[XB_XGEN(b.x)]) == gen, bar);
            __builtin_amdgcn_fence(__ATOMIC_ACQUIRE, "agent");
            asm volatile("s_waitcnt vmcnt(0)" ::: "memory");
        }
    }
    __syncthreads();
}
constexpr int NB = 4, SEQ = 8192, DM = 1024, T = NB * SEQ;
constexpr int NH = 8, HD = 64, CW = 512;
constexpr int N_IN = 5120;
constexpr int NLAYER = 2;
constexpr int NEXP = 32, DEXP = 512;
constexpr int MOE_ROWS = 73728, MOE_PANELS = MOE_ROWS / 256;
constexpr int WCAT_ROWS = 5888;
constexpr int LO_W = 768;

constexpr size_t MiB = 1u << 20;
constexpr size_t WS_CTL = 0, CTL_ZERO_BYTES = 1 * MiB;
constexpr size_t WS_VF   = 1 * MiB;
constexpr size_t WS_TAB  = 33 * MiB;
constexpr size_t WS_WM   = 34 * MiB;
constexpr size_t WS_XN   = 50 * MiB;
constexpr size_t WS_RW   = 114 * MiB;
constexpr size_t WS_MO   = 178 * MiB;
constexpr size_t WS_LO   = 210 * MiB;
constexpr size_t WS_YRM  = 114 * MiB;
constexpr int YRM_LD = 1024;
constexpr size_t WS_SIR  = 258 * MiB;
constexpr size_t WS_SIK  = 322 * MiB;
constexpr size_t WS_SCRW = 290 * MiB, WS_SCRA = 306 * MiB, WS_SCRB = 546 * MiB;
constexpr size_t WS_V1   = 418 * MiB;
constexpr size_t WS_G    = 450 * MiB;
constexpr size_t WS_YS   = 482 * MiB;
constexpr size_t WS_PO   = 418 * MiB;
constexpr size_t WS_PST  = 274 * MiB;
constexpr size_t WS_GA   = 418 * MiB;
constexpr size_t WS_H    = 50 * MiB;
constexpr size_t WS_SC1  = 482 * MiB;
constexpr size_t WS_SC2  = 354 * MiB;
constexpr size_t WS_SCT  = 290 * MiB;
constexpr size_t WS_WE   = 290 * MiB;
constexpr size_t WS_WD   = 354 * MiB;
constexpr size_t WS_AM   = 130 * MiB;
constexpr size_t WS_HM   = 194 * MiB;
constexpr size_t WS_YE   = 386 * MiB;
constexpr size_t WS_RT   = 546 * MiB;
constexpr size_t WS_END  = 556 * MiB;
constexpr size_t TB_KMEAN = 0;
constexpr size_t TB_KMEAN2 = 256 * 1024;
constexpr size_t TB_SEL   = 256 * 1024;
constexpr size_t RT_EID  = 0;
constexpr size_t RT_GATE = 256 * 1024;
constexpr size_t RT_ROW  = 512 * 1024;
constexpr size_t RT_GW   = 768 * 1024;
constexpr size_t RT_HIST = 1280 * 1024;
constexpr size_t RT_PEXP = 1408 * 1024;
constexpr size_t RT_TOK  = 1536 * 1024;
constexpr size_t RT_RSQ  = 2048 * 1024;
constexpr size_t RT_RSR  = 2304 * 1024;
constexpr size_t WS_SEL  = 562 * MiB;
constexpr size_t WS_NEED = 564 * MiB;
constexpr int CW_BAR = 4096;

constexpr int RING_BYTES = 131072;
constexpr int LDS_BYTES = 163840;
constexpr int MISC_OFF = LDS_BYTES - 256;
struct Frame {
    LAS unsigned char* lds;
    int tid, lane, wave;
    int G, bid;
    const __attribute__((address_space(4))) unsigned char* ka;
    GAS float* out_g; GAS unsigned char* ws_g;
    DI float* outp() const { return (float*)out_g; }
    DI unsigned char* wsp() const { return (unsigned char*)ws_g; }
    DI const float* inp(int i) const { return (const float*)(*(const GAS float* const __attribute__((address_space(4)))*)(ka + 8 * i)); }
};
#define LDS_WAIT() asm volatile("s_waitcnt lgkmcnt(0)" ::: "memory")

DI void tr_item(const float* src, int ld, int k0, bf16_t* dst, int Kd, const float* sc, int mode, LAS float* scr, int lane) {
#pragma unroll 8
    for (int i = 0; i < 32; ++i) { const int kk = 2 * i + (lane >> 5);
        float v = src ? src[(size_t)(k0 + kk) * ld + (lane & 31)] : 0.f;
        if (mode == 1) v *= sc[k0 + kk]; else if (mode == 2) v *= (1.f - sc[k0 + kk]);
        scr[kk * 33 + (lane & 31)] = v; }
    LDS_WAIT(); asm volatile("" ::: "memory");
    const int c = lane & 7;
#pragma unroll
    for (int j = 0; j < 4; ++j) { const int n = (lane >> 3) + 8 * j; const LAS float* s = scr + (8 * c) * 33 + n;
        u32x4 o; o.x = pk2(s[0 * 33], s[1 * 33]); o.y = pk2(s[2 * 33], s[3 * 33]); o.z = pk2(s[4 * 33], s[5 * 33]); o.w = pk2(s[6 * 33], s[7 * 33]);
        *(u32x4*)(dst + (size_t)n * Kd + k0 + 8 * c) = o; }
    LDS_WAIT(); asm volatile("" ::: "memory");
}

constexpr size_t WM_WCAT = 0, WM_BRR = (size_t)WCAT_ROWS * 1024 * 2, WM_BRM = WM_BRR + 1024 * 512 * 2, WM_OUT = WM_BRM + 1024 * 512 * 2;
DI void phase_conv_mixer(Frame& F, int l) {
    LAS float* scr = (LAS float*)(F.lds + F.wave * 16384);
    const int gw = F.bid * 8 + F.wave, NGW = F.G * 8;
    bf16_t* wcat = (bf16_t*)(F.wsp() + WS_WM + WM_WCAT);
    const float* w_in = F.inp(3) + (size_t)l * DM * N_IN;
    const float* mu_x = F.inp(5) + (size_t)l * 3 * DM;
    constexpr int NBLK = WCAT_ROWS / 32;
    constexpr int I_CAT = NBLK * 16, I_BR = 8 * 32, I_OUT = 16 * 32;
    for (int it = gw; it < I_CAT + 2 * I_BR + I_OUT; it += NGW) {
        int r = it;
        if (r < I_CAT) {
            const int nb = r / 16, kb = r % 16, k0 = kb * 64;
            if (nb < 48) { tr_item(w_in + 32 * nb, N_IN, k0, wcat + (size_t)(32 * nb) * 1024, 1024, nullptr, 0, scr, F.lane); }
            else if (nb < 72) {
                const int q = nb - 48; const float* src = nullptr; int ld = 0; const float* sc = nullptr; int mode = 0;
                if (q < 4)       { src = F.inp(7)  + (size_t)l * DM * 64  + 32 * (q & 1); ld = 64;  sc = mu_x;          mode = (q < 2) ? 2 : 1; }
                else if (q < 8)  { src = F.inp(10) + (size_t)l * DM * 64  + 32 * (q & 1); ld = 64;  sc = mu_x + DM;     mode = (q < 6) ? 2 : 1; }
                else if (q < 16) { src = F.inp(12) + (size_t)l * DM * 128 + 32 * (q & 3); ld = 128; sc = mu_x + 2 * DM; mode = (q < 12) ? 2 : 1; }
                else if (q < 18 && l > 0) { src = F.inp(21) + (size_t)(l - 1) * DM * 32; ld = 32; sc = F.inp(19) + (size_t)(l - 1) * DM; mode = (q == 16) ? 2 : 1; }
                tr_item(src, ld, k0, wcat + (size_t)(1536 + 32 * q) * 1024, 1024, sc, mode, scr, F.lane);
            }
            else if (nb < 120) { tr_item(w_in + 1536 + 32 * (nb - 72), N_IN, k0, wcat + (size_t)(2304 + 32 * (nb - 72)) * 1024, 1024, nullptr, 0, scr, F.lane); }
            else { tr_item(w_in + 3072 + 32 * (nb - 120), N_IN, k0, wcat + (size_t)(3840 + 32 * (nb - 120)) * 1024, 1024, nullptr, 0, scr, F.lane); }
            continue;
        }
        r -= I_CAT;
        if (r < I_BR) { const int nb = r / 8, kb = r % 8; tr_item(F.inp(26) + (size_t)l * 512 * 1024 + 32 * nb, 1024, kb * 64, (bf16_t*)(F.wsp() + WS_WM + WM_BRR) + (size_t)(32 * nb) * 1024, 1024, nullptr, 0, scr, F.lane); continue; }
        r -= I_BR;
        if (r < I_BR) { const int nb = r / 8, kb = r % 8; tr_item(F.inp(27) + (size_t)l * 512 * 1024 + 32 * nb, 1024, kb * 64, (bf16_t*)(F.wsp() + WS_WM + WM_BRR) + (size_t)(32 * nb) * 1024 + 512, 1024, nullptr, 0, scr, F.lane); continue; }
        r -= I_BR;
        { const int nb = r / 16, kb = r % 16; tr_item(F.inp(28) + (size_t)l * 1024 * 1024 + 32 * nb, 1024, kb * 64, (bf16_t*)(F.wsp() + WS_WM + WM_OUT) + (size_t)(32 * nb) * 1024, 1024, nullptr, 0, scr, F.lane); }
    }
}
struct ConvItem { const float* src; int ld, k0, n0, Kd, mode; bf16_t* dst; };
DI ConvItem conv_item(int it, const float* wg, const float* wu, const float* wdn, bf16_t* we, bf16_t* wd) {
    ConvItem c; const int e = it / 96; int r = it % 96;
    if (r < 64) { const int up = r >> 5; r &= 31; c.src = (up ? wu : wg) + (size_t)e * DM * DEXP; c.ld = DEXP; c.k0 = (r >> 1) * 64; c.n0 = (r & 1) * 256; c.dst = we + (size_t)e * 1024 * 1024; c.Kd = 1024; c.mode = up; }
    else { r -= 64; c.src = wdn + (size_t)e * DEXP * DM; c.ld = DM; c.k0 = (r >> 2) * 64; c.n0 = (r & 3) * 256; c.dst = wd + (size_t)e * 1024 * 512; c.Kd = 512; c.mode = 2; }
    return c;
}
DI void conv_load(const ConvItem& c, f32x4 (&v)[8], int tid) {
#pragma unroll
    for (int i = 0; i < 8; ++i) { const int idx = tid + 512 * i, row = idx >> 6, c4 = idx & 63; v[i] = *(const f32x4*)(c.src + (size_t)(c.k0 + row) * c.ld + c.n0 + 4 * c4); }
}
DI void conv_store(const ConvItem& c, const f32x4 (&v)[8], LAS float* scr, int tid) {
#pragma unroll
    for (int i = 0; i < 8; ++i) { const int idx = tid + 512 * i, row = idx >> 6, c4 = idx & 63; LAS float* d = scr + row * 257 + 4 * c4; d[0] = v[i].x; d[1] = v[i].y; d[2] = v[i].z; d[3] = v[i].w; }
    __syncthreads();
#pragma unroll
    for (int i = 0; i < 4; ++i) { const int idx = tid + 512 * i, n = idx >> 3, cc = idx & 7; const LAS float* sp = scr + (8 * cc) * 257 + n;
        u32x4 o; o.x = pk2(sp[0], sp[257]); o.y = pk2(sp[2 * 257], sp[3 * 257]); o.z = pk2(sp[4 * 257], sp[5 * 257]); o.w = pk2(sp[6 * 257], sp[7 * 257]);
        const int h = c.n0 + n; const int drow = (c.mode == 2) ? h : ((h >> 7) * 256 + c.mode * 128 + (h & 127));
        *(u32x4*)(c.dst + (size_t)drow * c.Kd + c.k0 + 8 * cc) = o; }
    __syncthreads();
}
constexpr int CONV_ITEMS = NEXP * 96, CONV_GROUP = 12, CONV_UNITS = CONV_ITEMS / CONV_GROUP;
DI void conv_experts_items(Frame& F, int l, int it_lo, int it_hi, int it_step) {
    LAS float* scr = (LAS float*)F.lds;
    bf16_t* we = (bf16_t*)(F.wsp() + WS_WE); bf16_t* wd = (bf16_t*)(F.wsp() + WS_WD);
    const float* wg = F.inp(33) + (size_t)l * NEXP * DM * DEXP; const float* wu = F.inp(34) + (size_t)l * NEXP * DM * DEXP; const float* wdn = F.inp(35) + (size_t)l * NEXP * DEXP * DM;
    __syncthreads();
    if (it_lo >= it_hi) return;
    f32x4 r0[8], r1[8], r2[8];
    ConvItem c0 = conv_item(it_lo, wg, wu, wdn, we, wd), c1 = c0, c2 = c0;
    conv_load(c0, r0, F.tid);
    const bool h1 = it_lo + it_step < it_hi; if (h1) { c1 = conv_item(it_lo + it_step, wg, wu, wdn, we, wd); conv_load(c1, r1, F.tid); }
    for (int it = it_lo; it < it_hi; it += 3 * it_step) {
        const int i2 = it + 2 * it_step, i3 = it + 3 * it_step, i4 = it + 4 * it_step;
        if (i2 < it_hi) { c2 = conv_item(i2, wg, wu, wdn, we, wd); conv_load(c2, r2, F.tid); }
        conv_store(c0, r0, scr, F.tid);
        if (it + it_step >= it_hi) break;
        if (i3 < it_hi) { c0 = conv_item(i3, wg, wu, wdn, we, wd); conv_load(c0, r0, F.tid); }
        conv_store(c1, r1, scr, F.tid);
        if (i2 >= it_hi) break;
        if (i4 < it_hi) { c1 = conv_item(i4, wg, wu, wdn, we, wd); conv_load(c1, r1, F.tid); }
        conv_store(c2, r2, scr, F.tid);
    }
}
DI void rms_row_to_bf16(const float* xrow, const float* gain, bf16_t* o0, bf16_t* o1, int lane) {
    const f32x4* xr = (const f32x4*)xrow + lane; const f32x4* gr = (const f32x4*)gain + lane;
    f32x4 v[4]; float s = 0.f;
#pragma unroll
    for (int j = 0; j < 4; ++j) { v[j] = xr[64 * j]; s += (v[j].x * v[j].x + v[j].y * v[j].y) + (v[j].z * v[j].z + v[j].w * v[j].w); }
    const float rs = 1.0f / sqrtf(wave_sum(s) * (1.f / DM) + 1e-6f);
#pragma unroll
    for (int j = 0; j < 4; ++j) { const f32x4 g = gr[64 * j]; const f32x4 y = v[j] * rs * g;
        u32x2 w; w.x = pk2(y.x, y.y); w.y = pk2(y.z, y.w);
        *((u32x2*)o0 + lane + 64 * j) = w; if (o1) *((u32x2*)o1 + lane + 64 * j) = w; }
}
DI void phase_norm_x(Frame& F, const float* x, const float* gain) {
    const int gw = F.bid * 8 + F.wave, NGW = F.G * 8; bf16_t* xn = (bf16_t*)(F.wsp() + WS_XN); int lane = F.lane;
    for (int mb = gw * 4; mb < T; mb += NGW * 4) {
        int m0 = mb; asm volatile("" : "+s"(m0), "+v"(lane));
        f32x4 v[4][4];
#pragma unroll
        for (int e = 0; e < 4; ++e) { const f32x4* xr = (const f32x4*)(x + (size_t)(m0 + e) * DM) + lane;
#pragma unroll
            for (int j = 0; j < 4; ++j) v[e][j] = xr[64 * j]; }
#pragma unroll
        for (int e = 0; e < 4; ++e) { float s = 0.f;
#pragma unroll
            for (int j = 0; j < 4; ++j) s += (v[e][j].x * v[e][j].x + v[e][j].y * v[e][j].y) + (v[e][j].z * v[e][j].z + v[e][j].w * v[e][j].w);
            const float rs = __builtin_amdgcn_rsqf(wave_sum(s) * (1.f / DM) + 1e-6f);
#pragma unroll
            for (int j = 0; j < 4; ++j) { const f32x4 g = ((const f32x4*)gain)[lane + 64 * j]; const f32x4 y = v[e][j] * rs * g; u32x2 w; w.x = pk2(y.x, y.y); w.y = pk2(y.z, y.w);
                *((u32x2*)(xn + (size_t)(m0 + e) * DM) + lane + 64 * j) = w; } }
    }
}

namespace pg8 {
struct EpiStore {
    static constexpr bool PERM = true, HAS_MID = false, HEADS = false;
    bf16_t* O; int ldc; int split; bf16_t* O2; int ldc2; int act;
    __device__ __forceinline__ void operator()(const f32x4 (&acc)[2][2][4][2], const Unit& u, int wr, int wc, int fr, int fq) const {
        const int row0 = u.pm * BM + wr * 64 + fr; int colt = u.pn * BM; bf16_t* base = O; int ld = ldc;
        if (split && colt >= split) { base = O2; ld = ldc2; colt -= split; }
        const int col0 = colt + wc * 32 + 8 * fq;
#pragma unroll
        for (int ai = 0; ai < 2; ++ai)
#pragma unroll
            for (int m = 0; m < 4; ++m) { bf16_t* rowp = base + (size_t)(row0 + ai * HALF + m * 16) * ld + col0;
#pragma unroll
                for (int bj = 0; bj < 2; ++bj) { f32x4 v0 = acc[ai][bj][m][0], v1 = acc[ai][bj][m][1];
                    if (act == 1) {
#pragma unroll
                        for (int j = 0; j < 4; ++j) { v0[j] = sigmoidf_(v0[j]); v1[j] = sigmoidf_(v1[j]); } }
                    u32x4 w; w.x = pk2(v0[0], v0[1]); w.y = pk2(v0[2], v0[3]); w.z = pk2(v1[0], v1[1]); w.w = pk2(v1[2], v1[3]);
                    *(u32x4*)(rowp + bj * HALF) = w; } }
    }
};
struct EpiBranch {
    static constexpr bool PERM = true, HAS_MID = false, HEADS = false;
    bf16_t* Hout; const bf16_t* gate; int gcol0; int first;
    __device__ __forceinline__ void operator()(const f32x4 (&acc)[2][2][4][2], const Unit& u, int wr, int wc, int fr, int fq) const {
        const int row0 = u.pm * BM + wr * 64 + fr; const int col0 = u.pn * BM + wc * 32 + 8 * fq;
#pragma unroll
        for (int ai = 0; ai < 2; ++ai)
#pragma unroll
            for (int m = 0; m < 4; ++m) { const size_t row = (size_t)(row0 + ai * HALF + m * 16);
#pragma unroll
                for (int bj = 0; bj < 2; ++bj) {
                    const u32x4 gv = *(const u32x4*)(gate + row * 2048 + gcol0 + col0 + bj * HALF);
                    bf16_t* hp = Hout + row * 1024 + col0 + bj * HALF;
                    f32x4 v0 = acc[ai][bj][m][0], v1 = acc[ai][bj][m][1];
                    v0[0] *= bflo(gv.x); v0[1] *= bfhi(gv.x); v0[2] *= bflo(gv.y); v0[3] *= bfhi(gv.y);
                    v1[0] *= bflo(gv.z); v1[1] *= bfhi(gv.z); v1[2] *= bflo(gv.w); v1[3] *= bfhi(gv.w);
                    if (!first) { const u32x4 hv = *(const u32x4*)hp;
                        v0[0] += bflo(hv.x); v0[1] += bfhi(hv.x); v0[2] += bflo(hv.y); v0[3] += bfhi(hv.y);
                        v1[0] += bflo(hv.z); v1[1] += bfhi(hv.z); v1[2] += bflo(hv.w); v1[3] += bfhi(hv.w); }
                    u32x4 w; w.x = pk2(v0[0], v0[1]); w.y = pk2(v0[2], v0[3]); w.z = pk2(v1[0], v1[1]); w.w = pk2(v1[2], v1[3]);
                    *(u32x4*)hp = w; } }
    }
};
struct EpiBranch2 {
    static constexpr bool PERM = true, HAS_MID = true, HEADS = false;
    bf16_t* Hout; const bf16_t* gate;
    __device__ __forceinline__ void mid(f32x4 (&acc)[2][2][4][2], const Unit& u, int wr, int wc, int fr_, int fq_) const {
        int fr = fr_, fq = fq_; asm volatile("" : "+v"(fr), "+v"(fq));
        const int row0 = u.pm * BM + wr * 64 + fr; const int col0 = u.pn * BM + wc * 32 + 8 * fq;
#pragma unroll
        for (int ai = 0; ai < 2; ++ai)
#pragma unroll
            for (int m = 0; m < 4; ++m) { const size_t row = (size_t)(row0 + ai * HALF + m * 16);
#pragma unroll
                for (int bj = 0; bj < 2; ++bj) {
                    const u32x4 gr = *(const u32x4*)(gate + row * 2048 + col0 + bj * HALF), gm = *(const u32x4*)(gate + row * 2048 + 1024 + col0 + bj * HALF);
                    const unsigned grw[4] = {gr.x, gr.y, gr.z, gr.w}, gmw[4] = {gm.x, gm.y, gm.z, gm.w};
#pragma unroll
                    for (int q = 0; q < 4; ++q) { const float r0 = bflo(grw[q]) * __builtin_amdgcn_rcpf(fmaxf(bflo(gmw[q]), 1e-30f)), r1 = bfhi(grw[q]) * __builtin_amdgcn_rcpf(fmaxf(bfhi(gmw[q]), 1e-30f));
                        acc[ai][bj][m][q >> 1][2 * (q & 1)] *= r0; acc[ai][bj][m][q >> 1][2 * (q & 1) + 1] *= r1; } }
                if (m == 3) asm volatile("" ::: "memory"); }
    }
    __device__ __forceinline__ void operator()(const f32x4 (&acc)[2][2][4][2], const Unit& u, int wr, int wc, int fr, int fq) const {
        const int row0 = u.pm * BM + wr * 64 + fr; const int col0 = u.pn * BM + wc * 32 + 8 * fq;
#pragma unroll
        for (int ai = 0; ai < 2; ++ai)
#pragma unroll
            for (int m = 0; m < 4; ++m) { const size_t row = (size_t)(row0 + ai * HALF + m * 16);
#pragma unroll
                for (int bj = 0; bj < 2; ++bj) {
                    const u32x4 gm = *(const u32x4*)(gate + row * 2048 + 1024 + col0 + bj * HALF);
                    f32x4 v0 = acc[ai][bj][m][0], v1 = acc[ai][bj][m][1];
                    v0[0] *= fmaxf(bflo(gm.x), 1e-30f); v0[1] *= fmaxf(bfhi(gm.x), 1e-30f); v0[2] *= fmaxf(bflo(gm.y), 1e-30f); v0[3] *= fmaxf(bfhi(gm.y), 1e-30f);
                    v1[0] *= fmaxf(bflo(gm.z), 1e-30f); v1[1] *= fmaxf(bfhi(gm.z), 1e-30f); v1[2] *= fmaxf(bflo(gm.w), 1e-30f); v1[3] *= fmaxf(bfhi(gm.w), 1e-30f);
                    u32x4 w; w.x = pk2(v0[0], v0[1]); w.y = pk2(v0[2], v0[3]); w.z = pk2(v1[0], v1[1]); w.w = pk2(v1[2], v1[3]);
                    *(u32x4*)(Hout + row * 1024 + col0 + bj * HALF) = w; } }
    }
};
struct EpiMoba {
    static constexpr bool PERM = true, HAS_MID = false, HEADS = true;
    bf16_t* MO; const float* qgain; const float* kgain; float* KM; int km_half;
    __device__ __forceinline__ void operator()(const f32x4 (&acc)[2][2][4][2], const Unit& u, int wr, int wc, int fr, int fq) const {
        const int row0 = u.pm * BM + wr * 64 + fr; const int kind = u.pn >> 1; const int colb = u.pn * BM + 64 * wc + 8 * fq;
        if (kind == 2) {
#pragma unroll
            for (int ai = 0; ai < 2; ++ai)
#pragma unroll
                for (int m = 0; m < 4; ++m) { bf16_t* rowp = MO + (size_t)(row0 + ai * HALF + m * 16) * 1536 + colb;
#pragma unroll
                    for (int bj = 0; bj < 2; ++bj) { const f32x4 v0 = acc[ai][bj][m][0], v1 = acc[ai][bj][m][1];
                        u32x4 w; w.x = pk2(v0[0], v0[1]); w.y = pk2(v0[2], v0[3]); w.z = pk2(v1[0], v1[1]); w.w = pk2(v1[2], v1[3]); *(u32x4*)(rowp + 32 * bj) = w; } }
            return;
        }
        const float* gp = (kind == 0 ? qgain : kgain) + 8 * fq; const float gs = (kind == 0) ? 0.125f : 1.0f;
        f32x4 gn[2][2];
#pragma unroll
        for (int bj = 0; bj < 2; ++bj)
#pragma unroll
            for (int n = 0; n < 2; ++n) gn[bj][n] = *(const f32x4*)(gp + 32 * bj + 4 * n) * gs;
        f32x4 cs[2][2];
#pragma unroll
        for (int bj = 0; bj < 2; ++bj)
#pragma unroll
            for (int n = 0; n < 2; ++n) cs[bj][n] = (f32x4){0.f, 0.f, 0.f, 0.f};
        float rsv[2][4];
#pragma unroll
        for (int ai = 0; ai < 2; ++ai)
#pragma unroll
            for (int m = 0; m < 4; ++m) { float ss = 0.f;
#pragma unroll
                for (int bj = 0; bj < 2; ++bj)
#pragma unroll
                    for (int n = 0; n < 2; ++n) { const f32x4 x = acc[ai][bj][m][n]; ss += (x[0] * x[0] + x[1] * x[1]) + (x[2] * x[2] + x[3] * x[3]); }
                rsv[ai][m] = ss; }
#pragma unroll
        for (int ai = 0; ai < 2; ++ai)
#pragma unroll
            for (int m = 0; m < 4; ++m) rsv[ai][m] += __shfl_xor(rsv[ai][m], 16);
#pragma unroll
        for (int ai = 0; ai < 2; ++ai)
#pragma unroll
            for (int m = 0; m < 4; ++m) { rsv[ai][m] += __shfl_xor(rsv[ai][m], 32); rsv[ai][m] = __builtin_amdgcn_rsqf(rsv[ai][m] * (1.f / 64.f) + 1e-6f); }
#pragma unroll
        for (int ai = 0; ai < 2; ++ai)
#pragma unroll
            for (int m = 0; m < 4; ++m) { const float rs = rsv[ai][m];
                bf16_t* rowp = MO + (size_t)(row0 + ai * HALF + m * 16) * 1536 + colb;
#pragma unroll
                for (int bj = 0; bj < 2; ++bj) { const f32x4 v0 = acc[ai][bj][m][0] * rs * gn[bj][0], v1 = acc[ai][bj][m][1] * rs * gn[bj][1];
                    cs[bj][0] += v0; cs[bj][1] += v1;
                    u32x4 w; w.x = pk2(v0[0], v0[1]); w.y = pk2(v0[2], v0[3]); w.z = pk2(v1[0], v1[1]); w.w = pk2(v1[2], v1[3]); *(u32x4*)(rowp + 32 * bj) = w; }
                asm volatile("" : "+v"(cs[0][0]), "+v"(cs[0][1]), "+v"(cs[1][0]), "+v"(cs[1][1]));
            }
        if (kind == 1) {
#pragma unroll
            for (int bj = 0; bj < 2; ++bj)
#pragma unroll
                for (int n = 0; n < 2; ++n) { f32x4 t = cs[bj][n];
#pragma unroll
                    for (int j = 0; j < 4; ++j) { float v = t[j]; v += dpp_mov<0xB1>(v); v += dpp_mov<0x4E>(v); v += dpp_mov<0x141>(v); v += dpp_mov<0x140>(v); t[j] = v * (1.f / 256.f); }
                    if (fr == 0) *(f32x4*)(KM + (size_t)wr * km_half + (size_t)u.pm * 512 + (u.pn * BM - 512) + 64 * wc + 32 * bj + 8 * fq + 4 * n) = t; }
        }
    }
};
struct EpiResid {
    static constexpr bool PERM = false, HAS_MID = false, HEADS = false;
    const float* xin; float* out;
    __device__ __forceinline__ void operator()(const f32x4 (&acc)[2][2][4][2], const Unit& u, int wr, int wc, int fr, int fq) const {
        const int row0 = u.pm * BM + wr * 64 + fr, col0 = u.pn * BM + wc * 32 + 4 * fq;
#pragma unroll
        for (int ai = 0; ai < 2; ++ai)
#pragma unroll
            for (int m = 0; m < 4; ++m) { const size_t off = (size_t)(row0 + ai * HALF + m * 16) * 1024 + col0;
#pragma unroll
                for (int bj = 0; bj < 2; ++bj)
#pragma unroll
                    for (int n = 0; n < 2; ++n) { const f32x4 xv = *(const f32x4*)(xin + off + bj * HALF + n * 16); *(f32x4*)(out + off + bj * HALF + n * 16) = xv + acc[ai][bj][m][n]; } }
    }
};
struct EpiExpertUp {
    static constexpr bool PERM = true, HAS_MID = false, HEADS = false;
    bf16_t* HM; const float* gw; const float* rsr;
    __device__ __forceinline__ void operator()(const f32x4 (&acc)[2][2][4][2], const Unit& u, int wr, int wc, int fr, int fq) const {
        const int row0 = u.pm * BM + wr * 64 + fr; const int col0 = u.pn * 128 + wc * 32 + 8 * fq;
#pragma unroll
        for (int ai = 0; ai < 2; ++ai)
#pragma unroll
            for (int m = 0; m < 4; ++m) { const size_t row = (size_t)(row0 + ai * HALF + m * 16); const float rs = rsr[row]; const float gwt = gw[row] * rs;
                f32x4 v0, v1;
#pragma unroll
                for (int j = 0; j < 4; ++j) { const float g0 = acc[ai][0][m][0][j] * rs, g1 = acc[ai][0][m][1][j] * rs;
                    v0[j] = g0 * sigmoidf_(g0) * acc[ai][1][m][0][j] * gwt; v1[j] = g1 * sigmoidf_(g1) * acc[ai][1][m][1][j] * gwt; }
                u32x4 w; w.x = pk2(v0[0], v0[1]); w.y = pk2(v0[2], v0[3]); w.z = pk2(v1[0], v1[1]); w.w = pk2(v1[2], v1[3]);
                *(u32x4*)(HM + row * 512 + col0) = w; }
    }
};
}
constexpr size_t SI_PLANE = (size_t)T * CW * 2;
DI float softplusf_(float z) { return fmaxf(z, 0.f) + __logf(1.0f + __expf(-fabsf(z))); }

#ifndef PREP_DUP
#define PREP_DUP 0
#endif
constexpr int ACT_P = 592;
constexpr size_t WM_L2T = (size_t)WCAT_ROWS * 1024 * 2 + 2 * 1024 * 512 * 2 + 1024 * 1024 * 2;
DI void phase_conv_lora2(Frame& F, int l) {
    bf16_t* L2T = (bf16_t*)(F.wsp() + WS_WM + WM_L2T);
    const float* w2 = F.inp(8) + (size_t)l * 64 * CW; const float* a2 = F.inp(11) + (size_t)l * 64 * CW; const float* g2 = F.inp(13) + (size_t)l * 128 * CW; const float* v2 = F.inp(22);
    for (int idx = F.bid * 512 + F.tid; idx < 288 * CW; idx += F.G * 512) { const int j = idx >> 9, c = idx & 511;
        float v;
        if (j < 64) v = w2[j * CW + c]; else if (j < 128) v = a2[(j - 64) * CW + c]; else if (j < 256) v = g2[(j - 128) * CW + c]; else v = (l > 0) ? v2[(j - 256) * CW + c] : 0.f;
        L2T[c * 288 + j] = f2bf(v); }
}
DI unsigned ror1(unsigned x) { return (unsigned)__builtin_amdgcn_update_dpp(0, (int)x, 0x121, 0xf, 0xf, true); }
DI unsigned shr1_keep(unsigned o, unsigned cur) { return (unsigned)__builtin_amdgcn_update_dpp((int)o, (int)cur, 0x111, 0xf, 0xf, false); }
DI unsigned prev_lane(unsigned older, unsigned cur) { return shr1_keep(ror1(older), cur); }
DI float row16_sum(float v) { v += dpp_mov<0xB1>(v); v += dpp_mov<0x4E>(v); v += dpp_mov<0x141>(v); v += dpp_mov<0x140>(v); return v; }
DI void phase_rwkv_prep2(Frame& F, int l, int tile_lo, int tile_hi, int tile_step, bool init) {
    LAS unsigned char* act = F.lds;
    LAS float* INVL = (LAS float*)(F.lds + 38912);
    LAS float* PRM = (LAS float*)(F.lds + 139264);
    const bf16_t* RW = (const bf16_t*)(F.wsp() + WS_RW); const bf16_t* LO = (const bf16_t*)(F.wsp() + WS_LO); const unsigned char* L2T = F.wsp() + WS_WM + WM_L2T;
    bf16_t* SIr = (bf16_t*)(F.wsp() + WS_SIR); bf16_t* SIk = (bf16_t*)(F.wsp() + WS_SIK);
    bf16_t* SCw = (bf16_t*)(F.wsp() + WS_SCRW) + (size_t)F.bid * 64 * CW; bf16_t* SCa = (bf16_t*)(F.wsp() + WS_SCRA) + (size_t)F.bid * 64 * CW; bf16_t* SCb = (bf16_t*)(F.wsp() + WS_SCRB) + (size_t)F.bid * 64 * CW;
    bf16_t* VF = (bf16_t*)(F.wsp() + WS_VF); bf16_t* V1 = (bf16_t*)(F.wsp() + WS_V1); bf16_t* Gb = (bf16_t*)(F.wsp() + WS_G);
    const int lane = F.lane, r16 = lane & 15, g = lane >> 4;
    if (init) { __syncthreads();
      const int c = F.tid;
      PRM[c] = F.inp(4)[(size_t)l * 3 * CW + c]; PRM[512 + c] = F.inp(4)[(size_t)l * 3 * CW + CW + c]; PRM[1024 + c] = F.inp(4)[(size_t)l * 3 * CW + 2 * CW + c];
      PRM[1536 + c] = F.inp(6)[l * CW + c]; PRM[2048 + c] = F.inp(9)[l * CW + c]; PRM[2560 + c] = F.inp(14)[l * CW + c]; PRM[3072 + c] = F.inp(15)[l * CW + c]; PRM[3584 + c] = l > 0 ? F.inp(20)[c] : 0.f; }
    for (int tile = tile_lo; tile < tile_hi; tile += tile_step) {
        int t0 = tile * 64; asm volatile("" : "+s"(t0));
        __syncthreads();
        for (int dup1_ = 0; dup1_ < ((PREP_DUP & 1) ? 2 : 1); ++dup1_)
        for (int grp = F.tid; grp < 64 * 36; grp += 512) { const int tt = grp / 36, jg = grp - tt * 36, j0 = 8 * jg; const int t = t0 + tt; const bool has_prev = (t % SEQ) != 0;
            int pj, qj; if (j0 < 64) { pj = j0; qj = 64 + j0; } else if (j0 < 128) { pj = 128 + (j0 - 64); qj = 192 + (j0 - 64); } else if (j0 < 256) { pj = 256 + (j0 - 128); qj = 384 + (j0 - 128); } else { pj = 512 + (j0 - 256); qj = 544 + (j0 - 256); }
            const u32x4 pv = *(const u32x4*)(LO + (size_t)t * LO_W + pj); u32x4 qv = {0u, 0u, 0u, 0u}; if (has_prev) qv = *(const u32x4*)(LO + (size_t)(t - 1) * LO_W + qj);
            const unsigned pw[4] = {pv.x, pv.y, pv.z, pv.w}, qw[4] = {qv.x, qv.y, qv.z, qv.w}; float v[8];
#pragma unroll
            for (int q = 0; q < 4; ++q) { v[2 * q] = bflo(pw[q]) + bflo(qw[q]); v[2 * q + 1] = bfhi(pw[q]) + bfhi(qw[q]); }
            if (j0 < 64) {
#pragma unroll
                for (int e = 0; e < 8; ++e) v[e] = 1.0f - 2.0f * __builtin_amdgcn_rcpf(1.0f + __expf(2.0f * v[e]));
            } else if (j0 >= 128 && j0 < 256) {
#pragma unroll
                for (int e = 0; e < 8; ++e) v[e] = sigmoidf_(v[e]);
            }
            u32x4 w; w.x = pk2(v[0], v[1]); w.y = pk2(v[2], v[3]); w.z = pk2(v[4], v[5]); w.w = pk2(v[6], v[7]);
            *(LAS u32x4*)(act + tt * ACT_P + j0 * 2) = w; }
        { int cw = 64 * F.wave + 16 * g; asm volatile("" : "+v"(cw));
          u32x4 kc[4][2], kq0[2];
          const bf16_t* RWt = RW + (size_t)t0 * 1536; const unsigned lk = (unsigned)(r16 * 1536 + 512 + cw);
#pragma unroll
          for (int tt = 0; tt < 4; ++tt) {
#pragma unroll
              for (int h = 0; h < 2; ++h) kc[tt][h] = *(const u32x4*)(RWt + 16 * tt * 1536 + 8 * h + lk); }
          { const int t = t0 + r16; const bool has_prev = (t % SEQ) != 0;
#pragma unroll
            for (int h = 0; h < 2; ++h) { kq0[h] = (u32x4){0u, 0u, 0u, 0u}; if (has_prev) kq0[h] = *(const u32x4*)(RWt - 1536 + 8 * h + lk); } }
#pragma unroll
          for (int tt = 0; tt < 4; ++tt) { float ss = 0.f;
#pragma unroll
              for (int h = 0; h < 2; ++h) {
                  const unsigned cwd[4] = {kc[tt][h].x, kc[tt][h].y, kc[tt][h].z, kc[tt][h].w}; unsigned pwd[4];
                  if (tt == 0) { pwd[0] = kq0[h].x; pwd[1] = kq0[h].y; pwd[2] = kq0[h].z; pwd[3] = kq0[h].w; }
                  else { const unsigned owd[4] = {kc[tt > 0 ? tt - 1 : 0][h].x, kc[tt > 0 ? tt - 1 : 0][h].y, kc[tt > 0 ? tt - 1 : 0][h].z, kc[tt > 0 ? tt - 1 : 0][h].w};
#pragma unroll
                      for (int d = 0; d < 4; ++d) pwd[d] = prev_lane(owd[d], cwd[d]); }
#pragma unroll
                  for (int d2 = 0; d2 < 2; ++d2) { const f32x4 muk = *(const LAS f32x4*)(PRM + 512 + cw + 8 * h + 4 * d2), kkc = *(const LAS f32x4*)(PRM + 2560 + cw + 8 * h + 4 * d2);
                      const float k0 = bflo(cwd[2 * d2]), k1 = bfhi(cwd[2 * d2]), k2 = bflo(cwd[2 * d2 + 1]), k3 = bfhi(cwd[2 * d2 + 1]), q0 = bflo(pwd[2 * d2]), q1 = bfhi(pwd[2 * d2]), q2 = bflo(pwd[2 * d2 + 1]), q3 = bfhi(pwd[2 * d2 + 1]);
                      const float a0 = (k0 + (q0 - k0) * muk[0]) * kkc[0], a1 = (k1 + (q1 - k1) * muk[1]) * kkc[1], a2 = (k2 + (q2 - k2) * muk[2]) * kkc[2], a3 = (k3 + (q3 - k3) * muk[3]) * kkc[3];
                      ss += (a0 * a0 + a1 * a1) + (a2 * a2 + a3 * a3); } }
              ss += __shfl_xor(ss, 16); ss += __shfl_xor(ss, 32);
              if (g == 0) INVL[(16 * tt + r16) * 8 + F.wave] = __builtin_amdgcn_rsqf(fmaxf(ss, 1e-24f)); } }
        __syncthreads();
#pragma unroll 1
        for (int j8 = 0; j8 < ((PREP_DUP & 8) ? 4 : 2); ++j8) { const int j = j8 & 1;
            int cb = 256 * j + 32 * F.wave; asm volatile("" : "+v"(cb));
            const int c0 = cb + 8 * g, hd = 4 * j + (F.wave >> 1);
            bf16x8 wf[2][9];
#pragma unroll
            for (int u = 0; u < 2; ++u) { const unsigned char* wrow = L2T + (size_t)(cb + 8 * (r16 >> 2) + 4 * u + (r16 & 3)) * 576 + 16 * g;
#pragma unroll
              for (int s = 0; s < 9; ++s) wf[u][s] = *(const bf16x8*)(wrow + 64 * s); }
            u32x4 cur[2][3], vfl[2], prv0[3]; unsigned rot[3][4] = {{0u, 0u, 0u, 0u}, {0u, 0u, 0u, 0u}, {0u, 0u, 0u, 0u}};
            const bf16_t* RWt = RW + (size_t)t0 * 1536; const unsigned lr = (unsigned)(r16 * 1536 + c0), lc = (unsigned)(r16 * CW + c0);
            const size_t tb = (size_t)t0 * CW;
#define PREP_LOAD(buf, tt_) do { _Pragma("unroll") for (int p_ = 0; p_ < 3; ++p_) cur[buf][p_] = *(const u32x4*)(RWt + 16 * (tt_) * 1536 + 512 * p_ + lr); \
                vfl[buf] = (u32x4){0u, 0u, 0u, 0u}; if (l > 0) vfl[buf] = *(const u32x4*)(VF + tb + 16 * (tt_) * CW + lc); } while (0)
            PREP_LOAD(0, 0);
            { const int t = t0 + r16; const bool has_prev = (t % SEQ) != 0;
#pragma unroll
              for (int p_ = 0; p_ < 3; ++p_) { prv0[p_] = (u32x4){0u, 0u, 0u, 0u}; if (has_prev) prv0[p_] = *(const u32x4*)(RWt - 1536 + 512 * p_ + lr); } }
#pragma unroll
            for (int tt = 0; tt < 4; ++tt) {
                const int bi = tt & 1;
                if (tt < 3) PREP_LOAD(bi ^ 1, tt + 1);
                const size_t oo = tb + 16 * tt * CW; const unsigned os = (unsigned)(16 * tt * CW) + lc;
                bf16x8 a[9];
#pragma unroll
                for (int s = 0; s < 9; ++s) a[s] = *(const LAS bf16x8*)(act + (16 * tt + r16) * ACT_P + (32 * s + 8 * g) * 2);
                const float inv = INVL[(16 * tt + r16) * 8 + hd];
                f32x4 aw[2], aa[2], ag[2], av[2];
#pragma unroll
                for (int u = 0; u < 2; ++u) { aw[u] = (f32x4){0.f, 0.f, 0.f, 0.f}; aa[u] = aw[u]; ag[u] = aw[u]; av[u] = aw[u];
                    aw[u] = mfma16(wf[u][0], a[0], aw[u]); aw[u] = mfma16(wf[u][1], a[1], aw[u]);
                    aa[u] = mfma16(wf[u][2], a[2], aa[u]); aa[u] = mfma16(wf[u][3], a[3], aa[u]);
                    ag[u] = mfma16(wf[u][4], a[4], ag[u]); ag[u] = mfma16(wf[u][5], a[5], ag[u]); ag[u] = mfma16(wf[u][6], a[6], ag[u]); ag[u] = mfma16(wf[u][7], a[7], ag[u]);
                    if (l > 0) av[u] = mfma16(wf[u][8], a[8], av[u]); }
                unsigned cw_[3][4], pw_[3][4];
#pragma unroll
                for (int p_ = 0; p_ < 3; ++p_) { cw_[p_][0] = cur[bi][p_].x; cw_[p_][1] = cur[bi][p_].y; cw_[p_][2] = cur[bi][p_].z; cw_[p_][3] = cur[bi][p_].w;
                    if (tt == 0) { pw_[p_][0] = prv0[p_].x; pw_[p_][1] = prv0[p_].y; pw_[p_][2] = prv0[p_].z; pw_[p_][3] = prv0[p_].w; }
                    else { pw_[p_][0] = shr1_keep(rot[p_][0], cw_[p_][0]); pw_[p_][1] = shr1_keep(rot[p_][1], cw_[p_][1]); pw_[p_][2] = shr1_keep(rot[p_][2], cw_[p_][2]); pw_[p_][3] = shr1_keep(rot[p_][3], cw_[p_][3]); }
#pragma unroll
                    for (int d = 0; d < 4; ++d) rot[p_][d] = ror1(cw_[p_][d]); }
                const unsigned vw_[4] = {vfl[bi].x, vfl[bi].y, vfl[bi].z, vfl[bi].w};
                float ro8[8], lw8[8], vo8[8], k28[8], ka8[8], kb8[8], g8[8];
#pragma unroll
                for (int u = 0; u < 2; ++u) {
                    const f32x4 mur = *(const LAS f32x4*)(PRM + c0 + 4 * u), muk = *(const LAS f32x4*)(PRM + 512 + c0 + 4 * u), muv = *(const LAS f32x4*)(PRM + 1024 + c0 + 4 * u), w0v = *(const LAS f32x4*)(PRM + 1536 + c0 + 4 * u),
                                a0v = *(const LAS f32x4*)(PRM + 2048 + c0 + 4 * u), kkc = *(const LAS f32x4*)(PRM + 2560 + c0 + 4 * u), kac = *(const LAS f32x4*)(PRM + 3072 + c0 + 4 * u), v0v = *(const LAS f32x4*)(PRM + 3584 + c0 + 4 * u);
#pragma unroll
                    for (int r = 0; r < 4; ++r) { const int e = 4 * u + r, d = e >> 1;
                        const float rp = (e & 1) ? bfhi(cw_[0][d]) : bflo(cw_[0][d]), kp = (e & 1) ? bfhi(cw_[1][d]) : bflo(cw_[1][d]), vp = (e & 1) ? bfhi(cw_[2][d]) : bflo(cw_[2][d]);
                        const float rq = (e & 1) ? bfhi(pw_[0][d]) : bflo(pw_[0][d]), kq_ = (e & 1) ? bfhi(pw_[1][d]) : bflo(pw_[1][d]), vq = (e & 1) ? bfhi(pw_[2][d]) : bflo(pw_[2][d]);
                        const float rr = rp + (rq - rp) * mur[r], k = kp + (kq_ - kp) * muk[r]; float v = vp + (vq - vp) * muv[r];
                        lw8[e] = -0.60653066f * sigmoidf_(w0v[r] + aw[u][r]);
                        const float alr = sigmoidf_(a0v[r] + aa[u][r]);
                        if (l > 0) { const float vf = (e & 1) ? bfhi(vw_[d]) : bflo(vw_[d]); v = v + (vf - v) * sigmoidf_(v0v[r] + av[u][r]); }
                        const float kk = k * kkc[r] * inv;
                        ro8[e] = rr; vo8[e] = v; k28[e] = k * (1.f + (alr - 1.f) * kac[r]); ka8[e] = kk; kb8[e] = kk * alr; g8[e] = ag[u][r]; } }
#define PREP_ST(ptr, arr) { u32x4 w_; w_.x = pk2(arr[0], arr[1]); w_.y = pk2(arr[2], arr[3]); w_.z = pk2(arr[4], arr[5]); w_.w = pk2(arr[6], arr[7]); *(u32x4*)(ptr) = w_; }
                PREP_ST(SIr + oo + lc, ro8) PREP_ST(SCw + os, lw8) PREP_ST(Gb + oo + lc, g8) PREP_ST((l > 0 ? V1 : VF) + oo + lc, vo8) PREP_ST(SIk + oo + lc, k28) PREP_ST(SCa + os, ka8) PREP_ST(SCb + os, kb8)
#undef PREP_ST
                asm volatile("" ::: "memory");
            }
#undef PREP_LOAD
        }
    }
}
constexpr int NUNIT = NB * NH * (SEQ / 64);
constexpr size_t U_PMP = 0, U_RPP = 8192, U1_BYTES = 16384;
constexpr size_t U_QMT = 0, U_YLT = 8192, U2_BYTES = 16384;
DI int permk(int k) { return (k & 32) | (((k >> 2) & 3) << 3) | (((k >> 4) & 1) << 2) | (k & 3); }
constexpr int MP = 144;
constexpr int SP = 80;
DI f32x4 mm_tile(const LAS unsigned char* xb, int px, int m0, const LAS unsigned char* yb, int py, int n0, int ks, f32x4 acc, int lane, int sx = 0, int sy = 0) {
    const int r16 = lane & 15, g = lane >> 4; const int fx = (m0 >> 4) & sx, fy = (n0 >> 4) & sy;
    for (int s = 0; s < ks; ++s) {
        const bf16x8 a = *(const LAS bf16x8*)(xb + (m0 + r16) * px + (((4 * s + g) ^ fx) << 4));
        const bf16x8 b = *(const LAS bf16x8*)(yb + (n0 + r16) * py + (((4 * s + g) ^ fy) << 4));
        acc = mfma16(a, b, acc);
    }
    return acc;
}
DI u32x2 pk4(f32x4 v) { u32x2 w; w.x = pk2(v[0], v[1]); w.y = pk2(v[2], v[3]); return w; }

#ifndef SA_TOUCH
#define SA_TOUCH 1
#endif
#ifndef SA_DUP
#define SA_DUP 0
#endif
#define SA_REP(bit) for (int sd_ = 0; sd_ < ((SA_DUP & (bit)) ? 2 : 1); ++sd_)
DI void phase_scan_a(Frame& F, int l, int u_lo, int u_hi, int u_step) {
    LAS unsigned char* const L = F.lds;
#define MB(n) (L + (n) * 9216)
    LAS float* const Gf = (LAS float*)(L + 110592);
    constexpr int GP = 68;
    LAS float* const SEG = (LAS float*)(L + 110592 + 64 * GP * 4);
    LAS float* const GL = SEG + 512;
    LAS unsigned char* const A21 = L + 110592 + 64 * GP * 4 + 2048 + 256;
    LAS unsigned char* const T11T = A21 + 2560;
    LAS unsigned char* const ZT = T11T + 2560;
    const bf16_t* SIr = (const bf16_t*)(F.wsp() + WS_SIR); const bf16_t* SIk = (const bf16_t*)(F.wsp() + WS_SIK);
    const bf16_t* SCw = (const bf16_t*)(F.wsp() + WS_SCRW) + (size_t)F.bid * 64 * CW; const bf16_t* SCa = (const bf16_t*)(F.wsp() + WS_SCRA) + (size_t)F.bid * 64 * CW; const bf16_t* SCb = (const bf16_t*)(F.wsp() + WS_SCRB) + (size_t)F.bid * 64 * CW;
    const bf16_t* V = (const bf16_t*)(F.wsp() + (l > 0 ? WS_V1 : WS_VF));
    const int lane = F.lane, wave = F.wave, r16 = lane & 15, g = lane >> 4;
    float plw[8]; u32x4 prv, pkv, pav, pbv, pvv;
#define SCANA_LOAD(uu) do { const int bh_ = (uu) & 31, c_ = (uu) >> 5, b_ = bh_ >> 3, h_ = bh_ & 7; const size_t t0_ = (size_t)b_ * SEQ + c_ * 64; \
        { const int k_ = F.tid & 63, seg_ = F.tid >> 6; _Pragma("unroll") for (int e = 0; e < 8; ++e) plw[e] = bf2f(SCw[(size_t)(8 * seg_ + e) * CW + h_ * 64 + k_]); } \
        { const int i_ = F.tid >> 3, k0_ = (F.tid & 7) * 8; const size_t go_ = (t0_ + i_) * CW + h_ * 64 + k0_, gs_ = (size_t)i_ * CW + h_ * 64 + k0_; \
          prv = *(const u32x4*)(SIr + go_); pkv = *(const u32x4*)(SIk + go_); pav = *(const u32x4*)(SCa + gs_); pbv = *(const u32x4*)(SCb + gs_); pvv = *(const u32x4*)(V + go_); } } while (0)
    if (u_lo < u_hi) SCANA_LOAD(u_lo);
    for (int u = u_lo; u < u_hi; u += u_step) {
        const int bh = u & 31, c = u >> 5, b = bh >> 3, h = bh & 7;
        const size_t t0 = (size_t)b * SEQ + c * 64; (void)t0; (void)b; (void)h;
        unsigned char* const rec1 = F.wsp() + WS_SC1 + (size_t)((bh * 128) + c) * U1_BYTES; unsigned char* const rec2 = F.wsp() + WS_SC2 + (size_t)((bh * 128) + c) * U2_BYTES;
        __syncthreads();
        SA_REP(1) {
        { const int k = F.tid & 63, seg = F.tid >> 6; float p[8]; float run = 0.f;
#pragma unroll
          for (int e = 0; e < 8; ++e) { run += plw[e]; p[e] = run; }
          SEG[seg * 64 + k] = run;
          __syncthreads();
          float off = 0.f;
#pragma unroll
          for (int s = 0; s < 8; ++s) off += (s < seg) ? SEG[s * 64 + k] : 0.f;
#pragma unroll
          for (int e = 0; e < 8; ++e) Gf[(8 * seg + e) * GP + k] = off + p[e];
        }
        __syncthreads();
        { const int i = F.tid >> 3, k0 = (F.tid & 7) * 8;
          const u32x4 rv = prv, kv = pkv, av = pav, bv = pbv, vv = pvv;
          float fr[8], fk[8], fa[8], fb[8], fv[8];
          const unsigned rw[4] = {rv.x, rv.y, rv.z, rv.w}, kw[4] = {kv.x, kv.y, kv.z, kv.w}, aw[4] = {av.x, av.y, av.z, av.w}, bw[4] = {bv.x, bv.y, bv.z, bv.w}, vw[4] = {vv.x, vv.y, vv.z, vv.w};
#pragma unroll
          for (int q = 0; q < 4; ++q) { fr[2 * q] = bflo(rw[q]); fr[2 * q + 1] = bfhi(rw[q]); fk[2 * q] = bflo(kw[q]); fk[2 * q + 1] = bfhi(kw[q]); fa[2 * q] = bflo(aw[q]); fa[2 * q + 1] = bfhi(aw[q]);
              fb[2 * q] = bflo(bw[q]); fb[2 * q + 1] = bfhi(bw[q]); fv[2 * q] = bflo(vw[q]); fv[2 * q + 1] = bfhi(vw[q]); }
          float at[8], rt[8], bt[8], kt[8], bh8[8], kh8[8];
#pragma unroll
          for (int e = 0; e < 8; ++e) { const float gi = Gf[i * GP + k0 + e], gp = (i > 0) ? Gf[(i - 1) * GP + k0 + e] : 0.f, gl = Gf[63 * GP + k0 + e];
              const float e1 = __expf(gp), e2 = __expf(gi), e3 = __expf(-gi), e4 = __expf(gl - gi);
              at[e] = -fa[e] * e1; rt[e] = fr[e] * e2; bt[e] = fb[e] * e3; kt[e] = fk[e] * e3; bh8[e] = fb[e] * e4; kh8[e] = fk[e] * e4;
              if (i == 63) GL[k0 + e] = e2; }
          u32x4 w;
          w.x = pk2(at[0], at[1]); w.y = pk2(at[2], at[3]); w.z = pk2(at[4], at[5]); w.w = pk2(at[6], at[7]); *(LAS u32x4*)(MB(0) + i * MP + k0 * 2) = w;
          w.x = pk2(rt[0], rt[1]); w.y = pk2(rt[2], rt[3]); w.z = pk2(rt[4], rt[5]); w.w = pk2(rt[6], rt[7]); *(LAS u32x4*)(MB(1) + i * MP + k0 * 2) = w;
          w.x = pk2(bt[0], bt[1]); w.y = pk2(bt[2], bt[3]); w.z = pk2(bt[4], bt[5]); w.w = pk2(bt[6], bt[7]); *(LAS u32x4*)(MB(2) + i * MP + k0 * 2) = w;
          w.x = pk2(kt[0], kt[1]); w.y = pk2(kt[2], kt[3]); w.z = pk2(kt[4], kt[5]); w.w = pk2(kt[6], kt[7]); *(LAS u32x4*)(MB(3) + i * MP + k0 * 2) = w;
          { const int sel = i & 1;
#pragma unroll
            for (int q = 0; q < 4; ++q) { const int row = k0 + 4 * sel + q; const int ro = row * MP + (((i >> 3) ^ ((row >> 4) & 3)) << 4) + (i & 6) * 2;
#define TW(dst, arr) { const float d0_ = dpp_mov<0x128>(arr[q]), d1_ = dpp_mov<0x128>(arr[4 + q]);     \
                       const float m_ = sel ? arr[4 + q] : arr[q], o_ = sel ? d1_ : d0_; *(LAS unsigned*)(dst + ro) = pk2(sel ? o_ : m_, sel ? m_ : o_); }
                TW(MB(4), at) TW(MB(5), fv) TW(MB(6), bh8) TW(MB(7), kh8)
#undef TW
            } }
        }
        __syncthreads(); }
        if (u + u_step < u_hi) SCANA_LOAD(u + u_step);
        __syncthreads();
        SA_REP(2) {
        { const int prod = wave >> 1;
          const LAS unsigned char* xb = (prod & 1) ? MB(3) : MB(2); const LAS unsigned char* yb = (prod < 2) ? MB(0) : MB(1);
          LAS unsigned char* ob = (prod == 1) ? MB(8) : (prod == 2) ? MB(9) : MB(10);
          float zf = 0.f; asm volatile("" : "+v"(zf));
          for (int q = 0; q < 8; ++q) { const int tt = (wave & 1) * 8 + q, tm = tt >> 2, tn = tt & 3;
              f32x4 acc = {zf, zf, zf, zf};
              if (tm <= tn) acc = mm_tile(xb, MP, 16 * tm, yb, MP, 16 * tn, 2, acc, lane);
              const int i = 16 * tn + r16, j0 = 16 * tm + 4 * g;
#pragma unroll
              for (int r = 0; r < 4; ++r) { const int j = j0 + r; const bool keep = (prod < 2) ? (j < i) : (j <= i); if (!keep) acc[r] = 0.f; }
              if (prod == 0) {
                  if ((i >> 5) == (j0 >> 5)) *(LAS f32x4*)(Gf + ((i >> 5) * 32 + (i & 31)) * 32 + (j0 & 31)) = acc;
                  if (i >= 32 && j0 < 32) *(LAS u32x2*)(A21 + (i - 32) * SP + j0 * 2) = pk4(acc);
              } else *(LAS u32x2*)(ob + i * MP + j0 * 2) = pk4(acc);
          } }
        __syncthreads();
        }
        f32x4 pyl[2] = {{0.f, 0.f, 0.f, 0.f}, {0.f, 0.f, 0.f, 0.f}}, pqm[2] = {{0.f, 0.f, 0.f, 0.f}, {0.f, 0.f, 0.f, 0.f}};
        SA_REP(4) {
        if (wave == 0) {
            const int blk = lane >> 5, cc = lane & 31; const LAS float* AD = Gf + blk * 1024;
            float Tc[32];
#pragma unroll
            for (int i = 0; i < 32; ++i) { float a0 = (i == cc) ? 1.f : 0.f, a1 = 0.f, a2 = 0.f, a3 = 0.f;
#pragma unroll
                for (int q = 0; q < (i + 3) / 4; ++q) { const f32x4 a = *(const LAS f32x4*)(AD + i * 32 + 4 * q);
                    if (4 * q + 0 < i) a0 += a[0] * Tc[4 * q + 0]; if (4 * q + 1 < i) a1 += a[1] * Tc[4 * q + 1]; if (4 * q + 2 < i) a2 += a[2] * Tc[4 * q + 2]; if (4 * q + 3 < i) a3 += a[3] * Tc[4 * q + 3]; }
                Tc[i] = (a0 + a1) + (a2 + a3); }
#pragma unroll
            for (int i = 0; i < 32; ++i) *(LAS bf16_t*)(MB(11) + (32 * blk + i) * MP + (32 * blk + cc) * 2) = f2bf(Tc[i]);
            if (blk == 0) {
#pragma unroll
                for (int q = 0; q < 4; ++q) { u32x4 w; w.x = pk2(Tc[8 * q], Tc[8 * q + 1]); w.y = pk2(Tc[8 * q + 2], Tc[8 * q + 3]); w.z = pk2(Tc[8 * q + 4], Tc[8 * q + 5]); w.w = pk2(Tc[8 * q + 6], Tc[8 * q + 7]);
                    *(LAS u32x4*)(T11T + cc * SP + q * 16) = w; }
            } else {
                unsigned z = 0u; asm volatile("" : "+v"(z));
#pragma unroll
                for (int q = 0; q < 4; ++q) *(LAS u32x4*)(MB(11) + cc * MP + 64 + q * 16) = (u32x4){z, z, z, z};
            }
        } else {
            for (int tt = wave - 1; tt < 16; tt += 7) { const int tm = tt >> 2, tn = tt & 3;
                f32x4 acc = {0.f, 0.f, 0.f, 0.f};
                acc = mm_tile(MB(8), MP, 16 * tm, MB(5), MP, 16 * tn, 2, acc, lane, 0, 3);
                *(LAS u32x2*)(MB(2) + (16 * tn + r16) * MP + (16 * tm + 4 * g) * 2) = pk4(acc); }
            if (sd_ == 0) {
#pragma unroll
                for (int q = 0; q < 2; ++q) { const int tt = wave * 2 + q, tm = tt >> 2, tn = tt & 3; const f32x4 z = {0.f, 0.f, 0.f, 0.f};
                    pyl[q] = mm_tile(MB(5), MP, 16 * tm, MB(10), MP, 16 * tn, 2, z, lane, 3, 0);
                    pqm[q] = mm_tile(MB(7), MP, 16 * tm, MB(5), MP, 16 * tn, 2, z, lane, 3, 3); } }
        }
        __syncthreads();
        if (wave < 4) { const int tm = wave >> 1, tn = wave & 1; f32x4 acc = {0.f, 0.f, 0.f, 0.f};
            acc = mm_tile(A21, SP, 16 * tm, T11T, SP, 16 * tn, 1, acc, lane);
            *(LAS u32x2*)(ZT + (16 * tn + r16) * SP + (16 * tm + 4 * g) * 2) = pk4(acc); }
        __syncthreads();
        if (wave < 4) { const int tm = wave >> 1, tn = wave & 1; f32x4 acc = {0.f, 0.f, 0.f, 0.f};
            acc = mm_tile(ZT, SP, 16 * tm, MB(11) + 32 * MP + 64, MP, 16 * tn, 1, acc, lane);
            *(LAS u32x2*)(MB(11) + (32 + 16 * tn + r16) * MP + (16 * tm + 4 * g) * 2) = pk4(acc); }
        __syncthreads();
        }
        SA_REP(8) {
        { const LAS unsigned char* yb = (wave < 4) ? MB(4) : MB(2); LAS unsigned char* ob = (wave < 4) ? MB(3) : MB(0);
          for (int q = 0; q < 4; ++q) { const int tt = (wave & 3) * 4 + q, tm = tt >> 2, tn = tt & 3;
              f32x4 acc = {0.f, 0.f, 0.f, 0.f};
              acc = mm_tile(MB(11), MP, 16 * tm, yb, MP, 16 * tn, 2, acc, lane, 0, (wave < 4) ? 3 : 0);
              *(LAS u32x2*)(ob + (16 * tn + r16) * MP + (16 * tm + 4 * g) * 2) = pk4(acc); } }
        __syncthreads();
        }
#if SA_TOUCH
        asm volatile("" : "+v"(plw[0]), "+v"(plw[1]), "+v"(plw[2]), "+v"(plw[3]), "+v"(plw[4]), "+v"(plw[5]), "+v"(plw[6]), "+v"(plw[7]), "+v"(prv), "+v"(pkv), "+v"(pav), "+v"(pbv), "+v"(pvv));
#endif
        SA_REP(16) {
#pragma unroll
        for (int q = 0; q < 2; ++q) { const int tt = wave * 2 + q, tm = tt >> 2, tn = tt & 3;
            { f32x4 acc = {0.f, 0.f, 0.f, 0.f}; acc = mm_tile(MB(3), MP, 16 * tm, MB(9), MP, 16 * tn, 2, acc, lane);
              const int i = 16 * tn + r16, k0 = 16 * tm + 4 * g; const u32x2 rr = *(const LAS u32x2*)(MB(1) + i * MP + k0 * 2);
              acc[0] += bflo(rr.x); acc[1] += bfhi(rr.x); acc[2] += bflo(rr.y); acc[3] += bfhi(rr.y);
              *(u32x2*)(rec1 + U_RPP + (size_t)(i * 64 + permk(k0)) * 2) = pk4(acc); }
            { f32x4 acc = {0.f, 0.f, 0.f, 0.f}; acc = mm_tile(MB(3), MP, 16 * tm, MB(6), MP, 16 * tn, 2, acc, lane, 0, 3);
              const int kp = 16 * tn + r16, k0 = 16 * tm + 4 * g;
#pragma unroll
              for (int r = 0; r < 4; ++r) if (k0 + r == kp) acc[r] += GL[kp];
              *(u32x2*)(rec1 + U_PMP + (size_t)(kp * 64 + permk(k0)) * 2) = pk4(acc); }
            { f32x4 acc = pyl[q]; acc = mm_tile(MB(0), MP, 16 * tm, MB(9), MP, 16 * tn, 2, acc, lane); if (wave == 0) acc = mm_tile(MB(5), MP, 16 * tm, MB(10), MP, 16 * tn, 2, acc, lane, 3, 0);
              *(u32x2*)(rec2 + U_YLT + (size_t)((16 * tn + r16) * 64 + 16 * tm + 4 * g) * 2) = pk4(acc); }
            { f32x4 acc = pqm[q]; acc = mm_tile(MB(6), MP, 16 * tm, MB(0), MP, 16 * tn, 2, acc, lane, 3, 0); if (wave == 0) acc = mm_tile(MB(7), MP, 16 * tm, MB(5), MP, 16 * tn, 2, acc, lane, 3, 3);
              *(u32x2*)(rec2 + U_QMT + (size_t)((16 * tn + r16) * 64 + 16 * tm + 4 * g) * 2) = pk4(acc); }
        }
        __syncthreads(); }
    }
#undef MB
#undef SCANA_LOAD
}

constexpr int SB_D = 9, SB_SLOT = 16384;
DI void scanb_issue(LAS unsigned char* lds, const unsigned char* r1b, const unsigned char* r2b, int cidx, int lw, int lane) {
    const unsigned char* rec1 = r1b + (size_t)cidx * U1_BYTES; const unsigned char* rec2 = r2b + (size_t)cidx * U2_BYTES;
    LAS unsigned char* slot = lds + (cidx % SB_D) * SB_SLOT;
#pragma unroll
    for (int i = 0; i < 2; ++i) { const int ci = 2 * lw + i;
        const int row = 8 * ci + (lane >> 3), sl = lane & 7;
        __builtin_amdgcn_global_load_lds((const unsigned*)(rec1 + U_PMP + row * 128 + ((sl ^ (row & 7)) << 4)), (LAS unsigned*)(slot + ci * 1024), 16, 0, 0); }
#pragma unroll
    for (int i = 0; i < 2; ++i) { const int ci = 2 * lw + i;
        const int v = 8 * ci + (lane >> 3), sl = lane & 7;
        __builtin_amdgcn_global_load_lds((const unsigned*)(rec2 + U_QMT + v * 128 + ((sl ^ (v & 7)) << 4)), (LAS unsigned*)(slot + 8192 + ci * 1024), 16, 0, 0); }
}
constexpr int CW_SFLG = 12288;
DI void phase_scan_b(Frame& F, int l) {
    const int lane = F.lane, r16 = lane & 15, g = lane >> 4, w = F.wave, v = 16 * (w & 3) + r16;
    for (int bh = F.bid; bh < NB * NH; bh += F.G) {
        const unsigned char* r1 = F.wsp() + WS_SC1 + (size_t)bh * 128 * U1_BYTES; const unsigned char* r2 = F.wsp() + WS_SC2 + (size_t)bh * 128 * U2_BYTES;
        bf16_t* sct = (bf16_t*)(F.wsp() + WS_SCT) + (size_t)bh * 128 * 4096;
        const __amdgpu_buffer_rsrc_t srs = __builtin_amdgcn_make_buffer_rsrc((void*)sct, 0, 128 * 8192, 0x00020000);
        GAS unsigned* flg = (GAS unsigned*)(F.ws_g + WS_CTL) + CW_SFLG + 64 * (l * 32 + bh);
        f32x4 sT[4];
        float zf = 0.f; asm volatile("" : "+v"(zf));
#pragma unroll
        for (int i = 0; i < 4; ++i) sT[i] = (f32x4){zf, zf, zf, zf};
        __syncthreads();
        if (w >= 4) {
#pragma unroll
            for (int d = 0; d < SB_D; ++d) scanb_issue(F.lds, r1, r2, d, w - 4, lane);
        }
        for (int c = 0; c < 128; ++c) {
            if (w >= 4) asm volatile("s_waitcnt vmcnt(28)" ::: "memory");
            __builtin_amdgcn_s_barrier();
            asm volatile("" ::: "memory");
            if (w >= 4) {
                if (c >= 1) { const int cn = c - 1 + SB_D; scanb_issue(F.lds, r1, r2, cn < 128 ? cn : c, w - 4, lane); }
            } else {
                const LAS unsigned char* slot = F.lds + (c % SB_D) * SB_SLOT;
                bf16x8 pm[4][2]; f32x4 q[4];
#pragma unroll
                for (int mt = 0; mt < 4; ++mt) { const int row = 16 * mt + r16;
#pragma unroll
                    for (int s2 = 0; s2 < 2; ++s2) pm[mt][s2] = *(const LAS bf16x8*)(slot + row * 128 + (((4 * s2 + g) ^ (row & 7)) << 4));
                    { const u32x2 qw = *(const LAS u32x2*)(slot + 8192 + v * 128 + (((2 * mt + (g >> 1)) ^ (v & 7)) << 4) + (g & 1) * 8); q[mt] = (f32x4){bflo(qw.x), bfhi(qw.x), bflo(qw.y), bfhi(qw.y)}; } }
                bf16x8 hi[2], lo[2];
#pragma unroll
                for (int s2 = 0; s2 < 2; ++s2) { u32x4 hw, lw;
#pragma unroll
                    for (int qq = 0; qq < 2; ++qq) { const f32x4 x = sT[2 * s2 + qq]; const unsigned h0 = pk2(x[0], x[1]), h1 = pk2(x[2], x[3]);
                        const unsigned l0 = pk2(x[0] - bflo(h0), x[1] - bfhi(h0)), l1 = pk2(x[2] - bflo(h1), x[3] - bfhi(h1));
                        if (qq == 0) { hw.x = h0; hw.y = h1; lw.x = l0; lw.y = l1; } else { hw.z = h0; hw.w = h1; lw.z = l0; lw.w = l1; } }
                    hi[s2] = __builtin_bit_cast(bf16x8, hw); lo[s2] = __builtin_bit_cast(bf16x8, lw);
                    __builtin_amdgcn_raw_buffer_store_b128(hw, srs, (int)(((unsigned)c * 4096u + (unsigned)v * 64u + 32u * s2 + 8u * g) * 2u), 0, 16); }
#pragma unroll
                for (int mt = 0; mt < 4; ++mt) { f32x4 n = q[mt];
#pragma unroll
                    for (int s2 = 0; s2 < 2; ++s2) { n = mfma16(pm[mt][s2], hi[s2], n); n = mfma16(pm[mt][s2], lo[s2], n); }
                    sT[mt] = n; }
                asm volatile("s_waitcnt lgkmcnt(0)" ::: "memory");
                if ((c & 3) == 3 && c >= 7) { asm volatile("s_waitcnt vmcnt(8)" ::: "memory");
                    if (lane == 0) __hip_atomic_fetch_add(flg, 1u, __ATOMIC_RELAXED, __HIP_MEMORY_SCOPE_AGENT); }
            }
        }
        asm volatile("s_waitcnt vmcnt(0)" ::: "memory");
        if (w < 4 && lane == 0) __hip_atomic_fetch_add(flg, 1u, __ATOMIC_RELAXED, __HIP_MEMORY_SCOPE_AGENT);
    }
}

struct ScanCIn { bf16x8 ra[2]; f32x4 yl[4]; bf16x8 sb[4][2]; };
DI void scanc_load(ScanCIn& o, const unsigned char* ws, GAS unsigned* flags, int item, int r16, int g) {
    asm volatile("" : "+s"(item));
    const int u = item >> 2, it = item & 3; const int bh = u & 31, c = u >> 5; const size_t ui = (size_t)(bh * 128 + c);
    {
      GAS unsigned* fw = flags + 64 * bh; const unsigned need = 4u * ((unsigned)(c >> 2) + 1u); unsigned spins = 0;
      while ((unsigned)__builtin_amdgcn_readfirstlane((int)__hip_atomic_load(fw, __ATOMIC_RELAXED, __HIP_MEMORY_SCOPE_AGENT)) < need) { __builtin_amdgcn_s_sleep(2); if (++spins > (1u << 20)) break; }
      asm volatile("" ::: "memory"); }
    const unsigned char* rec1 = ws + WS_SC1 + ui * U1_BYTES; const unsigned char* rec2 = ws + WS_SC2 + ui * U2_BYTES;
    const __amdgpu_buffer_rsrc_t srs = __builtin_amdgcn_make_buffer_rsrc((void*)(ws + WS_SCT + ui * 8192), 0, 8192, 0x00020000);
#pragma unroll
    for (int s = 0; s < 2; ++s) o.ra[s] = *(const bf16x8*)(rec1 + U_RPP + (size_t)((16 * it + r16) * 64 + 32 * s + 8 * g) * 2);
#pragma unroll
    for (int vt = 0; vt < 4; ++vt) { { const u32x2 yw = *(const u32x2*)(rec2 + U_YLT + (size_t)((16 * it + r16) * 64 + 32 * (vt >> 1) + 8 * g + 4 * (vt & 1)) * 2); o.yl[vt] = (f32x4){bflo(yw.x), bfhi(yw.x), bflo(yw.y), bfhi(yw.y)}; }
        const int vrow = 32 * (vt >> 1) + 8 * (r16 >> 2) + 4 * (vt & 1) + (r16 & 3);
#pragma unroll
        for (int s = 0; s < 2; ++s) o.sb[vt][s] = __builtin_bit_cast(bf16x8, __builtin_amdgcn_raw_buffer_load_b128(srs, (int)((vrow * 64 + 32 * s + 8 * g) * 2), 0, 16)); }
}
DI void scanc_item(const ScanCIn& o, Frame& F, int l, int item, int r16, int g) {
    const bf16_t* SIr = (const bf16_t*)(F.wsp() + WS_SIR); const bf16_t* SIk = (const bf16_t*)(F.wsp() + WS_SIK);
    const bf16_t* V = (const bf16_t*)(F.wsp() + (l > 0 ? WS_V1 : WS_VF)); const bf16_t* Gb = (const bf16_t*)(F.wsp() + WS_G); bf16_t* YR = (bf16_t*)(F.wsp() + WS_YRM);
    const int u = item >> 2, it = item & 3; const int bh = u & 31, c = u >> 5, b = bh >> 3, h = bh & 7;
    const size_t tok = (size_t)b * SEQ + c * 64 + 16 * it + r16; const size_t o0 = tok * CW + h * 64 + 8 * g, oy = tok * YRM_LD + h * 64 + 8 * g;
    u32x4 pr[2], pk[2], pv[2], pg[2];
#pragma unroll
    for (int p = 0; p < 2; ++p) { pr[p] = *(const u32x4*)(SIr + o0 + 32 * p); pk[p] = *(const u32x4*)(SIk + o0 + 32 * p); pv[p] = *(const u32x4*)(V + o0 + 32 * p); pg[p] = *(const u32x4*)(Gb + o0 + 32 * p); }
    f32x4 y[4];
#pragma unroll
    for (int vt = 0; vt < 4; ++vt) { y[vt] = o.yl[vt];
#pragma unroll
        for (int s = 0; s < 2; ++s) y[vt] = mfma16(o.sb[vt][s], o.ra[s], y[vt]); }
    float s1 = 0.f;
#pragma unroll
    for (int vt = 0; vt < 4; ++vt) s1 += (y[vt][0] + y[vt][1]) + (y[vt][2] + y[vt][3]);
    s1 += __shfl_xor(s1, 16); s1 += __shfl_xor(s1, 32);
    const float mean = s1 * (1.f / 64.f); float s2 = 0.f;
#pragma unroll
    for (int vt = 0; vt < 4; ++vt) { y[vt] = y[vt] - mean; s2 += (y[vt][0] * y[vt][0] + y[vt][1] * y[vt][1]) + (y[vt][2] * y[vt][2] + y[vt][3] * y[vt][3]); }
    s2 += __shfl_xor(s2, 16); s2 += __shfl_xor(s2, 32);
    const float rstd = __builtin_amdgcn_rsqf(s2 * (1.f / 64.f) + 64e-5f);
    const float* lng = F.inp(17) + l * CW + h * 64 + 8 * g; const float* lnb = F.inp(18) + l * CW + h * 64 + 8 * g; const float* rkp = F.inp(16) + l * CW + h * 64 + 8 * g;
    float s3 = 0.f;
#pragma unroll
    for (int p = 0; p < 2; ++p) { const f32x4 rk0 = *(const f32x4*)(rkp + 32 * p), rk1 = *(const f32x4*)(rkp + 32 * p + 4);
        s3 += bflo(pr[p].x) * bflo(pk[p].x) * rk0[0] + bfhi(pr[p].x) * bfhi(pk[p].x) * rk0[1] + bflo(pr[p].y) * bflo(pk[p].y) * rk0[2] + bfhi(pr[p].y) * bfhi(pk[p].y) * rk0[3]
            + bflo(pr[p].z) * bflo(pk[p].z) * rk1[0] + bfhi(pr[p].z) * bfhi(pk[p].z) * rk1[1] + bflo(pr[p].w) * bflo(pk[p].w) * rk1[2] + bfhi(pr[p].w) * bfhi(pk[p].w) * rk1[3]; }
    s3 += __shfl_xor(s3, 16); s3 += __shfl_xor(s3, 32);
#pragma unroll
    for (int p = 0; p < 2; ++p) { const f32x4 lg0 = *(const f32x4*)(lng + 32 * p), lg1 = *(const f32x4*)(lng + 32 * p + 4), lb0 = *(const f32x4*)(lnb + 32 * p), lb1 = *(const f32x4*)(lnb + 32 * p + 4);
        const f32x4 ya = y[2 * p], yb = y[2 * p + 1];
        const float o_0 = (ya[0] * rstd * lg0[0] + lb0[0] + s3 * bflo(pv[p].x)) * bflo(pg[p].x), o_1 = (ya[1] * rstd * lg0[1] + lb0[1] + s3 * bfhi(pv[p].x)) * bfhi(pg[p].x);
        const float o_2 = (ya[2] * rstd * lg0[2] + lb0[2] + s3 * bflo(pv[p].y)) * bflo(pg[p].y), o_3 = (ya[3] * rstd * lg0[3] + lb0[3] + s3 * bfhi(pv[p].y)) * bfhi(pg[p].y);
        const float o_4 = (yb[0] * rstd * lg1[0] + lb1[0] + s3 * bflo(pv[p].z)) * bflo(pg[p].z), o_5 = (yb[1] * rstd * lg1[1] + lb1[1] + s3 * bfhi(pv[p].z)) * bfhi(pg[p].z);
        const float o_6 = (yb[2] * rstd * lg1[2] + lb1[2] + s3 * bflo(pv[p].w)) * bflo(pg[p].w), o_7 = (yb[3] * rstd * lg1[3] + lb1[3] + s3 * bfhi(pv[p].w)) * bfhi(pg[p].w);
        u32x4 w; w.x = pk2(o_0, o_1); w.y = pk2(o_2, o_3); w.z = pk2(o_4, o_5); w.w = pk2(o_6, o_7); *(u32x4*)(YR + oy + 32 * p) = w; }
}
DI void phase_scan_c(Frame& F, int l, int nskip) {
    const int lane = F.lane, r16 = lane & 15, g = lane >> 4;
    const int first = (F.bid - nskip) * 8 + F.wave, stride = (F.G - nskip) * 8;
    if (first >= NUNIT * 4) return;
    GAS unsigned* flags = (GAS unsigned*)(F.ws_g + WS_CTL) + CW_SFLG + 64 * (l * 32);
    ScanCIn o0, o1;
    scanc_load(o0, F.wsp(), flags, first, r16, g);
    for (int item = first; item < NUNIT * 4; item += 2 * stride) {
        const int i1 = item + stride, i2 = item + 2 * stride;
        if (i1 < NUNIT * 4) scanc_load(o1, F.wsp(), flags, i1, r16, g);
        scanc_item(o0, F, l, item, r16, g);
        if (i1 < NUNIT * 4) { if (i2 < NUNIT * 4) scanc_load(o0, F.wsp(), flags, i2, r16, g); scanc_item(o1, F, l, i1, r16, g); }
    }
}

#ifndef FUSE_DUP
#define FUSE_DUP 0
#endif
DI void phase_prep_scana(Frame& F, int l) {
    phase_rwkv_prep2(F, l, 0, 0, 1, true);
#define RELANE() do { int l_ = F.lane; asm volatile("" : "+v"(l_)); F.lane = l_; F.tid = F.wave * 64 + l_; } while (0)
    for (int tile = F.bid; tile < T / 64; tile += F.G) {
        for (int fd_ = 0; fd_ < ((FUSE_DUP & 1) ? 2 : 1); ++fd_) {
        RELANE();
        phase_rwkv_prep2(F, l, tile, tile + 1, 1, false);
        }
        asm volatile("s_waitcnt vmcnt(0)" ::: "memory");
        __syncthreads();
        __builtin_amdgcn_fence(__ATOMIC_ACQUIRE, "agent");
        asm volatile("s_waitcnt vmcnt(0)" ::: "memory");
        const int b = tile >> 7, c = tile & 127; const int u0 = c * 32 + b * 8;
        for (int fd_ = 0; fd_ < ((FUSE_DUP & 2) ? 2 : 1); ++fd_) {
        RELANE();
        phase_scan_a(F, l, u0, u0 + 8, 1);
        }
    }
#undef RELANE
}
DI void phase_moba_prep(Frame& F, int l) {
    bf16_t* MO = (bf16_t*)(F.wsp() + WS_MO); float* KM = (float*)(F.wsp() + WS_TAB + TB_KMEAN);
    int c = F.tid; const float qg = F.inp(23)[l * 64 + (c & 63)] * 0.125f, kg = F.inp(24)[l * 64 + (c & 63)];
    for (int hs = F.bid; hs < T / 128; hs += F.G) {
        float ksum = 0.f;
        for (int tb = 0; tb < 128; tb += 8) {
            int tbase = hs * 128 + tb; asm volatile("" : "+s"(tbase), "+v"(c));
            float q[8], k[8];
#pragma unroll
            for (int e = 0; e < 8; ++e) { const size_t ro = (size_t)(tbase + e) * 1536; q[e] = bf2f(MO[ro + c]); k[e] = bf2f(MO[ro + 512 + c]); }
#pragma unroll
            for (int e = 0; e < 8; ++e) { const size_t ro = (size_t)(tbase + e) * 1536;
                const float qs = wave_sum(q[e] * q[e]) * (1.f / 64.f), ks = wave_sum(k[e] * k[e]) * (1.f / 64.f);
                const float qn = q[e] * (1.0f / sqrtf(qs + 1e-6f)) * qg, kn = k[e] * (1.0f / sqrtf(ks + 1e-6f)) * kg;
                MO[ro + c] = f2bf(qn); MO[ro + 512 + c] = f2bf(kn); ksum += kn; }
        }
        KM[(size_t)(hs & 1) * (TB_KMEAN2 / 4) + (size_t)(hs >> 1) * CW + c] = ksum * (1.f / 256.f);
    }
}
DI void phase_moba_gate(Frame& F) {
    LAS float* KL = (LAS float*)F.lds;
    const bf16_t* MO = (const bf16_t*)(F.wsp() + WS_MO); const float* KM = (const float*)(F.wsp() + WS_TAB + TB_KMEAN); unsigned* SEL = (unsigned*)(F.wsp() + WS_SEL);
    for (int sidx = F.bid; sidx < T / 64; sidx += F.G) {
        const int span = ((sidx / F.G) & 1) ? ((sidx & ~127) + (127 - (sidx & 127))) : sidx;
        const int t0 = span * 64, b = t0 / SEQ, blk = (t0 % SEQ) / 256;
        __syncthreads();
        { const int cc = F.tid, h = cc >> 6, d = cc & 63;
          for (int j0 = 0; j0 < blk; j0 += 8) { float v0[8], v1[8];
#pragma unroll
              for (int e = 0; e < 8; ++e) { const int j = (j0 + e < blk) ? j0 + e : blk - 1; const size_t ko = ((size_t)(b * 32 + j)) * CW + cc; v0[e] = KM[ko]; v1[e] = KM[ko + TB_KMEAN2 / 4]; }
#pragma unroll
              for (int e = 0; e < 8; ++e) if (j0 + e < blk) KL[h * 2052 + (j0 + e) * 64 + d] = v0[e] + v1[e]; } }
        __syncthreads();
        const int tok = F.tid >> 3, h = F.tid & 7; const int t = t0 + tok;
        float q[64];
        { const u32x4* qp = (const u32x4*)(MO + (size_t)t * 1536 + h * 64);
#pragma unroll
          for (int i = 0; i < 8; ++i) { const u32x4 w = qp[i]; q[8 * i] = bflo(w.x); q[8 * i + 1] = bfhi(w.x); q[8 * i + 2] = bflo(w.y); q[8 * i + 3] = bfhi(w.y); q[8 * i + 4] = bflo(w.z); q[8 * i + 5] = bfhi(w.z); q[8 * i + 6] = bflo(w.w); q[8 * i + 7] = bfhi(w.w); } }
        float v0 = -INFINITY, v1 = -INFINITY, v2 = -INFINITY; int i0 = 0, i1 = 1, i2 = 2;
        for (int j = 0; j < blk; ++j) {
            const LAS f32x4* kp = (const LAS f32x4*)(KL + h * 2052 + j * 64); float s = 0.f;
#pragma unroll
            for (int i = 0; i < 16; ++i) { const f32x4 kv = kp[i]; s += q[4 * i] * kv.x + q[4 * i + 1] * kv.y + q[4 * i + 2] * kv.z + q[4 * i + 3] * kv.w; }
            if (s > v0) { v2 = v1; i2 = i1; v1 = v0; i1 = i0; v0 = s; i0 = j; }
            else if (s > v1) { v2 = v1; i2 = i1; v1 = s; i1 = j; }
            else if (s > v2) { v2 = s; i2 = j; }
        }
        const int nv = blk < 3 ? blk : 3;
        SEL[(size_t)t * 8 + h] = (unsigned)i0 | ((unsigned)i1 << 8) | ((unsigned)i2 << 16) | ((unsigned)nv << 24);
    }
}

constexpr int KS_PITCH = 144, VT_PITCH = 520;
constexpr int NPIECE = 47;
constexpr int CW_QATT = 8192;
DI void phase_moba_attn(Frame& F, int l) {
    static constexpr unsigned PIECES[NPIECE] = {196608,1837578,590595,1574658,1115654,1640713,1968907,1443848,918789,1049857,1246983,393730,787456,721924,2034700,262401,2034179,2034957,2035214,2035471,2034692,2035728,2034944,2035985,2036242,2036499,2035461,2036756,2037013,2037270,2035969,2037527,2036230,2037784,2038041,2038298,2036743,2038555,2038812,2039069,2039326,2037512,2039583,2038018,2038281,2039050,2039563};
    LAS unsigned char* Ks = F.lds;
    LAS unsigned char* Vt = F.lds + 36864;
    LAS float* LUT = (LAS float*)(F.lds + 36864 + 33280);
    LAS unsigned* CTL = (LAS unsigned*)(F.lds + 36864 + 33280 + 528);
    LAS unsigned* LIST = CTL + 4;
    const bf16_t* MO = (const bf16_t*)(F.wsp() + WS_MO); const unsigned* SEL = (const unsigned*)(F.wsp() + WS_SEL);
    bf16_t* PO = (bf16_t*)(F.wsp() + WS_PO); f32x2* PST = (f32x2*)(F.wsp() + WS_PST);
    unsigned* qctr = (unsigned*)(F.wsp() + WS_CTL) + CW_QATT + 64 * l;
    const float* relb = F.inp(25);
    const int lane = F.lane;
    bool att_done = false, conv_done = false;
    for (int trip = 0;; ++trip) {
        if (!conv_done && (att_done || (trip % 3) == 2)) {
            __syncthreads();
            if (F.tid == 0) CTL[2] = __hip_atomic_fetch_add(qctr + 16, 1u, __ATOMIC_RELAXED, __HIP_MEMORY_SCOPE_AGENT);
            __syncthreads();
            const int cu = (int)CTL[2];
            if (cu >= CONV_UNITS) conv_done = true; else conv_experts_items(F, l, cu * CONV_GROUP, (cu + 1) * CONV_GROUP, 1);
        }
        if (att_done) { if (conv_done) break; continue; }
        __syncthreads();
        if (F.tid == 0) { CTL[0] = __hip_atomic_fetch_add(qctr, 1u, __ATOMIC_RELAXED, __HIP_MEMORY_SCOPE_AGENT); CTL[1] = 0u; }
        __syncthreads();
        const int u = (int)CTL[0];
        if (u >= NPIECE * NB * NH) { att_done = true; if (conv_done) break; continue; }
        const unsigned pc = PIECES[u >> 5]; const int bh = u & 31, b = bh >> 3, h = bh & 7;
        const int j = (int)(pc & 0xff), qlo = (int)((pc >> 8) & 0xff), qhi = (int)(pc >> 16); const int ncand = (qhi - qlo + 1) * 256;
        const size_t tokb = (size_t)b * SEQ;
        for (int id = F.tid; id < 2048; id += 512) { const int row = id >> 3, c8 = id & 7; const size_t ro = (tokb + j * 256 + row) * 1536 + h * 64 + c8 * 8;
            *(LAS u32x4*)(Ks + row * KS_PITCH + c8 * 16) = *(const u32x4*)(MO + ro + 512); }
        for (int id = F.tid; id < 1024; id += 512) { const int rp = id >> 3, c8 = id & 7; const size_t ro = (tokb + j * 256 + 2 * rp) * 1536 + h * 64 + c8 * 8 + 1024;
            const u32x4 v0 = *(const u32x4*)(MO + ro), v1 = *(const u32x4*)(MO + ro + 1536);
            const unsigned a[4] = {v0.x, v0.y, v0.z, v0.w}, bq[4] = {v1.x, v1.y, v1.z, v1.w};
            LAS unsigned char* vp = Vt + (c8 * 8) * VT_PITCH + rp * 4;
#pragma unroll
            for (int q = 0; q < 4; ++q) { *(LAS unsigned*)(vp + (2 * q) * VT_PITCH) = (a[q] & 0xffffu) | (bq[q] << 16); *(LAS unsigned*)(vp + (2 * q + 1) * VT_PITCH) = (a[q] >> 16) | (bq[q] & 0xffff0000u); } }
        if (F.tid <= 128) { const int n = F.tid; int bucket;
            if (n < 16) bucket = n; else { int lg = 16 + (int)(logf((float)n / 16.0f) / 2.0794415416798357f * 16.0f); bucket = lg < 31 ? lg : 31; }
            LUT[n] = relb[bucket * 8 + h]; }
        unsigned selw[11];
#pragma unroll
        for (int r = 0; r < 11; ++r) { const int qq = qlo * 256 + r * 512 + F.tid; selw[r] = (r * 512 + F.tid < ncand) ? SEL[(tokb + qq) * 8 + h] : 0u; }
#pragma unroll
        for (int r = 0; r < 11; ++r) { const int base = r * 512; if (base >= ncand) break;
            const int q = qlo * 256 + base + F.tid; const int qb = q >> 8; bool mem = false; unsigned ent = 0;
            if (base + F.tid >= ncand) { }
            else if (qb == j) { mem = true; ent = (unsigned)q | (3u << 16); }
            else { const unsigned s = selw[r]; const unsigned nv = s >> 24;
                if (nv > 0 && (s & 0xff) == (unsigned)j) { mem = true; ent = (unsigned)q; }
                else if (nv > 1 && ((s >> 8) & 0xff) == (unsigned)j) { mem = true; ent = (unsigned)q | (1u << 16); }
                else if (nv > 2 && ((s >> 16) & 0xff) == (unsigned)j) { mem = true; ent = (unsigned)q | (2u << 16); } }
            const unsigned long long bal = __ballot(mem); const int cnt = __popcll(bal);
            unsigned wbase = 0; if (lane == 0 && cnt > 0) wbase = __hip_atomic_fetch_add(&CTL[1], (unsigned)cnt, __ATOMIC_RELAXED, __HIP_MEMORY_SCOPE_WORKGROUP);
            wbase = (unsigned)__builtin_amdgcn_readfirstlane((int)wbase);
            if (mem) LIST[wbase + __popcll(bal & ((1ull << lane) - 1ull))] = ent;
        }
        __syncthreads();
        const int total = (int)CTL[1];
        const float bfar = LUT[128];
        const int ntile = (total + 31) >> 5;
        const int qi = lane & 31, half = lane >> 5;
        bf16x8 qfn[4]; unsigned enn = 0u;
        if (F.wave < ntile) { const int e0 = F.wave * 32 + qi; enn = LIST[e0 < total ? e0 : total - 1]; const size_t tk0 = tokb + (enn & 0xffffu);
#pragma unroll
            for (int kk = 0; kk < 4; ++kk) qfn[kk] = *(const bf16x8*)(MO + tk0 * 1536 + h * 64 + 16 * kk + 8 * half); }
        for (int tile = F.wave; tile < ntile; tile += 8) {
            const int e = tile * 32 + qi; const bool valid = e < total; const unsigned en = enn;
            const int q = (int)(en & 0xffffu), slot = (int)(en >> 16); const size_t tok = tokb + q;
            const bool need_lut = __any((q >> 8) <= j + 1);
            bf16x8 qf[4];
#pragma unroll
            for (int kk = 0; kk < 4; ++kk) qf[kk] = qfn[kk];
            if (tile + 8 < ntile) { const int e1 = (tile + 8) * 32 + qi; enn = LIST[e1 < total ? e1 : total - 1]; const size_t tk1 = tokb + (enn & 0xffffu);
#pragma unroll
                for (int kk = 0; kk < 4; ++kk) qfn[kk] = *(const bf16x8*)(MO + tk1 * 1536 + h * 64 + 16 * kk + 8 * half); }
            float mrun = -1e30f, lsum = 0.f;
            f32x16 oacc[2];
#pragma unroll
            for (int i = 0; i < 16; ++i) { oacc[0][i] = 0.f; oacc[1][i] = 0.f; }
            const int qrel = q - j * 256;
#pragma unroll 1
            for (int ck = 0; ck < 4; ++ck) {
                if (!__any(qrel >= 64 * ck)) break;
                f32x16 sacc[2];
#pragma unroll
                for (int k2 = 0; k2 < 2; ++k2) { const int kt = 2 * ck + k2;
#pragma unroll
                    for (int i = 0; i < 16; ++i) sacc[k2][i] = 0.f;
#pragma unroll
                    for (int kk = 0; kk < 4; ++kk) { const bf16x8 ka = *(const LAS bf16x8*)(Ks + (32 * kt + qi) * KS_PITCH + (16 * kk + 8 * half) * 2);
                        sacc[k2] = __builtin_amdgcn_mfma_f32_32x32x16_bf16(ka, qf[kk], sacc[k2], 0, 0, 0); } }
                float mx = -1e30f;
                if (need_lut) {
#pragma unroll
                    for (int k2 = 0; k2 < 2; ++k2)
#pragma unroll
                        for (int i = 0; i < 16; ++i) { const int key = 32 * (2 * ck + k2) + (i & 3) + 8 * (i >> 2) + 4 * half; const int n = qrel - key;
                            const float bias = LUT[n < 0 ? 0 : (n > 128 ? 128 : n)];
                            const float s = (n < 0) ? -1e30f : sacc[k2][i] + bias; sacc[k2][i] = s; mx = fmaxf(mx, s); }
                } else {
#pragma unroll
                    for (int k2 = 0; k2 < 2; ++k2)
#pragma unroll
                        for (int i = 0; i < 16; ++i) { const float s = sacc[k2][i] + bfar; sacc[k2][i] = s; mx = fmaxf(mx, s); }
                }
                mx = fmaxf(mx, __shfl_xor(mx, 32));
                const float mnew = fmaxf(mrun, mx); const float alpha = __expf(mrun - mnew); mrun = mnew;
                lsum *= alpha;
#pragma unroll
                for (int i = 0; i < 16; ++i) { oacc[0][i] *= alpha; oacc[1][i] *= alpha; }
#pragma unroll
                for (int k2 = 0; k2 < 2; ++k2) { const int kt = 2 * ck + k2;
#pragma unroll
                    for (int i = 0; i < 16; ++i) { const float p = __expf(sacc[k2][i] - mnew); sacc[k2][i] = p; lsum += p; }
#pragma unroll
                    for (int cc = 0; cc < 2; ++cc) {
                        u32x4 pw; pw.x = pk2(sacc[k2][8 * cc], sacc[k2][8 * cc + 1]); pw.y = pk2(sacc[k2][8 * cc + 2], sacc[k2][8 * cc + 3]); pw.z = pk2(sacc[k2][8 * cc + 4], sacc[k2][8 * cc + 5]); pw.w = pk2(sacc[k2][8 * cc + 6], sacc[k2][8 * cc + 7]);
                        const bf16x8 pf = __builtin_bit_cast(bf16x8, pw);
                        const int key0 = 32 * kt + 16 * cc + 4 * half;
#pragma unroll
                        for (int dt = 0; dt < 2; ++dt) { const LAS unsigned char* vb = Vt + (32 * dt + qi) * VT_PITCH + key0 * 2;
                            const u32x2 va = *(const LAS u32x2*)vb, vb2 = *(const LAS u32x2*)(vb + 16);
                            u32x4 vw; vw.x = va.x; vw.y = va.y; vw.z = vb2.x; vw.w = vb2.y;
                            oacc[dt] = __builtin_amdgcn_mfma_f32_32x32x16_bf16(__builtin_bit_cast(bf16x8, vw), pf, oacc[dt], 0, 0, 0); } } }
            }
            const float mx = mrun;
            lsum += __shfl_xor(lsum, 32);
            const float inv = 1.0f / lsum;
            if (valid) {
                bf16_t* op = PO + ((size_t)slot * T + tok) * CW + h * 64;
#pragma unroll
                for (int dt = 0; dt < 2; ++dt)
#pragma unroll
                    for (int ig = 0; ig < 4; ++ig) { u32x2 w; w.x = pk2(oacc[dt][4 * ig] * inv, oacc[dt][4 * ig + 1] * inv); w.y = pk2(oacc[dt][4 * ig + 2] * inv, oacc[dt][4 * ig + 3] * inv);
                        *(u32x2*)(op + 32 * dt + 8 * ig + 4 * half) = w; }
                if (half == 0) PST[((size_t)slot * T + tok) * 8 + h] = (f32x2){mx, lsum};
            }
        }
    }
}
DI void phase_moba_combine(Frame& F) {
    const bf16_t* PO = (const bf16_t*)(F.wsp() + WS_PO); const f32x2* PST = (const f32x2*)(F.wsp() + WS_PST); const unsigned* SEL = (const unsigned*)(F.wsp() + WS_SEL);
    bf16_t* YM = (bf16_t*)(F.wsp() + WS_YRM) + 512;
    int tid = F.tid;
    for (int tb = F.bid * 16; tb < T; tb += F.G * 16) {
        int tbase = tb; asm volatile("" : "+s"(tbase), "+v"(tid));
        const int c0 = (tid & 63) * 8, h = c0 >> 6;
        int nv[2]; f32x2 st[2][4]; u32x4 po[2][4];
#pragma unroll
        for (int e = 0; e < 2; ++e) { const int t = tbase + 8 * e + (tid >> 6); nv[e] = (int)(SEL[(size_t)t * 8 + h] >> 24);
#pragma unroll
            for (int s = 0; s < 4; ++s) { st[e][s] = PST[((size_t)s * T + t) * 8 + h]; po[e][s] = *(const u32x4*)(PO + ((size_t)s * T + t) * CW + c0); } }
#pragma unroll
        for (int e = 0; e < 2; ++e) { const int t = tbase + 8 * e + (tid >> 6); float M = -1e30f;
#pragma unroll
            for (int s = 0; s < 4; ++s) { const bool on = (s == 3) || (s < nv[e]); if (on) M = fmaxf(M, st[e][s].x); }
            float den = 0.f, num[8];
#pragma unroll
            for (int j = 0; j < 8; ++j) num[j] = 0.f;
#pragma unroll
            for (int s = 0; s < 4; ++s) { const bool on = (s == 3) || (s < nv[e]); if (on) { const float w = st[e][s].y * __expf(st[e][s].x - M); den += w;
                    num[0] += w * bflo(po[e][s].x); num[1] += w * bfhi(po[e][s].x); num[2] += w * bflo(po[e][s].y); num[3] += w * bfhi(po[e][s].y);
                    num[4] += w * bflo(po[e][s].z); num[5] += w * bfhi(po[e][s].z); num[6] += w * bflo(po[e][s].w); num[7] += w * bfhi(po[e][s].w); } }
            const float inv = __builtin_amdgcn_rcpf(den);
            u32x4 o; o.x = pk2(num[0] * inv, num[1] * inv); o.y = pk2(num[2] * inv, num[3] * inv); o.z = pk2(num[4] * inv, num[5] * inv); o.w = pk2(num[6] * inv, num[7] * inv);
            *(u32x4*)(YM + (size_t)t * YRM_LD + c0) = o; }
    }
}
DI void phase_router(Frame& F, int l) {
    LAS float* xs = (LAS float*)F.lds;
    LAS float* wsm = xs + 64 * 129;
    LAS float* lgt = wsm + 128 * 36;
    LAS float* ssq = lgt + 64 * 37;
    LAS int* hist = (LAS int*)(ssq + 64);
    const float* x = F.outp(); const float* gain = F.inp(2) + (size_t)l * DM;
    const float* wgrp = F.inp(29) + (size_t)l * DM * 4; const float* wexp = F.inp(31) + (size_t)l * DM * 32;
    const float* bgrp = F.inp(30) + l * 4; const float* bexp = F.inp(32) + l * 32;
    int* EID = (int*)(F.wsp() + WS_RT + RT_EID); float* GATE = (float*)(F.wsp() + WS_RT + RT_GATE); int* HIST = (int*)(F.wsp() + WS_RT + RT_HIST);
    const int tok = F.tid & 63, jg = F.tid >> 6;
    for (int tile = F.bid; tile < T / 64; tile += F.G) {
        const int t0 = tile * 64;
        float acc[5] = {0.f, 0.f, 0.f, 0.f, 0.f}; float ss = 0.f;
        if (F.tid < 32) hist[F.tid] = 0;
        for (int kc = 0; kc < DM; kc += 128) {
            __syncthreads();
            for (int idx = F.tid; idx < 64 * 128; idx += 512) { const int r = idx >> 7, k = idx & 127; xs[r * 129 + k] = x[(size_t)(t0 + r) * DM + kc + k]; }
            for (int idx = F.tid; idx < 128 * 36; idx += 512) { const int k = idx / 36, j = idx - k * 36; const float g = gain[kc + k];
                wsm[idx] = g * (j < 4 ? wgrp[(size_t)(kc + k) * 4 + j] : wexp[(size_t)(kc + k) * 32 + (j - 4)]); }
            __syncthreads();
            for (int k = 0; k < 128; ++k) { const float xv = xs[tok * 129 + k]; ss += xv * xv;
#pragma unroll
                for (int i = 0; i < 5; ++i) { const int j = jg + 8 * i; if (j < 36) acc[i] += xv * wsm[k * 36 + j]; } }
        }
#pragma unroll
        for (int i = 0; i < 5; ++i) { const int j = jg + 8 * i; if (j < 36) lgt[tok * 37 + j] = acc[i]; }
        if (jg == 0) ssq[tok] = ss;
        __syncthreads();
        if (F.tid < 64) {
            const int t = t0 + F.tid; const float rs = 1.0f / sqrtf(ssq[F.tid] * (1.f / DM) + 1e-6f);
            float lg[4]; int gs = 0; float gm = -INFINITY;
#pragma unroll
            for (int g = 0; g < 4; ++g) { lg[g] = lgt[F.tid * 37 + g] * rs + bgrp[g]; if (lg[g] > gm) { gm = lg[g]; gs = g; } }
            float gden = 0.f;
#pragma unroll
            for (int g = 0; g < 4; ++g) gden += expf(lg[g] - gm);
            const float ptop = 1.0f / gden;
            float le[8]; float e0 = -INFINITY, e1 = -INFINITY; int j0 = 0, j1 = 1;
#pragma unroll
            for (int e = 0; e < 8; ++e) { le[e] = lgt[F.tid * 37 + 4 + gs * 8 + e] * rs + bexp[gs * 8 + e];
                if (le[e] > e0) { e1 = e0; j1 = j0; e0 = le[e]; j0 = e; } else if (le[e] > e1) { e1 = le[e]; j1 = e; } }
            const float p1 = expf(e1 - e0);
            const float g0 = ptop / (1.f + p1), g1 = ptop * p1 / (1.f + p1);
            const int ex0 = gs * 8 + j0, ex1 = gs * 8 + j1;
            EID[t * 2] = ex0; EID[t * 2 + 1] = ex1; GATE[t * 2] = g0; GATE[t * 2 + 1] = g1;
            __hip_atomic_fetch_add(&hist[ex0], 1, __ATOMIC_RELAXED, __HIP_MEMORY_SCOPE_WORKGROUP); __hip_atomic_fetch_add(&hist[ex1], 1, __ATOMIC_RELAXED, __HIP_MEMORY_SCOPE_WORKGROUP);
        }
        __syncthreads();
        if (F.tid < 32) HIST[tile * 32 + F.tid] = hist[F.tid];
        __syncthreads();
    }
}
DI void phase_moe_gather(Frame& F, int l) {
    LAS int* tot = (LAS int*)F.lds; LAS int* off = tot + 32; LAS int* base = off + 32; LAS int* eidl = base + 32; LAS int* rowl = eidl + 128; LAS int* ps = rowl + 128; LAS int* po = ps + 512;
    const int* EID = (const int*)(F.wsp() + WS_RT + RT_EID); const float* GATE = (const float*)(F.wsp() + WS_RT + RT_GATE); const int* HIST = (const int*)(F.wsp() + WS_RT + RT_HIST);
    int* ROW = (int*)(F.wsp() + WS_RT + RT_ROW); float* GW = (float*)(F.wsp() + WS_RT + RT_GW); int* PEXP = (int*)(F.wsp() + WS_RT + RT_PEXP);
    int* TOK = (int*)(F.wsp() + WS_RT + RT_TOK); const float* RSQ = (const float*)(F.wsp() + WS_RT + RT_RSQ); float* RSR = (float*)(F.wsp() + WS_RT + RT_RSR);
    for (int tile = F.bid; tile < T / 64; tile += F.G) {
        const int t0 = tile * 64;
        __syncthreads();
        { const int e = F.tid & 31, part = F.tid >> 5; int s = 0, o = 0;
#pragma unroll 8
          for (int i = part * 32; i < part * 32 + 32; ++i) { const int v = HIST[i * 32 + e]; s += v; if (i < tile) o += v; }
          ps[F.tid] = s; po[F.tid] = o; }
        if (F.tid < 128) eidl[F.tid] = EID[t0 * 2 + F.tid];
        __syncthreads();
        if (F.tid < 32) { int s = 0, o = 0;
#pragma unroll
            for (int p = 0; p < 16; ++p) { s += ps[p * 32 + F.tid]; o += po[p * 32 + F.tid]; } tot[F.tid] = s; off[F.tid] = o; }
        __syncthreads();
        if (F.tid == 0) {
            int bs = 0; for (int e = 0; e < 32; ++e) { base[e] = bs; bs += (tot[e] + 255) & ~255; }
            if (tile == 0) { int p = 0; for (int e = 0; e < 32; ++e) { const int np = (tot[e] + 255) >> 8; for (int i = 0; i < np; ++i) PEXP[p++] = e; } PEXP[MOE_PANELS] = p; }
        }
        __syncthreads();
        if (F.tid < 128) { const int my = eidl[F.tid]; int rank = 0; for (int i = 0; i < F.tid; ++i) rank += (eidl[i] == my) ? 1 : 0;
            const int r = base[my] + off[my] + rank; rowl[F.tid] = r; ROW[t0 * 2 + F.tid] = r; GW[r] = GATE[t0 * 2 + F.tid]; TOK[r] = t0 + (F.tid >> 1); RSR[r] = RSQ[t0 + (F.tid >> 1)]; }
    }
}
DI void phase_moe_combine(Frame& F, int l) {
    const bf16_t* YE = (const bf16_t*)(F.wsp() + WS_YE); const int* ROW = (const int*)(F.wsp() + WS_RT + RT_ROW); bf16_t* XN = (bf16_t*)(F.wsp() + WS_XN);
    const float* gain = F.inp(1) + (size_t)(l + 1 < NLAYER ? l + 1 : l) * DM;
    const int gw = F.bid * 8 + F.wave, NGW = F.G * 8; int lane = F.lane;
    for (int tb = gw * 4; tb < T; tb += NGW * 4) {
        int tbase = tb; asm volatile("" : "+s"(tbase), "+v"(lane));
        int r0[4], r1[4];
#pragma unroll
        for (int e = 0; e < 4; ++e) { r0[e] = ROW[(tbase + e) * 2]; r1[e] = ROW[(tbase + e) * 2 + 1]; }
        u32x2 ya[4][4], yb[4][4]; f32x4 xv[4][4];
#pragma unroll
        for (int e = 0; e < 4; ++e) { const u32x2* y0 = (const u32x2*)(YE + (size_t)r0[e] * DM) + lane; const u32x2* y1 = (const u32x2*)(YE + (size_t)r1[e] * DM) + lane; const f32x4* xr = (const f32x4*)(F.outp() + (size_t)(tbase + e) * DM) + lane;
#pragma unroll
            for (int j = 0; j < 4; ++j) { ya[e][j] = y0[64 * j]; yb[e][j] = y1[64 * j]; xv[e][j] = xr[64 * j]; } }
#pragma unroll
        for (int e = 0; e < 4; ++e) { const int t = tbase + e; f32x4* xr = (f32x4*)(F.outp() + (size_t)t * DM) + lane; float s = 0.f;
#pragma unroll
            for (int j = 0; j < 4; ++j) { f32x4 v = xv[e][j]; const u32x2 a = ya[e][j], b = yb[e][j];
                v.x += bflo(a.x) + bflo(b.x); v.y += bfhi(a.x) + bfhi(b.x); v.z += bflo(a.y) + bflo(b.y); v.w += bfhi(a.y) + bfhi(b.y);
                xv[e][j] = v; xr[64 * j] = v; s += (v.x * v.x + v.y * v.y) + (v.z * v.z + v.w * v.w); }
            if (l + 1 < NLAYER) {
                const float rs = __builtin_amdgcn_rsqf(wave_sum(s) * (1.f / DM) + 1e-6f);
#pragma unroll
                for (int j = 0; j < 4; ++j) { const f32x4 g = ((const f32x4*)gain)[lane + 64 * j]; const f32x4 y = xv[e][j] * rs * g; u32x2 w; w.x = pk2(y.x, y.y); w.y = pk2(y.z, y.w); *((u32x2*)(XN + (size_t)t * DM) + lane + 64 * j) = w; }
            } }
    }
}
constexpr size_t TB_WRH = 512 * 1024, TB_WRL = TB_WRH + 48 * 1024 * 2;
DI void phase_conv_router(Frame& F, int l) {
    bf16_t* WRH = (bf16_t*)(F.wsp() + WS_TAB + TB_WRH); bf16_t* WRL = (bf16_t*)(F.wsp() + WS_TAB + TB_WRL);
    const float* gain = F.inp(2) + (size_t)l * DM; const float* wgrp = F.inp(29) + (size_t)l * DM * 4; const float* wexp = F.inp(31) + (size_t)l * DM * 32;
    for (int idx = F.bid * 512 + F.tid; idx < 48 * DM; idx += F.G * 512) { const int n = idx >> 10, k = idx & 1023;
        float v = (n < 4) ? wgrp[k * 4 + n] : (n < 36) ? wexp[k * 32 + (n - 4)] : 0.f; v *= gain[k];
        const bf16_t h = f2bf(v); WRH[idx] = h; WRL[idx] = f2bf(v - bf2f(h)); }
}
DI void phase_router2(Frame& F, int l) {
    LAS float* lgt = (LAS float*)F.lds + F.wave * 1024;
    LAS int* hist = (LAS int*)(F.lds + 8 * 4096);
    const float* x = F.outp(); const bf16_t* WRH = (const bf16_t*)(F.wsp() + WS_TAB + TB_WRH); const bf16_t* WRL = (const bf16_t*)(F.wsp() + WS_TAB + TB_WRL);
    const float* bgrp = F.inp(30) + l * 4; const float* bexp = F.inp(32) + l * 32;
    int* EID = (int*)(F.wsp() + WS_RT + RT_EID); float* GATE = (float*)(F.wsp() + WS_RT + RT_GATE); int* HIST = (int*)(F.wsp() + WS_RT + RT_HIST);
    const int lane = F.lane, r16 = lane & 15, g = lane >> 4;
    bf16_t* XN2 = (bf16_t*)(F.wsp() + WS_AM); const float* gain = F.inp(2) + (size_t)l * DM; float* RSQ = (float*)(F.wsp() + WS_RT + RT_RSQ);
    { int* TOK = (int*)(F.wsp() + WS_RT + RT_TOK); for (int i = F.bid * 512 + F.tid; i < MOE_ROWS; i += F.G * 512) TOK[i] = 0; }
    for (int task = F.bid; task < T / 128; task += F.G) {
        const int t0 = task * 128 + F.wave * 16;
        __syncthreads();
        if (F.tid < 64) hist[F.tid] = 0;
        __syncthreads();
        f32x4 acc[3];
#pragma unroll
        for (int nt = 0; nt < 3; ++nt) acc[nt] = (f32x4){0.f, 0.f, 0.f, 0.f};
        float ss = 0.f;
        const float* xr = x + (size_t)(t0 + r16) * DM + 8 * g; bf16_t* xo = XN2 + (size_t)(t0 + r16) * DM + 8 * g; const float* gp = gain + 8 * g;
#pragma unroll 2
        for (int s = 0; s < 32; ++s) {
            const f32x4 x0 = *(const f32x4*)(xr + 32 * s), x1 = *(const f32x4*)(xr + 32 * s + 4);
            ss += (x0.x * x0.x + x0.y * x0.y) + (x0.z * x0.z + x0.w * x0.w) + (x1.x * x1.x + x1.y * x1.y) + (x1.z * x1.z + x1.w * x1.w);
            { const f32x4 g0 = *(const f32x4*)(gp + 32 * s), g1 = *(const f32x4*)(gp + 32 * s + 4);
              u32x4 w; w.x = pk2(x0.x * g0.x, x0.y * g0.y); w.y = pk2(x0.z * g0.z, x0.w * g0.w); w.z = pk2(x1.x * g1.x, x1.y * g1.y); w.w = pk2(x1.z * g1.z, x1.w * g1.w);
              *(u32x4*)(xo + 32 * s) = w; }
            u32x4 hw, lw; hw.x = pk2(x0.x, x0.y); hw.y = pk2(x0.z, x0.w); hw.z = pk2(x1.x, x1.y); hw.w = pk2(x1.z, x1.w);
            lw.x = pk2(x0.x - bflo(hw.x), x0.y - bfhi(hw.x)); lw.y = pk2(x0.z - bflo(hw.y), x0.w - bfhi(hw.y)); lw.z = pk2(x1.x - bflo(hw.z), x1.y - bfhi(hw.z)); lw.w = pk2(x1.z - bflo(hw.w), x1.w - bfhi(hw.w));
            const bf16x8 ah = __builtin_bit_cast(bf16x8, hw), al = __builtin_bit_cast(bf16x8, lw);
#pragma unroll
            for (int nt = 0; nt < 3; ++nt) { const size_t wo = (size_t)(16 * nt + r16) * DM + 32 * s + 8 * g;
                const bf16x8 bh = *(const bf16x8*)(WRH + wo), bl = *(const bf16x8*)(WRL + wo);
                acc[nt] = mfma16(ah, bh, acc[nt]); acc[nt] = mfma16(ah, bl, acc[nt]); acc[nt] = mfma16(al, bh, acc[nt]); }
        }
        ss += __shfl_xor(ss, 16); ss += __shfl_xor(ss, 32);
        if (g == 0) RSQ[t0 + r16] = __builtin_amdgcn_rsqf(ss * (1.f / DM) + 1e-6f);
#pragma unroll
        for (int nt = 0; nt < 3; ++nt)
#pragma unroll
            for (int r = 0; r < 4; ++r) lgt[(4 * g + r) * 48 + 16 * nt + r16] = acc[nt][r];
        if (g == 0) lgt[768 + r16] = ss;
        LDS_WAIT(); asm volatile("" ::: "memory");
        if (lane < 16) {
            const int t = t0 + lane; const float rs = 1.0f / sqrtf(lgt[768 + lane] * (1.f / DM) + 1e-6f); const LAS float* lr = lgt + lane * 48;
            float lg[4]; int gs = 0; float gm = -INFINITY;
#pragma unroll
            for (int q = 0; q < 4; ++q) { lg[q] = lr[q] * rs + bgrp[q]; if (lg[q] > gm) { gm = lg[q]; gs = q; } }
            float gden = 0.f;
#pragma unroll
            for (int q = 0; q < 4; ++q) gden += expf(lg[q] - gm);
            const float ptop = 1.0f / gden;
            float e0 = -INFINITY, e1 = -INFINITY; int j0 = 0, j1 = 1;
#pragma unroll
            for (int e = 0; e < 8; ++e) { const float le = lr[4 + gs * 8 + e] * rs + bexp[gs * 8 + e];
                if (le > e0) { e1 = e0; j1 = j0; e0 = le; j0 = e; } else if (le > e1) { e1 = le; j1 = e; } }
            const float p1 = expf(e1 - e0);
            const float g0 = ptop / (1.f + p1), g1 = ptop * p1 / (1.f + p1);
            const int ex0 = gs * 8 + j0, ex1 = gs * 8 + j1;
            EID[t * 2] = ex0; EID[t * 2 + 1] = ex1; GATE[t * 2] = g0; GATE[t * 2 + 1] = g1;
            LAS int* hh = hist + (F.wave >> 2) * 32;
            __hip_atomic_fetch_add(&hh[ex0], 1, __ATOMIC_RELAXED, __HIP_MEMORY_SCOPE_WORKGROUP); __hip_atomic_fetch_add(&hh[ex1], 1, __ATOMIC_RELAXED, __HIP_MEMORY_SCOPE_WORKGROUP);
        }
        __syncthreads();
        if (F.tid < 64) HIST[(task * 2 + (F.tid >> 5)) * 32 + (F.tid & 31)] = hist[F.tid];
    }
}
#ifndef MK_PER_PHASE_LAUNCH
#define MK_PER_PHASE_LAUNCH 0
#endif
constexpr int PH_PER_LAYER = 19, NPHASE = PH_PER_LAYER * NLAYER;
struct Args { const float* in[36]; float* out; unsigned char* ws; int ph_lo, ph_hi; };

#ifndef SCAN_NAIVE
#define SCAN_NAIVE 0
#endif
#ifndef PHMASK
#define PHMASK 0x7ffff
#endif
#ifndef DUPMASK
#define DUPMASK 0
#endif
#define NREP(k) ((((DUPMASK) >> (k)) & 1) ? 2 : 1)
#define IN(k) (((PHMASK >> ((k) % PH_PER_LAYER)) & 1) && lo <= (k) && (k) < hi)
#define SEAM(k) do { asm volatile("" : "+s"(barp), "+s"(bar.x)); bar.bar = (unsigned*)barp; if (IN(k) && IN((k) + 1)) xcd_barrier(bar); asm volatile("" : "+s"(F.ws_g), "+s"(F.out_g), "+s"(F.ka), "+s"(F.bid), "+s"(F.G), "+s"(F.lds)); } while (0)
#define FRESH() do { asm volatile("" : "+s"(F.wave)); int l_ = (int)__builtin_amdgcn_mbcnt_hi(~0u, __builtin_amdgcn_mbcnt_lo(~0u, 0u)); asm volatile("" : "+v"(l_)); F.lane = l_; F.tid = F.wave * 64 + l_; } while (0)
__global__ void __launch_bounds__(512, 2) fwd_kernel(Args args) {
    extern __shared__ __attribute__((aligned(16))) unsigned char lds_raw[];
    Frame F;
    F.lds = (LAS unsigned char*)lds_raw;
    F.tid = threadIdx.x; F.lane = F.tid & 63; F.wave = __builtin_amdgcn_readfirstlane(F.tid >> 6);
    F.G = gridDim.x; F.bid = blockIdx.x;
    F.ka = (const __attribute__((address_space(4))) unsigned char*)__builtin_amdgcn_kernarg_segment_ptr();
    F.out_g = (GAS float*)args.out; F.ws_g = (GAS unsigned char*)args.ws;
    volatile LAS unsigned* MISC = (volatile LAS unsigned*)(F.lds + MISC_OFF);
    if (F.tid < 32) MISC[F.tid] = 0u;
    __syncthreads();
    const int lo = args.ph_lo, hi = args.ph_hi;
    GAS unsigned* barp = (GAS unsigned*)(F.ws_g + WS_CTL) + CW_BAR;
    XcdBarrier bar; bar.bar = (unsigned*)barp; bar.x = 0; bar.st = nullptr;
    if (hi - lo > 1) bar = xcd_barrier_post((unsigned*)barp, MISC + 8);

    bf16_t* const XN = (bf16_t*)(F.wsp() + WS_XN);
    bf16_t* const WCAT = (bf16_t*)(F.wsp() + WS_WM + WM_WCAT);
    for (int l = 0; l < NLAYER; ++l) {
        const int P = l * PH_PER_LAYER;
#define PHASE(k) if (IN(P + (k))) for (int rep_ = 0; rep_ < NREP(k); ++rep_)
        PHASE(0) { FRESH(); if (l == 0) { phase_conv_mixer(F, 0); phase_conv_lora2(F, 0); phase_conv_router(F, 0); phase_norm_x(F, F.inp(0), F.inp(1)); } }
        if (l == 0) SEAM(P + 0);
#if defined(XTRA_BARS)
        if (hi - lo > 1) for (int xb_ = 0; xb_ < XTRA_BARS; ++xb_) { asm volatile("" : "+s"(barp), "+s"(bar.x)); bar.bar = (unsigned*)barp; xcd_barrier(bar); }
#endif
        PHASE(1) { FRESH(); const int n1 = (l == 0) ? 2048 : 2304;
            pg8::Gemm g{XN, WCAT, T, n1, DM}; pg8::StaticOrder S; S.init(T, n1, F.G, F.bid);
            pg8::EpiStore E{(bf16_t*)(F.wsp() + WS_RW), 1536, 1536, (bf16_t*)(F.wsp() + WS_LO), LO_W, 0};
            pg8::gemm_phase<pg8::EpiStore, pg8::StaticOrder>(F.lds, g, S, E, F.tid); }
        SEAM(P + 1);
        PHASE(2) { FRESH(); phase_prep_scana(F, l); }
        SEAM(P + 2);
        PHASE(4) { FRESH(); if (F.bid < NB * NH && F.G > 2 * NB * NH) phase_scan_b(F, l); else if (F.G > 2 * NB * NH) phase_scan_c(F, l, NB * NH); else {   } }
        SEAM(P + 5);
        PHASE(6) { FRESH(); pg8::Gemm g{XN, WCAT + (size_t)2304 * DM, T, 1536, DM}; pg8::StaticOrder S; S.init(T, 1536, F.G, F.bid);
            pg8::EpiMoba E{(bf16_t*)(F.wsp() + WS_MO), F.inp(23) + l * 64, F.inp(24) + l * 64, (float*)(F.wsp() + WS_TAB + TB_KMEAN), (int)(TB_KMEAN2 / 4)};
            pg8::gemm_phase<pg8::EpiMoba, pg8::StaticOrder>(F.lds, g, S, E, F.tid); }
        SEAM(P + 6);
        PHASE(8) { FRESH(); phase_moba_gate(F); }
        SEAM(P + 8);
        PHASE(9) { FRESH(); phase_moba_attn(F, l); }
        SEAM(P + 9);
        PHASE(10) { FRESH(); phase_moba_combine(F); }
        SEAM(P + 10);
        PHASE(11) { FRESH(); pg8::Gemm g{XN, WCAT + (size_t)3840 * DM, T, 2048, DM}; pg8::StaticOrder S; S.init(T, 2048, F.G, F.bid);
            pg8::EpiStore E{(bf16_t*)(F.wsp() + WS_GA), 2048, 0, nullptr, 0, 1};
            pg8::gemm_phase<pg8::EpiStore, pg8::StaticOrder>(F.lds, g, S, E, F.tid); }
        SEAM(P + 11);
        PHASE(12) { FRESH(); pg8::Gemm g{(const bf16_t*)(F.wsp() + WS_YRM), (const bf16_t*)(F.wsp() + WS_WM + WM_BRR), T, DM, DM}; pg8::StaticOrder S; S.init(T, DM, F.G, F.bid);
            pg8::EpiBranch2 E{(bf16_t*)(F.wsp() + WS_H), (const bf16_t*)(F.wsp() + WS_GA)};
            pg8::gemm_phase<pg8::EpiBranch2, pg8::StaticOrder>(F.lds, g, S, E, F.tid); }
        SEAM(P + 12);
        PHASE(13) { FRESH(); pg8::Gemm g{(const bf16_t*)(F.wsp() + WS_H), (const bf16_t*)(F.wsp() + WS_WM + WM_OUT), T, DM, DM}; pg8::StaticOrder S; S.init(T, DM, F.G, F.bid);
            pg8::EpiResid E{l == 0 ? F.inp(0) : F.outp(), F.outp()};
            pg8::gemm_phase<pg8::EpiResid, pg8::StaticOrder>(F.lds, g, S, E, F.tid); }
        SEAM(P + 13);
        PHASE(14) { FRESH(); phase_router2(F, l); }
        SEAM(P + 14);
        PHASE(15) { FRESH(); phase_moe_gather(F, l); }
        SEAM(P + 15);
        PHASE(16) { FRESH(); const int* PEXP = (const int*)(F.wsp() + WS_RT + RT_PEXP); const int np = __builtin_amdgcn_readfirstlane(PEXP[MOE_PANELS]);
            pg8::Gemm g{(const bf16_t*)(F.wsp() + WS_AM), (const bf16_t*)(F.wsp() + WS_WE), np * 256, 1024, DM}; pg8::GatherOrder S; S.init(np * 256, 1024, F.G, F.bid); S.pexp = PEXP;
            LAS int* tokL = (LAS int*)(F.lds + RING_BYTES); S.tokL = tokL;
            { const int* TOK = (const int*)(F.wsp() + WS_RT + RT_TOK); __syncthreads();
              for (int i = 0; i < 16; ++i) { pg8::Unit uu; if (!S.next(i, uu)) break; if (F.tid < 256) tokL[i * 256 + F.tid] = TOK[uu.pm * 256 + F.tid]; }
              __syncthreads(); }
            pg8::EpiExpertUp E{(bf16_t*)(F.wsp() + WS_HM), (const float*)(F.wsp() + WS_RT + RT_GW), (const float*)(F.wsp() + WS_RT + RT_RSR)};
            pg8::gemm_phase<pg8::EpiExpertUp, pg8::GatherOrder>(F.lds, g, S, E, F.tid); }
        SEAM(P + 16);
        PHASE(17) { FRESH(); const int* PEXP = (const int*)(F.wsp() + WS_RT + RT_PEXP); const int np = __builtin_amdgcn_readfirstlane(PEXP[MOE_PANELS]);
            pg8::Gemm g{(const bf16_t*)(F.wsp() + WS_HM), (const bf16_t*)(F.wsp() + WS_WD), np * 256, 1024, DEXP}; pg8::GroupOrder S; S.init(np * 256, 1024, F.G, F.bid); S.pexp = PEXP;
            pg8::EpiStore E{(bf16_t*)(F.wsp() + WS_YE), 1024, 0, nullptr, 0, 0};
            pg8::gemm_phase<pg8::EpiStore, pg8::GroupOrder>(F.lds, g, S, E, F.tid); }
        SEAM(P + 17);
        PHASE(18) { FRESH(); phase_moe_combine(F, l); if (l + 1 < NLAYER) { phase_conv_mixer(F, l + 1); phase_conv_lora2(F, l + 1); phase_conv_router(F, l + 1); } }
        SEAM(P + 18);
#undef PHASE
    }
}

extern "C" void kernel_launch(void* const* d_in, const int* in_sizes, int n_in, void* d_out, int out_size, void* d_ws, size_t ws_size, hipStream_t stream) {
    static int grid = 0;
    if (grid == 0) {
        if (n_in != 36 || out_size != T * DM || ws_size < WS_NEED) { fprintf(stderr, "kernel_launch: unexpected problem (n_in %d, out %d, ws %zu); nothing launched\n", n_in, out_size, ws_size); grid = -1; return; }
        int dev = 0, cus = 0;
        if (hipGetDevice(&dev) != hipSuccess || hipDeviceGetAttribute(&cus, hipDeviceAttributeMultiprocessorCount, dev) != hipSuccess) { grid = -1; return; }
        if (hipFuncSetAttribute((const void*)fwd_kernel, hipFuncAttributeMaxDynamicSharedMemorySize, LDS_BYTES) != hipSuccess) { fprintf(stderr, "kernel_launch: hipFuncSetAttribute failed\n"); grid = -1; return; }
        int per_cu = 0;
        if (hipOccupancyMaxActiveBlocksPerMultiprocessor(&per_cu, (const void*)fwd_kernel, 512, LDS_BYTES) != hipSuccess || per_cu < 1) { fprintf(stderr, "kernel_launch: occupancy query says %d\n", per_cu); }
        (void)hipGetLastError();
        grid = cus;
    }
    if (grid < 0) return;
    (void)hipMemsetAsync((char*)d_ws + WS_CTL, 0, CTL_ZERO_BYTES, stream);
    Args a{};
    for (int i = 0; i < 36; ++i) a.in[i] = (const float*)d_in[i];
    a.out = (float*)d_out; a.ws = (unsigned char*)d_ws;
#if MK_PER_PHASE_LAUNCH
    for (int ph = 0; ph < NPHASE; ++ph) { if (ph == PH_PER_LAYER) continue; a.ph_lo = ph; a.ph_hi = ph + 1; hipLaunchKernelGGL(fwd_kernel, dim3(grid), dim3(512), LDS_BYTES, stream, a); }
#else
    a.ph_lo = 0; a.ph_hi = NPHASE;
    hipLaunchKernelGGL(fwd_kernel, dim3(grid), dim3(512), LDS_BYTES, stream, a);
#endif
}
```

```cpp
#include <hip/hip_runtime.h>
#include <cstdio>
#include <cstdint>
#define LAS __attribute__((address_space(3)))
#define GAS __attribute__((address_space(1)))
#define DI __device__ __forceinline__
typedef unsigned short bf16_t;
typedef short bf16x8 __attribute__((ext_vector_type(8)));
typedef short s16x4 __attribute__((ext_vector_type(4)));
typedef float f32x4 __attribute__((ext_vector_type(4)));
typedef float f32x2 __attribute__((ext_vector_type(2)));
typedef float f32x16 __attribute__((ext_vector_type(16)));
typedef unsigned u32x4 __attribute__((ext_vector_type(4)));
typedef unsigned u32x2 __attribute__((ext_vector_type(2)));
typedef __bf16 bf16v2 __attribute__((ext_vector_type(2)));

DI unsigned pk2(float lo, float hi) { f32x2 v = {lo, hi}; return __builtin_bit_cast(unsigned, __builtin_convertvector(v, bf16v2)); }
DI bf16_t f2bf(float f) { return (bf16_t)(pk2(f, 0.f) & 0xffffu); }
DI float bf2f(bf16_t b) { return __uint_as_float(((unsigned)b) << 16); }
DI float bflo(unsigned w) { return __uint_as_float(w << 16); }
DI float bfhi(unsigned w) { return __uint_as_float(w & 0xffff0000u); }
DI float rcpf_(float x) { return __builtin_amdgcn_rcpf(x); }
DI float sigmoidf_(float x) { return __builtin_amdgcn_rcpf(1.0f + __expf(-x)); }

template <int CTRL> DI float dpp_mov(float v) { return __builtin_bit_cast(float, __builtin_amdgcn_update_dpp(0, __builtin_bit_cast(int, v), CTRL, 0xf, 0xf, true)); }
DI float rdlane(float v, int l) { return __builtin_bit_cast(float, __builtin_amdgcn_readlane(__builtin_bit_cast(int, v), l)); }
DI float wave_sum(float v) {
    v += dpp_mov<0xB1>(v);
    v += dpp_mov<0x4E>(v);
    v += dpp_mov<0x141>(v);
    v += dpp_mov<0x140>(v);
    return (rdlane(v, 0) + rdlane(v, 16)) + (rdlane(v, 32) + rdlane(v, 48));
}
DI f32x4 mfma16(bf16x8 a, bf16x8 b, f32x4 c) { return __builtin_amdgcn_mfma_f32_16x16x32_bf16(a, b, c, 0, 0, 0); }
namespace pg8 {
constexpr int BM = 256, BK = 64, HALF = 128, HTB = HALF * BK * 2  , STAGE_BYTES = 8 * HTB, NXCD = 8, WGM = 8;

__host__ __device__ __forceinline__ int lds_byte(int r, int c) { const int st = (r >> 4) * 2 + (c >> 5), rr = r & 15, cc = c & 31, ob = rr * 64 + cc * 2; return st * 1024 + (ob ^ (((ob >> 9) & 1) << 5)); }
__host__ __device__ __forceinline__ void stage_rc(int b, int& R, int& C) { const int st = b / 1024, sb = b % 1024, swz = sb ^ (((sb >> 9) & 1) << 5); R = (st >> 1) * 16 + swz / 64; C = (st & 1) * 32 + (swz % 64) / 2; }
__host__ __device__ __forceinline__ int perm32(int rho) { const int n = rho >> 4, i = rho & 15; return 8 * (i >> 2) + 4 * n + (i & 3); }

struct Unit { int pm, pn, pb; };
struct Gemm { const bf16_t* A; const bf16_t* Bt; int M, N, K; };

struct StaticOrder {
    static constexpr bool GATHER = false;
    int nM, nN, nwg, G, c;
    __device__ __forceinline__ void init(int M, int N, int G_, int c_) { nM = M / BM; nN = N / BM; nwg = nM * nN; G = G_; c = c_; }
    __device__ __forceinline__ bool next(int i, Unit& u) const {
        const long L = (long)i * G + c; if (L >= nwg) return false;
        int wgid = (int)L; { const int q = nwg / NXCD, r = nwg % NXCD, xcd = wgid % NXCD, off = wgid / NXCD; wgid = (xcd < r ? xcd * (q + 1) : r * (q + 1) + (xcd - r) * q) + off; }
        const int nig = WGM * nN, gid = wgid / nig, fm = gid * WGM, gsz = (nM - fm) < WGM ? (nM - fm) : WGM;
        u.pm = fm + ((wgid % nig) % gsz); u.pn = (wgid % nig) / gsz; u.pb = u.pn; return true;
    }
};
struct GroupOrder : StaticOrder {
    const int* pexp;
    __device__ __forceinline__ bool next(int i, Unit& u) const {
        if (!StaticOrder::next(i, u)) return false;
        u.pb = __builtin_amdgcn_readfirstlane(pexp[u.pm]) * nN + u.pn; return true;
    }
};
struct GatherOrder : GroupOrder {
    static constexpr bool GATHER = true;
    const LAS int* tokL;
};

template <class Epi, class Sched, bool ALIGN_EPI = true, bool SP2 = true>
__device__ __forceinline__ void gemm_phase(LAS unsigned char* lds, const Gemm g, const Sched& S, const Epi& E, int tid_in) {
    const int tid = tid_in, wid = __builtin_amdgcn_readfirstlane(tid >> 6), lane = tid & 63, wr = wid >> 2, wc = wid & 3, fr = lane & 15, fq = lane >> 4;
    const int K = g.K, nt = K / BK;
    unsigned voffA[2], voffB[2];
#pragma unroll
    for (int i = 0; i < 2; ++i) { int R, C; stage_rc(tid * 16 + i * 8192, R, C); const int Rb = Epi::HEADS ? (64 * (R >> 5) + perm32(R & 31)) : Epi::PERM ? ((R & ~31) + perm32(R & 31)) : R;
        voffA[i] = (unsigned)(R * K + C) * 2u; voffB[i] = (unsigned)(Rb * K + C) * 2u; }
    unsigned goff[2][2] = {{0u, 0u}, {0u, 0u}}, goffN[2][2] = {{0u, 0u}, {0u, 0u}};
#define PG8_GOFF(dst, ui_) do { if constexpr (Sched::GATHER) { _Pragma("unroll") for (int h_ = 0; h_ < 2; ++h_) _Pragma("unroll") for (int i_ = 0; i_ < 2; ++i_) { int R_, C_; stage_rc(tid * 16 + i_ * 8192, R_, C_); \
        const int tk_ = S.tokL[(ui_) * 256 + 128 * h_ + R_]; dst[h_][i_] = (unsigned)(tk_ * K + C_) * 2u; } } } while (0)
#define PG8_STAGE_A(bufoff, kt, h, usenext) do { if constexpr (Sched::GATHER) { unsigned vo_[2] = { (usenext) ? goffN[h][0] : goff[h][0], (usenext) ? goffN[h][1] : goff[h][1] }; PG8_STAGE(bufoff, kt, vo_); } \
        else { PG8_STAGE(bufoff, (kt) + ((h) ? hstep : 0), voffA); } } while (0)
    const size_t kstep = (size_t)(BK * 2);
    const size_t hstep = (size_t)HALF * K * 2;
    const size_t hstepB = Epi::HEADS ? (size_t)32 * K * 2 : hstep;
    const size_t tstep = 2 * hstep;
    const unsigned ldsw = (unsigned)wid * 1024u;
    const int aoff = lds_byte(wr * 64 + fr, fq * 8), boff = lds_byte(wc * 32 + fr, fq * 8);
#define PG8_SA(b, h) (((b) * 2 + (h)) * HTB)
#define PG8_SB(b, h) ((4 + (b) * 2 + (h)) * HTB)
#define PG8_STAGE(bufoff, gbase, voff) do { _Pragma("unroll") for (int _i = 0; _i < 2; ++_i) \
        __builtin_amdgcn_global_load_lds((const unsigned*)((const char*)(gbase) + (voff)[_i]), (LAS unsigned*)(lds + (bufoff) + ldsw + _i * 8192), 16, 0, 0); } while (0)
#define PG8_LDA(dst, b, h) do { _Pragma("unroll") for (int m = 0; m < 4; ++m) _Pragma("unroll") for (int k = 0; k < 2; ++k) dst[m][k] = *(const LAS bf16x8*)(lds + PG8_SA(b, h) + aoff + m * 2048 + k * 1024); } while (0)
#define PG8_LDB(dst, b, h) do { _Pragma("unroll") for (int n = 0; n < 2; ++n) _Pragma("unroll") for (int k = 0; k < 2; ++k) dst[n][k] = *(const LAS bf16x8*)(lds + PG8_SB(b, h) + boff + n * 2048 + k * 1024); } while (0)
#define PG8_MMA(ai, bj, At, Bt) do { __builtin_amdgcn_s_setprio(1); _Pragma("unroll") for (int m = 0; m < 4; ++m) _Pragma("unroll") for (int n = 0; n < 2; ++n) _Pragma("unroll") for (int k = 0; k < 2; ++k) \
        acc[ai][bj][m][n] = __builtin_amdgcn_mfma_f32_16x16x32_bf16(Bt[n][k], At[m][k], acc[ai][bj][m][n], 0, 0, 0); __builtin_amdgcn_s_setprio(0); } while (0)
#define PG8_WAIT_V(n) asm volatile("s_waitcnt vmcnt(" #n ")" ::: "memory")
#define PG8_WAIT_L(n) asm volatile("s_waitcnt lgkmcnt(" #n ")" ::: "memory")
#define PG8_BAR __builtin_amdgcn_s_barrier()
#define PG8_SCHED __builtin_amdgcn_sched_barrier(0)
    Unit cur, nxt; int ui = 0;
    if (!S.next(0, cur)) return;
    f32x4 acc[2][2][4][2];
#pragma unroll
    for (int a = 0; a < 2; ++a)
#pragma unroll
        for (int b = 0; b < 2; ++b)
#pragma unroll
            for (int m = 0; m < 4; ++m)
#pragma unroll
                for (int n = 0; n < 2; ++n) acc[a][b][m][n] = (f32x4){0.f, 0.f, 0.f, 0.f};
    bf16x8 At[4][2], B0[2][2], B1[2][2];
    const char* cA = (const char*)g.A + (Sched::GATHER ? (size_t)0 : (size_t)cur.pm * tstep); const char* cB = (const char*)g.Bt + (size_t)cur.pb * tstep;
    PG8_GOFF(goff, 0);
    if constexpr (SP2) {
        PG8_STAGE(PG8_SB(0, 0), cB, voffB); PG8_STAGE(PG8_SB(0, 1), cB + hstepB, voffB); PG8_STAGE_A(PG8_SA(0, 0), cA, 0, false); PG8_STAGE_A(PG8_SA(0, 1), cA, 1, false);
        if (wr == 1) PG8_BAR;
        PG8_WAIT_V(2); PG8_BAR;
        PG8_STAGE(PG8_SB(1, 0), cB + kstep, voffB); PG8_STAGE_A(PG8_SA(1, 0), cA + kstep, 0, false); PG8_STAGE(PG8_SB(1, 1), cB + hstepB + kstep, voffB);
        PG8_WAIT_V(6); PG8_BAR;
    } else {
        PG8_STAGE(PG8_SB(0, 0), cB, voffB); PG8_STAGE_A(PG8_SA(0, 0), cA, 0, false); PG8_STAGE(PG8_SB(0, 1), cB + hstepB, voffB); PG8_STAGE_A(PG8_SA(0, 1), cA, 1, false);
        if (wr == 1) PG8_BAR;
        PG8_WAIT_V(4); PG8_BAR;
        PG8_STAGE(PG8_SB(1, 0), cB + kstep, voffB); PG8_STAGE_A(PG8_SA(1, 0), cA + kstep, 0, false); PG8_STAGE(PG8_SB(1, 1), cB + hstepB + kstep, voffB);
        PG8_WAIT_V(6); PG8_BAR;
    }
    for (;;) {
        const bool has_next = S.next(ui + 1, nxt);
        const char* nA = (has_next && !Sched::GATHER) ? (const char*)g.A + (size_t)nxt.pm * tstep : cA; const char* nB = has_next ? (const char*)g.Bt + (size_t)nxt.pb * tstep : cB;
        if constexpr (Sched::GATHER) { if (has_next) PG8_GOFF(goffN, ui + 1); else { goffN[0][0] = goff[0][0]; goffN[0][1] = goff[0][1]; goffN[1][0] = goff[1][0]; goffN[1][1] = goff[1][1]; } }
        for (int t = 0; t < nt; t += 2) {
            if constexpr (Epi::HAS_MID) { if (t == nt / 2) E.mid(acc, cur, wr, wc, fr, fq); }
            const bool last = (t == nt - 2);
            const char* a1 = cA + (size_t)(t + 1) * kstep;
            const char* a2 = last ? nA : cA + (size_t)(t + 2) * kstep; const char* b2 = last ? nB : cB + (size_t)(t + 2) * kstep;
            const char* a3 = a2 + kstep; const char* b3 = b2 + kstep;
            if constexpr (SP2) {
            PG8_LDB(B0, 0, 0); PG8_LDB(B1, 0, 1); PG8_SCHED; PG8_LDA(At, 0, 0); PG8_STAGE_A(PG8_SA(1, 1), a1, 1, false);
            PG8_WAIT_V(8); PG8_WAIT_L(0); PG8_BAR; PG8_MMA(0, 0, At, B0); PG8_MMA(0, 1, At, B1); PG8_BAR; PG8_SCHED;
            PG8_LDA(At, 0, 1); PG8_STAGE(PG8_SB(0, 0), b2, voffB); PG8_STAGE(PG8_SB(0, 1), b2 + hstepB, voffB); PG8_STAGE_A(PG8_SA(0, 0), a2, 0, last);
            PG8_WAIT_V(8); PG8_WAIT_L(0); PG8_BAR; PG8_MMA(1, 0, At, B0); PG8_MMA(1, 1, At, B1); PG8_BAR; PG8_SCHED;
            PG8_LDB(B0, 1, 0); PG8_LDB(B1, 1, 1); PG8_SCHED; PG8_LDA(At, 1, 0); PG8_STAGE_A(PG8_SA(0, 1), a2, 1, last);
            PG8_WAIT_V(8); PG8_WAIT_L(0); PG8_BAR; PG8_MMA(0, 0, At, B0); PG8_MMA(0, 1, At, B1); PG8_BAR; PG8_SCHED;
            PG8_LDA(At, 1, 1); PG8_STAGE(PG8_SB(1, 0), b3, voffB); PG8_STAGE(PG8_SB(1, 1), b3 + hstepB, voffB); PG8_STAGE_A(PG8_SA(1, 0), a3, 0, last);
            PG8_WAIT_V(8); PG8_WAIT_L(0); PG8_BAR; PG8_MMA(1, 0, At, B0); PG8_MMA(1, 1, At, B1); PG8_BAR; PG8_SCHED;
            } else {
            PG8_LDB(B0, 0, 0); PG8_SCHED; PG8_LDA(At, 0, 0); PG8_STAGE_A(PG8_SA(1, 1), a1, 1, false);
            PG8_WAIT_L(8); PG8_BAR; PG8_WAIT_L(0); PG8_MMA(0, 0, At, B0); PG8_BAR; PG8_SCHED;
            PG8_LDB(B1, 0, 1); PG8_STAGE(PG8_SB(0, 0), b2, voffB);
            PG8_BAR; PG8_WAIT_L(0); PG8_MMA(0, 1, At, B1); PG8_BAR;
            PG8_LDA(At, 0, 1); PG8_STAGE_A(PG8_SA(0, 0), a2, 0, last);
            PG8_BAR; PG8_WAIT_L(0); PG8_MMA(1, 0, At, B0); PG8_BAR; PG8_SCHED;
            PG8_STAGE(PG8_SB(0, 1), b2 + hstepB, voffB);
            PG8_WAIT_V(6); PG8_BAR; PG8_MMA(1, 1, At, B1); PG8_BAR;
            PG8_LDB(B0, 1, 0); PG8_SCHED; PG8_LDA(At, 1, 0); PG8_STAGE_A(PG8_SA(0, 1), a2, 1, last);
            PG8_WAIT_L(8); PG8_BAR; PG8_WAIT_L(0); PG8_MMA(0, 0, At, B0); PG8_BAR; PG8_SCHED;
            PG8_LDB(B1, 1, 1); PG8_STAGE(PG8_SB(1, 0), b3, voffB);
            PG8_BAR; PG8_WAIT_L(0); PG8_MMA(0, 1, At, B1); PG8_BAR;
            PG8_LDA(At, 1, 1); PG8_STAGE_A(PG8_SA(1, 0), a3, 0, last);
            PG8_BAR; PG8_WAIT_L(0); PG8_MMA(1, 0, At, B0); PG8_BAR; PG8_SCHED;
            PG8_STAGE(PG8_SB(1, 1), b3 + hstepB, voffB);
            PG8_WAIT_V(6); PG8_BAR; PG8_MMA(1, 1, At, B1); PG8_BAR;
            }
        }
        if constexpr (ALIGN_EPI) { if (wr == 0) PG8_BAR; }
        E(acc, cur, wr, wc, fr, fq);
        if (!has_next) break;
#pragma unroll
        for (int a = 0; a < 2; ++a)
#pragma unroll
            for (int b = 0; b < 2; ++b)
#pragma unroll
                for (int m = 0; m < 4; ++m)
#pragma unroll
                    for (int n = 0; n < 2; ++n) acc[a][b][m][n] = (f32x4){0.f, 0.f, 0.f, 0.f};
        cur = nxt; cA = nA; cB = nB; ++ui;
        if constexpr (Sched::GATHER) { goff[0][0] = goffN[0][0]; goff[0][1] = goffN[0][1]; goff[1][0] = goffN[1][0]; goff[1][1] = goffN[1][1]; }
        if constexpr (ALIGN_EPI) { if (wr == 1) PG8_BAR; }
    }
    PG8_WAIT_V(0);
    if constexpr (!ALIGN_EPI) { if (wr == 0) PG8_BAR; }
    PG8_BAR;
#undef PG8_SA
#undef PG8_GOFF
#undef PG8_STAGE_A
#undef PG8_SB
#undef PG8_STAGE
#undef PG8_LDA
#undef PG8_LDB
#undef PG8_MMA
#undef PG8_WAIT_V
#undef PG8_WAIT_L
#undef PG8_BAR
#undef PG8_SCHED
}
}
#define XB_TMO      128
#define XB_XCNT(j)  (256  + 64 * (j))
#define XB_XSUB(j)  (1280 + 64 * (j))
#define XB_XGEN(j)  (2304 + 64 * (j))
#define XB_TOP      3328
#define XB_TOPGEN   3392
#define XCD_BAR_WORDS 3456
#define XB_SPIN_CAP (1u << 18)

__device__ __forceinline__ unsigned xb_ld(unsigned* p)              { return __hip_atomic_load(p, __ATOMIC_RELAXED, __HIP_MEMORY_SCOPE_AGENT); }
__device__ __forceinline__ unsigned xb_add(unsigned* p, unsigned v) { return __hip_atomic_fetch_add(p, v, __ATOMIC_RELAXED, __HIP_MEMORY_SCOPE_AGENT); }
__device__ __forceinline__ unsigned xb_xcc_id() { return (unsigned)__builtin_amdgcn_s_getreg((3 << 11) | 20) & 0xFu; }
#define XB_SPIN(cond, bar) do { unsigned _sp = 0; while (cond) { __builtin_amdgcn_s_sleep(1); \
    if ((++_sp & 255u) == 0u) { if (xb_ld(&(bar)[XB_TMO])) break; if (_sp > XB_SPIN_CAP) { atomicAdd(&(bar)[XB_TMO], 1u); break; } } } } while (0)

struct XcdBarrier {
    unsigned* bar; unsigned x;
    volatile LAS unsigned* st;
};

__device__ __forceinline__ XcdBarrier xcd_barrier_post(unsigned* bar, volatile LAS unsigned* st) {
    XcdBarrier b; b.bar = bar; b.x = xb_xcc_id(); b.st = st;
    if (threadIdx.x == 0) (void)xb_add(&bar[XB_XCNT(b.x)], 1u);
    return b;
}
__device__ __forceinline__ void xcd_barrier_complete(unsigned* bar, unsigned x, unsigned& nloc, unsigned& nx) {
    const unsigned G = gridDim.x * gridDim.y * gridDim.z;
    unsigned sum, cnt, mine, sp = 0u;
    for (;;) {
        sum = 0u; cnt = 0u; mine = 0u;
#pragma unroll
        for (unsigned j = 0; j < 16; ++j) { const unsigned c = xb_ld(&bar[XB_XCNT(j)]); sum += c; cnt += (c > 0u) ? 1u : 0u; mine = (j == x) ? c : mine; }
        if (sum == G) break;
        __builtin_amdgcn_s_sleep(1);
        if ((++sp & 255u) == 0u) { if (xb_ld(&bar[XB_TMO])) break; if (sp > XB_SPIN_CAP) { atomicAdd(&bar[XB_TMO], 1u); break; } }
    }
    nloc = mine > 0u ? mine : 1u; nx = cnt > 0u ? cnt : 1u;
}

__device__ __forceinline__ void xcd_barrier(const XcdBarrier& b) {
    asm volatile("s_waitcnt vmcnt(0)" ::: "memory");
    __syncthreads();
    if (threadIdx.x == 0) {
        unsigned* bar = b.bar;
        __builtin_amdgcn_s_waitcnt(0);
        unsigned nloc = b.st[0], nx = b.st[1];
        if (nloc == 0u) { xcd_barrier_complete(bar, b.x, nloc, nx); b.st[0] = nloc; b.st[1] = nx; }
        const unsigned old = xb_add(&bar[XB_XSUB(b.x)], 1u);
        const unsigned gen = old / nloc;
        if (old + 1u == (gen + 1u) * nloc) {
            __builtin_amdgcn_fence(__ATOMIC_RELEASE, "agent");
            asm volatile("s_waitcnt vmcnt(0)" ::: "memory");
            const unsigned og = xb_add(&bar[XB_TOP], 1u);
            const unsigned tg = og / nx;
            if (og + 1u == (tg + 1u) * nx) xb_add(&bar[XB_TOPGEN], 1u);
            else XB_SPIN(xb_ld(&bar[XB_TOPGEN]) == tg, bar);
            __builtin_amdgcn_fence(__ATOMIC_ACQUIRE, "agent");
            xb_add(&bar[XB_XGEN(b.x)], 1u);
            asm volatile("s_waitcnt vmcnt(0)" ::: "memory");
        } else {
            XB_SPIN(xb_ld(&bar[XB_XGEN(b.x)]) == gen, bar);
            __builtin_amdgcn_fence(__ATOMIC_ACQUIRE, "agent");
            asm volatile("s_waitcnt vmcnt(0)" ::: "memory");
        }
    }
    __syncthreads();
}
constexpr int NB = 4, SEQ = 8192, DM = 1024, T = NB * SEQ;
constexpr int NH = 8, HD = 64, CW = 512;
constexpr int N_IN = 5120;
constexpr int NLAYER = 2;
constexpr int NEXP = 32, DEXP = 512;
constexpr int MOE_ROWS = 73728, MOE_PANELS = MOE_ROWS / 256;
constexpr int WCAT_ROWS = 5888;
constexpr int LO_W = 768;

constexpr size_t MiB = 1u << 20;
constexpr size_t WS_CTL = 0, CTL_ZERO_BYTES = 1 * MiB;
constexpr size_t WS_VF   = 1 * MiB;
constexpr size_t WS_TAB  = 33 * MiB;
constexpr size_t WS_WM   = 34 * MiB;
constexpr size_t WS_XN   = 50 * MiB;
constexpr size_t WS_RW   = 114 * MiB;
constexpr size_t WS_MO   = 178 * MiB;
constexpr size_t WS_LO   = 210 * MiB;
constexpr size_t WS_YRM  = 114 * MiB;
constexpr int YRM_LD = 1024;
constexpr size_t WS_SIR  = 258 * MiB;
constexpr size_t WS_SIK  = 322 * MiB;
constexpr size_t WS_SCRW = 290 * MiB, WS_SCRA = 306 * MiB, WS_SCRB = 546 * MiB;
constexpr size_t WS_V1   = 418 * MiB;
constexpr size_t WS_G    = 450 * MiB;
constexpr size_t WS_YS   = 482 * MiB;
constexpr size_t WS_PO   = 418 * MiB;
constexpr size_t WS_PST  = 274 * MiB;
constexpr size_t WS_GA   = 418 * MiB;
constexpr size_t WS_H    = 50 * MiB;
constexpr size_t WS_SC1  = 482 * MiB;
constexpr size_t WS_SC2  = 354 * MiB;
constexpr size_t WS_SCT  = 290 * MiB;
constexpr size_t WS_WE   = 290 * MiB;
constexpr size_t WS_WD   = 354 * MiB;
constexpr size_t WS_AM   = 130 * MiB;
constexpr size_t WS_HM   = 194 * MiB;
constexpr size_t WS_YE   = 386 * MiB;
constexpr size_t WS_RT   = 546 * MiB;
constexpr size_t WS_END  = 556 * MiB;
constexpr size_t TB_KMEAN = 0;
constexpr size_t TB_KMEAN2 = 256 * 1024;
constexpr size_t TB_SEL   = 256 * 1024;
constexpr size_t RT_EID  = 0;
constexpr size_t RT_GATE = 256 * 1024;
constexpr size_t RT_ROW  = 512 * 1024;
constexpr size_t RT_GW   = 768 * 1024;
constexpr size_t RT_HIST = 1280 * 1024;
constexpr size_t RT_PEXP = 1408 * 1024;
constexpr size_t RT_TOK  = 1536 * 1024;
constexpr size_t RT_RSQ  = 2048 * 1024;
constexpr size_t RT_RSR  = 2304 * 1024;
constexpr size_t WS_SEL  = 562 * MiB;
constexpr size_t WS_NEED = 564 * MiB;
constexpr int CW_BAR = 4096;

constexpr int RING_BYTES = 131072;
constexpr int LDS_BYTES = 163840;
constexpr int MISC_OFF = LDS_BYTES - 256;
struct Frame {
    LAS unsigned char* lds;
    int tid, lane, wave;
    int G, bid;
    const __attribute__((address_space(4))) unsigned char* ka;
    GAS float* out_g; GAS unsigned char* ws_g;
    DI float* outp() const { return (float*)out_g; }
    DI unsigned char* wsp() const { return (unsigned char*)ws_g; }
    DI const float* inp(int i) const { return (const float*)(*(const GAS float* const __attribute__((address_space(4)))*)(ka + 8 * i)); }
};
#define LDS_WAIT() asm volatile("s_waitcnt lgkmcnt(0)" ::: "memory")

DI void tr_item(const float* src, int ld, int k0, bf16_t* dst, int Kd, const float* sc, int mode, LAS float* scr, int lane) {
#pragma unroll 8
    for (int i = 0; i < 32; ++i) { const int kk = 2 * i + (lane >> 5);
        float v = src ? src[(size_t)(k0 + kk) * ld + (lane & 31)] : 0.f;
        if (mode == 1) v *= sc[k0 + kk]; else if (mode == 2) v *= (1.f - sc[k0 + kk]);
        scr[kk * 33 + (lane & 31)] = v; }
    LDS_WAIT(); asm volatile("" ::: "memory");
    const int c = lane & 7;
#pragma unroll
    for (int j = 0; j < 4; ++j) { const int n = (lane >> 3) + 8 * j; const LAS float* s = scr + (8 * c) * 33 + n;
        u32x4 o; o.x = pk2(s[0 * 33], s[1 * 33]); o.y = pk2(s[2 * 33], s[3 * 33]); o.z = pk2(s[4 * 33], s[5 * 33]); o.w = pk2(s[6 * 33], s[7 * 33]);
        *(u32x4*)(dst + (size_t)n * Kd + k0 + 8 * c) = o; }
    LDS_WAIT(); asm volatile("" ::: "memory");
}

constexpr size_t WM_WCAT = 0, WM_BRR = (size_t)WCAT_ROWS * 1024 * 2, WM_BRM = WM_BRR + 1024 * 512 * 2, WM_OUT = WM_BRM + 1024 * 512 * 2;
DI void phase_conv_mixer(Frame& F, int l) {
    LAS float* scr = (LAS float*)(F.lds + F.wave * 16384);
    const int gw = F.bid * 8 + F.wave, NGW = F.G * 8;
    bf16_t* wcat = (bf16_t*)(F.wsp() + WS_WM + WM_WCAT);
    const float* w_in = F.inp(3) + (size_t)l * DM * N_IN;
    const float* mu_x = F.inp(5) + (size_t)l * 3 * DM;
    constexpr int NBLK = WCAT_ROWS / 32;
    constexpr int I_CAT = NBLK * 16, I_BR = 8 * 32, I_OUT = 16 * 32;
    for (int it = gw; it < I_CAT + 2 * I_BR + I_OUT; it += NGW) {
        int r = it;
        if (r < I_CAT) {
            const int nb = r / 16, kb = r % 16, k0 = kb * 64;
            if (nb < 48) { tr_item(w_in + 32 * nb, N_IN, k0, wcat + (size_t)(32 * nb) * 1024, 1024, nullptr, 0, scr, F.lane); }
            else if (nb < 72) {
                const int q = nb - 48; const float* src = nullptr; int ld = 0; const float* sc = nullptr; int mode = 0;
                if (q < 4)       { src = F.inp(7)  + (size_t)l * DM * 64  + 32 * (q & 1); ld = 64;  sc = mu_x;          mode = (q < 2) ? 2 : 1; }
                else if (q < 8)  { src = F.inp(10) + (size_t)l * DM * 64  + 32 * (q & 1); ld = 64;  sc = mu_x + DM;     mode = (q < 6) ? 2 : 1; }
                else if (q < 16) { src = F.inp(12) + (size_t)l * DM * 128 + 32 * (q & 3); ld = 128; sc = mu_x + 2 * DM; mode = (q < 12) ? 2 : 1; }
                else if (q < 18 && l > 0) { src = F.inp(21) + (size_t)(l - 1) * DM * 32; ld = 32; sc = F.inp(19) + (size_t)(l - 1) * DM; mode = (q == 16) ? 2 : 1; }
                tr_item(src, ld, k0, wcat + (size_t)(1536 + 32 * q) * 1024, 1024, sc, mode, scr, F.lane);
            }
            else if (nb < 120) { tr_item(w_in + 1536 + 32 * (nb - 72), N_IN, k0, wcat + (size_t)(2304 + 32 * (nb - 72)) * 1024, 1024, nullptr, 0, scr, F.lane); }
            else { tr_item(w_in + 3072 + 32 * (nb - 120), N_IN, k0, wcat + (size_t)(3840 + 32 * (nb - 120)) * 1024, 1024, nullptr, 0, scr, F.lane); }
            continue;
        }
        r -= I_CAT;
        if (r < I_BR) { const int nb = r / 8, kb = r % 8; tr_item(F.inp(26) + (size_t)l * 512 * 1024 + 32 * nb, 1024, kb * 64, (bf16_t*)(F.wsp() + WS_WM + WM_BRR) + (size_t)(32 * nb) * 1024, 1024, nullptr, 0, scr, F.lane); continue; }
        r -= I_BR;
        if (r < I_BR) { const int nb = r / 8, kb = r % 8; tr_item(F.inp(27) + (size_t)l * 512 * 1024 + 32 * nb, 1024, kb * 64, (bf16_t*)(F.wsp() + WS_WM + WM_BRR) + (size_t)(32 * nb) * 1024 + 512, 1024, nullptr, 0, scr, F.lane); continue; }
        r -= I_BR;
        { const int nb = r / 16, kb = r % 16; tr_item(F.inp(28) + (size_t)l * 1024 * 1024 + 32 * nb, 1024, kb * 64, (bf16_t*)(F.wsp() + WS_WM + WM_OUT) + (size_t)(32 * nb) * 1024, 1024, nullptr, 0, scr, F.lane); }
    }
}
struct ConvItem { const float* src; int ld, k0, n0, Kd, mode; bf16_t* dst; };
DI ConvItem conv_item(int it, const float* wg, const float* wu, const float* wdn, bf16_t* we, bf16_t* wd) {
    ConvItem c; const int e = it / 96; int r = it % 96;
    if (r < 64) { const int up = r >> 5; r &= 31; c.src = (up ? wu : wg) + (size_t)e * DM * DEXP; c.ld = DEXP; c.k0 = (r >> 1) * 64; c.n0 = (r & 1) * 256; c.dst = we + (size_t)e * 1024 * 1024; c.Kd = 1024; c.mode = up; }
    else { r -= 64; c.src = wdn + (size_t)e * DEXP * DM; c.ld = DM; c.k0 = (r >> 2) * 64; c.n0 = (r & 3) * 256; c.dst = wd + (size_t)e * 1024 * 512; c.Kd = 512; c.mode = 2; }
    return c;
}
DI void conv_load(const ConvItem& c, f32x4 (&v)[8], int tid) {
#pragma unroll
    for (int i = 0; i < 8; ++i) { const int idx = tid + 512 * i, row = idx >> 6, c4 = idx & 63; v[i] = *(const f32x4*)(c.src + (size_t)(c.k0 + row) * c.ld + c.n0 + 4 * c4); }
}
DI void conv_store(const ConvItem& c, const f32x4 (&v)[8], LAS float* scr, int tid) {
#pragma unroll
    for (int i = 0; i < 8; ++i) { const int idx = tid + 512 * i, row = idx >> 6, c4 = idx & 63; LAS float* d = scr + row * 257 + 4 * c4; d[0] = v[i].x; d[1] = v[i].y; d[2] = v[i].z; d[3] = v[i].w; }
    __syncthreads();
#pragma unroll
    for (int i = 0; i < 4; ++i) { const int idx = tid + 512 * i, n = idx >> 3, cc = idx & 7; const LAS float* sp = scr + (8 * cc) * 257 + n;
        u32x4 o; o.x = pk2(sp[0], sp[257]); o.y = pk2(sp[2 * 257], sp[3 * 257]); o.z = pk2(sp[4 * 257], sp[5 * 257]); o.w = pk2(sp[6 * 257], sp[7 * 257]);
        const int h = c.n0 + n; const int drow = (c.mode == 2) ? h : ((h >> 7) * 256 + c.mode * 128 + (h & 127));
        *(u32x4*)(c.dst + (size_t)drow * c.Kd + c.k0 + 8 * cc) = o; }
    __syncthreads();
}
constexpr int CONV_ITEMS = NEXP * 96, CONV_GROUP = 12, CONV_UNITS = CONV_ITEMS / CONV_GROUP;
DI void conv_experts_items(Frame& F, int l, int it_lo, int it_hi, int it_step) {
    LAS float* scr = (LAS float*)F.lds;
    bf16_t* we = (bf16_t*)(F.wsp() + WS_WE); bf16_t* wd = (bf16_t*)(F.wsp() + WS_WD);
    const float* wg = F.inp(33) + (size_t)l * NEXP * DM * DEXP; const float* wu = F.inp(34) + (size_t)l * NEXP * DM * DEXP; const float* wdn = F.inp(35) + (size_t)l * NEXP * DEXP * DM;
    __syncthreads();
    if (it_lo >= it_hi) return;
    f32x4 r0[8], r1[8], r2[8];
    ConvItem c0 = conv_item(it_lo, wg, wu, wdn, we, wd), c1 = c0, c2 = c0;
    conv_load(c0, r0, F.tid);
    const bool h1 = it_lo + it_step < it_hi; if (h1) { c1 = conv_item(it_lo + it_step, wg, wu, wdn, we, wd); conv_load(c1, r1, F.tid); }
    for (int it = it_lo; it < it_hi; it += 3 * it_step) {
        const int i2 = it + 2 * it_step, i3 = it + 3 * it_step, i4 = it + 4 * it_step;
        if (i2 < it_hi) { c2 = conv_item(i2, wg, wu, wdn, we, wd); conv_load(c2, r2, F.tid); }
        conv_store(c0, r0, scr, F.tid);
        if (it + it_step >= it_hi) break;
        if (i3 < it_hi) { c0 = conv_item(i3, wg, wu, wdn, we, wd); conv_load(c0, r0, F.tid); }
        conv_store(c1, r1, scr, F.tid);
        if (i2 >= it_hi) break;
        if (i4 < it_hi) { c1 = conv_item(i4, wg, wu, wdn, we, wd); conv_load(c1, r1, F.tid); }
        conv_store(c2, r2, scr, F.tid);
    }
}
DI void rms_row_to_bf16(const float* xrow, const float* gain, bf16_t* o0, bf16_t* o1, int lane) {
    const f32x4* xr = (const f32x4*)xrow + lane; const f32x4* gr = (const f32x4*)gain + lane;
    f32x4 v[4]; float s = 0.f;
#pragma unroll
    for (int j = 0; j < 4; ++j) { v[j] = xr[64 * j]; s += (v[j].x * v[j].x + v[j].y * v[j].y) + (v[j].z * v[j].z + v[j].w * v[j].w); }
    const float rs = 1.0f / sqrtf(wave_sum(s) * (1.f / DM) + 1e-6f);
#pragma unroll
    for (int j = 0; j < 4; ++j) { const f32x4 g = gr[64 * j]; const f32x4 y = v[j] * rs * g;
        u32x2 w; w.x = pk2(y.x, y.y); w.y = pk2(y.z, y.w);
        *((u32x2*)o0 + lane + 64 * j) = w; if (o1) *((u32x2*)o1 + lane + 64 * j) = w; }
}
DI void phase_norm_x(Frame& F, const float* x, const float* gain) {
    const int gw = F.bid * 8 + F.wave, NGW = F.G * 8; bf16_t* xn = (bf16_t*)(F.wsp() + WS_XN); int lane = F.lane;
    for (int mb = gw * 4; mb < T; mb += NGW * 4) {
        int m0 = mb; asm volatile("" : "+s"(m0), "+v"(lane));
        f32x4 v[4][4];
#pragma unroll
        for (int e = 0; e < 4; ++e) { const f32x4* xr = (const f32x4*)(x + (size_t)(m0 + e) * DM) + lane;
#pragma unroll
            for (int j = 0; j < 4; ++j) v[e][j] = xr[64 * j]; }
#pragma unroll
        for (int e = 0; e < 4; ++e) { float s = 0.f;
#pragma unroll
            for (int j = 0; j < 4; ++j) s += (v[e][j].x * v[e][j].x + v[e][j].y * v[e][j].y) + (v[e][j].z * v[e][j].z + v[e][j].w * v[e][j].w);
            const float rs = __builtin_amdgcn_rsqf(wave_sum(s) * (1.f / DM) + 1e-6f);
#pragma unroll
            for (int j = 0; j < 4; ++j) { const f32x4 g = ((const f32x4*)gain)[lane + 64 * j]; const f32x4 y = v[e][j] * rs * g; u32x2 w; w.x = pk2(y.x, y.y); w.y = pk2(y.z, y.w);
                *((u32x2*)(xn + (size_t)(m0 + e) * DM) + lane + 64 * j) = w; } }
    }
}

namespace pg8 {
struct EpiStore {
    static constexpr bool PERM = true, HAS_MID = false, HEADS = false;
    bf16_t* O; int ldc; int split; bf16_t* O2; int ldc2; int act;
    __device__ __forceinline__ void operator()(const f32x4 (&acc)[2][2][4][2], const Unit& u, int wr, int wc, int fr, int fq) const {
        const int row0 = u.pm * BM + wr * 64 + fr; int colt = u.pn * BM; bf16_t* base = O; int ld = ldc;
        if (split && colt >= split) { base = O2; ld = ldc2; colt -= split; }
        const int col0 = colt + wc * 32 + 8 * fq;
#pragma unroll
        for (int ai = 0; ai < 2; ++ai)
#pragma unroll
            for (int m = 0; m < 4; ++m) { bf16_t* rowp = base + (size_t)(row0 + ai * HALF + m * 16) * ld + col0;
#pragma unroll
                for (int bj = 0; bj < 2; ++bj) { f32x4 v0 = acc[ai][bj][m][0], v1 = acc[ai][bj][m][1];
                    if (act == 1) {
#pragma unroll
                        for (int j = 0; j < 4; ++j) { v0[j] = sigmoidf_(v0[j]); v1[j] = sigmoidf_(v1[j]); } }
                    u32x4 w; w.x = pk2(v0[0], v0[1]); w.y = pk2(v0[2], v0[3]); w.z = pk2(v1[0], v1[1]); w.w = pk2(v1[2], v1[3]);
                    *(u32x4*)(rowp + bj * HALF) = w; } }
    }
};
struct EpiBranch {
    static constexpr bool PERM = true, HAS_MID = false, HEADS = false;
    bf16_t* Hout; const bf16_t* gate; int gcol0; int first;
    __device__ __forceinline__ void operator()(const f32x4 (&acc)[2][2][4][2], const Unit& u, int wr, int wc, int fr, int fq) const {
        const int row0 = u.pm * BM + wr * 64 + fr; const int col0 = u.pn * BM + wc * 32 + 8 * fq;
#pragma unroll
        for (int ai = 0; ai < 2; ++ai)
#pragma unroll
            for (int m = 0; m < 4; ++m) { const size_t row = (size_t)(row0 + ai * HALF + m * 16);
#pragma unroll
                for (int bj = 0; bj < 2; ++bj) {
                    const u32x4 gv = *(const u32x4*)(gate + row * 2048 + gcol0 + col0 + bj * HALF);
                    bf16_t* hp = Hout + row * 1024 + col0 + bj * HALF;
                    f32x4 v0 = acc[ai][bj][m][0], v1 = acc[ai][bj][m][1];
                    v0[0] *= bflo(gv.x); v0[1] *= bfhi(gv.x); v0[2] *= bflo(gv.y); v0[3] *= bfhi(gv.y);
                    v1[0] *= bflo(gv.z); v1[1] *= bfhi(gv.z); v1[2] *= bflo(gv.w); v1[3] *= bfhi(gv.w);
                    if (!first) { const u32x4 hv = *(const u32x4*)hp;
                        v0[0] += bflo(hv.x); v0[1] += bfhi(hv.x); v0[2] += bflo(hv.y); v0[3] += bfhi(hv.y);
                        v1[0] += bflo(hv.z); v1[1] += bfhi(hv.z); v1[2] += bflo(hv.w); v1[3] += bfhi(hv.w); }
                    u32x4 w; w.x = pk2(v0[0], v0[1]); w.y = pk2(v0[2], v0[3]); w.z = pk2(v1[0], v1[1]); w.w = pk2(v1[2], v1[3]);
                    *(u32x4*)hp = w; } }
    }
};
struct EpiBranch2 {
    static constexpr bool PERM = true, HAS_MID = true, HEADS = false;
    bf16_t* Hout; const bf16_t* gate;
    __device__ __forceinline__ void mid(f32x4 (&acc)[2][2][4][2], const Unit& u, int wr, int wc, int fr_, int fq_) const {
        int fr = fr_, fq = fq_; asm volatile("" : "+v"(fr), "+v"(fq));
        const int row0 = u.pm * BM + wr * 64 + fr; const int col0 = u.pn * BM + wc * 32 + 8 * fq;
#pragma unroll
        for (int ai = 0; ai < 2; ++ai)
#pragma unroll
            for (int m = 0; m < 4; ++m) { const size_t row = (size_t)(row0 + ai * HALF + m * 16);
#pragma unroll
                for (int bj = 0; bj < 2; ++bj) {
                    const u32x4 gr = *(const u32x4*)(gate + row * 2048 + col0 + bj * HALF), gm = *(const u32x4*)(gate + row * 2048 + 1024 + col0 + bj * HALF);
                    const unsigned grw[4] = {gr.x, gr.y, gr.z, gr.w}, gmw[4] = {gm.x, gm.y, gm.z, gm.w};
#pragma unroll
                    for (int q = 0; q < 4; ++q) { const float r0 = bflo(grw[q]) * __builtin_amdgcn_rcpf(fmaxf(bflo(gmw[q]), 1e-30f)), r1 = bfhi(grw[q]) * __builtin_amdgcn_rcpf(fmaxf(bfhi(gmw[q]), 1e-30f));
                        acc[ai][bj][m][q >> 1][2 * (q & 1)] *= r0; acc[ai][bj][m][q >> 1][2 * (q & 1) + 1] *= r1; } }
                if (m == 3) asm volatile("" ::: "memory"); }
    }
    __device__ __forceinline__ void operator()(const f32x4 (&acc)[2][2][4][2], const Unit& u, int wr, int wc, int fr, int fq) const {
        const int row0 = u.pm * BM + wr * 64 + fr; const int col0 = u.pn * BM + wc * 32 + 8 * fq;
#pragma unroll
        for (int ai = 0; ai < 2; ++ai)
#pragma unroll
            for (int m = 0; m < 4; ++m) { const size_t row = (size_t)(row0 + ai * HALF + m * 16);
#pragma unroll
                for (int bj = 0; bj < 2; ++bj) {
                    const u32x4 gm = *(const u32x4*)(gate + row * 2048 + 1024 + col0 + bj * HALF);
                    f32x4 v0 = acc[ai][bj][m][0], v1 = acc[ai][bj][m][1];
                    v0[0] *= fmaxf(bflo(gm.x), 1e-30f); v0[1] *= fmaxf(bfhi(gm.x), 1e-30f); v0[2] *= fmaxf(bflo(gm.y), 1e-30f); v0[3] *= fmaxf(bfhi(gm.y), 1e-30f);
                    v1[0] *= fmaxf(bflo(gm.z), 1e-30f); v1[1] *= fmaxf(bfhi(gm.z), 1e-30f); v1[2] *= fmaxf(bflo(gm.w), 1e-30f); v1[3] *= fmaxf(bfhi(gm.w), 1e-30f);
                    u32x4 w; w.x = pk2(v0[0], v0[1]); w.y = pk2(v0[2], v0[3]); w.z = pk2(v1[0], v1[1]); w.w = pk2(v1[2], v1[3]);
                    *(u32x4*)(Hout + row * 1024 + col0 + bj * HALF) = w; } }
    }
};
struct EpiMoba {
    static constexpr bool PERM = true, HAS_MID = false, HEADS = true;
    bf16_t* MO; const float* qgain; const float* kgain; float* KM; int km_half;
    __device__ __forceinline__ void operator()(const f32x4 (&acc)[2][2][4][2], const Unit& u, int wr, int wc, int fr, int fq) const {
        const int row0 = u.pm * BM + wr * 64 + fr; const int kind = u.pn >> 1; const int colb = u.pn * BM + 64 * wc + 8 * fq;
        if (kind == 2) {
#pragma unroll
            for (int ai = 0; ai < 2; ++ai)
#pragma unroll
                for (int m = 0; m < 4; ++m) { bf16_t* rowp = MO + (size_t)(row0 + ai * HALF + m * 16) * 1536 + colb;
#pragma unroll
                    for (int bj = 0; bj < 2; ++bj) { const f32x4 v0 = acc[ai][bj][m][0], v1 = acc[ai][bj][m][1];
                        u32x4 w; w.x = pk2(v0[0], v0[1]); w.y = pk2(v0[2], v0[3]); w.z = pk2(v1[0], v1[1]); w.w = pk2(v1[2], v1[3]); *(u32x4*)(rowp + 32 * bj) = w; } }
            return;
        }
        const float* gp = (kind == 0 ? qgain : kgain) + 8 * fq; const float gs = (kind == 0) ? 0.125f : 1.0f;
        f32x4 gn[2][2];
#pragma unroll
        for (int bj = 0; bj < 2; ++bj)
#pragma unroll
            for (int n = 0; n < 2; ++n) gn[bj][n] = *(const f32x4*)(gp + 32 * bj + 4 * n) * gs;
        f32x4 cs[2][2];
#pragma unroll
        for (int bj = 0; bj < 2; ++bj)
#pragma unroll
            for (int n = 0; n < 2; ++n) cs[bj][n] = (f32x4){0.f, 0.f, 0.f, 0.f};
        float rsv[2][4];
#pragma unroll
        for (int ai = 0; ai < 2; ++ai)
#pragma unroll
            for (int m = 0; m < 4; ++m) { float ss = 0.f;
#pragma unroll
                for (int bj = 0; bj < 2; ++bj)
#pragma unroll
                    for (int n = 0; n < 2; ++n) { const f32x4 x = acc[ai][bj][m][n]; ss += (x[0] * x[0] + x[1] * x[1]) + (x[2] * x[2] + x[3] * x[3]); }
                rsv[ai][m] = ss; }
#pragma unroll
        for (int ai = 0; ai < 2; ++ai)
#pragma unroll
            for (int m = 0; m < 4; ++m) rsv[ai][m] += __shfl_xor(rsv[ai][m], 16);
#pragma unroll
        for (int ai = 0; ai < 2; ++ai)
#pragma unroll
            for (int m = 0; m < 4; ++m) { rsv[ai][m] += __shfl_xor(rsv[ai][m], 32); rsv[ai][m] = __builtin_amdgcn_rsqf(rsv[ai][m] * (1.f / 64.f) + 1e-6f); }
#pragma unroll
        for (int ai = 0; ai < 2; ++ai)
#pragma unroll
            for (int m = 0; m < 4; ++m) { const float rs = rsv[ai][m];
                bf16_t* rowp = MO + (size_t)(row0 + ai * HALF + m * 16) * 1536 + colb;
#pragma unroll
                for (int bj = 0; bj < 2; ++bj) { const f32x4 v0 = acc[ai][bj][m][0] * rs * gn[bj][0], v1 = acc[ai][bj][m][1] * rs * gn[bj][1];
                    cs[bj][0] += v0; cs[bj][1] += v1;
                    u32x4 w; w.x = pk2(v0[0], v0[1]); w.y = pk2(v0[2], v0[3]); w.z = pk2(v1[0], v1[1]); w.w = pk2(v1[2], v1[3]); *(u32x4*)(rowp + 32 * bj) = w; }
                asm volatile("" : "+v"(cs[0][0]), "+v"(cs[0][1]), "+v"(cs[1][0]), "+v"(cs[1][1]));
            }
        if (kind == 1) {
#pragma unroll
            for (int bj = 0; bj < 2; ++bj)
#pragma unroll
                for (int n = 0; n < 2; ++n) { f32x4 t = cs[bj][n];
#pragma unroll
                    for (int j = 0; j < 4; ++j) { float v = t[j]; v += dpp_mov<0xB1>(v); v += dpp_mov<0x4E>(v); v += dpp_mov<0x141>(v); v += dpp_mov<0x140>(v); t[j] = v * (1.f / 256.f); }
                    if (fr == 0) *(f32x4*)(KM + (size_t)wr * km_half + (size_t)u.pm * 512 + (u.pn * BM - 512) + 64 * wc + 32 * bj + 8 * fq + 4 * n) = t; }
        }
    }
};
struct EpiResid {
    static constexpr bool PERM = false, HAS_MID = false, HEADS = false;
    const float* xin; float* out;
    __device__ __forceinline__ void operator()(const f32x4 (&acc)[2][2][4][2], const Unit& u, int wr, int wc, int fr, int fq) const {
        const int row0 = u.pm * BM + wr * 64 + fr, col0 = u.pn * BM + wc * 32 + 4 * fq;
#pragma unroll
        for (int ai = 0; ai < 2; ++ai)
#pragma unroll
            for (int m = 0; m < 4; ++m) { const size_t off = (size_t)(row0 + ai * HALF + m * 16) * 1024 + col0;
#pragma unroll
                for (int bj = 0; bj < 2; ++bj)
#pragma unroll
                    for (int n = 0; n < 2; ++n) { const f32x4 xv = *(const f32x4*)(xin + off + bj * HALF + n * 16); *(f32x4*)(out + off + bj * HALF + n * 16) = xv + acc[ai][bj][m][n]; } }
    }
};
struct EpiExpertUp {
    static constexpr bool PERM = true, HAS_MID = false, HEADS = false;
    bf16_t* HM; const float* gw; const float* rsr;
    __device__ __forceinline__ void operator()(const f32x4 (&acc)[2][2][4][2], const Unit& u, int wr, int wc, int fr, int fq) const {
        const int row0 = u.pm * BM + wr * 64 + fr; const int col0 = u.pn * 128 + wc * 32 + 8 * fq;
#pragma unroll
        for (int ai = 0; ai < 2; ++ai)
#pragma unroll
            for (int m = 0; m < 4; ++m) { const size_t row = (size_t)(row0 + ai * HALF + m * 16); const float rs = rsr[row]; const float gwt = gw[row] * rs;
                f32x4 v0, v1;
#pragma unroll
                for (int j = 0; j < 4; ++j) { const float g0 = acc[ai][0][m][0][j] * rs, g1 = acc[ai][0][m][1][j] * rs;
                    v0[j] = g0 * sigmoidf_(g0) * acc[ai][1][m][0][j] * gwt; v1[j] = g1 * sigmoidf_(g1) * acc[ai][1][m][1][j] * gwt; }
                u32x4 w; w.x = pk2(v0[0], v0[1]); w.y = pk2(v0[2], v0[3]); w.z = pk2(v1[0], v1[1]); w.w = pk2(v1[2], v1[3]);
                *(u32x4*)(HM + row * 512 + col0) = w; }
    }
};
}
constexpr size_t SI_PLANE = (size_t)T * CW * 2;
DI float softplusf_(float z) { return fmaxf(z, 0.f) + __logf(1.0f + __expf(-fabsf(z))); }

#ifndef PREP_DUP
#define PREP_DUP 0
#endif
constexpr int ACT_P = 592;
constexpr size_t WM_L2T = (size_t)WCAT_ROWS * 1024 * 2 + 2 * 1024 * 512 * 2 + 1024 * 1024 * 2;
DI void phase_conv_lora2(Frame& F, int l) {
    bf16_t* L2T = (bf16_t*)(F.wsp() + WS_WM + WM_L2T);
    const float* w2 = F.inp(8) + (size_t)l * 64 * CW; const float* a2 = F.inp(11) + (size_t)l * 64 * CW; const float* g2 = F.inp(13) + (size_t)l * 128 * CW; const float* v2 = F.inp(22);
    for (int idx = F.bid * 512 + F.tid; idx < 288 * CW; idx += F.G * 512) { const int j = idx >> 9, c = idx & 511;
        float v;
        if (j < 64) v = w2[j * CW + c]; else if (j < 128) v = a2[(j - 64) * CW + c]; else if (j < 256) v = g2[(j - 128) * CW + c]; else v = (l > 0) ? v2[(j - 256) * CW + c] : 0.f;
        L2T[c * 288 + j] = f2bf(v); }
}
DI unsigned ror1(unsigned x) { return (unsigned)__builtin_amdgcn_update_dpp(0, (int)x, 0x121, 0xf, 0xf, true); }
DI unsigned shr1_keep(unsigned o, unsigned cur) { return (unsigned)__builtin_amdgcn_update_dpp((int)o, (int)cur, 0x111, 0xf, 0xf, false); }
DI unsigned prev_lane(unsigned older, unsigned cur) { return shr1_keep(ror1(older), cur); }
DI float row16_sum(float v) { v += dpp_mov<0xB1>(v); v += dpp_mov<0x4E>(v); v += dpp_mov<0x141>(v); v += dpp_mov<0x140>(v); return v; }
DI void phase_rwkv_prep2(Frame& F, int l, int tile_lo, int tile_hi, int tile_step, bool init) {
    LAS unsigned char* act = F.lds;
    LAS float* INVL = (LAS float*)(F.lds + 38912);
    LAS float* PRM = (LAS float*)(F.lds + 139264);
    const bf16_t* RW = (const bf16_t*)(F.wsp() + WS_RW); const bf16_t* LO = (const bf16_t*)(F.wsp() + WS_LO); const unsigned char* L2T = F.wsp() + WS_WM + WM_L2T;
    bf16_t* SIr = (bf16_t*)(F.wsp() + WS_SIR); bf16_t* SIk = (bf16_t*)(F.wsp() + WS_SIK);
    bf16_t* SCw = (bf16_t*)(F.wsp() + WS_SCRW) + (size_t)F.bid * 64 * CW; bf16_t* SCa = (bf16_t*)(F.wsp() + WS_SCRA) + (size_t)F.bid * 64 * CW; bf16_t* SCb = (bf16_t*)(F.wsp() + WS_SCRB) + (size_t)F.bid * 64 * CW;
    bf16_t* VF = (bf16_t*)(F.wsp() + WS_VF); bf16_t* V1 = (bf16_t*)(F.wsp() + WS_V1); bf16_t* Gb = (bf16_t*)(F.wsp() + WS_G);
    const int lane = F.lane, r16 = lane & 15, g = lane >> 4;
    if (init) { __syncthreads();
      const int c = F.tid;
      PRM[c] = F.inp(4)[(size_t)l * 3 * CW + c]; PRM[512 + c] = F.inp(4)[(size_t)l * 3 * CW + CW + c]; PRM[1024 + c] = F.inp(4)[(size_t)l * 3 * CW + 2 * CW + c];
      PRM[1536 + c] = F.inp(6)[l * CW + c]; PRM[2048 + c] = F.inp(9)[l * CW + c]; PRM[2560 + c] = F.inp(14)[l * CW + c]; PRM[3072 + c] = F.inp(15)[l * CW + c]; PRM[3584 + c] = l > 0 ? F.inp(20)[c] : 0.f; }
    for (int tile = tile_lo; tile < tile_hi; tile += tile_step) {
        int t0 = tile * 64; asm volatile("" : "+s"(t0));
        __syncthreads();
        for (int dup1_ = 0; dup1_ < ((PREP_DUP & 1) ? 2 : 1); ++dup1_)
        for (int grp = F.tid; grp < 64 * 36; grp += 512) { const int tt = grp / 36, jg = grp - tt * 36, j0 = 8 * jg; const int t = t0 + tt; const bool has_prev = (t % SEQ) != 0;
            int pj, qj; if (j0 < 64) { pj = j0; qj = 64 + j0; } else if (j0 < 128) { pj = 128 + (j0 - 64); qj = 192 + (j0 - 64); } else if (j0 < 256) { pj = 256 + (j0 - 128); qj = 384 + (j0 - 128); } else { pj = 512 + (j0 - 256); qj = 544 + (j0 - 256); }
            const u32x4 pv = *(const u32x4*)(LO + (size_t)t * LO_W + pj); u32x4 qv = {0u, 0u, 0u, 0u}; if (has_prev) qv = *(const u32x4*)(LO + (size_t)(t - 1) * LO_W + qj);
            const unsigned pw[4] = {pv.x, pv.y, pv.z, pv.w}, qw[4] = {qv.x, qv.y, qv.z, qv.w}; float v[8];
#pragma unroll
            for (int q = 0; q < 4; ++q) { v[2 * q] = bflo(pw[q]) + bflo(qw[q]); v[2 * q + 1] = bfhi(pw[q]) + bfhi(qw[q]); }
            if (j0 < 64) {
#pragma unroll
                for (int e = 0; e < 8; ++e) v[e] = 1.0f - 2.0f * __builtin_amdgcn_rcpf(1.0f + __expf(2.0f * v[e]));
            } else if (j0 >= 128 && j0 < 256) {
#pragma unroll
                for (int e = 0; e < 8; ++e) v[e] = sigmoidf_(v[e]);
            }
            u32x4 w; w.x = pk2(v[0], v[1]); w.y = pk2(v[2], v[3]); w.z = pk2(v[4], v[5]); w.w = pk2(v[6], v[7]);
            *(LAS u32x4*)(act + tt * ACT_P + j0 * 2) = w; }
        { int cw = 64 * F.wave + 16 * g; asm volatile("" : "+v"(cw));
          u32x4 kc[4][2], kq0[2];
          const bf16_t* RWt = RW + (size_t)t0 * 1536; const unsigned lk = (unsigned)(r16 * 1536 + 512 + cw);
#pragma unroll
          for (int tt = 0; tt < 4; ++tt) {
#pragma unroll
              for (int h = 0; h < 2; ++h) kc[tt][h] = *(const u32x4*)(RWt + 16 * tt * 1536 + 8 * h + lk); }
          { const int t = t0 + r16; const bool has_prev = (t % SEQ) != 0;
#pragma unroll
            for (int h = 0; h < 2; ++h) { kq0[h] = (u32x4){0u, 0u, 0u, 0u}; if (has_prev) kq0[h] = *(const u32x4*)(RWt - 1536 + 8 * h + lk); } }
#pragma unroll
          for (int tt = 0; tt < 4; ++tt) { float ss = 0.f;
#pragma unroll
              for (int h = 0; h < 2; ++h) {
                  const unsigned cwd[4] = {kc[tt][h].x, kc[tt][h].y, kc[tt][h].z, kc[tt][h].w}; unsigned pwd[4];
                  if (tt == 0) { pwd[0] = kq0[h].x; pwd[1] = kq0[h].y; pwd[2] = kq0[h].z; pwd[3] = kq0[h].w; }
                  else { const unsigned owd[4] = {kc[tt > 0 ? tt - 1 : 0][h].x, kc[tt > 0 ? tt - 1 : 0][h].y, kc[tt > 0 ? tt - 1 : 0][h].z, kc[tt > 0 ? tt - 1 : 0][h].w};
#pragma unroll
                      for (int d = 0; d < 4; ++d) pwd[d] = prev_lane(owd[d], cwd[d]); }
#pragma unroll
                  for (int d2 = 0; d2 < 2; ++d2) { const f32x4 muk = *(const LAS f32x4*)(PRM + 512 + cw + 8 * h + 4 * d2), kkc = *(const LAS f32x4*)(PRM + 2560 + cw + 8 * h + 4 * d2);
                      const float k0 = bflo(cwd[2 * d2]), k1 = bfhi(cwd[2 * d2]), k2 = bflo(cwd[2 * d2 + 1]), k3 = bfhi(cwd[2 * d2 + 1]), q0 = bflo(pwd[2 * d2]), q1 = bfhi(pwd[2 * d2]), q2 = bflo(pwd[2 * d2 + 1]), q3 = bfhi(pwd[2 * d2 + 1]);
                      const float a0 = (k0 + (q0 - k0) * muk[0]) * kkc[0], a1 = (k1 + (q1 - k1) * muk[1]) * kkc[1], a2 = (k2 + (q2 - k2) * muk[2]) * kkc[2], a3 = (k3 + (q3 - k3) * muk[3]) * kkc[3];
                      ss += (a0 * a0 + a1 * a1) + (a2 * a2 + a3 * a3); } }
              ss += __shfl_xor(ss, 16); ss += __shfl_xor(ss, 32);
              if (g == 0) INVL[(16 * tt + r16) * 8 + F.wave] = __builtin_amdgcn_rsqf(fmaxf(ss, 1e-24f)); } }
        __syncthreads();
#pragma unroll 1
        for (int j8 = 0; j8 < ((PREP_DUP & 8) ? 4 : 2); ++j8) { const int j = j8 & 1;
            int cb = 256 * j + 32 * F.wave; asm volatile("" : "+v"(cb));
            const int c0 = cb + 8 * g, hd = 4 * j + (F.wave >> 1);
            bf16x8 wf[2][9];
#pragma unroll
            for (int u = 0; u < 2; ++u) { const unsigned char* wrow = L2T + (size_t)(cb + 8 * (r16 >> 2) + 4 * u + (r16 & 3)) * 576 + 16 * g;
#pragma unroll
              for (int s = 0; s < 9; ++s) wf[u][s] = *(const bf16x8*)(wrow + 64 * s); }
            u32x4 cur[2][3], vfl[2], prv0[3]; unsigned rot[3][4] = {{0u, 0u, 0u, 0u}, {0u, 0u, 0u, 0u}, {0u, 0u, 0u, 0u}};
            const bf16_t* RWt = RW + (size_t)t0 * 1536; const unsigned lr = (unsigned)(r16 * 1536 + c0), lc = (unsigned)(r16 * CW + c0);
            const size_t tb = (size_t)t0 * CW;
#define PREP_LOAD(buf, tt_) do { _Pragma("unroll") for (int p_ = 0; p_ < 3; ++p_) cur[buf][p_] = *(const u32x4*)(RWt + 16 * (tt_) * 1536 + 512 * p_ + lr); \
                vfl[buf] = (u32x4){0u, 0u, 0u, 0u}; if (l > 0) vfl[buf] = *(const u32x4*)(VF + tb + 16 * (tt_) * CW + lc); } while (0)
            PREP_LOAD(0, 0);
            { const int t = t0 + r16; const bool has_prev = (t % SEQ) != 0;
#pragma unroll
              for (int p_ = 0; p_ < 3; ++p_) { prv0[p_] = (u32x4){0u, 0u, 0u, 0u}; if (has_prev) prv0[p_] = *(const u32x4*)(RWt - 1536 + 512 * p_ + lr); } }
#pragma unroll
            for (int tt = 0; tt < 4; ++tt) {
                const int bi = tt & 1;
                if (tt < 3) PREP_LOAD(bi ^ 1, tt + 1);
                const size_t oo = tb + 16 * tt * CW; const unsigned os = (unsigned)(16 * tt * CW) + lc;
                bf16x8 a[9];
#pragma unroll
                for (int s = 0; s < 9; ++s) a[s] = *(const LAS bf16x8*)(act + (16 * tt + r16) * ACT_P + (32 * s + 8 * g) * 2);
                const float inv = INVL[(16 * tt + r16) * 8 + hd];
                f32x4 aw[2], aa[2], ag[2], av[2];
#pragma unroll
                for (int u = 0; u < 2; ++u) { aw[u] = (f32x4){0.f, 0.f, 0.f, 0.f}; aa[u] = aw[u]; ag[u] = aw[u]; av[u] = aw[u];
                    aw[u] = mfma16(wf[u][0], a[0], aw[u]); aw[u] = mfma16(wf[u][1], a[1], aw[u]);
                    aa[u] = mfma16(wf[u][2], a[2], aa[u]); aa[u] = mfma16(wf[u][3], a[3], aa[u]);
                    ag[u] = mfma16(wf[u][4], a[4], ag[u]); ag[u] = mfma16(wf[u][5], a[5], ag[u]); ag[u] = mfma16(wf[u][6], a[6], ag[u]); ag[u] = mfma16(wf[u][7], a[7], ag[u]);
                    if (l > 0) av[u] = mfma16(wf[u][8], a[8], av[u]); }
                unsigned cw_[3][4], pw_[3][4];
#pragma unroll
                for (int p_ = 0; p_ < 3; ++p_) { cw_[p_][0] = cur[bi][p_].x; cw_[p_][1] = cur[bi][p_].y; cw_[p_][2] = cur[bi][p_].z; cw_[p_][3] = cur[bi][p_].w;
                    if (tt == 0) { pw_[p_][0] = prv0[p_].x; pw_[p_][1] = prv0[p_].y; pw_[p_][2] = prv0[p_].z; pw_[p_][3] = prv0[p_].w; }
                    else { pw_[p_][0] = shr1_keep(rot[p_][0], cw_[p_][0]); pw_[p_][1] = shr1_keep(rot[p_][1], cw_[p_][1]); pw_[p_][2] = shr1_keep(rot[p_][2], cw_[p_][2]); pw_[p_][3] = shr1_keep(rot[p_][3], cw_[p_][3]); }
#pragma unroll
                    for (int d = 0; d < 4; ++d) rot[p_][d] = ror1(cw_[p_][d]); }
                const unsigned vw_[4] = {vfl[bi].x, vfl[bi].y, vfl[bi].z, vfl[bi].w};
                float ro8[8], lw8[8], vo8[8], k28[8], ka8[8], kb8[8], g8[8];
#pragma unroll
                for (int u = 0; u < 2; ++u) {
                    const f32x4 mur = *(const LAS f32x4*)(PRM + c0 + 4 * u), muk = *(const LAS f32x4*)(PRM + 512 + c0 + 4 * u), muv = *(const LAS f32x4*)(PRM + 1024 + c0 + 4 * u), w0v = *(const LAS f32x4*)(PRM + 1536 + c0 + 4 * u),
                                a0v = *(const LAS f32x4*)(PRM + 2048 + c0 + 4 * u), kkc = *(const LAS f32x4*)(PRM + 2560 + c0 + 4 * u), kac = *(const LAS f32x4*)(PRM + 3072 + c0 + 4 * u), v0v = *(const LAS f32x4*)(PRM + 3584 + c0 + 4 * u);
#pragma unroll
                    for (int r = 0; r < 4; ++r) { const int e = 4 * u + r, d = e >> 1;
                        const float rp = (e & 1) ? bfhi(cw_[0][d]) : bflo(cw_[0][d]), kp = (e & 1) ? bfhi(cw_[1][d]) : bflo(cw_[1][d]), vp = (e & 1) ? bfhi(cw_[2][d]) : bflo(cw_[2][d]);
                        const float rq = (e & 1) ? bfhi(pw_[0][d]) : bflo(pw_[0][d]), kq_ = (e & 1) ? bfhi(pw_[1][d]) : bflo(pw_[1][d]), vq = (e & 1) ? bfhi(pw_[2][d]) : bflo(pw_[2][d]);
                        const float rr = rp + (rq - rp) * mur[r], k = kp + (kq_ - kp) * muk[r]; float v = vp + (vq - vp) * muv[r];
                        lw8[e] = -0.60653066f * sigmoidf_(w0v[r] + aw[u][r]);
                        const float alr = sigmoidf_(a0v[r] + aa[u][r]);
                        if (l > 0) { const float vf = (e & 1) ? bfhi(vw_[d]) : bflo(vw_[d]); v = v + (vf - v) * sigmoidf_(v0v[r] + av[u][r]); }
                        const float kk = k * kkc[r] * inv;
                        ro8[e] = rr; vo8[e] = v; k28[e] = k * (1.f + (alr - 1.f) * kac[r]); ka8[e] = kk; kb8[e] = kk * alr; g8[e] = ag[u][r]; } }
#define PREP_ST(ptr, arr) { u32x4 w_; w_.x = pk2(arr[0], arr[1]); w_.y = pk2(arr[2], arr[3]); w_.z = pk2(arr[4], arr[5]); w_.w = pk2(arr[6], arr[7]); *(u32x4*)(ptr) = w_; }
                PREP_ST(SIr + oo + lc, ro8) PREP_ST(SCw + os, lw8) PREP_ST(Gb + oo + lc, g8) PREP_ST((l > 0 ? V1 : VF) + oo + lc, vo8) PREP_ST(SIk + oo + lc, k28) PREP_ST(SCa + os, ka8) PREP_ST(SCb + os, kb8)
#undef PREP_ST
                asm volatile("" ::: "memory");
            }
#undef PREP_LOAD
        }
    }
}
constexpr int NUNIT = NB * NH * (SEQ / 64);
constexpr size_t U_PMP = 0, U_RPP = 8192, U1_BYTES = 16384;
constexpr size_t U_QMT = 0, U_YLT = 8192, U2_BYTES = 16384;
DI int permk(int k) { return (k & 32) | (((k >> 2) & 3) << 3) | (((k >> 4) & 1) << 2) | (k & 3); }
constexpr int MP = 144;
constexpr int SP = 80;
DI f32x4 mm_tile(const LAS unsigned char* xb, int px, int m0, const LAS unsigned char* yb, int py, int n0, int ks, f32x4 acc, int lane, int sx = 0, int sy = 0) {
    const int r16 = lane & 15, g = lane >> 4; const int fx = (m0 >> 4) & sx, fy = (n0 >> 4) & sy;
    for (int s = 0; s < ks; ++s) {
        const bf16x8 a = *(const LAS bf16x8*)(xb + (m0 + r16) * px + (((4 * s + g) ^ fx) << 4));
        const bf16x8 b = *(const LAS bf16x8*)(yb + (n0 + r16) * py + (((4 * s + g) ^ fy) << 4));
        acc = mfma16(a, b, acc);
    }
    return acc;
}
DI u32x2 pk4(f32x4 v) { u32x2 w; w.x = pk2(v[0], v[1]); w.y = pk2(v[2], v[3]); return w; }

#ifndef SA_TOUCH
#define SA_TOUCH 1
#endif
#ifndef SA_DUP
#define SA_DUP 0
#endif
#define SA_REP(bit) for (int sd_ = 0; sd_ < ((SA_DUP & (bit)) ? 2 : 1); ++sd_)
DI void phase_scan_a(Frame& F, int l, int u_lo, int u_hi, int u_step) {
    LAS unsigned char* const L = F.lds;
#define MB(n) (L + (n) * 9216)
    LAS float* const Gf = (LAS float*)(L + 110592);
    constexpr int GP = 68;
    LAS float* const SEG = (LAS float*)(L + 110592 + 64 * GP * 4);
    LAS float* const GL = SEG + 512;
    LAS unsigned char* const A21 = L + 110592 + 64 * GP * 4 + 2048 + 256;
    LAS unsigned char* const T11T = A21 + 2560;
    LAS unsigned char* const ZT = T11T + 2560;
    const bf16_t* SIr = (const bf16_t*)(F.wsp() + WS_SIR); const bf16_t* SIk = (const bf16_t*)(F.wsp() + WS_SIK);
    const bf16_t* SCw = (const bf16_t*)(F.wsp() + WS_SCRW) + (size_t)F.bid * 64 * CW; const bf16_t* SCa = (const bf16_t*)(F.wsp() + WS_SCRA) + (size_t)F.bid * 64 * CW; const bf16_t* SCb = (const bf16_t*)(F.wsp() + WS_SCRB) + (size_t)F.bid * 64 * CW;
    const bf16_t* V = (const bf16_t*)(F.wsp() + (l > 0 ? WS_V1 : WS_VF));
    const int lane = F.lane, wave = F.wave, r16 = lane & 15, g = lane >> 4;
    float plw[8]; u32x4 prv, pkv, pav, pbv, pvv;
#define SCANA_LOAD(uu) do { const int bh_ = (uu) & 31, c_ = (uu) >> 5, b_ = bh_ >> 3, h_ = bh_ & 7; const size_t t0_ = (size_t)b_ * SEQ + c_ * 64; \
        { const int k_ = F.tid & 63, seg_ = F.tid >> 6; _Pragma("unroll") for (int e = 0; e < 8; ++e) plw[e] = bf2f(SCw[(size_t)(8 * seg_ + e) * CW + h_ * 64 + k_]); } \
        { const int i_ = F.tid >> 3, k0_ = (F.tid & 7) * 8; const size_t go_ = (t0_ + i_) * CW + h_ * 64 + k0_, gs_ = (size_t)i_ * CW + h_ * 64 + k0_; \
          prv = *(const u32x4*)(SIr + go_); pkv = *(const u32x4*)(SIk + go_); pav = *(const u32x4*)(SCa + gs_); pbv = *(const u32x4*)(SCb + gs_); pvv = *(const u32x4*)(V + go_); } } while (0)
    if (u_lo < u_hi) SCANA_LOAD(u_lo);
    __syncthreads();
    for (int u = u_lo; u < u_hi; u += u_step) {
        const int bh = u & 31, c = u >> 5, b = bh >> 3, h = bh & 7;
        const size_t t0 = (size_t)b * SEQ + c * 64; (void)t0; (void)b; (void)h;
        unsigned char* const rec1 = F.wsp() + WS_SC1 + (size_t)((bh * 128) + c) * U1_BYTES; unsigned char* const rec2 = F.wsp() + WS_SC2 + (size_t)((bh * 128) + c) * U2_BYTES;
        SA_REP(1) {
        { const int k = F.tid & 63, seg = F.tid >> 6; float p[8]; float run = 0.f;
#pragma unroll
          for (int e = 0; e < 8; ++e) { run += plw[e]; p[e] = run; }
          SEG[seg * 64 + k] = run;
          __syncthreads();
          float off = 0.f;
#pragma unroll
          for (int s = 0; s < 8; ++s) off += (s < seg) ? SEG[s * 64 + k] : 0.f;
#pragma unroll
          for (int e = 0; e < 8; ++e) Gf[(8 * seg + e) * GP + k] = off + p[e];
        }
        __syncthreads();
        { const int i = F.tid >> 3, k0 = (F.tid & 7) * 8;
          const u32x4 rv = prv, kv = pkv, av = pav, bv = pbv, vv = pvv;
          float fr[8], fk[8], fa[8], fb[8], fv[8];
          const unsigned rw[4] = {rv.x, rv.y, rv.z, rv.w}, kw[4] = {kv.x, kv.y, kv.z, kv.w}, aw[4] = {av.x, av.y, av.z, av.w}, bw[4] = {bv.x, bv.y, bv.z, bv.w}, vw[4] = {vv.x, vv.y, vv.z, vv.w};
#pragma unroll
          for (int q = 0; q < 4; ++q) { fr[2 * q] = bflo(rw[q]); fr[2 * q + 1] = bfhi(rw[q]); fk[2 * q] = bflo(kw[q]); fk[2 * q + 1] = bfhi(kw[q]); fa[2 * q] = bflo(aw[q]); fa[2 * q + 1] = bfhi(aw[q]);
              fb[2 * q] = bflo(bw[q]); fb[2 * q + 1] = bfhi(bw[q]); fv[2 * q] = bflo(vw[q]); fv[2 * q + 1] = bfhi(vw[q]); }
          float at[8], rt[8], bt[8], kt[8], bh8[8], kh8[8];
#pragma unroll
          for (int e = 0; e < 8; ++e) { const float gi = Gf[i * GP + k0 + e], gp = (i > 0) ? Gf[(i - 1) * GP + k0 + e] : 0.f, gl = Gf[63 * GP + k0 + e];
              const float e1 = __expf(gp), e2 = __expf(gi), e3 = __expf(-gi), e4 = __expf(gl - gi);
              at[e] = -fa[e] * e1; rt[e] = fr[e] * e2; bt[e] = fb[e] * e3; kt[e] = fk[e] * e3; bh8[e] = fb[e] * e4; kh8[e] = fk[e] * e4;
              if (i == 63) GL[k0 + e] = e2; }
          u32x4 w;
          w.x = pk2(at[0], at[1]); w.y = pk2(at[2], at[3]); w.z = pk2(at[4], at[5]); w.w = pk2(at[6], at[7]); *(LAS u32x4*)(MB(0) + i * MP + k0 * 2) = w;
          w.x = pk2(rt[0], rt[1]); w.y = pk2(rt[2], rt[3]); w.z = pk2(rt[4], rt[5]); w.w = pk2(rt[6], rt[7]); *(LAS u32x4*)(MB(1) + i * MP + k0 * 2) = w;
          w.x = pk2(bt[0], bt[1]); w.y = pk2(bt[2], bt[3]); w.z = pk2(bt[4], bt[5]); w.w = pk2(bt[6], bt[7]); *(LAS u32x4*)(MB(2) + i * MP + k0 * 2) = w;
          w.x = pk2(kt[0], kt[1]); w.y = pk2(kt[2], kt[3]); w.z = pk2(kt[4], kt[5]); w.w = pk2(kt[6], kt[7]); *(LAS u32x4*)(MB(3) + i * MP + k0 * 2) = w;
          { const int sel = i & 1;
#pragma unroll
            for (int q = 0; q < 4; ++q) { const int row = k0 + 4 * sel + q; const int ro = row * MP + (((i >> 3) ^ ((row >> 4) & 3)) << 4) + (i & 6) * 2;
#define TW(dst, arr) { const float d0_ = dpp_mov<0x128>(arr[q]), d1_ = dpp_mov<0x128>(arr[4 + q]);     \
                       const float m_ = sel ? arr[4 + q] : arr[q], o_ = sel ? d1_ : d0_; *(LAS unsigned*)(dst + ro) = pk2(sel ? o_ : m_, sel ? m_ : o_); }
                TW(MB(4), at) TW(MB(5), fv) TW(MB(6), bh8) TW(MB(7), kh8)
#undef TW
            } }
        }
        __syncthreads(); }
        if (u + u_step < u_hi) SCANA_LOAD(u + u_step);
        SA_REP(2) {
        { const int prod = wave >> 1;
          const LAS unsigned char* xb = (prod & 1) ? MB(3) : MB(2); const LAS unsigned char* yb = (prod < 2) ? MB(0) : MB(1);
          LAS unsigned char* ob = (prod == 1) ? MB(8) : (prod == 2) ? MB(9) : MB(10);
          float zf = 0.f; asm volatile("" : "+v"(zf));
          for (int q = 0; q < 8; ++q) { const int tt = (wave & 1) * 8 + q, tm = tt >> 2, tn = tt & 3;
              f32x4 acc = {zf, zf, zf, zf};
              if (tm <= tn) acc = mm_tile(xb, MP, 16 * tm, yb, MP, 16 * tn, 2, acc, lane);
              const int i = 16 * tn + r16, j0 = 16 * tm + 4 * g;
#pragma unroll
              for (int r = 0; r < 4; ++r) { const int j = j0 + r; const bool keep = (prod < 2) ? (j < i) : (j <= i); if (!keep) acc[r] = 0.f; }
              if (prod == 0) {
                  if ((i >> 5) == (j0 >> 5)) *(LAS f32x4*)(Gf + ((i >> 5) * 32 + (i & 31)) * 32 + (j0 & 31)) = acc;
                  if (i >= 32 && j0 < 32) *(LAS u32x2*)(A21 + (i - 32) * SP + j0 * 2) = pk4(acc);
              } else *(LAS u32x2*)(ob + i * MP + j0 * 2) = pk4(acc);
          } }
        __syncthreads();
        }
        f32x4 pyl[2] = {{0.f, 0.f, 0.f, 0.f}, {0.f, 0.f, 0.f, 0.f}}, pqm[2] = {{0.f, 0.f, 0.f, 0.f}, {0.f, 0.f, 0.f, 0.f}};
        SA_REP(4) {
        if (wave == 0) {
            const int blk = lane >> 5, cc = lane & 31; const LAS float* AD = Gf + blk * 1024;
            float Tc[32];
#pragma unroll
            for (int i = 0; i < 32; ++i) { float a0 = (i == cc) ? 1.f : 0.f, a1 = 0.f, a2 = 0.f, a3 = 0.f;
#pragma unroll
                for (int q = 0; q < (i + 3) / 4; ++q) { const f32x4 a = *(const LAS f32x4*)(AD + i * 32 + 4 * q);
                    if (4 * q + 0 < i) a0 += a[0] * Tc[4 * q + 0]; if (4 * q + 1 < i) a1 += a[1] * Tc[4 * q + 1]; if (4 * q + 2 < i) a2 += a[2] * Tc[4 * q + 2]; if (4 * q + 3 < i) a3 += a[3] * Tc[4 * q + 3]; }
                Tc[i] = (a0 + a1) + (a2 + a3); }
#pragma unroll
            for (int i = 0; i < 32; ++i) *(LAS bf16_t*)(MB(11) + (32 * blk + i) * MP + (32 * blk + cc) * 2) = f2bf(Tc[i]);
            if (blk == 0) {
#pragma unroll
                for (int q = 0; q < 4; ++q) { u32x4 w; w.x = pk2(Tc[8 * q], Tc[8 * q + 1]); w.y = pk2(Tc[8 * q + 2], Tc[8 * q + 3]); w.z = pk2(Tc[8 * q + 4], Tc[8 * q + 5]); w.w = pk2(Tc[8 * q + 6], Tc[8 * q + 7]);
                    *(LAS u32x4*)(T11T + cc * SP + q * 16) = w; }
            } else {
                unsigned z = 0u; asm volatile("" : "+v"(z));
#pragma unroll
                for (int q = 0; q < 4; ++q) *(LAS u32x4*)(MB(11) + cc * MP + 64 + q * 16) = (u32x4){z, z, z, z};
            }
        } else {
            for (int tt = wave - 1; tt < 16; tt += 7) { const int tm = tt >> 2, tn = tt & 3;
                f32x4 acc = {0.f, 0.f, 0.f, 0.f};
                acc = mm_tile(MB(8), MP, 16 * tm, MB(5), MP, 16 * tn, 2, acc, lane, 0, 3);
                *(LAS u32x2*)(MB(2) + (16 * tn + r16) * MP + (16 * tm + 4 * g) * 2) = pk4(acc); }
            if (sd_ == 0) {
#pragma unroll
                for (int q = 0; q < 2; ++q) { const int tt = wave * 2 + q, tm = tt >> 2, tn = tt & 3; const f32x4 z = {0.f, 0.f, 0.f, 0.f};
                    pyl[q] = mm_tile(MB(5), MP, 16 * tm, MB(10), MP, 16 * tn, 2, z, lane, 3, 0);
                    pqm[q] = mm_tile(MB(7), MP, 16 * tm, MB(5), MP, 16 * tn, 2, z, lane, 3, 3); } }
        }
        __syncthreads();
        if (wave < 4) { const int tm = wave >> 1, tn = wave & 1; LAS unsigned char* const zp = MB(0) + wave * 1280;
#pragma unroll
            for (int mt = 0; mt < 2; ++mt) { f32x4 acc = {0.f, 0.f, 0.f, 0.f};
                acc = mm_tile(A21, SP, 16 * mt, T11T, SP, 16 * tm, 1, acc, lane);
                *(LAS u32x2*)(zp + r16 * SP + (16 * mt + 4 * g) * 2) = pk4(acc); }
            asm volatile("s_waitcnt lgkmcnt(0)" ::: "memory");
            f32x4 acc = {0.f, 0.f, 0.f, 0.f};
            acc = mm_tile(zp, SP, 0, MB(11) + 32 * MP + 64, MP, 16 * tn, 1, acc, lane);
            *(LAS u32x2*)(MB(11) + (32 + 16 * tn + r16) * MP + (16 * tm + 4 * g) * 2) = pk4(acc); }
        __syncthreads();
        }
        SA_REP(8) {
        { const LAS unsigned char* yb = (wave < 4) ? MB(4) : MB(2); LAS unsigned char* ob = (wave < 4) ? MB(3) : MB(0);
          for (int q = 0; q < 4; ++q) { const int tt = (wave & 3) * 4 + q, tm = tt >> 2, tn = tt & 3;
              f32x4 acc = {0.f, 0.f, 0.f, 0.f};
              acc = mm_tile(MB(11), MP, 16 * tm, yb, MP, 16 * tn, 2, acc, lane, 0, (wave < 4) ? 3 : 0);
              *(LAS u32x2*)(ob + (16 * tn + r16) * MP + (16 * tm + 4 * g) * 2) = pk4(acc); } }
        __syncthreads();
        }
#if SA_TOUCH
        asm volatile("" : "+v"(plw[0]), "+v"(plw[1]), "+v"(plw[2]), "+v"(plw[3]), "+v"(plw[4]), "+v"(plw[5]), "+v"(plw[6]), "+v"(plw[7]), "+v"(prv), "+v"(pkv), "+v"(pav), "+v"(pbv), "+v"(pvv));
#endif
        SA_REP(16) {
#pragma unroll
        for (int q = 0; q < 2; ++q) { const int tt = wave * 2 + q, tm = tt >> 2, tn = tt & 3;
            { f32x4 acc = {0.f, 0.f, 0.f, 0.f}; acc = mm_tile(MB(3), MP, 16 * tm, MB(9), MP, 16 * tn, 2, acc, lane);
              const int i = 16 * tn + r16, k0 = 16 * tm + 4 * g; const u32x2 rr = *(const LAS u32x2*)(MB(1) + i * MP + k0 * 2);
              acc[0] += bflo(rr.x); acc[1] += bfhi(rr.x); acc[2] += bflo(rr.y); acc[3] += bfhi(rr.y);
              *(u32x2*)(rec1 + U_RPP + (size_t)(i * 64 + permk(k0)) * 2) = pk4(acc); }
            { f32x4 acc = {0.f, 0.f, 0.f, 0.f}; acc = mm_tile(MB(3), MP, 16 * tm, MB(6), MP, 16 * tn, 2, acc, lane, 0, 3);
              const int kp = 16 * tn + r16, k0 = 16 * tm + 4 * g;
#pragma unroll
              for (int r = 0; r < 4; ++r) if (k0 + r == kp) acc[r] += GL[kp];
              *(u32x2*)(rec1 + U_PMP + (size_t)(kp * 64 + permk(k0)) * 2) = pk4(acc); }
            { f32x4 acc = pyl[q]; acc = mm_tile(MB(0), MP, 16 * tm, MB(9), MP, 16 * tn, 2, acc, lane); if (wave == 0) acc = mm_tile(MB(5), MP, 16 * tm, MB(10), MP, 16 * tn, 2, acc, lane, 3, 0);
              *(u32x2*)(rec2 + U_YLT + (size_t)((16 * tn + r16) * 64 + 16 * tm + 4 * g) * 2) = pk4(acc); }
            { f32x4 acc = pqm[q]; acc = mm_tile(MB(6), MP, 16 * tm, MB(0), MP, 16 * tn, 2, acc, lane, 3, 0); if (wave == 0) acc = mm_tile(MB(7), MP, 16 * tm, MB(5), MP, 16 * tn, 2, acc, lane, 3, 3);
              *(u32x2*)(rec2 + U_QMT + (size_t)((16 * tn + r16) * 64 + 16 * tm + 4 * g) * 2) = pk4(acc); }
        }
        if (SA_DUP & 16) __syncthreads(); }
    }
#undef MB
#undef SCANA_LOAD
}

constexpr int SB_D = 9, SB_SLOT = 16384;
DI void scanb_issue(LAS unsigned char* lds, const unsigned char* r1b, const unsigned char* r2b, int cidx, int lw, int lane) {
    const unsigned char* rec1 = r1b + (size_t)cidx * U1_BYTES; const unsigned char* rec2 = r2b + (size_t)cidx * U2_BYTES;
    LAS unsigned char* slot = lds + (cidx % SB_D) * SB_SLOT;
#pragma unroll
    for (int i = 0; i < 2; ++i) { const int ci = 2 * lw + i;
        const int row = 8 * ci + (lane >> 3), sl = lane & 7;
        __builtin_amdgcn_global_load_lds((const unsigned*)(rec1 + U_PMP + row * 128 + ((sl ^ (row & 7)) << 4)), (LAS unsigned*)(slot + ci * 1024), 16, 0, 0); }
#pragma unroll
    for (int i = 0; i < 2; ++i) { const int ci = 2 * lw + i;
        const int v = 8 * ci + (lane >> 3), sl = lane & 7;
        __builtin_amdgcn_global_load_lds((const unsigned*)(rec2 + U_QMT + v * 128 + ((sl ^ (v & 7)) << 4)), (LAS unsigned*)(slot + 8192 + ci * 1024), 16, 0, 0); }
}
constexpr int CW_SFLG = 12288;
DI void phase_scan_b(Frame& F, int l) {
    const int lane = F.lane, r16 = lane & 15, g = lane >> 4, w = F.wave, v = 16 * (w & 3) + r16;
    for (int bh = F.bid; bh < NB * NH; bh += F.G) {
        const unsigned char* r1 = F.wsp() + WS_SC1 + (size_t)bh * 128 * U1_BYTES; const unsigned char* r2 = F.wsp() + WS_SC2 + (size_t)bh * 128 * U2_BYTES;
        bf16_t* sct = (bf16_t*)(F.wsp() + WS_SCT) + (size_t)bh * 128 * 4096;
        const __amdgpu_buffer_rsrc_t srs = __builtin_amdgcn_make_buffer_rsrc((void*)sct, 0, 128 * 8192, 0x00020000);
        GAS unsigned* flg = (GAS unsigned*)(F.ws_g + WS_CTL) + CW_SFLG + 64 * (l * 32 + bh);
        f32x4 sT[4];
        float zf = 0.f; asm volatile("" : "+v"(zf));
#pragma unroll
        for (int i = 0; i < 4; ++i) sT[i] = (f32x4){zf, zf, zf, zf};
        __syncthreads();
        if (w >= 4) {
#pragma unroll
            for (int d = 0; d < SB_D; ++d) scanb_issue(F.lds, r1, r2, d, w - 4, lane);
        }
        for (int c = 0; c < 128; ++c) {
            if (w >= 4) asm volatile("s_waitcnt vmcnt(28)" ::: "memory");
            __builtin_amdgcn_s_barrier();
            asm volatile("" ::: "memory");
            if (w >= 4) {
                if (c >= 1) { const int cn = c - 1 + SB_D; scanb_issue(F.lds, r1, r2, cn < 128 ? cn : c, w - 4, lane); }
            } else {
                const LAS unsigned char* slot = F.lds + (c % SB_D) * SB_SLOT;
                bf16x8 pm[4][2]; f32x4 q[4];
#pragma unroll
                for (int mt = 0; mt < 4; ++mt) { const int row = 16 * mt + r16;
#pragma unroll
                    for (int s2 = 0; s2 < 2; ++s2) pm[mt][s2] = *(const LAS bf16x8*)(slot + row * 128 + (((4 * s2 + g) ^ (row & 7)) << 4));
                    { const u32x2 qw = *(const LAS u32x2*)(slot + 8192 + v * 128 + (((2 * mt + (g >> 1)) ^ (v & 7)) << 4) + (g & 1) * 8); q[mt] = (f32x4){bflo(qw.x), bfhi(qw.x), bflo(qw.y), bfhi(qw.y)}; } }
                bf16x8 hi[2], lo[2];
#pragma unroll
                for (int s2 = 0; s2 < 2; ++s2) { u32x4 hw, lw;
#pragma unroll
                    for (int qq = 0; qq < 2; ++qq) { const f32x4 x = sT[2 * s2 + qq]; const unsigned h0 = pk2(x[0], x[1]), h1 = pk2(x[2], x[3]);
                        const unsigned l0 = pk2(x[0] - bflo(h0), x[1] - bfhi(h0)), l1 = pk2(x[2] - bflo(h1), x[3] - bfhi(h1));
                        if (qq == 0) { hw.x = h0; hw.y = h1; lw.x = l0; lw.y = l1; } else { hw.z = h0; hw.w = h1; lw.z = l0; lw.w = l1; } }
                    hi[s2] = __builtin_bit_cast(bf16x8, hw); lo[s2] = __builtin_bit_cast(bf16x8, lw);
                    __builtin_amdgcn_raw_buffer_store_b128(hw, srs, (int)(((unsigned)c * 4096u + (unsigned)v * 64u + 32u * s2 + 8u * g) * 2u), 0, 16); }
#pragma unroll
                for (int mt = 0; mt < 4; ++mt) { f32x4 n = q[mt];
#pragma unroll
                    for (int s2 = 0; s2 < 2; ++s2) { n = mfma16(pm[mt][s2], hi[s2], n); n = mfma16(pm[mt][s2], lo[s2], n); }
                    sT[mt] = n; }
                asm volatile("s_waitcnt lgkmcnt(0)" ::: "memory");
                if ((c & 3) == 3 && c >= 7) { asm volatile("s_waitcnt vmcnt(8)" ::: "memory");
                    if (lane == 0) __hip_atomic_fetch_add(flg, 1u, __ATOMIC_RELAXED, __HIP_MEMORY_SCOPE_AGENT); }
            }
        }
        asm volatile("s_waitcnt vmcnt(0)" ::: "memory");
        if (w < 4 && lane == 0) __hip_atomic_fetch_add(flg, 1u, __ATOMIC_RELAXED, __HIP_MEMORY_SCOPE_AGENT);
    }
}

struct ScanCIn { bf16x8 ra[2]; f32x4 yl[4]; bf16x8 sb[4][2]; };
DI void scanc_load(ScanCIn& o, const unsigned char* ws, GAS unsigned* flags, int item, int r16, int g) {
    asm volatile("" : "+s"(item));
    const int u = item >> 2, it = item & 3; const int bh = u & 31, c = u >> 5; const size_t ui = (size_t)(bh * 128 + c);
    {
      GAS unsigned* fw = flags + 64 * bh; const unsigned need = 4u * ((unsigned)(c >> 2) + 1u); unsigned spins = 0;
      while ((unsigned)__builtin_amdgcn_readfirstlane((int)__hip_atomic_load(fw, __ATOMIC_RELAXED, __HIP_MEMORY_SCOPE_AGENT)) < need) { __builtin_amdgcn_s_sleep(2); if (++spins > (1u << 20)) break; }
      asm volatile("" ::: "memory"); }
    const unsigned char* rec1 = ws + WS_SC1 + ui * U1_BYTES; const unsigned char* rec2 = ws + WS_SC2 + ui * U2_BYTES;
    const __amdgpu_buffer_rsrc_t srs = __builtin_amdgcn_make_buffer_rsrc((void*)(ws + WS_SCT + ui * 8192), 0, 8192, 0x00020000);
#pragma unroll
    for (int s = 0; s < 2; ++s) o.ra[s] = *(const bf16x8*)(rec1 + U_RPP + (size_t)((16 * it + r16) * 64 + 32 * s + 8 * g) * 2);
#pragma unroll
    for (int vt = 0; vt < 4; ++vt) { { const u32x2 yw = *(const u32x2*)(rec2 + U_YLT + (size_t)((16 * it + r16) * 64 + 32 * (vt >> 1) + 8 * g + 4 * (vt & 1)) * 2); o.yl[vt] = (f32x4){bflo(yw.x), bfhi(yw.x), bflo(yw.y), bfhi(yw.y)}; }
        const int vrow = 32 * (vt >> 1) + 8 * (r16 >> 2) + 4 * (vt & 1) + (r16 & 3);
#pragma unroll
        for (int s = 0; s < 2; ++s) o.sb[vt][s] = __builtin_bit_cast(bf16x8, __builtin_amdgcn_raw_buffer_load_b128(srs, (int)((vrow * 64 + 32 * s + 8 * g) * 2), 0, 16)); }
}
DI void scanc_item(const ScanCIn& o, Frame& F, int l, int item, int r16, int g) {
    const bf16_t* SIr = (const bf16_t*)(F.wsp() + WS_SIR); const bf16_t* SIk = (const bf16_t*)(F.wsp() + WS_SIK);
    const bf16_t* V = (const bf16_t*)(F.wsp() + (l > 0 ? WS_V1 : WS_VF)); const bf16_t* Gb = (const bf16_t*)(F.wsp() + WS_G); bf16_t* YR = (bf16_t*)(F.wsp() + WS_YRM);
    const int u = item >> 2, it = item & 3; const int bh = u & 31, c = u >> 5, b = bh >> 3, h = bh & 7;
    const size_t tok = (size_t)b * SEQ + c * 64 + 16 * it + r16; const size_t o0 = tok * CW + h * 64 + 8 * g, oy = tok * YRM_LD + h * 64 + 8 * g;
    u32x4 pr[2], pk[2], pv[2], pg[2];
#pragma unroll
    for (int p = 0; p < 2; ++p) { pr[p] = *(const u32x4*)(SIr + o0 + 32 * p); pk[p] = *(const u32x4*)(SIk + o0 + 32 * p); pv[p] = *(const u32x4*)(V + o0 + 32 * p); pg[p] = *(const u32x4*)(Gb + o0 + 32 * p); }
    f32x4 y[4];
#pragma unroll
    for (int vt = 0; vt < 4; ++vt) { y[vt] = o.yl[vt];
#pragma unroll
        for (int s = 0; s < 2; ++s) y[vt] = mfma16(o.sb[vt][s], o.ra[s], y[vt]); }
    float s1 = 0.f;
#pragma unroll
    for (int vt = 0; vt < 4; ++vt) s1 += (y[vt][0] + y[vt][1]) + (y[vt][2] + y[vt][3]);
    s1 += __shfl_xor(s1, 16); s1 += __shfl_xor(s1, 32);
    const float mean = s1 * (1.f / 64.f); float s2 = 0.f;
#pragma unroll
    for (int vt = 0; vt < 4; ++vt) { y[vt] = y[vt] - mean; s2 += (y[vt][0] * y[vt][0] + y[vt][1] * y[vt][1]) + (y[vt][2] * y[vt][2] + y[vt][3] * y[vt][3]); }
    s2 += __shfl_xor(s2, 16); s2 += __shfl_xor(s2, 32);
    const float rstd = __builtin_amdgcn_rsqf(s2 * (1.f / 64.f) + 64e-5f);
    const float* lng = F.inp(17) + l * CW + h * 64 + 8 * g; const float* lnb = F.inp(18) + l * CW + h * 64 + 8 * g; const float* rkp = F.inp(16) + l * CW + h * 64 + 8 * g;
    float s3 = 0.f;
#pragma unroll
    for (int p = 0; p < 2; ++p) { const f32x4 rk0 = *(const f32x4*)(rkp + 32 * p), rk1 = *(const f32x4*)(rkp + 32 * p + 4);
        s3 += bflo(pr[p].x) * bflo(pk[p].x) * rk0[0] + bfhi(pr[p].x) * bfhi(pk[p].x) * rk0[1] + bflo(pr[p].y) * bflo(pk[p].y) * rk0[2] + bfhi(pr[p].y) * bfhi(pk[p].y) * rk0[3]
            + bflo(pr[p].z) * bflo(pk[p].z) * rk1[0] + bfhi(pr[p].z) * bfhi(pk[p].z) * rk1[1] + bflo(pr[p].w) * bflo(pk[p].w) * rk1[2] + bfhi(pr[p].w) * bfhi(pk[p].w) * rk1[3]; }
    s3 += __shfl_xor(s3, 16); s3 += __shfl_xor(s3, 32);
#pragma unroll
    for (int p = 0; p < 2; ++p) { const f32x4 lg0 = *(const f32x4*)(lng + 32 * p), lg1 = *(const f32x4*)(lng + 32 * p + 4), lb0 = *(const f32x4*)(lnb + 32 * p), lb1 = *(const f32x4*)(lnb + 32 * p + 4);
        const f32x4 ya = y[2 * p], yb = y[2 * p + 1];
        const float o_0 = (ya[0] * rstd * lg0[0] + lb0[0] + s3 * bflo(pv[p].x)) * bflo(pg[p].x), o_1 = (ya[1] * rstd * lg0[1] + lb0[1] + s3 * bfhi(pv[p].x)) * bfhi(pg[p].x);
        const float o_2 = (ya[2] * rstd * lg0[2] + lb0[2] + s3 * bflo(pv[p].y)) * bflo(pg[p].y), o_3 = (ya[3] * rstd * lg0[3] + lb0[3] + s3 * bfhi(pv[p].y)) * bfhi(pg[p].y);
        const float o_4 = (yb[0] * rstd * lg1[0] + lb1[0] + s3 * bflo(pv[p].z)) * bflo(pg[p].z), o_5 = (yb[1] * rstd * lg1[1] + lb1[1] + s3 * bfhi(pv[p].z)) * bfhi(pg[p].z);
        const float o_6 = (yb[2] * rstd * lg1[2] + lb1[2] + s3 * bflo(pv[p].w)) * bflo(pg[p].w), o_7 = (yb[3] * rstd * lg1[3] + lb1[3] + s3 * bfhi(pv[p].w)) * bfhi(pg[p].w);
        u32x4 w; w.x = pk2(o_0, o_1); w.y = pk2(o_2, o_3); w.z = pk2(o_4, o_5); w.w = pk2(o_6, o_7); *(u32x4*)(YR + oy + 32 * p) = w; }
}
DI void phase_scan_c(Frame& F, int l, int nskip) {
    const int lane = F.lane, r16 = lane & 15, g = lane >> 4;
    const int first = (F.bid - nskip) * 8 + F.wave, stride = (F.G - nskip) * 8;
    if (first >= NUNIT * 4) return;
    GAS unsigned* flags = (GAS unsigned*)(F.ws_g + WS_CTL) + CW_SFLG + 64 * (l * 32);
    ScanCIn o0, o1;
    scanc_load(o0, F.wsp(), flags, first, r16, g);
    for (int item = first; item < NUNIT * 4; item += 2 * stride) {
        const int i1 = item + stride, i2 = item + 2 * stride;
        if (i1 < NUNIT * 4) scanc_load(o1, F.wsp(), flags, i1, r16, g);
        scanc_item(o0, F, l, item, r16, g);
        if (i1 < NUNIT * 4) { if (i2 < NUNIT * 4) scanc_load(o0, F.wsp(), flags, i2, r16, g); scanc_item(o1, F, l, i1, r16, g); }
    }
}

#ifndef FUSE_DUP
#define FUSE_DUP 0
#endif
DI void phase_prep_scana(Frame& F, int l) {
    phase_rwkv_prep2(F, l, 0, 0, 1, true);
#define RELANE() do { int l_ = F.lane; asm volatile("" : "+v"(l_)); F.lane = l_; F.tid = F.wave * 64 + l_; } while (0)
    for (int tile = F.bid; tile < T / 64; tile += F.G) {
        for (int fd_ = 0; fd_ < ((FUSE_DUP & 1) ? 2 : 1); ++fd_) {
        RELANE();
        phase_rwkv_prep2(F, l, tile, tile + 1, 1, false);
        }
        asm volatile("s_waitcnt vmcnt(0)" ::: "memory");
        __syncthreads();
        __builtin_amdgcn_fence(__ATOMIC_ACQUIRE, "agent");
        asm volatile("s_waitcnt vmcnt(0)" ::: "memory");
        const int b = tile >> 7, c = tile & 127; const int u0 = c * 32 + b * 8;
        for (int fd_ = 0; fd_ < ((FUSE_DUP & 2) ? 2 : 1); ++fd_) {
        RELANE();
        phase_scan_a(F, l, u0, u0 + 8, 1);
        }
    }
#undef RELANE
}
DI void phase_moba_prep(Frame& F, int l) {
    bf16_t* MO = (bf16_t*)(F.wsp() + WS_MO); float* KM = (float*)(F.wsp() + WS_TAB + TB_KMEAN);
    int c = F.tid; const float qg = F.inp(23)[l * 64 + (c & 63)] * 0.125f, kg = F.inp(24)[l * 64 + (c & 63)];
    for (int hs = F.bid; hs < T / 128; hs += F.G) {
        float ksum = 0.f;
        for (int tb = 0; tb < 128; tb += 8) {
            int tbase = hs * 128 + tb; asm volatile("" : "+s"(tbase), "+v"(c));
            float q[8], k[8];
#pragma unroll
            for (int e = 0; e < 8; ++e) { const size_t ro = (size_t)(tbase + e) * 1536; q[e] = bf2f(MO[ro + c]); k[e] = bf2f(MO[ro + 512 + c]); }
#pragma unroll
            for (int e = 0; e < 8; ++e) { const size_t ro = (size_t)(tbase + e) * 1536;
                const float qs = wave_sum(q[e] * q[e]) * (1.f / 64.f), ks = wave_sum(k[e] * k[e]) * (1.f / 64.f);
                const float qn = q[e] * (1.0f / sqrtf(qs + 1e-6f)) * qg, kn = k[e] * (1.0f / sqrtf(ks + 1e-6f)) * kg;
                MO[ro + c] = f2bf(qn); MO[ro + 512 + c] = f2bf(kn); ksum += kn; }
        }
        KM[(size_t)(hs & 1) * (TB_KMEAN2 / 4) + (size_t)(hs >> 1) * CW + c] = ksum * (1.f / 256.f);
    }
}
DI void phase_moba_gate(Frame& F) {
    LAS float* KL = (LAS float*)F.lds;
    const bf16_t* MO = (const bf16_t*)(F.wsp() + WS_MO); const float* KM = (const float*)(F.wsp() + WS_TAB + TB_KMEAN); unsigned* SEL = (unsigned*)(F.wsp() + WS_SEL);
    for (int sidx = F.bid; sidx < T / 64; sidx += F.G) {
        const int span = ((sidx / F.G) & 1) ? ((sidx & ~127) + (127 - (sidx & 127))) : sidx;
        const int t0 = span * 64, b = t0 / SEQ, blk = (t0 % SEQ) / 256;
        __syncthreads();
        { const int cc = F.tid, h = cc >> 6, d = cc & 63;
          for (int j0 = 0; j0 < blk; j0 += 8) { float v0[8], v1[8];
#pragma unroll
              for (int e = 0; e < 8; ++e) { const int j = (j0 + e < blk) ? j0 + e : blk - 1; const size_t ko = ((size_t)(b * 32 + j)) * CW + cc; v0[e] = KM[ko]; v1[e] = KM[ko + TB_KMEAN2 / 4]; }
#pragma unroll
              for (int e = 0; e < 8; ++e) if (j0 + e < blk) KL[h * 2052 + (j0 + e) * 64 + d] = v0[e] + v1[e]; } }
        __syncthreads();
        const int tok = F.tid >> 3, h = F.tid & 7; const int t = t0 + tok;
        float q[64];
        { const u32x4* qp = (const u32x4*)(MO + (size_t)t * 1536 + h * 64);
#pragma unroll
          for (int i = 0; i < 8; ++i) { const u32x4 w = qp[i]; q[8 * i] = bflo(w.x); q[8 * i + 1] = bfhi(w.x); q[8 * i + 2] = bflo(w.y); q[8 * i + 3] = bfhi(w.y); q[8 * i + 4] = bflo(w.z); q[8 * i + 5] = bfhi(w.z); q[8 * i + 6] = bflo(w.w); q[8 * i + 7] = bfhi(w.w); } }
        float v0 = -INFINITY, v1 = -INFINITY, v2 = -INFINITY; int i0 = 0, i1 = 1, i2 = 2;
        for (int j = 0; j < blk; ++j) {
            const LAS f32x4* kp = (const LAS f32x4*)(KL + h * 2052 + j * 64); float s = 0.f;
#pragma unroll
            for (int i = 0; i < 16; ++i) { const f32x4 kv = kp[i]; s += q[4 * i] * kv.x + q[4 * i + 1] * kv.y + q[4 * i + 2] * kv.z + q[4 * i + 3] * kv.w; }
            if (s > v0) { v2 = v1; i2 = i1; v1 = v0; i1 = i0; v0 = s; i0 = j; }
            else if (s > v1) { v2 = v1; i2 = i1; v1 = s; i1 = j; }
            else if (s > v2) { v2 = s; i2 = j; }
        }
        const int nv = blk < 3 ? blk : 3;
        SEL[(size_t)t * 8 + h] = (unsigned)i0 | ((unsigned)i1 << 8) | ((unsigned)i2 << 16) | ((unsigned)nv << 24);
    }
}

constexpr int KS_PITCH = 144, VT_PITCH = 520;
constexpr int NPIECE = 47;
constexpr int CW_QATT = 8192;
DI void phase_moba_attn(Frame& F, int l) {
    static constexpr unsigned PIECES[NPIECE] = {196608,1837578,590595,1574658,1115654,1640713,1968907,1443848,918789,1049857,1246983,393730,787456,721924,2034700,262401,2034179,2034957,2035214,2035471,2034692,2035728,2034944,2035985,2036242,2036499,2035461,2036756,2037013,2037270,2035969,2037527,2036230,2037784,2038041,2038298,2036743,2038555,2038812,2039069,2039326,2037512,2039583,2038018,2038281,2039050,2039563};
    LAS unsigned char* Ks = F.lds;
    LAS unsigned char* Vt = F.lds + 36864;
    LAS float* LUT = (LAS float*)(F.lds + 36864 + 33280);
    LAS unsigned* CTL = (LAS unsigned*)(F.lds + 36864 + 33280 + 528);
    LAS unsigned* LIST = CTL + 4;
    const bf16_t* MO = (const bf16_t*)(F.wsp() + WS_MO); const unsigned* SEL = (const unsigned*)(F.wsp() + WS_SEL);
    bf16_t* PO = (bf16_t*)(F.wsp() + WS_PO); f32x2* PST = (f32x2*)(F.wsp() + WS_PST);
    unsigned* qctr = (unsigned*)(F.wsp() + WS_CTL) + CW_QATT + 64 * l;
    const float* relb = F.inp(25);
    const int lane = F.lane;
    bool att_done = false, conv_done = false;
    for (int trip = 0;; ++trip) {
        if (!conv_done && (att_done || (trip % 3) == 2)) {
            __syncthreads();
            if (F.tid == 0) CTL[2] = __hip_atomic_fetch_add(qctr + 16, 1u, __ATOMIC_RELAXED, __HIP_MEMORY_SCOPE_AGENT);
            __syncthreads();
            const int cu = (int)CTL[2];
            if (cu >= CONV_UNITS) conv_done = true; else conv_experts_items(F, l, cu * CONV_GROUP, (cu + 1) * CONV_GROUP, 1);
        }
        if (att_done) { if (conv_done) break; continue; }
        __syncthreads();
        if (F.tid == 0) { CTL[0] = __hip_atomic_fetch_add(qctr, 1u, __ATOMIC_RELAXED, __HIP_MEMORY_SCOPE_AGENT); CTL[1] = 0u; }
        __syncthreads();
        const int u = (int)CTL[0];
        if (u >= NPIECE * NB * NH) { att_done = true; if (conv_done) break; continue; }
        const unsigned pc = PIECES[u >> 5]; const int bh = u & 31, b = bh >> 3, h = bh & 7;
        const int j = (int)(pc & 0xff), qlo = (int)((pc >> 8) & 0xff), qhi = (int)(pc >> 16); const int ncand = (qhi - qlo + 1) * 256;
        const size_t tokb = (size_t)b * SEQ;
        for (int id = F.tid; id < 2048; id += 512) { const int row = id >> 3, c8 = id & 7; const size_t ro = (tokb + j * 256 + row) * 1536 + h * 64 + c8 * 8;
            *(LAS u32x4*)(Ks + row * KS_PITCH + c8 * 16) = *(const u32x4*)(MO + ro + 512); }
        for (int id = F.tid; id < 1024; id += 512) { const int rp = id >> 3, c8 = id & 7; const size_t ro = (tokb + j * 256 + 2 * rp) * 1536 + h * 64 + c8 * 8 + 1024;
            const u32x4 v0 = *(const u32x4*)(MO + ro), v1 = *(const u32x4*)(MO + ro + 1536);
            const unsigned a[4] = {v0.x, v0.y, v0.z, v0.w}, bq[4] = {v1.x, v1.y, v1.z, v1.w};
            LAS unsigned char* vp = Vt + (c8 * 8) * VT_PITCH + rp * 4;
#pragma unroll
            for (int q = 0; q < 4; ++q) { *(LAS unsigned*)(vp + (2 * q) * VT_PITCH) = (a[q] & 0xffffu) | (bq[q] << 16); *(LAS unsigned*)(vp + (2 * q + 1) * VT_PITCH) = (a[q] >> 16) | (bq[q] & 0xffff0000u); } }
        if (F.tid <= 128) { const int n = F.tid; int bucket;
            if (n < 16) bucket = n; else { int lg = 16 + (int)(logf((float)n / 16.0f) / 2.0794415416798357f * 16.0f); bucket = lg < 31 ? lg : 31; }
            LUT[n] = relb[bucket * 8 + h]; }
        unsigned selw[11];
#pragma unroll
        for (int r = 0; r < 11; ++r) { const int qq = qlo * 256 + r * 512 + F.tid; selw[r] = (r * 512 + F.tid < ncand) ? SEL[(tokb + qq) * 8 + h] : 0u; }
#pragma unroll
        for (int r = 0; r < 11; ++r) { const int base = r * 512; if (base >= ncand) break;
            const int q = qlo * 256 + base + F.tid; const int qb = q >> 8; bool mem = false; unsigned ent = 0;
            if (base + F.tid >= ncand) { }
            else if (qb == j) { mem = true; ent = (unsigned)q | (3u << 16); }
            else { const unsigned s = selw[r]; const unsigned nv = s >> 24;
                if (nv > 0 && (s & 0xff) == (unsigned)j) { mem = true; ent = (unsigned)q; }
                else if (nv > 1 && ((s >> 8) & 0xff) == (unsigned)j) { mem = true; ent = (unsigned)q | (1u << 16); }
                else if (nv > 2 && ((s >> 16) & 0xff) == (unsigned)j) { mem = true; ent = (unsigned)q | (2u << 16); } }
            const unsigned long long bal = __ballot(mem); const int cnt = __popcll(bal);
            unsigned wbase = 0; if (lane == 0 && cnt > 0) wbase = __hip_atomic_fetch_add(&CTL[1], (unsigned)cnt, __ATOMIC_RELAXED, __HIP_MEMORY_SCOPE_WORKGROUP);
            wbase = (unsigned)__builtin_amdgcn_readfirstlane((int)wbase);
            if (mem) LIST[wbase + __popcll(bal & ((1ull << lane) - 1ull))] = ent;
        }
        __syncthreads();
        const int total = (int)CTL[1];
        const float bfar = LUT[128];
        const int ntile = (total + 31) >> 5;
        const int qi = lane & 31, half = lane >> 5;
        bf16x8 qfn[4]; unsigned enn = 0u;
        if (F.wave < ntile) { const int e0 = F.wave * 32 + qi; enn = LIST[e0 < total ? e0 : total - 1]; const size_t tk0 = tokb + (enn & 0xffffu);
#pragma unroll
            for (int kk = 0; kk < 4; ++kk) qfn[kk] = *(const bf16x8*)(MO + tk0 * 1536 + h * 64 + 16 * kk + 8 * half); }
        for (int tile = F.wave; tile < ntile; tile += 8) {
            const int e = tile * 32 + qi; const bool valid = e < total; const unsigned en = enn;
            const int q = (int)(en & 0xffffu), slot = (int)(en >> 16); const size_t tok = tokb + q;
            const bool need_lut = __any((q >> 8) <= j + 1);
            bf16x8 qf[4];
#pragma unroll
            for (int kk = 0; kk < 4; ++kk) qf[kk] = qfn[kk];
            if (tile + 8 < ntile) { const int e1 = (tile + 8) * 32 + qi; enn = LIST[e1 < total ? e1 : total - 1]; const size_t tk1 = tokb + (enn & 0xffffu);
#pragma unroll
                for (int kk = 0; kk < 4; ++kk) qfn[kk] = *(const bf16x8*)(MO + tk1 * 1536 + h * 64 + 16 * kk + 8 * half); }
            float mrun = -1e30f, lsum = 0.f;
            f32x16 oacc[2];
#pragma unroll
            for (int i = 0; i < 16; ++i) { oacc[0][i] = 0.f; oacc[1][i] = 0.f; }
            const int qrel = q - j * 256;
#pragma unroll 1
            for (int ck = 0; ck < 4; ++ck) {
                if (!__any(qrel >= 64 * ck)) break;
                f32x16 sacc[2];
#pragma unroll
                for (int k2 = 0; k2 < 2; ++k2) { const int kt = 2 * ck + k2;
#pragma unroll
                    for (int i = 0; i < 16; ++i) sacc[k2][i] = 0.f;
#pragma unroll
                    for (int kk = 0; kk < 4; ++kk) { const bf16x8 ka = *(const LAS bf16x8*)(Ks + (32 * kt + qi) * KS_PITCH + (16 * kk + 8 * half) * 2);
                        sacc[k2] = __builtin_amdgcn_mfma_f32_32x32x16_bf16(ka, qf[kk], sacc[k2], 0, 0, 0); } }
                float mx = -1e30f;
                if (need_lut) {
#pragma unroll
                    for (int k2 = 0; k2 < 2; ++k2)
#pragma unroll
                        for (int i = 0; i < 16; ++i) { const int key = 32 * (2 * ck + k2) + (i & 3) + 8 * (i >> 2) + 4 * half; const int n = qrel - key;
                            const float bias = LUT[n < 0 ? 0 : (n > 128 ? 128 : n)];
                            const float s = (n < 0) ? -1e30f : sacc[k2][i] + bias; sacc[k2][i] = s; mx = fmaxf(mx, s); }
                } else {
#pragma unroll
                    for (int k2 = 0; k2 < 2; ++k2)
#pragma unroll
                        for (int i = 0; i < 16; ++i) { const float s = sacc[k2][i] + bfar; sacc[k2][i] = s; mx = fmaxf(mx, s); }
                }
                mx = fmaxf(mx, __shfl_xor(mx, 32));
                const float mnew = fmaxf(mrun, mx); const float alpha = __expf(mrun - mnew); mrun = mnew;
                lsum *= alpha;
#pragma unroll
                for (int i = 0; i < 16; ++i) { oacc[0][i] *= alpha; oacc[1][i] *= alpha; }
#pragma unroll
                for (int k2 = 0; k2 < 2; ++k2) { const int kt = 2 * ck + k2;
#pragma unroll
                    for (int i = 0; i < 16; ++i) { const float p = __expf(sacc[k2][i] - mnew); sacc[k2][i] = p; lsum += p; }
#pragma unroll
                    for (int cc = 0; cc < 2; ++cc) {
                        u32x4 pw; pw.x = pk2(sacc[k2][8 * cc], sacc[k2][8 * cc + 1]); pw.y = pk2(sacc[k2][8 * cc + 2], sacc[k2][8 * cc + 3]); pw.z = pk2(sacc[k2][8 * cc + 4], sacc[k2][8 * cc + 5]); pw.w = pk2(sacc[k2][8 * cc + 6], sacc[k2][8 * cc + 7]);
                        const bf16x8 pf = __builtin_bit_cast(bf16x8, pw);
                        const int key0 = 32 * kt + 16 * cc + 4 * half;
#pragma unroll
                        for (int dt = 0; dt < 2; ++dt) { const LAS unsigned char* vb = Vt + (32 * dt + qi) * VT_PITCH + key0 * 2;
                            const u32x2 va = *(const LAS u32x2*)vb, vb2 = *(const LAS u32x2*)(vb + 16);
                            u32x4 vw; vw.x = va.x; vw.y = va.y; vw.z = vb2.x; vw.w = vb2.y;
                            oacc[dt] = __builtin_amdgcn_mfma_f32_32x32x16_bf16(__builtin_bit_cast(bf16x8, vw), pf, oacc[dt], 0, 0, 0); } } }
            }
            const float mx = mrun;
            lsum += __shfl_xor(lsum, 32);
            const float inv = 1.0f / lsum;
            if (valid) {
                bf16_t* op = PO + ((size_t)slot * T + tok) * CW + h * 64;
#pragma unroll
                for (int dt = 0; dt < 2; ++dt)
#pragma unroll
                    for (int ig = 0; ig < 4; ++ig) { u32x2 w; w.x = pk2(oacc[dt][4 * ig] * inv, oacc[dt][4 * ig + 1] * inv); w.y = pk2(oacc[dt][4 * ig + 2] * inv, oacc[dt][4 * ig + 3] * inv);
                        *(u32x2*)(op + 32 * dt + 8 * ig + 4 * half) = w; }
                if (half == 0) PST[((size_t)slot * T + tok) * 8 + h] = (f32x2){mx, lsum};
            }
        }
    }
}
DI void phase_moba_combine(Frame& F) {
    const bf16_t* PO = (const bf16_t*)(F.wsp() + WS_PO); const f32x2* PST = (const f32x2*)(F.wsp() + WS_PST); const unsigned* SEL = (const unsigned*)(F.wsp() + WS_SEL);
    bf16_t* YM = (bf16_t*)(F.wsp() + WS_YRM) + 512;
    int tid = F.tid;
    for (int tb = F.bid * 16; tb < T; tb += F.G * 16) {
        int tbase = tb; asm volatile("" : "+s"(tbase), "+v"(tid));
        const int c0 = (tid & 63) * 8, h = c0 >> 6;
        int nv[2]; f32x2 st[2][4]; u32x4 po[2][4];
#pragma unroll
        for (int e = 0; e < 2; ++e) { const int t = tbase + 8 * e + (tid >> 6); nv[e] = (int)(SEL[(size_t)t * 8 + h] >> 24);
#pragma unroll
            for (int s = 0; s < 4; ++s) { st[e][s] = PST[((size_t)s * T + t) * 8 + h]; po[e][s] = *(const u32x4*)(PO + ((size_t)s * T + t) * CW + c0); } }
#pragma unroll
        for (int e = 0; e < 2; ++e) { const int t = tbase + 8 * e + (tid >> 6); float M = -1e30f;
#pragma unroll
            for (int s = 0; s < 4; ++s) { const bool on = (s == 3) || (s < nv[e]); if (on) M = fmaxf(M, st[e][s].x); }
            float den = 0.f, num[8];
#pragma unroll
            for (int j = 0; j < 8; ++j) num[j] = 0.f;
#pragma unroll
            for (int s = 0; s < 4; ++s) { const bool on = (s == 3) || (s < nv[e]); if (on) { const float w = st[e][s].y * __expf(st[e][s].x - M); den += w;
                    num[0] += w * bflo(po[e][s].x); num[1] += w * bfhi(po[e][s].x); num[2] += w * bflo(po[e][s].y); num[3] += w * bfhi(po[e][s].y);
                    num[4] += w * bflo(po[e][s].z); num[5] += w * bfhi(po[e][s].z); num[6] += w * bflo(po[e][s].w); num[7] += w * bfhi(po[e][s].w); } }
            const float inv = __builtin_amdgcn_rcpf(den);
            u32x4 o; o.x = pk2(num[0] * inv, num[1] * inv); o.y = pk2(num[2] * inv, num[3] * inv); o.z = pk2(num[4] * inv, num[5] * inv); o.w = pk2(num[6] * inv, num[7] * inv);
            *(u32x4*)(YM + (size_t)t * YRM_LD + c0) = o; }
    }
}
DI void phase_router(Frame& F, int l) {
    LAS float* xs = (LAS float*)F.lds;
    LAS float* wsm = xs + 64 * 129;
    LAS float* lgt = wsm + 128 * 36;
    LAS float* ssq = lgt + 64 * 37;
    LAS int* hist = (LAS int*)(ssq + 64);
    const float* x = F.outp(); const float* gain = F.inp(2) + (size_t)l * DM;
    const float* wgrp = F.inp(29) + (size_t)l * DM * 4; const float* wexp = F.inp(31) + (size_t)l * DM * 32;
    const float* bgrp = F.inp(30) + l * 4; const float* bexp = F.inp(32) + l * 32;
    int* EID = (int*)(F.wsp() + WS_RT + RT_EID); float* GATE = (float*)(F.wsp() + WS_RT + RT_GATE); int* HIST = (int*)(F.wsp() + WS_RT + RT_HIST);
    const int tok = F.tid & 63, jg = F.tid >> 6;
    for (int tile = F.bid; tile < T / 64; tile += F.G) {
        const int t0 = tile * 64;
        float acc[5] = {0.f, 0.f, 0.f, 0.f, 0.f}; float ss = 0.f;
        if (F.tid < 32) hist[F.tid] = 0;
        for (int kc = 0; kc < DM; kc += 128) {
            __syncthreads();
            for (int idx = F.tid; idx < 64 * 128; idx += 512) { const int r = idx >> 7, k = idx & 127; xs[r * 129 + k] = x[(size_t)(t0 + r) * DM + kc + k]; }
            for (int idx = F.tid; idx < 128 * 36; idx += 512) { const int k = idx / 36, j = idx - k * 36; const float g = gain[kc + k];
                wsm[idx] = g * (j < 4 ? wgrp[(size_t)(kc + k) * 4 + j] : wexp[(size_t)(kc + k) * 32 + (j - 4)]); }
            __syncthreads();
            for (int k = 0; k < 128; ++k) { const float xv = xs[tok * 129 + k]; ss += xv * xv;
#pragma unroll
                for (int i = 0; i < 5; ++i) { const int j = jg + 8 * i; if (j < 36) acc[i] += xv * wsm[k * 36 + j]; } }
        }
#pragma unroll
        for (int i = 0; i < 5; ++i) { const int j = jg + 8 * i; if (j < 36) lgt[tok * 37 + j] = acc[i]; }
        if (jg == 0) ssq[tok] = ss;
        __syncthreads();
        if (F.tid < 64) {
            const int t = t0 + F.tid; const float rs = 1.0f / sqrtf(ssq[F.tid] * (1.f / DM) + 1e-6f);
            float lg[4]; int gs = 0; float gm = -INFINITY;
#pragma unroll
            for (int g = 0; g < 4; ++g) { lg[g] = lgt[F.tid * 37 + g] * rs + bgrp[g]; if (lg[g] > gm) { gm = lg[g]; gs = g; } }
            float gden = 0.f;
#pragma unroll
            for (int g = 0; g < 4; ++g) gden += expf(lg[g] - gm);
            const float ptop = 1.0f / gden;
            float le[8]; float e0 = -INFINITY, e1 = -INFINITY; int j0 = 0, j1 = 1;
#pragma unroll
            for (int e = 0; e < 8; ++e) { le[e] = lgt[F.tid * 37 + 4 + gs * 8 + e] * rs + bexp[gs * 8 + e];
                if (le[e] > e0) { e1 = e0; j1 = j0; e0 = le[e]; j0 = e; } else if (le[e] > e1) { e1 = le[e]; j1 = e; } }
            const float p1 = expf(e1 - e0);
            const float g0 = ptop / (1.f + p1), g1 = ptop * p1 / (1.f + p1);
            const int ex0 = gs * 8 + j0, ex1 = gs * 8 + j1;
            EID[t * 2] = ex0; EID[t * 2 + 1] = ex1; GATE[t * 2] = g0; GATE[t * 2 + 1] = g1;
            __hip_atomic_fetch_add(&hist[ex0], 1, __ATOMIC_RELAXED, __HIP_MEMORY_SCOPE_WORKGROUP); __hip_atomic_fetch_add(&hist[ex1], 1, __ATOMIC_RELAXED, __HIP_MEMORY_SCOPE_WORKGROUP);
        }
        __syncthreads();
        if (F.tid < 32) HIST[tile * 32 + F.tid] = hist[F.tid];
        __syncthreads();
    }
}
DI void phase_moe_gather(Frame& F, int l) {
    LAS int* tot = (LAS int*)F.lds; LAS int* off = tot + 32; LAS int* base = off + 32; LAS int* eidl = base + 32; LAS int* rowl = eidl + 128; LAS int* ps = rowl + 128; LAS int* po = ps + 512;
    const int* EID = (const int*)(F.wsp() + WS_RT + RT_EID); const float* GATE = (const float*)(F.wsp() + WS_RT + RT_GATE); const int* HIST = (const int*)(F.wsp() + WS_RT + RT_HIST);
    int* ROW = (int*)(F.wsp() + WS_RT + RT_ROW); float* GW = (float*)(F.wsp() + WS_RT + RT_GW); int* PEXP = (int*)(F.wsp() + WS_RT + RT_PEXP);
    int* TOK = (int*)(F.wsp() + WS_RT + RT_TOK); const float* RSQ = (const float*)(F.wsp() + WS_RT + RT_RSQ); float* RSR = (float*)(F.wsp() + WS_RT + RT_RSR);
    for (int tile = F.bid; tile < T / 64; tile += F.G) {
        const int t0 = tile * 64;
        __syncthreads();
        { const int e = F.tid & 31, part = F.tid >> 5; int s = 0, o = 0;
#pragma unroll 8
          for (int i = part * 32; i < part * 32 + 32; ++i) { const int v = HIST[i * 32 + e]; s += v; if (i < tile) o += v; }
          ps[F.tid] = s; po[F.tid] = o; }
        if (F.tid < 128) eidl[F.tid] = EID[t0 * 2 + F.tid];
        __syncthreads();
        if (F.tid < 32) { int s = 0, o = 0;
#pragma unroll
            for (int p = 0; p < 16; ++p) { s += ps[p * 32 + F.tid]; o += po[p * 32 + F.tid]; } tot[F.tid] = s; off[F.tid] = o; }
        __syncthreads();
        if (F.tid == 0) {
            int bs = 0; for (int e = 0; e < 32; ++e) { base[e] = bs; bs += (tot[e] + 255) & ~255; }
            if (tile == 0) { int p = 0; for (int e = 0; e < 32; ++e) { const int np = (tot[e] + 255) >> 8; for (int i = 0; i < np; ++i) PEXP[p++] = e; } PEXP[MOE_PANELS] = p; }
        }
        __syncthreads();
        if (F.tid < 128) { const int my = eidl[F.tid]; int rank = 0; for (int i = 0; i < F.tid; ++i) rank += (eidl[i] == my) ? 1 : 0;
            const int r = base[my] + off[my] + rank; rowl[F.tid] = r; ROW[t0 * 2 + F.tid] = r; GW[r] = GATE[t0 * 2 + F.tid]; TOK[r] = t0 + (F.tid >> 1); RSR[r] = RSQ[t0 + (F.tid >> 1)]; }
    }
}
DI void phase_moe_combine(Frame& F, int l) {
    const bf16_t* YE = (const bf16_t*)(F.wsp() + WS_YE); const int* ROW = (const int*)(F.wsp() + WS_RT + RT_ROW); bf16_t* XN = (bf16_t*)(F.wsp() + WS_XN);
    const float* gain = F.inp(1) + (size_t)(l + 1 < NLAYER ? l + 1 : l) * DM;
    const int gw = F.bid * 8 + F.wave, NGW = F.G * 8; int lane = F.lane;
    for (int tb = gw * 4; tb < T; tb += NGW * 4) {
        int tbase = tb; asm volatile("" : "+s"(tbase), "+v"(lane));
        int r0[4], r1[4];
#pragma unroll
        for (int e = 0; e < 4; ++e) { r0[e] = ROW[(tbase + e) * 2]; r1[e] = ROW[(tbase + e) * 2 + 1]; }
        u32x2 ya[4][4], yb[4][4]; f32x4 xv[4][4];
#pragma unroll
        for (int e = 0; e < 4; ++e) { const u32x2* y0 = (const u32x2*)(YE + (size_t)r0[e] * DM) + lane; const u32x2* y1 = (const u32x2*)(YE + (size_t)r1[e] * DM) + lane; const f32x4* xr = (const f32x4*)(F.outp() + (size_t)(tbase + e) * DM) + lane;
#pragma unroll
            for (int j = 0; j < 4; ++j) { ya[e][j] = y0[64 * j]; yb[e][j] = y1[64 * j]; xv[e][j] = xr[64 * j]; } }
#pragma unroll
        for (int e = 0; e < 4; ++e) { const int t = tbase + e; f32x4* xr = (f32x4*)(F.outp() + (size_t)t * DM) + lane; float s = 0.f;
#pragma unroll
            for (int j = 0; j < 4; ++j) { f32x4 v = xv[e][j]; const u32x2 a = ya[e][j], b = yb[e][j];
                v.x += bflo(a.x) + bflo(b.x); v.y += bfhi(a.x) + bfhi(b.x); v.z += bflo(a.y) + bflo(b.y); v.w += bfhi(a.y) + bfhi(b.y);
                xv[e][j] = v; xr[64 * j] = v; s += (v.x * v.x + v.y * v.y) + (v.z * v.z + v.w * v.w); }
            if (l + 1 < NLAYER) {
                const float rs = __builtin_amdgcn_rsqf(wave_sum(s) * (1.f / DM) + 1e-6f);
#pragma unroll
                for (int j = 0; j < 4; ++j) { const f32x4 g = ((const f32x4*)gain)[lane + 64 * j]; const f32x4 y = xv[e][j] * rs * g; u32x2 w; w.x = pk2(y.x, y.y); w.y = pk2(y.z, y.w); *((u32x2*)(XN + (size_t)t * DM) + lane + 64 * j) = w; }
            } }
    }
}
constexpr size_t TB_WRH = 512 * 1024, TB_WRL = TB_WRH + 48 * 1024 * 2;
DI void phase_conv_router(Frame& F, int l) {
    bf16_t* WRH = (bf16_t*)(F.wsp() + WS_TAB + TB_WRH); bf16_t* WRL = (bf16_t*)(F.wsp() + WS_TAB + TB_WRL);
    const float* gain = F.inp(2) + (size_t)l * DM; const float* wgrp = F.inp(29) + (size_t)l * DM * 4; const float* wexp = F.inp(31) + (size_t)l * DM * 32;
    for (int idx = F.bid * 512 + F.tid; idx < 48 * DM; idx += F.G * 512) { const int n = idx >> 10, k = idx & 1023;
        float v = (n < 4) ? wgrp[k * 4 + n] : (n < 36) ? wexp[k * 32 + (n - 4)] : 0.f; v *= gain[k];
        const bf16_t h = f2bf(v); WRH[idx] = h; WRL[idx] = f2bf(v - bf2f(h)); }
}
DI void phase_router2(Frame& F, int l) {
    LAS float* lgt = (LAS float*)F.lds + F.wave * 1024;
    LAS int* hist = (LAS int*)(F.lds + 8 * 4096);
    const float* x = F.outp(); const bf16_t* WRH = (const bf16_t*)(F.wsp() + WS_TAB + TB_WRH); const bf16_t* WRL = (const bf16_t*)(F.wsp() + WS_TAB + TB_WRL);
    const float* bgrp = F.inp(30) + l * 4; const float* bexp = F.inp(32) + l * 32;
    int* EID = (int*)(F.wsp() + WS_RT + RT_EID); float* GATE = (float*)(F.wsp() + WS_RT + RT_GATE); int* HIST = (int*)(F.wsp() + WS_RT + RT_HIST);
    const int lane = F.lane, r16 = lane & 15, g = lane >> 4;
    bf16_t* XN2 = (bf16_t*)(F.wsp() + WS_AM); const float* gain = F.inp(2) + (size_t)l * DM; float* RSQ = (float*)(F.wsp() + WS_RT + RT_RSQ);
    { int* TOK = (int*)(F.wsp() + WS_RT + RT_TOK); for (int i = F.bid * 512 + F.tid; i < MOE_ROWS; i += F.G * 512) TOK[i] = 0; }
    for (int task = F.bid; task < T / 128; task += F.G) {
        const int t0 = task * 128 + F.wave * 16;
        __syncthreads();
        if (F.tid < 64) hist[F.tid] = 0;
        __syncthreads();
        f32x4 acc[3];
#pragma unroll
        for (int nt = 0; nt < 3; ++nt) acc[nt] = (f32x4){0.f, 0.f, 0.f, 0.f};
        float ss = 0.f;
        const float* xr = x + (size_t)(t0 + r16) * DM + 8 * g; bf16_t* xo = XN2 + (size_t)(t0 + r16) * DM + 8 * g; const float* gp = gain + 8 * g;
#pragma unroll 2
        for (int s = 0; s < 32; ++s) {
            const f32x4 x0 = *(const f32x4*)(xr + 32 * s), x1 = *(const f32x4*)(xr + 32 * s + 4);
            ss += (x0.x * x0.x + x0.y * x0.y) + (x0.z * x0.z + x0.w * x0.w) + (x1.x * x1.x + x1.y * x1.y) + (x1.z * x1.z + x1.w * x1.w);
            { const f32x4 g0 = *(const f32x4*)(gp + 32 * s), g1 = *(const f32x4*)(gp + 32 * s + 4);
              u32x4 w; w.x = pk2(x0.x * g0.x, x0.y * g0.y); w.y = pk2(x0.z * g0.z, x0.w * g0.w); w.z = pk2(x1.x * g1.x, x1.y * g1.y); w.w = pk2(x1.z * g1.z, x1.w * g1.w);
              *(u32x4*)(xo + 32 * s) = w; }
            u32x4 hw, lw; hw.x = pk2(x0.x, x0.y); hw.y = pk2(x0.z, x0.w); hw.z = pk2(x1.x, x1.y); hw.w = pk2(x1.z, x1.w);
            lw.x = pk2(x0.x - bflo(hw.x), x0.y - bfhi(hw.x)); lw.y = pk2(x0.z - bflo(hw.y), x0.w - bfhi(hw.y)); lw.z = pk2(x1.x - bflo(hw.z), x1.y - bfhi(hw.z)); lw.w = pk2(x1.z - bflo(hw.w), x1.w - bfhi(hw.w));
            const bf16x8 ah = __builtin_bit_cast(bf16x8, hw), al = __builtin_bit_cast(bf16x8, lw);
#pragma unroll
            for (int nt = 0; nt < 3; ++nt) { const size_t wo = (size_t)(16 * nt + r16) * DM + 32 * s + 8 * g;
                const bf16x8 bh = *(const bf16x8*)(WRH + wo), bl = *(const bf16x8*)(WRL + wo);
                acc[nt] = mfma16(ah, bh, acc[nt]); acc[nt] = mfma16(ah, bl, acc[nt]); acc[nt] = mfma16(al, bh, acc[nt]); }
        }
        ss += __shfl_xor(ss, 16); ss += __shfl_xor(ss, 32);
        if (g == 0) RSQ[t0 + r16] = __builtin_amdgcn_rsqf(ss * (1.f / DM) + 1e-6f);
#pragma unroll
        for (int nt = 0; nt < 3; ++nt)
#pragma unroll
            for (int r = 0; r < 4; ++r) lgt[(4 * g + r) * 48 + 16 * nt + r16] = acc[nt][r];
        if (g == 0) lgt[768 + r16] = ss;
        LDS_WAIT(); asm volatile("" ::: "memory");
        if (lane < 16) {
            const int t = t0 + lane; const float rs = 1.0f / sqrtf(lgt[768 + lane] * (1.f / DM) + 1e-6f); const LAS float* lr = lgt + lane * 48;
            float lg[4]; int gs = 0; float gm = -INFINITY;
#pragma unroll
            for (int q = 0; q < 4; ++q) { lg[q] = lr[q] * rs + bgrp[q]; if (lg[q] > gm) { gm = lg[q]; gs = q; } }
            float gden = 0.f;
#pragma unroll
            for (int q = 0; q < 4; ++q) gden += expf(lg[q] - gm);
            const float ptop = 1.0f / gden;
            float e0 = -INFINITY, e1 = -INFINITY; int j0 = 0, j1 = 1;
#pragma unroll
            for (int e = 0; e < 8; ++e) { const float le = lr[4 + gs * 8 + e] * rs + bexp[gs * 8 + e];
                if (le > e0) { e1 = e0; j1 = j0; e0 = le; j0 = e; } else if (le > e1) { e1 = le; j1 = e; } }
            const float p1 = expf(e1 - e0);
            const float g0 = ptop / (1.f + p1), g1 = ptop * p1 / (1.f + p1);
            const int ex0 = gs * 8 + j0, ex1 = gs * 8 + j1;
            EID[t * 2] = ex0; EID[t * 2 + 1] = ex1; GATE[t * 2] = g0; GATE[t * 2 + 1] = g1;
            LAS int* hh = hist + (F.wave >> 2) * 32;
            __hip_atomic_fetch_add(&hh[ex0], 1, __ATOMIC_RELAXED, __HIP_MEMORY_SCOPE_WORKGROUP); __hip_atomic_fetch_add(&hh[ex1], 1, __ATOMIC_RELAXED, __HIP_MEMORY_SCOPE_WORKGROUP);
        }
        __syncthreads();
        if (F.tid < 64) HIST[(task * 2 + (F.tid >> 5)) * 32 + (F.tid & 31)] = hist[F.tid];
    }
}
#ifndef MK_PER_PHASE_LAUNCH
#define MK_PER_PHASE_LAUNCH 0
#endif
constexpr int PH_PER_LAYER = 19, NPHASE = PH_PER_LAYER * NLAYER;
struct Args { const float* in[36]; float* out; unsigned char* ws; int ph_lo, ph_hi; };

#ifndef SCAN_NAIVE
#define SCAN_NAIVE 0
#endif
#ifndef PHMASK
#define PHMASK 0x7ffff
#endif
#ifndef DUPMASK
#define DUPMASK 0
#endif
#define NREP(k) ((((DUPMASK) >> (k)) & 1) ? 2 : 1)
#define IN(k) (((PHMASK >> ((k) % PH_PER_LAYER)) & 1) && lo <= (k) && (k) < hi)
#define SEAM(k) do { asm volatile("" : "+s"(barp), "+s"(bar.x)); bar.bar = (unsigned*)barp; if (IN(k) && IN((k) + 1)) xcd_barrier(bar); asm volatile("" : "+s"(F.ws_g), "+s"(F.out_g), "+s"(F.ka), "+s"(F.bid), "+s"(F.G), "+s"(F.lds)); } while (0)
#define FRESH() do { asm volatile("" : "+s"(F.wave)); int l_ = (int)__builtin_amdgcn_mbcnt_hi(~0u, __builtin_amdgcn_mbcnt_lo(~0u, 0u)); asm volatile("" : "+v"(l_)); F.lane = l_; F.tid = F.wave * 64 + l_; } while (0)
__global__ void __launch_bounds__(512, 2) fwd_kernel(Args args) {
    extern __shared__ __attribute__((aligned(16))) unsigned char lds_raw[];
    Frame F;
    F.lds = (LAS unsigned char*)lds_raw;
    F.tid = threadIdx.x; F.lane = F.tid & 63; F.wave = __builtin_amdgcn_readfirstlane(F.tid >> 6);
    F.G = gridDim.x; F.bid = blockIdx.x;
    F.ka = (const __attribute__((address_space(4))) unsigned char*)__builtin_amdgcn_kernarg_segment_ptr();
    F.out_g = (GAS float*)args.out; F.ws_g = (GAS unsigned char*)args.ws;
    volatile LAS unsigned* MISC = (volatile LAS unsigned*)(F.lds + MISC_OFF);
    if (F.tid < 32) MISC[F.tid] = 0u;
    __syncthreads();
    const int lo = args.ph_lo, hi = args.ph_hi;
    GAS unsigned* barp = (GAS unsigned*)(F.ws_g + WS_CTL) + CW_BAR;
    XcdBarrier bar; bar.bar = (unsigned*)barp; bar.x = 0; bar.st = nullptr;
    if (hi - lo > 1) bar = xcd_barrier_post((unsigned*)barp, MISC + 8);

    bf16_t* const XN = (bf16_t*)(F.wsp() + WS_XN);
    bf16_t* const WCAT = (bf16_t*)(F.wsp() + WS_WM + WM_WCAT);
    for (int l = 0; l < NLAYER; ++l) {
        const int P = l * PH_PER_LAYER;
#define PHASE(k) if (IN(P + (k))) for (int rep_ = 0; rep_ < NREP(k); ++rep_)
        PHASE(0) { FRESH(); if (l == 0) { phase_conv_mixer(F, 0); phase_conv_lora2(F, 0); phase_conv_router(F, 0); phase_norm_x(F, F.inp(0), F.inp(1)); } }
        if (l == 0) SEAM(P + 0);
#if defined(XTRA_BARS)
        if (hi - lo > 1) for (int xb_ = 0; xb_ < XTRA_BARS; ++xb_) { asm volatile("" : "+s"(barp), "+s"(bar.x)); bar.bar = (unsigned*)barp; xcd_barrier(bar); }
#endif
        PHASE(1) { FRESH(); const int n1 = (l == 0) ? 2048 : 2304;
            pg8::Gemm g{XN, WCAT, T, n1, DM}; pg8::StaticOrder S; S.init(T, n1, F.G, F.bid);
            pg8::EpiStore E{(bf16_t*)(F.wsp() + WS_RW), 1536, 1536, (bf16_t*)(F.wsp() + WS_LO), LO_W, 0};
            pg8::gemm_phase<pg8::EpiStore, pg8::StaticOrder>(F.lds, g, S, E, F.tid); }
        SEAM(P + 1);
        PHASE(2) { FRESH(); phase_prep_scana(F, l); }
        SEAM(P + 2);
        PHASE(4) { FRESH(); if (F.bid < NB * NH && F.G > 2 * NB * NH) phase_scan_b(F, l); else if (F.G > 2 * NB * NH) phase_scan_c(F, l, NB * NH); else {   } }
        SEAM(P + 5);
        PHASE(6) { FRESH(); pg8::Gemm g{XN, WCAT + (size_t)2304 * DM, T, 1536, DM}; pg8::StaticOrder S; S.init(T, 1536, F.G, F.bid);
            pg8::EpiMoba E{(bf16_t*)(F.wsp() + WS_MO), F.inp(23) + l * 64, F.inp(24) + l * 64, (float*)(F.wsp() + WS_TAB + TB_KMEAN), (int)(TB_KMEAN2 / 4)};
            pg8::gemm_phase<pg8::EpiMoba, pg8::StaticOrder>(F.lds, g, S, E, F.tid); }
        SEAM(P + 6);
        PHASE(8) { FRESH(); phase_moba_gate(F); }
        SEAM(P + 8);
        PHASE(9) { FRESH(); phase_moba_attn(F, l); }
        SEAM(P + 9);
        PHASE(10) { FRESH(); phase_moba_combine(F); }
        SEAM(P + 10);
        PHASE(11) { FRESH(); pg8::Gemm g{XN, WCAT + (size_t)3840 * DM, T, 2048, DM}; pg8::StaticOrder S; S.init(T, 2048, F.G, F.bid);
            pg8::EpiStore E{(bf16_t*)(F.wsp() + WS_GA), 2048, 0, nullptr, 0, 1};
            pg8::gemm_phase<pg8::EpiStore, pg8::StaticOrder>(F.lds, g, S, E, F.tid); }
        SEAM(P + 11);
        PHASE(12) { FRESH(); pg8::Gemm g{(const bf16_t*)(F.wsp() + WS_YRM), (const bf16_t*)(F.wsp() + WS_WM + WM_BRR), T, DM, DM}; pg8::StaticOrder S; S.init(T, DM, F.G, F.bid);
            pg8::EpiBranch2 E{(bf16_t*)(F.wsp() + WS_H), (const bf16_t*)(F.wsp() + WS_GA)};
            pg8::gemm_phase<pg8::EpiBranch2, pg8::StaticOrder>(F.lds, g, S, E, F.tid); }
        SEAM(P + 12);
        PHASE(13) { FRESH(); pg8::Gemm g{(const bf16_t*)(F.wsp() + WS_H), (const bf16_t*)(F.wsp() + WS_WM + WM_OUT), T, DM, DM}; pg8::StaticOrder S; S.init(T, DM, F.G, F.bid);
            pg8::EpiResid E{l == 0 ? F.inp(0) : F.outp(), F.outp()};
            pg8::gemm_phase<pg8::EpiResid, pg8::StaticOrder>(F.lds, g, S, E, F.tid); }
        SEAM(P + 13);
        PHASE(14) { FRESH(); phase_router2(F, l); }
        SEAM(P + 14);
        PHASE(15) { FRESH(); phase_moe_gather(F, l); }
        SEAM(P + 15);
        PHASE(16) { FRESH(); const int* PEXP = (const int*)(F.wsp() + WS_RT + RT_PEXP); const int np = __builtin_amdgcn_readfirstlane(PEXP[MOE_PANELS]);
            pg8::Gemm g{(const bf16_t*)(F.wsp() + WS_AM), (const bf16_t*)(F.wsp() + WS_WE), np * 256, 1024, DM}; pg8::GatherOrder S; S.init(np * 256, 1024, F.G, F.bid); S.pexp = PEXP;
            LAS int* tokL = (LAS int*)(F.lds + RING_BYTES); S.tokL = tokL;
            { const int* TOK = (const int*)(F.wsp() + WS_RT + RT_TOK); __syncthreads();
              for (int i = 0; i < 16; ++i) { pg8::Unit uu; if (!S.next(i, uu)) break; if (F.tid < 256) tokL[i * 256 + F.tid] = TOK[uu.pm * 256 + F.tid]; }
              __syncthreads(); }
            pg8::EpiExpertUp E{(bf16_t*)(F.wsp() + WS_HM), (const float*)(F.wsp() + WS_RT + RT_GW), (const float*)(F.wsp() + WS_RT + RT_RSR)};
            pg8::gemm_phase<pg8::EpiExpertUp, pg8::GatherOrder>(F.lds, g, S, E, F.tid); }
        SEAM(P + 16);
        PHASE(17) { FRESH(); const int* PEXP = (const int*)(F.wsp() + WS_RT + RT_PEXP); const int np = __builtin_amdgcn_readfirstlane(PEXP[MOE_PANELS]);
            pg8::Gemm g{(const bf16_t*)(F.wsp() + WS_HM), (const bf16_t*)(F.wsp() + WS_WD), np * 256, 1024, DEXP}; pg8::GroupOrder S; S.init(np * 256, 1024, F.G, F.bid); S.pexp = PEXP;
            pg8::EpiStore E{(bf16_t*)(F.wsp() + WS_YE), 1024, 0, nullptr, 0, 0};
            pg8::gemm_phase<pg8::EpiStore, pg8::GroupOrder>(F.lds, g, S, E, F.tid); }
        SEAM(P + 17);
        PHASE(18) { FRESH(); phase_moe_combine(F, l); if (l + 1 < NLAYER) { phase_conv_mixer(F, l + 1); phase_conv_lora2(F, l + 1); phase_conv_router(F, l + 1); } }
        SEAM(P + 18);
#undef PHASE
    }
}

extern "C" void kernel_launch(void* const* d_in, const int* in_sizes, int n_in, void* d_out, int out_size, void* d_ws, size_t ws_size, hipStream_t stream) {
    static int grid = 0;
    if (grid == 0) {
        if (n_in != 36 || out_size != T * DM || ws_size < WS_NEED) { fprintf(stderr, "kernel_launch: unexpected problem (n_in %d, out %d, ws %zu); nothing launched\n", n_in, out_size, ws_size); grid = -1; return; }
        int dev = 0, cus = 0;
        if (hipGetDevice(&dev) != hipSuccess || hipDeviceGetAttribute(&cus, hipDeviceAttributeMultiprocessorCount, dev) != hipSuccess) { grid = -1; return; }
        if (hipFuncSetAttribute((const void*)fwd_kernel, hipFuncAttributeMaxDynamicSharedMemorySize, LDS_BYTES) != hipSuccess) { fprintf(stderr, "kernel_launch: hipFuncSetAttribute failed\n"); grid = -1; return; }
        int per_cu = 0;
        if (hipOccupancyMaxActiveBlocksPerMultiprocessor(&per_cu, (const void*)fwd_kernel, 512, LDS_BYTES) != hipSuccess || per_cu < 1) { fprintf(stderr, "kernel_launch: occupancy query says %d\n", per_cu); }
        (void)hipGetLastError();
        grid = cus;
    }
    if (grid < 0) return;
    (void)hipMemsetAsync((char*)d_ws + WS_CTL, 0, CTL_ZERO_BYTES, stream);
    Args a{};
    for (int i = 0; i < 36; ++i) a.in[i] = (const float*)d_in[i];
    a.out = (float*)d_out; a.ws = (unsigned char*)d_ws;
#if MK_PER_PHASE_LAUNCH
    for (int ph = 0; ph < NPHASE; ++ph) { if (ph == PH_PER_LAYER) continue; a.ph_lo = ph; a.ph_hi = ph + 1; hipLaunchKernelGGL(fwd_kernel, dim3(grid), dim3(512), LDS_BYTES, stream, a); }
#else
    a.ph_lo = 0; a.ph_hi = NPHASE;
    hipLaunchKernelGGL(fwd_kernel, dim3(grid), dim3(512), LDS_BYTES, stream, a);
#endif
}
```

```cpp
#include <hip/hip_runtime.h>
#include <cstdio>
#include <cstdint>
#define LAS __attribute__((address_space(3)))
#define GAS __attribute__((address_space(1)))
#define DI __device__ __forceinline__
typedef unsigned short bf16_t;
typedef short bf16x8 __attribute__((ext_vector_type(8)));
typedef short s16x4 __attribute__((ext_vector_type(4)));
typedef float f32x4 __attribute__((ext_vector_type(4)));
typedef float f32x2 __attribute__((ext_vector_type(2)));
typedef float f32x16 __attribute__((ext_vector_type(16)));
typedef unsigned u32x4 __attribute__((ext_vector_type(4)));
typedef unsigned u32x2 __attribute__((ext_vector_type(2)));
typedef __bf16 bf16v2 __attribute__((ext_vector_type(2)));

DI unsigned pk2(float lo, float hi) { f32x2 v = {lo, hi}; return __builtin_bit_cast(unsigned, __builtin_convertvector(v, bf16v2)); }
DI bf16_t f2bf(float f) { return (bf16_t)(pk2(f, 0.f) & 0xffffu); }
DI float bf2f(bf16_t b) { return __uint_as_float(((unsigned)b) << 16); }
DI float bflo(unsigned w) { return __uint_as_float(w << 16); }
DI float bfhi(unsigned w) { return __uint_as_float(w & 0xffff0000u); }
DI float rcpf_(float x) { return __builtin_amdgcn_rcpf(x); }
DI float sigmoidf_(float x) { return __builtin_amdgcn_rcpf(1.0f + __expf(-x)); }

template <int CTRL> DI float dpp_mov(float v) { return __builtin_bit_cast(float, __builtin_amdgcn_update_dpp(0, __builtin_bit_cast(int, v), CTRL, 0xf, 0xf, true)); }
DI float rdlane(float v, int l) { return __builtin_bit_cast(float, __builtin_amdgcn_readlane(__builtin_bit_cast(int, v), l)); }
DI float wave_sum(float v) {
    v += dpp_mov<0xB1>(v);
    v += dpp_mov<0x4E>(v);
    v += dpp_mov<0x141>(v);
    v += dpp_mov<0x140>(v);
    return (rdlane(v, 0) + rdlane(v, 16)) + (rdlane(v, 32) + rdlane(v, 48));
}
DI f32x4 mfma16(bf16x8 a, bf16x8 b, f32x4 c) { return __builtin_amdgcn_mfma_f32_16x16x32_bf16(a, b, c, 0, 0, 0); }
namespace pg8 {
constexpr int BM = 256, BK = 64, HALF = 128, HTB = HALF * BK * 2  , STAGE_BYTES = 8 * HTB, NXCD = 8, WGM = 8;

__host__ __device__ __forceinline__ int lds_byte(int r, int c) { const int st = (r >> 4) * 2 + (c >> 5), rr = r & 15, cc = c & 31, ob = rr * 64 + cc * 2; return st * 1024 + (ob ^ (((ob >> 9) & 1) << 5)); }
__host__ __device__ __forceinline__ void stage_rc(int b, int& R, int& C) { const int st = b / 1024, sb = b % 1024, swz = sb ^ (((sb >> 9) & 1) << 5); R = (st >> 1) * 16 + swz / 64; C = (st & 1) * 32 + (swz % 64) / 2; }
__host__ __device__ __forceinline__ int perm32(int rho) { const int n = rho >> 4, i = rho & 15; return 8 * (i >> 2) + 4 * n + (i & 3); }

struct Unit { int pm, pn, pb; };
struct Gemm { const bf16_t* A; const bf16_t* Bt; int M, N, K; };

struct StaticOrder {
    static constexpr bool GATHER = false;
    int nM, nN, nwg, G, c;
    __device__ __forceinline__ void init(int M, int N, int G_, int c_) { nM = M / BM; nN = N / BM; nwg = nM * nN; G = G_; c = c_; }
    __device__ __forceinline__ bool next(int i, Unit& u) const {
        const long L = (long)i * G + c; if (L >= nwg) return false;
        int wgid = (int)L; { const int q = nwg / NXCD, r = nwg % NXCD, xcd = wgid % NXCD, off = wgid / NXCD; wgid = (xcd < r ? xcd * (q + 1) : r * (q + 1) + (xcd - r) * q) + off; }
        const int nig = WGM * nN, gid = wgid / nig, fm = gid * WGM, gsz = (nM - fm) < WGM ? (nM - fm) : WGM;
        u.pm = fm + ((wgid % nig) % gsz); u.pn = (wgid % nig) / gsz; u.pb = u.pn; return true;
    }
};
struct GroupOrder : StaticOrder {
    const int* pexp;
    __device__ __forceinline__ bool next(int i, Unit& u) const {
        if (!StaticOrder::next(i, u)) return false;
        u.pb = __builtin_amdgcn_readfirstlane(pexp[u.pm]) * nN + u.pn; return true;
    }
};
struct GatherOrder : GroupOrder {
    static constexpr bool GATHER = true;
    const LAS int* tokL;
};

template <class Epi, class Sched, bool ALIGN_EPI = true, bool SP2 = true>
__device__ __forceinline__ void gemm_phase(LAS unsigned char* lds, const Gemm g, const Sched& S, const Epi& E, int tid_in) {
    const int tid = tid_in, wid = __builtin_amdgcn_readfirstlane(tid >> 6), lane = tid & 63, wr = wid >> 2, wc = wid & 3, fr = lane & 15, fq = lane >> 4;
    const int K = g.K, nt = K / BK;
    unsigned voffA[2], voffB[2];
#pragma unroll
    for (int i = 0; i < 2; ++i) { int R, C; stage_rc(tid * 16 + i * 8192, R, C); const int Rb = Epi::HEADS ? (64 * (R >> 5) + perm32(R & 31)) : Epi::PERM ? ((R & ~31) + perm32(R & 31)) : R;
        voffA[i] = (unsigned)(R * K + C) * 2u; voffB[i] = (unsigned)(Rb * K + C) * 2u; }
    unsigned goff[2][2] = {{0u, 0u}, {0u, 0u}}, goffN[2][2] = {{0u, 0u}, {0u, 0u}};
#define PG8_GOFF(dst, ui_) do { if constexpr (Sched::GATHER) { _Pragma("unroll") for (int h_ = 0; h_ < 2; ++h_) _Pragma("unroll") for (int i_ = 0; i_ < 2; ++i_) { int R_, C_; stage_rc(tid * 16 + i_ * 8192, R_, C_); \
        const int tk_ = S.tokL[(ui_) * 256 + 128 * h_ + R_]; dst[h_][i_] = (unsigned)(tk_ * K + C_) * 2u; } } } while (0)
#define PG8_STAGE_A(bufoff, kt, h, usenext) do { if constexpr (Sched::GATHER) { unsigned vo_[2] = { (usenext) ? goffN[h][0] : goff[h][0], (usenext) ? goffN[h][1] : goff[h][1] }; PG8_STAGE(bufoff, kt, vo_); } \
        else { PG8_STAGE(bufoff, (kt) + ((h) ? hstep : 0), voffA); } } while (0)
    const size_t kstep = (size_t)(BK * 2);
    const size_t hstep = (size_t)HALF * K * 2;
    const size_t hstepB = Epi::HEADS ? (size_t)32 * K * 2 : hstep;
    const size_t tstep = 2 * hstep;
    const unsigned ldsw = (unsigned)wid * 1024u;
    const int aoff = lds_byte(wr * 64 + fr, fq * 8), boff = lds_byte(wc * 32 + fr, fq * 8);
#define PG8_SA(b, h) (((b) * 2 + (h)) * HTB)
#define PG8_SB(b, h) ((4 + (b) * 2 + (h)) * HTB)
#define PG8_STAGE(bufoff, gbase, voff) do { _Pragma("unroll") for (int _i = 0; _i < 2; ++_i) \
        __builtin_amdgcn_global_load_lds((const unsigned*)((const char*)(gbase) + (voff)[_i]), (LAS unsigned*)(lds + (bufoff) + ldsw + _i * 8192), 16, 0, 0); } while (0)
#define PG8_LDA(dst, b, h) do { _Pragma("unroll") for (int m = 0; m < 4; ++m) _Pragma("unroll") for (int k = 0; k < 2; ++k) dst[m][k] = *(const LAS bf16x8*)(lds + PG8_SA(b, h) + aoff + m * 2048 + k * 1024); } while (0)
#define PG8_LDB(dst, b, h) do { _Pragma("unroll") for (int n = 0; n < 2; ++n) _Pragma("unroll") for (int k = 0; k < 2; ++k) dst[n][k] = *(const LAS bf16x8*)(lds + PG8_SB(b, h) + boff + n * 2048 + k * 1024); } while (0)
#define PG8_MMA(ai, bj, At, Bt) do { __builtin_amdgcn_s_setprio(1); _Pragma("unroll") for (int m = 0; m < 4; ++m) _Pragma("unroll") for (int n = 0; n < 2; ++n) _Pragma("unroll") for (int k = 0; k < 2; ++k) \
        acc[ai][bj][m][n] = __builtin_amdgcn_mfma_f32_16x16x32_bf16(Bt[n][k], At[m][k], acc[ai][bj][m][n], 0, 0, 0); __builtin_amdgcn_s_setprio(0); } while (0)
#define PG8_WAIT_V(n) asm volatile("s_waitcnt vmcnt(" #n ")" ::: "memory")
#define PG8_WAIT_L(n) asm volatile("s_waitcnt lgkmcnt(" #n ")" ::: "memory")
#define PG8_BAR __builtin_amdgcn_s_barrier()
#define PG8_SCHED __builtin_amdgcn_sched_barrier(0)
    Unit cur, nxt; int ui = 0;
    if (!S.next(0, cur)) return;
    f32x4 acc[2][2][4][2];
#pragma unroll
    for (int a = 0; a < 2; ++a)
#pragma unroll
        for (int b = 0; b < 2; ++b)
#pragma unroll
            for (int m = 0; m < 4; ++m)
#pragma unroll
                for (int n = 0; n < 2; ++n) acc[a][b][m][n] = (f32x4){0.f, 0.f, 0.f, 0.f};
    bf16x8 At[4][2], B0[2][2], B1[2][2];
    const char* cA = (const char*)g.A + (Sched::GATHER ? (size_t)0 : (size_t)cur.pm * tstep); const char* cB = (const char*)g.Bt + (size_t)cur.pb * tstep;
    PG8_GOFF(goff, 0);
    if constexpr (SP2) {
        PG8_STAGE(PG8_SB(0, 0), cB, voffB); PG8_STAGE(PG8_SB(0, 1), cB + hstepB, voffB); PG8_STAGE_A(PG8_SA(0, 0), cA, 0, false); PG8_STAGE_A(PG8_SA(0, 1), cA, 1, false);
        if (wr == 1) PG8_BAR;
        PG8_WAIT_V(2); PG8_BAR;
        PG8_STAGE(PG8_SB(1, 0), cB + kstep, voffB); PG8_STAGE_A(PG8_SA(1, 0), cA + kstep, 0, false); PG8_STAGE(PG8_SB(1, 1), cB + hstepB + kstep, voffB);
        PG8_WAIT_V(6); PG8_BAR;
    } else {
        PG8_STAGE(PG8_SB(0, 0), cB, voffB); PG8_STAGE_A(PG8_SA(0, 0), cA, 0, false); PG8_STAGE(PG8_SB(0, 1), cB + hstepB, voffB); PG8_STAGE_A(PG8_SA(0, 1), cA, 1, false);
        if (wr == 1) PG8_BAR;
        PG8_WAIT_V(4); PG8_BAR;
        PG8_STAGE(PG8_SB(1, 0), cB + kstep, voffB); PG8_STAGE_A(PG8_SA(1, 0), cA + kstep, 0, false); PG8_STAGE(PG8_SB(1, 1), cB + hstepB + kstep, voffB);
        PG8_WAIT_V(6); PG8_BAR;
    }
    for (;;) {
        const bool has_next = S.next(ui + 1, nxt);
        const char* nA = (has_next && !Sched::GATHER) ? (const char*)g.A + (size_t)nxt.pm * tstep : cA; const char* nB = has_next ? (const char*)g.Bt + (size_t)nxt.pb * tstep : cB;
        if constexpr (Sched::GATHER) { if (has_next) PG8_GOFF(goffN, ui + 1); else { goffN[0][0] = goff[0][0]; goffN[0][1] = goff[0][1]; goffN[1][0] = goff[1][0]; goffN[1][1] = goff[1][1]; } }
        for (int t = 0; t < nt; t += 2) {
            if constexpr (Epi::HAS_MID) { if (t == nt / 2) E.mid(acc, cur, wr, wc, fr, fq); }
            const bool last = (t == nt - 2);
            const char* a1 = cA + (size_t)(t + 1) * kstep;
            const char* a2 = last ? nA : cA + (size_t)(t + 2) * kstep; const char* b2 = last ? nB : cB + (size_t)(t + 2) * kstep;
            const char* a3 = a2 + kstep; const char* b3 = b2 + kstep;
            if constexpr (SP2) {
            PG8_LDB(B0, 0, 0); PG8_LDB(B1, 0, 1); PG8_SCHED; PG8_LDA(At, 0, 0); PG8_STAGE_A(PG8_SA(1, 1), a1, 1, false);
            PG8_WAIT_V(8); PG8_WAIT_L(0); PG8_BAR; PG8_MMA(0, 0, At, B0); PG8_MMA(0, 1, At, B1); PG8_BAR; PG8_SCHED;
            PG8_LDA(At, 0, 1); PG8_STAGE(PG8_SB(0, 0), b2, voffB); PG8_STAGE(PG8_SB(0, 1), b2 + hstepB, voffB); PG8_STAGE_A(PG8_SA(0, 0), a2, 0, last);
            PG8_WAIT_V(8); PG8_WAIT_L(0); PG8_BAR; PG8_MMA(1, 0, At, B0); PG8_MMA(1, 1, At, B1); PG8_BAR; PG8_SCHED;
            PG8_LDB(B0, 1, 0); PG8_LDB(B1, 1, 1); PG8_SCHED; PG8_LDA(At, 1, 0); PG8_STAGE_A(PG8_SA(0, 1), a2, 1, last);
            PG8_WAIT_V(8); PG8_WAIT_L(0); PG8_BAR; PG8_MMA(0, 0, At, B0); PG8_MMA(0, 1, At, B1); PG8_BAR; PG8_SCHED;
            PG8_LDA(At, 1, 1); PG8_STAGE(PG8_SB(1, 0), b3, voffB); PG8_STAGE(PG8_SB(1, 1), b3 + hstepB, voffB); PG8_STAGE_A(PG8_SA(1, 0), a3, 0, last);
            PG8_WAIT_V(8); PG8_WAIT_L(0); PG8_BAR; PG8_MMA(1, 0, At, B0); PG8_MMA(1, 1, At, B1); PG8_BAR; PG8_SCHED;
            } else {
            PG8_LDB(B0, 0, 0); PG8_SCHED; PG8_LDA(At, 0, 0); PG8_STAGE_A(PG8_SA(1, 1), a1, 1, false);
            PG8_WAIT_L(8); PG8_BAR; PG8_WAIT_L(0); PG8_MMA(0, 0, At, B0); PG8_BAR; PG8_SCHED;
            PG8_LDB(B1, 0, 1); PG8_STAGE(PG8_SB(0, 0), b2, voffB);
            PG8_BAR; PG8_WAIT_L(0); PG8_MMA(0, 1, At, B1); PG8_BAR;
            PG8_LDA(At, 0, 1); PG8_STAGE_A(PG8_SA(0, 0), a2, 0, last);
            PG8_BAR; PG8_WAIT_L(0); PG8_MMA(1, 0, At, B0); PG8_BAR; PG8_SCHED;
            PG8_STAGE(PG8_SB(0, 1), b2 + hstepB, voffB);
            PG8_WAIT_V(6); PG8_BAR; PG8_MMA(1, 1, At, B1); PG8_BAR;
            PG8_LDB(B0, 1, 0); PG8_SCHED; PG8_LDA(At, 1, 0); PG8_STAGE_A(PG8_SA(0, 1), a2, 1, last);
            PG8_WAIT_L(8); PG8_BAR; PG8_WAIT_L(0); PG8_MMA(0, 0, At, B0); PG8_BAR; PG8_SCHED;
            PG8_LDB(B1, 1, 1); PG8_STAGE(PG8_SB(1, 0), b3, voffB);
            PG8_BAR; PG8_WAIT_L(0); PG8_MMA(0, 1, At, B1); PG8_BAR;
            PG8_LDA(At, 1, 1); PG8_STAGE_A(PG8_SA(1, 0), a3, 0, last);
            PG8_BAR; PG8_WAIT_L(0); PG8_MMA(1, 0, At, B0); PG8_BAR; PG8_SCHED;
            PG8_STAGE(PG8_SB(1, 1), b3 + hstepB, voffB);
            PG8_WAIT_V(6); PG8_BAR; PG8_MMA(1, 1, At, B1); PG8_BAR;
            }
        }
        if constexpr (ALIGN_EPI) { if (wr == 0) PG8_BAR; }
        E(acc, cur, wr, wc, fr, fq);
        if (!has_next) break;
#pragma unroll
        for (int a = 0; a < 2; ++a)
#pragma unroll
            for (int b = 0; b < 2; ++b)
#pragma unroll
                for (int m = 0; m < 4; ++m)
#pragma unroll
                    for (int n = 0; n < 2; ++n) acc[a][b][m][n] = (f32x4){0.f, 0.f, 0.f, 0.f};
        cur = nxt; cA = nA; cB = nB; ++ui;
        if constexpr (Sched::GATHER) { goff[0][0] = goffN[0][0]; goff[0][1] = goffN[0][1]; goff[1][0] = goffN[1][0]; goff[1][1] = goffN[1][1]; }
        if constexpr (ALIGN_EPI) { if (wr == 1) PG8_BAR; }
    }
    PG8_WAIT_V(0);
    if constexpr (!ALIGN_EPI) { if (wr == 0) PG8_BAR; }
    PG8_BAR;
#undef PG8_SA
#undef PG8_GOFF
#undef PG8_STAGE_A
#undef PG8_SB
#undef PG8_STAGE
#undef PG8_LDA
#undef PG8_LDB
#undef PG8_MMA
#undef PG8_WAIT_V
#undef PG8_WAIT_L
#undef PG8_BAR
#undef PG8_SCHED
}
}
#define XB_TMO      128
#define XB_XCNT(j)  (256  + 64 * (j))
#define XB_XSUB(j)  (1280 + 64 * (j))
#define XB_XGEN(j)  (2304 + 64 * (j))
#define XB_TOP      3328
#define XB_TOPGEN   3392
#define XCD_BAR_WORDS 3456
#define XB_SPIN_CAP (1u << 18)

__device__ __forceinline__ unsigned xb_ld(unsigned* p)              { return __hip_atomic_load(p, __ATOMIC_RELAXED, __HIP_MEMORY_SCOPE_AGENT); }
__device__ __forceinline__ unsigned xb_add(unsigned* p, unsigned v) { return __hip_atomic_fetch_add(p, v, __ATOMIC_RELAXED, __HIP_MEMORY_SCOPE_AGENT); }
__device__ __forceinline__ unsigned xb_xcc_id() { return (unsigned)__builtin_amdgcn_s_getreg((3 << 11) | 20) & 0xFu; }
#define XB_SPIN(cond, bar) do { unsigned _sp = 0; while (cond) { __builtin_amdgcn_s_sleep(1); \
    if ((++_sp & 255u) == 0u) { if (xb_ld(&(bar)[XB_TMO])) break; if (_sp > XB_SPIN_CAP) { atomicAdd(&(bar)[XB_TMO], 1u); break; } } } } while (0)

struct XcdBarrier {
    unsigned* bar; unsigned x;
    volatile LAS unsigned* st;
};

__device__ __forceinline__ XcdBarrier xcd_barrier_post(unsigned* bar, volatile LAS unsigned* st) {
    XcdBarrier b; b.bar = bar; b.x = xb_xcc_id(); b.st = st;
    if (threadIdx.x == 0) (void)xb_add(&bar[XB_XCNT(b.x)], 1u);
    return b;
}
__device__ __forceinline__ void xcd_barrier_complete(unsigned* bar, unsigned x, unsigned& nloc, unsigned& nx) {
    const unsigned G = gridDim.x * gridDim.y * gridDim.z;
    unsigned sum, cnt, mine, sp = 0u;
    for (;;) {
        sum = 0u; cnt = 0u; mine = 0u;
#pragma unroll
        for (unsigned j = 0; j < 16; ++j) { const unsigned c = xb_ld(&bar[XB_XCNT(j)]); sum += c; cnt += (c > 0u) ? 1u : 0u; mine = (j == x) ? c : mine; }
        if (sum == G) break;
        __builtin_amdgcn_s_sleep(1);
        if ((++sp & 255u) == 0u) { if (xb_ld(&bar[XB_TMO])) break; if (sp > XB_SPIN_CAP) { atomicAdd(&bar[XB_TMO], 1u); break; } }
    }
    nloc = mine > 0u ? mine : 1u; nx = cnt > 0u ? cnt : 1u;
}

__device__ __forceinline__ void xcd_barrier(const XcdBarrier& b) {
    asm volatile("s_waitcnt vmcnt(0)" ::: "memory");
    __syncthreads();
    if (threadIdx.x == 0) {
        unsigned* bar = b.bar;
        __builtin_amdgcn_s_waitcnt(0);
        unsigned nloc = b.st[0], nx = b.st[1];
        if (nloc == 0u) { xcd_barrier_complete(bar, b.x, nloc, nx); b.st[0] = nloc; b.st[1] = nx; }
        const unsigned old = xb_add(&bar[XB_XSUB(b.x)], 1u);
        const unsigned gen = old / nloc;
        if (old + 1u == (gen + 1u) * nloc) {
            __builtin_amdgcn_fence(__ATOMIC_RELEASE, "agent");
            asm volatile("s_waitcnt vmcnt(0)" ::: "memory");
            const unsigned og = xb_add(&bar[XB_TOP], 1u);
            const unsigned tg = og / nx;
            if (og + 1u == (tg + 1u) * nx) xb_add(&bar[XB_TOPGEN], 1u);
            else XB_SPIN(xb_ld(&bar[XB_TOPGEN]) == tg, bar);
            __builtin_amdgcn_fence(__ATOMIC_ACQUIRE, "agent");
            xb_add(&bar[XB_XGEN(b.x)], 1u);
            asm volatile("s_waitcnt vmcnt(0)" ::: "memory");
        } else {
            XB_SPIN(xb_ld(&bar[XB_XGEN(b.x)]) == gen, bar);
            __builtin_amdgcn_fence(__ATOMIC_ACQUIRE, "agent");
            asm volatile("s_waitcnt vmcnt(0)" ::: "memory");
        }
    }
    __syncthreads();
}
constexpr int NB = 4, SEQ = 8192, DM = 1024, T = NB * SEQ;
constexpr int NH = 8, HD = 64, CW = 512;
constexpr int N_IN = 5120;
constexpr int NLAYER = 2;
constexpr int NEXP = 32, DEXP = 512;
constexpr int MOE_ROWS = 73728, MOE_PANELS = MOE_ROWS / 256;
constexpr int WCAT_ROWS = 5888;
constexpr int LO_W = 768;

constexpr size_t MiB = 1u << 20;
constexpr size_t WS_CTL = 0, CTL_ZERO_BYTES = 1 * MiB;
constexpr size_t WS_VF   = 1 * MiB;
constexpr size_t WS_TAB  = 33 * MiB;
constexpr size_t WS_WM   = 34 * MiB;
constexpr size_t WS_XN   = 50 * MiB;
constexpr size_t WS_RW   = 114 * MiB;
constexpr size_t WS_MO   = 178 * MiB;
constexpr size_t WS_LO   = 210 * MiB;
constexpr size_t WS_YRM  = 114 * MiB;
constexpr int YRM_LD = 1024;
constexpr size_t WS_SIR  = 258 * MiB;
constexpr size_t WS_SIK  = 322 * MiB;
constexpr size_t WS_SCRW = 290 * MiB, WS_SCRA = 306 * MiB, WS_SCRB = 546 * MiB;
constexpr size_t WS_V1   = 418 * MiB;
constexpr size_t WS_G    = 450 * MiB;
constexpr size_t WS_YS   = 482 * MiB;
constexpr size_t WS_PO   = 418 * MiB;
constexpr size_t WS_PST  = 274 * MiB;
constexpr size_t WS_GA   = 418 * MiB;
constexpr size_t WS_GA0  = 178 * MiB;
constexpr size_t WS_GA1  = 386 * MiB;
constexpr size_t WS_H    = 50 * MiB;
constexpr size_t WS_SC1  = 482 * MiB;
constexpr size_t WS_SC2  = 354 * MiB;
constexpr size_t WS_SCT  = 290 * MiB;
constexpr size_t WS_WE   = 290 * MiB;
constexpr size_t WS_WD   = 354 * MiB;
constexpr size_t WS_AM   = 130 * MiB;
constexpr size_t WS_HM   = 194 * MiB;
constexpr size_t WS_YE   = 386 * MiB;
constexpr size_t WS_RT   = 546 * MiB;
constexpr size_t WS_END  = 556 * MiB;
constexpr size_t TB_KMEAN = 0;
constexpr size_t TB_KMEAN2 = 256 * 1024;
constexpr size_t TB_SEL   = 256 * 1024;
constexpr size_t RT_EID  = 0;
constexpr size_t RT_GATE = 256 * 1024;
constexpr size_t RT_ROW  = 512 * 1024;
constexpr size_t RT_GW   = 768 * 1024;
constexpr size_t RT_HIST = 1280 * 1024;
constexpr size_t RT_PEXP = 1408 * 1024;
constexpr size_t RT_TOK  = 1536 * 1024;
constexpr size_t RT_RSQ  = 2048 * 1024;
constexpr size_t RT_RSR  = 2304 * 1024;
constexpr size_t WS_SEL  = 562 * MiB;
constexpr size_t WS_NEED = 564 * MiB;
constexpr int CW_BAR = 4096;

constexpr int RING_BYTES = 131072;
constexpr int LDS_BYTES = 163840;
constexpr int MISC_OFF = LDS_BYTES - 256;
struct Frame {
    LAS unsigned char* lds;
    int tid, lane, wave;
    int G, bid;
    const __attribute__((address_space(4))) unsigned char* ka;
    GAS float* out_g; GAS unsigned char* ws_g;
    DI float* outp() const { return (float*)out_g; }
    DI unsigned char* wsp() const { return (unsigned char*)ws_g; }
    DI const float* inp(int i) const { return (const float*)(*(const GAS float* const __attribute__((address_space(4)))*)(ka + 8 * i)); }
};
#define LDS_WAIT() asm volatile("s_waitcnt lgkmcnt(0)" ::: "memory")

DI void tr_item(const float* src, int ld, int k0, bf16_t* dst, int Kd, const float* sc, int mode, LAS float* scr, int lane) {
    float vv[32], sv[32];
#pragma unroll
    for (int i = 0; i < 32; ++i) { const int kk = 2 * i + (lane >> 5);
        vv[i] = src ? src[(size_t)(k0 + kk) * ld + (lane & 31)] : 0.f; sv[i] = (mode != 0) ? sc[k0 + kk] : 1.f; }
#pragma unroll
    for (int i = 0; i < 32; ++i) asm volatile("" : "+v"(vv[i]), "+v"(sv[i]));
#pragma unroll
    for (int i = 0; i < 32; ++i) { const int kk = 2 * i + (lane >> 5);
        float v = vv[i];
        if (mode == 1) v *= sv[i]; else if (mode == 2) v *= (1.f - sv[i]);
        scr[kk * 33 + (lane & 31)] = v; }
    LDS_WAIT(); asm volatile("" ::: "memory");
    const int c = lane & 7;
#pragma unroll
    for (int j = 0; j < 4; ++j) { const int n = (lane >> 3) + 8 * j; const LAS float* s = scr + (8 * c) * 33 + n;
        u32x4 o; o.x = pk2(s[0 * 33], s[1 * 33]); o.y = pk2(s[2 * 33], s[3 * 33]); o.z = pk2(s[4 * 33], s[5 * 33]); o.w = pk2(s[6 * 33], s[7 * 33]);
        *(u32x4*)(dst + (size_t)n * Kd + k0 + 8 * c) = o; }
    LDS_WAIT(); asm volatile("" ::: "memory");
}

constexpr size_t WM_WCAT = 0, WM_BRR = (size_t)WCAT_ROWS * 1024 * 2, WM_BRM = WM_BRR + 1024 * 512 * 2, WM_OUT = WM_BRM + 1024 * 512 * 2;
DI void phase_conv_mixer(Frame& F, int l) {
    LAS float* scr = (LAS float*)(F.lds + F.wave * 16384);
    const int gw = F.bid * 8 + F.wave, NGW = F.G * 8;
    bf16_t* wcat = (bf16_t*)(F.wsp() + WS_WM + WM_WCAT);
    const float* w_in = F.inp(3) + (size_t)l * DM * N_IN;
    const float* mu_x = F.inp(5) + (size_t)l * 3 * DM;
    constexpr int NBLK = WCAT_ROWS / 32;
    constexpr int I_CAT = NBLK * 16, I_BR = 8 * 32, I_OUT = 16 * 32;
    for (int it = gw; it < I_CAT + 2 * I_BR + I_OUT; it += NGW) {
        int r = it;
        if (r < I_CAT) {
            const int nb = r / 16, kb = r % 16, k0 = kb * 64;
            if (nb < 48) { tr_item(w_in + 32 * nb, N_IN, k0, wcat + (size_t)(32 * nb) * 1024, 1024, nullptr, 0, scr, F.lane); }
            else if (nb < 72) {
                const int q = nb - 48; const float* src = nullptr; int ld = 0; const float* sc = nullptr; int mode = 0;
                if (q < 4)       { src = F.inp(7)  + (size_t)l * DM * 64  + 32 * (q & 1); ld = 64;  sc = mu_x;          mode = (q < 2) ? 2 : 1; }
                else if (q < 8)  { src = F.inp(10) + (size_t)l * DM * 64  + 32 * (q & 1); ld = 64;  sc = mu_x + DM;     mode = (q < 6) ? 2 : 1; }
                else if (q < 16) { src = F.inp(12) + (size_t)l * DM * 128 + 32 * (q & 3); ld = 128; sc = mu_x + 2 * DM; mode = (q < 12) ? 2 : 1; }
                else if (q < 18 && l > 0) { src = F.inp(21) + (size_t)(l - 1) * DM * 32; ld = 32; sc = F.inp(19) + (size_t)(l - 1) * DM; mode = (q == 16) ? 2 : 1; }
                tr_item(src, ld, k0, wcat + (size_t)(1536 + 32 * q) * 1024, 1024, sc, mode, scr, F.lane);
            }
            else if (nb < 120) { tr_item(w_in + 1536 + 32 * (nb - 72), N_IN, k0, wcat + (size_t)(2304 + 32 * (nb - 72)) * 1024, 1024, nullptr, 0, scr, F.lane); }
            else { tr_item(w_in + 3072 + 32 * (nb - 120), N_IN, k0, wcat + (size_t)(3840 + 32 * (nb - 120)) * 1024, 1024, nullptr, 0, scr, F.lane); }
            continue;
        }
        r -= I_CAT;
        if (r < I_BR) { const int nb = r / 8, kb = r % 8; tr_item(F.inp(26) + (size_t)l * 512 * 1024 + 32 * nb, 1024, kb * 64, (bf16_t*)(F.wsp() + WS_WM + WM_BRR) + (size_t)(32 * nb) * 1024, 1024, nullptr, 0, scr, F.lane); continue; }
        r -= I_BR;
        if (r < I_BR) { const int nb = r / 8, kb = r % 8; tr_item(F.inp(27) + (size_t)l * 512 * 1024 + 32 * nb, 1024, kb * 64, (bf16_t*)(F.wsp() + WS_WM + WM_BRR) + (size_t)(32 * nb) * 1024 + 512, 1024, nullptr, 0, scr, F.lane); continue; }
        r -= I_BR;
        { const int nb = r / 16, kb = r % 16; tr_item(F.inp(28) + (size_t)l * 1024 * 1024 + 32 * nb, 1024, kb * 64, (bf16_t*)(F.wsp() + WS_WM + WM_OUT) + (size_t)(32 * nb) * 1024, 1024, nullptr, 0, scr, F.lane); }
    }
}
struct ConvItem { const float* src; int ld, k0, n0, Kd, mode; bf16_t* dst; };
DI ConvItem conv_item(int it, const float* wg, const float* wu, const float* wdn, bf16_t* we, bf16_t* wd) {
    ConvItem c; const int e = it / 96; int r = it % 96;
    if (r < 64) { const int up = r >> 5; r &= 31; c.src = (up ? wu : wg) + (size_t)e * DM * DEXP; c.ld = DEXP; c.k0 = (r >> 1) * 64; c.n0 = (r & 1) * 256; c.dst = we + (size_t)e * 1024 * 1024; c.Kd = 1024; c.mode = up; }
    else { r -= 64; c.src = wdn + (size_t)e * DEXP * DM; c.ld = DM; c.k0 = (r >> 2) * 64; c.n0 = (r & 3) * 256; c.dst = wd + (size_t)e * 1024 * 512; c.Kd = 512; c.mode = 2; }
    return c;
}
DI void conv_load(const ConvItem& c, f32x4 (&v)[8], int tid) {
#pragma unroll
    for (int i = 0; i < 8; ++i) { const int idx = tid + 512 * i, row = idx >> 6, c4 = idx & 63; v[i] = *(const f32x4*)(c.src + (size_t)(c.k0 + row) * c.ld + c.n0 + 4 * c4); }
}
DI void conv_store(const ConvItem& c, const f32x4 (&v)[8], LAS float* scr, int tid) {
#pragma unroll
    for (int i = 0; i < 8; ++i) { const int idx = tid + 512 * i, row = idx >> 6, c4 = idx & 63; LAS float* d = scr + row * 257 + 4 * c4; d[0] = v[i].x; d[1] = v[i].y; d[2] = v[i].z; d[3] = v[i].w; }
    __syncthreads();
#pragma unroll
    for (int i = 0; i < 4; ++i) { const int idx = tid + 512 * i, n = idx >> 3, cc = idx & 7; const LAS float* sp = scr + (8 * cc) * 257 + n;
        u32x4 o; o.x = pk2(sp[0], sp[257]); o.y = pk2(sp[2 * 257], sp[3 * 257]); o.z = pk2(sp[4 * 257], sp[5 * 257]); o.w = pk2(sp[6 * 257], sp[7 * 257]);
        const int h = c.n0 + n; const int drow = (c.mode == 2) ? h : ((h >> 7) * 256 + c.mode * 128 + (h & 127));
        *(u32x4*)(c.dst + (size_t)drow * c.Kd + c.k0 + 8 * cc) = o; }
    __syncthreads();
}
constexpr int CONV_ITEMS = NEXP * 96, CONV_GROUP = 12, CONV_UNITS = CONV_ITEMS / CONV_GROUP;
DI void conv_experts_items(Frame& F, int l, int it_lo, int it_hi, int it_step) {
    (void)it_hi; (void)it_step;
    LAS float* scr = (LAS float*)F.lds;
    bf16_t* we = (bf16_t*)(F.wsp() + WS_WE); bf16_t* wd = (bf16_t*)(F.wsp() + WS_WD);
    const float* wg = F.inp(33) + (size_t)l * NEXP * DM * DEXP; const float* wu = F.inp(34) + (size_t)l * NEXP * DM * DEXP; const float* wdn = F.inp(35) + (size_t)l * NEXP * DEXP * DM;
    __syncthreads();
    f32x4 r[3][8]; ConvItem c[3];
    c[0] = conv_item(it_lo, wg, wu, wdn, we, wd); conv_load(c[0], r[0], F.tid);
    c[1] = conv_item(it_lo + 1, wg, wu, wdn, we, wd); conv_load(c[1], r[1], F.tid);
#pragma unroll
    for (int k = 0; k < CONV_GROUP; ++k) {
        if (k + 2 < CONV_GROUP) { c[(k + 2) % 3] = conv_item(it_lo + k + 2, wg, wu, wdn, we, wd); conv_load(c[(k + 2) % 3], r[(k + 2) % 3], F.tid); }
        conv_store(c[k % 3], r[k % 3], scr, F.tid);
    }
}
DI void rms_row_to_bf16(const float* xrow, const float* gain, bf16_t* o0, bf16_t* o1, int lane) {
    const f32x4* xr = (const f32x4*)xrow + lane; const f32x4* gr = (const f32x4*)gain + lane;
    f32x4 v[4]; float s = 0.f;
#pragma unroll
    for (int j = 0; j < 4; ++j) { v[j] = xr[64 * j]; s += (v[j].x * v[j].x + v[j].y * v[j].y) + (v[j].z * v[j].z + v[j].w * v[j].w); }
    const float rs = 1.0f / sqrtf(wave_sum(s) * (1.f / DM) + 1e-6f);
#pragma unroll
    for (int j = 0; j < 4; ++j) { const f32x4 g = gr[64 * j]; const f32x4 y = v[j] * rs * g;
        u32x2 w; w.x = pk2(y.x, y.y); w.y = pk2(y.z, y.w);
        *((u32x2*)o0 + lane + 64 * j) = w; if (o1) *((u32x2*)o1 + lane + 64 * j) = w; }
}
DI void phase_norm_x(Frame& F, const float* x, const float* gain) {
    const int gw = F.bid * 8 + F.wave, NGW = F.G * 8; bf16_t* xn = (bf16_t*)(F.wsp() + WS_XN); int lane = F.lane;
    f32x4 gv[4];
#pragma unroll
    for (int j = 0; j < 4; ++j) gv[j] = ((const f32x4*)gain)[lane + 64 * j];
    for (int mb = gw * 4; mb < T; mb += NGW * 4) {
        int m0 = mb; asm volatile("" : "+s"(m0), "+v"(lane));
        f32x4 v[4][4];
#pragma unroll
        for (int e = 0; e < 4; ++e) { const f32x4* xr = (const f32x4*)(x + (size_t)(m0 + e) * DM) + lane;
#pragma unroll
            for (int j = 0; j < 4; ++j) v[e][j] = xr[64 * j]; }
#pragma unroll
        for (int e = 0; e < 4; ++e) { float s = 0.f;
#pragma unroll
            for (int j = 0; j < 4; ++j) s += (v[e][j].x * v[e][j].x + v[e][j].y * v[e][j].y) + (v[e][j].z * v[e][j].z + v[e][j].w * v[e][j].w);
            const float rs = __builtin_amdgcn_rsqf(wave_sum(s) * (1.f / DM) + 1e-6f);
#pragma unroll
            for (int j = 0; j < 4; ++j) { const f32x4 y = v[e][j] * rs * gv[j]; u32x2 w; w.x = pk2(y.x, y.y); w.y = pk2(y.z, y.w);
                *((u32x2*)(xn + (size_t)(m0 + e) * DM) + lane + 64 * j) = w; } }
    }
}

namespace pg8 {
struct EpiStore {
    static constexpr bool PERM = true, HAS_MID = false, HEADS = false;
    bf16_t* O; int ldc; int split; bf16_t* O2; int ldc2; int act;
    __device__ __forceinline__ void operator()(const f32x4 (&acc)[2][2][4][2], const Unit& u, int wr, int wc, int fr, int fq) const {
        const int row0 = u.pm * BM + wr * 64 + fr; int colt = u.pn * BM; bf16_t* base = O; int ld = ldc;
        if (split && colt >= split) { base = O2; ld = ldc2; colt -= split; }
        const int col0 = colt + wc * 32 + 8 * fq;
#pragma unroll
        for (int ai = 0; ai < 2; ++ai)
#pragma unroll
            for (int m = 0; m < 4; ++m) { bf16_t* rowp = base + (size_t)(row0 + ai * HALF + m * 16) * ld + col0;
#pragma unroll
                for (int bj = 0; bj < 2; ++bj) { f32x4 v0 = acc[ai][bj][m][0], v1 = acc[ai][bj][m][1];
                    if (act == 1) {
#pragma unroll
                        for (int j = 0; j < 4; ++j) { v0[j] = sigmoidf_(v0[j]); v1[j] = sigmoidf_(v1[j]); } }
                    u32x4 w; w.x = pk2(v0[0], v0[1]); w.y = pk2(v0[2], v0[3]); w.z = pk2(v1[0], v1[1]); w.w = pk2(v1[2], v1[3]);
                    *(u32x4*)(rowp + bj * HALF) = w; } }
    }
};
struct EpiBranch {
    static constexpr bool PERM = true, HAS_MID = false, HEADS = false;
    bf16_t* Hout; const bf16_t* gate; int gcol0; int first;
    __device__ __forceinline__ void operator()(const f32x4 (&acc)[2][2][4][2], const Unit& u, int wr, int wc, int fr, int fq) const {
        const int row0 = u.pm * BM + wr * 64 + fr; const int col0 = u.pn * BM + wc * 32 + 8 * fq;
#pragma unroll
        for (int ai = 0; ai < 2; ++ai)
#pragma unroll
            for (int m = 0; m < 4; ++m) { const size_t row = (size_t)(row0 + ai * HALF + m * 16);
#pragma unroll
                for (int bj = 0; bj < 2; ++bj) {
                    const u32x4 gv = *(const u32x4*)(gate + row * 2048 + gcol0 + col0 + bj * HALF);
                    bf16_t* hp = Hout + row * 1024 + col0 + bj * HALF;
                    f32x4 v0 = acc[ai][bj][m][0], v1 = acc[ai][bj][m][1];
                    v0[0] *= bflo(gv.x); v0[1] *= bfhi(gv.x); v0[2] *= bflo(gv.y); v0[3] *= bfhi(gv.y);
                    v1[0] *= bflo(gv.z); v1[1] *= bfhi(gv.z); v1[2] *= bflo(gv.w); v1[3] *= bfhi(gv.w);
                    if (!first) { const u32x4 hv = *(const u32x4*)hp;
                        v0[0] += bflo(hv.x); v0[1] += bfhi(hv.x); v0[2] += bflo(hv.y); v0[3] += bfhi(hv.y);
                        v1[0] += bflo(hv.z); v1[1] += bfhi(hv.z); v1[2] += bflo(hv.w); v1[3] += bfhi(hv.w); }
                    u32x4 w; w.x = pk2(v0[0], v0[1]); w.y = pk2(v0[2], v0[3]); w.z = pk2(v1[0], v1[1]); w.w = pk2(v1[2], v1[3]);
                    *(u32x4*)hp = w; } }
    }
};
struct EpiBranch2 {
    static constexpr bool PERM = true, HAS_MID = true, HEADS = false;
    bf16_t* Hout; const bf16_t* g0; const bf16_t* g1;
    __device__ __forceinline__ void mid(f32x4 (&acc)[2][2][4][2], const Unit& u, int wr, int wc, int fr_, int fq_) const {
        int fr = fr_, fq = fq_; asm volatile("" : "+v"(fr), "+v"(fq));
        const int row0 = u.pm * BM + wr * 64 + fr; const int col0 = u.pn * BM + wc * 32 + 8 * fq;
        const bf16_t* gmb = (u.pn < 2) ? g0 + 1024 : g1 - 512; const size_t gld = (u.pn < 2) ? 1536 : 512;
#pragma unroll
        for (int ai = 0; ai < 2; ++ai)
#pragma unroll
            for (int mp = 0; mp < 2; ++mp) { u32x4 grv[2][2], gmv[2][2];
#pragma unroll
              for (int mm = 0; mm < 2; ++mm)
#pragma unroll
                for (int bj = 0; bj < 2; ++bj) { const size_t row = (size_t)(row0 + ai * HALF + (2 * mp + mm) * 16);
                    grv[mm][bj] = *(const u32x4*)(g0 + row * 1536 + col0 + bj * HALF); gmv[mm][bj] = *(const u32x4*)(gmb + row * gld + col0 + bj * HALF); }
              asm volatile("" : "+v"(grv[0][0]), "+v"(grv[0][1]), "+v"(grv[1][0]), "+v"(grv[1][1]), "+v"(gmv[0][0]), "+v"(gmv[0][1]), "+v"(gmv[1][0]), "+v"(gmv[1][1]));
#pragma unroll
              for (int mm = 0; mm < 2; ++mm) { const int m = 2 * mp + mm;
#pragma unroll
                for (int bj = 0; bj < 2; ++bj) {
                    const u32x4 gr = grv[mm][bj], gm = gmv[mm][bj];
                    const unsigned grw[4] = {gr.x, gr.y, gr.z, gr.w}, gmw[4] = {gm.x, gm.y, gm.z, gm.w};
#pragma unroll
                    for (int q = 0; q < 4; ++q) { const float r0 = bflo(grw[q]) * __builtin_amdgcn_rcpf(fmaxf(bflo(gmw[q]), 1e-30f)), r1 = bfhi(grw[q]) * __builtin_amdgcn_rcpf(fmaxf(bfhi(gmw[q]), 1e-30f));
                        acc[ai][bj][m][q >> 1][2 * (q & 1)] *= r0; acc[ai][bj][m][q >> 1][2 * (q & 1) + 1] *= r1; } } }
              asm volatile("" ::: "memory"); }
    }
    __device__ __forceinline__ void operator()(const f32x4 (&acc)[2][2][4][2], const Unit& u, int wr, int wc, int fr, int fq) const {
        const int row0 = u.pm * BM + wr * 64 + fr; const int col0 = u.pn * BM + wc * 32 + 8 * fq;
        u32x4 gmv[2][4][2];
        const bf16_t* gmb = (u.pn < 2) ? g0 + 1024 : g1 - 512; const size_t gld = (u.pn < 2) ? 1536 : 512;
#pragma unroll
        for (int ai = 0; ai < 2; ++ai)
#pragma unroll
            for (int m = 0; m < 4; ++m)
#pragma unroll
                for (int bj = 0; bj < 2; ++bj) gmv[ai][m][bj] = *(const u32x4*)(gmb + (size_t)(row0 + ai * HALF + m * 16) * gld + col0 + bj * HALF);
#pragma unroll
        for (int ai = 0; ai < 2; ++ai)
#pragma unroll
            for (int m = 0; m < 4; ++m) asm volatile("" : "+v"(gmv[ai][m][0]), "+v"(gmv[ai][m][1]));
#pragma unroll
        for (int ai = 0; ai < 2; ++ai)
#pragma unroll
            for (int m = 0; m < 4; ++m) { const size_t row = (size_t)(row0 + ai * HALF + m * 16);
#pragma unroll
                for (int bj = 0; bj < 2; ++bj) {
                    const u32x4 gm = gmv[ai][m][bj];
                    f32x4 v0 = acc[ai][bj][m][0], v1 = acc[ai][bj][m][1];
                    v0[0] *= fmaxf(bflo(gm.x), 1e-30f); v0[1] *= fmaxf(bfhi(gm.x), 1e-30f); v0[2] *= fmaxf(bflo(gm.y), 1e-30f); v0[3] *= fmaxf(bfhi(gm.y), 1e-30f);
                    v1[0] *= fmaxf(bflo(gm.z), 1e-30f); v1[1] *= fmaxf(bfhi(gm.z), 1e-30f); v1[2] *= fmaxf(bflo(gm.w), 1e-30f); v1[3] *= fmaxf(bfhi(gm.w), 1e-30f);
                    u32x4 w; w.x = pk2(v0[0], v0[1]); w.y = pk2(v0[2], v0[3]); w.z = pk2(v1[0], v1[1]); w.w = pk2(v1[2], v1[3]);
                    *(u32x4*)(Hout + row * 1024 + col0 + bj * HALF) = w; } }
    }
};
struct EpiMoba {
    static constexpr bool PERM = true, HAS_MID = false, HEADS = true;
    bf16_t* MO; const float* qgain; const float* kgain; float* KM; int km_half;
    __device__ __forceinline__ void operator()(const f32x4 (&acc)[2][2][4][2], const Unit& u, int wr, int wc, int fr, int fq) const {
        const int row0 = u.pm * BM + wr * 64 + fr; const int kind = u.pn >> 1; const int colb = u.pn * BM + 64 * wc + 8 * fq;
        if (kind == 2) {
#pragma unroll
            for (int ai = 0; ai < 2; ++ai)
#pragma unroll
                for (int m = 0; m < 4; ++m) { bf16_t* rowp = MO + (size_t)(row0 + ai * HALF + m * 16) * 1536 + colb;
#pragma unroll
                    for (int bj = 0; bj < 2; ++bj) { const f32x4 v0 = acc[ai][bj][m][0], v1 = acc[ai][bj][m][1];
                        u32x4 w; w.x = pk2(v0[0], v0[1]); w.y = pk2(v0[2], v0[3]); w.z = pk2(v1[0], v1[1]); w.w = pk2(v1[2], v1[3]); *(u32x4*)(rowp + 32 * bj) = w; } }
            return;
        }
        const float* gp = (kind == 0 ? qgain : kgain) + 8 * fq; const float gs = (kind == 0) ? 0.125f : 1.0f;
        f32x4 gn[2][2];
#pragma unroll
        for (int bj = 0; bj < 2; ++bj)
#pragma unroll
            for (int n = 0; n < 2; ++n) gn[bj][n] = *(const f32x4*)(gp + 32 * bj + 4 * n) * gs;
        f32x4 cs[2][2];
#pragma unroll
        for (int bj = 0; bj < 2; ++bj)
#pragma unroll
            for (int n = 0; n < 2; ++n) cs[bj][n] = (f32x4){0.f, 0.f, 0.f, 0.f};
        float rsv[2][4];
#pragma unroll
        for (int ai = 0; ai < 2; ++ai)
#pragma unroll
            for (int m = 0; m < 4; ++m) { float ss = 0.f;
#pragma unroll
                for (int bj = 0; bj < 2; ++bj)
#pragma unroll
                    for (int n = 0; n < 2; ++n) { const f32x4 x = acc[ai][bj][m][n]; ss += (x[0] * x[0] + x[1] * x[1]) + (x[2] * x[2] + x[3] * x[3]); }
                rsv[ai][m] = ss; }
#pragma unroll
        for (int ai = 0; ai < 2; ++ai)
#pragma unroll
            for (int m = 0; m < 4; ++m) rsv[ai][m] += __shfl_xor(rsv[ai][m], 16);
#pragma unroll
        for (int ai = 0; ai < 2; ++ai)
#pragma unroll
            for (int m = 0; m < 4; ++m) { rsv[ai][m] += __shfl_xor(rsv[ai][m], 32); rsv[ai][m] = __builtin_amdgcn_rsqf(rsv[ai][m] * (1.f / 64.f) + 1e-6f); }
#pragma unroll
        for (int ai = 0; ai < 2; ++ai)
#pragma unroll
            for (int m = 0; m < 4; ++m) { const float rs = rsv[ai][m];
                bf16_t* rowp = MO + (size_t)(row0 + ai * HALF + m * 16) * 1536 + colb;
#pragma unroll
                for (int bj = 0; bj < 2; ++bj) { const f32x4 v0 = acc[ai][bj][m][0] * rs * gn[bj][0], v1 = acc[ai][bj][m][1] * rs * gn[bj][1];
                    cs[bj][0] += v0; cs[bj][1] += v1;
                    u32x4 w; w.x = pk2(v0[0], v0[1]); w.y = pk2(v0[2], v0[3]); w.z = pk2(v1[0], v1[1]); w.w = pk2(v1[2], v1[3]); *(u32x4*)(rowp + 32 * bj) = w; }
                asm volatile("" : "+v"(cs[0][0]), "+v"(cs[0][1]), "+v"(cs[1][0]), "+v"(cs[1][1]));
            }
        if (kind == 1) {
#pragma unroll
            for (int bj = 0; bj < 2; ++bj)
#pragma unroll
                for (int n = 0; n < 2; ++n) { f32x4 t = cs[bj][n];
#pragma unroll
                    for (int j = 0; j < 4; ++j) { float v = t[j]; v += dpp_mov<0xB1>(v); v += dpp_mov<0x4E>(v); v += dpp_mov<0x141>(v); v += dpp_mov<0x140>(v); t[j] = v * (1.f / 256.f); }
                    if (fr == 0) *(f32x4*)(KM + (size_t)wr * km_half + (size_t)u.pm * 512 + (u.pn * BM - 512) + 64 * wc + 32 * bj + 8 * fq + 4 * n) = t; }
        }
    }
};
struct EpiResid {
    static constexpr bool PERM = false, HAS_MID = false, HEADS = false;
    const float* xin; float* out;
    __device__ __forceinline__ void operator()(const f32x4 (&acc)[2][2][4][2], const Unit& u, int wr, int wc, int fr, int fq) const {
        const int row0 = u.pm * BM + wr * 64 + fr, col0 = u.pn * BM + wc * 32 + 4 * fq;
#pragma unroll
        for (int ai = 0; ai < 2; ++ai) { f32x4 xv[4][2][2];
#pragma unroll
            for (int m = 0; m < 4; ++m) { const size_t off = (size_t)(row0 + ai * HALF + m * 16) * 1024 + col0;
#pragma unroll
                for (int bj = 0; bj < 2; ++bj)
#pragma unroll
                    for (int n = 0; n < 2; ++n) xv[m][bj][n] = *(const f32x4*)(xin + off + bj * HALF + n * 16); }
#pragma unroll
            for (int m = 0; m < 4; ++m) asm volatile("" : "+v"(xv[m][0][0]), "+v"(xv[m][0][1]), "+v"(xv[m][1][0]), "+v"(xv[m][1][1]));
#pragma unroll
            for (int m = 0; m < 4; ++m) { const size_t off = (size_t)(row0 + ai * HALF + m * 16) * 1024 + col0;
#pragma unroll
                for (int bj = 0; bj < 2; ++bj)
#pragma unroll
                    for (int n = 0; n < 2; ++n) *(f32x4*)(out + off + bj * HALF + n * 16) = xv[m][bj][n] + acc[ai][bj][m][n]; } }
    }
};
struct EpiExpertUp {
    static constexpr bool PERM = true, HAS_MID = false, HEADS = false;
    bf16_t* HM; const float* gw; const float* rsr;
    __device__ __forceinline__ void operator()(const f32x4 (&acc)[2][2][4][2], const Unit& u, int wr, int wc, int fr, int fq) const {
        const int row0 = u.pm * BM + wr * 64 + fr; const int col0 = u.pn * 128 + wc * 32 + 8 * fq;
        float rsv[2][4], gwv[2][4];
#pragma unroll
        for (int ai = 0; ai < 2; ++ai)
#pragma unroll
            for (int m = 0; m < 4; ++m) { const size_t row = (size_t)(row0 + ai * HALF + m * 16); rsv[ai][m] = rsr[row]; gwv[ai][m] = gw[row]; }
#pragma unroll
        for (int ai = 0; ai < 2; ++ai)
#pragma unroll
            for (int m = 0; m < 4; ++m) asm volatile("" : "+v"(rsv[ai][m]), "+v"(gwv[ai][m]));
#pragma unroll
        for (int ai = 0; ai < 2; ++ai)
#pragma unroll
            for (int m = 0; m < 4; ++m) { const size_t row = (size_t)(row0 + ai * HALF + m * 16); const float rs = rsv[ai][m]; const float gwt = gwv[ai][m] * rs;
                f32x4 v0, v1;
#pragma unroll
                for (int j = 0; j < 4; ++j) { const float g0 = acc[ai][0][m][0][j] * rs, g1 = acc[ai][0][m][1][j] * rs;
                    v0[j] = g0 * sigmoidf_(g0) * acc[ai][1][m][0][j] * gwt; v1[j] = g1 * sigmoidf_(g1) * acc[ai][1][m][1][j] * gwt; }
                u32x4 w; w.x = pk2(v0[0], v0[1]); w.y = pk2(v0[2], v0[3]); w.z = pk2(v1[0], v1[1]); w.w = pk2(v1[2], v1[3]);
                *(u32x4*)(HM + row * 512 + col0) = w; }
    }
};
}
constexpr size_t SI_PLANE = (size_t)T * CW * 2;
DI float softplusf_(float z) { return fmaxf(z, 0.f) + __logf(1.0f + __expf(-fabsf(z))); }

#ifndef PREP_DUP
#define PREP_DUP 0
#endif
constexpr int ACT_P = 592;
constexpr size_t WM_L2T = (size_t)WCAT_ROWS * 1024 * 2 + 2 * 1024 * 512 * 2 + 1024 * 1024 * 2;
DI void phase_conv_lora2(Frame& F, int l) {
    bf16_t* L2T = (bf16_t*)(F.wsp() + WS_WM + WM_L2T);
    const float* w2 = F.inp(8) + (size_t)l * 64 * CW; const float* a2 = F.inp(11) + (size_t)l * 64 * CW; const float* g2 = F.inp(13) + (size_t)l * 128 * CW; const float* v2 = F.inp(22);
    for (int idx = F.bid * 512 + F.tid; idx < 288 * CW; idx += F.G * 512) { const int j = idx >> 9, c = idx & 511;
        float v;
        if (j < 64) v = w2[j * CW + c]; else if (j < 128) v = a2[(j - 64) * CW + c]; else if (j < 256) v = g2[(j - 128) * CW + c]; else v = (l > 0) ? v2[(j - 256) * CW + c] : 0.f;
        L2T[c * 288 + j] = f2bf(v); }
}
DI unsigned ror1(unsigned x) { return (unsigned)__builtin_amdgcn_update_dpp(0, (int)x, 0x121, 0xf, 0xf, true); }
DI unsigned shr1_keep(unsigned o, unsigned cur) { return (unsigned)__builtin_amdgcn_update_dpp((int)o, (int)cur, 0x111, 0xf, 0xf, false); }
DI unsigned prev_lane(unsigned older, unsigned cur) { return shr1_keep(ror1(older), cur); }
DI float row16_sum(float v) { v += dpp_mov<0xB1>(v); v += dpp_mov<0x4E>(v); v += dpp_mov<0x141>(v); v += dpp_mov<0x140>(v); return v; }
DI void phase_rwkv_prep2(Frame& F, int l, int tile_lo, int tile_hi, int tile_step, bool init) {
    LAS unsigned char* act = F.lds;
    LAS float* INVL = (LAS float*)(F.lds + 38912);
    LAS float* PRM = (LAS float*)(F.lds + 139264);
    const bf16_t* RW = (const bf16_t*)(F.wsp() + WS_RW); const bf16_t* LO = (const bf16_t*)(F.wsp() + WS_LO); const unsigned char* L2T = F.wsp() + WS_WM + WM_L2T;
    bf16_t* SIr = (bf16_t*)(F.wsp() + WS_SIR); bf16_t* SIk = (bf16_t*)(F.wsp() + WS_SIK);
    bf16_t* SCw = (bf16_t*)(F.wsp() + WS_SCRW) + (size_t)F.bid * 64 * CW; bf16_t* SCa = (bf16_t*)(F.wsp() + WS_SCRA) + (size_t)F.bid * 64 * CW; bf16_t* SCb = (bf16_t*)(F.wsp() + WS_SCRB) + (size_t)F.bid * 64 * CW;
    bf16_t* VF = (bf16_t*)(F.wsp() + WS_VF); bf16_t* V1 = (bf16_t*)(F.wsp() + WS_V1); bf16_t* Gb = (bf16_t*)(F.wsp() + WS_G);
    const int lane = F.lane, r16 = lane & 15, g = lane >> 4;
    if (init) { __syncthreads();
      const int c = F.tid;
      PRM[c] = F.inp(4)[(size_t)l * 3 * CW + c]; PRM[512 + c] = F.inp(4)[(size_t)l * 3 * CW + CW + c]; PRM[1024 + c] = F.inp(4)[(size_t)l * 3 * CW + 2 * CW + c];
      PRM[1536 + c] = F.inp(6)[l * CW + c]; PRM[2048 + c] = F.inp(9)[l * CW + c]; PRM[2560 + c] = F.inp(14)[l * CW + c]; PRM[3072 + c] = F.inp(15)[l * CW + c]; PRM[3584 + c] = l > 0 ? F.inp(20)[c] : 0.f; }
    for (int tile = tile_lo; tile < tile_hi; tile += tile_step) {
        int t0 = tile * 64; asm volatile("" : "+s"(t0));
        __syncthreads();
        u32x4 s1p[5], s1q[5];
#pragma unroll
        for (int it = 0; it < 5; ++it) { const int grp = F.tid + 512 * it; s1p[it] = (u32x4){0u, 0u, 0u, 0u}; s1q[it] = (u32x4){0u, 0u, 0u, 0u};
            if (grp < 64 * 36) { const int tt = grp / 36, jg = grp - tt * 36, j0 = 8 * jg; const int t = t0 + tt; const bool has_prev = (t % SEQ) != 0;
                int pj, qj; if (j0 < 64) { pj = j0; qj = 64 + j0; } else if (j0 < 128) { pj = 128 + (j0 - 64); qj = 192 + (j0 - 64); } else if (j0 < 256) { pj = 256 + (j0 - 128); qj = 384 + (j0 - 128); } else { pj = 512 + (j0 - 256); qj = 544 + (j0 - 256); }
                s1p[it] = *(const u32x4*)(LO + (size_t)t * LO_W + pj); if (has_prev) s1q[it] = *(const u32x4*)(LO + (size_t)(t - 1) * LO_W + qj); } }
        { int cw = 64 * F.wave + 16 * g; asm volatile("" : "+v"(cw));
          u32x4 kc[4][2], kq0[2];
          const bf16_t* RWt = RW + (size_t)t0 * 1536; const unsigned lk = (unsigned)(r16 * 1536 + 512 + cw);
#pragma unroll
          for (int tt = 0; tt < 4; ++tt) {
#pragma unroll
              for (int h = 0; h < 2; ++h) kc[tt][h] = *(const u32x4*)(RWt + 16 * tt * 1536 + 8 * h + lk); }
          { const int t = t0 + r16; const bool has_prev = (t % SEQ) != 0;
#pragma unroll
            for (int h = 0; h < 2; ++h) { kq0[h] = (u32x4){0u, 0u, 0u, 0u}; if (has_prev) kq0[h] = *(const u32x4*)(RWt - 1536 + 8 * h + lk); } }
#pragma unroll
        for (int it = 0; it < 5; ++it) asm volatile("" : "+v"(s1p[it]), "+v"(s1q[it]));
#pragma unroll
        for (int it = 0; it < 5; ++it) { const int grp = F.tid + 512 * it;
            if (grp < 64 * 36) { const int tt = grp / 36, jg = grp - tt * 36, j0 = 8 * jg;
                const u32x4 pv = s1p[it], qv = s1q[it];
                const unsigned pw[4] = {pv.x, pv.y, pv.z, pv.w}, qw[4] = {qv.x, qv.y, qv.z, qv.w}; float v[8];
#pragma unroll
                for (int q = 0; q < 4; ++q) { v[2 * q] = bflo(pw[q]) + bflo(qw[q]); v[2 * q + 1] = bfhi(pw[q]) + bfhi(qw[q]); }
                if (j0 < 64) {
#pragma unroll
                    for (int e = 0; e < 8; ++e) v[e] = 1.0f - 2.0f * __builtin_amdgcn_rcpf(1.0f + __expf(2.0f * v[e]));
                } else if (j0 >= 128 && j0 < 256) {
#pragma unroll
                    for (int e = 0; e < 8; ++e) v[e] = sigmoidf_(v[e]);
                }
                u32x4 w; w.x = pk2(v[0], v[1]); w.y = pk2(v[2], v[3]); w.z = pk2(v[4], v[5]); w.w = pk2(v[6], v[7]);
                *(LAS u32x4*)(act + tt * ACT_P + j0 * 2) = w; } }
#pragma unroll
          for (int tt = 0; tt < 4; ++tt) { float ss = 0.f;
#pragma unroll
              for (int h = 0; h < 2; ++h) {
                  const unsigned cwd[4] = {kc[tt][h].x, kc[tt][h].y, kc[tt][h].z, kc[tt][h].w}; unsigned pwd[4];
                  if (tt == 0) { pwd[0] = kq0[h].x; pwd[1] = kq0[h].y; pwd[2] = kq0[h].z; pwd[3] = kq0[h].w; }
                  else { const unsigned owd[4] = {kc[tt > 0 ? tt - 1 : 0][h].x, kc[tt > 0 ? tt - 1 : 0][h].y, kc[tt > 0 ? tt - 1 : 0][h].z, kc[tt > 0 ? tt - 1 : 0][h].w};
#pragma unroll
                      for (int d = 0; d < 4; ++d) pwd[d] = prev_lane(owd[d], cwd[d]); }
#pragma unroll
                  for (int d2 = 0; d2 < 2; ++d2) { const f32x4 muk = *(const LAS f32x4*)(PRM + 512 + cw + 8 * h + 4 * d2), kkc = *(const LAS f32x4*)(PRM + 2560 + cw + 8 * h + 4 * d2);
                      const float k0 = bflo(cwd[2 * d2]), k1 = bfhi(cwd[2 * d2]), k2 = bflo(cwd[2 * d2 + 1]), k3 = bfhi(cwd[2 * d2 + 1]), q0 = bflo(pwd[2 * d2]), q1 = bfhi(pwd[2 * d2]), q2 = bflo(pwd[2 * d2 + 1]), q3 = bfhi(pwd[2 * d2 + 1]);
                      const float a0 = (k0 + (q0 - k0) * muk[0]) * kkc[0], a1 = (k1 + (q1 - k1) * muk[1]) * kkc[1], a2 = (k2 + (q2 - k2) * muk[2]) * kkc[2], a3 = (k3 + (q3 - k3) * muk[3]) * kkc[3];
                      ss += (a0 * a0 + a1 * a1) + (a2 * a2 + a3 * a3); } }
              ss += __shfl_xor(ss, 16); ss += __shfl_xor(ss, 32);
              if (g == 0) INVL[(16 * tt + r16) * 8 + F.wave] = __builtin_amdgcn_rsqf(fmaxf(ss, 1e-24f)); } }
        __syncthreads();
#pragma unroll 1
        for (int j8 = 0; j8 < ((PREP_DUP & 8) ? 4 : 2); ++j8) { const int j = j8 & 1;
            int cb = 256 * j + 32 * F.wave; asm volatile("" : "+v"(cb));
            const int c0 = cb + 8 * g, hd = 4 * j + (F.wave >> 1);
            bf16x8 wf[2][9];
#pragma unroll
            for (int u = 0; u < 2; ++u) { const unsigned char* wrow = L2T + (size_t)(cb + 8 * (r16 >> 2) + 4 * u + (r16 & 3)) * 576 + 16 * g;
#pragma unroll
              for (int s = 0; s < 9; ++s) wf[u][s] = *(const bf16x8*)(wrow + 64 * s); }
            u32x4 cur[2][3], vfl[2], prv0[3]; unsigned rot[3][4] = {{0u, 0u, 0u, 0u}, {0u, 0u, 0u, 0u}, {0u, 0u, 0u, 0u}};
            const bf16_t* RWt = RW + (size_t)t0 * 1536; const unsigned lr = (unsigned)(r16 * 1536 + c0), lc = (unsigned)(r16 * CW + c0);
            const size_t tb = (size_t)t0 * CW;
#define PREP_LOAD(buf, tt_) do { _Pragma("unroll") for (int p_ = 0; p_ < 3; ++p_) cur[buf][p_] = *(const u32x4*)(RWt + 16 * (tt_) * 1536 + 512 * p_ + lr); \
                vfl[buf] = (u32x4){0u, 0u, 0u, 0u}; if (l > 0) vfl[buf] = *(const u32x4*)(VF + tb + 16 * (tt_) * CW + lc); } while (0)
            PREP_LOAD(0, 0);
            { const int t = t0 + r16; const bool has_prev = (t % SEQ) != 0;
#pragma unroll
              for (int p_ = 0; p_ < 3; ++p_) { prv0[p_] = (u32x4){0u, 0u, 0u, 0u}; if (has_prev) prv0[p_] = *(const u32x4*)(RWt - 1536 + 512 * p_ + lr); } }
#pragma unroll
            for (int tt = 0; tt < 4; ++tt) {
                const int bi = tt & 1;
                if (tt < 3) PREP_LOAD(bi ^ 1, tt + 1);
                const size_t oo = tb + 16 * tt * CW; const unsigned os = (unsigned)(16 * tt * CW) + lc;
                bf16x8 a[9];
#pragma unroll
                for (int s = 0; s < 9; ++s) a[s] = *(const LAS bf16x8*)(act + (16 * tt + r16) * ACT_P + (32 * s + 8 * g) * 2);
                const float inv = INVL[(16 * tt + r16) * 8 + hd];
                f32x4 aw[2], aa[2], ag[2], av[2];
#pragma unroll
                for (int u = 0; u < 2; ++u) { aw[u] = (f32x4){0.f, 0.f, 0.f, 0.f}; aa[u] = aw[u]; ag[u] = aw[u]; av[u] = aw[u];
                    aw[u] = mfma16(wf[u][0], a[0], aw[u]); aw[u] = mfma16(wf[u][1], a[1], aw[u]);
                    aa[u] = mfma16(wf[u][2], a[2], aa[u]); aa[u] = mfma16(wf[u][3], a[3], aa[u]);
                    ag[u] = mfma16(wf[u][4], a[4], ag[u]); ag[u] = mfma16(wf[u][5], a[5], ag[u]); ag[u] = mfma16(wf[u][6], a[6], ag[u]); ag[u] = mfma16(wf[u][7], a[7], ag[u]);
                    if (l > 0) av[u] = mfma16(wf[u][8], a[8], av[u]); }
                unsigned cw_[3][4], pw_[3][4];
#pragma unroll
                for (int p_ = 0; p_ < 3; ++p_) { cw_[p_][0] = cur[bi][p_].x; cw_[p_][1] = cur[bi][p_].y; cw_[p_][2] = cur[bi][p_].z; cw_[p_][3] = cur[bi][p_].w;
                    if (tt == 0) { pw_[p_][0] = prv0[p_].x; pw_[p_][1] = prv0[p_].y; pw_[p_][2] = prv0[p_].z; pw_[p_][3] = prv0[p_].w; }
                    else { pw_[p_][0] = shr1_keep(rot[p_][0], cw_[p_][0]); pw_[p_][1] = shr1_keep(rot[p_][1], cw_[p_][1]); pw_[p_][2] = shr1_keep(rot[p_][2], cw_[p_][2]); pw_[p_][3] = shr1_keep(rot[p_][3], cw_[p_][3]); }
#pragma unroll
                    for (int d = 0; d < 4; ++d) rot[p_][d] = ror1(cw_[p_][d]); }
                const unsigned vw_[4] = {vfl[bi].x, vfl[bi].y, vfl[bi].z, vfl[bi].w};
                float ro8[8], lw8[8], vo8[8], k28[8], ka8[8], kb8[8], g8[8];
#pragma unroll
                for (int u = 0; u < 2; ++u) {
                    const f32x4 mur = *(const LAS f32x4*)(PRM + c0 + 4 * u), muk = *(const LAS f32x4*)(PRM + 512 + c0 + 4 * u), muv = *(const LAS f32x4*)(PRM + 1024 + c0 + 4 * u), w0v = *(const LAS f32x4*)(PRM + 1536 + c0 + 4 * u),
                                a0v = *(const LAS f32x4*)(PRM + 2048 + c0 + 4 * u), kkc = *(const LAS f32x4*)(PRM + 2560 + c0 + 4 * u), kac = *(const LAS f32x4*)(PRM + 3072 + c0 + 4 * u), v0v = *(const LAS f32x4*)(PRM + 3584 + c0 + 4 * u);
#pragma unroll
                    for (int r = 0; r < 4; ++r) { const int e = 4 * u + r, d = e >> 1;
                        const float rp = (e & 1) ? bfhi(cw_[0][d]) : bflo(cw_[0][d]), kp = (e & 1) ? bfhi(cw_[1][d]) : bflo(cw_[1][d]), vp = (e & 1) ? bfhi(cw_[2][d]) : bflo(cw_[2][d]);
                        const float rq = (e & 1) ? bfhi(pw_[0][d]) : bflo(pw_[0][d]), kq_ = (e & 1) ? bfhi(pw_[1][d]) : bflo(pw_[1][d]), vq = (e & 1) ? bfhi(pw_[2][d]) : bflo(pw_[2][d]);
                        const float rr = rp + (rq - rp) * mur[r], k = kp + (kq_ - kp) * muk[r]; float v = vp + (vq - vp) * muv[r];
                        lw8[e] = -0.60653066f * sigmoidf_(w0v[r] + aw[u][r]);
                        const float alr = sigmoidf_(a0v[r] + aa[u][r]);
                        if (l > 0) { const float vf = (e & 1) ? bfhi(vw_[d]) : bflo(vw_[d]); v = v + (vf - v) * sigmoidf_(v0v[r] + av[u][r]); }
                        const float kk = k * kkc[r] * inv;
                        ro8[e] = rr; vo8[e] = v; k28[e] = k * (1.f + (alr - 1.f) * kac[r]); ka8[e] = kk; kb8[e] = kk * alr; g8[e] = ag[u][r]; } }
#define PREP_ST(ptr, arr) { u32x4 w_; w_.x = pk2(arr[0], arr[1]); w_.y = pk2(arr[2], arr[3]); w_.z = pk2(arr[4], arr[5]); w_.w = pk2(arr[6], arr[7]); *(u32x4*)(ptr) = w_; }
                PREP_ST(SIr + oo + lc, ro8) PREP_ST(SCw + os, lw8) PREP_ST(Gb + oo + lc, g8) PREP_ST((l > 0 ? V1 : VF) + oo + lc, vo8) PREP_ST(SIk + oo + lc, k28) PREP_ST(SCa + os, ka8) PREP_ST(SCb + os, kb8)
#undef PREP_ST
                asm volatile("" ::: "memory");
            }
#undef PREP_LOAD
        }
    }
}
constexpr int NUNIT = NB * NH * (SEQ / 64);
constexpr size_t U_PMP = 0, U_RPP = 8192, U1_BYTES = 16384;
constexpr size_t U_QMT = 0, U_YLT = 8192, U2_BYTES = 16384;
DI int permk(int k) { return (k & 32) | (((k >> 2) & 3) << 3) | (((k >> 4) & 1) << 2) | (k & 3); }
constexpr int MP = 144;
constexpr int SP = 80;
DI f32x4 mm_tile(const LAS unsigned char* xb, int px, int m0, const LAS unsigned char* yb, int py, int n0, int ks, f32x4 acc, int lane, int sx = 0, int sy = 0) {
    const int r16 = lane & 15, g = lane >> 4; const int fx = (m0 >> 4) & sx, fy = (n0 >> 4) & sy;
    for (int s = 0; s < ks; ++s) {
        const bf16x8 a = *(const LAS bf16x8*)(xb + (m0 + r16) * px + (((4 * s + g) ^ fx) << 4));
        const bf16x8 b = *(const LAS bf16x8*)(yb + (n0 + r16) * py + (((4 * s + g) ^ fy) << 4));
        acc = mfma16(a, b, acc);
    }
    return acc;
}
DI bf16x8 mfrag(const LAS unsigned char* b, int pitch, int row0, int s, int sw, int lane) { const int r16 = lane & 15, g = lane >> 4; return *(const LAS bf16x8*)(b + (row0 + r16) * pitch + (((4 * s + g) ^ ((row0 >> 4) & sw)) << 4)); }
#define PIN8(a) asm volatile("" : "+v"(a))
DI u32x2 pk4(f32x4 v) { u32x2 w; w.x = pk2(v[0], v[1]); w.y = pk2(v[2], v[3]); return w; }

#ifndef SA_TOUCH
#define SA_TOUCH 1
#endif
#ifndef SA_DUP
#define SA_DUP 0
#endif
#define SA_REP(bit) for (int sd_ = 0; sd_ < ((SA_DUP & (bit)) ? 2 : 1); ++sd_)
DI void phase_scan_a(Frame& F, int l, int u_lo, int u_hi, int u_step) {
    LAS unsigned char* const L = F.lds;
#define MB(n) (L + (n) * 9216)
    LAS float* const Gf = (LAS float*)(L + 110592);
    constexpr int GP = 68;
    LAS float* const SEG = (LAS float*)(L + 110592 + 64 * GP * 4);
    LAS float* const GL = SEG + 512;
    LAS unsigned char* const A21 = L + 110592 + 64 * GP * 4 + 2048 + 256;
    LAS unsigned char* const T11T = A21 + 2560;
    LAS unsigned char* const ZT = T11T + 2560;
    const bf16_t* SIr = (const bf16_t*)(F.wsp() + WS_SIR); const bf16_t* SIk = (const bf16_t*)(F.wsp() + WS_SIK);
    const bf16_t* SCw = (const bf16_t*)(F.wsp() + WS_SCRW) + (size_t)F.bid * 64 * CW; const bf16_t* SCa = (const bf16_t*)(F.wsp() + WS_SCRA) + (size_t)F.bid * 64 * CW; const bf16_t* SCb = (const bf16_t*)(F.wsp() + WS_SCRB) + (size_t)F.bid * 64 * CW;
    const bf16_t* V = (const bf16_t*)(F.wsp() + (l > 0 ? WS_V1 : WS_VF));
    const int lane = F.lane, wave = F.wave, r16 = lane & 15, g = lane >> 4;
    float plw[8]; u32x4 prv, pkv, pav, pbv, pvv;
#define SCANA_LOAD(uu) do { int tq_ = F.tid; asm volatile("" : "+v"(tq_)); const int bh_ = (uu) & 31, c_ = (uu) >> 5, b_ = bh_ >> 3, h_ = bh_ & 7; const size_t t0_ = (size_t)b_ * SEQ + c_ * 64; \
        { const int k_ = tq_ & 63, seg_ = tq_ >> 6; _Pragma("unroll") for (int e = 0; e < 8; ++e) plw[e] = bf2f(SCw[(size_t)(8 * seg_ + e) * CW + h_ * 64 + k_]); } \
        { const int i_ = tq_ >> 3, k0_ = (tq_ & 7) * 8; const size_t go_ = (t0_ + i_) * CW + h_ * 64 + k0_, gs_ = (size_t)i_ * CW + h_ * 64 + k0_; \
          prv = *(const u32x4*)(SIr + go_); pkv = *(const u32x4*)(SIk + go_); pav = *(const u32x4*)(SCa + gs_); pbv = *(const u32x4*)(SCb + gs_); pvv = *(const u32x4*)(V + go_); } } while (0)
    if (u_lo < u_hi) SCANA_LOAD(u_lo);
    __syncthreads();
    for (int u = u_lo; u < u_hi; u += u_step) {
        const int bh = u & 31, c = u >> 5, b = bh >> 3, h = bh & 7;
        const size_t t0 = (size_t)b * SEQ + c * 64; (void)t0; (void)b; (void)h;
        unsigned char* const rec1 = F.wsp() + WS_SC1 + (size_t)((bh * 128) + c) * U1_BYTES; unsigned char* const rec2 = F.wsp() + WS_SC2 + (size_t)((bh * 128) + c) * U2_BYTES;
        SA_REP(1) {
        { const int k = F.tid & 63, seg = F.tid >> 6; float p[8]; float run = 0.f;
#pragma unroll
          for (int e = 0; e < 8; ++e) { run += plw[e]; p[e] = run; }
          SEG[seg * 64 + k] = run;
          __syncthreads();
          float off = 0.f;
#pragma unroll
          for (int s = 0; s < 8; ++s) off += (s < seg) ? SEG[s * 64 + k] : 0.f;
#pragma unroll
          for (int e = 0; e < 8; ++e) Gf[(8 * seg + e) * GP + k] = off + p[e];
        }
        __syncthreads();
        { const int i = F.tid >> 3, k0 = (F.tid & 7) * 8;
          const u32x4 rv = prv, kv = pkv, av = pav, bv = pbv, vv = pvv;
          float fr[8], fk[8], fa[8], fb[8], fv[8];
          const unsigned rw[4] = {rv.x, rv.y, rv.z, rv.w}, kw[4] = {kv.x, kv.y, kv.z, kv.w}, aw[4] = {av.x, av.y, av.z, av.w}, bw[4] = {bv.x, bv.y, bv.z, bv.w}, vw[4] = {vv.x, vv.y, vv.z, vv.w};
#pragma unroll
          for (int q = 0; q < 4; ++q) { fr[2 * q] = bflo(rw[q]); fr[2 * q + 1] = bfhi(rw[q]); fk[2 * q] = bflo(kw[q]); fk[2 * q + 1] = bfhi(kw[q]); fa[2 * q] = bflo(aw[q]); fa[2 * q + 1] = bfhi(aw[q]);
              fb[2 * q] = bflo(bw[q]); fb[2 * q + 1] = bfhi(bw[q]); fv[2 * q] = bflo(vw[q]); fv[2 * q + 1] = bfhi(vw[q]); }
          float at[8], rt[8], bt[8], kt[8], bh8[8], kh8[8];
#pragma unroll
          for (int e = 0; e < 8; ++e) { const float gi = Gf[i * GP + k0 + e], gp = (i > 0) ? Gf[(i - 1) * GP + k0 + e] : 0.f, gl = Gf[63 * GP + k0 + e];
              const float e1 = __expf(gp), e2 = __expf(gi), e3 = __expf(-gi), e4 = __expf(gl - gi);
              at[e] = -fa[e] * e1; rt[e] = fr[e] * e2; bt[e] = fb[e] * e3; kt[e] = fk[e] * e3; bh8[e] = fb[e] * e4; kh8[e] = fk[e] * e4;
              if (i == 63) GL[k0 + e] = e2; }
          u32x4 w;
          w.x = pk2(at[0], at[1]); w.y = pk2(at[2], at[3]); w.z = pk2(at[4], at[5]); w.w = pk2(at[6], at[7]); *(LAS u32x4*)(MB(0) + i * MP + k0 * 2) = w;
          w.x = pk2(rt[0], rt[1]); w.y = pk2(rt[2], rt[3]); w.z = pk2(rt[4], rt[5]); w.w = pk2(rt[6], rt[7]); *(LAS u32x4*)(MB(1) + i * MP + k0 * 2) = w;
          w.x = pk2(bt[0], bt[1]); w.y = pk2(bt[2], bt[3]); w.z = pk2(bt[4], bt[5]); w.w = pk2(bt[6], bt[7]); *(LAS u32x4*)(MB(2) + i * MP + k0 * 2) = w;
          w.x = pk2(kt[0], kt[1]); w.y = pk2(kt[2], kt[3]); w.z = pk2(kt[4], kt[5]); w.w = pk2(kt[6], kt[7]); *(LAS u32x4*)(MB(3) + i * MP + k0 * 2) = w;
          { const int sel = i & 1;
#pragma unroll
            for (int q = 0; q < 4; ++q) { const int row = k0 + 4 * sel + q; const int ro = row * MP + (((i >> 3) ^ ((row >> 4) & 3)) << 4) + (i & 6) * 2;
#define TW(dst, arr) { const float d0_ = dpp_mov<0x128>(arr[q]), d1_ = dpp_mov<0x128>(arr[4 + q]);     \
                       const float m_ = sel ? arr[4 + q] : arr[q], o_ = sel ? d1_ : d0_; *(LAS unsigned*)(dst + ro) = pk2(sel ? o_ : m_, sel ? m_ : o_); }
                TW(MB(4), at) TW(MB(5), fv) TW(MB(6), bh8) TW(MB(7), kh8)
#undef TW
            } }
        }
        __syncthreads(); }
        if (u + u_step < u_hi) SCANA_LOAD(u + u_step);
        SA_REP(2) {
        { const int prod = wave >> 1;
          const LAS unsigned char* xb = (prod & 1) ? MB(3) : MB(2); const LAS unsigned char* yb = (prod < 2) ? MB(0) : MB(1);
          LAS unsigned char* ob = (prod == 1) ? MB(8) : (prod == 2) ? MB(9) : MB(10);
          float zf = 0.f; asm volatile("" : "+v"(zf));
          bf16x8 xf[2][2], yf[4][2]; int lq = lane; asm volatile("" : "+v"(lq));
#pragma unroll
          for (int a = 0; a < 2; ++a)
#pragma unroll
              for (int s = 0; s < 2; ++s) xf[a][s] = mfrag(xb, MP, 16 * ((wave & 1) * 2 + a), s, 0, lq);
#pragma unroll
          for (int n = 0; n < 4; ++n)
#pragma unroll
              for (int s = 0; s < 2; ++s) yf[n][s] = mfrag(yb, MP, 16 * n, s, 0, lq);
#pragma unroll
          for (int a = 0; a < 2; ++a) { PIN8(xf[a][0]); PIN8(xf[a][1]); }
#pragma unroll
          for (int n = 0; n < 4; ++n) { PIN8(yf[n][0]); PIN8(yf[n][1]); }
#pragma unroll
          for (int q = 0; q < 8; ++q) { const int tt = (wave & 1) * 8 + q, tm = tt >> 2, tn = tt & 3;
              f32x4 acc = {zf, zf, zf, zf};
              if (tm <= tn) { acc = mfma16(xf[q >> 2][0], yf[tn][0], acc); acc = mfma16(xf[q >> 2][1], yf[tn][1], acc); }
              const int i = 16 * tn + r16, j0 = 16 * tm + 4 * g;
#pragma unroll
              for (int r = 0; r < 4; ++r) { const int j = j0 + r; const bool keep = (prod < 2) ? (j < i) : (j <= i); if (!keep) acc[r] = 0.f; }
              if (prod == 0) {
                  if ((i >> 5) == (j0 >> 5)) *(LAS f32x4*)(Gf + ((i >> 5) * 32 + (i & 31)) * 32 + (j0 & 31)) = acc;
                  if (i >= 32 && j0 < 32) *(LAS u32x2*)(A21 + (i - 32) * SP + j0 * 2) = pk4(acc);
              } else *(LAS u32x2*)(ob + i * MP + j0 * 2) = pk4(acc);
          } }
        __syncthreads();
        }
        f32x4 pyl[2] = {{0.f, 0.f, 0.f, 0.f}, {0.f, 0.f, 0.f, 0.f}}, pqm[2] = {{0.f, 0.f, 0.f, 0.f}, {0.f, 0.f, 0.f, 0.f}};
        SA_REP(4) {
        if (wave == 0) {
            const int blk = lane >> 5, cc = lane & 31; const LAS float* AD = Gf + blk * 1024;
            float Tc[32]; f32x4 rq[2][8];
#pragma unroll
            for (int q = 0; q < 1; ++q) rq[1][q] = *(const LAS f32x4*)(AD + 1 * 32 + 4 * q);
#pragma unroll
            for (int i = 0; i < 32; ++i) { float a0 = (i == cc) ? 1.f : 0.f, a1 = 0.f, a2 = 0.f, a3 = 0.f;
                if (i + 1 < 32 && i >= 1) {
#pragma unroll
                    for (int q = 0; q < (i + 1 + 3) / 4; ++q) rq[(i + 1) & 1][q] = *(const LAS f32x4*)(AD + (i + 1) * 32 + 4 * q); }
                __builtin_amdgcn_sched_barrier(0);
#pragma unroll
                for (int q = 0; q < (i + 3) / 4; ++q) { const f32x4 a = rq[i & 1][q];
                    if (4 * q + 0 < i) a0 += a[0] * Tc[4 * q + 0]; if (4 * q + 1 < i) a1 += a[1] * Tc[4 * q + 1]; if (4 * q + 2 < i) a2 += a[2] * Tc[4 * q + 2]; if (4 * q + 3 < i) a3 += a[3] * Tc[4 * q + 3]; }
                Tc[i] = (a0 + a1) + (a2 + a3);
                __builtin_amdgcn_sched_barrier(0); }
#pragma unroll
            for (int i = 0; i < 32; ++i) *(LAS bf16_t*)(MB(11) + (32 * blk + i) * MP + (32 * blk + cc) * 2) = f2bf(Tc[i]);
            if (blk == 0) {
#pragma unroll
                for (int q = 0; q < 4; ++q) { u32x4 w; w.x = pk2(Tc[8 * q], Tc[8 * q + 1]); w.y = pk2(Tc[8 * q + 2], Tc[8 * q + 3]); w.z = pk2(Tc[8 * q + 4], Tc[8 * q + 5]); w.w = pk2(Tc[8 * q + 6], Tc[8 * q + 7]);
                    *(LAS u32x4*)(T11T + cc * SP + q * 16) = w; }
            } else {
                unsigned z = 0u; asm volatile("" : "+v"(z));
#pragma unroll
                for (int q = 0; q < 4; ++q) *(LAS u32x4*)(MB(11) + cc * MP + 64 + q * 16) = (u32x4){z, z, z, z};
            }
        } else {
            int lq = lane; asm volatile("" : "+v"(lq));
            { bf16x8 xa[3][2], ya[3][2];
#pragma unroll
              for (int k3 = 0; k3 < 3; ++k3) { const int tt = (wave - 1 + 7 * k3) & 15, tm = tt >> 2, tn = tt & 3;
#pragma unroll
                  for (int s = 0; s < 2; ++s) { xa[k3][s] = mfrag(MB(8), MP, 16 * tm, s, 0, lq); ya[k3][s] = mfrag(MB(5), MP, 16 * tn, s, 3, lq); } }
#pragma unroll
              for (int k3 = 0; k3 < 3; ++k3) { PIN8(xa[k3][0]); PIN8(xa[k3][1]); PIN8(ya[k3][0]); PIN8(ya[k3][1]); }
#pragma unroll
              for (int k3 = 0; k3 < 3; ++k3) { const int tt0 = wave - 1 + 7 * k3; if (tt0 < 16) { const int tm = tt0 >> 2, tn = tt0 & 3;
                  f32x4 acc = {0.f, 0.f, 0.f, 0.f}; acc = mfma16(xa[k3][0], ya[k3][0], acc); acc = mfma16(xa[k3][1], ya[k3][1], acc);
                  *(LAS u32x2*)(MB(2) + (16 * tn + r16) * MP + (16 * tm + 4 * g) * 2) = pk4(acc); } } }
            if (sd_ == 0) {
                const int tm = wave >> 1; bf16x8 x5[2], x7[2], y10[2][2], y5[2][2];
#pragma unroll
                for (int s = 0; s < 2; ++s) { x5[s] = mfrag(MB(5), MP, 16 * tm, s, 3, lq); x7[s] = mfrag(MB(7), MP, 16 * tm, s, 3, lq);
#pragma unroll
                    for (int q = 0; q < 2; ++q) { const int tn = (wave * 2 + q) & 3; y10[q][s] = mfrag(MB(10), MP, 16 * tn, s, 0, lq); y5[q][s] = mfrag(MB(5), MP, 16 * tn, s, 3, lq); } }
                PIN8(x5[0]); PIN8(x5[1]); PIN8(x7[0]); PIN8(x7[1]);
#pragma unroll
                for (int q = 0; q < 2; ++q) { PIN8(y10[q][0]); PIN8(y10[q][1]); PIN8(y5[q][0]); PIN8(y5[q][1]); }
#pragma unroll
                for (int q = 0; q < 2; ++q) { f32x4 z = {0.f, 0.f, 0.f, 0.f};
                    pyl[q] = mfma16(x5[1], y10[q][1], mfma16(x5[0], y10[q][0], z));
                    pqm[q] = mfma16(x7[1], y5[q][1], mfma16(x7[0], y5[q][0], z)); } }
        }
        __syncthreads();
        if (wave < 4) { const int tm = wave >> 1, tn = wave & 1; LAS unsigned char* const zp = MB(0) + wave * 1280;
#pragma unroll
            for (int mt = 0; mt < 2; ++mt) { f32x4 acc = {0.f, 0.f, 0.f, 0.f};
                acc = mm_tile(A21, SP, 16 * mt, T11T, SP, 16 * tm, 1, acc, lane);
                *(LAS u32x2*)(zp + r16 * SP + (16 * mt + 4 * g) * 2) = pk4(acc); }
            asm volatile("s_waitcnt lgkmcnt(0)" ::: "memory");
            f32x4 acc = {0.f, 0.f, 0.f, 0.f};
            acc = mm_tile(zp, SP, 0, MB(11) + 32 * MP + 64, MP, 16 * tn, 1, acc, lane);
            *(LAS u32x2*)(MB(11) + (32 + 16 * tn + r16) * MP + (16 * tm + 4 * g) * 2) = pk4(acc); }
        __syncthreads();
        }
        SA_REP(8) {
        { const LAS unsigned char* yb = (wave < 4) ? MB(4) : MB(2); LAS unsigned char* ob = (wave < 4) ? MB(3) : MB(0);
          const int tm = wave & 3, ysw = (wave < 4) ? 3 : 0;
          bf16x8 xf[2], yf[4][2]; int lq = lane; asm volatile("" : "+v"(lq));
#pragma unroll
          for (int s = 0; s < 2; ++s) { xf[s] = mfrag(MB(11), MP, 16 * tm, s, 0, lq);
#pragma unroll
              for (int n = 0; n < 4; ++n) yf[n][s] = mfrag(yb, MP, 16 * n, s, ysw, lq); }
          PIN8(xf[0]); PIN8(xf[1]);
#pragma unroll
          for (int n = 0; n < 4; ++n) { PIN8(yf[n][0]); PIN8(yf[n][1]); }
#pragma unroll
          for (int tn = 0; tn < 4; ++tn) { f32x4 acc = {0.f, 0.f, 0.f, 0.f};
              acc = mfma16(xf[0], yf[tn][0], acc); acc = mfma16(xf[1], yf[tn][1], acc);
              *(LAS u32x2*)(ob + (16 * tn + r16) * MP + (16 * tm + 4 * g) * 2) = pk4(acc); } }
        __syncthreads();
        }
#if SA_TOUCH
        asm volatile("" : "+v"(plw[0]), "+v"(plw[1]), "+v"(plw[2]), "+v"(plw[3]), "+v"(plw[4]), "+v"(plw[5]), "+v"(plw[6]), "+v"(plw[7]), "+v"(prv), "+v"(pkv), "+v"(pav), "+v"(pbv), "+v"(pvv));
#endif
        SA_REP(16) {
        { const int tm = wave >> 1;
          bf16x8 x3[2], x0[2], x6[2], y9[2][2], y6[2][2], y0[2][2]; u32x2 rrv[2]; int lq = lane; asm volatile("" : "+v"(lq));
#pragma unroll
          for (int s = 0; s < 2; ++s) { x3[s] = mfrag(MB(3), MP, 16 * tm, s, 0, lq); x0[s] = mfrag(MB(0), MP, 16 * tm, s, 0, lq); x6[s] = mfrag(MB(6), MP, 16 * tm, s, 3, lq);
#pragma unroll
              for (int q = 0; q < 2; ++q) { const int tn = (wave * 2 + q) & 3; y9[q][s] = mfrag(MB(9), MP, 16 * tn, s, 0, lq); y6[q][s] = mfrag(MB(6), MP, 16 * tn, s, 3, lq); y0[q][s] = mfrag(MB(0), MP, 16 * tn, s, 0, lq); } }
#pragma unroll
          for (int q = 0; q < 2; ++q) { const int tn = (wave * 2 + q) & 3; rrv[q] = *(const LAS u32x2*)(MB(1) + (16 * tn + r16) * MP + (16 * tm + 4 * g) * 2); }
          PIN8(x3[0]); PIN8(x3[1]); PIN8(x0[0]); PIN8(x0[1]); PIN8(x6[0]); PIN8(x6[1]);
#pragma unroll
          for (int q = 0; q < 2; ++q) { PIN8(y9[q][0]); PIN8(y9[q][1]); PIN8(y6[q][0]); PIN8(y6[q][1]); PIN8(y0[q][0]); PIN8(y0[q][1]); PIN8(rrv[q]); }
#pragma unroll
          for (int q = 0; q < 2; ++q) { const int tn = (wave * 2 + q) & 3;
            { f32x4 acc = {0.f, 0.f, 0.f, 0.f}; acc = mfma16(x3[0], y9[q][0], acc); acc = mfma16(x3[1], y9[q][1], acc);
              const int i = 16 * tn + r16, k0 = 16 * tm + 4 * g; const u32x2 rr = rrv[q];
              acc[0] += bflo(rr.x); acc[1] += bfhi(rr.x); acc[2] += bflo(rr.y); acc[3] += bfhi(rr.y);
              *(u32x2*)(rec1 + U_RPP + (size_t)(i * 64 + permk(k0)) * 2) = pk4(acc); }
            { f32x4 acc = {0.f, 0.f, 0.f, 0.f}; acc = mfma16(x3[0], y6[q][0], acc); acc = mfma16(x3[1], y6[q][1], acc);
              const int kp = 16 * tn + r16, k0 = 16 * tm + 4 * g;
#pragma unroll
              for (int r = 0; r < 4; ++r) if (k0 + r == kp) acc[r] += GL[kp];
              *(u32x2*)(rec1 + U_PMP + (size_t)(kp * 64 + permk(k0)) * 2) = pk4(acc); }
            { f32x4 acc = pyl[q]; acc = mfma16(x0[0], y9[q][0], acc); acc = mfma16(x0[1], y9[q][1], acc); if (wave == 0) acc = mm_tile(MB(5), MP, 16 * tm, MB(10), MP, 16 * tn, 2, acc, lane, 3, 0);
              *(u32x2*)(rec2 + U_YLT + (size_t)((16 * tn + r16) * 64 + 16 * tm + 4 * g) * 2) = pk4(acc); }
            { f32x4 acc = pqm[q]; acc = mfma16(x6[0], y0[q][0], acc); acc = mfma16(x6[1], y0[q][1], acc); if (wave == 0) acc = mm_tile(MB(7), MP, 16 * tm, MB(5), MP, 16 * tn, 2, acc, lane, 3, 3);
              *(u32x2*)(rec2 + U_QMT + (size_t)((16 * tn + r16) * 64 + 16 * tm + 4 * g) * 2) = pk4(acc); }
          } }
        if (SA_DUP & 16) __syncthreads(); }
    }
#undef MB
#undef SCANA_LOAD
}

constexpr int SB_D = 9, SB_SLOT = 16384;
DI void scanb_issue(LAS unsigned char* lds, const unsigned char* r1b, const unsigned char* r2b, int cidx, int lw, int lane) {
    const unsigned char* rec1 = r1b + (size_t)cidx * U1_BYTES; const unsigned char* rec2 = r2b + (size_t)cidx * U2_BYTES;
    LAS unsigned char* slot = lds + (cidx % SB_D) * SB_SLOT;
#pragma unroll
    for (int i = 0; i < 2; ++i) { const int ci = 2 * lw + i;
        const int row = 8 * ci + (lane >> 3), sl = lane & 7;
        __builtin_amdgcn_global_load_lds((const unsigned*)(rec1 + U_PMP + row * 128 + ((sl ^ (row & 7)) << 4)), (LAS unsigned*)(slot + ci * 1024), 16, 0, 0); }
#pragma unroll
    for (int i = 0; i < 2; ++i) { const int ci = 2 * lw + i;
        const int v = 8 * ci + (lane >> 3), sl = lane & 7;
        __builtin_amdgcn_global_load_lds((const unsigned*)(rec2 + U_QMT + v * 128 + ((sl ^ (v & 7)) << 4)), (LAS unsigned*)(slot + 8192 + ci * 1024), 16, 0, 0); }
}
constexpr int CW_SFLG = 12288;
DI void phase_scan_b(Frame& F, int l) {
    const int lane = F.lane, r16 = lane & 15, g = lane >> 4, w = F.wave, v = 16 * (w & 3) + r16;
    for (int bh = F.bid; bh < NB * NH; bh += F.G) {
        const unsigned char* r1 = F.wsp() + WS_SC1 + (size_t)bh * 128 * U1_BYTES; const unsigned char* r2 = F.wsp() + WS_SC2 + (size_t)bh * 128 * U2_BYTES;
        bf16_t* sct = (bf16_t*)(F.wsp() + WS_SCT) + (size_t)bh * 128 * 4096;
        const __amdgpu_buffer_rsrc_t srs = __builtin_amdgcn_make_buffer_rsrc((void*)sct, 0, 128 * 8192, 0x00020000);
        GAS unsigned* flg = (GAS unsigned*)(F.ws_g + WS_CTL) + CW_SFLG + 64 * (l * 32 + bh);
        f32x4 sT[4];
        float zf = 0.f; asm volatile("" : "+v"(zf));
#pragma unroll
        for (int i = 0; i < 4; ++i) sT[i] = (f32x4){zf, zf, zf, zf};
        __syncthreads();
        if (w >= 4) {
#pragma unroll
            for (int d = 0; d < SB_D; ++d) scanb_issue(F.lds, r1, r2, d, w - 4, lane);
        }
        for (int c = 0; c < 128; ++c) {
            if (w >= 4) asm volatile("s_waitcnt vmcnt(28)" ::: "memory");
            __builtin_amdgcn_s_barrier();
            asm volatile("" ::: "memory");
            if (w >= 4) {
                if (c >= 1) { const int cn = c - 1 + SB_D; scanb_issue(F.lds, r1, r2, cn < 128 ? cn : c, w - 4, lane); }
            } else {
                const LAS unsigned char* slot = F.lds + (c % SB_D) * SB_SLOT;
                bf16x8 pm[4][2]; f32x4 q[4];
#pragma unroll
                for (int mt = 0; mt < 4; ++mt) { const int row = 16 * mt + r16;
#pragma unroll
                    for (int s2 = 0; s2 < 2; ++s2) pm[mt][s2] = *(const LAS bf16x8*)(slot + row * 128 + (((4 * s2 + g) ^ (row & 7)) << 4));
                    { const u32x2 qw = *(const LAS u32x2*)(slot + 8192 + v * 128 + (((2 * mt + (g >> 1)) ^ (v & 7)) << 4) + (g & 1) * 8); q[mt] = (f32x4){bflo(qw.x), bfhi(qw.x), bflo(qw.y), bfhi(qw.y)}; } }
                bf16x8 hi[2], lo[2];
#pragma unroll
                for (int s2 = 0; s2 < 2; ++s2) { u32x4 hw, lw;
#pragma unroll
                    for (int qq = 0; qq < 2; ++qq) { const f32x4 x = sT[2 * s2 + qq]; const unsigned h0 = pk2(x[0], x[1]), h1 = pk2(x[2], x[3]);
                        const unsigned l0 = pk2(x[0] - bflo(h0), x[1] - bfhi(h0)), l1 = pk2(x[2] - bflo(h1), x[3] - bfhi(h1));
                        if (qq == 0) { hw.x = h0; hw.y = h1; lw.x = l0; lw.y = l1; } else { hw.z = h0; hw.w = h1; lw.z = l0; lw.w = l1; } }
                    hi[s2] = __builtin_bit_cast(bf16x8, hw); lo[s2] = __builtin_bit_cast(bf16x8, lw);
                    __builtin_amdgcn_raw_buffer_store_b128(hw, srs, (int)(((unsigned)c * 4096u + (unsigned)v * 64u + 32u * s2 + 8u * g) * 2u), 0, 16); }
#pragma unroll
                for (int mt = 0; mt < 4; ++mt) { f32x4 n = q[mt];
#pragma unroll
                    for (int s2 = 0; s2 < 2; ++s2) { n = mfma16(pm[mt][s2], hi[s2], n); n = mfma16(pm[mt][s2], lo[s2], n); }
                    sT[mt] = n; }
                asm volatile("s_waitcnt lgkmcnt(0)" ::: "memory");
                if ((c & 3) == 3 && c >= 7) { asm volatile("s_waitcnt vmcnt(8)" ::: "memory");
                    if (lane == 0) __hip_atomic_fetch_add(flg, 1u, __ATOMIC_RELAXED, __HIP_MEMORY_SCOPE_AGENT); }
            }
        }
        asm volatile("s_waitcnt vmcnt(0)" ::: "memory");
        if (w < 4 && lane == 0) __hip_atomic_fetch_add(flg, 1u, __ATOMIC_RELAXED, __HIP_MEMORY_SCOPE_AGENT);
    }
}

struct ScanCIn { bf16x8 ra[2]; f32x4 yl[4]; bf16x8 sb[4][2]; u32x4 pr[2], pk[2], pv[2], pg[2]; };
DI void scanc_load(ScanCIn& o, const unsigned char* ws, GAS unsigned* flags, int item, int r16, int g, int l) {
    asm volatile("" : "+s"(item));
    const int u = item >> 2, it = item & 3; const int bh = u & 31, c = u >> 5; const size_t ui = (size_t)(bh * 128 + c);
    {
      GAS unsigned* fw = flags + 64 * bh; const unsigned need = 4u * ((unsigned)(c >> 2) + 1u); unsigned spins = 0;
      while ((unsigned)__builtin_amdgcn_readfirstlane((int)__hip_atomic_load(fw, __ATOMIC_RELAXED, __HIP_MEMORY_SCOPE_AGENT)) < need) { __builtin_amdgcn_s_sleep(24); if (++spins > (1u << 20)) break; }
      asm volatile("" ::: "memory"); }
    const unsigned char* rec1 = ws + WS_SC1 + ui * U1_BYTES; const unsigned char* rec2 = ws + WS_SC2 + ui * U2_BYTES;
    const __amdgpu_buffer_rsrc_t srs = __builtin_amdgcn_make_buffer_rsrc((void*)(ws + WS_SCT + ui * 8192), 0, 8192, 0x00020000);
#pragma unroll
    for (int s = 0; s < 2; ++s) o.ra[s] = *(const bf16x8*)(rec1 + U_RPP + (size_t)((16 * it + r16) * 64 + 32 * s + 8 * g) * 2);
#pragma unroll
    for (int vt = 0; vt < 4; ++vt) { { const u32x2 yw = *(const u32x2*)(rec2 + U_YLT + (size_t)((16 * it + r16) * 64 + 32 * (vt >> 1) + 8 * g + 4 * (vt & 1)) * 2); o.yl[vt] = (f32x4){bflo(yw.x), bfhi(yw.x), bflo(yw.y), bfhi(yw.y)}; }
        const int vrow = 32 * (vt >> 1) + 8 * (r16 >> 2) + 4 * (vt & 1) + (r16 & 3);
#pragma unroll
        for (int s = 0; s < 2; ++s) o.sb[vt][s] = __builtin_bit_cast(bf16x8, __builtin_amdgcn_raw_buffer_load_b128(srs, (int)((vrow * 64 + 32 * s + 8 * g) * 2), 0, 16)); }
    { const bf16_t* SIr = (const bf16_t*)(ws + WS_SIR); const bf16_t* SIk = (const bf16_t*)(ws + WS_SIK); const bf16_t* V = (const bf16_t*)(ws + (l > 0 ? WS_V1 : WS_VF)); const bf16_t* Gb = (const bf16_t*)(ws + WS_G);
      const int b = bh >> 3, h = bh & 7; const size_t o0 = ((size_t)b * SEQ + c * 64 + 16 * it + r16) * CW + h * 64 + 8 * g;
#pragma unroll
      for (int p = 0; p < 2; ++p) { o.pr[p] = *(const u32x4*)(SIr + o0 + 32 * p); o.pk[p] = *(const u32x4*)(SIk + o0 + 32 * p); o.pv[p] = *(const u32x4*)(V + o0 + 32 * p); o.pg[p] = *(const u32x4*)(Gb + o0 + 32 * p); } }
}
DI void scanc_item(const ScanCIn& o, Frame& F, int l, int item, int r16, int g) {
    const bf16_t* SIr = (const bf16_t*)(F.wsp() + WS_SIR); const bf16_t* SIk = (const bf16_t*)(F.wsp() + WS_SIK);
    const bf16_t* V = (const bf16_t*)(F.wsp() + (l > 0 ? WS_V1 : WS_VF)); const bf16_t* Gb = (const bf16_t*)(F.wsp() + WS_G); bf16_t* YR = (bf16_t*)(F.wsp() + WS_YRM);
    const int u = item >> 2, it = item & 3; const int bh = u & 31, c = u >> 5, b = bh >> 3, h = bh & 7;
    const size_t tok = (size_t)b * SEQ + c * 64 + 16 * it + r16; const size_t o0 = tok * CW + h * 64 + 8 * g, oy = tok * YRM_LD + h * 64 + 8 * g;
    u32x4 pr[2], pk[2], pv[2], pg[2];
#pragma unroll
    for (int p = 0; p < 2; ++p) { pr[p] = o.pr[p]; pk[p] = o.pk[p]; pv[p] = o.pv[p]; pg[p] = o.pg[p]; }
    f32x4 y[4];
#pragma unroll
    for (int vt = 0; vt < 4; ++vt) { y[vt] = o.yl[vt];
#pragma unroll
        for (int s = 0; s < 2; ++s) y[vt] = mfma16(o.sb[vt][s], o.ra[s], y[vt]); }
    float s1 = 0.f;
#pragma unroll
    for (int vt = 0; vt < 4; ++vt) s1 += (y[vt][0] + y[vt][1]) + (y[vt][2] + y[vt][3]);
    s1 += __shfl_xor(s1, 16); s1 += __shfl_xor(s1, 32);
    const float mean = s1 * (1.f / 64.f); float s2 = 0.f;
#pragma unroll
    for (int vt = 0; vt < 4; ++vt) { y[vt] = y[vt] - mean; s2 += (y[vt][0] * y[vt][0] + y[vt][1] * y[vt][1]) + (y[vt][2] * y[vt][2] + y[vt][3] * y[vt][3]); }
    s2 += __shfl_xor(s2, 16); s2 += __shfl_xor(s2, 32);
    const float rstd = __builtin_amdgcn_rsqf(s2 * (1.f / 64.f) + 64e-5f);
    const LAS float* lng = (const LAS float*)F.lds + h * 64 + 8 * g; const LAS float* lnb = lng + 512; const LAS float* rkp = lng + 1024;
    float s3 = 0.f;
#pragma unroll
    for (int p = 0; p < 2; ++p) { const f32x4 rk0 = *(const LAS f32x4*)(rkp + 32 * p), rk1 = *(const LAS f32x4*)(rkp + 32 * p + 4);
        s3 += bflo(pr[p].x) * bflo(pk[p].x) * rk0[0] + bfhi(pr[p].x) * bfhi(pk[p].x) * rk0[1] + bflo(pr[p].y) * bflo(pk[p].y) * rk0[2] + bfhi(pr[p].y) * bfhi(pk[p].y) * rk0[3]
            + bflo(pr[p].z) * bflo(pk[p].z) * rk1[0] + bfhi(pr[p].z) * bfhi(pk[p].z) * rk1[1] + bflo(pr[p].w) * bflo(pk[p].w) * rk1[2] + bfhi(pr[p].w) * bfhi(pk[p].w) * rk1[3]; }
    s3 += __shfl_xor(s3, 16); s3 += __shfl_xor(s3, 32);
#pragma unroll
    for (int p = 0; p < 2; ++p) { const f32x4 lg0 = *(const LAS f32x4*)(lng + 32 * p), lg1 = *(const LAS f32x4*)(lng + 32 * p + 4), lb0 = *(const LAS f32x4*)(lnb + 32 * p), lb1 = *(const LAS f32x4*)(lnb + 32 * p + 4);
        const f32x4 ya = y[2 * p], yb = y[2 * p + 1];
        const float o_0 = (ya[0] * rstd * lg0[0] + lb0[0] + s3 * bflo(pv[p].x)) * bflo(pg[p].x), o_1 = (ya[1] * rstd * lg0[1] + lb0[1] + s3 * bfhi(pv[p].x)) * bfhi(pg[p].x);
        const float o_2 = (ya[2] * rstd * lg0[2] + lb0[2] + s3 * bflo(pv[p].y)) * bflo(pg[p].y), o_3 = (ya[3] * rstd * lg0[3] + lb0[3] + s3 * bfhi(pv[p].y)) * bfhi(pg[p].y);
        const float o_4 = (yb[0] * rstd * lg1[0] + lb1[0] + s3 * bflo(pv[p].z)) * bflo(pg[p].z), o_5 = (yb[1] * rstd * lg1[1] + lb1[1] + s3 * bfhi(pv[p].z)) * bfhi(pg[p].z);
        const float o_6 = (yb[2] * rstd * lg1[2] + lb1[2] + s3 * bflo(pv[p].w)) * bflo(pg[p].w), o_7 = (yb[3] * rstd * lg1[3] + lb1[3] + s3 * bfhi(pv[p].w)) * bfhi(pg[p].w);
        u32x4 w; w.x = pk2(o_0, o_1); w.y = pk2(o_2, o_3); w.z = pk2(o_4, o_5); w.w = pk2(o_6, o_7); *(u32x4*)(YR + oy + 32 * p) = w; }
}
DI void phase_scan_c(Frame& F, int l, int nskip) {
    const int lane = F.lane, r16 = lane & 15, g = lane >> 4;
    const int first = (F.bid - nskip) * 8 + F.wave, stride = (F.G - nskip) * 8;
    { LAS float* LN = (LAS float*)F.lds; const int c = F.lane + 64 * F.wave;
      __syncthreads(); LN[c] = F.inp(17)[l * CW + c]; LN[512 + c] = F.inp(18)[l * CW + c]; LN[1024 + c] = F.inp(16)[l * CW + c]; __syncthreads(); }
    if (first >= NUNIT * 4) return;
    GAS unsigned* flags = (GAS unsigned*)(F.ws_g + WS_CTL) + CW_SFLG + 64 * (l * 32);
    ScanCIn o0, o1;
    scanc_load(o0, F.wsp(), flags, first, r16, g, l);
    for (int item = first; item < NUNIT * 4; item += 2 * stride) {
        const int i1 = item + stride, i2 = item + 2 * stride;
        if (i1 < NUNIT * 4) scanc_load(o1, F.wsp(), flags, i1, r16, g, l);
        scanc_item(o0, F, l, item, r16, g);
        if (i1 < NUNIT * 4) { if (i2 < NUNIT * 4) scanc_load(o0, F.wsp(), flags, i2, r16, g, l); scanc_item(o1, F, l, i1, r16, g); }
    }
}

#ifndef FUSE_DUP
#define FUSE_DUP 0
#endif
DI void phase_prep_scana(Frame& F, int l) {
    phase_rwkv_prep2(F, l, 0, 0, 1, true);
#define RELANE() do { int l_ = F.lane; asm volatile("" : "+v"(l_)); F.lane = l_; F.tid = F.wave * 64 + l_; } while (0)
    for (int tile = F.bid; tile < T / 64; tile += F.G) {
        for (int fd_ = 0; fd_ < ((FUSE_DUP & 1) ? 2 : 1); ++fd_) {
        RELANE();
        phase_rwkv_prep2(F, l, tile, tile + 1, 1, false);
        }
        asm volatile("s_waitcnt vmcnt(0)" ::: "memory");
        __syncthreads();
        __builtin_amdgcn_fence(__ATOMIC_ACQUIRE, "agent");
        asm volatile("s_waitcnt vmcnt(0)" ::: "memory");
        const int b = tile >> 7, c = tile & 127; const int u0 = c * 32 + b * 8;
        for (int fd_ = 0; fd_ < ((FUSE_DUP & 2) ? 2 : 1); ++fd_) {
        RELANE();
        phase_scan_a(F, l, u0, u0 + 8, 1);
        }
    }
#undef RELANE
}
DI void phase_moba_prep(Frame& F, int l) {
    bf16_t* MO = (bf16_t*)(F.wsp() + WS_MO); float* KM = (float*)(F.wsp() + WS_TAB + TB_KMEAN);
    int c = F.tid; const float qg = F.inp(23)[l * 64 + (c & 63)] * 0.125f, kg = F.inp(24)[l * 64 + (c & 63)];
    for (int hs = F.bid; hs < T / 128; hs += F.G) {
        float ksum = 0.f;
        for (int tb = 0; tb < 128; tb += 8) {
            int tbase = hs * 128 + tb; asm volatile("" : "+s"(tbase), "+v"(c));
            float q[8], k[8];
#pragma unroll
            for (int e = 0; e < 8; ++e) { const size_t ro = (size_t)(tbase + e) * 1536; q[e] = bf2f(MO[ro + c]); k[e] = bf2f(MO[ro + 512 + c]); }
#pragma unroll
            for (int e = 0; e < 8; ++e) { const size_t ro = (size_t)(tbase + e) * 1536;
                const float qs = wave_sum(q[e] * q[e]) * (1.f / 64.f), ks = wave_sum(k[e] * k[e]) * (1.f / 64.f);
                const float qn = q[e] * (1.0f / sqrtf(qs + 1e-6f)) * qg, kn = k[e] * (1.0f / sqrtf(ks + 1e-6f)) * kg;
                MO[ro + c] = f2bf(qn); MO[ro + 512 + c] = f2bf(kn); ksum += kn; }
        }
        KM[(size_t)(hs & 1) * (TB_KMEAN2 / 4) + (size_t)(hs >> 1) * CW + c] = ksum * (1.f / 256.f);
    }
}
DI void gate_ins(float s, int j, float& v0, int& i0, float& v1, int& i1, float& v2, int& i2, bool tie) {
    const bool b0 = (s > v0) || (tie && s == v0 && j < i0), b1 = (s > v1) || (tie && s == v1 && j < i1), b2 = (s > v2) || (tie && s == v2 && j < i2);
    const float n2 = b1 ? v1 : (b2 ? s : v2); const int m2 = b1 ? i1 : (b2 ? j : i2);
    const float n1 = b0 ? v0 : (b1 ? s : v1); const int m1 = b0 ? i0 : (b1 ? j : i1);
    v0 = b0 ? s : v0; i0 = b0 ? j : i0; v1 = n1; i1 = m1; v2 = n2; i2 = m2;
}
constexpr int KG_P = 144, KG_H = 32 * KG_P, KG_LO = 8 * KG_H;
DI void phase_moba_gate(Frame& F) {
    LAS unsigned char* KL = F.lds;
    const bf16_t* MO = (const bf16_t*)(F.wsp() + WS_MO); const float* KM = (const float*)(F.wsp() + WS_TAB + TB_KMEAN); unsigned* SEL = (unsigned*)(F.wsp() + WS_SEL);
    const int lane = F.lane, r16 = lane & 15, g = lane >> 4, h = F.wave;
    for (int sidx = F.bid; sidx < T / 64; sidx += F.G) {
        const int span = ((sidx / F.G) & 1) ? ((sidx & ~127) + (127 - (sidx & 127))) : sidx;
        const int t0 = span * 64, b = t0 / SEQ, blk = (t0 % SEQ) / 256;
        bf16x8 qf[4][2];
#pragma unroll
        for (int nt = 0; nt < 4; ++nt)
#pragma unroll
            for (int s = 0; s < 2; ++s) qf[nt][s] = *(const bf16x8*)(MO + (size_t)(t0 + 16 * nt + r16) * 1536 + h * 64 + 32 * s + 8 * g);
        __syncthreads();
        { const int cc = F.tid, hh = cc >> 6, d = cc & 63;
          for (int j0 = 0; j0 < blk; j0 += 8) { float v0[8], v1[8];
#pragma unroll
              for (int e = 0; e < 8; ++e) { const int j = (j0 + e < blk) ? j0 + e : blk - 1; const size_t ko = ((size_t)(b * 32 + j)) * CW + cc; v0[e] = KM[ko]; v1[e] = KM[ko + TB_KMEAN2 / 4]; }
#pragma unroll
              for (int e = 0; e < 8; ++e) asm volatile("" : "+v"(v0[e]), "+v"(v1[e]));
#pragma unroll
              for (int e = 0; e < 8; ++e) if (j0 + e < blk) { const float v = v0[e] + v1[e]; const bf16_t hi = f2bf(v); const bf16_t lo = f2bf(v - bf2f(hi));
                  *(LAS bf16_t*)(KL + hh * KG_H + (j0 + e) * KG_P + d * 2) = hi; *(LAS bf16_t*)(KL + KG_LO + hh * KG_H + (j0 + e) * KG_P + d * 2) = lo; } } }
        __syncthreads();
        unsigned selw[4];
        if (blk > 0) {
            f32x4 acc[2][4];
#pragma unroll
            for (int mt = 0; mt < 2; ++mt) { bf16x8 ah[2], al[2];
#pragma unroll
                for (int s = 0; s < 2; ++s) { ah[s] = *(const LAS bf16x8*)(KL + h * KG_H + (16 * mt + r16) * KG_P + (32 * s + 8 * g) * 2); al[s] = *(const LAS bf16x8*)(KL + KG_LO + h * KG_H + (16 * mt + r16) * KG_P + (32 * s + 8 * g) * 2); }
#pragma unroll
                for (int nt = 0; nt < 4; ++nt) { f32x4 a = {0.f, 0.f, 0.f, 0.f};
#pragma unroll
                    for (int s = 0; s < 2; ++s) { a = mfma16(ah[s], qf[nt][s], a); a = mfma16(al[s], qf[nt][s], a); }
                    acc[mt][nt] = a; } }
#pragma unroll
            for (int nt = 0; nt < 4; ++nt) {
                float v0 = -INFINITY, v1 = -INFINITY, v2 = -INFINITY; int i0 = 0, i1 = 1, i2 = 2;
#pragma unroll
                for (int mt = 0; mt < 2; ++mt)
#pragma unroll
                    for (int r = 0; r < 4; ++r) { const int j = 16 * mt + 4 * g + r; const float s = (j < blk) ? acc[mt][nt][r] : -INFINITY; gate_ins(s, j, v0, i0, v1, i1, v2, i2, false); }
#pragma unroll
                for (int x = 16; x <= 32; x <<= 1) {
                    const float p0 = __shfl_xor(v0, x), p1 = __shfl_xor(v1, x), p2 = __shfl_xor(v2, x); const int q0 = __shfl_xor(i0, x), q1 = __shfl_xor(i1, x), q2 = __shfl_xor(i2, x);
                    gate_ins(p0, q0, v0, i0, v1, i1, v2, i2, true); gate_ins(p1, q1, v0, i0, v1, i1, v2, i2, true); gate_ins(p2, q2, v0, i0, v1, i1, v2, i2, true); }
                const int nv = blk < 3 ? blk : 3;
                selw[nt] = (unsigned)i0 | ((unsigned)i1 << 8) | ((unsigned)i2 << 16) | ((unsigned)nv << 24); }
        } else {
#pragma unroll
            for (int nt = 0; nt < 4; ++nt) selw[nt] = 0u | (1u << 8) | (2u << 16);
        }
        if (g == 0) {
#pragma unroll
            for (int nt = 0; nt < 4; ++nt) SEL[(size_t)(t0 + 16 * nt + r16) * 8 + h] = selw[nt]; }
    }
}

constexpr int KS_PITCH = 144, VT_PITCH = 520;
#ifndef ATT_DUP
#define ATT_DUP 0
#endif
constexpr int NPIECE = 35;
constexpr int CW_QATT = 8192;
DI void phase_moba_attn(Frame& F, int l, int rep = 0) {
    static constexpr unsigned PIECES[NPIECE] = {1179905,1638914,786432,2032387,2032644,2032901,2033158,2033415,2033672,2033929,2034186,2034443,2034700,2034957,2035214,2035471,2035728,2034944,2035985,2036242,2036499,2036756,2037013,2037270,2037527,2037784,2038041,2036481,2038298,2038555,2038812,2039069,2039326,2039583,2038274};
    LAS unsigned char* Ks = F.lds;
    LAS unsigned char* Vt = F.lds + 36864;
    LAS float* LUT = (LAS float*)(F.lds + 36864 + 33280);
    LAS unsigned* CTL = (LAS unsigned*)(F.lds + 36864 + 33280 + 528);
    LAS unsigned* LIST = CTL + 4;
    const bf16_t* MO = (const bf16_t*)(F.wsp() + WS_MO); const unsigned* SEL = (const unsigned*)(F.wsp() + WS_SEL);
    bf16_t* PO = (bf16_t*)(F.wsp() + WS_PO); f32x2* PST = (f32x2*)(F.wsp() + WS_PST);
    unsigned* qctr = (unsigned*)(F.wsp() + WS_CTL) + CW_QATT + 64 * l + 32 * rep;
    const float* relb = F.inp(25);
    const int lane = F.lane;
    bool att_done = false, conv_done = false;
    unsigned nu = 0u; if (F.tid == 0) nu = __hip_atomic_fetch_add(qctr, 1u, __ATOMIC_RELAXED, __HIP_MEMORY_SCOPE_AGENT);
    for (int trip = 0;; ++trip) {
        if (!conv_done && (att_done || (trip % 3) == 2)) {
            __syncthreads();
            if (F.tid == 0) CTL[2] = __hip_atomic_fetch_add(qctr + 16, 1u, __ATOMIC_RELAXED, __HIP_MEMORY_SCOPE_AGENT);
            __syncthreads();
            const int cu = (int)CTL[2];
            if (cu >= CONV_UNITS) conv_done = true; else conv_experts_items(F, l, cu * CONV_GROUP, (cu + 1) * CONV_GROUP, 1);
        }
        if (att_done) { if (conv_done) break; continue; }
        __syncthreads();
        if (F.tid == 0) { CTL[0] = nu; CTL[1] = 0u; if (nu < (unsigned)(NPIECE * NB * NH)) nu = __hip_atomic_fetch_add(qctr, 1u, __ATOMIC_RELAXED, __HIP_MEMORY_SCOPE_AGENT); }
        __syncthreads();
        const int u = (int)CTL[0];
        if (u >= NPIECE * NB * NH) { att_done = true; if (conv_done) break; continue; }
        const unsigned pc = PIECES[u >> 5]; const int bh = u & 31, b = bh >> 3, h = bh & 7;
        const int j = (int)(pc & 0xff), qlo = (int)((pc >> 8) & 0xff), qhi = (int)(pc >> 16); const int ncand = (qhi - qlo + 1) * 256;
        const size_t tokb = (size_t)b * SEQ;
        unsigned selw[15];
        u32x4 kr[4], va[2], vb[2]; float lutv = 0.f;
#pragma unroll
        for (int r = 0; r < 15; ++r) { const int qq = qlo * 256 + r * 512 + F.tid; selw[r] = (r * 512 + F.tid < ncand) ? SEL[(tokb + qq) * 8 + h] : 0u; }
#pragma unroll
        for (int it = 0; it < 4; ++it) { const int id = F.tid + 512 * it, row = id >> 3, c8 = id & 7; kr[it] = *(const u32x4*)(MO + (tokb + j * 256 + row) * 1536 + h * 64 + c8 * 8 + 512); }
#pragma unroll
        for (int it = 0; it < 2; ++it) { const int id = F.tid + 512 * it, rp = id >> 3, c8 = id & 7; const size_t ro = (tokb + j * 256 + 2 * rp) * 1536 + h * 64 + c8 * 8 + 1024;
            va[it] = *(const u32x4*)(MO + ro); vb[it] = *(const u32x4*)(MO + ro + 1536); }
        if (F.tid <= 128) { const int n = F.tid; int bucket;
            if (n < 16) bucket = n; else { int lg = 16 + (int)(logf((float)n / 16.0f) / 2.0794415416798357f * 16.0f); bucket = lg < 31 ? lg : 31; }
            lutv = relb[bucket * 8 + h]; }
#pragma unroll
        for (int r = 0; r < 15; ++r) asm volatile("" : "+v"(selw[r]));
#pragma unroll
        for (int r = 0; r < 15; ++r) { const int base = r * 512; if (base >= ncand) break;
            const int q = qlo * 256 + base + F.tid; const int qb = q >> 8; bool mem = false; unsigned ent = 0;
            if (base + F.tid >= ncand) { }
            else if (qb == j) { mem = true; ent = (unsigned)q | (3u << 16); }
            else { const unsigned s = selw[r]; const unsigned nv = s >> 24;
                if (nv > 0 && (s & 0xff) == (unsigned)j) { mem = true; ent = (unsigned)q; }
                else if (nv > 1 && ((s >> 8) & 0xff) == (unsigned)j) { mem = true; ent = (unsigned)q | (1u << 16); }
                else if (nv > 2 && ((s >> 16) & 0xff) == (unsigned)j) { mem = true; ent = (unsigned)q | (2u << 16); } }
            const unsigned long long bal = __ballot(mem); const int cnt = __popcll(bal);
            unsigned wbase = 0; if (lane == 0 && cnt > 0) wbase = __hip_atomic_fetch_add(&CTL[1], (unsigned)cnt, __ATOMIC_RELAXED, __HIP_MEMORY_SCOPE_WORKGROUP);
            wbase = (unsigned)__builtin_amdgcn_readfirstlane((int)wbase);
            if (mem) LIST[wbase + __builtin_amdgcn_mbcnt_hi((unsigned)(bal >> 32), __builtin_amdgcn_mbcnt_lo((unsigned)bal, 0u))] = ent;
        }
        __syncthreads();
        const int total = (int)CTL[1];
        const int ntile = (total + 31) >> 5;
        const int qi = lane & 31, half = lane >> 5;
        bf16x8 qfn[4]; unsigned enn = 0u;
        if (F.wave < ntile) { const int e0 = F.wave * 32 + qi; enn = LIST[e0 < total ? e0 : total - 1]; const size_t tk0 = tokb + (enn & 0xffffu);
#pragma unroll
            for (int kk = 0; kk < 4; ++kk) qfn[kk] = *(const bf16x8*)(MO + tk0 * 1536 + h * 64 + 16 * kk + 8 * half); }
#pragma unroll
        for (int it = 0; it < 4; ++it) asm volatile("" : "+v"(kr[it]));
        asm volatile("" : "+v"(va[0]), "+v"(va[1]), "+v"(vb[0]), "+v"(vb[1]), "+v"(lutv));
#pragma unroll
        for (int it = 0; it < 4; ++it) { const int id = F.tid + 512 * it, row = id >> 3, c8 = id & 7; *(LAS u32x4*)(Ks + row * KS_PITCH + c8 * 16) = kr[it]; }
#pragma unroll
        for (int it = 0; it < 2; ++it) { const int id = F.tid + 512 * it, rp = id >> 3, c8 = id & 7;
            const unsigned a[4] = {va[it].x, va[it].y, va[it].z, va[it].w}, bq[4] = {vb[it].x, vb[it].y, vb[it].z, vb[it].w};
            LAS unsigned char* vp = Vt + (c8 * 8) * VT_PITCH + rp * 4;
#pragma unroll
            for (int q = 0; q < 4; ++q) { *(LAS unsigned*)(vp + (2 * q) * VT_PITCH) = (a[q] & 0xffffu) | (bq[q] << 16); *(LAS unsigned*)(vp + (2 * q + 1) * VT_PITCH) = (a[q] >> 16) | (bq[q] & 0xffff0000u); } }
        if (F.tid <= 128) LUT[1 + F.tid] = lutv;
        if (F.tid == 129) LUT[0] = -1e30f;
        __syncthreads();
        const float bfar = LUT[129];
        for (int ad2_ = 0; ad2_ < ((ATT_DUP & 2) ? 2 : 1); ++ad2_) {
        if (ad2_ > 0 && F.wave < ntile) { const int e0 = F.wave * 32 + qi; enn = LIST[e0 < total ? e0 : total - 1]; const size_t tk0 = tokb + (enn & 0xffffu);
#pragma unroll
            for (int kk = 0; kk < 4; ++kk) qfn[kk] = *(const bf16x8*)(MO + tk0 * 1536 + h * 64 + 16 * kk + 8 * half); }
        for (int tile = F.wave; tile < ntile; tile += 8) {
            const int e = tile * 32 + qi; const bool valid = e < total; const unsigned en = enn;
            const int q = (int)(en & 0xffffu), slot = (int)(en >> 16); const size_t tok = tokb + q;
            bf16x8 qf[4];
#pragma unroll
            for (int kk = 0; kk < 4; ++kk) qf[kk] = qfn[kk];
            if (tile + 8 < ntile) { const int e1 = (tile + 8) * 32 + qi; enn = LIST[e1 < total ? e1 : total - 1]; const size_t tk1 = tokb + (enn & 0xffffu);
#pragma unroll
                for (int kk = 0; kk < 4; ++kk) qfn[kk] = *(const bf16x8*)(MO + tk1 * 1536 + h * 64 + 16 * kk + 8 * half); }
            constexpr float L2E = 1.4426950408889634f;
            float mrun = -1e30f, ls0 = 0.f, ls1 = 0.f, ls2 = 0.f, ls3 = 0.f;
            f32x16 oacc[2];
#pragma unroll
            for (int i = 0; i < 16; ++i) { oacc[0][i] = 0.f; oacc[1][i] = 0.f; }
            const int qrel0 = q - j * 256;
#pragma unroll 1
            for (int ck = 0; ck < 4; ++ck) {
                if (!__any(qrel0 >= 64 * ck)) break;
                int qrel = qrel0; asm volatile("" : "+v"(qrel));
                bf16x8 ka[2][4];
#pragma unroll
                for (int k2 = 0; k2 < 2; ++k2)
#pragma unroll
                    for (int kk = 0; kk < 4; ++kk) ka[k2][kk] = *(const LAS bf16x8*)(Ks + (32 * (2 * ck + k2) + qi) * KS_PITCH + (16 * kk + 8 * half) * 2);
                f32x16 sacc[2];
#pragma unroll
                for (int k2 = 0; k2 < 2; ++k2) {
#pragma unroll
                    for (int i = 0; i < 16; ++i) sacc[k2][i] = 0.f;
#pragma unroll
                    for (int kk = 0; kk < 4; ++kk) sacc[k2] = __builtin_amdgcn_mfma_f32_32x32x16_bf16(ka[k2][kk], qf[kk], sacc[k2], 0, 0, 0); }
                float mx = -1e30f;
                if (__any(qrel <= 64 * ck + 191)) {
#pragma unroll
                    for (int k2 = 0; k2 < 2; ++k2) {
                        float bb[16];
#pragma unroll
                        for (int i = 0; i < 16; ++i) { const int key = 32 * (2 * ck + k2) + (i & 3) + 8 * (i >> 2) + 4 * half; const int n = qrel - key;
                            bb[i] = LUT[1 + (n < -1 ? -1 : (n > 128 ? 128 : n))]; }
#pragma unroll
                        for (int i = 0; i < 16; ++i) asm volatile("" : "+v"(bb[i]));
#pragma unroll
                        for (int i = 0; i < 16; ++i) { const float s = sacc[k2][i] + bb[i]; sacc[k2][i] = s; mx = fmaxf(mx, s); } }
                } else {
#pragma unroll
                    for (int k2 = 0; k2 < 2; ++k2)
#pragma unroll
                        for (int i = 0; i < 16; ++i) { const float s = sacc[k2][i] + bfar; sacc[k2][i] = s; mx = fmaxf(mx, s); }
                }
                mx = fmaxf(mx, __shfl_xor(mx, 32));
                const float mnew = fmaxf(mrun, mx); const bool grew = __any(mnew > mrun);
                if (grew) {
                    const float alpha = __builtin_amdgcn_exp2f((mrun - mnew) * L2E);
                    ls0 *= alpha; ls1 *= alpha; ls2 *= alpha; ls3 *= alpha;
#pragma unroll
                    for (int i = 0; i < 16; ++i) { oacc[0][i] *= alpha; oacc[1][i] *= alpha; } }
                mrun = mnew;
                const float nm = -mnew * L2E;
#pragma unroll
                for (int k2 = 0; k2 < 2; ++k2) { const int kt = 2 * ck + k2;
#pragma unroll
                    for (int i = 0; i < 16; i += 4) { const float p0 = __builtin_amdgcn_exp2f(__builtin_fmaf(sacc[k2][i], L2E, nm)), p1 = __builtin_amdgcn_exp2f(__builtin_fmaf(sacc[k2][i + 1], L2E, nm)),
                                                                  p2 = __builtin_amdgcn_exp2f(__builtin_fmaf(sacc[k2][i + 2], L2E, nm)), p3 = __builtin_amdgcn_exp2f(__builtin_fmaf(sacc[k2][i + 3], L2E, nm));
                        sacc[k2][i] = p0; sacc[k2][i + 1] = p1; sacc[k2][i + 2] = p2; sacc[k2][i + 3] = p3; ls0 += p0; ls1 += p1; ls2 += p2; ls3 += p3; }
#pragma unroll
                    for (int cc = 0; cc < 2; ++cc) {
                        u32x4 pw; pw.x = pk2(sacc[k2][8 * cc], sacc[k2][8 * cc + 1]); pw.y = pk2(sacc[k2][8 * cc + 2], sacc[k2][8 * cc + 3]); pw.z = pk2(sacc[k2][8 * cc + 4], sacc[k2][8 * cc + 5]); pw.w = pk2(sacc[k2][8 * cc + 6], sacc[k2][8 * cc + 7]);
                        const bf16x8 pf = __builtin_bit_cast(bf16x8, pw);
                        const int key0 = 32 * kt + 16 * cc + 4 * half;
#pragma unroll
                        for (int dt = 0; dt < 2; ++dt) { const LAS unsigned char* vb = Vt + (32 * dt + qi) * VT_PITCH + key0 * 2;
                            const u32x2 va = *(const LAS u32x2*)vb, vb2 = *(const LAS u32x2*)(vb + 16);
                            u32x4 vw; vw.x = va.x; vw.y = va.y; vw.z = vb2.x; vw.w = vb2.y;
                            oacc[dt] = __builtin_amdgcn_mfma_f32_32x32x16_bf16(__builtin_bit_cast(bf16x8, vw), pf, oacc[dt], 0, 0, 0); } } }
            }
            float lsum = (ls0 + ls1) + (ls2 + ls3);
#pragma unroll
            for (int kk = 0; kk < 4; ++kk) asm volatile("" : "+v"(qfn[kk]));
            asm volatile("" : "+v"(enn));
            const float mx = mrun;
            lsum += __shfl_xor(lsum, 32);
            const float inv = 1.0f / lsum;
            if (valid) {
                int hf = half; asm volatile("" : "+v"(hf));
                bf16_t* op = PO + ((size_t)slot * T + tok) * CW + h * 64 + 4 * hf;
#pragma unroll
                for (int dt = 0; dt < 2; ++dt)
#pragma unroll
                    for (int ig = 0; ig < 4; ++ig) { u32x2 w; w.x = pk2(oacc[dt][4 * ig] * inv, oacc[dt][4 * ig + 1] * inv); w.y = pk2(oacc[dt][4 * ig + 2] * inv, oacc[dt][4 * ig + 3] * inv);
                        *(u32x2*)(op + 32 * dt + 8 * ig) = w; }
                if (half == 0) PST[((size_t)slot * T + tok) * 8 + h] = (f32x2){mx, lsum};
            }
        }
        }
    }
}
DI void phase_moba_combine(Frame& F) {
    const bf16_t* PO = (const bf16_t*)(F.wsp() + WS_PO); const f32x2* PST = (const f32x2*)(F.wsp() + WS_PST); const unsigned* SEL = (const unsigned*)(F.wsp() + WS_SEL);
    bf16_t* YM = (bf16_t*)(F.wsp() + WS_YRM) + 512;
    int tid = F.tid;
    for (int tb = F.bid * 16; tb < T; tb += F.G * 16) {
        int tbase = tb; asm volatile("" : "+s"(tbase), "+v"(tid));
        const int c0 = (tid & 63) * 8, h = c0 >> 6;
        int nv[2]; f32x2 st[2][4]; u32x4 po[2][4];
#pragma unroll
        for (int e = 0; e < 2; ++e) { const int t = tbase + 8 * e + (tid >> 6); nv[e] = (int)(SEL[(size_t)t * 8 + h] >> 24);
#pragma unroll
            for (int s = 0; s < 4; ++s) { st[e][s] = PST[((size_t)s * T + t) * 8 + h]; po[e][s] = __builtin_nontemporal_load((const u32x4*)(PO + ((size_t)s * T + t) * CW + c0)); } }
#pragma unroll
        for (int e = 0; e < 2; ++e) { const int t = tbase + 8 * e + (tid >> 6); float M = -1e30f;
#pragma unroll
            for (int s = 0; s < 4; ++s) { const bool on = (s == 3) || (s < nv[e]); if (on) M = fmaxf(M, st[e][s].x); }
            float den = 0.f, num[8];
#pragma unroll
            for (int j = 0; j < 8; ++j) num[j] = 0.f;
#pragma unroll
            for (int s = 0; s < 4; ++s) { const bool on = (s == 3) || (s < nv[e]); if (on) { const float w = st[e][s].y * __expf(st[e][s].x - M); den += w;
                    num[0] += w * bflo(po[e][s].x); num[1] += w * bfhi(po[e][s].x); num[2] += w * bflo(po[e][s].y); num[3] += w * bfhi(po[e][s].y);
                    num[4] += w * bflo(po[e][s].z); num[5] += w * bfhi(po[e][s].z); num[6] += w * bflo(po[e][s].w); num[7] += w * bfhi(po[e][s].w); } }
            const float inv = __builtin_amdgcn_rcpf(den);
            u32x4 o; o.x = pk2(num[0] * inv, num[1] * inv); o.y = pk2(num[2] * inv, num[3] * inv); o.z = pk2(num[4] * inv, num[5] * inv); o.w = pk2(num[6] * inv, num[7] * inv);
            *(u32x4*)(YM + (size_t)t * YRM_LD + c0) = o; }
    }
}
DI void phase_router(Frame& F, int l) {
    LAS float* xs = (LAS float*)F.lds;
    LAS float* wsm = xs + 64 * 129;
    LAS float* lgt = wsm + 128 * 36;
    LAS float* ssq = lgt + 64 * 37;
    LAS int* hist = (LAS int*)(ssq + 64);
    const float* x = F.outp(); const float* gain = F.inp(2) + (size_t)l * DM;
    const float* wgrp = F.inp(29) + (size_t)l * DM * 4; const float* wexp = F.inp(31) + (size_t)l * DM * 32;
    const float* bgrp = F.inp(30) + l * 4; const float* bexp = F.inp(32) + l * 32;
    int* EID = (int*)(F.wsp() + WS_RT + RT_EID); float* GATE = (float*)(F.wsp() + WS_RT + RT_GATE); int* HIST = (int*)(F.wsp() + WS_RT + RT_HIST);
    const int tok = F.tid & 63, jg = F.tid >> 6;
    for (int tile = F.bid; tile < T / 64; tile += F.G) {
        const int t0 = tile * 64;
        float acc[5] = {0.f, 0.f, 0.f, 0.f, 0.f}; float ss = 0.f;
        if (F.tid < 32) hist[F.tid] = 0;
        for (int kc = 0; kc < DM; kc += 128) {
            __syncthreads();
            for (int idx = F.tid; idx < 64 * 128; idx += 512) { const int r = idx >> 7, k = idx & 127; xs[r * 129 + k] = x[(size_t)(t0 + r) * DM + kc + k]; }
            for (int idx = F.tid; idx < 128 * 36; idx += 512) { const int k = idx / 36, j = idx - k * 36; const float g = gain[kc + k];
                wsm[idx] = g * (j < 4 ? wgrp[(size_t)(kc + k) * 4 + j] : wexp[(size_t)(kc + k) * 32 + (j - 4)]); }
            __syncthreads();
            for (int k = 0; k < 128; ++k) { const float xv = xs[tok * 129 + k]; ss += xv * xv;
#pragma unroll
                for (int i = 0; i < 5; ++i) { const int j = jg + 8 * i; if (j < 36) acc[i] += xv * wsm[k * 36 + j]; } }
        }
#pragma unroll
        for (int i = 0; i < 5; ++i) { const int j = jg + 8 * i; if (j < 36) lgt[tok * 37 + j] = acc[i]; }
        if (jg == 0) ssq[tok] = ss;
        __syncthreads();
        if (F.tid < 64) {
            const int t = t0 + F.tid; const float rs = 1.0f / sqrtf(ssq[F.tid] * (1.f / DM) + 1e-6f);
            float lg[4]; int gs = 0; float gm = -INFINITY;
#pragma unroll
            for (int g = 0; g < 4; ++g) { lg[g] = lgt[F.tid * 37 + g] * rs + bgrp[g]; if (lg[g] > gm) { gm = lg[g]; gs = g; } }
            float gden = 0.f;
#pragma unroll
            for (int g = 0; g < 4; ++g) gden += expf(lg[g] - gm);
            const float ptop = 1.0f / gden;
            float le[8]; float e0 = -INFINITY, e1 = -INFINITY; int j0 = 0, j1 = 1;
#pragma unroll
            for (int e = 0; e < 8; ++e) { le[e] = lgt[F.tid * 37 + 4 + gs * 8 + e] * rs + bexp[gs * 8 + e];
                if (le[e] > e0) { e1 = e0; j1 = j0; e0 = le[e]; j0 = e; } else if (le[e] > e1) { e1 = le[e]; j1 = e; } }
            const float p1 = expf(e1 - e0);
            const float g0 = ptop / (1.f + p1), g1 = ptop * p1 / (1.f + p1);
            const int ex0 = gs * 8 + j0, ex1 = gs * 8 + j1;
            EID[t * 2] = ex0; EID[t * 2 + 1] = ex1; GATE[t * 2] = g0; GATE[t * 2 + 1] = g1;
            __hip_atomic_fetch_add(&hist[ex0], 1, __ATOMIC_RELAXED, __HIP_MEMORY_SCOPE_WORKGROUP); __hip_atomic_fetch_add(&hist[ex1], 1, __ATOMIC_RELAXED, __HIP_MEMORY_SCOPE_WORKGROUP);
        }
        __syncthreads();
        if (F.tid < 32) HIST[tile * 32 + F.tid] = hist[F.tid];
        __syncthreads();
    }
}
DI void phase_moe_gather(Frame& F, int l) {
    LAS int* tot = (LAS int*)F.lds; LAS int* offA = tot + 32; LAS int* offB = offA + 32; LAS int* base = offB + 32; LAS int* eidl = base + 32; LAS int* ps = eidl + 256; LAS int* pa = ps + 512; LAS int* pb = pa + 512;
    const int* EID = (const int*)(F.wsp() + WS_RT + RT_EID); const float* GATE = (const float*)(F.wsp() + WS_RT + RT_GATE); const int* HIST = (const int*)(F.wsp() + WS_RT + RT_HIST);
    int* ROW = (int*)(F.wsp() + WS_RT + RT_ROW); float* GW = (float*)(F.wsp() + WS_RT + RT_GW); int* PEXP = (int*)(F.wsp() + WS_RT + RT_PEXP);
    int* TOK = (int*)(F.wsp() + WS_RT + RT_TOK); const float* RSQ = (const float*)(F.wsp() + WS_RT + RT_RSQ); float* RSR = (float*)(F.wsp() + WS_RT + RT_RSR);
    for (int tileA = F.bid; tileA < T / 64; tileA += 2 * F.G) {
        const int tileB = tileA + F.G; const bool hasB = tileB < T / 64;
        __syncthreads();
        { const int e = F.tid & 31, part = F.tid >> 5; int hv[32];
#pragma unroll
          for (int i = 0; i < 32; ++i) hv[i] = HIST[(part * 32 + i) * 32 + e];
          int ev = 0; if (F.tid < 256) { const int sel = F.tid >> 7; if (sel == 0 || hasB) ev = EID[(sel ? tileB : tileA) * 128 + (F.tid & 127)]; }
#pragma unroll
          for (int i = 0; i < 32; ++i) asm volatile("" : "+v"(hv[i]));
          int s = 0, oa = 0, ob = 0;
#pragma unroll
          for (int i = 0; i < 32; ++i) { const int idx = part * 32 + i; s += hv[i]; if (idx < tileA) oa += hv[i]; if (idx < tileB) ob += hv[i]; }
          ps[F.tid] = s; pa[F.tid] = oa; pb[F.tid] = ob; if (F.tid < 256) eidl[F.tid] = ev; }
        __syncthreads();
        if (F.tid < 32) { int s = 0, oa = 0, ob = 0;
#pragma unroll
            for (int q = 0; q < 16; ++q) { s += ps[q * 32 + F.tid]; oa += pa[q * 32 + F.tid]; ob += pb[q * 32 + F.tid]; }
            const int cnt = (s + 255) & ~255; int inc = cnt;
#pragma unroll
            for (int d = 1; d < 32; d <<= 1) { const int o = __shfl_up(inc, d); if (F.tid >= d) inc += o; }
            tot[F.tid] = s; offA[F.tid] = oa; offB[F.tid] = ob; base[F.tid] = inc - cnt; }
        __syncthreads();
        if (tileA == 0) {
            for (int pnl = F.tid; pnl <= MOE_PANELS; pnl += 512) {
                if (pnl == MOE_PANELS) { PEXP[MOE_PANELS] = (base[31] + ((tot[31] + 255) & ~255)) >> 8; }
                else { int e = 0;
#pragma unroll
                    for (int q = 1; q < 32; ++q) e += ((base[q] >> 8) <= pnl) ? 1 : 0;
                    PEXP[pnl] = e; } }
        }
        if (F.tid < 256 && (F.tid < 128 || hasB)) { const int sel = F.tid >> 7, idx = F.tid & 127; const int t0 = (sel ? tileB : tileA) * 64; const LAS int* el = eidl + sel * 128;
            const int my = el[idx]; int rank = 0; for (int i = 0; i < idx; ++i) rank += (el[i] == my) ? 1 : 0;
            const int r = base[my] + (sel ? offB[my] : offA[my]) + rank; ROW[t0 * 2 + idx] = r; GW[r] = GATE[t0 * 2 + idx]; TOK[r] = t0 + (idx >> 1); RSR[r] = RSQ[t0 + (idx >> 1)]; }
    }
}
DI void phase_moe_combine(Frame& F, int l, int rep = 0) {
    const bf16_t* YE = (const bf16_t*)(F.wsp() + WS_YE); const int* ROW = (const int*)(F.wsp() + WS_RT + RT_ROW); bf16_t* XN = (bf16_t*)(F.wsp() + (rep ? 258 * MiB : WS_XN));
    float* const xout = rep ? (float*)(F.wsp() + 130 * MiB) : F.outp();
    const float* gain = F.inp(1) + (size_t)(l + 1 < NLAYER ? l + 1 : l) * DM;
    const int gw = F.bid * 8 + F.wave, NGW = F.G * 8; int lane = F.lane;
    f32x4 gv[4];
#pragma unroll
    for (int j = 0; j < 4; ++j) gv[j] = ((const f32x4*)gain)[lane + 64 * j];
    for (int tb = gw * 4; tb < T; tb += NGW * 4) {
        int tbase = tb; asm volatile("" : "+s"(tbase), "+v"(lane));
        int r0[4], r1[4];
#pragma unroll
        for (int e = 0; e < 4; ++e) { r0[e] = ROW[(tbase + e) * 2]; r1[e] = ROW[(tbase + e) * 2 + 1]; }
        u32x2 ya[4][4], yb[4][4]; f32x4 xv[4][4];
#pragma unroll
        for (int e = 0; e < 4; ++e) { const u32x2* y0 = (const u32x2*)(YE + (size_t)r0[e] * DM) + lane; const u32x2* y1 = (const u32x2*)(YE + (size_t)r1[e] * DM) + lane; const f32x4* xr = (const f32x4*)(F.outp() + (size_t)(tbase + e) * DM) + lane;
#pragma unroll
            for (int j = 0; j < 4; ++j) { ya[e][j] = __builtin_nontemporal_load(y0 + 64 * j); yb[e][j] = __builtin_nontemporal_load(y1 + 64 * j); xv[e][j] = xr[64 * j]; } }
#pragma unroll
        for (int e = 0; e < 4; ++e) { const int t = tbase + e; f32x4* xr = (f32x4*)(xout + (size_t)t * DM) + lane; float s = 0.f;
#pragma unroll
            for (int j = 0; j < 4; ++j) { f32x4 v = xv[e][j]; const u32x2 a = ya[e][j], b = yb[e][j];
                v.x += bflo(a.x) + bflo(b.x); v.y += bfhi(a.x) + bfhi(b.x); v.z += bflo(a.y) + bflo(b.y); v.w += bfhi(a.y) + bfhi(b.y);
                xv[e][j] = v; xr[64 * j] = v; s += (v.x * v.x + v.y * v.y) + (v.z * v.z + v.w * v.w); }
            if (l + 1 < NLAYER) {
                const float rs = __builtin_amdgcn_rsqf(wave_sum(s) * (1.f / DM) + 1e-6f);
#pragma unroll
                for (int j = 0; j < 4; ++j) { const f32x4 y = xv[e][j] * rs * gv[j]; u32x2 w; w.x = pk2(y.x, y.y); w.y = pk2(y.z, y.w); *((u32x2*)(XN + (size_t)t * DM) + lane + 64 * j) = w; }
            } }
    }
}
constexpr size_t TB_WRH = 512 * 1024, TB_WRL = TB_WRH + 48 * 1024 * 2;
DI void phase_conv_router(Frame& F, int l) {
    bf16_t* WRH = (bf16_t*)(F.wsp() + WS_TAB + TB_WRH); bf16_t* WRL = (bf16_t*)(F.wsp() + WS_TAB + TB_WRL);
    const float* gain = F.inp(2) + (size_t)l * DM; const float* wgrp = F.inp(29) + (size_t)l * DM * 4; const float* wexp = F.inp(31) + (size_t)l * DM * 32;
    for (int idx = F.bid * 512 + F.tid; idx < 48 * DM; idx += F.G * 512) { const int n = idx >> 10, k = idx & 1023;
        float v = (n < 4) ? wgrp[k * 4 + n] : (n < 36) ? wexp[k * 32 + (n - 4)] : 0.f; v *= gain[k];
        const bf16_t h = f2bf(v); WRH[idx] = h; WRL[idx] = f2bf(v - bf2f(h)); }
}
DI void phase_router2(Frame& F, int l) {
    LAS float* lgt = (LAS float*)F.lds + F.wave * 1024;
    LAS int* hist = (LAS int*)(F.lds + 8 * 4096);
    const float* x = F.outp(); const bf16_t* WRH = (const bf16_t*)(F.wsp() + WS_TAB + TB_WRH); const bf16_t* WRL = (const bf16_t*)(F.wsp() + WS_TAB + TB_WRL);
    const float* bgrp = F.inp(30) + l * 4; const float* bexp = F.inp(32) + l * 32;
    int* EID = (int*)(F.wsp() + WS_RT + RT_EID); float* GATE = (float*)(F.wsp() + WS_RT + RT_GATE); int* HIST = (int*)(F.wsp() + WS_RT + RT_HIST);
    const int lane = F.lane, r16 = lane & 15, g = lane >> 4;
    bf16_t* XN2 = (bf16_t*)(F.wsp() + WS_AM); const float* gain = F.inp(2) + (size_t)l * DM; float* RSQ = (float*)(F.wsp() + WS_RT + RT_RSQ);
    { int* TOK = (int*)(F.wsp() + WS_RT + RT_TOK); for (int i = F.bid * 512 + F.tid; i < MOE_ROWS; i += F.G * 512) TOK[i] = 0; }
    constexpr int WH_P = 1040; LAS unsigned char* WHL = F.lds + 40960; LAS unsigned char* WLL = F.lds + 40960 + 38912;
    for (int task = F.bid; task < T / 128; task += F.G) {
        const int t0 = task * 128 + F.wave * 16;
        __syncthreads();
        if (F.tid < 64) hist[F.tid] = 0;
        __syncthreads();
        f32x4 acc[3];
#pragma unroll
        for (int nt = 0; nt < 3; ++nt) acc[nt] = (f32x4){0.f, 0.f, 0.f, 0.f};
        float ss = 0.f;
        const float* xr = x + (size_t)(t0 + r16) * DM + 8 * g; bf16_t* xo = XN2 + (size_t)(t0 + r16) * DM + 8 * g; const float* gp = gain + 8 * g;
#pragma unroll 1
        for (int kh = 0; kh < 2; ++kh) {
        { u32x4 tv[10];
#pragma unroll
          for (int i = 0; i < 10; ++i) { const int idx = F.tid + 512 * i; tv[i] = (u32x4){0u, 0u, 0u, 0u};
              if (idx < 2 * 37 * 64) { const int tb_ = idx / (37 * 64), r_ = idx - tb_ * (37 * 64), row = r_ >> 6, c16 = r_ & 63; tv[i] = *(const u32x4*)((tb_ ? WRL : WRH) + (size_t)row * DM + kh * 512 + c16 * 8); } }
#pragma unroll
          for (int i = 0; i < 10; ++i) asm volatile("" : "+v"(tv[i]));
          __syncthreads();
#pragma unroll
          for (int i = 0; i < 10; ++i) { const int idx = F.tid + 512 * i;
              if (idx < 2 * 37 * 64) { const int tb_ = idx / (37 * 64), r_ = idx - tb_ * (37 * 64), row = r_ >> 6, c16 = r_ & 63; *(LAS u32x4*)((tb_ ? WLL : WHL) + row * WH_P + c16 * 16) = tv[i]; } }
          __syncthreads(); }
#pragma unroll 1
        for (int sb = 16 * kh; sb < 16 * kh + 16; sb += 4) {
            f32x4 xa[4][2], ga[4][2];
#pragma unroll
            for (int u = 0; u < 4; ++u) { const int s = sb + u;
                xa[u][0] = *(const f32x4*)(xr + 32 * s); xa[u][1] = *(const f32x4*)(xr + 32 * s + 4); ga[u][0] = *(const f32x4*)(gp + 32 * s); ga[u][1] = *(const f32x4*)(gp + 32 * s + 4); }
#pragma unroll
            for (int u = 0; u < 4; ++u) asm volatile("" : "+v"(xa[u][0]), "+v"(xa[u][1]), "+v"(ga[u][0]), "+v"(ga[u][1]));
#pragma unroll
            for (int u = 0; u < 4; ++u) { const int s = sb + u;
                const f32x4 x0 = xa[u][0], x1 = xa[u][1];
                ss += (x0.x * x0.x + x0.y * x0.y) + (x0.z * x0.z + x0.w * x0.w) + (x1.x * x1.x + x1.y * x1.y) + (x1.z * x1.z + x1.w * x1.w);
                { const f32x4 g0 = ga[u][0], g1 = ga[u][1];
                  u32x4 w; w.x = pk2(x0.x * g0.x, x0.y * g0.y); w.y = pk2(x0.z * g0.z, x0.w * g0.w); w.z = pk2(x1.x * g1.x, x1.y * g1.y); w.w = pk2(x1.z * g1.z, x1.w * g1.w);
                  *(u32x4*)(xo + 32 * s) = w; }
                u32x4 hw, lw; hw.x = pk2(x0.x, x0.y); hw.y = pk2(x0.z, x0.w); hw.z = pk2(x1.x, x1.y); hw.w = pk2(x1.z, x1.w);
                lw.x = pk2(x0.x - bflo(hw.x), x0.y - bfhi(hw.x)); lw.y = pk2(x0.z - bflo(hw.y), x0.w - bfhi(hw.y)); lw.z = pk2(x1.x - bflo(hw.z), x1.y - bfhi(hw.z)); lw.w = pk2(x1.z - bflo(hw.w), x1.w - bfhi(hw.w));
                const bf16x8 ah = __builtin_bit_cast(bf16x8, hw), al = __builtin_bit_cast(bf16x8, lw);
#pragma unroll
                for (int nt = 0; nt < 3; ++nt) { const int rr = (16 * nt + r16 < 36) ? 16 * nt + r16 : 36; const int wo = rr * WH_P + (32 * (s - 16 * kh) + 8 * g) * 2;
                    const bf16x8 wh = *(const LAS bf16x8*)(WHL + wo), wl = *(const LAS bf16x8*)(WLL + wo);
                    acc[nt] = mfma16(ah, wh, acc[nt]); acc[nt] = mfma16(ah, wl, acc[nt]); acc[nt] = mfma16(al, wh, acc[nt]); } }
        }
        }
        ss += __shfl_xor(ss, 16); ss += __shfl_xor(ss, 32);
        if (g == 0) RSQ[t0 + r16] = __builtin_amdgcn_rsqf(ss * (1.f / DM) + 1e-6f);
#pragma unroll
        for (int nt = 0; nt < 3; ++nt)
#pragma unroll
            for (int r = 0; r < 4; ++r) lgt[(4 * g + r) * 48 + 16 * nt + r16] = acc[nt][r];
        if (g == 0) lgt[768 + r16] = ss;
        LDS_WAIT(); asm volatile("" ::: "memory");
        if (lane < 16) {
            const int t = t0 + lane; const float rs = 1.0f / sqrtf(lgt[768 + lane] * (1.f / DM) + 1e-6f); const LAS float* lr = lgt + lane * 48;
            float lg[4]; int gs = 0; float gm = -INFINITY;
#pragma unroll
            for (int q = 0; q < 4; ++q) { lg[q] = lr[q] * rs + bgrp[q]; if (lg[q] > gm) { gm = lg[q]; gs = q; } }
            float gden = 0.f;
#pragma unroll
            for (int q = 0; q < 4; ++q) gden += expf(lg[q] - gm);
            const float ptop = 1.0f / gden;
            float e0 = -INFINITY, e1 = -INFINITY; int j0 = 0, j1 = 1;
#pragma unroll
            for (int e = 0; e < 8; ++e) { const float le = lr[4 + gs * 8 + e] * rs + bexp[gs * 8 + e];
                if (le > e0) { e1 = e0; j1 = j0; e0 = le; j0 = e; } else if (le > e1) { e1 = le; j1 = e; } }
            const float p1 = expf(e1 - e0);
            const float g0 = ptop / (1.f + p1), g1 = ptop * p1 / (1.f + p1);
            const int ex0 = gs * 8 + j0, ex1 = gs * 8 + j1;
            EID[t * 2] = ex0; EID[t * 2 + 1] = ex1; GATE[t * 2] = g0; GATE[t * 2 + 1] = g1;
            LAS int* hh = hist + (F.wave >> 2) * 32;
            __hip_atomic_fetch_add(&hh[ex0], 1, __ATOMIC_RELAXED, __HIP_MEMORY_SCOPE_WORKGROUP); __hip_atomic_fetch_add(&hh[ex1], 1, __ATOMIC_RELAXED, __HIP_MEMORY_SCOPE_WORKGROUP);
        }
        __syncthreads();
        if (F.tid < 64) HIST[(task * 2 + (F.tid >> 5)) * 32 + (F.tid & 31)] = hist[F.tid];
    }
}
#ifndef MK_PER_PHASE_LAUNCH
#define MK_PER_PHASE_LAUNCH 0
#endif
constexpr int PH_PER_LAYER = 19, NPHASE = PH_PER_LAYER * NLAYER;
struct Args { const float* in[36]; float* out; unsigned char* ws; int ph_lo, ph_hi; };

#ifndef SCAN_NAIVE
#define SCAN_NAIVE 0
#endif
#ifndef PHMASK
#define PHMASK 0x7ffff
#endif
#ifndef DUPMASK
#define DUPMASK 0
#endif
#define NREP(k) ((((DUPMASK) >> (k)) & 1) ? 2 : 1)
#define IN(k) (((PHMASK >> ((k) % PH_PER_LAYER)) & 1) && lo <= (k) && (k) < hi)
#define SEAM(k) do { asm volatile("" : "+s"(barp), "+s"(bar.x)); bar.bar = (unsigned*)barp; if (IN(k) && IN((k) + 1)) xcd_barrier(bar); asm volatile("" : "+s"(F.ws_g), "+s"(F.out_g), "+s"(F.ka), "+s"(F.bid), "+s"(F.G), "+s"(F.lds)); } while (0)
#define FRESH() do { asm volatile("" : "+s"(F.wave)); int l_ = (int)__builtin_amdgcn_mbcnt_hi(~0u, __builtin_amdgcn_mbcnt_lo(~0u, 0u)); asm volatile("" : "+v"(l_)); F.lane = l_; F.tid = F.wave * 64 + l_; } while (0)
__global__ void __launch_bounds__(512, 2) fwd_kernel(Args args) {
    extern __shared__ __attribute__((aligned(16))) unsigned char lds_raw[];
    Frame F;
    F.lds = (LAS unsigned char*)lds_raw;
    F.tid = threadIdx.x; F.lane = F.tid & 63; F.wave = __builtin_amdgcn_readfirstlane(F.tid >> 6);
    F.G = gridDim.x; F.bid = blockIdx.x;
    F.ka = (const __attribute__((address_space(4))) unsigned char*)__builtin_amdgcn_kernarg_segment_ptr();
    F.out_g = (GAS float*)args.out; F.ws_g = (GAS unsigned char*)args.ws;
    volatile LAS unsigned* MISC = (volatile LAS unsigned*)(F.lds + MISC_OFF);
    if (F.tid < 32) MISC[F.tid] = 0u;
    __syncthreads();
    const int lo = args.ph_lo, hi = args.ph_hi;
    GAS unsigned* barp = (GAS unsigned*)(F.ws_g + WS_CTL) + CW_BAR;
    XcdBarrier bar; bar.bar = (unsigned*)barp; bar.x = 0; bar.st = nullptr;
    if (hi - lo > 1) bar = xcd_barrier_post((unsigned*)barp, MISC + 8);

    bf16_t* const XN = (bf16_t*)(F.wsp() + WS_XN);
    bf16_t* const WCAT = (bf16_t*)(F.wsp() + WS_WM + WM_WCAT);
    for (int l = 0; l < NLAYER; ++l) {
        const int P = l * PH_PER_LAYER;
#define PHASE(k) if (IN(P + (k))) for (int rep_ = 0; rep_ < NREP(k); ++rep_)
        PHASE(0) { FRESH(); if (l == 0) { phase_conv_mixer(F, 0); phase_conv_lora2(F, 0); phase_conv_router(F, 0); phase_norm_x(F, F.inp(0), F.inp(1)); } }
        if (l == 0) SEAM(P + 0);
#if defined(XTRA_BARS)
        if (hi - lo > 1) for (int xb_ = 0; xb_ < XTRA_BARS; ++xb_) { asm volatile("" : "+s"(barp), "+s"(bar.x)); bar.bar = (unsigned*)barp; xcd_barrier(bar); }
#endif
        PHASE(1) { FRESH(); const int n1 = (l == 0) ? 2048 : 2304;
            pg8::Gemm g{XN, WCAT, T, n1, DM}; pg8::StaticOrder S; S.init(T, n1, F.G, F.bid);
            pg8::EpiStore E{(bf16_t*)(F.wsp() + WS_RW), 1536, 1536, (bf16_t*)(F.wsp() + WS_LO), LO_W, 0};
            pg8::gemm_phase<pg8::EpiStore, pg8::StaticOrder>(F.lds, g, S, E, F.tid); }
        SEAM(P + 1);
        PHASE(2) { FRESH(); phase_prep_scana(F, l); }
        SEAM(P + 2);
        PHASE(4) { FRESH(); if (F.bid < NB * NH && F.G > 2 * NB * NH) phase_scan_b(F, l); else if (F.G > 2 * NB * NH) phase_scan_c(F, l, NB * NH); else {   } }
        SEAM(P + 5);
        PHASE(6) { FRESH(); pg8::Gemm g{XN, WCAT + (size_t)2304 * DM, T, 1536, DM}; pg8::StaticOrder S; S.init(T, 1536, F.G, F.bid);
            pg8::EpiMoba E{(bf16_t*)(F.wsp() + WS_MO), F.inp(23) + l * 64, F.inp(24) + l * 64, (float*)(F.wsp() + WS_TAB + TB_KMEAN), (int)(TB_KMEAN2 / 4)};
            pg8::gemm_phase<pg8::EpiMoba, pg8::StaticOrder>(F.lds, g, S, E, F.tid); }
        SEAM(P + 6);
        PHASE(8) { FRESH(); phase_moba_gate(F); }
        SEAM(P + 8);
        PHASE(9) { FRESH(); phase_moba_attn(F, l, rep_); }
        SEAM(P + 9);
        PHASE(10) { FRESH(); phase_moba_combine(F); }
        PHASE(11) { FRESH(); pg8::Gemm g{XN, WCAT + (size_t)3840 * DM, T, 2048, DM}; pg8::StaticOrder S; S.init(T, 2048, F.G, F.bid);
            pg8::EpiStore E{(bf16_t*)(F.wsp() + WS_GA0), 1536, 1536, (bf16_t*)(F.wsp() + WS_GA1), 512, 1};
            pg8::gemm_phase<pg8::EpiStore, pg8::StaticOrder>(F.lds, g, S, E, F.tid); }
        SEAM(P + 11);
        PHASE(12) { FRESH(); pg8::Gemm g{(const bf16_t*)(F.wsp() + WS_YRM), (const bf16_t*)(F.wsp() + WS_WM + WM_BRR), T, DM, DM}; pg8::StaticOrder S; S.init(T, DM, F.G, F.bid);
            pg8::EpiBranch2 E{(bf16_t*)(F.wsp() + WS_H), (const bf16_t*)(F.wsp() + WS_GA0), (const bf16_t*)(F.wsp() + WS_GA1)};
            pg8::gemm_phase<pg8::EpiBranch2, pg8::StaticOrder>(F.lds, g, S, E, F.tid); }
        SEAM(P + 12);
        PHASE(13) { FRESH(); pg8::Gemm g{(const bf16_t*)(F.wsp() + WS_H), (const bf16_t*)(F.wsp() + WS_WM + WM_OUT), T, DM, DM}; pg8::StaticOrder S; S.init(T, DM, F.G, F.bid);
            pg8::EpiResid E{l == 0 ? F.inp(0) : F.outp(), rep_ ? (float*)(F.wsp() + WS_GA) : (float*)F.outp()};
            pg8::gemm_phase<pg8::EpiResid, pg8::StaticOrder>(F.lds, g, S, E, F.tid); }
        SEAM(P + 13);
        PHASE(14) { FRESH(); phase_router2(F, l); }
        SEAM(P + 14);
        PHASE(15) { FRESH(); phase_moe_gather(F, l); }
        SEAM(P + 15);
        PHASE(16) { FRESH(); const int* PEXP = (const int*)(F.wsp() + WS_RT + RT_PEXP); const int np = __builtin_amdgcn_readfirstlane(PEXP[MOE_PANELS]);
            pg8::Gemm g{(const bf16_t*)(F.wsp() + WS_AM), (const bf16_t*)(F.wsp() + WS_WE), np * 256, 1024, DM}; pg8::GatherOrder S; S.init(np * 256, 1024, F.G, F.bid); S.pexp = PEXP;
            LAS int* tokL = (LAS int*)(F.lds + RING_BYTES); S.tokL = tokL;
            { const int* TOK = (const int*)(F.wsp() + WS_RT + RT_TOK); __syncthreads();
              for (int i0 = 0; i0 < 16; i0 += 8) { int tv[8];
#pragma unroll
                for (int i = 0; i < 8; ++i) { pg8::Unit uu; tv[i] = 0; if (S.next(i0 + i, uu) && F.tid < 256) tv[i] = TOK[uu.pm * 256 + F.tid]; }
#pragma unroll
                for (int i = 0; i < 8; ++i) asm volatile("" : "+v"(tv[i]));
#pragma unroll
                for (int i = 0; i < 8; ++i) if (F.tid < 256) tokL[(i0 + i) * 256 + F.tid] = tv[i];
                pg8::Unit uu; if (!S.next(i0 + 8, uu)) break; }
              __syncthreads(); }
            pg8::EpiExpertUp E{(bf16_t*)(F.wsp() + WS_HM), (const float*)(F.wsp() + WS_RT + RT_GW), (const float*)(F.wsp() + WS_RT + RT_RSR)};
            pg8::gemm_phase<pg8::EpiExpertUp, pg8::GatherOrder>(F.lds, g, S, E, F.tid); }
        SEAM(P + 16);
        PHASE(17) { FRESH(); const int* PEXP = (const int*)(F.wsp() + WS_RT + RT_PEXP); const int np = __builtin_amdgcn_readfirstlane(PEXP[MOE_PANELS]);
            pg8::Gemm g{(const bf16_t*)(F.wsp() + WS_HM), (const bf16_t*)(F.wsp() + WS_WD), np * 256, 1024, DEXP}; pg8::GroupOrder S; S.init(np * 256, 1024, F.G, F.bid); S.pexp = PEXP;
            pg8::EpiStore E{(bf16_t*)(F.wsp() + WS_YE), 1024, 0, nullptr, 0, 0};
            pg8::gemm_phase<pg8::EpiStore, pg8::GroupOrder>(F.lds, g, S, E, F.tid); }
        SEAM(P + 17);
        PHASE(18) { FRESH(); phase_moe_combine(F, l, rep_); if (l + 1 < NLAYER) { phase_conv_mixer(F, l + 1); phase_conv_lora2(F, l + 1); phase_conv_router(F, l + 1); } }
        SEAM(P + 18);
#undef PHASE
    }
}

extern "C" void kernel_launch(void* const* d_in, const int* in_sizes, int n_in, void* d_out, int out_size, void* d_ws, size_t ws_size, hipStream_t stream) {
    static int grid = 0;
    if (grid == 0) {
        if (n_in != 36 || out_size != T * DM || ws_size < WS_NEED) { fprintf(stderr, "kernel_launch: unexpected problem (n_in %d, out %d, ws %zu); nothing launched\n", n_in, out_size, ws_size); grid = -1; return; }
        int dev = 0, cus = 0;
        if (hipGetDevice(&dev) != hipSuccess || hipDeviceGetAttribute(&cus, hipDeviceAttributeMultiprocessorCount, dev) != hipSuccess) { grid = -1; return; }
        if (hipFuncSetAttribute((const void*)fwd_kernel, hipFuncAttributeMaxDynamicSharedMemorySize, LDS_BYTES) != hipSuccess) { fprintf(stderr, "kernel_launch: hipFuncSetAttribute failed\n"); grid = -1; return; }
        int per_cu = 0;
        if (hipOccupancyMaxActiveBlocksPerMultiprocessor(&per_cu, (const void*)fwd_kernel, 512, LDS_BYTES) != hipSuccess || per_cu < 1) { fprintf(stderr, "kernel_launch: occupancy query says %d\n", per_cu); }
        (void)hipGetLastError();
        grid = cus;
    }
    if (grid < 0) return;
    (void)hipMemsetAsync((char*)d_ws + WS_CTL, 0, CTL_ZERO_BYTES, stream);
    Args a{};
    for (int i = 0; i < 36; ++i) a.in[i] = (const float*)d_in[i];
    a.out = (float*)d_out; a.ws = (unsigned char*)d_ws;
#if MK_PER_PHASE_LAUNCH
    for (int ph = 0; ph < NPHASE; ++ph) { if (ph == PH_PER_LAYER) continue; a.ph_lo = ph; a.ph_hi = ph + 1; hipLaunchKernelGGL(fwd_kernel, dim3(grid), dim3(512), LDS_BYTES, stream, a); }
#else
    a.ph_lo = 0; a.ph_hi = NPHASE;
    hipLaunchKernelGGL(fwd_kernel, dim3(grid), dim3(512), LDS_BYTES, stream, a);
#endif
}
```
